# Optimizing an MI355X kernel written in HIP

```python
import math
import jax, jax.numpy as jnp
from jax import lax
import numpy as np

D_MODEL = 1024
BATCH = 4
SEQ = 4096
DEPTH = 4
DEC_BATCH = 16
DEC_SEQ = 4096
PAST_LEN = 128

F32 = jnp.float32
NORM_EPS = 1e-6
NEG_INF = -1e30

ATT_HEAD_DIM = 64
ATT_WIDTH = D_MODEL // 2
ATT_HEADS = ATT_WIDTH // ATT_HEAD_DIM
RWKV_HEAD_DIM = 64
RWKV_WIDTH = D_MODEL - ATT_WIDTH
RWKV_HEADS = RWKV_WIDTH // RWKV_HEAD_DIM
MIX_WIDTH = ATT_WIDTH + RWKV_WIDTH

DILATIONS = ((128, 1), (512, 4), (2048, 16))
ROPE_THETA = 500000.0
ROPE_DIM = ATT_HEAD_DIM // 4

DECAY_LORA = 64
ICLR_LORA = 64
GATE_LORA = 128
LN_X_EPS = 64e-5
RWKV_COLS = 3 * RWKV_WIDTH + 2 * DECAY_LORA + 2 * ICLR_LORA + GATE_LORA
IN_COLS = 3 * ATT_WIDTH + RWKV_COLS

PEER_HEADS = 8
PEER_N_KEYS = 128
PEER_N_EXPERTS = PEER_N_KEYS * PEER_N_KEYS
PEER_KEY_DIM = 256
PEER_TOPK = 16
PEER_BLOCK = 256

PLE_DIM = 256

kernel_name = 'hybrid_dilated_attn_rwkv7_peer_encoder'


def rms_norm(x, g):
    xf = x.astype(F32)
    y = xf * lax.rsqrt(jnp.mean(xf * xf, axis=-1, keepdims=True) + NORM_EPS)
    return (y * g.astype(F32)).astype(x.dtype)


def partial_rotary(t):
    s = t.shape[1]
    half = ROPE_DIM // 2
    inv_freq = ROPE_THETA ** (-jnp.arange(half, dtype=F32) / half)
    ang = jnp.arange(s, dtype=F32)[:, None] * inv_freq[None, :]
    cos = jnp.cos(ang)[None, :, None, :]
    sin = jnp.sin(ang)[None, :, None, :]
    tf = t.astype(F32)
    x1, x2, rest = tf[..., :half], tf[..., half:ROPE_DIM], tf[..., ROPE_DIM:]
    out = jnp.concatenate([x1 * cos - x2 * sin, x2 * cos + x1 * sin, rest], axis=-1)
    return out.astype(t.dtype)


def dilated_band_partial(q, k, v, window, dilation):
    b, s, h, dh = q.shape
    half = window // (2 * dilation)
    blk = half
    n_len = s // dilation
    nb = -(-n_len // blk)
    lp = nb * blk
    n = b * dilation

    def to_classes(t):
        t = jnp.moveaxis(t.reshape(b, n_len, dilation, h, dh), 2, 1).reshape(n, n_len, h, dh)
        t = jnp.pad(t, ((0, 0), (0, lp - n_len), (0, 0), (0, 0)))
        return t.reshape(n, nb, blk, h, dh)

    def band(t):
        tp = jnp.pad(t, ((0, 0), (1, 1), (0, 0), (0, 0), (0, 0)))
        return jnp.concatenate([tp[:, :-2], tp[:, 1:-1], tp[:, 2:]], axis=2)

    def from_classes(t):
        rest = t.shape[3:]
        t = t.reshape((b, dilation, lp) + rest)[:, :, :n_len]
        return jnp.moveaxis(t, 1, 2).reshape((b, s) + rest)

    qb = to_classes(q)
    kb = band(to_classes(k))
    vb = band(to_classes(v))
    scores = jnp.einsum('nbqhd,nbkhd->nbhqk', qb, kb).astype(F32) * (dh ** -0.5)
    qpos = jnp.arange(nb)[:, None] * blk + jnp.arange(blk)[None, :]
    kpos = jnp.arange(nb)[:, None] * blk - blk + jnp.arange(3 * blk)[None, :]
    rel = kpos[:, None, :] - qpos[:, :, None]
    valid = (jnp.abs(rel) <= half) & (kpos[:, None, :] >= 0) & (kpos[:, None, :] < n_len)
    scores = jnp.where(valid[None, :, None], scores, NEG_INF)
    m = scores.max(axis=-1)
    p = jnp.exp(scores - m[..., None])
    l = p.sum(axis=-1)
    o = jnp.einsum('nbhqk,nbkhd->nbqhd', p, vb.astype(F32))
    m = jnp.swapaxes(m, 2, 3)
    l = jnp.swapaxes(l, 2, 3)
    return from_classes(o), from_classes(m), from_classes(l)


def dilated_attention(q, k, v, norm_g):
    b, s, _ = q.shape
    heads = lambda t: t.reshape(b, s, ATT_HEADS, ATT_HEAD_DIM)
    q = partial_rotary(heads(q))
    k = partial_rotary(heads(k))
    v = heads(v)
    parts = [dilated_band_partial(q, k, v, w, d) for w, d in DILATIONS]
    m_max = jnp.max(jnp.stack([pm for _, pm, _ in parts]), axis=0)
    num = sum(jnp.exp(pm - m_max)[..., None] * po for po, pm, _ in parts)
    den = sum(jnp.exp(pm - m_max) * pl for _, pm, pl in parts)
    o = num / den[..., None]
    o = o * lax.rsqrt(jnp.mean(o * o, axis=-1, keepdims=True) + NORM_EPS)
    return (o.reshape(b, s, ATT_WIDTH) * norm_g).astype(q.dtype)


def centred_shift(u, w):
    prev = jnp.pad(u[:, :-1], ((0, 0), (1, 0), (0, 0)))
    nxt = jnp.pad(u[:, 1:], ((0, 0), (0, 1), (0, 0)))
    return w[0] * prev + w[1] * u + w[2] * nxt


def wkv_scan(r, w, k, v, a, b, reverse):
    bsz, _, h, n = r.shape
    seq = tuple(t.astype(F32).transpose(1, 0, 2, 3) for t in (r, w, k, v, a, b))

    def step(state, inp):
        r_t, w_t, k_t, v_t, a_t, b_t = inp
        sa = jnp.einsum('bhvk,bhk->bhv', state, a_t)
        state = state * w_t[:, :, None, :] + sa[..., None] * b_t[:, :, None, :] + v_t[..., None] * k_t[:, :, None, :]
        return state, jnp.einsum('bhvk,bhk->bhv', state, r_t)

    _, ys = lax.scan(step, jnp.zeros((bsz, h, n, n), F32), seq, reverse=reverse)
    return ys.transpose(1, 0, 2, 3)


def rwkv_time_mix(u, shift_w, w0, w2, a0, a2, g2, k_k, k_a, r_k, ln_w, ln_b):
    bsz, s, _ = u.shape
    u = centred_shift(u, shift_w)
    sizes = [RWKV_WIDTH, RWKV_WIDTH, RWKV_WIDTH, DECAY_LORA, DECAY_LORA, ICLR_LORA, ICLR_LORA]
    offsets = []
    acc = 0
    for sz in sizes:
        acc += sz
        offsets.append(acc)
    r, k, v, wd_f, wd_b, ad_f, ad_b, gd = jnp.split(u, offsets, axis=-1)
    g = jax.nn.sigmoid(gd) @ g2
    heads = lambda t: t.reshape(bsz, s, RWKV_HEADS, RWKV_HEAD_DIM)
    kk = heads(k * k_k).astype(F32)
    kk = kk / jnp.maximum(jnp.linalg.norm(kk, axis=-1, keepdims=True), 1e-12)

    def direction(wd, ad, d, reverse):
        w_log = -jax.nn.softplus(-(w0[d] + jnp.tanh(wd) @ w2[d])) - 0.5
        decay = jnp.exp(-jnp.exp(w_log.astype(F32)))
        a = jax.nn.sigmoid(a0[d] + ad @ a2[d])
        kd = k * (1.0 + (a - 1.0) * k_a)
        y = wkv_scan(heads(r), heads(decay), heads(kd), heads(v), -kk, kk * heads(a).astype(F32), reverse)
        return y, kd

    y_f, k_f = direction(wd_f, ad_f, 0, False)
    y_b, k_b = direction(wd_b, ad_b, 1, True)
    y = y_f + y_b
    mu = jnp.mean(y, axis=-1, keepdims=True)
    var = jnp.mean(jnp.square(y - mu), axis=-1, keepdims=True)
    y = (y - mu) * lax.rsqrt(var + LN_X_EPS)
    y = y.reshape(bsz, s, RWKV_WIDTH) * ln_w + ln_b
    bonus = jnp.sum(heads(r * (k_f + k_b)) * r_k, axis=-1, keepdims=True) * heads(v)
    return (y.astype(u.dtype) + bonus.reshape(bsz, s, RWKV_WIDTH)) * g


def peer_ffn(x, w_q, sub_keys, u_tab, v_tab):
    bsz, s, d = x.shape
    t = bsz * s
    xt = x.reshape(t, d)
    q = (xt @ w_q).reshape(t, PEER_HEADS, 2, PEER_KEY_DIM // 2)
    scores = jnp.einsum('thpc,hpnc->thpn', q, sub_keys).astype(F32)
    top_s, top_i = lax.top_k(scores, PEER_TOPK)
    cand_s = (top_s[:, :, 0, :, None] + top_s[:, :, 1, None, :]).reshape(t, PEER_HEADS, PEER_TOPK * PEER_TOPK)
    cand_i = (top_i[:, :, 0, :, None] * PEER_N_KEYS + top_i[:, :, 1, None, :]).reshape(t, PEER_HEADS, PEER_TOPK * PEER_TOPK)
    best_s, pos = lax.top_k(cand_s, PEER_TOPK)
    expert = jnp.take_along_axis(cand_i, pos, axis=-1)
    gate = jax.nn.softmax(best_s, axis=-1)
    chunk = math.gcd(t, PEER_BLOCK)
    nc = t // chunk

    def expert_block(args):
        xc, ec, gc = args
        u = jnp.take(u_tab, ec, axis=0)
        hid = jax.nn.gelu(jnp.einsum('chkd,cd->chk', u, xc).astype(F32), approximate=False)
        vv = jnp.take(v_tab, ec, axis=0)
        return jnp.einsum('chk,chkd->cd', (gc * hid).astype(x.dtype), vv)

    out = lax.map(expert_block, (xt.reshape(nc, chunk, d),
                                 expert.reshape(nc, chunk, PEER_HEADS, PEER_TOPK),
                                 gate.reshape(nc, chunk, PEER_HEADS, PEER_TOPK)))
    return out.reshape(bsz, s, d)


def encoder_layer(h, p_i, norm_mix_g, w_in, att_norm_g, rwkv_shift, rwkv_w0, rwkv_w2, rwkv_a0, rwkv_a2,
                  rwkv_g2, rwkv_k_k, rwkv_k_a, rwkv_r_k, rwkv_ln_w, rwkv_ln_b, w_out, norm_ffn_g,
                  peer_w_q, peer_sub_keys, peer_u, peer_v, ple_norm_g, ple_w_gate, ple_b_gate, ple_w_proj):
    xn = rms_norm(h, norm_mix_g)
    proj = xn @ w_in
    q, k, v = jnp.split(proj[..., :3 * ATT_WIDTH], 3, axis=-1)
    att = dilated_attention(q, k, v, att_norm_g)
    rw = rwkv_time_mix(proj[..., 3 * ATT_WIDTH:], rwkv_shift, rwkv_w0, rwkv_w2, rwkv_a0, rwkv_a2,
                       rwkv_g2, rwkv_k_k, rwkv_k_a, rwkv_r_k, rwkv_ln_w, rwkv_ln_b)
    h = h + jnp.concatenate([att, rw], axis=-1) @ w_out
    h = h + peer_ffn(rms_norm(h, norm_ffn_g), peer_w_q, peer_sub_keys, peer_u, peer_v)
    gate = jax.nn.sigmoid(rms_norm(h, ple_norm_g) @ ple_w_gate + ple_b_gate)
    return h + gate * (p_i @ ple_w_proj)


def encoder_trunk(x, p, weights, final_norm_g):
    h = x
    for i in range(DEPTH):
        h = encoder_layer(h, p[i], *[w[i] for w in weights])
    return rms_norm(h, final_norm_g)


def setup_inputs(seed: int = 0) -> dict:
    key = jax.random.key(seed)
    keys = jax.random.split(key, 32)

    def nrm(i, shape, scale):
        return jax.random.normal(keys[i], shape, F32) * scale

    def gain(i, shape):
        return 1.0 + nrm(i, shape, 0.05)

    shift_base = jnp.array([0.25, 0.5, 0.25], F32)[None, :, None]
    return {
        'x_prompt': nrm(0, (BATCH, SEQ, D_MODEL), 1.0),
        'x_sample': nrm(1, (DEC_BATCH, DEC_SEQ, D_MODEL), 1.0),
        'p_prompt': nrm(2, (DEPTH, BATCH, SEQ, PLE_DIM), 1.0),
        'p_sample': nrm(3, (DEPTH, DEC_BATCH, DEC_SEQ, PLE_DIM), 1.0),
        'norm_mix_g': gain(4, (DEPTH, D_MODEL)),
        'w_in': nrm(5, (DEPTH, D_MODEL, IN_COLS), D_MODEL ** -0.5),
        'att_norm_g': gain(6, (DEPTH, ATT_WIDTH)),
        'rwkv_shift': shift_base + nrm(7, (DEPTH, 3, RWKV_COLS), 0.1),
        'rwkv_w0': -0.5 + nrm(8, (DEPTH, 2, RWKV_WIDTH), 0.5),
        'rwkv_w2': nrm(9, (DEPTH, 2, DECAY_LORA, RWKV_WIDTH), 0.1),
        'rwkv_a0': nrm(10, (DEPTH, 2, RWKV_WIDTH), 0.5),
        'rwkv_a2': nrm(11, (DEPTH, 2, ICLR_LORA, RWKV_WIDTH), ICLR_LORA ** -0.5),
        'rwkv_g2': nrm(12, (DEPTH, GATE_LORA, RWKV_WIDTH), GATE_LORA ** -0.5),
        'rwkv_k_k': 0.85 + nrm(13, (DEPTH, RWKV_WIDTH), 0.1),
        'rwkv_k_a': gain(14, (DEPTH, RWKV_WIDTH)),
        'rwkv_r_k': nrm(15, (DEPTH, RWKV_HEADS, RWKV_HEAD_DIM), 0.1),
        'rwkv_ln_w': gain(16, (DEPTH, RWKV_WIDTH)),
        'rwkv_ln_b': nrm(17, (DEPTH, RWKV_WIDTH), 0.02),
        'w_out': nrm(18, (DEPTH, MIX_WIDTH, D_MODEL), MIX_WIDTH ** -0.5),
        'norm_ffn_g': gain(19, (DEPTH, D_MODEL)),
        'peer_w_q': nrm(20, (DEPTH, D_MODEL, PEER_HEADS * PEER_KEY_DIM), D_MODEL ** -0.5),
        'peer_sub_keys': nrm(21, (DEPTH, PEER_HEADS, 2, PEER_N_KEYS, PEER_KEY_DIM // 2), (PEER_KEY_DIM // 2) ** -0.5),
        'peer_u': nrm(22, (DEPTH, PEER_N_EXPERTS, D_MODEL), D_MODEL ** -0.5),
        'peer_v': nrm(23, (DEPTH, PEER_N_EXPERTS, D_MODEL), 0.2),
        'ple_norm_g': gain(24, (DEPTH, D_MODEL)),
        'ple_w_gate': nrm(25, (DEPTH, D_MODEL, D_MODEL), D_MODEL ** -0.5),
        'ple_b_gate': nrm(26, (DEPTH, D_MODEL), 0.02),
        'ple_w_proj': nrm(27, (DEPTH, PLE_DIM, D_MODEL), PLE_DIM ** -0.5),
        'final_norm_g': gain(28, (D_MODEL,)),
    }


def reference(x_prompt, x_sample, p_prompt, p_sample, norm_mix_g, w_in, att_norm_g, rwkv_shift,
              rwkv_w0, rwkv_w2, rwkv_a0, rwkv_a2, rwkv_g2, rwkv_k_k, rwkv_k_a, rwkv_r_k, rwkv_ln_w,
              rwkv_ln_b, w_out, norm_ffn_g, peer_w_q, peer_sub_keys, peer_u, peer_v, ple_norm_g,
              ple_w_gate, ple_b_gate, ple_w_proj, final_norm_g):
    weights = (norm_mix_g, w_in, att_norm_g, rwkv_shift, rwkv_w0, rwkv_w2, rwkv_a0, rwkv_a2, rwkv_g2,
               rwkv_k_k, rwkv_k_a, rwkv_r_k, rwkv_ln_w, rwkv_ln_b, w_out, norm_ffn_g, peer_w_q,
               peer_sub_keys, peer_u, peer_v, ple_norm_g, ple_w_gate, ple_b_gate, ple_w_proj)
    y_prompt = encoder_trunk(x_prompt, p_prompt, weights, final_norm_g)
    y_sample = encoder_trunk(x_sample, p_sample, weights, final_norm_g)
    return (y_prompt, y_sample)
```

```cpp
#include <hip/hip_runtime.h>
#include <stdint.h>
#include <stdio.h>

#ifndef ONE_LAUNCH
#define ONE_LAUNCH 1
#endif

typedef unsigned short bf16_t;
typedef float f32x4 __attribute__((ext_vector_type(4)));
typedef float f32x2 __attribute__((ext_vector_type(2)));
typedef unsigned u32x4 __attribute__((ext_vector_type(4)));
typedef unsigned u32x2 __attribute__((ext_vector_type(2)));
typedef __bf16 bf16x2_t __attribute__((ext_vector_type(2)));

#define DEV __device__ __forceinline__

namespace cfg {
constexpr int NSEQ = 20, SEQ = 4096, T = NSEQ * SEQ, TP = 4 * SEQ, D = 1024, NL = 4;
constexpr int INC = 3456, INP = 3584;
constexpr int QKVW = 1536, UW = 2048, UC = 1920;
constexpr int NWG = 256, NTHR = 512;
constexpr int LDS_BYTES = 147456;
constexpr size_t MiB = 1ull << 20;
constexpr size_t WB_OFF = 0;
constexpr size_t WB_LAYER = 16 * MiB;
constexpr size_t WB_IN = 0, WB_OUT = 7 * MiB, WB_QK = 9 * MiB, WB_GATE = 13 * MiB, WB_PROJ = 15 * MiB;
constexpr size_t HB_OFF = 64 * MiB;
constexpr size_t MIX_OFF = 224 * MiB;
constexpr size_t SMALL_OFF = 384 * MiB;
constexpr size_t RSTD_OFF = SMALL_OFF;
constexpr size_t ROPEC_OFF = SMALL_OFF + 512 * 1024, ROPES_OFF = SMALL_OFF + 640 * 1024;
constexpr size_t BAR_OFF = SMALL_OFF + 1 * MiB;
constexpr size_t BIG_OFF = 386 * MiB;
constexpr size_t QKV_OFF = BIG_OFF;
constexpr size_t WF_OFF = BIG_OFF, WB2_OFF = BIG_OFF + 80 * MiB, AF_OFF = BIG_OFF + 160 * MiB;
constexpr size_t U_OFF = BIG_OFF + 240 * MiB;
constexpr size_t AB_OFF = BIG_OFF + 560 * MiB;
constexpr size_t YF_OFF = BIG_OFF + 640 * MiB, YB_OFF = BIG_OFF + 720 * MiB;
constexpr size_t SC_OFF = BIG_OFF;
constexpr size_t TOPI_OFF = BIG_OFF + 640 * MiB, TOPG_OFF = BIG_OFF + 680 * MiB;
constexpr size_t PTU_OFF = BIG_OFF + 720 * MiB, PTV_OFF = BIG_OFF + 752 * MiB;
constexpr size_t PB_OFF = BIG_OFF + 784 * MiB;
constexpr size_t GATE_OFF = BIG_OFF;
constexpr size_t WS_END = BIG_OFF + 824 * MiB;
}
using namespace cfg;

struct Args {
    const float* x_prompt; const float* x_sample; const float* p_prompt; const float* p_sample;
    const float* norm_mix_g; const float* w_in; const float* att_norm_g; const float* rwkv_shift;
    const float* rwkv_w0; const float* rwkv_w2; const float* rwkv_a0; const float* rwkv_a2; const float* rwkv_g2;
    const float* rwkv_k_k; const float* rwkv_k_a; const float* rwkv_r_k; const float* rwkv_ln_w; const float* rwkv_ln_b;
    const float* w_out; const float* norm_ffn_g; const float* peer_w_q; const float* peer_sub_keys; const float* peer_u; const float* peer_v;
    const float* ple_norm_g; const float* ple_w_gate; const float* ple_b_gate; const float* ple_w_proj; const float* final_norm_g;
    float* h;
    unsigned char* ws;
};

DEV int tid_() { int t = threadIdx.x; asm volatile("" : "+v"(t)); return t; }
DEV float bf2f(unsigned h) { return __uint_as_float(h << 16); }
DEV float bflo(unsigned d) { return __uint_as_float(d << 16); }
DEV float bfhi(unsigned d) { return __uint_as_float(d & 0xffff0000u); }
DEV unsigned f2bf(float f) { const unsigned u = __float_as_uint(f); return (u + 0x7fffu + ((u >> 16) & 1u)) >> 16; }
DEV unsigned pack2(float lo, float hi) { return f2bf(lo) | (f2bf(hi) << 16); }
DEV float dot2bf(unsigned a, unsigned b, float c) { return __builtin_amdgcn_fdot2_f32_bf16(__builtin_bit_cast(bf16x2_t, a), __builtin_bit_cast(bf16x2_t, b), c, false); }
DEV float wave_sum(float v) {
#pragma unroll
    for (int o = 32; o > 0; o >>= 1) v += __shfl_xor(v, o);
    return v;
}
DEV float wave_max(float v) {
#pragma unroll
    for (int o = 32; o > 0; o >>= 1) v = fmaxf(v, __shfl_xor(v, o));
    return v;
}
DEV float sum8(float v) {
    v += __int_as_float(__builtin_amdgcn_mov_dpp(__float_as_int(v), 0xB1, 0xF, 0xF, true));
    v += __int_as_float(__builtin_amdgcn_mov_dpp(__float_as_int(v), 0x4E, 0xF, 0xF, true));
    v += __int_as_float(__builtin_amdgcn_mov_dpp(__float_as_int(v), 0x141, 0xF, 0xF, true));
    return v;
}
DEV float sigmoidf_(float x) { return 1.0f / (1.0f + __expf(-x)); }
namespace pg8 {
#define PG8_LAS __attribute__((address_space(3)))
typedef unsigned short bf16_t;
typedef short bf16x8 __attribute__((ext_vector_type(8)));
typedef float f32x4 __attribute__((ext_vector_type(4)));
typedef unsigned u32x4 __attribute__((ext_vector_type(4)));
constexpr int BM = 256, BK = 64, HALF = 128, HTB = HALF * BK * 2  , STAGE_BYTES = 8 * HTB, NXCD = 8, WGM = 8;

__host__ __device__ __forceinline__ int lds_byte(int r, int c) { const int st = (r >> 4) * 2 + (c >> 5), rr = r & 15, cc = c & 31, ob = rr * 64 + cc * 2; return st * 1024 + (ob ^ (((ob >> 9) & 1) << 5)); }
__host__ __device__ __forceinline__ void stage_rc(int b, int& R, int& C) { const int st = b / 1024, sb = b % 1024, swz = sb ^ (((sb >> 9) & 1) << 5); R = (st >> 1) * 16 + swz / 64; C = (st & 1) * 32 + (swz % 64) / 2; }
__host__ __device__ __forceinline__ int perm32(int rho) { const int n = rho >> 4, i = rho & 15; return 8 * (i >> 2) + 4 * n + (i & 3); }

struct Unit { int pm, pn; };
struct Gemm { const bf16_t* A; const bf16_t* Bt; int M, N, K; };

struct StaticOrder {
    int nM, nN, nwg, G, c;
    __host__ __device__ void init(int M, int N, int G_, int c_) { nM = M / BM; nN = N / BM; nwg = nM * nN; G = G_; c = c_; }
    __host__ __device__ bool next(int i, Unit& u) const {
        const long L = (long)i * G + c; if (L >= nwg) return false;
        int wgid = (int)L; { const int q = nwg / NXCD, r = nwg % NXCD, xcd = wgid % NXCD, off = wgid / NXCD; wgid = (xcd < r ? xcd * (q + 1) : r * (q + 1) + (xcd - r) * q) + off; }
        const int nig = WGM * nN, gid = wgid / nig, fm = gid * WGM, gsz = (nM - fm) < WGM ? (nM - fm) : WGM;
        u.pm = fm + ((wgid % nig) % gsz); u.pn = (wgid % nig) / gsz; return true;
    }
    __device__ __forceinline__ void a_ready(const Unit&) const {}
    __device__ __forceinline__ void done(const Unit&) const {}
};
__device__ __forceinline__ unsigned cvt_pk_bf16(float lo, float hi) { unsigned r; asm volatile("v_cvt_pk_bf16_f32 %0, %1, %2" : "=v"(r) : "v"(lo), "v"(hi)); return r; }

struct EpiProj {
    static constexpr bool PERM = true, AFTER_DRAIN = false;
    bf16_t* qkv; bf16_t* u; const float* rstd; const float* rc; const float* rs;
    __device__ __forceinline__ void operator()(const f32x4 (&acc)[2][2][4][2], const Unit& un, int wr, int wc, int fr, int fq) const {
        const int row0 = un.pm * BM + wr * 64 + fr;
        const bool isq = un.pn < 6;
        bf16_t* base = isq ? qkv : u; const int ld = isq ? 1536 : 2048; const int colt = isq ? un.pn * BM : (un.pn - 6) * BM;
        const int col0 = colt + wc * 32 + 8 * fq;
        const bool rope = (un.pn < 4) && ((wc & 1) == 0);
#pragma unroll
        for (int ai = 0; ai < 2; ++ai)
#pragma unroll
            for (int m = 0; m < 4; ++m) {
                const int row = row0 + ai * HALF + m * 16; const float s = rstd[row]; const int pos = row & 4095;
                f32x4 c0 = {1.f, 1.f, 1.f, 1.f}, c1 = c0, s0 = {0.f, 0.f, 0.f, 0.f}, s1 = s0;
                if (rope) { c0 = *(const f32x4*)(rc + pos * 8); c1 = *(const f32x4*)(rc + pos * 8 + 4); s0 = *(const f32x4*)(rs + pos * 8); s1 = *(const f32x4*)(rs + pos * 8 + 4); }
                bf16_t* rowp = base + (size_t)row * ld + col0;
#pragma unroll
                for (int bj = 0; bj < 2; ++bj) {
                    f32x4 v0 = acc[ai][bj][m][0] * s, v1 = acc[ai][bj][m][1] * s;
                    if (rope) {
                        f32x4 o0, o1;
#pragma unroll
                        for (int c = 0; c < 4; ++c) { o0[c] = __shfl_xor(v0[c], 16); o1[c] = __shfl_xor(v1[c], 16); }
                        if (fq == 0) { v0 = v0 * c0 - o0 * s0; v1 = v1 * c1 - o1 * s1; }
                        else if (fq == 1) { v0 = v0 * c0 + o0 * s0; v1 = v1 * c1 + o1 * s1; }
                    }
                    u32x4 w; w.x = cvt_pk_bf16(v0[0], v0[1]); w.y = cvt_pk_bf16(v0[2], v0[3]); w.z = cvt_pk_bf16(v1[0], v1[1]); w.w = cvt_pk_bf16(v1[2], v1[3]);
                    *(u32x4*)(rowp + bj * HALF) = w;
                }
            }
    }
};
template <int MODE> struct EpiF32x {
    static constexpr bool PERM = false, AFTER_DRAIN = false;
    float* C; int ldc; const bf16_t* gate;
    __device__ __forceinline__ void operator()(const f32x4 (&acc)[2][2][4][2], const Unit& un, int wr, int wc, int fr, int fq) const {
        const int row0 = un.pm * BM + wr * 64 + fr, col0 = un.pn * BM + wc * 32 + 4 * fq;
#pragma unroll
        for (int ai = 0; ai < 2; ++ai)
#pragma unroll
            for (int m = 0; m < 4; ++m) {
                const size_t ro = (size_t)(row0 + ai * HALF + m * 16) * ldc + col0;
                if (MODE != 0) asm volatile("" ::: "memory");
#pragma unroll
                for (int bj = 0; bj < 2; ++bj)
#pragma unroll
                    for (int n = 0; n < 2; ++n) {
                        f32x4* p = (f32x4*)(C + ro + bj * HALF + n * 16);
                        if (MODE == 0) *p = acc[ai][bj][m][n];
                        else if (MODE == 1) *p = *p + acc[ai][bj][m][n];
                        else { const u32x2 g = *(const u32x2*)(gate + ro + bj * HALF + n * 16);
                               f32x4 gv; gv[0] = __uint_as_float(g.x << 16); gv[1] = __uint_as_float(g.x & 0xffff0000u); gv[2] = __uint_as_float(g.y << 16); gv[3] = __uint_as_float(g.y & 0xffff0000u);
                               *p = *p + gv * acc[ai][bj][m][n]; }
                    }
            }
    }
};
struct EpiGate {
    static constexpr bool PERM = true, AFTER_DRAIN = false;
    bf16_t* O; const float* rstd; const float* bias;
    __device__ __forceinline__ void operator()(const f32x4 (&acc)[2][2][4][2], const Unit& un, int wr, int wc, int fr, int fq) const {
        const int row0 = un.pm * BM + wr * 64 + fr, col0 = un.pn * BM + wc * 32 + 8 * fq;
        f32x4 bv[2][2];
#pragma unroll
        for (int bj = 0; bj < 2; ++bj)
#pragma unroll
            for (int n = 0; n < 2; ++n) bv[bj][n] = *(const f32x4*)(bias + col0 + bj * HALF + 4 * n);
#pragma unroll
        for (int ai = 0; ai < 2; ++ai)
#pragma unroll
            for (int m = 0; m < 4; ++m) {
                const int row = row0 + ai * HALF + m * 16; const float s = rstd[row];
                bf16_t* rowp = O + (size_t)row * 1024 + col0;
#pragma unroll
                for (int bj = 0; bj < 2; ++bj) {
                    f32x4 v0 = acc[ai][bj][m][0] * s + bv[bj][0], v1 = acc[ai][bj][m][1] * s + bv[bj][1];
#pragma unroll
                    for (int c = 0; c < 4; ++c) { v0[c] = 1.0f / (1.0f + __expf(-v0[c])); v1[c] = 1.0f / (1.0f + __expf(-v1[c])); }
                    u32x4 w; w.x = cvt_pk_bf16(v0[0], v0[1]); w.y = cvt_pk_bf16(v0[2], v0[3]); w.z = cvt_pk_bf16(v1[0], v1[1]); w.w = cvt_pk_bf16(v1[2], v1[3]);
                    *(u32x4*)(rowp + bj * HALF) = w;
                }
            }
    }
};
template <class Epi, class Sched, bool STAMP = false>
__device__ __forceinline__ void gemm_phase(PG8_LAS unsigned char* lds, const Gemm g, const Sched& S, const Epi& E, unsigned long long* stamps, const int tid_in) {
    const int tid = tid_in, wid = __builtin_amdgcn_readfirstlane(tid >> 6), lane = tid & 63, wr = wid >> 2, wc = wid & 3, fr = lane & 15, fq = lane >> 4;
    const int K = g.K, nt = K / BK;
    int ts_lo = 0, ts_hi = 0, nts = 0; const unsigned long long rt_entry = STAMP ? (unsigned long long)wall_clock64() : 0ull;
#define PG8_STAMP() do { if (STAMP && wid == 0 && nts < 64) { const unsigned long long _c = (unsigned long long)clock64(); \
        ts_lo = (lane == nts) ? (int)(unsigned)_c : ts_lo; ts_hi = (lane == nts) ? (int)(unsigned)(_c >> 32) : ts_hi; ++nts; } } while (0)
    PG8_STAMP();
    unsigned voffA[2], voffB[2];
#pragma unroll
    for (int i = 0; i < 2; ++i) { int R, C; stage_rc(tid * 16 + i * 8192, R, C); const int Rb = Epi::PERM ? ((R & ~31) + perm32(R & 31)) : R;
        voffA[i] = (unsigned)(R * K + C) * 2u; voffB[i] = (unsigned)(Rb * K + C) * 2u; }
    const size_t kstep = (size_t)(BK * 2);
    const size_t hstep = (size_t)HALF * K * 2;
    const size_t tstep = 2 * hstep;
    const unsigned ldsw = (unsigned)wid * 1024u;
    const int aoff = lds_byte(wr * 64 + fr, fq * 8), boff = lds_byte(wc * 32 + fr, fq * 8);
#define PG8_SA(b, h) (((b) * 2 + (h)) * HTB)
#define PG8_SB(b, h) ((4 + (b) * 2 + (h)) * HTB)
#define PG8_STAGE(bufoff, gbase, voff) do { _Pragma("unroll") for (int _i = 0; _i < 2; ++_i) \
        __builtin_amdgcn_global_load_lds((const unsigned*)((const char*)(gbase) + (voff)[_i]), (PG8_LAS unsigned*)(lds + (bufoff) + ldsw + _i * 8192), 16, 0, 0); } while (0)
#define PG8_LDA(dst, b, h) do { _Pragma("unroll") for (int m = 0; m < 4; ++m) _Pragma("unroll") for (int k = 0; k < 2; ++k) dst[m][k] = *(const PG8_LAS bf16x8*)(lds + PG8_SA(b, h) + aoff + m * 2048 + k * 1024); } while (0)
#define PG8_LDB(dst, b, h) do { _Pragma("unroll") for (int n = 0; n < 2; ++n) _Pragma("unroll") for (int k = 0; k < 2; ++k) dst[n][k] = *(const PG8_LAS bf16x8*)(lds + PG8_SB(b, h) + boff + n * 2048 + k * 1024); } while (0)
#define PG8_MMA(ai, bj, At, Bt) do { __builtin_amdgcn_s_setprio(1); _Pragma("unroll") for (int m = 0; m < 4; ++m) _Pragma("unroll") for (int n = 0; n < 2; ++n) _Pragma("unroll") for (int k = 0; k < 2; ++k) \
        acc[ai][bj][m][n] = __builtin_amdgcn_mfma_f32_16x16x32_bf16(Bt[n][k], At[m][k], acc[ai][bj][m][n], 0, 0, 0); __builtin_amdgcn_s_setprio(0); } while (0)
#define PG8_WAIT_V(n) asm volatile("s_waitcnt vmcnt(" #n ")" ::: "memory")
#define PG8_WAIT_L(n) asm volatile("s_waitcnt lgkmcnt(" #n ")" ::: "memory")
#define PG8_BAR __builtin_amdgcn_s_barrier()
#define PG8_SCHED __builtin_amdgcn_sched_barrier(0)
    Unit cur, nxt; int ui = 0;
    if (!S.next(0, cur)) return;
    f32x4 acc[2][2][4][2];
#pragma unroll
    for (int a = 0; a < 2; ++a)
#pragma unroll
        for (int b = 0; b < 2; ++b)
#pragma unroll
            for (int m = 0; m < 4; ++m)
#pragma unroll
                for (int n = 0; n < 2; ++n) acc[a][b][m][n] = (f32x4){0.f, 0.f, 0.f, 0.f};
    bf16x8 At[4][2], B0[2][2], B1[2][2];
    const char* cA = (const char*)g.A + (size_t)cur.pm * tstep; const char* cB = (const char*)g.Bt + (size_t)cur.pn * tstep;
    S.a_ready(cur);
    PG8_STAGE(PG8_SB(0, 0), cB, voffB); PG8_STAGE(PG8_SA(0, 0), cA, voffA); PG8_STAGE(PG8_SB(0, 1), cB + hstep, voffB); PG8_STAGE(PG8_SA(0, 1), cA + hstep, voffA);
    if (wr == 1) PG8_BAR;
    PG8_WAIT_V(4); PG8_BAR;
    PG8_STAGE(PG8_SB(1, 0), cB + kstep, voffB); PG8_STAGE(PG8_SA(1, 0), cA + kstep, voffA); PG8_STAGE(PG8_SB(1, 1), cB + hstep + kstep, voffB);
    PG8_WAIT_V(6); PG8_BAR;
    PG8_STAMP();
    for (;;) {
        const bool has_next = S.next(ui + 1, nxt);
        const char* nA = has_next ? (const char*)g.A + (size_t)nxt.pm * tstep : cA; const char* nB = has_next ? (const char*)g.Bt + (size_t)nxt.pn * tstep : cB;
        for (int t = 0; t < nt; t += 2) {
            const bool last = (t == nt - 2);
            const char* a1 = cA + (size_t)(t + 1) * kstep;
            const char* a2 = last ? nA : cA + (size_t)(t + 2) * kstep; const char* b2 = last ? nB : cB + (size_t)(t + 2) * kstep;
            const char* a3 = a2 + kstep; const char* b3 = b2 + kstep;
            if (last && has_next) S.a_ready(nxt);
            PG8_LDB(B0, 0, 0); PG8_SCHED; PG8_LDA(At, 0, 0); PG8_STAGE(PG8_SA(1, 1), a1 + hstep, voffA);
            PG8_WAIT_L(8); PG8_BAR; PG8_WAIT_L(0); PG8_MMA(0, 0, At, B0); PG8_BAR; PG8_SCHED;
            PG8_LDB(B1, 0, 1); PG8_STAGE(PG8_SB(0, 0), b2, voffB);
            PG8_BAR; PG8_WAIT_L(0); PG8_MMA(0, 1, At, B1); PG8_BAR;
            PG8_LDA(At, 0, 1); PG8_STAGE(PG8_SA(0, 0), a2, voffA);
            PG8_BAR; PG8_WAIT_L(0); PG8_MMA(1, 0, At, B0); PG8_BAR; PG8_SCHED;
            PG8_STAGE(PG8_SB(0, 1), b2 + hstep, voffB);
            PG8_WAIT_V(6); PG8_BAR; PG8_MMA(1, 1, At, B1); PG8_BAR;
            PG8_LDB(B0, 1, 0); PG8_SCHED; PG8_LDA(At, 1, 0); PG8_STAGE(PG8_SA(0, 1), a2 + hstep, voffA);
            PG8_WAIT_L(8); PG8_BAR; PG8_WAIT_L(0); PG8_MMA(0, 0, At, B0); PG8_BAR; PG8_SCHED;
            PG8_LDB(B1, 1, 1); PG8_STAGE(PG8_SB(1, 0), b3, voffB);
            PG8_BAR; PG8_WAIT_L(0); PG8_MMA(0, 1, At, B1); PG8_BAR;
            PG8_LDA(At, 1, 1); PG8_STAGE(PG8_SA(1, 0), a3, voffA);
            PG8_BAR; PG8_WAIT_L(0); PG8_MMA(1, 0, At, B0); PG8_BAR; PG8_SCHED;
            PG8_STAGE(PG8_SB(1, 1), b3 + hstep, voffB);
            PG8_WAIT_V(6); PG8_BAR; PG8_MMA(1, 1, At, B1); PG8_BAR;
        }
        PG8_STAMP();
        if constexpr (!Epi::AFTER_DRAIN) { E(acc, cur, wr, wc, fr, fq); S.done(cur); }
        PG8_STAMP();
        if (!has_next) break;
#pragma unroll
        for (int a = 0; a < 2; ++a)
#pragma unroll
            for (int b = 0; b < 2; ++b)
#pragma unroll
                for (int m = 0; m < 4; ++m)
#pragma unroll
                    for (int n = 0; n < 2; ++n) acc[a][b][m][n] = (f32x4){0.f, 0.f, 0.f, 0.f};
        cur = nxt; cA = nA; cB = nB; ++ui;
    }
    PG8_WAIT_V(0);
    if (wr == 0) PG8_BAR;
    PG8_BAR;
    if constexpr (Epi::AFTER_DRAIN) { E.fused(acc, cur, wr, wc, fr, fq, lds, wid, lane); S.done(cur); }
    PG8_STAMP();
    if (STAMP && wid == 0) { stamps[lane] = lane < nts ? (((unsigned long long)(unsigned)ts_hi << 32) | (unsigned)ts_lo) : 0ull;
        if (lane == 62) stamps[62] = rt_entry; if (lane == 63) stamps[63] = (unsigned long long)wall_clock64(); }
#undef PG8_STAMP
#undef PG8_SA
#undef PG8_SB
#undef PG8_STAGE
#undef PG8_LDA
#undef PG8_LDB
#undef PG8_MMA
#undef PG8_WAIT_V
#undef PG8_WAIT_L
#undef PG8_BAR
#undef PG8_SCHED
}
}
#define XB_TMO      128
#define XB_XCNT(j)  (256  + 64 * (j))
#define XB_XSUB(j)  (1280 + 64 * (j))
#define XB_XGEN(j)  (2304 + 64 * (j))
#define XB_TOP      3328
#define XB_TOPGEN   3392
#define XCD_BAR_WORDS 3456
#define XB_SPIN_CAP (1u << 23)
#define LAS __attribute__((address_space(3)))

__device__ __forceinline__ unsigned xb_ld(unsigned* p)              { return __hip_atomic_load(p, __ATOMIC_RELAXED, __HIP_MEMORY_SCOPE_AGENT); }
__device__ __forceinline__ unsigned xb_add(unsigned* p, unsigned v) { return __hip_atomic_fetch_add(p, v, __ATOMIC_RELAXED, __HIP_MEMORY_SCOPE_AGENT); }
__device__ __forceinline__ unsigned xb_xcc_id() { return (unsigned)__builtin_amdgcn_s_getreg((3 << 11) | 20) & 0xFu; }
#define XB_SPIN(cond, bar) do { unsigned _sp = 0; while (cond) { __builtin_amdgcn_s_sleep(1); \
    if ((++_sp & 255u) == 0u) { if (xb_ld(&(bar)[XB_TMO])) break; if (_sp > XB_SPIN_CAP) { atomicAdd(&(bar)[XB_TMO], 1u); break; } } } } while (0)

struct XcdBarrier {
    unsigned* bar; unsigned x;
    volatile LAS unsigned* st;
};

__device__ __forceinline__ XcdBarrier xcd_barrier_post(unsigned* bar, volatile LAS unsigned* st) {
    XcdBarrier b; b.bar = bar; b.x = xb_xcc_id(); b.st = st;
    if (threadIdx.x == 0) (void)xb_add(&bar[XB_XCNT(b.x)], 1u);
    return b;
}
__device__ __forceinline__ void xcd_barrier_complete(unsigned* bar, unsigned x, unsigned& nloc, unsigned& nx) {
    const unsigned G = gridDim.x * gridDim.y * gridDim.z;
    unsigned sum, cnt, mine, sp = 0u;
    for (;;) {
        sum = 0u; cnt = 0u; mine = 0u;
#pragma unroll
        for (unsigned j = 0; j < 16; ++j) { const unsigned c = xb_ld(&bar[XB_XCNT(j)]); sum += c; cnt += (c > 0u) ? 1u : 0u; mine = (j == x) ? c : mine; }
        if (sum == G) break;
        __builtin_amdgcn_s_sleep(1);
        if ((++sp & 255u) == 0u) { if (xb_ld(&bar[XB_TMO])) break; if (sp > XB_SPIN_CAP) { atomicAdd(&bar[XB_TMO], 1u); break; } }
    }
    nloc = mine > 0u ? mine : 1u; nx = cnt > 0u ? cnt : 1u;
}

__device__ __forceinline__ void xcd_barrier(const XcdBarrier& b, const int tid) {
    asm volatile("s_waitcnt vmcnt(0)" ::: "memory");
    __syncthreads();
    if (tid == 0) {
        unsigned* bar = b.bar; unsigned bx = b.x;
        asm volatile("" : "+s"(bar), "+s"(bx));
        __builtin_amdgcn_s_waitcnt(0);
        unsigned nloc = b.st[0], nx = b.st[1];
        if (nloc == 0u) { xcd_barrier_complete(bar, bx, nloc, nx); b.st[0] = nloc; b.st[1] = nx; }
        const unsigned old = xb_add(&bar[XB_XSUB(bx)], 1u);
        const unsigned gen = old / nloc;
        if (old + 1u == (gen + 1u) * nloc) {
            __builtin_amdgcn_fence(__ATOMIC_RELEASE, "agent");
            asm volatile("s_waitcnt vmcnt(0)" ::: "memory");
            const unsigned og = xb_add(&bar[XB_TOP], 1u);
            const unsigned tg = og / nx;
            if (og + 1u == (tg + 1u) * nx) xb_add(&bar[XB_TOPGEN], 1u);
            else XB_SPIN(xb_ld(&bar[XB_TOPGEN]) == tg, bar);
            __builtin_amdgcn_fence(__ATOMIC_ACQUIRE, "agent");
            xb_add(&bar[XB_XGEN(bx)], 1u);
            asm volatile("s_waitcnt vmcnt(0)" ::: "memory");
        } else {
            XB_SPIN(xb_ld(&bar[XB_XGEN(bx)]) == gen, bar);
            __builtin_amdgcn_fence(__ATOMIC_ACQUIRE, "agent");
            asm volatile("s_waitcnt vmcnt(0)" ::: "memory");
        }
    }
    __syncthreads();
}


typedef __attribute__((address_space(3))) unsigned char lds_u8;

DEV bf16_t* wsb(const Args& a, size_t off) { return (bf16_t*)(a.ws + off); }
DEV float* wsf(const Args& a, size_t off) { return (float*)(a.ws + off); }

DEV void ph_rowprep(const Args& a, bool from_x, const int tid0) {
    const int lane = tid0 & 63, wv = tid0 >> 6;
    const int gw = blockIdx.x * 8 + wv, nw = gridDim.x * 8;
    bf16_t* hb = wsb(a, HB_OFF); float* rstd = wsf(a, RSTD_OFF);
    for (int t = gw; t < T; t += nw) {
        const float* src = from_x ? (t < TP ? a.x_prompt + (size_t)t * D : a.x_sample + (size_t)(t - TP) * D) : a.h + (size_t)t * D;
        f32x4 v[4]; float ss = 0.f;
#pragma unroll
        for (int i = 0; i < 4; ++i) { v[i] = *(const f32x4*)(src + (i * 64 + lane) * 4); ss += v[i][0] * v[i][0] + v[i][1] * v[i][1] + v[i][2] * v[i][2] + v[i][3] * v[i][3]; }
        ss = wave_sum(ss);
#pragma unroll
        for (int i = 0; i < 4; ++i) {
            if (from_x) *(f32x4*)(a.h + (size_t)t * D + (i * 64 + lane) * 4) = v[i];
            u32x2 p; p.x = pack2(v[i][0], v[i][1]); p.y = pack2(v[i][2], v[i][3]);
            *(u32x2*)(hb + (size_t)t * D + (i * 64 + lane) * 4) = p;
        }
        if (lane == 0) rstd[t] = rsqrtf(ss * (1.0f / 1024.0f) + 1e-6f);
    }
}

DEV void ph_final(const Args& a, const int tid0) {
    const int lane = tid0 & 63, wv = tid0 >> 6;
    const int gw = blockIdx.x * 8 + wv, nw = gridDim.x * 8;
    for (int t = gw; t < T; t += nw) {
        float* row = a.h + (size_t)t * D;
        f32x4 v[4]; float ss = 0.f;
#pragma unroll
        for (int i = 0; i < 4; ++i) { v[i] = *(const f32x4*)(row + (i * 64 + lane) * 4); ss += v[i][0] * v[i][0] + v[i][1] * v[i][1] + v[i][2] * v[i][2] + v[i][3] * v[i][3]; }
        ss = wave_sum(ss);
        const float r = rsqrtf(ss * (1.0f / 1024.0f) + 1e-6f);
#pragma unroll
        for (int i = 0; i < 4; ++i) { const f32x4 g = *(const f32x4*)(a.final_norm_g + (i * 64 + lane) * 4); *(f32x4*)(row + (i * 64 + lane) * 4) = v[i] * r * g; }
    }
}

DEV void transpose_cvt(const float* __restrict__ src, bf16_t* __restrict__ dst, int K, int N, int Npad, const float* __restrict__ g, float* tile, const int tid0) {
    const int tx = tid0 & 63, ty = tid0 >> 6;
    const int tk = K / 64, tn = Npad / 64;
    for (int tl = blockIdx.x; tl < tk * tn; tl += gridDim.x) {
        const int k0 = (tl % tk) * 64, n0 = (tl / tk) * 64;
        __syncthreads();
        for (int i = ty; i < 64; i += 8) { const int k = k0 + i, n = n0 + tx; float v = (n < N) ? src[(size_t)k * N + n] : 0.f; if (g) v *= g[k]; tile[i * 65 + tx] = v; }
        __syncthreads();
        for (int i = ty; i < 64; i += 8) dst[(size_t)(n0 + i) * K + k0 + tx] = (bf16_t)f2bf(tile[tx * 65 + i]);
    }
}
DEV void fold_wqk(const Args& a, float* lds, const int tid0) {
    float* swq = lds;
    float* ssk = lds + 64 * 132;
    const int tid = tid0, key = tid & 127, kq = tid >> 7;
    for (int un = blockIdx.x; un < NL * 16 * 16; un += gridDim.x) {
        const int l = un >> 8, hp = (un >> 4) & 15, k0 = (un & 15) * 64;
        __syncthreads();
        for (int i = tid; i < 64 * 128; i += NTHR) { const int r = i >> 7, c = i & 127; swq[r * 132 + c] = a.peer_w_q[((size_t)l * 1024 + k0 + r) * 2048 + hp * 128 + c]; }
        for (int i = tid; i < 128 * 128; i += NTHR) { const int r = i >> 7, c = i & 127; ssk[r * 132 + c] = a.peer_sub_keys[(((size_t)l * 16 + hp) * 128 + r) * 128 + c]; }
        __syncthreads();
        float acc[16];
#pragma unroll
        for (int i = 0; i < 16; ++i) acc[i] = 0.f;
        for (int c = 0; c < 128; c += 4) {
            const f32x4 s = *(const f32x4*)(ssk + key * 132 + c);
#pragma unroll
            for (int i = 0; i < 16; ++i) { const f32x4 w = *(const f32x4*)(swq + (kq * 16 + i) * 132 + c); acc[i] += s[0] * w[0] + s[1] * w[1] + s[2] * w[2] + s[3] * w[3]; }
        }
        bf16_t* dst = wsb(a, WB_OFF + (size_t)l * WB_LAYER + WB_QK) + (size_t)(hp * 128 + key) * 1024 + k0 + kq * 16;
        const float* g = a.norm_ffn_g + l * 1024 + k0 + kq * 16;
#pragma unroll
        for (int i = 0; i < 16; i += 2) *(unsigned*)(dst + i) = pack2(acc[i] * g[i], acc[i + 1] * g[i + 1]);
    }
}
DEV void ph_prologue(const Args& a, float* lds, const int tid0) {
    { float* rc = wsf(a, ROPEC_OFF); float* rs = wsf(a, ROPES_OFF);
      for (int i = blockIdx.x * NTHR + tid0; i < 4096 * 8; i += gridDim.x * NTHR) {
          const int pos = i >> 3, f = i & 7;
          const float invf = (float)pow(500000.0, -(double)f / 8.0);
          const float ang = (float)pos * invf;
          rc[i] = (float)cos((double)ang); rs[i] = (float)sin((double)ang);
      } }
    for (int l = 0; l < NL; ++l) {
        bf16_t* wb = wsb(a, WB_OFF + (size_t)l * WB_LAYER);
        transpose_cvt(a.w_in + (size_t)l * 1024 * INC, wb + WB_IN / 2, 1024, INC, INP, a.norm_mix_g + l * 1024, lds, tid0);
        transpose_cvt(a.w_out + (size_t)l * 1024 * 1024, wb + WB_OUT / 2, 1024, 1024, 1024, nullptr, lds, tid0);
        transpose_cvt(a.ple_w_gate + (size_t)l * 1024 * 1024, wb + WB_GATE / 2, 1024, 1024, 1024, a.ple_norm_g + l * 1024, lds, tid0);
        transpose_cvt(a.ple_w_proj + (size_t)l * 256 * 1024, wb + WB_PROJ / 2, 256, 1024, 1024, nullptr, lds, tid0);
    }
    fold_wqk(a, lds, tid0);
}
DEV void ph_convert(const Args& a, int layer, const int tid0) {
    const size_t gtid = (size_t)blockIdx.x * NTHR + tid0, gn = (size_t)gridDim.x * NTHR;
    const float* us = a.peer_u + (size_t)layer * 16384 * 1024; const float* vs = a.peer_v + (size_t)layer * 16384 * 1024;
    bf16_t* ud = wsb(a, PTU_OFF); bf16_t* vd = wsb(a, PTV_OFF);
    const float* g = a.norm_ffn_g + layer * 1024;
    for (size_t i = gtid; i < (size_t)16384 * 1024 / 4; i += gn) {
        const f32x4 x = *(const f32x4*)(us + i * 4), y = *(const f32x4*)(vs + i * 4), gg = *(const f32x4*)(g + ((i * 4) & 1023));
        u32x2 p; p.x = pack2(x[0] * gg[0], x[1] * gg[1]); p.y = pack2(x[2] * gg[2], x[3] * gg[3]); *(u32x2*)(ud + i * 4) = p;
        u32x2 q; q.x = pack2(y[0], y[1]); q.y = pack2(y[2], y[3]); *(u32x2*)(vd + i * 4) = q;
    }
    bf16_t* pb = wsb(a, PB_OFF);
    const float* pp = a.p_prompt + (size_t)layer * TP * 256; const float* ps = a.p_sample + (size_t)layer * (T - TP) * 256;
    for (size_t i = gtid; i < (size_t)T * 256 / 4; i += gn) {
        const size_t e = i * 4; const f32x4 x = (e < (size_t)TP * 256) ? *(const f32x4*)(pp + e) : *(const f32x4*)(ps + (e - (size_t)TP * 256));
        u32x2 p; p.x = pack2(x[0], x[1]); p.y = pack2(x[2], x[3]); *(u32x2*)(pb + e) = p;
    }
}

DEV void ph_attn(const Args& a, int layer, float* lds, const int tid0) {
    const int lane = tid0 & 63, wv = __builtin_amdgcn_readfirstlane(tid0 >> 6);
    float* sp = lds + wv * 448;
    const bf16_t* qkv = wsb(a, QKV_OFF); bf16_t* mix = wsb(a, MIX_OFF);
    const int NU = T * 8;
    const int per = (NU + (int)gridDim.x - 1) / (int)gridDim.x;
    const int u0 = blockIdx.x * per, u1 = (u0 + per < NU) ? u0 + per : NU;
    for (int un = u0 + wv; un < u1; un += 8) {
        const int sh = un >> 12, pos = un & 4095, seq = sh >> 3, hd = sh & 7;
        const size_t tb = (size_t)seq * 4096;
        const u32x4* qp = (const u32x4*)(qkv + (tb + pos) * 1536 + hd * 64);
        u32x4 q[8];
#pragma unroll
        for (int i = 0; i < 8; ++i) q[i] = qp[i];
        float sc[7]; float mx = -3.0e38f;
#pragma unroll
        for (int rd = 0; rd < 7; ++rd) {
            const int e = rd * 64 + lane;
            const int di = e / 129, j = e - di * 129 - 64;
            const int dl = (di == 0) ? 1 : (di == 1 ? 4 : 16);
            const int pk = pos + j * dl;
            const bool valid = (e < 387) && (pk >= 0) && (pk < 4096);
            const int pkc = valid ? pk : pos;
            const u32x4* kp = (const u32x4*)(qkv + (tb + pkc) * 1536 + 512 + hd * 64);
            float s = 0.f;
#pragma unroll
            for (int i = 0; i < 8; ++i) { const u32x4 kk = kp[i]; s = dot2bf(q[i].x, kk.x, s); s = dot2bf(q[i].y, kk.y, s); s = dot2bf(q[i].z, kk.z, s); s = dot2bf(q[i].w, kk.w, s); }
            s = valid ? s * 0.125f : -1.0e30f;
            sc[rd] = s; mx = fmaxf(mx, s);
        }
        mx = wave_max(mx);
        float l = 0.f;
#pragma unroll
        for (int rd = 0; rd < 7; ++rd) { const float p = __expf(sc[rd] - mx); sp[rd * 64 + lane] = p; l += p; }
        l = wave_sum(l);
        float o = 0.f;
        for (int di = 0; di < 3; ++di) {
            const int dl = (di == 0) ? 1 : (di == 1 ? 4 : 16);
            for (int jj = 0; jj < 129; ++jj) {
                const int pk = pos + (jj - 64) * dl;
                if (pk < 0 || pk >= 4096) continue;
                const float p = sp[di * 129 + jj];
                o += p * bf2f(qkv[(tb + pk) * 1536 + 1024 + hd * 64 + lane]);
            }
        }
        o = o / l;
        const float ms = wave_sum(o * o) * (1.0f / 64.0f);
        o = o * rsqrtf(ms + 1e-6f) * a.att_norm_g[layer * 512 + hd * 64 + lane];
        mix[(tb + pos) * 1024 + hd * 64 + lane] = (bf16_t)f2bf(o);
    }
}

DEV void ph_lora(const Args& a, int layer, float* lds, const int tid0) {
    float* act = lds;
    const int tid = tid0;
    const bf16_t* U = wsb(a, U_OFF);
    const float* sw = a.rwkv_shift + (size_t)layer * 3 * UC;
    for (int tile = blockIdx.x; tile < T / 64; tile += gridDim.x) {
        const int t0 = tile * 64;
        __syncthreads();
        for (int i = tid; i < 64 * 256; i += NTHR) {
            const int tk = i >> 8, c = i & 255, t = t0 + tk, pos = t & 4095, uc = 1536 + c;
            float v = sw[UC + uc] * bf2f(U[(size_t)t * UW + uc]);
            if (pos > 0) v += sw[uc] * bf2f(U[(size_t)(t - 1) * UW + uc]);
            if (pos < 4095) v += sw[2 * UC + uc] * bf2f(U[(size_t)(t + 1) * UW + uc]);
            act[tk * 256 + c] = (c < 128) ? tanhf(v) : v;
        }
        __syncthreads();
        const int ch = tid;
#pragma unroll 1
        for (int arr = 0; arr < 4; ++arr) {
            const int dir = arr & 1; const bool isw = arr < 2;
            const float* W = (isw ? a.rwkv_w2 : a.rwkv_a2) + ((size_t)(layer * 2 + dir) * 64) * 512 + ch;
            float wreg[64];
#pragma unroll
            for (int j = 0; j < 64; ++j) wreg[j] = W[j * 512];
            const float bias = (isw ? a.rwkv_w0 : a.rwkv_a0)[(layer * 2 + dir) * 512 + ch];
            bf16_t* out = wsb(a, arr == 0 ? WF_OFF : (arr == 1 ? WB2_OFF : (arr == 2 ? AF_OFF : AB_OFF)));
#pragma unroll 1
            for (int tk = 0; tk < 64; ++tk) {
                const float* ap = act + tk * 256 + arr * 64;
                float s = bias;
#pragma unroll
                for (int j = 0; j < 64; j += 4) { const f32x4 x = *(const f32x4*)(ap + j); s += x[0] * wreg[j] + x[1] * wreg[j + 1] + x[2] * wreg[j + 2] + x[3] * wreg[j + 3]; }
                const float sg = sigmoidf_(s);
                const float r = isw ? __expf(-0.60653066f * sg) : sg;
                out[(size_t)(t0 + tk) * 512 + ch] = (bf16_t)f2bf(r);
            }
        }
    }
}

DEV void ph_scan(const Args& a, int layer, float* lds, const int tid0) {
    const int tid = tid0, lane = tid & 63, wv = __builtin_amdgcn_readfirstlane(tid >> 6);
    const int dir = wv >> 2, w4 = wv & 3;
    float* buf = lds;
    const bf16_t* U = wsb(a, U_OFF);
    const bf16_t* Wd = wsb(a, dir ? WB2_OFF : WF_OFF); const bf16_t* Ad = wsb(a, dir ? AB_OFF : AF_OFF);
    bf16_t* Y = wsb(a, dir ? YB_OFF : YF_OFF);
    const float* sw = a.rwkv_shift + (size_t)layer * 3 * UC;
    const int js = lane & 7, q = lane >> 3, r0 = 16 * w4 + 2 * q;
    for (int un = blockIdx.x; un < NSEQ * 8; un += gridDim.x) {
        const int seq = un >> 3, hd = un & 7; const size_t tb = (size_t)seq * 4096; const int cb = hd * 64, pch = cb + lane;
        const float kkc = a.rwkv_k_k[layer * 512 + pch], kac = a.rwkv_k_a[layer * 512 + pch];
        float swr[3], swk[3], swv[3];
#pragma unroll
        for (int s = 0; s < 3; ++s) { swr[s] = sw[s * UC + pch]; swk[s] = sw[s * UC + 512 + pch]; swv[s] = sw[s * UC + 1024 + pch]; }
        float S0[8], S1[8];
#pragma unroll
        for (int i = 0; i < 8; ++i) { S0[i] = 0.f; S1[i] = 0.f; }
        for (int blk = 0; blk < 256; ++blk) {
            __syncthreads();
#pragma unroll
            for (int si = 0; si < 4; ++si) {
                const int s = w4 * 4 + si, step = blk * 16 + s, pos = dir ? 4095 - step : step; const size_t t = tb + pos;
                const bf16_t* up = U + t * UW + pch;
                float rr = swr[1] * bf2f(up[0]), kk = swk[1] * bf2f(up[512]), vv = swv[1] * bf2f(up[1024]);
                if (pos > 0) { const bf16_t* um = up - UW; rr += swr[0] * bf2f(um[0]); kk += swk[0] * bf2f(um[512]); vv += swv[0] * bf2f(um[1024]); }
                if (pos < 4095) { const bf16_t* un2 = up + UW; rr += swr[2] * bf2f(un2[0]); kk += swk[2] * bf2f(un2[512]); vv += swv[2] * bf2f(un2[1024]); }
                const float kx = kk * kkc;
                const float nrm = sqrtf(wave_sum(kx * kx));
                const float kn = kx / fmaxf(nrm, 1e-12f);
                const float av = bf2f(Ad[t * 512 + pch]), wvv = bf2f(Wd[t * 512 + pch]);
                float* o = buf + ((dir * 16 + s) * 6) * 64 + lane;
                o[0] = wvv; o[64] = -kn; o[128] = kn * av; o[192] = kk * (1.0f + (av - 1.0f) * kac); o[256] = rr; o[320] = vv;
            }
            __syncthreads();
            for (int s = 0; s < 16; ++s) {
                const float* vb = buf + ((dir * 16 + s) * 6) * 64;
                const f32x4 w0 = *(const f32x4*)(vb + 8 * js), w1 = *(const f32x4*)(vb + 8 * js + 4);
                const f32x4 a0 = *(const f32x4*)(vb + 64 + 8 * js), a1 = *(const f32x4*)(vb + 64 + 8 * js + 4);
                const f32x4 b0 = *(const f32x4*)(vb + 128 + 8 * js), b1 = *(const f32x4*)(vb + 128 + 8 * js + 4);
                const f32x4 k0 = *(const f32x4*)(vb + 192 + 8 * js), k1 = *(const f32x4*)(vb + 192 + 8 * js + 4);
                const f32x4 q0 = *(const f32x4*)(vb + 256 + 8 * js), q1 = *(const f32x4*)(vb + 256 + 8 * js + 4);
                const f32x2 v2 = *(const f32x2*)(vb + 320 + r0);
                float sa0 = 0.f, sa1 = 0.f;
#pragma unroll
                for (int i = 0; i < 4; ++i) { sa0 += S0[i] * a0[i] + S0[i + 4] * a1[i]; sa1 += S1[i] * a0[i] + S1[i + 4] * a1[i]; }
                sa0 = sum8(sa0); sa1 = sum8(sa1);
                float y0 = 0.f, y1 = 0.f;
#pragma unroll
                for (int i = 0; i < 4; ++i) {
                    S0[i] = S0[i] * w0[i] + sa0 * b0[i] + v2[0] * k0[i]; S0[i + 4] = S0[i + 4] * w1[i] + sa0 * b1[i] + v2[0] * k1[i];
                    S1[i] = S1[i] * w0[i] + sa1 * b0[i] + v2[1] * k0[i]; S1[i + 4] = S1[i + 4] * w1[i] + sa1 * b1[i] + v2[1] * k1[i];
                    y0 += S0[i] * q0[i] + S0[i + 4] * q1[i]; y1 += S1[i] * q0[i] + S1[i + 4] * q1[i];
                }
                y0 = sum8(y0); y1 = sum8(y1);
                if (js == 0) { const int step = blk * 16 + s, pos = dir ? 4095 - step : step; *(unsigned*)(Y + (tb + pos) * 512 + cb + r0) = pack2(y0, y1); }
            }
        }
    }
}

DEV void ph_post(const Args& a, int layer, float* lds, const int tid0) {
    const int lane = tid0 & 63, wv = __builtin_amdgcn_readfirstlane(tid0 >> 6);
    const int gw = blockIdx.x * 8 + wv, nw = gridDim.x * 8;
    float* sg = lds + wv * 128;
    const bf16_t* U = wsb(a, U_OFF); const bf16_t* AF = wsb(a, AF_OFF); const bf16_t* AB = wsb(a, AB_OFF);
    const bf16_t* YF = wsb(a, YF_OFF); const bf16_t* YB = wsb(a, YB_OFF); bf16_t* mix = wsb(a, MIX_OFF);
    const float* sw = a.rwkv_shift + (size_t)layer * 3 * UC;
    const int c8 = 8 * lane;
    for (int t = gw; t < T; t += nw) {
        const int pos = t & 4095; const bool hp = pos > 0, hn = pos < 4095;
        const bf16_t* up = U + (size_t)t * UW;
        {
            const int uc = 1792 + 2 * lane;
            const unsigned c = *(const unsigned*)(up + uc);
            float v0 = sw[UC + uc] * bflo(c), v1 = sw[UC + uc + 1] * bfhi(c);
            if (hp) { const unsigned p = *(const unsigned*)(up - UW + uc); v0 += sw[uc] * bflo(p); v1 += sw[uc + 1] * bfhi(p); }
            if (hn) { const unsigned n = *(const unsigned*)(up + UW + uc); v0 += sw[2 * UC + uc] * bflo(n); v1 += sw[2 * UC + uc + 1] * bfhi(n); }
            sg[2 * lane] = sigmoidf_(v0); sg[2 * lane + 1] = sigmoidf_(v1);
        }
        float g[8];
#pragma unroll
        for (int i = 0; i < 8; ++i) g[i] = 0.f;
        const float* g2 = a.rwkv_g2 + (size_t)layer * 128 * 512 + c8;
        for (int j = 0; j < 128; ++j) {
            const float s = sg[j]; const f32x4 x0 = *(const f32x4*)(g2 + j * 512), x1 = *(const f32x4*)(g2 + j * 512 + 4);
#pragma unroll
            for (int i = 0; i < 4; ++i) { g[i] += s * x0[i]; g[i + 4] += s * x1[i]; }
        }
        float r[8], k[8], v[8];
#pragma unroll
        for (int arr = 0; arr < 3; ++arr) {
            float* dst = arr == 0 ? r : (arr == 1 ? k : v);
            const int uc = arr * 512 + c8;
            const u32x4 c = *(const u32x4*)(up + uc);
            u32x4 p = {0u, 0u, 0u, 0u}, n = {0u, 0u, 0u, 0u};
            if (hp) p = *(const u32x4*)(up - UW + uc);
            if (hn) n = *(const u32x4*)(up + UW + uc);
#pragma unroll
            for (int i = 0; i < 4; ++i) {
                dst[2 * i] = sw[uc + 2 * i] * bflo(p[i]) + sw[UC + uc + 2 * i] * bflo(c[i]) + sw[2 * UC + uc + 2 * i] * bflo(n[i]);
                dst[2 * i + 1] = sw[uc + 2 * i + 1] * bfhi(p[i]) + sw[UC + uc + 2 * i + 1] * bfhi(c[i]) + sw[2 * UC + uc + 2 * i + 1] * bfhi(n[i]);
            }
        }
        const u32x4 afp = *(const u32x4*)(AF + (size_t)t * 512 + c8), abp = *(const u32x4*)(AB + (size_t)t * 512 + c8);
        const u32x4 yfp = *(const u32x4*)(YF + (size_t)t * 512 + c8), ybp = *(const u32x4*)(YB + (size_t)t * 512 + c8);
        float y[8]; float ysum = 0.f, bs = 0.f;
#pragma unroll
        for (int i = 0; i < 4; ++i) {
            y[2 * i] = bflo(yfp[i]) + bflo(ybp[i]); y[2 * i + 1] = bfhi(yfp[i]) + bfhi(ybp[i]);
            ysum += y[2 * i] + y[2 * i + 1];
            const float ka0 = a.rwkv_k_a[layer * 512 + c8 + 2 * i], ka1 = a.rwkv_k_a[layer * 512 + c8 + 2 * i + 1];
            const float kd0 = k[2 * i] * (1.0f + (bflo(afp[i]) - 1.0f) * ka0) + k[2 * i] * (1.0f + (bflo(abp[i]) - 1.0f) * ka0);
            const float kd1 = k[2 * i + 1] * (1.0f + (bfhi(afp[i]) - 1.0f) * ka1) + k[2 * i + 1] * (1.0f + (bfhi(abp[i]) - 1.0f) * ka1);
            bs += r[2 * i] * kd0 * a.rwkv_r_k[layer * 512 + c8 + 2 * i] + r[2 * i + 1] * kd1 * a.rwkv_r_k[layer * 512 + c8 + 2 * i + 1];
        }
        const float mu = sum8(ysum) * (1.0f / 64.0f);
        float vs = 0.f;
#pragma unroll
        for (int i = 0; i < 8; ++i) { y[i] -= mu; vs += y[i] * y[i]; }
        const float rstdv = rsqrtf(sum8(vs) * (1.0f / 64.0f) + 64e-5f);
        bs = sum8(bs);
        float o[8];
#pragma unroll
        for (int i = 0; i < 8; ++i) o[i] = (y[i] * rstdv * a.rwkv_ln_w[layer * 512 + c8 + i] + a.rwkv_ln_b[layer * 512 + c8 + i] + bs * v[i]) * g[i];
        u32x4 ov; ov.x = pack2(o[0], o[1]); ov.y = pack2(o[2], o[3]); ov.z = pack2(o[4], o[5]); ov.w = pack2(o[6], o[7]);
        *(u32x4*)(mix + (size_t)t * 1024 + 512 + c8) = ov;
    }
}

DEV void ph_topk(const Args& a, float* lds, const int tid0) {
    const int lane = tid0 & 63, wv = __builtin_amdgcn_readfirstlane(tid0 >> 6);
    const int gw = blockIdx.x * 8 + wv, nw = gridDim.x * 8;
    float* tv = lds + wv * 32; int* ti = (int*)(lds + 8 * 32) + wv * 32;
    const float* SC = wsf(a, SC_OFF); int* TOPI = (int*)(a.ws + TOPI_OFF); float* TOPG = wsf(a, TOPG_OFF); const float* rstd = wsf(a, RSTD_OFF);
    const float NINF = -3.0e38f;
    for (int un = gw; un < T * 8; un += nw) {
        const int t = un >> 3, hd = un & 7;
#pragma unroll
        for (int p = 0; p < 2; ++p) {
            const float* sp = SC + (size_t)t * 2048 + (hd * 2 + p) * 128;
            float v0 = sp[lane], v1 = sp[64 + lane];
            for (int r = 0; r < 16; ++r) {
                const float m = wave_max(fmaxf(v0, v1));
                const unsigned long long b0 = __ballot(v0 == m);
                int idx;
                if (b0) idx = __builtin_ctzll(b0); else { const unsigned long long b1 = __ballot(v1 == m); idx = 64 + __builtin_ctzll(b1); }
                if (lane == 0) { tv[p * 16 + r] = m; ti[p * 16 + r] = idx; }
                if (idx < 64) { if (lane == idx) v0 = NINF; } else { if (lane == idx - 64) v1 = NINF; }
            }
        }
        float cv[4];
#pragma unroll
        for (int s = 0; s < 4; ++s) { const int c = lane + 64 * s; cv[s] = tv[c >> 4] + tv[16 + (c & 15)]; }
        float mybest = NINF; int myc = 0;
        for (int r = 0; r < 16; ++r) {
            const float m = wave_max(fmaxf(fmaxf(cv[0], cv[1]), fmaxf(cv[2], cv[3])));
            int c = -1;
#pragma unroll
            for (int s = 0; s < 4; ++s) { const unsigned long long b = __ballot(cv[s] == m); if (c < 0 && b) c = 64 * s + __builtin_ctzll(b); }
            if (lane == r) { mybest = m; myc = c; }
#pragma unroll
            for (int s = 0; s < 4; ++s) if (c == 64 * s + lane) cv[s] = NINF;
        }
        const float z = (lane < 16) ? rstd[t] * mybest : NINF;
        const float mz = wave_max(z);
        const float e = (lane < 16) ? __expf(z - mz) : 0.f;
        const float se = wave_sum(e);
        if (lane < 16) {
            TOPI[(size_t)t * 128 + hd * 16 + lane] = ti[myc >> 4] * 128 + ti[16 + (myc & 15)];
            TOPG[(size_t)t * 128 + hd * 16 + lane] = e / se;
        }
    }
}

DEV void ph_peer(const Args& a, const int tid0) {
    const int lane = tid0 & 63, wv = tid0 >> 6;
    const int gw = blockIdx.x * 8 + wv, nw = gridDim.x * 8;
    bf16_t* hb = wsb(a, HB_OFF); float* rstd = wsf(a, RSTD_OFF);
    const int* TOPI = (const int*)(a.ws + TOPI_OFF); const float* TOPG = wsf(a, TOPG_OFF);
    const bf16_t* PU = wsb(a, PTU_OFF); const bf16_t* PV = wsb(a, PTV_OFF);
    const int c8 = 8 * lane;
    for (int t = gw; t < T; t += nw) {
        const u32x4 x0 = *(const u32x4*)(hb + (size_t)t * 1024 + c8), x1 = *(const u32x4*)(hb + (size_t)t * 1024 + 512 + c8);
        const float rs = rstd[t];
        const int e0 = TOPI[(size_t)t * 128 + lane], e1 = TOPI[(size_t)t * 128 + 64 + lane];
        const float g0 = TOPG[(size_t)t * 128 + lane], g1 = TOPG[(size_t)t * 128 + 64 + lane];
        float out[16];
#pragma unroll
        for (int i = 0; i < 16; ++i) out[i] = 0.f;
#pragma unroll 4
        for (int k = 0; k < 128; ++k) {
            const int e = __shfl(k < 64 ? e0 : e1, k & 63); const float gt = __shfl(k < 64 ? g0 : g1, k & 63);
            const u32x4 ua = *(const u32x4*)(PU + (size_t)e * 1024 + c8), ub = *(const u32x4*)(PU + (size_t)e * 1024 + 512 + c8);
            const u32x4 va = *(const u32x4*)(PV + (size_t)e * 1024 + c8), vb = *(const u32x4*)(PV + (size_t)e * 1024 + 512 + c8);
            float d = 0.f;
#pragma unroll
            for (int i = 0; i < 4; ++i) { d = dot2bf(x0[i], ua[i], d); d = dot2bf(x1[i], ub[i], d); }
            d = wave_sum(d);
            const float hp = rs * d;
            const float w = gt * 0.5f * hp * (1.0f + erff(hp * 0.70710678f));
#pragma unroll
            for (int i = 0; i < 4; ++i) { out[2 * i] += w * bflo(va[i]); out[2 * i + 1] += w * bfhi(va[i]); out[8 + 2 * i] += w * bflo(vb[i]); out[8 + 2 * i + 1] += w * bfhi(vb[i]); }
        }
        float* hr = a.h + (size_t)t * 1024;
        f32x4 h0 = *(const f32x4*)(hr + c8), h1 = *(const f32x4*)(hr + c8 + 4), h2 = *(const f32x4*)(hr + 512 + c8), h3 = *(const f32x4*)(hr + 512 + c8 + 4);
        float ss = 0.f;
#pragma unroll
        for (int i = 0; i < 4; ++i) { h0[i] += out[i]; h1[i] += out[4 + i]; h2[i] += out[8 + i]; h3[i] += out[12 + i]; ss += h0[i] * h0[i] + h1[i] * h1[i] + h2[i] * h2[i] + h3[i] * h3[i]; }
        *(f32x4*)(hr + c8) = h0; *(f32x4*)(hr + c8 + 4) = h1; *(f32x4*)(hr + 512 + c8) = h2; *(f32x4*)(hr + 512 + c8 + 4) = h3;
        ss = wave_sum(ss);
        u32x4 p0, p1; p0.x = pack2(h0[0], h0[1]); p0.y = pack2(h0[2], h0[3]); p0.z = pack2(h1[0], h1[1]); p0.w = pack2(h1[2], h1[3]);
        p1.x = pack2(h2[0], h2[1]); p1.y = pack2(h2[2], h2[3]); p1.z = pack2(h3[0], h3[1]); p1.w = pack2(h3[2], h3[3]);
        *(u32x4*)(hb + (size_t)t * 1024 + c8) = p0; *(u32x4*)(hb + (size_t)t * 1024 + 512 + c8) = p1;
        if (lane == 0) rstd[t] = rsqrtf(ss * (1.0f / 1024.0f) + 1e-6f);
    }
}

extern __shared__ __attribute__((aligned(16))) unsigned char smem[];

enum { PH_PROLOGUE = 0, PH_ROWPREP_X, PH_ROWPREP, PH_GEMM1, PH_ATTN, PH_LORA, PH_SCAN, PH_POST, PH_GEMM2, PH_CONVERT, PH_GEMM3, PH_TOPK, PH_PEER, PH_GEMM4A, PH_GEMM4B, PH_FINAL };

template <int PH> DEV void run_phase(const Args& a, int layer, const int tid0) {
    float* ldsf = (float*)smem;
    PG8_LAS unsigned char* ldsg = (PG8_LAS unsigned char*)smem;
    const bf16_t* wb = wsb(a, WB_OFF + (size_t)layer * WB_LAYER);
    if constexpr (PH == PH_PROLOGUE) ph_prologue(a, ldsf, tid0);
    else if constexpr (PH == PH_ROWPREP_X) ph_rowprep(a, true, tid0);
    else if constexpr (PH == PH_ROWPREP) ph_rowprep(a, false, tid0);
    else if constexpr (PH == PH_GEMM1) {
        pg8::Gemm g{wsb(a, HB_OFF), wb + WB_IN / 2, T, INP, 1024};
        pg8::StaticOrder S; S.init(T, INP, gridDim.x, blockIdx.x);
        pg8::EpiProj E{wsb(a, QKV_OFF), wsb(a, U_OFF), wsf(a, RSTD_OFF), wsf(a, ROPEC_OFF), wsf(a, ROPES_OFF)};
        pg8::gemm_phase<pg8::EpiProj, pg8::StaticOrder, false>(ldsg, g, S, E, nullptr, tid0);
    }
    else if constexpr (PH == PH_ATTN) ph_attn(a, layer, ldsf, tid0);
    else if constexpr (PH == PH_LORA) ph_lora(a, layer, ldsf, tid0);
    else if constexpr (PH == PH_SCAN) ph_scan(a, layer, ldsf, tid0);
    else if constexpr (PH == PH_POST) ph_post(a, layer, ldsf, tid0);
    else if constexpr (PH == PH_GEMM2) {
        pg8::Gemm g{wsb(a, MIX_OFF), wb + WB_OUT / 2, T, 1024, 1024};
        pg8::StaticOrder S; S.init(T, 1024, gridDim.x, blockIdx.x);
        pg8::EpiF32x<1> E{a.h, 1024, nullptr};
        pg8::gemm_phase<pg8::EpiF32x<1>, pg8::StaticOrder, false>(ldsg, g, S, E, nullptr, tid0);
    }
    else if constexpr (PH == PH_CONVERT) ph_convert(a, layer, tid0);
    else if constexpr (PH == PH_GEMM3) {
        pg8::Gemm g{wsb(a, HB_OFF), wb + WB_QK / 2, T, 2048, 1024};
        pg8::StaticOrder S; S.init(T, 2048, gridDim.x, blockIdx.x);
        pg8::EpiF32x<0> E{wsf(a, SC_OFF), 2048, nullptr};
        pg8::gemm_phase<pg8::EpiF32x<0>, pg8::StaticOrder, false>(ldsg, g, S, E, nullptr, tid0);
    }
    else if constexpr (PH == PH_TOPK) ph_topk(a, ldsf, tid0);
    else if constexpr (PH == PH_PEER) ph_peer(a, tid0);
    else if constexpr (PH == PH_GEMM4A) {
        pg8::Gemm g{wsb(a, HB_OFF), wb + WB_GATE / 2, T, 1024, 1024};
        pg8::StaticOrder S; S.init(T, 1024, gridDim.x, blockIdx.x);
        pg8::EpiGate E{wsb(a, GATE_OFF), wsf(a, RSTD_OFF), a.ple_b_gate + layer * 1024};
        pg8::gemm_phase<pg8::EpiGate, pg8::StaticOrder, false>(ldsg, g, S, E, nullptr, tid0);
    }
    else if constexpr (PH == PH_GEMM4B) {
        pg8::Gemm g{wsb(a, PB_OFF), wb + WB_PROJ / 2, T, 1024, 256};
        pg8::StaticOrder S; S.init(T, 1024, gridDim.x, blockIdx.x);
        pg8::EpiF32x<2> E{a.h, 1024, wsb(a, GATE_OFF)};
        pg8::gemm_phase<pg8::EpiF32x<2>, pg8::StaticOrder, false>(ldsg, g, S, E, nullptr, tid0);
    }
    else if constexpr (PH == PH_FINAL) ph_final(a, tid0);
}

#if !ONE_LAUNCH
template <int PH> __global__ void __launch_bounds__(NTHR, 2) k_phase(Args a, int layer) { run_phase<PH>(a, layer, (int)threadIdx.x); }
#endif

#if ONE_LAUNCH
typedef const __attribute__((address_space(4))) unsigned long long* kargs_t;
static_assert(sizeof(Args) == 31 * 8, "Args is 31 pointers, no padding");
DEV Args load_args(kargs_t kp) { Args r; unsigned long long* d = (unsigned long long*)&r;
#pragma unroll
    for (int i = 0; i < 31; ++i) d[i] = kp[i];
    return r; }
#define RUN(PH, layer) do { kargs_t kp_ = (kargs_t)__builtin_amdgcn_kernarg_segment_ptr(); asm volatile("" : "+s"(kp_)); const Args la_ = load_args(kp_); int t_; asm volatile("v_mbcnt_lo_u32_b32 %0, -1, 0\n\tv_mbcnt_hi_u32_b32 %0, -1, %0\n\tv_lshl_add_u32 %0, %1, 6, %0" : "=&v"(t_) : "s"(wv0_)); run_phase<PH>(la_, layer, t_); } while (0)
#define BAR() do { kargs_t kp_ = (kargs_t)__builtin_amdgcn_kernarg_segment_ptr(); asm volatile("" : "+s"(kp_)); XcdBarrier b_; b_.bar = (unsigned*)((unsigned char*)kp_[30] + BAR_OFF); b_.x = xb_xcc_id(); b_.st = (volatile LAS unsigned*)(smem + LDS_BYTES - 16); int t_; asm volatile("v_mbcnt_lo_u32_b32 %0, -1, 0\n\tv_mbcnt_hi_u32_b32 %0, -1, %0\n\tv_lshl_add_u32 %0, %1, 6, %0" : "=&v"(t_) : "s"(wv0_)); xcd_barrier(b_, t_); } while (0)
__global__ void __launch_bounds__(NTHR, 2) k_mega(Args a) {
    if (threadIdx.x == 0) *(uint4*)(smem + LDS_BYTES - 16) = make_uint4(0u, 0u, 0u, 0u);
    __syncthreads();
    (void)xcd_barrier_post((unsigned*)(a.ws + BAR_OFF), (volatile LAS unsigned*)(smem + LDS_BYTES - 16));
    const int wv0_ = __builtin_amdgcn_readfirstlane((int)threadIdx.x >> 6);
    RUN(PH_PROLOGUE, 0);
    RUN(PH_ROWPREP_X, 0); BAR();
    for (int layer = 0; layer < NL; ++layer) {
        if (layer > 0) { RUN(PH_ROWPREP, layer); BAR(); }
        RUN(PH_GEMM1, layer); BAR();
        RUN(PH_ATTN, layer); BAR();
        RUN(PH_LORA, layer); BAR();
        RUN(PH_SCAN, layer); BAR();
        RUN(PH_POST, layer); BAR();
        RUN(PH_GEMM2, layer); BAR();
        RUN(PH_ROWPREP, layer); RUN(PH_CONVERT, layer); BAR();
        RUN(PH_GEMM3, layer); BAR();
        RUN(PH_TOPK, layer); BAR();
        RUN(PH_PEER, layer); BAR();
        RUN(PH_GEMM4A, layer); BAR();
        RUN(PH_GEMM4B, layer); BAR();
    }
    RUN(PH_FINAL, 0);
}
#endif

#if !ONE_LAUNCH
template <int PH> static void launch_phase(const Args& a, int layer, hipStream_t st) {
    static bool attr = false;
    if (!attr) { (void)hipFuncSetAttribute((const void*)k_phase<PH>, hipFuncAttributeMaxDynamicSharedMemorySize, LDS_BYTES); attr = true; }
    hipLaunchKernelGGL(k_phase<PH>, dim3(NWG), dim3(NTHR), LDS_BYTES, st, a, layer);
}
#endif

extern "C" void kernel_launch(void* const* d_in, const int* in_sizes, int n_in, void* d_out, int out_size, void* d_ws, size_t ws_size, hipStream_t stream) {
    if (n_in != 29 || out_size != T * D || ws_size < WS_END) {
        fprintf(stderr, "kernel_launch: unexpected shapes (n_in %d, out %d, ws %zu, need %zu); nothing launched\n", n_in, out_size, ws_size, (size_t)WS_END);
        return;
    }
    Args a{};
    const float** ap = (const float**)&a;
    for (int i = 0; i < 29; ++i) ap[i] = (const float*)d_in[i];
    a.h = (float*)d_out; a.ws = (unsigned char*)d_ws;
#if ONE_LAUNCH
    static bool attr = false;
    if (!attr) { (void)hipFuncSetAttribute((const void*)k_mega, hipFuncAttributeMaxDynamicSharedMemorySize, LDS_BYTES); attr = true; }
    (void)hipMemsetAsync((char*)d_ws + BAR_OFF, 0, XCD_BAR_WORDS * sizeof(unsigned), stream);
    hipLaunchKernelGGL(k_mega, dim3(NWG), dim3(NTHR), LDS_BYTES, stream, a);
#else
    launch_phase<PH_PROLOGUE>(a, 0, stream);
    launch_phase<PH_ROWPREP_X>(a, 0, stream);
    for (int layer = 0; layer < NL; ++layer) {
        if (layer > 0) launch_phase<PH_ROWPREP>(a, layer, stream);
        launch_phase<PH_GEMM1>(a, layer, stream);
        launch_phase<PH_ATTN>(a, layer, stream);
        launch_phase<PH_LORA>(a, layer, stream);
        launch_phase<PH_SCAN>(a, layer, stream);
        launch_phase<PH_POST>(a, layer, stream);
        launch_phase<PH_GEMM2>(a, layer, stream);
        launch_phase<PH_ROWPREP>(a, layer, stream);
        launch_phase<PH_CONVERT>(a, layer, stream);
        launch_phase<PH_GEMM3>(a, layer, stream);
        launch_phase<PH_TOPK>(a, layer, stream);
        launch_phase<PH_PEER>(a, layer, stream);
        launch_phase<PH_GEMM4A>(a, layer, stream);
        launch_phase<PH_GEMM4B>(a, layer, stream);
    }
    launch_phase<PH_FINAL>(a, 0, stream);
#endif
}
```

```cpp
#include <hip/hip_runtime.h>
#include <stdint.h>
#include <stdio.h>

#ifndef ONE_LAUNCH
#define ONE_LAUNCH 1
#endif

typedef unsigned short bf16_t;
typedef float f32x4 __attribute__((ext_vector_type(4)));
typedef float f32x2 __attribute__((ext_vector_type(2)));
typedef unsigned u32x4 __attribute__((ext_vector_type(4)));
typedef unsigned u32x2 __attribute__((ext_vector_type(2)));
typedef __bf16 bf16x2_t __attribute__((ext_vector_type(2)));

#define DEV __device__ __forceinline__

namespace cfg {
constexpr int NSEQ = 20, SEQ = 4096, T = NSEQ * SEQ, TP = 4 * SEQ, D = 1024, NL = 4;
constexpr int INC = 3456, INP = 3584;
constexpr int QKVW = 1536, UW = 2048, UC = 1920;
constexpr int NWG = 256, NTHR = 512;
constexpr int LDS_BYTES = 147456;
constexpr size_t MiB = 1ull << 20;
constexpr size_t WB_OFF = 0;
constexpr size_t WB_LAYER = 16 * MiB;
constexpr size_t WB_IN = 0, WB_OUT = 7 * MiB, WB_QK = 9 * MiB, WB_GATE = 13 * MiB, WB_PROJ = 15 * MiB;
constexpr size_t HB_OFF = 64 * MiB;
constexpr size_t MIX_OFF = 224 * MiB;
constexpr size_t SMALL_OFF = 384 * MiB;
constexpr size_t RSTD_OFF = SMALL_OFF;
constexpr size_t ROPEC_OFF = SMALL_OFF + 512 * 1024, ROPES_OFF = SMALL_OFF + 640 * 1024;
constexpr size_t BAR_OFF = SMALL_OFF + 1 * MiB;
constexpr size_t BIG_OFF = 386 * MiB;
constexpr size_t QKV_OFF = BIG_OFF;
constexpr size_t WF_OFF = BIG_OFF, WB2_OFF = BIG_OFF + 80 * MiB, AF_OFF = BIG_OFF + 160 * MiB;
constexpr size_t U_OFF = BIG_OFF + 240 * MiB;
constexpr size_t AB_OFF = BIG_OFF + 560 * MiB;
constexpr size_t YF_OFF = BIG_OFF + 640 * MiB, YB_OFF = BIG_OFF + 720 * MiB;
constexpr size_t OP_OFF = BIG_OFF + 560 * MiB;
constexpr size_t ML_OFF = BIG_OFF + 800 * MiB;
constexpr size_t SC_OFF = BIG_OFF;
constexpr size_t TOPI_OFF = BIG_OFF + 640 * MiB, TOPG_OFF = BIG_OFF + 680 * MiB;
constexpr size_t PTU_OFF = BIG_OFF + 720 * MiB, PTV_OFF = BIG_OFF + 752 * MiB;
constexpr size_t PB_OFF = BIG_OFF + 784 * MiB;
constexpr size_t GATE_OFF = BIG_OFF;
constexpr size_t WS_END = BIG_OFF + 824 * MiB;
}
using namespace cfg;

struct Args {
    const float* x_prompt; const float* x_sample; const float* p_prompt; const float* p_sample;
    const float* norm_mix_g; const float* w_in; const float* att_norm_g; const float* rwkv_shift;
    const float* rwkv_w0; const float* rwkv_w2; const float* rwkv_a0; const float* rwkv_a2; const float* rwkv_g2;
    const float* rwkv_k_k; const float* rwkv_k_a; const float* rwkv_r_k; const float* rwkv_ln_w; const float* rwkv_ln_b;
    const float* w_out; const float* norm_ffn_g; const float* peer_w_q; const float* peer_sub_keys; const float* peer_u; const float* peer_v;
    const float* ple_norm_g; const float* ple_w_gate; const float* ple_b_gate; const float* ple_w_proj; const float* final_norm_g;
    float* h;
    unsigned char* ws;
};

DEV int tid_() { int t = threadIdx.x; asm volatile("" : "+v"(t)); return t; }
DEV float bf2f(unsigned h) { return __uint_as_float(h << 16); }
DEV float bflo(unsigned d) { return __uint_as_float(d << 16); }
DEV float bfhi(unsigned d) { return __uint_as_float(d & 0xffff0000u); }
DEV unsigned f2bf(float f) { const unsigned u = __float_as_uint(f); return (u + 0x7fffu + ((u >> 16) & 1u)) >> 16; }
DEV unsigned pack2(float lo, float hi) { return f2bf(lo) | (f2bf(hi) << 16); }
DEV float dot2bf(unsigned a, unsigned b, float c) { return __builtin_amdgcn_fdot2_f32_bf16(__builtin_bit_cast(bf16x2_t, a), __builtin_bit_cast(bf16x2_t, b), c, false); }
DEV float shx_(float v, int lane, int o) { return __int_as_float(__builtin_amdgcn_ds_bpermute((lane ^ o) << 2, __float_as_int(v))); }
DEV float shf_(float v, int src) { return __int_as_float(__builtin_amdgcn_ds_bpermute(src << 2, __float_as_int(v))); }
DEV int shf_(int v, int src) { return __builtin_amdgcn_ds_bpermute(src << 2, v); }
#define SHX(v, o) shx_((v), lane, (o))
#define SHF(v, src) shf_((v), (src))
DEV float wave_sum_(float v, int lane) {
#pragma unroll
    for (int o = 32; o > 0; o >>= 1) v += shx_(v, lane, o);
    return v;
}
DEV float wave_max_(float v, int lane) {
#pragma unroll
    for (int o = 32; o > 0; o >>= 1) v = fmaxf(v, shx_(v, lane, o));
    return v;
}
#define wave_sum(x) wave_sum_((x), lane)
#define wave_max(x) wave_max_((x), lane)
DEV float sum8(float v) {
    v += __int_as_float(__builtin_amdgcn_mov_dpp(__float_as_int(v), 0xB1, 0xF, 0xF, true));
    v += __int_as_float(__builtin_amdgcn_mov_dpp(__float_as_int(v), 0x4E, 0xF, 0xF, true));
    v += __int_as_float(__builtin_amdgcn_mov_dpp(__float_as_int(v), 0x141, 0xF, 0xF, true));
    return v;
}
DEV float sigmoidf_(float x) { return 1.0f / (1.0f + __expf(-x)); }
namespace pg8 {
#define PG8_LAS __attribute__((address_space(3)))
typedef unsigned short bf16_t;
typedef short bf16x8 __attribute__((ext_vector_type(8)));
typedef float f32x4 __attribute__((ext_vector_type(4)));
typedef unsigned u32x4 __attribute__((ext_vector_type(4)));
constexpr int BM = 256, BK = 64, HALF = 128, HTB = HALF * BK * 2  , STAGE_BYTES = 8 * HTB, NXCD = 8, WGM = 8;

__host__ __device__ __forceinline__ int lds_byte(int r, int c) { const int st = (r >> 4) * 2 + (c >> 5), rr = r & 15, cc = c & 31, ob = rr * 64 + cc * 2; return st * 1024 + (ob ^ (((ob >> 9) & 1) << 5)); }
__host__ __device__ __forceinline__ void stage_rc(int b, int& R, int& C) { const int st = b / 1024, sb = b % 1024, swz = sb ^ (((sb >> 9) & 1) << 5); R = (st >> 1) * 16 + swz / 64; C = (st & 1) * 32 + (swz % 64) / 2; }
__host__ __device__ __forceinline__ int perm32(int rho) { const int n = rho >> 4, i = rho & 15; return 8 * (i >> 2) + 4 * n + (i & 3); }

struct Unit { int pm, pn; };
struct Gemm { const bf16_t* A; const bf16_t* Bt; int M, N, K; };

struct StaticOrder {
    int nM, nN, nwg, G, c;
    __host__ __device__ void init(int M, int N, int G_, int c_) { nM = M / BM; nN = N / BM; nwg = nM * nN; G = G_; c = c_; }
    __host__ __device__ bool next(int i, Unit& u) const {
        const long L = (long)i * G + c; if (L >= nwg) return false;
        int wgid = (int)L; { const int q = nwg / NXCD, r = nwg % NXCD, xcd = wgid % NXCD, off = wgid / NXCD; wgid = (xcd < r ? xcd * (q + 1) : r * (q + 1) + (xcd - r) * q) + off; }
        const int nig = WGM * nN, gid = wgid / nig, fm = gid * WGM, gsz = (nM - fm) < WGM ? (nM - fm) : WGM;
        u.pm = fm + ((wgid % nig) % gsz); u.pn = (wgid % nig) / gsz; return true;
    }
    __device__ __forceinline__ void a_ready(const Unit&) const {}
    __device__ __forceinline__ void done(const Unit&) const {}
};
__device__ __forceinline__ unsigned cvt_pk_bf16(float lo, float hi) { unsigned r; asm volatile("v_cvt_pk_bf16_f32 %0, %1, %2" : "=v"(r) : "v"(lo), "v"(hi)); return r; }

struct EpiProj {
    static constexpr bool PERM = true, AFTER_DRAIN = false;
    bf16_t* qkv; bf16_t* u; const float* rstd; const float* rc; const float* rs;
    __device__ __forceinline__ void operator()(const f32x4 (&acc)[2][2][4][2], const Unit& un, int wr, int wc, int fr, int fq) const {
        const int row0 = un.pm * BM + wr * 64 + fr, lane = fr + 16 * fq;
        const bool isq = un.pn < 6;
        bf16_t* base = isq ? qkv : u; const int ld = isq ? 1536 : 2048; const int colt = isq ? un.pn * BM : (un.pn - 6) * BM;
        const int col0 = colt + wc * 32 + 8 * fq;
        const bool rope = (un.pn < 4) && ((wc & 1) == 0);
#pragma unroll
        for (int ai = 0; ai < 2; ++ai)
#pragma unroll
            for (int m = 0; m < 4; ++m) {
                const int row = row0 + ai * HALF + m * 16; const float s = rstd[row]; const int pos = row & 4095;
                f32x4 c0 = {1.f, 1.f, 1.f, 1.f}, c1 = c0, s0 = {0.f, 0.f, 0.f, 0.f}, s1 = s0;
                if (rope) { c0 = *(const f32x4*)(rc + pos * 8); c1 = *(const f32x4*)(rc + pos * 8 + 4); s0 = *(const f32x4*)(rs + pos * 8); s1 = *(const f32x4*)(rs + pos * 8 + 4); }
                bf16_t* rowp = base + (size_t)row * ld + col0;
#pragma unroll
                for (int bj = 0; bj < 2; ++bj) {
                    f32x4 v0 = acc[ai][bj][m][0] * s, v1 = acc[ai][bj][m][1] * s;
                    if (rope) {
                        f32x4 o0, o1;
#pragma unroll
                        for (int c = 0; c < 4; ++c) { o0[c] = SHX(v0[c], 16); o1[c] = SHX(v1[c], 16); }
                        if (fq == 0) { v0 = v0 * c0 - o0 * s0; v1 = v1 * c1 - o1 * s1; }
                        else if (fq == 1) { v0 = v0 * c0 + o0 * s0; v1 = v1 * c1 + o1 * s1; }
                    }
                    u32x4 w; w.x = cvt_pk_bf16(v0[0], v0[1]); w.y = cvt_pk_bf16(v0[2], v0[3]); w.z = cvt_pk_bf16(v1[0], v1[1]); w.w = cvt_pk_bf16(v1[2], v1[3]);
                    *(u32x4*)(rowp + bj * HALF) = w;
                }
            }
    }
};
template <int MODE> struct EpiF32x {
    static constexpr bool PERM = false, AFTER_DRAIN = false;
    float* C; int ldc; const bf16_t* gate;
    __device__ __forceinline__ void operator()(const f32x4 (&acc)[2][2][4][2], const Unit& un, int wr, int wc, int fr, int fq) const {
        const int row0 = un.pm * BM + wr * 64 + fr, col0 = un.pn * BM + wc * 32 + 4 * fq;
#pragma unroll
        for (int ai = 0; ai < 2; ++ai)
#pragma unroll
            for (int m = 0; m < 4; ++m) {
                const size_t ro = (size_t)(row0 + ai * HALF + m * 16) * ldc + col0;
                if (MODE != 0) asm volatile("" ::: "memory");
#pragma unroll
                for (int bj = 0; bj < 2; ++bj)
#pragma unroll
                    for (int n = 0; n < 2; ++n) {
                        f32x4* p = (f32x4*)(C + ro + bj * HALF + n * 16);
                        if (MODE == 0) *p = acc[ai][bj][m][n];
                        else if (MODE == 1) *p = *p + acc[ai][bj][m][n];
                        else { const u32x2 g = *(const u32x2*)(gate + ro + bj * HALF + n * 16);
                               f32x4 gv; gv[0] = __uint_as_float(g.x << 16); gv[1] = __uint_as_float(g.x & 0xffff0000u); gv[2] = __uint_as_float(g.y << 16); gv[3] = __uint_as_float(g.y & 0xffff0000u);
                               *p = *p + gv * acc[ai][bj][m][n]; }
                    }
            }
    }
};
struct EpiGate {
    static constexpr bool PERM = true, AFTER_DRAIN = false;
    bf16_t* O; const float* rstd; const float* bias;
    __device__ __forceinline__ void operator()(const f32x4 (&acc)[2][2][4][2], const Unit& un, int wr, int wc, int fr, int fq) const {
        const int row0 = un.pm * BM + wr * 64 + fr, col0 = un.pn * BM + wc * 32 + 8 * fq;
        f32x4 bv[2][2];
#pragma unroll
        for (int bj = 0; bj < 2; ++bj)
#pragma unroll
            for (int n = 0; n < 2; ++n) bv[bj][n] = *(const f32x4*)(bias + col0 + bj * HALF + 4 * n);
#pragma unroll
        for (int ai = 0; ai < 2; ++ai)
#pragma unroll
            for (int m = 0; m < 4; ++m) {
                const int row = row0 + ai * HALF + m * 16; const float s = rstd[row];
                bf16_t* rowp = O + (size_t)row * 1024 + col0;
#pragma unroll
                for (int bj = 0; bj < 2; ++bj) {
                    f32x4 v0 = acc[ai][bj][m][0] * s + bv[bj][0], v1 = acc[ai][bj][m][1] * s + bv[bj][1];
#pragma unroll
                    for (int c = 0; c < 4; ++c) { v0[c] = 1.0f / (1.0f + __expf(-v0[c])); v1[c] = 1.0f / (1.0f + __expf(-v1[c])); }
                    u32x4 w; w.x = cvt_pk_bf16(v0[0], v0[1]); w.y = cvt_pk_bf16(v0[2], v0[3]); w.z = cvt_pk_bf16(v1[0], v1[1]); w.w = cvt_pk_bf16(v1[2], v1[3]);
                    *(u32x4*)(rowp + bj * HALF) = w;
                }
            }
    }
};
template <class Epi, class Sched, bool STAMP = false>
__device__ __forceinline__ void gemm_phase(PG8_LAS unsigned char* lds, const Gemm g, const Sched& S, const Epi& E, unsigned long long* stamps, const int tid_in) {
    const int tid = tid_in, wid = __builtin_amdgcn_readfirstlane(tid >> 6), lane = tid & 63, wr = wid >> 2, wc = wid & 3, fr = lane & 15, fq = lane >> 4;
    const int K = g.K, nt = K / BK;
    int ts_lo = 0, ts_hi = 0, nts = 0; const unsigned long long rt_entry = STAMP ? (unsigned long long)wall_clock64() : 0ull;
#define PG8_STAMP() do { if (STAMP && wid == 0 && nts < 64) { const unsigned long long _c = (unsigned long long)clock64(); \
        ts_lo = (lane == nts) ? (int)(unsigned)_c : ts_lo; ts_hi = (lane == nts) ? (int)(unsigned)(_c >> 32) : ts_hi; ++nts; } } while (0)
    PG8_STAMP();
    unsigned voffA[2], voffB[2];
#pragma unroll
    for (int i = 0; i < 2; ++i) { int R, C; stage_rc(tid * 16 + i * 8192, R, C); const int Rb = Epi::PERM ? ((R & ~31) + perm32(R & 31)) : R;
        voffA[i] = (unsigned)(R * K + C) * 2u; voffB[i] = (unsigned)(Rb * K + C) * 2u; }
    const size_t kstep = (size_t)(BK * 2);
    const size_t hstep = (size_t)HALF * K * 2;
    const size_t tstep = 2 * hstep;
    const unsigned ldsw = (unsigned)wid * 1024u;
    const int aoff = lds_byte(wr * 64 + fr, fq * 8), boff = lds_byte(wc * 32 + fr, fq * 8);
#define PG8_SA(b, h) (((b) * 2 + (h)) * HTB)
#define PG8_SB(b, h) ((4 + (b) * 2 + (h)) * HTB)
#define PG8_STAGE(bufoff, gbase, voff) do { _Pragma("unroll") for (int _i = 0; _i < 2; ++_i) \
        __builtin_amdgcn_global_load_lds((const unsigned*)((const char*)(gbase) + (voff)[_i]), (PG8_LAS unsigned*)(lds + (bufoff) + ldsw + _i * 8192), 16, 0, 0); } while (0)
#define PG8_LDA(dst, b, h) do { _Pragma("unroll") for (int m = 0; m < 4; ++m) _Pragma("unroll") for (int k = 0; k < 2; ++k) dst[m][k] = *(const PG8_LAS bf16x8*)(lds + PG8_SA(b, h) + aoff + m * 2048 + k * 1024); } while (0)
#define PG8_LDB(dst, b, h) do { _Pragma("unroll") for (int n = 0; n < 2; ++n) _Pragma("unroll") for (int k = 0; k < 2; ++k) dst[n][k] = *(const PG8_LAS bf16x8*)(lds + PG8_SB(b, h) + boff + n * 2048 + k * 1024); } while (0)
#define PG8_MMA(ai, bj, At, Bt) do { __builtin_amdgcn_s_setprio(1); _Pragma("unroll") for (int m = 0; m < 4; ++m) _Pragma("unroll") for (int n = 0; n < 2; ++n) _Pragma("unroll") for (int k = 0; k < 2; ++k) \
        acc[ai][bj][m][n] = __builtin_amdgcn_mfma_f32_16x16x32_bf16(Bt[n][k], At[m][k], acc[ai][bj][m][n], 0, 0, 0); __builtin_amdgcn_s_setprio(0); } while (0)
#define PG8_WAIT_V(n) asm volatile("s_waitcnt vmcnt(" #n ")" ::: "memory")
#define PG8_WAIT_L(n) asm volatile("s_waitcnt lgkmcnt(" #n ")" ::: "memory")
#define PG8_BAR __builtin_amdgcn_s_barrier()
#define PG8_SCHED __builtin_amdgcn_sched_barrier(0)
    Unit cur, nxt; int ui = 0;
    if (!S.next(0, cur)) return;
    f32x4 acc[2][2][4][2];
#pragma unroll
    for (int a = 0; a < 2; ++a)
#pragma unroll
        for (int b = 0; b < 2; ++b)
#pragma unroll
            for (int m = 0; m < 4; ++m)
#pragma unroll
                for (int n = 0; n < 2; ++n) acc[a][b][m][n] = (f32x4){0.f, 0.f, 0.f, 0.f};
    bf16x8 At[4][2], B0[2][2], B1[2][2];
    const char* cA = (const char*)g.A + (size_t)cur.pm * tstep; const char* cB = (const char*)g.Bt + (size_t)cur.pn * tstep;
    S.a_ready(cur);
    PG8_STAGE(PG8_SB(0, 0), cB, voffB); PG8_STAGE(PG8_SA(0, 0), cA, voffA); PG8_STAGE(PG8_SB(0, 1), cB + hstep, voffB); PG8_STAGE(PG8_SA(0, 1), cA + hstep, voffA);
    if (wr == 1) PG8_BAR;
    PG8_WAIT_V(4); PG8_BAR;
    PG8_STAGE(PG8_SB(1, 0), cB + kstep, voffB); PG8_STAGE(PG8_SA(1, 0), cA + kstep, voffA); PG8_STAGE(PG8_SB(1, 1), cB + hstep + kstep, voffB);
    PG8_WAIT_V(6); PG8_BAR;
    PG8_STAMP();
    for (;;) {
        const bool has_next = S.next(ui + 1, nxt);
        const char* nA = has_next ? (const char*)g.A + (size_t)nxt.pm * tstep : cA; const char* nB = has_next ? (const char*)g.Bt + (size_t)nxt.pn * tstep : cB;
        for (int t = 0; t < nt; t += 2) {
            const bool last = (t == nt - 2);
            const char* a1 = cA + (size_t)(t + 1) * kstep;
            const char* a2 = last ? nA : cA + (size_t)(t + 2) * kstep; const char* b2 = last ? nB : cB + (size_t)(t + 2) * kstep;
            const char* a3 = a2 + kstep; const char* b3 = b2 + kstep;
            if (last && has_next) S.a_ready(nxt);
            PG8_LDB(B0, 0, 0); PG8_SCHED; PG8_LDA(At, 0, 0); PG8_STAGE(PG8_SA(1, 1), a1 + hstep, voffA);
            PG8_WAIT_L(8); PG8_BAR; PG8_WAIT_L(0); PG8_MMA(0, 0, At, B0); PG8_BAR; PG8_SCHED;
            PG8_LDB(B1, 0, 1); PG8_STAGE(PG8_SB(0, 0), b2, voffB);
            PG8_BAR; PG8_WAIT_L(0); PG8_MMA(0, 1, At, B1); PG8_BAR;
            PG8_LDA(At, 0, 1); PG8_STAGE(PG8_SA(0, 0), a2, voffA);
            PG8_BAR; PG8_WAIT_L(0); PG8_MMA(1, 0, At, B0); PG8_BAR; PG8_SCHED;
            PG8_STAGE(PG8_SB(0, 1), b2 + hstep, voffB);
            PG8_WAIT_V(6); PG8_BAR; PG8_MMA(1, 1, At, B1); PG8_BAR;
            PG8_LDB(B0, 1, 0); PG8_SCHED; PG8_LDA(At, 1, 0); PG8_STAGE(PG8_SA(0, 1), a2 + hstep, voffA);
            PG8_WAIT_L(8); PG8_BAR; PG8_WAIT_L(0); PG8_MMA(0, 0, At, B0); PG8_BAR; PG8_SCHED;
            PG8_LDB(B1, 1, 1); PG8_STAGE(PG8_SB(1, 0), b3, voffB);
            PG8_BAR; PG8_WAIT_L(0); PG8_MMA(0, 1, At, B1); PG8_BAR;
            PG8_LDA(At, 1, 1); PG8_STAGE(PG8_SA(1, 0), a3, voffA);
            PG8_BAR; PG8_WAIT_L(0); PG8_MMA(1, 0, At, B0); PG8_BAR; PG8_SCHED;
            PG8_STAGE(PG8_SB(1, 1), b3 + hstep, voffB);
            PG8_WAIT_V(6); PG8_BAR; PG8_MMA(1, 1, At, B1); PG8_BAR;
        }
        PG8_STAMP();
        if constexpr (!Epi::AFTER_DRAIN) { E(acc, cur, wr, wc, fr, fq); S.done(cur); }
        PG8_STAMP();
        if (!has_next) break;
#pragma unroll
        for (int a = 0; a < 2; ++a)
#pragma unroll
            for (int b = 0; b < 2; ++b)
#pragma unroll
                for (int m = 0; m < 4; ++m)
#pragma unroll
                    for (int n = 0; n < 2; ++n) acc[a][b][m][n] = (f32x4){0.f, 0.f, 0.f, 0.f};
        cur = nxt; cA = nA; cB = nB; ++ui;
    }
    PG8_WAIT_V(0);
    if (wr == 0) PG8_BAR;
    PG8_BAR;
    if constexpr (Epi::AFTER_DRAIN) { E.fused(acc, cur, wr, wc, fr, fq, lds, wid, lane); S.done(cur); }
    PG8_STAMP();
    if (STAMP && wid == 0) { stamps[lane] = lane < nts ? (((unsigned long long)(unsigned)ts_hi << 32) | (unsigned)ts_lo) : 0ull;
        if (lane == 62) stamps[62] = rt_entry; if (lane == 63) stamps[63] = (unsigned long long)wall_clock64(); }
#undef PG8_STAMP
#undef PG8_SA
#undef PG8_SB
#undef PG8_STAGE
#undef PG8_LDA
#undef PG8_LDB
#undef PG8_MMA
#undef PG8_WAIT_V
#undef PG8_WAIT_L
#undef PG8_BAR
#undef PG8_SCHED
}
}
#define XB_TMO      128
#define XB_XCNT(j)  (256  + 64 * (j))
#define XB_XSUB(j)  (1280 + 64 * (j))
#define XB_XGEN(j)  (2304 + 64 * (j))
#define XB_TOP      3328
#define XB_TOPGEN   3392
#define XCD_BAR_WORDS 3456
#define XB_SPIN_CAP (1u << 23)
#define LAS __attribute__((address_space(3)))

__device__ __forceinline__ unsigned xb_ld(unsigned* p)              { return __hip_atomic_load(p, __ATOMIC_RELAXED, __HIP_MEMORY_SCOPE_AGENT); }
__device__ __forceinline__ unsigned xb_add(unsigned* p, unsigned v) { return __hip_atomic_fetch_add(p, v, __ATOMIC_RELAXED, __HIP_MEMORY_SCOPE_AGENT); }
__device__ __forceinline__ unsigned xb_xcc_id() { return (unsigned)__builtin_amdgcn_s_getreg((3 << 11) | 20) & 0xFu; }
#define XB_SPIN(cond, bar) do { unsigned _sp = 0; while (cond) { __builtin_amdgcn_s_sleep(1); \
    if ((++_sp & 255u) == 0u) { if (xb_ld(&(bar)[XB_TMO])) break; if (_sp > XB_SPIN_CAP) { atomicAdd(&(bar)[XB_TMO], 1u); break; } } } } while (0)

struct XcdBarrier {
    unsigned* bar; unsigned x;
    volatile LAS unsigned* st;
};

__device__ __forceinline__ XcdBarrier xcd_barrier_post(unsigned* bar, volatile LAS unsigned* st) {
    XcdBarrier b; b.bar = bar; b.x = xb_xcc_id(); b.st = st;
    if (threadIdx.x == 0) (void)xb_add(&bar[XB_XCNT(b.x)], 1u);
    return b;
}
__device__ __forceinline__ void xcd_barrier_complete(unsigned* bar, unsigned x, unsigned& nloc, unsigned& nx) {
    const unsigned G = gridDim.x * gridDim.y * gridDim.z;
    unsigned sum, cnt, mine, sp = 0u;
    for (;;) {
        sum = 0u; cnt = 0u; mine = 0u;
#pragma unroll
        for (unsigned j = 0; j < 16; ++j) { const unsigned c = xb_ld(&bar[XB_XCNT(j)]); sum += c; cnt += (c > 0u) ? 1u : 0u; mine = (j == x) ? c : mine; }
        if (sum == G) break;
        __builtin_amdgcn_s_sleep(1);
        if ((++sp & 255u) == 0u) { if (xb_ld(&bar[XB_TMO])) break; if (sp > XB_SPIN_CAP) { atomicAdd(&bar[XB_TMO], 1u); break; } }
    }
    nloc = mine > 0u ? mine : 1u; nx = cnt > 0u ? cnt : 1u;
}

__device__ __forceinline__ void xcd_barrier(const XcdBarrier& b, const int tid) {
    asm volatile("s_waitcnt vmcnt(0)" ::: "memory");
    __syncthreads();
    if (tid == 0) {
        unsigned* bar = b.bar; unsigned bx = b.x;
        asm volatile("" : "+s"(bar), "+s"(bx));
        __builtin_amdgcn_s_waitcnt(0);
        unsigned nloc = b.st[0], nx = b.st[1];
        if (nloc == 0u) { xcd_barrier_complete(bar, bx, nloc, nx); b.st[0] = nloc; b.st[1] = nx; }
        const unsigned old = xb_add(&bar[XB_XSUB(bx)], 1u);
        const unsigned gen = old / nloc;
        if (old + 1u == (gen + 1u) * nloc) {
            __builtin_amdgcn_fence(__ATOMIC_RELEASE, "agent");
            asm volatile("s_waitcnt vmcnt(0)" ::: "memory");
            const unsigned og = xb_add(&bar[XB_TOP], 1u);
            const unsigned tg = og / nx;
            if (og + 1u == (tg + 1u) * nx) xb_add(&bar[XB_TOPGEN], 1u);
            else XB_SPIN(xb_ld(&bar[XB_TOPGEN]) == tg, bar);
            __builtin_amdgcn_fence(__ATOMIC_ACQUIRE, "agent");
            xb_add(&bar[XB_XGEN(bx)], 1u);
            asm volatile("s_waitcnt vmcnt(0)" ::: "memory");
        } else {
            XB_SPIN(xb_ld(&bar[XB_XGEN(bx)]) == gen, bar);
            __builtin_amdgcn_fence(__ATOMIC_ACQUIRE, "agent");
            asm volatile("s_waitcnt vmcnt(0)" ::: "memory");
        }
    }
    __syncthreads();
}


typedef __attribute__((address_space(3))) unsigned char lds_u8;

DEV bf16_t* wsb(const Args& a, size_t off) { return (bf16_t*)(a.ws + off); }
DEV float* wsf(const Args& a, size_t off) { return (float*)(a.ws + off); }

DEV void ph_rowprep(const Args& a, bool from_x, const int tid0) {
    const int lane = tid0 & 63, wv = tid0 >> 6;
    const int gw = blockIdx.x * 8 + wv, nw = gridDim.x * 8;
    bf16_t* hb = wsb(a, HB_OFF); float* rstd = wsf(a, RSTD_OFF);
    for (int t = gw; t < T; t += nw) {
        const float* src = from_x ? (t < TP ? a.x_prompt + (size_t)t * D : a.x_sample + (size_t)(t - TP) * D) : a.h + (size_t)t * D;
        f32x4 v[4]; float ss = 0.f;
#pragma unroll
        for (int i = 0; i < 4; ++i) { v[i] = *(const f32x4*)(src + (i * 64 + lane) * 4); ss += v[i][0] * v[i][0] + v[i][1] * v[i][1] + v[i][2] * v[i][2] + v[i][3] * v[i][3]; }
        ss = wave_sum(ss);
#pragma unroll
        for (int i = 0; i < 4; ++i) {
            if (from_x) *(f32x4*)(a.h + (size_t)t * D + (i * 64 + lane) * 4) = v[i];
            u32x2 p; p.x = pack2(v[i][0], v[i][1]); p.y = pack2(v[i][2], v[i][3]);
            *(u32x2*)(hb + (size_t)t * D + (i * 64 + lane) * 4) = p;
        }
        if (lane == 0) rstd[t] = rsqrtf(ss * (1.0f / 1024.0f) + 1e-6f);
    }
}

DEV void ph_final(const Args& a, const int tid0) {
    const int lane = tid0 & 63, wv = tid0 >> 6;
    const int gw = blockIdx.x * 8 + wv, nw = gridDim.x * 8;
    for (int t = gw; t < T; t += nw) {
        float* row = a.h + (size_t)t * D;
        f32x4 v[4]; float ss = 0.f;
#pragma unroll
        for (int i = 0; i < 4; ++i) { v[i] = *(const f32x4*)(row + (i * 64 + lane) * 4); ss += v[i][0] * v[i][0] + v[i][1] * v[i][1] + v[i][2] * v[i][2] + v[i][3] * v[i][3]; }
        ss = wave_sum(ss);
        const float r = rsqrtf(ss * (1.0f / 1024.0f) + 1e-6f);
#pragma unroll
        for (int i = 0; i < 4; ++i) { const f32x4 g = *(const f32x4*)(a.final_norm_g + (i * 64 + lane) * 4); *(f32x4*)(row + (i * 64 + lane) * 4) = v[i] * r * g; }
    }
}

DEV void transpose_cvt(const float* __restrict__ src, bf16_t* __restrict__ dst, int K, int N, int Npad, const float* __restrict__ g, float* tile, const int tid0) {
    const int tx = tid0 & 63, ty = tid0 >> 6;
    const int tk = K / 64, tn = Npad / 64;
    for (int tl = blockIdx.x; tl < tk * tn; tl += gridDim.x) {
        const int k0 = (tl % tk) * 64, n0 = (tl / tk) * 64;
        __syncthreads();
        for (int i = ty; i < 64; i += 8) { const int k = k0 + i, n = n0 + tx; float v = (n < N) ? src[(size_t)k * N + n] : 0.f; if (g) v *= g[k]; tile[i * 65 + tx] = v; }
        __syncthreads();
        for (int i = ty; i < 64; i += 8) dst[(size_t)(n0 + i) * K + k0 + tx] = (bf16_t)f2bf(tile[tx * 65 + i]);
    }
}
DEV void fold_wqk(const Args& a, float* lds, const int tid0) {
    float* swq = lds;
    float* ssk = lds + 64 * 132;
    const int tid = tid0, key = tid & 127, kq = tid >> 7;
    for (int un = blockIdx.x; un < NL * 16 * 16; un += gridDim.x) {
        const int l = un >> 8, hp = (un >> 4) & 15, k0 = (un & 15) * 64;
        __syncthreads();
        for (int i = tid; i < 64 * 128; i += NTHR) { const int r = i >> 7, c = i & 127; swq[r * 132 + c] = a.peer_w_q[((size_t)l * 1024 + k0 + r) * 2048 + hp * 128 + c]; }
        for (int i = tid; i < 128 * 128; i += NTHR) { const int r = i >> 7, c = i & 127; ssk[r * 132 + c] = a.peer_sub_keys[(((size_t)l * 16 + hp) * 128 + r) * 128 + c]; }
        __syncthreads();
        float acc[16];
#pragma unroll
        for (int i = 0; i < 16; ++i) acc[i] = 0.f;
        for (int c = 0; c < 128; c += 4) {
            const f32x4 s = *(const f32x4*)(ssk + key * 132 + c);
#pragma unroll
            for (int i = 0; i < 16; ++i) { const f32x4 w = *(const f32x4*)(swq + (kq * 16 + i) * 132 + c); acc[i] += s[0] * w[0] + s[1] * w[1] + s[2] * w[2] + s[3] * w[3]; }
        }
        bf16_t* dst = wsb(a, WB_OFF + (size_t)l * WB_LAYER + WB_QK) + (size_t)(hp * 128 + key) * 1024 + k0 + kq * 16;
        const float* g = a.norm_ffn_g + l * 1024 + k0 + kq * 16;
#pragma unroll
        for (int i = 0; i < 16; i += 2) *(unsigned*)(dst + i) = pack2(acc[i] * g[i], acc[i + 1] * g[i + 1]);
    }
}
DEV void ph_prologue(const Args& a, float* lds, const int tid0) {
    { float* rc = wsf(a, ROPEC_OFF); float* rs = wsf(a, ROPES_OFF);
      for (int i = blockIdx.x * NTHR + tid0; i < 4096 * 8; i += gridDim.x * NTHR) {
          const int pos = i >> 3, f = i & 7;
          const float invf = (float)pow(500000.0, -(double)f / 8.0);
          const float ang = (float)pos * invf;
          rc[i] = (float)cos((double)ang); rs[i] = (float)sin((double)ang);
      } }
    for (int l = 0; l < NL; ++l) {
        bf16_t* wb = wsb(a, WB_OFF + (size_t)l * WB_LAYER);
        transpose_cvt(a.w_in + (size_t)l * 1024 * INC, wb + WB_IN / 2, 1024, INC, INP, a.norm_mix_g + l * 1024, lds, tid0);
        transpose_cvt(a.w_out + (size_t)l * 1024 * 1024, wb + WB_OUT / 2, 1024, 1024, 1024, nullptr, lds, tid0);
        transpose_cvt(a.ple_w_gate + (size_t)l * 1024 * 1024, wb + WB_GATE / 2, 1024, 1024, 1024, a.ple_norm_g + l * 1024, lds, tid0);
        transpose_cvt(a.ple_w_proj + (size_t)l * 256 * 1024, wb + WB_PROJ / 2, 256, 1024, 1024, nullptr, lds, tid0);
    }
    fold_wqk(a, lds, tid0);
}
DEV void ph_convert(const Args& a, int layer, const int tid0) {
    const size_t gtid = (size_t)blockIdx.x * NTHR + tid0, gn = (size_t)gridDim.x * NTHR;
    const float* us = a.peer_u + (size_t)layer * 16384 * 1024; const float* vs = a.peer_v + (size_t)layer * 16384 * 1024;
    bf16_t* ud = wsb(a, PTU_OFF); bf16_t* vd = wsb(a, PTV_OFF);
    const float* g = a.norm_ffn_g + layer * 1024;
    for (size_t i = gtid; i < (size_t)16384 * 1024 / 4; i += gn) {
        const f32x4 x = *(const f32x4*)(us + i * 4), y = *(const f32x4*)(vs + i * 4), gg = *(const f32x4*)(g + ((i * 4) & 1023));
        u32x2 p; p.x = pack2(x[0] * gg[0], x[1] * gg[1]); p.y = pack2(x[2] * gg[2], x[3] * gg[3]); *(u32x2*)(ud + i * 4) = p;
        u32x2 q; q.x = pack2(y[0], y[1]); q.y = pack2(y[2], y[3]); *(u32x2*)(vd + i * 4) = q;
    }
    bf16_t* pb = wsb(a, PB_OFF);
    const float* pp = a.p_prompt + (size_t)layer * TP * 256; const float* ps = a.p_sample + (size_t)layer * (T - TP) * 256;
    for (size_t i = gtid; i < (size_t)T * 256 / 4; i += gn) {
        const size_t e = i * 4; const f32x4 x = (e < (size_t)TP * 256) ? *(const f32x4*)(pp + e) : *(const f32x4*)(ps + (e - (size_t)TP * 256));
        u32x2 p; p.x = pack2(x[0], x[1]); p.y = pack2(x[2], x[3]); *(u32x2*)(pb + e) = p;
    }
}

DEV void ph_attn(const Args& a, int layer, float* lds, const int tid0) {
    const int lane = tid0 & 63, wv = __builtin_amdgcn_readfirstlane(tid0 >> 6);
    float* sp = lds + wv * 448;
    const bf16_t* qkv = wsb(a, QKV_OFF); bf16_t* mix = wsb(a, MIX_OFF);
    const int NU = T * 8;
    const int per = (NU + (int)gridDim.x - 1) / (int)gridDim.x;
    const int u0 = blockIdx.x * per, u1 = (u0 + per < NU) ? u0 + per : NU;
    for (int un = u0 + wv; un < u1; un += 8) {
        const int sh = un >> 12, pos = un & 4095, seq = sh >> 3, hd = sh & 7;
        const size_t tb = (size_t)seq * 4096;
        const u32x4* qp = (const u32x4*)(qkv + (tb + pos) * 1536 + hd * 64);
        u32x4 q[8];
#pragma unroll
        for (int i = 0; i < 8; ++i) q[i] = qp[i];
        float sc[7]; float mx = -3.0e38f;
#pragma unroll
        for (int rd = 0; rd < 7; ++rd) {
            const int e = rd * 64 + lane;
            const int di = e / 129, j = e - di * 129 - 64;
            const int dl = (di == 0) ? 1 : (di == 1 ? 4 : 16);
            const int pk = pos + j * dl;
            const bool valid = (e < 387) && (pk >= 0) && (pk < 4096);
            const int pkc = valid ? pk : pos;
            const u32x4* kp = (const u32x4*)(qkv + (tb + pkc) * 1536 + 512 + hd * 64);
            float s = 0.f;
#pragma unroll
            for (int i = 0; i < 8; ++i) { const u32x4 kk = kp[i]; s = dot2bf(q[i].x, kk.x, s); s = dot2bf(q[i].y, kk.y, s); s = dot2bf(q[i].z, kk.z, s); s = dot2bf(q[i].w, kk.w, s); }
            s = valid ? s * 0.125f : -1.0e30f;
            sc[rd] = s; mx = fmaxf(mx, s);
        }
        mx = wave_max(mx);
        float l = 0.f;
#pragma unroll
        for (int rd = 0; rd < 7; ++rd) { const float p = __expf(sc[rd] - mx); sp[rd * 64 + lane] = p; l += p; }
        l = wave_sum(l);
        float o = 0.f;
        for (int di = 0; di < 3; ++di) {
            const int dl = (di == 0) ? 1 : (di == 1 ? 4 : 16);
            for (int jj = 0; jj < 129; ++jj) {
                const int pk = pos + (jj - 64) * dl;
                if (pk < 0 || pk >= 4096) continue;
                const float p = sp[di * 129 + jj];
                o += p * bf2f(qkv[(tb + pk) * 1536 + 1024 + hd * 64 + lane]);
            }
        }
        o = o / l;
        const float ms = wave_sum(o * o) * (1.0f / 64.0f);
        o = o * rsqrtf(ms + 1e-6f) * a.att_norm_g[layer * 512 + hd * 64 + lane];
        mix[(tb + pos) * 1024 + hd * 64 + lane] = (bf16_t)f2bf(o);
    }
}

DEV void ph_lora(const Args& a, int layer, float* lds, const int tid0) {
    float* act = lds;
    const int tid = tid0;
    const bf16_t* U = wsb(a, U_OFF);
    const float* sw = a.rwkv_shift + (size_t)layer * 3 * UC;
    for (int tile = blockIdx.x; tile < T / 64; tile += gridDim.x) {
        const int t0 = tile * 64;
        __syncthreads();
        for (int i = tid; i < 64 * 256; i += NTHR) {
            const int tk = i >> 8, c = i & 255, t = t0 + tk, pos = t & 4095, uc = 1536 + c;
            float v = sw[UC + uc] * bf2f(U[(size_t)t * UW + uc]);
            if (pos > 0) v += sw[uc] * bf2f(U[(size_t)(t - 1) * UW + uc]);
            if (pos < 4095) v += sw[2 * UC + uc] * bf2f(U[(size_t)(t + 1) * UW + uc]);
            act[tk * 256 + c] = (c < 128) ? tanhf(v) : v;
        }
        __syncthreads();
        const int ch = tid;
#pragma unroll 1
        for (int arr = 0; arr < 4; ++arr) {
            const int dir = arr & 1; const bool isw = arr < 2;
            const float* W = (isw ? a.rwkv_w2 : a.rwkv_a2) + ((size_t)(layer * 2 + dir) * 64) * 512 + ch;
            float wreg[64];
#pragma unroll
            for (int j = 0; j < 64; ++j) wreg[j] = W[j * 512];
            const float bias = (isw ? a.rwkv_w0 : a.rwkv_a0)[(layer * 2 + dir) * 512 + ch];
            bf16_t* out = wsb(a, arr == 0 ? WF_OFF : (arr == 1 ? WB2_OFF : (arr == 2 ? AF_OFF : AB_OFF)));
#pragma unroll 1
            for (int tk = 0; tk < 64; ++tk) {
                const float* ap = act + tk * 256 + arr * 64;
                float s = bias;
#pragma unroll
                for (int j = 0; j < 64; j += 4) { const f32x4 x = *(const f32x4*)(ap + j); s += x[0] * wreg[j] + x[1] * wreg[j + 1] + x[2] * wreg[j + 2] + x[3] * wreg[j + 3]; }
                const float sg = sigmoidf_(s);
                const float r = isw ? __expf(-0.60653066f * sg) : sg;
                out[(size_t)(t0 + tk) * 512 + ch] = (bf16_t)f2bf(r);
            }
        }
    }
}

DEV void ph_scan(const Args& a, int layer, float* lds, const int tid0) {
    const int tid = tid0, lane = tid & 63, wv = __builtin_amdgcn_readfirstlane(tid >> 6);
    const int dir = wv >> 2, w4 = wv & 3;
    float* buf = lds;
    const bf16_t* U = wsb(a, U_OFF);
    const bf16_t* Wd = wsb(a, dir ? WB2_OFF : WF_OFF); const bf16_t* Ad = wsb(a, dir ? AB_OFF : AF_OFF);
    bf16_t* Y = wsb(a, dir ? YB_OFF : YF_OFF);
    const float* sw = a.rwkv_shift + (size_t)layer * 3 * UC;
    const int js = lane & 7, q = lane >> 3, r0 = 16 * w4 + 2 * q;
    for (int un = blockIdx.x; un < NSEQ * 8; un += gridDim.x) {
        const int seq = un >> 3, hd = un & 7; const size_t tb = (size_t)seq * 4096; const int cb = hd * 64, pch = cb + lane;
        const float kkc = a.rwkv_k_k[layer * 512 + pch], kac = a.rwkv_k_a[layer * 512 + pch];
        float swr[3], swk[3], swv[3];
#pragma unroll
        for (int s = 0; s < 3; ++s) { swr[s] = sw[s * UC + pch]; swk[s] = sw[s * UC + 512 + pch]; swv[s] = sw[s * UC + 1024 + pch]; }
        float S0[8], S1[8];
#pragma unroll
        for (int i = 0; i < 8; ++i) { S0[i] = 0.f; S1[i] = 0.f; }
        for (int blk = 0; blk < 256; ++blk) {
            __syncthreads();
#pragma unroll
            for (int si = 0; si < 4; ++si) {
                const int s = w4 * 4 + si, step = blk * 16 + s, pos = dir ? 4095 - step : step; const size_t t = tb + pos;
                const bf16_t* up = U + t * UW + pch;
                float rr = swr[1] * bf2f(up[0]), kk = swk[1] * bf2f(up[512]), vv = swv[1] * bf2f(up[1024]);
                if (pos > 0) { const bf16_t* um = up - UW; rr += swr[0] * bf2f(um[0]); kk += swk[0] * bf2f(um[512]); vv += swv[0] * bf2f(um[1024]); }
                if (pos < 4095) { const bf16_t* un2 = up + UW; rr += swr[2] * bf2f(un2[0]); kk += swk[2] * bf2f(un2[512]); vv += swv[2] * bf2f(un2[1024]); }
                const float kx = kk * kkc;
                const float nrm = sqrtf(wave_sum(kx * kx));
                const float kn = kx / fmaxf(nrm, 1e-12f);
                const float av = bf2f(Ad[t * 512 + pch]), wvv = bf2f(Wd[t * 512 + pch]);
                float* o = buf + ((dir * 16 + s) * 6) * 64 + lane;
                o[0] = wvv; o[64] = -kn; o[128] = kn * av; o[192] = kk * (1.0f + (av - 1.0f) * kac); o[256] = rr; o[320] = vv;
            }
            __syncthreads();
            for (int s = 0; s < 16; ++s) {
                const float* vb = buf + ((dir * 16 + s) * 6) * 64;
                const f32x4 w0 = *(const f32x4*)(vb + 8 * js), w1 = *(const f32x4*)(vb + 8 * js + 4);
                const f32x4 a0 = *(const f32x4*)(vb + 64 + 8 * js), a1 = *(const f32x4*)(vb + 64 + 8 * js + 4);
                const f32x4 b0 = *(const f32x4*)(vb + 128 + 8 * js), b1 = *(const f32x4*)(vb + 128 + 8 * js + 4);
                const f32x4 k0 = *(const f32x4*)(vb + 192 + 8 * js), k1 = *(const f32x4*)(vb + 192 + 8 * js + 4);
                const f32x4 q0 = *(const f32x4*)(vb + 256 + 8 * js), q1 = *(const f32x4*)(vb + 256 + 8 * js + 4);
                const f32x2 v2 = *(const f32x2*)(vb + 320 + r0);
                float sa0 = 0.f, sa1 = 0.f;
#pragma unroll
                for (int i = 0; i < 4; ++i) { sa0 += S0[i] * a0[i] + S0[i + 4] * a1[i]; sa1 += S1[i] * a0[i] + S1[i + 4] * a1[i]; }
                sa0 = sum8(sa0); sa1 = sum8(sa1);
                float y0 = 0.f, y1 = 0.f;
#pragma unroll
                for (int i = 0; i < 4; ++i) {
                    S0[i] = S0[i] * w0[i] + sa0 * b0[i] + v2[0] * k0[i]; S0[i + 4] = S0[i + 4] * w1[i] + sa0 * b1[i] + v2[0] * k1[i];
                    S1[i] = S1[i] * w0[i] + sa1 * b0[i] + v2[1] * k0[i]; S1[i + 4] = S1[i + 4] * w1[i] + sa1 * b1[i] + v2[1] * k1[i];
                    y0 += S0[i] * q0[i] + S0[i + 4] * q1[i]; y1 += S1[i] * q0[i] + S1[i + 4] * q1[i];
                }
                y0 = sum8(y0); y1 = sum8(y1);
                if (js == 0) { const int step = blk * 16 + s, pos = dir ? 4095 - step : step; *(unsigned*)(Y + (tb + pos) * 512 + cb + r0) = pack2(y0, y1); }
            }
        }
    }
}

DEV void ph_post(const Args& a, int layer, float* lds, const int tid0) {
    const int lane = tid0 & 63, wv = __builtin_amdgcn_readfirstlane(tid0 >> 6);
    const int gw = blockIdx.x * 8 + wv, nw = gridDim.x * 8;
    float* sg = lds + wv * 128;
    const bf16_t* U = wsb(a, U_OFF); const bf16_t* AF = wsb(a, AF_OFF); const bf16_t* AB = wsb(a, AB_OFF);
    const bf16_t* YF = wsb(a, YF_OFF); const bf16_t* YB = wsb(a, YB_OFF); bf16_t* mix = wsb(a, MIX_OFF);
    const float* sw = a.rwkv_shift + (size_t)layer * 3 * UC;
    const int c8 = 8 * lane;
    for (int t = gw; t < T; t += nw) {
        const int pos = t & 4095; const bool hp = pos > 0, hn = pos < 4095;
        const bf16_t* up = U + (size_t)t * UW;
        {
            const int uc = 1792 + 2 * lane;
            const unsigned c = *(const unsigned*)(up + uc);
            float v0 = sw[UC + uc] * bflo(c), v1 = sw[UC + uc + 1] * bfhi(c);
            if (hp) { const unsigned p = *(const unsigned*)(up - UW + uc); v0 += sw[uc] * bflo(p); v1 += sw[uc + 1] * bfhi(p); }
            if (hn) { const unsigned n = *(const unsigned*)(up + UW + uc); v0 += sw[2 * UC + uc] * bflo(n); v1 += sw[2 * UC + uc + 1] * bfhi(n); }
            sg[2 * lane] = sigmoidf_(v0); sg[2 * lane + 1] = sigmoidf_(v1);
        }
        float g[8];
#pragma unroll
        for (int i = 0; i < 8; ++i) g[i] = 0.f;
        const float* g2 = a.rwkv_g2 + (size_t)layer * 128 * 512 + c8;
        for (int j = 0; j < 128; ++j) {
            const float s = sg[j]; const f32x4 x0 = *(const f32x4*)(g2 + j * 512), x1 = *(const f32x4*)(g2 + j * 512 + 4);
#pragma unroll
            for (int i = 0; i < 4; ++i) { g[i] += s * x0[i]; g[i + 4] += s * x1[i]; }
        }
        float r[8], k[8], v[8];
#pragma unroll
        for (int arr = 0; arr < 3; ++arr) {
            float* dst = arr == 0 ? r : (arr == 1 ? k : v);
            const int uc = arr * 512 + c8;
            const u32x4 c = *(const u32x4*)(up + uc);
            u32x4 p = {0u, 0u, 0u, 0u}, n = {0u, 0u, 0u, 0u};
            if (hp) p = *(const u32x4*)(up - UW + uc);
            if (hn) n = *(const u32x4*)(up + UW + uc);
#pragma unroll
            for (int i = 0; i < 4; ++i) {
                dst[2 * i] = sw[uc + 2 * i] * bflo(p[i]) + sw[UC + uc + 2 * i] * bflo(c[i]) + sw[2 * UC + uc + 2 * i] * bflo(n[i]);
                dst[2 * i + 1] = sw[uc + 2 * i + 1] * bfhi(p[i]) + sw[UC + uc + 2 * i + 1] * bfhi(c[i]) + sw[2 * UC + uc + 2 * i + 1] * bfhi(n[i]);
            }
        }
        const u32x4 afp = *(const u32x4*)(AF + (size_t)t * 512 + c8), abp = *(const u32x4*)(AB + (size_t)t * 512 + c8);
        const u32x4 yfp = *(const u32x4*)(YF + (size_t)t * 512 + c8), ybp = *(const u32x4*)(YB + (size_t)t * 512 + c8);
        float y[8]; float ysum = 0.f, bs = 0.f;
#pragma unroll
        for (int i = 0; i < 4; ++i) {
            y[2 * i] = bflo(yfp[i]) + bflo(ybp[i]); y[2 * i + 1] = bfhi(yfp[i]) + bfhi(ybp[i]);
            ysum += y[2 * i] + y[2 * i + 1];
            const float ka0 = a.rwkv_k_a[layer * 512 + c8 + 2 * i], ka1 = a.rwkv_k_a[layer * 512 + c8 + 2 * i + 1];
            const float kd0 = k[2 * i] * (1.0f + (bflo(afp[i]) - 1.0f) * ka0) + k[2 * i] * (1.0f + (bflo(abp[i]) - 1.0f) * ka0);
            const float kd1 = k[2 * i + 1] * (1.0f + (bfhi(afp[i]) - 1.0f) * ka1) + k[2 * i + 1] * (1.0f + (bfhi(abp[i]) - 1.0f) * ka1);
            bs += r[2 * i] * kd0 * a.rwkv_r_k[layer * 512 + c8 + 2 * i] + r[2 * i + 1] * kd1 * a.rwkv_r_k[layer * 512 + c8 + 2 * i + 1];
        }
        const float mu = sum8(ysum) * (1.0f / 64.0f);
        float vs = 0.f;
#pragma unroll
        for (int i = 0; i < 8; ++i) { y[i] -= mu; vs += y[i] * y[i]; }
        const float rstdv = rsqrtf(sum8(vs) * (1.0f / 64.0f) + 64e-5f);
        bs = sum8(bs);
        float o[8];
#pragma unroll
        for (int i = 0; i < 8; ++i) o[i] = (y[i] * rstdv * a.rwkv_ln_w[layer * 512 + c8 + i] + a.rwkv_ln_b[layer * 512 + c8 + i] + bs * v[i]) * g[i];
        u32x4 ov; ov.x = pack2(o[0], o[1]); ov.y = pack2(o[2], o[3]); ov.z = pack2(o[4], o[5]); ov.w = pack2(o[6], o[7]);
        *(u32x4*)(mix + (size_t)t * 1024 + 512 + c8) = ov;
    }
}

DEV void ph_topk(const Args& a, float* lds, const int tid0) {
    const int lane = tid0 & 63, wv = __builtin_amdgcn_readfirstlane(tid0 >> 6);
    const int gw = blockIdx.x * 8 + wv, nw = gridDim.x * 8;
    float* tv = lds + wv * 32; int* ti = (int*)(lds + 8 * 32) + wv * 32;
    const float* SC = wsf(a, SC_OFF); int* TOPI = (int*)(a.ws + TOPI_OFF); float* TOPG = wsf(a, TOPG_OFF); const float* rstd = wsf(a, RSTD_OFF);
    const float NINF = -3.0e38f;
    for (int un = gw; un < T * 8; un += nw) {
        const int t = un >> 3, hd = un & 7;
#pragma unroll
        for (int p = 0; p < 2; ++p) {
            const float* sp = SC + (size_t)t * 2048 + (hd * 2 + p) * 128;
            float v0 = sp[lane], v1 = sp[64 + lane];
            for (int r = 0; r < 16; ++r) {
                const float m = wave_max(fmaxf(v0, v1));
                const unsigned long long b0 = __ballot(v0 == m);
                int idx;
                if (b0) idx = __builtin_ctzll(b0); else { const unsigned long long b1 = __ballot(v1 == m); idx = 64 + __builtin_ctzll(b1); }
                if (lane == 0) { tv[p * 16 + r] = m; ti[p * 16 + r] = idx; }
                if (idx < 64) { if (lane == idx) v0 = NINF; } else { if (lane == idx - 64) v1 = NINF; }
            }
        }
        float cv[4];
#pragma unroll
        for (int s = 0; s < 4; ++s) { const int c = lane + 64 * s; cv[s] = tv[c >> 4] + tv[16 + (c & 15)]; }
        float mybest = NINF; int myc = 0;
        for (int r = 0; r < 16; ++r) {
            const float m = wave_max(fmaxf(fmaxf(cv[0], cv[1]), fmaxf(cv[2], cv[3])));
            int c = -1;
#pragma unroll
            for (int s = 0; s < 4; ++s) { const unsigned long long b = __ballot(cv[s] == m); if (c < 0 && b) c = 64 * s + __builtin_ctzll(b); }
            if (lane == r) { mybest = m; myc = c; }
#pragma unroll
            for (int s = 0; s < 4; ++s) if (c == 64 * s + lane) cv[s] = NINF;
        }
        const float z = (lane < 16) ? rstd[t] * mybest : NINF;
        const float mz = wave_max(z);
        const float e = (lane < 16) ? __expf(z - mz) : 0.f;
        const float se = wave_sum(e);
        if (lane < 16) {
            TOPI[(size_t)t * 128 + hd * 16 + lane] = ti[myc >> 4] * 128 + ti[16 + (myc & 15)];
            TOPG[(size_t)t * 128 + hd * 16 + lane] = e / se;
        }
    }
}

DEV void ph_peer(const Args& a, const int tid0) {
    const int lane = tid0 & 63, wv = tid0 >> 6;
    const int gw = blockIdx.x * 8 + wv, nw = gridDim.x * 8;
    bf16_t* hb = wsb(a, HB_OFF); float* rstd = wsf(a, RSTD_OFF);
    const int* TOPI = (const int*)(a.ws + TOPI_OFF); const float* TOPG = wsf(a, TOPG_OFF);
    const bf16_t* PU = wsb(a, PTU_OFF); const bf16_t* PV = wsb(a, PTV_OFF);
    const int c8 = 8 * lane;
    for (int t = gw; t < T; t += nw) {
        const u32x4 x0 = *(const u32x4*)(hb + (size_t)t * 1024 + c8), x1 = *(const u32x4*)(hb + (size_t)t * 1024 + 512 + c8);
        const float rs = rstd[t];
        const int e0 = TOPI[(size_t)t * 128 + lane], e1 = TOPI[(size_t)t * 128 + 64 + lane];
        const float g0 = TOPG[(size_t)t * 128 + lane], g1 = TOPG[(size_t)t * 128 + 64 + lane];
        float out[16];
#pragma unroll
        for (int i = 0; i < 16; ++i) out[i] = 0.f;
#pragma unroll 4
        for (int k = 0; k < 128; ++k) {
            const int e = SHF(k < 64 ? e0 : e1, k & 63); const float gt = SHF(k < 64 ? g0 : g1, k & 63);
            const u32x4 ua = *(const u32x4*)(PU + (size_t)e * 1024 + c8), ub = *(const u32x4*)(PU + (size_t)e * 1024 + 512 + c8);
            const u32x4 va = *(const u32x4*)(PV + (size_t)e * 1024 + c8), vb = *(const u32x4*)(PV + (size_t)e * 1024 + 512 + c8);
            float d = 0.f;
#pragma unroll
            for (int i = 0; i < 4; ++i) { d = dot2bf(x0[i], ua[i], d); d = dot2bf(x1[i], ub[i], d); }
            d = wave_sum(d);
            const float hp = rs * d;
            const float w = gt * 0.5f * hp * (1.0f + erff(hp * 0.70710678f));
#pragma unroll
            for (int i = 0; i < 4; ++i) { out[2 * i] += w * bflo(va[i]); out[2 * i + 1] += w * bfhi(va[i]); out[8 + 2 * i] += w * bflo(vb[i]); out[8 + 2 * i + 1] += w * bfhi(vb[i]); }
        }
        float* hr = a.h + (size_t)t * 1024;
        f32x4 h0 = *(const f32x4*)(hr + c8), h1 = *(const f32x4*)(hr + c8 + 4), h2 = *(const f32x4*)(hr + 512 + c8), h3 = *(const f32x4*)(hr + 512 + c8 + 4);
        float ss = 0.f;
#pragma unroll
        for (int i = 0; i < 4; ++i) { h0[i] += out[i]; h1[i] += out[4 + i]; h2[i] += out[8 + i]; h3[i] += out[12 + i]; ss += h0[i] * h0[i] + h1[i] * h1[i] + h2[i] * h2[i] + h3[i] * h3[i]; }
        *(f32x4*)(hr + c8) = h0; *(f32x4*)(hr + c8 + 4) = h1; *(f32x4*)(hr + 512 + c8) = h2; *(f32x4*)(hr + 512 + c8 + 4) = h3;
        ss = wave_sum(ss);
        u32x4 p0, p1; p0.x = pack2(h0[0], h0[1]); p0.y = pack2(h0[2], h0[3]); p0.z = pack2(h1[0], h1[1]); p0.w = pack2(h1[2], h1[3]);
        p1.x = pack2(h2[0], h2[1]); p1.y = pack2(h2[2], h2[3]); p1.z = pack2(h3[0], h3[1]); p1.w = pack2(h3[2], h3[3]);
        *(u32x4*)(hb + (size_t)t * 1024 + c8) = p0; *(u32x4*)(hb + (size_t)t * 1024 + 512 + c8) = p1;
        if (lane == 0) rstd[t] = rsqrtf(ss * (1.0f / 1024.0f) + 1e-6f);
    }
}

DEV float sum16(float v) {
    v = sum8(v);
    v += __int_as_float(__builtin_amdgcn_mov_dpp(__float_as_int(v), 0x140, 0xF, 0xF, true));
    return v;
}
DEV float max16(float v) {
    v = fmaxf(v, __int_as_float(__builtin_amdgcn_mov_dpp(__float_as_int(v), 0xB1, 0xF, 0xF, true)));
    v = fmaxf(v, __int_as_float(__builtin_amdgcn_mov_dpp(__float_as_int(v), 0x4E, 0xF, 0xF, true)));
    v = fmaxf(v, __int_as_float(__builtin_amdgcn_mov_dpp(__float_as_int(v), 0x141, 0xF, 0xF, true)));
    v = fmaxf(v, __int_as_float(__builtin_amdgcn_mov_dpp(__float_as_int(v), 0x140, 0xF, 0xF, true)));
    return v;
}
DEV float rl(float v, int l) { return __int_as_float(__builtin_amdgcn_readlane(__float_as_int(v), l)); }
DEV float wave_sum_dpp(float v) { v = sum16(v); return (rl(v, 0) + rl(v, 16)) + (rl(v, 32) + rl(v, 48)); }
DEV unsigned fkey(float f) { const unsigned b = __float_as_uint(f); return b ^ ((unsigned)((int)b >> 31) | 0x80000000u); }
DEV int mbcnt64(unsigned long long m) { return (int)__builtin_amdgcn_mbcnt_hi((unsigned)(m >> 32), __builtin_amdgcn_mbcnt_lo((unsigned)m, 0u)); }

DEV void ph_topk2(const Args& a, float* lds, const int tid0) {
    const int lane = tid0 & 63, wv = __builtin_amdgcn_readfirstlane(tid0 >> 6);
    const int gw = blockIdx.x * 8 + wv, nw = gridDim.x * 8;
    float* tv = lds + wv * 32; int* ti = (int*)(lds + 8 * 32) + wv * 32;
    const float* SC = wsf(a, SC_OFF); int* TOPI = (int*)(a.ws + TOPI_OFF); float* TOPG = wsf(a, TOPG_OFF); const float* rstd = wsf(a, RSTD_OFF);
    for (int un = gw; un < T * 8; un += nw) {
        const int t = un >> 3, hd = un & 7;
        const float* sp = SC + (size_t)t * 2048 + hd * 256;
        float v[4]; unsigned k[4];
#pragma unroll
        for (int i = 0; i < 4; ++i) { v[i] = sp[i * 64 + lane]; k[i] = fkey(v[i]); }
        unsigned t0 = 0u, t1 = 0u;
        for (int b = 31; b >= 0; --b) {
            const unsigned c0 = t0 | (1u << b), c1 = t1 | (1u << b);
            const int n0 = __builtin_popcountll(__ballot(k[0] >= c0)) + __builtin_popcountll(__ballot(k[1] >= c0));
            const int n1 = __builtin_popcountll(__ballot(k[2] >= c1)) + __builtin_popcountll(__ballot(k[3] >= c1));
            t0 = (n0 >= 16) ? c0 : t0; t1 = (n1 >= 16) ? c1 : t1;
        }
#pragma unroll
        for (int p = 0; p < 2; ++p) {
            const unsigned tp = p ? t1 : t0;
            const unsigned long long ga = __ballot(k[2 * p] > tp), gb = __ballot(k[2 * p + 1] > tp);
            const unsigned long long ea = __ballot(k[2 * p] == tp), eb = __ballot(k[2 * p + 1] == tp);
            const int nga = __builtin_popcountll(ga), ng = nga + __builtin_popcountll(gb), need = 16 - ng, nea = __builtin_popcountll(ea);
            int pa = -1, pb = -1;
            if (k[2 * p] > tp) pa = mbcnt64(ga); else if (k[2 * p] == tp) { const int r = mbcnt64(ea); if (r < need) pa = ng + r; }
            if (k[2 * p + 1] > tp) pb = nga + mbcnt64(gb); else if (k[2 * p + 1] == tp) { const int r = nea + mbcnt64(eb); if (r < need) pb = ng + r; }
            if (pa >= 0) { tv[p * 16 + pa] = v[2 * p]; ti[p * 16 + pa] = lane; }
            if (pb >= 0) { tv[p * 16 + pb] = v[2 * p + 1]; ti[p * 16 + pb] = 64 + lane; }
        }
        float cv[4]; unsigned kc[4];
#pragma unroll
        for (int s = 0; s < 4; ++s) { const int c = lane + 64 * s; cv[s] = tv[c >> 4] + tv[16 + (c & 15)]; kc[s] = fkey(cv[s]); }
        const float m0 = max16(lane < 16 ? tv[lane & 15] : -3.0e38f), m1 = max16(lane < 16 ? tv[16 + (lane & 15)] : -3.0e38f);
        const float mx = rl(m0, 0) + rl(m1, 0);
        unsigned t2 = 0u;
        for (int b = 31; b >= 0; --b) {
            const unsigned c2 = t2 | (1u << b);
            const int n = (__builtin_popcountll(__ballot(kc[0] >= c2)) + __builtin_popcountll(__ballot(kc[1] >= c2))) + (__builtin_popcountll(__ballot(kc[2] >= c2)) + __builtin_popcountll(__ballot(kc[3] >= c2)));
            t2 = (n >= 16) ? c2 : t2;
        }
        int pos[4]; int ng = 0;
#pragma unroll
        for (int s = 0; s < 4; ++s) { const unsigned long long g = __ballot(kc[s] > t2); pos[s] = (kc[s] > t2) ? ng + mbcnt64(g) : -1; ng += __builtin_popcountll(g); }
        int ne = 0; const int need = 16 - ng;
#pragma unroll
        for (int s = 0; s < 4; ++s) { const unsigned long long e = __ballot(kc[s] == t2); if (kc[s] == t2) { const int r = ne + mbcnt64(e); if (r < need) pos[s] = ng + r; } ne += __builtin_popcountll(e); }
        const float rs = rstd[t];
        float ex[4]; float es = 0.f;
#pragma unroll
        for (int s = 0; s < 4; ++s) { ex[s] = (pos[s] >= 0) ? __expf(rs * (cv[s] - mx)) : 0.f; es += ex[s]; }
        const float inv = 1.0f / wave_sum_dpp(es);
#pragma unroll
        for (int s = 0; s < 4; ++s) if (pos[s] >= 0) {
            const int c = lane + 64 * s;
            TOPI[(size_t)t * 128 + hd * 16 + pos[s]] = ti[c >> 4] * 128 + ti[16 + (c & 15)];
            TOPG[(size_t)t * 128 + hd * 16 + pos[s]] = ex[s] * inv;
        }
    }
}

DEV unsigned pack4_fp8(float a, float b, float c, float d) {
    int w = __builtin_amdgcn_cvt_pk_fp8_f32(a, b, 0, false);
    w = __builtin_amdgcn_cvt_pk_fp8_f32(c, d, w, true);
    return (unsigned)w;
}
DEV void ph_convert8(const Args& a, int layer, const int tid0) {
    const size_t gtid = (size_t)blockIdx.x * NTHR + tid0, gn = (size_t)gridDim.x * NTHR;
    const float* us = a.peer_u + (size_t)layer * 16384 * 1024; const float* vs = a.peer_v + (size_t)layer * 16384 * 1024;
    unsigned* ud = (unsigned*)(a.ws + PTU_OFF); unsigned* vd = (unsigned*)(a.ws + PTV_OFF);
    const float* g = a.norm_ffn_g + layer * 1024;
    for (size_t i = gtid; i < (size_t)16384 * 1024 / 16; i += gn) {
        u32x4 pu, pv;
#pragma unroll
        for (int j = 0; j < 4; ++j) {
            const f32x4 x = *(const f32x4*)(us + i * 16 + j * 4), y = *(const f32x4*)(vs + i * 16 + j * 4), gg = *(const f32x4*)(g + ((i * 16 + j * 4) & 1023));
            pu[j] = pack4_fp8(x[0] * gg[0] * 256.f, x[1] * gg[1] * 256.f, x[2] * gg[2] * 256.f, x[3] * gg[3] * 256.f);
            pv[j] = pack4_fp8(y[0] * 32.f, y[1] * 32.f, y[2] * 32.f, y[3] * 32.f);
        }
        *(u32x4*)(ud + i * 4) = pu; *(u32x4*)(vd + i * 4) = pv;
    }
    bf16_t* pb = wsb(a, PB_OFF);
    const float* pp = a.p_prompt + (size_t)layer * TP * 256; const float* ps = a.p_sample + (size_t)layer * (T - TP) * 256;
    for (size_t i = gtid; i < (size_t)T * 256 / 4; i += gn) {
        const size_t e = i * 4; const f32x4 x = (e < (size_t)TP * 256) ? *(const f32x4*)(pp + e) : *(const f32x4*)(ps + (e - (size_t)TP * 256));
        u32x2 p; p.x = pack2(x[0], x[1]); p.y = pack2(x[2], x[3]); *(u32x2*)(pb + e) = p;
    }
}

DEV void ph_peer8(const Args& a, const int tid0) {
    const int lane = tid0 & 63, wv = tid0 >> 6;
    const int gw = blockIdx.x * 8 + wv, nw = gridDim.x * 8;
    bf16_t* hb = wsb(a, HB_OFF); float* rstd = wsf(a, RSTD_OFF);
    const int* TOPI = (const int*)(a.ws + TOPI_OFF); const float* TOPG = wsf(a, TOPG_OFF);
    const unsigned char* PU = a.ws + PTU_OFF; const unsigned char* PV = a.ws + PTV_OFF;
    const int c16 = 16 * lane;
    const bool b5 = lane & 32, b4 = lane & 16, b3 = lane & 8;
    for (int t = gw; t < T; t += nw) {
        float x[16];
        { const u32x4 x0 = *(const u32x4*)(hb + (size_t)t * 1024 + c16), x1 = *(const u32x4*)(hb + (size_t)t * 1024 + c16 + 8);
#pragma unroll
          for (int i = 0; i < 4; ++i) { x[2 * i] = bflo(x0[i]); x[2 * i + 1] = bfhi(x0[i]); x[8 + 2 * i] = bflo(x1[i]); x[8 + 2 * i + 1] = bfhi(x1[i]); } }
        const float rs = rstd[t] * (1.0f / 256.0f);
        const int e0 = TOPI[(size_t)t * 128 + lane], e1 = TOPI[(size_t)t * 128 + 64 + lane];
        const float g0 = TOPG[(size_t)t * 128 + lane], g1 = TOPG[(size_t)t * 128 + 64 + lane];
        float out[16];
#pragma unroll
        for (int i = 0; i < 16; ++i) out[i] = 0.f;
#pragma unroll 1
        for (int kb = 0; kb < 128; kb += 8) {
            const int es = (kb < 64) ? e0 : e1; const float gs = (kb < 64) ? g0 : g1;
            u32x4 ur[8], vr[8];
#pragma unroll
            for (int i = 0; i < 8; ++i) { const int e = __builtin_amdgcn_readlane(es, (kb + i) & 63); ur[i] = *(const u32x4*)(PU + (size_t)e * 1024 + c16); vr[i] = *(const u32x4*)(PV + (size_t)e * 1024 + c16); }
            float d[8];
#pragma unroll
            for (int i = 0; i < 8; ++i) {
                float s = 0.f;
#pragma unroll
                for (int j = 0; j < 4; ++j) {
                    const f32x2 lo = __builtin_amdgcn_cvt_pk_f32_fp8((int)ur[i][j], false), hi = __builtin_amdgcn_cvt_pk_f32_fp8((int)ur[i][j], true);
                    s += lo[0] * x[4 * j] + lo[1] * x[4 * j + 1] + hi[0] * x[4 * j + 2] + hi[1] * x[4 * j + 3];
                }
                d[i] = s;
            }
            float r4[4], r2[2];
#pragma unroll
            for (int i = 0; i < 4; ++i) { const float send = b5 ? d[i] : d[4 + i], keep = b5 ? d[4 + i] : d[i]; r4[i] = keep + SHX(send, 32); }
#pragma unroll
            for (int i = 0; i < 2; ++i) { const float send = b4 ? r4[i] : r4[2 + i], keep = b4 ? r4[2 + i] : r4[i]; r2[i] = keep + SHX(send, 16); }
            const float send1 = b3 ? r2[0] : r2[1], keep1 = b3 ? r2[1] : r2[0];
            const float dd = sum8(keep1 + SHX(send1, 8));
            const float hp = rs * dd;
            const float gt = SHF(gs, (kb + (lane >> 3)) & 63);
            const float w = gt * 0.5f * hp * (1.0f + erff(hp * 0.70710678f)) * (1.0f / 32.0f);
#pragma unroll
            for (int i = 0; i < 8; ++i) {
                const float wi = rl(w, 8 * i);
#pragma unroll
                for (int j = 0; j < 4; ++j) {
                    const f32x2 lo = __builtin_amdgcn_cvt_pk_f32_fp8((int)vr[i][j], false), hi = __builtin_amdgcn_cvt_pk_f32_fp8((int)vr[i][j], true);
                    out[4 * j] += wi * lo[0]; out[4 * j + 1] += wi * lo[1]; out[4 * j + 2] += wi * hi[0]; out[4 * j + 3] += wi * hi[1];
                }
            }
        }
        float* hr = a.h + (size_t)t * 1024 + c16;
        f32x4 hv[4]; float ss = 0.f;
#pragma unroll
        for (int j = 0; j < 4; ++j) { hv[j] = *(const f32x4*)(hr + 4 * j);
#pragma unroll
            for (int c = 0; c < 4; ++c) { hv[j][c] += out[4 * j + c]; ss += hv[j][c] * hv[j][c]; }
            *(f32x4*)(hr + 4 * j) = hv[j]; }
        ss = wave_sum(ss);
        u32x4 p0, p1;
        p0.x = pack2(hv[0][0], hv[0][1]); p0.y = pack2(hv[0][2], hv[0][3]); p0.z = pack2(hv[1][0], hv[1][1]); p0.w = pack2(hv[1][2], hv[1][3]);
        p1.x = pack2(hv[2][0], hv[2][1]); p1.y = pack2(hv[2][2], hv[2][3]); p1.z = pack2(hv[3][0], hv[3][1]); p1.w = pack2(hv[3][2], hv[3][3]);
        *(u32x4*)(hb + (size_t)t * 1024 + c16) = p0; *(u32x4*)(hb + (size_t)t * 1024 + c16 + 8) = p1;
        if (lane == 0) rstd[t] = rsqrtf(ss * (1.0f / 1024.0f) + 1e-6f);
    }
}

typedef short bf16x8 __attribute__((ext_vector_type(8)));
typedef float f32x16 __attribute__((ext_vector_type(16)));
#define MFMA32(a, b, c) __builtin_amdgcn_mfma_f32_32x32x16_bf16((a), (b), (c), 0, 0, 0)
DEV bf16x8 pack_frag(float x0, float x1, float x2, float x3, float x4, float x5, float x6, float x7) {
    u32x4 p;
    asm volatile("v_cvt_pk_bf16_f32 %0, %4, %5\n\tv_cvt_pk_bf16_f32 %1, %6, %7\n\tv_cvt_pk_bf16_f32 %2, %8, %9\n\tv_cvt_pk_bf16_f32 %3, %10, %11\n\ts_nop 1"
                 : "=&v"(p[0]), "=&v"(p[1]), "=&v"(p[2]), "=&v"(p[3]) : "v"(x0), "v"(x1), "v"(x2), "v"(x3), "v"(x4), "v"(x5), "v"(x6), "v"(x7));
    return __builtin_bit_cast(bf16x8, p);
}
DEV void ph_attn2(const Args& a, unsigned char* ldsb, const int tid0) {
    const int lane = tid0 & 63, wv = __builtin_amdgcn_readfirstlane(tid0 >> 6), r = lane & 31, h = lane >> 5;
    unsigned char* vt = ldsb + wv * 5120;
    const bf16_t* qkv = wsb(a, QKV_OFF);
    bf16_t* OP = wsb(a, OP_OFF); float* ML = wsf(a, ML_OFF);
    const int x16 = r & 15, permr = (r & 16) + 8 * ((x16 >> 2) & 1) + 4 * ((x16 >> 3) & 1) + (x16 & 3);
    const float sc = 0.125f * 1.44269504f, NEG = -1.0e30f;
    const int nitem = NSEQ * 8 * 3 * 128, per = nitem / (int)gridDim.x;
    for (int it = 0; it < per / 8; ++it) {
        const int w = blockIdx.x * per + it * 8 + wv;
        const int sh = w / 384, rem = w - sh * 384, di = rem >> 7, idx = rem & 127;
        const int sft = 2 * di, nbc = 128 >> sft, rr = idx >> (7 - sft), cb = idx & (nbc - 1), cq0 = cb * 32, nlen = 4096 >> sft;
        const int seq = sh >> 3, hd = sh & 7; const size_t tb = (size_t)seq * 4096;
        const size_t tokq = tb + ((size_t)(cq0 + r) << sft) + rr;
        const bf16_t* qp = qkv + tokq * 1536 + hd * 64 + 8 * h;
        bf16x8 qf[4];
#pragma unroll
        for (int s = 0; s < 4; ++s) qf[s] = *(const bf16x8*)(qp + 16 * s);
        float m = NEG, l = 0.f;
        f32x16 O0, O1;
#pragma unroll
        for (int i = 0; i < 16; ++i) { O0[i] = 0.f; O1[i] = 0.f; }
#pragma unroll
        for (int kt = 0; kt < 5; ++kt) {
            const int kb = cq0 - 64 + 32 * kt;
            if (kb < 0 || kb >= nlen) continue;
            const size_t tokk = tb + ((size_t)(kb + r) << sft) + rr;
            const bf16_t* kp = qkv + tokk * 1536 + 512 + hd * 64 + 8 * h;
            bf16x8 kf[4], vf[4];
#pragma unroll
            for (int s = 0; s < 4; ++s) { kf[s] = *(const bf16x8*)(kp + 16 * s); vf[s] = *(const bf16x8*)(kp + 512 + 16 * s); }
            f32x16 S;
#pragma unroll
            for (int i = 0; i < 16; ++i) S[i] = 0.f;
#pragma unroll
            for (int s = 0; s < 4; ++s) S = MFMA32(kf[s], qf[s], S);
            float lm = NEG;
#pragma unroll
            for (int i = 0; i < 16; ++i) {
                const int row = (i & 3) + 8 * (i >> 2) + 4 * h;
                float v = S[i] * sc;
                if (kt == 0) v = (row >= r) ? v : NEG;
                if (kt == 4) v = (row <= r) ? v : NEG;
                S[i] = v; lm = fmaxf(lm, v);
            }
            lm = fmaxf(lm, SHX(lm, 32));
            const float mn = fmaxf(m, lm), alpha = __builtin_amdgcn_exp2f(m - mn);
            m = mn; l *= alpha;
            float ps = 0.f;
#pragma unroll
            for (int i = 0; i < 16; ++i) { O0[i] *= alpha; O1[i] *= alpha; S[i] = __builtin_amdgcn_exp2f(S[i] - mn); ps += S[i]; }
            l += ps;
            const bf16x8 pb0 = pack_frag(S[0], S[1], S[2], S[3], S[4], S[5], S[6], S[7]);
            const bf16x8 pb1 = pack_frag(S[8], S[9], S[10], S[11], S[12], S[13], S[14], S[15]);
            asm volatile("" ::: "memory");
#pragma unroll
            for (int i = 0; i < 4; ++i)
#pragma unroll
                for (int e = 0; e < 8; ++e) *(short*)(vt + (16 * i + 8 * h + e) * 80 + 2 * permr) = vf[i][e];
            asm volatile("" ::: "memory");
#pragma unroll
            for (int s = 0; s < 2; ++s) {
                const bf16x8 a0 = *(const bf16x8*)(vt + r * 80 + 32 * s + 16 * h), a1 = *(const bf16x8*)(vt + (r + 32) * 80 + 32 * s + 16 * h);
                O0 = MFMA32(a0, s ? pb1 : pb0, O0); O1 = MFMA32(a1, s ? pb1 : pb0, O1);
            }
            asm volatile("" ::: "memory");
        }
        l += SHX(l, 32);
        const float inv = 1.0f / l;
        bf16_t* op = OP + ((size_t)di * T + tokq) * 512 + hd * 64 + 4 * h;
#pragma unroll
        for (int g = 0; g < 4; ++g) {
            u32x2 p0, p1;
            p0.x = pack2(O0[4 * g] * inv, O0[4 * g + 1] * inv); p0.y = pack2(O0[4 * g + 2] * inv, O0[4 * g + 3] * inv);
            p1.x = pack2(O1[4 * g] * inv, O1[4 * g + 1] * inv); p1.y = pack2(O1[4 * g + 2] * inv, O1[4 * g + 3] * inv);
            *(u32x2*)(op + 8 * g) = p0; *(u32x2*)(op + 32 + 8 * g) = p1;
        }
        if (h == 0) { f32x2 ml; ml[0] = m; ml[1] = l; *(f32x2*)(ML + (((size_t)di * T + tokq) * 8 + hd) * 2) = ml; }
    }
}
DEV void ph_attn_merge(const Args& a, int layer, const int tid0) {
    const int lane = tid0 & 63, wv = tid0 >> 6;
    const int gw = blockIdx.x * 8 + wv, nw = gridDim.x * 8;
    const bf16_t* OP = wsb(a, OP_OFF); const float* ML = wsf(a, ML_OFF); bf16_t* mix = wsb(a, MIX_OFF);
    const int c8 = 8 * lane, hd = lane >> 3;
    const f32x4 gA = *(const f32x4*)(a.att_norm_g + layer * 512 + c8), gB = *(const f32x4*)(a.att_norm_g + layer * 512 + c8 + 4);
    for (int t = gw; t < T; t += nw) {
        u32x4 o[3]; f32x2 ml[3];
#pragma unroll
        for (int d = 0; d < 3; ++d) { o[d] = *(const u32x4*)(OP + ((size_t)d * T + t) * 512 + c8); ml[d] = *(const f32x2*)(ML + (((size_t)d * T + t) * 8 + hd) * 2); }
        const float mm = fmaxf(ml[0][0], fmaxf(ml[1][0], ml[2][0]));
        float wgt[3]; float den = 0.f;
#pragma unroll
        for (int d = 0; d < 3; ++d) { wgt[d] = __builtin_amdgcn_exp2f(ml[d][0] - mm) * ml[d][1]; den += wgt[d]; }
        const float iden = 1.0f / den;
        float v[8]; float ss = 0.f;
#pragma unroll
        for (int i = 0; i < 4; ++i) {
            v[2 * i] = (wgt[0] * bflo(o[0][i]) + wgt[1] * bflo(o[1][i]) + wgt[2] * bflo(o[2][i])) * iden;
            v[2 * i + 1] = (wgt[0] * bfhi(o[0][i]) + wgt[1] * bfhi(o[1][i]) + wgt[2] * bfhi(o[2][i])) * iden;
            ss += v[2 * i] * v[2 * i] + v[2 * i + 1] * v[2 * i + 1];
        }
        const float rn = rsqrtf(sum8(ss) * (1.0f / 64.0f) + 1e-6f);
        u32x4 ov;
        ov.x = pack2(v[0] * rn * gA[0], v[1] * rn * gA[1]); ov.y = pack2(v[2] * rn * gA[2], v[3] * rn * gA[3]);
        ov.z = pack2(v[4] * rn * gB[0], v[5] * rn * gB[1]); ov.w = pack2(v[6] * rn * gB[2], v[7] * rn * gB[3]);
        *(u32x4*)(mix + (size_t)t * 1024 + c8) = ov;
    }
}

extern __shared__ __attribute__((aligned(16))) unsigned char smem[];

enum { PH_PROLOGUE = 0, PH_ROWPREP_X, PH_ROWPREP, PH_GEMM1, PH_ATTN, PH_MERGE, PH_LORA, PH_SCAN, PH_POST, PH_GEMM2, PH_CONVERT, PH_GEMM3, PH_TOPK, PH_PEER, PH_GEMM4A, PH_GEMM4B, PH_FINAL };

template <int PH> DEV void run_phase(const Args& a, int layer, const int tid0) {
    float* ldsf = (float*)smem;
    PG8_LAS unsigned char* ldsg = (PG8_LAS unsigned char*)smem;
    const bf16_t* wb = wsb(a, WB_OFF + (size_t)layer * WB_LAYER);
    if constexpr (PH == PH_PROLOGUE) ph_prologue(a, ldsf, tid0);
    else if constexpr (PH == PH_ROWPREP_X) ph_rowprep(a, true, tid0);
    else if constexpr (PH == PH_ROWPREP) ph_rowprep(a, false, tid0);
    else if constexpr (PH == PH_GEMM1) {
        pg8::Gemm g{wsb(a, HB_OFF), wb + WB_IN / 2, T, INP, 1024};
        pg8::StaticOrder S; S.init(T, INP, gridDim.x, blockIdx.x);
        pg8::EpiProj E{wsb(a, QKV_OFF), wsb(a, U_OFF), wsf(a, RSTD_OFF), wsf(a, ROPEC_OFF), wsf(a, ROPES_OFF)};
        pg8::gemm_phase<pg8::EpiProj, pg8::StaticOrder, false>(ldsg, g, S, E, nullptr, tid0);
    }
    else if constexpr (PH == PH_ATTN) ph_attn2(a, smem, tid0);
    else if constexpr (PH == PH_MERGE) ph_attn_merge(a, layer, tid0);
    else if constexpr (PH == PH_LORA) ph_lora(a, layer, ldsf, tid0);
    else if constexpr (PH == PH_SCAN) ph_scan(a, layer, ldsf, tid0);
    else if constexpr (PH == PH_POST) ph_post(a, layer, ldsf, tid0);
    else if constexpr (PH == PH_GEMM2) {
        pg8::Gemm g{wsb(a, MIX_OFF), wb + WB_OUT / 2, T, 1024, 1024};
        pg8::StaticOrder S; S.init(T, 1024, gridDim.x, blockIdx.x);
        pg8::EpiF32x<1> E{a.h, 1024, nullptr};
        pg8::gemm_phase<pg8::EpiF32x<1>, pg8::StaticOrder, false>(ldsg, g, S, E, nullptr, tid0);
    }
    else if constexpr (PH == PH_CONVERT) ph_convert8(a, layer, tid0);
    else if constexpr (PH == PH_GEMM3) {
        pg8::Gemm g{wsb(a, HB_OFF), wb + WB_QK / 2, T, 2048, 1024};
        pg8::StaticOrder S; S.init(T, 2048, gridDim.x, blockIdx.x);
        pg8::EpiF32x<0> E{wsf(a, SC_OFF), 2048, nullptr};
        pg8::gemm_phase<pg8::EpiF32x<0>, pg8::StaticOrder, false>(ldsg, g, S, E, nullptr, tid0);
    }
    else if constexpr (PH == PH_TOPK) ph_topk2(a, ldsf, tid0);
    else if constexpr (PH == PH_PEER) ph_peer8(a, tid0);
    else if constexpr (PH == PH_GEMM4A) {
        pg8::Gemm g{wsb(a, HB_OFF), wb + WB_GATE / 2, T, 1024, 1024};
        pg8::StaticOrder S; S.init(T, 1024, gridDim.x, blockIdx.x);
        pg8::EpiGate E{wsb(a, GATE_OFF), wsf(a, RSTD_OFF), a.ple_b_gate + layer * 1024};
        pg8::gemm_phase<pg8::EpiGate, pg8::StaticOrder, false>(ldsg, g, S, E, nullptr, tid0);
    }
    else if constexpr (PH == PH_GEMM4B) {
        pg8::Gemm g{wsb(a, PB_OFF), wb + WB_PROJ / 2, T, 1024, 256};
        pg8::StaticOrder S; S.init(T, 1024, gridDim.x, blockIdx.x);
        pg8::EpiF32x<2> E{a.h, 1024, wsb(a, GATE_OFF)};
        pg8::gemm_phase<pg8::EpiF32x<2>, pg8::StaticOrder, false>(ldsg, g, S, E, nullptr, tid0);
    }
    else if constexpr (PH == PH_FINAL) ph_final(a, tid0);
}

#if !ONE_LAUNCH
template <int PH> __global__ void __launch_bounds__(NTHR, 2) k_phase(Args a, int layer) { run_phase<PH>(a, layer, (int)threadIdx.x); }
#endif

#if ONE_LAUNCH
typedef const __attribute__((address_space(4))) unsigned long long* kargs_t;
static_assert(sizeof(Args) == 31 * 8, "Args is 31 pointers, no padding");
DEV Args load_args(kargs_t kp) { Args r; unsigned long long* d = (unsigned long long*)&r;
#pragma unroll
    for (int i = 0; i < 31; ++i) d[i] = kp[i];
    return r; }
#define RUN(PH, layer) do { kargs_t kp_ = (kargs_t)__builtin_amdgcn_kernarg_segment_ptr(); asm volatile("" : "+s"(kp_)); const Args la_ = load_args(kp_); int t_; asm volatile("v_mbcnt_lo_u32_b32 %0, -1, 0\n\tv_mbcnt_hi_u32_b32 %0, -1, %0\n\tv_lshl_add_u32 %0, %1, 6, %0" : "=&v"(t_) : "s"(wv0_)); run_phase<PH>(la_, layer, t_); } while (0)
#define BAR() do { kargs_t kp_ = (kargs_t)__builtin_amdgcn_kernarg_segment_ptr(); asm volatile("" : "+s"(kp_)); XcdBarrier b_; b_.bar = (unsigned*)((unsigned char*)kp_[30] + BAR_OFF); b_.x = xb_xcc_id(); b_.st = (volatile LAS unsigned*)(smem + LDS_BYTES - 16); int t_; asm volatile("v_mbcnt_lo_u32_b32 %0, -1, 0\n\tv_mbcnt_hi_u32_b32 %0, -1, %0\n\tv_lshl_add_u32 %0, %1, 6, %0" : "=&v"(t_) : "s"(wv0_)); xcd_barrier(b_, t_); } while (0)
__global__ void __launch_bounds__(NTHR, 2) k_mega(Args a) {
    if (threadIdx.x == 0) *(uint4*)(smem + LDS_BYTES - 16) = make_uint4(0u, 0u, 0u, 0u);
    __syncthreads();
    (void)xcd_barrier_post((unsigned*)(a.ws + BAR_OFF), (volatile LAS unsigned*)(smem + LDS_BYTES - 16));
    const int wv0_ = __builtin_amdgcn_readfirstlane((int)threadIdx.x >> 6);
    RUN(PH_PROLOGUE, 0);
    RUN(PH_ROWPREP_X, 0); BAR();
    for (int layer = 0; layer < NL; ++layer) {
        if (layer > 0) { RUN(PH_ROWPREP, layer); BAR(); }
        RUN(PH_GEMM1, layer); BAR();
        RUN(PH_ATTN, layer); BAR();
        RUN(PH_MERGE, layer); BAR();
        RUN(PH_LORA, layer); BAR();
        RUN(PH_SCAN, layer); BAR();
        RUN(PH_POST, layer); BAR();
        RUN(PH_GEMM2, layer); BAR();
        RUN(PH_ROWPREP, layer); RUN(PH_CONVERT, layer); BAR();
        RUN(PH_GEMM3, layer); BAR();
        RUN(PH_TOPK, layer); BAR();
        RUN(PH_PEER, layer); BAR();
        RUN(PH_GEMM4A, layer); BAR();
        RUN(PH_GEMM4B, layer); BAR();
    }
    RUN(PH_FINAL, 0);
}
#endif

#if !ONE_LAUNCH
template <int PH> static void launch_phase(const Args& a, int layer, hipStream_t st) {
    static bool attr = false;
    if (!attr) { (void)hipFuncSetAttribute((const void*)k_phase<PH>, hipFuncAttributeMaxDynamicSharedMemorySize, LDS_BYTES); attr = true; }
    hipLaunchKernelGGL(k_phase<PH>, dim3(NWG), dim3(NTHR), LDS_BYTES, st, a, layer);
}
#endif

extern "C" void kernel_launch(void* const* d_in, const int* in_sizes, int n_in, void* d_out, int out_size, void* d_ws, size_t ws_size, hipStream_t stream) {
    if (n_in != 29 || out_size != T * D || ws_size < WS_END) {
        fprintf(stderr, "kernel_launch: unexpected shapes (n_in %d, out %d, ws %zu, need %zu); nothing launched\n", n_in, out_size, ws_size, (size_t)WS_END);
        return;
    }
    Args a{};
    const float** ap = (const float**)&a;
    for (int i = 0; i < 29; ++i) ap[i] = (const float*)d_in[i];
    a.h = (float*)d_out; a.ws = (unsigned char*)d_ws;
#if ONE_LAUNCH
    static bool attr = false;
    if (!attr) { (void)hipFuncSetAttribute((const void*)k_mega, hipFuncAttributeMaxDynamicSharedMemorySize, LDS_BYTES); attr = true; }
    (void)hipMemsetAsync((char*)d_ws + BAR_OFF, 0, XCD_BAR_WORDS * sizeof(unsigned), stream);
    hipLaunchKernelGGL(k_mega, dim3(NWG), dim3(NTHR), LDS_BYTES, stream, a);
#else
    launch_phase<PH_PROLOGUE>(a, 0, stream);
    launch_phase<PH_ROWPREP_X>(a, 0, stream);
    for (int layer = 0; layer < NL; ++layer) {
        if (layer > 0) launch_phase<PH_ROWPREP>(a, layer, stream);
        launch_phase<PH_GEMM1>(a, layer, stream);
        launch_phase<PH_ATTN>(a, layer, stream);
        launch_phase<PH_MERGE>(a, layer, stream);
        launch_phase<PH_LORA>(a, layer, stream);
        launch_phase<PH_SCAN>(a, layer, stream);
        launch_phase<PH_POST>(a, layer, stream);
        launch_phase<PH_GEMM2>(a, layer, stream);
        launch_phase<PH_ROWPREP>(a, layer, stream);
        launch_phase<PH_CONVERT>(a, layer, stream);
        launch_phase<PH_GEMM3>(a, layer, stream);
        launch_phase<PH_TOPK>(a, layer, stream);
        launch_phase<PH_PEER>(a, layer, stream);
        launch_phase<PH_GEMM4A>(a, layer, stream);
        launch_phase<PH_GEMM4B>(a, layer, stream);
    }
    launch_phase<PH_FINAL>(a, 0, stream);
#endif
}
```

```cpp
#include <hip/hip_runtime.h>
#include <stdint.h>
#include <stdio.h>

#ifndef ONE_LAUNCH
#define ONE_LAUNCH 1
#endif

typedef unsigned short bf16_t;
typedef float f32x4 __attribute__((ext_vector_type(4)));
typedef float f32x2 __attribute__((ext_vector_type(2)));
typedef unsigned u32x4 __attribute__((ext_vector_type(4)));
typedef unsigned u32x2 __attribute__((ext_vector_type(2)));
typedef __bf16 bf16x2_t __attribute__((ext_vector_type(2)));

#define DEV __device__ __forceinline__

namespace cfg {
constexpr int NSEQ = 20, SEQ = 4096, T = NSEQ * SEQ, TP = 4 * SEQ, D = 1024, NL = 4;
constexpr int INC = 3456, INP = 3584;
constexpr int QKVW = 1536, UW = 2048, UC = 1920;
constexpr int NWG = 256, NTHR = 512;
constexpr int LDS_BYTES = 147456;
constexpr size_t MiB = 1ull << 20;
constexpr size_t WB_OFF = 0;
constexpr size_t WB_LAYER = 16 * MiB;
constexpr size_t WB_IN = 0, WB_OUT = 7 * MiB, WB_QK = 9 * MiB, WB_GATE = 13 * MiB, WB_PROJ = 15 * MiB, WB_LORA = 15 * MiB + 512 * 1024;
constexpr size_t HB_OFF = 64 * MiB;
constexpr size_t MIX_OFF = 224 * MiB;
constexpr size_t SMALL_OFF = 384 * MiB;
constexpr size_t RSTD_OFF = SMALL_OFF;
constexpr size_t ROPEC_OFF = SMALL_OFF + 512 * 1024, ROPES_OFF = SMALL_OFF + 640 * 1024;
constexpr size_t BAR_OFF = SMALL_OFF + 1 * MiB;
constexpr size_t BIG_OFF = 386 * MiB;
constexpr size_t QKV_OFF = BIG_OFF;
constexpr size_t RS_OFF = BIG_OFF, KS_OFF = BIG_OFF + 80 * MiB, G_OFF = BIG_OFF + 160 * MiB;
constexpr size_t U_OFF = BIG_OFF + 240 * MiB;
constexpr size_t WF_OFF = BIG_OFF + 560 * MiB, WB2_OFF = BIG_OFF + 640 * MiB, AF_OFF = BIG_OFF + 720 * MiB, AB_OFF = BIG_OFF + 800 * MiB;
constexpr size_t OP_OFF = BIG_OFF + 560 * MiB;
constexpr size_t ML_OFF = BIG_OFF + 800 * MiB;
constexpr size_t SC_OFF = BIG_OFF;
constexpr size_t TOPI_OFF = BIG_OFF + 640 * MiB, TOPG_OFF = BIG_OFF + 680 * MiB;
constexpr size_t PTU_OFF = BIG_OFF + 720 * MiB, PTV_OFF = BIG_OFF + 752 * MiB;
constexpr size_t PB_OFF = BIG_OFF + 784 * MiB;
constexpr size_t GATE_OFF = BIG_OFF;
constexpr size_t WS_END = BIG_OFF + 880 * MiB;
}
using namespace cfg;

struct Args {
    const float* x_prompt; const float* x_sample; const float* p_prompt; const float* p_sample;
    const float* norm_mix_g; const float* w_in; const float* att_norm_g; const float* rwkv_shift;
    const float* rwkv_w0; const float* rwkv_w2; const float* rwkv_a0; const float* rwkv_a2; const float* rwkv_g2;
    const float* rwkv_k_k; const float* rwkv_k_a; const float* rwkv_r_k; const float* rwkv_ln_w; const float* rwkv_ln_b;
    const float* w_out; const float* norm_ffn_g; const float* peer_w_q; const float* peer_sub_keys; const float* peer_u; const float* peer_v;
    const float* ple_norm_g; const float* ple_w_gate; const float* ple_b_gate; const float* ple_w_proj; const float* final_norm_g;
    float* h;
    unsigned char* ws;
};

DEV int tid_() { int t = threadIdx.x; asm volatile("" : "+v"(t)); return t; }
DEV float bf2f(unsigned h) { return __uint_as_float(h << 16); }
DEV float bflo(unsigned d) { return __uint_as_float(d << 16); }
DEV float bfhi(unsigned d) { return __uint_as_float(d & 0xffff0000u); }
DEV unsigned f2bf(float f) { const unsigned u = __float_as_uint(f); return (u + 0x7fffu + ((u >> 16) & 1u)) >> 16; }
DEV unsigned pack2(float lo, float hi) { return f2bf(lo) | (f2bf(hi) << 16); }
DEV float dot2bf(unsigned a, unsigned b, float c) { return __builtin_amdgcn_fdot2_f32_bf16(__builtin_bit_cast(bf16x2_t, a), __builtin_bit_cast(bf16x2_t, b), c, false); }
DEV float shx_(float v, int lane, int o) { return __int_as_float(__builtin_amdgcn_ds_bpermute((lane ^ o) << 2, __float_as_int(v))); }
DEV float shf_(float v, int src) { return __int_as_float(__builtin_amdgcn_ds_bpermute(src << 2, __float_as_int(v))); }
DEV int shf_(int v, int src) { return __builtin_amdgcn_ds_bpermute(src << 2, v); }
#define SHX(v, o) shx_((v), lane, (o))
#define SHF(v, src) shf_((v), (src))
DEV float wave_sum_(float v, int lane) {
#pragma unroll
    for (int o = 32; o > 0; o >>= 1) v += shx_(v, lane, o);
    return v;
}
DEV float wave_max_(float v, int lane) {
#pragma unroll
    for (int o = 32; o > 0; o >>= 1) v = fmaxf(v, shx_(v, lane, o));
    return v;
}
#define wave_sum(x) wave_sum_((x), lane)
#define wave_max(x) wave_max_((x), lane)
DEV float sum8(float v) {
    v += __int_as_float(__builtin_amdgcn_mov_dpp(__float_as_int(v), 0xB1, 0xF, 0xF, true));
    v += __int_as_float(__builtin_amdgcn_mov_dpp(__float_as_int(v), 0x4E, 0xF, 0xF, true));
    v += __int_as_float(__builtin_amdgcn_mov_dpp(__float_as_int(v), 0x141, 0xF, 0xF, true));
    return v;
}
DEV float sigmoidf_(float x) { return 1.0f / (1.0f + __expf(-x)); }
namespace pg8 {
#define PG8_LAS __attribute__((address_space(3)))
typedef unsigned short bf16_t;
typedef short bf16x8 __attribute__((ext_vector_type(8)));
typedef float f32x4 __attribute__((ext_vector_type(4)));
typedef unsigned u32x4 __attribute__((ext_vector_type(4)));
constexpr int BM = 256, BK = 64, HALF = 128, HTB = HALF * BK * 2  , STAGE_BYTES = 8 * HTB, NXCD = 8, WGM = 8;

__host__ __device__ __forceinline__ int lds_byte(int r, int c) { const int st = (r >> 4) * 2 + (c >> 5), rr = r & 15, cc = c & 31, ob = rr * 64 + cc * 2; return st * 1024 + (ob ^ (((ob >> 9) & 1) << 5)); }
__host__ __device__ __forceinline__ void stage_rc(int b, int& R, int& C) { const int st = b / 1024, sb = b % 1024, swz = sb ^ (((sb >> 9) & 1) << 5); R = (st >> 1) * 16 + swz / 64; C = (st & 1) * 32 + (swz % 64) / 2; }
__host__ __device__ __forceinline__ int perm32(int rho) { const int n = rho >> 4, i = rho & 15; return 8 * (i >> 2) + 4 * n + (i & 3); }

struct Unit { int pm, pn; };
struct Gemm { const bf16_t* A; const bf16_t* Bt; int M, N, K; };

struct StaticOrder {
    int nM, nN, nwg, G, c;
    __host__ __device__ void init(int M, int N, int G_, int c_) { nM = M / BM; nN = N / BM; nwg = nM * nN; G = G_; c = c_; }
    __host__ __device__ bool next(int i, Unit& u) const {
        const long L = (long)i * G + c; if (L >= nwg) return false;
        int wgid = (int)L; { const int q = nwg / NXCD, r = nwg % NXCD, xcd = wgid % NXCD, off = wgid / NXCD; wgid = (xcd < r ? xcd * (q + 1) : r * (q + 1) + (xcd - r) * q) + off; }
        const int nig = WGM * nN, gid = wgid / nig, fm = gid * WGM, gsz = (nM - fm) < WGM ? (nM - fm) : WGM;
        u.pm = fm + ((wgid % nig) % gsz); u.pn = (wgid % nig) / gsz; return true;
    }
    __device__ __forceinline__ void a_ready(const Unit&) const {}
    __device__ __forceinline__ void done(const Unit&) const {}
};
__device__ __forceinline__ unsigned cvt_pk_bf16(float lo, float hi) { unsigned r; asm volatile("v_cvt_pk_bf16_f32 %0, %1, %2" : "=v"(r) : "v"(lo), "v"(hi)); return r; }

struct EpiProj {
    static constexpr bool PERM = true, AFTER_DRAIN = false;
    bf16_t* qkv; bf16_t* u; const float* rstd; const float* rc; const float* rs;
    __device__ __forceinline__ void operator()(const f32x4 (&acc)[2][2][4][2], const Unit& un, int wr, int wc, int fr, int fq) const {
        const int row0 = un.pm * BM + wr * 64 + fr, lane = fr + 16 * fq;
        const bool isq = un.pn < 6;
        bf16_t* base = isq ? qkv : u; const int ld = isq ? 1536 : 2048; const int colt = isq ? un.pn * BM : (un.pn - 6) * BM;
        const int col0 = colt + wc * 32 + 8 * fq;
        const bool rope = (un.pn < 4) && ((wc & 1) == 0);
#pragma unroll
        for (int ai = 0; ai < 2; ++ai)
#pragma unroll
            for (int m = 0; m < 4; ++m) {
                const int row = row0 + ai * HALF + m * 16; const float s = rstd[row]; const int pos = row & 4095;
                f32x4 c0 = {1.f, 1.f, 1.f, 1.f}, c1 = c0, s0 = {0.f, 0.f, 0.f, 0.f}, s1 = s0;
                if (rope) { c0 = *(const f32x4*)(rc + pos * 8); c1 = *(const f32x4*)(rc + pos * 8 + 4); s0 = *(const f32x4*)(rs + pos * 8); s1 = *(const f32x4*)(rs + pos * 8 + 4); }
                bf16_t* rowp = base + (size_t)row * ld + col0;
#pragma unroll
                for (int bj = 0; bj < 2; ++bj) {
                    f32x4 v0 = acc[ai][bj][m][0] * s, v1 = acc[ai][bj][m][1] * s;
                    if (rope) {
                        f32x4 o0, o1;
#pragma unroll
                        for (int c = 0; c < 4; ++c) { o0[c] = SHX(v0[c], 16); o1[c] = SHX(v1[c], 16); }
                        if (fq == 0) { v0 = v0 * c0 - o0 * s0; v1 = v1 * c1 - o1 * s1; }
                        else if (fq == 1) { v0 = v0 * c0 + o0 * s0; v1 = v1 * c1 + o1 * s1; }
                    }
                    u32x4 w; w.x = cvt_pk_bf16(v0[0], v0[1]); w.y = cvt_pk_bf16(v0[2], v0[3]); w.z = cvt_pk_bf16(v1[0], v1[1]); w.w = cvt_pk_bf16(v1[2], v1[3]);
                    *(u32x4*)(rowp + bj * HALF) = w;
                }
            }
    }
};
template <int MODE> struct EpiF32x {
    static constexpr bool PERM = false, AFTER_DRAIN = false;
    float* C; int ldc; const bf16_t* gate;
    __device__ __forceinline__ void operator()(const f32x4 (&acc)[2][2][4][2], const Unit& un, int wr, int wc, int fr, int fq) const {
        const int row0 = un.pm * BM + wr * 64 + fr, col0 = un.pn * BM + wc * 32 + 4 * fq;
#pragma unroll
        for (int ai = 0; ai < 2; ++ai)
#pragma unroll
            for (int m = 0; m < 4; ++m) {
                const size_t ro = (size_t)(row0 + ai * HALF + m * 16) * ldc + col0;
                if (MODE != 0) asm volatile("" ::: "memory");
#pragma unroll
                for (int bj = 0; bj < 2; ++bj)
#pragma unroll
                    for (int n = 0; n < 2; ++n) {
                        f32x4* p = (f32x4*)(C + ro + bj * HALF + n * 16);
                        if (MODE == 0) *p = acc[ai][bj][m][n];
                        else if (MODE == 1) *p = *p + acc[ai][bj][m][n];
                        else { const u32x2 g = *(const u32x2*)(gate + ro + bj * HALF + n * 16);
                               f32x4 gv; gv[0] = __uint_as_float(g.x << 16); gv[1] = __uint_as_float(g.x & 0xffff0000u); gv[2] = __uint_as_float(g.y << 16); gv[3] = __uint_as_float(g.y & 0xffff0000u);
                               *p = *p + gv * acc[ai][bj][m][n]; }
                    }
            }
    }
};
struct EpiGate {
    static constexpr bool PERM = true, AFTER_DRAIN = false;
    bf16_t* O; const float* rstd; const float* bias;
    __device__ __forceinline__ void operator()(const f32x4 (&acc)[2][2][4][2], const Unit& un, int wr, int wc, int fr, int fq) const {
        const int row0 = un.pm * BM + wr * 64 + fr, col0 = un.pn * BM + wc * 32 + 8 * fq;
        f32x4 bv[2][2];
#pragma unroll
        for (int bj = 0; bj < 2; ++bj)
#pragma unroll
            for (int n = 0; n < 2; ++n) bv[bj][n] = *(const f32x4*)(bias + col0 + bj * HALF + 4 * n);
#pragma unroll
        for (int ai = 0; ai < 2; ++ai)
#pragma unroll
            for (int m = 0; m < 4; ++m) {
                const int row = row0 + ai * HALF + m * 16; const float s = rstd[row];
                bf16_t* rowp = O + (size_t)row * 1024 + col0;
#pragma unroll
                for (int bj = 0; bj < 2; ++bj) {
                    f32x4 v0 = acc[ai][bj][m][0] * s + bv[bj][0], v1 = acc[ai][bj][m][1] * s + bv[bj][1];
#pragma unroll
                    for (int c = 0; c < 4; ++c) { v0[c] = 1.0f / (1.0f + __expf(-v0[c])); v1[c] = 1.0f / (1.0f + __expf(-v1[c])); }
                    u32x4 w; w.x = cvt_pk_bf16(v0[0], v0[1]); w.y = cvt_pk_bf16(v0[2], v0[3]); w.z = cvt_pk_bf16(v1[0], v1[1]); w.w = cvt_pk_bf16(v1[2], v1[3]);
                    *(u32x4*)(rowp + bj * HALF) = w;
                }
            }
    }
};
template <class Epi, class Sched, bool STAMP = false>
__device__ __forceinline__ void gemm_phase(PG8_LAS unsigned char* lds, const Gemm g, const Sched& S, const Epi& E, unsigned long long* stamps, const int tid_in) {
    const int tid = tid_in, wid = __builtin_amdgcn_readfirstlane(tid >> 6), lane = tid & 63, wr = wid >> 2, wc = wid & 3, fr = lane & 15, fq = lane >> 4;
    const int K = g.K, nt = K / BK;
    int ts_lo = 0, ts_hi = 0, nts = 0; const unsigned long long rt_entry = STAMP ? (unsigned long long)wall_clock64() : 0ull;
#define PG8_STAMP() do { if (STAMP && wid == 0 && nts < 64) { const unsigned long long _c = (unsigned long long)clock64(); \
        ts_lo = (lane == nts) ? (int)(unsigned)_c : ts_lo; ts_hi = (lane == nts) ? (int)(unsigned)(_c >> 32) : ts_hi; ++nts; } } while (0)
    PG8_STAMP();
    unsigned voffA[2], voffB[2];
#pragma unroll
    for (int i = 0; i < 2; ++i) { int R, C; stage_rc(tid * 16 + i * 8192, R, C); const int Rb = Epi::PERM ? ((R & ~31) + perm32(R & 31)) : R;
        voffA[i] = (unsigned)(R * K + C) * 2u; voffB[i] = (unsigned)(Rb * K + C) * 2u; }
    const size_t kstep = (size_t)(BK * 2);
    const size_t hstep = (size_t)HALF * K * 2;
    const size_t tstep = 2 * hstep;
    const unsigned ldsw = (unsigned)wid * 1024u;
    const int aoff = lds_byte(wr * 64 + fr, fq * 8), boff = lds_byte(wc * 32 + fr, fq * 8);
#define PG8_SA(b, h) (((b) * 2 + (h)) * HTB)
#define PG8_SB(b, h) ((4 + (b) * 2 + (h)) * HTB)
#define PG8_STAGE(bufoff, gbase, voff) do { _Pragma("unroll") for (int _i = 0; _i < 2; ++_i) \
        __builtin_amdgcn_global_load_lds((const unsigned*)((const char*)(gbase) + (voff)[_i]), (PG8_LAS unsigned*)(lds + (bufoff) + ldsw + _i * 8192), 16, 0, 0); } while (0)
#define PG8_LDA(dst, b, h) do { _Pragma("unroll") for (int m = 0; m < 4; ++m) _Pragma("unroll") for (int k = 0; k < 2; ++k) dst[m][k] = *(const PG8_LAS bf16x8*)(lds + PG8_SA(b, h) + aoff + m * 2048 + k * 1024); } while (0)
#define PG8_LDB(dst, b, h) do { _Pragma("unroll") for (int n = 0; n < 2; ++n) _Pragma("unroll") for (int k = 0; k < 2; ++k) dst[n][k] = *(const PG8_LAS bf16x8*)(lds + PG8_SB(b, h) + boff + n * 2048 + k * 1024); } while (0)
#define PG8_MMA(ai, bj, At, Bt) do { __builtin_amdgcn_s_setprio(1); _Pragma("unroll") for (int m = 0; m < 4; ++m) _Pragma("unroll") for (int n = 0; n < 2; ++n) _Pragma("unroll") for (int k = 0; k < 2; ++k) \
        acc[ai][bj][m][n] = __builtin_amdgcn_mfma_f32_16x16x32_bf16(Bt[n][k], At[m][k], acc[ai][bj][m][n], 0, 0, 0); __builtin_amdgcn_s_setprio(0); } while (0)
#define PG8_WAIT_V(n) asm volatile("s_waitcnt vmcnt(" #n ")" ::: "memory")
#define PG8_WAIT_L(n) asm volatile("s_waitcnt lgkmcnt(" #n ")" ::: "memory")
#define PG8_BAR __builtin_amdgcn_s_barrier()
#define PG8_SCHED __builtin_amdgcn_sched_barrier(0)
    Unit cur, nxt; int ui = 0;
    if (!S.next(0, cur)) return;
    f32x4 acc[2][2][4][2];
#pragma unroll
    for (int a = 0; a < 2; ++a)
#pragma unroll
        for (int b = 0; b < 2; ++b)
#pragma unroll
            for (int m = 0; m < 4; ++m)
#pragma unroll
                for (int n = 0; n < 2; ++n) acc[a][b][m][n] = (f32x4){0.f, 0.f, 0.f, 0.f};
    bf16x8 At[4][2], B0[2][2], B1[2][2];
    const char* cA = (const char*)g.A + (size_t)cur.pm * tstep; const char* cB = (const char*)g.Bt + (size_t)cur.pn * tstep;
    S.a_ready(cur);
    PG8_STAGE(PG8_SB(0, 0), cB, voffB); PG8_STAGE(PG8_SA(0, 0), cA, voffA); PG8_STAGE(PG8_SB(0, 1), cB + hstep, voffB); PG8_STAGE(PG8_SA(0, 1), cA + hstep, voffA);
    if (wr == 1) PG8_BAR;
    PG8_WAIT_V(4); PG8_BAR;
    PG8_STAGE(PG8_SB(1, 0), cB + kstep, voffB); PG8_STAGE(PG8_SA(1, 0), cA + kstep, voffA); PG8_STAGE(PG8_SB(1, 1), cB + hstep + kstep, voffB);
    PG8_WAIT_V(6); PG8_BAR;
    PG8_STAMP();
    for (;;) {
        const bool has_next = S.next(ui + 1, nxt);
        const char* nA = has_next ? (const char*)g.A + (size_t)nxt.pm * tstep : cA; const char* nB = has_next ? (const char*)g.Bt + (size_t)nxt.pn * tstep : cB;
        for (int t = 0; t < nt; t += 2) {
            const bool last = (t == nt - 2);
            const char* a1 = cA + (size_t)(t + 1) * kstep;
            const char* a2 = last ? nA : cA + (size_t)(t + 2) * kstep; const char* b2 = last ? nB : cB + (size_t)(t + 2) * kstep;
            const char* a3 = a2 + kstep; const char* b3 = b2 + kstep;
            if (last && has_next) S.a_ready(nxt);
            PG8_LDB(B0, 0, 0); PG8_SCHED; PG8_LDA(At, 0, 0); PG8_STAGE(PG8_SA(1, 1), a1 + hstep, voffA);
            PG8_WAIT_L(8); PG8_BAR; PG8_WAIT_L(0); PG8_MMA(0, 0, At, B0); PG8_BAR; PG8_SCHED;
            PG8_LDB(B1, 0, 1); PG8_STAGE(PG8_SB(0, 0), b2, voffB);
            PG8_BAR; PG8_WAIT_L(0); PG8_MMA(0, 1, At, B1); PG8_BAR;
            PG8_LDA(At, 0, 1); PG8_STAGE(PG8_SA(0, 0), a2, voffA);
            PG8_BAR; PG8_WAIT_L(0); PG8_MMA(1, 0, At, B0); PG8_BAR; PG8_SCHED;
            PG8_STAGE(PG8_SB(0, 1), b2 + hstep, voffB);
            PG8_WAIT_V(6); PG8_BAR; PG8_MMA(1, 1, At, B1); PG8_BAR;
            PG8_LDB(B0, 1, 0); PG8_SCHED; PG8_LDA(At, 1, 0); PG8_STAGE(PG8_SA(0, 1), a2 + hstep, voffA);
            PG8_WAIT_L(8); PG8_BAR; PG8_WAIT_L(0); PG8_MMA(0, 0, At, B0); PG8_BAR; PG8_SCHED;
            PG8_LDB(B1, 1, 1); PG8_STAGE(PG8_SB(1, 0), b3, voffB);
            PG8_BAR; PG8_WAIT_L(0); PG8_MMA(0, 1, At, B1); PG8_BAR;
            PG8_LDA(At, 1, 1); PG8_STAGE(PG8_SA(1, 0), a3, voffA);
            PG8_BAR; PG8_WAIT_L(0); PG8_MMA(1, 0, At, B0); PG8_BAR; PG8_SCHED;
            PG8_STAGE(PG8_SB(1, 1), b3 + hstep, voffB);
            PG8_WAIT_V(6); PG8_BAR; PG8_MMA(1, 1, At, B1); PG8_BAR;
        }
        PG8_STAMP();
        if constexpr (!Epi::AFTER_DRAIN) { E(acc, cur, wr, wc, fr, fq); S.done(cur); }
        PG8_STAMP();
        if (!has_next) break;
#pragma unroll
        for (int a = 0; a < 2; ++a)
#pragma unroll
            for (int b = 0; b < 2; ++b)
#pragma unroll
                for (int m = 0; m < 4; ++m)
#pragma unroll
                    for (int n = 0; n < 2; ++n) acc[a][b][m][n] = (f32x4){0.f, 0.f, 0.f, 0.f};
        cur = nxt; cA = nA; cB = nB; ++ui;
    }
    PG8_WAIT_V(0);
    if (wr == 0) PG8_BAR;
    PG8_BAR;
    if constexpr (Epi::AFTER_DRAIN) { E.fused(acc, cur, wr, wc, fr, fq, lds, wid, lane); S.done(cur); }
    PG8_STAMP();
    if (STAMP && wid == 0) { stamps[lane] = lane < nts ? (((unsigned long long)(unsigned)ts_hi << 32) | (unsigned)ts_lo) : 0ull;
        if (lane == 62) stamps[62] = rt_entry; if (lane == 63) stamps[63] = (unsigned long long)wall_clock64(); }
#undef PG8_STAMP
#undef PG8_SA
#undef PG8_SB
#undef PG8_STAGE
#undef PG8_LDA
#undef PG8_LDB
#undef PG8_MMA
#undef PG8_WAIT_V
#undef PG8_WAIT_L
#undef PG8_BAR
#undef PG8_SCHED
}
}
#define XB_TMO      128
#define XB_XCNT(j)  (256  + 64 * (j))
#define XB_XSUB(j)  (1280 + 64 * (j))
#define XB_XGEN(j)  (2304 + 64 * (j))
#define XB_TOP      3328
#define XB_TOPGEN   3392
#define XCD_BAR_WORDS 3456
#define XB_SPIN_CAP (1u << 23)
#define LAS __attribute__((address_space(3)))

__device__ __forceinline__ unsigned xb_ld(unsigned* p)              { return __hip_atomic_load(p, __ATOMIC_RELAXED, __HIP_MEMORY_SCOPE_AGENT); }
__device__ __forceinline__ unsigned xb_add(unsigned* p, unsigned v) { return __hip_atomic_fetch_add(p, v, __ATOMIC_RELAXED, __HIP_MEMORY_SCOPE_AGENT); }
__device__ __forceinline__ unsigned xb_xcc_id() { return (unsigned)__builtin_amdgcn_s_getreg((3 << 11) | 20) & 0xFu; }
#define XB_SPIN(cond, bar) do { unsigned _sp = 0; while (cond) { __builtin_amdgcn_s_sleep(1); \
    if ((++_sp & 255u) == 0u) { if (xb_ld(&(bar)[XB_TMO])) break; if (_sp > XB_SPIN_CAP) { atomicAdd(&(bar)[XB_TMO], 1u); break; } } } } while (0)

struct XcdBarrier {
    unsigned* bar; unsigned x;
    volatile LAS unsigned* st;
};

__device__ __forceinline__ XcdBarrier xcd_barrier_post(unsigned* bar, volatile LAS unsigned* st) {
    XcdBarrier b; b.bar = bar; b.x = xb_xcc_id(); b.st = st;
    if (threadIdx.x == 0) (void)xb_add(&bar[XB_XCNT(b.x)], 1u);
    return b;
}
__device__ __forceinline__ void xcd_barrier_complete(unsigned* bar, unsigned x, unsigned& nloc, unsigned& nx) {
    const unsigned G = gridDim.x * gridDim.y * gridDim.z;
    unsigned sum, cnt, mine, sp = 0u;
    for (;;) {
        sum = 0u; cnt = 0u; mine = 0u;
#pragma unroll
        for (unsigned j = 0; j < 16; ++j) { const unsigned c = xb_ld(&bar[XB_XCNT(j)]); sum += c; cnt += (c > 0u) ? 1u : 0u; mine = (j == x) ? c : mine; }
        if (sum == G) break;
        __builtin_amdgcn_s_sleep(1);
        if ((++sp & 255u) == 0u) { if (xb_ld(&bar[XB_TMO])) break; if (sp > XB_SPIN_CAP) { atomicAdd(&bar[XB_TMO], 1u); break; } }
    }
    nloc = mine > 0u ? mine : 1u; nx = cnt > 0u ? cnt : 1u;
}

__device__ __forceinline__ void xcd_barrier(const XcdBarrier& b, const int tid) {
    asm volatile("s_waitcnt vmcnt(0)" ::: "memory");
    __syncthreads();
    if (tid == 0) {
        unsigned* bar = b.bar; unsigned bx = b.x;
        asm volatile("" : "+s"(bar), "+s"(bx));
        __builtin_amdgcn_s_waitcnt(0);
        unsigned nloc = b.st[0], nx = b.st[1];
        if (nloc == 0u) { xcd_barrier_complete(bar, bx, nloc, nx); b.st[0] = nloc; b.st[1] = nx; }
        const unsigned old = xb_add(&bar[XB_XSUB(bx)], 1u);
        const unsigned gen = old / nloc;
        if (old + 1u == (gen + 1u) * nloc) {
            __builtin_amdgcn_fence(__ATOMIC_RELEASE, "agent");
            asm volatile("s_waitcnt vmcnt(0)" ::: "memory");
            const unsigned og = xb_add(&bar[XB_TOP], 1u);
            const unsigned tg = og / nx;
            if (og + 1u == (tg + 1u) * nx) xb_add(&bar[XB_TOPGEN], 1u);
            else XB_SPIN(xb_ld(&bar[XB_TOPGEN]) == tg, bar);
            __builtin_amdgcn_fence(__ATOMIC_ACQUIRE, "agent");
            xb_add(&bar[XB_XGEN(bx)], 1u);
            asm volatile("s_waitcnt vmcnt(0)" ::: "memory");
        } else {
            XB_SPIN(xb_ld(&bar[XB_XGEN(bx)]) == gen, bar);
            __builtin_amdgcn_fence(__ATOMIC_ACQUIRE, "agent");
            asm volatile("s_waitcnt vmcnt(0)" ::: "memory");
        }
    }
    __syncthreads();
}


typedef __attribute__((address_space(3))) unsigned char lds_u8;

DEV bf16_t* wsb(const Args& a, size_t off) { return (bf16_t*)(a.ws + off); }
DEV float* wsf(const Args& a, size_t off) { return (float*)(a.ws + off); }

DEV void ph_rowprep(const Args& a, bool from_x, const int tid0) {
    const int lane = tid0 & 63, wv = tid0 >> 6;
    const int gw = blockIdx.x * 8 + wv, nw = gridDim.x * 8;
    bf16_t* hb = wsb(a, HB_OFF); float* rstd = wsf(a, RSTD_OFF);
    for (int t = gw; t < T; t += nw) {
        const float* src = from_x ? (t < TP ? a.x_prompt + (size_t)t * D : a.x_sample + (size_t)(t - TP) * D) : a.h + (size_t)t * D;
        f32x4 v[4]; float ss = 0.f;
#pragma unroll
        for (int i = 0; i < 4; ++i) { v[i] = *(const f32x4*)(src + (i * 64 + lane) * 4); ss += v[i][0] * v[i][0] + v[i][1] * v[i][1] + v[i][2] * v[i][2] + v[i][3] * v[i][3]; }
        ss = wave_sum(ss);
#pragma unroll
        for (int i = 0; i < 4; ++i) {
            if (from_x) *(f32x4*)(a.h + (size_t)t * D + (i * 64 + lane) * 4) = v[i];
            u32x2 p; p.x = pack2(v[i][0], v[i][1]); p.y = pack2(v[i][2], v[i][3]);
            *(u32x2*)(hb + (size_t)t * D + (i * 64 + lane) * 4) = p;
        }
        if (lane == 0) rstd[t] = rsqrtf(ss * (1.0f / 1024.0f) + 1e-6f);
    }
}

DEV void ph_final(const Args& a, const int tid0) {
    const int lane = tid0 & 63, wv = tid0 >> 6;
    const int gw = blockIdx.x * 8 + wv, nw = gridDim.x * 8;
    for (int t = gw; t < T; t += nw) {
        float* row = a.h + (size_t)t * D;
        f32x4 v[4]; float ss = 0.f;
#pragma unroll
        for (int i = 0; i < 4; ++i) { v[i] = *(const f32x4*)(row + (i * 64 + lane) * 4); ss += v[i][0] * v[i][0] + v[i][1] * v[i][1] + v[i][2] * v[i][2] + v[i][3] * v[i][3]; }
        ss = wave_sum(ss);
        const float r = rsqrtf(ss * (1.0f / 1024.0f) + 1e-6f);
#pragma unroll
        for (int i = 0; i < 4; ++i) { const f32x4 g = *(const f32x4*)(a.final_norm_g + (i * 64 + lane) * 4); *(f32x4*)(row + (i * 64 + lane) * 4) = v[i] * r * g; }
    }
}

DEV void transpose_cvt(const float* __restrict__ src, bf16_t* __restrict__ dst, int K, int N, int Npad, const float* __restrict__ g, float* tile, const int tid0) {
    const int tx = tid0 & 63, ty = tid0 >> 6;
    const int tk = K / 64, tn = Npad / 64;
    for (int tl = blockIdx.x; tl < tk * tn; tl += gridDim.x) {
        const int k0 = (tl % tk) * 64, n0 = (tl / tk) * 64;
        __syncthreads();
        for (int i = ty; i < 64; i += 8) { const int k = k0 + i, n = n0 + tx; float v = (n < N) ? src[(size_t)k * N + n] : 0.f; if (g) v *= g[k]; tile[i * 65 + tx] = v; }
        __syncthreads();
        for (int i = ty; i < 64; i += 8) dst[(size_t)(n0 + i) * K + k0 + tx] = (bf16_t)f2bf(tile[tx * 65 + i]);
    }
}
DEV void fold_wqk(const Args& a, float* lds, const int tid0) {
    float* swq = lds;
    float* ssk = lds + 64 * 132;
    const int tid = tid0, key = tid & 127, kq = tid >> 7;
    for (int un = blockIdx.x; un < NL * 16 * 16; un += gridDim.x) {
        const int l = un >> 8, hp = (un >> 4) & 15, k0 = (un & 15) * 64;
        __syncthreads();
        for (int i = tid; i < 64 * 128; i += NTHR) { const int r = i >> 7, c = i & 127; swq[r * 132 + c] = a.peer_w_q[((size_t)l * 1024 + k0 + r) * 2048 + hp * 128 + c]; }
        for (int i = tid; i < 128 * 128; i += NTHR) { const int r = i >> 7, c = i & 127; ssk[r * 132 + c] = a.peer_sub_keys[(((size_t)l * 16 + hp) * 128 + r) * 128 + c]; }
        __syncthreads();
        float acc[16];
#pragma unroll
        for (int i = 0; i < 16; ++i) acc[i] = 0.f;
        for (int c = 0; c < 128; c += 4) {
            const f32x4 s = *(const f32x4*)(ssk + key * 132 + c);
#pragma unroll
            for (int i = 0; i < 16; ++i) { const f32x4 w = *(const f32x4*)(swq + (kq * 16 + i) * 132 + c); acc[i] += s[0] * w[0] + s[1] * w[1] + s[2] * w[2] + s[3] * w[3]; }
        }
        bf16_t* dst = wsb(a, WB_OFF + (size_t)l * WB_LAYER + WB_QK) + (size_t)(hp * 128 + key) * 1024 + k0 + kq * 16;
        const float* g = a.norm_ffn_g + l * 1024 + k0 + kq * 16;
#pragma unroll
        for (int i = 0; i < 16; i += 2) *(unsigned*)(dst + i) = pack2(acc[i] * g[i], acc[i + 1] * g[i + 1]);
    }
}
DEV void ph_prologue(const Args& a, float* lds, const int tid0) {
    { float* rc = wsf(a, ROPEC_OFF); float* rs = wsf(a, ROPES_OFF);
      for (int i = blockIdx.x * NTHR + tid0; i < 4096 * 8; i += gridDim.x * NTHR) {
          const int pos = i >> 3, f = i & 7;
          const float invf = (float)pow(500000.0, -(double)f / 8.0);
          const float ang = (float)pos * invf;
          rc[i] = (float)cos((double)ang); rs[i] = (float)sin((double)ang);
      } }
    for (int l = 0; l < NL; ++l) {
        bf16_t* wb = wsb(a, WB_OFF + (size_t)l * WB_LAYER);
        transpose_cvt(a.w_in + (size_t)l * 1024 * INC, wb + WB_IN / 2, 1024, INC, INP, a.norm_mix_g + l * 1024, lds, tid0);
        transpose_cvt(a.w_out + (size_t)l * 1024 * 1024, wb + WB_OUT / 2, 1024, 1024, 1024, nullptr, lds, tid0);
        transpose_cvt(a.ple_w_gate + (size_t)l * 1024 * 1024, wb + WB_GATE / 2, 1024, 1024, 1024, a.ple_norm_g + l * 1024, lds, tid0);
        transpose_cvt(a.ple_w_proj + (size_t)l * 256 * 1024, wb + WB_PROJ / 2, 256, 1024, 1024, nullptr, lds, tid0);
        for (int dr = 0; dr < 2; ++dr) {
            transpose_cvt(a.rwkv_w2 + (size_t)(l * 2 + dr) * 64 * 512, wb + WB_LORA / 2 + dr * 512 * 64, 64, 512, 512, nullptr, lds, tid0);
            transpose_cvt(a.rwkv_a2 + (size_t)(l * 2 + dr) * 64 * 512, wb + WB_LORA / 2 + (2 + dr) * 512 * 64, 64, 512, 512, nullptr, lds, tid0);
        }
        transpose_cvt(a.rwkv_g2 + (size_t)l * 128 * 512, wb + WB_LORA / 2 + 4 * 512 * 64, 128, 512, 512, nullptr, lds, tid0);
    }
    fold_wqk(a, lds, tid0);
}

DEV float sum16(float v) {
    v = sum8(v);
    v += __int_as_float(__builtin_amdgcn_mov_dpp(__float_as_int(v), 0x140, 0xF, 0xF, true));
    return v;
}
DEV float max16(float v) {
    v = fmaxf(v, __int_as_float(__builtin_amdgcn_mov_dpp(__float_as_int(v), 0xB1, 0xF, 0xF, true)));
    v = fmaxf(v, __int_as_float(__builtin_amdgcn_mov_dpp(__float_as_int(v), 0x4E, 0xF, 0xF, true)));
    v = fmaxf(v, __int_as_float(__builtin_amdgcn_mov_dpp(__float_as_int(v), 0x141, 0xF, 0xF, true)));
    v = fmaxf(v, __int_as_float(__builtin_amdgcn_mov_dpp(__float_as_int(v), 0x140, 0xF, 0xF, true)));
    return v;
}
DEV float rl(float v, int l) { return __int_as_float(__builtin_amdgcn_readlane(__float_as_int(v), l)); }
DEV float wave_sum_dpp(float v) { v = sum16(v); return (rl(v, 0) + rl(v, 16)) + (rl(v, 32) + rl(v, 48)); }
DEV unsigned fkey(float f) { const unsigned b = __float_as_uint(f); return b ^ ((unsigned)((int)b >> 31) | 0x80000000u); }
DEV int mbcnt64(unsigned long long m) { return (int)__builtin_amdgcn_mbcnt_hi((unsigned)(m >> 32), __builtin_amdgcn_mbcnt_lo((unsigned)m, 0u)); }

DEV void ph_topk2(const Args& a, float* lds, const int tid0) {
    const int lane = tid0 & 63, wv = __builtin_amdgcn_readfirstlane(tid0 >> 6);
    const int gw = blockIdx.x * 8 + wv, nw = gridDim.x * 8;
    float* tv = lds + wv * 32; int* ti = (int*)(lds + 8 * 32) + wv * 32;
    const float* SC = wsf(a, SC_OFF); int* TOPI = (int*)(a.ws + TOPI_OFF); float* TOPG = wsf(a, TOPG_OFF); const float* rstd = wsf(a, RSTD_OFF);
    for (int un = gw; un < T * 8; un += nw) {
        const int t = un >> 3, hd = un & 7;
        const float* sp = SC + (size_t)t * 2048 + hd * 256;
        float v[4]; unsigned k[4];
#pragma unroll
        for (int i = 0; i < 4; ++i) { v[i] = sp[i * 64 + lane]; k[i] = fkey(v[i]); }
        unsigned t0 = 0u, t1 = 0u;
        for (int b = 31; b >= 0; --b) {
            const unsigned c0 = t0 | (1u << b), c1 = t1 | (1u << b);
            const int n0 = __builtin_popcountll(__ballot(k[0] >= c0)) + __builtin_popcountll(__ballot(k[1] >= c0));
            const int n1 = __builtin_popcountll(__ballot(k[2] >= c1)) + __builtin_popcountll(__ballot(k[3] >= c1));
            t0 = (n0 >= 16) ? c0 : t0; t1 = (n1 >= 16) ? c1 : t1;
        }
#pragma unroll
        for (int p = 0; p < 2; ++p) {
            const unsigned tp = p ? t1 : t0;
            const unsigned long long ga = __ballot(k[2 * p] > tp), gb = __ballot(k[2 * p + 1] > tp);
            const unsigned long long ea = __ballot(k[2 * p] == tp), eb = __ballot(k[2 * p + 1] == tp);
            const int nga = __builtin_popcountll(ga), ng = nga + __builtin_popcountll(gb), need = 16 - ng, nea = __builtin_popcountll(ea);
            int pa = -1, pb = -1;
            if (k[2 * p] > tp) pa = mbcnt64(ga); else if (k[2 * p] == tp) { const int r = mbcnt64(ea); if (r < need) pa = ng + r; }
            if (k[2 * p + 1] > tp) pb = nga + mbcnt64(gb); else if (k[2 * p + 1] == tp) { const int r = nea + mbcnt64(eb); if (r < need) pb = ng + r; }
            if (pa >= 0) { tv[p * 16 + pa] = v[2 * p]; ti[p * 16 + pa] = lane; }
            if (pb >= 0) { tv[p * 16 + pb] = v[2 * p + 1]; ti[p * 16 + pb] = 64 + lane; }
        }
        float cv[4]; unsigned kc[4];
#pragma unroll
        for (int s = 0; s < 4; ++s) { const int c = lane + 64 * s; cv[s] = tv[c >> 4] + tv[16 + (c & 15)]; kc[s] = fkey(cv[s]); }
        const float m0 = max16(lane < 16 ? tv[lane & 15] : -3.0e38f), m1 = max16(lane < 16 ? tv[16 + (lane & 15)] : -3.0e38f);
        const float mx = rl(m0, 0) + rl(m1, 0);
        unsigned t2 = 0u;
        for (int b = 31; b >= 0; --b) {
            const unsigned c2 = t2 | (1u << b);
            const int n = (__builtin_popcountll(__ballot(kc[0] >= c2)) + __builtin_popcountll(__ballot(kc[1] >= c2))) + (__builtin_popcountll(__ballot(kc[2] >= c2)) + __builtin_popcountll(__ballot(kc[3] >= c2)));
            t2 = (n >= 16) ? c2 : t2;
        }
        int pos[4]; int ng = 0;
#pragma unroll
        for (int s = 0; s < 4; ++s) { const unsigned long long g = __ballot(kc[s] > t2); pos[s] = (kc[s] > t2) ? ng + mbcnt64(g) : -1; ng += __builtin_popcountll(g); }
        int ne = 0; const int need = 16 - ng;
#pragma unroll
        for (int s = 0; s < 4; ++s) { const unsigned long long e = __ballot(kc[s] == t2); if (kc[s] == t2) { const int r = ne + mbcnt64(e); if (r < need) pos[s] = ng + r; } ne += __builtin_popcountll(e); }
        const float rs = rstd[t];
        float ex[4]; float es = 0.f;
#pragma unroll
        for (int s = 0; s < 4; ++s) { ex[s] = (pos[s] >= 0) ? __expf(rs * (cv[s] - mx)) : 0.f; es += ex[s]; }
        const float inv = 1.0f / wave_sum_dpp(es);
#pragma unroll
        for (int s = 0; s < 4; ++s) if (pos[s] >= 0) {
            const int c = lane + 64 * s;
            TOPI[(size_t)t * 128 + hd * 16 + pos[s]] = ti[c >> 4] * 128 + ti[16 + (c & 15)];
            TOPG[(size_t)t * 128 + hd * 16 + pos[s]] = ex[s] * inv;
        }
    }
}

DEV unsigned pack4_fp8(float a, float b, float c, float d) {
    int w = __builtin_amdgcn_cvt_pk_fp8_f32(a, b, 0, false);
    w = __builtin_amdgcn_cvt_pk_fp8_f32(c, d, w, true);
    return (unsigned)w;
}
DEV void ph_convert8(const Args& a, int layer, const int tid0) {
    const size_t gtid = (size_t)blockIdx.x * NTHR + tid0, gn = (size_t)gridDim.x * NTHR;
    const float* us = a.peer_u + (size_t)layer * 16384 * 1024; const float* vs = a.peer_v + (size_t)layer * 16384 * 1024;
    unsigned* ud = (unsigned*)(a.ws + PTU_OFF); unsigned* vd = (unsigned*)(a.ws + PTV_OFF);
    const float* g = a.norm_ffn_g + layer * 1024;
    for (size_t i = gtid; i < (size_t)16384 * 1024 / 16; i += gn) {
        u32x4 pu, pv;
#pragma unroll
        for (int j = 0; j < 4; ++j) {
            const f32x4 x = *(const f32x4*)(us + i * 16 + j * 4), y = *(const f32x4*)(vs + i * 16 + j * 4), gg = *(const f32x4*)(g + ((i * 16 + j * 4) & 1023));
            pu[j] = pack4_fp8(x[0] * gg[0] * 256.f, x[1] * gg[1] * 256.f, x[2] * gg[2] * 256.f, x[3] * gg[3] * 256.f);
            pv[j] = pack4_fp8(y[0] * 32.f, y[1] * 32.f, y[2] * 32.f, y[3] * 32.f);
        }
        *(u32x4*)(ud + i * 4) = pu; *(u32x4*)(vd + i * 4) = pv;
    }
    bf16_t* pb = wsb(a, PB_OFF);
    const float* pp = a.p_prompt + (size_t)layer * TP * 256; const float* ps = a.p_sample + (size_t)layer * (T - TP) * 256;
    for (size_t i = gtid; i < (size_t)T * 256 / 4; i += gn) {
        const size_t e = i * 4; const f32x4 x = (e < (size_t)TP * 256) ? *(const f32x4*)(pp + e) : *(const f32x4*)(ps + (e - (size_t)TP * 256));
        u32x2 p; p.x = pack2(x[0], x[1]); p.y = pack2(x[2], x[3]); *(u32x2*)(pb + e) = p;
    }
}

DEV void ph_peer8(const Args& a, const int tid0) {
    const int lane = tid0 & 63, wv = tid0 >> 6;
    const int gw = blockIdx.x * 8 + wv, nw = gridDim.x * 8;
    bf16_t* hb = wsb(a, HB_OFF); float* rstd = wsf(a, RSTD_OFF);
    const int* TOPI = (const int*)(a.ws + TOPI_OFF); const float* TOPG = wsf(a, TOPG_OFF);
    const unsigned char* PU = a.ws + PTU_OFF; const unsigned char* PV = a.ws + PTV_OFF;
    const int c16 = 16 * lane;
    const bool b5 = lane & 32, b4 = lane & 16, b3 = lane & 8;
    for (int t = gw; t < T; t += nw) {
        float x[16];
        { const u32x4 x0 = *(const u32x4*)(hb + (size_t)t * 1024 + c16), x1 = *(const u32x4*)(hb + (size_t)t * 1024 + c16 + 8);
#pragma unroll
          for (int i = 0; i < 4; ++i) { x[2 * i] = bflo(x0[i]); x[2 * i + 1] = bfhi(x0[i]); x[8 + 2 * i] = bflo(x1[i]); x[8 + 2 * i + 1] = bfhi(x1[i]); } }
        const float rs = rstd[t] * (1.0f / 256.0f);
        const int e0 = TOPI[(size_t)t * 128 + lane], e1 = TOPI[(size_t)t * 128 + 64 + lane];
        const float g0 = TOPG[(size_t)t * 128 + lane], g1 = TOPG[(size_t)t * 128 + 64 + lane];
        float out[16];
#pragma unroll
        for (int i = 0; i < 16; ++i) out[i] = 0.f;
#pragma unroll 1
        for (int kb = 0; kb < 128; kb += 8) {
            const int es = (kb < 64) ? e0 : e1; const float gs = (kb < 64) ? g0 : g1;
            u32x4 ur[8], vr[8];
#pragma unroll
            for (int i = 0; i < 8; ++i) { const int e = __builtin_amdgcn_readlane(es, (kb + i) & 63); ur[i] = *(const u32x4*)(PU + (size_t)e * 1024 + c16); vr[i] = *(const u32x4*)(PV + (size_t)e * 1024 + c16); }
            float d[8];
#pragma unroll
            for (int i = 0; i < 8; ++i) {
                float s = 0.f;
#pragma unroll
                for (int j = 0; j < 4; ++j) {
                    const f32x2 lo = __builtin_amdgcn_cvt_pk_f32_fp8((int)ur[i][j], false), hi = __builtin_amdgcn_cvt_pk_f32_fp8((int)ur[i][j], true);
                    s += lo[0] * x[4 * j] + lo[1] * x[4 * j + 1] + hi[0] * x[4 * j + 2] + hi[1] * x[4 * j + 3];
                }
                d[i] = s;
            }
            float r4[4], r2[2];
#pragma unroll
            for (int i = 0; i < 4; ++i) { const float send = b5 ? d[i] : d[4 + i], keep = b5 ? d[4 + i] : d[i]; r4[i] = keep + SHX(send, 32); }
#pragma unroll
            for (int i = 0; i < 2; ++i) { const float send = b4 ? r4[i] : r4[2 + i], keep = b4 ? r4[2 + i] : r4[i]; r2[i] = keep + SHX(send, 16); }
            const float send1 = b3 ? r2[0] : r2[1], keep1 = b3 ? r2[1] : r2[0];
            const float dd = sum8(keep1 + SHX(send1, 8));
            const float hp = rs * dd;
            const float gt = SHF(gs, (kb + (lane >> 3)) & 63);
            const float w = gt * 0.5f * hp * (1.0f + erff(hp * 0.70710678f)) * (1.0f / 32.0f);
#pragma unroll
            for (int i = 0; i < 8; ++i) {
                const float wi = rl(w, 8 * i);
#pragma unroll
                for (int j = 0; j < 4; ++j) {
                    const f32x2 lo = __builtin_amdgcn_cvt_pk_f32_fp8((int)vr[i][j], false), hi = __builtin_amdgcn_cvt_pk_f32_fp8((int)vr[i][j], true);
                    out[4 * j] += wi * lo[0]; out[4 * j + 1] += wi * lo[1]; out[4 * j + 2] += wi * hi[0]; out[4 * j + 3] += wi * hi[1];
                }
            }
        }
        float* hr = a.h + (size_t)t * 1024 + c16;
        f32x4 hv[4]; float ss = 0.f;
#pragma unroll
        for (int j = 0; j < 4; ++j) { hv[j] = *(const f32x4*)(hr + 4 * j);
#pragma unroll
            for (int c = 0; c < 4; ++c) { hv[j][c] += out[4 * j + c]; ss += hv[j][c] * hv[j][c]; }
            *(f32x4*)(hr + 4 * j) = hv[j]; }
        ss = wave_sum(ss);
        u32x4 p0, p1;
        p0.x = pack2(hv[0][0], hv[0][1]); p0.y = pack2(hv[0][2], hv[0][3]); p0.z = pack2(hv[1][0], hv[1][1]); p0.w = pack2(hv[1][2], hv[1][3]);
        p1.x = pack2(hv[2][0], hv[2][1]); p1.y = pack2(hv[2][2], hv[2][3]); p1.z = pack2(hv[3][0], hv[3][1]); p1.w = pack2(hv[3][2], hv[3][3]);
        *(u32x4*)(hb + (size_t)t * 1024 + c16) = p0; *(u32x4*)(hb + (size_t)t * 1024 + c16 + 8) = p1;
        if (lane == 0) rstd[t] = rsqrtf(ss * (1.0f / 1024.0f) + 1e-6f);
    }
}

typedef short bf16x8 __attribute__((ext_vector_type(8)));
typedef float f32x16 __attribute__((ext_vector_type(16)));
#define MFMA32(a, b, c) __builtin_amdgcn_mfma_f32_32x32x16_bf16((a), (b), (c), 0, 0, 0)
DEV bf16x8 pack_frag(float x0, float x1, float x2, float x3, float x4, float x5, float x6, float x7) {
    u32x4 p;
    asm volatile("v_cvt_pk_bf16_f32 %0, %4, %5\n\tv_cvt_pk_bf16_f32 %1, %6, %7\n\tv_cvt_pk_bf16_f32 %2, %8, %9\n\tv_cvt_pk_bf16_f32 %3, %10, %11\n\ts_nop 1"
                 : "=&v"(p[0]), "=&v"(p[1]), "=&v"(p[2]), "=&v"(p[3]) : "v"(x0), "v"(x1), "v"(x2), "v"(x3), "v"(x4), "v"(x5), "v"(x6), "v"(x7));
    return __builtin_bit_cast(bf16x8, p);
}
DEV void ph_attn2(const Args& a, unsigned char* ldsb, const int tid0) {
    const int lane = tid0 & 63, wv = __builtin_amdgcn_readfirstlane(tid0 >> 6), r = lane & 31, h = lane >> 5;
    unsigned char* vt = ldsb + wv * 5120;
    const bf16_t* qkv = wsb(a, QKV_OFF);
    bf16_t* OP = wsb(a, OP_OFF); float* ML = wsf(a, ML_OFF);
    const int x16 = r & 15, permr = (r & 16) + 8 * ((x16 >> 2) & 1) + 4 * ((x16 >> 3) & 1) + (x16 & 3);
    const float sc = 0.125f * 1.44269504f, NEG = -1.0e30f;
    const int nitem = NSEQ * 8 * 3 * 128, per = nitem / (int)gridDim.x;
    for (int it = 0; it < per / 8; ++it) {
        const int w = blockIdx.x * per + it * 8 + wv;
        const int sh = w / 384, rem = w - sh * 384, di = rem >> 7, idx = rem & 127;
        const int sft = 2 * di, nbc = 128 >> sft, rr = idx >> (7 - sft), cb = idx & (nbc - 1), cq0 = cb * 32, nlen = 4096 >> sft;
        const int seq = sh >> 3, hd = sh & 7; const size_t tb = (size_t)seq * 4096;
        const size_t tokq = tb + ((size_t)(cq0 + r) << sft) + rr;
        const bf16_t* qp = qkv + tokq * 1536 + hd * 64 + 8 * h;
        bf16x8 qf[4];
#pragma unroll
        for (int s = 0; s < 4; ++s) qf[s] = *(const bf16x8*)(qp + 16 * s);
        float m = NEG, l = 0.f;
        f32x16 O0, O1;
#pragma unroll
        for (int i = 0; i < 16; ++i) { O0[i] = 0.f; O1[i] = 0.f; }
#pragma unroll
        for (int kt = 0; kt < 5; ++kt) {
            const int kb = cq0 - 64 + 32 * kt;
            if (kb < 0 || kb >= nlen) continue;
            const size_t tokk = tb + ((size_t)(kb + r) << sft) + rr;
            const bf16_t* kp = qkv + tokk * 1536 + 512 + hd * 64 + 8 * h;
            bf16x8 kf[4], vf[4];
#pragma unroll
            for (int s = 0; s < 4; ++s) { kf[s] = *(const bf16x8*)(kp + 16 * s); vf[s] = *(const bf16x8*)(kp + 512 + 16 * s); }
            f32x16 S;
#pragma unroll
            for (int i = 0; i < 16; ++i) S[i] = 0.f;
#pragma unroll
            for (int s = 0; s < 4; ++s) S = MFMA32(kf[s], qf[s], S);
            float lm = NEG;
#pragma unroll
            for (int i = 0; i < 16; ++i) {
                const int row = (i & 3) + 8 * (i >> 2) + 4 * h;
                float v = S[i] * sc;
                if (kt == 0) v = (row >= r) ? v : NEG;
                if (kt == 4) v = (row <= r) ? v : NEG;
                S[i] = v; lm = fmaxf(lm, v);
            }
            lm = fmaxf(lm, SHX(lm, 32));
            const float mn = fmaxf(m, lm), alpha = __builtin_amdgcn_exp2f(m - mn);
            m = mn; l *= alpha;
            float ps = 0.f;
#pragma unroll
            for (int i = 0; i < 16; ++i) { O0[i] *= alpha; O1[i] *= alpha; S[i] = __builtin_amdgcn_exp2f(S[i] - mn); ps += S[i]; }
            l += ps;
            const bf16x8 pb0 = pack_frag(S[0], S[1], S[2], S[3], S[4], S[5], S[6], S[7]);
            const bf16x8 pb1 = pack_frag(S[8], S[9], S[10], S[11], S[12], S[13], S[14], S[15]);
            asm volatile("" ::: "memory");
#pragma unroll
            for (int i = 0; i < 4; ++i)
#pragma unroll
                for (int e = 0; e < 8; ++e) *(short*)(vt + (16 * i + 8 * h + e) * 80 + 2 * permr) = vf[i][e];
            asm volatile("" ::: "memory");
#pragma unroll
            for (int s = 0; s < 2; ++s) {
                const bf16x8 a0 = *(const bf16x8*)(vt + r * 80 + 32 * s + 16 * h), a1 = *(const bf16x8*)(vt + (r + 32) * 80 + 32 * s + 16 * h);
                O0 = MFMA32(a0, s ? pb1 : pb0, O0); O1 = MFMA32(a1, s ? pb1 : pb0, O1);
            }
            asm volatile("" ::: "memory");
        }
        l += SHX(l, 32);
        const float inv = 1.0f / l;
        bf16_t* op = OP + ((size_t)di * T + tokq) * 512 + hd * 64 + 4 * h;
#pragma unroll
        for (int g = 0; g < 4; ++g) {
            u32x2 p0, p1;
            p0.x = pack2(O0[4 * g] * inv, O0[4 * g + 1] * inv); p0.y = pack2(O0[4 * g + 2] * inv, O0[4 * g + 3] * inv);
            p1.x = pack2(O1[4 * g] * inv, O1[4 * g + 1] * inv); p1.y = pack2(O1[4 * g + 2] * inv, O1[4 * g + 3] * inv);
            *(u32x2*)(op + 8 * g) = p0; *(u32x2*)(op + 32 + 8 * g) = p1;
        }
        if (h == 0) { f32x2 ml; ml[0] = m; ml[1] = l; *(f32x2*)(ML + (((size_t)di * T + tokq) * 8 + hd) * 2) = ml; }
    }
}
DEV void ph_attn_merge(const Args& a, int layer, const int tid0) {
    const int lane = tid0 & 63, wv = tid0 >> 6;
    const int gw = blockIdx.x * 8 + wv, nw = gridDim.x * 8;
    const bf16_t* OP = wsb(a, OP_OFF); const float* ML = wsf(a, ML_OFF); bf16_t* mix = wsb(a, MIX_OFF);
    const int c8 = 8 * lane, hd = lane >> 3;
    const f32x4 gA = *(const f32x4*)(a.att_norm_g + layer * 512 + c8), gB = *(const f32x4*)(a.att_norm_g + layer * 512 + c8 + 4);
    for (int t = gw; t < T; t += nw) {
        u32x4 o[3]; f32x2 ml[3];
#pragma unroll
        for (int d = 0; d < 3; ++d) { o[d] = *(const u32x4*)(OP + ((size_t)d * T + t) * 512 + c8); ml[d] = *(const f32x2*)(ML + (((size_t)d * T + t) * 8 + hd) * 2); }
        const float mm = fmaxf(ml[0][0], fmaxf(ml[1][0], ml[2][0]));
        float wgt[3]; float den = 0.f;
#pragma unroll
        for (int d = 0; d < 3; ++d) { wgt[d] = __builtin_amdgcn_exp2f(ml[d][0] - mm) * ml[d][1]; den += wgt[d]; }
        const float iden = 1.0f / den;
        float v[8]; float ss = 0.f;
#pragma unroll
        for (int i = 0; i < 4; ++i) {
            v[2 * i] = (wgt[0] * bflo(o[0][i]) + wgt[1] * bflo(o[1][i]) + wgt[2] * bflo(o[2][i])) * iden;
            v[2 * i + 1] = (wgt[0] * bfhi(o[0][i]) + wgt[1] * bfhi(o[1][i]) + wgt[2] * bfhi(o[2][i])) * iden;
            ss += v[2 * i] * v[2 * i] + v[2 * i + 1] * v[2 * i + 1];
        }
        const float rn = rsqrtf(sum8(ss) * (1.0f / 64.0f) + 1e-6f);
        u32x4 ov;
        ov.x = pack2(v[0] * rn * gA[0], v[1] * rn * gA[1]); ov.y = pack2(v[2] * rn * gA[2], v[3] * rn * gA[3]);
        ov.z = pack2(v[4] * rn * gB[0], v[5] * rn * gB[1]); ov.w = pack2(v[6] * rn * gB[2], v[7] * rn * gB[3]);
        *(u32x4*)(mix + (size_t)t * 1024 + c8) = ov;
    }
}

DEV float tanh_fast(float x) { return 1.0f - 2.0f / (1.0f + __expf(2.0f * x)); }

DEV void ph_rwkv_prep1(const Args& a, int layer, const int tid0) {
    const int lane = tid0 & 63, wv = __builtin_amdgcn_readfirstlane(tid0 >> 6), r = lane & 31, h = lane >> 5;
    const int gw = blockIdx.x * 8 + wv, nw = gridDim.x * 8;
    const bf16_t* U = wsb(a, U_OFF);
    const float* sw = a.rwkv_shift + (size_t)layer * 3 * UC;
    const bf16_t* wl = wsb(a, WB_OFF + (size_t)layer * WB_LAYER + WB_LORA);
    for (int tile = gw; tile < T / 32; tile += nw) {
        const int t = tile * 32 + r, pos = t & 4095;
        const bool hp = pos > 0, hn = pos < 4095;
        const bf16_t* up = U + (size_t)t * UW + 1536 + 8 * h;
#pragma unroll 1
        for (int arr = 0; arr < 5; ++arr) {
            const int coff = (arr < 4) ? arr * 64 : 256, nk = (arr < 4) ? 4 : 8, kw = nk * 16;
            bf16x8 xf[8];
#pragma unroll
            for (int s = 0; s < 8; ++s) {
                if (s < nk) {
                    const int col = coff + 16 * s;
                    const u32x4 c = *(const u32x4*)(up + col);
                    u32x4 p = {0u, 0u, 0u, 0u}, n = {0u, 0u, 0u, 0u};
                    if (hp) p = *(const u32x4*)(up - UW + col);
                    if (hn) n = *(const u32x4*)(up + UW + col);
                    const float* s0 = sw + 1536 + 8 * h + col;
                    const f32x4 wp0 = *(const f32x4*)(s0), wp1 = *(const f32x4*)(s0 + 4), wc0 = *(const f32x4*)(s0 + UC), wc1 = *(const f32x4*)(s0 + UC + 4), wn0 = *(const f32x4*)(s0 + 2 * UC), wn1 = *(const f32x4*)(s0 + 2 * UC + 4);
                    float v[8];
#pragma unroll
                    for (int i = 0; i < 4; ++i) {
                        const float a0 = (i < 2) ? wp0[2 * i] : wp1[2 * i - 4], a1 = (i < 2) ? wp0[2 * i + 1] : wp1[2 * i - 3];
                        const float b0 = (i < 2) ? wc0[2 * i] : wc1[2 * i - 4], b1 = (i < 2) ? wc0[2 * i + 1] : wc1[2 * i - 3];
                        const float c0 = (i < 2) ? wn0[2 * i] : wn1[2 * i - 4], c1 = (i < 2) ? wn0[2 * i + 1] : wn1[2 * i - 3];
                        v[2 * i] = a0 * bflo(p[i]) + b0 * bflo(c[i]) + c0 * bflo(n[i]);
                        v[2 * i + 1] = a1 * bfhi(p[i]) + b1 * bfhi(c[i]) + c1 * bfhi(n[i]);
                    }
                    if (arr < 2) {
#pragma unroll
                        for (int i = 0; i < 8; ++i) v[i] = tanh_fast(v[i]);
                    } else if (arr == 4) {
#pragma unroll
                        for (int i = 0; i < 8; ++i) v[i] = sigmoidf_(v[i]);
                    }
                    xf[s] = pack_frag(v[0], v[1], v[2], v[3], v[4], v[5], v[6], v[7]);
                }
            }
            const bf16_t* wt = wl + (arr < 4 ? arr * 512 * 64 : 4 * 512 * 64) + 8 * h;
            bf16_t* out = wsb(a, arr == 0 ? WF_OFF : arr == 1 ? WB2_OFF : arr == 2 ? AF_OFF : arr == 3 ? AB_OFF : G_OFF) + (size_t)t * 512 + 4 * h;
            const float* bias = (arr < 2) ? a.rwkv_w0 + (layer * 2 + arr) * 512 : a.rwkv_a0 + (layer * 2 + (arr & 1)) * 512;
#pragma unroll 1
            for (int nt = 0; nt < 16; ++nt) {
                f32x16 C;
#pragma unroll
                for (int i = 0; i < 16; ++i) C[i] = 0.f;
                const bf16_t* wr = wt + (size_t)(nt * 32 + r) * kw;
#pragma unroll
                for (int s = 0; s < 8; ++s) if (s < nk) { const bf16x8 A = *(const bf16x8*)(wr + 16 * s); C = MFMA32(A, xf[s], C); }
#pragma unroll
                for (int g = 0; g < 4; ++g) {
                    float o[4];
                    if (arr < 4) {
                        const f32x4 bv = *(const f32x4*)(bias + nt * 32 + 8 * g + 4 * h);
#pragma unroll
                        for (int j = 0; j < 4; ++j) { const float sg = sigmoidf_(C[4 * g + j] + bv[j]); o[j] = (arr < 2) ? __expf(-0.60653066f * sg) : sg; }
                    } else {
#pragma unroll
                        for (int j = 0; j < 4; ++j) o[j] = C[4 * g + j];
                    }
                    u32x2 pk; pk.x = pack2(o[0], o[1]); pk.y = pack2(o[2], o[3]);
                    *(u32x2*)(out + nt * 32 + 8 * g) = pk;
                }
            }
        }
    }
    {
        const int c16 = 16 * lane;
        bf16_t* dst = wsb(a, lane < 32 ? RS_OFF : KS_OFF) + (c16 & 511);
        for (int t = gw; t < T; t += nw) {
            const int pos = t & 4095; const bool hp = pos > 0, hn = pos < 4095;
            const bf16_t* up = U + (size_t)t * UW + c16;
            u32x4 o[2];
#pragma unroll
            for (int q = 0; q < 2; ++q) {
                const u32x4 c = *(const u32x4*)(up + 8 * q);
                u32x4 p = {0u, 0u, 0u, 0u}, n = {0u, 0u, 0u, 0u};
                if (hp) p = *(const u32x4*)(up - UW + 8 * q);
                if (hn) n = *(const u32x4*)(up + UW + 8 * q);
                const float* s0 = sw + c16 + 8 * q;
#pragma unroll
                for (int i = 0; i < 4; ++i) {
                    const float lo = s0[2 * i] * bflo(p[i]) + s0[UC + 2 * i] * bflo(c[i]) + s0[2 * UC + 2 * i] * bflo(n[i]);
                    const float hi = s0[2 * i + 1] * bfhi(p[i]) + s0[UC + 2 * i + 1] * bfhi(c[i]) + s0[2 * UC + 2 * i + 1] * bfhi(n[i]);
                    o[q][i] = pack2(lo, hi);
                }
            }
            *(u32x4*)(dst + (size_t)t * 512) = o[0]; *(u32x4*)(dst + (size_t)t * 512 + 8) = o[1];
        }
    }
}
DEV void ph_rwkv_prep2(const Args& a, int layer, const int tid0) {
    const int lane = tid0 & 63, wv = tid0 >> 6;
    const int gw = blockIdx.x * 8 + wv, nw = gridDim.x * 8;
    bf16_t* U = wsb(a, U_OFF); const bf16_t* KS = wsb(a, KS_OFF);
    const float* sw = a.rwkv_shift + (size_t)layer * 3 * UC;
    const int c8 = 8 * lane;
    float kkc[8], sv[3][8];
#pragma unroll
    for (int i = 0; i < 8; ++i) { kkc[i] = a.rwkv_k_k[layer * 512 + c8 + i]; sv[0][i] = sw[1024 + c8 + i]; sv[1][i] = sw[UC + 1024 + c8 + i]; sv[2][i] = sw[2 * UC + 1024 + c8 + i]; }
    for (int t = gw; t < T; t += nw) {
        const int pos = t & 4095; const bool hp = pos > 0, hn = pos < 4095;
        bf16_t* up = U + (size_t)t * UW;
        const u32x4 ks = *(const u32x4*)(KS + (size_t)t * 512 + c8);
        const u32x4 c = *(const u32x4*)(up + 1024 + c8);
        u32x4 p = {0u, 0u, 0u, 0u}, n = {0u, 0u, 0u, 0u};
        if (hp) p = *(const u32x4*)(up - UW + 1024 + c8);
        if (hn) n = *(const u32x4*)(up + UW + 1024 + c8);
        float kx[8]; float ss = 0.f;
#pragma unroll
        for (int i = 0; i < 4; ++i) { kx[2 * i] = bflo(ks[i]) * kkc[2 * i]; kx[2 * i + 1] = bfhi(ks[i]) * kkc[2 * i + 1]; ss += kx[2 * i] * kx[2 * i] + kx[2 * i + 1] * kx[2 * i + 1]; }
        const float inv = 1.0f / fmaxf(sqrtf(sum8(ss)), 1e-12f);
        u32x4 ko, vo;
#pragma unroll
        for (int i = 0; i < 4; ++i) {
            ko[i] = pack2(kx[2 * i] * inv, kx[2 * i + 1] * inv);
            vo[i] = pack2(sv[0][2 * i] * bflo(p[i]) + sv[1][2 * i] * bflo(c[i]) + sv[2][2 * i] * bflo(n[i]), sv[0][2 * i + 1] * bfhi(p[i]) + sv[1][2 * i + 1] * bfhi(c[i]) + sv[2][2 * i + 1] * bfhi(n[i]));
        }
        *(u32x4*)(up + c8) = ko; *(u32x4*)(up + 1536 + c8) = vo;
    }
}

DEV void ph_scan2(const Args& a, int layer, float* lds, const int tid0) {
    const int tid = tid0, lane = tid & 63, wv = __builtin_amdgcn_readfirstlane(tid >> 6);
    const int dir = wv >> 2, w4 = wv & 3;
    float* vecs = lds;
    float* ybuf = lds + 2 * 12288;
    const bf16_t* U = wsb(a, U_OFF); const bf16_t* RS = wsb(a, RS_OFF); const bf16_t* KS = wsb(a, KS_OFF);
    const bf16_t* Wd = wsb(a, dir ? WB2_OFF : WF_OFF); const bf16_t* Ad = wsb(a, dir ? AB_OFF : AF_OFF);
    bf16_t* Uw = wsb(a, U_OFF);
    const int js = lane & 7, q = lane >> 3, r0 = 16 * w4 + 2 * q;
    for (int un = blockIdx.x; un < NSEQ * 8; un += gridDim.x) {
        const int seq = un >> 3, hd = un & 7; const size_t tb = (size_t)seq * 4096; const int cb = hd * 64, pch = cb + lane;
        const float kac = a.rwkv_k_a[layer * 512 + pch];
        f32x2 S0[4], S1[4];
#pragma unroll
        for (int i = 0; i < 4; ++i) { S0[i] = (f32x2){0.f, 0.f}; S1[i] = (f32x2){0.f, 0.f}; }
        unsigned short pr[4][6];
#define SCAN_ISSUE(blk_) do { _Pragma("unroll") for (int si = 0; si < 4; ++si) { const int step_ = (blk_) * 16 + w4 * 4 + si, pos_ = dir ? 4095 - step_ : step_; const size_t t_ = tb + pos_; \
            pr[si][0] = Wd[t_ * 512 + pch]; pr[si][1] = U[t_ * UW + pch]; pr[si][2] = Ad[t_ * 512 + pch]; pr[si][3] = KS[t_ * 512 + pch]; pr[si][4] = RS[t_ * 512 + pch]; pr[si][5] = U[t_ * UW + 1536 + pch]; } } while (0)
#define SCAN_COMMIT(buf_) do { _Pragma("unroll") for (int si = 0; si < 4; ++si) { float* o_ = vecs + (((buf_) * 2 + dir) * 16 + w4 * 4 + si) * 384 + lane; \
            const float w_ = bf2f(pr[si][0]), kk_ = bf2f(pr[si][1]), av_ = bf2f(pr[si][2]), ks_ = bf2f(pr[si][3]); \
            o_[0] = w_; o_[64] = -kk_; o_[128] = kk_ * av_; o_[192] = ks_ * (1.0f + (av_ - 1.0f) * kac); o_[256] = bf2f(pr[si][4]); o_[320] = bf2f(pr[si][5]); } } while (0)
        __syncthreads();
        SCAN_ISSUE(0); SCAN_COMMIT(0);
        __syncthreads();
        for (int blk = 0; blk < 256; ++blk) {
            const int cur = blk & 1;
            if (blk + 1 < 256) SCAN_ISSUE(blk + 1);
            const float* vb0 = vecs + ((cur * 2 + dir) * 16) * 384;
            float* yb = ybuf + ((cur * 2 + dir) * 16) * 64 + r0;
#pragma unroll
            for (int s = 0; s < 16; ++s) {
                if (s == 8 && blk + 1 < 256) SCAN_COMMIT(cur ^ 1);
                const float* vb = vb0 + s * 384 + 8 * js;
                const f32x4 w0 = *(const f32x4*)(vb), w1 = *(const f32x4*)(vb + 4);
                const f32x4 a0 = *(const f32x4*)(vb + 64), a1 = *(const f32x4*)(vb + 68);
                const f32x4 b0 = *(const f32x4*)(vb + 128), b1 = *(const f32x4*)(vb + 132);
                const f32x4 k0 = *(const f32x4*)(vb + 192), k1 = *(const f32x4*)(vb + 196);
                const f32x4 q0 = *(const f32x4*)(vb + 256), q1 = *(const f32x4*)(vb + 260);
                const f32x2 v2 = *(const f32x2*)(vb0 + s * 384 + 320 + r0);
                const f32x2 av[4] = {{a0[0], a0[1]}, {a0[2], a0[3]}, {a1[0], a1[1]}, {a1[2], a1[3]}};
                const f32x2 wv2[4] = {{w0[0], w0[1]}, {w0[2], w0[3]}, {w1[0], w1[1]}, {w1[2], w1[3]}};
                const f32x2 bv[4] = {{b0[0], b0[1]}, {b0[2], b0[3]}, {b1[0], b1[1]}, {b1[2], b1[3]}};
                const f32x2 kv[4] = {{k0[0], k0[1]}, {k0[2], k0[3]}, {k1[0], k1[1]}, {k1[2], k1[3]}};
                const f32x2 qv[4] = {{q0[0], q0[1]}, {q0[2], q0[3]}, {q1[0], q1[1]}, {q1[2], q1[3]}};
                f32x2 t0 = S0[0] * av[0] + S0[1] * av[1], t1 = S0[2] * av[2] + S0[3] * av[3];
                f32x2 u0 = S1[0] * av[0] + S1[1] * av[1], u1 = S1[2] * av[2] + S1[3] * av[3];
                t0 = t0 + t1; u0 = u0 + u1;
                const float sa0 = sum8(t0[0] + t0[1]), sa1 = sum8(u0[0] + u0[1]);
                f32x2 y0 = {0.f, 0.f}, y1 = {0.f, 0.f};
#pragma unroll
                for (int i = 0; i < 4; ++i) {
                    S0[i] = S0[i] * wv2[i] + (bv[i] * sa0 + kv[i] * v2[0]);
                    S1[i] = S1[i] * wv2[i] + (bv[i] * sa1 + kv[i] * v2[1]);
                    y0 = y0 + S0[i] * qv[i]; y1 = y1 + S1[i] * qv[i];
                }
                const float ys0 = sum8(y0[0] + y0[1]), ys1 = sum8(y1[0] + y1[1]);
                if (js == 0) { f32x2 yo; yo[0] = ys0; yo[1] = ys1; *(f32x2*)(yb + s * 64) = yo; }
            }
            __syncthreads();
            {
                const int d2 = tid >> 8, s2 = (tid >> 4) & 15, c4 = (tid & 15) * 4;
                const f32x4 yv = *(const f32x4*)(ybuf + ((cur * 2 + d2) * 16 + s2) * 64 + c4);
                const int step = blk * 16 + s2, pos = d2 ? 4095 - step : step;
                u32x2 pk; pk.x = pack2(yv[0], yv[1]); pk.y = pack2(yv[2], yv[3]);
                *(u32x2*)(Uw + (tb + pos) * UW + 512 + 512 * d2 + cb + c4) = pk;
            }
        }
#undef SCAN_ISSUE
#undef SCAN_COMMIT
    }
}

DEV void ph_post2(const Args& a, int layer, const int tid0) {
    const int lane = tid0 & 63, wv = tid0 >> 6;
    const int gw = blockIdx.x * 8 + wv, nw = gridDim.x * 8;
    const bf16_t* U = wsb(a, U_OFF); const bf16_t* RS = wsb(a, RS_OFF); const bf16_t* KS = wsb(a, KS_OFF); const bf16_t* G = wsb(a, G_OFF);
    const bf16_t* AF = wsb(a, AF_OFF); const bf16_t* AB = wsb(a, AB_OFF); bf16_t* mix = wsb(a, MIX_OFF);
    const int c8 = 8 * lane;
    float kac[8], rkc[8], lnw[8], lnb[8];
#pragma unroll
    for (int i = 0; i < 8; ++i) { kac[i] = a.rwkv_k_a[layer * 512 + c8 + i]; rkc[i] = a.rwkv_r_k[layer * 512 + c8 + i]; lnw[i] = a.rwkv_ln_w[layer * 512 + c8 + i]; lnb[i] = a.rwkv_ln_b[layer * 512 + c8 + i]; }
    for (int t = gw; t < T; t += nw) {
        const bf16_t* up = U + (size_t)t * UW;
        const u32x4 rp = *(const u32x4*)(RS + (size_t)t * 512 + c8), kp = *(const u32x4*)(KS + (size_t)t * 512 + c8), gp = *(const u32x4*)(G + (size_t)t * 512 + c8);
        const u32x4 afp = *(const u32x4*)(AF + (size_t)t * 512 + c8), abp = *(const u32x4*)(AB + (size_t)t * 512 + c8);
        const u32x4 yfp = *(const u32x4*)(up + 512 + c8), ybp = *(const u32x4*)(up + 1024 + c8), vp = *(const u32x4*)(up + 1536 + c8);
        float y[8], rr[8], kk[8], vv[8], gg[8], sa[8];
#pragma unroll
        for (int i = 0; i < 4; ++i) {
            y[2 * i] = bflo(yfp[i]) + bflo(ybp[i]); y[2 * i + 1] = bfhi(yfp[i]) + bfhi(ybp[i]);
            rr[2 * i] = bflo(rp[i]); rr[2 * i + 1] = bfhi(rp[i]); kk[2 * i] = bflo(kp[i]); kk[2 * i + 1] = bfhi(kp[i]);
            vv[2 * i] = bflo(vp[i]); vv[2 * i + 1] = bfhi(vp[i]); gg[2 * i] = bflo(gp[i]); gg[2 * i + 1] = bfhi(gp[i]);
            sa[2 * i] = bflo(afp[i]) + bflo(abp[i]); sa[2 * i + 1] = bfhi(afp[i]) + bfhi(abp[i]);
        }
        float ysum = 0.f, bs = 0.f;
#pragma unroll
        for (int i = 0; i < 8; ++i) { ysum += y[i]; bs += rr[i] * kk[i] * (2.0f + (sa[i] - 2.0f) * kac[i]) * rkc[i]; }
        const float mu = sum8(ysum) * (1.0f / 64.0f);
        float vs = 0.f;
#pragma unroll
        for (int i = 0; i < 8; ++i) { y[i] -= mu; vs += y[i] * y[i]; }
        const float rstdv = rsqrtf(sum8(vs) * (1.0f / 64.0f) + 64e-5f);
        bs = sum8(bs);
        float o[8];
#pragma unroll
        for (int i = 0; i < 8; ++i) o[i] = (y[i] * rstdv * lnw[i] + lnb[i] + bs * vv[i]) * gg[i];
        u32x4 ov; ov.x = pack2(o[0], o[1]); ov.y = pack2(o[2], o[3]); ov.z = pack2(o[4], o[5]); ov.w = pack2(o[6], o[7]);
        *(u32x4*)(mix + (size_t)t * 1024 + 512 + c8) = ov;
    }
}

extern __shared__ __attribute__((aligned(16))) unsigned char smem[];

enum { PH_PROLOGUE = 0, PH_ROWPREP_X, PH_ROWPREP, PH_GEMM1, PH_ATTN, PH_MERGE, PH_LORA, PH_PREP2, PH_SCAN, PH_POST, PH_GEMM2, PH_CONVERT, PH_GEMM3, PH_TOPK, PH_PEER, PH_GEMM4A, PH_GEMM4B, PH_FINAL };

template <int PH> DEV void run_phase(const Args& a, int layer, const int tid0) {
    float* ldsf = (float*)smem;
    PG8_LAS unsigned char* ldsg = (PG8_LAS unsigned char*)smem;
    const bf16_t* wb = wsb(a, WB_OFF + (size_t)layer * WB_LAYER);
    if constexpr (PH == PH_PROLOGUE) ph_prologue(a, ldsf, tid0);
    else if constexpr (PH == PH_ROWPREP_X) ph_rowprep(a, true, tid0);
    else if constexpr (PH == PH_ROWPREP) ph_rowprep(a, false, tid0);
    else if constexpr (PH == PH_GEMM1) {
        pg8::Gemm g{wsb(a, HB_OFF), wb + WB_IN / 2, T, INP, 1024};
        pg8::StaticOrder S; S.init(T, INP, gridDim.x, blockIdx.x);
        pg8::EpiProj E{wsb(a, QKV_OFF), wsb(a, U_OFF), wsf(a, RSTD_OFF), wsf(a, ROPEC_OFF), wsf(a, ROPES_OFF)};
        pg8::gemm_phase<pg8::EpiProj, pg8::StaticOrder, false>(ldsg, g, S, E, nullptr, tid0);
    }
    else if constexpr (PH == PH_ATTN) ph_attn2(a, smem, tid0);
    else if constexpr (PH == PH_MERGE) ph_attn_merge(a, layer, tid0);
    else if constexpr (PH == PH_LORA) ph_rwkv_prep1(a, layer, tid0);
    else if constexpr (PH == PH_PREP2) ph_rwkv_prep2(a, layer, tid0);
    else if constexpr (PH == PH_SCAN) ph_scan2(a, layer, ldsf, tid0);
    else if constexpr (PH == PH_POST) ph_post2(a, layer, tid0);
    else if constexpr (PH == PH_GEMM2) {
        pg8::Gemm g{wsb(a, MIX_OFF), wb + WB_OUT / 2, T, 1024, 1024};
        pg8::StaticOrder S; S.init(T, 1024, gridDim.x, blockIdx.x);
        pg8::EpiF32x<1> E{a.h, 1024, nullptr};
        pg8::gemm_phase<pg8::EpiF32x<1>, pg8::StaticOrder, false>(ldsg, g, S, E, nullptr, tid0);
    }
    else if constexpr (PH == PH_CONVERT) ph_convert8(a, layer, tid0);
    else if constexpr (PH == PH_GEMM3) {
        pg8::Gemm g{wsb(a, HB_OFF), wb + WB_QK / 2, T, 2048, 1024};
        pg8::StaticOrder S; S.init(T, 2048, gridDim.x, blockIdx.x);
        pg8::EpiF32x<0> E{wsf(a, SC_OFF), 2048, nullptr};
        pg8::gemm_phase<pg8::EpiF32x<0>, pg8::StaticOrder, false>(ldsg, g, S, E, nullptr, tid0);
    }
    else if constexpr (PH == PH_TOPK) ph_topk2(a, ldsf, tid0);
    else if constexpr (PH == PH_PEER) ph_peer8(a, tid0);
    else if constexpr (PH == PH_GEMM4A) {
        pg8::Gemm g{wsb(a, HB_OFF), wb + WB_GATE / 2, T, 1024, 1024};
        pg8::StaticOrder S; S.init(T, 1024, gridDim.x, blockIdx.x);
        pg8::EpiGate E{wsb(a, GATE_OFF), wsf(a, RSTD_OFF), a.ple_b_gate + layer * 1024};
        pg8::gemm_phase<pg8::EpiGate, pg8::StaticOrder, false>(ldsg, g, S, E, nullptr, tid0);
    }
    else if constexpr (PH == PH_GEMM4B) {
        pg8::Gemm g{wsb(a, PB_OFF), wb + WB_PROJ / 2, T, 1024, 256};
        pg8::StaticOrder S; S.init(T, 1024, gridDim.x, blockIdx.x);
        pg8::EpiF32x<2> E{a.h, 1024, wsb(a, GATE_OFF)};
        pg8::gemm_phase<pg8::EpiF32x<2>, pg8::StaticOrder, false>(ldsg, g, S, E, nullptr, tid0);
    }
    else if constexpr (PH == PH_FINAL) ph_final(a, tid0);
}

#if !ONE_LAUNCH
template <int PH> __global__ void __launch_bounds__(NTHR, 2) k_phase(Args a, int layer) { run_phase<PH>(a, layer, (int)threadIdx.x); }
#endif

#if ONE_LAUNCH
#ifndef REP_SCAN
#define REP_SCAN 1
#endif
#ifndef REP_TOPK
#define REP_TOPK 1
#endif
#ifndef REP_GEMM1
#define REP_GEMM1 1
#endif
#ifndef REP_LORA
#define REP_LORA 1
#endif
#ifndef REP_POST
#define REP_POST 1
#endif
#ifndef REP_ATTN
#define REP_ATTN 1
#endif
#ifndef REP_GEMM3
#define REP_GEMM3 1
#endif
typedef const __attribute__((address_space(4))) unsigned long long* kargs_t;
static_assert(sizeof(Args) == 31 * 8, "Args is 31 pointers, no padding");
#define AS1 __attribute__((address_space(1)))
DEV Args load_args(kargs_t kp) {
    Args r; const float** d = (const float**)&r;
#pragma unroll
    for (int i = 0; i < 29; ++i) d[i] = (const float*)(AS1 const float*)kp[i];
    r.h = (float*)(AS1 float*)kp[29]; r.ws = (unsigned char*)(AS1 unsigned char*)kp[30];
    return r; }
#define RUN(PH, layer) do { kargs_t kp_ = (kargs_t)__builtin_amdgcn_kernarg_segment_ptr(); asm volatile("" : "+s"(kp_)); const Args la_ = load_args(kp_); int t_; asm volatile("v_mbcnt_lo_u32_b32 %0, -1, 0\n\tv_mbcnt_hi_u32_b32 %0, -1, %0\n\tv_lshl_add_u32 %0, %1, 6, %0" : "=&v"(t_) : "s"(wv0_)); run_phase<PH>(la_, layer, t_); } while (0)
#define BAR() do { kargs_t kp_ = (kargs_t)__builtin_amdgcn_kernarg_segment_ptr(); asm volatile("" : "+s"(kp_)); XcdBarrier b_; b_.bar = (unsigned*)((unsigned char*)kp_[30] + BAR_OFF); b_.x = xb_xcc_id(); b_.st = (volatile LAS unsigned*)(smem + LDS_BYTES - 16); int t_; asm volatile("v_mbcnt_lo_u32_b32 %0, -1, 0\n\tv_mbcnt_hi_u32_b32 %0, -1, %0\n\tv_lshl_add_u32 %0, %1, 6, %0" : "=&v"(t_) : "s"(wv0_)); xcd_barrier(b_, t_); } while (0)
__global__ void __launch_bounds__(NTHR, 2) k_mega(Args a) {
    if (threadIdx.x == 0) *(uint4*)(smem + LDS_BYTES - 16) = make_uint4(0u, 0u, 0u, 0u);
    __syncthreads();
    (void)xcd_barrier_post((unsigned*)(a.ws + BAR_OFF), (volatile LAS unsigned*)(smem + LDS_BYTES - 16));
    const int wv0_ = __builtin_amdgcn_readfirstlane((int)threadIdx.x >> 6);
    RUN(PH_PROLOGUE, 0);
    RUN(PH_ROWPREP_X, 0); BAR();
    for (int layer = 0; layer < NL; ++layer) {
        if (layer > 0) { RUN(PH_ROWPREP, layer); BAR(); }
        for (int rep_ = 0; rep_ < REP_GEMM1; ++rep_) { RUN(PH_GEMM1, layer); BAR(); }
        for (int rep_ = 0; rep_ < REP_ATTN; ++rep_) { RUN(PH_ATTN, layer); BAR(); RUN(PH_MERGE, layer); BAR(); }
        for (int rep_ = 0; rep_ < REP_LORA; ++rep_) { RUN(PH_LORA, layer); BAR(); }
        RUN(PH_PREP2, layer); BAR();
        for (int rep_ = 0; rep_ < REP_SCAN; ++rep_) { RUN(PH_SCAN, layer); BAR(); }
        for (int rep_ = 0; rep_ < REP_POST; ++rep_) { RUN(PH_POST, layer); BAR(); }
        RUN(PH_GEMM2, layer); BAR();
        RUN(PH_ROWPREP, layer); RUN(PH_CONVERT, layer); BAR();
        for (int rep_ = 0; rep_ < REP_GEMM3; ++rep_) { RUN(PH_GEMM3, layer); BAR(); }
        for (int rep_ = 0; rep_ < REP_TOPK; ++rep_) { RUN(PH_TOPK, layer); BAR(); }
        RUN(PH_PEER, layer); BAR();
        RUN(PH_GEMM4A, layer); BAR();
        RUN(PH_GEMM4B, layer); BAR();
    }
    RUN(PH_FINAL, 0);
}
#endif

#if !ONE_LAUNCH
template <int PH> static void launch_phase(const Args& a, int layer, hipStream_t st) {
    static bool attr = false;
    if (!attr) { (void)hipFuncSetAttribute((const void*)k_phase<PH>, hipFuncAttributeMaxDynamicSharedMemorySize, LDS_BYTES); attr = true; }
    hipLaunchKernelGGL(k_phase<PH>, dim3(NWG), dim3(NTHR), LDS_BYTES, st, a, layer);
}
#endif

extern "C" void kernel_launch(void* const* d_in, const int* in_sizes, int n_in, void* d_out, int out_size, void* d_ws, size_t ws_size, hipStream_t stream) {
    if (n_in != 29 || out_size != T * D || ws_size < WS_END) {
        fprintf(stderr, "kernel_launch: unexpected shapes (n_in %d, out %d, ws %zu, need %zu); nothing launched\n", n_in, out_size, ws_size, (size_t)WS_END);
        return;
    }
    Args a{};
    const float** ap = (const float**)&a;
    for (int i = 0; i < 29; ++i) ap[i] = (const float*)d_in[i];
    a.h = (float*)d_out; a.ws = (unsigned char*)d_ws;
#if ONE_LAUNCH
    static bool attr = false;
    if (!attr) { (void)hipFuncSetAttribute((const void*)k_mega, hipFuncAttributeMaxDynamicSharedMemorySize, LDS_BYTES); attr = true; }
    (void)hipMemsetAsync((char*)d_ws + BAR_OFF, 0, XCD_BAR_WORDS * sizeof(unsigned), stream);
    hipLaunchKernelGGL(k_mega, dim3(NWG), dim3(NTHR), LDS_BYTES, stream, a);
#else
    launch_phase<PH_PROLOGUE>(a, 0, stream);
    launch_phase<PH_ROWPREP_X>(a, 0, stream);
    for (int layer = 0; layer < NL; ++layer) {
        if (layer > 0) launch_phase<PH_ROWPREP>(a, layer, stream);
        launch_phase<PH_GEMM1>(a, layer, stream);
        launch_phase<PH_ATTN>(a, layer, stream);
        launch_phase<PH_MERGE>(a, layer, stream);
        launch_phase<PH_LORA>(a, layer, stream);
        launch_phase<PH_PREP2>(a, layer, stream);
        launch_phase<PH_SCAN>(a, layer, stream);
        launch_phase<PH_POST>(a, layer, stream);
        launch_phase<PH_GEMM2>(a, layer, stream);
        launch_phase<PH_ROWPREP>(a, layer, stream);
        launch_phase<PH_CONVERT>(a, layer, stream);
        launch_phase<PH_GEMM3>(a, layer, stream);
        launch_phase<PH_TOPK>(a, layer, stream);
        launch_phase<PH_PEER>(a, layer, stream);
        launch_phase<PH_GEMM4A>(a, layer, stream);
        launch_phase<PH_GEMM4B>(a, layer, stream);
    }
    launch_phase<PH_FINAL>(a, 0, stream);
#endif
}
```

```cpp
#include <hip/hip_runtime.h>
#include <stdint.h>
#include <stdio.h>

#ifndef ONE_LAUNCH
#define ONE_LAUNCH 1
#endif

typedef unsigned short bf16_t;
typedef float f32x4 __attribute__((ext_vector_type(4)));
typedef float f32x2 __attribute__((ext_vector_type(2)));
typedef unsigned u32x4 __attribute__((ext_vector_type(4)));
typedef unsigned u32x2 __attribute__((ext_vector_type(2)));
typedef __bf16 bf16x2_t __attribute__((ext_vector_type(2)));

#define DEV __device__ __forceinline__

namespace cfg {
constexpr int NSEQ = 20, SEQ = 4096, T = NSEQ * SEQ, TP = 4 * SEQ, D = 1024, NL = 4;
constexpr int INC = 3456, INP = 3584;
constexpr int QKVW = 1536, UW = 2048, UC = 1920;
constexpr int NWG = 256, NTHR = 512;
constexpr int LDS_BYTES = 147456;
constexpr size_t MiB = 1ull << 20;
constexpr size_t WB_OFF = 0;
constexpr size_t WB_LAYER = 16 * MiB;
constexpr size_t WB_IN = 0, WB_OUT = 7 * MiB, WB_QK = 9 * MiB, WB_GATE = 13 * MiB, WB_PROJ = 15 * MiB, WB_LORA = 15 * MiB + 512 * 1024;
constexpr size_t HB_OFF = 64 * MiB;
constexpr size_t MIX_OFF = 224 * MiB;
constexpr size_t SMALL_OFF = 384 * MiB;
constexpr size_t RSTD_OFF = SMALL_OFF;
constexpr size_t ROPEC_OFF = SMALL_OFF + 512 * 1024, ROPES_OFF = SMALL_OFF + 640 * 1024;
constexpr size_t BAR_OFF = SMALL_OFF + 1 * MiB;
constexpr size_t BIG_OFF = 386 * MiB;
constexpr size_t QKV_OFF = BIG_OFF;
constexpr size_t RS_OFF = BIG_OFF, KS_OFF = BIG_OFF + 80 * MiB, G_OFF = BIG_OFF + 160 * MiB;
constexpr size_t U_OFF = BIG_OFF + 240 * MiB;
constexpr size_t WF_OFF = BIG_OFF + 560 * MiB, WB2_OFF = BIG_OFF + 640 * MiB, AF_OFF = BIG_OFF + 720 * MiB, AB_OFF = BIG_OFF + 800 * MiB;
constexpr size_t OP_OFF = BIG_OFF + 560 * MiB;
constexpr size_t ML_OFF = BIG_OFF + 800 * MiB;
constexpr size_t SC_OFF = BIG_OFF;
constexpr size_t TOPI_OFF = BIG_OFF + 640 * MiB, TOPG_OFF = BIG_OFF + 680 * MiB;
constexpr size_t PTU_OFF = BIG_OFF + 720 * MiB, PTV_OFF = BIG_OFF + 752 * MiB;
constexpr size_t PB_OFF = BIG_OFF + 784 * MiB;
constexpr size_t GATE_OFF = BIG_OFF;
constexpr size_t SSQ_OFF = BIG_OFF + 880 * MiB;
constexpr size_t WS_END = BIG_OFF + 886 * MiB;
}
using namespace cfg;

struct Args {
    const float* x_prompt; const float* x_sample; const float* p_prompt; const float* p_sample;
    const float* norm_mix_g; const float* w_in; const float* att_norm_g; const float* rwkv_shift;
    const float* rwkv_w0; const float* rwkv_w2; const float* rwkv_a0; const float* rwkv_a2; const float* rwkv_g2;
    const float* rwkv_k_k; const float* rwkv_k_a; const float* rwkv_r_k; const float* rwkv_ln_w; const float* rwkv_ln_b;
    const float* w_out; const float* norm_ffn_g; const float* peer_w_q; const float* peer_sub_keys; const float* peer_u; const float* peer_v;
    const float* ple_norm_g; const float* ple_w_gate; const float* ple_b_gate; const float* ple_w_proj; const float* final_norm_g;
    float* h;
    unsigned char* ws;
};

DEV int tid_() { int t = threadIdx.x; asm volatile("" : "+v"(t)); return t; }
DEV float bf2f(unsigned h) { return __uint_as_float(h << 16); }
DEV float bflo(unsigned d) { return __uint_as_float(d << 16); }
DEV float bfhi(unsigned d) { return __uint_as_float(d & 0xffff0000u); }
DEV unsigned f2bf(float f) { const unsigned u = __float_as_uint(f); return (u + 0x7fffu + ((u >> 16) & 1u)) >> 16; }
DEV unsigned pack2(float lo, float hi) { return f2bf(lo) | (f2bf(hi) << 16); }
DEV float dot2bf(unsigned a, unsigned b, float c) { return __builtin_amdgcn_fdot2_f32_bf16(__builtin_bit_cast(bf16x2_t, a), __builtin_bit_cast(bf16x2_t, b), c, false); }
DEV float shx_(float v, int lane, int o) { return __int_as_float(__builtin_amdgcn_ds_bpermute((lane ^ o) << 2, __float_as_int(v))); }
DEV float shf_(float v, int src) { return __int_as_float(__builtin_amdgcn_ds_bpermute(src << 2, __float_as_int(v))); }
DEV int shf_(int v, int src) { return __builtin_amdgcn_ds_bpermute(src << 2, v); }
#define SHX(v, o) shx_((v), lane, (o))
#define SHF(v, src) shf_((v), (src))
DEV float wave_sum_(float v, int lane) {
#pragma unroll
    for (int o = 32; o > 0; o >>= 1) v += shx_(v, lane, o);
    return v;
}
DEV float wave_max_(float v, int lane) {
#pragma unroll
    for (int o = 32; o > 0; o >>= 1) v = fmaxf(v, shx_(v, lane, o));
    return v;
}
#define wave_sum(x) wave_sum_((x), lane)
#define wave_max(x) wave_max_((x), lane)
DEV float sum8(float v) {
    v += __int_as_float(__builtin_amdgcn_mov_dpp(__float_as_int(v), 0xB1, 0xF, 0xF, true));
    v += __int_as_float(__builtin_amdgcn_mov_dpp(__float_as_int(v), 0x4E, 0xF, 0xF, true));
    v += __int_as_float(__builtin_amdgcn_mov_dpp(__float_as_int(v), 0x141, 0xF, 0xF, true));
    return v;
}
DEV float rstd_parts(const float* ssq, int t) { const f32x4* p = (const f32x4*)(ssq + (size_t)t * 16); const f32x4 a = p[0], b = p[1], c = p[2], d = p[3];
    const float s = ((a[0] + a[1]) + (a[2] + a[3])) + ((b[0] + b[1]) + (b[2] + b[3])) + ((c[0] + c[1]) + (c[2] + c[3])) + ((d[0] + d[1]) + (d[2] + d[3]));
    return rsqrtf(s * (1.0f / 1024.0f) + 1e-6f); }
DEV float sigmoidf_(float x) { return 1.0f / (1.0f + __expf(-x)); }
namespace pg8 {
#define PG8_LAS __attribute__((address_space(3)))
typedef unsigned short bf16_t;
typedef short bf16x8 __attribute__((ext_vector_type(8)));
typedef float f32x4 __attribute__((ext_vector_type(4)));
typedef unsigned u32x4 __attribute__((ext_vector_type(4)));
constexpr int BM = 256, BK = 64, HALF = 128, HTB = HALF * BK * 2  , STAGE_BYTES = 8 * HTB, NXCD = 8, WGM = 8;

__host__ __device__ __forceinline__ int lds_byte(int r, int c) { const int st = (r >> 4) * 2 + (c >> 5), rr = r & 15, cc = c & 31, ob = rr * 64 + cc * 2; return st * 1024 + (ob ^ (((ob >> 9) & 1) << 5)); }
__host__ __device__ __forceinline__ void stage_rc(int b, int& R, int& C) { const int st = b / 1024, sb = b % 1024, swz = sb ^ (((sb >> 9) & 1) << 5); R = (st >> 1) * 16 + swz / 64; C = (st & 1) * 32 + (swz % 64) / 2; }
__host__ __device__ __forceinline__ int perm32(int rho) { const int n = rho >> 4, i = rho & 15; return 8 * (i >> 2) + 4 * n + (i & 3); }

struct Unit { int pm, pn; };
struct Gemm { const bf16_t* A; const bf16_t* Bt; int M, N, K; };

struct StaticOrder {
    int nM, nN, nwg, G, c;
    __host__ __device__ void init(int M, int N, int G_, int c_) { nM = M / BM; nN = N / BM; nwg = nM * nN; G = G_; c = c_; }
    __host__ __device__ bool next(int i, Unit& u) const {
        const long L = (long)i * G + c; if (L >= nwg) return false;
        int wgid = (int)L; { const int q = nwg / NXCD, r = nwg % NXCD, xcd = wgid % NXCD, off = wgid / NXCD; wgid = (xcd < r ? xcd * (q + 1) : r * (q + 1) + (xcd - r) * q) + off; }
        const int nig = WGM * nN, gid = wgid / nig, fm = gid * WGM, gsz = (nM - fm) < WGM ? (nM - fm) : WGM;
        u.pm = fm + ((wgid % nig) % gsz); u.pn = (wgid % nig) / gsz; return true;
    }
    __device__ __forceinline__ void a_ready(const Unit&) const {}
    __device__ __forceinline__ void done(const Unit&) const {}
};
__device__ __forceinline__ unsigned cvt_pk_bf16(float lo, float hi) { unsigned r; asm volatile("v_cvt_pk_bf16_f32 %0, %1, %2" : "=v"(r) : "v"(lo), "v"(hi)); return r; }

struct EpiProj {
    static constexpr bool PERM = true, AFTER_DRAIN = false;
    bf16_t* qkv; bf16_t* u; const float* ssq; const float* rc; const float* rs;
    __device__ __forceinline__ void operator()(const f32x4 (&acc)[2][2][4][2], const Unit& un, int wr, int wc, int fr, int fq) const {
        const int row0 = un.pm * BM + wr * 64 + fr, lane = fr + 16 * fq;
        const bool isq = un.pn < 6;
        bf16_t* base = isq ? qkv : u; const int ld = isq ? 1536 : 2048; const int colt = isq ? un.pn * BM : (un.pn - 6) * BM;
        const int col0 = colt + wc * 32 + 8 * fq;
        const bool rope = (un.pn < 4) && ((wc & 1) == 0);
#pragma unroll
        for (int ai = 0; ai < 2; ++ai)
#pragma unroll
            for (int m = 0; m < 4; ++m) {
                const int row = row0 + ai * HALF + m * 16; const float s = rstd_parts(ssq, row); const int pos = row & 4095;
                f32x4 c0 = {1.f, 1.f, 1.f, 1.f}, c1 = c0, s0 = {0.f, 0.f, 0.f, 0.f}, s1 = s0;
                if (rope) { c0 = *(const f32x4*)(rc + pos * 8); c1 = *(const f32x4*)(rc + pos * 8 + 4); s0 = *(const f32x4*)(rs + pos * 8); s1 = *(const f32x4*)(rs + pos * 8 + 4); }
                bf16_t* rowp = base + (size_t)row * ld + col0;
#pragma unroll
                for (int bj = 0; bj < 2; ++bj) {
                    f32x4 v0 = acc[ai][bj][m][0] * s, v1 = acc[ai][bj][m][1] * s;
                    if (rope) {
                        f32x4 o0, o1;
#pragma unroll
                        for (int c = 0; c < 4; ++c) { o0[c] = SHX(v0[c], 16); o1[c] = SHX(v1[c], 16); }
                        if (fq == 0) { v0 = v0 * c0 - o0 * s0; v1 = v1 * c1 - o1 * s1; }
                        else if (fq == 1) { v0 = v0 * c0 + o0 * s0; v1 = v1 * c1 + o1 * s1; }
                    }
                    u32x4 w; w.x = cvt_pk_bf16(v0[0], v0[1]); w.y = cvt_pk_bf16(v0[2], v0[3]); w.z = cvt_pk_bf16(v1[0], v1[1]); w.w = cvt_pk_bf16(v1[2], v1[3]);
                    *(u32x4*)(rowp + bj * HALF) = w;
                }
            }
    }
};
template <int MODE> struct EpiF32x {
    static constexpr bool PERM = false, AFTER_DRAIN = false;
    float* C; int ldc; const bf16_t* gate; bf16_t* hb; float* ssq;
    __device__ __forceinline__ void operator()(const f32x4 (&acc)[2][2][4][2], const Unit& un, int wr, int wc, int fr, int fq) const {
        const int row0 = un.pm * BM + wr * 64 + fr, col0 = un.pn * BM + wc * 32 + 4 * fq, lane = fr + 16 * fq;
#pragma unroll
        for (int ai = 0; ai < 2; ++ai)
#pragma unroll
            for (int m = 0; m < 4; ++m) {
                const int row = row0 + ai * HALF + m * 16;
                const size_t ro = (size_t)row * ldc + col0;
                if (MODE != 0) asm volatile("" ::: "memory");
                float ss = 0.f;
#pragma unroll
                for (int bj = 0; bj < 2; ++bj)
#pragma unroll
                    for (int n = 0; n < 2; ++n) {
                        if (MODE == 2 && (bj | n)) asm volatile("" ::: "memory");
                        f32x4* p = (f32x4*)(C + ro + bj * HALF + n * 16);
                        if (MODE == 0) *p = acc[ai][bj][m][n];
                        else {
                            f32x4 v;
                            if (MODE == 1) v = *p + acc[ai][bj][m][n];
                            else { const u32x2 g = *(const u32x2*)(gate + ro + bj * HALF + n * 16);
                                   f32x4 gv; gv[0] = __uint_as_float(g.x << 16); gv[1] = __uint_as_float(g.x & 0xffff0000u); gv[2] = __uint_as_float(g.y << 16); gv[3] = __uint_as_float(g.y & 0xffff0000u);
                                   v = *p + gv * acc[ai][bj][m][n]; }
                            *p = v;
                            ss += (v[0] * v[0] + v[1] * v[1]) + (v[2] * v[2] + v[3] * v[3]);
                            u32x2 pk; pk.x = cvt_pk_bf16(v[0], v[1]); pk.y = cvt_pk_bf16(v[2], v[3]);
                            *(u32x2*)(hb + ro + bj * HALF + n * 16) = pk;
                        }
                    }
                if (MODE != 0) {
                    ss += SHX(ss, 16); ss += SHX(ss, 32);
                    if (fq == 0) ssq[(size_t)row * 16 + un.pn * 4 + wc] = ss;
                }
            }
    }
};
struct EpiGate {
    static constexpr bool PERM = true, AFTER_DRAIN = false;
    bf16_t* O; const float* rstd; const float* bias;
    __device__ __forceinline__ void operator()(const f32x4 (&acc)[2][2][4][2], const Unit& un, int wr, int wc, int fr, int fq) const {
        const int row0 = un.pm * BM + wr * 64 + fr, col0 = un.pn * BM + wc * 32 + 8 * fq;
        f32x4 bv[2][2];
#pragma unroll
        for (int bj = 0; bj < 2; ++bj)
#pragma unroll
            for (int n = 0; n < 2; ++n) bv[bj][n] = *(const f32x4*)(bias + col0 + bj * HALF + 4 * n);
#pragma unroll
        for (int ai = 0; ai < 2; ++ai)
#pragma unroll
            for (int m = 0; m < 4; ++m) {
                const int row = row0 + ai * HALF + m * 16; const float s = rstd[row];
                bf16_t* rowp = O + (size_t)row * 1024 + col0;
#pragma unroll
                for (int bj = 0; bj < 2; ++bj) {
                    f32x4 v0 = acc[ai][bj][m][0] * s + bv[bj][0], v1 = acc[ai][bj][m][1] * s + bv[bj][1];
#pragma unroll
                    for (int c = 0; c < 4; ++c) { v0[c] = 1.0f / (1.0f + __expf(-v0[c])); v1[c] = 1.0f / (1.0f + __expf(-v1[c])); }
                    u32x4 w; w.x = cvt_pk_bf16(v0[0], v0[1]); w.y = cvt_pk_bf16(v0[2], v0[3]); w.z = cvt_pk_bf16(v1[0], v1[1]); w.w = cvt_pk_bf16(v1[2], v1[3]);
                    *(u32x4*)(rowp + bj * HALF) = w;
                }
            }
    }
};
template <class Epi, class Sched, bool STAMP = false>
__device__ __forceinline__ void gemm_phase(PG8_LAS unsigned char* lds, const Gemm g, const Sched& S, const Epi& E, unsigned long long* stamps, const int tid_in) {
    const int tid = tid_in, wid = __builtin_amdgcn_readfirstlane(tid >> 6), lane = tid & 63, wr = wid >> 2, wc = wid & 3, fr = lane & 15, fq = lane >> 4;
    const int K = g.K, nt = K / BK;
    int ts_lo = 0, ts_hi = 0, nts = 0; const unsigned long long rt_entry = STAMP ? (unsigned long long)wall_clock64() : 0ull;
#define PG8_STAMP() do { if (STAMP && wid == 0 && nts < 64) { const unsigned long long _c = (unsigned long long)clock64(); \
        ts_lo = (lane == nts) ? (int)(unsigned)_c : ts_lo; ts_hi = (lane == nts) ? (int)(unsigned)(_c >> 32) : ts_hi; ++nts; } } while (0)
    PG8_STAMP();
    unsigned voffA[2], voffB[2];
#pragma unroll
    for (int i = 0; i < 2; ++i) { int R, C; stage_rc(tid * 16 + i * 8192, R, C); const int Rb = Epi::PERM ? ((R & ~31) + perm32(R & 31)) : R;
        voffA[i] = (unsigned)(R * K + C) * 2u; voffB[i] = (unsigned)(Rb * K + C) * 2u; }
    const size_t kstep = (size_t)(BK * 2);
    const size_t hstep = (size_t)HALF * K * 2;
    const size_t tstep = 2 * hstep;
    const unsigned ldsw = (unsigned)wid * 1024u;
    const int aoff = lds_byte(wr * 64 + fr, fq * 8), boff = lds_byte(wc * 32 + fr, fq * 8);
#define PG8_SA(b, h) (((b) * 2 + (h)) * HTB)
#define PG8_SB(b, h) ((4 + (b) * 2 + (h)) * HTB)
#define PG8_STAGE(bufoff, gbase, voff) do { _Pragma("unroll") for (int _i = 0; _i < 2; ++_i) \
        __builtin_amdgcn_global_load_lds((const unsigned*)((const char*)(gbase) + (voff)[_i]), (PG8_LAS unsigned*)(lds + (bufoff) + ldsw + _i * 8192), 16, 0, 0); } while (0)
#define PG8_LDA(dst, b, h) do { _Pragma("unroll") for (int m = 0; m < 4; ++m) _Pragma("unroll") for (int k = 0; k < 2; ++k) dst[m][k] = *(const PG8_LAS bf16x8*)(lds + PG8_SA(b, h) + aoff + m * 2048 + k * 1024); } while (0)
#define PG8_LDB(dst, b, h) do { _Pragma("unroll") for (int n = 0; n < 2; ++n) _Pragma("unroll") for (int k = 0; k < 2; ++k) dst[n][k] = *(const PG8_LAS bf16x8*)(lds + PG8_SB(b, h) + boff + n * 2048 + k * 1024); } while (0)
#define PG8_MMA(ai, bj, At, Bt) do { __builtin_amdgcn_s_setprio(1); _Pragma("unroll") for (int m = 0; m < 4; ++m) _Pragma("unroll") for (int n = 0; n < 2; ++n) _Pragma("unroll") for (int k = 0; k < 2; ++k) \
        acc[ai][bj][m][n] = __builtin_amdgcn_mfma_f32_16x16x32_bf16(Bt[n][k], At[m][k], acc[ai][bj][m][n], 0, 0, 0); __builtin_amdgcn_s_setprio(0); } while (0)
#define PG8_WAIT_V(n) asm volatile("s_waitcnt vmcnt(" #n ")" ::: "memory")
#define PG8_WAIT_L(n) asm volatile("s_waitcnt lgkmcnt(" #n ")" ::: "memory")
#define PG8_BAR __builtin_amdgcn_s_barrier()
#define PG8_SCHED __builtin_amdgcn_sched_barrier(0)
    Unit cur, nxt; int ui = 0;
    if (!S.next(0, cur)) return;
    f32x4 acc[2][2][4][2];
#pragma unroll
    for (int a = 0; a < 2; ++a)
#pragma unroll
        for (int b = 0; b < 2; ++b)
#pragma unroll
            for (int m = 0; m < 4; ++m)
#pragma unroll
                for (int n = 0; n < 2; ++n) acc[a][b][m][n] = (f32x4){0.f, 0.f, 0.f, 0.f};
    bf16x8 At[4][2], B0[2][2], B1[2][2];
    const char* cA = (const char*)g.A + (size_t)cur.pm * tstep; const char* cB = (const char*)g.Bt + (size_t)cur.pn * tstep;
    S.a_ready(cur);
    PG8_STAGE(PG8_SB(0, 0), cB, voffB); PG8_STAGE(PG8_SA(0, 0), cA, voffA); PG8_STAGE(PG8_SB(0, 1), cB + hstep, voffB); PG8_STAGE(PG8_SA(0, 1), cA + hstep, voffA);
    if (wr == 1) PG8_BAR;
    PG8_WAIT_V(4); PG8_BAR;
    PG8_STAGE(PG8_SB(1, 0), cB + kstep, voffB); PG8_STAGE(PG8_SA(1, 0), cA + kstep, voffA); PG8_STAGE(PG8_SB(1, 1), cB + hstep + kstep, voffB);
    PG8_WAIT_V(6); PG8_BAR;
    PG8_STAMP();
    for (;;) {
        const bool has_next = S.next(ui + 1, nxt);
        const char* nA = has_next ? (const char*)g.A + (size_t)nxt.pm * tstep : cA; const char* nB = has_next ? (const char*)g.Bt + (size_t)nxt.pn * tstep : cB;
        for (int t = 0; t < nt; t += 2) {
            const bool last = (t == nt - 2);
            const char* a1 = cA + (size_t)(t + 1) * kstep;
            const char* a2 = last ? nA : cA + (size_t)(t + 2) * kstep; const char* b2 = last ? nB : cB + (size_t)(t + 2) * kstep;
            const char* a3 = a2 + kstep; const char* b3 = b2 + kstep;
            if (last && has_next) S.a_ready(nxt);
            PG8_LDB(B0, 0, 0); PG8_SCHED; PG8_LDA(At, 0, 0); PG8_STAGE(PG8_SA(1, 1), a1 + hstep, voffA);
            PG8_WAIT_L(8); PG8_BAR; PG8_WAIT_L(0); PG8_MMA(0, 0, At, B0); PG8_BAR; PG8_SCHED;
            PG8_LDB(B1, 0, 1); PG8_STAGE(PG8_SB(0, 0), b2, voffB);
            PG8_BAR; PG8_WAIT_L(0); PG8_MMA(0, 1, At, B1); PG8_BAR;
            PG8_LDA(At, 0, 1); PG8_STAGE(PG8_SA(0, 0), a2, voffA);
            PG8_BAR; PG8_WAIT_L(0); PG8_MMA(1, 0, At, B0); PG8_BAR; PG8_SCHED;
            PG8_STAGE(PG8_SB(0, 1), b2 + hstep, voffB);
            PG8_WAIT_V(6); PG8_BAR; PG8_MMA(1, 1, At, B1); PG8_BAR;
            PG8_LDB(B0, 1, 0); PG8_SCHED; PG8_LDA(At, 1, 0); PG8_STAGE(PG8_SA(0, 1), a2 + hstep, voffA);
            PG8_WAIT_L(8); PG8_BAR; PG8_WAIT_L(0); PG8_MMA(0, 0, At, B0); PG8_BAR; PG8_SCHED;
            PG8_LDB(B1, 1, 1); PG8_STAGE(PG8_SB(1, 0), b3, voffB);
            PG8_BAR; PG8_WAIT_L(0); PG8_MMA(0, 1, At, B1); PG8_BAR;
            PG8_LDA(At, 1, 1); PG8_STAGE(PG8_SA(1, 0), a3, voffA);
            PG8_BAR; PG8_WAIT_L(0); PG8_MMA(1, 0, At, B0); PG8_BAR; PG8_SCHED;
            PG8_STAGE(PG8_SB(1, 1), b3 + hstep, voffB);
            PG8_WAIT_V(6); PG8_BAR; PG8_MMA(1, 1, At, B1); PG8_BAR;
        }
        PG8_STAMP();
        if constexpr (!Epi::AFTER_DRAIN) { E(acc, cur, wr, wc, fr, fq); S.done(cur); }
        PG8_STAMP();
        if (!has_next) break;
#pragma unroll
        for (int a = 0; a < 2; ++a)
#pragma unroll
            for (int b = 0; b < 2; ++b)
#pragma unroll
                for (int m = 0; m < 4; ++m)
#pragma unroll
                    for (int n = 0; n < 2; ++n) acc[a][b][m][n] = (f32x4){0.f, 0.f, 0.f, 0.f};
        cur = nxt; cA = nA; cB = nB; ++ui;
    }
    PG8_WAIT_V(0);
    if (wr == 0) PG8_BAR;
    PG8_BAR;
    if constexpr (Epi::AFTER_DRAIN) { E.fused(acc, cur, wr, wc, fr, fq, lds, wid, lane); S.done(cur); }
    PG8_STAMP();
    if (STAMP && wid == 0) { stamps[lane] = lane < nts ? (((unsigned long long)(unsigned)ts_hi << 32) | (unsigned)ts_lo) : 0ull;
        if (lane == 62) stamps[62] = rt_entry; if (lane == 63) stamps[63] = (unsigned long long)wall_clock64(); }
#undef PG8_STAMP
#undef PG8_SA
#undef PG8_SB
#undef PG8_STAGE
#undef PG8_LDA
#undef PG8_LDB
#undef PG8_MMA
#undef PG8_WAIT_V
#undef PG8_WAIT_L
#undef PG8_BAR
#undef PG8_SCHED
}
}
#define XB_TMO      128
#define XB_XCNT(j)  (256  + 64 * (j))
#define XB_XSUB(j)  (1280 + 64 * (j))
#define XB_XGEN(j)  (2304 + 64 * (j))
#define XB_TOP      3328
#define XB_TOPGEN   3392
#define XCD_BAR_WORDS 3456
#define XB_SPIN_CAP (1u << 23)
#define LAS __attribute__((address_space(3)))

__device__ __forceinline__ unsigned xb_ld(unsigned* p)              { return __hip_atomic_load(p, __ATOMIC_RELAXED, __HIP_MEMORY_SCOPE_AGENT); }
__device__ __forceinline__ unsigned xb_add(unsigned* p, unsigned v) { return __hip_atomic_fetch_add(p, v, __ATOMIC_RELAXED, __HIP_MEMORY_SCOPE_AGENT); }
__device__ __forceinline__ unsigned xb_xcc_id() { return (unsigned)__builtin_amdgcn_s_getreg((3 << 11) | 20) & 0xFu; }
#define XB_SPIN(cond, bar) do { unsigned _sp = 0; while (cond) { __builtin_amdgcn_s_sleep(1); \
    if ((++_sp & 255u) == 0u) { if (xb_ld(&(bar)[XB_TMO])) break; if (_sp > XB_SPIN_CAP) { atomicAdd(&(bar)[XB_TMO], 1u); break; } } } } while (0)

struct XcdBarrier {
    unsigned* bar; unsigned x;
    volatile LAS unsigned* st;
};

__device__ __forceinline__ XcdBarrier xcd_barrier_post(unsigned* bar, volatile LAS unsigned* st) {
    XcdBarrier b; b.bar = bar; b.x = xb_xcc_id(); b.st = st;
    if (threadIdx.x == 0) (void)xb_add(&bar[XB_XCNT(b.x)], 1u);
    return b;
}
__device__ __forceinline__ void xcd_barrier_complete(unsigned* bar, unsigned x, unsigned& nloc, unsigned& nx) {
    const unsigned G = gridDim.x * gridDim.y * gridDim.z;
    unsigned sum, cnt, mine, sp = 0u;
    for (;;) {
        sum = 0u; cnt = 0u; mine = 0u;
#pragma unroll
        for (unsigned j = 0; j < 16; ++j) { const unsigned c = xb_ld(&bar[XB_XCNT(j)]); sum += c; cnt += (c > 0u) ? 1u : 0u; mine = (j == x) ? c : mine; }
        if (sum == G) break;
        __builtin_amdgcn_s_sleep(1);
        if ((++sp & 255u) == 0u) { if (xb_ld(&bar[XB_TMO])) break; if (sp > XB_SPIN_CAP) { atomicAdd(&bar[XB_TMO], 1u); break; } }
    }
    nloc = mine > 0u ? mine : 1u; nx = cnt > 0u ? cnt : 1u;
}

__device__ __forceinline__ void xcd_barrier(const XcdBarrier& b, const int tid) {
    asm volatile("s_waitcnt vmcnt(0)" ::: "memory");
    __syncthreads();
    if (tid == 0) {
        unsigned* bar = b.bar; unsigned bx = b.x;
        asm volatile("" : "+s"(bar), "+s"(bx));
        __builtin_amdgcn_s_waitcnt(0);
        unsigned nloc = b.st[0], nx = b.st[1];
        if (nloc == 0u) { xcd_barrier_complete(bar, bx, nloc, nx); b.st[0] = nloc; b.st[1] = nx; }
        const unsigned old = xb_add(&bar[XB_XSUB(bx)], 1u);
        const unsigned gen = old / nloc;
        if (old + 1u == (gen + 1u) * nloc) {
            __builtin_amdgcn_fence(__ATOMIC_RELEASE, "agent");
            asm volatile("s_waitcnt vmcnt(0)" ::: "memory");
            const unsigned og = xb_add(&bar[XB_TOP], 1u);
            const unsigned tg = og / nx;
            if (og + 1u == (tg + 1u) * nx) xb_add(&bar[XB_TOPGEN], 1u);
            else XB_SPIN(xb_ld(&bar[XB_TOPGEN]) == tg, bar);
            __builtin_amdgcn_fence(__ATOMIC_ACQUIRE, "agent");
            xb_add(&bar[XB_XGEN(bx)], 1u);
            asm volatile("s_waitcnt vmcnt(0)" ::: "memory");
        } else {
            XB_SPIN(xb_ld(&bar[XB_XGEN(bx)]) == gen, bar);
            __builtin_amdgcn_fence(__ATOMIC_ACQUIRE, "agent");
            asm volatile("s_waitcnt vmcnt(0)" ::: "memory");
        }
    }
    __syncthreads();
}


typedef __attribute__((address_space(3))) unsigned char lds_u8;
extern __shared__ __attribute__((aligned(16))) unsigned char smem[];
DEV unsigned char* smem_base() { return smem; }

DEV bf16_t* wsb(const Args& a, size_t off) { return (bf16_t*)(a.ws + off); }
DEV float* wsf(const Args& a, size_t off) { return (float*)(a.ws + off); }

DEV void ph_rowprep(const Args& a, bool from_x, const int tid0) {
    const int lane = tid0 & 63, wv = tid0 >> 6;
    const int gw = blockIdx.x * 8 + wv, nw = gridDim.x * 8;
    bf16_t* hb = wsb(a, HB_OFF); float* ssq = wsf(a, SSQ_OFF);
    for (int t = gw; t < T; t += nw) {
        const float* src = from_x ? (t < TP ? a.x_prompt + (size_t)t * D : a.x_sample + (size_t)(t - TP) * D) : a.h + (size_t)t * D;
        f32x4 v[4]; float ss = 0.f;
#pragma unroll
        for (int i = 0; i < 4; ++i) { v[i] = *(const f32x4*)(src + (i * 64 + lane) * 4); ss += v[i][0] * v[i][0] + v[i][1] * v[i][1] + v[i][2] * v[i][2] + v[i][3] * v[i][3]; }
        ss = wave_sum(ss);
#pragma unroll
        for (int i = 0; i < 4; ++i) {
            if (from_x) *(f32x4*)(a.h + (size_t)t * D + (i * 64 + lane) * 4) = v[i];
            u32x2 p; p.x = pack2(v[i][0], v[i][1]); p.y = pack2(v[i][2], v[i][3]);
            *(u32x2*)(hb + (size_t)t * D + (i * 64 + lane) * 4) = p;
        }
        if (lane < 16) ssq[(size_t)t * 16 + lane] = (lane == 0) ? ss : 0.f;
    }
}

DEV void ph_final(const Args& a, const int tid0) {
    const int lane = tid0 & 63, wv = tid0 >> 6;
    const int gw = blockIdx.x * 8 + wv, nw = gridDim.x * 8;
    for (int t = gw; t < T; t += nw) {
        float* row = a.h + (size_t)t * D;
        f32x4 v[4]; float ss = 0.f;
#pragma unroll
        for (int i = 0; i < 4; ++i) { v[i] = *(const f32x4*)(row + (i * 64 + lane) * 4); ss += v[i][0] * v[i][0] + v[i][1] * v[i][1] + v[i][2] * v[i][2] + v[i][3] * v[i][3]; }
        ss = wave_sum(ss);
        const float r = rsqrtf(ss * (1.0f / 1024.0f) + 1e-6f);
#pragma unroll
        for (int i = 0; i < 4; ++i) { const f32x4 g = *(const f32x4*)(a.final_norm_g + (i * 64 + lane) * 4); *(f32x4*)(row + (i * 64 + lane) * 4) = v[i] * r * g; }
    }
}

DEV void transpose_cvt(const float* __restrict__ src, bf16_t* __restrict__ dst, int K, int N, int Npad, const float* __restrict__ g, float* tile, const int tid0) {
    const int tx = tid0 & 63, ty = tid0 >> 6;
    const int tk = K / 64, tn = Npad / 64;
    for (int tl = blockIdx.x; tl < tk * tn; tl += gridDim.x) {
        const int k0 = (tl % tk) * 64, n0 = (tl / tk) * 64;
        __syncthreads();
        for (int i = ty; i < 64; i += 8) { const int k = k0 + i, n = n0 + tx; float v = (n < N) ? src[(size_t)k * N + n] : 0.f; if (g) v *= g[k]; tile[i * 65 + tx] = v; }
        __syncthreads();
        for (int i = ty; i < 64; i += 8) dst[(size_t)(n0 + i) * K + k0 + tx] = (bf16_t)f2bf(tile[tx * 65 + i]);
    }
}
DEV void fold_wqk(const Args& a, float* lds, const int tid0) {
    float* swq = lds;
    float* ssk = lds + 64 * 132;
    const int tid = tid0, key = tid & 127, kq = tid >> 7;
    for (int un = blockIdx.x; un < NL * 16 * 16; un += gridDim.x) {
        const int l = un >> 8, hp = (un >> 4) & 15, k0 = (un & 15) * 64;
        __syncthreads();
        for (int i = tid; i < 64 * 128; i += NTHR) { const int r = i >> 7, c = i & 127; swq[r * 132 + c] = a.peer_w_q[((size_t)l * 1024 + k0 + r) * 2048 + hp * 128 + c]; }
        for (int i = tid; i < 128 * 128; i += NTHR) { const int r = i >> 7, c = i & 127; ssk[r * 132 + c] = a.peer_sub_keys[(((size_t)l * 16 + hp) * 128 + r) * 128 + c]; }
        __syncthreads();
        float acc[16];
#pragma unroll
        for (int i = 0; i < 16; ++i) acc[i] = 0.f;
        for (int c = 0; c < 128; c += 4) {
            const f32x4 s = *(const f32x4*)(ssk + key * 132 + c);
#pragma unroll
            for (int i = 0; i < 16; ++i) { const f32x4 w = *(const f32x4*)(swq + (kq * 16 + i) * 132 + c); acc[i] += s[0] * w[0] + s[1] * w[1] + s[2] * w[2] + s[3] * w[3]; }
        }
        bf16_t* dst = wsb(a, WB_OFF + (size_t)l * WB_LAYER + WB_QK) + (size_t)(hp * 128 + key) * 1024 + k0 + kq * 16;
        const float* g = a.norm_ffn_g + l * 1024 + k0 + kq * 16;
#pragma unroll
        for (int i = 0; i < 16; i += 2) *(unsigned*)(dst + i) = pack2(acc[i] * g[i], acc[i + 1] * g[i + 1]);
    }
}
DEV void ph_prologue(const Args& a, float* lds, const int tid0) {
    { float* rc = wsf(a, ROPEC_OFF); float* rs = wsf(a, ROPES_OFF);
      for (int i = blockIdx.x * NTHR + tid0; i < 4096 * 8; i += gridDim.x * NTHR) {
          const int pos = i >> 3, f = i & 7;
          const float invf = (float)pow(500000.0, -(double)f / 8.0);
          const float ang = (float)pos * invf;
          rc[i] = (float)cos((double)ang); rs[i] = (float)sin((double)ang);
      } }
    for (int l = 0; l < NL; ++l) {
        bf16_t* wb = wsb(a, WB_OFF + (size_t)l * WB_LAYER);
        transpose_cvt(a.w_in + (size_t)l * 1024 * INC, wb + WB_IN / 2, 1024, INC, INP, a.norm_mix_g + l * 1024, lds, tid0);
        transpose_cvt(a.w_out + (size_t)l * 1024 * 1024, wb + WB_OUT / 2, 1024, 1024, 1024, nullptr, lds, tid0);
        transpose_cvt(a.ple_w_gate + (size_t)l * 1024 * 1024, wb + WB_GATE / 2, 1024, 1024, 1024, a.ple_norm_g + l * 1024, lds, tid0);
        transpose_cvt(a.ple_w_proj + (size_t)l * 256 * 1024, wb + WB_PROJ / 2, 256, 1024, 1024, nullptr, lds, tid0);
        for (int dr = 0; dr < 2; ++dr) {
            transpose_cvt(a.rwkv_w2 + (size_t)(l * 2 + dr) * 64 * 512, wb + WB_LORA / 2 + dr * 512 * 64, 64, 512, 512, nullptr, lds, tid0);
            transpose_cvt(a.rwkv_a2 + (size_t)(l * 2 + dr) * 64 * 512, wb + WB_LORA / 2 + (2 + dr) * 512 * 64, 64, 512, 512, nullptr, lds, tid0);
        }
        transpose_cvt(a.rwkv_g2 + (size_t)l * 128 * 512, wb + WB_LORA / 2 + 4 * 512 * 64, 128, 512, 512, nullptr, lds, tid0);
    }
    fold_wqk(a, lds, tid0);
}

DEV float sum16(float v) {
    v = sum8(v);
    v += __int_as_float(__builtin_amdgcn_mov_dpp(__float_as_int(v), 0x140, 0xF, 0xF, true));
    return v;
}
DEV float max16(float v) {
    v = fmaxf(v, __int_as_float(__builtin_amdgcn_mov_dpp(__float_as_int(v), 0xB1, 0xF, 0xF, true)));
    v = fmaxf(v, __int_as_float(__builtin_amdgcn_mov_dpp(__float_as_int(v), 0x4E, 0xF, 0xF, true)));
    v = fmaxf(v, __int_as_float(__builtin_amdgcn_mov_dpp(__float_as_int(v), 0x141, 0xF, 0xF, true)));
    v = fmaxf(v, __int_as_float(__builtin_amdgcn_mov_dpp(__float_as_int(v), 0x140, 0xF, 0xF, true)));
    return v;
}
DEV float rl(float v, int l) { return __int_as_float(__builtin_amdgcn_readlane(__float_as_int(v), l)); }
DEV float wave_sum_dpp(float v) { v = sum16(v); return (rl(v, 0) + rl(v, 16)) + (rl(v, 32) + rl(v, 48)); }
DEV unsigned fkey(float f) { const unsigned b = __float_as_uint(f); return b ^ ((unsigned)((int)b >> 31) | 0x80000000u); }
DEV int mbcnt64(unsigned long long m) { return (int)__builtin_amdgcn_mbcnt_hi((unsigned)(m >> 32), __builtin_amdgcn_mbcnt_lo((unsigned)m, 0u)); }

DEV void ph_topk2(const Args& a, float* lds, const int tid0, const int gw, const int nw, const int NP) {
    const int lane = tid0 & 63, wv = __builtin_amdgcn_readfirstlane(tid0 >> 6);
    float* tvb = lds + wv * 64; int* tib = (int*)(lds + 8 * 64) + wv * 64;
    const float* SC = wsf(a, SC_OFF); int* TOPI = (int*)(a.ws + TOPI_OFF); float* TOPG = wsf(a, TOPG_OFF); const float* ssq = wsf(a, SSQ_OFF);
    float vn[2][4];
    if (gw < NP) {
#pragma unroll
        for (int u = 0; u < 2; ++u)
#pragma unroll
            for (int i = 0; i < 4; ++i) vn[u][i] = SC[(size_t)gw * 512 + u * 256 + i * 64 + lane];
    }
    for (int up = gw; up < NP; up += nw) {
        const int t = up >> 2, hd0 = (up & 3) * 2;
        float v[2][4]; unsigned k[2][4];
#pragma unroll
        for (int u = 0; u < 2; ++u)
#pragma unroll
            for (int i = 0; i < 4; ++i) { v[u][i] = vn[u][i]; k[u][i] = fkey(v[u][i]); }
        if (up + nw < NP) {
#pragma unroll
            for (int u = 0; u < 2; ++u)
#pragma unroll
                for (int i = 0; i < 4; ++i) vn[u][i] = SC[(size_t)(up + nw) * 512 + u * 256 + i * 64 + lane];
        }
        unsigned th[4] = {0u, 0u, 0u, 0u}; unsigned dm = 0u;
        for (int b = 31; b >= 0; --b) {
            const unsigned bit = 1u << b;
            unsigned long long ma[4], mb[4];
#pragma unroll
            for (int q = 0; q < 4; ++q) { const unsigned c = th[q] | bit; ma[q] = __ballot(k[q >> 1][2 * (q & 1)] >= c); mb[q] = __ballot(k[q >> 1][2 * (q & 1) + 1] >= c); }
#pragma unroll
            for (int q = 0; q < 4; ++q) {
                const int n = __builtin_popcountll(ma[q]) + __builtin_popcountll(mb[q]);
                th[q] = (n >= 16) ? (th[q] | bit) : th[q]; dm |= (n == 16) ? (1u << q) : 0u;
            }
            if (dm == 15u) break;
        }
#pragma unroll
        for (int q = 0; q < 4; ++q) {
            const int u = q >> 1, p = q & 1; const unsigned tp = th[q];
            const unsigned ka = k[u][2 * p], kb = k[u][2 * p + 1];
            const unsigned long long ga = __ballot(ka > tp), gb = __ballot(kb > tp), ea = __ballot(ka == tp), eb = __ballot(kb == tp);
            const int nga = __builtin_popcountll(ga), ng = nga + __builtin_popcountll(gb), need = 16 - ng, nea = __builtin_popcountll(ea);
            int pa = -1, pb = -1;
            if (ka > tp) pa = mbcnt64(ga); else if (ka == tp) { const int r = mbcnt64(ea); if (r < need) pa = ng + r; }
            if (kb > tp) pb = nga + mbcnt64(gb); else if (kb == tp) { const int r = nea + mbcnt64(eb); if (r < need) pb = ng + r; }
            if (pa >= 0) { tvb[q * 16 + pa] = v[u][2 * p]; tib[q * 16 + pa] = lane; }
            if (pb >= 0) { tvb[q * 16 + pb] = v[u][2 * p + 1]; tib[q * 16 + pb] = 64 + lane; }
        }
        float cv[2][4]; unsigned kc[2][4]; float mx[2];
#pragma unroll
        for (int u = 0; u < 2; ++u) {
#pragma unroll
            for (int s = 0; s < 4; ++s) { const int c = lane + 64 * s; cv[u][s] = tvb[u * 32 + (c >> 4)] + tvb[u * 32 + 16 + (c & 15)]; kc[u][s] = fkey(cv[u][s]); }
            const float m0 = max16(lane < 16 ? tvb[u * 32 + (lane & 15)] : -3.0e38f), m1 = max16(lane < 16 ? tvb[u * 32 + 16 + (lane & 15)] : -3.0e38f);
            mx[u] = rl(m0, 0) + rl(m1, 0);
        }
        unsigned t2[2] = {0u, 0u}; unsigned dm2 = 0u;
        for (int b = 31; b >= 0; --b) {
            const unsigned bit = 1u << b;
            unsigned long long mc[2][4];
#pragma unroll
            for (int u = 0; u < 2; ++u)
#pragma unroll
                for (int s4 = 0; s4 < 4; ++s4) mc[u][s4] = __ballot(kc[u][s4] >= (t2[u] | bit));
#pragma unroll
            for (int u = 0; u < 2; ++u) {
                const int n = (__builtin_popcountll(mc[u][0]) + __builtin_popcountll(mc[u][1])) + (__builtin_popcountll(mc[u][2]) + __builtin_popcountll(mc[u][3]));
                t2[u] = (n >= 16) ? (t2[u] | bit) : t2[u]; dm2 |= (n == 16) ? (1u << u) : 0u;
            }
            if (dm2 == 3u) break;
        }
        const float rs = rstd_parts(ssq, t);
#pragma unroll
        for (int u = 0; u < 2; ++u) {
            int pos[4]; int ng = 0;
#pragma unroll
            for (int s = 0; s < 4; ++s) { const unsigned long long g = __ballot(kc[u][s] > t2[u]); pos[s] = (kc[u][s] > t2[u]) ? ng + mbcnt64(g) : -1; ng += __builtin_popcountll(g); }
            int ne = 0; const int need = 16 - ng;
#pragma unroll
            for (int s = 0; s < 4; ++s) { const unsigned long long e = __ballot(kc[u][s] == t2[u]); if (kc[u][s] == t2[u]) { const int r = ne + mbcnt64(e); if (r < need) pos[s] = ng + r; } ne += __builtin_popcountll(e); }
            float ex[4]; float es = 0.f;
#pragma unroll
            for (int s = 0; s < 4; ++s) { ex[s] = (pos[s] >= 0) ? __expf(rs * (cv[u][s] - mx[u])) : 0.f; es += ex[s]; }
            const float inv = 1.0f / wave_sum_dpp(es);
#pragma unroll
            for (int s = 0; s < 4; ++s) if (pos[s] >= 0) {
                const int c = lane + 64 * s;
                TOPI[(size_t)t * 128 + (hd0 + u) * 16 + pos[s]] = tib[u * 32 + (c >> 4)] * 128 + tib[u * 32 + 16 + (c & 15)];
                TOPG[(size_t)t * 128 + (hd0 + u) * 16 + pos[s]] = ex[s] * inv;
            }
        }
    }
}

DEV unsigned pack4_fp8(float a, float b, float c, float d) {
    int w = __builtin_amdgcn_cvt_pk_fp8_f32(a, b, 0, false);
    w = __builtin_amdgcn_cvt_pk_fp8_f32(c, d, w, true);
    return (unsigned)w;
}
DEV void ph_convert8(const Args& a, int layer, const int tid0) {
    const size_t gtid = (size_t)blockIdx.x * NTHR + tid0, gn = (size_t)gridDim.x * NTHR;
    const float* us = a.peer_u + (size_t)layer * 16384 * 1024; const float* vs = a.peer_v + (size_t)layer * 16384 * 1024;
    unsigned* ud = (unsigned*)(a.ws + PTU_OFF); unsigned* vd = (unsigned*)(a.ws + PTV_OFF);
    const float* g = a.norm_ffn_g + layer * 1024;
    for (size_t i = gtid; i < (size_t)16384 * 1024 / 16; i += gn) {
        u32x4 pu, pv;
#pragma unroll
        for (int j = 0; j < 4; ++j) {
            const f32x4 x = *(const f32x4*)(us + i * 16 + j * 4), y = *(const f32x4*)(vs + i * 16 + j * 4), gg = *(const f32x4*)(g + ((i * 16 + j * 4) & 1023));
            pu[j] = pack4_fp8(x[0] * gg[0] * 256.f, x[1] * gg[1] * 256.f, x[2] * gg[2] * 256.f, x[3] * gg[3] * 256.f);
            pv[j] = pack4_fp8(y[0] * 32.f, y[1] * 32.f, y[2] * 32.f, y[3] * 32.f);
        }
        *(u32x4*)(ud + i * 4) = pu; *(u32x4*)(vd + i * 4) = pv;
    }
    bf16_t* pb = wsb(a, PB_OFF);
    const float* pp = a.p_prompt + (size_t)layer * TP * 256; const float* ps = a.p_sample + (size_t)layer * (T - TP) * 256;
    for (size_t i = gtid; i < (size_t)T * 256 / 4; i += gn) {
        const size_t e = i * 4; const f32x4 x = (e < (size_t)TP * 256) ? *(const f32x4*)(pp + e) : *(const f32x4*)(ps + (e - (size_t)TP * 256));
        u32x2 p; p.x = pack2(x[0], x[1]); p.y = pack2(x[2], x[3]); *(u32x2*)(pb + e) = p;
    }
}

template <bool DRY> DEV void ph_peer8(const Args& a, const int tid0) {
    const int lane = tid0 & 63, wv = tid0 >> 6;
    const int gw = blockIdx.x * 8 + wv, nw = gridDim.x * 8;
    bf16_t* hb = wsb(a, HB_OFF); float* rstd = wsf(a, RSTD_OFF);
    const int* TOPI = (const int*)(a.ws + TOPI_OFF); const float* TOPG = wsf(a, TOPG_OFF);
    const unsigned char* PU = a.ws + PTU_OFF; const unsigned char* PV = a.ws + PTV_OFF;
    const int c16 = 16 * lane;
    const bool b5 = lane & 32, b4 = lane & 16, b3 = lane & 8;
    for (int t = gw; t < T; t += nw) {
        float x[16];
        { const u32x4 x0 = *(const u32x4*)(hb + (size_t)t * 1024 + c16), x1 = *(const u32x4*)(hb + (size_t)t * 1024 + c16 + 8);
#pragma unroll
          for (int i = 0; i < 4; ++i) { x[2 * i] = bflo(x0[i]); x[2 * i + 1] = bfhi(x0[i]); x[8 + 2 * i] = bflo(x1[i]); x[8 + 2 * i + 1] = bfhi(x1[i]); } }
        const float rs = rstd[t] * (1.0f / 256.0f);
        const int e0 = TOPI[(size_t)t * 128 + lane], e1 = TOPI[(size_t)t * 128 + 64 + lane];
        const float g0 = TOPG[(size_t)t * 128 + lane], g1 = TOPG[(size_t)t * 128 + 64 + lane];
        float out[16];
#pragma unroll
        for (int i = 0; i < 16; ++i) out[i] = 0.f;
#pragma unroll 1
        for (int kb = 0; kb < 128; kb += 8) {
            const int es = (kb < 64) ? e0 : e1; const float gs = (kb < 64) ? g0 : g1;
            u32x4 ur[8], vr[8];
#pragma unroll
            for (int i = 0; i < 8; ++i) { const int e = __builtin_amdgcn_readlane(es, (kb + i) & 63); ur[i] = *(const u32x4*)(PU + (size_t)e * 1024 + c16); vr[i] = *(const u32x4*)(PV + (size_t)e * 1024 + c16); }
            float d[8];
#pragma unroll
            for (int i = 0; i < 8; ++i) {
                float s = 0.f;
#pragma unroll
                for (int j = 0; j < 4; ++j) {
                    const f32x2 lo = __builtin_amdgcn_cvt_pk_f32_fp8((int)ur[i][j], false), hi = __builtin_amdgcn_cvt_pk_f32_fp8((int)ur[i][j], true);
                    s += lo[0] * x[4 * j] + lo[1] * x[4 * j + 1] + hi[0] * x[4 * j + 2] + hi[1] * x[4 * j + 3];
                }
                d[i] = s;
            }
            float r4[4], r2[2];
#pragma unroll
            for (int i = 0; i < 4; ++i) { const float send = b5 ? d[i] : d[4 + i], keep = b5 ? d[4 + i] : d[i]; r4[i] = keep + SHX(send, 32); }
#pragma unroll
            for (int i = 0; i < 2; ++i) { const float send = b4 ? r4[i] : r4[2 + i], keep = b4 ? r4[2 + i] : r4[i]; r2[i] = keep + SHX(send, 16); }
            const float send1 = b3 ? r2[0] : r2[1], keep1 = b3 ? r2[1] : r2[0];
            const float dd = sum8(keep1 + SHX(send1, 8));
            const float hp = rs * dd;
            const float gt = SHF(gs, (kb + (lane >> 3)) & 63);
            const float w = gt * 0.5f * hp * (1.0f + erff(hp * 0.70710678f)) * (1.0f / 32.0f);
#pragma unroll
            for (int i = 0; i < 8; ++i) {
                const float wi = rl(w, 8 * i);
#pragma unroll
                for (int j = 0; j < 4; ++j) {
                    const f32x2 lo = __builtin_amdgcn_cvt_pk_f32_fp8((int)vr[i][j], false), hi = __builtin_amdgcn_cvt_pk_f32_fp8((int)vr[i][j], true);
                    out[4 * j] += wi * lo[0]; out[4 * j + 1] += wi * lo[1]; out[4 * j + 2] += wi * hi[0]; out[4 * j + 3] += wi * hi[1];
                }
            }
        }
        float* hr = a.h + (size_t)t * 1024 + c16;
        f32x4 hv[4]; float ss = 0.f;
#pragma unroll
        for (int j = 0; j < 4; ++j) { hv[j] = *(const f32x4*)(hr + 4 * j);
#pragma unroll
            for (int c = 0; c < 4; ++c) { hv[j][c] += out[4 * j + c]; ss += hv[j][c] * hv[j][c]; }
            if (!DRY) *(f32x4*)(hr + 4 * j) = hv[j]; }
        ss = wave_sum(ss);
        if (DRY && ss != -1.0f) continue;
        u32x4 p0, p1;
        p0.x = pack2(hv[0][0], hv[0][1]); p0.y = pack2(hv[0][2], hv[0][3]); p0.z = pack2(hv[1][0], hv[1][1]); p0.w = pack2(hv[1][2], hv[1][3]);
        p1.x = pack2(hv[2][0], hv[2][1]); p1.y = pack2(hv[2][2], hv[2][3]); p1.z = pack2(hv[3][0], hv[3][1]); p1.w = pack2(hv[3][2], hv[3][3]);
        *(u32x4*)(hb + (size_t)t * 1024 + c16) = p0; *(u32x4*)(hb + (size_t)t * 1024 + c16 + 8) = p1;
        if (lane == 0) rstd[t] = rsqrtf(ss * (1.0f / 1024.0f) + 1e-6f);
    }
}

typedef short bf16x8 __attribute__((ext_vector_type(8)));
typedef float f32x16 __attribute__((ext_vector_type(16)));
#define MFMA32(a, b, c) __builtin_amdgcn_mfma_f32_32x32x16_bf16((a), (b), (c), 0, 0, 0)
DEV bf16x8 pack_frag(float x0, float x1, float x2, float x3, float x4, float x5, float x6, float x7) {
    u32x4 p;
    asm volatile("v_cvt_pk_bf16_f32 %0, %4, %5\n\tv_cvt_pk_bf16_f32 %1, %6, %7\n\tv_cvt_pk_bf16_f32 %2, %8, %9\n\tv_cvt_pk_bf16_f32 %3, %10, %11\n\ts_nop 1"
                 : "=&v"(p[0]), "=&v"(p[1]), "=&v"(p[2]), "=&v"(p[3]) : "v"(x0), "v"(x1), "v"(x2), "v"(x3), "v"(x4), "v"(x5), "v"(x6), "v"(x7));
    return __builtin_bit_cast(bf16x8, p);
}
DEV void ph_attn2(const Args& a, unsigned char* ldsb, const int tid0) {
    const int lane = tid0 & 63, wv = __builtin_amdgcn_readfirstlane(tid0 >> 6), r = lane & 31, h = lane >> 5;
    unsigned char* vt = ldsb + wv * 5120;
    const bf16_t* qkv = wsb(a, QKV_OFF);
    bf16_t* OP = wsb(a, OP_OFF); float* ML = wsf(a, ML_OFF);
    const int x16 = r & 15, permr = (r & 16) + 8 * ((x16 >> 2) & 1) + 4 * ((x16 >> 3) & 1) + (x16 & 3);
    const float sc = 0.125f * 1.44269504f, NEG = -1.0e30f;
    const int nitem = NSEQ * 8 * 3 * 128, per = nitem / (int)gridDim.x;
    for (int it = 0; it < per / 8; ++it) {
        const int w = blockIdx.x * per + it * 8 + wv;
        const int sh = w / 384, rem = w - sh * 384, di = rem >> 7, idx = rem & 127;
        const int sft = 2 * di, nbc = 128 >> sft, rr = idx >> (7 - sft), cb = idx & (nbc - 1), cq0 = cb * 32, nlen = 4096 >> sft;
        const int seq = sh >> 3, hd = sh & 7; const size_t tb = (size_t)seq * 4096;
        const size_t tokq = tb + ((size_t)(cq0 + r) << sft) + rr;
        const bf16_t* qp = qkv + tokq * 1536 + hd * 64 + 8 * h;
        bf16x8 qf[4];
#pragma unroll
        for (int s = 0; s < 4; ++s) qf[s] = *(const bf16x8*)(qp + 16 * s);
        float m = NEG, l = 0.f;
        f32x16 O0, O1;
#pragma unroll
        for (int i = 0; i < 16; ++i) { O0[i] = 0.f; O1[i] = 0.f; }
        bf16x8 kfb[2][4], vfb[2][4];
#define ATT_LOAD(kt_) do { const int kb_ = cq0 - 64 + 32 * (kt_); const size_t tokk_ = tb + ((size_t)(kb_ + r) << sft) + rr; const bf16_t* kp_ = qkv + tokk_ * 1536 + 512 + hd * 64 + 8 * h; \
            _Pragma("unroll") for (int s_ = 0; s_ < 4; ++s_) { kfb[(kt_) & 1][s_] = *(const bf16x8*)(kp_ + 16 * s_); vfb[(kt_) & 1][s_] = *(const bf16x8*)(kp_ + 512 + 16 * s_); } } while (0)
        if (cq0 - 64 >= 0) ATT_LOAD(0);
#pragma unroll
        for (int kt = 0; kt < 5; ++kt) {
            const int kb = cq0 - 64 + 32 * kt;
            if (kt + 1 < 5) { const int kbn = kb + 32; if (kbn >= 0 && kbn < nlen) ATT_LOAD(kt + 1); }
            asm volatile("" ::: "memory");
            if (kb < 0 || kb >= nlen) continue;
            bf16x8 kf[4], vf[4];
#pragma unroll
            for (int s = 0; s < 4; ++s) { kf[s] = kfb[kt & 1][s]; vf[s] = vfb[kt & 1][s]; }
            f32x16 S;
#pragma unroll
            for (int i = 0; i < 16; ++i) S[i] = 0.f;
#pragma unroll
            for (int s = 0; s < 4; ++s) S = MFMA32(kf[s], qf[s], S);
            float lm = NEG;
#pragma unroll
            for (int i = 0; i < 16; ++i) {
                const int row = (i & 3) + 8 * (i >> 2) + 4 * h;
                float v = S[i] * sc;
                if (kt == 0) v = (row >= r) ? v : NEG;
                if (kt == 4) v = (row <= r) ? v : NEG;
                S[i] = v; lm = fmaxf(lm, v);
            }
            lm = fmaxf(lm, SHX(lm, 32));
            const float mn = fmaxf(m, lm), alpha = __builtin_amdgcn_exp2f(m - mn);
            m = mn; l *= alpha;
            float ps = 0.f;
#pragma unroll
            for (int i = 0; i < 16; ++i) { O0[i] *= alpha; O1[i] *= alpha; S[i] = __builtin_amdgcn_exp2f(S[i] - mn); ps += S[i]; }
            l += ps;
            const bf16x8 pb0 = pack_frag(S[0], S[1], S[2], S[3], S[4], S[5], S[6], S[7]);
            const bf16x8 pb1 = pack_frag(S[8], S[9], S[10], S[11], S[12], S[13], S[14], S[15]);
            asm volatile("" ::: "memory");
#pragma unroll
            for (int i = 0; i < 4; ++i)
#pragma unroll
                for (int e = 0; e < 8; ++e) *(short*)(vt + (16 * i + 8 * h + e) * 80 + 2 * permr) = vf[i][e];
            asm volatile("" ::: "memory");
#pragma unroll
            for (int s = 0; s < 2; ++s) {
                const bf16x8 a0 = *(const bf16x8*)(vt + r * 80 + 32 * s + 16 * h), a1 = *(const bf16x8*)(vt + (r + 32) * 80 + 32 * s + 16 * h);
                O0 = MFMA32(a0, s ? pb1 : pb0, O0); O1 = MFMA32(a1, s ? pb1 : pb0, O1);
            }
            asm volatile("" ::: "memory");
        }
#undef ATT_LOAD
        l += SHX(l, 32);
        const float inv = 1.0f / l;
        bf16_t* op = OP + ((size_t)di * T + tokq) * 512 + hd * 64 + 4 * h;
#pragma unroll
        for (int g = 0; g < 4; ++g) {
            u32x2 p0, p1;
            p0.x = pack2(O0[4 * g] * inv, O0[4 * g + 1] * inv); p0.y = pack2(O0[4 * g + 2] * inv, O0[4 * g + 3] * inv);
            p1.x = pack2(O1[4 * g] * inv, O1[4 * g + 1] * inv); p1.y = pack2(O1[4 * g + 2] * inv, O1[4 * g + 3] * inv);
            *(u32x2*)(op + 8 * g) = p0; *(u32x2*)(op + 32 + 8 * g) = p1;
        }
        if (h == 0) { f32x2 ml; ml[0] = m; ml[1] = l; *(f32x2*)(ML + (((size_t)di * T + tokq) * 8 + hd) * 2) = ml; }
    }
}
DEV void ph_attn_merge(const Args& a, int layer, const int tid0) {
    const int lane = tid0 & 63, wv = tid0 >> 6;
    const int gw = blockIdx.x * 8 + wv, nw = gridDim.x * 8;
    const bf16_t* OP = wsb(a, OP_OFF); const float* ML = wsf(a, ML_OFF); bf16_t* mix = wsb(a, MIX_OFF);
    const int c8 = 8 * lane, hd = lane >> 3;
    const f32x4 gA = *(const f32x4*)(a.att_norm_g + layer * 512 + c8), gB = *(const f32x4*)(a.att_norm_g + layer * 512 + c8 + 4);
    for (int t = gw; t < T; t += nw) {
        u32x4 o[3]; f32x2 ml[3];
#pragma unroll
        for (int d = 0; d < 3; ++d) { o[d] = *(const u32x4*)(OP + ((size_t)d * T + t) * 512 + c8); ml[d] = *(const f32x2*)(ML + (((size_t)d * T + t) * 8 + hd) * 2); }
        const float mm = fmaxf(ml[0][0], fmaxf(ml[1][0], ml[2][0]));
        float wgt[3]; float den = 0.f;
#pragma unroll
        for (int d = 0; d < 3; ++d) { wgt[d] = __builtin_amdgcn_exp2f(ml[d][0] - mm) * ml[d][1]; den += wgt[d]; }
        const float iden = 1.0f / den;
        float v[8]; float ss = 0.f;
#pragma unroll
        for (int i = 0; i < 4; ++i) {
            v[2 * i] = (wgt[0] * bflo(o[0][i]) + wgt[1] * bflo(o[1][i]) + wgt[2] * bflo(o[2][i])) * iden;
            v[2 * i + 1] = (wgt[0] * bfhi(o[0][i]) + wgt[1] * bfhi(o[1][i]) + wgt[2] * bfhi(o[2][i])) * iden;
            ss += v[2 * i] * v[2 * i] + v[2 * i + 1] * v[2 * i + 1];
        }
        const float rn = rsqrtf(sum8(ss) * (1.0f / 64.0f) + 1e-6f);
        u32x4 ov;
        ov.x = pack2(v[0] * rn * gA[0], v[1] * rn * gA[1]); ov.y = pack2(v[2] * rn * gA[2], v[3] * rn * gA[3]);
        ov.z = pack2(v[4] * rn * gB[0], v[5] * rn * gB[1]); ov.w = pack2(v[6] * rn * gB[2], v[7] * rn * gB[3]);
        *(u32x4*)(mix + (size_t)t * 1024 + c8) = ov;
    }
}

DEV float tanh_fast(float x) { return 1.0f - 2.0f / (1.0f + __expf(2.0f * x)); }

DEV void ph_rwkv_prep1(const Args& a, int layer, unsigned char* ldsb, const int tid0) {
    const int lane = tid0 & 63, wv = __builtin_amdgcn_readfirstlane(tid0 >> 6), r = lane & 31, h = lane >> 5;
    const int gw = blockIdx.x * 8 + wv, nw = gridDim.x * 8;
    const int sub = wv & 1, ng = wv >> 1;
    const bf16_t* U = wsb(a, U_OFF);
    const float* sw = a.rwkv_shift + (size_t)layer * 3 * UC;
    const bf16_t* wl = wsb(a, WB_OFF + (size_t)layer * WB_LAYER + WB_LORA);
#pragma unroll 1
    for (int arr = 0; arr < 5; ++arr) {
        const int coff = (arr < 4) ? arr * 64 : 256, nk = (arr < 4) ? 4 : 8, kw = nk * 16, rsb = kw * 2 + 16;
        __syncthreads();
        {
            const bf16_t* wsrc = wl + (arr < 4 ? arr * 512 * 64 : 4 * 512 * 64);
            const int cpr = kw / 8;
            for (int i = tid0; i < 512 * cpr; i += NTHR) { const int row = i / cpr, c = i - row * cpr; *(u32x4*)(ldsb + row * rsb + c * 16) = *(const u32x4*)(wsrc + (size_t)row * kw + c * 8); }
        }
        __syncthreads();
        bf16_t* outb = wsb(a, arr == 0 ? WF_OFF : arr == 1 ? WB2_OFF : arr == 2 ? AF_OFF : arr == 3 ? AB_OFF : G_OFF);
        const float* bias = (arr < 2) ? a.rwkv_w0 + (layer * 2 + arr) * 512 : a.rwkv_a0 + (layer * 2 + (arr & 1)) * 512;
        f32x4 bvr[4][4];
#pragma unroll
        for (int q = 0; q < 4; ++q)
#pragma unroll
            for (int g = 0; g < 4; ++g) bvr[q][g] = *(const f32x4*)(bias + (ng * 4 + q) * 32 + 8 * g + 4 * h);
#pragma unroll 1
        for (int tile = blockIdx.x; tile < T / 64; tile += gridDim.x) {
            const int t = tile * 64 + sub * 32 + r, pos = t & 4095;
            const bool hp = pos > 0, hn = pos < 4095;
            const bf16_t* up = U + (size_t)t * UW + 1536 + 8 * h;
            bf16x8 xf[8];
#pragma unroll
            for (int s = 0; s < 8; ++s) {
                if (s < nk) {
                    const int col = coff + 16 * s;
                    const u32x4 c = *(const u32x4*)(up + col);
                    u32x4 p = {0u, 0u, 0u, 0u}, n = {0u, 0u, 0u, 0u};
                    if (hp) p = *(const u32x4*)(up - UW + col);
                    if (hn) n = *(const u32x4*)(up + UW + col);
                    const float* s0 = sw + 1536 + 8 * h + col;
                    const f32x4 wp0 = *(const f32x4*)(s0), wp1 = *(const f32x4*)(s0 + 4), wc0 = *(const f32x4*)(s0 + UC), wc1 = *(const f32x4*)(s0 + UC + 4), wn0 = *(const f32x4*)(s0 + 2 * UC), wn1 = *(const f32x4*)(s0 + 2 * UC + 4);
                    float v[8];
#pragma unroll
                    for (int i = 0; i < 4; ++i) {
                        const float a0 = (i < 2) ? wp0[2 * i] : wp1[2 * i - 4], a1 = (i < 2) ? wp0[2 * i + 1] : wp1[2 * i - 3];
                        const float b0 = (i < 2) ? wc0[2 * i] : wc1[2 * i - 4], b1 = (i < 2) ? wc0[2 * i + 1] : wc1[2 * i - 3];
                        const float c0 = (i < 2) ? wn0[2 * i] : wn1[2 * i - 4], c1 = (i < 2) ? wn0[2 * i + 1] : wn1[2 * i - 3];
                        v[2 * i] = a0 * bflo(p[i]) + b0 * bflo(c[i]) + c0 * bflo(n[i]);
                        v[2 * i + 1] = a1 * bfhi(p[i]) + b1 * bfhi(c[i]) + c1 * bfhi(n[i]);
                    }
                    if (arr < 2) {
#pragma unroll
                        for (int i = 0; i < 8; ++i) v[i] = tanh_fast(v[i]);
                    } else if (arr == 4) {
#pragma unroll
                        for (int i = 0; i < 8; ++i) v[i] = sigmoidf_(v[i]);
                    }
                    xf[s] = pack_frag(v[0], v[1], v[2], v[3], v[4], v[5], v[6], v[7]);
                }
            }
            bf16_t* out = outb + (size_t)t * 512 + 4 * h;
#pragma unroll
            for (int q = 0; q < 4; ++q) {
                const int nt = ng * 4 + q;
                f32x16 C;
#pragma unroll
                for (int i = 0; i < 16; ++i) C[i] = 0.f;
                const unsigned char* wr = ldsb + (nt * 32 + r) * rsb + 16 * h;
#pragma unroll
                for (int s = 0; s < 8; ++s) if (s < nk) { const bf16x8 A = *(const bf16x8*)(wr + 32 * s); C = MFMA32(A, xf[s], C); }
#pragma unroll
                for (int g = 0; g < 4; ++g) {
                    float o[4];
                    if (arr < 4) {
                        const f32x4 bv = bvr[q][g];
#pragma unroll
                        for (int j = 0; j < 4; ++j) { const float sg = sigmoidf_(C[4 * g + j] + bv[j]); o[j] = (arr < 2) ? __expf(-0.60653066f * sg) : sg; }
                    } else {
#pragma unroll
                        for (int j = 0; j < 4; ++j) o[j] = C[4 * g + j];
                    }
                    u32x2 pk; pk.x = pack2(o[0], o[1]); pk.y = pack2(o[2], o[3]);
                    *(u32x2*)(out + nt * 32 + 8 * g) = pk;
                }
            }
        }
    }
    {
        const int c16 = 16 * lane;
        bf16_t* dst = wsb(a, lane < 32 ? RS_OFF : KS_OFF) + (c16 & 511);
        float swp[16], swc[16], swn[16];
#pragma unroll
        for (int i = 0; i < 16; ++i) { swp[i] = sw[c16 + i]; swc[i] = sw[UC + c16 + i]; swn[i] = sw[2 * UC + c16 + i]; }
        for (int t = gw; t < T; t += nw) {
            const int pos = t & 4095; const bool hp = pos > 0, hn = pos < 4095;
            const bf16_t* up = U + (size_t)t * UW + c16;
            u32x4 c[2], p[2], n[2];
#pragma unroll
            for (int q = 0; q < 2; ++q) {
                c[q] = *(const u32x4*)(up + 8 * q); p[q] = (u32x4){0u, 0u, 0u, 0u}; n[q] = (u32x4){0u, 0u, 0u, 0u};
                if (hp) p[q] = *(const u32x4*)(up - UW + 8 * q);
                if (hn) n[q] = *(const u32x4*)(up + UW + 8 * q);
            }
            u32x4 o[2];
#pragma unroll
            for (int q = 0; q < 2; ++q)
#pragma unroll
                for (int i = 0; i < 4; ++i) {
                    const int e = 8 * q + 2 * i;
                    const float lo = swp[e] * bflo(p[q][i]) + swc[e] * bflo(c[q][i]) + swn[e] * bflo(n[q][i]);
                    const float hi = swp[e + 1] * bfhi(p[q][i]) + swc[e + 1] * bfhi(c[q][i]) + swn[e + 1] * bfhi(n[q][i]);
                    o[q][i] = pack2(lo, hi);
                }
            *(u32x4*)(dst + (size_t)t * 512) = o[0]; *(u32x4*)(dst + (size_t)t * 512 + 8) = o[1];
        }
    }
}
DEV void ph_rwkv_prep2(const Args& a, int layer, const int tid0) {
    const int lane = tid0 & 63, wv = tid0 >> 6;
    const int gw = blockIdx.x * 8 + wv, nw = gridDim.x * 8;
    bf16_t* U = wsb(a, U_OFF); const bf16_t* KS = wsb(a, KS_OFF);
    const float* sw = a.rwkv_shift + (size_t)layer * 3 * UC;
    const int c8 = 8 * lane;
    float kkc[8], sv[3][8];
#pragma unroll
    for (int i = 0; i < 8; ++i) { kkc[i] = a.rwkv_k_k[layer * 512 + c8 + i]; sv[0][i] = sw[1024 + c8 + i]; sv[1][i] = sw[UC + 1024 + c8 + i]; sv[2][i] = sw[2 * UC + 1024 + c8 + i]; }
    for (int t = gw; t < T; t += nw) {
        const int pos = t & 4095; const bool hp = pos > 0, hn = pos < 4095;
        bf16_t* up = U + (size_t)t * UW;
        const u32x4 ks = *(const u32x4*)(KS + (size_t)t * 512 + c8);
        const u32x4 c = *(const u32x4*)(up + 1024 + c8);
        u32x4 p = {0u, 0u, 0u, 0u}, n = {0u, 0u, 0u, 0u};
        if (hp) p = *(const u32x4*)(up - UW + 1024 + c8);
        if (hn) n = *(const u32x4*)(up + UW + 1024 + c8);
        float kx[8]; float ss = 0.f;
#pragma unroll
        for (int i = 0; i < 4; ++i) { kx[2 * i] = bflo(ks[i]) * kkc[2 * i]; kx[2 * i + 1] = bfhi(ks[i]) * kkc[2 * i + 1]; ss += kx[2 * i] * kx[2 * i] + kx[2 * i + 1] * kx[2 * i + 1]; }
        const float inv = 1.0f / fmaxf(sqrtf(sum8(ss)), 1e-12f);
        u32x4 ko, vo;
#pragma unroll
        for (int i = 0; i < 4; ++i) {
            ko[i] = pack2(kx[2 * i] * inv, kx[2 * i + 1] * inv);
            vo[i] = pack2(sv[0][2 * i] * bflo(p[i]) + sv[1][2 * i] * bflo(c[i]) + sv[2][2 * i] * bflo(n[i]), sv[0][2 * i + 1] * bfhi(p[i]) + sv[1][2 * i + 1] * bfhi(c[i]) + sv[2][2 * i + 1] * bfhi(n[i]));
        }
        *(u32x4*)(up + c8) = ko; *(u32x4*)(up + 1536 + c8) = vo;
    }
}

DEV void ph_scan2(const Args& a, int layer, float* lds, const int tid0) {
    const int tid = tid0, lane = tid & 63, wv = __builtin_amdgcn_readfirstlane(tid >> 6);
    const int dir = wv >> 2, w4 = wv & 3;
    float* vecs = lds;
    float* ybuf = lds + 2 * 12288;
    const bf16_t* U = wsb(a, U_OFF); const bf16_t* RS = wsb(a, RS_OFF); const bf16_t* KS = wsb(a, KS_OFF);
    const bf16_t* Wd = wsb(a, dir ? WB2_OFF : WF_OFF); const bf16_t* Ad = wsb(a, dir ? AB_OFF : AF_OFF);
    bf16_t* Uw = wsb(a, U_OFF);
    const int js = lane & 7, q = lane >> 3, r0 = 16 * w4 + 2 * q;
    for (int un = blockIdx.x; un < NSEQ * 8; un += gridDim.x) {
        const int seq = un >> 3, hd = un & 7; const size_t tb = (size_t)seq * 4096; const int cb = hd * 64, pch = cb + lane;
        const float kac = a.rwkv_k_a[layer * 512 + pch];
        f32x2 S0[4], S1[4];
#pragma unroll
        for (int i = 0; i < 4; ++i) { S0[i] = (f32x2){0.f, 0.f}; S1[i] = (f32x2){0.f, 0.f}; }
        unsigned short pr[4][6];
#define SCAN_ISSUE(blk_) do { _Pragma("unroll") for (int si = 0; si < 4; ++si) { const int step_ = (blk_) * 16 + w4 * 4 + si, pos_ = dir ? 4095 - step_ : step_; const size_t t_ = tb + pos_; \
            pr[si][0] = Wd[t_ * 512 + pch]; pr[si][1] = U[t_ * UW + pch]; pr[si][2] = Ad[t_ * 512 + pch]; pr[si][3] = KS[t_ * 512 + pch]; pr[si][4] = RS[t_ * 512 + pch]; pr[si][5] = U[t_ * UW + 1536 + pch]; } } while (0)
#define SCAN_COMMIT(buf_) do { _Pragma("unroll") for (int si = 0; si < 4; ++si) { float* o_ = vecs + (((buf_) * 2 + dir) * 16 + w4 * 4 + si) * 384 + lane; \
            const float w_ = bf2f(pr[si][0]), kk_ = bf2f(pr[si][1]), av_ = bf2f(pr[si][2]), ks_ = bf2f(pr[si][3]); \
            o_[0] = w_; o_[64] = -kk_; o_[128] = kk_ * av_; o_[192] = ks_ * (1.0f + (av_ - 1.0f) * kac); o_[256] = bf2f(pr[si][4]); o_[320] = bf2f(pr[si][5]); } } while (0)
        __syncthreads();
        SCAN_ISSUE(0); SCAN_COMMIT(0);
        __syncthreads();
        for (int blk = 0; blk < 256; ++blk) {
            const int cur = blk & 1;
            if (blk + 1 < 256) SCAN_ISSUE(blk + 1);
            const float* vb0 = vecs + ((cur * 2 + dir) * 16) * 384;
            float* yb = ybuf + ((cur * 2 + dir) * 16) * 64 + r0;
            const float* vbl = vb0 + 8 * js;
            f32x4 cw0 = *(const f32x4*)(vbl), cw1 = *(const f32x4*)(vbl + 4), ca0 = *(const f32x4*)(vbl + 64), ca1 = *(const f32x4*)(vbl + 68), cb0 = *(const f32x4*)(vbl + 128), cb1 = *(const f32x4*)(vbl + 132);
            f32x4 ck0 = *(const f32x4*)(vbl + 192), ck1 = *(const f32x4*)(vbl + 196), cq0 = *(const f32x4*)(vbl + 256), cq1 = *(const f32x4*)(vbl + 260);
            f32x2 cv2 = *(const f32x2*)(vb0 + 320 + r0);
#pragma unroll
            for (int s = 0; s < 16; ++s) {
                if (s == 8 && blk + 1 < 256) SCAN_COMMIT(cur ^ 1);
                const f32x4 w0 = cw0, w1 = cw1, a0 = ca0, a1 = ca1, b0 = cb0, b1 = cb1, k0 = ck0, k1 = ck1, q0 = cq0, q1 = cq1; const f32x2 v2 = cv2;
                if (s < 15) {
                    const float* vn = vbl + (s + 1) * 384;
                    cw0 = *(const f32x4*)(vn); cw1 = *(const f32x4*)(vn + 4); ca0 = *(const f32x4*)(vn + 64); ca1 = *(const f32x4*)(vn + 68); cb0 = *(const f32x4*)(vn + 128); cb1 = *(const f32x4*)(vn + 132);
                    ck0 = *(const f32x4*)(vn + 192); ck1 = *(const f32x4*)(vn + 196); cq0 = *(const f32x4*)(vn + 256); cq1 = *(const f32x4*)(vn + 260);
                    cv2 = *(const f32x2*)(vb0 + (s + 1) * 384 + 320 + r0);
                    asm volatile("" ::: "memory");
                }
                const f32x2 av[4] = {{a0[0], a0[1]}, {a0[2], a0[3]}, {a1[0], a1[1]}, {a1[2], a1[3]}};
                const f32x2 wv2[4] = {{w0[0], w0[1]}, {w0[2], w0[3]}, {w1[0], w1[1]}, {w1[2], w1[3]}};
                const f32x2 bv[4] = {{b0[0], b0[1]}, {b0[2], b0[3]}, {b1[0], b1[1]}, {b1[2], b1[3]}};
                const f32x2 kv[4] = {{k0[0], k0[1]}, {k0[2], k0[3]}, {k1[0], k1[1]}, {k1[2], k1[3]}};
                const f32x2 qv[4] = {{q0[0], q0[1]}, {q0[2], q0[3]}, {q1[0], q1[1]}, {q1[2], q1[3]}};
                f32x2 t0 = S0[0] * av[0] + S0[1] * av[1], t1 = S0[2] * av[2] + S0[3] * av[3];
                f32x2 u0 = S1[0] * av[0] + S1[1] * av[1], u1 = S1[2] * av[2] + S1[3] * av[3];
                t0 = t0 + t1; u0 = u0 + u1;
                const float sa0 = sum8(t0[0] + t0[1]), sa1 = sum8(u0[0] + u0[1]);
                f32x2 y0 = {0.f, 0.f}, y1 = {0.f, 0.f};
#pragma unroll
                for (int i = 0; i < 4; ++i) {
                    S0[i] = S0[i] * wv2[i] + (bv[i] * sa0 + kv[i] * v2[0]);
                    S1[i] = S1[i] * wv2[i] + (bv[i] * sa1 + kv[i] * v2[1]);
                    y0 = y0 + S0[i] * qv[i]; y1 = y1 + S1[i] * qv[i];
                }
                const float ys0 = sum8(y0[0] + y0[1]), ys1 = sum8(y1[0] + y1[1]);
                if (js == 0) { f32x2 yo; yo[0] = ys0; yo[1] = ys1; *(f32x2*)(yb + s * 64) = yo; }
            }
            __syncthreads();
            {
                const int d2 = tid >> 8, s2 = (tid >> 4) & 15, c4 = (tid & 15) * 4;
                const f32x4 yv = *(const f32x4*)(ybuf + ((cur * 2 + d2) * 16 + s2) * 64 + c4);
                const int step = blk * 16 + s2, pos = d2 ? 4095 - step : step;
                u32x2 pk; pk.x = pack2(yv[0], yv[1]); pk.y = pack2(yv[2], yv[3]);
                *(u32x2*)(Uw + (tb + pos) * UW + 512 + 512 * d2 + cb + c4) = pk;
            }
        }
#undef SCAN_ISSUE
#undef SCAN_COMMIT
    }
}

DEV void ph_post2(const Args& a, int layer, const int tid0) {
    const int lane = tid0 & 63, wv = tid0 >> 6;
    const int gw = blockIdx.x * 8 + wv, nw = gridDim.x * 8;
    const bf16_t* U = wsb(a, U_OFF); const bf16_t* RS = wsb(a, RS_OFF); const bf16_t* KS = wsb(a, KS_OFF); const bf16_t* G = wsb(a, G_OFF);
    const bf16_t* AF = wsb(a, AF_OFF); const bf16_t* AB = wsb(a, AB_OFF); bf16_t* mix = wsb(a, MIX_OFF);
    const int c8 = 8 * lane;
    float kac[8], rkc[8], lnw[8], lnb[8];
#pragma unroll
    for (int i = 0; i < 8; ++i) { kac[i] = a.rwkv_k_a[layer * 512 + c8 + i]; rkc[i] = a.rwkv_r_k[layer * 512 + c8 + i]; lnw[i] = a.rwkv_ln_w[layer * 512 + c8 + i]; lnb[i] = a.rwkv_ln_b[layer * 512 + c8 + i]; }
    for (int t = gw; t < T; t += nw) {
        const bf16_t* up = U + (size_t)t * UW;
        const u32x4 rp = *(const u32x4*)(RS + (size_t)t * 512 + c8), kp = *(const u32x4*)(KS + (size_t)t * 512 + c8), gp = *(const u32x4*)(G + (size_t)t * 512 + c8);
        const u32x4 afp = *(const u32x4*)(AF + (size_t)t * 512 + c8), abp = *(const u32x4*)(AB + (size_t)t * 512 + c8);
        const u32x4 yfp = *(const u32x4*)(up + 512 + c8), ybp = *(const u32x4*)(up + 1024 + c8), vp = *(const u32x4*)(up + 1536 + c8);
        float y[8], rr[8], kk[8], vv[8], gg[8], sa[8];
#pragma unroll
        for (int i = 0; i < 4; ++i) {
            y[2 * i] = bflo(yfp[i]) + bflo(ybp[i]); y[2 * i + 1] = bfhi(yfp[i]) + bfhi(ybp[i]);
            rr[2 * i] = bflo(rp[i]); rr[2 * i + 1] = bfhi(rp[i]); kk[2 * i] = bflo(kp[i]); kk[2 * i + 1] = bfhi(kp[i]);
            vv[2 * i] = bflo(vp[i]); vv[2 * i + 1] = bfhi(vp[i]); gg[2 * i] = bflo(gp[i]); gg[2 * i + 1] = bfhi(gp[i]);
            sa[2 * i] = bflo(afp[i]) + bflo(abp[i]); sa[2 * i + 1] = bfhi(afp[i]) + bfhi(abp[i]);
        }
        float ysum = 0.f, bs = 0.f;
#pragma unroll
        for (int i = 0; i < 8; ++i) { ysum += y[i]; bs += rr[i] * kk[i] * (2.0f + (sa[i] - 2.0f) * kac[i]) * rkc[i]; }
        const float mu = sum8(ysum) * (1.0f / 64.0f);
        float vs = 0.f;
#pragma unroll
        for (int i = 0; i < 8; ++i) { y[i] -= mu; vs += y[i] * y[i]; }
        const float rstdv = rsqrtf(sum8(vs) * (1.0f / 64.0f) + 64e-5f);
        bs = sum8(bs);
        float o[8];
#pragma unroll
        for (int i = 0; i < 8; ++i) o[i] = (y[i] * rstdv * lnw[i] + lnb[i] + bs * vv[i]) * gg[i];
        u32x4 ov; ov.x = pack2(o[0], o[1]); ov.y = pack2(o[2], o[3]); ov.z = pack2(o[4], o[5]); ov.w = pack2(o[6], o[7]);
        *(u32x4*)(mix + (size_t)t * 1024 + 512 + c8) = ov;
    }
}

#ifndef PEER_SYNC
#define PEER_SYNC 2
#endif
template <bool DRY> DEV void ph_peer_sliced(const Args& a, const int tid0) {
    const int lane = tid0 & 63, wv = tid0 >> 6;
    const int gw = blockIdx.x * 8 + wv, nw = gridDim.x * 8;
    bf16_t* hb = wsb(a, HB_OFF); float* rstd = wsf(a, RSTD_OFF);
    const int* TOPI = (const int*)(a.ws + TOPI_OFF); const float* TOPG = wsf(a, TOPG_OFF);
    const unsigned char* PU = a.ws + PTU_OFF; const unsigned char* PV = a.ws + PTV_OFF;
    const int c16 = 16 * lane;
    const bool b5 = lane & 32, b4 = lane & 16;
    const int nround = T / (nw * 4);
    for (int rd = 0; rd < nround; ++rd) {
        u32x4 xa[4], xb[4]; float out[4][16]; int e0[4], e1[4]; float g0[4], g1[4], rs[4];
#pragma unroll
        for (int tk = 0; tk < 4; ++tk) {
            const int t = gw + nw * (rd * 4 + tk);
            xa[tk] = *(const u32x4*)(hb + (size_t)t * 1024 + c16); xb[tk] = *(const u32x4*)(hb + (size_t)t * 1024 + c16 + 8);
            rs[tk] = rstd[t] * (1.0f / 256.0f);
            e0[tk] = TOPI[(size_t)t * 128 + lane]; e1[tk] = TOPI[(size_t)t * 128 + 64 + lane];
            g0[tk] = TOPG[(size_t)t * 128 + lane]; g1[tk] = TOPG[(size_t)t * 128 + 64 + lane];
#pragma unroll
            for (int i = 0; i < 16; ++i) out[tk][i] = 0.f;
        }
#pragma unroll 1
        for (int s = 0; s < 16; ++s) {
#pragma unroll
            for (int tk = 0; tk < 4; ++tk) {
                unsigned long long m0 = __ballot((e0[tk] >> 10) == s), m1 = __ballot((e1[tk] >> 10) == s);
                while (m0 | m1) {
                    int ex[4]; float gx[4];
#pragma unroll
                    for (int i = 0; i < 4; ++i) {
                        if (m0) { const int ix = __builtin_ctzll(m0); m0 &= m0 - 1; ex[i] = __builtin_amdgcn_readlane(e0[tk], ix); gx[i] = rl(g0[tk], ix); }
                        else if (m1) { const int ix = __builtin_ctzll(m1); m1 &= m1 - 1; ex[i] = __builtin_amdgcn_readlane(e1[tk], ix); gx[i] = rl(g1[tk], ix); }
                        else { ex[i] = ex[0]; gx[i] = 0.f; }
                    }
#ifdef PROBE_EMASK
                    if (DRY) {
#pragma unroll
                        for (int i = 0; i < 4; ++i) ex[i] &= PROBE_EMASK;
                    }
#endif
                    u32x4 ur[4], vr[4];
#pragma unroll
                    for (int i = 0; i < 4; ++i) { ur[i] = *(const u32x4*)(PU + (size_t)ex[i] * 1024 + c16); vr[i] = *(const u32x4*)(PV + (size_t)ex[i] * 1024 + c16); }
                    float d[4];
#pragma unroll
                    for (int i = 0; i < 4; ++i) {
                        float sm = 0.f;
#pragma unroll
                        for (int j = 0; j < 4; ++j) {
                            const f32x2 lo = __builtin_amdgcn_cvt_pk_f32_fp8((int)ur[i][j], false), hi = __builtin_amdgcn_cvt_pk_f32_fp8((int)ur[i][j], true);
                            const unsigned ulo = (__float_as_uint(lo[0]) >> 16) | (__float_as_uint(lo[1]) & 0xffff0000u), uhi = (__float_as_uint(hi[0]) >> 16) | (__float_as_uint(hi[1]) & 0xffff0000u);
                            const unsigned xlo = (j < 2) ? xa[tk][2 * j] : xb[tk][2 * j - 4], xhi = (j < 2) ? xa[tk][2 * j + 1] : xb[tk][2 * j - 3];
                            sm = dot2bf(ulo, xlo, sm); sm = dot2bf(uhi, xhi, sm);
                        }
                        d[i] = sm;
                    }
                    float r2[2];
#pragma unroll
                    for (int i = 0; i < 2; ++i) { const float send = b5 ? d[i] : d[2 + i], keep = b5 ? d[2 + i] : d[i]; r2[i] = keep + SHX(send, 32); }
                    const float send1 = b4 ? r2[0] : r2[1], keep1 = b4 ? r2[1] : r2[0];
                    const float dd = sum16(keep1 + SHX(send1, 16));
                    const float hp = rs[tk] * dd;
                    const float gl = 0.5f * hp * (1.0f + erff(hp * 0.70710678f)) * (1.0f / 32.0f);
#pragma unroll
                    for (int i = 0; i < 4; ++i) {
                        const float wi = rl(gl, 16 * i) * gx[i];
#pragma unroll
                        for (int j = 0; j < 4; ++j) {
                            const f32x2 lo = __builtin_amdgcn_cvt_pk_f32_fp8((int)vr[i][j], false), hi = __builtin_amdgcn_cvt_pk_f32_fp8((int)vr[i][j], true);
                            out[tk][4 * j] += wi * lo[0]; out[tk][4 * j + 1] += wi * lo[1]; out[tk][4 * j + 2] += wi * hi[0]; out[tk][4 * j + 3] += wi * hi[1];
                        }
                    }
                }
            }
        }
#pragma unroll
        for (int tk = 0; tk < 4; ++tk) {
            const int t = gw + nw * (rd * 4 + tk);
            float* hr = a.h + (size_t)t * 1024 + c16;
            f32x4 hv[4]; float ss = 0.f;
#pragma unroll
            for (int j = 0; j < 4; ++j) { hv[j] = *(const f32x4*)(hr + 4 * j);
#pragma unroll
                for (int c = 0; c < 4; ++c) { hv[j][c] += out[tk][4 * j + c]; ss += hv[j][c] * hv[j][c]; }
                if (!DRY) *(f32x4*)(hr + 4 * j) = hv[j]; }
            ss = wave_sum(ss);
            if (DRY && ss != -1.0f) continue;
            u32x4 p0, p1;
            p0.x = pack2(hv[0][0], hv[0][1]); p0.y = pack2(hv[0][2], hv[0][3]); p0.z = pack2(hv[1][0], hv[1][1]); p0.w = pack2(hv[1][2], hv[1][3]);
            p1.x = pack2(hv[2][0], hv[2][1]); p1.y = pack2(hv[2][2], hv[2][3]); p1.z = pack2(hv[3][0], hv[3][1]); p1.w = pack2(hv[3][2], hv[3][3]);
            *(u32x4*)(hb + (size_t)t * 1024 + c16) = p0; *(u32x4*)(hb + (size_t)t * 1024 + c16 + 8) = p1;
            if (lane == 0) rstd[t] = rsqrtf(ss * (1.0f / 1024.0f) + 1e-6f);
        }
        if ((rd % PEER_SYNC) == PEER_SYNC - 1 && rd + 1 < nround) {
            XcdBarrier b_; b_.bar = (unsigned*)(a.ws + BAR_OFF); b_.x = xb_xcc_id(); b_.st = (volatile LAS unsigned*)(smem_base() + LDS_BYTES - 16);
            xcd_barrier(b_, tid0);
        }
    }
}

#ifdef PROBE_EMASK
#define PEER_EM(e) (DRY ? ((e) & PROBE_EMASK) : (e))
#else
#define PEER_EM(e) (e)
#endif
template <bool DRY> DEV void ph_peer_pipe(const Args& a, const int tid0, const int gw, const int nw, const int ntok) {
    const int lane = tid0 & 63;
    bf16_t* hb = wsb(a, HB_OFF); float* rstd = wsf(a, RSTD_OFF); const float* ssq = wsf(a, SSQ_OFF);
    const int* TOPI = (const int*)(a.ws + TOPI_OFF); const float* TOPG = wsf(a, TOPG_OFF);
    const unsigned char* PU = a.ws + PTU_OFF; const unsigned char* PV = a.ws + PTV_OFF;
    const int c16 = 16 * lane;
    const bool b5 = lane & 32, b4 = lane & 16, b3 = lane & 8;
    const bool dost = DRY ? (__builtin_amdgcn_readfirstlane(TOPI[0]) == -12345) : true;
    u32x4 ur[2][8], vr[8];
    int e0, e1, e0n = 0, e1n = 0; float g0, g1, g0n = 0.f, g1n = 0.f;
    u32x4 xa, xb, xan = {0u, 0u, 0u, 0u}, xbn = {0u, 0u, 0u, 0u}; float rsv, rsn = 0.f;
#define PEER_ISSUE_U(slot_, b_, es0_, es1_) do { _Pragma("unroll") for (int i_ = 0; i_ < 8; ++i_) { const int k_ = (b_) * 8 + i_; \
        const int e_ = PEER_EM(__builtin_amdgcn_readlane((k_ < 64) ? (es0_) : (es1_), k_ & 63)); ur[slot_][i_] = *(const u32x4*)(PU + (size_t)e_ * 1024 + c16); } } while (0)
#define PEER_ISSUE_V(slot_, b_, es0_, es1_) do { _Pragma("unroll") for (int i_ = 0; i_ < 8; ++i_) { const int k_ = (b_) * 8 + i_; \
        const int e_ = PEER_EM(__builtin_amdgcn_readlane((k_ < 64) ? (es0_) : (es1_), k_ & 63)); vr[i_] = *(const u32x4*)(PV + (size_t)e_ * 1024 + c16); } } while (0)
    if (ntok <= 0) return;
    {   const int t0 = gw;
        e0 = TOPI[(size_t)t0 * 128 + lane]; e1 = TOPI[(size_t)t0 * 128 + 64 + lane]; g0 = TOPG[(size_t)t0 * 128 + lane]; g1 = TOPG[(size_t)t0 * 128 + 64 + lane];
        xa = *(const u32x4*)(hb + (size_t)t0 * 1024 + c16); xb = *(const u32x4*)(hb + (size_t)t0 * 1024 + c16 + 8); rsv = rstd_parts(ssq, t0); }
    PEER_ISSUE_U(0, 0, e0, e1);
#pragma unroll 1
    for (int j = 0; j < ntok; ++j) {
        const int t = gw + nw * j; const bool more = (j + 1 < ntok);
        float* hr = a.h + (size_t)t * 1024 + c16;
        if (more) { const int tn = t + nw;
            e0n = TOPI[(size_t)tn * 128 + lane]; e1n = TOPI[(size_t)tn * 128 + 64 + lane]; }
        const float rs = rsv * (1.0f / 256.0f);
        float out[16];
#pragma unroll
        for (int i = 0; i < 16; ++i) out[i] = 0.f;
#pragma unroll 1
        for (int b2 = 0; b2 < 16; b2 += 2)
#pragma unroll
        for (int bb = 0; bb < 2; ++bb) {
            const int b = b2 + bb;
            PEER_ISSUE_V(0, b, e0, e1);
            if (bb == 0) PEER_ISSUE_U(1, b + 1, e0, e1);
            else if (b < 15) PEER_ISSUE_U(0, b + 1, e0, e1);
            else if (more) PEER_ISSUE_U(0, 0, e0n, e1n);
            asm volatile("" ::: "memory");
            float d[8];
#pragma unroll
            for (int i = 0; i < 8; ++i) {
                float sm = 0.f;
#pragma unroll
                for (int q = 0; q < 4; ++q) {
                    const unsigned uw = ur[bb][i][q];
                    const f32x2 lo = __builtin_amdgcn_cvt_pk_f32_fp8((int)uw, false), hi = __builtin_amdgcn_cvt_pk_f32_fp8((int)uw, true);
                    const unsigned ulo = (__float_as_uint(lo[0]) >> 16) | (__float_as_uint(lo[1]) & 0xffff0000u), uhi = (__float_as_uint(hi[0]) >> 16) | (__float_as_uint(hi[1]) & 0xffff0000u);
                    const unsigned xlo = (q < 2) ? xa[2 * q] : xb[2 * q - 4], xhi = (q < 2) ? xa[2 * q + 1] : xb[2 * q - 3];
                    sm = dot2bf(ulo, xlo, sm); sm = dot2bf(uhi, xhi, sm);
                }
                d[i] = sm;
            }
            float r4[4], r2[2];
#pragma unroll
            for (int i = 0; i < 4; ++i) { const float send = b5 ? d[i] : d[4 + i], keep = b5 ? d[4 + i] : d[i]; r4[i] = keep + SHX(send, 32); }
#pragma unroll
            for (int i = 0; i < 2; ++i) { const float send = b4 ? r4[i] : r4[2 + i], keep = b4 ? r4[2 + i] : r4[i]; r2[i] = keep + SHX(send, 16); }
            const float send1 = b3 ? r2[0] : r2[1], keep1 = b3 ? r2[1] : r2[0];
            const float dd = sum8(keep1 + SHX(send1, 8));
            const float hp = rs * dd;
            const float gt = SHF((b < 8) ? g0 : g1, (b * 8 + (lane >> 3)) & 63);
            const float w = gt * 0.5f * hp * (1.0f + erff(hp * 0.70710678f)) * (1.0f / 32.0f);
#pragma unroll
            for (int i = 0; i < 8; ++i) {
                const float wi = rl(w, 8 * i);
#pragma unroll
                for (int q = 0; q < 4; ++q) {
                    const unsigned vw = vr[i][q];
                    const f32x2 lo = __builtin_amdgcn_cvt_pk_f32_fp8((int)vw, false), hi = __builtin_amdgcn_cvt_pk_f32_fp8((int)vw, true);
                    out[4 * q] += wi * lo[0]; out[4 * q + 1] += wi * lo[1]; out[4 * q + 2] += wi * hi[0]; out[4 * q + 3] += wi * hi[1];
                }
            }
        }
        if (more) { const int tn = t + nw;
            g0n = TOPG[(size_t)tn * 128 + lane]; g1n = TOPG[(size_t)tn * 128 + 64 + lane];
            xan = *(const u32x4*)(hb + (size_t)tn * 1024 + c16); xbn = *(const u32x4*)(hb + (size_t)tn * 1024 + c16 + 8); rsn = rstd_parts(ssq, tn); }
        float ss = 0.f;
        f32x4 hv[4];
#pragma unroll
        for (int q = 0; q < 4; ++q) hv[q] = *(const f32x4*)(hr + 4 * q);
#pragma unroll
        for (int q = 0; q < 4; ++q) {
#pragma unroll
            for (int c = 0; c < 4; ++c) { hv[q][c] += out[4 * q + c]; ss += hv[q][c] * hv[q][c]; }
            if (dost) *(f32x4*)(hr + 4 * q) = hv[q];
        }
        ss = wave_sum(ss);
        if (dost) {
            u32x4 p0, p1;
            p0.x = pack2(hv[0][0], hv[0][1]); p0.y = pack2(hv[0][2], hv[0][3]); p0.z = pack2(hv[1][0], hv[1][1]); p0.w = pack2(hv[1][2], hv[1][3]);
            p1.x = pack2(hv[2][0], hv[2][1]); p1.y = pack2(hv[2][2], hv[2][3]); p1.z = pack2(hv[3][0], hv[3][1]); p1.w = pack2(hv[3][2], hv[3][3]);
            *(u32x4*)(hb + (size_t)t * 1024 + c16) = p0; *(u32x4*)(hb + (size_t)t * 1024 + c16 + 8) = p1;
            if (lane == 0) rstd[t] = rsqrtf(ss * (1.0f / 1024.0f) + 1e-6f);
        }
        e0 = e0n; e1 = e1n; g0 = g0n; g1 = g1n; xa = xan; xb = xbn; rsv = rsn;
    }
#undef PEER_ISSUE_U
#undef PEER_ISSUE_V
}

#ifndef PEER_NCH
#define PEER_NCH 8
#endif
#ifndef PEER_NPW
#define PEER_NPW 3
#endif
DEV void ph_topk_peer(const Args& a, float* lds, const int tid0) {
    const int wv = __builtin_amdgcn_readfirstlane(tid0 >> 6);
    constexpr int CH = T / PEER_NCH;
    const int npeer = gridDim.x * PEER_NPW, ntopk = gridDim.x * (8 - PEER_NPW);
#pragma unroll 1
    for (int s = 0; s <= PEER_NCH; ++s) {
        if (wv < PEER_NPW) {
            if (s >= 1) { const int pw = blockIdx.x * PEER_NPW + wv; ph_peer_pipe<false>(a, tid0, (s - 1) * CH + pw, npeer, (CH - pw + npeer - 1) / npeer); }
        } else {
            if (s < PEER_NCH) { const int tw = blockIdx.x * (8 - PEER_NPW) + (wv - PEER_NPW); ph_topk2(a, lds, tid0, s * CH * 4 + tw, ntopk, (s + 1) * CH * 4); }
        }
        XcdBarrier b_; b_.bar = (unsigned*)(a.ws + BAR_OFF); b_.x = xb_xcc_id(); b_.st = (volatile LAS unsigned*)(smem_base() + LDS_BYTES - 16);
        xcd_barrier(b_, tid0);
    }
}

extern __shared__ __attribute__((aligned(16))) unsigned char smem[];

enum { PH_PROLOGUE = 0, PH_ROWPREP_X, PH_ROWPREP, PH_GEMM1, PH_ATTN, PH_MERGE, PH_LORA, PH_PREP2, PH_SCAN, PH_POST, PH_GEMM2, PH_CONVERT, PH_GEMM3, PH_TOPK, PH_PEER, PH_PEERDRY, PH_TOPKPEER, PH_GEMM4A, PH_GEMM4B, PH_FINAL };

template <int PH> DEV void run_phase(const Args& a, int layer, const int tid0) {
    float* ldsf = (float*)smem;
    PG8_LAS unsigned char* ldsg = (PG8_LAS unsigned char*)smem;
    const bf16_t* wb = wsb(a, WB_OFF + (size_t)layer * WB_LAYER);
    if constexpr (PH == PH_PROLOGUE) ph_prologue(a, ldsf, tid0);
    else if constexpr (PH == PH_ROWPREP_X) ph_rowprep(a, true, tid0);
    else if constexpr (PH == PH_ROWPREP) ph_rowprep(a, false, tid0);
    else if constexpr (PH == PH_GEMM1) {
        pg8::Gemm g{wsb(a, HB_OFF), wb + WB_IN / 2, T, INP, 1024};
        pg8::StaticOrder S; S.init(T, INP, gridDim.x, blockIdx.x);
        pg8::EpiProj E{wsb(a, QKV_OFF), wsb(a, U_OFF), wsf(a, SSQ_OFF), wsf(a, ROPEC_OFF), wsf(a, ROPES_OFF)};
        pg8::gemm_phase<pg8::EpiProj, pg8::StaticOrder, false>(ldsg, g, S, E, nullptr, tid0);
    }
    else if constexpr (PH == PH_ATTN) ph_attn2(a, smem, tid0);
    else if constexpr (PH == PH_MERGE) ph_attn_merge(a, layer, tid0);
    else if constexpr (PH == PH_LORA) ph_rwkv_prep1(a, layer, smem, tid0);
    else if constexpr (PH == PH_PREP2) ph_rwkv_prep2(a, layer, tid0);
    else if constexpr (PH == PH_SCAN) ph_scan2(a, layer, ldsf, tid0);
    else if constexpr (PH == PH_POST) ph_post2(a, layer, tid0);
    else if constexpr (PH == PH_GEMM2) {
        pg8::Gemm g{wsb(a, MIX_OFF), wb + WB_OUT / 2, T, 1024, 1024};
        pg8::StaticOrder S; S.init(T, 1024, gridDim.x, blockIdx.x);
        pg8::EpiF32x<1> E{a.h, 1024, nullptr, wsb(a, HB_OFF), wsf(a, SSQ_OFF)};
        pg8::gemm_phase<pg8::EpiF32x<1>, pg8::StaticOrder, false>(ldsg, g, S, E, nullptr, tid0);
    }
    else if constexpr (PH == PH_CONVERT) ph_convert8(a, layer, tid0);
    else if constexpr (PH == PH_GEMM3) {
        pg8::Gemm g{wsb(a, HB_OFF), wb + WB_QK / 2, T, 2048, 1024};
        pg8::StaticOrder S; S.init(T, 2048, gridDim.x, blockIdx.x);
        pg8::EpiF32x<0> E{wsf(a, SC_OFF), 2048, nullptr, nullptr, nullptr};
        pg8::gemm_phase<pg8::EpiF32x<0>, pg8::StaticOrder, false>(ldsg, g, S, E, nullptr, tid0);
    }
    else if constexpr (PH == PH_TOPK) ph_topk2(a, ldsf, tid0, blockIdx.x * 8 + (tid0 >> 6), gridDim.x * 8, T * 4);
    else if constexpr (PH == PH_TOPKPEER) ph_topk_peer(a, ldsf, tid0);
    else if constexpr (PH == PH_PEER) ph_peer_pipe<false>(a, tid0, blockIdx.x * 8 + (tid0 >> 6), gridDim.x * 8, T / (gridDim.x * 8));
    else if constexpr (PH == PH_PEERDRY) ph_peer_pipe<true>(a, tid0, blockIdx.x * 8 + (tid0 >> 6), gridDim.x * 8, T / (gridDim.x * 8));
    else if constexpr (PH == PH_GEMM4A) {
        pg8::Gemm g{wsb(a, HB_OFF), wb + WB_GATE / 2, T, 1024, 1024};
        pg8::StaticOrder S; S.init(T, 1024, gridDim.x, blockIdx.x);
        pg8::EpiGate E{wsb(a, GATE_OFF), wsf(a, RSTD_OFF), a.ple_b_gate + layer * 1024};
        pg8::gemm_phase<pg8::EpiGate, pg8::StaticOrder, false>(ldsg, g, S, E, nullptr, tid0);
    }
    else if constexpr (PH == PH_GEMM4B) {
        pg8::Gemm g{wsb(a, PB_OFF), wb + WB_PROJ / 2, T, 1024, 256};
        pg8::StaticOrder S; S.init(T, 1024, gridDim.x, blockIdx.x);
        pg8::EpiF32x<2> E{a.h, 1024, wsb(a, GATE_OFF), wsb(a, HB_OFF), wsf(a, SSQ_OFF)};
        pg8::gemm_phase<pg8::EpiF32x<2>, pg8::StaticOrder, false>(ldsg, g, S, E, nullptr, tid0);
    }
    else if constexpr (PH == PH_FINAL) ph_final(a, tid0);
}

#if !ONE_LAUNCH
template <int PH> __global__ void __launch_bounds__(NTHR, 2) k_phase(Args a, int layer) { run_phase<PH>(a, layer, (int)threadIdx.x); }
#endif

#if ONE_LAUNCH
#ifndef REP_PEER
#define REP_PEER 1
#endif
#ifndef REP_SCAN
#define REP_SCAN 1
#endif
#ifndef REP_TOPK
#define REP_TOPK 1
#endif
#ifndef REP_GEMM1
#define REP_GEMM1 1
#endif
#ifndef REP_LORA
#define REP_LORA 1
#endif
#ifndef REP_POST
#define REP_POST 1
#endif
#ifndef REP_ATTN
#define REP_ATTN 1
#endif
#ifndef REP_GEMM3
#define REP_GEMM3 1
#endif
typedef const __attribute__((address_space(4))) unsigned long long* kargs_t;
static_assert(sizeof(Args) == 31 * 8, "Args is 31 pointers, no padding");
#define AS1 __attribute__((address_space(1)))
DEV Args load_args(kargs_t kp) {
    Args r; const float** d = (const float**)&r;
#pragma unroll
    for (int i = 0; i < 29; ++i) d[i] = (const float*)(AS1 const float*)kp[i];
    r.h = (float*)(AS1 float*)kp[29]; r.ws = (unsigned char*)(AS1 unsigned char*)kp[30];
    return r; }
#define RUN(PH, layer) do { kargs_t kp_ = (kargs_t)__builtin_amdgcn_kernarg_segment_ptr(); asm volatile("" : "+s"(kp_)); const Args la_ = load_args(kp_); int t_; asm volatile("v_mbcnt_lo_u32_b32 %0, -1, 0\n\tv_mbcnt_hi_u32_b32 %0, -1, %0\n\tv_lshl_add_u32 %0, %1, 6, %0" : "=&v"(t_) : "s"(wv0_)); run_phase<PH>(la_, layer, t_); } while (0)
#define BAR() do { kargs_t kp_ = (kargs_t)__builtin_amdgcn_kernarg_segment_ptr(); asm volatile("" : "+s"(kp_)); XcdBarrier b_; b_.bar = (unsigned*)((unsigned char*)kp_[30] + BAR_OFF); b_.x = xb_xcc_id(); b_.st = (volatile LAS unsigned*)(smem + LDS_BYTES - 16); int t_; asm volatile("v_mbcnt_lo_u32_b32 %0, -1, 0\n\tv_mbcnt_hi_u32_b32 %0, -1, %0\n\tv_lshl_add_u32 %0, %1, 6, %0" : "=&v"(t_) : "s"(wv0_)); xcd_barrier(b_, t_); } while (0)
#define LAYER_BODY(layer) do { \
        for (int rep_ = 0; rep_ < REP_GEMM1; ++rep_) { RUN(PH_GEMM1, layer); BAR(); } \
        for (int rep_ = 0; rep_ < REP_ATTN; ++rep_) { RUN(PH_ATTN, layer); BAR(); RUN(PH_MERGE, layer); BAR(); } \
        for (int rep_ = 0; rep_ < REP_LORA; ++rep_) { RUN(PH_LORA, layer); BAR(); } \
        RUN(PH_PREP2, layer); BAR(); \
        for (int rep_ = 0; rep_ < REP_SCAN; ++rep_) { RUN(PH_SCAN, layer); BAR(); } \
        for (int rep_ = 0; rep_ < REP_POST; ++rep_) { RUN(PH_POST, layer); BAR(); } \
        RUN(PH_GEMM2, layer); BAR(); \
        RUN(PH_CONVERT, layer); BAR(); \
        for (int rep_ = 0; rep_ < REP_GEMM3; ++rep_) { RUN(PH_GEMM3, layer); BAR(); } \
        RUN(PH_TOPKPEER, layer); \
        RUN(PH_GEMM4A, layer); BAR(); \
        RUN(PH_GEMM4B, layer); BAR(); \
    } while (0)
__global__ void __launch_bounds__(NTHR, 2) k_mega(Args a) {
    if (threadIdx.x == 0) *(uint4*)(smem + LDS_BYTES - 16) = make_uint4(0u, 0u, 0u, 0u);
    __syncthreads();
    (void)xcd_barrier_post((unsigned*)(a.ws + BAR_OFF), (volatile LAS unsigned*)(smem + LDS_BYTES - 16));
    const int wv0_ = __builtin_amdgcn_readfirstlane((int)threadIdx.x >> 6);
    RUN(PH_PROLOGUE, 0);
    RUN(PH_ROWPREP_X, 0); BAR();
    LAYER_BODY(0); LAYER_BODY(1); LAYER_BODY(2); LAYER_BODY(3);
    RUN(PH_FINAL, 0);
}
#endif

#if !ONE_LAUNCH
template <int PH> static void launch_phase(const Args& a, int layer, hipStream_t st) {
    static bool attr = false;
    if (!attr) { (void)hipFuncSetAttribute((const void*)k_phase<PH>, hipFuncAttributeMaxDynamicSharedMemorySize, LDS_BYTES); attr = true; }
    hipLaunchKernelGGL(k_phase<PH>, dim3(NWG), dim3(NTHR), LDS_BYTES, st, a, layer);
}
#endif

extern "C" void kernel_launch(void* const* d_in, const int* in_sizes, int n_in, void* d_out, int out_size, void* d_ws, size_t ws_size, hipStream_t stream) {
    if (n_in != 29 || out_size != T * D || ws_size < WS_END) {
        fprintf(stderr, "kernel_launch: unexpected shapes (n_in %d, out %d, ws %zu, need %zu); nothing launched\n", n_in, out_size, ws_size, (size_t)WS_END);
        return;
    }
    Args a{};
    const float** ap = (const float**)&a;
    for (int i = 0; i < 29; ++i) ap[i] = (const float*)d_in[i];
    a.h = (float*)d_out; a.ws = (unsigned char*)d_ws;
#if ONE_LAUNCH
    static bool attr = false;
    if (!attr) { (void)hipFuncSetAttribute((const void*)k_mega, hipFuncAttributeMaxDynamicSharedMemorySize, LDS_BYTES); attr = true; }
    (void)hipMemsetAsync((char*)d_ws + BAR_OFF, 0, XCD_BAR_WORDS * sizeof(unsigned), stream);
    hipLaunchKernelGGL(k_mega, dim3(NWG), dim3(NTHR), LDS_BYTES, stream, a);
#else
    launch_phase<PH_PROLOGUE>(a, 0, stream);
    launch_phase<PH_ROWPREP_X>(a, 0, stream);
    for (int layer = 0; layer < NL; ++layer) {
        if (layer > 0) launch_phase<PH_ROWPREP>(a, layer, stream);
        launch_phase<PH_GEMM1>(a, layer, stream);
        launch_phase<PH_ATTN>(a, layer, stream);
        launch_phase<PH_MERGE>(a, layer, stream);
        launch_phase<PH_LORA>(a, layer, stream);
        launch_phase<PH_PREP2>(a, layer, stream);
        launch_phase<PH_SCAN>(a, layer, stream);
        launch_phase<PH_POST>(a, layer, stream);
        launch_phase<PH_GEMM2>(a, layer, stream);
        launch_phase<PH_ROWPREP>(a, layer, stream);
        launch_phase<PH_CONVERT>(a, layer, stream);
        launch_phase<PH_GEMM3>(a, layer, stream);
        launch_phase<PH_TOPK>(a, layer, stream);
        launch_phase<PH_PEER>(a, layer, stream);
        launch_phase<PH_GEMM4A>(a, layer, stream);
        launch_phase<PH_GEMM4B>(a, layer, stream);
    }
    launch_phase<PH_FINAL>(a, 0, stream);
#endif
}
```

```cpp
#include <hip/hip_runtime.h>
#include <stdint.h>
#include <stdio.h>

#ifndef ONE_LAUNCH
#define ONE_LAUNCH 1
#endif

#ifndef REP_ATTNX
#define REP_ATTNX 0
#endif
#ifndef REP_MERGE
#define REP_MERGE 0
#endif
#ifndef ATTN_VAR
#define ATTN_VAR 0
#endif

typedef unsigned short bf16_t;
typedef float f32x4 __attribute__((ext_vector_type(4)));
typedef float f32x2 __attribute__((ext_vector_type(2)));
typedef unsigned u32x4 __attribute__((ext_vector_type(4)));
typedef unsigned u32x2 __attribute__((ext_vector_type(2)));
typedef __bf16 bf16x2_t __attribute__((ext_vector_type(2)));

#define DEV __device__ __forceinline__

namespace cfg {
constexpr int NSEQ = 20, SEQ = 4096, T = NSEQ * SEQ, TP = 4 * SEQ, D = 1024, NL = 4;
constexpr int INC = 3456, INP = 3584;
constexpr int QKVW = 1536, UW = 2048, UC = 1920;
constexpr int NWG = 256, NTHR = 512;
constexpr int LDS_BYTES = 147456;
constexpr size_t MiB = 1ull << 20;
constexpr size_t WB_OFF = 0;
constexpr size_t WB_LAYER = 16 * MiB;
constexpr size_t WB_IN = 0, WB_OUT = 7 * MiB, WB_QK = 9 * MiB, WB_GATE = 13 * MiB, WB_PROJ = 15 * MiB, WB_LORA = 15 * MiB + 512 * 1024;
constexpr size_t HB_OFF = 64 * MiB;
constexpr size_t MIX_OFF = 224 * MiB;
constexpr size_t SMALL_OFF = 384 * MiB;
constexpr size_t RSTD_OFF = SMALL_OFF;
constexpr size_t ROPEC_OFF = SMALL_OFF + 512 * 1024, ROPES_OFF = SMALL_OFF + 640 * 1024;
constexpr size_t BAR_OFF = SMALL_OFF + 1 * MiB;
constexpr size_t BIG_OFF = 386 * MiB;
constexpr size_t QKV_OFF = BIG_OFF;
constexpr size_t RS_OFF = BIG_OFF, KS_OFF = BIG_OFF + 80 * MiB, G_OFF = BIG_OFF + 160 * MiB;
constexpr size_t U_OFF = BIG_OFF + 240 * MiB;
constexpr size_t WF_OFF = BIG_OFF + 560 * MiB, WB2_OFF = BIG_OFF + 640 * MiB, AF_OFF = BIG_OFF + 720 * MiB, AB_OFF = BIG_OFF + 800 * MiB;
constexpr size_t OP_OFF = BIG_OFF + 560 * MiB;
constexpr size_t ML_OFF = BIG_OFF + 800 * MiB;
constexpr size_t SC_OFF = BIG_OFF;
constexpr size_t TOPI_OFF = BIG_OFF + 640 * MiB, TOPG_OFF = BIG_OFF + 680 * MiB;
constexpr size_t PTU_OFF = BIG_OFF + 720 * MiB, PTV_OFF = BIG_OFF + 752 * MiB;
constexpr size_t PB_OFF = BIG_OFF + 784 * MiB;
constexpr size_t GATE_OFF = BIG_OFF;
constexpr size_t SSQ_OFF = BIG_OFF + 880 * MiB;
constexpr size_t WS_END = BIG_OFF + 886 * MiB;
}
using namespace cfg;

struct Args {
    const float* x_prompt; const float* x_sample; const float* p_prompt; const float* p_sample;
    const float* norm_mix_g; const float* w_in; const float* att_norm_g; const float* rwkv_shift;
    const float* rwkv_w0; const float* rwkv_w2; const float* rwkv_a0; const float* rwkv_a2; const float* rwkv_g2;
    const float* rwkv_k_k; const float* rwkv_k_a; const float* rwkv_r_k; const float* rwkv_ln_w; const float* rwkv_ln_b;
    const float* w_out; const float* norm_ffn_g; const float* peer_w_q; const float* peer_sub_keys; const float* peer_u; const float* peer_v;
    const float* ple_norm_g; const float* ple_w_gate; const float* ple_b_gate; const float* ple_w_proj; const float* final_norm_g;
    float* h;
    unsigned char* ws;
};

DEV int tid_() { int t = threadIdx.x; asm volatile("" : "+v"(t)); return t; }
DEV float bf2f(unsigned h) { return __uint_as_float(h << 16); }
DEV float bflo(unsigned d) { return __uint_as_float(d << 16); }
DEV float bfhi(unsigned d) { return __uint_as_float(d & 0xffff0000u); }
DEV unsigned f2bf(float f) { const unsigned u = __float_as_uint(f); return (u + 0x7fffu + ((u >> 16) & 1u)) >> 16; }
DEV unsigned pack2(float lo, float hi) { return f2bf(lo) | (f2bf(hi) << 16); }
DEV float dot2bf(unsigned a, unsigned b, float c) { return __builtin_amdgcn_fdot2_f32_bf16(__builtin_bit_cast(bf16x2_t, a), __builtin_bit_cast(bf16x2_t, b), c, false); }
DEV float shx_(float v, int lane, int o) { return __int_as_float(__builtin_amdgcn_ds_bpermute((lane ^ o) << 2, __float_as_int(v))); }
DEV float shf_(float v, int src) { return __int_as_float(__builtin_amdgcn_ds_bpermute(src << 2, __float_as_int(v))); }
DEV int shf_(int v, int src) { return __builtin_amdgcn_ds_bpermute(src << 2, v); }
#define SHX(v, o) shx_((v), lane, (o))
#define SHF(v, src) shf_((v), (src))
DEV float wave_sum_(float v, int lane) {
#pragma unroll
    for (int o = 32; o > 0; o >>= 1) v += shx_(v, lane, o);
    return v;
}
DEV float wave_max_(float v, int lane) {
#pragma unroll
    for (int o = 32; o > 0; o >>= 1) v = fmaxf(v, shx_(v, lane, o));
    return v;
}
#define wave_sum(x) wave_sum_((x), lane)
#define wave_max(x) wave_max_((x), lane)
DEV float sum8(float v) {
    v += __int_as_float(__builtin_amdgcn_mov_dpp(__float_as_int(v), 0xB1, 0xF, 0xF, true));
    v += __int_as_float(__builtin_amdgcn_mov_dpp(__float_as_int(v), 0x4E, 0xF, 0xF, true));
    v += __int_as_float(__builtin_amdgcn_mov_dpp(__float_as_int(v), 0x141, 0xF, 0xF, true));
    return v;
}
DEV float rstd_parts(const float* ssq, int t) { const f32x4* p = (const f32x4*)(ssq + (size_t)t * 16); const f32x4 a = p[0], b = p[1], c = p[2], d = p[3];
    const float s = ((a[0] + a[1]) + (a[2] + a[3])) + ((b[0] + b[1]) + (b[2] + b[3])) + ((c[0] + c[1]) + (c[2] + c[3])) + ((d[0] + d[1]) + (d[2] + d[3]));
    return rsqrtf(s * (1.0f / 1024.0f) + 1e-6f); }
DEV float sigmoidf_(float x) { return 1.0f / (1.0f + __expf(-x)); }
namespace pg8 {
#define PG8_LAS __attribute__((address_space(3)))
typedef unsigned short bf16_t;
typedef short bf16x8 __attribute__((ext_vector_type(8)));
typedef float f32x4 __attribute__((ext_vector_type(4)));
typedef unsigned u32x4 __attribute__((ext_vector_type(4)));
constexpr int BM = 256, BK = 64, HALF = 128, HTB = HALF * BK * 2  , STAGE_BYTES = 8 * HTB, NXCD = 8, WGM = 8;

__host__ __device__ __forceinline__ int lds_byte(int r, int c) { const int st = (r >> 4) * 2 + (c >> 5), rr = r & 15, cc = c & 31, ob = rr * 64 + cc * 2; return st * 1024 + (ob ^ (((ob >> 9) & 1) << 5)); }
__host__ __device__ __forceinline__ void stage_rc(int b, int& R, int& C) { const int st = b / 1024, sb = b % 1024, swz = sb ^ (((sb >> 9) & 1) << 5); R = (st >> 1) * 16 + swz / 64; C = (st & 1) * 32 + (swz % 64) / 2; }
__host__ __device__ __forceinline__ int perm32(int rho) { const int n = rho >> 4, i = rho & 15; return 8 * (i >> 2) + 4 * n + (i & 3); }

struct Unit { int pm, pn; };
struct Gemm { const bf16_t* A; const bf16_t* Bt; int M, N, K; };

struct StaticOrder {
    int nM, nN, nwg, G, c;
    __host__ __device__ void init(int M, int N, int G_, int c_) { nM = M / BM; nN = N / BM; nwg = nM * nN; G = G_; c = c_; }
    __host__ __device__ bool next(int i, Unit& u) const {
        const long L = (long)i * G + c; if (L >= nwg) return false;
        int wgid = (int)L; { const int q = nwg / NXCD, r = nwg % NXCD, xcd = wgid % NXCD, off = wgid / NXCD; wgid = (xcd < r ? xcd * (q + 1) : r * (q + 1) + (xcd - r) * q) + off; }
        const int nig = WGM * nN, gid = wgid / nig, fm = gid * WGM, gsz = (nM - fm) < WGM ? (nM - fm) : WGM;
        u.pm = fm + ((wgid % nig) % gsz); u.pn = (wgid % nig) / gsz; return true;
    }
    __device__ __forceinline__ void a_ready(const Unit&) const {}
    __device__ __forceinline__ void done(const Unit&) const {}
};
__device__ __forceinline__ unsigned cvt_pk_bf16(float lo, float hi) { unsigned r; asm volatile("v_cvt_pk_bf16_f32 %0, %1, %2" : "=v"(r) : "v"(lo), "v"(hi)); return r; }

struct EpiProj {
    static constexpr bool PERM = true, AFTER_DRAIN = false;
    bf16_t* qkv; bf16_t* u; const float* ssq; const float* rc; const float* rs;
    __device__ __forceinline__ void operator()(const f32x4 (&acc)[2][2][4][2], const Unit& un, int wr, int wc, int fr, int fq) const {
        const int row0 = un.pm * BM + wr * 64 + fr, lane = fr + 16 * fq;
        const bool isq = un.pn < 6;
        bf16_t* base = isq ? qkv : u; const int ld = isq ? 1536 : 2048; const int colt = isq ? un.pn * BM : (un.pn - 6) * BM;
        const int col0 = colt + wc * 32 + 8 * fq;
        const bool rope = (un.pn < 4) && ((wc & 1) == 0);
#pragma unroll
        for (int ai = 0; ai < 2; ++ai)
#pragma unroll
            for (int m = 0; m < 4; ++m) {
                const int row = row0 + ai * HALF + m * 16; const float s = rstd_parts(ssq, row); const int pos = row & 4095;
                f32x4 c0 = {1.f, 1.f, 1.f, 1.f}, c1 = c0, s0 = {0.f, 0.f, 0.f, 0.f}, s1 = s0;
                if (rope) { c0 = *(const f32x4*)(rc + pos * 8); c1 = *(const f32x4*)(rc + pos * 8 + 4); s0 = *(const f32x4*)(rs + pos * 8); s1 = *(const f32x4*)(rs + pos * 8 + 4); }
                bf16_t* rowp = base + (size_t)row * ld + col0;
#pragma unroll
                for (int bj = 0; bj < 2; ++bj) {
                    f32x4 v0 = acc[ai][bj][m][0] * s, v1 = acc[ai][bj][m][1] * s;
                    if (rope) {
                        f32x4 o0, o1;
#pragma unroll
                        for (int c = 0; c < 4; ++c) { o0[c] = SHX(v0[c], 16); o1[c] = SHX(v1[c], 16); }
                        if (fq == 0) { v0 = v0 * c0 - o0 * s0; v1 = v1 * c1 - o1 * s1; }
                        else if (fq == 1) { v0 = v0 * c0 + o0 * s0; v1 = v1 * c1 + o1 * s1; }
                    }
                    u32x4 w; w.x = cvt_pk_bf16(v0[0], v0[1]); w.y = cvt_pk_bf16(v0[2], v0[3]); w.z = cvt_pk_bf16(v1[0], v1[1]); w.w = cvt_pk_bf16(v1[2], v1[3]);
                    *(u32x4*)(rowp + bj * HALF) = w;
                }
            }
    }
};
template <int MODE> struct EpiF32x {
    static constexpr bool PERM = false, AFTER_DRAIN = false;
    float* C; int ldc; const bf16_t* gate; bf16_t* hb; float* ssq;
    __device__ __forceinline__ void operator()(const f32x4 (&acc)[2][2][4][2], const Unit& un, int wr, int wc, int fr, int fq) const {
        const int row0 = un.pm * BM + wr * 64 + fr, col0 = un.pn * BM + wc * 32 + 4 * fq, lane = fr + 16 * fq;
#pragma unroll
        for (int ai = 0; ai < 2; ++ai)
#pragma unroll
            for (int m = 0; m < 4; ++m) {
                const int row = row0 + ai * HALF + m * 16;
                const size_t ro = (size_t)row * ldc + col0;
                if (MODE != 0) asm volatile("" ::: "memory");
                float ss = 0.f;
#pragma unroll
                for (int bj = 0; bj < 2; ++bj)
#pragma unroll
                    for (int n = 0; n < 2; ++n) {
                        if (MODE == 2 && (bj | n)) asm volatile("" ::: "memory");
                        f32x4* p = (f32x4*)(C + ro + bj * HALF + n * 16);
                        if (MODE == 0) *p = acc[ai][bj][m][n];
                        else {
                            f32x4 v;
                            if (MODE == 1) v = *p + acc[ai][bj][m][n];
                            else { const u32x2 g = *(const u32x2*)(gate + ro + bj * HALF + n * 16);
                                   f32x4 gv; gv[0] = __uint_as_float(g.x << 16); gv[1] = __uint_as_float(g.x & 0xffff0000u); gv[2] = __uint_as_float(g.y << 16); gv[3] = __uint_as_float(g.y & 0xffff0000u);
                                   v = *p + gv * acc[ai][bj][m][n]; }
                            *p = v;
                            ss += (v[0] * v[0] + v[1] * v[1]) + (v[2] * v[2] + v[3] * v[3]);
                            u32x2 pk; pk.x = cvt_pk_bf16(v[0], v[1]); pk.y = cvt_pk_bf16(v[2], v[3]);
                            *(u32x2*)(hb + ro + bj * HALF + n * 16) = pk;
                        }
                    }
                if (MODE != 0) {
                    ss += SHX(ss, 16); ss += SHX(ss, 32);
                    if (fq == 0) ssq[(size_t)row * 16 + un.pn * 4 + wc] = ss;
                }
            }
    }
};
struct EpiGate {
    static constexpr bool PERM = true, AFTER_DRAIN = false;
    bf16_t* O; const float* rstd; const float* bias;
    __device__ __forceinline__ void operator()(const f32x4 (&acc)[2][2][4][2], const Unit& un, int wr, int wc, int fr, int fq) const {
        const int row0 = un.pm * BM + wr * 64 + fr, col0 = un.pn * BM + wc * 32 + 8 * fq;
        f32x4 bv[2][2];
#pragma unroll
        for (int bj = 0; bj < 2; ++bj)
#pragma unroll
            for (int n = 0; n < 2; ++n) bv[bj][n] = *(const f32x4*)(bias + col0 + bj * HALF + 4 * n);
#pragma unroll
        for (int ai = 0; ai < 2; ++ai)
#pragma unroll
            for (int m = 0; m < 4; ++m) {
                const int row = row0 + ai * HALF + m * 16; const float s = rstd[row];
                bf16_t* rowp = O + (size_t)row * 1024 + col0;
#pragma unroll
                for (int bj = 0; bj < 2; ++bj) {
                    f32x4 v0 = acc[ai][bj][m][0] * s + bv[bj][0], v1 = acc[ai][bj][m][1] * s + bv[bj][1];
#pragma unroll
                    for (int c = 0; c < 4; ++c) { v0[c] = 1.0f / (1.0f + __expf(-v0[c])); v1[c] = 1.0f / (1.0f + __expf(-v1[c])); }
                    u32x4 w; w.x = cvt_pk_bf16(v0[0], v0[1]); w.y = cvt_pk_bf16(v0[2], v0[3]); w.z = cvt_pk_bf16(v1[0], v1[1]); w.w = cvt_pk_bf16(v1[2], v1[3]);
                    *(u32x4*)(rowp + bj * HALF) = w;
                }
            }
    }
};
template <class Epi, class Sched, bool STAMP = false>
__device__ __forceinline__ void gemm_phase(PG8_LAS unsigned char* lds, const Gemm g, const Sched& S, const Epi& E, unsigned long long* stamps, const int tid_in) {
    const int tid = tid_in, wid = __builtin_amdgcn_readfirstlane(tid >> 6), lane = tid & 63, wr = wid >> 2, wc = wid & 3, fr = lane & 15, fq = lane >> 4;
    const int K = g.K, nt = K / BK;
    int ts_lo = 0, ts_hi = 0, nts = 0; const unsigned long long rt_entry = STAMP ? (unsigned long long)wall_clock64() : 0ull;
#define PG8_STAMP() do { if (STAMP && wid == 0 && nts < 64) { const unsigned long long _c = (unsigned long long)clock64(); \
        ts_lo = (lane == nts) ? (int)(unsigned)_c : ts_lo; ts_hi = (lane == nts) ? (int)(unsigned)(_c >> 32) : ts_hi; ++nts; } } while (0)
    PG8_STAMP();
    unsigned voffA[2], voffB[2];
#pragma unroll
    for (int i = 0; i < 2; ++i) { int R, C; stage_rc(tid * 16 + i * 8192, R, C); const int Rb = Epi::PERM ? ((R & ~31) + perm32(R & 31)) : R;
        voffA[i] = (unsigned)(R * K + C) * 2u; voffB[i] = (unsigned)(Rb * K + C) * 2u; }
    const size_t kstep = (size_t)(BK * 2);
    const size_t hstep = (size_t)HALF * K * 2;
    const size_t tstep = 2 * hstep;
    const unsigned ldsw = (unsigned)wid * 1024u;
    const int aoff = lds_byte(wr * 64 + fr, fq * 8), boff = lds_byte(wc * 32 + fr, fq * 8);
#define PG8_SA(b, h) (((b) * 2 + (h)) * HTB)
#define PG8_SB(b, h) ((4 + (b) * 2 + (h)) * HTB)
#define PG8_STAGE(bufoff, gbase, voff) do { _Pragma("unroll") for (int _i = 0; _i < 2; ++_i) \
        __builtin_amdgcn_global_load_lds((const unsigned*)((const char*)(gbase) + (voff)[_i]), (PG8_LAS unsigned*)(lds + (bufoff) + ldsw + _i * 8192), 16, 0, 0); } while (0)
#define PG8_LDA(dst, b, h) do { _Pragma("unroll") for (int m = 0; m < 4; ++m) _Pragma("unroll") for (int k = 0; k < 2; ++k) dst[m][k] = *(const PG8_LAS bf16x8*)(lds + PG8_SA(b, h) + aoff + m * 2048 + k * 1024); } while (0)
#define PG8_LDB(dst, b, h) do { _Pragma("unroll") for (int n = 0; n < 2; ++n) _Pragma("unroll") for (int k = 0; k < 2; ++k) dst[n][k] = *(const PG8_LAS bf16x8*)(lds + PG8_SB(b, h) + boff + n * 2048 + k * 1024); } while (0)
#define PG8_MMA(ai, bj, At, Bt) do { __builtin_amdgcn_s_setprio(1); _Pragma("unroll") for (int m = 0; m < 4; ++m) _Pragma("unroll") for (int n = 0; n < 2; ++n) _Pragma("unroll") for (int k = 0; k < 2; ++k) \
        acc[ai][bj][m][n] = __builtin_amdgcn_mfma_f32_16x16x32_bf16(Bt[n][k], At[m][k], acc[ai][bj][m][n], 0, 0, 0); __builtin_amdgcn_s_setprio(0); } while (0)
#define PG8_WAIT_V(n) asm volatile("s_waitcnt vmcnt(" #n ")" ::: "memory")
#define PG8_WAIT_L(n) asm volatile("s_waitcnt lgkmcnt(" #n ")" ::: "memory")
#define PG8_BAR __builtin_amdgcn_s_barrier()
#define PG8_SCHED __builtin_amdgcn_sched_barrier(0)
    Unit cur, nxt; int ui = 0;
    if (!S.next(0, cur)) return;
    f32x4 acc[2][2][4][2];
#pragma unroll
    for (int a = 0; a < 2; ++a)
#pragma unroll
        for (int b = 0; b < 2; ++b)
#pragma unroll
            for (int m = 0; m < 4; ++m)
#pragma unroll
                for (int n = 0; n < 2; ++n) acc[a][b][m][n] = (f32x4){0.f, 0.f, 0.f, 0.f};
    bf16x8 At[4][2], B0[2][2], B1[2][2];
    const char* cA = (const char*)g.A + (size_t)cur.pm * tstep; const char* cB = (const char*)g.Bt + (size_t)cur.pn * tstep;
    S.a_ready(cur);
    PG8_STAGE(PG8_SB(0, 0), cB, voffB); PG8_STAGE(PG8_SA(0, 0), cA, voffA); PG8_STAGE(PG8_SB(0, 1), cB + hstep, voffB); PG8_STAGE(PG8_SA(0, 1), cA + hstep, voffA);
    if (wr == 1) PG8_BAR;
    PG8_WAIT_V(4); PG8_BAR;
    PG8_STAGE(PG8_SB(1, 0), cB + kstep, voffB); PG8_STAGE(PG8_SA(1, 0), cA + kstep, voffA); PG8_STAGE(PG8_SB(1, 1), cB + hstep + kstep, voffB);
    PG8_WAIT_V(6); PG8_BAR;
    PG8_STAMP();
    for (;;) {
        const bool has_next = S.next(ui + 1, nxt);
        const char* nA = has_next ? (const char*)g.A + (size_t)nxt.pm * tstep : cA; const char* nB = has_next ? (const char*)g.Bt + (size_t)nxt.pn * tstep : cB;
        for (int t = 0; t < nt; t += 2) {
            const bool last = (t == nt - 2);
            const char* a1 = cA + (size_t)(t + 1) * kstep;
            const char* a2 = last ? nA : cA + (size_t)(t + 2) * kstep; const char* b2 = last ? nB : cB + (size_t)(t + 2) * kstep;
            const char* a3 = a2 + kstep; const char* b3 = b2 + kstep;
            if (last && has_next) S.a_ready(nxt);
            PG8_LDB(B0, 0, 0); PG8_SCHED; PG8_LDA(At, 0, 0); PG8_STAGE(PG8_SA(1, 1), a1 + hstep, voffA);
            PG8_WAIT_L(8); PG8_BAR; PG8_WAIT_L(0); PG8_MMA(0, 0, At, B0); PG8_BAR; PG8_SCHED;
            PG8_LDB(B1, 0, 1); PG8_STAGE(PG8_SB(0, 0), b2, voffB);
            PG8_BAR; PG8_WAIT_L(0); PG8_MMA(0, 1, At, B1); PG8_BAR;
            PG8_LDA(At, 0, 1); PG8_STAGE(PG8_SA(0, 0), a2, voffA);
            PG8_BAR; PG8_WAIT_L(0); PG8_MMA(1, 0, At, B0); PG8_BAR; PG8_SCHED;
            PG8_STAGE(PG8_SB(0, 1), b2 + hstep, voffB);
            PG8_WAIT_V(6); PG8_BAR; PG8_MMA(1, 1, At, B1); PG8_BAR;
            PG8_LDB(B0, 1, 0); PG8_SCHED; PG8_LDA(At, 1, 0); PG8_STAGE(PG8_SA(0, 1), a2 + hstep, voffA);
            PG8_WAIT_L(8); PG8_BAR; PG8_WAIT_L(0); PG8_MMA(0, 0, At, B0); PG8_BAR; PG8_SCHED;
            PG8_LDB(B1, 1, 1); PG8_STAGE(PG8_SB(1, 0), b3, voffB);
            PG8_BAR; PG8_WAIT_L(0); PG8_MMA(0, 1, At, B1); PG8_BAR;
            PG8_LDA(At, 1, 1); PG8_STAGE(PG8_SA(1, 0), a3, voffA);
            PG8_BAR; PG8_WAIT_L(0); PG8_MMA(1, 0, At, B0); PG8_BAR; PG8_SCHED;
            PG8_STAGE(PG8_SB(1, 1), b3 + hstep, voffB);
            PG8_WAIT_V(6); PG8_BAR; PG8_MMA(1, 1, At, B1); PG8_BAR;
        }
        PG8_STAMP();
        if constexpr (!Epi::AFTER_DRAIN) { E(acc, cur, wr, wc, fr, fq); S.done(cur); }
        PG8_STAMP();
        if (!has_next) break;
#pragma unroll
        for (int a = 0; a < 2; ++a)
#pragma unroll
            for (int b = 0; b < 2; ++b)
#pragma unroll
                for (int m = 0; m < 4; ++m)
#pragma unroll
                    for (int n = 0; n < 2; ++n) acc[a][b][m][n] = (f32x4){0.f, 0.f, 0.f, 0.f};
        cur = nxt; cA = nA; cB = nB; ++ui;
    }
    PG8_WAIT_V(0);
    if (wr == 0) PG8_BAR;
    PG8_BAR;
    if constexpr (Epi::AFTER_DRAIN) { E.fused(acc, cur, wr, wc, fr, fq, lds, wid, lane); S.done(cur); }
    PG8_STAMP();
    if (STAMP && wid == 0) { stamps[lane] = lane < nts ? (((unsigned long long)(unsigned)ts_hi << 32) | (unsigned)ts_lo) : 0ull;
        if (lane == 62) stamps[62] = rt_entry; if (lane == 63) stamps[63] = (unsigned long long)wall_clock64(); }
#undef PG8_STAMP
#undef PG8_SA
#undef PG8_SB
#undef PG8_STAGE
#undef PG8_LDA
#undef PG8_LDB
#undef PG8_MMA
#undef PG8_WAIT_V
#undef PG8_WAIT_L
#undef PG8_BAR
#undef PG8_SCHED
}
}
#define XB_TMO      128
#define XB_XCNT(j)  (256  + 64 * (j))
#define XB_XSUB(j)  (1280 + 64 * (j))
#define XB_XGEN(j)  (2304 + 64 * (j))
#define XB_TOP      3328
#define XB_TOPGEN   3392
#define XCD_BAR_WORDS 3456
#define XB_SPIN_CAP (1u << 23)
#define LAS __attribute__((address_space(3)))

__device__ __forceinline__ unsigned xb_ld(unsigned* p)              { return __hip_atomic_load(p, __ATOMIC_RELAXED, __HIP_MEMORY_SCOPE_AGENT); }
__device__ __forceinline__ unsigned xb_add(unsigned* p, unsigned v) { return __hip_atomic_fetch_add(p, v, __ATOMIC_RELAXED, __HIP_MEMORY_SCOPE_AGENT); }
__device__ __forceinline__ unsigned xb_xcc_id() { return (unsigned)__builtin_amdgcn_s_getreg((3 << 11) | 20) & 0xFu; }
#define XB_SPIN(cond, bar) do { unsigned _sp = 0; while (cond) { __builtin_amdgcn_s_sleep(1); \
    if ((++_sp & 255u) == 0u) { if (xb_ld(&(bar)[XB_TMO])) break; if (_sp > XB_SPIN_CAP) { atomicAdd(&(bar)[XB_TMO], 1u); break; } } } } while (0)

struct XcdBarrier {
    unsigned* bar; unsigned x;
    volatile LAS unsigned* st;
};

__device__ __forceinline__ XcdBarrier xcd_barrier_post(unsigned* bar, volatile LAS unsigned* st) {
    XcdBarrier b; b.bar = bar; b.x = xb_xcc_id(); b.st = st;
    if (threadIdx.x == 0) (void)xb_add(&bar[XB_XCNT(b.x)], 1u);
    return b;
}
__device__ __forceinline__ void xcd_barrier_complete(unsigned* bar, unsigned x, unsigned& nloc, unsigned& nx) {
    const unsigned G = gridDim.x * gridDim.y * gridDim.z;
    unsigned sum, cnt, mine, sp = 0u;
    for (;;) {
        sum = 0u; cnt = 0u; mine = 0u;
#pragma unroll
        for (unsigned j = 0; j < 16; ++j) { const unsigned c = xb_ld(&bar[XB_XCNT(j)]); sum += c; cnt += (c > 0u) ? 1u : 0u; mine = (j == x) ? c : mine; }
        if (sum == G) break;
        __builtin_amdgcn_s_sleep(1);
        if ((++sp & 255u) == 0u) { if (xb_ld(&bar[XB_TMO])) break; if (sp > XB_SPIN_CAP) { atomicAdd(&bar[XB_TMO], 1u); break; } }
    }
    nloc = mine > 0u ? mine : 1u; nx = cnt > 0u ? cnt : 1u;
}

__device__ __forceinline__ void xcd_barrier(const XcdBarrier& b, const int tid) {
    asm volatile("s_waitcnt vmcnt(0)" ::: "memory");
    __syncthreads();
    if (tid == 0) {
        unsigned* bar = b.bar; unsigned bx = b.x;
        asm volatile("" : "+s"(bar), "+s"(bx));
        __builtin_amdgcn_s_waitcnt(0);
        unsigned nloc = b.st[0], nx = b.st[1];
        if (nloc == 0u) { xcd_barrier_complete(bar, bx, nloc, nx); b.st[0] = nloc; b.st[1] = nx; }
        const unsigned old = xb_add(&bar[XB_XSUB(bx)], 1u);
        const unsigned gen = old / nloc;
        if (old + 1u == (gen + 1u) * nloc) {
            __builtin_amdgcn_fence(__ATOMIC_RELEASE, "agent");
            asm volatile("s_waitcnt vmcnt(0)" ::: "memory");
            const unsigned og = xb_add(&bar[XB_TOP], 1u);
            const unsigned tg = og / nx;
            if (og + 1u == (tg + 1u) * nx) xb_add(&bar[XB_TOPGEN], 1u);
            else XB_SPIN(xb_ld(&bar[XB_TOPGEN]) == tg, bar);
            __builtin_amdgcn_fence(__ATOMIC_ACQUIRE, "agent");
            xb_add(&bar[XB_XGEN(bx)], 1u);
            asm volatile("s_waitcnt vmcnt(0)" ::: "memory");
        } else {
            XB_SPIN(xb_ld(&bar[XB_XGEN(bx)]) == gen, bar);
            __builtin_amdgcn_fence(__ATOMIC_ACQUIRE, "agent");
            asm volatile("s_waitcnt vmcnt(0)" ::: "memory");
        }
    }
    __syncthreads();
}


typedef __attribute__((address_space(3))) unsigned char lds_u8;
extern __shared__ __attribute__((aligned(16))) unsigned char smem[];
DEV unsigned char* smem_base() { return smem; }

DEV bf16_t* wsb(const Args& a, size_t off) { return (bf16_t*)(a.ws + off); }
DEV float* wsf(const Args& a, size_t off) { return (float*)(a.ws + off); }

DEV void ph_rowprep(const Args& a, bool from_x, const int tid0) {
    const int lane = tid0 & 63, wv = tid0 >> 6;
    const int gw = blockIdx.x * 8 + wv, nw = gridDim.x * 8;
    bf16_t* hb = wsb(a, HB_OFF); float* ssq = wsf(a, SSQ_OFF);
    for (int t = gw; t < T; t += nw) {
        const float* src = from_x ? (t < TP ? a.x_prompt + (size_t)t * D : a.x_sample + (size_t)(t - TP) * D) : a.h + (size_t)t * D;
        f32x4 v[4]; float ss = 0.f;
#pragma unroll
        for (int i = 0; i < 4; ++i) { v[i] = *(const f32x4*)(src + (i * 64 + lane) * 4); ss += v[i][0] * v[i][0] + v[i][1] * v[i][1] + v[i][2] * v[i][2] + v[i][3] * v[i][3]; }
        ss = wave_sum(ss);
#pragma unroll
        for (int i = 0; i < 4; ++i) {
            if (from_x) *(f32x4*)(a.h + (size_t)t * D + (i * 64 + lane) * 4) = v[i];
            u32x2 p; p.x = pack2(v[i][0], v[i][1]); p.y = pack2(v[i][2], v[i][3]);
            *(u32x2*)(hb + (size_t)t * D + (i * 64 + lane) * 4) = p;
        }
        if (lane < 16) ssq[(size_t)t * 16 + lane] = (lane == 0) ? ss : 0.f;
    }
}

DEV void ph_final(const Args& a, const int tid0) {
    const int lane = tid0 & 63, wv = tid0 >> 6;
    const int gw = blockIdx.x * 8 + wv, nw = gridDim.x * 8;
    for (int t = gw; t < T; t += nw) {
        float* row = a.h + (size_t)t * D;
        f32x4 v[4]; float ss = 0.f;
#pragma unroll
        for (int i = 0; i < 4; ++i) { v[i] = *(const f32x4*)(row + (i * 64 + lane) * 4); ss += v[i][0] * v[i][0] + v[i][1] * v[i][1] + v[i][2] * v[i][2] + v[i][3] * v[i][3]; }
        ss = wave_sum(ss);
        const float r = rsqrtf(ss * (1.0f / 1024.0f) + 1e-6f);
#pragma unroll
        for (int i = 0; i < 4; ++i) { const f32x4 g = *(const f32x4*)(a.final_norm_g + (i * 64 + lane) * 4); *(f32x4*)(row + (i * 64 + lane) * 4) = v[i] * r * g; }
    }
}

DEV void transpose_cvt(const float* __restrict__ src, bf16_t* __restrict__ dst, int K, int N, int Npad, const float* __restrict__ g, float* tile, const int tid0) {
    const int tx = tid0 & 63, ty = tid0 >> 6;
    const int tk = K / 64, tn = Npad / 64;
    for (int tl = blockIdx.x; tl < tk * tn; tl += gridDim.x) {
        const int k0 = (tl % tk) * 64, n0 = (tl / tk) * 64;
        __syncthreads();
        for (int i = ty; i < 64; i += 8) { const int k = k0 + i, n = n0 + tx; float v = (n < N) ? src[(size_t)k * N + n] : 0.f; if (g) v *= g[k]; tile[i * 65 + tx] = v; }
        __syncthreads();
        for (int i = ty; i < 64; i += 8) dst[(size_t)(n0 + i) * K + k0 + tx] = (bf16_t)f2bf(tile[tx * 65 + i]);
    }
}
DEV void fold_wqk(const Args& a, float* lds, const int tid0) {
    float* swq = lds;
    float* ssk = lds + 64 * 132;
    const int tid = tid0, key = tid & 127, kq = tid >> 7;
    for (int un = blockIdx.x; un < NL * 16 * 16; un += gridDim.x) {
        const int l = un >> 8, hp = (un >> 4) & 15, k0 = (un & 15) * 64;
        __syncthreads();
        for (int i = tid; i < 64 * 128; i += NTHR) { const int r = i >> 7, c = i & 127; swq[r * 132 + c] = a.peer_w_q[((size_t)l * 1024 + k0 + r) * 2048 + hp * 128 + c]; }
        for (int i = tid; i < 128 * 128; i += NTHR) { const int r = i >> 7, c = i & 127; ssk[r * 132 + c] = a.peer_sub_keys[(((size_t)l * 16 + hp) * 128 + r) * 128 + c]; }
        __syncthreads();
        float acc[16];
#pragma unroll
        for (int i = 0; i < 16; ++i) acc[i] = 0.f;
        for (int c = 0; c < 128; c += 4) {
            const f32x4 s = *(const f32x4*)(ssk + key * 132 + c);
#pragma unroll
            for (int i = 0; i < 16; ++i) { const f32x4 w = *(const f32x4*)(swq + (kq * 16 + i) * 132 + c); acc[i] += s[0] * w[0] + s[1] * w[1] + s[2] * w[2] + s[3] * w[3]; }
        }
        bf16_t* dst = wsb(a, WB_OFF + (size_t)l * WB_LAYER + WB_QK) + (size_t)(hp * 128 + key) * 1024 + k0 + kq * 16;
        const float* g = a.norm_ffn_g + l * 1024 + k0 + kq * 16;
#pragma unroll
        for (int i = 0; i < 16; i += 2) *(unsigned*)(dst + i) = pack2(acc[i] * g[i], acc[i + 1] * g[i + 1]);
    }
}
DEV void ph_prologue(const Args& a, float* lds, const int tid0) {
    { float* rc = wsf(a, ROPEC_OFF); float* rs = wsf(a, ROPES_OFF);
      for (int i = blockIdx.x * NTHR + tid0; i < 4096 * 8; i += gridDim.x * NTHR) {
          const int pos = i >> 3, f = i & 7;
          const float invf = (float)pow(500000.0, -(double)f / 8.0);
          const float ang = (float)pos * invf;
          rc[i] = (float)cos((double)ang); rs[i] = (float)sin((double)ang);
      } }
    for (int l = 0; l < NL; ++l) {
        bf16_t* wb = wsb(a, WB_OFF + (size_t)l * WB_LAYER);
        transpose_cvt(a.w_in + (size_t)l * 1024 * INC, wb + WB_IN / 2, 1024, INC, INP, a.norm_mix_g + l * 1024, lds, tid0);
        transpose_cvt(a.w_out + (size_t)l * 1024 * 1024, wb + WB_OUT / 2, 1024, 1024, 1024, nullptr, lds, tid0);
        transpose_cvt(a.ple_w_gate + (size_t)l * 1024 * 1024, wb + WB_GATE / 2, 1024, 1024, 1024, a.ple_norm_g + l * 1024, lds, tid0);
        transpose_cvt(a.ple_w_proj + (size_t)l * 256 * 1024, wb + WB_PROJ / 2, 256, 1024, 1024, nullptr, lds, tid0);
        for (int dr = 0; dr < 2; ++dr) {
            transpose_cvt(a.rwkv_w2 + (size_t)(l * 2 + dr) * 64 * 512, wb + WB_LORA / 2 + dr * 512 * 64, 64, 512, 512, nullptr, lds, tid0);
            transpose_cvt(a.rwkv_a2 + (size_t)(l * 2 + dr) * 64 * 512, wb + WB_LORA / 2 + (2 + dr) * 512 * 64, 64, 512, 512, nullptr, lds, tid0);
        }
        transpose_cvt(a.rwkv_g2 + (size_t)l * 128 * 512, wb + WB_LORA / 2 + 4 * 512 * 64, 128, 512, 512, nullptr, lds, tid0);
    }
    fold_wqk(a, lds, tid0);
}

DEV float sum16(float v) {
    v = sum8(v);
    v += __int_as_float(__builtin_amdgcn_mov_dpp(__float_as_int(v), 0x140, 0xF, 0xF, true));
    return v;
}
DEV float max16(float v) {
    v = fmaxf(v, __int_as_float(__builtin_amdgcn_mov_dpp(__float_as_int(v), 0xB1, 0xF, 0xF, true)));
    v = fmaxf(v, __int_as_float(__builtin_amdgcn_mov_dpp(__float_as_int(v), 0x4E, 0xF, 0xF, true)));
    v = fmaxf(v, __int_as_float(__builtin_amdgcn_mov_dpp(__float_as_int(v), 0x141, 0xF, 0xF, true)));
    v = fmaxf(v, __int_as_float(__builtin_amdgcn_mov_dpp(__float_as_int(v), 0x140, 0xF, 0xF, true)));
    return v;
}
DEV float rl(float v, int l) { return __int_as_float(__builtin_amdgcn_readlane(__float_as_int(v), l)); }
DEV float wave_sum_dpp(float v) { v = sum16(v); return (rl(v, 0) + rl(v, 16)) + (rl(v, 32) + rl(v, 48)); }
DEV unsigned fkey(float f) { const unsigned b = __float_as_uint(f); return b ^ ((unsigned)((int)b >> 31) | 0x80000000u); }
DEV int mbcnt64(unsigned long long m) { return (int)__builtin_amdgcn_mbcnt_hi((unsigned)(m >> 32), __builtin_amdgcn_mbcnt_lo((unsigned)m, 0u)); }

DEV void ph_topk2(const Args& a, float* lds, const int tid0, const int gw, const int nw, const int NP) {
    const int lane = tid0 & 63, wv = __builtin_amdgcn_readfirstlane(tid0 >> 6);
    float* tvb = lds + wv * 64; int* tib = (int*)(lds + 8 * 64) + wv * 64;
    const float* SC = wsf(a, SC_OFF); int* TOPI = (int*)(a.ws + TOPI_OFF); float* TOPG = wsf(a, TOPG_OFF); const float* ssq = wsf(a, SSQ_OFF);
    float vn[2][4];
    if (gw < NP) {
#pragma unroll
        for (int u = 0; u < 2; ++u)
#pragma unroll
            for (int i = 0; i < 4; ++i) vn[u][i] = SC[(size_t)gw * 512 + u * 256 + i * 64 + lane];
    }
    for (int up = gw; up < NP; up += nw) {
        const int t = up >> 2, hd0 = (up & 3) * 2;
        float v[2][4]; unsigned k[2][4];
#pragma unroll
        for (int u = 0; u < 2; ++u)
#pragma unroll
            for (int i = 0; i < 4; ++i) { v[u][i] = vn[u][i]; k[u][i] = fkey(v[u][i]); }
        if (up + nw < NP) {
#pragma unroll
            for (int u = 0; u < 2; ++u)
#pragma unroll
                for (int i = 0; i < 4; ++i) vn[u][i] = SC[(size_t)(up + nw) * 512 + u * 256 + i * 64 + lane];
        }
        unsigned th[4] = {0u, 0u, 0u, 0u}; unsigned dm = 0u;
        for (int b = 31; b >= 0; --b) {
            const unsigned bit = 1u << b;
            unsigned long long ma[4], mb[4];
#pragma unroll
            for (int q = 0; q < 4; ++q) { const unsigned c = th[q] | bit; ma[q] = __ballot(k[q >> 1][2 * (q & 1)] >= c); mb[q] = __ballot(k[q >> 1][2 * (q & 1) + 1] >= c); }
#pragma unroll
            for (int q = 0; q < 4; ++q) {
                const int n = __builtin_popcountll(ma[q]) + __builtin_popcountll(mb[q]);
                th[q] = (n >= 16) ? (th[q] | bit) : th[q]; dm |= (n == 16) ? (1u << q) : 0u;
            }
            if (dm == 15u) break;
        }
#pragma unroll
        for (int q = 0; q < 4; ++q) {
            const int u = q >> 1, p = q & 1; const unsigned tp = th[q];
            const unsigned ka = k[u][2 * p], kb = k[u][2 * p + 1];
            const unsigned long long ga = __ballot(ka > tp), gb = __ballot(kb > tp), ea = __ballot(ka == tp), eb = __ballot(kb == tp);
            const int nga = __builtin_popcountll(ga), ng = nga + __builtin_popcountll(gb), need = 16 - ng, nea = __builtin_popcountll(ea);
            int pa = -1, pb = -1;
            if (ka > tp) pa = mbcnt64(ga); else if (ka == tp) { const int r = mbcnt64(ea); if (r < need) pa = ng + r; }
            if (kb > tp) pb = nga + mbcnt64(gb); else if (kb == tp) { const int r = nea + mbcnt64(eb); if (r < need) pb = ng + r; }
            if (pa >= 0) { tvb[q * 16 + pa] = v[u][2 * p]; tib[q * 16 + pa] = lane; }
            if (pb >= 0) { tvb[q * 16 + pb] = v[u][2 * p + 1]; tib[q * 16 + pb] = 64 + lane; }
        }
        float cv[2][4]; unsigned kc[2][4]; float mx[2];
#pragma unroll
        for (int u = 0; u < 2; ++u) {
#pragma unroll
            for (int s = 0; s < 4; ++s) { const int c = lane + 64 * s; cv[u][s] = tvb[u * 32 + (c >> 4)] + tvb[u * 32 + 16 + (c & 15)]; kc[u][s] = fkey(cv[u][s]); }
            const float m0 = max16(lane < 16 ? tvb[u * 32 + (lane & 15)] : -3.0e38f), m1 = max16(lane < 16 ? tvb[u * 32 + 16 + (lane & 15)] : -3.0e38f);
            mx[u] = rl(m0, 0) + rl(m1, 0);
        }
        unsigned t2[2] = {0u, 0u}; unsigned dm2 = 0u;
        for (int b = 31; b >= 0; --b) {
            const unsigned bit = 1u << b;
            unsigned long long mc[2][4];
#pragma unroll
            for (int u = 0; u < 2; ++u)
#pragma unroll
                for (int s4 = 0; s4 < 4; ++s4) mc[u][s4] = __ballot(kc[u][s4] >= (t2[u] | bit));
#pragma unroll
            for (int u = 0; u < 2; ++u) {
                const int n = (__builtin_popcountll(mc[u][0]) + __builtin_popcountll(mc[u][1])) + (__builtin_popcountll(mc[u][2]) + __builtin_popcountll(mc[u][3]));
                t2[u] = (n >= 16) ? (t2[u] | bit) : t2[u]; dm2 |= (n == 16) ? (1u << u) : 0u;
            }
            if (dm2 == 3u) break;
        }
        const float rs = rstd_parts(ssq, t);
#pragma unroll
        for (int u = 0; u < 2; ++u) {
            int pos[4]; int ng = 0;
#pragma unroll
            for (int s = 0; s < 4; ++s) { const unsigned long long g = __ballot(kc[u][s] > t2[u]); pos[s] = (kc[u][s] > t2[u]) ? ng + mbcnt64(g) : -1; ng += __builtin_popcountll(g); }
            int ne = 0; const int need = 16 - ng;
#pragma unroll
            for (int s = 0; s < 4; ++s) { const unsigned long long e = __ballot(kc[u][s] == t2[u]); if (kc[u][s] == t2[u]) { const int r = ne + mbcnt64(e); if (r < need) pos[s] = ng + r; } ne += __builtin_popcountll(e); }
            float ex[4]; float es = 0.f;
#pragma unroll
            for (int s = 0; s < 4; ++s) { ex[s] = (pos[s] >= 0) ? __expf(rs * (cv[u][s] - mx[u])) : 0.f; es += ex[s]; }
            const float inv = 1.0f / wave_sum_dpp(es);
#pragma unroll
            for (int s = 0; s < 4; ++s) if (pos[s] >= 0) {
                const int c = lane + 64 * s;
                TOPI[(size_t)t * 128 + (hd0 + u) * 16 + pos[s]] = tib[u * 32 + (c >> 4)] * 128 + tib[u * 32 + 16 + (c & 15)];
                TOPG[(size_t)t * 128 + (hd0 + u) * 16 + pos[s]] = ex[s] * inv;
            }
        }
    }
}

DEV unsigned pack4_fp8(float a, float b, float c, float d) {
    int w = __builtin_amdgcn_cvt_pk_fp8_f32(a, b, 0, false);
    w = __builtin_amdgcn_cvt_pk_fp8_f32(c, d, w, true);
    return (unsigned)w;
}
DEV void ph_convert8(const Args& a, int layer, const int tid0) {
    const size_t gtid = (size_t)blockIdx.x * NTHR + tid0, gn = (size_t)gridDim.x * NTHR;
    const float* us = a.peer_u + (size_t)layer * 16384 * 1024; const float* vs = a.peer_v + (size_t)layer * 16384 * 1024;
    unsigned* ud = (unsigned*)(a.ws + PTU_OFF); unsigned* vd = (unsigned*)(a.ws + PTV_OFF);
    const float* g = a.norm_ffn_g + layer * 1024;
    for (size_t i = gtid; i < (size_t)16384 * 1024 / 16; i += gn) {
        u32x4 pu, pv;
#pragma unroll
        for (int j = 0; j < 4; ++j) {
            const f32x4 x = *(const f32x4*)(us + i * 16 + j * 4), y = *(const f32x4*)(vs + i * 16 + j * 4), gg = *(const f32x4*)(g + ((i * 16 + j * 4) & 1023));
            pu[j] = pack4_fp8(x[0] * gg[0] * 256.f, x[1] * gg[1] * 256.f, x[2] * gg[2] * 256.f, x[3] * gg[3] * 256.f);
            pv[j] = pack4_fp8(y[0] * 32.f, y[1] * 32.f, y[2] * 32.f, y[3] * 32.f);
        }
        *(u32x4*)(ud + i * 4) = pu; *(u32x4*)(vd + i * 4) = pv;
    }
    bf16_t* pb = wsb(a, PB_OFF);
    const float* pp = a.p_prompt + (size_t)layer * TP * 256; const float* ps = a.p_sample + (size_t)layer * (T - TP) * 256;
    for (size_t i = gtid; i < (size_t)T * 256 / 4; i += gn) {
        const size_t e = i * 4; const f32x4 x = (e < (size_t)TP * 256) ? *(const f32x4*)(pp + e) : *(const f32x4*)(ps + (e - (size_t)TP * 256));
        u32x2 p; p.x = pack2(x[0], x[1]); p.y = pack2(x[2], x[3]); *(u32x2*)(pb + e) = p;
    }
}

template <bool DRY> DEV void ph_peer8(const Args& a, const int tid0) {
    const int lane = tid0 & 63, wv = tid0 >> 6;
    const int gw = blockIdx.x * 8 + wv, nw = gridDim.x * 8;
    bf16_t* hb = wsb(a, HB_OFF); float* rstd = wsf(a, RSTD_OFF);
    const int* TOPI = (const int*)(a.ws + TOPI_OFF); const float* TOPG = wsf(a, TOPG_OFF);
    const unsigned char* PU = a.ws + PTU_OFF; const unsigned char* PV = a.ws + PTV_OFF;
    const int c16 = 16 * lane;
    const bool b5 = lane & 32, b4 = lane & 16, b3 = lane & 8;
    for (int t = gw; t < T; t += nw) {
        float x[16];
        { const u32x4 x0 = *(const u32x4*)(hb + (size_t)t * 1024 + c16), x1 = *(const u32x4*)(hb + (size_t)t * 1024 + c16 + 8);
#pragma unroll
          for (int i = 0; i < 4; ++i) { x[2 * i] = bflo(x0[i]); x[2 * i + 1] = bfhi(x0[i]); x[8 + 2 * i] = bflo(x1[i]); x[8 + 2 * i + 1] = bfhi(x1[i]); } }
        const float rs = rstd[t] * (1.0f / 256.0f);
        const int e0 = TOPI[(size_t)t * 128 + lane], e1 = TOPI[(size_t)t * 128 + 64 + lane];
        const float g0 = TOPG[(size_t)t * 128 + lane], g1 = TOPG[(size_t)t * 128 + 64 + lane];
        float out[16];
#pragma unroll
        for (int i = 0; i < 16; ++i) out[i] = 0.f;
#pragma unroll 1
        for (int kb = 0; kb < 128; kb += 8) {
            const int es = (kb < 64) ? e0 : e1; const float gs = (kb < 64) ? g0 : g1;
            u32x4 ur[8], vr[8];
#pragma unroll
            for (int i = 0; i < 8; ++i) { const int e = __builtin_amdgcn_readlane(es, (kb + i) & 63); ur[i] = *(const u32x4*)(PU + (size_t)e * 1024 + c16); vr[i] = *(const u32x4*)(PV + (size_t)e * 1024 + c16); }
            float d[8];
#pragma unroll
            for (int i = 0; i < 8; ++i) {
                float s = 0.f;
#pragma unroll
                for (int j = 0; j < 4; ++j) {
                    const f32x2 lo = __builtin_amdgcn_cvt_pk_f32_fp8((int)ur[i][j], false), hi = __builtin_amdgcn_cvt_pk_f32_fp8((int)ur[i][j], true);
                    s += lo[0] * x[4 * j] + lo[1] * x[4 * j + 1] + hi[0] * x[4 * j + 2] + hi[1] * x[4 * j + 3];
                }
                d[i] = s;
            }
            float r4[4], r2[2];
#pragma unroll
            for (int i = 0; i < 4; ++i) { const float send = b5 ? d[i] : d[4 + i], keep = b5 ? d[4 + i] : d[i]; r4[i] = keep + SHX(send, 32); }
#pragma unroll
            for (int i = 0; i < 2; ++i) { const float send = b4 ? r4[i] : r4[2 + i], keep = b4 ? r4[2 + i] : r4[i]; r2[i] = keep + SHX(send, 16); }
            const float send1 = b3 ? r2[0] : r2[1], keep1 = b3 ? r2[1] : r2[0];
            const float dd = sum8(keep1 + SHX(send1, 8));
            const float hp = rs * dd;
            const float gt = SHF(gs, (kb + (lane >> 3)) & 63);
            const float w = gt * 0.5f * hp * (1.0f + erff(hp * 0.70710678f)) * (1.0f / 32.0f);
#pragma unroll
            for (int i = 0; i < 8; ++i) {
                const float wi = rl(w, 8 * i);
#pragma unroll
                for (int j = 0; j < 4; ++j) {
                    const f32x2 lo = __builtin_amdgcn_cvt_pk_f32_fp8((int)vr[i][j], false), hi = __builtin_amdgcn_cvt_pk_f32_fp8((int)vr[i][j], true);
                    out[4 * j] += wi * lo[0]; out[4 * j + 1] += wi * lo[1]; out[4 * j + 2] += wi * hi[0]; out[4 * j + 3] += wi * hi[1];
                }
            }
        }
        float* hr = a.h + (size_t)t * 1024 + c16;
        f32x4 hv[4]; float ss = 0.f;
#pragma unroll
        for (int j = 0; j < 4; ++j) { hv[j] = *(const f32x4*)(hr + 4 * j);
#pragma unroll
            for (int c = 0; c < 4; ++c) { hv[j][c] += out[4 * j + c]; ss += hv[j][c] * hv[j][c]; }
            if (!DRY) *(f32x4*)(hr + 4 * j) = hv[j]; }
        ss = wave_sum(ss);
        if (DRY && ss != -1.0f) continue;
        u32x4 p0, p1;
        p0.x = pack2(hv[0][0], hv[0][1]); p0.y = pack2(hv[0][2], hv[0][3]); p0.z = pack2(hv[1][0], hv[1][1]); p0.w = pack2(hv[1][2], hv[1][3]);
        p1.x = pack2(hv[2][0], hv[2][1]); p1.y = pack2(hv[2][2], hv[2][3]); p1.z = pack2(hv[3][0], hv[3][1]); p1.w = pack2(hv[3][2], hv[3][3]);
        *(u32x4*)(hb + (size_t)t * 1024 + c16) = p0; *(u32x4*)(hb + (size_t)t * 1024 + c16 + 8) = p1;
        if (lane == 0) rstd[t] = rsqrtf(ss * (1.0f / 1024.0f) + 1e-6f);
    }
}

typedef short bf16x8 __attribute__((ext_vector_type(8)));
typedef float f32x16 __attribute__((ext_vector_type(16)));
#define MFMA32(a, b, c) __builtin_amdgcn_mfma_f32_32x32x16_bf16((a), (b), (c), 0, 0, 0)
DEV bf16x8 pack_frag(float x0, float x1, float x2, float x3, float x4, float x5, float x6, float x7) {
    u32x4 p;
    asm volatile("v_cvt_pk_bf16_f32 %0, %4, %5\n\tv_cvt_pk_bf16_f32 %1, %6, %7\n\tv_cvt_pk_bf16_f32 %2, %8, %9\n\tv_cvt_pk_bf16_f32 %3, %10, %11\n\ts_nop 1"
                 : "=&v"(p[0]), "=&v"(p[1]), "=&v"(p[2]), "=&v"(p[3]) : "v"(x0), "v"(x1), "v"(x2), "v"(x3), "v"(x4), "v"(x5), "v"(x6), "v"(x7));
    return __builtin_bit_cast(bf16x8, p);
}
template <int VAR> DEV void ph_attn2(const Args& a, unsigned char* ldsb, const int tid0) {
    const int lane = tid0 & 63, wv = __builtin_amdgcn_readfirstlane(tid0 >> 6), r = lane & 31, h = lane >> 5;
    unsigned char* vt = ldsb + wv * 4608;
    const bf16_t* qkv = wsb(a, QKV_OFF);
    bf16_t* OP = wsb(a, OP_OFF); float* ML = wsf(a, ML_OFF);
    const int i16 = lane & 15, tq = i16 >> 2, tp = i16 & 3, tblk = (lane >> 4) & 1;
    const unsigned tr_addr = (unsigned)(size_t)vt + (4 * h + tq) * 144 + 2 * (16 * tblk + 4 * tp);
    const float sc = 0.125f * 1.44269504f, NEG = -1.0e30f;
    const int nitem = NSEQ * 8 * 3 * 128, per = nitem / (int)gridDim.x;
    for (int it = 0; it < per / 8; ++it) {
        const int w = blockIdx.x * per + it * 8 + wv;
        const int sh = w / 384, rem = w - sh * 384, di = rem >> 7, idx = rem & 127;
        const int sft = (VAR == 1) ? 0 : 2 * di, nbc = 128 >> sft, rr = idx >> (7 - sft), cb = idx & (nbc - 1), cq0 = cb * 32, nlen = 4096 >> sft;
        const int seq = sh >> 3, hd = sh & 7; const size_t tb = (size_t)seq * 4096;
        const size_t tokq = tb + ((size_t)(cq0 + r) << sft) + rr;
        const bf16_t* qp = qkv + tokq * 1536 + hd * 64 + 8 * h;
        bf16x8 qf[4];
#pragma unroll
        for (int s = 0; s < 4; ++s) qf[s] = *(const bf16x8*)(qp + 16 * s);
        float m = NEG, l = 0.f;
        f32x16 O0, O1;
#pragma unroll
        for (int i = 0; i < 16; ++i) { O0[i] = 0.f; O1[i] = 0.f; }
        bf16x8 kfb[2][4], vfb[2][4];
#define ATT_LOAD(kt_) do { const int kb_ = cq0 - 64 + 32 * (kt_); const size_t tokk_ = tb + ((size_t)(kb_ + r) << sft) + rr; const bf16_t* kp_ = qkv + tokk_ * 1536 + 512 + hd * 64 + 8 * h; \
            _Pragma("unroll") for (int s_ = 0; s_ < 4; ++s_) { kfb[(kt_) & 1][s_] = *(const bf16x8*)(kp_ + 16 * s_); vfb[(kt_) & 1][s_] = *(const bf16x8*)(kp_ + 512 + 16 * s_); } } while (0)
        if (cq0 - 64 >= 0) ATT_LOAD(0);
#pragma unroll
        for (int kt = 0; kt < 5; ++kt) {
            const int kb = cq0 - 64 + 32 * kt;
            if (kt + 1 < 5) { const int kbn = kb + 32; if (kbn >= 0 && kbn < nlen) ATT_LOAD(kt + 1); }
            asm volatile("" ::: "memory");
            if (kb < 0 || kb >= nlen) continue;
            bf16x8 kf[4], vf[4];
#pragma unroll
            for (int s = 0; s < 4; ++s) { kf[s] = kfb[kt & 1][s]; vf[s] = vfb[kt & 1][s]; }
            f32x16 S;
#pragma unroll
            for (int i = 0; i < 16; ++i) S[i] = 0.f;
#pragma unroll
            for (int s = 0; s < 4; ++s) S = MFMA32(kf[s], qf[s], S);
            float lm = NEG;
#pragma unroll
            for (int i = 0; i < 16; ++i) {
                const int row = (i & 3) + 8 * (i >> 2) + 4 * h;
                float v = S[i] * sc;
                if (kt == 0) v = (row >= r) ? v : NEG;
                if (kt == 4) v = (row <= r) ? v : NEG;
                S[i] = v; lm = fmaxf(lm, v);
            }
            lm = fmaxf(lm, SHX(lm, 32));
            const float mn = fmaxf(m, lm), alpha = __builtin_amdgcn_exp2f(m - mn);
            m = mn; l *= alpha;
            float ps = 0.f;
#pragma unroll
            for (int i = 0; i < 16; ++i) { O0[i] *= alpha; O1[i] *= alpha; S[i] = __builtin_amdgcn_exp2f(S[i] - mn); ps += S[i]; }
            l += ps;
            const bf16x8 pb0 = pack_frag(S[0], S[1], S[2], S[3], S[4], S[5], S[6], S[7]);
            const bf16x8 pb1 = pack_frag(S[8], S[9], S[10], S[11], S[12], S[13], S[14], S[15]);
            asm volatile("" ::: "memory");
#pragma unroll
            for (int i = 0; i < 4; ++i) *(bf16x8*)(vt + r * 144 + 2 * (16 * i + 8 * h)) = vf[i];
            typedef short s16x4 __attribute__((ext_vector_type(4)));
            s16x4 t00l, t00h, t01l, t01h, t10l, t10h, t11l, t11h;
            asm volatile("s_waitcnt lgkmcnt(0)\n\t"
                         "ds_read_b64_tr_b16 %0, %8\n\tds_read_b64_tr_b16 %1, %8 offset:1152\n\t"
                         "ds_read_b64_tr_b16 %2, %8 offset:2304\n\tds_read_b64_tr_b16 %3, %8 offset:3456\n\t"
                         "ds_read_b64_tr_b16 %4, %8 offset:64\n\tds_read_b64_tr_b16 %5, %8 offset:1216\n\t"
                         "ds_read_b64_tr_b16 %6, %8 offset:2368\n\tds_read_b64_tr_b16 %7, %8 offset:3520\n\t"
                         "s_waitcnt lgkmcnt(0)"
                         : "=&v"(t00l), "=&v"(t00h), "=&v"(t01l), "=&v"(t01h), "=&v"(t10l), "=&v"(t10h), "=&v"(t11l), "=&v"(t11h) : "v"(tr_addr) : "memory");
            const bf16x8 a00 = __builtin_shufflevector(t00l, t00h, 0, 1, 2, 3, 4, 5, 6, 7), a01 = __builtin_shufflevector(t01l, t01h, 0, 1, 2, 3, 4, 5, 6, 7);
            const bf16x8 a10 = __builtin_shufflevector(t10l, t10h, 0, 1, 2, 3, 4, 5, 6, 7), a11 = __builtin_shufflevector(t11l, t11h, 0, 1, 2, 3, 4, 5, 6, 7);
            O0 = MFMA32(a00, pb0, O0); O1 = MFMA32(a10, pb0, O1);
            O0 = MFMA32(a01, pb1, O0); O1 = MFMA32(a11, pb1, O1);
            asm volatile("" ::: "memory");
        }
#undef ATT_LOAD
        l += SHX(l, 32);
        const float inv = 1.0f / l;
        if (VAR == 2 && tokq != 0x7fffffff) continue;
        bf16_t* op = OP + ((size_t)di * T + tokq) * 512 + hd * 64 + 4 * h;
#pragma unroll
        for (int g = 0; g < 4; ++g) {
            u32x2 p0, p1;
            p0.x = pack2(O0[4 * g] * inv, O0[4 * g + 1] * inv); p0.y = pack2(O0[4 * g + 2] * inv, O0[4 * g + 3] * inv);
            p1.x = pack2(O1[4 * g] * inv, O1[4 * g + 1] * inv); p1.y = pack2(O1[4 * g + 2] * inv, O1[4 * g + 3] * inv);
            *(u32x2*)(op + 8 * g) = p0; *(u32x2*)(op + 32 + 8 * g) = p1;
        }
        if (h == 0) { f32x2 ml; ml[0] = m; ml[1] = l; *(f32x2*)(ML + (((size_t)di * T + tokq) * 8 + hd) * 2) = ml; }
    }
}
DEV void ph_attn_merge(const Args& a, int layer, const int tid0) {
    const int lane = tid0 & 63, wv = tid0 >> 6;
    const int gw = blockIdx.x * 8 + wv, nw = gridDim.x * 8;
    const bf16_t* OP = wsb(a, OP_OFF); const float* ML = wsf(a, ML_OFF); bf16_t* mix = wsb(a, MIX_OFF);
    const int c8 = 8 * lane, hd = lane >> 3;
    const f32x4 gA = *(const f32x4*)(a.att_norm_g + layer * 512 + c8), gB = *(const f32x4*)(a.att_norm_g + layer * 512 + c8 + 4);
    for (int t = gw; t < T; t += nw) {
        u32x4 o[3]; f32x2 ml[3];
#pragma unroll
        for (int d = 0; d < 3; ++d) { o[d] = *(const u32x4*)(OP + ((size_t)d * T + t) * 512 + c8); ml[d] = *(const f32x2*)(ML + (((size_t)d * T + t) * 8 + hd) * 2); }
        const float mm = fmaxf(ml[0][0], fmaxf(ml[1][0], ml[2][0]));
        float wgt[3]; float den = 0.f;
#pragma unroll
        for (int d = 0; d < 3; ++d) { wgt[d] = __builtin_amdgcn_exp2f(ml[d][0] - mm) * ml[d][1]; den += wgt[d]; }
        const float iden = 1.0f / den;
        float v[8]; float ss = 0.f;
#pragma unroll
        for (int i = 0; i < 4; ++i) {
            v[2 * i] = (wgt[0] * bflo(o[0][i]) + wgt[1] * bflo(o[1][i]) + wgt[2] * bflo(o[2][i])) * iden;
            v[2 * i + 1] = (wgt[0] * bfhi(o[0][i]) + wgt[1] * bfhi(o[1][i]) + wgt[2] * bfhi(o[2][i])) * iden;
            ss += v[2 * i] * v[2 * i] + v[2 * i + 1] * v[2 * i + 1];
        }
        const float rn = rsqrtf(sum8(ss) * (1.0f / 64.0f) + 1e-6f);
        u32x4 ov;
        ov.x = pack2(v[0] * rn * gA[0], v[1] * rn * gA[1]); ov.y = pack2(v[2] * rn * gA[2], v[3] * rn * gA[3]);
        ov.z = pack2(v[4] * rn * gB[0], v[5] * rn * gB[1]); ov.w = pack2(v[6] * rn * gB[2], v[7] * rn * gB[3]);
        *(u32x4*)(mix + (size_t)t * 1024 + c8) = ov;
    }
}

DEV float tanh_fast(float x) { return 1.0f - 2.0f / (1.0f + __expf(2.0f * x)); }

DEV void ph_rwkv_prep1(const Args& a, int layer, unsigned char* ldsb, const int tid0) {
    const int lane = tid0 & 63, wv = __builtin_amdgcn_readfirstlane(tid0 >> 6), r = lane & 31, h = lane >> 5;
    const int gw = blockIdx.x * 8 + wv, nw = gridDim.x * 8;
    const int sub = wv & 1, ng = wv >> 1;
    const bf16_t* U = wsb(a, U_OFF);
    const float* sw = a.rwkv_shift + (size_t)layer * 3 * UC;
    const bf16_t* wl = wsb(a, WB_OFF + (size_t)layer * WB_LAYER + WB_LORA);
#pragma unroll 1
    for (int arr = 0; arr < 5; ++arr) {
        const int coff = (arr < 4) ? arr * 64 : 256, nk = (arr < 4) ? 4 : 8, kw = nk * 16, rsb = kw * 2 + 16;
        __syncthreads();
        {
            const bf16_t* wsrc = wl + (arr < 4 ? arr * 512 * 64 : 4 * 512 * 64);
            const int cpr = kw / 8;
            for (int i = tid0; i < 512 * cpr; i += NTHR) { const int row = i / cpr, c = i - row * cpr; *(u32x4*)(ldsb + row * rsb + c * 16) = *(const u32x4*)(wsrc + (size_t)row * kw + c * 8); }
        }
        __syncthreads();
        bf16_t* outb = wsb(a, arr == 0 ? WF_OFF : arr == 1 ? WB2_OFF : arr == 2 ? AF_OFF : arr == 3 ? AB_OFF : G_OFF);
        const float* bias = (arr < 2) ? a.rwkv_w0 + (layer * 2 + arr) * 512 : a.rwkv_a0 + (layer * 2 + (arr & 1)) * 512;
        f32x4 bvr[4][4];
#pragma unroll
        for (int q = 0; q < 4; ++q)
#pragma unroll
            for (int g = 0; g < 4; ++g) bvr[q][g] = *(const f32x4*)(bias + (ng * 4 + q) * 32 + 8 * g + 4 * h);
#pragma unroll 1
        for (int tile = blockIdx.x; tile < T / 64; tile += gridDim.x) {
            const int t = tile * 64 + sub * 32 + r, pos = t & 4095;
            const bool hp = pos > 0, hn = pos < 4095;
            const bf16_t* up = U + (size_t)t * UW + 1536 + 8 * h;
            bf16x8 xf[8];
#pragma unroll
            for (int s = 0; s < 8; ++s) {
                if (s < nk) {
                    const int col = coff + 16 * s;
                    const u32x4 c = *(const u32x4*)(up + col);
                    u32x4 p = {0u, 0u, 0u, 0u}, n = {0u, 0u, 0u, 0u};
                    if (hp) p = *(const u32x4*)(up - UW + col);
                    if (hn) n = *(const u32x4*)(up + UW + col);
                    const float* s0 = sw + 1536 + 8 * h + col;
                    const f32x4 wp0 = *(const f32x4*)(s0), wp1 = *(const f32x4*)(s0 + 4), wc0 = *(const f32x4*)(s0 + UC), wc1 = *(const f32x4*)(s0 + UC + 4), wn0 = *(const f32x4*)(s0 + 2 * UC), wn1 = *(const f32x4*)(s0 + 2 * UC + 4);
                    float v[8];
#pragma unroll
                    for (int i = 0; i < 4; ++i) {
                        const float a0 = (i < 2) ? wp0[2 * i] : wp1[2 * i - 4], a1 = (i < 2) ? wp0[2 * i + 1] : wp1[2 * i - 3];
                        const float b0 = (i < 2) ? wc0[2 * i] : wc1[2 * i - 4], b1 = (i < 2) ? wc0[2 * i + 1] : wc1[2 * i - 3];
                        const float c0 = (i < 2) ? wn0[2 * i] : wn1[2 * i - 4], c1 = (i < 2) ? wn0[2 * i + 1] : wn1[2 * i - 3];
                        v[2 * i] = a0 * bflo(p[i]) + b0 * bflo(c[i]) + c0 * bflo(n[i]);
                        v[2 * i + 1] = a1 * bfhi(p[i]) + b1 * bfhi(c[i]) + c1 * bfhi(n[i]);
                    }
                    if (arr < 2) {
#pragma unroll
                        for (int i = 0; i < 8; ++i) v[i] = tanh_fast(v[i]);
                    } else if (arr == 4) {
#pragma unroll
                        for (int i = 0; i < 8; ++i) v[i] = sigmoidf_(v[i]);
                    }
                    xf[s] = pack_frag(v[0], v[1], v[2], v[3], v[4], v[5], v[6], v[7]);
                }
            }
            bf16_t* out = outb + (size_t)t * 512 + 4 * h;
#pragma unroll
            for (int q = 0; q < 4; ++q) {
                const int nt = ng * 4 + q;
                f32x16 C;
#pragma unroll
                for (int i = 0; i < 16; ++i) C[i] = 0.f;
                const unsigned char* wr = ldsb + (nt * 32 + r) * rsb + 16 * h;
#pragma unroll
                for (int s = 0; s < 8; ++s) if (s < nk) { const bf16x8 A = *(const bf16x8*)(wr + 32 * s); C = MFMA32(A, xf[s], C); }
#pragma unroll
                for (int g = 0; g < 4; ++g) {
                    float o[4];
                    if (arr < 4) {
                        const f32x4 bv = bvr[q][g];
#pragma unroll
                        for (int j = 0; j < 4; ++j) { const float sg = sigmoidf_(C[4 * g + j] + bv[j]); o[j] = (arr < 2) ? __expf(-0.60653066f * sg) : sg; }
                    } else {
#pragma unroll
                        for (int j = 0; j < 4; ++j) o[j] = C[4 * g + j];
                    }
                    u32x2 pk; pk.x = pack2(o[0], o[1]); pk.y = pack2(o[2], o[3]);
                    *(u32x2*)(out + nt * 32 + 8 * g) = pk;
                }
            }
        }
    }
    {
        const int c16 = 16 * lane;
        bf16_t* dst = wsb(a, lane < 32 ? RS_OFF : KS_OFF) + (c16 & 511);
        float swp[16], swc[16], swn[16];
#pragma unroll
        for (int i = 0; i < 16; ++i) { swp[i] = sw[c16 + i]; swc[i] = sw[UC + c16 + i]; swn[i] = sw[2 * UC + c16 + i]; }
        for (int t = gw; t < T; t += nw) {
            const int pos = t & 4095; const bool hp = pos > 0, hn = pos < 4095;
            const bf16_t* up = U + (size_t)t * UW + c16;
            u32x4 c[2], p[2], n[2];
#pragma unroll
            for (int q = 0; q < 2; ++q) {
                c[q] = *(const u32x4*)(up + 8 * q); p[q] = (u32x4){0u, 0u, 0u, 0u}; n[q] = (u32x4){0u, 0u, 0u, 0u};
                if (hp) p[q] = *(const u32x4*)(up - UW + 8 * q);
                if (hn) n[q] = *(const u32x4*)(up + UW + 8 * q);
            }
            u32x4 o[2];
#pragma unroll
            for (int q = 0; q < 2; ++q)
#pragma unroll
                for (int i = 0; i < 4; ++i) {
                    const int e = 8 * q + 2 * i;
                    const float lo = swp[e] * bflo(p[q][i]) + swc[e] * bflo(c[q][i]) + swn[e] * bflo(n[q][i]);
                    const float hi = swp[e + 1] * bfhi(p[q][i]) + swc[e + 1] * bfhi(c[q][i]) + swn[e + 1] * bfhi(n[q][i]);
                    o[q][i] = pack2(lo, hi);
                }
            *(u32x4*)(dst + (size_t)t * 512) = o[0]; *(u32x4*)(dst + (size_t)t * 512 + 8) = o[1];
        }
    }
}
DEV void ph_rwkv_prep2(const Args& a, int layer, const int tid0) {
    const int lane = tid0 & 63, wv = tid0 >> 6;
    const int gw = blockIdx.x * 8 + wv, nw = gridDim.x * 8;
    bf16_t* U = wsb(a, U_OFF); const bf16_t* KS = wsb(a, KS_OFF);
    const float* sw = a.rwkv_shift + (size_t)layer * 3 * UC;
    const int c8 = 8 * lane;
    float kkc[8], sv[3][8];
#pragma unroll
    for (int i = 0; i < 8; ++i) { kkc[i] = a.rwkv_k_k[layer * 512 + c8 + i]; sv[0][i] = sw[1024 + c8 + i]; sv[1][i] = sw[UC + 1024 + c8 + i]; sv[2][i] = sw[2 * UC + 1024 + c8 + i]; }
    for (int t = gw; t < T; t += nw) {
        const int pos = t & 4095; const bool hp = pos > 0, hn = pos < 4095;
        bf16_t* up = U + (size_t)t * UW;
        const u32x4 ks = *(const u32x4*)(KS + (size_t)t * 512 + c8);
        const u32x4 c = *(const u32x4*)(up + 1024 + c8);
        u32x4 p = {0u, 0u, 0u, 0u}, n = {0u, 0u, 0u, 0u};
        if (hp) p = *(const u32x4*)(up - UW + 1024 + c8);
        if (hn) n = *(const u32x4*)(up + UW + 1024 + c8);
        float kx[8]; float ss = 0.f;
#pragma unroll
        for (int i = 0; i < 4; ++i) { kx[2 * i] = bflo(ks[i]) * kkc[2 * i]; kx[2 * i + 1] = bfhi(ks[i]) * kkc[2 * i + 1]; ss += kx[2 * i] * kx[2 * i] + kx[2 * i + 1] * kx[2 * i + 1]; }
        const float inv = 1.0f / fmaxf(sqrtf(sum8(ss)), 1e-12f);
        u32x4 ko, vo;
#pragma unroll
        for (int i = 0; i < 4; ++i) {
            ko[i] = pack2(kx[2 * i] * inv, kx[2 * i + 1] * inv);
            vo[i] = pack2(sv[0][2 * i] * bflo(p[i]) + sv[1][2 * i] * bflo(c[i]) + sv[2][2 * i] * bflo(n[i]), sv[0][2 * i + 1] * bfhi(p[i]) + sv[1][2 * i + 1] * bfhi(c[i]) + sv[2][2 * i + 1] * bfhi(n[i]));
        }
        *(u32x4*)(up + c8) = ko; *(u32x4*)(up + 1536 + c8) = vo;
    }
}

DEV void ph_scan3(const Args& a, int layer, float* lds, const int tid0) {
    const int tid = tid0, lane = tid & 63, wv = __builtin_amdgcn_readfirstlane(tid >> 6);
    float* vecs = lds;
    float* ybuf = lds + 2 * 12288;
    const bf16_t* U = wsb(a, U_OFF); const bf16_t* RS = wsb(a, RS_OFF); const bf16_t* KS = wsb(a, KS_OFF);
    bf16_t* Uw = wsb(a, U_OFF);
    const bool helper = wv >= 4;
    const int dir = helper ? ((wv - 4) >> 1) : (wv >> 1), part = wv & 1;
    const bf16_t* Wd = wsb(a, dir ? WB2_OFF : WF_OFF); const bf16_t* Ad = wsb(a, dir ? AB_OFF : AF_OFF);
    const int js = lane & 7, q = lane >> 3, r0 = 32 * part + 4 * q;
    for (int un = blockIdx.x; un < NSEQ * 8; un += gridDim.x) {
        const int seq = un >> 3, hd = un & 7; const size_t tb = (size_t)seq * 4096; const int cb = hd * 64, pch = cb + lane;
        const float kac = a.rwkv_k_a[layer * 512 + pch];
        f32x2 S[4][4];
#pragma unroll
        for (int rw = 0; rw < 4; ++rw)
#pragma unroll
            for (int i = 0; i < 4; ++i) S[rw][i] = (f32x2){0.f, 0.f};
#define SCAN_PREP(blk_, buf_) do { unsigned short pr_[8][6]; \
            _Pragma("unroll") for (int si = 0; si < 8; ++si) { const int step_ = (blk_) * 16 + part * 8 + si, pos_ = dir ? 4095 - step_ : step_; const size_t t_ = tb + pos_; \
                pr_[si][0] = Wd[t_ * 512 + pch]; pr_[si][1] = U[t_ * UW + pch]; pr_[si][2] = Ad[t_ * 512 + pch]; pr_[si][3] = KS[t_ * 512 + pch]; pr_[si][4] = RS[t_ * 512 + pch]; pr_[si][5] = U[t_ * UW + 1536 + pch]; } \
            _Pragma("unroll") for (int si = 0; si < 8; ++si) { float* o_ = vecs + (((buf_) * 2 + dir) * 16 + part * 8 + si) * 384 + lane; \
                const float w_ = bf2f(pr_[si][0]), kk_ = bf2f(pr_[si][1]), av_ = bf2f(pr_[si][2]), ks_ = bf2f(pr_[si][3]); \
                o_[0] = w_; o_[64] = -kk_; o_[128] = kk_ * av_; o_[192] = ks_ * (1.0f + (av_ - 1.0f) * kac); o_[256] = bf2f(pr_[si][4]); o_[320] = bf2f(pr_[si][5]); } } while (0)
        __syncthreads();
        if (helper) SCAN_PREP(0, 0);
        __syncthreads();
        for (int blk = 0; blk < 256; ++blk) {
            const int cur = blk & 1;
            if (helper) {
                if (blk + 1 < 256) SCAN_PREP(blk + 1, cur ^ 1);
                if (blk > 0) {
                    const int s2 = part * 8 + (lane >> 3), c8 = (lane & 7) * 8;
                    const float* yp = ybuf + (((cur ^ 1) * 2 + dir) * 16 + s2) * 64 + c8;
                    const f32x4 y0 = *(const f32x4*)(yp), y1 = *(const f32x4*)(yp + 4);
                    const int step = (blk - 1) * 16 + s2, pos = dir ? 4095 - step : step;
                    u32x4 pk; pk.x = pack2(y0[0], y0[1]); pk.y = pack2(y0[2], y0[3]); pk.z = pack2(y1[0], y1[1]); pk.w = pack2(y1[2], y1[3]);
                    *(u32x4*)(Uw + (tb + pos) * UW + 512 + 512 * dir + cb + c8) = pk;
                }
            } else {
                const float* vb0 = vecs + ((cur * 2 + dir) * 16) * 384;
                float* yb = ybuf + ((cur * 2 + dir) * 16) * 64 + r0;
                const float* vbl = vb0 + 8 * js;
                f32x4 cw0 = *(const f32x4*)(vbl), cw1 = *(const f32x4*)(vbl + 4), ca0 = *(const f32x4*)(vbl + 64), ca1 = *(const f32x4*)(vbl + 68), cb0 = *(const f32x4*)(vbl + 128), cb1 = *(const f32x4*)(vbl + 132);
                f32x4 ck0 = *(const f32x4*)(vbl + 192), ck1 = *(const f32x4*)(vbl + 196), cq0 = *(const f32x4*)(vbl + 256), cq1 = *(const f32x4*)(vbl + 260);
                f32x4 cv4 = *(const f32x4*)(vb0 + 320 + r0);
#pragma unroll
                for (int s = 0; s < 16; ++s) {
                    const f32x4 w0 = cw0, w1 = cw1, a0 = ca0, a1 = ca1, b0 = cb0, b1 = cb1, k0 = ck0, k1 = ck1, q0 = cq0, q1 = cq1, v4 = cv4;
                    if (s < 15) {
                        const float* vn = vbl + (s + 1) * 384;
                        cw0 = *(const f32x4*)(vn); cw1 = *(const f32x4*)(vn + 4); ca0 = *(const f32x4*)(vn + 64); ca1 = *(const f32x4*)(vn + 68); cb0 = *(const f32x4*)(vn + 128); cb1 = *(const f32x4*)(vn + 132);
                        ck0 = *(const f32x4*)(vn + 192); ck1 = *(const f32x4*)(vn + 196); cq0 = *(const f32x4*)(vn + 256); cq1 = *(const f32x4*)(vn + 260);
                        cv4 = *(const f32x4*)(vb0 + (s + 1) * 384 + 320 + r0);
                        asm volatile("" ::: "memory");
                    }
                    const f32x2 av[4] = {{a0[0], a0[1]}, {a0[2], a0[3]}, {a1[0], a1[1]}, {a1[2], a1[3]}};
                    const f32x2 wv2[4] = {{w0[0], w0[1]}, {w0[2], w0[3]}, {w1[0], w1[1]}, {w1[2], w1[3]}};
                    const f32x2 bv[4] = {{b0[0], b0[1]}, {b0[2], b0[3]}, {b1[0], b1[1]}, {b1[2], b1[3]}};
                    const f32x2 kv[4] = {{k0[0], k0[1]}, {k0[2], k0[3]}, {k1[0], k1[1]}, {k1[2], k1[3]}};
                    const f32x2 qv[4] = {{q0[0], q0[1]}, {q0[2], q0[3]}, {q1[0], q1[1]}, {q1[2], q1[3]}};
                    float sa[4];
#pragma unroll
                    for (int rw = 0; rw < 4; ++rw) { const f32x2 t0 = (S[rw][0] * av[0] + S[rw][1] * av[1]) + (S[rw][2] * av[2] + S[rw][3] * av[3]); sa[rw] = sum8(t0[0] + t0[1]); }
                    f32x4 yo;
#pragma unroll
                    for (int rw = 0; rw < 4; ++rw) {
                        f32x2 y2 = {0.f, 0.f};
#pragma unroll
                        for (int i = 0; i < 4; ++i) { S[rw][i] = S[rw][i] * wv2[i] + (bv[i] * sa[rw] + kv[i] * v4[rw]); y2 = y2 + S[rw][i] * qv[i]; }
                        yo[rw] = sum8(y2[0] + y2[1]);
                    }
                    if (js == 0) *(f32x4*)(yb + s * 64) = yo;
                }
            }
            __syncthreads();
        }
        if (helper) {
            const int cur = 1, blk = 256;
            const int s2 = part * 8 + (lane >> 3), c8 = (lane & 7) * 8;
            const float* yp = ybuf + ((cur * 2 + dir) * 16 + s2) * 64 + c8;
            const f32x4 y0 = *(const f32x4*)(yp), y1 = *(const f32x4*)(yp + 4);
            const int step = (blk - 1) * 16 + s2, pos = dir ? 4095 - step : step;
            u32x4 pk; pk.x = pack2(y0[0], y0[1]); pk.y = pack2(y0[2], y0[3]); pk.z = pack2(y1[0], y1[1]); pk.w = pack2(y1[2], y1[3]);
            *(u32x4*)(Uw + (tb + pos) * UW + 512 + 512 * dir + cb + c8) = pk;
        }
#undef SCAN_PREP
    }
}

DEV void ph_post2(const Args& a, int layer, const int tid0) {
    const int lane = tid0 & 63, wv = tid0 >> 6;
    const int gw = blockIdx.x * 8 + wv, nw = gridDim.x * 8;
    const bf16_t* U = wsb(a, U_OFF); const bf16_t* RS = wsb(a, RS_OFF); const bf16_t* KS = wsb(a, KS_OFF); const bf16_t* G = wsb(a, G_OFF);
    const bf16_t* AF = wsb(a, AF_OFF); const bf16_t* AB = wsb(a, AB_OFF); bf16_t* mix = wsb(a, MIX_OFF);
    const int c8 = 8 * lane;
    float kac[8], rkc[8], lnw[8], lnb[8];
#pragma unroll
    for (int i = 0; i < 8; ++i) { kac[i] = a.rwkv_k_a[layer * 512 + c8 + i]; rkc[i] = a.rwkv_r_k[layer * 512 + c8 + i]; lnw[i] = a.rwkv_ln_w[layer * 512 + c8 + i]; lnb[i] = a.rwkv_ln_b[layer * 512 + c8 + i]; }
    for (int t = gw; t < T; t += nw) {
        const bf16_t* up = U + (size_t)t * UW;
        const u32x4 rp = *(const u32x4*)(RS + (size_t)t * 512 + c8), kp = *(const u32x4*)(KS + (size_t)t * 512 + c8), gp = *(const u32x4*)(G + (size_t)t * 512 + c8);
        const u32x4 afp = *(const u32x4*)(AF + (size_t)t * 512 + c8), abp = *(const u32x4*)(AB + (size_t)t * 512 + c8);
        const u32x4 yfp = *(const u32x4*)(up + 512 + c8), ybp = *(const u32x4*)(up + 1024 + c8), vp = *(const u32x4*)(up + 1536 + c8);
        float y[8], rr[8], kk[8], vv[8], gg[8], sa[8];
#pragma unroll
        for (int i = 0; i < 4; ++i) {
            y[2 * i] = bflo(yfp[i]) + bflo(ybp[i]); y[2 * i + 1] = bfhi(yfp[i]) + bfhi(ybp[i]);
            rr[2 * i] = bflo(rp[i]); rr[2 * i + 1] = bfhi(rp[i]); kk[2 * i] = bflo(kp[i]); kk[2 * i + 1] = bfhi(kp[i]);
            vv[2 * i] = bflo(vp[i]); vv[2 * i + 1] = bfhi(vp[i]); gg[2 * i] = bflo(gp[i]); gg[2 * i + 1] = bfhi(gp[i]);
            sa[2 * i] = bflo(afp[i]) + bflo(abp[i]); sa[2 * i + 1] = bfhi(afp[i]) + bfhi(abp[i]);
        }
        float ysum = 0.f, bs = 0.f;
#pragma unroll
        for (int i = 0; i < 8; ++i) { ysum += y[i]; bs += rr[i] * kk[i] * (2.0f + (sa[i] - 2.0f) * kac[i]) * rkc[i]; }
        const float mu = sum8(ysum) * (1.0f / 64.0f);
        float vs = 0.f;
#pragma unroll
        for (int i = 0; i < 8; ++i) { y[i] -= mu; vs += y[i] * y[i]; }
        const float rstdv = rsqrtf(sum8(vs) * (1.0f / 64.0f) + 64e-5f);
        bs = sum8(bs);
        float o[8];
#pragma unroll
        for (int i = 0; i < 8; ++i) o[i] = (y[i] * rstdv * lnw[i] + lnb[i] + bs * vv[i]) * gg[i];
        u32x4 ov; ov.x = pack2(o[0], o[1]); ov.y = pack2(o[2], o[3]); ov.z = pack2(o[4], o[5]); ov.w = pack2(o[6], o[7]);
        *(u32x4*)(mix + (size_t)t * 1024 + 512 + c8) = ov;
    }
}

#ifndef PEER_SYNC
#define PEER_SYNC 2
#endif
template <bool DRY> DEV void ph_peer_sliced(const Args& a, const int tid0) {
    const int lane = tid0 & 63, wv = tid0 >> 6;
    const int gw = blockIdx.x * 8 + wv, nw = gridDim.x * 8;
    bf16_t* hb = wsb(a, HB_OFF); float* rstd = wsf(a, RSTD_OFF);
    const int* TOPI = (const int*)(a.ws + TOPI_OFF); const float* TOPG = wsf(a, TOPG_OFF);
    const unsigned char* PU = a.ws + PTU_OFF; const unsigned char* PV = a.ws + PTV_OFF;
    const int c16 = 16 * lane;
    const bool b5 = lane & 32, b4 = lane & 16;
    const int nround = T / (nw * 4);
    for (int rd = 0; rd < nround; ++rd) {
        u32x4 xa[4], xb[4]; float out[4][16]; int e0[4], e1[4]; float g0[4], g1[4], rs[4];
#pragma unroll
        for (int tk = 0; tk < 4; ++tk) {
            const int t = gw + nw * (rd * 4 + tk);
            xa[tk] = *(const u32x4*)(hb + (size_t)t * 1024 + c16); xb[tk] = *(const u32x4*)(hb + (size_t)t * 1024 + c16 + 8);
            rs[tk] = rstd[t] * (1.0f / 256.0f);
            e0[tk] = TOPI[(size_t)t * 128 + lane]; e1[tk] = TOPI[(size_t)t * 128 + 64 + lane];
            g0[tk] = TOPG[(size_t)t * 128 + lane]; g1[tk] = TOPG[(size_t)t * 128 + 64 + lane];
#pragma unroll
            for (int i = 0; i < 16; ++i) out[tk][i] = 0.f;
        }
#pragma unroll 1
        for (int s = 0; s < 16; ++s) {
#pragma unroll
            for (int tk = 0; tk < 4; ++tk) {
                unsigned long long m0 = __ballot((e0[tk] >> 10) == s), m1 = __ballot((e1[tk] >> 10) == s);
                while (m0 | m1) {
                    int ex[4]; float gx[4];
#pragma unroll
                    for (int i = 0; i < 4; ++i) {
                        if (m0) { const int ix = __builtin_ctzll(m0); m0 &= m0 - 1; ex[i] = __builtin_amdgcn_readlane(e0[tk], ix); gx[i] = rl(g0[tk], ix); }
                        else if (m1) { const int ix = __builtin_ctzll(m1); m1 &= m1 - 1; ex[i] = __builtin_amdgcn_readlane(e1[tk], ix); gx[i] = rl(g1[tk], ix); }
                        else { ex[i] = ex[0]; gx[i] = 0.f; }
                    }
#ifdef PROBE_EMASK
                    if (DRY) {
#pragma unroll
                        for (int i = 0; i < 4; ++i) ex[i] &= PROBE_EMASK;
                    }
#endif
                    u32x4 ur[4], vr[4];
#pragma unroll
                    for (int i = 0; i < 4; ++i) { ur[i] = *(const u32x4*)(PU + (size_t)ex[i] * 1024 + c16); vr[i] = *(const u32x4*)(PV + (size_t)ex[i] * 1024 + c16); }
                    float d[4];
#pragma unroll
                    for (int i = 0; i < 4; ++i) {
                        float sm = 0.f;
#pragma unroll
                        for (int j = 0; j < 4; ++j) {
                            const f32x2 lo = __builtin_amdgcn_cvt_pk_f32_fp8((int)ur[i][j], false), hi = __builtin_amdgcn_cvt_pk_f32_fp8((int)ur[i][j], true);
                            const unsigned ulo = (__float_as_uint(lo[0]) >> 16) | (__float_as_uint(lo[1]) & 0xffff0000u), uhi = (__float_as_uint(hi[0]) >> 16) | (__float_as_uint(hi[1]) & 0xffff0000u);
                            const unsigned xlo = (j < 2) ? xa[tk][2 * j] : xb[tk][2 * j - 4], xhi = (j < 2) ? xa[tk][2 * j + 1] : xb[tk][2 * j - 3];
                            sm = dot2bf(ulo, xlo, sm); sm = dot2bf(uhi, xhi, sm);
                        }
                        d[i] = sm;
                    }
                    float r2[2];
#pragma unroll
                    for (int i = 0; i < 2; ++i) { const float send = b5 ? d[i] : d[2 + i], keep = b5 ? d[2 + i] : d[i]; r2[i] = keep + SHX(send, 32); }
                    const float send1 = b4 ? r2[0] : r2[1], keep1 = b4 ? r2[1] : r2[0];
                    const float dd = sum16(keep1 + SHX(send1, 16));
                    const float hp = rs[tk] * dd;
                    const float gl = 0.5f * hp * (1.0f + erff(hp * 0.70710678f)) * (1.0f / 32.0f);
#pragma unroll
                    for (int i = 0; i < 4; ++i) {
                        const float wi = rl(gl, 16 * i) * gx[i];
#pragma unroll
                        for (int j = 0; j < 4; ++j) {
                            const f32x2 lo = __builtin_amdgcn_cvt_pk_f32_fp8((int)vr[i][j], false), hi = __builtin_amdgcn_cvt_pk_f32_fp8((int)vr[i][j], true);
                            out[tk][4 * j] += wi * lo[0]; out[tk][4 * j + 1] += wi * lo[1]; out[tk][4 * j + 2] += wi * hi[0]; out[tk][4 * j + 3] += wi * hi[1];
                        }
                    }
                }
            }
        }
#pragma unroll
        for (int tk = 0; tk < 4; ++tk) {
            const int t = gw + nw * (rd * 4 + tk);
            float* hr = a.h + (size_t)t * 1024 + c16;
            f32x4 hv[4]; float ss = 0.f;
#pragma unroll
            for (int j = 0; j < 4; ++j) { hv[j] = *(const f32x4*)(hr + 4 * j);
#pragma unroll
                for (int c = 0; c < 4; ++c) { hv[j][c] += out[tk][4 * j + c]; ss += hv[j][c] * hv[j][c]; }
                if (!DRY) *(f32x4*)(hr + 4 * j) = hv[j]; }
            ss = wave_sum(ss);
            if (DRY && ss != -1.0f) continue;
            u32x4 p0, p1;
            p0.x = pack2(hv[0][0], hv[0][1]); p0.y = pack2(hv[0][2], hv[0][3]); p0.z = pack2(hv[1][0], hv[1][1]); p0.w = pack2(hv[1][2], hv[1][3]);
            p1.x = pack2(hv[2][0], hv[2][1]); p1.y = pack2(hv[2][2], hv[2][3]); p1.z = pack2(hv[3][0], hv[3][1]); p1.w = pack2(hv[3][2], hv[3][3]);
            *(u32x4*)(hb + (size_t)t * 1024 + c16) = p0; *(u32x4*)(hb + (size_t)t * 1024 + c16 + 8) = p1;
            if (lane == 0) rstd[t] = rsqrtf(ss * (1.0f / 1024.0f) + 1e-6f);
        }
        if ((rd % PEER_SYNC) == PEER_SYNC - 1 && rd + 1 < nround) {
            XcdBarrier b_; b_.bar = (unsigned*)(a.ws + BAR_OFF); b_.x = xb_xcc_id(); b_.st = (volatile LAS unsigned*)(smem_base() + LDS_BYTES - 16);
            xcd_barrier(b_, tid0);
        }
    }
}

#ifdef PROBE_EMASK
#define PEER_EM(e) (DRY ? ((e) & PROBE_EMASK) : (e))
#else
#define PEER_EM(e) (e)
#endif
template <bool DRY> DEV void ph_peer_pipe(const Args& a, const int tid0, const int gw, const int nw, const int ntok) {
    const int lane = tid0 & 63;
    bf16_t* hb = wsb(a, HB_OFF); float* rstd = wsf(a, RSTD_OFF); const float* ssq = wsf(a, SSQ_OFF);
    const int* TOPI = (const int*)(a.ws + TOPI_OFF); const float* TOPG = wsf(a, TOPG_OFF);
    const unsigned char* PU = a.ws + PTU_OFF; const unsigned char* PV = a.ws + PTV_OFF;
    const int c16 = 16 * lane;
    const bool b5 = lane & 32, b4 = lane & 16, b3 = lane & 8;
    const bool dost = DRY ? (__builtin_amdgcn_readfirstlane(TOPI[0]) == -12345) : true;
    u32x4 ur[2][8], vr[8];
    int e0, e1, e0n = 0, e1n = 0; float g0, g1, g0n = 0.f, g1n = 0.f;
    u32x4 xa, xb, xan = {0u, 0u, 0u, 0u}, xbn = {0u, 0u, 0u, 0u}; float rsv, rsn = 0.f;
#define PEER_ISSUE_U(slot_, b_, es0_, es1_) do { _Pragma("unroll") for (int i_ = 0; i_ < 8; ++i_) { const int k_ = (b_) * 8 + i_; \
        const int e_ = PEER_EM(__builtin_amdgcn_readlane((k_ < 64) ? (es0_) : (es1_), k_ & 63)); ur[slot_][i_] = *(const u32x4*)(PU + (size_t)e_ * 1024 + c16); } } while (0)
#define PEER_ISSUE_V(slot_, b_, es0_, es1_) do { _Pragma("unroll") for (int i_ = 0; i_ < 8; ++i_) { const int k_ = (b_) * 8 + i_; \
        const int e_ = PEER_EM(__builtin_amdgcn_readlane((k_ < 64) ? (es0_) : (es1_), k_ & 63)); vr[i_] = *(const u32x4*)(PV + (size_t)e_ * 1024 + c16); } } while (0)
    if (ntok <= 0) return;
    {   const int t0 = gw;
        e0 = TOPI[(size_t)t0 * 128 + lane]; e1 = TOPI[(size_t)t0 * 128 + 64 + lane]; g0 = TOPG[(size_t)t0 * 128 + lane]; g1 = TOPG[(size_t)t0 * 128 + 64 + lane];
        xa = *(const u32x4*)(hb + (size_t)t0 * 1024 + c16); xb = *(const u32x4*)(hb + (size_t)t0 * 1024 + c16 + 8); rsv = rstd_parts(ssq, t0); }
    PEER_ISSUE_U(0, 0, e0, e1);
#pragma unroll 1
    for (int j = 0; j < ntok; ++j) {
        const int t = gw + nw * j; const bool more = (j + 1 < ntok);
        float* hr = a.h + (size_t)t * 1024 + c16;
        if (more) { const int tn = t + nw;
            e0n = TOPI[(size_t)tn * 128 + lane]; e1n = TOPI[(size_t)tn * 128 + 64 + lane]; }
        const float rs = rsv * (1.0f / 256.0f);
        float out[16];
#pragma unroll
        for (int i = 0; i < 16; ++i) out[i] = 0.f;
#pragma unroll 1
        for (int b2 = 0; b2 < 16; b2 += 2)
#pragma unroll
        for (int bb = 0; bb < 2; ++bb) {
            const int b = b2 + bb;
            PEER_ISSUE_V(0, b, e0, e1);
            if (bb == 0) PEER_ISSUE_U(1, b + 1, e0, e1);
            else if (b < 15) PEER_ISSUE_U(0, b + 1, e0, e1);
            else if (more) PEER_ISSUE_U(0, 0, e0n, e1n);
            asm volatile("" ::: "memory");
            float d[8];
#pragma unroll
            for (int i = 0; i < 8; ++i) {
                float sm = 0.f;
#pragma unroll
                for (int q = 0; q < 4; ++q) {
                    const unsigned uw = ur[bb][i][q];
                    const f32x2 lo = __builtin_amdgcn_cvt_pk_f32_fp8((int)uw, false), hi = __builtin_amdgcn_cvt_pk_f32_fp8((int)uw, true);
                    const unsigned ulo = (__float_as_uint(lo[0]) >> 16) | (__float_as_uint(lo[1]) & 0xffff0000u), uhi = (__float_as_uint(hi[0]) >> 16) | (__float_as_uint(hi[1]) & 0xffff0000u);
                    const unsigned xlo = (q < 2) ? xa[2 * q] : xb[2 * q - 4], xhi = (q < 2) ? xa[2 * q + 1] : xb[2 * q - 3];
                    sm = dot2bf(ulo, xlo, sm); sm = dot2bf(uhi, xhi, sm);
                }
                d[i] = sm;
            }
            float r4[4], r2[2];
#pragma unroll
            for (int i = 0; i < 4; ++i) { const float send = b5 ? d[i] : d[4 + i], keep = b5 ? d[4 + i] : d[i]; r4[i] = keep + SHX(send, 32); }
#pragma unroll
            for (int i = 0; i < 2; ++i) { const float send = b4 ? r4[i] : r4[2 + i], keep = b4 ? r4[2 + i] : r4[i]; r2[i] = keep + SHX(send, 16); }
            const float send1 = b3 ? r2[0] : r2[1], keep1 = b3 ? r2[1] : r2[0];
            const float dd = sum8(keep1 + SHX(send1, 8));
            const float hp = rs * dd;
            const float gt = SHF((b < 8) ? g0 : g1, (b * 8 + (lane >> 3)) & 63);
            const float w = gt * 0.5f * hp * (1.0f + erff(hp * 0.70710678f)) * (1.0f / 32.0f);
#pragma unroll
            for (int i = 0; i < 8; ++i) {
                const float wi = rl(w, 8 * i);
#pragma unroll
                for (int q = 0; q < 4; ++q) {
                    const unsigned vw = vr[i][q];
                    const f32x2 lo = __builtin_amdgcn_cvt_pk_f32_fp8((int)vw, false), hi = __builtin_amdgcn_cvt_pk_f32_fp8((int)vw, true);
                    out[4 * q] += wi * lo[0]; out[4 * q + 1] += wi * lo[1]; out[4 * q + 2] += wi * hi[0]; out[4 * q + 3] += wi * hi[1];
                }
            }
        }
        if (more) { const int tn = t + nw;
            g0n = TOPG[(size_t)tn * 128 + lane]; g1n = TOPG[(size_t)tn * 128 + 64 + lane];
            xan = *(const u32x4*)(hb + (size_t)tn * 1024 + c16); xbn = *(const u32x4*)(hb + (size_t)tn * 1024 + c16 + 8); rsn = rstd_parts(ssq, tn); }
        float ss = 0.f;
        f32x4 hv[4];
#pragma unroll
        for (int q = 0; q < 4; ++q) hv[q] = *(const f32x4*)(hr + 4 * q);
#pragma unroll
        for (int q = 0; q < 4; ++q) {
#pragma unroll
            for (int c = 0; c < 4; ++c) { hv[q][c] += out[4 * q + c]; ss += hv[q][c] * hv[q][c]; }
            if (dost) *(f32x4*)(hr + 4 * q) = hv[q];
        }
        ss = wave_sum(ss);
        if (dost) {
            u32x4 p0, p1;
            p0.x = pack2(hv[0][0], hv[0][1]); p0.y = pack2(hv[0][2], hv[0][3]); p0.z = pack2(hv[1][0], hv[1][1]); p0.w = pack2(hv[1][2], hv[1][3]);
            p1.x = pack2(hv[2][0], hv[2][1]); p1.y = pack2(hv[2][2], hv[2][3]); p1.z = pack2(hv[3][0], hv[3][1]); p1.w = pack2(hv[3][2], hv[3][3]);
            *(u32x4*)(hb + (size_t)t * 1024 + c16) = p0; *(u32x4*)(hb + (size_t)t * 1024 + c16 + 8) = p1;
            if (lane == 0) rstd[t] = rsqrtf(ss * (1.0f / 1024.0f) + 1e-6f);
        }
        e0 = e0n; e1 = e1n; g0 = g0n; g1 = g1n; xa = xan; xb = xbn; rsv = rsn;
    }
#undef PEER_ISSUE_U
#undef PEER_ISSUE_V
}

#ifndef PEER_NCH
#define PEER_NCH 8
#endif
#ifndef PEER_NPW
#define PEER_NPW 3
#endif
DEV void ph_topk_peer(const Args& a, float* lds, const int tid0) {
    const int wv = __builtin_amdgcn_readfirstlane(tid0 >> 6);
    constexpr int CH = T / PEER_NCH;
    const int npeer = gridDim.x * PEER_NPW, ntopk = gridDim.x * (8 - PEER_NPW);
#pragma unroll 1
    for (int s = 0; s <= PEER_NCH; ++s) {
        if (wv < PEER_NPW) {
            if (s >= 1) { const int pw = blockIdx.x * PEER_NPW + wv; ph_peer_pipe<false>(a, tid0, (s - 1) * CH + pw, npeer, (CH - pw + npeer - 1) / npeer); }
        } else {
            if (s < PEER_NCH) { const int tw = blockIdx.x * (8 - PEER_NPW) + (wv - PEER_NPW); ph_topk2(a, lds, tid0, s * CH * 4 + tw, ntopk, (s + 1) * CH * 4); }
        }
        XcdBarrier b_; b_.bar = (unsigned*)(a.ws + BAR_OFF); b_.x = xb_xcc_id(); b_.st = (volatile LAS unsigned*)(smem_base() + LDS_BYTES - 16);
        xcd_barrier(b_, tid0);
    }
}

typedef float f32x4v __attribute__((ext_vector_type(4)));
#define MFMA16(a, b, c) __builtin_amdgcn_mfma_f32_16x16x32_bf16((a), (b), (c), 0, 0, 0)
namespace sc4 {
constexpr int E_AH = 0, E_RH = 2304, E_BH = 4608, E_KH = 6912, E_BHT = 9216, E_KHT = 12288, E_VT = 15360, E_GC = 18432, E_BYTES = 18688;
constexpr int G_NKAT = 0, G_NBRT = 768, G_NKRT = 1536, G_TT = 2304, G_BYTES = 3072;
constexpr int OFF_E = 0, OFF_G = 6 * E_BYTES, OFF_NBAT = OFF_G + 4 * G_BYTES, OFF_Y = OFF_NBAT + 2 * 1024, TOTAL = OFF_Y + 16384;
}
DEV bf16x8 frag2(u32x2 lo, u32x2 hi) { u32x4 v; v.x = lo.x; v.y = lo.y; v.z = hi.x; v.w = hi.y; return __builtin_bit_cast(bf16x8, v); }
DEV bf16x8 pack_acc(f32x4v p, f32x4v q) { u32x4 v; v.x = pack2(p[0], p[1]); v.y = pack2(p[2], p[3]); v.z = pack2(q[0], q[1]); v.w = pack2(q[2], q[3]); return __builtin_bit_cast(bf16x8, v); }
DEV void ph_scan4(const Args& a, int layer, unsigned char* lb, const int tid0) {
    using namespace sc4;
    static_assert(TOTAL <= LDS_BYTES - 16, "scan LDS map");
    const int lane = tid0 & 63, wv = __builtin_amdgcn_readfirstlane(tid0 >> 6);
    const int r = lane & 15, g = lane >> 4;
    const bf16_t* U = wsb(a, U_OFF); const bf16_t* RS = wsb(a, RS_OFF); const bf16_t* KS = wsb(a, KS_OFF); bf16_t* Uw = wsb(a, U_OFF);
    const bool is_state = wv < 4;
    const int dir = is_state ? (wv >> 1) : ((wv - 4) >> 1), role = wv & 1;
    const bf16_t* Wd = wsb(a, dir ? WB2_OFF : WF_OFF); const bf16_t* Ad = wsb(a, dir ? AB_OFF : AF_OFF);
    const u32x2 z2 = {0u, 0u}; const u32x4 z4 = {0u, 0u, 0u, 0u};
    for (int un = blockIdx.x; un < NSEQ * 8; un += gridDim.x) {
        const int seq = un >> 3, hd = un & 7; const size_t tb = (size_t)seq * 4096; const int cb = hd * 64, pch = cb + lane;
        const float kac = a.rwkv_k_a[layer * 512 + pch];
#define SC4_ISSUE(n_) do { _Pragma("unroll") for (int s_ = 0; s_ < 16; ++s_) { const int step_ = (n_) * 16 + s_, pos_ = dir ? 4095 - step_ : step_; const size_t t_ = tb + pos_; \
            pr[s_][0] = Wd[t_ * 512 + pch]; pr[s_][1] = U[t_ * UW + pch]; pr[s_][2] = Ad[t_ * 512 + pch]; pr[s_][3] = KS[t_ * 512 + pch]; pr[s_][4] = RS[t_ * 512 + pch]; pr[s_][5] = U[t_ * UW + 1536 + pch]; } } while (0)
        __syncthreads();
        if (is_state) {
            f32x4v X[4][2];
#pragma unroll
            for (int m = 0; m < 4; ++m)
#pragma unroll
                for (int vt = 0; vt < 2; ++vt) X[m][vt] = (f32x4v){0.f, 0.f, 0.f, 0.f};
#pragma unroll 1
            for (int p = 0; p < 259; ++p) {
                if (p >= 2 && p < 258) {
                    const int n = p - 2;
                    const unsigned char* E = lb + OFF_E + (dir * 3 + (n % 3)) * E_BYTES;
                    const unsigned char* G = lb + OFF_G + (dir * 2 + (n & 1)) * G_BYTES;
                    float* yb = (float*)(lb + OFF_Y) + (((n & 1) * 2 + dir) * 16) * 64 + 32 * role;
                    bf16x8 fa[2], fr[2];
#pragma unroll
                    for (int s = 0; s < 2; ++s) {
                        fa[s] = frag2(*(const u32x2*)(E + E_AH + r * 144 + 2 * (32 * s + 4 * g)), *(const u32x2*)(E + E_AH + r * 144 + 2 * (32 * s + 16 + 4 * g)));
                        fr[s] = frag2(*(const u32x2*)(E + E_RH + r * 144 + 2 * (32 * s + 4 * g)), *(const u32x2*)(E + E_RH + r * 144 + 2 * (32 * s + 16 + 4 * g)));
                    }
                    const int g1 = g & 1;
                    u32x4 nka = *(const u32x4*)(G + G_NKAT + r * 48 + 16 * g1), nkr = *(const u32x4*)(G + G_NKRT + r * 48 + 16 * g1);
                    if (g >= 2) { nka = z4; nkr = z4; }
                    const bf16x8 fnka = __builtin_bit_cast(bf16x8, nka), fnkr = __builtin_bit_cast(bf16x8, nkr);
                    const bf16x8 ftt = frag2(*(const u32x2*)(G + G_TT + r * 48 + 8 * g), z2), fnbr = frag2(*(const u32x2*)(G + G_NBRT + r * 48 + 8 * g), z2);
                    bf16x8 fbt[4], fkt[4]; f32x4v gc[4];
#pragma unroll
                    for (int m = 0; m < 4; ++m) {
                        fbt[m] = frag2(*(const u32x2*)(E + E_BHT + (16 * m + r) * 48 + 8 * g), z2);
                        u32x4 kt = *(const u32x4*)(E + E_KHT + (16 * m + r) * 48 + 16 * g1); if (g >= 2) kt = z4; fkt[m] = __builtin_bit_cast(bf16x8, kt);
                        gc[m] = *(const f32x4v*)(E + E_GC + 4 * (16 * m + 4 * g));
                    }
#pragma unroll
                    for (int vt = 0; vt < 2; ++vt) {
                        const int v0 = 32 * role + 16 * vt;
                        u32x4 vv = *(const u32x4*)(E + E_VT + (v0 + r) * 48 + 16 * g1); if (g >= 2) vv = z4;
                        const bf16x8 vb = __builtin_bit_cast(bf16x8, vv);
                        const bf16x8 xb0 = pack_acc(X[0][vt], X[1][vt]), xb1 = pack_acc(X[2][vt], X[3][vt]);
                        f32x4v W = {0.f, 0.f, 0.f, 0.f};
                        W = MFMA16(fa[0], xb0, W); W = MFMA16(fa[1], xb1, W); W = MFMA16(fnka, vb, W);
                        const f32x4v zero4 = {0.f, 0.f, 0.f, 0.f};
                        f32x4v Uc = MFMA16(ftt, pack_acc(W, zero4), zero4);
                        const bf16x8 ub = pack_acc(Uc, zero4);
                        f32x4v Y = {0.f, 0.f, 0.f, 0.f};
                        Y = MFMA16(fr[0], xb0, Y); Y = MFMA16(fr[1], xb1, Y); Y = MFMA16(fnbr, ub, Y); Y = MFMA16(fnkr, vb, Y);
#pragma unroll
                        for (int i = 0; i < 4; ++i) yb[(4 * g + i) * 64 + 16 * vt + r] = Y[i];
#pragma unroll
                        for (int m = 0; m < 4; ++m) { f32x4v xm = MFMA16(fbt[m], ub, X[m][vt]); xm = MFMA16(fkt[m], vb, xm); X[m][vt] = xm * gc[m]; }
                    }
                }
                __syncthreads();
            }
        } else if (role == 0) {
            unsigned short pr[16][6];
            SC4_ISSUE(0);
#pragma unroll 1
            for (int p = 0; p < 259; ++p) {
                if (p < 256) {
                    unsigned char* E = lb + OFF_E + (dir * 3 + (p % 3)) * E_BYTES;
                    float gcur = 1.0f;
                    unsigned bt[8], kt[8], vtw[8];
#pragma unroll
                    for (int s = 0; s < 16; ++s) {
                        const float w_ = bf2f(pr[s][0]), kk_ = bf2f(pr[s][1]), ic_ = bf2f(pr[s][2]), ks_ = bf2f(pr[s][3]), r_ = bf2f(pr[s][4]), v_ = bf2f(pr[s][5]);
                        const float gprev = gcur; gcur *= w_;
                        const float ig = __builtin_amdgcn_rcpf(gcur);
                        const unsigned ah = f2bf(-gprev * kk_), bh = f2bf(kk_ * ic_ * ig), kh = f2bf(ks_ * (1.0f + (ic_ - 1.0f) * kac) * ig), rh = f2bf(gcur * r_), vh = pr[s][5];
                        *(unsigned short*)(E + E_AH + s * 144 + 2 * lane) = (unsigned short)ah; *(unsigned short*)(E + E_RH + s * 144 + 2 * lane) = (unsigned short)rh;
                        *(unsigned short*)(E + E_BH + s * 144 + 2 * lane) = (unsigned short)bh; *(unsigned short*)(E + E_KH + s * 144 + 2 * lane) = (unsigned short)kh;
                        if (s & 1) { bt[s >> 1] |= bh << 16; kt[s >> 1] |= kh << 16; vtw[s >> 1] |= vh << 16; } else { bt[s >> 1] = bh; kt[s >> 1] = kh; vtw[s >> 1] = vh; }
                        (void)v_;
                    }
                    *(u32x4*)(E + E_BHT + lane * 48) = (u32x4){bt[0], bt[1], bt[2], bt[3]}; *(u32x4*)(E + E_BHT + lane * 48 + 16) = (u32x4){bt[4], bt[5], bt[6], bt[7]};
                    *(u32x4*)(E + E_KHT + lane * 48) = (u32x4){kt[0], kt[1], kt[2], kt[3]}; *(u32x4*)(E + E_KHT + lane * 48 + 16) = (u32x4){kt[4], kt[5], kt[6], kt[7]};
                    *(u32x4*)(E + E_VT + lane * 48) = (u32x4){vtw[0], vtw[1], vtw[2], vtw[3]}; *(u32x4*)(E + E_VT + lane * 48 + 16) = (u32x4){vtw[4], vtw[5], vtw[6], vtw[7]};
                    *(float*)(E + E_GC + 4 * lane) = gcur;
                    if (p + 1 < 256) SC4_ISSUE(p + 1);
                }
                __syncthreads();
            }
        } else {
#pragma unroll 1
            for (int p = 0; p < 259; ++p) {
                if (p >= 1 && p < 257) {
                    const int n = p - 1;
                    const unsigned char* E = lb + OFF_E + (dir * 3 + (n % 3)) * E_BYTES;
                    unsigned char* G = lb + OFF_G + (dir * 2 + (n & 1)) * G_BYTES;
                    float* nbat = (float*)(lb + OFF_NBAT + dir * 1024);
                    bf16x8 ab[2], rb[2], bA[2], kA[2];
#pragma unroll
                    for (int s = 0; s < 2; ++s) {
                        ab[s] = *(const bf16x8*)(E + E_AH + r * 144 + 2 * (32 * s + 8 * g)); rb[s] = *(const bf16x8*)(E + E_RH + r * 144 + 2 * (32 * s + 8 * g));
                        bA[s] = *(const bf16x8*)(E + E_BH + r * 144 + 2 * (32 * s + 8 * g)); kA[s] = *(const bf16x8*)(E + E_KH + r * 144 + 2 * (32 * s + 8 * g));
                    }
                    const f32x4v zero4 = {0.f, 0.f, 0.f, 0.f};
                    f32x4v nba = MFMA16(bA[1], ab[1], MFMA16(bA[0], ab[0], zero4)), nka = MFMA16(kA[1], ab[1], MFMA16(kA[0], ab[0], zero4));
                    f32x4v nbr = MFMA16(bA[1], rb[1], MFMA16(bA[0], rb[0], zero4)), nkr = MFMA16(kA[1], rb[1], MFMA16(kA[0], rb[0], zero4));
#pragma unroll
                    for (int i = 0; i < 4; ++i) { const int j = 4 * g + i; if (j >= r) { nba[i] = 0.f; nka[i] = 0.f; } if (j > r) { nbr[i] = 0.f; nkr[i] = 0.f; } }
                    *(f32x4v*)(nbat + r * 16 + 4 * g) = nba;
                    u32x2 pk; pk.x = pack2(nka[0], nka[1]); pk.y = pack2(nka[2], nka[3]); *(u32x2*)(G + G_NKAT + r * 48 + 8 * g) = pk;
                    pk.x = pack2(nbr[0], nbr[1]); pk.y = pack2(nbr[2], nbr[3]); *(u32x2*)(G + G_NBRT + r * 48 + 8 * g) = pk;
                    pk.x = pack2(nkr[0], nkr[1]); pk.y = pack2(nkr[2], nkr[3]); *(u32x2*)(G + G_NKRT + r * 48 + 8 * g) = pk;
                    asm volatile("s_waitcnt lgkmcnt(0)" ::: "memory");
                    float Tr[16];
#pragma unroll
                    for (int t = 0; t < 16; ++t) {
                        float acc = (lane == t) ? 1.0f : 0.f;
#pragma unroll
                        for (int i4 = 0; i4 < (t + 3) / 4; ++i4) { const f32x4v nb = *(const f32x4v*)(nbat + t * 16 + 4 * i4);
#pragma unroll
                            for (int i = 0; i < 4; ++i) if (4 * i4 + i < t) acc += Tr[4 * i4 + i] * nb[i]; }
                        Tr[t] = acc;
                        if (lane < 16) *(unsigned short*)(G + G_TT + t * 48 + 2 * lane) = (unsigned short)f2bf(acc);
                    }
                }
                if (p >= 3) {
                    const int n = p - 3;
                    const float* yb = (const float*)(lb + OFF_Y) + (((n & 1) * 2 + dir) * 16) * 64;
                    const int s2 = lane >> 2, c16 = (lane & 3) * 16;
                    const f32x4v y0 = *(const f32x4v*)(yb + s2 * 64 + c16), y1 = *(const f32x4v*)(yb + s2 * 64 + c16 + 4), y2 = *(const f32x4v*)(yb + s2 * 64 + c16 + 8), y3 = *(const f32x4v*)(yb + s2 * 64 + c16 + 12);
                    const int step = n * 16 + s2, pos = dir ? 4095 - step : step;
                    u32x4 o0, o1; o0.x = pack2(y0[0], y0[1]); o0.y = pack2(y0[2], y0[3]); o0.z = pack2(y1[0], y1[1]); o0.w = pack2(y1[2], y1[3]);
                    o1.x = pack2(y2[0], y2[1]); o1.y = pack2(y2[2], y2[3]); o1.z = pack2(y3[0], y3[1]); o1.w = pack2(y3[2], y3[3]);
                    bf16_t* dst = Uw + (tb + pos) * UW + 512 + 512 * dir + cb + c16;
                    *(u32x4*)(dst) = o0; *(u32x4*)(dst + 8) = o1;
                }
                __syncthreads();
            }
        }
#undef SC4_ISSUE
    }
}

extern __shared__ __attribute__((aligned(16))) unsigned char smem[];

enum { PH_PROLOGUE = 0, PH_ROWPREP_X, PH_ROWPREP, PH_GEMM1, PH_ATTN, PH_ATTNX, PH_MERGE, PH_LORA, PH_PREP2, PH_SCAN, PH_POST, PH_GEMM2, PH_CONVERT, PH_GEMM3, PH_TOPK, PH_PEER, PH_PEERDRY, PH_TOPKPEER, PH_GEMM4A, PH_GEMM4B, PH_FINAL };

template <int PH> DEV void run_phase(const Args& a, int layer, const int tid0) {
    float* ldsf = (float*)smem;
    PG8_LAS unsigned char* ldsg = (PG8_LAS unsigned char*)smem;
    const bf16_t* wb = wsb(a, WB_OFF + (size_t)layer * WB_LAYER);
    if constexpr (PH == PH_PROLOGUE) ph_prologue(a, ldsf, tid0);
    else if constexpr (PH == PH_ROWPREP_X) ph_rowprep(a, true, tid0);
    else if constexpr (PH == PH_ROWPREP) ph_rowprep(a, false, tid0);
    else if constexpr (PH == PH_GEMM1) {
        pg8::Gemm g{wsb(a, HB_OFF), wb + WB_IN / 2, T, INP, 1024};
        pg8::StaticOrder S; S.init(T, INP, gridDim.x, blockIdx.x);
        pg8::EpiProj E{wsb(a, QKV_OFF), wsb(a, U_OFF), wsf(a, SSQ_OFF), wsf(a, ROPEC_OFF), wsf(a, ROPES_OFF)};
        pg8::gemm_phase<pg8::EpiProj, pg8::StaticOrder, false>(ldsg, g, S, E, nullptr, tid0);
    }
    else if constexpr (PH == PH_ATTN) ph_attn2<0>(a, smem, tid0);
    else if constexpr (PH == PH_ATTNX) ph_attn2<ATTN_VAR>(a, smem, tid0);
    else if constexpr (PH == PH_MERGE) ph_attn_merge(a, layer, tid0);
    else if constexpr (PH == PH_LORA) ph_rwkv_prep1(a, layer, smem, tid0);
    else if constexpr (PH == PH_PREP2) ph_rwkv_prep2(a, layer, tid0);
    else if constexpr (PH == PH_SCAN) ph_scan4(a, layer, smem, tid0);
    else if constexpr (PH == PH_POST) ph_post2(a, layer, tid0);
    else if constexpr (PH == PH_GEMM2) {
        pg8::Gemm g{wsb(a, MIX_OFF), wb + WB_OUT / 2, T, 1024, 1024};
        pg8::StaticOrder S; S.init(T, 1024, gridDim.x, blockIdx.x);
        pg8::EpiF32x<1> E{a.h, 1024, nullptr, wsb(a, HB_OFF), wsf(a, SSQ_OFF)};
        pg8::gemm_phase<pg8::EpiF32x<1>, pg8::StaticOrder, false>(ldsg, g, S, E, nullptr, tid0);
    }
    else if constexpr (PH == PH_CONVERT) ph_convert8(a, layer, tid0);
    else if constexpr (PH == PH_GEMM3) {
        pg8::Gemm g{wsb(a, HB_OFF), wb + WB_QK / 2, T, 2048, 1024};
        pg8::StaticOrder S; S.init(T, 2048, gridDim.x, blockIdx.x);
        pg8::EpiF32x<0> E{wsf(a, SC_OFF), 2048, nullptr, nullptr, nullptr};
        pg8::gemm_phase<pg8::EpiF32x<0>, pg8::StaticOrder, false>(ldsg, g, S, E, nullptr, tid0);
    }
    else if constexpr (PH == PH_TOPK) ph_topk2(a, ldsf, tid0, blockIdx.x * 8 + (tid0 >> 6), gridDim.x * 8, T * 4);
    else if constexpr (PH == PH_TOPKPEER) ph_topk_peer(a, ldsf, tid0);
    else if constexpr (PH == PH_PEER) ph_peer_pipe<false>(a, tid0, blockIdx.x * 8 + (tid0 >> 6), gridDim.x * 8, T / (gridDim.x * 8));
    else if constexpr (PH == PH_PEERDRY) ph_peer_pipe<true>(a, tid0, blockIdx.x * 8 + (tid0 >> 6), gridDim.x * 8, T / (gridDim.x * 8));
    else if constexpr (PH == PH_GEMM4A) {
        pg8::Gemm g{wsb(a, HB_OFF), wb + WB_GATE / 2, T, 1024, 1024};
        pg8::StaticOrder S; S.init(T, 1024, gridDim.x, blockIdx.x);
        pg8::EpiGate E{wsb(a, GATE_OFF), wsf(a, RSTD_OFF), a.ple_b_gate + layer * 1024};
        pg8::gemm_phase<pg8::EpiGate, pg8::StaticOrder, false>(ldsg, g, S, E, nullptr, tid0);
    }
    else if constexpr (PH == PH_GEMM4B) {
        pg8::Gemm g{wsb(a, PB_OFF), wb + WB_PROJ / 2, T, 1024, 256};
        pg8::StaticOrder S; S.init(T, 1024, gridDim.x, blockIdx.x);
        pg8::EpiF32x<2> E{a.h, 1024, wsb(a, GATE_OFF), wsb(a, HB_OFF), wsf(a, SSQ_OFF)};
        pg8::gemm_phase<pg8::EpiF32x<2>, pg8::StaticOrder, false>(ldsg, g, S, E, nullptr, tid0);
    }
    else if constexpr (PH == PH_FINAL) ph_final(a, tid0);
}

#if !ONE_LAUNCH
template <int PH> __global__ void __launch_bounds__(NTHR, 2) k_phase(Args a, int layer) { run_phase<PH>(a, layer, (int)threadIdx.x); }
#endif

#if ONE_LAUNCH
#ifndef REP_PEER
#define REP_PEER 1
#endif
#ifndef REP_SCAN
#define REP_SCAN 1
#endif
#ifndef REP_TOPK
#define REP_TOPK 1
#endif
#ifndef REP_GEMM1
#define REP_GEMM1 1
#endif
#ifndef REP_LORA
#define REP_LORA 1
#endif
#ifndef REP_POST
#define REP_POST 1
#endif
#ifndef REP_ATTN
#define REP_ATTN 1
#endif
#ifndef REP_GEMM3
#define REP_GEMM3 1
#endif
typedef const __attribute__((address_space(4))) unsigned long long* kargs_t;
static_assert(sizeof(Args) == 31 * 8, "Args is 31 pointers, no padding");
#define AS1 __attribute__((address_space(1)))
DEV Args load_args(kargs_t kp) {
    Args r; const float** d = (const float**)&r;
#pragma unroll
    for (int i = 0; i < 29; ++i) d[i] = (const float*)(AS1 const float*)kp[i];
    r.h = (float*)(AS1 float*)kp[29]; r.ws = (unsigned char*)(AS1 unsigned char*)kp[30];
    return r; }
#define RUN(PH, layer) do { kargs_t kp_ = (kargs_t)__builtin_amdgcn_kernarg_segment_ptr(); asm volatile("" : "+s"(kp_)); const Args la_ = load_args(kp_); int t_; asm volatile("v_mbcnt_lo_u32_b32 %0, -1, 0\n\tv_mbcnt_hi_u32_b32 %0, -1, %0\n\tv_lshl_add_u32 %0, %1, 6, %0" : "=&v"(t_) : "s"(wv0_)); run_phase<PH>(la_, layer, t_); } while (0)
#define BAR() do { kargs_t kp_ = (kargs_t)__builtin_amdgcn_kernarg_segment_ptr(); asm volatile("" : "+s"(kp_)); XcdBarrier b_; b_.bar = (unsigned*)((unsigned char*)kp_[30] + BAR_OFF); b_.x = xb_xcc_id(); b_.st = (volatile LAS unsigned*)(smem + LDS_BYTES - 16); int t_; asm volatile("v_mbcnt_lo_u32_b32 %0, -1, 0\n\tv_mbcnt_hi_u32_b32 %0, -1, %0\n\tv_lshl_add_u32 %0, %1, 6, %0" : "=&v"(t_) : "s"(wv0_)); xcd_barrier(b_, t_); } while (0)
#define LAYER_BODY(layer) do { \
        for (int rep_ = 0; rep_ < REP_GEMM1; ++rep_) { RUN(PH_GEMM1, layer); BAR(); } \
        if (REP_ATTNX) { RUN(PH_ATTNX, layer); BAR(); } \
        if (REP_MERGE) { RUN(PH_MERGE, layer); BAR(); } \
        for (int rep_ = 0; rep_ < REP_ATTN; ++rep_) { RUN(PH_ATTN, layer); BAR(); RUN(PH_MERGE, layer); BAR(); } \
        for (int rep_ = 0; rep_ < REP_LORA; ++rep_) { RUN(PH_LORA, layer); BAR(); } \
        RUN(PH_PREP2, layer); BAR(); \
        for (int rep_ = 0; rep_ < REP_SCAN; ++rep_) { RUN(PH_SCAN, layer); BAR(); } \
        for (int rep_ = 0; rep_ < REP_POST; ++rep_) { RUN(PH_POST, layer); BAR(); } \
        RUN(PH_GEMM2, layer); BAR(); \
        RUN(PH_CONVERT, layer); BAR(); \
        for (int rep_ = 0; rep_ < REP_GEMM3; ++rep_) { RUN(PH_GEMM3, layer); BAR(); } \
        RUN(PH_TOPKPEER, layer); \
        RUN(PH_GEMM4A, layer); BAR(); \
        RUN(PH_GEMM4B, layer); BAR(); \
    } while (0)
__global__ void __launch_bounds__(NTHR, 2) k_mega(Args a) {
    if (threadIdx.x == 0) *(uint4*)(smem + LDS_BYTES - 16) = make_uint4(0u, 0u, 0u, 0u);
    __syncthreads();
    (void)xcd_barrier_post((unsigned*)(a.ws + BAR_OFF), (volatile LAS unsigned*)(smem + LDS_BYTES - 16));
    const int wv0_ = __builtin_amdgcn_readfirstlane((int)threadIdx.x >> 6);
    RUN(PH_PROLOGUE, 0);
    RUN(PH_ROWPREP_X, 0); BAR();
    LAYER_BODY(0); LAYER_BODY(1); LAYER_BODY(2); LAYER_BODY(3);
    RUN(PH_FINAL, 0);
}
#endif

#if !ONE_LAUNCH
template <int PH> static void launch_phase(const Args& a, int layer, hipStream_t st) {
    static bool attr = false;
    if (!attr) { (void)hipFuncSetAttribute((const void*)k_phase<PH>, hipFuncAttributeMaxDynamicSharedMemorySize, LDS_BYTES); attr = true; }
    hipLaunchKernelGGL(k_phase<PH>, dim3(NWG), dim3(NTHR), LDS_BYTES, st, a, layer);
}
#endif

extern "C" void kernel_launch(void* const* d_in, const int* in_sizes, int n_in, void* d_out, int out_size, void* d_ws, size_t ws_size, hipStream_t stream) {
    if (n_in != 29 || out_size != T * D || ws_size < WS_END) {
        fprintf(stderr, "kernel_launch: unexpected shapes (n_in %d, out %d, ws %zu, need %zu); nothing launched\n", n_in, out_size, ws_size, (size_t)WS_END);
        return;
    }
    Args a{};
    const float** ap = (const float**)&a;
    for (int i = 0; i < 29; ++i) ap[i] = (const float*)d_in[i];
    a.h = (float*)d_out; a.ws = (unsigned char*)d_ws;
#if ONE_LAUNCH
    static bool attr = false;
    if (!attr) { (void)hipFuncSetAttribute((const void*)k_mega, hipFuncAttributeMaxDynamicSharedMemorySize, LDS_BYTES); attr = true; }
    (void)hipMemsetAsync((char*)d_ws + BAR_OFF, 0, XCD_BAR_WORDS * sizeof(unsigned), stream);
    hipLaunchKernelGGL(k_mega, dim3(NWG), dim3(NTHR), LDS_BYTES, stream, a);
#else
    launch_phase<PH_PROLOGUE>(a, 0, stream);
    launch_phase<PH_ROWPREP_X>(a, 0, stream);
    for (int layer = 0; layer < NL; ++layer) {
        if (layer > 0) launch_phase<PH_ROWPREP>(a, layer, stream);
        launch_phase<PH_GEMM1>(a, layer, stream);
        launch_phase<PH_ATTN>(a, layer, stream);
        launch_phase<PH_MERGE>(a, layer, stream);
        launch_phase<PH_LORA>(a, layer, stream);
        launch_phase<PH_PREP2>(a, layer, stream);
        launch_phase<PH_SCAN>(a, layer, stream);
        launch_phase<PH_POST>(a, layer, stream);
        launch_phase<PH_GEMM2>(a, layer, stream);
        launch_phase<PH_ROWPREP>(a, layer, stream);
        launch_phase<PH_CONVERT>(a, layer, stream);
        launch_phase<PH_GEMM3>(a, layer, stream);
        launch_phase<PH_TOPK>(a, layer, stream);
        launch_phase<PH_PEER>(a, layer, stream);
        launch_phase<PH_GEMM4A>(a, layer, stream);
        launch_phase<PH_GEMM4B>(a, layer, stream);
    }
    launch_phase<PH_FINAL>(a, 0, stream);
#endif
}
```

```cpp
#include <hip/hip_runtime.h>
#include <stdint.h>
#include <stdio.h>

#ifndef ONE_LAUNCH
#define ONE_LAUNCH 1
#endif

#ifndef REP_ATTNX
#define REP_ATTNX 0
#endif
#ifndef REP_MERGE
#define REP_MERGE 0
#endif
#ifndef ATTN_VAR
#define ATTN_VAR 0
#endif

typedef unsigned short bf16_t;
typedef float f32x4 __attribute__((ext_vector_type(4)));
typedef float f32x2 __attribute__((ext_vector_type(2)));
typedef unsigned u32x4 __attribute__((ext_vector_type(4)));
typedef unsigned u32x2 __attribute__((ext_vector_type(2)));
typedef __bf16 bf16x2_t __attribute__((ext_vector_type(2)));

#define DEV __device__ __forceinline__

namespace cfg {
constexpr int NSEQ = 20, SEQ = 4096, T = NSEQ * SEQ, TP = 4 * SEQ, D = 1024, NL = 4;
constexpr int INC = 3456, INP = 3584;
constexpr int QKVW = 1536, UW = 2048, UC = 1920;
constexpr int NWG = 256, NTHR = 512;
constexpr int LDS_BYTES = 163840;
constexpr size_t MiB = 1ull << 20;
constexpr size_t WB_OFF = 0;
constexpr size_t WB_LAYER = 16 * MiB;
constexpr size_t WB_IN = 0, WB_OUT = 7 * MiB, WB_QK = 9 * MiB, WB_GATE = 13 * MiB, WB_PROJ = 15 * MiB, WB_LORA = 15 * MiB + 512 * 1024;
constexpr size_t HB_OFF = 64 * MiB;
constexpr size_t MIX_OFF = 224 * MiB;
constexpr size_t SMALL_OFF = 384 * MiB;
constexpr size_t RSTD_OFF = SMALL_OFF;
constexpr size_t ROPEC_OFF = SMALL_OFF + 512 * 1024, ROPES_OFF = SMALL_OFF + 640 * 1024;
constexpr size_t BAR_OFF = SMALL_OFF + 1 * MiB;
constexpr size_t BIG_OFF = 386 * MiB;
constexpr size_t QKV_OFF = BIG_OFF;
constexpr size_t RS_OFF = BIG_OFF, KS_OFF = BIG_OFF + 80 * MiB, G_OFF = BIG_OFF + 160 * MiB;
constexpr size_t U_OFF = BIG_OFF + 240 * MiB;
constexpr size_t WF_OFF = BIG_OFF + 560 * MiB, WB2_OFF = BIG_OFF + 640 * MiB, AF_OFF = BIG_OFF + 720 * MiB, AB_OFF = BIG_OFF + 800 * MiB;
constexpr size_t OP_OFF = BIG_OFF + 560 * MiB;
constexpr size_t ML_OFF = BIG_OFF + 800 * MiB;
constexpr size_t SC_OFF = BIG_OFF;
constexpr size_t TOPI_OFF = BIG_OFF + 640 * MiB, TOPG_OFF = BIG_OFF + 680 * MiB;
constexpr size_t PTU_OFF = BIG_OFF + 720 * MiB, PTV_OFF = BIG_OFF + 752 * MiB;
constexpr size_t PB_OFF = BIG_OFF + 784 * MiB;
constexpr size_t GATE_OFF = BIG_OFF;
constexpr size_t SSQ_OFF = BIG_OFF + 880 * MiB;
constexpr size_t WS_END = BIG_OFF + 886 * MiB;
}
using namespace cfg;

struct Args {
    const float* x_prompt; const float* x_sample; const float* p_prompt; const float* p_sample;
    const float* norm_mix_g; const float* w_in; const float* att_norm_g; const float* rwkv_shift;
    const float* rwkv_w0; const float* rwkv_w2; const float* rwkv_a0; const float* rwkv_a2; const float* rwkv_g2;
    const float* rwkv_k_k; const float* rwkv_k_a; const float* rwkv_r_k; const float* rwkv_ln_w; const float* rwkv_ln_b;
    const float* w_out; const float* norm_ffn_g; const float* peer_w_q; const float* peer_sub_keys; const float* peer_u; const float* peer_v;
    const float* ple_norm_g; const float* ple_w_gate; const float* ple_b_gate; const float* ple_w_proj; const float* final_norm_g;
    float* h;
    unsigned char* ws;
};

DEV int tid_() { int t = threadIdx.x; asm volatile("" : "+v"(t)); return t; }
DEV float bf2f(unsigned h) { return __uint_as_float(h << 16); }
DEV float bflo(unsigned d) { return __uint_as_float(d << 16); }
DEV float bfhi(unsigned d) { return __uint_as_float(d & 0xffff0000u); }
DEV unsigned pack2(float lo, float hi) { const f32x2 v = {lo, hi}; return __builtin_bit_cast(unsigned, __builtin_convertvector(v, bf16x2_t)); }
DEV unsigned f2bf(float f) { return pack2(f, 0.f) & 0xffffu; }
DEV float dot2bf(unsigned a, unsigned b, float c) { return __builtin_amdgcn_fdot2_f32_bf16(__builtin_bit_cast(bf16x2_t, a), __builtin_bit_cast(bf16x2_t, b), c, false); }
DEV float shx_(float v, int lane, int o) { return __int_as_float(__builtin_amdgcn_ds_bpermute((lane ^ o) << 2, __float_as_int(v))); }
DEV float shf_(float v, int src) { return __int_as_float(__builtin_amdgcn_ds_bpermute(src << 2, __float_as_int(v))); }
DEV int shf_(int v, int src) { return __builtin_amdgcn_ds_bpermute(src << 2, v); }
#define SHX(v, o) shx_((v), lane, (o))
#define SHF(v, src) shf_((v), (src))
DEV float wave_sum_(float v, int lane) {
#pragma unroll
    for (int o = 32; o > 0; o >>= 1) v += shx_(v, lane, o);
    return v;
}
DEV float wave_max_(float v, int lane) {
#pragma unroll
    for (int o = 32; o > 0; o >>= 1) v = fmaxf(v, shx_(v, lane, o));
    return v;
}
#define wave_sum(x) wave_sum_((x), lane)
#define wave_max(x) wave_max_((x), lane)
DEV float sum8(float v) {
    v += __int_as_float(__builtin_amdgcn_mov_dpp(__float_as_int(v), 0xB1, 0xF, 0xF, true));
    v += __int_as_float(__builtin_amdgcn_mov_dpp(__float_as_int(v), 0x4E, 0xF, 0xF, true));
    v += __int_as_float(__builtin_amdgcn_mov_dpp(__float_as_int(v), 0x141, 0xF, 0xF, true));
    return v;
}
DEV float rstd_parts(const float* ssq, int t) { const f32x4* p = (const f32x4*)(ssq + (size_t)t * 16); const f32x4 a = p[0], b = p[1], c = p[2], d = p[3];
    const float s = ((a[0] + a[1]) + (a[2] + a[3])) + ((b[0] + b[1]) + (b[2] + b[3])) + ((c[0] + c[1]) + (c[2] + c[3])) + ((d[0] + d[1]) + (d[2] + d[3]));
    return rsqrtf(s * (1.0f / 1024.0f) + 1e-6f); }
DEV float sigmoidf_(float x) { return 1.0f / (1.0f + __expf(-x)); }
namespace pg8 {
#define PG8_LAS __attribute__((address_space(3)))
typedef unsigned short bf16_t;
typedef short bf16x8 __attribute__((ext_vector_type(8)));
typedef float f32x4 __attribute__((ext_vector_type(4)));
typedef unsigned u32x4 __attribute__((ext_vector_type(4)));
constexpr int BM = 256, BK = 64, HALF = 128, HTB = HALF * BK * 2  , STAGE_BYTES = 8 * HTB, NXCD = 8, WGM = 8;

__host__ __device__ __forceinline__ int lds_byte(int r, int c) { const int st = (r >> 4) * 2 + (c >> 5), rr = r & 15, cc = c & 31, ob = rr * 64 + cc * 2; return st * 1024 + (ob ^ (((ob >> 9) & 1) << 5)); }
__host__ __device__ __forceinline__ void stage_rc(int b, int& R, int& C) { const int st = b / 1024, sb = b % 1024, swz = sb ^ (((sb >> 9) & 1) << 5); R = (st >> 1) * 16 + swz / 64; C = (st & 1) * 32 + (swz % 64) / 2; }
__host__ __device__ __forceinline__ int perm32(int rho) { const int n = rho >> 4, i = rho & 15; return 8 * (i >> 2) + 4 * n + (i & 3); }

struct Unit { int pm, pn; };
struct Gemm { const bf16_t* A; const bf16_t* Bt; int M, N, K; };

struct StaticOrder {
    int nM, nN, nwg, G, c;
    __host__ __device__ void init(int M, int N, int G_, int c_) { nM = M / BM; nN = N / BM; nwg = nM * nN; G = G_; c = c_; }
    __host__ __device__ bool next(int i, Unit& u) const {
        const long L = (long)i * G + c; if (L >= nwg) return false;
        int wgid = (int)L; { const int q = nwg / NXCD, r = nwg % NXCD, xcd = wgid % NXCD, off = wgid / NXCD; wgid = (xcd < r ? xcd * (q + 1) : r * (q + 1) + (xcd - r) * q) + off; }
        const int nig = WGM * nN, gid = wgid / nig, fm = gid * WGM, gsz = (nM - fm) < WGM ? (nM - fm) : WGM;
        u.pm = fm + ((wgid % nig) % gsz); u.pn = (wgid % nig) / gsz; return true;
    }
    __device__ __forceinline__ void a_ready(const Unit&) const {}
    __device__ __forceinline__ void done(const Unit&) const {}
};
__device__ __forceinline__ unsigned cvt_pk_bf16(float lo, float hi) { unsigned r; asm volatile("v_cvt_pk_bf16_f32 %0, %1, %2" : "=v"(r) : "v"(lo), "v"(hi)); return r; }

struct EpiProj {
    static constexpr bool PERM = true, AFTER_DRAIN = false;
    bf16_t* qkv; bf16_t* u; const float* ssq; const float* rc; const float* rs;
    __device__ __forceinline__ void operator()(const f32x4 (&acc)[2][2][4][2], const Unit& un, int wr, int wc, int fr, int fq) const {
        const int row0 = un.pm * BM + wr * 64 + fr, lane = fr + 16 * fq;
        const bool isq = un.pn < 6;
        bf16_t* base = isq ? qkv : u; const int ld = isq ? 1536 : 2048; const int colt = isq ? un.pn * BM : (un.pn - 6) * BM;
        const int col0 = colt + wc * 32 + 8 * fq;
        const bool rope = (un.pn < 4) && ((wc & 1) == 0);
        f32x4 pq[2][4];
#pragma unroll
        for (int ai = 0; ai < 2; ++ai)
#pragma unroll
            for (int m = 0; m < 4; ++m) pq[ai][m] = *(const f32x4*)(ssq + (size_t)(row0 + ai * HALF + m * 16) * 16 + 4 * fq);
        float rsd[2][4];
#pragma unroll
        for (int ai = 0; ai < 2; ++ai)
#pragma unroll
            for (int m = 0; m < 4; ++m) { float t = (pq[ai][m][0] + pq[ai][m][1]) + (pq[ai][m][2] + pq[ai][m][3]); t += SHX(t, 16); t += SHX(t, 32); rsd[ai][m] = rsqrtf(t * (1.0f / 1024.0f) + 1e-6f); }
#pragma unroll
        for (int ai = 0; ai < 2; ++ai)
#pragma unroll
            for (int m = 0; m < 4; ++m) {
                const int row = row0 + ai * HALF + m * 16; const float s = rsd[ai][m]; const int pos = row & 4095;
                f32x4 c0 = {1.f, 1.f, 1.f, 1.f}, c1 = c0, s0 = {0.f, 0.f, 0.f, 0.f}, s1 = s0;
                if (rope) { c0 = *(const f32x4*)(rc + pos * 8); c1 = *(const f32x4*)(rc + pos * 8 + 4); s0 = *(const f32x4*)(rs + pos * 8); s1 = *(const f32x4*)(rs + pos * 8 + 4); }
                bf16_t* rowp = base + (size_t)row * ld + col0;
#pragma unroll
                for (int bj = 0; bj < 2; ++bj) {
                    f32x4 v0 = acc[ai][bj][m][0] * s, v1 = acc[ai][bj][m][1] * s;
                    if (rope) {
                        f32x4 o0, o1;
#pragma unroll
                        for (int c = 0; c < 4; ++c) { o0[c] = SHX(v0[c], 16); o1[c] = SHX(v1[c], 16); }
                        if (fq == 0) { v0 = v0 * c0 - o0 * s0; v1 = v1 * c1 - o1 * s1; }
                        else if (fq == 1) { v0 = v0 * c0 + o0 * s0; v1 = v1 * c1 + o1 * s1; }
                    }
                    u32x4 w; w.x = cvt_pk_bf16(v0[0], v0[1]); w.y = cvt_pk_bf16(v0[2], v0[3]); w.z = cvt_pk_bf16(v1[0], v1[1]); w.w = cvt_pk_bf16(v1[2], v1[3]);
                    *(u32x4*)(rowp + bj * HALF) = w;
                }
            }
    }
};
template <int MODE> struct EpiF32x {
    static constexpr bool PERM = false, AFTER_DRAIN = false;
    float* C; int ldc; const bf16_t* gate; bf16_t* hb; float* ssq;
    __device__ __forceinline__ void operator()(const f32x4 (&acc)[2][2][4][2], const Unit& un, int wr, int wc, int fr, int fq) const {
        const int row0 = un.pm * BM + wr * 64 + fr, col0 = un.pn * BM + wc * 32 + 4 * fq, lane = fr + 16 * fq;
#pragma unroll
        for (int ai = 0; ai < 2; ++ai)
#pragma unroll
            for (int m = 0; m < 4; ++m) {
                const int row = row0 + ai * HALF + m * 16;
                const size_t ro = (size_t)row * ldc + col0;
                if (MODE != 0) asm volatile("" ::: "memory");
                float ss = 0.f;
#pragma unroll
                for (int bj = 0; bj < 2; ++bj)
#pragma unroll
                    for (int n = 0; n < 2; ++n) {
                        if (MODE == 2 && (bj | n)) asm volatile("" ::: "memory");
                        f32x4* p = (f32x4*)(C + ro + bj * HALF + n * 16);
                        if (MODE == 0) *p = acc[ai][bj][m][n];
                        else {
                            f32x4 v;
                            if (MODE == 1) v = *p + acc[ai][bj][m][n];
                            else { const u32x2 g = *(const u32x2*)(gate + ro + bj * HALF + n * 16);
                                   f32x4 gv; gv[0] = __uint_as_float(g.x << 16); gv[1] = __uint_as_float(g.x & 0xffff0000u); gv[2] = __uint_as_float(g.y << 16); gv[3] = __uint_as_float(g.y & 0xffff0000u);
                                   v = *p + gv * acc[ai][bj][m][n]; }
                            *p = v;
                            ss += (v[0] * v[0] + v[1] * v[1]) + (v[2] * v[2] + v[3] * v[3]);
                            u32x2 pk; pk.x = cvt_pk_bf16(v[0], v[1]); pk.y = cvt_pk_bf16(v[2], v[3]);
                            *(u32x2*)(hb + ro + bj * HALF + n * 16) = pk;
                        }
                    }
                if (MODE != 0) {
                    ss += SHX(ss, 16); ss += SHX(ss, 32);
                    if (fq == 0) ssq[(size_t)row * 16 + un.pn * 4 + wc] = ss;
                }
            }
    }
};
struct EpiGate {
    static constexpr bool PERM = true, AFTER_DRAIN = false;
    bf16_t* O; const float* rstd; const float* bias;
    __device__ __forceinline__ void operator()(const f32x4 (&acc)[2][2][4][2], const Unit& un, int wr, int wc, int fr, int fq) const {
        const int row0 = un.pm * BM + wr * 64 + fr, col0 = un.pn * BM + wc * 32 + 8 * fq;
        f32x4 bv[2][2];
#pragma unroll
        for (int bj = 0; bj < 2; ++bj)
#pragma unroll
            for (int n = 0; n < 2; ++n) bv[bj][n] = *(const f32x4*)(bias + col0 + bj * HALF + 4 * n);
#pragma unroll
        for (int ai = 0; ai < 2; ++ai)
#pragma unroll
            for (int m = 0; m < 4; ++m) {
                const int row = row0 + ai * HALF + m * 16; const float s = rstd[row];
                bf16_t* rowp = O + (size_t)row * 1024 + col0;
#pragma unroll
                for (int bj = 0; bj < 2; ++bj) {
                    f32x4 v0 = acc[ai][bj][m][0] * s + bv[bj][0], v1 = acc[ai][bj][m][1] * s + bv[bj][1];
#pragma unroll
                    for (int c = 0; c < 4; ++c) { v0[c] = 1.0f / (1.0f + __expf(-v0[c])); v1[c] = 1.0f / (1.0f + __expf(-v1[c])); }
                    u32x4 w; w.x = cvt_pk_bf16(v0[0], v0[1]); w.y = cvt_pk_bf16(v0[2], v0[3]); w.z = cvt_pk_bf16(v1[0], v1[1]); w.w = cvt_pk_bf16(v1[2], v1[3]);
                    *(u32x4*)(rowp + bj * HALF) = w;
                }
            }
    }
};
template <class Epi, class Sched, bool STAMP = false>
__device__ __forceinline__ void gemm_phase(PG8_LAS unsigned char* lds, const Gemm g, const Sched& S, const Epi& E, unsigned long long* stamps, const int tid_in) {
    const int tid = tid_in, wid = __builtin_amdgcn_readfirstlane(tid >> 6), lane = tid & 63, wr = wid >> 2, wc = wid & 3, fr = lane & 15, fq = lane >> 4;
    const int K = g.K, nt = K / BK;
    int ts_lo = 0, ts_hi = 0, nts = 0; const unsigned long long rt_entry = STAMP ? (unsigned long long)wall_clock64() : 0ull;
#define PG8_STAMP() do { if (STAMP && wid == 0 && nts < 64) { const unsigned long long _c = (unsigned long long)clock64(); \
        ts_lo = (lane == nts) ? (int)(unsigned)_c : ts_lo; ts_hi = (lane == nts) ? (int)(unsigned)(_c >> 32) : ts_hi; ++nts; } } while (0)
    PG8_STAMP();
    unsigned voffA[2], voffB[2];
#pragma unroll
    for (int i = 0; i < 2; ++i) { int R, C; stage_rc(tid * 16 + i * 8192, R, C); const int Rb = Epi::PERM ? ((R & ~31) + perm32(R & 31)) : R;
        voffA[i] = (unsigned)(R * K + C) * 2u; voffB[i] = (unsigned)(Rb * K + C) * 2u; }
    const size_t kstep = (size_t)(BK * 2);
    const size_t hstep = (size_t)HALF * K * 2;
    const size_t tstep = 2 * hstep;
    const unsigned ldsw = (unsigned)wid * 1024u;
    const int aoff = lds_byte(wr * 64 + fr, fq * 8), boff = lds_byte(wc * 32 + fr, fq * 8);
#define PG8_SA(b, h) (((b) * 2 + (h)) * HTB)
#define PG8_SB(b, h) ((4 + (b) * 2 + (h)) * HTB)
#define PG8_STAGE(bufoff, gbase, voff) do { _Pragma("unroll") for (int _i = 0; _i < 2; ++_i) \
        __builtin_amdgcn_global_load_lds((const unsigned*)((const char*)(gbase) + (voff)[_i]), (PG8_LAS unsigned*)(lds + (bufoff) + ldsw + _i * 8192), 16, 0, 0); } while (0)
#define PG8_LDA(dst, b, h) do { _Pragma("unroll") for (int m = 0; m < 4; ++m) _Pragma("unroll") for (int k = 0; k < 2; ++k) dst[m][k] = *(const PG8_LAS bf16x8*)(lds + PG8_SA(b, h) + aoff + m * 2048 + k * 1024); } while (0)
#define PG8_LDB(dst, b, h) do { _Pragma("unroll") for (int n = 0; n < 2; ++n) _Pragma("unroll") for (int k = 0; k < 2; ++k) dst[n][k] = *(const PG8_LAS bf16x8*)(lds + PG8_SB(b, h) + boff + n * 2048 + k * 1024); } while (0)
#define PG8_MMA(ai, bj, At, Bt) do { __builtin_amdgcn_s_setprio(1); _Pragma("unroll") for (int m = 0; m < 4; ++m) _Pragma("unroll") for (int n = 0; n < 2; ++n) _Pragma("unroll") for (int k = 0; k < 2; ++k) \
        acc[ai][bj][m][n] = __builtin_amdgcn_mfma_f32_16x16x32_bf16(Bt[n][k], At[m][k], acc[ai][bj][m][n], 0, 0, 0); __builtin_amdgcn_s_setprio(0); } while (0)
#define PG8_WAIT_V(n) asm volatile("s_waitcnt vmcnt(" #n ")" ::: "memory")
#define PG8_WAIT_L(n) asm volatile("s_waitcnt lgkmcnt(" #n ")" ::: "memory")
#define PG8_BAR __builtin_amdgcn_s_barrier()
#define PG8_SCHED __builtin_amdgcn_sched_barrier(0)
    Unit cur, nxt; int ui = 0;
    if (!S.next(0, cur)) return;
    f32x4 acc[2][2][4][2];
#pragma unroll
    for (int a = 0; a < 2; ++a)
#pragma unroll
        for (int b = 0; b < 2; ++b)
#pragma unroll
            for (int m = 0; m < 4; ++m)
#pragma unroll
                for (int n = 0; n < 2; ++n) acc[a][b][m][n] = (f32x4){0.f, 0.f, 0.f, 0.f};
    bf16x8 At[4][2], B0[2][2], B1[2][2];
    const char* cA = (const char*)g.A + (size_t)cur.pm * tstep; const char* cB = (const char*)g.Bt + (size_t)cur.pn * tstep;
    S.a_ready(cur);
    PG8_STAGE(PG8_SB(0, 0), cB, voffB); PG8_STAGE(PG8_SA(0, 0), cA, voffA); PG8_STAGE(PG8_SB(0, 1), cB + hstep, voffB); PG8_STAGE(PG8_SA(0, 1), cA + hstep, voffA);
    if (wr == 1) PG8_BAR;
    PG8_WAIT_V(4); PG8_BAR;
    PG8_STAGE(PG8_SB(1, 0), cB + kstep, voffB); PG8_STAGE(PG8_SA(1, 0), cA + kstep, voffA); PG8_STAGE(PG8_SB(1, 1), cB + hstep + kstep, voffB);
    PG8_WAIT_V(6); PG8_BAR;
    PG8_STAMP();
    for (;;) {
        const bool has_next = S.next(ui + 1, nxt);
        const char* nA = has_next ? (const char*)g.A + (size_t)nxt.pm * tstep : cA; const char* nB = has_next ? (const char*)g.Bt + (size_t)nxt.pn * tstep : cB;
        for (int t = 0; t < nt; t += 2) {
            const bool last = (t == nt - 2);
            const char* a1 = cA + (size_t)(t + 1) * kstep;
            const char* a2 = last ? nA : cA + (size_t)(t + 2) * kstep; const char* b2 = last ? nB : cB + (size_t)(t + 2) * kstep;
            const char* a3 = a2 + kstep; const char* b3 = b2 + kstep;
            if (last && has_next) S.a_ready(nxt);
            PG8_LDB(B0, 0, 0); PG8_SCHED; PG8_LDA(At, 0, 0); PG8_STAGE(PG8_SA(1, 1), a1 + hstep, voffA);
            PG8_WAIT_L(8); PG8_BAR; PG8_WAIT_L(0); PG8_MMA(0, 0, At, B0); PG8_BAR; PG8_SCHED;
            PG8_LDB(B1, 0, 1); PG8_STAGE(PG8_SB(0, 0), b2, voffB);
            PG8_BAR; PG8_WAIT_L(0); PG8_MMA(0, 1, At, B1); PG8_BAR;
            PG8_LDA(At, 0, 1); PG8_STAGE(PG8_SA(0, 0), a2, voffA);
            PG8_BAR; PG8_WAIT_L(0); PG8_MMA(1, 0, At, B0); PG8_BAR; PG8_SCHED;
            PG8_STAGE(PG8_SB(0, 1), b2 + hstep, voffB);
            PG8_WAIT_V(6); PG8_BAR; PG8_MMA(1, 1, At, B1); PG8_BAR;
            PG8_LDB(B0, 1, 0); PG8_SCHED; PG8_LDA(At, 1, 0); PG8_STAGE(PG8_SA(0, 1), a2 + hstep, voffA);
            PG8_WAIT_L(8); PG8_BAR; PG8_WAIT_L(0); PG8_MMA(0, 0, At, B0); PG8_BAR; PG8_SCHED;
            PG8_LDB(B1, 1, 1); PG8_STAGE(PG8_SB(1, 0), b3, voffB);
            PG8_BAR; PG8_WAIT_L(0); PG8_MMA(0, 1, At, B1); PG8_BAR;
            PG8_LDA(At, 1, 1); PG8_STAGE(PG8_SA(1, 0), a3, voffA);
            PG8_BAR; PG8_WAIT_L(0); PG8_MMA(1, 0, At, B0); PG8_BAR; PG8_SCHED;
            PG8_STAGE(PG8_SB(1, 1), b3 + hstep, voffB);
            PG8_WAIT_V(6); PG8_BAR; PG8_MMA(1, 1, At, B1); PG8_BAR;
        }
        PG8_STAMP();
        if constexpr (!Epi::AFTER_DRAIN) { E(acc, cur, wr, wc, fr, fq); S.done(cur); }
        PG8_STAMP();
        if (!has_next) break;
#pragma unroll
        for (int a = 0; a < 2; ++a)
#pragma unroll
            for (int b = 0; b < 2; ++b)
#pragma unroll
                for (int m = 0; m < 4; ++m)
#pragma unroll
                    for (int n = 0; n < 2; ++n) acc[a][b][m][n] = (f32x4){0.f, 0.f, 0.f, 0.f};
        cur = nxt; cA = nA; cB = nB; ++ui;
    }
    PG8_WAIT_V(0);
    if (wr == 0) PG8_BAR;
    PG8_BAR;
    if constexpr (Epi::AFTER_DRAIN) { E.fused(acc, cur, wr, wc, fr, fq, lds, wid, lane); S.done(cur); }
    PG8_STAMP();
    if (STAMP && wid == 0) { stamps[lane] = lane < nts ? (((unsigned long long)(unsigned)ts_hi << 32) | (unsigned)ts_lo) : 0ull;
        if (lane == 62) stamps[62] = rt_entry; if (lane == 63) stamps[63] = (unsigned long long)wall_clock64(); }
#undef PG8_STAMP
#undef PG8_SA
#undef PG8_SB
#undef PG8_STAGE
#undef PG8_LDA
#undef PG8_LDB
#undef PG8_MMA
#undef PG8_WAIT_V
#undef PG8_WAIT_L
#undef PG8_BAR
#undef PG8_SCHED
}
}
#define XB_TMO      128
#define XB_XCNT(j)  (256  + 64 * (j))
#define XB_XSUB(j)  (1280 + 64 * (j))
#define XB_XGEN(j)  (2304 + 64 * (j))
#define XB_TOP      3328
#define XB_TOPGEN   3392
#define XCD_BAR_WORDS 3456
#define XB_SPIN_CAP (1u << 23)
#define LAS __attribute__((address_space(3)))

__device__ __forceinline__ unsigned xb_ld(unsigned* p)              { return __hip_atomic_load(p, __ATOMIC_RELAXED, __HIP_MEMORY_SCOPE_AGENT); }
__device__ __forceinline__ unsigned xb_add(unsigned* p, unsigned v) { return __hip_atomic_fetch_add(p, v, __ATOMIC_RELAXED, __HIP_MEMORY_SCOPE_AGENT); }
__device__ __forceinline__ unsigned xb_xcc_id() { return (unsigned)__builtin_amdgcn_s_getreg((3 << 11) | 20) & 0xFu; }
#define XB_SPIN(cond, bar) do { unsigned _sp = 0; while (cond) { __builtin_amdgcn_s_sleep(1); \
    if ((++_sp & 255u) == 0u) { if (xb_ld(&(bar)[XB_TMO])) break; if (_sp > XB_SPIN_CAP) { atomicAdd(&(bar)[XB_TMO], 1u); break; } } } } while (0)

struct XcdBarrier {
    unsigned* bar; unsigned x;
    volatile LAS unsigned* st;
};

__device__ __forceinline__ XcdBarrier xcd_barrier_post(unsigned* bar, volatile LAS unsigned* st) {
    XcdBarrier b; b.bar = bar; b.x = xb_xcc_id(); b.st = st;
    if (threadIdx.x == 0) (void)xb_add(&bar[XB_XCNT(b.x)], 1u);
    return b;
}
__device__ __forceinline__ void xcd_barrier_complete(unsigned* bar, unsigned x, unsigned& nloc, unsigned& nx) {
    const unsigned G = gridDim.x * gridDim.y * gridDim.z;
    unsigned sum, cnt, mine, sp = 0u;
    for (;;) {
        sum = 0u; cnt = 0u; mine = 0u;
#pragma unroll
        for (unsigned j = 0; j < 16; ++j) { const unsigned c = xb_ld(&bar[XB_XCNT(j)]); sum += c; cnt += (c > 0u) ? 1u : 0u; mine = (j == x) ? c : mine; }
        if (sum == G) break;
        __builtin_amdgcn_s_sleep(1);
        if ((++sp & 255u) == 0u) { if (xb_ld(&bar[XB_TMO])) break; if (sp > XB_SPIN_CAP) { atomicAdd(&bar[XB_TMO], 1u); break; } }
    }
    nloc = mine > 0u ? mine : 1u; nx = cnt > 0u ? cnt : 1u;
}

__device__ __forceinline__ void xcd_barrier(const XcdBarrier& b, const int tid) {
    asm volatile("s_waitcnt vmcnt(0)" ::: "memory");
    __syncthreads();
    if (tid == 0) {
        unsigned* bar = b.bar; unsigned bx = b.x;
        asm volatile("" : "+s"(bar), "+s"(bx));
        __builtin_amdgcn_s_waitcnt(0);
        unsigned nloc = b.st[0], nx = b.st[1];
        if (nloc == 0u) { xcd_barrier_complete(bar, bx, nloc, nx); b.st[0] = nloc; b.st[1] = nx; }
        const unsigned old = xb_add(&bar[XB_XSUB(bx)], 1u);
        const unsigned gen = old / nloc;
        if (old + 1u == (gen + 1u) * nloc) {
            __builtin_amdgcn_fence(__ATOMIC_RELEASE, "agent");
            asm volatile("s_waitcnt vmcnt(0)" ::: "memory");
            const unsigned og = xb_add(&bar[XB_TOP], 1u);
            const unsigned tg = og / nx;
            if (og + 1u == (tg + 1u) * nx) xb_add(&bar[XB_TOPGEN], 1u);
            else XB_SPIN(xb_ld(&bar[XB_TOPGEN]) == tg, bar);
            __builtin_amdgcn_fence(__ATOMIC_ACQUIRE, "agent");
            xb_add(&bar[XB_XGEN(bx)], 1u);
            asm volatile("s_waitcnt vmcnt(0)" ::: "memory");
        } else {
            XB_SPIN(xb_ld(&bar[XB_XGEN(bx)]) == gen, bar);
            __builtin_amdgcn_fence(__ATOMIC_ACQUIRE, "agent");
            asm volatile("s_waitcnt vmcnt(0)" ::: "memory");
        }
    }
    __syncthreads();
}


typedef __attribute__((address_space(3))) unsigned char lds_u8;
extern __shared__ __attribute__((aligned(16))) unsigned char smem[];
DEV unsigned char* smem_base() { return smem; }

DEV bf16_t* wsb(const Args& a, size_t off) { return (bf16_t*)(a.ws + off); }
DEV float* wsf(const Args& a, size_t off) { return (float*)(a.ws + off); }

DEV void ph_rowprep(const Args& a, bool from_x, const int tid0) {
    const int lane = tid0 & 63, wv = tid0 >> 6;
    const int gw = blockIdx.x * 8 + wv, nw = gridDim.x * 8;
    bf16_t* hb = wsb(a, HB_OFF); float* ssq = wsf(a, SSQ_OFF);
    for (int t = gw; t < T; t += nw) {
        const float* src = from_x ? (t < TP ? a.x_prompt + (size_t)t * D : a.x_sample + (size_t)(t - TP) * D) : a.h + (size_t)t * D;
        f32x4 v[4]; float ss = 0.f;
#pragma unroll
        for (int i = 0; i < 4; ++i) { v[i] = *(const f32x4*)(src + (i * 64 + lane) * 4); ss += v[i][0] * v[i][0] + v[i][1] * v[i][1] + v[i][2] * v[i][2] + v[i][3] * v[i][3]; }
        ss = wave_sum(ss);
#pragma unroll
        for (int i = 0; i < 4; ++i) {
            if (from_x) *(f32x4*)(a.h + (size_t)t * D + (i * 64 + lane) * 4) = v[i];
            u32x2 p; p.x = pack2(v[i][0], v[i][1]); p.y = pack2(v[i][2], v[i][3]);
            *(u32x2*)(hb + (size_t)t * D + (i * 64 + lane) * 4) = p;
        }
        if (lane < 16) ssq[(size_t)t * 16 + lane] = (lane == 0) ? ss : 0.f;
    }
}

DEV void ph_final(const Args& a, const int tid0) {
    const int lane = tid0 & 63, wv = tid0 >> 6;
    const int gw = blockIdx.x * 8 + wv, nw = gridDim.x * 8;
    for (int t = gw; t < T; t += nw) {
        float* row = a.h + (size_t)t * D;
        f32x4 v[4]; float ss = 0.f;
#pragma unroll
        for (int i = 0; i < 4; ++i) { v[i] = *(const f32x4*)(row + (i * 64 + lane) * 4); ss += v[i][0] * v[i][0] + v[i][1] * v[i][1] + v[i][2] * v[i][2] + v[i][3] * v[i][3]; }
        ss = wave_sum(ss);
        const float r = rsqrtf(ss * (1.0f / 1024.0f) + 1e-6f);
#pragma unroll
        for (int i = 0; i < 4; ++i) { const f32x4 g = *(const f32x4*)(a.final_norm_g + (i * 64 + lane) * 4); *(f32x4*)(row + (i * 64 + lane) * 4) = v[i] * r * g; }
    }
}

DEV void transpose_cvt(const float* __restrict__ src, bf16_t* __restrict__ dst, int K, int N, int Npad, const float* __restrict__ g, float* tile, const int tid0) {
    const int tx = tid0 & 63, ty = tid0 >> 6;
    const int tk = K / 64, tn = Npad / 64;
    for (int tl = blockIdx.x; tl < tk * tn; tl += gridDim.x) {
        const int k0 = (tl % tk) * 64, n0 = (tl / tk) * 64;
        __syncthreads();
        for (int i = ty; i < 64; i += 8) { const int k = k0 + i, n = n0 + tx; float v = (n < N) ? src[(size_t)k * N + n] : 0.f; if (g) v *= g[k]; tile[i * 65 + tx] = v; }
        __syncthreads();
        for (int i = ty; i < 64; i += 8) dst[(size_t)(n0 + i) * K + k0 + tx] = (bf16_t)f2bf(tile[tx * 65 + i]);
    }
}
DEV void fold_wqk(const Args& a, float* lds, const int tid0) {
    float* swq = lds;
    float* ssk = lds + 64 * 132;
    const int tid = tid0, key = tid & 127, kq = tid >> 7;
    for (int un = blockIdx.x; un < NL * 16 * 16; un += gridDim.x) {
        const int l = un >> 8, hp = (un >> 4) & 15, k0 = (un & 15) * 64;
        __syncthreads();
        for (int i = tid; i < 64 * 128; i += NTHR) { const int r = i >> 7, c = i & 127; swq[r * 132 + c] = a.peer_w_q[((size_t)l * 1024 + k0 + r) * 2048 + hp * 128 + c]; }
        for (int i = tid; i < 128 * 128; i += NTHR) { const int r = i >> 7, c = i & 127; ssk[r * 132 + c] = a.peer_sub_keys[(((size_t)l * 16 + hp) * 128 + r) * 128 + c]; }
        __syncthreads();
        float acc[16];
#pragma unroll
        for (int i = 0; i < 16; ++i) acc[i] = 0.f;
        for (int c = 0; c < 128; c += 4) {
            const f32x4 s = *(const f32x4*)(ssk + key * 132 + c);
#pragma unroll
            for (int i = 0; i < 16; ++i) { const f32x4 w = *(const f32x4*)(swq + (kq * 16 + i) * 132 + c); acc[i] += s[0] * w[0] + s[1] * w[1] + s[2] * w[2] + s[3] * w[3]; }
        }
        bf16_t* dst = wsb(a, WB_OFF + (size_t)l * WB_LAYER + WB_QK) + (size_t)(hp * 128 + key) * 1024 + k0 + kq * 16;
        const float* g = a.norm_ffn_g + l * 1024 + k0 + kq * 16;
#pragma unroll
        for (int i = 0; i < 16; i += 2) *(unsigned*)(dst + i) = pack2(acc[i] * g[i], acc[i + 1] * g[i + 1]);
    }
}
DEV void ph_prologue(const Args& a, float* lds, const int tid0) {
    { float* rc = wsf(a, ROPEC_OFF); float* rs = wsf(a, ROPES_OFF);
      for (int i = blockIdx.x * NTHR + tid0; i < 4096 * 8; i += gridDim.x * NTHR) {
          const int pos = i >> 3, f = i & 7;
          const float invf = (float)pow(500000.0, -(double)f / 8.0);
          const float ang = (float)pos * invf;
          rc[i] = (float)cos((double)ang); rs[i] = (float)sin((double)ang);
      } }
    for (int l = 0; l < NL; ++l) {
        bf16_t* wb = wsb(a, WB_OFF + (size_t)l * WB_LAYER);
        transpose_cvt(a.w_in + (size_t)l * 1024 * INC, wb + WB_IN / 2, 1024, INC, INP, a.norm_mix_g + l * 1024, lds, tid0);
        transpose_cvt(a.w_out + (size_t)l * 1024 * 1024, wb + WB_OUT / 2, 1024, 1024, 1024, nullptr, lds, tid0);
        transpose_cvt(a.ple_w_gate + (size_t)l * 1024 * 1024, wb + WB_GATE / 2, 1024, 1024, 1024, a.ple_norm_g + l * 1024, lds, tid0);
        transpose_cvt(a.ple_w_proj + (size_t)l * 256 * 1024, wb + WB_PROJ / 2, 256, 1024, 1024, nullptr, lds, tid0);
        for (int dr = 0; dr < 2; ++dr) {
            transpose_cvt(a.rwkv_w2 + (size_t)(l * 2 + dr) * 64 * 512, wb + WB_LORA / 2 + dr * 512 * 64, 64, 512, 512, nullptr, lds, tid0);
            transpose_cvt(a.rwkv_a2 + (size_t)(l * 2 + dr) * 64 * 512, wb + WB_LORA / 2 + (2 + dr) * 512 * 64, 64, 512, 512, nullptr, lds, tid0);
        }
        transpose_cvt(a.rwkv_g2 + (size_t)l * 128 * 512, wb + WB_LORA / 2 + 4 * 512 * 64, 128, 512, 512, nullptr, lds, tid0);
    }
    fold_wqk(a, lds, tid0);
}

DEV float sum16(float v) {
    v = sum8(v);
    v += __int_as_float(__builtin_amdgcn_mov_dpp(__float_as_int(v), 0x140, 0xF, 0xF, true));
    return v;
}
DEV float max16(float v) {
    v = fmaxf(v, __int_as_float(__builtin_amdgcn_mov_dpp(__float_as_int(v), 0xB1, 0xF, 0xF, true)));
    v = fmaxf(v, __int_as_float(__builtin_amdgcn_mov_dpp(__float_as_int(v), 0x4E, 0xF, 0xF, true)));
    v = fmaxf(v, __int_as_float(__builtin_amdgcn_mov_dpp(__float_as_int(v), 0x141, 0xF, 0xF, true)));
    v = fmaxf(v, __int_as_float(__builtin_amdgcn_mov_dpp(__float_as_int(v), 0x140, 0xF, 0xF, true)));
    return v;
}
DEV float rl(float v, int l) { return __int_as_float(__builtin_amdgcn_readlane(__float_as_int(v), l)); }
DEV float wave_sum_dpp(float v) { v = sum16(v); return (rl(v, 0) + rl(v, 16)) + (rl(v, 32) + rl(v, 48)); }
DEV unsigned fkey(float f) { const unsigned b = __float_as_uint(f); return b ^ ((unsigned)((int)b >> 31) | 0x80000000u); }
DEV int mbcnt64(unsigned long long m) { return (int)__builtin_amdgcn_mbcnt_hi((unsigned)(m >> 32), __builtin_amdgcn_mbcnt_lo((unsigned)m, 0u)); }

#ifndef TOPK_NU
#define TOPK_NU 4
#endif
DEV void ph_topk2(const Args& a, float* lds, const int tid0, const int gw, const int nw, const int NP) {
    const int lane = tid0 & 63, wv = __builtin_amdgcn_readfirstlane(tid0 >> 6);
    constexpr int NU = TOPK_NU, NQ = 2 * NU, GPT = 8 / NU;
    float* tvb = lds + wv * (NQ * 16); int* tib = (int*)(lds + 8 * NQ * 16) + wv * (NQ * 16);
    const float* SC = wsf(a, SC_OFF); int* TOPI = (int*)(a.ws + TOPI_OFF); float* TOPG = wsf(a, TOPG_OFF); const float* ssq = wsf(a, SSQ_OFF);
    float vn[NU][4];
    if (gw < NP) {
#pragma unroll
        for (int u = 0; u < NU; ++u)
#pragma unroll
            for (int i = 0; i < 4; ++i) vn[u][i] = SC[(size_t)gw * (NU * 256) + u * 256 + i * 64 + lane];
    }
    for (int up = gw; up < NP; up += nw) {
        const int t = up / GPT, hd0 = (up % GPT) * NU;
        float v[NU][4]; unsigned k[NU][4];
#pragma unroll
        for (int u = 0; u < NU; ++u)
#pragma unroll
            for (int i = 0; i < 4; ++i) { v[u][i] = vn[u][i]; k[u][i] = fkey(v[u][i]); }
        if (up + nw < NP) {
#pragma unroll
            for (int u = 0; u < NU; ++u)
#pragma unroll
                for (int i = 0; i < 4; ++i) vn[u][i] = SC[(size_t)(up + nw) * (NU * 256) + u * 256 + i * 64 + lane];
        }
        unsigned th[NQ]; unsigned dm = 0u;
#pragma unroll
        for (int q = 0; q < NQ; ++q) th[q] = 0u;
        for (int b = 31; b >= 0; --b) {
            const unsigned bit = 1u << b;
            unsigned long long ma[NQ], mb[NQ];
#pragma unroll
            for (int q = 0; q < NQ; ++q) { const unsigned c = th[q] | bit; ma[q] = __ballot(k[q >> 1][2 * (q & 1)] >= c); mb[q] = __ballot(k[q >> 1][2 * (q & 1) + 1] >= c); }
#pragma unroll
            for (int q = 0; q < NQ; ++q) {
                const int n = __builtin_popcountll(ma[q]) + __builtin_popcountll(mb[q]);
                th[q] = (n >= 16) ? (th[q] | bit) : th[q]; dm |= (n == 16) ? (1u << q) : 0u;
            }
            if (dm == (1u << NQ) - 1u) break;
        }
#pragma unroll
        for (int q = 0; q < NQ; ++q) {
            const int u = q >> 1, p = q & 1; const unsigned tp = th[q];
            const unsigned ka = k[u][2 * p], kb = k[u][2 * p + 1];
            const unsigned long long ga = __ballot(ka > tp), gb = __ballot(kb > tp), ea = __ballot(ka == tp), eb = __ballot(kb == tp);
            const int nga = __builtin_popcountll(ga), ng = nga + __builtin_popcountll(gb), need = 16 - ng, nea = __builtin_popcountll(ea);
            int pa = -1, pb = -1;
            if (ka > tp) pa = mbcnt64(ga); else if (ka == tp) { const int r = mbcnt64(ea); if (r < need) pa = ng + r; }
            if (kb > tp) pb = nga + mbcnt64(gb); else if (kb == tp) { const int r = nea + mbcnt64(eb); if (r < need) pb = ng + r; }
            if (pa >= 0) { tvb[q * 16 + pa] = v[u][2 * p]; tib[q * 16 + pa] = lane; }
            if (pb >= 0) { tvb[q * 16 + pb] = v[u][2 * p + 1]; tib[q * 16 + pb] = 64 + lane; }
        }
        float cv[NU][4]; unsigned kc[NU][4]; float mx[NU];
#pragma unroll
        for (int u = 0; u < NU; ++u) {
#pragma unroll
            for (int s = 0; s < 4; ++s) { const int c = lane + 64 * s; cv[u][s] = tvb[u * 32 + (c >> 4)] + tvb[u * 32 + 16 + (c & 15)]; kc[u][s] = fkey(cv[u][s]); }
            const float m0 = max16(lane < 16 ? tvb[u * 32 + (lane & 15)] : -3.0e38f), m1 = max16(lane < 16 ? tvb[u * 32 + 16 + (lane & 15)] : -3.0e38f);
            mx[u] = rl(m0, 0) + rl(m1, 0);
        }
        unsigned t2[NU]; unsigned dm2 = 0u;
#pragma unroll
        for (int u = 0; u < NU; ++u) t2[u] = 0u;
        for (int b = 31; b >= 0; --b) {
            const unsigned bit = 1u << b;
            unsigned long long mc[NU][4];
#pragma unroll
            for (int u = 0; u < NU; ++u)
#pragma unroll
                for (int s4 = 0; s4 < 4; ++s4) mc[u][s4] = __ballot(kc[u][s4] >= (t2[u] | bit));
#pragma unroll
            for (int u = 0; u < NU; ++u) {
                const int n = (__builtin_popcountll(mc[u][0]) + __builtin_popcountll(mc[u][1])) + (__builtin_popcountll(mc[u][2]) + __builtin_popcountll(mc[u][3]));
                t2[u] = (n >= 16) ? (t2[u] | bit) : t2[u]; dm2 |= (n == 16) ? (1u << u) : 0u;
            }
            if (dm2 == (1u << NU) - 1u) break;
        }
        const float rs = rstd_parts(ssq, t);
#pragma unroll
        for (int u = 0; u < NU; ++u) {
            int pos[4]; int ng = 0;
#pragma unroll
            for (int s = 0; s < 4; ++s) { const unsigned long long g = __ballot(kc[u][s] > t2[u]); pos[s] = (kc[u][s] > t2[u]) ? ng + mbcnt64(g) : -1; ng += __builtin_popcountll(g); }
            int ne = 0; const int need = 16 - ng;
#pragma unroll
            for (int s = 0; s < 4; ++s) { const unsigned long long e = __ballot(kc[u][s] == t2[u]); if (kc[u][s] == t2[u]) { const int r = ne + mbcnt64(e); if (r < need) pos[s] = ng + r; } ne += __builtin_popcountll(e); }
            float ex[4]; float es = 0.f;
#pragma unroll
            for (int s = 0; s < 4; ++s) { ex[s] = (pos[s] >= 0) ? __expf(rs * (cv[u][s] - mx[u])) : 0.f; es += ex[s]; }
            const float inv = 1.0f / wave_sum_dpp(es);
#pragma unroll
            for (int s = 0; s < 4; ++s) if (pos[s] >= 0) {
                const int c = lane + 64 * s;
                TOPI[(size_t)t * 128 + (hd0 + u) * 16 + pos[s]] = tib[u * 32 + (c >> 4)] * 128 + tib[u * 32 + 16 + (c & 15)];
                TOPG[(size_t)t * 128 + (hd0 + u) * 16 + pos[s]] = ex[s] * inv;
            }
        }
    }
}

DEV unsigned pack4_fp8(float a, float b, float c, float d) {
    int w = __builtin_amdgcn_cvt_pk_fp8_f32(a, b, 0, false);
    w = __builtin_amdgcn_cvt_pk_fp8_f32(c, d, w, true);
    return (unsigned)w;
}
DEV void ph_convert8(const Args& a, int layer, const int tid0) {
    const size_t gtid = (size_t)blockIdx.x * NTHR + tid0, gn = (size_t)gridDim.x * NTHR;
    const float* us = a.peer_u + (size_t)layer * 16384 * 1024; const float* vs = a.peer_v + (size_t)layer * 16384 * 1024;
    unsigned* ud = (unsigned*)(a.ws + PTU_OFF); unsigned* vd = (unsigned*)(a.ws + PTV_OFF);
    const float* g = a.norm_ffn_g + layer * 1024;
    for (size_t i = gtid; i < (size_t)16384 * 1024 / 16; i += gn) {
        u32x4 pu, pv;
#pragma unroll
        for (int j = 0; j < 4; ++j) {
            const f32x4 x = *(const f32x4*)(us + i * 16 + j * 4), y = *(const f32x4*)(vs + i * 16 + j * 4), gg = *(const f32x4*)(g + ((i * 16 + j * 4) & 1023));
            pu[j] = pack4_fp8(x[0] * gg[0] * 256.f, x[1] * gg[1] * 256.f, x[2] * gg[2] * 256.f, x[3] * gg[3] * 256.f);
            pv[j] = pack4_fp8(y[0] * 32.f, y[1] * 32.f, y[2] * 32.f, y[3] * 32.f);
        }
        *(u32x4*)(ud + i * 4) = pu; *(u32x4*)(vd + i * 4) = pv;
    }
    bf16_t* pb = wsb(a, PB_OFF);
    const float* pp = a.p_prompt + (size_t)layer * TP * 256; const float* ps = a.p_sample + (size_t)layer * (T - TP) * 256;
    for (size_t i = gtid; i < (size_t)T * 256 / 4; i += gn) {
        const size_t e = i * 4; const f32x4 x = (e < (size_t)TP * 256) ? *(const f32x4*)(pp + e) : *(const f32x4*)(ps + (e - (size_t)TP * 256));
        u32x2 p; p.x = pack2(x[0], x[1]); p.y = pack2(x[2], x[3]); *(u32x2*)(pb + e) = p;
    }
}

template <bool DRY> DEV void ph_peer8(const Args& a, const int tid0) {
    const int lane = tid0 & 63, wv = tid0 >> 6;
    const int gw = blockIdx.x * 8 + wv, nw = gridDim.x * 8;
    bf16_t* hb = wsb(a, HB_OFF); float* rstd = wsf(a, RSTD_OFF);
    const int* TOPI = (const int*)(a.ws + TOPI_OFF); const float* TOPG = wsf(a, TOPG_OFF);
    const unsigned char* PU = a.ws + PTU_OFF; const unsigned char* PV = a.ws + PTV_OFF;
    const int c16 = 16 * lane;
    const bool b5 = lane & 32, b4 = lane & 16, b3 = lane & 8;
    for (int t = gw; t < T; t += nw) {
        float x[16];
        { const u32x4 x0 = *(const u32x4*)(hb + (size_t)t * 1024 + c16), x1 = *(const u32x4*)(hb + (size_t)t * 1024 + c16 + 8);
#pragma unroll
          for (int i = 0; i < 4; ++i) { x[2 * i] = bflo(x0[i]); x[2 * i + 1] = bfhi(x0[i]); x[8 + 2 * i] = bflo(x1[i]); x[8 + 2 * i + 1] = bfhi(x1[i]); } }
        const float rs = rstd[t] * (1.0f / 256.0f);
        const int e0 = TOPI[(size_t)t * 128 + lane], e1 = TOPI[(size_t)t * 128 + 64 + lane];
        const float g0 = TOPG[(size_t)t * 128 + lane], g1 = TOPG[(size_t)t * 128 + 64 + lane];
        float out[16];
#pragma unroll
        for (int i = 0; i < 16; ++i) out[i] = 0.f;
#pragma unroll 1
        for (int kb = 0; kb < 128; kb += 8) {
            const int es = (kb < 64) ? e0 : e1; const float gs = (kb < 64) ? g0 : g1;
            u32x4 ur[8], vr[8];
#pragma unroll
            for (int i = 0; i < 8; ++i) { const int e = __builtin_amdgcn_readlane(es, (kb + i) & 63); ur[i] = *(const u32x4*)(PU + (size_t)e * 1024 + c16); vr[i] = *(const u32x4*)(PV + (size_t)e * 1024 + c16); }
            float d[8];
#pragma unroll
            for (int i = 0; i < 8; ++i) {
                float s = 0.f;
#pragma unroll
                for (int j = 0; j < 4; ++j) {
                    const f32x2 lo = __builtin_amdgcn_cvt_pk_f32_fp8((int)ur[i][j], false), hi = __builtin_amdgcn_cvt_pk_f32_fp8((int)ur[i][j], true);
                    s += lo[0] * x[4 * j] + lo[1] * x[4 * j + 1] + hi[0] * x[4 * j + 2] + hi[1] * x[4 * j + 3];
                }
                d[i] = s;
            }
            float r4[4], r2[2];
#pragma unroll
            for (int i = 0; i < 4; ++i) { const float send = b5 ? d[i] : d[4 + i], keep = b5 ? d[4 + i] : d[i]; r4[i] = keep + SHX(send, 32); }
#pragma unroll
            for (int i = 0; i < 2; ++i) { const float send = b4 ? r4[i] : r4[2 + i], keep = b4 ? r4[2 + i] : r4[i]; r2[i] = keep + SHX(send, 16); }
            const float send1 = b3 ? r2[0] : r2[1], keep1 = b3 ? r2[1] : r2[0];
            const float dd = sum8(keep1 + SHX(send1, 8));
            const float hp = rs * dd;
            const float gt = SHF(gs, (kb + (lane >> 3)) & 63);
            const float w = gt * 0.5f * hp * (1.0f + erff(hp * 0.70710678f)) * (1.0f / 32.0f);
#pragma unroll
            for (int i = 0; i < 8; ++i) {
                const float wi = rl(w, 8 * i);
#pragma unroll
                for (int j = 0; j < 4; ++j) {
                    const f32x2 lo = __builtin_amdgcn_cvt_pk_f32_fp8((int)vr[i][j], false), hi = __builtin_amdgcn_cvt_pk_f32_fp8((int)vr[i][j], true);
                    out[4 * j] += wi * lo[0]; out[4 * j + 1] += wi * lo[1]; out[4 * j + 2] += wi * hi[0]; out[4 * j + 3] += wi * hi[1];
                }
            }
        }
        float* hr = a.h + (size_t)t * 1024 + c16;
        f32x4 hv[4]; float ss = 0.f;
#pragma unroll
        for (int j = 0; j < 4; ++j) { hv[j] = *(const f32x4*)(hr + 4 * j);
#pragma unroll
            for (int c = 0; c < 4; ++c) { hv[j][c] += out[4 * j + c]; ss += hv[j][c] * hv[j][c]; }
            if (!DRY) *(f32x4*)(hr + 4 * j) = hv[j]; }
        ss = wave_sum(ss);
        if (DRY && ss != -1.0f) continue;
        u32x4 p0, p1;
        p0.x = pack2(hv[0][0], hv[0][1]); p0.y = pack2(hv[0][2], hv[0][3]); p0.z = pack2(hv[1][0], hv[1][1]); p0.w = pack2(hv[1][2], hv[1][3]);
        p1.x = pack2(hv[2][0], hv[2][1]); p1.y = pack2(hv[2][2], hv[2][3]); p1.z = pack2(hv[3][0], hv[3][1]); p1.w = pack2(hv[3][2], hv[3][3]);
        *(u32x4*)(hb + (size_t)t * 1024 + c16) = p0; *(u32x4*)(hb + (size_t)t * 1024 + c16 + 8) = p1;
        if (lane == 0) rstd[t] = rsqrtf(ss * (1.0f / 1024.0f) + 1e-6f);
    }
}

typedef short bf16x8 __attribute__((ext_vector_type(8)));
typedef float f32x16 __attribute__((ext_vector_type(16)));
#define MFMA32(a, b, c) __builtin_amdgcn_mfma_f32_32x32x16_bf16((a), (b), (c), 0, 0, 0)
DEV bf16x8 pack_frag(float x0, float x1, float x2, float x3, float x4, float x5, float x6, float x7) {
    u32x4 p;
    asm volatile("v_cvt_pk_bf16_f32 %0, %4, %5\n\tv_cvt_pk_bf16_f32 %1, %6, %7\n\tv_cvt_pk_bf16_f32 %2, %8, %9\n\tv_cvt_pk_bf16_f32 %3, %10, %11\n\ts_nop 1"
                 : "=&v"(p[0]), "=&v"(p[1]), "=&v"(p[2]), "=&v"(p[3]) : "v"(x0), "v"(x1), "v"(x2), "v"(x3), "v"(x4), "v"(x5), "v"(x6), "v"(x7));
    return __builtin_bit_cast(bf16x8, p);
}
template <int VAR> DEV void ph_attn2(const Args& a, unsigned char* ldsb, const int tid0) {
    const int lane = tid0 & 63, wv = __builtin_amdgcn_readfirstlane(tid0 >> 6), r = lane & 31, h = lane >> 5;
    unsigned char* vt = ldsb + wv * 4608;
    const bf16_t* qkv = wsb(a, QKV_OFF);
    bf16_t* OP = wsb(a, OP_OFF); float* ML = wsf(a, ML_OFF);
    const int i16 = lane & 15, tq = i16 >> 2, tp = i16 & 3, tblk = (lane >> 4) & 1;
    const unsigned tr_addr = (unsigned)(size_t)vt + (4 * h + tq) * 144 + 2 * (16 * tblk + 4 * tp);
    const float sc = 0.125f * 1.44269504f, NEG = -1.0e30f;
    const int nitem = NSEQ * 8 * 3 * 128, per = nitem / (int)gridDim.x;
    for (int it = 0; it < per / 8; ++it) {
        const int w = blockIdx.x * per + it * 8 + wv;
        const int sh = w / 384, rem = w - sh * 384, di = rem >> 7, idx = rem & 127;
        const int sft = (VAR == 1) ? 0 : 2 * di, nbc = 128 >> sft, rr = idx >> (7 - sft), cb = idx & (nbc - 1), cq0 = cb * 32, nlen = 4096 >> sft;
        const int seq = sh >> 3, hd = sh & 7; const size_t tb = (size_t)seq * 4096;
        const size_t tokq = tb + ((size_t)(cq0 + r) << sft) + rr;
        const bf16_t* qp = qkv + tokq * 1536 + hd * 64 + 8 * h;
        bf16x8 qf[4];
#pragma unroll
        for (int s = 0; s < 4; ++s) qf[s] = *(const bf16x8*)(qp + 16 * s);
        float m = NEG, l = 0.f;
        f32x16 O0, O1;
#pragma unroll
        for (int i = 0; i < 16; ++i) { O0[i] = 0.f; O1[i] = 0.f; }
        bf16x8 kfb[2][4], vfb[2][4];
#define ATT_LOAD(kt_) do { const int kb_ = cq0 - 64 + 32 * (kt_); const size_t tokk_ = tb + ((size_t)(kb_ + r) << sft) + rr; const bf16_t* kp_ = qkv + tokk_ * 1536 + 512 + hd * 64 + 8 * h; \
            _Pragma("unroll") for (int s_ = 0; s_ < 4; ++s_) { kfb[(kt_) & 1][s_] = *(const bf16x8*)(kp_ + 16 * s_); vfb[(kt_) & 1][s_] = *(const bf16x8*)(kp_ + 512 + 16 * s_); } } while (0)
        if (cq0 - 64 >= 0) ATT_LOAD(0);
#pragma unroll
        for (int kt = 0; kt < 5; ++kt) {
            const int kb = cq0 - 64 + 32 * kt;
            if (kt + 1 < 5) { const int kbn = kb + 32; if (kbn >= 0 && kbn < nlen) ATT_LOAD(kt + 1); }
            asm volatile("" ::: "memory");
            if (kb < 0 || kb >= nlen) continue;
            bf16x8 kf[4], vf[4];
#pragma unroll
            for (int s = 0; s < 4; ++s) { kf[s] = kfb[kt & 1][s]; vf[s] = vfb[kt & 1][s]; }
            f32x16 S;
#pragma unroll
            for (int i = 0; i < 16; ++i) S[i] = 0.f;
#pragma unroll
            for (int s = 0; s < 4; ++s) S = MFMA32(kf[s], qf[s], S);
            float lm = NEG;
#pragma unroll
            for (int i = 0; i < 16; ++i) {
                const int row = (i & 3) + 8 * (i >> 2) + 4 * h;
                float v = S[i] * sc;
                if (kt == 0) v = (row >= r) ? v : NEG;
                if (kt == 4) v = (row <= r) ? v : NEG;
                S[i] = v; lm = fmaxf(lm, v);
            }
            lm = fmaxf(lm, SHX(lm, 32));
            const float mn = fmaxf(m, lm), alpha = __builtin_amdgcn_exp2f(m - mn);
            m = mn; l *= alpha;
            float ps = 0.f;
#pragma unroll
            for (int i = 0; i < 16; ++i) { O0[i] *= alpha; O1[i] *= alpha; S[i] = __builtin_amdgcn_exp2f(S[i] - mn); ps += S[i]; }
            l += ps;
            const bf16x8 pb0 = pack_frag(S[0], S[1], S[2], S[3], S[4], S[5], S[6], S[7]);
            const bf16x8 pb1 = pack_frag(S[8], S[9], S[10], S[11], S[12], S[13], S[14], S[15]);
            asm volatile("" ::: "memory");
#pragma unroll
            for (int i = 0; i < 4; ++i) *(bf16x8*)(vt + r * 144 + 2 * (16 * i + 8 * h)) = vf[i];
            typedef short s16x4 __attribute__((ext_vector_type(4)));
            s16x4 t00l, t00h, t01l, t01h, t10l, t10h, t11l, t11h;
            asm volatile("s_waitcnt lgkmcnt(0)\n\t"
                         "ds_read_b64_tr_b16 %0, %8\n\tds_read_b64_tr_b16 %1, %8 offset:1152\n\t"
                         "ds_read_b64_tr_b16 %2, %8 offset:2304\n\tds_read_b64_tr_b16 %3, %8 offset:3456\n\t"
                         "ds_read_b64_tr_b16 %4, %8 offset:64\n\tds_read_b64_tr_b16 %5, %8 offset:1216\n\t"
                         "ds_read_b64_tr_b16 %6, %8 offset:2368\n\tds_read_b64_tr_b16 %7, %8 offset:3520\n\t"
                         "s_waitcnt lgkmcnt(0)"
                         : "=&v"(t00l), "=&v"(t00h), "=&v"(t01l), "=&v"(t01h), "=&v"(t10l), "=&v"(t10h), "=&v"(t11l), "=&v"(t11h) : "v"(tr_addr) : "memory");
            const bf16x8 a00 = __builtin_shufflevector(t00l, t00h, 0, 1, 2, 3, 4, 5, 6, 7), a01 = __builtin_shufflevector(t01l, t01h, 0, 1, 2, 3, 4, 5, 6, 7);
            const bf16x8 a10 = __builtin_shufflevector(t10l, t10h, 0, 1, 2, 3, 4, 5, 6, 7), a11 = __builtin_shufflevector(t11l, t11h, 0, 1, 2, 3, 4, 5, 6, 7);
            O0 = MFMA32(a00, pb0, O0); O1 = MFMA32(a10, pb0, O1);
            O0 = MFMA32(a01, pb1, O0); O1 = MFMA32(a11, pb1, O1);
            asm volatile("" ::: "memory");
        }
#undef ATT_LOAD
        l += SHX(l, 32);
        const float inv = 1.0f / l;
        if (VAR == 2 && tokq != 0x7fffffff) continue;
        bf16_t* op = OP + ((size_t)di * T + tokq) * 512 + hd * 64 + 4 * h;
#pragma unroll
        for (int g = 0; g < 4; ++g) {
            u32x2 p0, p1;
            p0.x = pack2(O0[4 * g] * inv, O0[4 * g + 1] * inv); p0.y = pack2(O0[4 * g + 2] * inv, O0[4 * g + 3] * inv);
            p1.x = pack2(O1[4 * g] * inv, O1[4 * g + 1] * inv); p1.y = pack2(O1[4 * g + 2] * inv, O1[4 * g + 3] * inv);
            *(u32x2*)(op + 8 * g) = p0; *(u32x2*)(op + 32 + 8 * g) = p1;
        }
        if (h == 0) { f32x2 ml; ml[0] = m; ml[1] = l; *(f32x2*)(ML + (((size_t)di * T + tokq) * 8 + hd) * 2) = ml; }
    }
}
DEV void ph_attn_merge(const Args& a, int layer, const int tid0) {
    const int lane = tid0 & 63, wv = tid0 >> 6;
    const int gw = blockIdx.x * 8 + wv, nw = gridDim.x * 8;
    const bf16_t* OP = wsb(a, OP_OFF); const float* ML = wsf(a, ML_OFF); bf16_t* mix = wsb(a, MIX_OFF);
    const int c8 = 8 * lane, hd = lane >> 3;
    const f32x4 gA = *(const f32x4*)(a.att_norm_g + layer * 512 + c8), gB = *(const f32x4*)(a.att_norm_g + layer * 512 + c8 + 4);
    for (int t = gw; t < T; t += nw) {
        u32x4 o[3]; f32x2 ml[3];
#pragma unroll
        for (int d = 0; d < 3; ++d) { o[d] = *(const u32x4*)(OP + ((size_t)d * T + t) * 512 + c8); ml[d] = *(const f32x2*)(ML + (((size_t)d * T + t) * 8 + hd) * 2); }
        const float mm = fmaxf(ml[0][0], fmaxf(ml[1][0], ml[2][0]));
        float wgt[3]; float den = 0.f;
#pragma unroll
        for (int d = 0; d < 3; ++d) { wgt[d] = __builtin_amdgcn_exp2f(ml[d][0] - mm) * ml[d][1]; den += wgt[d]; }
        const float iden = 1.0f / den;
        float v[8]; float ss = 0.f;
#pragma unroll
        for (int i = 0; i < 4; ++i) {
            v[2 * i] = (wgt[0] * bflo(o[0][i]) + wgt[1] * bflo(o[1][i]) + wgt[2] * bflo(o[2][i])) * iden;
            v[2 * i + 1] = (wgt[0] * bfhi(o[0][i]) + wgt[1] * bfhi(o[1][i]) + wgt[2] * bfhi(o[2][i])) * iden;
            ss += v[2 * i] * v[2 * i] + v[2 * i + 1] * v[2 * i + 1];
        }
        const float rn = rsqrtf(sum8(ss) * (1.0f / 64.0f) + 1e-6f);
        u32x4 ov;
        ov.x = pack2(v[0] * rn * gA[0], v[1] * rn * gA[1]); ov.y = pack2(v[2] * rn * gA[2], v[3] * rn * gA[3]);
        ov.z = pack2(v[4] * rn * gB[0], v[5] * rn * gB[1]); ov.w = pack2(v[6] * rn * gB[2], v[7] * rn * gB[3]);
        *(u32x4*)(mix + (size_t)t * 1024 + c8) = ov;
    }
}

DEV float tanh_fast(float x) { return 1.0f - 2.0f / (1.0f + __expf(2.0f * x)); }

DEV void ph_rwkv_prep1(const Args& a, int layer, unsigned char* ldsb, const int tid0) {
    const int lane = tid0 & 63, wv = __builtin_amdgcn_readfirstlane(tid0 >> 6), r = lane & 31, h = lane >> 5;
    const int gw = blockIdx.x * 8 + wv, nw = gridDim.x * 8;
    const int sub = wv & 1, ng = wv >> 1;
    const bf16_t* U = wsb(a, U_OFF);
    const float* sw = a.rwkv_shift + (size_t)layer * 3 * UC;
    const bf16_t* wl = wsb(a, WB_OFF + (size_t)layer * WB_LAYER + WB_LORA);
#pragma unroll 1
    for (int arr = 0; arr < 5; ++arr) {
        const int coff = (arr < 4) ? arr * 64 : 256, nk = (arr < 4) ? 4 : 8, kw = nk * 16, rsb = kw * 2 + 16;
        __syncthreads();
        {
            const bf16_t* wsrc = wl + (arr < 4 ? arr * 512 * 64 : 4 * 512 * 64);
            const int cpr = kw / 8;
            for (int i = tid0; i < 512 * cpr; i += NTHR) { const int row = i / cpr, c = i - row * cpr; *(u32x4*)(ldsb + row * rsb + c * 16) = *(const u32x4*)(wsrc + (size_t)row * kw + c * 8); }
        }
        __syncthreads();
        bf16_t* outb = wsb(a, arr == 0 ? WF_OFF : arr == 1 ? WB2_OFF : arr == 2 ? AF_OFF : arr == 3 ? AB_OFF : G_OFF);
        const float* bias = (arr < 2) ? a.rwkv_w0 + (layer * 2 + arr) * 512 : a.rwkv_a0 + (layer * 2 + (arr & 1)) * 512;
        f32x4 bvr[4][4];
#pragma unroll
        for (int q = 0; q < 4; ++q)
#pragma unroll
            for (int g = 0; g < 4; ++g) bvr[q][g] = *(const f32x4*)(bias + (ng * 4 + q) * 32 + 8 * g + 4 * h);
#pragma unroll 1
        for (int tile = blockIdx.x; tile < T / 64; tile += gridDim.x) {
            const int t = tile * 64 + sub * 32 + r, pos = t & 4095;
            const bool hp = pos > 0, hn = pos < 4095;
            const bf16_t* up = U + (size_t)t * UW + 1536 + 8 * h;
            bf16x8 xf[8];
#pragma unroll
            for (int s = 0; s < 8; ++s) {
                if (s < nk) {
                    const int col = coff + 16 * s;
                    const u32x4 c = *(const u32x4*)(up + col);
                    u32x4 p = {0u, 0u, 0u, 0u}, n = {0u, 0u, 0u, 0u};
                    if (hp) p = *(const u32x4*)(up - UW + col);
                    if (hn) n = *(const u32x4*)(up + UW + col);
                    const float* s0 = sw + 1536 + 8 * h + col;
                    const f32x4 wp0 = *(const f32x4*)(s0), wp1 = *(const f32x4*)(s0 + 4), wc0 = *(const f32x4*)(s0 + UC), wc1 = *(const f32x4*)(s0 + UC + 4), wn0 = *(const f32x4*)(s0 + 2 * UC), wn1 = *(const f32x4*)(s0 + 2 * UC + 4);
                    float v[8];
#pragma unroll
                    for (int i = 0; i < 4; ++i) {
                        const float a0 = (i < 2) ? wp0[2 * i] : wp1[2 * i - 4], a1 = (i < 2) ? wp0[2 * i + 1] : wp1[2 * i - 3];
                        const float b0 = (i < 2) ? wc0[2 * i] : wc1[2 * i - 4], b1 = (i < 2) ? wc0[2 * i + 1] : wc1[2 * i - 3];
                        const float c0 = (i < 2) ? wn0[2 * i] : wn1[2 * i - 4], c1 = (i < 2) ? wn0[2 * i + 1] : wn1[2 * i - 3];
                        v[2 * i] = a0 * bflo(p[i]) + b0 * bflo(c[i]) + c0 * bflo(n[i]);
                        v[2 * i + 1] = a1 * bfhi(p[i]) + b1 * bfhi(c[i]) + c1 * bfhi(n[i]);
                    }
                    if (arr < 2) {
#pragma unroll
                        for (int i = 0; i < 8; ++i) v[i] = tanh_fast(v[i]);
                    } else if (arr == 4) {
#pragma unroll
                        for (int i = 0; i < 8; ++i) v[i] = sigmoidf_(v[i]);
                    }
                    xf[s] = pack_frag(v[0], v[1], v[2], v[3], v[4], v[5], v[6], v[7]);
                }
            }
            bf16_t* out = outb + (size_t)t * 512 + 4 * h;
#pragma unroll
            for (int q = 0; q < 4; ++q) {
                const int nt = ng * 4 + q;
                f32x16 C;
#pragma unroll
                for (int i = 0; i < 16; ++i) C[i] = 0.f;
                const unsigned char* wr = ldsb + (nt * 32 + r) * rsb + 16 * h;
#pragma unroll
                for (int s = 0; s < 8; ++s) if (s < nk) { const bf16x8 A = *(const bf16x8*)(wr + 32 * s); C = MFMA32(A, xf[s], C); }
#pragma unroll
                for (int g = 0; g < 4; ++g) {
                    float o[4];
                    if (arr < 4) {
                        const f32x4 bv = bvr[q][g];
#pragma unroll
                        for (int j = 0; j < 4; ++j) { const float sg = sigmoidf_(C[4 * g + j] + bv[j]); o[j] = (arr < 2) ? __expf(-0.60653066f * sg) : sg; }
                    } else {
#pragma unroll
                        for (int j = 0; j < 4; ++j) o[j] = C[4 * g + j];
                    }
                    u32x2 pk; pk.x = pack2(o[0], o[1]); pk.y = pack2(o[2], o[3]);
                    *(u32x2*)(out + nt * 32 + 8 * g) = pk;
                }
            }
        }
    }
    {
        const int c16 = 16 * lane;
        bf16_t* dst = wsb(a, lane < 32 ? RS_OFF : KS_OFF) + (c16 & 511);
        float swp[16], swc[16], swn[16];
#pragma unroll
        for (int i = 0; i < 16; ++i) { swp[i] = sw[c16 + i]; swc[i] = sw[UC + c16 + i]; swn[i] = sw[2 * UC + c16 + i]; }
        for (int t = gw; t < T; t += nw) {
            const int pos = t & 4095; const bool hp = pos > 0, hn = pos < 4095;
            const bf16_t* up = U + (size_t)t * UW + c16;
            u32x4 c[2], p[2], n[2];
#pragma unroll
            for (int q = 0; q < 2; ++q) {
                c[q] = *(const u32x4*)(up + 8 * q); p[q] = (u32x4){0u, 0u, 0u, 0u}; n[q] = (u32x4){0u, 0u, 0u, 0u};
                if (hp) p[q] = *(const u32x4*)(up - UW + 8 * q);
                if (hn) n[q] = *(const u32x4*)(up + UW + 8 * q);
            }
            u32x4 o[2];
#pragma unroll
            for (int q = 0; q < 2; ++q)
#pragma unroll
                for (int i = 0; i < 4; ++i) {
                    const int e = 8 * q + 2 * i;
                    const float lo = swp[e] * bflo(p[q][i]) + swc[e] * bflo(c[q][i]) + swn[e] * bflo(n[q][i]);
                    const float hi = swp[e + 1] * bfhi(p[q][i]) + swc[e + 1] * bfhi(c[q][i]) + swn[e + 1] * bfhi(n[q][i]);
                    o[q][i] = pack2(lo, hi);
                }
            *(u32x4*)(dst + (size_t)t * 512) = o[0]; *(u32x4*)(dst + (size_t)t * 512 + 8) = o[1];
        }
    }
}
DEV void ph_rwkv_prep2(const Args& a, int layer, const int tid0) {
    const int lane = tid0 & 63, wv = tid0 >> 6;
    const int gw = blockIdx.x * 8 + wv, nw = gridDim.x * 8;
    bf16_t* U = wsb(a, U_OFF); const bf16_t* KS = wsb(a, KS_OFF);
    const float* sw = a.rwkv_shift + (size_t)layer * 3 * UC;
    const int c8 = 8 * lane;
    float kkc[8], sv[3][8];
#pragma unroll
    for (int i = 0; i < 8; ++i) { kkc[i] = a.rwkv_k_k[layer * 512 + c8 + i]; sv[0][i] = sw[1024 + c8 + i]; sv[1][i] = sw[UC + 1024 + c8 + i]; sv[2][i] = sw[2 * UC + 1024 + c8 + i]; }
    for (int t = gw; t < T; t += nw) {
        const int pos = t & 4095; const bool hp = pos > 0, hn = pos < 4095;
        bf16_t* up = U + (size_t)t * UW;
        const u32x4 ks = *(const u32x4*)(KS + (size_t)t * 512 + c8);
        const u32x4 c = *(const u32x4*)(up + 1024 + c8);
        u32x4 p = {0u, 0u, 0u, 0u}, n = {0u, 0u, 0u, 0u};
        if (hp) p = *(const u32x4*)(up - UW + 1024 + c8);
        if (hn) n = *(const u32x4*)(up + UW + 1024 + c8);
        float kx[8]; float ss = 0.f;
#pragma unroll
        for (int i = 0; i < 4; ++i) { kx[2 * i] = bflo(ks[i]) * kkc[2 * i]; kx[2 * i + 1] = bfhi(ks[i]) * kkc[2 * i + 1]; ss += kx[2 * i] * kx[2 * i] + kx[2 * i + 1] * kx[2 * i + 1]; }
        const float inv = 1.0f / fmaxf(sqrtf(sum8(ss)), 1e-12f);
        u32x4 ko, vo;
#pragma unroll
        for (int i = 0; i < 4; ++i) {
            ko[i] = pack2(kx[2 * i] * inv, kx[2 * i + 1] * inv);
            vo[i] = pack2(sv[0][2 * i] * bflo(p[i]) + sv[1][2 * i] * bflo(c[i]) + sv[2][2 * i] * bflo(n[i]), sv[0][2 * i + 1] * bfhi(p[i]) + sv[1][2 * i + 1] * bfhi(c[i]) + sv[2][2 * i + 1] * bfhi(n[i]));
        }
        *(u32x4*)(up + c8) = ko; *(u32x4*)(up + 1536 + c8) = vo;
    }
}

DEV void ph_scan3(const Args& a, int layer, float* lds, const int tid0) {
    const int tid = tid0, lane = tid & 63, wv = __builtin_amdgcn_readfirstlane(tid >> 6);
    float* vecs = lds;
    float* ybuf = lds + 2 * 12288;
    const bf16_t* U = wsb(a, U_OFF); const bf16_t* RS = wsb(a, RS_OFF); const bf16_t* KS = wsb(a, KS_OFF);
    bf16_t* Uw = wsb(a, U_OFF);
    const bool helper = wv >= 4;
    const int dir = helper ? ((wv - 4) >> 1) : (wv >> 1), part = wv & 1;
    const bf16_t* Wd = wsb(a, dir ? WB2_OFF : WF_OFF); const bf16_t* Ad = wsb(a, dir ? AB_OFF : AF_OFF);
    const int js = lane & 7, q = lane >> 3, r0 = 32 * part + 4 * q;
    for (int un = blockIdx.x; un < NSEQ * 8; un += gridDim.x) {
        const int seq = un >> 3, hd = un & 7; const size_t tb = (size_t)seq * 4096; const int cb = hd * 64, pch = cb + lane;
        const float kac = a.rwkv_k_a[layer * 512 + pch];
        f32x2 S[4][4];
#pragma unroll
        for (int rw = 0; rw < 4; ++rw)
#pragma unroll
            for (int i = 0; i < 4; ++i) S[rw][i] = (f32x2){0.f, 0.f};
#define SCAN_PREP(blk_, buf_) do { unsigned short pr_[8][6]; \
            _Pragma("unroll") for (int si = 0; si < 8; ++si) { const int step_ = (blk_) * 16 + part * 8 + si, pos_ = dir ? 4095 - step_ : step_; const size_t t_ = tb + pos_; \
                pr_[si][0] = Wd[t_ * 512 + pch]; pr_[si][1] = U[t_ * UW + pch]; pr_[si][2] = Ad[t_ * 512 + pch]; pr_[si][3] = KS[t_ * 512 + pch]; pr_[si][4] = RS[t_ * 512 + pch]; pr_[si][5] = U[t_ * UW + 1536 + pch]; } \
            _Pragma("unroll") for (int si = 0; si < 8; ++si) { float* o_ = vecs + (((buf_) * 2 + dir) * 16 + part * 8 + si) * 384 + lane; \
                const float w_ = bf2f(pr_[si][0]), kk_ = bf2f(pr_[si][1]), av_ = bf2f(pr_[si][2]), ks_ = bf2f(pr_[si][3]); \
                o_[0] = w_; o_[64] = -kk_; o_[128] = kk_ * av_; o_[192] = ks_ * (1.0f + (av_ - 1.0f) * kac); o_[256] = bf2f(pr_[si][4]); o_[320] = bf2f(pr_[si][5]); } } while (0)
        __syncthreads();
        if (helper) SCAN_PREP(0, 0);
        __syncthreads();
        for (int blk = 0; blk < 256; ++blk) {
            const int cur = blk & 1;
            if (helper) {
                if (blk + 1 < 256) SCAN_PREP(blk + 1, cur ^ 1);
                if (blk > 0) {
                    const int s2 = part * 8 + (lane >> 3), c8 = (lane & 7) * 8;
                    const float* yp = ybuf + (((cur ^ 1) * 2 + dir) * 16 + s2) * 64 + c8;
                    const f32x4 y0 = *(const f32x4*)(yp), y1 = *(const f32x4*)(yp + 4);
                    const int step = (blk - 1) * 16 + s2, pos = dir ? 4095 - step : step;
                    u32x4 pk; pk.x = pack2(y0[0], y0[1]); pk.y = pack2(y0[2], y0[3]); pk.z = pack2(y1[0], y1[1]); pk.w = pack2(y1[2], y1[3]);
                    *(u32x4*)(Uw + (tb + pos) * UW + 512 + 512 * dir + cb + c8) = pk;
                }
            } else {
                const float* vb0 = vecs + ((cur * 2 + dir) * 16) * 384;
                float* yb = ybuf + ((cur * 2 + dir) * 16) * 64 + r0;
                const float* vbl = vb0 + 8 * js;
                f32x4 cw0 = *(const f32x4*)(vbl), cw1 = *(const f32x4*)(vbl + 4), ca0 = *(const f32x4*)(vbl + 64), ca1 = *(const f32x4*)(vbl + 68), cb0 = *(const f32x4*)(vbl + 128), cb1 = *(const f32x4*)(vbl + 132);
                f32x4 ck0 = *(const f32x4*)(vbl + 192), ck1 = *(const f32x4*)(vbl + 196), cq0 = *(const f32x4*)(vbl + 256), cq1 = *(const f32x4*)(vbl + 260);
                f32x4 cv4 = *(const f32x4*)(vb0 + 320 + r0);
#pragma unroll
                for (int s = 0; s < 16; ++s) {
                    const f32x4 w0 = cw0, w1 = cw1, a0 = ca0, a1 = ca1, b0 = cb0, b1 = cb1, k0 = ck0, k1 = ck1, q0 = cq0, q1 = cq1, v4 = cv4;
                    if (s < 15) {
                        const float* vn = vbl + (s + 1) * 384;
                        cw0 = *(const f32x4*)(vn); cw1 = *(const f32x4*)(vn + 4); ca0 = *(const f32x4*)(vn + 64); ca1 = *(const f32x4*)(vn + 68); cb0 = *(const f32x4*)(vn + 128); cb1 = *(const f32x4*)(vn + 132);
                        ck0 = *(const f32x4*)(vn + 192); ck1 = *(const f32x4*)(vn + 196); cq0 = *(const f32x4*)(vn + 256); cq1 = *(const f32x4*)(vn + 260);
                        cv4 = *(const f32x4*)(vb0 + (s + 1) * 384 + 320 + r0);
                        asm volatile("" ::: "memory");
                    }
                    const f32x2 av[4] = {{a0[0], a0[1]}, {a0[2], a0[3]}, {a1[0], a1[1]}, {a1[2], a1[3]}};
                    const f32x2 wv2[4] = {{w0[0], w0[1]}, {w0[2], w0[3]}, {w1[0], w1[1]}, {w1[2], w1[3]}};
                    const f32x2 bv[4] = {{b0[0], b0[1]}, {b0[2], b0[3]}, {b1[0], b1[1]}, {b1[2], b1[3]}};
                    const f32x2 kv[4] = {{k0[0], k0[1]}, {k0[2], k0[3]}, {k1[0], k1[1]}, {k1[2], k1[3]}};
                    const f32x2 qv[4] = {{q0[0], q0[1]}, {q0[2], q0[3]}, {q1[0], q1[1]}, {q1[2], q1[3]}};
                    float sa[4];
#pragma unroll
                    for (int rw = 0; rw < 4; ++rw) { const f32x2 t0 = (S[rw][0] * av[0] + S[rw][1] * av[1]) + (S[rw][2] * av[2] + S[rw][3] * av[3]); sa[rw] = sum8(t0[0] + t0[1]); }
                    f32x4 yo;
#pragma unroll
                    for (int rw = 0; rw < 4; ++rw) {
                        f32x2 y2 = {0.f, 0.f};
#pragma unroll
                        for (int i = 0; i < 4; ++i) { S[rw][i] = S[rw][i] * wv2[i] + (bv[i] * sa[rw] + kv[i] * v4[rw]); y2 = y2 + S[rw][i] * qv[i]; }
                        yo[rw] = sum8(y2[0] + y2[1]);
                    }
                    if (js == 0) *(f32x4*)(yb + s * 64) = yo;
                }
            }
            __syncthreads();
        }
        if (helper) {
            const int cur = 1, blk = 256;
            const int s2 = part * 8 + (lane >> 3), c8 = (lane & 7) * 8;
            const float* yp = ybuf + ((cur * 2 + dir) * 16 + s2) * 64 + c8;
            const f32x4 y0 = *(const f32x4*)(yp), y1 = *(const f32x4*)(yp + 4);
            const int step = (blk - 1) * 16 + s2, pos = dir ? 4095 - step : step;
            u32x4 pk; pk.x = pack2(y0[0], y0[1]); pk.y = pack2(y0[2], y0[3]); pk.z = pack2(y1[0], y1[1]); pk.w = pack2(y1[2], y1[3]);
            *(u32x4*)(Uw + (tb + pos) * UW + 512 + 512 * dir + cb + c8) = pk;
        }
#undef SCAN_PREP
    }
}

DEV void ph_post2(const Args& a, int layer, const int tid0) {
    const int lane = tid0 & 63, wv = tid0 >> 6;
    const int gw = blockIdx.x * 8 + wv, nw = gridDim.x * 8;
    const bf16_t* U = wsb(a, U_OFF); const bf16_t* RS = wsb(a, RS_OFF); const bf16_t* KS = wsb(a, KS_OFF); const bf16_t* G = wsb(a, G_OFF);
    const bf16_t* AF = wsb(a, AF_OFF); const bf16_t* AB = wsb(a, AB_OFF); bf16_t* mix = wsb(a, MIX_OFF);
    const int c8 = 8 * lane;
    float kac[8], rkc[8], lnw[8], lnb[8];
#pragma unroll
    for (int i = 0; i < 8; ++i) { kac[i] = a.rwkv_k_a[layer * 512 + c8 + i]; rkc[i] = a.rwkv_r_k[layer * 512 + c8 + i]; lnw[i] = a.rwkv_ln_w[layer * 512 + c8 + i]; lnb[i] = a.rwkv_ln_b[layer * 512 + c8 + i]; }
    for (int t = gw; t < T; t += nw) {
        const bf16_t* up = U + (size_t)t * UW;
        const u32x4 rp = *(const u32x4*)(RS + (size_t)t * 512 + c8), kp = *(const u32x4*)(KS + (size_t)t * 512 + c8), gp = *(const u32x4*)(G + (size_t)t * 512 + c8);
        const u32x4 afp = *(const u32x4*)(AF + (size_t)t * 512 + c8), abp = *(const u32x4*)(AB + (size_t)t * 512 + c8);
        const u32x4 yfp = *(const u32x4*)(up + 512 + c8), ybp = *(const u32x4*)(up + 1024 + c8), vp = *(const u32x4*)(up + 1536 + c8);
        float y[8], rr[8], kk[8], vv[8], gg[8], sa[8];
#pragma unroll
        for (int i = 0; i < 4; ++i) {
            y[2 * i] = bflo(yfp[i]) + bflo(ybp[i]); y[2 * i + 1] = bfhi(yfp[i]) + bfhi(ybp[i]);
            rr[2 * i] = bflo(rp[i]); rr[2 * i + 1] = bfhi(rp[i]); kk[2 * i] = bflo(kp[i]); kk[2 * i + 1] = bfhi(kp[i]);
            vv[2 * i] = bflo(vp[i]); vv[2 * i + 1] = bfhi(vp[i]); gg[2 * i] = bflo(gp[i]); gg[2 * i + 1] = bfhi(gp[i]);
            sa[2 * i] = bflo(afp[i]) + bflo(abp[i]); sa[2 * i + 1] = bfhi(afp[i]) + bfhi(abp[i]);
        }
        float ysum = 0.f, bs = 0.f;
#pragma unroll
        for (int i = 0; i < 8; ++i) { ysum += y[i]; bs += rr[i] * kk[i] * (2.0f + (sa[i] - 2.0f) * kac[i]) * rkc[i]; }
        const float mu = sum8(ysum) * (1.0f / 64.0f);
        float vs = 0.f;
#pragma unroll
        for (int i = 0; i < 8; ++i) { y[i] -= mu; vs += y[i] * y[i]; }
        const float rstdv = rsqrtf(sum8(vs) * (1.0f / 64.0f) + 64e-5f);
        bs = sum8(bs);
        float o[8];
#pragma unroll
        for (int i = 0; i < 8; ++i) o[i] = (y[i] * rstdv * lnw[i] + lnb[i] + bs * vv[i]) * gg[i];
        u32x4 ov; ov.x = pack2(o[0], o[1]); ov.y = pack2(o[2], o[3]); ov.z = pack2(o[4], o[5]); ov.w = pack2(o[6], o[7]);
        *(u32x4*)(mix + (size_t)t * 1024 + 512 + c8) = ov;
    }
}

#ifndef PEER_SYNC
#define PEER_SYNC 2
#endif
template <bool DRY> DEV void ph_peer_sliced(const Args& a, const int tid0) {
    const int lane = tid0 & 63, wv = tid0 >> 6;
    const int gw = blockIdx.x * 8 + wv, nw = gridDim.x * 8;
    bf16_t* hb = wsb(a, HB_OFF); float* rstd = wsf(a, RSTD_OFF);
    const int* TOPI = (const int*)(a.ws + TOPI_OFF); const float* TOPG = wsf(a, TOPG_OFF);
    const unsigned char* PU = a.ws + PTU_OFF; const unsigned char* PV = a.ws + PTV_OFF;
    const int c16 = 16 * lane;
    const bool b5 = lane & 32, b4 = lane & 16;
    const int nround = T / (nw * 4);
    for (int rd = 0; rd < nround; ++rd) {
        u32x4 xa[4], xb[4]; float out[4][16]; int e0[4], e1[4]; float g0[4], g1[4], rs[4];
#pragma unroll
        for (int tk = 0; tk < 4; ++tk) {
            const int t = gw + nw * (rd * 4 + tk);
            xa[tk] = *(const u32x4*)(hb + (size_t)t * 1024 + c16); xb[tk] = *(const u32x4*)(hb + (size_t)t * 1024 + c16 + 8);
            rs[tk] = rstd[t] * (1.0f / 256.0f);
            e0[tk] = TOPI[(size_t)t * 128 + lane]; e1[tk] = TOPI[(size_t)t * 128 + 64 + lane];
            g0[tk] = TOPG[(size_t)t * 128 + lane]; g1[tk] = TOPG[(size_t)t * 128 + 64 + lane];
#pragma unroll
            for (int i = 0; i < 16; ++i) out[tk][i] = 0.f;
        }
#pragma unroll 1
        for (int s = 0; s < 16; ++s) {
#pragma unroll
            for (int tk = 0; tk < 4; ++tk) {
                unsigned long long m0 = __ballot((e0[tk] >> 10) == s), m1 = __ballot((e1[tk] >> 10) == s);
                while (m0 | m1) {
                    int ex[4]; float gx[4];
#pragma unroll
                    for (int i = 0; i < 4; ++i) {
                        if (m0) { const int ix = __builtin_ctzll(m0); m0 &= m0 - 1; ex[i] = __builtin_amdgcn_readlane(e0[tk], ix); gx[i] = rl(g0[tk], ix); }
                        else if (m1) { const int ix = __builtin_ctzll(m1); m1 &= m1 - 1; ex[i] = __builtin_amdgcn_readlane(e1[tk], ix); gx[i] = rl(g1[tk], ix); }
                        else { ex[i] = ex[0]; gx[i] = 0.f; }
                    }
#ifdef PROBE_EMASK
                    if (DRY) {
#pragma unroll
                        for (int i = 0; i < 4; ++i) ex[i] &= PROBE_EMASK;
                    }
#endif
                    u32x4 ur[4], vr[4];
#pragma unroll
                    for (int i = 0; i < 4; ++i) { ur[i] = *(const u32x4*)(PU + (size_t)ex[i] * 1024 + c16); vr[i] = *(const u32x4*)(PV + (size_t)ex[i] * 1024 + c16); }
                    float d[4];
#pragma unroll
                    for (int i = 0; i < 4; ++i) {
                        float sm = 0.f;
#pragma unroll
                        for (int j = 0; j < 4; ++j) {
                            const f32x2 lo = __builtin_amdgcn_cvt_pk_f32_fp8((int)ur[i][j], false), hi = __builtin_amdgcn_cvt_pk_f32_fp8((int)ur[i][j], true);
                            const unsigned ulo = (__float_as_uint(lo[0]) >> 16) | (__float_as_uint(lo[1]) & 0xffff0000u), uhi = (__float_as_uint(hi[0]) >> 16) | (__float_as_uint(hi[1]) & 0xffff0000u);
                            const unsigned xlo = (j < 2) ? xa[tk][2 * j] : xb[tk][2 * j - 4], xhi = (j < 2) ? xa[tk][2 * j + 1] : xb[tk][2 * j - 3];
                            sm = dot2bf(ulo, xlo, sm); sm = dot2bf(uhi, xhi, sm);
                        }
                        d[i] = sm;
                    }
                    float r2[2];
#pragma unroll
                    for (int i = 0; i < 2; ++i) { const float send = b5 ? d[i] : d[2 + i], keep = b5 ? d[2 + i] : d[i]; r2[i] = keep + SHX(send, 32); }
                    const float send1 = b4 ? r2[0] : r2[1], keep1 = b4 ? r2[1] : r2[0];
                    const float dd = sum16(keep1 + SHX(send1, 16));
                    const float hp = rs[tk] * dd;
                    const float gl = 0.5f * hp * (1.0f + erff(hp * 0.70710678f)) * (1.0f / 32.0f);
#pragma unroll
                    for (int i = 0; i < 4; ++i) {
                        const float wi = rl(gl, 16 * i) * gx[i];
#pragma unroll
                        for (int j = 0; j < 4; ++j) {
                            const f32x2 lo = __builtin_amdgcn_cvt_pk_f32_fp8((int)vr[i][j], false), hi = __builtin_amdgcn_cvt_pk_f32_fp8((int)vr[i][j], true);
                            out[tk][4 * j] += wi * lo[0]; out[tk][4 * j + 1] += wi * lo[1]; out[tk][4 * j + 2] += wi * hi[0]; out[tk][4 * j + 3] += wi * hi[1];
                        }
                    }
                }
            }
        }
#pragma unroll
        for (int tk = 0; tk < 4; ++tk) {
            const int t = gw + nw * (rd * 4 + tk);
            float* hr = a.h + (size_t)t * 1024 + c16;
            f32x4 hv[4]; float ss = 0.f;
#pragma unroll
            for (int j = 0; j < 4; ++j) { hv[j] = *(const f32x4*)(hr + 4 * j);
#pragma unroll
                for (int c = 0; c < 4; ++c) { hv[j][c] += out[tk][4 * j + c]; ss += hv[j][c] * hv[j][c]; }
                if (!DRY) *(f32x4*)(hr + 4 * j) = hv[j]; }
            ss = wave_sum(ss);
            if (DRY && ss != -1.0f) continue;
            u32x4 p0, p1;
            p0.x = pack2(hv[0][0], hv[0][1]); p0.y = pack2(hv[0][2], hv[0][3]); p0.z = pack2(hv[1][0], hv[1][1]); p0.w = pack2(hv[1][2], hv[1][3]);
            p1.x = pack2(hv[2][0], hv[2][1]); p1.y = pack2(hv[2][2], hv[2][3]); p1.z = pack2(hv[3][0], hv[3][1]); p1.w = pack2(hv[3][2], hv[3][3]);
            *(u32x4*)(hb + (size_t)t * 1024 + c16) = p0; *(u32x4*)(hb + (size_t)t * 1024 + c16 + 8) = p1;
            if (lane == 0) rstd[t] = rsqrtf(ss * (1.0f / 1024.0f) + 1e-6f);
        }
        if ((rd % PEER_SYNC) == PEER_SYNC - 1 && rd + 1 < nround) {
            XcdBarrier b_; b_.bar = (unsigned*)(a.ws + BAR_OFF); b_.x = xb_xcc_id(); b_.st = (volatile LAS unsigned*)(smem_base() + LDS_BYTES - 16);
            xcd_barrier(b_, tid0);
        }
    }
}

#ifdef PROBE_EMASK
#define PEER_EM(e) (DRY ? ((e) & PROBE_EMASK) : (e))
#else
#define PEER_EM(e) (e)
#endif
template <bool DRY> DEV void ph_peer_pipe(const Args& a, const int tid0, const int gw, const int nw, const int ntok) {
    const int lane = tid0 & 63;
    bf16_t* hb = wsb(a, HB_OFF); float* rstd = wsf(a, RSTD_OFF); const float* ssq = wsf(a, SSQ_OFF);
    const int* TOPI = (const int*)(a.ws + TOPI_OFF); const float* TOPG = wsf(a, TOPG_OFF);
    const unsigned char* PU = a.ws + PTU_OFF; const unsigned char* PV = a.ws + PTV_OFF;
    const int c16 = 16 * lane;
    const bool b5 = lane & 32, b4 = lane & 16, b3 = lane & 8;
    const bool dost = DRY ? (__builtin_amdgcn_readfirstlane(TOPI[0]) == -12345) : true;
    u32x4 ur[2][8], vr[8];
    int e0, e1, e0n = 0, e1n = 0; float g0, g1, g0n = 0.f, g1n = 0.f;
    u32x4 xa, xb, xan = {0u, 0u, 0u, 0u}, xbn = {0u, 0u, 0u, 0u}; float rsv, rsn = 0.f;
#define PEER_ISSUE_U(slot_, b_, es0_, es1_) do { _Pragma("unroll") for (int i_ = 0; i_ < 8; ++i_) { const int k_ = (b_) * 8 + i_; \
        const int e_ = PEER_EM(__builtin_amdgcn_readlane((k_ < 64) ? (es0_) : (es1_), k_ & 63)); ur[slot_][i_] = *(const u32x4*)(PU + (size_t)e_ * 1024 + c16); } } while (0)
#define PEER_ISSUE_V(slot_, b_, es0_, es1_) do { _Pragma("unroll") for (int i_ = 0; i_ < 8; ++i_) { const int k_ = (b_) * 8 + i_; \
        const int e_ = PEER_EM(__builtin_amdgcn_readlane((k_ < 64) ? (es0_) : (es1_), k_ & 63)); vr[i_] = *(const u32x4*)(PV + (size_t)e_ * 1024 + c16); } } while (0)
    if (ntok <= 0) return;
    {   const int t0 = gw;
        e0 = TOPI[(size_t)t0 * 128 + lane]; e1 = TOPI[(size_t)t0 * 128 + 64 + lane]; g0 = TOPG[(size_t)t0 * 128 + lane]; g1 = TOPG[(size_t)t0 * 128 + 64 + lane];
        xa = *(const u32x4*)(hb + (size_t)t0 * 1024 + c16); xb = *(const u32x4*)(hb + (size_t)t0 * 1024 + c16 + 8); rsv = rstd_parts(ssq, t0); }
    PEER_ISSUE_U(0, 0, e0, e1);
#pragma unroll 1
    for (int j = 0; j < ntok; ++j) {
        const int t = gw + nw * j; const bool more = (j + 1 < ntok);
        float* hr = a.h + (size_t)t * 1024 + c16;
        if (more) { const int tn = t + nw;
            e0n = TOPI[(size_t)tn * 128 + lane]; e1n = TOPI[(size_t)tn * 128 + 64 + lane]; }
        const float rs = rsv * (1.0f / 256.0f);
        float out[16];
#pragma unroll
        for (int i = 0; i < 16; ++i) out[i] = 0.f;
#pragma unroll 1
        for (int b2 = 0; b2 < 16; b2 += 2)
#pragma unroll
        for (int bb = 0; bb < 2; ++bb) {
            const int b = b2 + bb;
            PEER_ISSUE_V(0, b, e0, e1);
            if (bb == 0) PEER_ISSUE_U(1, b + 1, e0, e1);
            else if (b < 15) PEER_ISSUE_U(0, b + 1, e0, e1);
            else if (more) PEER_ISSUE_U(0, 0, e0n, e1n);
            asm volatile("" ::: "memory");
            float d[8];
#pragma unroll
            for (int i = 0; i < 8; ++i) {
                float sm = 0.f;
#pragma unroll
                for (int q = 0; q < 4; ++q) {
                    const unsigned uw = ur[bb][i][q];
                    const f32x2 lo = __builtin_amdgcn_cvt_pk_f32_fp8((int)uw, false), hi = __builtin_amdgcn_cvt_pk_f32_fp8((int)uw, true);
                    const unsigned ulo = pack2(lo[0], lo[1]), uhi = pack2(hi[0], hi[1]);
                    const unsigned xlo = (q < 2) ? xa[2 * q] : xb[2 * q - 4], xhi = (q < 2) ? xa[2 * q + 1] : xb[2 * q - 3];
                    sm = dot2bf(ulo, xlo, sm); sm = dot2bf(uhi, xhi, sm);
                }
                d[i] = sm;
            }
            float r4[4], r2[2];
#pragma unroll
            for (int i = 0; i < 4; ++i) { const float send = b5 ? d[i] : d[4 + i], keep = b5 ? d[4 + i] : d[i]; r4[i] = keep + SHX(send, 32); }
#pragma unroll
            for (int i = 0; i < 2; ++i) { const float send = b4 ? r4[i] : r4[2 + i], keep = b4 ? r4[2 + i] : r4[i]; r2[i] = keep + SHX(send, 16); }
            const float send1 = b3 ? r2[0] : r2[1], keep1 = b3 ? r2[1] : r2[0];
            const float dd = sum8(keep1 + SHX(send1, 8));
            const float hp = rs * dd;
            const float gt = SHF((b < 8) ? g0 : g1, (b * 8 + (lane >> 3)) & 63);
            const float w = gt * 0.5f * hp * (1.0f + erff(hp * 0.70710678f)) * (1.0f / 32.0f);
#pragma unroll
            for (int i = 0; i < 8; ++i) {
                const float wi = rl(w, 8 * i);
#pragma unroll
                for (int q = 0; q < 4; ++q) {
                    const unsigned vw = vr[i][q];
                    const f32x2 lo = __builtin_amdgcn_cvt_pk_f32_fp8((int)vw, false), hi = __builtin_amdgcn_cvt_pk_f32_fp8((int)vw, true);
                    out[4 * q] += wi * lo[0]; out[4 * q + 1] += wi * lo[1]; out[4 * q + 2] += wi * hi[0]; out[4 * q + 3] += wi * hi[1];
                }
            }
        }
        if (more) { const int tn = t + nw;
            g0n = TOPG[(size_t)tn * 128 + lane]; g1n = TOPG[(size_t)tn * 128 + 64 + lane];
            xan = *(const u32x4*)(hb + (size_t)tn * 1024 + c16); xbn = *(const u32x4*)(hb + (size_t)tn * 1024 + c16 + 8); rsn = rstd_parts(ssq, tn); }
        float ss = 0.f;
        f32x4 hv[4];
#pragma unroll
        for (int q = 0; q < 4; ++q) hv[q] = *(const f32x4*)(hr + 4 * q);
#pragma unroll
        for (int q = 0; q < 4; ++q) {
#pragma unroll
            for (int c = 0; c < 4; ++c) { hv[q][c] += out[4 * q + c]; ss += hv[q][c] * hv[q][c]; }
            if (dost) *(f32x4*)(hr + 4 * q) = hv[q];
        }
        ss = wave_sum(ss);
        if (dost) {
            u32x4 p0, p1;
            p0.x = pack2(hv[0][0], hv[0][1]); p0.y = pack2(hv[0][2], hv[0][3]); p0.z = pack2(hv[1][0], hv[1][1]); p0.w = pack2(hv[1][2], hv[1][3]);
            p1.x = pack2(hv[2][0], hv[2][1]); p1.y = pack2(hv[2][2], hv[2][3]); p1.z = pack2(hv[3][0], hv[3][1]); p1.w = pack2(hv[3][2], hv[3][3]);
            *(u32x4*)(hb + (size_t)t * 1024 + c16) = p0; *(u32x4*)(hb + (size_t)t * 1024 + c16 + 8) = p1;
            if (lane == 0) rstd[t] = rsqrtf(ss * (1.0f / 1024.0f) + 1e-6f);
        }
        e0 = e0n; e1 = e1n; g0 = g0n; g1 = g1n; xa = xan; xb = xbn; rsv = rsn;
    }
#undef PEER_ISSUE_U
#undef PEER_ISSUE_V
}

#ifndef PEER_NCH
#define PEER_NCH 8
#endif
#ifndef PEER_NPW
#define PEER_NPW 3
#endif
DEV void ph_topk_peer(const Args& a, float* lds, const int tid0) {
    const int wv = __builtin_amdgcn_readfirstlane(tid0 >> 6);
    constexpr int CH = T / PEER_NCH;
    const int npeer = gridDim.x * PEER_NPW, ntopk = gridDim.x * (8 - PEER_NPW);
#pragma unroll 1
    for (int s = 0; s <= PEER_NCH; ++s) {
        if (wv < PEER_NPW) {
            if (s >= 1) { const int pw = blockIdx.x * PEER_NPW + wv; ph_peer_pipe<false>(a, tid0, (s - 1) * CH + pw, npeer, (CH - pw + npeer - 1) / npeer); }
        } else {
            if (s < PEER_NCH) { const int tw = blockIdx.x * (8 - PEER_NPW) + (wv - PEER_NPW); ph_topk2(a, lds, tid0, s * CH * (8 / TOPK_NU) + tw, ntopk, (s + 1) * CH * (8 / TOPK_NU)); }
        }
        XcdBarrier b_; b_.bar = (unsigned*)(a.ws + BAR_OFF); b_.x = xb_xcc_id(); b_.st = (volatile LAS unsigned*)(smem_base() + LDS_BYTES - 16);
        xcd_barrier(b_, tid0);
    }
}

typedef float f32x4v __attribute__((ext_vector_type(4)));
#define MFMA16(a, b, c) __builtin_amdgcn_mfma_f32_16x16x32_bf16((a), (b), (c), 0, 0, 0)
namespace sc4 {
constexpr int E_AH = 0, E_RH = 2304, E_BH = 4608, E_KH = 6912, E_BHT = 9216, E_KHT = 12288, E_VT = 15360, E_GC = 18432, E_BYTES = 18688;
constexpr int G_NKAT = 0, G_NBRT = 768, G_NKRT = 1536, G_BYTES = 2304;
constexpr int OFF_E = 0, OFF_G = 6 * E_BYTES, OFF_NBAT = OFF_G + 4 * G_BYTES, OFF_TT = OFF_NBAT + 4 * 1024, OFF_Y = OFF_TT + 4 * 768, TOTAL = OFF_Y + 16384;
}
DEV bf16x8 frag2(u32x2 lo, u32x2 hi) { u32x4 v; v.x = lo.x; v.y = lo.y; v.z = hi.x; v.w = hi.y; return __builtin_bit_cast(bf16x8, v); }
DEV bf16x8 pack_acc(f32x4v p, f32x4v q) { u32x4 v; v.x = pack2(p[0], p[1]); v.y = pack2(p[2], p[3]); v.z = pack2(q[0], q[1]); v.w = pack2(q[2], q[3]); return __builtin_bit_cast(bf16x8, v); }
DEV void ph_scan4(const Args& a, int layer, unsigned char* lb, const int tid0) {
    using namespace sc4;
    static_assert(TOTAL <= LDS_BYTES - 16, "scan LDS map");
    const int lane = tid0 & 63, wv = __builtin_amdgcn_readfirstlane(tid0 >> 6);
    const int r = lane & 15, g = lane >> 4;
    const bf16_t* U = wsb(a, U_OFF); const bf16_t* RS = wsb(a, RS_OFF); const bf16_t* KS = wsb(a, KS_OFF); bf16_t* Uw = wsb(a, U_OFF);
    const bool is_state = wv < 4;
    const int dir = is_state ? (wv >> 1) : ((wv - 4) >> 1), role = wv & 1;
    const bf16_t* Wd = wsb(a, dir ? WB2_OFF : WF_OFF); const bf16_t* Ad = wsb(a, dir ? AB_OFF : AF_OFF);
    const u32x2 z2 = {0u, 0u}; const u32x4 z4 = {0u, 0u, 0u, 0u};
    for (int un = blockIdx.x; un < NSEQ * 8; un += gridDim.x) {
        const int seq = un >> 3, hd = un & 7; const size_t tb = (size_t)seq * 4096; const int cb = hd * 64, pch = cb + lane;
        const float kac = a.rwkv_k_a[layer * 512 + pch];
#define SC4_ISSUE(n_) do { _Pragma("unroll") for (int s_ = 0; s_ < 16; ++s_) { const int step_ = (n_) * 16 + s_, pos_ = dir ? 4095 - step_ : step_; const size_t t_ = tb + pos_; \
            pr[s_][0] = Wd[t_ * 512 + pch]; pr[s_][1] = U[t_ * UW + pch]; pr[s_][2] = Ad[t_ * 512 + pch]; pr[s_][3] = KS[t_ * 512 + pch]; pr[s_][4] = RS[t_ * 512 + pch]; pr[s_][5] = U[t_ * UW + 1536 + pch]; } } while (0)
        __syncthreads();
        if (is_state) {
            f32x4v X[4][2];
#pragma unroll
            for (int m = 0; m < 4; ++m)
#pragma unroll
                for (int vt = 0; vt < 2; ++vt) X[m][vt] = (f32x4v){0.f, 0.f, 0.f, 0.f};
#pragma unroll 1
            for (int p = 0; p < 260; ++p) {
                if (p >= 2 && p < 258) {
                    const int n = p - 2;
                    const unsigned char* E = lb + OFF_E + (dir * 3 + (n % 3)) * E_BYTES;
                    const unsigned char* G = lb + OFF_G + (dir * 2 + (n & 1)) * G_BYTES;
                    float* yb = (float*)(lb + OFF_Y) + (((n & 1) * 2 + dir) * 16) * 64 + 32 * role;
                    bf16x8 fa[2], fr[2];
#pragma unroll
                    for (int s = 0; s < 2; ++s) {
                        fa[s] = frag2(*(const u32x2*)(E + E_AH + r * 144 + 2 * (32 * s + 4 * g)), *(const u32x2*)(E + E_AH + r * 144 + 2 * (32 * s + 16 + 4 * g)));
                        fr[s] = frag2(*(const u32x2*)(E + E_RH + r * 144 + 2 * (32 * s + 4 * g)), *(const u32x2*)(E + E_RH + r * 144 + 2 * (32 * s + 16 + 4 * g)));
                    }
                    const int g1 = g & 1;
                    u32x4 nka = *(const u32x4*)(G + G_NKAT + r * 48 + 16 * g1), nkr = *(const u32x4*)(G + G_NKRT + r * 48 + 16 * g1);
                    if (g >= 2) { nka = z4; nkr = z4; }
                    const bf16x8 fnka = __builtin_bit_cast(bf16x8, nka), fnkr = __builtin_bit_cast(bf16x8, nkr);
                    bf16x8 ftt;
                    {
                        const float* nbat = (const float*)(lb + OFF_NBAT + (dir * 2 + (n & 1)) * 1024);
                        unsigned char* tts = lb + OFF_TT + wv * 768;
                        float Tr[16];
#pragma unroll
                        for (int tg = 0; tg < 4; ++tg) {
                            f32x4v nbq[4][4];
#pragma unroll
                            for (int tt = 0; tt < 4; ++tt)
#pragma unroll
                                for (int i4 = 0; i4 < 4; ++i4) if (4 * i4 < 4 * tg + tt) nbq[tt][i4] = *(const f32x4v*)(nbat + (4 * tg + tt) * 16 + 4 * i4);
#pragma unroll
                            for (int tt = 0; tt < 4; ++tt) {
                                const int t = 4 * tg + tt;
                                float acc = (lane == t) ? 1.0f : 0.f, acc2 = 0.f;
#pragma unroll
                                for (int i = 0; i < t; ++i) { const float pr_ = Tr[i] * nbq[tt][i >> 2][i & 3]; if (i & 1) acc2 += pr_; else acc += pr_; }
                                acc += acc2; Tr[t] = acc;
                                if (lane < 16) *(unsigned short*)(tts + t * 48 + 2 * lane) = (unsigned short)f2bf(acc);
                            }
                        }
                        asm volatile("s_waitcnt lgkmcnt(0)" ::: "memory");
                        ftt = frag2(*(const u32x2*)(tts + r * 48 + 8 * g), z2);
                    }
                    const bf16x8 fnbr = frag2(*(const u32x2*)(G + G_NBRT + r * 48 + 8 * g), z2);
                    bf16x8 fbt[4], fkt[4]; f32x4v gc[4];
#pragma unroll
                    for (int m = 0; m < 4; ++m) {
                        fbt[m] = frag2(*(const u32x2*)(E + E_BHT + (16 * m + r) * 48 + 8 * g), z2);
                        u32x4 kt = *(const u32x4*)(E + E_KHT + (16 * m + r) * 48 + 16 * g1); if (g >= 2) kt = z4; fkt[m] = __builtin_bit_cast(bf16x8, kt);
                        gc[m] = *(const f32x4v*)(E + E_GC + 4 * (16 * m + 4 * g));
                    }
#pragma unroll
                    for (int vt = 0; vt < 2; ++vt) {
                        const int v0 = 32 * role + 16 * vt;
                        u32x4 vv = *(const u32x4*)(E + E_VT + (v0 + r) * 48 + 16 * g1); if (g >= 2) vv = z4;
                        const bf16x8 vb = __builtin_bit_cast(bf16x8, vv);
                        const bf16x8 xb0 = pack_acc(X[0][vt], X[1][vt]), xb1 = pack_acc(X[2][vt], X[3][vt]);
                        f32x4v W = {0.f, 0.f, 0.f, 0.f};
                        W = MFMA16(fa[0], xb0, W); W = MFMA16(fa[1], xb1, W); W = MFMA16(fnka, vb, W);
                        const f32x4v zero4 = {0.f, 0.f, 0.f, 0.f};
                        f32x4v Uc = MFMA16(ftt, pack_acc(W, zero4), zero4);
                        const bf16x8 ub = pack_acc(Uc, zero4);
                        f32x4v Y = {0.f, 0.f, 0.f, 0.f};
                        Y = MFMA16(fr[0], xb0, Y); Y = MFMA16(fr[1], xb1, Y); Y = MFMA16(fnbr, ub, Y); Y = MFMA16(fnkr, vb, Y);
#pragma unroll
                        for (int i = 0; i < 4; ++i) yb[(4 * g + i) * 64 + 16 * vt + r] = Y[i];
#pragma unroll
                        for (int m = 0; m < 4; ++m) { f32x4v xm = MFMA16(fbt[m], ub, X[m][vt]); xm = MFMA16(fkt[m], vb, xm); X[m][vt] = xm * gc[m]; }
                    }
                }
                __syncthreads();
            }
        } else {
            unsigned short prA[8][6], pwA[8], prB[8][6], pwB[8];
#define SC5_ISSUE(pr, pw, n_) do { _Pragma("unroll") for (int s_ = 0; s_ < 8; ++s_) { const int step_ = (n_) * 16 + 8 * role + s_, pos_ = dir ? 4095 - step_ : step_; const size_t t_ = tb + pos_; \
            pr[s_][0] = Wd[t_ * 512 + pch]; pr[s_][1] = U[t_ * UW + pch]; pr[s_][2] = Ad[t_ * 512 + pch]; pr[s_][3] = KS[t_ * 512 + pch]; pr[s_][4] = RS[t_ * 512 + pch]; pr[s_][5] = U[t_ * UW + 1536 + pch]; \
            if (role) { const int st0_ = (n_) * 16 + s_, p0_ = dir ? 4095 - st0_ : st0_; pw[s_] = Wd[(tb + p0_) * 512 + pch]; } } } while (0)
            SC5_ISSUE(prA, pwA, 0); SC5_ISSUE(prB, pwB, 1);
#define SC5_PERIOD(pr, pw, p_) do { const int p = (p_); \
                if (p < 256) { \
                    unsigned char* E = lb + OFF_E + (dir * 3 + (p % 3)) * E_BYTES; \
                    float gcur = 1.0f; \
                    if (role) { \
_Pragma("unroll") \
                        for (int s = 0; s < 8; ++s) gcur *= bf2f(pw[s]); \
                    } \
                    unsigned bt[4], kt[4], vtw[4]; \
_Pragma("unroll") \
                    for (int s = 0; s < 8; ++s) { \
                        const int st = 8 * role + s; \
                        const float w_ = bf2f(pr[s][0]), kk_ = bf2f(pr[s][1]), ic_ = bf2f(pr[s][2]), ks_ = bf2f(pr[s][3]), r_ = bf2f(pr[s][4]); \
                        const float gprev = gcur; gcur *= w_; \
                        const float ig = __builtin_amdgcn_rcpf(gcur); \
                        const unsigned ah = f2bf(-gprev * kk_), bh = f2bf(kk_ * ic_ * ig), kh = f2bf(ks_ * (1.0f + (ic_ - 1.0f) * kac) * ig), rh = f2bf(gcur * r_), vh = pr[s][5]; \
                        *(unsigned short*)(E + E_AH + st * 144 + 2 * lane) = (unsigned short)ah; *(unsigned short*)(E + E_RH + st * 144 + 2 * lane) = (unsigned short)rh; \
                        *(unsigned short*)(E + E_BH + st * 144 + 2 * lane) = (unsigned short)bh; *(unsigned short*)(E + E_KH + st * 144 + 2 * lane) = (unsigned short)kh; \
                        if (s & 1) { bt[s >> 1] |= bh << 16; kt[s >> 1] |= kh << 16; vtw[s >> 1] |= vh << 16; } else { bt[s >> 1] = bh; kt[s >> 1] = kh; vtw[s >> 1] = vh; } \
                    } \
                    *(u32x4*)(E + E_BHT + lane * 48 + 16 * role) = (u32x4){bt[0], bt[1], bt[2], bt[3]}; \
                    *(u32x4*)(E + E_KHT + lane * 48 + 16 * role) = (u32x4){kt[0], kt[1], kt[2], kt[3]}; \
                    *(u32x4*)(E + E_VT + lane * 48 + 16 * role) = (u32x4){vtw[0], vtw[1], vtw[2], vtw[3]}; \
                    if (role) *(float*)(E + E_GC + 4 * lane) = gcur; \
                } \
                if (role == 0) { \
                    if (p >= 1 && p < 257) { \
                        const int n = p - 1; \
                        const unsigned char* E = lb + OFF_E + (dir * 3 + (n % 3)) * E_BYTES; \
                        unsigned char* G = lb + OFF_G + (dir * 2 + (n & 1)) * G_BYTES; \
                        float* nbat = (float*)(lb + OFF_NBAT + (dir * 2 + (n & 1)) * 1024); \
                        bf16x8 ab[2], rb[2], bA[2], kA[2]; \
_Pragma("unroll") \
                        for (int s = 0; s < 2; ++s) { \
                            ab[s] = *(const bf16x8*)(E + E_AH + r * 144 + 2 * (32 * s + 8 * g)); rb[s] = *(const bf16x8*)(E + E_RH + r * 144 + 2 * (32 * s + 8 * g)); \
                            bA[s] = *(const bf16x8*)(E + E_BH + r * 144 + 2 * (32 * s + 8 * g)); kA[s] = *(const bf16x8*)(E + E_KH + r * 144 + 2 * (32 * s + 8 * g)); \
                        } \
                        const f32x4v zero4 = {0.f, 0.f, 0.f, 0.f}; \
                        f32x4v nba = MFMA16(bA[1], ab[1], MFMA16(bA[0], ab[0], zero4)), nka = MFMA16(kA[1], ab[1], MFMA16(kA[0], ab[0], zero4)); \
                        f32x4v nbr = MFMA16(bA[1], rb[1], MFMA16(bA[0], rb[0], zero4)), nkr = MFMA16(kA[1], rb[1], MFMA16(kA[0], rb[0], zero4)); \
_Pragma("unroll") \
                        for (int i = 0; i < 4; ++i) { const int j = 4 * g + i; if (j >= r) { nba[i] = 0.f; nka[i] = 0.f; } if (j > r) { nbr[i] = 0.f; nkr[i] = 0.f; } } \
                        *(f32x4v*)(nbat + r * 16 + 4 * g) = nba; \
                        u32x2 pk; pk.x = pack2(nka[0], nka[1]); pk.y = pack2(nka[2], nka[3]); *(u32x2*)(G + G_NKAT + r * 48 + 8 * g) = pk; \
                        pk.x = pack2(nbr[0], nbr[1]); pk.y = pack2(nbr[2], nbr[3]); *(u32x2*)(G + G_NBRT + r * 48 + 8 * g) = pk; \
                        pk.x = pack2(nkr[0], nkr[1]); pk.y = pack2(nkr[2], nkr[3]); *(u32x2*)(G + G_NKRT + r * 48 + 8 * g) = pk; \
                    } \
                } else { \
                    if (p >= 3 && p < 259) { \
                        const int n = p - 3; \
                        const float* yb = (const float*)(lb + OFF_Y) + (((n & 1) * 2 + dir) * 16) * 64; \
                        const int s2 = lane >> 2, c16 = (lane & 3) * 16; \
                        const f32x4v y0 = *(const f32x4v*)(yb + s2 * 64 + c16), y1 = *(const f32x4v*)(yb + s2 * 64 + c16 + 4), y2 = *(const f32x4v*)(yb + s2 * 64 + c16 + 8), y3 = *(const f32x4v*)(yb + s2 * 64 + c16 + 12); \
                        const int step = n * 16 + s2, pos = dir ? 4095 - step : step; \
                        u32x4 o0, o1; o0.x = pack2(y0[0], y0[1]); o0.y = pack2(y0[2], y0[3]); o0.z = pack2(y1[0], y1[1]); o0.w = pack2(y1[2], y1[3]); \
                        o1.x = pack2(y2[0], y2[1]); o1.y = pack2(y2[2], y2[3]); o1.z = pack2(y3[0], y3[1]); o1.w = pack2(y3[2], y3[3]); \
                        bf16_t* dst = Uw + (tb + pos) * UW + 512 + 512 * dir + cb + c16; \
                        *(u32x4*)(dst) = o0; *(u32x4*)(dst + 8) = o1; \
                    } \
                } \
                if (p + 2 < 256) SC5_ISSUE(pr, pw, p + 2); \
                __syncthreads(); \
            } while (0)
#pragma unroll 1
            for (int p2 = 0; p2 < 260; p2 += 2) { SC5_PERIOD(prA, pwA, p2); SC5_PERIOD(prB, pwB, p2 + 1); }
#undef SC5_PERIOD
#undef SC5_ISSUE
        }
#undef SC4_ISSUE
    }
}

extern __shared__ __attribute__((aligned(16))) unsigned char smem[];

enum { PH_PROLOGUE = 0, PH_ROWPREP_X, PH_ROWPREP, PH_GEMM1, PH_ATTN, PH_ATTNX, PH_MERGE, PH_LORA, PH_PREP2, PH_SCAN, PH_POST, PH_GEMM2, PH_CONVERT, PH_GEMM3, PH_TOPK, PH_PEER, PH_PEERDRY, PH_TOPKPEER, PH_GEMM4A, PH_GEMM4B, PH_FINAL };

template <int PH> DEV void run_phase(const Args& a, int layer, const int tid0) {
    float* ldsf = (float*)smem;
    PG8_LAS unsigned char* ldsg = (PG8_LAS unsigned char*)smem;
    const bf16_t* wb = wsb(a, WB_OFF + (size_t)layer * WB_LAYER);
    if constexpr (PH == PH_PROLOGUE) ph_prologue(a, ldsf, tid0);
    else if constexpr (PH == PH_ROWPREP_X) ph_rowprep(a, true, tid0);
    else if constexpr (PH == PH_ROWPREP) ph_rowprep(a, false, tid0);
    else if constexpr (PH == PH_GEMM1) {
        pg8::Gemm g{wsb(a, HB_OFF), wb + WB_IN / 2, T, INP, 1024};
        pg8::StaticOrder S; S.init(T, INP, gridDim.x, blockIdx.x);
        pg8::EpiProj E{wsb(a, QKV_OFF), wsb(a, U_OFF), wsf(a, SSQ_OFF), wsf(a, ROPEC_OFF), wsf(a, ROPES_OFF)};
        pg8::gemm_phase<pg8::EpiProj, pg8::StaticOrder, false>(ldsg, g, S, E, nullptr, tid0);
    }
    else if constexpr (PH == PH_ATTN) ph_attn2<0>(a, smem, tid0);
    else if constexpr (PH == PH_ATTNX) ph_attn2<ATTN_VAR>(a, smem, tid0);
    else if constexpr (PH == PH_MERGE) ph_attn_merge(a, layer, tid0);
    else if constexpr (PH == PH_LORA) ph_rwkv_prep1(a, layer, smem, tid0);
    else if constexpr (PH == PH_PREP2) ph_rwkv_prep2(a, layer, tid0);
    else if constexpr (PH == PH_SCAN) ph_scan4(a, layer, smem, tid0);
    else if constexpr (PH == PH_POST) ph_post2(a, layer, tid0);
    else if constexpr (PH == PH_GEMM2) {
        pg8::Gemm g{wsb(a, MIX_OFF), wb + WB_OUT / 2, T, 1024, 1024};
        pg8::StaticOrder S; S.init(T, 1024, gridDim.x, blockIdx.x);
        pg8::EpiF32x<1> E{a.h, 1024, nullptr, wsb(a, HB_OFF), wsf(a, SSQ_OFF)};
        pg8::gemm_phase<pg8::EpiF32x<1>, pg8::StaticOrder, false>(ldsg, g, S, E, nullptr, tid0);
    }
    else if constexpr (PH == PH_CONVERT) ph_convert8(a, layer, tid0);
    else if constexpr (PH == PH_GEMM3) {
        pg8::Gemm g{wsb(a, HB_OFF), wb + WB_QK / 2, T, 2048, 1024};
        pg8::StaticOrder S; S.init(T, 2048, gridDim.x, blockIdx.x);
        pg8::EpiF32x<0> E{wsf(a, SC_OFF), 2048, nullptr, nullptr, nullptr};
        pg8::gemm_phase<pg8::EpiF32x<0>, pg8::StaticOrder, false>(ldsg, g, S, E, nullptr, tid0);
    }
    else if constexpr (PH == PH_TOPK) ph_topk2(a, ldsf, tid0, blockIdx.x * 8 + (tid0 >> 6), gridDim.x * 8, T * (8 / TOPK_NU));
    else if constexpr (PH == PH_TOPKPEER) ph_topk_peer(a, ldsf, tid0);
    else if constexpr (PH == PH_PEER) ph_peer_pipe<false>(a, tid0, blockIdx.x * 8 + (tid0 >> 6), gridDim.x * 8, T / (gridDim.x * 8));
    else if constexpr (PH == PH_PEERDRY) ph_peer_pipe<true>(a, tid0, blockIdx.x * 8 + (tid0 >> 6), gridDim.x * 8, T / (gridDim.x * 8));
    else if constexpr (PH == PH_GEMM4A) {
        pg8::Gemm g{wsb(a, HB_OFF), wb + WB_GATE / 2, T, 1024, 1024};
        pg8::StaticOrder S; S.init(T, 1024, gridDim.x, blockIdx.x);
        pg8::EpiGate E{wsb(a, GATE_OFF), wsf(a, RSTD_OFF), a.ple_b_gate + layer * 1024};
        pg8::gemm_phase<pg8::EpiGate, pg8::StaticOrder, false>(ldsg, g, S, E, nullptr, tid0);
    }
    else if constexpr (PH == PH_GEMM4B) {
        pg8::Gemm g{wsb(a, PB_OFF), wb + WB_PROJ / 2, T, 1024, 256};
        pg8::StaticOrder S; S.init(T, 1024, gridDim.x, blockIdx.x);
        pg8::EpiF32x<2> E{a.h, 1024, wsb(a, GATE_OFF), wsb(a, HB_OFF), wsf(a, SSQ_OFF)};
        pg8::gemm_phase<pg8::EpiF32x<2>, pg8::StaticOrder, false>(ldsg, g, S, E, nullptr, tid0);
    }
    else if constexpr (PH == PH_FINAL) ph_final(a, tid0);
}

#if !ONE_LAUNCH
template <int PH> __global__ void __launch_bounds__(NTHR, 2) k_phase(Args a, int layer) { run_phase<PH>(a, layer, (int)threadIdx.x); }
#endif

#if ONE_LAUNCH
#ifndef REP_PEER
#define REP_PEER 1
#endif
#ifndef REP_SCAN
#define REP_SCAN 1
#endif
#ifndef REP_TOPK
#define REP_TOPK 1
#endif
#ifndef REP_GEMM1
#define REP_GEMM1 1
#endif
#ifndef REP_LORA
#define REP_LORA 1
#endif
#ifndef REP_POST
#define REP_POST 1
#endif
#ifndef REP_ATTN
#define REP_ATTN 1
#endif
#ifndef REP_GEMM3
#define REP_GEMM3 1
#endif
typedef const __attribute__((address_space(4))) unsigned long long* kargs_t;
static_assert(sizeof(Args) == 31 * 8, "Args is 31 pointers, no padding");
#define AS1 __attribute__((address_space(1)))
DEV Args load_args(kargs_t kp) {
    Args r; const float** d = (const float**)&r;
#pragma unroll
    for (int i = 0; i < 29; ++i) d[i] = (const float*)(AS1 const float*)kp[i];
    r.h = (float*)(AS1 float*)kp[29]; r.ws = (unsigned char*)(AS1 unsigned char*)kp[30];
    return r; }
#define RUN(PH, layer) do { kargs_t kp_ = (kargs_t)__builtin_amdgcn_kernarg_segment_ptr(); asm volatile("" : "+s"(kp_)); const Args la_ = load_args(kp_); int t_; asm volatile("v_mbcnt_lo_u32_b32 %0, -1, 0\n\tv_mbcnt_hi_u32_b32 %0, -1, %0\n\tv_lshl_add_u32 %0, %1, 6, %0" : "=&v"(t_) : "s"(wv0_)); run_phase<PH>(la_, layer, t_); } while (0)
#define BAR() do { kargs_t kp_ = (kargs_t)__builtin_amdgcn_kernarg_segment_ptr(); asm volatile("" : "+s"(kp_)); XcdBarrier b_; b_.bar = (unsigned*)((unsigned char*)kp_[30] + BAR_OFF); b_.x = xb_xcc_id(); b_.st = (volatile LAS unsigned*)(smem + LDS_BYTES - 16); int t_; asm volatile("v_mbcnt_lo_u32_b32 %0, -1, 0\n\tv_mbcnt_hi_u32_b32 %0, -1, %0\n\tv_lshl_add_u32 %0, %1, 6, %0" : "=&v"(t_) : "s"(wv0_)); xcd_barrier(b_, t_); } while (0)
#define LAYER_BODY(layer) do { \
        for (int rep_ = 0; rep_ < REP_GEMM1; ++rep_) { RUN(PH_GEMM1, layer); BAR(); } \
        if (REP_ATTNX) { RUN(PH_ATTNX, layer); BAR(); } \
        if (REP_MERGE) { RUN(PH_MERGE, layer); BAR(); } \
        for (int rep_ = 0; rep_ < REP_ATTN; ++rep_) { RUN(PH_ATTN, layer); BAR(); RUN(PH_MERGE, layer); BAR(); } \
        for (int rep_ = 0; rep_ < REP_LORA; ++rep_) { RUN(PH_LORA, layer); BAR(); } \
        RUN(PH_PREP2, layer); BAR(); \
        for (int rep_ = 0; rep_ < REP_SCAN; ++rep_) { RUN(PH_SCAN, layer); BAR(); } \
        for (int rep_ = 0; rep_ < REP_POST; ++rep_) { RUN(PH_POST, layer); BAR(); } \
        RUN(PH_GEMM2, layer); BAR(); \
        RUN(PH_CONVERT, layer); BAR(); \
        for (int rep_ = 0; rep_ < REP_GEMM3; ++rep_) { RUN(PH_GEMM3, layer); BAR(); } \
        RUN(PH_TOPKPEER, layer); \
        RUN(PH_GEMM4A, layer); BAR(); \
        RUN(PH_GEMM4B, layer); BAR(); \
    } while (0)
__global__ void __launch_bounds__(NTHR, 2) k_mega(Args a) {
    if (threadIdx.x == 0) *(uint4*)(smem + LDS_BYTES - 16) = make_uint4(0u, 0u, 0u, 0u);
    __syncthreads();
    (void)xcd_barrier_post((unsigned*)(a.ws + BAR_OFF), (volatile LAS unsigned*)(smem + LDS_BYTES - 16));
    const int wv0_ = __builtin_amdgcn_readfirstlane((int)threadIdx.x >> 6);
    RUN(PH_PROLOGUE, 0);
    RUN(PH_ROWPREP_X, 0); BAR();
    LAYER_BODY(0); LAYER_BODY(1); LAYER_BODY(2); LAYER_BODY(3);
    RUN(PH_FINAL, 0);
}
#endif

#if !ONE_LAUNCH
template <int PH> static void launch_phase(const Args& a, int layer, hipStream_t st) {
    static bool attr = false;
    if (!attr) { (void)hipFuncSetAttribute((const void*)k_phase<PH>, hipFuncAttributeMaxDynamicSharedMemorySize, LDS_BYTES); attr = true; }
    hipLaunchKernelGGL(k_phase<PH>, dim3(NWG), dim3(NTHR), LDS_BYTES, st, a, layer);
}
#endif

extern "C" void kernel_launch(void* const* d_in, const int* in_sizes, int n_in, void* d_out, int out_size, void* d_ws, size_t ws_size, hipStream_t stream) {
    if (n_in != 29 || out_size != T * D || ws_size < WS_END) {
        fprintf(stderr, "kernel_launch: unexpected shapes (n_in %d, out %d, ws %zu, need %zu); nothing launched\n", n_in, out_size, ws_size, (size_t)WS_END);
        return;
    }
    Args a{};
    const float** ap = (const float**)&a;
    for (int i = 0; i < 29; ++i) ap[i] = (const float*)d_in[i];
    a.h = (float*)d_out; a.ws = (unsigned char*)d_ws;
#if ONE_LAUNCH
    static bool attr = false;
    if (!attr) { (void)hipFuncSetAttribute((const void*)k_mega, hipFuncAttributeMaxDynamicSharedMemorySize, LDS_BYTES); attr = true; }
    (void)hipMemsetAsync((char*)d_ws + BAR_OFF, 0, XCD_BAR_WORDS * sizeof(unsigned), stream);
    hipLaunchKernelGGL(k_mega, dim3(NWG), dim3(NTHR), LDS_BYTES, stream, a);
#else
    launch_phase<PH_PROLOGUE>(a, 0, stream);
    launch_phase<PH_ROWPREP_X>(a, 0, stream);
    for (int layer = 0; layer < NL; ++layer) {
        if (layer > 0) launch_phase<PH_ROWPREP>(a, layer, stream);
        launch_phase<PH_GEMM1>(a, layer, stream);
        launch_phase<PH_ATTN>(a, layer, stream);
        launch_phase<PH_MERGE>(a, layer, stream);
        launch_phase<PH_LORA>(a, layer, stream);
        launch_phase<PH_PREP2>(a, layer, stream);
        launch_phase<PH_SCAN>(a, layer, stream);
        launch_phase<PH_POST>(a, layer, stream);
        launch_phase<PH_GEMM2>(a, layer, stream);
        launch_phase<PH_ROWPREP>(a, layer, stream);
        launch_phase<PH_CONVERT>(a, layer, stream);
        launch_phase<PH_GEMM3>(a, layer, stream);
        launch_phase<PH_TOPK>(a, layer, stream);
        launch_phase<PH_PEER>(a, layer, stream);
        launch_phase<PH_GEMM4A>(a, layer, stream);
        launch_phase<PH_GEMM4B>(a, layer, stream);
    }
    launch_phase<PH_FINAL>(a, 0, stream);
#endif
}
```

```cpp
#include <hip/hip_runtime.h>
#include <stdint.h>
#include <stdio.h>

#ifndef ONE_LAUNCH
#define ONE_LAUNCH 1
#endif

#ifndef REP_PREP2
#define REP_PREP2 1
#endif
#ifndef REP_CONVERT
#define REP_CONVERT 1
#endif
#ifndef REP_GEMM4A
#define REP_GEMM4A 1
#endif
#ifndef REP_ATTNX
#define REP_ATTNX 0
#endif
#ifndef REP_MERGE
#define REP_MERGE 0
#endif
#ifndef ATTN_VAR
#define ATTN_VAR 0
#endif

typedef unsigned short bf16_t;
typedef float f32x4 __attribute__((ext_vector_type(4)));
typedef float f32x2 __attribute__((ext_vector_type(2)));
typedef unsigned u32x4 __attribute__((ext_vector_type(4)));
typedef unsigned u32x2 __attribute__((ext_vector_type(2)));
typedef __bf16 bf16x2_t __attribute__((ext_vector_type(2)));

#define DEV __device__ __forceinline__

namespace cfg {
constexpr int NSEQ = 20, SEQ = 4096, T = NSEQ * SEQ, TP = 4 * SEQ, D = 1024, NL = 4;
constexpr int INC = 3456, INP = 3584;
constexpr int QKVW = 1536, UW = 2048, UC = 1920;
constexpr int NWG = 256, NTHR = 512;
constexpr int LDS_BYTES = 163840;
constexpr size_t MiB = 1ull << 20;
constexpr size_t WB_OFF = 0;
constexpr size_t WB_LAYER = 16 * MiB;
constexpr size_t WB_IN = 0, WB_OUT = 7 * MiB, WB_QK = 9 * MiB, WB_GATE = 13 * MiB, WB_PROJ = 15 * MiB, WB_LORA = 15 * MiB + 512 * 1024;
constexpr size_t HB_OFF = 64 * MiB;
constexpr size_t MIX_OFF = 224 * MiB;
constexpr size_t SMALL_OFF = 384 * MiB;
constexpr size_t RSTD_OFF = SMALL_OFF;
constexpr size_t ROPEC_OFF = SMALL_OFF + 512 * 1024, ROPES_OFF = SMALL_OFF + 640 * 1024;
constexpr size_t BAR_OFF = SMALL_OFF + 1 * MiB;
constexpr size_t BIG_OFF = 386 * MiB;
constexpr size_t QKV_OFF = BIG_OFF;
constexpr size_t RS_OFF = BIG_OFF, KS_OFF = BIG_OFF + 80 * MiB, G_OFF = BIG_OFF + 160 * MiB;
constexpr size_t U_OFF = BIG_OFF + 240 * MiB;
constexpr size_t WF_OFF = BIG_OFF + 560 * MiB, WB2_OFF = BIG_OFF + 640 * MiB, AF_OFF = BIG_OFF + 720 * MiB, AB_OFF = BIG_OFF + 800 * MiB;
constexpr size_t OP_OFF = BIG_OFF + 560 * MiB;
constexpr size_t ML_OFF = BIG_OFF + 800 * MiB;
constexpr size_t SC_OFF = BIG_OFF;
constexpr size_t TOPI_OFF = BIG_OFF + 640 * MiB, TOPG_OFF = BIG_OFF + 680 * MiB;
constexpr size_t PTU_OFF = BIG_OFF + 720 * MiB, PTV_OFF = BIG_OFF + 752 * MiB;
constexpr size_t PB_OFF = BIG_OFF + 784 * MiB;
constexpr size_t GATE_OFF = BIG_OFF;
constexpr size_t SSQ_OFF = BIG_OFF + 880 * MiB;
constexpr size_t WS_END = BIG_OFF + 886 * MiB;
}
using namespace cfg;

struct Args {
    const float* x_prompt; const float* x_sample; const float* p_prompt; const float* p_sample;
    const float* norm_mix_g; const float* w_in; const float* att_norm_g; const float* rwkv_shift;
    const float* rwkv_w0; const float* rwkv_w2; const float* rwkv_a0; const float* rwkv_a2; const float* rwkv_g2;
    const float* rwkv_k_k; const float* rwkv_k_a; const float* rwkv_r_k; const float* rwkv_ln_w; const float* rwkv_ln_b;
    const float* w_out; const float* norm_ffn_g; const float* peer_w_q; const float* peer_sub_keys; const float* peer_u; const float* peer_v;
    const float* ple_norm_g; const float* ple_w_gate; const float* ple_b_gate; const float* ple_w_proj; const float* final_norm_g;
    float* h;
    unsigned char* ws;
};

DEV int tid_() { int t = threadIdx.x; asm volatile("" : "+v"(t)); return t; }
DEV float bf2f(unsigned h) { return __uint_as_float(h << 16); }
DEV float bflo(unsigned d) { return __uint_as_float(d << 16); }
DEV float bfhi(unsigned d) { return __uint_as_float(d & 0xffff0000u); }
DEV unsigned pack2(float lo, float hi) { const f32x2 v = {lo, hi}; return __builtin_bit_cast(unsigned, __builtin_convertvector(v, bf16x2_t)); }
DEV unsigned f2bf(float f) { return pack2(f, 0.f) & 0xffffu; }
DEV float dot2bf(unsigned a, unsigned b, float c) { return __builtin_amdgcn_fdot2_f32_bf16(__builtin_bit_cast(bf16x2_t, a), __builtin_bit_cast(bf16x2_t, b), c, false); }
DEV float shx_(float v, int lane, int o) { return __int_as_float(__builtin_amdgcn_ds_bpermute((lane ^ o) << 2, __float_as_int(v))); }
DEV float shf_(float v, int src) { return __int_as_float(__builtin_amdgcn_ds_bpermute(src << 2, __float_as_int(v))); }
DEV int shf_(int v, int src) { return __builtin_amdgcn_ds_bpermute(src << 2, v); }
#define SHX(v, o) shx_((v), lane, (o))
#define SHF(v, src) shf_((v), (src))
DEV float wave_sum_(float v, int lane) {
#pragma unroll
    for (int o = 32; o > 0; o >>= 1) v += shx_(v, lane, o);
    return v;
}
DEV float wave_max_(float v, int lane) {
#pragma unroll
    for (int o = 32; o > 0; o >>= 1) v = fmaxf(v, shx_(v, lane, o));
    return v;
}
#define wave_sum(x) wave_sum_((x), lane)
#define wave_max(x) wave_max_((x), lane)
DEV float sum8(float v) {
    v += __int_as_float(__builtin_amdgcn_mov_dpp(__float_as_int(v), 0xB1, 0xF, 0xF, true));
    v += __int_as_float(__builtin_amdgcn_mov_dpp(__float_as_int(v), 0x4E, 0xF, 0xF, true));
    v += __int_as_float(__builtin_amdgcn_mov_dpp(__float_as_int(v), 0x141, 0xF, 0xF, true));
    return v;
}
DEV float rstd_parts(const float* ssq, int t) { const f32x4* p = (const f32x4*)(ssq + (size_t)t * 16); const f32x4 a = p[0], b = p[1], c = p[2], d = p[3];
    const float s = ((a[0] + a[1]) + (a[2] + a[3])) + ((b[0] + b[1]) + (b[2] + b[3])) + ((c[0] + c[1]) + (c[2] + c[3])) + ((d[0] + d[1]) + (d[2] + d[3]));
    return rsqrtf(s * (1.0f / 1024.0f) + 1e-6f); }
DEV float sigmoidf_(float x) { return 1.0f / (1.0f + __expf(-x)); }
namespace pg8 {
#define PG8_LAS __attribute__((address_space(3)))
typedef unsigned short bf16_t;
typedef short bf16x8 __attribute__((ext_vector_type(8)));
typedef float f32x4 __attribute__((ext_vector_type(4)));
typedef unsigned u32x4 __attribute__((ext_vector_type(4)));
constexpr int BM = 256, BK = 64, HALF = 128, HTB = HALF * BK * 2  , STAGE_BYTES = 8 * HTB, NXCD = 8, WGM = 8;

__host__ __device__ __forceinline__ int lds_byte(int r, int c) { const int st = (r >> 4) * 2 + (c >> 5), rr = r & 15, cc = c & 31, ob = rr * 64 + cc * 2; return st * 1024 + (ob ^ (((ob >> 9) & 1) << 5)); }
__host__ __device__ __forceinline__ void stage_rc(int b, int& R, int& C) { const int st = b / 1024, sb = b % 1024, swz = sb ^ (((sb >> 9) & 1) << 5); R = (st >> 1) * 16 + swz / 64; C = (st & 1) * 32 + (swz % 64) / 2; }
__host__ __device__ __forceinline__ int perm32(int rho) { const int n = rho >> 4, i = rho & 15; return 8 * (i >> 2) + 4 * n + (i & 3); }

struct Unit { int pm, pn; };
struct Gemm { const bf16_t* A; const bf16_t* Bt; int M, N, K; };

struct StaticOrder {
    int nM, nN, nwg, G, c;
    __host__ __device__ void init(int M, int N, int G_, int c_) { nM = M / BM; nN = N / BM; nwg = nM * nN; G = G_; c = c_; }
    __host__ __device__ bool next(int i, Unit& u) const {
        const long L = (long)i * G + c; if (L >= nwg) return false;
        int wgid = (int)L; { const int q = nwg / NXCD, r = nwg % NXCD, xcd = wgid % NXCD, off = wgid / NXCD; wgid = (xcd < r ? xcd * (q + 1) : r * (q + 1) + (xcd - r) * q) + off; }
        const int nig = WGM * nN, gid = wgid / nig, fm = gid * WGM, gsz = (nM - fm) < WGM ? (nM - fm) : WGM;
        u.pm = fm + ((wgid % nig) % gsz); u.pn = (wgid % nig) / gsz; return true;
    }
    __device__ __forceinline__ void a_ready(const Unit&) const {}
    __device__ __forceinline__ void done(const Unit&) const {}
};
__device__ __forceinline__ unsigned cvt_pk_bf16(float lo, float hi) { unsigned r; asm volatile("v_cvt_pk_bf16_f32 %0, %1, %2" : "=v"(r) : "v"(lo), "v"(hi)); return r; }

struct EpiProj {
    static constexpr bool PERM = true, AFTER_DRAIN = false;
    bf16_t* qkv; bf16_t* u; const float* ssq; const float* rc; const float* rs;
    __device__ __forceinline__ void operator()(const f32x4 (&acc)[2][2][4][2], const Unit& un, int wr, int wc, int fr, int fq) const {
        const int row0 = un.pm * BM + wr * 64 + fr, lane = fr + 16 * fq;
        const bool isq = un.pn < 6;
        bf16_t* base = isq ? qkv : u; const int ld = isq ? 1536 : 2048; const int colt = isq ? un.pn * BM : (un.pn - 6) * BM;
        const int col0 = colt + wc * 32 + 8 * fq;
        const bool rope = (un.pn < 4) && ((wc & 1) == 0);
        f32x4 pq[2][4];
#pragma unroll
        for (int ai = 0; ai < 2; ++ai)
#pragma unroll
            for (int m = 0; m < 4; ++m) pq[ai][m] = *(const f32x4*)(ssq + (size_t)(row0 + ai * HALF + m * 16) * 16 + 4 * fq);
        float rsd[2][4];
#pragma unroll
        for (int ai = 0; ai < 2; ++ai)
#pragma unroll
            for (int m = 0; m < 4; ++m) { float t = (pq[ai][m][0] + pq[ai][m][1]) + (pq[ai][m][2] + pq[ai][m][3]); t += SHX(t, 16); t += SHX(t, 32); rsd[ai][m] = rsqrtf(t * (1.0f / 1024.0f) + 1e-6f); }
#pragma unroll
        for (int ai = 0; ai < 2; ++ai)
#pragma unroll
            for (int m = 0; m < 4; ++m) {
                const int row = row0 + ai * HALF + m * 16; const float s = rsd[ai][m]; const int pos = row & 4095;
                f32x4 c0 = {1.f, 1.f, 1.f, 1.f}, c1 = c0, s0 = {0.f, 0.f, 0.f, 0.f}, s1 = s0;
                if (rope) { c0 = *(const f32x4*)(rc + pos * 8); c1 = *(const f32x4*)(rc + pos * 8 + 4); s0 = *(const f32x4*)(rs + pos * 8); s1 = *(const f32x4*)(rs + pos * 8 + 4); }
                bf16_t* rowp = base + (size_t)row * ld + col0;
#pragma unroll
                for (int bj = 0; bj < 2; ++bj) {
                    f32x4 v0 = acc[ai][bj][m][0] * s, v1 = acc[ai][bj][m][1] * s;
                    if (rope) {
                        f32x4 o0, o1;
#pragma unroll
                        for (int c = 0; c < 4; ++c) { o0[c] = SHX(v0[c], 16); o1[c] = SHX(v1[c], 16); }
                        if (fq == 0) { v0 = v0 * c0 - o0 * s0; v1 = v1 * c1 - o1 * s1; }
                        else if (fq == 1) { v0 = v0 * c0 + o0 * s0; v1 = v1 * c1 + o1 * s1; }
                    }
                    u32x4 w; w.x = cvt_pk_bf16(v0[0], v0[1]); w.y = cvt_pk_bf16(v0[2], v0[3]); w.z = cvt_pk_bf16(v1[0], v1[1]); w.w = cvt_pk_bf16(v1[2], v1[3]);
                    *(u32x4*)(rowp + bj * HALF) = w;
                }
            }
    }
};
template <int MODE> struct EpiF32x {
    static constexpr bool PERM = true, AFTER_DRAIN = false;
    float* C; int ldc; const bf16_t* gate; bf16_t* hb; float* ssq;
    __device__ __forceinline__ void operator()(const f32x4 (&acc)[2][2][4][2], const Unit& un, int wr, int wc, int fr, int fq) const {
        const int row0 = un.pm * BM + wr * 64 + fr, col0 = un.pn * BM + wc * 32 + 8 * fq, lane = fr + 16 * fq;
#pragma unroll
        for (int ai = 0; ai < 2; ++ai)
#pragma unroll
            for (int m = 0; m < 4; ++m) {
                const int row = row0 + ai * HALF + m * 16;
                const size_t ro = (size_t)row * ldc + col0;
                if (MODE != 0) asm volatile("" ::: "memory");
                float ss = 0.f;
#pragma unroll
                for (int bj = 0; bj < 2; ++bj) {
                    if (MODE == 2 && bj) asm volatile("" ::: "memory");
                    f32x4* p = (f32x4*)(C + ro + bj * HALF);
                    if (MODE == 0) { p[0] = acc[ai][bj][m][0]; p[1] = acc[ai][bj][m][1]; }
                    else {
                        f32x4 v0, v1;
                        if (MODE == 1) { v0 = p[0] + acc[ai][bj][m][0]; v1 = p[1] + acc[ai][bj][m][1]; }
                        else { const u32x4 g = *(const u32x4*)(gate + ro + bj * HALF);
                               f32x4 g0, g1; g0[0] = __uint_as_float(g.x << 16); g0[1] = __uint_as_float(g.x & 0xffff0000u); g0[2] = __uint_as_float(g.y << 16); g0[3] = __uint_as_float(g.y & 0xffff0000u);
                               g1[0] = __uint_as_float(g.z << 16); g1[1] = __uint_as_float(g.z & 0xffff0000u); g1[2] = __uint_as_float(g.w << 16); g1[3] = __uint_as_float(g.w & 0xffff0000u);
                               v0 = p[0] + g0 * acc[ai][bj][m][0]; v1 = p[1] + g1 * acc[ai][bj][m][1]; }
                        p[0] = v0; p[1] = v1;
                        ss += ((v0[0] * v0[0] + v0[1] * v0[1]) + (v0[2] * v0[2] + v0[3] * v0[3])) + ((v1[0] * v1[0] + v1[1] * v1[1]) + (v1[2] * v1[2] + v1[3] * v1[3]));
                        u32x4 pk; pk.x = cvt_pk_bf16(v0[0], v0[1]); pk.y = cvt_pk_bf16(v0[2], v0[3]); pk.z = cvt_pk_bf16(v1[0], v1[1]); pk.w = cvt_pk_bf16(v1[2], v1[3]);
                        *(u32x4*)(hb + ro + bj * HALF) = pk;
                    }
                }
                if (MODE != 0) {
                    ss += SHX(ss, 16); ss += SHX(ss, 32);
                    if (fq == 0) ssq[(size_t)row * 16 + un.pn * 4 + wc] = ss;
                }
            }
    }
};
struct EpiGate {
    static constexpr bool PERM = true, AFTER_DRAIN = false;
    bf16_t* O; const float* rstd; const float* bias;
    __device__ __forceinline__ void operator()(const f32x4 (&acc)[2][2][4][2], const Unit& un, int wr, int wc, int fr, int fq) const {
        const int row0 = un.pm * BM + wr * 64 + fr, col0 = un.pn * BM + wc * 32 + 8 * fq;
        f32x4 bv[2][2];
#pragma unroll
        for (int bj = 0; bj < 2; ++bj)
#pragma unroll
            for (int n = 0; n < 2; ++n) bv[bj][n] = *(const f32x4*)(bias + col0 + bj * HALF + 4 * n);
#pragma unroll
        for (int ai = 0; ai < 2; ++ai)
#pragma unroll
            for (int m = 0; m < 4; ++m) {
                const int row = row0 + ai * HALF + m * 16; const float s = rstd[row];
                bf16_t* rowp = O + (size_t)row * 1024 + col0;
#pragma unroll
                for (int bj = 0; bj < 2; ++bj) {
                    f32x4 v0 = acc[ai][bj][m][0] * s + bv[bj][0], v1 = acc[ai][bj][m][1] * s + bv[bj][1];
#pragma unroll
                    for (int c = 0; c < 4; ++c) { v0[c] = 1.0f / (1.0f + __expf(-v0[c])); v1[c] = 1.0f / (1.0f + __expf(-v1[c])); }
                    u32x4 w; w.x = cvt_pk_bf16(v0[0], v0[1]); w.y = cvt_pk_bf16(v0[2], v0[3]); w.z = cvt_pk_bf16(v1[0], v1[1]); w.w = cvt_pk_bf16(v1[2], v1[3]);
                    *(u32x4*)(rowp + bj * HALF) = w;
                }
            }
    }
};
template <class Epi, class Sched, bool STAMP = false>
__device__ __forceinline__ void gemm_phase(PG8_LAS unsigned char* lds, const Gemm g, const Sched& S, const Epi& E, unsigned long long* stamps, const int tid_in) {
    const int tid = tid_in, wid = __builtin_amdgcn_readfirstlane(tid >> 6), lane = tid & 63, wr = wid >> 2, wc = wid & 3, fr = lane & 15, fq = lane >> 4;
    const int K = g.K, nt = K / BK;
    int ts_lo = 0, ts_hi = 0, nts = 0; const unsigned long long rt_entry = STAMP ? (unsigned long long)wall_clock64() : 0ull;
#define PG8_STAMP() do { if (STAMP && wid == 0 && nts < 64) { const unsigned long long _c = (unsigned long long)clock64(); \
        ts_lo = (lane == nts) ? (int)(unsigned)_c : ts_lo; ts_hi = (lane == nts) ? (int)(unsigned)(_c >> 32) : ts_hi; ++nts; } } while (0)
    PG8_STAMP();
    unsigned voffA[2], voffB[2];
#pragma unroll
    for (int i = 0; i < 2; ++i) { int R, C; stage_rc(tid * 16 + i * 8192, R, C); const int Rb = Epi::PERM ? ((R & ~31) + perm32(R & 31)) : R;
        voffA[i] = (unsigned)(R * K + C) * 2u; voffB[i] = (unsigned)(Rb * K + C) * 2u; }
    const size_t kstep = (size_t)(BK * 2);
    const size_t hstep = (size_t)HALF * K * 2;
    const size_t tstep = 2 * hstep;
    const unsigned ldsw = (unsigned)wid * 1024u;
    const int aoff = lds_byte(wr * 64 + fr, fq * 8), boff = lds_byte(wc * 32 + fr, fq * 8);
#define PG8_SA(b, h) (((b) * 2 + (h)) * HTB)
#define PG8_SB(b, h) ((4 + (b) * 2 + (h)) * HTB)
#define PG8_STAGE(bufoff, gbase, voff) do { _Pragma("unroll") for (int _i = 0; _i < 2; ++_i) \
        __builtin_amdgcn_global_load_lds((const unsigned*)((const char*)(gbase) + (voff)[_i]), (PG8_LAS unsigned*)(lds + (bufoff) + ldsw + _i * 8192), 16, 0, 0); } while (0)
#define PG8_LDA(dst, b, h) do { _Pragma("unroll") for (int m = 0; m < 4; ++m) _Pragma("unroll") for (int k = 0; k < 2; ++k) dst[m][k] = *(const PG8_LAS bf16x8*)(lds + PG8_SA(b, h) + aoff + m * 2048 + k * 1024); } while (0)
#define PG8_LDB(dst, b, h) do { _Pragma("unroll") for (int n = 0; n < 2; ++n) _Pragma("unroll") for (int k = 0; k < 2; ++k) dst[n][k] = *(const PG8_LAS bf16x8*)(lds + PG8_SB(b, h) + boff + n * 2048 + k * 1024); } while (0)
#define PG8_MMA(ai, bj, At, Bt) do { __builtin_amdgcn_s_setprio(1); _Pragma("unroll") for (int m = 0; m < 4; ++m) _Pragma("unroll") for (int n = 0; n < 2; ++n) _Pragma("unroll") for (int k = 0; k < 2; ++k) \
        acc[ai][bj][m][n] = __builtin_amdgcn_mfma_f32_16x16x32_bf16(Bt[n][k], At[m][k], acc[ai][bj][m][n], 0, 0, 0); __builtin_amdgcn_s_setprio(0); } while (0)
#define PG8_WAIT_V(n) asm volatile("s_waitcnt vmcnt(" #n ")" ::: "memory")
#define PG8_WAIT_L(n) asm volatile("s_waitcnt lgkmcnt(" #n ")" ::: "memory")
#define PG8_BAR __builtin_amdgcn_s_barrier()
#define PG8_SCHED __builtin_amdgcn_sched_barrier(0)
    Unit cur, nxt; int ui = 0;
    if (!S.next(0, cur)) return;
    f32x4 acc[2][2][4][2];
#pragma unroll
    for (int a = 0; a < 2; ++a)
#pragma unroll
        for (int b = 0; b < 2; ++b)
#pragma unroll
            for (int m = 0; m < 4; ++m)
#pragma unroll
                for (int n = 0; n < 2; ++n) acc[a][b][m][n] = (f32x4){0.f, 0.f, 0.f, 0.f};
    bf16x8 At[4][2], B0[2][2], B1[2][2];
    const char* cA = (const char*)g.A + (size_t)cur.pm * tstep; const char* cB = (const char*)g.Bt + (size_t)cur.pn * tstep;
    S.a_ready(cur);
    PG8_STAGE(PG8_SB(0, 0), cB, voffB); PG8_STAGE(PG8_SA(0, 0), cA, voffA); PG8_STAGE(PG8_SB(0, 1), cB + hstep, voffB); PG8_STAGE(PG8_SA(0, 1), cA + hstep, voffA);
    if (wr == 1) PG8_BAR;
    PG8_WAIT_V(4); PG8_BAR;
    PG8_STAGE(PG8_SB(1, 0), cB + kstep, voffB); PG8_STAGE(PG8_SA(1, 0), cA + kstep, voffA); PG8_STAGE(PG8_SB(1, 1), cB + hstep + kstep, voffB);
    PG8_WAIT_V(6); PG8_BAR;
    PG8_STAMP();
    for (;;) {
        const bool has_next = S.next(ui + 1, nxt);
        const char* nA = has_next ? (const char*)g.A + (size_t)nxt.pm * tstep : cA; const char* nB = has_next ? (const char*)g.Bt + (size_t)nxt.pn * tstep : cB;
        for (int t = 0; t < nt; t += 2) {
            const bool last = (t == nt - 2);
            const char* a1 = cA + (size_t)(t + 1) * kstep;
            const char* a2 = last ? nA : cA + (size_t)(t + 2) * kstep; const char* b2 = last ? nB : cB + (size_t)(t + 2) * kstep;
            const char* a3 = a2 + kstep; const char* b3 = b2 + kstep;
            if (last && has_next) S.a_ready(nxt);
            PG8_LDB(B0, 0, 0); PG8_SCHED; PG8_LDA(At, 0, 0); PG8_STAGE(PG8_SA(1, 1), a1 + hstep, voffA);
            PG8_WAIT_L(8); PG8_BAR; PG8_WAIT_L(0); PG8_MMA(0, 0, At, B0); PG8_BAR; PG8_SCHED;
            PG8_LDB(B1, 0, 1); PG8_STAGE(PG8_SB(0, 0), b2, voffB);
            PG8_BAR; PG8_WAIT_L(0); PG8_MMA(0, 1, At, B1); PG8_BAR;
            PG8_LDA(At, 0, 1); PG8_STAGE(PG8_SA(0, 0), a2, voffA);
            PG8_BAR; PG8_WAIT_L(0); PG8_MMA(1, 0, At, B0); PG8_BAR; PG8_SCHED;
            PG8_STAGE(PG8_SB(0, 1), b2 + hstep, voffB);
            PG8_WAIT_V(6); PG8_BAR; PG8_MMA(1, 1, At, B1); PG8_BAR;
            PG8_LDB(B0, 1, 0); PG8_SCHED; PG8_LDA(At, 1, 0); PG8_STAGE(PG8_SA(0, 1), a2 + hstep, voffA);
            PG8_WAIT_L(8); PG8_BAR; PG8_WAIT_L(0); PG8_MMA(0, 0, At, B0); PG8_BAR; PG8_SCHED;
            PG8_LDB(B1, 1, 1); PG8_STAGE(PG8_SB(1, 0), b3, voffB);
            PG8_BAR; PG8_WAIT_L(0); PG8_MMA(0, 1, At, B1); PG8_BAR;
            PG8_LDA(At, 1, 1); PG8_STAGE(PG8_SA(1, 0), a3, voffA);
            PG8_BAR; PG8_WAIT_L(0); PG8_MMA(1, 0, At, B0); PG8_BAR; PG8_SCHED;
            PG8_STAGE(PG8_SB(1, 1), b3 + hstep, voffB);
            PG8_WAIT_V(6); PG8_BAR; PG8_MMA(1, 1, At, B1); PG8_BAR;
        }
        PG8_STAMP();
        if constexpr (!Epi::AFTER_DRAIN) { E(acc, cur, wr, wc, fr, fq); S.done(cur); }
        PG8_STAMP();
        if (!has_next) break;
#pragma unroll
        for (int a = 0; a < 2; ++a)
#pragma unroll
            for (int b = 0; b < 2; ++b)
#pragma unroll
                for (int m = 0; m < 4; ++m)
#pragma unroll
                    for (int n = 0; n < 2; ++n) acc[a][b][m][n] = (f32x4){0.f, 0.f, 0.f, 0.f};
        cur = nxt; cA = nA; cB = nB; ++ui;
    }
    PG8_WAIT_V(0);
    if (wr == 0) PG8_BAR;
    PG8_BAR;
    if constexpr (Epi::AFTER_DRAIN) { E.fused(acc, cur, wr, wc, fr, fq, lds, wid, lane); S.done(cur); }
    PG8_STAMP();
    if (STAMP && wid == 0) { stamps[lane] = lane < nts ? (((unsigned long long)(unsigned)ts_hi << 32) | (unsigned)ts_lo) : 0ull;
        if (lane == 62) stamps[62] = rt_entry; if (lane == 63) stamps[63] = (unsigned long long)wall_clock64(); }
#undef PG8_STAMP
#undef PG8_SA
#undef PG8_SB
#undef PG8_STAGE
#undef PG8_LDA
#undef PG8_LDB
#undef PG8_MMA
#undef PG8_WAIT_V
#undef PG8_WAIT_L
#undef PG8_BAR
#undef PG8_SCHED
}
}
#define XB_TMO      128
#define XB_XCNT(j)  (256  + 64 * (j))
#define XB_XSUB(j)  (1280 + 64 * (j))
#define XB_XGEN(j)  (2304 + 64 * (j))
#define XB_TOP      3328
#define XB_TOPGEN   3392
#define XCD_BAR_WORDS 3456
#define XB_SPIN_CAP (1u << 23)
#define LAS __attribute__((address_space(3)))

__device__ __forceinline__ unsigned xb_ld(unsigned* p)              { return __hip_atomic_load(p, __ATOMIC_RELAXED, __HIP_MEMORY_SCOPE_AGENT); }
__device__ __forceinline__ unsigned xb_add(unsigned* p, unsigned v) { return __hip_atomic_fetch_add(p, v, __ATOMIC_RELAXED, __HIP_MEMORY_SCOPE_AGENT); }
__device__ __forceinline__ unsigned xb_xcc_id() { return (unsigned)__builtin_amdgcn_s_getreg((3 << 11) | 20) & 0xFu; }
#define XB_SPIN(cond, bar) do { unsigned _sp = 0; while (cond) { __builtin_amdgcn_s_sleep(1); \
    if ((++_sp & 255u) == 0u) { if (xb_ld(&(bar)[XB_TMO])) break; if (_sp > XB_SPIN_CAP) { atomicAdd(&(bar)[XB_TMO], 1u); break; } } } } while (0)

struct XcdBarrier {
    unsigned* bar; unsigned x;
    volatile LAS unsigned* st;
};

__device__ __forceinline__ XcdBarrier xcd_barrier_post(unsigned* bar, volatile LAS unsigned* st) {
    XcdBarrier b; b.bar = bar; b.x = xb_xcc_id(); b.st = st;
    if (threadIdx.x == 0) (void)xb_add(&bar[XB_XCNT(b.x)], 1u);
    return b;
}
__device__ __forceinline__ void xcd_barrier_complete(unsigned* bar, unsigned x, unsigned& nloc, unsigned& nx) {
    const unsigned G = gridDim.x * gridDim.y * gridDim.z;
    unsigned sum, cnt, mine, sp = 0u;
    for (;;) {
        sum = 0u; cnt = 0u; mine = 0u;
#pragma unroll
        for (unsigned j = 0; j < 16; ++j) { const unsigned c = xb_ld(&bar[XB_XCNT(j)]); sum += c; cnt += (c > 0u) ? 1u : 0u; mine = (j == x) ? c : mine; }
        if (sum == G) break;
        __builtin_amdgcn_s_sleep(1);
        if ((++sp & 255u) == 0u) { if (xb_ld(&bar[XB_TMO])) break; if (sp > XB_SPIN_CAP) { atomicAdd(&bar[XB_TMO], 1u); break; } }
    }
    nloc = mine > 0u ? mine : 1u; nx = cnt > 0u ? cnt : 1u;
}

__device__ __forceinline__ void xcd_barrier(const XcdBarrier& b, const int tid) {
    asm volatile("s_waitcnt vmcnt(0)" ::: "memory");
    __syncthreads();
    if (tid == 0) {
        unsigned* bar = b.bar; unsigned bx = b.x;
        asm volatile("" : "+s"(bar), "+s"(bx));
        __builtin_amdgcn_s_waitcnt(0);
        unsigned nloc = b.st[0], nx = b.st[1];
        if (nloc == 0u) { xcd_barrier_complete(bar, bx, nloc, nx); b.st[0] = nloc; b.st[1] = nx; }
        const unsigned old = xb_add(&bar[XB_XSUB(bx)], 1u);
        const unsigned gen = old / nloc;
        if (old + 1u == (gen + 1u) * nloc) {
            __builtin_amdgcn_fence(__ATOMIC_RELEASE, "agent");
            asm volatile("s_waitcnt vmcnt(0)" ::: "memory");
            const unsigned og = xb_add(&bar[XB_TOP], 1u);
            const unsigned tg = og / nx;
            if (og + 1u == (tg + 1u) * nx) xb_add(&bar[XB_TOPGEN], 1u);
            else XB_SPIN(xb_ld(&bar[XB_TOPGEN]) == tg, bar);
            __builtin_amdgcn_fence(__ATOMIC_ACQUIRE, "agent");
            xb_add(&bar[XB_XGEN(bx)], 1u);
            asm volatile("s_waitcnt vmcnt(0)" ::: "memory");
        } else {
            XB_SPIN(xb_ld(&bar[XB_XGEN(bx)]) == gen, bar);
            __builtin_amdgcn_fence(__ATOMIC_ACQUIRE, "agent");
            asm volatile("s_waitcnt vmcnt(0)" ::: "memory");
        }
    }
    __syncthreads();
}


typedef __attribute__((address_space(3))) unsigned char lds_u8;
extern __shared__ __attribute__((aligned(16))) unsigned char smem[];
DEV unsigned char* smem_base() { return smem; }

DEV bf16_t* wsb(const Args& a, size_t off) { return (bf16_t*)(a.ws + off); }
DEV float* wsf(const Args& a, size_t off) { return (float*)(a.ws + off); }

DEV void ph_rowprep(const Args& a, bool from_x, const int tid0) {
    const int lane = tid0 & 63, wv = tid0 >> 6;
    const int gw = blockIdx.x * 8 + wv, nw = gridDim.x * 8;
    bf16_t* hb = wsb(a, HB_OFF); float* ssq = wsf(a, SSQ_OFF);
    for (int t = gw; t < T; t += nw) {
        const float* src = from_x ? (t < TP ? a.x_prompt + (size_t)t * D : a.x_sample + (size_t)(t - TP) * D) : a.h + (size_t)t * D;
        f32x4 v[4]; float ss = 0.f;
#pragma unroll
        for (int i = 0; i < 4; ++i) { v[i] = *(const f32x4*)(src + (i * 64 + lane) * 4); ss += v[i][0] * v[i][0] + v[i][1] * v[i][1] + v[i][2] * v[i][2] + v[i][3] * v[i][3]; }
        ss = wave_sum(ss);
#pragma unroll
        for (int i = 0; i < 4; ++i) {
            if (from_x) *(f32x4*)(a.h + (size_t)t * D + (i * 64 + lane) * 4) = v[i];
            u32x2 p; p.x = pack2(v[i][0], v[i][1]); p.y = pack2(v[i][2], v[i][3]);
            *(u32x2*)(hb + (size_t)t * D + (i * 64 + lane) * 4) = p;
        }
        if (lane < 16) ssq[(size_t)t * 16 + lane] = (lane == 0) ? ss : 0.f;
    }
}

DEV void ph_final(const Args& a, const int tid0) {
    const int lane = tid0 & 63, wv = tid0 >> 6;
    const int gw = blockIdx.x * 8 + wv, nw = gridDim.x * 8;
    for (int t = gw; t < T; t += nw) {
        float* row = a.h + (size_t)t * D;
        f32x4 v[4]; float ss = 0.f;
#pragma unroll
        for (int i = 0; i < 4; ++i) { v[i] = *(const f32x4*)(row + (i * 64 + lane) * 4); ss += v[i][0] * v[i][0] + v[i][1] * v[i][1] + v[i][2] * v[i][2] + v[i][3] * v[i][3]; }
        ss = wave_sum(ss);
        const float r = rsqrtf(ss * (1.0f / 1024.0f) + 1e-6f);
#pragma unroll
        for (int i = 0; i < 4; ++i) { const f32x4 g = *(const f32x4*)(a.final_norm_g + (i * 64 + lane) * 4); *(f32x4*)(row + (i * 64 + lane) * 4) = v[i] * r * g; }
    }
}

DEV void transpose_cvt(const float* __restrict__ src, bf16_t* __restrict__ dst, int K, int N, int Npad, const float* __restrict__ g, float* tile, const int tid0) {
    const int tx = tid0 & 63, ty = tid0 >> 6;
    const int tk = K / 64, tn = Npad / 64;
    for (int tl = blockIdx.x; tl < tk * tn; tl += gridDim.x) {
        const int k0 = (tl % tk) * 64, n0 = (tl / tk) * 64;
        __syncthreads();
        for (int i = ty; i < 64; i += 8) { const int k = k0 + i, n = n0 + tx; float v = (n < N) ? src[(size_t)k * N + n] : 0.f; if (g) v *= g[k]; tile[i * 65 + tx] = v; }
        __syncthreads();
        for (int i = ty; i < 64; i += 8) dst[(size_t)(n0 + i) * K + k0 + tx] = (bf16_t)f2bf(tile[tx * 65 + i]);
    }
}
DEV void fold_wqk(const Args& a, float* lds, const int tid0) {
    float* swq = lds;
    float* ssk = lds + 64 * 132;
    const int tid = tid0, key = tid & 127, kq = tid >> 7;
    for (int un = blockIdx.x; un < NL * 16 * 16; un += gridDim.x) {
        const int l = un >> 8, hp = (un >> 4) & 15, k0 = (un & 15) * 64;
        __syncthreads();
        for (int i = tid; i < 64 * 128; i += NTHR) { const int r = i >> 7, c = i & 127; swq[r * 132 + c] = a.peer_w_q[((size_t)l * 1024 + k0 + r) * 2048 + hp * 128 + c]; }
        for (int i = tid; i < 128 * 128; i += NTHR) { const int r = i >> 7, c = i & 127; ssk[r * 132 + c] = a.peer_sub_keys[(((size_t)l * 16 + hp) * 128 + r) * 128 + c]; }
        __syncthreads();
        float acc[16];
#pragma unroll
        for (int i = 0; i < 16; ++i) acc[i] = 0.f;
        for (int c = 0; c < 128; c += 4) {
            const f32x4 s = *(const f32x4*)(ssk + key * 132 + c);
#pragma unroll
            for (int i = 0; i < 16; ++i) { const f32x4 w = *(const f32x4*)(swq + (kq * 16 + i) * 132 + c); acc[i] += s[0] * w[0] + s[1] * w[1] + s[2] * w[2] + s[3] * w[3]; }
        }
        bf16_t* dst = wsb(a, WB_OFF + (size_t)l * WB_LAYER + WB_QK) + (size_t)(hp * 128 + key) * 1024 + k0 + kq * 16;
        const float* g = a.norm_ffn_g + l * 1024 + k0 + kq * 16;
#pragma unroll
        for (int i = 0; i < 16; i += 2) *(unsigned*)(dst + i) = pack2(acc[i] * g[i], acc[i + 1] * g[i + 1]);
    }
}
DEV void ph_prologue(const Args& a, float* lds, const int tid0) {
    { float* rc = wsf(a, ROPEC_OFF); float* rs = wsf(a, ROPES_OFF);
      for (int i = blockIdx.x * NTHR + tid0; i < 4096 * 8; i += gridDim.x * NTHR) {
          const int pos = i >> 3, f = i & 7;
          const float invf = (float)pow(500000.0, -(double)f / 8.0);
          const float ang = (float)pos * invf;
          rc[i] = (float)cos((double)ang); rs[i] = (float)sin((double)ang);
      } }
    for (int l = 0; l < NL; ++l) {
        bf16_t* wb = wsb(a, WB_OFF + (size_t)l * WB_LAYER);
        transpose_cvt(a.w_in + (size_t)l * 1024 * INC, wb + WB_IN / 2, 1024, INC, INP, a.norm_mix_g + l * 1024, lds, tid0);
        transpose_cvt(a.w_out + (size_t)l * 1024 * 1024, wb + WB_OUT / 2, 1024, 1024, 1024, nullptr, lds, tid0);
        transpose_cvt(a.ple_w_gate + (size_t)l * 1024 * 1024, wb + WB_GATE / 2, 1024, 1024, 1024, a.ple_norm_g + l * 1024, lds, tid0);
        transpose_cvt(a.ple_w_proj + (size_t)l * 256 * 1024, wb + WB_PROJ / 2, 256, 1024, 1024, nullptr, lds, tid0);
        for (int dr = 0; dr < 2; ++dr) {
            transpose_cvt(a.rwkv_w2 + (size_t)(l * 2 + dr) * 64 * 512, wb + WB_LORA / 2 + dr * 512 * 64, 64, 512, 512, nullptr, lds, tid0);
            transpose_cvt(a.rwkv_a2 + (size_t)(l * 2 + dr) * 64 * 512, wb + WB_LORA / 2 + (2 + dr) * 512 * 64, 64, 512, 512, nullptr, lds, tid0);
        }
        transpose_cvt(a.rwkv_g2 + (size_t)l * 128 * 512, wb + WB_LORA / 2 + 4 * 512 * 64, 128, 512, 512, nullptr, lds, tid0);
    }
    fold_wqk(a, lds, tid0);
}

DEV float sum16(float v) {
    v = sum8(v);
    v += __int_as_float(__builtin_amdgcn_mov_dpp(__float_as_int(v), 0x140, 0xF, 0xF, true));
    return v;
}
DEV float max16(float v) {
    v = fmaxf(v, __int_as_float(__builtin_amdgcn_mov_dpp(__float_as_int(v), 0xB1, 0xF, 0xF, true)));
    v = fmaxf(v, __int_as_float(__builtin_amdgcn_mov_dpp(__float_as_int(v), 0x4E, 0xF, 0xF, true)));
    v = fmaxf(v, __int_as_float(__builtin_amdgcn_mov_dpp(__float_as_int(v), 0x141, 0xF, 0xF, true)));
    v = fmaxf(v, __int_as_float(__builtin_amdgcn_mov_dpp(__float_as_int(v), 0x140, 0xF, 0xF, true)));
    return v;
}
DEV float rl(float v, int l) { return __int_as_float(__builtin_amdgcn_readlane(__float_as_int(v), l)); }
DEV float wave_sum_dpp(float v) { v = sum16(v); return (rl(v, 0) + rl(v, 16)) + (rl(v, 32) + rl(v, 48)); }
DEV unsigned fkey(float f) { const unsigned b = __float_as_uint(f); return b ^ ((unsigned)((int)b >> 31) | 0x80000000u); }
DEV int mbcnt64(unsigned long long m) { return (int)__builtin_amdgcn_mbcnt_hi((unsigned)(m >> 32), __builtin_amdgcn_mbcnt_lo((unsigned)m, 0u)); }

#ifndef TOPK_NU
#define TOPK_NU 4
#endif
DEV void ph_topk2(const Args& a, float* lds, const int tid0, const int gw, const int nw, const int NP) {
    const int lane = tid0 & 63, wv = __builtin_amdgcn_readfirstlane(tid0 >> 6);
    constexpr int NU = TOPK_NU, NQ = 2 * NU, GPT = 8 / NU;
    float* tvb = lds + wv * (NQ * 16); int* tib = (int*)(lds + 8 * NQ * 16) + wv * (NQ * 16);
    const float* SC = wsf(a, SC_OFF); int* TOPI = (int*)(a.ws + TOPI_OFF); float* TOPG = wsf(a, TOPG_OFF); const float* ssq = wsf(a, SSQ_OFF);
    float vn[NU][4];
    if (gw < NP) {
#pragma unroll
        for (int u = 0; u < NU; ++u)
#pragma unroll
            for (int i = 0; i < 4; ++i) vn[u][i] = SC[(size_t)gw * (NU * 256) + u * 256 + i * 64 + lane];
    }
    for (int up = gw; up < NP; up += nw) {
        const int t = up / GPT, hd0 = (up % GPT) * NU;
        float v[NU][4]; unsigned k[NU][4];
#pragma unroll
        for (int u = 0; u < NU; ++u)
#pragma unroll
            for (int i = 0; i < 4; ++i) { v[u][i] = vn[u][i]; k[u][i] = fkey(v[u][i]); }
        if (up + nw < NP) {
#pragma unroll
            for (int u = 0; u < NU; ++u)
#pragma unroll
                for (int i = 0; i < 4; ++i) vn[u][i] = SC[(size_t)(up + nw) * (NU * 256) + u * 256 + i * 64 + lane];
        }
        unsigned th[NQ]; unsigned dm = 0u;
#pragma unroll
        for (int q = 0; q < NQ; ++q) th[q] = 0u;
        for (int b = 31; b >= 0; --b) {
            const unsigned bit = 1u << b;
            unsigned long long ma[NQ], mb[NQ];
#pragma unroll
            for (int q = 0; q < NQ; ++q) { const unsigned c = th[q] | bit; ma[q] = __ballot(k[q >> 1][2 * (q & 1)] >= c); mb[q] = __ballot(k[q >> 1][2 * (q & 1) + 1] >= c); }
#pragma unroll
            for (int q = 0; q < NQ; ++q) {
                const int n = __builtin_popcountll(ma[q]) + __builtin_popcountll(mb[q]);
                th[q] = (n >= 16) ? (th[q] | bit) : th[q]; dm |= (n == 16) ? (1u << q) : 0u;
            }
            if (dm == (1u << NQ) - 1u) break;
        }
#pragma unroll
        for (int q = 0; q < NQ; ++q) {
            const int u = q >> 1, p = q & 1; const unsigned tp = th[q];
            const unsigned ka = k[u][2 * p], kb = k[u][2 * p + 1];
            const unsigned long long ga = __ballot(ka > tp), gb = __ballot(kb > tp), ea = __ballot(ka == tp), eb = __ballot(kb == tp);
            const int nga = __builtin_popcountll(ga), ng = nga + __builtin_popcountll(gb), need = 16 - ng, nea = __builtin_popcountll(ea);
            int pa = -1, pb = -1;
            if (ka > tp) pa = mbcnt64(ga); else if (ka == tp) { const int r = mbcnt64(ea); if (r < need) pa = ng + r; }
            if (kb > tp) pb = nga + mbcnt64(gb); else if (kb == tp) { const int r = nea + mbcnt64(eb); if (r < need) pb = ng + r; }
            if (pa >= 0) { tvb[q * 16 + pa] = v[u][2 * p]; tib[q * 16 + pa] = lane; }
            if (pb >= 0) { tvb[q * 16 + pb] = v[u][2 * p + 1]; tib[q * 16 + pb] = 64 + lane; }
        }
        float cv[NU][4]; unsigned kc[NU][4]; float mx[NU];
#pragma unroll
        for (int u = 0; u < NU; ++u) {
#pragma unroll
            for (int s = 0; s < 4; ++s) { const int c = lane + 64 * s; cv[u][s] = tvb[u * 32 + (c >> 4)] + tvb[u * 32 + 16 + (c & 15)]; kc[u][s] = fkey(cv[u][s]); }
            const float m0 = max16(lane < 16 ? tvb[u * 32 + (lane & 15)] : -3.0e38f), m1 = max16(lane < 16 ? tvb[u * 32 + 16 + (lane & 15)] : -3.0e38f);
            mx[u] = rl(m0, 0) + rl(m1, 0);
        }
        unsigned t2[NU]; unsigned dm2 = 0u;
#pragma unroll
        for (int u = 0; u < NU; ++u) t2[u] = 0u;
        for (int b = 31; b >= 0; --b) {
            const unsigned bit = 1u << b;
            unsigned long long mc[NU][4];
#pragma unroll
            for (int u = 0; u < NU; ++u)
#pragma unroll
                for (int s4 = 0; s4 < 4; ++s4) mc[u][s4] = __ballot(kc[u][s4] >= (t2[u] | bit));
#pragma unroll
            for (int u = 0; u < NU; ++u) {
                const int n = (__builtin_popcountll(mc[u][0]) + __builtin_popcountll(mc[u][1])) + (__builtin_popcountll(mc[u][2]) + __builtin_popcountll(mc[u][3]));
                t2[u] = (n >= 16) ? (t2[u] | bit) : t2[u]; dm2 |= (n == 16) ? (1u << u) : 0u;
            }
            if (dm2 == (1u << NU) - 1u) break;
        }
        const float rs = rstd_parts(ssq, t);
#pragma unroll
        for (int u = 0; u < NU; ++u) {
            int pos[4]; int ng = 0;
#pragma unroll
            for (int s = 0; s < 4; ++s) { const unsigned long long g = __ballot(kc[u][s] > t2[u]); pos[s] = (kc[u][s] > t2[u]) ? ng + mbcnt64(g) : -1; ng += __builtin_popcountll(g); }
            int ne = 0; const int need = 16 - ng;
#pragma unroll
            for (int s = 0; s < 4; ++s) { const unsigned long long e = __ballot(kc[u][s] == t2[u]); if (kc[u][s] == t2[u]) { const int r = ne + mbcnt64(e); if (r < need) pos[s] = ng + r; } ne += __builtin_popcountll(e); }
            float ex[4]; float es = 0.f;
#pragma unroll
            for (int s = 0; s < 4; ++s) { ex[s] = (pos[s] >= 0) ? __expf(rs * (cv[u][s] - mx[u])) : 0.f; es += ex[s]; }
            const float inv = 1.0f / wave_sum_dpp(es);
#pragma unroll
            for (int s = 0; s < 4; ++s) if (pos[s] >= 0) {
                const int c = lane + 64 * s;
                TOPI[(size_t)t * 128 + (hd0 + u) * 16 + pos[s]] = tib[u * 32 + (c >> 4)] * 128 + tib[u * 32 + 16 + (c & 15)];
                TOPG[(size_t)t * 128 + (hd0 + u) * 16 + pos[s]] = ex[s] * inv;
            }
        }
    }
}

DEV unsigned pack4_fp8(float a, float b, float c, float d) {
    int w = __builtin_amdgcn_cvt_pk_fp8_f32(a, b, 0, false);
    w = __builtin_amdgcn_cvt_pk_fp8_f32(c, d, w, true);
    return (unsigned)w;
}
DEV void ph_convert8(const Args& a, int layer, const int tid0) {
    const size_t gtid = (size_t)blockIdx.x * NTHR + tid0, gn = (size_t)gridDim.x * NTHR;
    const float* us = a.peer_u + (size_t)layer * 16384 * 1024; const float* vs = a.peer_v + (size_t)layer * 16384 * 1024;
    unsigned* ud = (unsigned*)(a.ws + PTU_OFF); unsigned* vd = (unsigned*)(a.ws + PTV_OFF);
    const float* g = a.norm_ffn_g + layer * 1024;
    for (size_t i = gtid; i < (size_t)16384 * 1024 / 16; i += gn) {
        u32x4 pu, pv;
#pragma unroll
        for (int j = 0; j < 4; ++j) {
            const f32x4 x = *(const f32x4*)(us + i * 16 + j * 4), y = *(const f32x4*)(vs + i * 16 + j * 4), gg = *(const f32x4*)(g + ((i * 16 + j * 4) & 1023));
            pu[j] = pack4_fp8(x[0] * gg[0] * 256.f, x[1] * gg[1] * 256.f, x[2] * gg[2] * 256.f, x[3] * gg[3] * 256.f);
            pv[j] = pack4_fp8(y[0] * 32.f, y[1] * 32.f, y[2] * 32.f, y[3] * 32.f);
        }
        *(u32x4*)(ud + i * 4) = pu; *(u32x4*)(vd + i * 4) = pv;
    }
    bf16_t* pb = wsb(a, PB_OFF);
    const float* pp = a.p_prompt + (size_t)layer * TP * 256; const float* ps = a.p_sample + (size_t)layer * (T - TP) * 256;
    for (size_t i = gtid; i < (size_t)T * 256 / 4; i += gn) {
        const size_t e = i * 4; const f32x4 x = (e < (size_t)TP * 256) ? *(const f32x4*)(pp + e) : *(const f32x4*)(ps + (e - (size_t)TP * 256));
        u32x2 p; p.x = pack2(x[0], x[1]); p.y = pack2(x[2], x[3]); *(u32x2*)(pb + e) = p;
    }
}

template <bool DRY> DEV void ph_peer8(const Args& a, const int tid0) {
    const int lane = tid0 & 63, wv = tid0 >> 6;
    const int gw = blockIdx.x * 8 + wv, nw = gridDim.x * 8;
    bf16_t* hb = wsb(a, HB_OFF); float* rstd = wsf(a, RSTD_OFF);
    const int* TOPI = (const int*)(a.ws + TOPI_OFF); const float* TOPG = wsf(a, TOPG_OFF);
    const unsigned char* PU = a.ws + PTU_OFF; const unsigned char* PV = a.ws + PTV_OFF;
    const int c16 = 16 * lane;
    const bool b5 = lane & 32, b4 = lane & 16, b3 = lane & 8;
    for (int t = gw; t < T; t += nw) {
        float x[16];
        { const u32x4 x0 = *(const u32x4*)(hb + (size_t)t * 1024 + c16), x1 = *(const u32x4*)(hb + (size_t)t * 1024 + c16 + 8);
#pragma unroll
          for (int i = 0; i < 4; ++i) { x[2 * i] = bflo(x0[i]); x[2 * i + 1] = bfhi(x0[i]); x[8 + 2 * i] = bflo(x1[i]); x[8 + 2 * i + 1] = bfhi(x1[i]); } }
        const float rs = rstd[t] * (1.0f / 256.0f);
        const int e0 = TOPI[(size_t)t * 128 + lane], e1 = TOPI[(size_t)t * 128 + 64 + lane];
        const float g0 = TOPG[(size_t)t * 128 + lane], g1 = TOPG[(size_t)t * 128 + 64 + lane];
        float out[16];
#pragma unroll
        for (int i = 0; i < 16; ++i) out[i] = 0.f;
#pragma unroll 1
        for (int kb = 0; kb < 128; kb += 8) {
            const int es = (kb < 64) ? e0 : e1; const float gs = (kb < 64) ? g0 : g1;
            u32x4 ur[8], vr[8];
#pragma unroll
            for (int i = 0; i < 8; ++i) { const int e = __builtin_amdgcn_readlane(es, (kb + i) & 63); ur[i] = *(const u32x4*)(PU + (size_t)e * 1024 + c16); vr[i] = *(const u32x4*)(PV + (size_t)e * 1024 + c16); }
            float d[8];
#pragma unroll
            for (int i = 0; i < 8; ++i) {
                float s = 0.f;
#pragma unroll
                for (int j = 0; j < 4; ++j) {
                    const f32x2 lo = __builtin_amdgcn_cvt_pk_f32_fp8((int)ur[i][j], false), hi = __builtin_amdgcn_cvt_pk_f32_fp8((int)ur[i][j], true);
                    s += lo[0] * x[4 * j] + lo[1] * x[4 * j + 1] + hi[0] * x[4 * j + 2] + hi[1] * x[4 * j + 3];
                }
                d[i] = s;
            }
            float r4[4], r2[2];
#pragma unroll
            for (int i = 0; i < 4; ++i) { const float send = b5 ? d[i] : d[4 + i], keep = b5 ? d[4 + i] : d[i]; r4[i] = keep + SHX(send, 32); }
#pragma unroll
            for (int i = 0; i < 2; ++i) { const float send = b4 ? r4[i] : r4[2 + i], keep = b4 ? r4[2 + i] : r4[i]; r2[i] = keep + SHX(send, 16); }
            const float send1 = b3 ? r2[0] : r2[1], keep1 = b3 ? r2[1] : r2[0];
            const float dd = sum8(keep1 + SHX(send1, 8));
            const float hp = rs * dd;
            const float gt = SHF(gs, (kb + (lane >> 3)) & 63);
            const float w = gt * 0.5f * hp * (1.0f + erff(hp * 0.70710678f)) * (1.0f / 32.0f);
#pragma unroll
            for (int i = 0; i < 8; ++i) {
                const float wi = rl(w, 8 * i);
#pragma unroll
                for (int j = 0; j < 4; ++j) {
                    const f32x2 lo = __builtin_amdgcn_cvt_pk_f32_fp8((int)vr[i][j], false), hi = __builtin_amdgcn_cvt_pk_f32_fp8((int)vr[i][j], true);
                    out[4 * j] += wi * lo[0]; out[4 * j + 1] += wi * lo[1]; out[4 * j + 2] += wi * hi[0]; out[4 * j + 3] += wi * hi[1];
                }
            }
        }
        float* hr = a.h + (size_t)t * 1024 + c16;
        f32x4 hv[4]; float ss = 0.f;
#pragma unroll
        for (int j = 0; j < 4; ++j) { hv[j] = *(const f32x4*)(hr + 4 * j);
#pragma unroll
            for (int c = 0; c < 4; ++c) { hv[j][c] += out[4 * j + c]; ss += hv[j][c] * hv[j][c]; }
            if (!DRY) *(f32x4*)(hr + 4 * j) = hv[j]; }
        ss = wave_sum(ss);
        if (DRY && ss != -1.0f) continue;
        u32x4 p0, p1;
        p0.x = pack2(hv[0][0], hv[0][1]); p0.y = pack2(hv[0][2], hv[0][3]); p0.z = pack2(hv[1][0], hv[1][1]); p0.w = pack2(hv[1][2], hv[1][3]);
        p1.x = pack2(hv[2][0], hv[2][1]); p1.y = pack2(hv[2][2], hv[2][3]); p1.z = pack2(hv[3][0], hv[3][1]); p1.w = pack2(hv[3][2], hv[3][3]);
        *(u32x4*)(hb + (size_t)t * 1024 + c16) = p0; *(u32x4*)(hb + (size_t)t * 1024 + c16 + 8) = p1;
        if (lane == 0) rstd[t] = rsqrtf(ss * (1.0f / 1024.0f) + 1e-6f);
    }
}

typedef short bf16x8 __attribute__((ext_vector_type(8)));
typedef float f32x16 __attribute__((ext_vector_type(16)));
#define MFMA32(a, b, c) __builtin_amdgcn_mfma_f32_32x32x16_bf16((a), (b), (c), 0, 0, 0)
DEV bf16x8 pack_frag(float x0, float x1, float x2, float x3, float x4, float x5, float x6, float x7) {
    u32x4 p;
    asm volatile("v_cvt_pk_bf16_f32 %0, %4, %5\n\tv_cvt_pk_bf16_f32 %1, %6, %7\n\tv_cvt_pk_bf16_f32 %2, %8, %9\n\tv_cvt_pk_bf16_f32 %3, %10, %11\n\ts_nop 1"
                 : "=&v"(p[0]), "=&v"(p[1]), "=&v"(p[2]), "=&v"(p[3]) : "v"(x0), "v"(x1), "v"(x2), "v"(x3), "v"(x4), "v"(x5), "v"(x6), "v"(x7));
    return __builtin_bit_cast(bf16x8, p);
}
template <int VAR> DEV void ph_attn2(const Args& a, unsigned char* ldsb, const int tid0) {
    const int lane = tid0 & 63, wv = __builtin_amdgcn_readfirstlane(tid0 >> 6), r = lane & 31, h = lane >> 5;
    unsigned char* vt = ldsb + wv * 4608;
    const bf16_t* qkv = wsb(a, QKV_OFF);
    bf16_t* OP = wsb(a, OP_OFF); float* ML = wsf(a, ML_OFF);
    const int i16 = lane & 15, tq = i16 >> 2, tp = i16 & 3, tblk = (lane >> 4) & 1;
    const unsigned tr_addr = (unsigned)(size_t)vt + (4 * h + tq) * 144 + 2 * (16 * tblk + 4 * tp);
    const float sc = 0.125f * 1.44269504f, NEG = -1.0e30f;
    const int nitem = NSEQ * 8 * 3 * 128, per = nitem / (int)gridDim.x;
    for (int it = 0; it < per / 8; ++it) {
        const int w = blockIdx.x * per + it * 8 + wv;
        const int sh = w / 384, rem = w - sh * 384, di = rem >> 7, idx = rem & 127;
        const int sft = (VAR == 1) ? 0 : 2 * di, nbc = 128 >> sft, rr = idx >> (7 - sft), cb = idx & (nbc - 1), cq0 = cb * 32, nlen = 4096 >> sft;
        const int seq = sh >> 3, hd = sh & 7; const size_t tb = (size_t)seq * 4096;
        const size_t tokq = tb + ((size_t)(cq0 + r) << sft) + rr;
        const bf16_t* qp = qkv + tokq * 1536 + hd * 64 + 8 * h;
        bf16x8 qf[4];
#pragma unroll
        for (int s = 0; s < 4; ++s) qf[s] = *(const bf16x8*)(qp + 16 * s);
        float m = NEG, l = 0.f;
        f32x16 O0, O1;
#pragma unroll
        for (int i = 0; i < 16; ++i) { O0[i] = 0.f; O1[i] = 0.f; }
        bf16x8 kfb[2][4], vfb[2][4];
#define ATT_LOAD(kt_) do { const int kb_ = cq0 - 64 + 32 * (kt_); const size_t tokk_ = tb + ((size_t)(kb_ + r) << sft) + rr; const bf16_t* kp_ = qkv + tokk_ * 1536 + 512 + hd * 64 + 8 * h; \
            _Pragma("unroll") for (int s_ = 0; s_ < 4; ++s_) { kfb[(kt_) & 1][s_] = *(const bf16x8*)(kp_ + 16 * s_); vfb[(kt_) & 1][s_] = *(const bf16x8*)(kp_ + 512 + 16 * s_); } } while (0)
        if (cq0 - 64 >= 0) ATT_LOAD(0);
#pragma unroll
        for (int kt = 0; kt < 5; ++kt) {
            const int kb = cq0 - 64 + 32 * kt;
            if (kt + 1 < 5) { const int kbn = kb + 32; if (kbn >= 0 && kbn < nlen) ATT_LOAD(kt + 1); }
            asm volatile("" ::: "memory");
            if (kb < 0 || kb >= nlen) continue;
            bf16x8 kf[4], vf[4];
#pragma unroll
            for (int s = 0; s < 4; ++s) { kf[s] = kfb[kt & 1][s]; vf[s] = vfb[kt & 1][s]; }
            f32x16 S;
#pragma unroll
            for (int i = 0; i < 16; ++i) S[i] = 0.f;
#pragma unroll
            for (int s = 0; s < 4; ++s) S = MFMA32(kf[s], qf[s], S);
            float lm = NEG;
#pragma unroll
            for (int i = 0; i < 16; ++i) {
                const int row = (i & 3) + 8 * (i >> 2) + 4 * h;
                float v = S[i] * sc;
                if (kt == 0) v = (row >= r) ? v : NEG;
                if (kt == 4) v = (row <= r) ? v : NEG;
                S[i] = v; lm = fmaxf(lm, v);
            }
            lm = fmaxf(lm, SHX(lm, 32));
            const float mn = fmaxf(m, lm), alpha = __builtin_amdgcn_exp2f(m - mn);
            m = mn; l *= alpha;
            float ps = 0.f;
#pragma unroll
            for (int i = 0; i < 16; ++i) { O0[i] *= alpha; O1[i] *= alpha; S[i] = __builtin_amdgcn_exp2f(S[i] - mn); ps += S[i]; }
            l += ps;
            const bf16x8 pb0 = pack_frag(S[0], S[1], S[2], S[3], S[4], S[5], S[6], S[7]);
            const bf16x8 pb1 = pack_frag(S[8], S[9], S[10], S[11], S[12], S[13], S[14], S[15]);
            asm volatile("" ::: "memory");
#pragma unroll
            for (int i = 0; i < 4; ++i) *(bf16x8*)(vt + r * 144 + 2 * (16 * i + 8 * h)) = vf[i];
            typedef short s16x4 __attribute__((ext_vector_type(4)));
            s16x4 t00l, t00h, t01l, t01h, t10l, t10h, t11l, t11h;
            asm volatile("s_waitcnt lgkmcnt(0)\n\t"
                         "ds_read_b64_tr_b16 %0, %8\n\tds_read_b64_tr_b16 %1, %8 offset:1152\n\t"
                         "ds_read_b64_tr_b16 %2, %8 offset:2304\n\tds_read_b64_tr_b16 %3, %8 offset:3456\n\t"
                         "ds_read_b64_tr_b16 %4, %8 offset:64\n\tds_read_b64_tr_b16 %5, %8 offset:1216\n\t"
                         "ds_read_b64_tr_b16 %6, %8 offset:2368\n\tds_read_b64_tr_b16 %7, %8 offset:3520\n\t"
                         "s_waitcnt lgkmcnt(0)"
                         : "=&v"(t00l), "=&v"(t00h), "=&v"(t01l), "=&v"(t01h), "=&v"(t10l), "=&v"(t10h), "=&v"(t11l), "=&v"(t11h) : "v"(tr_addr) : "memory");
            const bf16x8 a00 = __builtin_shufflevector(t00l, t00h, 0, 1, 2, 3, 4, 5, 6, 7), a01 = __builtin_shufflevector(t01l, t01h, 0, 1, 2, 3, 4, 5, 6, 7);
            const bf16x8 a10 = __builtin_shufflevector(t10l, t10h, 0, 1, 2, 3, 4, 5, 6, 7), a11 = __builtin_shufflevector(t11l, t11h, 0, 1, 2, 3, 4, 5, 6, 7);
            O0 = MFMA32(a00, pb0, O0); O1 = MFMA32(a10, pb0, O1);
            O0 = MFMA32(a01, pb1, O0); O1 = MFMA32(a11, pb1, O1);
            asm volatile("" ::: "memory");
        }
#undef ATT_LOAD
        l += SHX(l, 32);
        const float inv = 1.0f / l;
        if (VAR == 2 && tokq != 0x7fffffff) continue;
        bf16_t* op = OP + ((size_t)di * T + tokq) * 512 + hd * 64 + 4 * h;
#pragma unroll
        for (int g = 0; g < 4; ++g) {
            u32x2 p0, p1;
            p0.x = pack2(O0[4 * g] * inv, O0[4 * g + 1] * inv); p0.y = pack2(O0[4 * g + 2] * inv, O0[4 * g + 3] * inv);
            p1.x = pack2(O1[4 * g] * inv, O1[4 * g + 1] * inv); p1.y = pack2(O1[4 * g + 2] * inv, O1[4 * g + 3] * inv);
            *(u32x2*)(op + 8 * g) = p0; *(u32x2*)(op + 32 + 8 * g) = p1;
        }
        if (h == 0) { f32x2 ml; ml[0] = m; ml[1] = l; *(f32x2*)(ML + (((size_t)di * T + tokq) * 8 + hd) * 2) = ml; }
    }
}
DEV void ph_attn3(const Args& a, int layer, unsigned char* ldsb, const int tid0) {
    const int lane = tid0 & 63, wv = __builtin_amdgcn_readfirstlane(tid0 >> 6), r = lane & 31, h = lane >> 5;
    unsigned char* OL = ldsb;
    float* MLl = (float*)(ldsb + 73728);
    unsigned char* vt = ldsb + 77824 + wv * 4608;
    const bf16_t* qkv = wsb(a, QKV_OFF);
    bf16_t* mix = wsb(a, MIX_OFF);
    const int i16 = lane & 15, tq = i16 >> 2, tp = i16 & 3, tblk = (lane >> 4) & 1;
    const unsigned tr_addr = (unsigned)(size_t)vt + (4 * h + tq) * 144 + 2 * (16 * tblk + 4 * tp);
    const float sc = 0.125f * 1.44269504f, NEG = -1.0e30f;
    for (int un = blockIdx.x; un < NSEQ * 8 * 8; un += gridDim.x) {
      const int sh = un >> 3, sp = un & 7, seq = sh >> 3, hd = sh & 7; const size_t tb = (size_t)seq * 4096;
      __syncthreads();
#pragma unroll 1
      for (int di = 0; di < 3; ++di) {
#pragma unroll 1
       for (int k2 = 0; k2 < 2; ++k2) {
        const int idx16 = wv * 2 + k2;
        const int sft = 2 * di, nlen = 4096 >> sft;
        const int rr = (di == 0) ? 0 : (di == 1 ? (idx16 >> 2) : idx16), cb = (di == 0) ? (16 * sp + idx16) : (di == 1 ? (4 * sp + (idx16 & 3)) : sp), cq0 = cb * 32;
        const size_t tokq = tb + ((size_t)(cq0 + r) << sft) + rr;
        const bf16_t* qp = qkv + tokq * 1536 + hd * 64 + 8 * h;
        bf16x8 qf[4];
#pragma unroll
        for (int s = 0; s < 4; ++s) qf[s] = *(const bf16x8*)(qp + 16 * s);
        float m = NEG, l = 0.f;
        f32x16 O0, O1;
#pragma unroll
        for (int i = 0; i < 16; ++i) { O0[i] = 0.f; O1[i] = 0.f; }
        bf16x8 kfb[2][4], vfb[2][4];
#define ATT_LOAD(kt_) do { const int kb_ = cq0 - 64 + 32 * (kt_); const size_t tokk_ = tb + ((size_t)(kb_ + r) << sft) + rr; const bf16_t* kp_ = qkv + tokk_ * 1536 + 512 + hd * 64 + 8 * h; \
            _Pragma("unroll") for (int s_ = 0; s_ < 4; ++s_) { kfb[(kt_) & 1][s_] = *(const bf16x8*)(kp_ + 16 * s_); vfb[(kt_) & 1][s_] = *(const bf16x8*)(kp_ + 512 + 16 * s_); } } while (0)
        if (cq0 - 64 >= 0) ATT_LOAD(0);
#pragma unroll
        for (int kt = 0; kt < 5; ++kt) {
            const int kb = cq0 - 64 + 32 * kt;
            if (kt + 1 < 5) { const int kbn = kb + 32; if (kbn >= 0 && kbn < nlen) ATT_LOAD(kt + 1); }
            asm volatile("" ::: "memory");
            if (kb < 0 || kb >= nlen) continue;
            bf16x8 kf[4], vf[4];
#pragma unroll
            for (int s = 0; s < 4; ++s) { kf[s] = kfb[kt & 1][s]; vf[s] = vfb[kt & 1][s]; }
            f32x16 S;
#pragma unroll
            for (int i = 0; i < 16; ++i) S[i] = 0.f;
#pragma unroll
            for (int s = 0; s < 4; ++s) S = MFMA32(kf[s], qf[s], S);
            float lm = NEG;
#pragma unroll
            for (int i = 0; i < 16; ++i) {
                const int row = (i & 3) + 8 * (i >> 2) + 4 * h;
                float v = S[i] * sc;
                if (kt == 0) v = (row >= r) ? v : NEG;
                if (kt == 4) v = (row <= r) ? v : NEG;
                S[i] = v; lm = fmaxf(lm, v);
            }
            lm = fmaxf(lm, SHX(lm, 32));
            const float mn = fmaxf(m, lm), alpha = __builtin_amdgcn_exp2f(m - mn);
            m = mn; l *= alpha;
            float ps = 0.f;
#pragma unroll
            for (int i = 0; i < 16; ++i) { O0[i] *= alpha; O1[i] *= alpha; S[i] = __builtin_amdgcn_exp2f(S[i] - mn); ps += S[i]; }
            l += ps;
            const bf16x8 pb0 = pack_frag(S[0], S[1], S[2], S[3], S[4], S[5], S[6], S[7]);
            const bf16x8 pb1 = pack_frag(S[8], S[9], S[10], S[11], S[12], S[13], S[14], S[15]);
            asm volatile("" ::: "memory");
#pragma unroll
            for (int i = 0; i < 4; ++i) *(bf16x8*)(vt + r * 144 + 2 * (16 * i + 8 * h)) = vf[i];
            typedef short s16x4 __attribute__((ext_vector_type(4)));
            s16x4 t00l, t00h, t01l, t01h, t10l, t10h, t11l, t11h;
            asm volatile("s_waitcnt lgkmcnt(0)\n\t"
                         "ds_read_b64_tr_b16 %0, %8\n\tds_read_b64_tr_b16 %1, %8 offset:1152\n\t"
                         "ds_read_b64_tr_b16 %2, %8 offset:2304\n\tds_read_b64_tr_b16 %3, %8 offset:3456\n\t"
                         "ds_read_b64_tr_b16 %4, %8 offset:64\n\tds_read_b64_tr_b16 %5, %8 offset:1216\n\t"
                         "ds_read_b64_tr_b16 %6, %8 offset:2368\n\tds_read_b64_tr_b16 %7, %8 offset:3520\n\t"
                         "s_waitcnt lgkmcnt(0)"
                         : "=&v"(t00l), "=&v"(t00h), "=&v"(t01l), "=&v"(t01h), "=&v"(t10l), "=&v"(t10h), "=&v"(t11l), "=&v"(t11h) : "v"(tr_addr) : "memory");
            const bf16x8 a00 = __builtin_shufflevector(t00l, t00h, 0, 1, 2, 3, 4, 5, 6, 7), a01 = __builtin_shufflevector(t01l, t01h, 0, 1, 2, 3, 4, 5, 6, 7);
            const bf16x8 a10 = __builtin_shufflevector(t10l, t10h, 0, 1, 2, 3, 4, 5, 6, 7), a11 = __builtin_shufflevector(t11l, t11h, 0, 1, 2, 3, 4, 5, 6, 7);
            O0 = MFMA32(a00, pb0, O0); O1 = MFMA32(a10, pb0, O1);
            O0 = MFMA32(a01, pb1, O0); O1 = MFMA32(a11, pb1, O1);
            asm volatile("" ::: "memory");
        }
#undef ATT_LOAD
        l += SHX(l, 32);
        const int ql = (((cq0 + r) << sft) + rr) - 512 * sp;
        unsigned char* orow = OL + ql * 144 + 8 * h;
        float ao = 0.f, ap = 1.0f;
        if (di > 0) {
            const f32x2 mo = *(const f32x2*)(MLl + 2 * ql);
            const float mn = fmaxf(mo[0], m);
            ao = __builtin_amdgcn_exp2f(mo[0] - mn); ap = __builtin_amdgcn_exp2f(m - mn);
            l = ao * mo[1] + ap * l; m = mn;
        }
#pragma unroll
        for (int g = 0; g < 4; ++g) {
            f32x4 v0 = {O0[4 * g] * ap, O0[4 * g + 1] * ap, O0[4 * g + 2] * ap, O0[4 * g + 3] * ap}, v1 = {O1[4 * g] * ap, O1[4 * g + 1] * ap, O1[4 * g + 2] * ap, O1[4 * g + 3] * ap};
            if (di > 0) {
                const u32x2 o0 = *(const u32x2*)(orow + 16 * g), o1 = *(const u32x2*)(orow + 64 + 16 * g);
                v0[0] += ao * bflo(o0.x); v0[1] += ao * bfhi(o0.x); v0[2] += ao * bflo(o0.y); v0[3] += ao * bfhi(o0.y);
                v1[0] += ao * bflo(o1.x); v1[1] += ao * bfhi(o1.x); v1[2] += ao * bflo(o1.y); v1[3] += ao * bfhi(o1.y);
            }
            u32x2 p0, p1; p0.x = pack2(v0[0], v0[1]); p0.y = pack2(v0[2], v0[3]); p1.x = pack2(v1[0], v1[1]); p1.y = pack2(v1[2], v1[3]);
            *(u32x2*)(orow + 16 * g) = p0; *(u32x2*)(orow + 64 + 16 * g) = p1;
        }
        if (h == 0) { f32x2 ml; ml[0] = m; ml[1] = l; *(f32x2*)(MLl + 2 * ql) = ml; }
       }
       __syncthreads();
      }
      {
        const int ql = tid0;
        const float inv = 1.0f / MLl[2 * ql + 1];
        float o[64]; float ss = 0.f;
#pragma unroll
        for (int c = 0; c < 8; ++c) {
            const u32x4 w4 = *(const u32x4*)(OL + ql * 144 + 16 * c);
#pragma unroll
            for (int i = 0; i < 4; ++i) { o[8 * c + 2 * i] = bflo(w4[i]) * inv; o[8 * c + 2 * i + 1] = bfhi(w4[i]) * inv; ss += o[8 * c + 2 * i] * o[8 * c + 2 * i] + o[8 * c + 2 * i + 1] * o[8 * c + 2 * i + 1]; }
        }
        const float rn = rsqrtf(ss * (1.0f / 64.0f) + 1e-6f);
        const float* gp = a.att_norm_g + layer * 512 + hd * 64;
        bf16_t* dst = mix + (tb + 512 * sp + ql) * 1024 + hd * 64;
#pragma unroll
        for (int c = 0; c < 8; ++c) {
            const f32x4 g0 = *(const f32x4*)(gp + 8 * c), g1 = *(const f32x4*)(gp + 8 * c + 4);
            u32x4 w4; w4.x = pack2(o[8 * c] * rn * g0[0], o[8 * c + 1] * rn * g0[1]); w4.y = pack2(o[8 * c + 2] * rn * g0[2], o[8 * c + 3] * rn * g0[3]);
            w4.z = pack2(o[8 * c + 4] * rn * g1[0], o[8 * c + 5] * rn * g1[1]); w4.w = pack2(o[8 * c + 6] * rn * g1[2], o[8 * c + 7] * rn * g1[3]);
            *(u32x4*)(dst + 8 * c) = w4;
        }
      }
    }
}
DEV void ph_attn_merge(const Args& a, int layer, const int tid0) {
    const int lane = tid0 & 63, wv = tid0 >> 6;
    const int gw = blockIdx.x * 8 + wv, nw = gridDim.x * 8;
    const bf16_t* OP = wsb(a, OP_OFF); const float* ML = wsf(a, ML_OFF); bf16_t* mix = wsb(a, MIX_OFF);
    const int c8 = 8 * lane, hd = lane >> 3;
    const f32x4 gA = *(const f32x4*)(a.att_norm_g + layer * 512 + c8), gB = *(const f32x4*)(a.att_norm_g + layer * 512 + c8 + 4);
    for (int t = gw; t < T; t += nw) {
        u32x4 o[3]; f32x2 ml[3];
#pragma unroll
        for (int d = 0; d < 3; ++d) { o[d] = *(const u32x4*)(OP + ((size_t)d * T + t) * 512 + c8); ml[d] = *(const f32x2*)(ML + (((size_t)d * T + t) * 8 + hd) * 2); }
        const float mm = fmaxf(ml[0][0], fmaxf(ml[1][0], ml[2][0]));
        float wgt[3]; float den = 0.f;
#pragma unroll
        for (int d = 0; d < 3; ++d) { wgt[d] = __builtin_amdgcn_exp2f(ml[d][0] - mm) * ml[d][1]; den += wgt[d]; }
        const float iden = 1.0f / den;
        float v[8]; float ss = 0.f;
#pragma unroll
        for (int i = 0; i < 4; ++i) {
            v[2 * i] = (wgt[0] * bflo(o[0][i]) + wgt[1] * bflo(o[1][i]) + wgt[2] * bflo(o[2][i])) * iden;
            v[2 * i + 1] = (wgt[0] * bfhi(o[0][i]) + wgt[1] * bfhi(o[1][i]) + wgt[2] * bfhi(o[2][i])) * iden;
            ss += v[2 * i] * v[2 * i] + v[2 * i + 1] * v[2 * i + 1];
        }
        const float rn = rsqrtf(sum8(ss) * (1.0f / 64.0f) + 1e-6f);
        u32x4 ov;
        ov.x = pack2(v[0] * rn * gA[0], v[1] * rn * gA[1]); ov.y = pack2(v[2] * rn * gA[2], v[3] * rn * gA[3]);
        ov.z = pack2(v[4] * rn * gB[0], v[5] * rn * gB[1]); ov.w = pack2(v[6] * rn * gB[2], v[7] * rn * gB[3]);
        *(u32x4*)(mix + (size_t)t * 1024 + c8) = ov;
    }
}

DEV float tanh_fast(float x) { return 1.0f - 2.0f / (1.0f + __expf(2.0f * x)); }

DEV void ph_rwkv_prep1(const Args& a, int layer, unsigned char* ldsb, const int tid0) {
    const int lane = tid0 & 63, wv = __builtin_amdgcn_readfirstlane(tid0 >> 6), r = lane & 31, h = lane >> 5;
    const int gw = blockIdx.x * 8 + wv, nw = gridDim.x * 8;
    const int sub = wv & 1, ng = wv >> 1;
    const bf16_t* U = wsb(a, U_OFF);
    const float* sw = a.rwkv_shift + (size_t)layer * 3 * UC;
    const bf16_t* wl = wsb(a, WB_OFF + (size_t)layer * WB_LAYER + WB_LORA);
#pragma unroll 1
    for (int arr = 0; arr < 5; ++arr) {
        const int coff = (arr < 4) ? arr * 64 : 256, nk = (arr < 4) ? 4 : 8, kw = nk * 16, rsb = kw * 2 + 16;
        __syncthreads();
        {
            const bf16_t* wsrc = wl + (arr < 4 ? arr * 512 * 64 : 4 * 512 * 64);
            const int cpr = kw / 8;
            for (int i = tid0; i < 512 * cpr; i += NTHR) { const int row = i / cpr, c = i - row * cpr; *(u32x4*)(ldsb + row * rsb + c * 16) = *(const u32x4*)(wsrc + (size_t)row * kw + c * 8); }
        }
        __syncthreads();
        bf16_t* outb = wsb(a, arr == 0 ? WF_OFF : arr == 1 ? WB2_OFF : arr == 2 ? AF_OFF : arr == 3 ? AB_OFF : G_OFF);
        const float* bias = (arr < 2) ? a.rwkv_w0 + (layer * 2 + arr) * 512 : a.rwkv_a0 + (layer * 2 + (arr & 1)) * 512;
        f32x4 bvr[4][4];
#pragma unroll
        for (int q = 0; q < 4; ++q)
#pragma unroll
            for (int g = 0; g < 4; ++g) bvr[q][g] = *(const f32x4*)(bias + (ng * 4 + q) * 32 + 8 * g + 4 * h);
#pragma unroll 1
        for (int tile = blockIdx.x; tile < T / 64; tile += gridDim.x) {
            const int t = tile * 64 + sub * 32 + r, pos = t & 4095;
            const bool hp = pos > 0, hn = pos < 4095;
            const bf16_t* up = U + (size_t)t * UW + 1536 + 8 * h;
            bf16x8 xf[8];
#pragma unroll
            for (int s = 0; s < 8; ++s) {
                if (s < nk) {
                    const int col = coff + 16 * s;
                    const u32x4 c = *(const u32x4*)(up + col);
                    u32x4 p = {0u, 0u, 0u, 0u}, n = {0u, 0u, 0u, 0u};
                    if (hp) p = *(const u32x4*)(up - UW + col);
                    if (hn) n = *(const u32x4*)(up + UW + col);
                    const float* s0 = sw + 1536 + 8 * h + col;
                    const f32x4 wp0 = *(const f32x4*)(s0), wp1 = *(const f32x4*)(s0 + 4), wc0 = *(const f32x4*)(s0 + UC), wc1 = *(const f32x4*)(s0 + UC + 4), wn0 = *(const f32x4*)(s0 + 2 * UC), wn1 = *(const f32x4*)(s0 + 2 * UC + 4);
                    float v[8];
#pragma unroll
                    for (int i = 0; i < 4; ++i) {
                        const float a0 = (i < 2) ? wp0[2 * i] : wp1[2 * i - 4], a1 = (i < 2) ? wp0[2 * i + 1] : wp1[2 * i - 3];
                        const float b0 = (i < 2) ? wc0[2 * i] : wc1[2 * i - 4], b1 = (i < 2) ? wc0[2 * i + 1] : wc1[2 * i - 3];
                        const float c0 = (i < 2) ? wn0[2 * i] : wn1[2 * i - 4], c1 = (i < 2) ? wn0[2 * i + 1] : wn1[2 * i - 3];
                        v[2 * i] = a0 * bflo(p[i]) + b0 * bflo(c[i]) + c0 * bflo(n[i]);
                        v[2 * i + 1] = a1 * bfhi(p[i]) + b1 * bfhi(c[i]) + c1 * bfhi(n[i]);
                    }
                    if (arr < 2) {
#pragma unroll
                        for (int i = 0; i < 8; ++i) v[i] = tanh_fast(v[i]);
                    } else if (arr == 4) {
#pragma unroll
                        for (int i = 0; i < 8; ++i) v[i] = sigmoidf_(v[i]);
                    }
                    xf[s] = pack_frag(v[0], v[1], v[2], v[3], v[4], v[5], v[6], v[7]);
                }
            }
            bf16_t* out = outb + (size_t)t * 512 + 4 * h;
#pragma unroll
            for (int q = 0; q < 4; ++q) {
                const int nt = ng * 4 + q;
                f32x16 C;
#pragma unroll
                for (int i = 0; i < 16; ++i) C[i] = 0.f;
                const unsigned char* wr = ldsb + (nt * 32 + r) * rsb + 16 * h;
#pragma unroll
                for (int s = 0; s < 8; ++s) if (s < nk) { const bf16x8 A = *(const bf16x8*)(wr + 32 * s); C = MFMA32(A, xf[s], C); }
#pragma unroll
                for (int g = 0; g < 4; ++g) {
                    float o[4];
                    if (arr < 4) {
                        const f32x4 bv = bvr[q][g];
#pragma unroll
                        for (int j = 0; j < 4; ++j) { const float sg = sigmoidf_(C[4 * g + j] + bv[j]); o[j] = (arr < 2) ? __expf(-0.60653066f * sg) : sg; }
                    } else {
#pragma unroll
                        for (int j = 0; j < 4; ++j) o[j] = C[4 * g + j];
                    }
                    u32x2 pk; pk.x = pack2(o[0], o[1]); pk.y = pack2(o[2], o[3]);
                    *(u32x2*)(out + nt * 32 + 8 * g) = pk;
                }
            }
        }
    }
    {
        const int c16 = 16 * lane;
        bf16_t* dst = wsb(a, lane < 32 ? RS_OFF : KS_OFF) + (c16 & 511);
        float swp[16], swc[16], swn[16];
#pragma unroll
        for (int i = 0; i < 16; ++i) { swp[i] = sw[c16 + i]; swc[i] = sw[UC + c16 + i]; swn[i] = sw[2 * UC + c16 + i]; }
        for (int t0 = gw; t0 < T; t0 += 2 * nw) {
            u32x4 c[2][2], p[2][2], n[2][2];
#pragma unroll
            for (int k = 0; k < 2; ++k) {
                const int t = t0 + k * nw; const int pos = t & 4095; const bool hp = pos > 0, hn = pos < 4095;
                const bf16_t* up = U + (size_t)t * UW + c16;
#pragma unroll
                for (int q = 0; q < 2; ++q) {
                    c[k][q] = *(const u32x4*)(up + 8 * q); p[k][q] = (u32x4){0u, 0u, 0u, 0u}; n[k][q] = (u32x4){0u, 0u, 0u, 0u};
                    if (hp) p[k][q] = *(const u32x4*)(up - UW + 8 * q);
                    if (hn) n[k][q] = *(const u32x4*)(up + UW + 8 * q);
                }
            }
#pragma unroll
            for (int k = 0; k < 2; ++k) {
                const int t = t0 + k * nw;
                u32x4 o[2];
#pragma unroll
                for (int q = 0; q < 2; ++q)
#pragma unroll
                    for (int i = 0; i < 4; ++i) {
                        const int e = 8 * q + 2 * i;
                        const float lo = swp[e] * bflo(p[k][q][i]) + swc[e] * bflo(c[k][q][i]) + swn[e] * bflo(n[k][q][i]);
                        const float hi = swp[e + 1] * bfhi(p[k][q][i]) + swc[e + 1] * bfhi(c[k][q][i]) + swn[e + 1] * bfhi(n[k][q][i]);
                        o[q][i] = pack2(lo, hi);
                    }
                *(u32x4*)(dst + (size_t)t * 512) = o[0]; *(u32x4*)(dst + (size_t)t * 512 + 8) = o[1];
            }
        }
    }
}
DEV void ph_rwkv_prep2(const Args& a, int layer, const int tid0) {
    const int lane = tid0 & 63, wv = tid0 >> 6;
    const int gw = blockIdx.x * 8 + wv, nw = gridDim.x * 8;
    bf16_t* U = wsb(a, U_OFF); const bf16_t* KS = wsb(a, KS_OFF);
    const float* sw = a.rwkv_shift + (size_t)layer * 3 * UC;
    const int c8 = 8 * lane;
    float kkc[8], sv[3][8];
#pragma unroll
    for (int i = 0; i < 8; ++i) { kkc[i] = a.rwkv_k_k[layer * 512 + c8 + i]; sv[0][i] = sw[1024 + c8 + i]; sv[1][i] = sw[UC + 1024 + c8 + i]; sv[2][i] = sw[2 * UC + 1024 + c8 + i]; }
    for (int t = gw; t < T; t += nw) {
        const int pos = t & 4095; const bool hp = pos > 0, hn = pos < 4095;
        bf16_t* up = U + (size_t)t * UW;
        const u32x4 ks = *(const u32x4*)(KS + (size_t)t * 512 + c8);
        const u32x4 c = *(const u32x4*)(up + 1024 + c8);
        u32x4 p = {0u, 0u, 0u, 0u}, n = {0u, 0u, 0u, 0u};
        if (hp) p = *(const u32x4*)(up - UW + 1024 + c8);
        if (hn) n = *(const u32x4*)(up + UW + 1024 + c8);
        float kx[8]; float ss = 0.f;
#pragma unroll
        for (int i = 0; i < 4; ++i) { kx[2 * i] = bflo(ks[i]) * kkc[2 * i]; kx[2 * i + 1] = bfhi(ks[i]) * kkc[2 * i + 1]; ss += kx[2 * i] * kx[2 * i] + kx[2 * i + 1] * kx[2 * i + 1]; }
        const float inv = 1.0f / fmaxf(sqrtf(sum8(ss)), 1e-12f);
        u32x4 ko, vo;
#pragma unroll
        for (int i = 0; i < 4; ++i) {
            ko[i] = pack2(kx[2 * i] * inv, kx[2 * i + 1] * inv);
            vo[i] = pack2(sv[0][2 * i] * bflo(p[i]) + sv[1][2 * i] * bflo(c[i]) + sv[2][2 * i] * bflo(n[i]), sv[0][2 * i + 1] * bfhi(p[i]) + sv[1][2 * i + 1] * bfhi(c[i]) + sv[2][2 * i + 1] * bfhi(n[i]));
        }
        *(u32x4*)(up + c8) = ko; *(u32x4*)(up + 1536 + c8) = vo;
    }
}

DEV void ph_scan3(const Args& a, int layer, float* lds, const int tid0) {
    const int tid = tid0, lane = tid & 63, wv = __builtin_amdgcn_readfirstlane(tid >> 6);
    float* vecs = lds;
    float* ybuf = lds + 2 * 12288;
    const bf16_t* U = wsb(a, U_OFF); const bf16_t* RS = wsb(a, RS_OFF); const bf16_t* KS = wsb(a, KS_OFF);
    bf16_t* Uw = wsb(a, U_OFF);
    const bool helper = wv >= 4;
    const int dir = helper ? ((wv - 4) >> 1) : (wv >> 1), part = wv & 1;
    const bf16_t* Wd = wsb(a, dir ? WB2_OFF : WF_OFF); const bf16_t* Ad = wsb(a, dir ? AB_OFF : AF_OFF);
    const int js = lane & 7, q = lane >> 3, r0 = 32 * part + 4 * q;
    for (int un = blockIdx.x; un < NSEQ * 8; un += gridDim.x) {
        const int seq = un >> 3, hd = un & 7; const size_t tb = (size_t)seq * 4096; const int cb = hd * 64, pch = cb + lane;
        const float kac = a.rwkv_k_a[layer * 512 + pch];
        f32x2 S[4][4];
#pragma unroll
        for (int rw = 0; rw < 4; ++rw)
#pragma unroll
            for (int i = 0; i < 4; ++i) S[rw][i] = (f32x2){0.f, 0.f};
#define SCAN_PREP(blk_, buf_) do { unsigned short pr_[8][6]; \
            _Pragma("unroll") for (int si = 0; si < 8; ++si) { const int step_ = (blk_) * 16 + part * 8 + si, pos_ = dir ? 4095 - step_ : step_; const size_t t_ = tb + pos_; \
                pr_[si][0] = Wd[t_ * 512 + pch]; pr_[si][1] = U[t_ * UW + pch]; pr_[si][2] = Ad[t_ * 512 + pch]; pr_[si][3] = KS[t_ * 512 + pch]; pr_[si][4] = RS[t_ * 512 + pch]; pr_[si][5] = U[t_ * UW + 1536 + pch]; } \
            _Pragma("unroll") for (int si = 0; si < 8; ++si) { float* o_ = vecs + (((buf_) * 2 + dir) * 16 + part * 8 + si) * 384 + lane; \
                const float w_ = bf2f(pr_[si][0]), kk_ = bf2f(pr_[si][1]), av_ = bf2f(pr_[si][2]), ks_ = bf2f(pr_[si][3]); \
                o_[0] = w_; o_[64] = -kk_; o_[128] = kk_ * av_; o_[192] = ks_ * (1.0f + (av_ - 1.0f) * kac); o_[256] = bf2f(pr_[si][4]); o_[320] = bf2f(pr_[si][5]); } } while (0)
        __syncthreads();
        if (helper) SCAN_PREP(0, 0);
        __syncthreads();
        for (int blk = 0; blk < 256; ++blk) {
            const int cur = blk & 1;
            if (helper) {
                if (blk + 1 < 256) SCAN_PREP(blk + 1, cur ^ 1);
                if (blk > 0) {
                    const int s2 = part * 8 + (lane >> 3), c8 = (lane & 7) * 8;
                    const float* yp = ybuf + (((cur ^ 1) * 2 + dir) * 16 + s2) * 64 + c8;
                    const f32x4 y0 = *(const f32x4*)(yp), y1 = *(const f32x4*)(yp + 4);
                    const int step = (blk - 1) * 16 + s2, pos = dir ? 4095 - step : step;
                    u32x4 pk; pk.x = pack2(y0[0], y0[1]); pk.y = pack2(y0[2], y0[3]); pk.z = pack2(y1[0], y1[1]); pk.w = pack2(y1[2], y1[3]);
                    *(u32x4*)(Uw + (tb + pos) * UW + 512 + 512 * dir + cb + c8) = pk;
                }
            } else {
                const float* vb0 = vecs + ((cur * 2 + dir) * 16) * 384;
                float* yb = ybuf + ((cur * 2 + dir) * 16) * 64 + r0;
                const float* vbl = vb0 + 8 * js;
                f32x4 cw0 = *(const f32x4*)(vbl), cw1 = *(const f32x4*)(vbl + 4), ca0 = *(const f32x4*)(vbl + 64), ca1 = *(const f32x4*)(vbl + 68), cb0 = *(const f32x4*)(vbl + 128), cb1 = *(const f32x4*)(vbl + 132);
                f32x4 ck0 = *(const f32x4*)(vbl + 192), ck1 = *(const f32x4*)(vbl + 196), cq0 = *(const f32x4*)(vbl + 256), cq1 = *(const f32x4*)(vbl + 260);
                f32x4 cv4 = *(const f32x4*)(vb0 + 320 + r0);
#pragma unroll
                for (int s = 0; s < 16; ++s) {
                    const f32x4 w0 = cw0, w1 = cw1, a0 = ca0, a1 = ca1, b0 = cb0, b1 = cb1, k0 = ck0, k1 = ck1, q0 = cq0, q1 = cq1, v4 = cv4;
                    if (s < 15) {
                        const float* vn = vbl + (s + 1) * 384;
                        cw0 = *(const f32x4*)(vn); cw1 = *(const f32x4*)(vn + 4); ca0 = *(const f32x4*)(vn + 64); ca1 = *(const f32x4*)(vn + 68); cb0 = *(const f32x4*)(vn + 128); cb1 = *(const f32x4*)(vn + 132);
                        ck0 = *(const f32x4*)(vn + 192); ck1 = *(const f32x4*)(vn + 196); cq0 = *(const f32x4*)(vn + 256); cq1 = *(const f32x4*)(vn + 260);
                        cv4 = *(const f32x4*)(vb0 + (s + 1) * 384 + 320 + r0);
                        asm volatile("" ::: "memory");
                    }
                    const f32x2 av[4] = {{a0[0], a0[1]}, {a0[2], a0[3]}, {a1[0], a1[1]}, {a1[2], a1[3]}};
                    const f32x2 wv2[4] = {{w0[0], w0[1]}, {w0[2], w0[3]}, {w1[0], w1[1]}, {w1[2], w1[3]}};
                    const f32x2 bv[4] = {{b0[0], b0[1]}, {b0[2], b0[3]}, {b1[0], b1[1]}, {b1[2], b1[3]}};
                    const f32x2 kv[4] = {{k0[0], k0[1]}, {k0[2], k0[3]}, {k1[0], k1[1]}, {k1[2], k1[3]}};
                    const f32x2 qv[4] = {{q0[0], q0[1]}, {q0[2], q0[3]}, {q1[0], q1[1]}, {q1[2], q1[3]}};
                    float sa[4];
#pragma unroll
                    for (int rw = 0; rw < 4; ++rw) { const f32x2 t0 = (S[rw][0] * av[0] + S[rw][1] * av[1]) + (S[rw][2] * av[2] + S[rw][3] * av[3]); sa[rw] = sum8(t0[0] + t0[1]); }
                    f32x4 yo;
#pragma unroll
                    for (int rw = 0; rw < 4; ++rw) {
                        f32x2 y2 = {0.f, 0.f};
#pragma unroll
                        for (int i = 0; i < 4; ++i) { S[rw][i] = S[rw][i] * wv2[i] + (bv[i] * sa[rw] + kv[i] * v4[rw]); y2 = y2 + S[rw][i] * qv[i]; }
                        yo[rw] = sum8(y2[0] + y2[1]);
                    }
                    if (js == 0) *(f32x4*)(yb + s * 64) = yo;
                }
            }
            __syncthreads();
        }
        if (helper) {
            const int cur = 1, blk = 256;
            const int s2 = part * 8 + (lane >> 3), c8 = (lane & 7) * 8;
            const float* yp = ybuf + ((cur * 2 + dir) * 16 + s2) * 64 + c8;
            const f32x4 y0 = *(const f32x4*)(yp), y1 = *(const f32x4*)(yp + 4);
            const int step = (blk - 1) * 16 + s2, pos = dir ? 4095 - step : step;
            u32x4 pk; pk.x = pack2(y0[0], y0[1]); pk.y = pack2(y0[2], y0[3]); pk.z = pack2(y1[0], y1[1]); pk.w = pack2(y1[2], y1[3]);
            *(u32x4*)(Uw + (tb + pos) * UW + 512 + 512 * dir + cb + c8) = pk;
        }
#undef SCAN_PREP
    }
}

DEV void ph_post2(const Args& a, int layer, const int tid0) {
    const int lane = tid0 & 63, wv = tid0 >> 6;
    const int gw = blockIdx.x * 8 + wv, nw = gridDim.x * 8;
    const bf16_t* U = wsb(a, U_OFF); const bf16_t* RS = wsb(a, RS_OFF); const bf16_t* KS = wsb(a, KS_OFF); const bf16_t* G = wsb(a, G_OFF);
    const bf16_t* AF = wsb(a, AF_OFF); const bf16_t* AB = wsb(a, AB_OFF); bf16_t* mix = wsb(a, MIX_OFF);
    const int c8 = 8 * lane;
    float kac[8], rkc[8], lnw[8], lnb[8];
#pragma unroll
    for (int i = 0; i < 8; ++i) { kac[i] = a.rwkv_k_a[layer * 512 + c8 + i]; rkc[i] = a.rwkv_r_k[layer * 512 + c8 + i]; lnw[i] = a.rwkv_ln_w[layer * 512 + c8 + i]; lnb[i] = a.rwkv_ln_b[layer * 512 + c8 + i]; }
    struct PostLd { u32x4 rp, kp, gp, afp, abp, yfp, ybp, vp; };
    for (int t0 = gw; t0 < T; t0 += 2 * nw) {
        PostLd L[2];
#pragma unroll
        for (int k = 0; k < 2; ++k) {
            const int t = t0 + k * nw; const bf16_t* up = U + (size_t)t * UW;
            L[k].rp = *(const u32x4*)(RS + (size_t)t * 512 + c8); L[k].kp = *(const u32x4*)(KS + (size_t)t * 512 + c8); L[k].gp = *(const u32x4*)(G + (size_t)t * 512 + c8);
            L[k].afp = *(const u32x4*)(AF + (size_t)t * 512 + c8); L[k].abp = *(const u32x4*)(AB + (size_t)t * 512 + c8);
            L[k].yfp = *(const u32x4*)(up + 512 + c8); L[k].ybp = *(const u32x4*)(up + 1024 + c8); L[k].vp = *(const u32x4*)(up + 1536 + c8);
        }
#pragma unroll
        for (int k = 0; k < 2; ++k) {
        const int t = t0 + k * nw;
        const u32x4 rp = L[k].rp, kp = L[k].kp, gp = L[k].gp, afp = L[k].afp, abp = L[k].abp, yfp = L[k].yfp, ybp = L[k].ybp, vp = L[k].vp;
        float y[8], rr[8], kk[8], vv[8], gg[8], sa[8];
#pragma unroll
        for (int i = 0; i < 4; ++i) {
            y[2 * i] = bflo(yfp[i]) + bflo(ybp[i]); y[2 * i + 1] = bfhi(yfp[i]) + bfhi(ybp[i]);
            rr[2 * i] = bflo(rp[i]); rr[2 * i + 1] = bfhi(rp[i]); kk[2 * i] = bflo(kp[i]); kk[2 * i + 1] = bfhi(kp[i]);
            vv[2 * i] = bflo(vp[i]); vv[2 * i + 1] = bfhi(vp[i]); gg[2 * i] = bflo(gp[i]); gg[2 * i + 1] = bfhi(gp[i]);
            sa[2 * i] = bflo(afp[i]) + bflo(abp[i]); sa[2 * i + 1] = bfhi(afp[i]) + bfhi(abp[i]);
        }
        float ysum = 0.f, bs = 0.f;
#pragma unroll
        for (int i = 0; i < 8; ++i) { ysum += y[i]; bs += rr[i] * kk[i] * (2.0f + (sa[i] - 2.0f) * kac[i]) * rkc[i]; }
        const float mu = sum8(ysum) * (1.0f / 64.0f);
        float vs = 0.f;
#pragma unroll
        for (int i = 0; i < 8; ++i) { y[i] -= mu; vs += y[i] * y[i]; }
        const float rstdv = rsqrtf(sum8(vs) * (1.0f / 64.0f) + 64e-5f);
        bs = sum8(bs);
        float o[8];
#pragma unroll
        for (int i = 0; i < 8; ++i) o[i] = (y[i] * rstdv * lnw[i] + lnb[i] + bs * vv[i]) * gg[i];
        u32x4 ov; ov.x = pack2(o[0], o[1]); ov.y = pack2(o[2], o[3]); ov.z = pack2(o[4], o[5]); ov.w = pack2(o[6], o[7]);
        *(u32x4*)(mix + (size_t)t * 1024 + 512 + c8) = ov;
        }
    }
}

#ifndef PEER_SYNC
#define PEER_SYNC 2
#endif
template <bool DRY> DEV void ph_peer_sliced(const Args& a, const int tid0) {
    const int lane = tid0 & 63, wv = tid0 >> 6;
    const int gw = blockIdx.x * 8 + wv, nw = gridDim.x * 8;
    bf16_t* hb = wsb(a, HB_OFF); float* rstd = wsf(a, RSTD_OFF);
    const int* TOPI = (const int*)(a.ws + TOPI_OFF); const float* TOPG = wsf(a, TOPG_OFF);
    const unsigned char* PU = a.ws + PTU_OFF; const unsigned char* PV = a.ws + PTV_OFF;
    const int c16 = 16 * lane;
    const bool b5 = lane & 32, b4 = lane & 16;
    const int nround = T / (nw * 4);
    for (int rd = 0; rd < nround; ++rd) {
        u32x4 xa[4], xb[4]; float out[4][16]; int e0[4], e1[4]; float g0[4], g1[4], rs[4];
#pragma unroll
        for (int tk = 0; tk < 4; ++tk) {
            const int t = gw + nw * (rd * 4 + tk);
            xa[tk] = *(const u32x4*)(hb + (size_t)t * 1024 + c16); xb[tk] = *(const u32x4*)(hb + (size_t)t * 1024 + c16 + 8);
            rs[tk] = rstd[t] * (1.0f / 256.0f);
            e0[tk] = TOPI[(size_t)t * 128 + lane]; e1[tk] = TOPI[(size_t)t * 128 + 64 + lane];
            g0[tk] = TOPG[(size_t)t * 128 + lane]; g1[tk] = TOPG[(size_t)t * 128 + 64 + lane];
#pragma unroll
            for (int i = 0; i < 16; ++i) out[tk][i] = 0.f;
        }
#pragma unroll 1
        for (int s = 0; s < 16; ++s) {
#pragma unroll
            for (int tk = 0; tk < 4; ++tk) {
                unsigned long long m0 = __ballot((e0[tk] >> 10) == s), m1 = __ballot((e1[tk] >> 10) == s);
                while (m0 | m1) {
                    int ex[4]; float gx[4];
#pragma unroll
                    for (int i = 0; i < 4; ++i) {
                        if (m0) { const int ix = __builtin_ctzll(m0); m0 &= m0 - 1; ex[i] = __builtin_amdgcn_readlane(e0[tk], ix); gx[i] = rl(g0[tk], ix); }
                        else if (m1) { const int ix = __builtin_ctzll(m1); m1 &= m1 - 1; ex[i] = __builtin_amdgcn_readlane(e1[tk], ix); gx[i] = rl(g1[tk], ix); }
                        else { ex[i] = ex[0]; gx[i] = 0.f; }
                    }
#ifdef PROBE_EMASK
                    if (DRY) {
#pragma unroll
                        for (int i = 0; i < 4; ++i) ex[i] &= PROBE_EMASK;
                    }
#endif
                    u32x4 ur[4], vr[4];
#pragma unroll
                    for (int i = 0; i < 4; ++i) { ur[i] = *(const u32x4*)(PU + (size_t)ex[i] * 1024 + c16); vr[i] = *(const u32x4*)(PV + (size_t)ex[i] * 1024 + c16); }
                    float d[4];
#pragma unroll
                    for (int i = 0; i < 4; ++i) {
                        float sm = 0.f;
#pragma unroll
                        for (int j = 0; j < 4; ++j) {
                            const f32x2 lo = __builtin_amdgcn_cvt_pk_f32_fp8((int)ur[i][j], false), hi = __builtin_amdgcn_cvt_pk_f32_fp8((int)ur[i][j], true);
                            const unsigned ulo = (__float_as_uint(lo[0]) >> 16) | (__float_as_uint(lo[1]) & 0xffff0000u), uhi = (__float_as_uint(hi[0]) >> 16) | (__float_as_uint(hi[1]) & 0xffff0000u);
                            const unsigned xlo = (j < 2) ? xa[tk][2 * j] : xb[tk][2 * j - 4], xhi = (j < 2) ? xa[tk][2 * j + 1] : xb[tk][2 * j - 3];
                            sm = dot2bf(ulo, xlo, sm); sm = dot2bf(uhi, xhi, sm);
                        }
                        d[i] = sm;
                    }
                    float r2[2];
#pragma unroll
                    for (int i = 0; i < 2; ++i) { const float send = b5 ? d[i] : d[2 + i], keep = b5 ? d[2 + i] : d[i]; r2[i] = keep + SHX(send, 32); }
                    const float send1 = b4 ? r2[0] : r2[1], keep1 = b4 ? r2[1] : r2[0];
                    const float dd = sum16(keep1 + SHX(send1, 16));
                    const float hp = rs[tk] * dd;
                    const float gl = 0.5f * hp * (1.0f + erff(hp * 0.70710678f)) * (1.0f / 32.0f);
#pragma unroll
                    for (int i = 0; i < 4; ++i) {
                        const float wi = rl(gl, 16 * i) * gx[i];
#pragma unroll
                        for (int j = 0; j < 4; ++j) {
                            const f32x2 lo = __builtin_amdgcn_cvt_pk_f32_fp8((int)vr[i][j], false), hi = __builtin_amdgcn_cvt_pk_f32_fp8((int)vr[i][j], true);
                            out[tk][4 * j] += wi * lo[0]; out[tk][4 * j + 1] += wi * lo[1]; out[tk][4 * j + 2] += wi * hi[0]; out[tk][4 * j + 3] += wi * hi[1];
                        }
                    }
                }
            }
        }
#pragma unroll
        for (int tk = 0; tk < 4; ++tk) {
            const int t = gw + nw * (rd * 4 + tk);
            float* hr = a.h + (size_t)t * 1024 + c16;
            f32x4 hv[4]; float ss = 0.f;
#pragma unroll
            for (int j = 0; j < 4; ++j) { hv[j] = *(const f32x4*)(hr + 4 * j);
#pragma unroll
                for (int c = 0; c < 4; ++c) { hv[j][c] += out[tk][4 * j + c]; ss += hv[j][c] * hv[j][c]; }
                if (!DRY) *(f32x4*)(hr + 4 * j) = hv[j]; }
            ss = wave_sum(ss);
            if (DRY && ss != -1.0f) continue;
            u32x4 p0, p1;
            p0.x = pack2(hv[0][0], hv[0][1]); p0.y = pack2(hv[0][2], hv[0][3]); p0.z = pack2(hv[1][0], hv[1][1]); p0.w = pack2(hv[1][2], hv[1][3]);
            p1.x = pack2(hv[2][0], hv[2][1]); p1.y = pack2(hv[2][2], hv[2][3]); p1.z = pack2(hv[3][0], hv[3][1]); p1.w = pack2(hv[3][2], hv[3][3]);
            *(u32x4*)(hb + (size_t)t * 1024 + c16) = p0; *(u32x4*)(hb + (size_t)t * 1024 + c16 + 8) = p1;
            if (lane == 0) rstd[t] = rsqrtf(ss * (1.0f / 1024.0f) + 1e-6f);
        }
        if ((rd % PEER_SYNC) == PEER_SYNC - 1 && rd + 1 < nround) {
            XcdBarrier b_; b_.bar = (unsigned*)(a.ws + BAR_OFF); b_.x = xb_xcc_id(); b_.st = (volatile LAS unsigned*)(smem_base() + LDS_BYTES - 16);
            xcd_barrier(b_, tid0);
        }
    }
}

#ifdef PROBE_EMASK
#define PEER_EM(e) (DRY ? ((e) & PROBE_EMASK) : (e))
#else
#define PEER_EM(e) (e)
#endif
template <bool DRY> DEV void ph_peer_pipe(const Args& a, const int tid0, const int gw, const int nw, const int ntok) {
    const int lane = tid0 & 63;
    bf16_t* hb = wsb(a, HB_OFF); float* rstd = wsf(a, RSTD_OFF); const float* ssq = wsf(a, SSQ_OFF);
    const int* TOPI = (const int*)(a.ws + TOPI_OFF); const float* TOPG = wsf(a, TOPG_OFF);
    const unsigned char* PU = a.ws + PTU_OFF; const unsigned char* PV = a.ws + PTV_OFF;
    const int c16 = 16 * lane;
    const bool b5 = lane & 32, b4 = lane & 16, b3 = lane & 8;
    const bool dost = DRY ? (__builtin_amdgcn_readfirstlane(TOPI[0]) == -12345) : true;
    u32x4 ur[2][8], vr[8];
    int e0, e1, e0n = 0, e1n = 0; float g0, g1, g0n = 0.f, g1n = 0.f;
    u32x4 xa, xb, xan = {0u, 0u, 0u, 0u}, xbn = {0u, 0u, 0u, 0u}; float rsv, rsn = 0.f;
#define PEER_ISSUE_U(slot_, b_, es0_, es1_) do { _Pragma("unroll") for (int i_ = 0; i_ < 8; ++i_) { const int k_ = (b_) * 8 + i_; \
        const int e_ = PEER_EM(__builtin_amdgcn_readlane((k_ < 64) ? (es0_) : (es1_), k_ & 63)); ur[slot_][i_] = *(const u32x4*)(PU + (size_t)e_ * 1024 + c16); } } while (0)
#define PEER_ISSUE_V(slot_, b_, es0_, es1_) do { _Pragma("unroll") for (int i_ = 0; i_ < 8; ++i_) { const int k_ = (b_) * 8 + i_; \
        const int e_ = PEER_EM(__builtin_amdgcn_readlane((k_ < 64) ? (es0_) : (es1_), k_ & 63)); vr[i_] = *(const u32x4*)(PV + (size_t)e_ * 1024 + c16); } } while (0)
    if (ntok <= 0) return;
    {   const int t0 = gw;
        e0 = TOPI[(size_t)t0 * 128 + lane]; e1 = TOPI[(size_t)t0 * 128 + 64 + lane]; g0 = TOPG[(size_t)t0 * 128 + lane]; g1 = TOPG[(size_t)t0 * 128 + 64 + lane];
        xa = *(const u32x4*)(hb + (size_t)t0 * 1024 + c16); xb = *(const u32x4*)(hb + (size_t)t0 * 1024 + c16 + 8); rsv = rstd_parts(ssq, t0); }
    PEER_ISSUE_U(0, 0, e0, e1);
#pragma unroll 1
    for (int j = 0; j < ntok; ++j) {
        const int t = gw + nw * j; const bool more = (j + 1 < ntok);
        float* hr = a.h + (size_t)t * 1024 + c16;
        if (more) { const int tn = t + nw;
            e0n = TOPI[(size_t)tn * 128 + lane]; e1n = TOPI[(size_t)tn * 128 + 64 + lane]; }
        const float rs = rsv * (1.0f / 256.0f);
        float out[16];
#pragma unroll
        for (int i = 0; i < 16; ++i) out[i] = 0.f;
#pragma unroll 1
        for (int b2 = 0; b2 < 16; b2 += 2)
#pragma unroll
        for (int bb = 0; bb < 2; ++bb) {
            const int b = b2 + bb;
            PEER_ISSUE_V(0, b, e0, e1);
            if (bb == 0) PEER_ISSUE_U(1, b + 1, e0, e1);
            else if (b < 15) PEER_ISSUE_U(0, b + 1, e0, e1);
            else if (more) PEER_ISSUE_U(0, 0, e0n, e1n);
            asm volatile("" ::: "memory");
            float d[8];
#pragma unroll
            for (int i = 0; i < 8; ++i) {
                float sm = 0.f;
#pragma unroll
                for (int q = 0; q < 4; ++q) {
                    const unsigned uw = ur[bb][i][q];
                    const f32x2 lo = __builtin_amdgcn_cvt_pk_f32_fp8((int)uw, false), hi = __builtin_amdgcn_cvt_pk_f32_fp8((int)uw, true);
                    const unsigned ulo = pack2(lo[0], lo[1]), uhi = pack2(hi[0], hi[1]);
                    const unsigned xlo = (q < 2) ? xa[2 * q] : xb[2 * q - 4], xhi = (q < 2) ? xa[2 * q + 1] : xb[2 * q - 3];
                    sm = dot2bf(ulo, xlo, sm); sm = dot2bf(uhi, xhi, sm);
                }
                d[i] = sm;
            }
            float r4[4], r2[2];
#pragma unroll
            for (int i = 0; i < 4; ++i) { const float send = b5 ? d[i] : d[4 + i], keep = b5 ? d[4 + i] : d[i]; r4[i] = keep + SHX(send, 32); }
#pragma unroll
            for (int i = 0; i < 2; ++i) { const float send = b4 ? r4[i] : r4[2 + i], keep = b4 ? r4[2 + i] : r4[i]; r2[i] = keep + SHX(send, 16); }
            const float send1 = b3 ? r2[0] : r2[1], keep1 = b3 ? r2[1] : r2[0];
            const float dd = sum8(keep1 + SHX(send1, 8));
            const float hp = rs * dd;
            const float gt = SHF((b < 8) ? g0 : g1, (b * 8 + (lane >> 3)) & 63);
            const float w = gt * 0.5f * hp * (1.0f + erff(hp * 0.70710678f)) * (1.0f / 32.0f);
#pragma unroll
            for (int i = 0; i < 8; ++i) {
                const float wi = rl(w, 8 * i);
#pragma unroll
                for (int q = 0; q < 4; ++q) {
                    const unsigned vw = vr[i][q];
                    const f32x2 lo = __builtin_amdgcn_cvt_pk_f32_fp8((int)vw, false), hi = __builtin_amdgcn_cvt_pk_f32_fp8((int)vw, true);
                    out[4 * q] += wi * lo[0]; out[4 * q + 1] += wi * lo[1]; out[4 * q + 2] += wi * hi[0]; out[4 * q + 3] += wi * hi[1];
                }
            }
        }
        if (more) { const int tn = t + nw;
            g0n = TOPG[(size_t)tn * 128 + lane]; g1n = TOPG[(size_t)tn * 128 + 64 + lane];
            xan = *(const u32x4*)(hb + (size_t)tn * 1024 + c16); xbn = *(const u32x4*)(hb + (size_t)tn * 1024 + c16 + 8); rsn = rstd_parts(ssq, tn); }
        float ss = 0.f;
        f32x4 hv[4];
#pragma unroll
        for (int q = 0; q < 4; ++q) hv[q] = *(const f32x4*)(hr + 4 * q);
#pragma unroll
        for (int q = 0; q < 4; ++q) {
#pragma unroll
            for (int c = 0; c < 4; ++c) { hv[q][c] += out[4 * q + c]; ss += hv[q][c] * hv[q][c]; }
            if (dost) *(f32x4*)(hr + 4 * q) = hv[q];
        }
        ss = wave_sum(ss);
        if (dost) {
            u32x4 p0, p1;
            p0.x = pack2(hv[0][0], hv[0][1]); p0.y = pack2(hv[0][2], hv[0][3]); p0.z = pack2(hv[1][0], hv[1][1]); p0.w = pack2(hv[1][2], hv[1][3]);
            p1.x = pack2(hv[2][0], hv[2][1]); p1.y = pack2(hv[2][2], hv[2][3]); p1.z = pack2(hv[3][0], hv[3][1]); p1.w = pack2(hv[3][2], hv[3][3]);
            *(u32x4*)(hb + (size_t)t * 1024 + c16) = p0; *(u32x4*)(hb + (size_t)t * 1024 + c16 + 8) = p1;
            if (lane == 0) rstd[t] = rsqrtf(ss * (1.0f / 1024.0f) + 1e-6f);
        }
        e0 = e0n; e1 = e1n; g0 = g0n; g1 = g1n; xa = xan; xb = xbn; rsv = rsn;
    }
#undef PEER_ISSUE_U
#undef PEER_ISSUE_V
}

#ifndef PEER_NCH
#define PEER_NCH 8
#endif
#ifndef PEER_NPW
#define PEER_NPW 3
#endif
DEV void ph_topk_peer(const Args& a, float* lds, const int tid0) {
    const int wv = __builtin_amdgcn_readfirstlane(tid0 >> 6);
    constexpr int CH = T / PEER_NCH;
    const int npeer = gridDim.x * PEER_NPW, ntopk = gridDim.x * (8 - PEER_NPW);
#pragma unroll 1
    for (int s = 0; s <= PEER_NCH; ++s) {
        const int w8 = blockIdx.x * 8 + wv, n8 = gridDim.x * 8;
        if (s == 0) {
            ph_topk2(a, lds, tid0, w8, n8, CH * (8 / TOPK_NU));
        } else if (s == PEER_NCH) {
            ph_peer_pipe<false>(a, tid0, (s - 1) * CH + w8, n8, (CH - w8 + n8 - 1) / n8);
        } else if (wv < PEER_NPW) {
            const int pw = blockIdx.x * PEER_NPW + wv; ph_peer_pipe<false>(a, tid0, (s - 1) * CH + pw, npeer, (CH - pw + npeer - 1) / npeer);
        } else {
            const int tw = blockIdx.x * (8 - PEER_NPW) + (wv - PEER_NPW); ph_topk2(a, lds, tid0, s * CH * (8 / TOPK_NU) + tw, ntopk, (s + 1) * CH * (8 / TOPK_NU));
        }
        XcdBarrier b_; b_.bar = (unsigned*)(a.ws + BAR_OFF); b_.x = xb_xcc_id(); b_.st = (volatile LAS unsigned*)(smem_base() + LDS_BYTES - 16);
        xcd_barrier(b_, tid0);
    }
}

typedef float f32x4v __attribute__((ext_vector_type(4)));
#define MFMA16(a, b, c) __builtin_amdgcn_mfma_f32_16x16x32_bf16((a), (b), (c), 0, 0, 0)
namespace sc4 {
constexpr int E_AH = 0, E_RH = 2304, E_BH = 4608, E_KH = 6912, E_BHT = 9216, E_KHT = 12288, E_VT = 15360, E_GC = 18432, E_BYTES = 18688;
constexpr int G_NKAT = 0, G_NBRT = 768, G_NKRT = 1536, G_BYTES = 2304;
constexpr int OFF_E = 0, OFF_G = 6 * E_BYTES, OFF_NBAT = OFF_G + 4 * G_BYTES, OFF_TT = OFF_NBAT + 4 * 1024, OFF_Y = OFF_TT + 4 * 768, TOTAL = OFF_Y + 16384;
}
DEV bf16x8 frag2(u32x2 lo, u32x2 hi) { u32x4 v; v.x = lo.x; v.y = lo.y; v.z = hi.x; v.w = hi.y; return __builtin_bit_cast(bf16x8, v); }
DEV bf16x8 pack_acc(f32x4v p, f32x4v q) { u32x4 v; v.x = pack2(p[0], p[1]); v.y = pack2(p[2], p[3]); v.z = pack2(q[0], q[1]); v.w = pack2(q[2], q[3]); return __builtin_bit_cast(bf16x8, v); }
DEV void ph_scan4(const Args& a, int layer, unsigned char* lb, const int tid0) {
    using namespace sc4;
    static_assert(TOTAL <= LDS_BYTES - 16, "scan LDS map");
    const int lane = tid0 & 63, wv = __builtin_amdgcn_readfirstlane(tid0 >> 6);
    const int r = lane & 15, g = lane >> 4;
    const bf16_t* U = wsb(a, U_OFF); const bf16_t* RS = wsb(a, RS_OFF); const bf16_t* KS = wsb(a, KS_OFF); bf16_t* Uw = wsb(a, U_OFF);
    const bool is_state = wv < 4;
    const int dir = is_state ? (wv >> 1) : ((wv - 4) >> 1), role = wv & 1;
    const bf16_t* Wd = wsb(a, dir ? WB2_OFF : WF_OFF); const bf16_t* Ad = wsb(a, dir ? AB_OFF : AF_OFF);
    const u32x2 z2 = {0u, 0u}; const u32x4 z4 = {0u, 0u, 0u, 0u};
    for (int un = blockIdx.x; un < NSEQ * 8; un += gridDim.x) {
        const int seq = un >> 3, hd = un & 7; const size_t tb = (size_t)seq * 4096; const int cb = hd * 64, pch = cb + lane;
        const float kac = a.rwkv_k_a[layer * 512 + pch];
#define SC4_ISSUE(n_) do { _Pragma("unroll") for (int s_ = 0; s_ < 16; ++s_) { const int step_ = (n_) * 16 + s_, pos_ = dir ? 4095 - step_ : step_; const size_t t_ = tb + pos_; \
            pr[s_][0] = Wd[t_ * 512 + pch]; pr[s_][1] = U[t_ * UW + pch]; pr[s_][2] = Ad[t_ * 512 + pch]; pr[s_][3] = KS[t_ * 512 + pch]; pr[s_][4] = RS[t_ * 512 + pch]; pr[s_][5] = U[t_ * UW + 1536 + pch]; } } while (0)
        __syncthreads();
        if (is_state) {
            f32x4v X[4][2];
#pragma unroll
            for (int m = 0; m < 4; ++m)
#pragma unroll
                for (int vt = 0; vt < 2; ++vt) X[m][vt] = (f32x4v){0.f, 0.f, 0.f, 0.f};
#pragma unroll 1
            for (int p = 0; p < 260; ++p) {
                if (p >= 2 && p < 258) {
                    const int n = p - 2;
                    const unsigned char* E = lb + OFF_E + (dir * 3 + (n % 3)) * E_BYTES;
                    const unsigned char* G = lb + OFF_G + (dir * 2 + (n & 1)) * G_BYTES;
                    float* yb = (float*)(lb + OFF_Y) + (((n & 1) * 2 + dir) * 16) * 64 + 32 * role;
                    bf16x8 fa[2], fr[2];
#pragma unroll
                    for (int s = 0; s < 2; ++s) {
                        fa[s] = frag2(*(const u32x2*)(E + E_AH + r * 144 + 2 * (32 * s + 4 * g)), *(const u32x2*)(E + E_AH + r * 144 + 2 * (32 * s + 16 + 4 * g)));
                        fr[s] = frag2(*(const u32x2*)(E + E_RH + r * 144 + 2 * (32 * s + 4 * g)), *(const u32x2*)(E + E_RH + r * 144 + 2 * (32 * s + 16 + 4 * g)));
                    }
                    const int g1 = g & 1;
                    u32x4 nka = *(const u32x4*)(G + G_NKAT + r * 48 + 16 * g1), nkr = *(const u32x4*)(G + G_NKRT + r * 48 + 16 * g1);
                    if (g >= 2) { nka = z4; nkr = z4; }
                    const bf16x8 fnka = __builtin_bit_cast(bf16x8, nka), fnkr = __builtin_bit_cast(bf16x8, nkr);
                    bf16x8 ftt;
                    {
                        const float* nbat = (const float*)(lb + OFF_NBAT + (dir * 2 + (n & 1)) * 1024);
                        unsigned char* tts = lb + OFF_TT + wv * 768;
                        float Tr[16];
#pragma unroll
                        for (int tg = 0; tg < 4; ++tg) {
                            f32x4v nbq[4][4];
#pragma unroll
                            for (int tt = 0; tt < 4; ++tt)
#pragma unroll
                                for (int i4 = 0; i4 < 4; ++i4) if (4 * i4 < 4 * tg + tt) nbq[tt][i4] = *(const f32x4v*)(nbat + (4 * tg + tt) * 16 + 4 * i4);
#pragma unroll
                            for (int tt = 0; tt < 4; ++tt) {
                                const int t = 4 * tg + tt;
                                float acc = (lane == t) ? 1.0f : 0.f, acc2 = 0.f;
#pragma unroll
                                for (int i = 0; i < t; ++i) { const float pr_ = Tr[i] * nbq[tt][i >> 2][i & 3]; if (i & 1) acc2 += pr_; else acc += pr_; }
                                acc += acc2; Tr[t] = acc;
                                if (lane < 16) *(unsigned short*)(tts + t * 48 + 2 * lane) = (unsigned short)f2bf(acc);
                            }
                        }
                        asm volatile("s_waitcnt lgkmcnt(0)" ::: "memory");
                        ftt = frag2(*(const u32x2*)(tts + r * 48 + 8 * g), z2);
                    }
                    const bf16x8 fnbr = frag2(*(const u32x2*)(G + G_NBRT + r * 48 + 8 * g), z2);
                    bf16x8 fbt[4], fkt[4]; f32x4v gc[4];
#pragma unroll
                    for (int m = 0; m < 4; ++m) {
                        fbt[m] = frag2(*(const u32x2*)(E + E_BHT + (16 * m + r) * 48 + 8 * g), z2);
                        u32x4 kt = *(const u32x4*)(E + E_KHT + (16 * m + r) * 48 + 16 * g1); if (g >= 2) kt = z4; fkt[m] = __builtin_bit_cast(bf16x8, kt);
                        gc[m] = *(const f32x4v*)(E + E_GC + 4 * (16 * m + 4 * g));
                    }
#pragma unroll
                    for (int vt = 0; vt < 2; ++vt) {
                        const int v0 = 32 * role + 16 * vt;
                        u32x4 vv = *(const u32x4*)(E + E_VT + (v0 + r) * 48 + 16 * g1); if (g >= 2) vv = z4;
                        const bf16x8 vb = __builtin_bit_cast(bf16x8, vv);
                        const bf16x8 xb0 = pack_acc(X[0][vt], X[1][vt]), xb1 = pack_acc(X[2][vt], X[3][vt]);
                        f32x4v W = {0.f, 0.f, 0.f, 0.f};
                        W = MFMA16(fa[0], xb0, W); W = MFMA16(fa[1], xb1, W); W = MFMA16(fnka, vb, W);
                        const f32x4v zero4 = {0.f, 0.f, 0.f, 0.f};
                        f32x4v Uc = MFMA16(ftt, pack_acc(W, zero4), zero4);
                        const bf16x8 ub = pack_acc(Uc, zero4);
                        f32x4v Y = {0.f, 0.f, 0.f, 0.f};
                        Y = MFMA16(fr[0], xb0, Y); Y = MFMA16(fr[1], xb1, Y); Y = MFMA16(fnbr, ub, Y); Y = MFMA16(fnkr, vb, Y);
#pragma unroll
                        for (int i = 0; i < 4; ++i) yb[(4 * g + i) * 64 + 16 * vt + r] = Y[i];
#pragma unroll
                        for (int m = 0; m < 4; ++m) { f32x4v xm = MFMA16(fbt[m], ub, X[m][vt]); xm = MFMA16(fkt[m], vb, xm); X[m][vt] = xm * gc[m]; }
                    }
                }
                __syncthreads();
            }
        } else {
            unsigned short prA[8][6], pwA[8], prB[8][6], pwB[8];
#define SC5_ISSUE(pr, pw, n_) do { _Pragma("unroll") for (int s_ = 0; s_ < 8; ++s_) { const int step_ = (n_) * 16 + 8 * role + s_, pos_ = dir ? 4095 - step_ : step_; const size_t t_ = tb + pos_; \
            pr[s_][0] = Wd[t_ * 512 + pch]; pr[s_][1] = U[t_ * UW + pch]; pr[s_][2] = Ad[t_ * 512 + pch]; pr[s_][3] = KS[t_ * 512 + pch]; pr[s_][4] = RS[t_ * 512 + pch]; pr[s_][5] = U[t_ * UW + 1536 + pch]; \
            if (role) { const int st0_ = (n_) * 16 + s_, p0_ = dir ? 4095 - st0_ : st0_; pw[s_] = Wd[(tb + p0_) * 512 + pch]; } } } while (0)
            SC5_ISSUE(prA, pwA, 0); SC5_ISSUE(prB, pwB, 1);
#define SC5_PERIOD(pr, pw, p_) do { const int p = (p_); \
                if (p < 256) { \
                    unsigned char* E = lb + OFF_E + (dir * 3 + (p % 3)) * E_BYTES; \
                    float gcur = 1.0f; \
                    if (role) { \
_Pragma("unroll") \
                        for (int s = 0; s < 8; ++s) gcur *= bf2f(pw[s]); \
                    } \
                    unsigned bt[4], kt[4], vtw[4]; \
_Pragma("unroll") \
                    for (int s = 0; s < 8; ++s) { \
                        const int st = 8 * role + s; \
                        const float w_ = bf2f(pr[s][0]), kk_ = bf2f(pr[s][1]), ic_ = bf2f(pr[s][2]), ks_ = bf2f(pr[s][3]), r_ = bf2f(pr[s][4]); \
                        const float gprev = gcur; gcur *= w_; \
                        const float ig = __builtin_amdgcn_rcpf(gcur); \
                        const unsigned ah = f2bf(-gprev * kk_), bh = f2bf(kk_ * ic_ * ig), kh = f2bf(ks_ * (1.0f + (ic_ - 1.0f) * kac) * ig), rh = f2bf(gcur * r_), vh = pr[s][5]; \
                        *(unsigned short*)(E + E_AH + st * 144 + 2 * lane) = (unsigned short)ah; *(unsigned short*)(E + E_RH + st * 144 + 2 * lane) = (unsigned short)rh; \
                        *(unsigned short*)(E + E_BH + st * 144 + 2 * lane) = (unsigned short)bh; *(unsigned short*)(E + E_KH + st * 144 + 2 * lane) = (unsigned short)kh; \
                        if (s & 1) { bt[s >> 1] |= bh << 16; kt[s >> 1] |= kh << 16; vtw[s >> 1] |= vh << 16; } else { bt[s >> 1] = bh; kt[s >> 1] = kh; vtw[s >> 1] = vh; } \
                    } \
                    *(u32x4*)(E + E_BHT + lane * 48 + 16 * role) = (u32x4){bt[0], bt[1], bt[2], bt[3]}; \
                    *(u32x4*)(E + E_KHT + lane * 48 + 16 * role) = (u32x4){kt[0], kt[1], kt[2], kt[3]}; \
                    *(u32x4*)(E + E_VT + lane * 48 + 16 * role) = (u32x4){vtw[0], vtw[1], vtw[2], vtw[3]}; \
                    if (role) *(float*)(E + E_GC + 4 * lane) = gcur; \
                } \
                if (role == 0) { \
                    if (p >= 1 && p < 257) { \
                        const int n = p - 1; \
                        const unsigned char* E = lb + OFF_E + (dir * 3 + (n % 3)) * E_BYTES; \
                        unsigned char* G = lb + OFF_G + (dir * 2 + (n & 1)) * G_BYTES; \
                        float* nbat = (float*)(lb + OFF_NBAT + (dir * 2 + (n & 1)) * 1024); \
                        bf16x8 ab[2], rb[2], bA[2], kA[2]; \
_Pragma("unroll") \
                        for (int s = 0; s < 2; ++s) { \
                            ab[s] = *(const bf16x8*)(E + E_AH + r * 144 + 2 * (32 * s + 8 * g)); rb[s] = *(const bf16x8*)(E + E_RH + r * 144 + 2 * (32 * s + 8 * g)); \
                            bA[s] = *(const bf16x8*)(E + E_BH + r * 144 + 2 * (32 * s + 8 * g)); kA[s] = *(const bf16x8*)(E + E_KH + r * 144 + 2 * (32 * s + 8 * g)); \
                        } \
                        const f32x4v zero4 = {0.f, 0.f, 0.f, 0.f}; \
                        f32x4v nba = MFMA16(bA[1], ab[1], MFMA16(bA[0], ab[0], zero4)), nka = MFMA16(kA[1], ab[1], MFMA16(kA[0], ab[0], zero4)); \
                        f32x4v nbr = MFMA16(bA[1], rb[1], MFMA16(bA[0], rb[0], zero4)), nkr = MFMA16(kA[1], rb[1], MFMA16(kA[0], rb[0], zero4)); \
_Pragma("unroll") \
                        for (int i = 0; i < 4; ++i) { const int j = 4 * g + i; if (j >= r) { nba[i] = 0.f; nka[i] = 0.f; } if (j > r) { nbr[i] = 0.f; nkr[i] = 0.f; } } \
                        *(f32x4v*)(nbat + r * 16 + 4 * g) = nba; \
                        u32x2 pk; pk.x = pack2(nka[0], nka[1]); pk.y = pack2(nka[2], nka[3]); *(u32x2*)(G + G_NKAT + r * 48 + 8 * g) = pk; \
                        pk.x = pack2(nbr[0], nbr[1]); pk.y = pack2(nbr[2], nbr[3]); *(u32x2*)(G + G_NBRT + r * 48 + 8 * g) = pk; \
                        pk.x = pack2(nkr[0], nkr[1]); pk.y = pack2(nkr[2], nkr[3]); *(u32x2*)(G + G_NKRT + r * 48 + 8 * g) = pk; \
                    } \
                } else { \
                    if (p >= 3 && p < 259) { \
                        const int n = p - 3; \
                        const float* yb = (const float*)(lb + OFF_Y) + (((n & 1) * 2 + dir) * 16) * 64; \
                        const int s2 = lane >> 2, c16 = (lane & 3) * 16; \
                        const f32x4v y0 = *(const f32x4v*)(yb + s2 * 64 + c16), y1 = *(const f32x4v*)(yb + s2 * 64 + c16 + 4), y2 = *(const f32x4v*)(yb + s2 * 64 + c16 + 8), y3 = *(const f32x4v*)(yb + s2 * 64 + c16 + 12); \
                        const int step = n * 16 + s2, pos = dir ? 4095 - step : step; \
                        u32x4 o0, o1; o0.x = pack2(y0[0], y0[1]); o0.y = pack2(y0[2], y0[3]); o0.z = pack2(y1[0], y1[1]); o0.w = pack2(y1[2], y1[3]); \
                        o1.x = pack2(y2[0], y2[1]); o1.y = pack2(y2[2], y2[3]); o1.z = pack2(y3[0], y3[1]); o1.w = pack2(y3[2], y3[3]); \
                        bf16_t* dst = Uw + (tb + pos) * UW + 512 + 512 * dir + cb + c16; \
                        *(u32x4*)(dst) = o0; *(u32x4*)(dst + 8) = o1; \
                    } \
                } \
                if (p + 2 < 256) SC5_ISSUE(pr, pw, p + 2); \
                __syncthreads(); \
            } while (0)
#pragma unroll 1
            for (int p2 = 0; p2 < 260; p2 += 2) { SC5_PERIOD(prA, pwA, p2); SC5_PERIOD(prB, pwB, p2 + 1); }
#undef SC5_PERIOD
#undef SC5_ISSUE
        }
#undef SC4_ISSUE
    }
}

extern __shared__ __attribute__((aligned(16))) unsigned char smem[];

enum { PH_PROLOGUE = 0, PH_ROWPREP_X, PH_ROWPREP, PH_GEMM1, PH_ATTN, PH_ATTNX, PH_MERGE, PH_LORA, PH_PREP2, PH_SCAN, PH_POST, PH_GEMM2, PH_CONVERT, PH_GEMM3, PH_TOPK, PH_PEER, PH_PEERDRY, PH_TOPKPEER, PH_GEMM4A, PH_GEMM4B, PH_FINAL };

template <int PH> DEV void run_phase(const Args& a, int layer, const int tid0) {
    float* ldsf = (float*)smem;
    PG8_LAS unsigned char* ldsg = (PG8_LAS unsigned char*)smem;
    const bf16_t* wb = wsb(a, WB_OFF + (size_t)layer * WB_LAYER);
    if constexpr (PH == PH_PROLOGUE) ph_prologue(a, ldsf, tid0);
    else if constexpr (PH == PH_ROWPREP_X) ph_rowprep(a, true, tid0);
    else if constexpr (PH == PH_ROWPREP) ph_rowprep(a, false, tid0);
    else if constexpr (PH == PH_GEMM1) {
        pg8::Gemm g{wsb(a, HB_OFF), wb + WB_IN / 2, T, INP, 1024};
        pg8::StaticOrder S; S.init(T, INP, gridDim.x, blockIdx.x);
        pg8::EpiProj E{wsb(a, QKV_OFF), wsb(a, U_OFF), wsf(a, SSQ_OFF), wsf(a, ROPEC_OFF), wsf(a, ROPES_OFF)};
        pg8::gemm_phase<pg8::EpiProj, pg8::StaticOrder, false>(ldsg, g, S, E, nullptr, tid0);
    }
    else if constexpr (PH == PH_ATTN) ph_attn3(a, layer, smem, tid0);
    else if constexpr (PH == PH_ATTNX) ph_attn2<ATTN_VAR>(a, smem, tid0);
    else if constexpr (PH == PH_MERGE) ph_attn_merge(a, layer, tid0);
    else if constexpr (PH == PH_LORA) ph_rwkv_prep1(a, layer, smem, tid0);
    else if constexpr (PH == PH_PREP2) ph_rwkv_prep2(a, layer, tid0);
    else if constexpr (PH == PH_SCAN) ph_scan4(a, layer, smem, tid0);
    else if constexpr (PH == PH_POST) ph_post2(a, layer, tid0);
    else if constexpr (PH == PH_GEMM2) {
        pg8::Gemm g{wsb(a, MIX_OFF), wb + WB_OUT / 2, T, 1024, 1024};
        pg8::StaticOrder S; S.init(T, 1024, gridDim.x, blockIdx.x);
        pg8::EpiF32x<1> E{a.h, 1024, nullptr, wsb(a, HB_OFF), wsf(a, SSQ_OFF)};
        pg8::gemm_phase<pg8::EpiF32x<1>, pg8::StaticOrder, false>(ldsg, g, S, E, nullptr, tid0);
    }
    else if constexpr (PH == PH_CONVERT) ph_convert8(a, layer, tid0);
    else if constexpr (PH == PH_GEMM3) {
        pg8::Gemm g{wsb(a, HB_OFF), wb + WB_QK / 2, T, 2048, 1024};
        pg8::StaticOrder S; S.init(T, 2048, gridDim.x, blockIdx.x);
        pg8::EpiF32x<0> E{wsf(a, SC_OFF), 2048, nullptr, nullptr, nullptr};
        pg8::gemm_phase<pg8::EpiF32x<0>, pg8::StaticOrder, false>(ldsg, g, S, E, nullptr, tid0);
    }
    else if constexpr (PH == PH_TOPK) ph_topk2(a, ldsf, tid0, blockIdx.x * 8 + (tid0 >> 6), gridDim.x * 8, T * (8 / TOPK_NU));
    else if constexpr (PH == PH_TOPKPEER) ph_topk_peer(a, ldsf, tid0);
    else if constexpr (PH == PH_PEER) ph_peer_pipe<false>(a, tid0, blockIdx.x * 8 + (tid0 >> 6), gridDim.x * 8, T / (gridDim.x * 8));
    else if constexpr (PH == PH_PEERDRY) ph_peer_pipe<true>(a, tid0, blockIdx.x * 8 + (tid0 >> 6), gridDim.x * 8, T / (gridDim.x * 8));
    else if constexpr (PH == PH_GEMM4A) {
        pg8::Gemm g{wsb(a, HB_OFF), wb + WB_GATE / 2, T, 1024, 1024};
        pg8::StaticOrder S; S.init(T, 1024, gridDim.x, blockIdx.x);
        pg8::EpiGate E{wsb(a, GATE_OFF), wsf(a, RSTD_OFF), a.ple_b_gate + layer * 1024};
        pg8::gemm_phase<pg8::EpiGate, pg8::StaticOrder, false>(ldsg, g, S, E, nullptr, tid0);
    }
    else if constexpr (PH == PH_GEMM4B) {
        pg8::Gemm g{wsb(a, PB_OFF), wb + WB_PROJ / 2, T, 1024, 256};
        pg8::StaticOrder S; S.init(T, 1024, gridDim.x, blockIdx.x);
        pg8::EpiF32x<2> E{a.h, 1024, wsb(a, GATE_OFF), wsb(a, HB_OFF), wsf(a, SSQ_OFF)};
        pg8::gemm_phase<pg8::EpiF32x<2>, pg8::StaticOrder, false>(ldsg, g, S, E, nullptr, tid0);
    }
    else if constexpr (PH == PH_FINAL) ph_final(a, tid0);
}

#if !ONE_LAUNCH
template <int PH> __global__ void __launch_bounds__(NTHR, 2) k_phase(Args a, int layer) { run_phase<PH>(a, layer, (int)threadIdx.x); }
#endif

#if ONE_LAUNCH
#ifndef REP_PEER
#define REP_PEER 1
#endif
#ifndef REP_SCAN
#define REP_SCAN 1
#endif
#ifndef REP_TOPK
#define REP_TOPK 1
#endif
#ifndef REP_GEMM1
#define REP_GEMM1 1
#endif
#ifndef REP_LORA
#define REP_LORA 1
#endif
#ifndef REP_POST
#define REP_POST 1
#endif
#ifndef REP_ATTN
#define REP_ATTN 1
#endif
#ifndef REP_GEMM3
#define REP_GEMM3 1
#endif
typedef const __attribute__((address_space(4))) unsigned long long* kargs_t;
static_assert(sizeof(Args) == 31 * 8, "Args is 31 pointers, no padding");
#define AS1 __attribute__((address_space(1)))
DEV Args load_args(kargs_t kp) {
    Args r; const float** d = (const float**)&r;
#pragma unroll
    for (int i = 0; i < 29; ++i) d[i] = (const float*)(AS1 const float*)kp[i];
    r.h = (float*)(AS1 float*)kp[29]; r.ws = (unsigned char*)(AS1 unsigned char*)kp[30];
    return r; }
#define RUN(PH, layer) do { kargs_t kp_ = (kargs_t)__builtin_amdgcn_kernarg_segment_ptr(); asm volatile("" : "+s"(kp_)); const Args la_ = load_args(kp_); int t_; asm volatile("v_mbcnt_lo_u32_b32 %0, -1, 0\n\tv_mbcnt_hi_u32_b32 %0, -1, %0\n\tv_lshl_add_u32 %0, %1, 6, %0" : "=&v"(t_) : "s"(wv0_)); run_phase<PH>(la_, layer, t_); } while (0)
#define BAR() do { kargs_t kp_ = (kargs_t)__builtin_amdgcn_kernarg_segment_ptr(); asm volatile("" : "+s"(kp_)); XcdBarrier b_; b_.bar = (unsigned*)((unsigned char*)kp_[30] + BAR_OFF); b_.x = xb_xcc_id(); b_.st = (volatile LAS unsigned*)(smem + LDS_BYTES - 16); int t_; asm volatile("v_mbcnt_lo_u32_b32 %0, -1, 0\n\tv_mbcnt_hi_u32_b32 %0, -1, %0\n\tv_lshl_add_u32 %0, %1, 6, %0" : "=&v"(t_) : "s"(wv0_)); xcd_barrier(b_, t_); } while (0)
#define LAYER_BODY(layer) do { \
        for (int rep_ = 0; rep_ < REP_GEMM1; ++rep_) { RUN(PH_GEMM1, layer); BAR(); } \
        if (REP_ATTNX) { RUN(PH_ATTNX, layer); BAR(); } \
        for (int rep_ = 0; rep_ < REP_ATTN; ++rep_) { RUN(PH_ATTN, layer); BAR(); } \
        for (int rep_ = 0; rep_ < REP_LORA; ++rep_) { RUN(PH_LORA, layer); BAR(); } \
        for (int rep_ = 0; rep_ < REP_PREP2; ++rep_) { RUN(PH_PREP2, layer); BAR(); } \
        for (int rep_ = 0; rep_ < REP_SCAN; ++rep_) { RUN(PH_SCAN, layer); BAR(); } \
        for (int rep_ = 0; rep_ < REP_POST; ++rep_) { RUN(PH_POST, layer); BAR(); } \
        RUN(PH_GEMM2, layer); BAR(); \
        for (int rep_ = 0; rep_ < REP_CONVERT; ++rep_) { RUN(PH_CONVERT, layer); BAR(); } \
        for (int rep_ = 0; rep_ < REP_GEMM3; ++rep_) { RUN(PH_GEMM3, layer); BAR(); } \
        RUN(PH_TOPKPEER, layer); \
        for (int rep_ = 0; rep_ < REP_GEMM4A; ++rep_) { RUN(PH_GEMM4A, layer); BAR(); } \
        RUN(PH_GEMM4B, layer); BAR(); \
    } while (0)
__global__ void __launch_bounds__(NTHR, 2) k_mega(Args a) {
    if (threadIdx.x == 0) *(uint4*)(smem + LDS_BYTES - 16) = make_uint4(0u, 0u, 0u, 0u);
    __syncthreads();
    (void)xcd_barrier_post((unsigned*)(a.ws + BAR_OFF), (volatile LAS unsigned*)(smem + LDS_BYTES - 16));
    const int wv0_ = __builtin_amdgcn_readfirstlane((int)threadIdx.x >> 6);
    RUN(PH_PROLOGUE, 0);
    RUN(PH_ROWPREP_X, 0); BAR();
    LAYER_BODY(0); LAYER_BODY(1); LAYER_BODY(2); LAYER_BODY(3);
    RUN(PH_FINAL, 0);
}
#endif

#if !ONE_LAUNCH
template <int PH> static void launch_phase(const Args& a, int layer, hipStream_t st) {
    static bool attr = false;
    if (!attr) { (void)hipFuncSetAttribute((const void*)k_phase<PH>, hipFuncAttributeMaxDynamicSharedMemorySize, LDS_BYTES); attr = true; }
    hipLaunchKernelGGL(k_phase<PH>, dim3(NWG), dim3(NTHR), LDS_BYTES, st, a, layer);
}
#endif

extern "C" void kernel_launch(void* const* d_in, const int* in_sizes, int n_in, void* d_out, int out_size, void* d_ws, size_t ws_size, hipStream_t stream) {
    if (n_in != 29 || out_size != T * D || ws_size < WS_END) {
        fprintf(stderr, "kernel_launch: unexpected shapes (n_in %d, out %d, ws %zu, need %zu); nothing launched\n", n_in, out_size, ws_size, (size_t)WS_END);
        return;
    }
    Args a{};
    const float** ap = (const float**)&a;
    for (int i = 0; i < 29; ++i) ap[i] = (const float*)d_in[i];
    a.h = (float*)d_out; a.ws = (unsigned char*)d_ws;
#if ONE_LAUNCH
    static bool attr = false;
    if (!attr) { (void)hipFuncSetAttribute((const void*)k_mega, hipFuncAttributeMaxDynamicSharedMemorySize, LDS_BYTES); attr = true; }
    (void)hipMemsetAsync((char*)d_ws + BAR_OFF, 0, XCD_BAR_WORDS * sizeof(unsigned), stream);
    hipLaunchKernelGGL(k_mega, dim3(NWG), dim3(NTHR), LDS_BYTES, stream, a);
#else
    launch_phase<PH_PROLOGUE>(a, 0, stream);
    launch_phase<PH_ROWPREP_X>(a, 0, stream);
    for (int layer = 0; layer < NL; ++layer) {
        if (layer > 0) launch_phase<PH_ROWPREP>(a, layer, stream);
        launch_phase<PH_GEMM1>(a, layer, stream);
        launch_phase<PH_ATTN>(a, layer, stream);
        launch_phase<PH_MERGE>(a, layer, stream);
        launch_phase<PH_LORA>(a, layer, stream);
        launch_phase<PH_PREP2>(a, layer, stream);
        launch_phase<PH_SCAN>(a, layer, stream);
        launch_phase<PH_POST>(a, layer, stream);
        launch_phase<PH_GEMM2>(a, layer, stream);
        launch_phase<PH_ROWPREP>(a, layer, stream);
        launch_phase<PH_CONVERT>(a, layer, stream);
        launch_phase<PH_GEMM3>(a, layer, stream);
        launch_phase<PH_TOPK>(a, layer, stream);
        launch_phase<PH_PEER>(a, layer, stream);
        launch_phase<PH_GEMM4A>(a, layer, stream);
        launch_phase<PH_GEMM4B>(a, layer, stream);
    }
    launch_phase<PH_FINAL>(a, 0, stream);
#endif
}
```

```cpp
#include <hip/hip_runtime.h>
#include <stdint.h>
#include <stdio.h>

#ifndef ONE_LAUNCH
#define ONE_LAUNCH 1
#endif

#ifndef REP_PREP2
#define REP_PREP2 1
#endif
#ifndef REP_CONVERT
#define REP_CONVERT 1
#endif
#ifndef REP_GEMM4A
#define REP_GEMM4A 1
#endif
#ifndef REP_ATTNX
#define REP_ATTNX 0
#endif
#ifndef REP_MERGE
#define REP_MERGE 0
#endif
#ifndef ATTN_VAR
#define ATTN_VAR 0
#endif

typedef unsigned short bf16_t;
typedef float f32x4 __attribute__((ext_vector_type(4)));
typedef float f32x2 __attribute__((ext_vector_type(2)));
typedef unsigned u32x4 __attribute__((ext_vector_type(4)));
typedef unsigned u32x2 __attribute__((ext_vector_type(2)));
typedef __bf16 bf16x2_t __attribute__((ext_vector_type(2)));

#define DEV __device__ __forceinline__

namespace cfg {
constexpr int NSEQ = 20, SEQ = 4096, T = NSEQ * SEQ, TP = 4 * SEQ, D = 1024, NL = 4;
constexpr int INC = 3456, INP = 3584;
constexpr int QKVW = 1536, UW = 2048, UC = 1920;
constexpr int NWG = 256, NTHR = 512;
constexpr int LDS_BYTES = 163840;
constexpr size_t MiB = 1ull << 20;
constexpr size_t WB_OFF = 0;
constexpr size_t WB_LAYER = 16 * MiB;
constexpr size_t WB_IN = 0, WB_OUT = 7 * MiB, WB_QK = 9 * MiB, WB_GATE = 13 * MiB, WB_PROJ = 15 * MiB, WB_LORA = 15 * MiB + 512 * 1024;
constexpr size_t HB_OFF = 64 * MiB;
constexpr size_t MIX_OFF = 224 * MiB;
constexpr size_t SMALL_OFF = 384 * MiB;
constexpr size_t RSTD_OFF = SMALL_OFF;
constexpr size_t ROPEC_OFF = SMALL_OFF + 512 * 1024, ROPES_OFF = SMALL_OFF + 640 * 1024;
constexpr size_t BAR_OFF = SMALL_OFF + 1 * MiB;
constexpr size_t BIG_OFF = 386 * MiB;
constexpr size_t QKV_OFF = BIG_OFF;
constexpr size_t RS_OFF = BIG_OFF, KS_OFF = BIG_OFF + 80 * MiB, G_OFF = BIG_OFF + 160 * MiB;
constexpr size_t U_OFF = BIG_OFF + 240 * MiB;
constexpr size_t WF_OFF = BIG_OFF + 560 * MiB, WB2_OFF = BIG_OFF + 640 * MiB, AF_OFF = BIG_OFF + 720 * MiB, AB_OFF = BIG_OFF + 800 * MiB;
constexpr size_t OP_OFF = BIG_OFF + 560 * MiB;
constexpr size_t ML_OFF = BIG_OFF + 800 * MiB;
constexpr size_t SC_OFF = BIG_OFF;
constexpr size_t TOPI_OFF = BIG_OFF + 640 * MiB, TOPG_OFF = BIG_OFF + 680 * MiB;
constexpr size_t PTU_OFF = BIG_OFF + 720 * MiB, PTV_OFF = BIG_OFF + 752 * MiB;
constexpr size_t PB_OFF = BIG_OFF + 784 * MiB;
constexpr size_t GATE_OFF = BIG_OFF;
constexpr size_t SSQ_OFF = BIG_OFF + 880 * MiB;
constexpr size_t WS_END = BIG_OFF + 886 * MiB;
}
using namespace cfg;

struct Args {
    const float* x_prompt; const float* x_sample; const float* p_prompt; const float* p_sample;
    const float* norm_mix_g; const float* w_in; const float* att_norm_g; const float* rwkv_shift;
    const float* rwkv_w0; const float* rwkv_w2; const float* rwkv_a0; const float* rwkv_a2; const float* rwkv_g2;
    const float* rwkv_k_k; const float* rwkv_k_a; const float* rwkv_r_k; const float* rwkv_ln_w; const float* rwkv_ln_b;
    const float* w_out; const float* norm_ffn_g; const float* peer_w_q; const float* peer_sub_keys; const float* peer_u; const float* peer_v;
    const float* ple_norm_g; const float* ple_w_gate; const float* ple_b_gate; const float* ple_w_proj; const float* final_norm_g;
    float* h;
    unsigned char* ws;
};

DEV int tid_() { int t = threadIdx.x; asm volatile("" : "+v"(t)); return t; }
DEV float bf2f(unsigned h) { return __uint_as_float(h << 16); }
DEV float bflo(unsigned d) { return __uint_as_float(d << 16); }
DEV float bfhi(unsigned d) { return __uint_as_float(d & 0xffff0000u); }
DEV unsigned pack2(float lo, float hi) { const f32x2 v = {lo, hi}; return __builtin_bit_cast(unsigned, __builtin_convertvector(v, bf16x2_t)); }
DEV unsigned f2bf(float f) { return pack2(f, 0.f) & 0xffffu; }
DEV float dot2bf(unsigned a, unsigned b, float c) { return __builtin_amdgcn_fdot2_f32_bf16(__builtin_bit_cast(bf16x2_t, a), __builtin_bit_cast(bf16x2_t, b), c, false); }
DEV float shx_(float v, int lane, int o) { return __int_as_float(__builtin_amdgcn_ds_bpermute((lane ^ o) << 2, __float_as_int(v))); }
DEV float shf_(float v, int src) { return __int_as_float(__builtin_amdgcn_ds_bpermute(src << 2, __float_as_int(v))); }
DEV int shf_(int v, int src) { return __builtin_amdgcn_ds_bpermute(src << 2, v); }
#define SHX(v, o) shx_((v), lane, (o))
#define SHF(v, src) shf_((v), (src))
DEV float wave_sum_(float v, int lane) {
#pragma unroll
    for (int o = 32; o > 0; o >>= 1) v += shx_(v, lane, o);
    return v;
}
DEV float wave_max_(float v, int lane) {
#pragma unroll
    for (int o = 32; o > 0; o >>= 1) v = fmaxf(v, shx_(v, lane, o));
    return v;
}
#define wave_sum(x) wave_sum_((x), lane)
#define wave_max(x) wave_max_((x), lane)
DEV float sum8(float v) {
    v += __int_as_float(__builtin_amdgcn_mov_dpp(__float_as_int(v), 0xB1, 0xF, 0xF, true));
    v += __int_as_float(__builtin_amdgcn_mov_dpp(__float_as_int(v), 0x4E, 0xF, 0xF, true));
    v += __int_as_float(__builtin_amdgcn_mov_dpp(__float_as_int(v), 0x141, 0xF, 0xF, true));
    return v;
}
DEV float rstd_parts(const float* ssq, int t) { const f32x4* p = (const f32x4*)(ssq + (size_t)t * 16); const f32x4 a = p[0], b = p[1], c = p[2], d = p[3];
    const float s = ((a[0] + a[1]) + (a[2] + a[3])) + ((b[0] + b[1]) + (b[2] + b[3])) + ((c[0] + c[1]) + (c[2] + c[3])) + ((d[0] + d[1]) + (d[2] + d[3]));
    return rsqrtf(s * (1.0f / 1024.0f) + 1e-6f); }
DEV float sigmoidf_(float x) { return __builtin_amdgcn_rcpf(1.0f + __expf(-x)); }
namespace pg8 {
#define PG8_LAS __attribute__((address_space(3)))
typedef unsigned short bf16_t;
typedef short bf16x8 __attribute__((ext_vector_type(8)));
typedef float f32x4 __attribute__((ext_vector_type(4)));
typedef unsigned u32x4 __attribute__((ext_vector_type(4)));
constexpr int BM = 256, BK = 64, HALF = 128, HTB = HALF * BK * 2  , STAGE_BYTES = 8 * HTB, NXCD = 8, WGM = 8;

__host__ __device__ __forceinline__ int lds_byte(int r, int c) { const int st = (r >> 4) * 2 + (c >> 5), rr = r & 15, cc = c & 31, ob = rr * 64 + cc * 2; return st * 1024 + (ob ^ (((ob >> 9) & 1) << 5)); }
__host__ __device__ __forceinline__ void stage_rc(int b, int& R, int& C) { const int st = b / 1024, sb = b % 1024, swz = sb ^ (((sb >> 9) & 1) << 5); R = (st >> 1) * 16 + swz / 64; C = (st & 1) * 32 + (swz % 64) / 2; }
__host__ __device__ __forceinline__ int perm32(int rho) { const int n = rho >> 4, i = rho & 15; return 8 * (i >> 2) + 4 * n + (i & 3); }

struct Unit { int pm, pn; };
struct Gemm { const bf16_t* A; const bf16_t* Bt; int M, N, K; };

struct StaticOrder {
    int nM, nN, nwg, G, c;
    __host__ __device__ void init(int M, int N, int G_, int c_) { nM = M / BM; nN = N / BM; nwg = nM * nN; G = G_; c = c_; }
    __host__ __device__ bool next(int i, Unit& u) const {
        const long L = (long)i * G + c; if (L >= nwg) return false;
        int wgid = (int)L; { const int q = nwg / NXCD, r = nwg % NXCD, xcd = wgid % NXCD, off = wgid / NXCD; wgid = (xcd < r ? xcd * (q + 1) : r * (q + 1) + (xcd - r) * q) + off; }
        const int nig = WGM * nN, gid = wgid / nig, fm = gid * WGM, gsz = (nM - fm) < WGM ? (nM - fm) : WGM;
        u.pm = fm + ((wgid % nig) % gsz); u.pn = (wgid % nig) / gsz; return true;
    }
    __device__ __forceinline__ void a_ready(const Unit&) const {}
    __device__ __forceinline__ void done(const Unit&) const {}
};
__device__ __forceinline__ unsigned cvt_pk_bf16(float lo, float hi) { unsigned r; asm volatile("v_cvt_pk_bf16_f32 %0, %1, %2" : "=v"(r) : "v"(lo), "v"(hi)); return r; }

struct EpiProj {
    static constexpr bool PERM = true, AFTER_DRAIN = false;
    bf16_t* qkv; bf16_t* u; const float* ssq; const float* rc; const float* rs;
    __device__ __forceinline__ void operator()(const f32x4 (&acc)[2][2][4][2], const Unit& un, int wr, int wc, int fr, int fq) const {
        const int row0 = un.pm * BM + wr * 64 + fr, lane = fr + 16 * fq;
        const bool isq = un.pn < 6;
        bf16_t* base = isq ? qkv : u; const int ld = isq ? 1536 : 2048; const int colt = isq ? un.pn * BM : (un.pn - 6) * BM;
        const int col0 = colt + wc * 32 + 8 * fq;
        const bool rope = (un.pn < 4) && ((wc & 1) == 0);
        f32x4 pq[2][4];
#pragma unroll
        for (int ai = 0; ai < 2; ++ai)
#pragma unroll
            for (int m = 0; m < 4; ++m) pq[ai][m] = *(const f32x4*)(ssq + (size_t)(row0 + ai * HALF + m * 16) * 16 + 4 * fq);
        float rsd[2][4];
#pragma unroll
        for (int ai = 0; ai < 2; ++ai)
#pragma unroll
            for (int m = 0; m < 4; ++m) { float t = (pq[ai][m][0] + pq[ai][m][1]) + (pq[ai][m][2] + pq[ai][m][3]); t += SHX(t, 16); t += SHX(t, 32); rsd[ai][m] = rsqrtf(t * (1.0f / 1024.0f) + 1e-6f); }
#pragma unroll
        for (int ai = 0; ai < 2; ++ai)
#pragma unroll
            for (int m = 0; m < 4; ++m) {
                const int row = row0 + ai * HALF + m * 16; const float s = rsd[ai][m]; const int pos = row & 4095;
                f32x4 c0 = {1.f, 1.f, 1.f, 1.f}, c1 = c0, s0 = {0.f, 0.f, 0.f, 0.f}, s1 = s0;
                if (rope) { c0 = *(const f32x4*)(rc + pos * 8); c1 = *(const f32x4*)(rc + pos * 8 + 4); s0 = *(const f32x4*)(rs + pos * 8); s1 = *(const f32x4*)(rs + pos * 8 + 4); }
                bf16_t* rowp = base + (size_t)row * ld + col0;
#pragma unroll
                for (int bj = 0; bj < 2; ++bj) {
                    f32x4 v0 = acc[ai][bj][m][0] * s, v1 = acc[ai][bj][m][1] * s;
                    if (rope) {
                        f32x4 o0, o1;
#pragma unroll
                        for (int c = 0; c < 4; ++c) { o0[c] = SHX(v0[c], 16); o1[c] = SHX(v1[c], 16); }
                        if (fq == 0) { v0 = v0 * c0 - o0 * s0; v1 = v1 * c1 - o1 * s1; }
                        else if (fq == 1) { v0 = v0 * c0 + o0 * s0; v1 = v1 * c1 + o1 * s1; }
                    }
                    u32x4 w; w.x = cvt_pk_bf16(v0[0], v0[1]); w.y = cvt_pk_bf16(v0[2], v0[3]); w.z = cvt_pk_bf16(v1[0], v1[1]); w.w = cvt_pk_bf16(v1[2], v1[3]);
                    *(u32x4*)(rowp + bj * HALF) = w;
                }
            }
    }
};
template <int MODE> struct EpiF32x {
    static constexpr bool PERM = true, AFTER_DRAIN = false;
    float* C; int ldc; const bf16_t* gate; bf16_t* hb; float* ssq;
    __device__ __forceinline__ void operator()(const f32x4 (&acc)[2][2][4][2], const Unit& un, int wr, int wc, int fr, int fq) const {
        const int row0 = un.pm * BM + wr * 64 + fr, col0 = un.pn * BM + wc * 32 + 8 * fq, lane = fr + 16 * fq;
#pragma unroll
        for (int ai = 0; ai < 2; ++ai)
#pragma unroll
            for (int m = 0; m < 4; ++m) {
                const int row = row0 + ai * HALF + m * 16;
                const size_t ro = (size_t)row * ldc + col0;
                if (MODE != 0) asm volatile("" ::: "memory");
                float ss = 0.f;
#pragma unroll
                for (int bj = 0; bj < 2; ++bj) {
                    if (MODE == 2 && bj) asm volatile("" ::: "memory");
                    f32x4* p = (f32x4*)(C + ro + bj * HALF);
                    if (MODE == 0) { p[0] = acc[ai][bj][m][0]; p[1] = acc[ai][bj][m][1]; }
                    else {
                        f32x4 v0, v1;
                        if (MODE == 1) { v0 = p[0] + acc[ai][bj][m][0]; v1 = p[1] + acc[ai][bj][m][1]; }
                        else { const u32x4 g = *(const u32x4*)(gate + ro + bj * HALF);
                               f32x4 g0, g1; g0[0] = __uint_as_float(g.x << 16); g0[1] = __uint_as_float(g.x & 0xffff0000u); g0[2] = __uint_as_float(g.y << 16); g0[3] = __uint_as_float(g.y & 0xffff0000u);
                               g1[0] = __uint_as_float(g.z << 16); g1[1] = __uint_as_float(g.z & 0xffff0000u); g1[2] = __uint_as_float(g.w << 16); g1[3] = __uint_as_float(g.w & 0xffff0000u);
                               v0 = p[0] + g0 * acc[ai][bj][m][0]; v1 = p[1] + g1 * acc[ai][bj][m][1]; }
                        p[0] = v0; p[1] = v1;
                        ss += ((v0[0] * v0[0] + v0[1] * v0[1]) + (v0[2] * v0[2] + v0[3] * v0[3])) + ((v1[0] * v1[0] + v1[1] * v1[1]) + (v1[2] * v1[2] + v1[3] * v1[3]));
                        u32x4 pk; pk.x = cvt_pk_bf16(v0[0], v0[1]); pk.y = cvt_pk_bf16(v0[2], v0[3]); pk.z = cvt_pk_bf16(v1[0], v1[1]); pk.w = cvt_pk_bf16(v1[2], v1[3]);
                        *(u32x4*)(hb + ro + bj * HALF) = pk;
                    }
                }
                if (MODE != 0) {
                    ss += SHX(ss, 16); ss += SHX(ss, 32);
                    if (fq == 0) ssq[(size_t)row * 16 + un.pn * 4 + wc] = ss;
                }
            }
    }
};
struct EpiGate {
    static constexpr bool PERM = true, AFTER_DRAIN = false;
    bf16_t* O; const float* rstd; const float* bias;
    __device__ __forceinline__ void operator()(const f32x4 (&acc)[2][2][4][2], const Unit& un, int wr, int wc, int fr, int fq) const {
        const int row0 = un.pm * BM + wr * 64 + fr, col0 = un.pn * BM + wc * 32 + 8 * fq;
        f32x4 bv[2][2];
#pragma unroll
        for (int bj = 0; bj < 2; ++bj)
#pragma unroll
            for (int n = 0; n < 2; ++n) bv[bj][n] = *(const f32x4*)(bias + col0 + bj * HALF + 4 * n);
#pragma unroll
        for (int ai = 0; ai < 2; ++ai)
#pragma unroll
            for (int m = 0; m < 4; ++m) {
                const int row = row0 + ai * HALF + m * 16; const float s = rstd[row];
                bf16_t* rowp = O + (size_t)row * 1024 + col0;
#pragma unroll
                for (int bj = 0; bj < 2; ++bj) {
                    f32x4 v0 = acc[ai][bj][m][0] * s + bv[bj][0], v1 = acc[ai][bj][m][1] * s + bv[bj][1];
#pragma unroll
                    for (int c = 0; c < 4; ++c) { v0[c] = __builtin_amdgcn_rcpf(1.0f + __expf(-v0[c])); v1[c] = __builtin_amdgcn_rcpf(1.0f + __expf(-v1[c])); }
                    u32x4 w; w.x = cvt_pk_bf16(v0[0], v0[1]); w.y = cvt_pk_bf16(v0[2], v0[3]); w.z = cvt_pk_bf16(v1[0], v1[1]); w.w = cvt_pk_bf16(v1[2], v1[3]);
                    *(u32x4*)(rowp + bj * HALF) = w;
                }
            }
    }
};
template <class Epi, class Sched, bool STAMP = false>
__device__ __forceinline__ void gemm_phase(PG8_LAS unsigned char* lds, const Gemm g, const Sched& S, const Epi& E, unsigned long long* stamps, const int tid_in) {
    const int tid = tid_in, wid = __builtin_amdgcn_readfirstlane(tid >> 6), lane = tid & 63, wr = wid >> 2, wc = wid & 3, fr = lane & 15, fq = lane >> 4;
    const int K = g.K, nt = K / BK;
    int ts_lo = 0, ts_hi = 0, nts = 0; const unsigned long long rt_entry = STAMP ? (unsigned long long)wall_clock64() : 0ull;
#define PG8_STAMP() do { if (STAMP && wid == 0 && nts < 64) { const unsigned long long _c = (unsigned long long)clock64(); \
        ts_lo = (lane == nts) ? (int)(unsigned)_c : ts_lo; ts_hi = (lane == nts) ? (int)(unsigned)(_c >> 32) : ts_hi; ++nts; } } while (0)
    PG8_STAMP();
    unsigned voffA[2], voffB[2];
#pragma unroll
    for (int i = 0; i < 2; ++i) { int R, C; stage_rc(tid * 16 + i * 8192, R, C); const int Rb = Epi::PERM ? ((R & ~31) + perm32(R & 31)) : R;
        voffA[i] = (unsigned)(R * K + C) * 2u; voffB[i] = (unsigned)(Rb * K + C) * 2u; }
    const size_t kstep = (size_t)(BK * 2);
    const size_t hstep = (size_t)HALF * K * 2;
    const size_t tstep = 2 * hstep;
    const unsigned ldsw = (unsigned)wid * 1024u;
    const int aoff = lds_byte(wr * 64 + fr, fq * 8), boff = lds_byte(wc * 32 + fr, fq * 8);
#define PG8_SA(b, h) (((b) * 2 + (h)) * HTB)
#define PG8_SB(b, h) ((4 + (b) * 2 + (h)) * HTB)
#define PG8_STAGE(bufoff, gbase, voff) do { _Pragma("unroll") for (int _i = 0; _i < 2; ++_i) \
        __builtin_amdgcn_global_load_lds((const unsigned*)((const char*)(gbase) + (voff)[_i]), (PG8_LAS unsigned*)(lds + (bufoff) + ldsw + _i * 8192), 16, 0, 0); } while (0)
#define PG8_LDA(dst, b, h) do { _Pragma("unroll") for (int m = 0; m < 4; ++m) _Pragma("unroll") for (int k = 0; k < 2; ++k) dst[m][k] = *(const PG8_LAS bf16x8*)(lds + PG8_SA(b, h) + aoff + m * 2048 + k * 1024); } while (0)
#define PG8_LDB(dst, b, h) do { _Pragma("unroll") for (int n = 0; n < 2; ++n) _Pragma("unroll") for (int k = 0; k < 2; ++k) dst[n][k] = *(const PG8_LAS bf16x8*)(lds + PG8_SB(b, h) + boff + n * 2048 + k * 1024); } while (0)
#define PG8_MMA(ai, bj, At, Bt) do { __builtin_amdgcn_s_setprio(1); _Pragma("unroll") for (int m = 0; m < 4; ++m) _Pragma("unroll") for (int n = 0; n < 2; ++n) _Pragma("unroll") for (int k = 0; k < 2; ++k) \
        acc[ai][bj][m][n] = __builtin_amdgcn_mfma_f32_16x16x32_bf16(Bt[n][k], At[m][k], acc[ai][bj][m][n], 0, 0, 0); __builtin_amdgcn_s_setprio(0); } while (0)
#define PG8_WAIT_V(n) asm volatile("s_waitcnt vmcnt(" #n ")" ::: "memory")
#define PG8_WAIT_L(n) asm volatile("s_waitcnt lgkmcnt(" #n ")" ::: "memory")
#define PG8_BAR __builtin_amdgcn_s_barrier()
#define PG8_SCHED __builtin_amdgcn_sched_barrier(0)
    Unit cur, nxt; int ui = 0;
    if (!S.next(0, cur)) return;
    f32x4 acc[2][2][4][2];
#pragma unroll
    for (int a = 0; a < 2; ++a)
#pragma unroll
        for (int b = 0; b < 2; ++b)
#pragma unroll
            for (int m = 0; m < 4; ++m)
#pragma unroll
                for (int n = 0; n < 2; ++n) acc[a][b][m][n] = (f32x4){0.f, 0.f, 0.f, 0.f};
    bf16x8 At[4][2], B0[2][2], B1[2][2];
    const char* cA = (const char*)g.A + (size_t)cur.pm * tstep; const char* cB = (const char*)g.Bt + (size_t)cur.pn * tstep;
    S.a_ready(cur);
    PG8_STAGE(PG8_SB(0, 0), cB, voffB); PG8_STAGE(PG8_SA(0, 0), cA, voffA); PG8_STAGE(PG8_SB(0, 1), cB + hstep, voffB); PG8_STAGE(PG8_SA(0, 1), cA + hstep, voffA);
    if (wr == 1) PG8_BAR;
    PG8_WAIT_V(4); PG8_BAR;
    PG8_STAGE(PG8_SB(1, 0), cB + kstep, voffB); PG8_STAGE(PG8_SA(1, 0), cA + kstep, voffA); PG8_STAGE(PG8_SB(1, 1), cB + hstep + kstep, voffB);
    PG8_WAIT_V(6); PG8_BAR;
    PG8_STAMP();
    for (;;) {
        const bool has_next = S.next(ui + 1, nxt);
        const char* nA = has_next ? (const char*)g.A + (size_t)nxt.pm * tstep : cA; const char* nB = has_next ? (const char*)g.Bt + (size_t)nxt.pn * tstep : cB;
        for (int t = 0; t < nt; t += 2) {
            const bool last = (t == nt - 2);
            const char* a1 = cA + (size_t)(t + 1) * kstep;
            const char* a2 = last ? nA : cA + (size_t)(t + 2) * kstep; const char* b2 = last ? nB : cB + (size_t)(t + 2) * kstep;
            const char* a3 = a2 + kstep; const char* b3 = b2 + kstep;
            if (last && has_next) S.a_ready(nxt);
            PG8_LDB(B0, 0, 0); PG8_SCHED; PG8_LDA(At, 0, 0); PG8_STAGE(PG8_SA(1, 1), a1 + hstep, voffA);
            PG8_WAIT_L(8); PG8_BAR; PG8_WAIT_L(0); PG8_MMA(0, 0, At, B0); PG8_BAR; PG8_SCHED;
            PG8_LDB(B1, 0, 1); PG8_STAGE(PG8_SB(0, 0), b2, voffB);
            PG8_BAR; PG8_WAIT_L(0); PG8_MMA(0, 1, At, B1); PG8_BAR;
            PG8_LDA(At, 0, 1); PG8_STAGE(PG8_SA(0, 0), a2, voffA);
            PG8_BAR; PG8_WAIT_L(0); PG8_MMA(1, 0, At, B0); PG8_BAR; PG8_SCHED;
            PG8_STAGE(PG8_SB(0, 1), b2 + hstep, voffB);
            PG8_WAIT_V(6); PG8_BAR; PG8_MMA(1, 1, At, B1); PG8_BAR;
            PG8_LDB(B0, 1, 0); PG8_SCHED; PG8_LDA(At, 1, 0); PG8_STAGE(PG8_SA(0, 1), a2 + hstep, voffA);
            PG8_WAIT_L(8); PG8_BAR; PG8_WAIT_L(0); PG8_MMA(0, 0, At, B0); PG8_BAR; PG8_SCHED;
            PG8_LDB(B1, 1, 1); PG8_STAGE(PG8_SB(1, 0), b3, voffB);
            PG8_BAR; PG8_WAIT_L(0); PG8_MMA(0, 1, At, B1); PG8_BAR;
            PG8_LDA(At, 1, 1); PG8_STAGE(PG8_SA(1, 0), a3, voffA);
            PG8_BAR; PG8_WAIT_L(0); PG8_MMA(1, 0, At, B0); PG8_BAR; PG8_SCHED;
            PG8_STAGE(PG8_SB(1, 1), b3 + hstep, voffB);
            PG8_WAIT_V(6); PG8_BAR; PG8_MMA(1, 1, At, B1); PG8_BAR;
        }
        PG8_STAMP();
        if constexpr (!Epi::AFTER_DRAIN) { E(acc, cur, wr, wc, fr, fq); S.done(cur); }
        PG8_STAMP();
        if (!has_next) break;
#pragma unroll
        for (int a = 0; a < 2; ++a)
#pragma unroll
            for (int b = 0; b < 2; ++b)
#pragma unroll
                for (int m = 0; m < 4; ++m)
#pragma unroll
                    for (int n = 0; n < 2; ++n) acc[a][b][m][n] = (f32x4){0.f, 0.f, 0.f, 0.f};
        cur = nxt; cA = nA; cB = nB; ++ui;
    }
    PG8_WAIT_V(0);
    if (wr == 0) PG8_BAR;
    PG8_BAR;
    if constexpr (Epi::AFTER_DRAIN) { E.fused(acc, cur, wr, wc, fr, fq, lds, wid, lane); S.done(cur); }
    PG8_STAMP();
    if (STAMP && wid == 0) { stamps[lane] = lane < nts ? (((unsigned long long)(unsigned)ts_hi << 32) | (unsigned)ts_lo) : 0ull;
        if (lane == 62) stamps[62] = rt_entry; if (lane == 63) stamps[63] = (unsigned long long)wall_clock64(); }
#undef PG8_STAMP
#undef PG8_SA
#undef PG8_SB
#undef PG8_STAGE
#undef PG8_LDA
#undef PG8_LDB
#undef PG8_MMA
#undef PG8_WAIT_V
#undef PG8_WAIT_L
#undef PG8_BAR
#undef PG8_SCHED
}
}
#define XB_TMO      128
#define XB_XCNT(j)  (256  + 64 * (j))
#define XB_XSUB(j)  (1280 + 64 * (j))
#define XB_XGEN(j)  (2304 + 64 * (j))
#define XB_TOP      3328
#define XB_TOPGEN   3392
#define XCD_BAR_WORDS 3456
#define XB_SPIN_CAP (1u << 23)
#define LAS __attribute__((address_space(3)))

__device__ __forceinline__ unsigned xb_ld(unsigned* p)              { return __hip_atomic_load(p, __ATOMIC_RELAXED, __HIP_MEMORY_SCOPE_AGENT); }
__device__ __forceinline__ unsigned xb_add(unsigned* p, unsigned v) { return __hip_atomic_fetch_add(p, v, __ATOMIC_RELAXED, __HIP_MEMORY_SCOPE_AGENT); }
__device__ __forceinline__ unsigned xb_xcc_id() { return (unsigned)__builtin_amdgcn_s_getreg((3 << 11) | 20) & 0xFu; }
#define XB_SPIN(cond, bar) do { unsigned _sp = 0; while (cond) { __builtin_amdgcn_s_sleep(1); \
    if ((++_sp & 255u) == 0u) { if (xb_ld(&(bar)[XB_TMO])) break; if (_sp > XB_SPIN_CAP) { atomicAdd(&(bar)[XB_TMO], 1u); break; } } } } while (0)

struct XcdBarrier {
    unsigned* bar; unsigned x;
    volatile LAS unsigned* st;
};

__device__ __forceinline__ XcdBarrier xcd_barrier_post(unsigned* bar, volatile LAS unsigned* st) {
    XcdBarrier b; b.bar = bar; b.x = xb_xcc_id(); b.st = st;
    if (threadIdx.x == 0) (void)xb_add(&bar[XB_XCNT(b.x)], 1u);
    return b;
}
__device__ __forceinline__ void xcd_barrier_complete(unsigned* bar, unsigned x, unsigned& nloc, unsigned& nx) {
    const unsigned G = gridDim.x * gridDim.y * gridDim.z;
    unsigned sum, cnt, mine, sp = 0u;
    for (;;) {
        sum = 0u; cnt = 0u; mine = 0u;
#pragma unroll
        for (unsigned j = 0; j < 16; ++j) { const unsigned c = xb_ld(&bar[XB_XCNT(j)]); sum += c; cnt += (c > 0u) ? 1u : 0u; mine = (j == x) ? c : mine; }
        if (sum == G) break;
        __builtin_amdgcn_s_sleep(1);
        if ((++sp & 255u) == 0u) { if (xb_ld(&bar[XB_TMO])) break; if (sp > XB_SPIN_CAP) { atomicAdd(&bar[XB_TMO], 1u); break; } }
    }
    nloc = mine > 0u ? mine : 1u; nx = cnt > 0u ? cnt : 1u;
}

__device__ __forceinline__ void xcd_barrier(const XcdBarrier& b, const int tid) {
    asm volatile("s_waitcnt vmcnt(0)" ::: "memory");
    __syncthreads();
    if (tid == 0) {
        unsigned* bar = b.bar; unsigned bx = b.x;
        asm volatile("" : "+s"(bar), "+s"(bx));
        __builtin_amdgcn_s_waitcnt(0);
        unsigned nloc = b.st[0], nx = b.st[1];
        if (nloc == 0u) { xcd_barrier_complete(bar, bx, nloc, nx); b.st[0] = nloc; b.st[1] = nx; }
        const unsigned old = xb_add(&bar[XB_XSUB(bx)], 1u);
        const unsigned gen = old / nloc;
        if (old + 1u == (gen + 1u) * nloc) {
            __builtin_amdgcn_fence(__ATOMIC_RELEASE, "agent");
            asm volatile("s_waitcnt vmcnt(0)" ::: "memory");
            const unsigned og = xb_add(&bar[XB_TOP], 1u);
            const unsigned tg = og / nx;
            if (og + 1u == (tg + 1u) * nx) xb_add(&bar[XB_TOPGEN], 1u);
            else XB_SPIN(xb_ld(&bar[XB_TOPGEN]) == tg, bar);
            __builtin_amdgcn_fence(__ATOMIC_ACQUIRE, "agent");
            xb_add(&bar[XB_XGEN(bx)], 1u);
            asm volatile("s_waitcnt vmcnt(0)" ::: "memory");
        } else {
            XB_SPIN(xb_ld(&bar[XB_XGEN(bx)]) == gen, bar);
            __builtin_amdgcn_fence(__ATOMIC_ACQUIRE, "agent");
            asm volatile("s_waitcnt vmcnt(0)" ::: "memory");
        }
    }
    __syncthreads();
}


typedef __attribute__((address_space(3))) unsigned char lds_u8;
extern __shared__ __attribute__((aligned(16))) unsigned char smem[];
DEV unsigned char* smem_base() { return smem; }

DEV bf16_t* wsb(const Args& a, size_t off) { return (bf16_t*)(a.ws + off); }
DEV float* wsf(const Args& a, size_t off) { return (float*)(a.ws + off); }

DEV void ph_rowprep(const Args& a, bool from_x, const int tid0) {
    const int lane = tid0 & 63, wv = tid0 >> 6;
    const int gw = blockIdx.x * 8 + wv, nw = gridDim.x * 8;
    bf16_t* hb = wsb(a, HB_OFF); float* ssq = wsf(a, SSQ_OFF);
    for (int t = gw; t < T; t += nw) {
        const float* src = from_x ? (t < TP ? a.x_prompt + (size_t)t * D : a.x_sample + (size_t)(t - TP) * D) : a.h + (size_t)t * D;
        f32x4 v[4]; float ss = 0.f;
#pragma unroll
        for (int i = 0; i < 4; ++i) { v[i] = *(const f32x4*)(src + (i * 64 + lane) * 4); ss += v[i][0] * v[i][0] + v[i][1] * v[i][1] + v[i][2] * v[i][2] + v[i][3] * v[i][3]; }
        ss = wave_sum(ss);
#pragma unroll
        for (int i = 0; i < 4; ++i) {
            if (from_x) *(f32x4*)(a.h + (size_t)t * D + (i * 64 + lane) * 4) = v[i];
            u32x2 p; p.x = pack2(v[i][0], v[i][1]); p.y = pack2(v[i][2], v[i][3]);
            *(u32x2*)(hb + (size_t)t * D + (i * 64 + lane) * 4) = p;
        }
        if (lane < 16) ssq[(size_t)t * 16 + lane] = (lane == 0) ? ss : 0.f;
    }
}

DEV void ph_final(const Args& a, const int tid0) {
    const int lane = tid0 & 63, wv = tid0 >> 6;
    const int gw = blockIdx.x * 8 + wv, nw = gridDim.x * 8;
    for (int t = gw; t < T; t += nw) {
        float* row = a.h + (size_t)t * D;
        f32x4 v[4]; float ss = 0.f;
#pragma unroll
        for (int i = 0; i < 4; ++i) { v[i] = *(const f32x4*)(row + (i * 64 + lane) * 4); ss += v[i][0] * v[i][0] + v[i][1] * v[i][1] + v[i][2] * v[i][2] + v[i][3] * v[i][3]; }
        ss = wave_sum(ss);
        const float r = rsqrtf(ss * (1.0f / 1024.0f) + 1e-6f);
#pragma unroll
        for (int i = 0; i < 4; ++i) { const f32x4 g = *(const f32x4*)(a.final_norm_g + (i * 64 + lane) * 4); *(f32x4*)(row + (i * 64 + lane) * 4) = v[i] * r * g; }
    }
}

DEV void transpose_cvt(const float* __restrict__ src, bf16_t* __restrict__ dst, int K, int N, int Npad, const float* __restrict__ g, float* tile, const int tid0) {
    const int tx = tid0 & 63, ty = tid0 >> 6;
    const int tk = K / 64, tn = Npad / 64;
    for (int tl = blockIdx.x; tl < tk * tn; tl += gridDim.x) {
        const int k0 = (tl % tk) * 64, n0 = (tl / tk) * 64;
        __syncthreads();
        for (int i = ty; i < 64; i += 8) { const int k = k0 + i, n = n0 + tx; float v = (n < N) ? src[(size_t)k * N + n] : 0.f; if (g) v *= g[k]; tile[i * 65 + tx] = v; }
        __syncthreads();
        for (int i = ty; i < 64; i += 8) dst[(size_t)(n0 + i) * K + k0 + tx] = (bf16_t)f2bf(tile[tx * 65 + i]);
    }
}
DEV void fold_wqk(const Args& a, float* lds, const int tid0) {
    float* swq = lds;
    float* ssk = lds + 64 * 132;
    const int tid = tid0, key = tid & 127, kq = tid >> 7;
    for (int un = blockIdx.x; un < NL * 16 * 16; un += gridDim.x) {
        const int l = un >> 8, hp = (un >> 4) & 15, k0 = (un & 15) * 64;
        __syncthreads();
        for (int i = tid; i < 64 * 128; i += NTHR) { const int r = i >> 7, c = i & 127; swq[r * 132 + c] = a.peer_w_q[((size_t)l * 1024 + k0 + r) * 2048 + hp * 128 + c]; }
        for (int i = tid; i < 128 * 128; i += NTHR) { const int r = i >> 7, c = i & 127; ssk[r * 132 + c] = a.peer_sub_keys[(((size_t)l * 16 + hp) * 128 + r) * 128 + c]; }
        __syncthreads();
        float acc[16];
#pragma unroll
        for (int i = 0; i < 16; ++i) acc[i] = 0.f;
        for (int c = 0; c < 128; c += 4) {
            const f32x4 s = *(const f32x4*)(ssk + key * 132 + c);
#pragma unroll
            for (int i = 0; i < 16; ++i) { const f32x4 w = *(const f32x4*)(swq + (kq * 16 + i) * 132 + c); acc[i] += s[0] * w[0] + s[1] * w[1] + s[2] * w[2] + s[3] * w[3]; }
        }
        bf16_t* dst = wsb(a, WB_OFF + (size_t)l * WB_LAYER + WB_QK) + (size_t)(hp * 128 + key) * 1024 + k0 + kq * 16;
        const float* g = a.norm_ffn_g + l * 1024 + k0 + kq * 16;
#pragma unroll
        for (int i = 0; i < 16; i += 2) *(unsigned*)(dst + i) = pack2(acc[i] * g[i], acc[i + 1] * g[i + 1]);
    }
}
DEV void ph_prologue(const Args& a, float* lds, const int tid0) {
    { float* rc = wsf(a, ROPEC_OFF); float* rs = wsf(a, ROPES_OFF);
      for (int i = blockIdx.x * NTHR + tid0; i < 4096 * 8; i += gridDim.x * NTHR) {
          const int pos = i >> 3, f = i & 7;
          const float invf = (float)pow(500000.0, -(double)f / 8.0);
          const float ang = (float)pos * invf;
          rc[i] = (float)cos((double)ang); rs[i] = (float)sin((double)ang);
      } }
    for (int l = 0; l < NL; ++l) {
        bf16_t* wb = wsb(a, WB_OFF + (size_t)l * WB_LAYER);
        transpose_cvt(a.w_in + (size_t)l * 1024 * INC, wb + WB_IN / 2, 1024, INC, INP, a.norm_mix_g + l * 1024, lds, tid0);
        transpose_cvt(a.w_out + (size_t)l * 1024 * 1024, wb + WB_OUT / 2, 1024, 1024, 1024, nullptr, lds, tid0);
        transpose_cvt(a.ple_w_gate + (size_t)l * 1024 * 1024, wb + WB_GATE / 2, 1024, 1024, 1024, a.ple_norm_g + l * 1024, lds, tid0);
        transpose_cvt(a.ple_w_proj + (size_t)l * 256 * 1024, wb + WB_PROJ / 2, 256, 1024, 1024, nullptr, lds, tid0);
        for (int dr = 0; dr < 2; ++dr) {
            transpose_cvt(a.rwkv_w2 + (size_t)(l * 2 + dr) * 64 * 512, wb + WB_LORA / 2 + dr * 512 * 64, 64, 512, 512, nullptr, lds, tid0);
            transpose_cvt(a.rwkv_a2 + (size_t)(l * 2 + dr) * 64 * 512, wb + WB_LORA / 2 + (2 + dr) * 512 * 64, 64, 512, 512, nullptr, lds, tid0);
        }
        transpose_cvt(a.rwkv_g2 + (size_t)l * 128 * 512, wb + WB_LORA / 2 + 4 * 512 * 64, 128, 512, 512, nullptr, lds, tid0);
    }
    fold_wqk(a, lds, tid0);
}

DEV float sum16(float v) {
    v = sum8(v);
    v += __int_as_float(__builtin_amdgcn_mov_dpp(__float_as_int(v), 0x140, 0xF, 0xF, true));
    return v;
}
DEV float max16(float v) {
    v = fmaxf(v, __int_as_float(__builtin_amdgcn_mov_dpp(__float_as_int(v), 0xB1, 0xF, 0xF, true)));
    v = fmaxf(v, __int_as_float(__builtin_amdgcn_mov_dpp(__float_as_int(v), 0x4E, 0xF, 0xF, true)));
    v = fmaxf(v, __int_as_float(__builtin_amdgcn_mov_dpp(__float_as_int(v), 0x141, 0xF, 0xF, true)));
    v = fmaxf(v, __int_as_float(__builtin_amdgcn_mov_dpp(__float_as_int(v), 0x140, 0xF, 0xF, true)));
    return v;
}
DEV float rl(float v, int l) { return __int_as_float(__builtin_amdgcn_readlane(__float_as_int(v), l)); }
DEV float wave_sum_dpp(float v) { v = sum16(v); return (rl(v, 0) + rl(v, 16)) + (rl(v, 32) + rl(v, 48)); }
DEV unsigned fkey(float f) { const unsigned b = __float_as_uint(f); return b ^ ((unsigned)((int)b >> 31) | 0x80000000u); }
DEV int mbcnt64(unsigned long long m) { return (int)__builtin_amdgcn_mbcnt_hi((unsigned)(m >> 32), __builtin_amdgcn_mbcnt_lo((unsigned)m, 0u)); }

#ifndef TOPK_NU
#define TOPK_NU 4
#endif
DEV void ph_topk2(const Args& a, float* lds, const int tid0, const int gw, const int nw, const int NP) {
    const int lane = tid0 & 63, wv = __builtin_amdgcn_readfirstlane(tid0 >> 6);
    constexpr int NU = TOPK_NU, NQ = 2 * NU, GPT = 8 / NU;
    float* tvb = lds + wv * (NQ * 16); int* tib = (int*)(lds + 8 * NQ * 16) + wv * (NQ * 16);
    const float* SC = wsf(a, SC_OFF); int* TOPI = (int*)(a.ws + TOPI_OFF); float* TOPG = wsf(a, TOPG_OFF); const float* ssq = wsf(a, SSQ_OFF);
    float vn[NU][4];
    if (gw < NP) {
#pragma unroll
        for (int u = 0; u < NU; ++u)
#pragma unroll
            for (int i = 0; i < 4; ++i) vn[u][i] = SC[(size_t)gw * (NU * 256) + u * 256 + i * 64 + lane];
    }
    for (int up = gw; up < NP; up += nw) {
        const int t = up / GPT, hd0 = (up % GPT) * NU;
        float v[NU][4]; unsigned k[NU][4];
#pragma unroll
        for (int u = 0; u < NU; ++u)
#pragma unroll
            for (int i = 0; i < 4; ++i) { v[u][i] = vn[u][i]; k[u][i] = fkey(v[u][i]); }
        if (up + nw < NP) {
#pragma unroll
            for (int u = 0; u < NU; ++u)
#pragma unroll
                for (int i = 0; i < 4; ++i) vn[u][i] = SC[(size_t)(up + nw) * (NU * 256) + u * 256 + i * 64 + lane];
        }
        unsigned th[NQ]; unsigned dm = 0u;
#pragma unroll
        for (int q = 0; q < NQ; ++q) th[q] = 0u;
        for (int b = 31; b >= 0; --b) {
            const unsigned bit = 1u << b;
            unsigned long long ma[NQ], mb[NQ];
#pragma unroll
            for (int q = 0; q < NQ; ++q) { const unsigned c = th[q] | bit; ma[q] = __ballot(k[q >> 1][2 * (q & 1)] >= c); mb[q] = __ballot(k[q >> 1][2 * (q & 1) + 1] >= c); }
#pragma unroll
            for (int q = 0; q < NQ; ++q) {
                const int n = __builtin_popcountll(ma[q]) + __builtin_popcountll(mb[q]);
                th[q] = (n >= 16) ? (th[q] | bit) : th[q]; dm |= (n == 16) ? (1u << q) : 0u;
            }
            if (dm == (1u << NQ) - 1u) break;
        }
#pragma unroll
        for (int q = 0; q < NQ; ++q) {
            const int u = q >> 1, p = q & 1; const unsigned tp = th[q];
            const unsigned ka = k[u][2 * p], kb = k[u][2 * p + 1];
            const unsigned long long ga = __ballot(ka > tp), gb = __ballot(kb > tp), ea = __ballot(ka == tp), eb = __ballot(kb == tp);
            const int nga = __builtin_popcountll(ga), ng = nga + __builtin_popcountll(gb), need = 16 - ng, nea = __builtin_popcountll(ea);
            const int rga = mbcnt64(ga), rgb = nga + mbcnt64(gb), rea = mbcnt64(ea), reb = nea + mbcnt64(eb);
            const int pa = (ka > tp) ? rga : ((ka == tp && rea < need) ? ng + rea : -1);
            const int pb = (kb > tp) ? rgb : ((kb == tp && reb < need) ? ng + reb : -1);
            if (pa >= 0) { tvb[q * 16 + pa] = v[u][2 * p]; tib[q * 16 + pa] = lane; }
            if (pb >= 0) { tvb[q * 16 + pb] = v[u][2 * p + 1]; tib[q * 16 + pb] = 64 + lane; }
        }
        float cv[NU][4]; unsigned kc[NU][4]; float mx[NU];
#pragma unroll
        for (int u = 0; u < NU; ++u) {
#pragma unroll
            for (int s = 0; s < 4; ++s) { const int c = lane + 64 * s; cv[u][s] = tvb[u * 32 + (c >> 4)] + tvb[u * 32 + 16 + (c & 15)]; kc[u][s] = fkey(cv[u][s]); }
            const float m0 = max16(lane < 16 ? tvb[u * 32 + (lane & 15)] : -3.0e38f), m1 = max16(lane < 16 ? tvb[u * 32 + 16 + (lane & 15)] : -3.0e38f);
            mx[u] = rl(m0, 0) + rl(m1, 0);
        }
        unsigned t2[NU]; unsigned dm2 = 0u;
#pragma unroll
        for (int u = 0; u < NU; ++u) t2[u] = 0u;
        for (int b = 31; b >= 0; --b) {
            const unsigned bit = 1u << b;
            unsigned long long mc[NU][4];
#pragma unroll
            for (int u = 0; u < NU; ++u)
#pragma unroll
                for (int s4 = 0; s4 < 4; ++s4) mc[u][s4] = __ballot(kc[u][s4] >= (t2[u] | bit));
#pragma unroll
            for (int u = 0; u < NU; ++u) {
                const int n = (__builtin_popcountll(mc[u][0]) + __builtin_popcountll(mc[u][1])) + (__builtin_popcountll(mc[u][2]) + __builtin_popcountll(mc[u][3]));
                t2[u] = (n >= 16) ? (t2[u] | bit) : t2[u]; dm2 |= (n == 16) ? (1u << u) : 0u;
            }
            if (dm2 == (1u << NU) - 1u) break;
        }
        const float rs = rstd_parts(ssq, t);
#pragma unroll
        for (int u = 0; u < NU; ++u) {
            int pos[4]; int ng = 0;
#pragma unroll
            for (int s = 0; s < 4; ++s) { const unsigned long long g = __ballot(kc[u][s] > t2[u]); pos[s] = (kc[u][s] > t2[u]) ? ng + mbcnt64(g) : -1; ng += __builtin_popcountll(g); }
            int ne = 0; const int need = 16 - ng;
#pragma unroll
            for (int s = 0; s < 4; ++s) { const unsigned long long e = __ballot(kc[u][s] == t2[u]); const int r = ne + mbcnt64(e); pos[s] = (kc[u][s] == t2[u] && r < need) ? ng + r : pos[s]; ne += __builtin_popcountll(e); }
            float ex[4]; float es = 0.f;
#pragma unroll
            for (int s = 0; s < 4; ++s) { ex[s] = (pos[s] >= 0) ? __expf(rs * (cv[u][s] - mx[u])) : 0.f; es += ex[s]; }
            const float inv = __builtin_amdgcn_rcpf(wave_sum_dpp(es));
#pragma unroll
            for (int s = 0; s < 4; ++s) if (pos[s] >= 0) {
                const int c = lane + 64 * s;
                TOPI[(size_t)t * 128 + (hd0 + u) * 16 + pos[s]] = tib[u * 32 + (c >> 4)] * 128 + tib[u * 32 + 16 + (c & 15)];
                TOPG[(size_t)t * 128 + (hd0 + u) * 16 + pos[s]] = ex[s] * inv;
            }
        }
    }
}

DEV unsigned pack4_fp8(float a, float b, float c, float d) {
    int w = __builtin_amdgcn_cvt_pk_fp8_f32(a, b, 0, false);
    w = __builtin_amdgcn_cvt_pk_fp8_f32(c, d, w, true);
    return (unsigned)w;
}
DEV void ph_convert8(const Args& a, int layer, const int tid0) {
    const size_t gtid = (size_t)blockIdx.x * NTHR + tid0, gn = (size_t)gridDim.x * NTHR;
    const float* us = a.peer_u + (size_t)layer * 16384 * 1024; const float* vs = a.peer_v + (size_t)layer * 16384 * 1024;
    unsigned* ud = (unsigned*)(a.ws + PTU_OFF); unsigned* vd = (unsigned*)(a.ws + PTV_OFF);
    const float* g = a.norm_ffn_g + layer * 1024;
    for (size_t i = gtid; i < (size_t)16384 * 1024 / 16; i += gn) {
        u32x4 pu, pv;
#pragma unroll
        for (int j = 0; j < 4; ++j) {
            const f32x4 x = *(const f32x4*)(us + i * 16 + j * 4), y = *(const f32x4*)(vs + i * 16 + j * 4), gg = *(const f32x4*)(g + ((i * 16 + j * 4) & 1023));
            pu[j] = pack4_fp8(x[0] * gg[0] * 256.f, x[1] * gg[1] * 256.f, x[2] * gg[2] * 256.f, x[3] * gg[3] * 256.f);
            pv[j] = pack4_fp8(y[0] * 32.f, y[1] * 32.f, y[2] * 32.f, y[3] * 32.f);
        }
        *(u32x4*)(ud + i * 4) = pu; *(u32x4*)(vd + i * 4) = pv;
    }
    bf16_t* pb = wsb(a, PB_OFF);
    const float* pp = a.p_prompt + (size_t)layer * TP * 256; const float* ps = a.p_sample + (size_t)layer * (T - TP) * 256;
    for (size_t i = gtid; i < (size_t)T * 256 / 4; i += gn) {
        const size_t e = i * 4; const f32x4 x = (e < (size_t)TP * 256) ? *(const f32x4*)(pp + e) : *(const f32x4*)(ps + (e - (size_t)TP * 256));
        u32x2 p; p.x = pack2(x[0], x[1]); p.y = pack2(x[2], x[3]); *(u32x2*)(pb + e) = p;
    }
}


typedef short bf16x8 __attribute__((ext_vector_type(8)));
typedef float f32x16 __attribute__((ext_vector_type(16)));
#define MFMA32(a, b, c) __builtin_amdgcn_mfma_f32_32x32x16_bf16((a), (b), (c), 0, 0, 0)
DEV bf16x8 pack_frag(float x0, float x1, float x2, float x3, float x4, float x5, float x6, float x7) {
    u32x4 p;
    asm volatile("v_cvt_pk_bf16_f32 %0, %4, %5\n\tv_cvt_pk_bf16_f32 %1, %6, %7\n\tv_cvt_pk_bf16_f32 %2, %8, %9\n\tv_cvt_pk_bf16_f32 %3, %10, %11\n\ts_nop 1"
                 : "=&v"(p[0]), "=&v"(p[1]), "=&v"(p[2]), "=&v"(p[3]) : "v"(x0), "v"(x1), "v"(x2), "v"(x3), "v"(x4), "v"(x5), "v"(x6), "v"(x7));
    return __builtin_bit_cast(bf16x8, p);
}
DEV void ph_attn3(const Args& a, int layer, unsigned char* ldsb, const int tid0) {
    const int lane = tid0 & 63, wv = __builtin_amdgcn_readfirstlane(tid0 >> 6), r = lane & 31, h = lane >> 5;
    unsigned char* OL = ldsb;
    float* MLl = (float*)(ldsb + 73728);
    unsigned char* vt = ldsb + 77824 + wv * 4608;
    const bf16_t* qkv = wsb(a, QKV_OFF);
    bf16_t* mix = wsb(a, MIX_OFF);
    const int i16 = lane & 15, tq = i16 >> 2, tp = i16 & 3, tblk = (lane >> 4) & 1;
    const unsigned tr_addr = (unsigned)(size_t)vt + (4 * h + tq) * 144 + 2 * (16 * tblk + 4 * tp);
    const float sc = 0.125f * 1.44269504f, NEG = -1.0e30f;
    for (int un = blockIdx.x; un < NSEQ * 8 * 8; un += gridDim.x) {
      const int sh = un >> 3, sp = un & 7, seq = sh >> 3, hd = sh & 7; const size_t tb = (size_t)seq * 4096;
      __syncthreads();
#pragma unroll 1
      for (int di = 0; di < 3; ++di) {
#pragma unroll 1
       for (int k2 = 0; k2 < 2; ++k2) {
        const int idx16 = wv * 2 + k2;
        const int sft = 2 * di, nlen = 4096 >> sft;
        const int rr = (di == 0) ? 0 : (di == 1 ? (idx16 >> 2) : idx16), cb = (di == 0) ? (16 * sp + idx16) : (di == 1 ? (4 * sp + (idx16 & 3)) : sp), cq0 = cb * 32;
        const size_t tokq = tb + ((size_t)(cq0 + r) << sft) + rr;
        const bf16_t* qp = qkv + tokq * 1536 + hd * 64 + 8 * h;
        bf16x8 qf[4];
#pragma unroll
        for (int s = 0; s < 4; ++s) qf[s] = *(const bf16x8*)(qp + 16 * s);
        float m = NEG, l = 0.f;
        f32x16 O0, O1;
#pragma unroll
        for (int i = 0; i < 16; ++i) { O0[i] = 0.f; O1[i] = 0.f; }
        bf16x8 kfb[2][4], vfb[2][4];
#define ATT_LOAD(kt_) do { const int kb_ = cq0 - 64 + 32 * (kt_); const size_t tokk_ = tb + ((size_t)(kb_ + r) << sft) + rr; const bf16_t* kp_ = qkv + tokk_ * 1536 + 512 + hd * 64 + 8 * h; \
            _Pragma("unroll") for (int s_ = 0; s_ < 4; ++s_) { kfb[(kt_) & 1][s_] = *(const bf16x8*)(kp_ + 16 * s_); vfb[(kt_) & 1][s_] = *(const bf16x8*)(kp_ + 512 + 16 * s_); } } while (0)
        if (cq0 - 64 >= 0) ATT_LOAD(0);
#pragma unroll
        for (int kt = 0; kt < 5; ++kt) {
            const int kb = cq0 - 64 + 32 * kt;
            if (kt + 1 < 5) { const int kbn = kb + 32; if (kbn >= 0 && kbn < nlen) ATT_LOAD(kt + 1); }
            asm volatile("" ::: "memory");
            if (kb < 0 || kb >= nlen) continue;
            bf16x8 kf[4], vf[4];
#pragma unroll
            for (int s = 0; s < 4; ++s) { kf[s] = kfb[kt & 1][s]; vf[s] = vfb[kt & 1][s]; }
            f32x16 S;
#pragma unroll
            for (int i = 0; i < 16; ++i) S[i] = 0.f;
#pragma unroll
            for (int s = 0; s < 4; ++s) S = MFMA32(kf[s], qf[s], S);
            float lm = NEG;
#pragma unroll
            for (int i = 0; i < 16; ++i) {
                const int row = (i & 3) + 8 * (i >> 2) + 4 * h;
                float v = S[i] * sc;
                if (kt == 0) v = (row >= r) ? v : NEG;
                if (kt == 4) v = (row <= r) ? v : NEG;
                S[i] = v; lm = fmaxf(lm, v);
            }
            lm = fmaxf(lm, SHX(lm, 32));
            const float mn = fmaxf(m, lm), alpha = __builtin_amdgcn_exp2f(m - mn);
            m = mn; l *= alpha;
            float ps = 0.f;
#pragma unroll
            for (int i = 0; i < 16; ++i) { O0[i] *= alpha; O1[i] *= alpha; S[i] = __builtin_amdgcn_exp2f(S[i] - mn); ps += S[i]; }
            l += ps;
            const bf16x8 pb0 = pack_frag(S[0], S[1], S[2], S[3], S[4], S[5], S[6], S[7]);
            const bf16x8 pb1 = pack_frag(S[8], S[9], S[10], S[11], S[12], S[13], S[14], S[15]);
            asm volatile("" ::: "memory");
#pragma unroll
            for (int i = 0; i < 4; ++i) *(bf16x8*)(vt + r * 144 + 2 * (16 * i + 8 * h)) = vf[i];
            typedef short s16x4 __attribute__((ext_vector_type(4)));
            s16x4 t00l, t00h, t01l, t01h, t10l, t10h, t11l, t11h;
            asm volatile("s_waitcnt lgkmcnt(0)\n\t"
                         "ds_read_b64_tr_b16 %0, %8\n\tds_read_b64_tr_b16 %1, %8 offset:1152\n\t"
                         "ds_read_b64_tr_b16 %2, %8 offset:2304\n\tds_read_b64_tr_b16 %3, %8 offset:3456\n\t"
                         "ds_read_b64_tr_b16 %4, %8 offset:64\n\tds_read_b64_tr_b16 %5, %8 offset:1216\n\t"
                         "ds_read_b64_tr_b16 %6, %8 offset:2368\n\tds_read_b64_tr_b16 %7, %8 offset:3520\n\t"
                         "s_waitcnt lgkmcnt(0)"
                         : "=&v"(t00l), "=&v"(t00h), "=&v"(t01l), "=&v"(t01h), "=&v"(t10l), "=&v"(t10h), "=&v"(t11l), "=&v"(t11h) : "v"(tr_addr) : "memory");
            const bf16x8 a00 = __builtin_shufflevector(t00l, t00h, 0, 1, 2, 3, 4, 5, 6, 7), a01 = __builtin_shufflevector(t01l, t01h, 0, 1, 2, 3, 4, 5, 6, 7);
            const bf16x8 a10 = __builtin_shufflevector(t10l, t10h, 0, 1, 2, 3, 4, 5, 6, 7), a11 = __builtin_shufflevector(t11l, t11h, 0, 1, 2, 3, 4, 5, 6, 7);
            O0 = MFMA32(a00, pb0, O0); O1 = MFMA32(a10, pb0, O1);
            O0 = MFMA32(a01, pb1, O0); O1 = MFMA32(a11, pb1, O1);
            asm volatile("" ::: "memory");
        }
#undef ATT_LOAD
        l += SHX(l, 32);
        const int ql = (((cq0 + r) << sft) + rr) - 512 * sp;
        unsigned char* orow = OL + ql * 144 + 8 * h;
        float ao = 0.f, ap = 1.0f;
        if (di > 0) {
            const f32x2 mo = *(const f32x2*)(MLl + 2 * ql);
            const float mn = fmaxf(mo[0], m);
            ao = __builtin_amdgcn_exp2f(mo[0] - mn); ap = __builtin_amdgcn_exp2f(m - mn);
            l = ao * mo[1] + ap * l; m = mn;
        }
#pragma unroll
        for (int g = 0; g < 4; ++g) {
            f32x4 v0 = {O0[4 * g] * ap, O0[4 * g + 1] * ap, O0[4 * g + 2] * ap, O0[4 * g + 3] * ap}, v1 = {O1[4 * g] * ap, O1[4 * g + 1] * ap, O1[4 * g + 2] * ap, O1[4 * g + 3] * ap};
            if (di > 0) {
                const u32x2 o0 = *(const u32x2*)(orow + 16 * g), o1 = *(const u32x2*)(orow + 64 + 16 * g);
                v0[0] += ao * bflo(o0.x); v0[1] += ao * bfhi(o0.x); v0[2] += ao * bflo(o0.y); v0[3] += ao * bfhi(o0.y);
                v1[0] += ao * bflo(o1.x); v1[1] += ao * bfhi(o1.x); v1[2] += ao * bflo(o1.y); v1[3] += ao * bfhi(o1.y);
            }
            u32x2 p0, p1; p0.x = pack2(v0[0], v0[1]); p0.y = pack2(v0[2], v0[3]); p1.x = pack2(v1[0], v1[1]); p1.y = pack2(v1[2], v1[3]);
            *(u32x2*)(orow + 16 * g) = p0; *(u32x2*)(orow + 64 + 16 * g) = p1;
        }
        if (h == 0) { f32x2 ml; ml[0] = m; ml[1] = l; *(f32x2*)(MLl + 2 * ql) = ml; }
       }
       __syncthreads();
      }
      {
        const int ql = tid0;
        const float inv = __builtin_amdgcn_rcpf(MLl[2 * ql + 1]);
        float o[64]; float ss = 0.f;
#pragma unroll
        for (int c = 0; c < 8; ++c) {
            const u32x4 w4 = *(const u32x4*)(OL + ql * 144 + 16 * c);
#pragma unroll
            for (int i = 0; i < 4; ++i) { o[8 * c + 2 * i] = bflo(w4[i]) * inv; o[8 * c + 2 * i + 1] = bfhi(w4[i]) * inv; ss += o[8 * c + 2 * i] * o[8 * c + 2 * i] + o[8 * c + 2 * i + 1] * o[8 * c + 2 * i + 1]; }
        }
        const float rn = rsqrtf(ss * (1.0f / 64.0f) + 1e-6f);
        const float* gp = a.att_norm_g + layer * 512 + hd * 64;
        bf16_t* dst = mix + (tb + 512 * sp + ql) * 1024 + hd * 64;
#pragma unroll
        for (int c = 0; c < 8; ++c) {
            const f32x4 g0 = *(const f32x4*)(gp + 8 * c), g1 = *(const f32x4*)(gp + 8 * c + 4);
            u32x4 w4; w4.x = pack2(o[8 * c] * rn * g0[0], o[8 * c + 1] * rn * g0[1]); w4.y = pack2(o[8 * c + 2] * rn * g0[2], o[8 * c + 3] * rn * g0[3]);
            w4.z = pack2(o[8 * c + 4] * rn * g1[0], o[8 * c + 5] * rn * g1[1]); w4.w = pack2(o[8 * c + 6] * rn * g1[2], o[8 * c + 7] * rn * g1[3]);
            *(u32x4*)(dst + 8 * c) = w4;
        }
      }
    }
}

DEV float tanh_fast(float x) { return 1.0f - 2.0f * __builtin_amdgcn_rcpf(1.0f + __expf(2.0f * x)); }

DEV void ph_rwkv_prep1(const Args& a, int layer, unsigned char* ldsb, const int tid0) {
    const int lane = tid0 & 63, wv = __builtin_amdgcn_readfirstlane(tid0 >> 6), r = lane & 31, h = lane >> 5;
    const int gw = blockIdx.x * 8 + wv, nw = gridDim.x * 8;
    const int sub = wv & 1, ng = wv >> 1;
    const bf16_t* U = wsb(a, U_OFF);
    const float* sw = a.rwkv_shift + (size_t)layer * 3 * UC;
    const bf16_t* wl = wsb(a, WB_OFF + (size_t)layer * WB_LAYER + WB_LORA);
#pragma unroll 1
    for (int arr = 0; arr < 5; ++arr) {
        const int coff = (arr < 4) ? arr * 64 : 256, nk = (arr < 4) ? 4 : 8, kw = nk * 16, rsb = kw * 2 + 16;
        __syncthreads();
        {
            const bf16_t* wsrc = wl + (arr < 4 ? arr * 512 * 64 : 4 * 512 * 64);
            const int cpr = kw / 8;
            for (int i = tid0; i < 512 * cpr; i += NTHR) { const int row = i / cpr, c = i - row * cpr; *(u32x4*)(ldsb + row * rsb + c * 16) = *(const u32x4*)(wsrc + (size_t)row * kw + c * 8); }
        }
        __syncthreads();
        bf16_t* outb = wsb(a, arr == 0 ? WF_OFF : arr == 1 ? WB2_OFF : arr == 2 ? AF_OFF : arr == 3 ? AB_OFF : G_OFF);
        const float* bias = (arr < 2) ? a.rwkv_w0 + (layer * 2 + arr) * 512 : a.rwkv_a0 + (layer * 2 + (arr & 1)) * 512;
        f32x4 bvr[4][4];
#pragma unroll
        for (int q = 0; q < 4; ++q)
#pragma unroll
            for (int g = 0; g < 4; ++g) bvr[q][g] = *(const f32x4*)(bias + (ng * 4 + q) * 32 + 8 * g + 4 * h);
#pragma unroll 1
        for (int tile = blockIdx.x; tile < T / 64; tile += gridDim.x) {
            const int t = tile * 64 + sub * 32 + r, pos = t & 4095;
            const bool hp = pos > 0, hn = pos < 4095;
            const bf16_t* up = U + (size_t)t * UW + 1536 + 8 * h;
            bf16x8 xf[8];
#pragma unroll
            for (int s = 0; s < 8; ++s) {
                if (s < nk) {
                    const int col = coff + 16 * s;
                    const u32x4 c = *(const u32x4*)(up + col);
                    u32x4 p = {0u, 0u, 0u, 0u}, n = {0u, 0u, 0u, 0u};
                    if (hp) p = *(const u32x4*)(up - UW + col);
                    if (hn) n = *(const u32x4*)(up + UW + col);
                    const float* s0 = sw + 1536 + 8 * h + col;
                    const f32x4 wp0 = *(const f32x4*)(s0), wp1 = *(const f32x4*)(s0 + 4), wc0 = *(const f32x4*)(s0 + UC), wc1 = *(const f32x4*)(s0 + UC + 4), wn0 = *(const f32x4*)(s0 + 2 * UC), wn1 = *(const f32x4*)(s0 + 2 * UC + 4);
                    float v[8];
#pragma unroll
                    for (int i = 0; i < 4; ++i) {
                        const float a0 = (i < 2) ? wp0[2 * i] : wp1[2 * i - 4], a1 = (i < 2) ? wp0[2 * i + 1] : wp1[2 * i - 3];
                        const float b0 = (i < 2) ? wc0[2 * i] : wc1[2 * i - 4], b1 = (i < 2) ? wc0[2 * i + 1] : wc1[2 * i - 3];
                        const float c0 = (i < 2) ? wn0[2 * i] : wn1[2 * i - 4], c1 = (i < 2) ? wn0[2 * i + 1] : wn1[2 * i - 3];
                        v[2 * i] = a0 * bflo(p[i]) + b0 * bflo(c[i]) + c0 * bflo(n[i]);
                        v[2 * i + 1] = a1 * bfhi(p[i]) + b1 * bfhi(c[i]) + c1 * bfhi(n[i]);
                    }
                    if (arr < 2) {
#pragma unroll
                        for (int i = 0; i < 8; ++i) v[i] = tanh_fast(v[i]);
                    } else if (arr == 4) {
#pragma unroll
                        for (int i = 0; i < 8; ++i) v[i] = sigmoidf_(v[i]);
                    }
                    xf[s] = pack_frag(v[0], v[1], v[2], v[3], v[4], v[5], v[6], v[7]);
                }
            }
            bf16_t* out = outb + (size_t)t * 512 + 4 * h;
#pragma unroll
            for (int q = 0; q < 4; ++q) {
                const int nt = ng * 4 + q;
                f32x16 C;
#pragma unroll
                for (int i = 0; i < 16; ++i) C[i] = 0.f;
                const unsigned char* wr = ldsb + (nt * 32 + r) * rsb + 16 * h;
#pragma unroll
                for (int s = 0; s < 8; ++s) if (s < nk) { const bf16x8 A = *(const bf16x8*)(wr + 32 * s); C = MFMA32(A, xf[s], C); }
#pragma unroll
                for (int g = 0; g < 4; ++g) {
                    float o[4];
                    if (arr < 4) {
                        const f32x4 bv = bvr[q][g];
#pragma unroll
                        for (int j = 0; j < 4; ++j) { const float sg = sigmoidf_(C[4 * g + j] + bv[j]); o[j] = (arr < 2) ? __expf(-0.60653066f * sg) : sg; }
                    } else {
#pragma unroll
                        for (int j = 0; j < 4; ++j) o[j] = C[4 * g + j];
                    }
                    u32x2 pk; pk.x = pack2(o[0], o[1]); pk.y = pack2(o[2], o[3]);
                    *(u32x2*)(out + nt * 32 + 8 * g) = pk;
                }
            }
        }
    }
    {
        const int c16 = 16 * lane;
        bf16_t* dst = wsb(a, lane < 32 ? RS_OFF : KS_OFF) + (c16 & 511);
        float swp[16], swc[16], swn[16];
#pragma unroll
        for (int i = 0; i < 16; ++i) { swp[i] = sw[c16 + i]; swc[i] = sw[UC + c16 + i]; swn[i] = sw[2 * UC + c16 + i]; }
        for (int t0 = gw; t0 < T; t0 += 2 * nw) {
            u32x4 c[2][2], p[2][2], n[2][2];
#pragma unroll
            for (int k = 0; k < 2; ++k) {
                const int t = t0 + k * nw; const int pos = t & 4095; const bool hp = pos > 0, hn = pos < 4095;
                const bf16_t* up = U + (size_t)t * UW + c16;
#pragma unroll
                for (int q = 0; q < 2; ++q) {
                    c[k][q] = *(const u32x4*)(up + 8 * q); p[k][q] = (u32x4){0u, 0u, 0u, 0u}; n[k][q] = (u32x4){0u, 0u, 0u, 0u};
                    if (hp) p[k][q] = *(const u32x4*)(up - UW + 8 * q);
                    if (hn) n[k][q] = *(const u32x4*)(up + UW + 8 * q);
                }
            }
#pragma unroll
            for (int k = 0; k < 2; ++k) {
                const int t = t0 + k * nw;
                u32x4 o[2];
#pragma unroll
                for (int q = 0; q < 2; ++q)
#pragma unroll
                    for (int i = 0; i < 4; ++i) {
                        const int e = 8 * q + 2 * i;
                        const float lo = swp[e] * bflo(p[k][q][i]) + swc[e] * bflo(c[k][q][i]) + swn[e] * bflo(n[k][q][i]);
                        const float hi = swp[e + 1] * bfhi(p[k][q][i]) + swc[e + 1] * bfhi(c[k][q][i]) + swn[e + 1] * bfhi(n[k][q][i]);
                        o[q][i] = pack2(lo, hi);
                    }
                *(u32x4*)(dst + (size_t)t * 512) = o[0]; *(u32x4*)(dst + (size_t)t * 512 + 8) = o[1];
            }
        }
    }
}
DEV void ph_rwkv_prep2(const Args& a, int layer, const int tid0) {
    const int lane = tid0 & 63, wv = tid0 >> 6;
    const int gw = blockIdx.x * 8 + wv, nw = gridDim.x * 8;
    bf16_t* U = wsb(a, U_OFF); const bf16_t* KS = wsb(a, KS_OFF);
    const float* sw = a.rwkv_shift + (size_t)layer * 3 * UC;
    const int c8 = 8 * lane;
    float kkc[8], sv[3][8];
#pragma unroll
    for (int i = 0; i < 8; ++i) { kkc[i] = a.rwkv_k_k[layer * 512 + c8 + i]; sv[0][i] = sw[1024 + c8 + i]; sv[1][i] = sw[UC + 1024 + c8 + i]; sv[2][i] = sw[2 * UC + 1024 + c8 + i]; }
    for (int t = gw; t < T; t += nw) {
        const int pos = t & 4095; const bool hp = pos > 0, hn = pos < 4095;
        bf16_t* up = U + (size_t)t * UW;
        const u32x4 ks = *(const u32x4*)(KS + (size_t)t * 512 + c8);
        const u32x4 c = *(const u32x4*)(up + 1024 + c8);
        u32x4 p = {0u, 0u, 0u, 0u}, n = {0u, 0u, 0u, 0u};
        if (hp) p = *(const u32x4*)(up - UW + 1024 + c8);
        if (hn) n = *(const u32x4*)(up + UW + 1024 + c8);
        float kx[8]; float ss = 0.f;
#pragma unroll
        for (int i = 0; i < 4; ++i) { kx[2 * i] = bflo(ks[i]) * kkc[2 * i]; kx[2 * i + 1] = bfhi(ks[i]) * kkc[2 * i + 1]; ss += kx[2 * i] * kx[2 * i] + kx[2 * i + 1] * kx[2 * i + 1]; }
        const float inv = 1.0f / fmaxf(sqrtf(sum8(ss)), 1e-12f);
        u32x4 ko, vo;
#pragma unroll
        for (int i = 0; i < 4; ++i) {
            ko[i] = pack2(kx[2 * i] * inv, kx[2 * i + 1] * inv);
            vo[i] = pack2(sv[0][2 * i] * bflo(p[i]) + sv[1][2 * i] * bflo(c[i]) + sv[2][2 * i] * bflo(n[i]), sv[0][2 * i + 1] * bfhi(p[i]) + sv[1][2 * i + 1] * bfhi(c[i]) + sv[2][2 * i + 1] * bfhi(n[i]));
        }
        *(u32x4*)(up + c8) = ko; *(u32x4*)(up + 1536 + c8) = vo;
    }
}

DEV void ph_post2(const Args& a, int layer, const int tid0) {
    const int lane = tid0 & 63, wv = tid0 >> 6;
    const int gw = blockIdx.x * 8 + wv, nw = gridDim.x * 8;
    const bf16_t* U = wsb(a, U_OFF); const bf16_t* RS = wsb(a, RS_OFF); const bf16_t* KS = wsb(a, KS_OFF); const bf16_t* G = wsb(a, G_OFF);
    const bf16_t* AF = wsb(a, AF_OFF); const bf16_t* AB = wsb(a, AB_OFF); bf16_t* mix = wsb(a, MIX_OFF);
    const int c8 = 8 * lane;
    float kac[8], rkc[8], lnw[8], lnb[8];
#pragma unroll
    for (int i = 0; i < 8; ++i) { kac[i] = a.rwkv_k_a[layer * 512 + c8 + i]; rkc[i] = a.rwkv_r_k[layer * 512 + c8 + i]; lnw[i] = a.rwkv_ln_w[layer * 512 + c8 + i]; lnb[i] = a.rwkv_ln_b[layer * 512 + c8 + i]; }
    struct PostLd { u32x4 rp, kp, gp, afp, abp, yfp, ybp, vp; };
    for (int t0 = gw; t0 < T; t0 += 2 * nw) {
        PostLd L[2];
#pragma unroll
        for (int k = 0; k < 2; ++k) {
            const int t = t0 + k * nw; const bf16_t* up = U + (size_t)t * UW;
            L[k].rp = *(const u32x4*)(RS + (size_t)t * 512 + c8); L[k].kp = *(const u32x4*)(KS + (size_t)t * 512 + c8); L[k].gp = *(const u32x4*)(G + (size_t)t * 512 + c8);
            L[k].afp = *(const u32x4*)(AF + (size_t)t * 512 + c8); L[k].abp = *(const u32x4*)(AB + (size_t)t * 512 + c8);
            L[k].yfp = *(const u32x4*)(up + 512 + c8); L[k].ybp = *(const u32x4*)(up + 1024 + c8); L[k].vp = *(const u32x4*)(up + 1536 + c8);
        }
#pragma unroll
        for (int k = 0; k < 2; ++k) {
        const int t = t0 + k * nw;
        const u32x4 rp = L[k].rp, kp = L[k].kp, gp = L[k].gp, afp = L[k].afp, abp = L[k].abp, yfp = L[k].yfp, ybp = L[k].ybp, vp = L[k].vp;
        float y[8], rr[8], kk[8], vv[8], gg[8], sa[8];
#pragma unroll
        for (int i = 0; i < 4; ++i) {
            y[2 * i] = bflo(yfp[i]) + bflo(ybp[i]); y[2 * i + 1] = bfhi(yfp[i]) + bfhi(ybp[i]);
            rr[2 * i] = bflo(rp[i]); rr[2 * i + 1] = bfhi(rp[i]); kk[2 * i] = bflo(kp[i]); kk[2 * i + 1] = bfhi(kp[i]);
            vv[2 * i] = bflo(vp[i]); vv[2 * i + 1] = bfhi(vp[i]); gg[2 * i] = bflo(gp[i]); gg[2 * i + 1] = bfhi(gp[i]);
            sa[2 * i] = bflo(afp[i]) + bflo(abp[i]); sa[2 * i + 1] = bfhi(afp[i]) + bfhi(abp[i]);
        }
        float ysum = 0.f, bs = 0.f;
#pragma unroll
        for (int i = 0; i < 8; ++i) { ysum += y[i]; bs += rr[i] * kk[i] * (2.0f + (sa[i] - 2.0f) * kac[i]) * rkc[i]; }
        const float mu = sum8(ysum) * (1.0f / 64.0f);
        float vs = 0.f;
#pragma unroll
        for (int i = 0; i < 8; ++i) { y[i] -= mu; vs += y[i] * y[i]; }
        const float rstdv = rsqrtf(sum8(vs) * (1.0f / 64.0f) + 64e-5f);
        bs = sum8(bs);
        float o[8];
#pragma unroll
        for (int i = 0; i < 8; ++i) o[i] = (y[i] * rstdv * lnw[i] + lnb[i] + bs * vv[i]) * gg[i];
        u32x4 ov; ov.x = pack2(o[0], o[1]); ov.y = pack2(o[2], o[3]); ov.z = pack2(o[4], o[5]); ov.w = pack2(o[6], o[7]);
        *(u32x4*)(mix + (size_t)t * 1024 + 512 + c8) = ov;
        }
    }
}

#ifdef PROBE_EMASK
#define PEER_EM(e) (DRY ? ((e) & PROBE_EMASK) : (e))
#else
#define PEER_EM(e) (e)
#endif
template <bool DRY> DEV void ph_peer_pipe(const Args& a, const int tid0, const int gw, const int nw, const int ntok) {
    const int lane = tid0 & 63;
    bf16_t* hb = wsb(a, HB_OFF); float* rstd = wsf(a, RSTD_OFF); const float* ssq = wsf(a, SSQ_OFF);
    const int* TOPI = (const int*)(a.ws + TOPI_OFF); const float* TOPG = wsf(a, TOPG_OFF);
    const unsigned char* PU = a.ws + PTU_OFF; const unsigned char* PV = a.ws + PTV_OFF;
    const int c16 = 16 * lane;
    const bool b5 = lane & 32, b4 = lane & 16, b3 = lane & 8;
    const bool dost = DRY ? (__builtin_amdgcn_readfirstlane(TOPI[0]) == -12345) : true;
    u32x4 ur[2][8], vr[8];
    int e0, e1, e0n = 0, e1n = 0; float g0, g1, g0n = 0.f, g1n = 0.f;
    u32x4 xa, xb, xan = {0u, 0u, 0u, 0u}, xbn = {0u, 0u, 0u, 0u}; float rsv, rsn = 0.f;
#define PEER_ISSUE_U(slot_, b_, es0_, es1_) do { _Pragma("unroll") for (int i_ = 0; i_ < 8; ++i_) { const int k_ = (b_) * 8 + i_; \
        const int e_ = PEER_EM(__builtin_amdgcn_readlane((k_ < 64) ? (es0_) : (es1_), k_ & 63)); ur[slot_][i_] = *(const u32x4*)(PU + (size_t)e_ * 1024 + c16); } } while (0)
#define PEER_ISSUE_V(slot_, b_, es0_, es1_) do { _Pragma("unroll") for (int i_ = 0; i_ < 8; ++i_) { const int k_ = (b_) * 8 + i_; \
        const int e_ = PEER_EM(__builtin_amdgcn_readlane((k_ < 64) ? (es0_) : (es1_), k_ & 63)); vr[i_] = *(const u32x4*)(PV + (size_t)e_ * 1024 + c16); } } while (0)
    if (ntok <= 0) return;
    {   const int t0 = gw;
        e0 = TOPI[(size_t)t0 * 128 + lane]; e1 = TOPI[(size_t)t0 * 128 + 64 + lane]; g0 = TOPG[(size_t)t0 * 128 + lane]; g1 = TOPG[(size_t)t0 * 128 + 64 + lane];
        xa = *(const u32x4*)(hb + (size_t)t0 * 1024 + c16); xb = *(const u32x4*)(hb + (size_t)t0 * 1024 + c16 + 8); rsv = rstd_parts(ssq, t0); }
    PEER_ISSUE_U(0, 0, e0, e1);
#pragma unroll 1
    for (int j = 0; j < ntok; ++j) {
        const int t = gw + nw * j; const bool more = (j + 1 < ntok);
        float* hr = a.h + (size_t)t * 1024 + c16;
        if (more) { const int tn = t + nw;
            e0n = TOPI[(size_t)tn * 128 + lane]; e1n = TOPI[(size_t)tn * 128 + 64 + lane]; }
        const float rs = rsv * (1.0f / 256.0f);
        float out[16];
#pragma unroll
        for (int i = 0; i < 16; ++i) out[i] = 0.f;
#pragma unroll 1
        for (int b2 = 0; b2 < 16; b2 += 2)
#pragma unroll
        for (int bb = 0; bb < 2; ++bb) {
            const int b = b2 + bb;
            PEER_ISSUE_V(0, b, e0, e1);
            if (bb == 0) PEER_ISSUE_U(1, b + 1, e0, e1);
            else if (b < 15) PEER_ISSUE_U(0, b + 1, e0, e1);
            else if (more) PEER_ISSUE_U(0, 0, e0n, e1n);
            asm volatile("" ::: "memory");
            float d[8];
#pragma unroll
            for (int i = 0; i < 8; ++i) {
                float sm = 0.f;
#pragma unroll
                for (int q = 0; q < 4; ++q) {
                    const unsigned uw = ur[bb][i][q];
                    const f32x2 lo = __builtin_amdgcn_cvt_pk_f32_fp8((int)uw, false), hi = __builtin_amdgcn_cvt_pk_f32_fp8((int)uw, true);
                    const unsigned ulo = pack2(lo[0], lo[1]), uhi = pack2(hi[0], hi[1]);
                    const unsigned xlo = (q < 2) ? xa[2 * q] : xb[2 * q - 4], xhi = (q < 2) ? xa[2 * q + 1] : xb[2 * q - 3];
                    sm = dot2bf(ulo, xlo, sm); sm = dot2bf(uhi, xhi, sm);
                }
                d[i] = sm;
            }
            float r4[4], r2[2];
#pragma unroll
            for (int i = 0; i < 4; ++i) { const float send = b5 ? d[i] : d[4 + i], keep = b5 ? d[4 + i] : d[i]; r4[i] = keep + SHX(send, 32); }
#pragma unroll
            for (int i = 0; i < 2; ++i) { const float send = b4 ? r4[i] : r4[2 + i], keep = b4 ? r4[2 + i] : r4[i]; r2[i] = keep + SHX(send, 16); }
            const float send1 = b3 ? r2[0] : r2[1], keep1 = b3 ? r2[1] : r2[0];
            const float dd = sum8(keep1 + SHX(send1, 8));
            const float hp = rs * dd;
            const float gt = SHF((b < 8) ? g0 : g1, (b * 8 + (lane >> 3)) & 63);
            const float w = gt * 0.5f * hp * (1.0f + erff(hp * 0.70710678f)) * (1.0f / 32.0f);
#pragma unroll
            for (int i = 0; i < 8; ++i) {
                const float wi = rl(w, 8 * i);
#pragma unroll
                for (int q = 0; q < 4; ++q) {
                    const unsigned vw = vr[i][q];
                    const f32x2 lo = __builtin_amdgcn_cvt_pk_f32_fp8((int)vw, false), hi = __builtin_amdgcn_cvt_pk_f32_fp8((int)vw, true);
                    out[4 * q] += wi * lo[0]; out[4 * q + 1] += wi * lo[1]; out[4 * q + 2] += wi * hi[0]; out[4 * q + 3] += wi * hi[1];
                }
            }
        }
        if (more) { const int tn = t + nw;
            g0n = TOPG[(size_t)tn * 128 + lane]; g1n = TOPG[(size_t)tn * 128 + 64 + lane];
            xan = *(const u32x4*)(hb + (size_t)tn * 1024 + c16); xbn = *(const u32x4*)(hb + (size_t)tn * 1024 + c16 + 8); rsn = rstd_parts(ssq, tn); }
        float ss = 0.f;
        f32x4 hv[4];
#pragma unroll
        for (int q = 0; q < 4; ++q) hv[q] = *(const f32x4*)(hr + 4 * q);
#pragma unroll
        for (int q = 0; q < 4; ++q) {
#pragma unroll
            for (int c = 0; c < 4; ++c) { hv[q][c] += out[4 * q + c]; ss += hv[q][c] * hv[q][c]; }
            if (dost) *(f32x4*)(hr + 4 * q) = hv[q];
        }
        ss = wave_sum(ss);
        if (dost) {
            u32x4 p0, p1;
            p0.x = pack2(hv[0][0], hv[0][1]); p0.y = pack2(hv[0][2], hv[0][3]); p0.z = pack2(hv[1][0], hv[1][1]); p0.w = pack2(hv[1][2], hv[1][3]);
            p1.x = pack2(hv[2][0], hv[2][1]); p1.y = pack2(hv[2][2], hv[2][3]); p1.z = pack2(hv[3][0], hv[3][1]); p1.w = pack2(hv[3][2], hv[3][3]);
            *(u32x4*)(hb + (size_t)t * 1024 + c16) = p0; *(u32x4*)(hb + (size_t)t * 1024 + c16 + 8) = p1;
            if (lane == 0) rstd[t] = rsqrtf(ss * (1.0f / 1024.0f) + 1e-6f);
        }
        e0 = e0n; e1 = e1n; g0 = g0n; g1 = g1n; xa = xan; xb = xbn; rsv = rsn;
    }
#undef PEER_ISSUE_U
#undef PEER_ISSUE_V
}

#ifndef PEER_NCH
#define PEER_NCH 8
#endif
#ifndef PEER_NPW
#define PEER_NPW 3
#endif
DEV void ph_topk_peer(const Args& a, float* lds, const int tid0) {
    const int wv = __builtin_amdgcn_readfirstlane(tid0 >> 6);
    constexpr int CH = T / PEER_NCH;
    const int npeer = gridDim.x * PEER_NPW, ntopk = gridDim.x * (8 - PEER_NPW);
#pragma unroll 1
    for (int s = 0; s <= PEER_NCH; ++s) {
        const int w8 = blockIdx.x * 8 + wv, n8 = gridDim.x * 8;
        if (s == 0) {
            ph_topk2(a, lds, tid0, w8, n8, CH * (8 / TOPK_NU));
        } else if (s == PEER_NCH) {
            ph_peer_pipe<false>(a, tid0, (s - 1) * CH + w8, n8, (CH - w8 + n8 - 1) / n8);
        } else if (wv < PEER_NPW) {
            const int pw = blockIdx.x * PEER_NPW + wv; ph_peer_pipe<false>(a, tid0, (s - 1) * CH + pw, npeer, (CH - pw + npeer - 1) / npeer);
        } else {
            const int tw = blockIdx.x * (8 - PEER_NPW) + (wv - PEER_NPW); ph_topk2(a, lds, tid0, s * CH * (8 / TOPK_NU) + tw, ntopk, (s + 1) * CH * (8 / TOPK_NU));
        }
        XcdBarrier b_; b_.bar = (unsigned*)(a.ws + BAR_OFF); b_.x = xb_xcc_id(); b_.st = (volatile LAS unsigned*)(smem_base() + LDS_BYTES - 16);
        xcd_barrier(b_, tid0);
    }
}

typedef float f32x4v __attribute__((ext_vector_type(4)));
#define MFMA16(a, b, c) __builtin_amdgcn_mfma_f32_16x16x32_bf16((a), (b), (c), 0, 0, 0)
namespace sc4 {
constexpr int E_AH = 0, E_RH = 2304, E_BH = 4608, E_KH = 6912, E_BHT = 9216, E_KHT = 12288, E_VT = 15360, E_GC = 18432, E_BYTES = 18688;
constexpr int G_NKAT = 0, G_NBRT = 768, G_NKRT = 1536, G_BYTES = 2304;
constexpr int OFF_E = 0, OFF_G = 6 * E_BYTES, OFF_NBAT = OFF_G + 4 * G_BYTES, OFF_TT = OFF_NBAT + 4 * 1024, OFF_Y = OFF_TT + 4 * 768, TOTAL = OFF_Y + 16384;
}
DEV bf16x8 frag2(u32x2 lo, u32x2 hi) { u32x4 v; v.x = lo.x; v.y = lo.y; v.z = hi.x; v.w = hi.y; return __builtin_bit_cast(bf16x8, v); }
DEV bf16x8 pack_acc(f32x4v p, f32x4v q) { u32x4 v; v.x = pack2(p[0], p[1]); v.y = pack2(p[2], p[3]); v.z = pack2(q[0], q[1]); v.w = pack2(q[2], q[3]); return __builtin_bit_cast(bf16x8, v); }
DEV void ph_scan4(const Args& a, int layer, unsigned char* lb, const int tid0) {
    using namespace sc4;
    static_assert(TOTAL <= LDS_BYTES - 16, "scan LDS map");
    const int lane = tid0 & 63, wv = __builtin_amdgcn_readfirstlane(tid0 >> 6);
    const int r = lane & 15, g = lane >> 4;
    const bf16_t* U = wsb(a, U_OFF); const bf16_t* RS = wsb(a, RS_OFF); const bf16_t* KS = wsb(a, KS_OFF); bf16_t* Uw = wsb(a, U_OFF);
    const bool is_state = wv < 4;
    const int dir = is_state ? (wv >> 1) : ((wv - 4) >> 1), role = wv & 1;
    const bf16_t* Wd = wsb(a, dir ? WB2_OFF : WF_OFF); const bf16_t* Ad = wsb(a, dir ? AB_OFF : AF_OFF);
    const u32x2 z2 = {0u, 0u}; const u32x4 z4 = {0u, 0u, 0u, 0u};
    for (int un = blockIdx.x; un < NSEQ * 8; un += gridDim.x) {
        const int seq = un >> 3, hd = un & 7; const size_t tb = (size_t)seq * 4096; const int cb = hd * 64, pch = cb + lane;
        const float kac = a.rwkv_k_a[layer * 512 + pch];
        __syncthreads();
        if (is_state) {
            f32x4v X[4][2];
#pragma unroll
            for (int m = 0; m < 4; ++m)
#pragma unroll
                for (int vt = 0; vt < 2; ++vt) X[m][vt] = (f32x4v){0.f, 0.f, 0.f, 0.f};
#pragma unroll 1
            for (int p = 0; p < 260; ++p) {
                if (p >= 2 && p < 258) {
                    const int n = p - 2;
                    const unsigned char* E = lb + OFF_E + (dir * 3 + (n % 3)) * E_BYTES;
                    const unsigned char* G = lb + OFF_G + (dir * 2 + (n & 1)) * G_BYTES;
                    float* yb = (float*)(lb + OFF_Y) + (((n & 1) * 2 + dir) * 16) * 64 + 32 * role;
                    bf16x8 fa[2], fr[2];
#pragma unroll
                    for (int s = 0; s < 2; ++s) {
                        fa[s] = frag2(*(const u32x2*)(E + E_AH + r * 144 + 2 * (32 * s + 4 * g)), *(const u32x2*)(E + E_AH + r * 144 + 2 * (32 * s + 16 + 4 * g)));
                        fr[s] = frag2(*(const u32x2*)(E + E_RH + r * 144 + 2 * (32 * s + 4 * g)), *(const u32x2*)(E + E_RH + r * 144 + 2 * (32 * s + 16 + 4 * g)));
                    }
                    const int g1 = g & 1;
                    u32x4 nka = *(const u32x4*)(G + G_NKAT + r * 48 + 16 * g1), nkr = *(const u32x4*)(G + G_NKRT + r * 48 + 16 * g1);
                    if (g >= 2) { nka = z4; nkr = z4; }
                    const bf16x8 fnka = __builtin_bit_cast(bf16x8, nka), fnkr = __builtin_bit_cast(bf16x8, nkr);
                    bf16x8 ftt;
                    {
                        const float* nbat = (const float*)(lb + OFF_NBAT + (dir * 2 + (n & 1)) * 1024);
                        unsigned char* tts = lb + OFF_TT + wv * 768;
                        float Tr[16];
#pragma unroll
                        for (int tg = 0; tg < 4; ++tg) {
                            f32x4v nbq[4][4];
#pragma unroll
                            for (int tt = 0; tt < 4; ++tt)
#pragma unroll
                                for (int i4 = 0; i4 < 4; ++i4) if (4 * i4 < 4 * tg + tt) nbq[tt][i4] = *(const f32x4v*)(nbat + (4 * tg + tt) * 16 + 4 * i4);
#pragma unroll
                            for (int tt = 0; tt < 4; ++tt) {
                                const int t = 4 * tg + tt;
                                float acc = (lane == t) ? 1.0f : 0.f, acc2 = 0.f;
#pragma unroll
                                for (int i = 0; i < t; ++i) { const float pr_ = Tr[i] * nbq[tt][i >> 2][i & 3]; if (i & 1) acc2 += pr_; else acc += pr_; }
                                acc += acc2; Tr[t] = acc;
                                if (lane < 16) *(unsigned short*)(tts + t * 48 + 2 * lane) = (unsigned short)f2bf(acc);
                            }
                        }
                        asm volatile("s_waitcnt lgkmcnt(0)" ::: "memory");
                        ftt = frag2(*(const u32x2*)(tts + r * 48 + 8 * g), z2);
                    }
                    const bf16x8 fnbr = frag2(*(const u32x2*)(G + G_NBRT + r * 48 + 8 * g), z2);
                    bf16x8 fbt[4], fkt[4]; f32x4v gc[4];
#pragma unroll
                    for (int m = 0; m < 4; ++m) {
                        fbt[m] = frag2(*(const u32x2*)(E + E_BHT + (16 * m + r) * 48 + 8 * g), z2);
                        u32x4 kt = *(const u32x4*)(E + E_KHT + (16 * m + r) * 48 + 16 * g1); if (g >= 2) kt = z4; fkt[m] = __builtin_bit_cast(bf16x8, kt);
                        gc[m] = *(const f32x4v*)(E + E_GC + 4 * (16 * m + 4 * g));
                    }
#pragma unroll
                    for (int vt = 0; vt < 2; ++vt) {
                        const int v0 = 32 * role + 16 * vt;
                        u32x4 vv = *(const u32x4*)(E + E_VT + (v0 + r) * 48 + 16 * g1); if (g >= 2) vv = z4;
                        const bf16x8 vb = __builtin_bit_cast(bf16x8, vv);
                        const bf16x8 xb0 = pack_acc(X[0][vt], X[1][vt]), xb1 = pack_acc(X[2][vt], X[3][vt]);
                        f32x4v W = {0.f, 0.f, 0.f, 0.f};
                        W = MFMA16(fa[0], xb0, W); W = MFMA16(fa[1], xb1, W); W = MFMA16(fnka, vb, W);
                        const f32x4v zero4 = {0.f, 0.f, 0.f, 0.f};
                        f32x4v Uc = MFMA16(ftt, pack_acc(W, zero4), zero4);
                        const bf16x8 ub = pack_acc(Uc, zero4);
                        f32x4v Y = {0.f, 0.f, 0.f, 0.f};
                        Y = MFMA16(fr[0], xb0, Y); Y = MFMA16(fr[1], xb1, Y); Y = MFMA16(fnbr, ub, Y); Y = MFMA16(fnkr, vb, Y);
#pragma unroll
                        for (int i = 0; i < 4; ++i) yb[(4 * g + i) * 64 + 16 * vt + r] = Y[i];
#pragma unroll
                        for (int m = 0; m < 4; ++m) { f32x4v xm = MFMA16(fbt[m], ub, X[m][vt]); xm = MFMA16(fkt[m], vb, xm); X[m][vt] = xm * gc[m]; }
                    }
                }
                __syncthreads();
            }
        } else {
            unsigned short prA[8][6], pwA[8], prB[8][6], pwB[8];
#define SC5_ISSUE(pr, pw, n_) do { _Pragma("unroll") for (int s_ = 0; s_ < 8; ++s_) { const int step_ = (n_) * 16 + 8 * role + s_, pos_ = dir ? 4095 - step_ : step_; const size_t t_ = tb + pos_; \
            pr[s_][0] = Wd[t_ * 512 + pch]; pr[s_][1] = U[t_ * UW + pch]; pr[s_][2] = Ad[t_ * 512 + pch]; pr[s_][3] = KS[t_ * 512 + pch]; pr[s_][4] = RS[t_ * 512 + pch]; pr[s_][5] = U[t_ * UW + 1536 + pch]; \
            if (role) { const int st0_ = (n_) * 16 + s_, p0_ = dir ? 4095 - st0_ : st0_; pw[s_] = Wd[(tb + p0_) * 512 + pch]; } } } while (0)
            SC5_ISSUE(prA, pwA, 0); SC5_ISSUE(prB, pwB, 1);
#define SC5_PERIOD(pr, pw, p_) do { const int p = (p_); \
                if (p < 256) { \
                    unsigned char* E = lb + OFF_E + (dir * 3 + (p % 3)) * E_BYTES; \
                    float gcur = 1.0f; \
                    if (role) { \
_Pragma("unroll") \
                        for (int s = 0; s < 8; ++s) gcur *= bf2f(pw[s]); \
                    } \
                    unsigned bt[4], kt[4], vtw[4]; \
_Pragma("unroll") \
                    for (int s = 0; s < 8; ++s) { \
                        const int st = 8 * role + s; \
                        const float w_ = bf2f(pr[s][0]), kk_ = bf2f(pr[s][1]), ic_ = bf2f(pr[s][2]), ks_ = bf2f(pr[s][3]), r_ = bf2f(pr[s][4]); \
                        const float gprev = gcur; gcur *= w_; \
                        const float ig = __builtin_amdgcn_rcpf(gcur); \
                        const unsigned ah = f2bf(-gprev * kk_), bh = f2bf(kk_ * ic_ * ig), kh = f2bf(ks_ * (1.0f + (ic_ - 1.0f) * kac) * ig), rh = f2bf(gcur * r_), vh = pr[s][5]; \
                        *(unsigned short*)(E + E_AH + st * 144 + 2 * lane) = (unsigned short)ah; *(unsigned short*)(E + E_RH + st * 144 + 2 * lane) = (unsigned short)rh; \
                        *(unsigned short*)(E + E_BH + st * 144 + 2 * lane) = (unsigned short)bh; *(unsigned short*)(E + E_KH + st * 144 + 2 * lane) = (unsigned short)kh; \
                        if (s & 1) { bt[s >> 1] |= bh << 16; kt[s >> 1] |= kh << 16; vtw[s >> 1] |= vh << 16; } else { bt[s >> 1] = bh; kt[s >> 1] = kh; vtw[s >> 1] = vh; } \
                    } \
                    *(u32x4*)(E + E_BHT + lane * 48 + 16 * role) = (u32x4){bt[0], bt[1], bt[2], bt[3]}; \
                    *(u32x4*)(E + E_KHT + lane * 48 + 16 * role) = (u32x4){kt[0], kt[1], kt[2], kt[3]}; \
                    *(u32x4*)(E + E_VT + lane * 48 + 16 * role) = (u32x4){vtw[0], vtw[1], vtw[2], vtw[3]}; \
                    if (role) *(float*)(E + E_GC + 4 * lane) = gcur; \
                } \
                if (role == 0) { \
                    if (p >= 1 && p < 257) { \
                        const int n = p - 1; \
                        const unsigned char* E = lb + OFF_E + (dir * 3 + (n % 3)) * E_BYTES; \
                        unsigned char* G = lb + OFF_G + (dir * 2 + (n & 1)) * G_BYTES; \
                        float* nbat = (float*)(lb + OFF_NBAT + (dir * 2 + (n & 1)) * 1024); \
                        bf16x8 ab[2], rb[2], bA[2], kA[2]; \
_Pragma("unroll") \
                        for (int s = 0; s < 2; ++s) { \
                            ab[s] = *(const bf16x8*)(E + E_AH + r * 144 + 2 * (32 * s + 8 * g)); rb[s] = *(const bf16x8*)(E + E_RH + r * 144 + 2 * (32 * s + 8 * g)); \
                            bA[s] = *(const bf16x8*)(E + E_BH + r * 144 + 2 * (32 * s + 8 * g)); kA[s] = *(const bf16x8*)(E + E_KH + r * 144 + 2 * (32 * s + 8 * g)); \
                        } \
                        const f32x4v zero4 = {0.f, 0.f, 0.f, 0.f}; \
                        f32x4v nba = MFMA16(bA[1], ab[1], MFMA16(bA[0], ab[0], zero4)), nka = MFMA16(kA[1], ab[1], MFMA16(kA[0], ab[0], zero4)); \
                        f32x4v nbr = MFMA16(bA[1], rb[1], MFMA16(bA[0], rb[0], zero4)), nkr = MFMA16(kA[1], rb[1], MFMA16(kA[0], rb[0], zero4)); \
_Pragma("unroll") \
                        for (int i = 0; i < 4; ++i) { const int j = 4 * g + i; if (j >= r) { nba[i] = 0.f; nka[i] = 0.f; } if (j > r) { nbr[i] = 0.f; nkr[i] = 0.f; } } \
                        *(f32x4v*)(nbat + r * 16 + 4 * g) = nba; \
                        u32x2 pk; pk.x = pack2(nka[0], nka[1]); pk.y = pack2(nka[2], nka[3]); *(u32x2*)(G + G_NKAT + r * 48 + 8 * g) = pk; \
                        pk.x = pack2(nbr[0], nbr[1]); pk.y = pack2(nbr[2], nbr[3]); *(u32x2*)(G + G_NBRT + r * 48 + 8 * g) = pk; \
                        pk.x = pack2(nkr[0], nkr[1]); pk.y = pack2(nkr[2], nkr[3]); *(u32x2*)(G + G_NKRT + r * 48 + 8 * g) = pk; \
                    } \
                } else { \
                    if (p >= 3 && p < 259) { \
                        const int n = p - 3; \
                        const float* yb = (const float*)(lb + OFF_Y) + (((n & 1) * 2 + dir) * 16) * 64; \
                        const int s2 = lane >> 2, c16 = (lane & 3) * 16; \
                        const f32x4v y0 = *(const f32x4v*)(yb + s2 * 64 + c16), y1 = *(const f32x4v*)(yb + s2 * 64 + c16 + 4), y2 = *(const f32x4v*)(yb + s2 * 64 + c16 + 8), y3 = *(const f32x4v*)(yb + s2 * 64 + c16 + 12); \
                        const int step = n * 16 + s2, pos = dir ? 4095 - step : step; \
                        u32x4 o0, o1; o0.x = pack2(y0[0], y0[1]); o0.y = pack2(y0[2], y0[3]); o0.z = pack2(y1[0], y1[1]); o0.w = pack2(y1[2], y1[3]); \
                        o1.x = pack2(y2[0], y2[1]); o1.y = pack2(y2[2], y2[3]); o1.z = pack2(y3[0], y3[1]); o1.w = pack2(y3[2], y3[3]); \
                        bf16_t* dst = Uw + (tb + pos) * UW + 512 + 512 * dir + cb + c16; \
                        *(u32x4*)(dst) = o0; *(u32x4*)(dst + 8) = o1; \
                    } \
                } \
                if (p + 2 < 256) SC5_ISSUE(pr, pw, p + 2); \
                __syncthreads(); \
            } while (0)
#pragma unroll 1
            for (int p2 = 0; p2 < 260; p2 += 2) { SC5_PERIOD(prA, pwA, p2); SC5_PERIOD(prB, pwB, p2 + 1); }
#undef SC5_PERIOD
#undef SC5_ISSUE
        }
    }
}

extern __shared__ __attribute__((aligned(16))) unsigned char smem[];

enum { PH_PROLOGUE = 0, PH_ROWPREP_X, PH_GEMM1, PH_ATTN, PH_LORA, PH_PREP2, PH_SCAN, PH_POST, PH_GEMM2, PH_CONVERT, PH_GEMM3, PH_TOPK, PH_PEER, PH_PEERDRY, PH_TOPKPEER, PH_GEMM4A, PH_GEMM4B, PH_FINAL };

template <int PH> DEV void run_phase(const Args& a, int layer, const int tid0) {
    float* ldsf = (float*)smem;
    PG8_LAS unsigned char* ldsg = (PG8_LAS unsigned char*)smem;
    const bf16_t* wb = wsb(a, WB_OFF + (size_t)layer * WB_LAYER);
    if constexpr (PH == PH_PROLOGUE) ph_prologue(a, ldsf, tid0);
    else if constexpr (PH == PH_ROWPREP_X) ph_rowprep(a, true, tid0);
    else if constexpr (PH == PH_GEMM1) {
        pg8::Gemm g{wsb(a, HB_OFF), wb + WB_IN / 2, T, INP, 1024};
        pg8::StaticOrder S; S.init(T, INP, gridDim.x, blockIdx.x);
        pg8::EpiProj E{wsb(a, QKV_OFF), wsb(a, U_OFF), wsf(a, SSQ_OFF), wsf(a, ROPEC_OFF), wsf(a, ROPES_OFF)};
        pg8::gemm_phase<pg8::EpiProj, pg8::StaticOrder, false>(ldsg, g, S, E, nullptr, tid0);
    }
    else if constexpr (PH == PH_ATTN) ph_attn3(a, layer, smem, tid0);
    else if constexpr (PH == PH_LORA) ph_rwkv_prep1(a, layer, smem, tid0);
    else if constexpr (PH == PH_PREP2) ph_rwkv_prep2(a, layer, tid0);
    else if constexpr (PH == PH_SCAN) ph_scan4(a, layer, smem, tid0);
    else if constexpr (PH == PH_POST) ph_post2(a, layer, tid0);
    else if constexpr (PH == PH_GEMM2) {
        pg8::Gemm g{wsb(a, MIX_OFF), wb + WB_OUT / 2, T, 1024, 1024};
        pg8::StaticOrder S; S.init(T, 1024, gridDim.x, blockIdx.x);
        pg8::EpiF32x<1> E{a.h, 1024, nullptr, wsb(a, HB_OFF), wsf(a, SSQ_OFF)};
        pg8::gemm_phase<pg8::EpiF32x<1>, pg8::StaticOrder, false>(ldsg, g, S, E, nullptr, tid0);
    }
    else if constexpr (PH == PH_CONVERT) ph_convert8(a, layer, tid0);
    else if constexpr (PH == PH_GEMM3) {
        pg8::Gemm g{wsb(a, HB_OFF), wb + WB_QK / 2, T, 2048, 1024};
        pg8::StaticOrder S; S.init(T, 2048, gridDim.x, blockIdx.x);
        pg8::EpiF32x<0> E{wsf(a, SC_OFF), 2048, nullptr, nullptr, nullptr};
        pg8::gemm_phase<pg8::EpiF32x<0>, pg8::StaticOrder, false>(ldsg, g, S, E, nullptr, tid0);
    }
    else if constexpr (PH == PH_TOPK) ph_topk2(a, ldsf, tid0, blockIdx.x * 8 + (tid0 >> 6), gridDim.x * 8, T * (8 / TOPK_NU));
    else if constexpr (PH == PH_TOPKPEER) ph_topk_peer(a, ldsf, tid0);
    else if constexpr (PH == PH_PEER) ph_peer_pipe<false>(a, tid0, blockIdx.x * 8 + (tid0 >> 6), gridDim.x * 8, T / (gridDim.x * 8));
    else if constexpr (PH == PH_PEERDRY) ph_peer_pipe<true>(a, tid0, blockIdx.x * 8 + (tid0 >> 6), gridDim.x * 8, T / (gridDim.x * 8));
    else if constexpr (PH == PH_GEMM4A) {
        pg8::Gemm g{wsb(a, HB_OFF), wb + WB_GATE / 2, T, 1024, 1024};
        pg8::StaticOrder S; S.init(T, 1024, gridDim.x, blockIdx.x);
        pg8::EpiGate E{wsb(a, GATE_OFF), wsf(a, RSTD_OFF), a.ple_b_gate + layer * 1024};
        pg8::gemm_phase<pg8::EpiGate, pg8::StaticOrder, false>(ldsg, g, S, E, nullptr, tid0);
    }
    else if constexpr (PH == PH_GEMM4B) {
        pg8::Gemm g{wsb(a, PB_OFF), wb + WB_PROJ / 2, T, 1024, 256};
        pg8::StaticOrder S; S.init(T, 1024, gridDim.x, blockIdx.x);
        pg8::EpiF32x<2> E{a.h, 1024, wsb(a, GATE_OFF), wsb(a, HB_OFF), wsf(a, SSQ_OFF)};
        pg8::gemm_phase<pg8::EpiF32x<2>, pg8::StaticOrder, false>(ldsg, g, S, E, nullptr, tid0);
    }
    else if constexpr (PH == PH_FINAL) ph_final(a, tid0);
}

#if !ONE_LAUNCH
template <int PH> __global__ void __launch_bounds__(NTHR, 2) k_phase(Args a, int layer) { run_phase<PH>(a, layer, (int)threadIdx.x); }
#endif

#if ONE_LAUNCH
#ifndef REP_PEER
#define REP_PEER 1
#endif
#ifndef REP_SCAN
#define REP_SCAN 1
#endif
#ifndef REP_TOPK
#define REP_TOPK 1
#endif
#ifndef REP_GEMM1
#define REP_GEMM1 1
#endif
#ifndef REP_LORA
#define REP_LORA 1
#endif
#ifndef REP_POST
#define REP_POST 1
#endif
#ifndef REP_ATTN
#define REP_ATTN 1
#endif
#ifndef REP_GEMM3
#define REP_GEMM3 1
#endif
typedef const __attribute__((address_space(4))) unsigned long long* kargs_t;
static_assert(sizeof(Args) == 31 * 8, "Args is 31 pointers, no padding");
#define AS1 __attribute__((address_space(1)))
DEV Args load_args(kargs_t kp) {
    Args r; const float** d = (const float**)&r;
#pragma unroll
    for (int i = 0; i < 29; ++i) d[i] = (const float*)(AS1 const float*)kp[i];
    r.h = (float*)(AS1 float*)kp[29]; r.ws = (unsigned char*)(AS1 unsigned char*)kp[30];
    return r; }
#define RUN(PH, layer) do { kargs_t kp_ = (kargs_t)__builtin_amdgcn_kernarg_segment_ptr(); asm volatile("" : "+s"(kp_)); const Args la_ = load_args(kp_); int t_; asm volatile("v_mbcnt_lo_u32_b32 %0, -1, 0\n\tv_mbcnt_hi_u32_b32 %0, -1, %0\n\tv_lshl_add_u32 %0, %1, 6, %0" : "=&v"(t_) : "s"(wv0_)); run_phase<PH>(la_, layer, t_); } while (0)
#define BAR() do { kargs_t kp_ = (kargs_t)__builtin_amdgcn_kernarg_segment_ptr(); asm volatile("" : "+s"(kp_)); XcdBarrier b_; b_.bar = (unsigned*)((unsigned char*)kp_[30] + BAR_OFF); b_.x = xb_xcc_id(); b_.st = (volatile LAS unsigned*)(smem + LDS_BYTES - 16); int t_; asm volatile("v_mbcnt_lo_u32_b32 %0, -1, 0\n\tv_mbcnt_hi_u32_b32 %0, -1, %0\n\tv_lshl_add_u32 %0, %1, 6, %0" : "=&v"(t_) : "s"(wv0_)); xcd_barrier(b_, t_); } while (0)
#define LAYER_BODY(layer) do { \
        for (int rep_ = 0; rep_ < REP_GEMM1; ++rep_) { RUN(PH_GEMM1, layer); BAR(); } \
        for (int rep_ = 0; rep_ < REP_ATTN; ++rep_) { RUN(PH_ATTN, layer); BAR(); } \
        for (int rep_ = 0; rep_ < REP_LORA; ++rep_) { RUN(PH_LORA, layer); BAR(); } \
        for (int rep_ = 0; rep_ < REP_PREP2; ++rep_) { RUN(PH_PREP2, layer); BAR(); } \
        for (int rep_ = 0; rep_ < REP_SCAN; ++rep_) { RUN(PH_SCAN, layer); BAR(); } \
        for (int rep_ = 0; rep_ < REP_POST; ++rep_) { RUN(PH_POST, layer); BAR(); } \
        RUN(PH_GEMM2, layer); BAR(); \
        for (int rep_ = 0; rep_ < REP_CONVERT; ++rep_) { RUN(PH_CONVERT, layer); BAR(); } \
        for (int rep_ = 0; rep_ < REP_GEMM3; ++rep_) { RUN(PH_GEMM3, layer); BAR(); } \
        RUN(PH_TOPKPEER, layer); \
        for (int rep_ = 0; rep_ < REP_GEMM4A; ++rep_) { RUN(PH_GEMM4A, layer); BAR(); } \
        RUN(PH_GEMM4B, layer); BAR(); \
    } while (0)
__global__ void __launch_bounds__(NTHR, 2) k_mega(Args a) {
    if (threadIdx.x == 0) *(uint4*)(smem + LDS_BYTES - 16) = make_uint4(0u, 0u, 0u, 0u);
    __syncthreads();
    (void)xcd_barrier_post((unsigned*)(a.ws + BAR_OFF), (volatile LAS unsigned*)(smem + LDS_BYTES - 16));
    const int wv0_ = __builtin_amdgcn_readfirstlane((int)threadIdx.x >> 6);
    RUN(PH_PROLOGUE, 0);
    RUN(PH_ROWPREP_X, 0); BAR();
    LAYER_BODY(0); LAYER_BODY(1); LAYER_BODY(2); LAYER_BODY(3);
    RUN(PH_FINAL, 0);
}
#endif

#if !ONE_LAUNCH
template <int PH> static void launch_phase(const Args& a, int layer, hipStream_t st) {
    static bool attr = false;
    if (!attr) { (void)hipFuncSetAttribute((const void*)k_phase<PH>, hipFuncAttributeMaxDynamicSharedMemorySize, LDS_BYTES); attr = true; }
    hipLaunchKernelGGL(k_phase<PH>, dim3(NWG), dim3(NTHR), LDS_BYTES, st, a, layer);
}
#endif

extern "C" void kernel_launch(void* const* d_in, const int* in_sizes, int n_in, void* d_out, int out_size, void* d_ws, size_t ws_size, hipStream_t stream) {
    if (n_in != 29 || out_size != T * D || ws_size < WS_END) {
        fprintf(stderr, "kernel_launch: unexpected shapes (n_in %d, out %d, ws %zu, need %zu); nothing launched\n", n_in, out_size, ws_size, (size_t)WS_END);
        return;
    }
    Args a{};
    const float** ap = (const float**)&a;
    for (int i = 0; i < 29; ++i) ap[i] = (const float*)d_in[i];
    a.h = (float*)d_out; a.ws = (unsigned char*)d_ws;
#if ONE_LAUNCH
    static bool attr = false;
    if (!attr) { (void)hipFuncSetAttribute((const void*)k_mega, hipFuncAttributeMaxDynamicSharedMemorySize, LDS_BYTES); attr = true; }
    (void)hipMemsetAsync((char*)d_ws + BAR_OFF, 0, XCD_BAR_WORDS * sizeof(unsigned), stream);
    hipLaunchKernelGGL(k_mega, dim3(NWG), dim3(NTHR), LDS_BYTES, stream, a);
#else
    launch_phase<PH_PROLOGUE>(a, 0, stream);
    launch_phase<PH_ROWPREP_X>(a, 0, stream);
    for (int layer = 0; layer < NL; ++layer) {
        launch_phase<PH_GEMM1>(a, layer, stream);
        launch_phase<PH_ATTN>(a, layer, stream);
        launch_phase<PH_LORA>(a, layer, stream);
        launch_phase<PH_PREP2>(a, layer, stream);
        launch_phase<PH_SCAN>(a, layer, stream);
        launch_phase<PH_POST>(a, layer, stream);
        launch_phase<PH_GEMM2>(a, layer, stream);
        launch_phase<PH_CONVERT>(a, layer, stream);
        launch_phase<PH_GEMM3>(a, layer, stream);
        launch_phase<PH_TOPK>(a, layer, stream);
        launch_phase<PH_PEER>(a, layer, stream);
        launch_phase<PH_GEMM4A>(a, layer, stream);
        launch_phase<PH_GEMM4B>(a, layer, stream);
    }
    launch_phase<PH_FINAL>(a, 0, stream);
#endif
}
```

```cpp
#include <hip/hip_runtime.h>
#include <stdint.h>
#include <stdio.h>

#ifndef ONE_LAUNCH
#define ONE_LAUNCH 1
#endif

#ifndef REP_PREP2
#define REP_PREP2 1
#endif
#ifndef REP_CONVERT
#define REP_CONVERT 1
#endif
#ifndef REP_GEMM4A
#define REP_GEMM4A 1
#endif
#ifndef REP_ATTNX
#define REP_ATTNX 0
#endif
#ifndef REP_MERGE
#define REP_MERGE 0
#endif
#ifndef ATTN_VAR
#define ATTN_VAR 0
#endif

typedef unsigned short bf16_t;
typedef float f32x4 __attribute__((ext_vector_type(4)));
typedef float f32x2 __attribute__((ext_vector_type(2)));
typedef unsigned u32x4 __attribute__((ext_vector_type(4)));
typedef unsigned u32x2 __attribute__((ext_vector_type(2)));
typedef __bf16 bf16x2_t __attribute__((ext_vector_type(2)));

#define DEV __device__ __forceinline__

namespace cfg {
constexpr int NSEQ = 20, SEQ = 4096, T = NSEQ * SEQ, TP = 4 * SEQ, D = 1024, NL = 4;
constexpr int INC = 3456, INP = 3584;
constexpr int QKVW = 1536, UW = 2048, UC = 1920;
constexpr int NWG = 256, NTHR = 512;
constexpr int LDS_BYTES = 163840;
constexpr size_t MiB = 1ull << 20;
constexpr size_t WB_OFF = 0;
constexpr size_t WB_LAYER = 16 * MiB;
constexpr size_t WB_IN = 0, WB_OUT = 7 * MiB, WB_QK = 9 * MiB, WB_GATE = 13 * MiB, WB_PROJ = 15 * MiB, WB_LORA = 15 * MiB + 512 * 1024;
constexpr size_t HB_OFF = 64 * MiB;
constexpr size_t MIX_OFF = 224 * MiB;
constexpr size_t SMALL_OFF = 384 * MiB;
constexpr size_t RSTD_OFF = SMALL_OFF;
constexpr size_t ROPEC_OFF = SMALL_OFF + 512 * 1024, ROPES_OFF = SMALL_OFF + 640 * 1024;
constexpr size_t BAR_OFF = SMALL_OFF + 1 * MiB;
constexpr size_t BIG_OFF = 386 * MiB;
constexpr size_t QKV_OFF = BIG_OFF;
constexpr size_t RS_OFF = BIG_OFF, KS_OFF = BIG_OFF + 80 * MiB, G_OFF = BIG_OFF + 160 * MiB;
constexpr size_t U_OFF = BIG_OFF + 240 * MiB;
constexpr size_t WF_OFF = BIG_OFF + 560 * MiB, WB2_OFF = BIG_OFF + 640 * MiB, AF_OFF = BIG_OFF + 720 * MiB, AB_OFF = BIG_OFF + 800 * MiB;
constexpr size_t OP_OFF = BIG_OFF + 560 * MiB;
constexpr size_t ML_OFF = BIG_OFF + 800 * MiB;
constexpr size_t SC_OFF = BIG_OFF;
constexpr size_t TOPI_OFF = BIG_OFF + 640 * MiB, TOPG_OFF = BIG_OFF + 680 * MiB;
constexpr size_t PTU_OFF = BIG_OFF + 720 * MiB, PTV_OFF = BIG_OFF + 752 * MiB;
constexpr size_t PB_OFF = BIG_OFF + 784 * MiB;
constexpr size_t GATE_OFF = BIG_OFF;
constexpr size_t SSQ_OFF = BIG_OFF + 880 * MiB;
constexpr size_t WS_END = BIG_OFF + 886 * MiB;
}
using namespace cfg;

struct Args {
    const float* x_prompt; const float* x_sample; const float* p_prompt; const float* p_sample;
    const float* norm_mix_g; const float* w_in; const float* att_norm_g; const float* rwkv_shift;
    const float* rwkv_w0; const float* rwkv_w2; const float* rwkv_a0; const float* rwkv_a2; const float* rwkv_g2;
    const float* rwkv_k_k; const float* rwkv_k_a; const float* rwkv_r_k; const float* rwkv_ln_w; const float* rwkv_ln_b;
    const float* w_out; const float* norm_ffn_g; const float* peer_w_q; const float* peer_sub_keys; const float* peer_u; const float* peer_v;
    const float* ple_norm_g; const float* ple_w_gate; const float* ple_b_gate; const float* ple_w_proj; const float* final_norm_g;
    float* h;
    unsigned char* ws;
};

DEV int tid_() { int t = threadIdx.x; asm volatile("" : "+v"(t)); return t; }
DEV float bf2f(unsigned h) { return __uint_as_float(h << 16); }
DEV float bflo(unsigned d) { return __uint_as_float(d << 16); }
DEV float bfhi(unsigned d) { return __uint_as_float(d & 0xffff0000u); }
DEV unsigned pack2(float lo, float hi) { const f32x2 v = {lo, hi}; return __builtin_bit_cast(unsigned, __builtin_convertvector(v, bf16x2_t)); }
DEV unsigned f2bf(float f) { return pack2(f, 0.f) & 0xffffu; }
DEV float dot2bf(unsigned a, unsigned b, float c) { return __builtin_amdgcn_fdot2_f32_bf16(__builtin_bit_cast(bf16x2_t, a), __builtin_bit_cast(bf16x2_t, b), c, false); }
DEV float shx_(float v, int lane, int o) { return __int_as_float(__builtin_amdgcn_ds_bpermute((lane ^ o) << 2, __float_as_int(v))); }
DEV float shf_(float v, int src) { return __int_as_float(__builtin_amdgcn_ds_bpermute(src << 2, __float_as_int(v))); }
DEV int shf_(int v, int src) { return __builtin_amdgcn_ds_bpermute(src << 2, v); }
#define SHX(v, o) shx_((v), lane, (o))
#define SHF(v, src) shf_((v), (src))
DEV float wave_sum_(float v, int lane) {
#pragma unroll
    for (int o = 32; o > 0; o >>= 1) v += shx_(v, lane, o);
    return v;
}
DEV float wave_max_(float v, int lane) {
#pragma unroll
    for (int o = 32; o > 0; o >>= 1) v = fmaxf(v, shx_(v, lane, o));
    return v;
}
#define wave_sum(x) wave_sum_((x), lane)
#define wave_max(x) wave_max_((x), lane)
DEV float sum8(float v) {
    v += __int_as_float(__builtin_amdgcn_mov_dpp(__float_as_int(v), 0xB1, 0xF, 0xF, true));
    v += __int_as_float(__builtin_amdgcn_mov_dpp(__float_as_int(v), 0x4E, 0xF, 0xF, true));
    v += __int_as_float(__builtin_amdgcn_mov_dpp(__float_as_int(v), 0x141, 0xF, 0xF, true));
    return v;
}
DEV float rstd_parts(const float* ssq, int t) { const f32x4* p = (const f32x4*)(ssq + (size_t)t * 16); const f32x4 a = p[0], b = p[1], c = p[2], d = p[3];
    const float s = ((a[0] + a[1]) + (a[2] + a[3])) + ((b[0] + b[1]) + (b[2] + b[3])) + ((c[0] + c[1]) + (c[2] + c[3])) + ((d[0] + d[1]) + (d[2] + d[3]));
    return rsqrtf(s * (1.0f / 1024.0f) + 1e-6f); }
DEV float sigmoidf_(float x) { return __builtin_amdgcn_rcpf(1.0f + __expf(-x)); }
namespace pg8 {
#define PG8_LAS __attribute__((address_space(3)))
typedef unsigned short bf16_t;
typedef short bf16x8 __attribute__((ext_vector_type(8)));
typedef float f32x4 __attribute__((ext_vector_type(4)));
typedef unsigned u32x4 __attribute__((ext_vector_type(4)));
constexpr int BM = 256, BK = 64, HALF = 128, HTB = HALF * BK * 2  , STAGE_BYTES = 8 * HTB, NXCD = 8, WGM = 8;

__host__ __device__ __forceinline__ int lds_byte(int r, int c) { const int st = (r >> 4) * 2 + (c >> 5), rr = r & 15, cc = c & 31, ob = rr * 64 + cc * 2; return st * 1024 + (ob ^ (((ob >> 9) & 1) << 5)); }
__host__ __device__ __forceinline__ void stage_rc(int b, int& R, int& C) { const int st = b / 1024, sb = b % 1024, swz = sb ^ (((sb >> 9) & 1) << 5); R = (st >> 1) * 16 + swz / 64; C = (st & 1) * 32 + (swz % 64) / 2; }
__host__ __device__ __forceinline__ int perm32(int rho) { const int n = rho >> 4, i = rho & 15; return 8 * (i >> 2) + 4 * n + (i & 3); }

struct Unit { int pm, pn; };
struct Gemm { const bf16_t* A; const bf16_t* Bt; int M, N, K; };

struct StaticOrder {
    int nM, nN, nwg, G, c;
    __host__ __device__ void init(int M, int N, int G_, int c_) { nM = M / BM; nN = N / BM; nwg = nM * nN; G = G_; c = c_; }
    __host__ __device__ bool next(int i, Unit& u) const {
        const long L = (long)i * G + c; if (L >= nwg) return false;
        int wgid = (int)L; { const int q = nwg / NXCD, r = nwg % NXCD, xcd = wgid % NXCD, off = wgid / NXCD; wgid = (xcd < r ? xcd * (q + 1) : r * (q + 1) + (xcd - r) * q) + off; }
        const int nig = WGM * nN, gid = wgid / nig, fm = gid * WGM, gsz = (nM - fm) < WGM ? (nM - fm) : WGM;
        u.pm = fm + ((wgid % nig) % gsz); u.pn = (wgid % nig) / gsz; return true;
    }
    __device__ __forceinline__ void a_ready(const Unit&) const {}
    __device__ __forceinline__ void done(const Unit&) const {}
};
__device__ __forceinline__ unsigned cvt_pk_bf16(float lo, float hi) { unsigned r; asm volatile("v_cvt_pk_bf16_f32 %0, %1, %2" : "=v"(r) : "v"(lo), "v"(hi)); return r; }

struct EpiProj {
    static constexpr bool PERM = true, AFTER_DRAIN = false;
    bf16_t* qkv; bf16_t* u; const float* ssq; const float* rc; const float* rs;
    __device__ __forceinline__ void operator()(const f32x4 (&acc)[2][2][4][2], const Unit& un, int wr, int wc, int fr, int fq) const {
        const int row0 = un.pm * BM + wr * 64 + fr, lane = fr + 16 * fq;
        const bool isq = un.pn < 6;
        bf16_t* base = isq ? qkv : u; const int ld = isq ? 1536 : 2048; const int colt = isq ? un.pn * BM : (un.pn - 6) * BM;
        const int col0 = colt + wc * 32 + 8 * fq;
        const bool rope = (un.pn < 4) && ((wc & 1) == 0);
        f32x4 pq[2][4];
#pragma unroll
        for (int ai = 0; ai < 2; ++ai)
#pragma unroll
            for (int m = 0; m < 4; ++m) pq[ai][m] = *(const f32x4*)(ssq + (size_t)(row0 + ai * HALF + m * 16) * 16 + 4 * fq);
        float rsd[2][4];
#pragma unroll
        for (int ai = 0; ai < 2; ++ai)
#pragma unroll
            for (int m = 0; m < 4; ++m) { float t = (pq[ai][m][0] + pq[ai][m][1]) + (pq[ai][m][2] + pq[ai][m][3]); t += SHX(t, 16); t += SHX(t, 32); rsd[ai][m] = rsqrtf(t * (1.0f / 1024.0f) + 1e-6f); }
#pragma unroll
        for (int ai = 0; ai < 2; ++ai)
#pragma unroll
            for (int m = 0; m < 4; ++m) {
                const int row = row0 + ai * HALF + m * 16; const float s = rsd[ai][m]; const int pos = row & 4095;
                f32x4 c0 = {1.f, 1.f, 1.f, 1.f}, c1 = c0, s0 = {0.f, 0.f, 0.f, 0.f}, s1 = s0;
                if (rope) { c0 = *(const f32x4*)(rc + pos * 8); c1 = *(const f32x4*)(rc + pos * 8 + 4); s0 = *(const f32x4*)(rs + pos * 8); s1 = *(const f32x4*)(rs + pos * 8 + 4); }
                bf16_t* rowp = base + (size_t)row * ld + col0;
#pragma unroll
                for (int bj = 0; bj < 2; ++bj) {
                    f32x4 v0 = acc[ai][bj][m][0] * s, v1 = acc[ai][bj][m][1] * s;
                    if (rope) {
                        f32x4 o0, o1;
#pragma unroll
                        for (int c = 0; c < 4; ++c) { o0[c] = SHX(v0[c], 16); o1[c] = SHX(v1[c], 16); }
                        if (fq == 0) { v0 = v0 * c0 - o0 * s0; v1 = v1 * c1 - o1 * s1; }
                        else if (fq == 1) { v0 = v0 * c0 + o0 * s0; v1 = v1 * c1 + o1 * s1; }
                    }
                    u32x4 w; w.x = cvt_pk_bf16(v0[0], v0[1]); w.y = cvt_pk_bf16(v0[2], v0[3]); w.z = cvt_pk_bf16(v1[0], v1[1]); w.w = cvt_pk_bf16(v1[2], v1[3]);
                    *(u32x4*)(rowp + bj * HALF) = w;
                }
            }
    }
};
template <int MODE> struct EpiF32x {
    static constexpr bool PERM = true, AFTER_DRAIN = false;
    float* C; int ldc; const bf16_t* gate; bf16_t* hb; float* ssq;
    __device__ __forceinline__ void operator()(const f32x4 (&acc)[2][2][4][2], const Unit& un, int wr, int wc, int fr, int fq) const {
        const int row0 = un.pm * BM + wr * 64 + fr, col0 = un.pn * BM + wc * 32 + 8 * fq, lane = fr + 16 * fq;
#pragma unroll
        for (int ai = 0; ai < 2; ++ai)
#pragma unroll
            for (int m = 0; m < 4; ++m) {
                const int row = row0 + ai * HALF + m * 16;
                const size_t ro = (size_t)row * ldc + col0;
                if (MODE != 0) asm volatile("" ::: "memory");
                float ss = 0.f;
#pragma unroll
                for (int bj = 0; bj < 2; ++bj) {
                    if (MODE == 2 && bj) asm volatile("" ::: "memory");
                    f32x4* p = (f32x4*)(C + ro + bj * HALF);
                    if (MODE == 0) { p[0] = acc[ai][bj][m][0]; p[1] = acc[ai][bj][m][1]; }
                    else {
                        f32x4 v0, v1;
                        if (MODE == 1) { v0 = p[0] + acc[ai][bj][m][0]; v1 = p[1] + acc[ai][bj][m][1]; }
                        else { const u32x4 g = *(const u32x4*)(gate + ro + bj * HALF);
                               f32x4 g0, g1; g0[0] = __uint_as_float(g.x << 16); g0[1] = __uint_as_float(g.x & 0xffff0000u); g0[2] = __uint_as_float(g.y << 16); g0[3] = __uint_as_float(g.y & 0xffff0000u);
                               g1[0] = __uint_as_float(g.z << 16); g1[1] = __uint_as_float(g.z & 0xffff0000u); g1[2] = __uint_as_float(g.w << 16); g1[3] = __uint_as_float(g.w & 0xffff0000u);
                               v0 = p[0] + g0 * acc[ai][bj][m][0]; v1 = p[1] + g1 * acc[ai][bj][m][1]; }
                        p[0] = v0; p[1] = v1;
                        ss += ((v0[0] * v0[0] + v0[1] * v0[1]) + (v0[2] * v0[2] + v0[3] * v0[3])) + ((v1[0] * v1[0] + v1[1] * v1[1]) + (v1[2] * v1[2] + v1[3] * v1[3]));
                        u32x4 pk; pk.x = cvt_pk_bf16(v0[0], v0[1]); pk.y = cvt_pk_bf16(v0[2], v0[3]); pk.z = cvt_pk_bf16(v1[0], v1[1]); pk.w = cvt_pk_bf16(v1[2], v1[3]);
                        *(u32x4*)(hb + ro + bj * HALF) = pk;
                    }
                }
                if (MODE != 0) {
                    ss += SHX(ss, 16); ss += SHX(ss, 32);
                    if (fq == 0) ssq[(size_t)row * 16 + un.pn * 4 + wc] = ss;
                }
            }
    }
};
struct EpiGate {
    static constexpr bool PERM = true, AFTER_DRAIN = false;
    bf16_t* O; const float* rstd; const float* bias;
    __device__ __forceinline__ void operator()(const f32x4 (&acc)[2][2][4][2], const Unit& un, int wr, int wc, int fr, int fq) const {
        const int row0 = un.pm * BM + wr * 64 + fr, col0 = un.pn * BM + wc * 32 + 8 * fq;
        f32x4 bv[2][2];
#pragma unroll
        for (int bj = 0; bj < 2; ++bj)
#pragma unroll
            for (int n = 0; n < 2; ++n) bv[bj][n] = *(const f32x4*)(bias + col0 + bj * HALF + 4 * n);
#pragma unroll
        for (int ai = 0; ai < 2; ++ai)
#pragma unroll
            for (int m = 0; m < 4; ++m) {
                const int row = row0 + ai * HALF + m * 16; const float s = rstd[row];
                bf16_t* rowp = O + (size_t)row * 1024 + col0;
#pragma unroll
                for (int bj = 0; bj < 2; ++bj) {
                    f32x4 v0 = acc[ai][bj][m][0] * s + bv[bj][0], v1 = acc[ai][bj][m][1] * s + bv[bj][1];
#pragma unroll
                    for (int c = 0; c < 4; ++c) { v0[c] = __builtin_amdgcn_rcpf(1.0f + __expf(-v0[c])); v1[c] = __builtin_amdgcn_rcpf(1.0f + __expf(-v1[c])); }
                    u32x4 w; w.x = cvt_pk_bf16(v0[0], v0[1]); w.y = cvt_pk_bf16(v0[2], v0[3]); w.z = cvt_pk_bf16(v1[0], v1[1]); w.w = cvt_pk_bf16(v1[2], v1[3]);
                    *(u32x4*)(rowp + bj * HALF) = w;
                }
            }
    }
};
template <class Epi, class Sched, bool STAMP = false>
__device__ __forceinline__ void gemm_phase(PG8_LAS unsigned char* lds, const Gemm g, const Sched& S, const Epi& E, unsigned long long* stamps, const int tid_in) {
    const int tid = tid_in, wid = __builtin_amdgcn_readfirstlane(tid >> 6), lane = tid & 63, wr = wid >> 2, wc = wid & 3, fr = lane & 15, fq = lane >> 4;
    const int K = g.K, nt = K / BK;
    int ts_lo = 0, ts_hi = 0, nts = 0; const unsigned long long rt_entry = STAMP ? (unsigned long long)wall_clock64() : 0ull;
#define PG8_STAMP() do { if (STAMP && wid == 0 && nts < 64) { const unsigned long long _c = (unsigned long long)clock64(); \
        ts_lo = (lane == nts) ? (int)(unsigned)_c : ts_lo; ts_hi = (lane == nts) ? (int)(unsigned)(_c >> 32) : ts_hi; ++nts; } } while (0)
    PG8_STAMP();
    unsigned voffA[2], voffB[2];
#pragma unroll
    for (int i = 0; i < 2; ++i) { int R, C; stage_rc(tid * 16 + i * 8192, R, C); const int Rb = Epi::PERM ? ((R & ~31) + perm32(R & 31)) : R;
        voffA[i] = (unsigned)(R * K + C) * 2u; voffB[i] = (unsigned)(Rb * K + C) * 2u; }
    const size_t kstep = (size_t)(BK * 2);
    const size_t hstep = (size_t)HALF * K * 2;
    const size_t tstep = 2 * hstep;
    const unsigned ldsw = (unsigned)wid * 1024u;
    const int aoff = lds_byte(wr * 64 + fr, fq * 8), boff = lds_byte(wc * 32 + fr, fq * 8);
#define PG8_SA(b, h) (((b) * 2 + (h)) * HTB)
#define PG8_SB(b, h) ((4 + (b) * 2 + (h)) * HTB)
#define PG8_STAGE(bufoff, gbase, voff) do { _Pragma("unroll") for (int _i = 0; _i < 2; ++_i) \
        __builtin_amdgcn_global_load_lds((const unsigned*)((const char*)(gbase) + (voff)[_i]), (PG8_LAS unsigned*)(lds + (bufoff) + ldsw + _i * 8192), 16, 0, 0); } while (0)
#define PG8_LDA(dst, b, h) do { _Pragma("unroll") for (int m = 0; m < 4; ++m) _Pragma("unroll") for (int k = 0; k < 2; ++k) dst[m][k] = *(const PG8_LAS bf16x8*)(lds + PG8_SA(b, h) + aoff + m * 2048 + k * 1024); } while (0)
#define PG8_LDB(dst, b, h) do { _Pragma("unroll") for (int n = 0; n < 2; ++n) _Pragma("unroll") for (int k = 0; k < 2; ++k) dst[n][k] = *(const PG8_LAS bf16x8*)(lds + PG8_SB(b, h) + boff + n * 2048 + k * 1024); } while (0)
#define PG8_MMA(ai, bj, At, Bt) do { __builtin_amdgcn_s_setprio(1); _Pragma("unroll") for (int m = 0; m < 4; ++m) _Pragma("unroll") for (int n = 0; n < 2; ++n) _Pragma("unroll") for (int k = 0; k < 2; ++k) \
        acc[ai][bj][m][n] = __builtin_amdgcn_mfma_f32_16x16x32_bf16(Bt[n][k], At[m][k], acc[ai][bj][m][n], 0, 0, 0); __builtin_amdgcn_s_setprio(0); } while (0)
#define PG8_WAIT_V(n) asm volatile("s_waitcnt vmcnt(" #n ")" ::: "memory")
#define PG8_WAIT_L(n) asm volatile("s_waitcnt lgkmcnt(" #n ")" ::: "memory")
#define PG8_BAR __builtin_amdgcn_s_barrier()
#define PG8_SCHED __builtin_amdgcn_sched_barrier(0)
    Unit cur, nxt; int ui = 0;
    if (!S.next(0, cur)) return;
    f32x4 acc[2][2][4][2];
#pragma unroll
    for (int a = 0; a < 2; ++a)
#pragma unroll
        for (int b = 0; b < 2; ++b)
#pragma unroll
            for (int m = 0; m < 4; ++m)
#pragma unroll
                for (int n = 0; n < 2; ++n) acc[a][b][m][n] = (f32x4){0.f, 0.f, 0.f, 0.f};
    bf16x8 At[4][2], B0[2][2], B1[2][2];
    const char* cA = (const char*)g.A + (size_t)cur.pm * tstep; const char* cB = (const char*)g.Bt + (size_t)cur.pn * tstep;
    S.a_ready(cur);
    PG8_STAGE(PG8_SB(0, 0), cB, voffB); PG8_STAGE(PG8_SA(0, 0), cA, voffA); PG8_STAGE(PG8_SB(0, 1), cB + hstep, voffB); PG8_STAGE(PG8_SA(0, 1), cA + hstep, voffA);
    if (wr == 1) PG8_BAR;
    PG8_WAIT_V(4); PG8_BAR;
    PG8_STAGE(PG8_SB(1, 0), cB + kstep, voffB); PG8_STAGE(PG8_SA(1, 0), cA + kstep, voffA); PG8_STAGE(PG8_SB(1, 1), cB + hstep + kstep, voffB);
    PG8_WAIT_V(6); PG8_BAR;
    PG8_STAMP();
    for (;;) {
        const bool has_next = S.next(ui + 1, nxt);
        const char* nA = has_next ? (const char*)g.A + (size_t)nxt.pm * tstep : cA; const char* nB = has_next ? (const char*)g.Bt + (size_t)nxt.pn * tstep : cB;
        for (int t = 0; t < nt; t += 2) {
            const bool last = (t == nt - 2);
            const char* a1 = cA + (size_t)(t + 1) * kstep;
            const char* a2 = last ? nA : cA + (size_t)(t + 2) * kstep; const char* b2 = last ? nB : cB + (size_t)(t + 2) * kstep;
            const char* a3 = a2 + kstep; const char* b3 = b2 + kstep;
            if (last && has_next) S.a_ready(nxt);
            PG8_LDB(B0, 0, 0); PG8_SCHED; PG8_LDA(At, 0, 0); PG8_STAGE(PG8_SA(1, 1), a1 + hstep, voffA);
            PG8_WAIT_L(8); PG8_BAR; PG8_WAIT_L(0); PG8_MMA(0, 0, At, B0); PG8_BAR; PG8_SCHED;
            PG8_LDB(B1, 0, 1); PG8_STAGE(PG8_SB(0, 0), b2, voffB);
            PG8_BAR; PG8_WAIT_L(0); PG8_MMA(0, 1, At, B1); PG8_BAR;
            PG8_LDA(At, 0, 1); PG8_STAGE(PG8_SA(0, 0), a2, voffA);
            PG8_BAR; PG8_WAIT_L(0); PG8_MMA(1, 0, At, B0); PG8_BAR; PG8_SCHED;
            PG8_STAGE(PG8_SB(0, 1), b2 + hstep, voffB);
            PG8_WAIT_V(6); PG8_BAR; PG8_MMA(1, 1, At, B1); PG8_BAR;
            PG8_LDB(B0, 1, 0); PG8_SCHED; PG8_LDA(At, 1, 0); PG8_STAGE(PG8_SA(0, 1), a2 + hstep, voffA);
            PG8_WAIT_L(8); PG8_BAR; PG8_WAIT_L(0); PG8_MMA(0, 0, At, B0); PG8_BAR; PG8_SCHED;
            PG8_LDB(B1, 1, 1); PG8_STAGE(PG8_SB(1, 0), b3, voffB);
            PG8_BAR; PG8_WAIT_L(0); PG8_MMA(0, 1, At, B1); PG8_BAR;
            PG8_LDA(At, 1, 1); PG8_STAGE(PG8_SA(1, 0), a3, voffA);
            PG8_BAR; PG8_WAIT_L(0); PG8_MMA(1, 0, At, B0); PG8_BAR; PG8_SCHED;
            PG8_STAGE(PG8_SB(1, 1), b3 + hstep, voffB);
            PG8_WAIT_V(6); PG8_BAR; PG8_MMA(1, 1, At, B1); PG8_BAR;
        }
        PG8_STAMP();
        if constexpr (!Epi::AFTER_DRAIN) { E(acc, cur, wr, wc, fr, fq); S.done(cur); }
        PG8_STAMP();
        if (!has_next) break;
#pragma unroll
        for (int a = 0; a < 2; ++a)
#pragma unroll
            for (int b = 0; b < 2; ++b)
#pragma unroll
                for (int m = 0; m < 4; ++m)
#pragma unroll
                    for (int n = 0; n < 2; ++n) acc[a][b][m][n] = (f32x4){0.f, 0.f, 0.f, 0.f};
        cur = nxt; cA = nA; cB = nB; ++ui;
    }
    PG8_WAIT_V(0);
    if (wr == 0) PG8_BAR;
    PG8_BAR;
    if constexpr (Epi::AFTER_DRAIN) { E.fused(acc, cur, wr, wc, fr, fq, lds, wid, lane); S.done(cur); }
    PG8_STAMP();
    if (STAMP && wid == 0) { stamps[lane] = lane < nts ? (((unsigned long long)(unsigned)ts_hi << 32) | (unsigned)ts_lo) : 0ull;
        if (lane == 62) stamps[62] = rt_entry; if (lane == 63) stamps[63] = (unsigned long long)wall_clock64(); }
#undef PG8_STAMP
#undef PG8_SA
#undef PG8_SB
#undef PG8_STAGE
#undef PG8_LDA
#undef PG8_LDB
#undef PG8_MMA
#undef PG8_WAIT_V
#undef PG8_WAIT_L
#undef PG8_BAR
#undef PG8_SCHED
}
}
#define XB_TMO      128
#define XB_XCNT(j)  (256  + 64 * (j))
#define XB_XSUB(j)  (1280 + 64 * (j))
#define XB_XGEN(j)  (2304 + 64 * (j))
#define XB_TOP      3328
#define XB_TOPGEN   3392
#define XCD_BAR_WORDS 3456
#define XB_SPIN_CAP (1u << 23)
#define LAS __attribute__((address_space(3)))

__device__ __forceinline__ unsigned xb_ld(unsigned* p)              { return __hip_atomic_load(p, __ATOMIC_RELAXED, __HIP_MEMORY_SCOPE_AGENT); }
__device__ __forceinline__ unsigned xb_add(unsigned* p, unsigned v) { return __hip_atomic_fetch_add(p, v, __ATOMIC_RELAXED, __HIP_MEMORY_SCOPE_AGENT); }
__device__ __forceinline__ unsigned xb_xcc_id() { return (unsigned)__builtin_amdgcn_s_getreg((3 << 11) | 20) & 0xFu; }
#define XB_SPIN(cond, bar) do { unsigned _sp = 0; while (cond) { __builtin_amdgcn_s_sleep(1); \
    if ((++_sp & 255u) == 0u) { if (xb_ld(&(bar)[XB_TMO])) break; if (_sp > XB_SPIN_CAP) { atomicAdd(&(bar)[XB_TMO], 1u); break; } } } } while (0)

struct XcdBarrier {
    unsigned* bar; unsigned x;
    volatile LAS unsigned* st;
};

__device__ __forceinline__ XcdBarrier xcd_barrier_post(unsigned* bar, volatile LAS unsigned* st) {
    XcdBarrier b; b.bar = bar; b.x = xb_xcc_id(); b.st = st;
    if (threadIdx.x == 0) (void)xb_add(&bar[XB_XCNT(b.x)], 1u);
    return b;
}
__device__ __forceinline__ void xcd_barrier_complete(unsigned* bar, unsigned x, unsigned& nloc, unsigned& nx) {
    const unsigned G = gridDim.x * gridDim.y * gridDim.z;
    unsigned sum, cnt, mine, sp = 0u;
    for (;;) {
        sum = 0u; cnt = 0u; mine = 0u;
#pragma unroll
        for (unsigned j = 0; j < 16; ++j) { const unsigned c = xb_ld(&bar[XB_XCNT(j)]); sum += c; cnt += (c > 0u) ? 1u : 0u; mine = (j == x) ? c : mine; }
        if (sum == G) break;
        __builtin_amdgcn_s_sleep(1);
        if ((++sp & 255u) == 0u) { if (xb_ld(&bar[XB_TMO])) break; if (sp > XB_SPIN_CAP) { atomicAdd(&bar[XB_TMO], 1u); break; } }
    }
    nloc = mine > 0u ? mine : 1u; nx = cnt > 0u ? cnt : 1u;
}

__device__ __forceinline__ void xcd_barrier(const XcdBarrier& b, const int tid) {
    asm volatile("s_waitcnt vmcnt(0)" ::: "memory");
    __syncthreads();
    if (tid == 0) {
        unsigned* bar = b.bar; unsigned bx = b.x;
        asm volatile("" : "+s"(bar), "+s"(bx));
        __builtin_amdgcn_s_waitcnt(0);
        unsigned nloc = b.st[0], nx = b.st[1];
        if (nloc == 0u) { xcd_barrier_complete(bar, bx, nloc, nx); b.st[0] = nloc; b.st[1] = nx; }
        const unsigned old = xb_add(&bar[XB_XSUB(bx)], 1u);
        const unsigned gen = old / nloc;
        if (old + 1u == (gen + 1u) * nloc) {
            __builtin_amdgcn_fence(__ATOMIC_RELEASE, "agent");
            asm volatile("s_waitcnt vmcnt(0)" ::: "memory");
            const unsigned og = xb_add(&bar[XB_TOP], 1u);
            const unsigned tg = og / nx;
            if (og + 1u == (tg + 1u) * nx) xb_add(&bar[XB_TOPGEN], 1u);
            else XB_SPIN(xb_ld(&bar[XB_TOPGEN]) == tg, bar);
            __builtin_amdgcn_fence(__ATOMIC_ACQUIRE, "agent");
            xb_add(&bar[XB_XGEN(bx)], 1u);
            asm volatile("s_waitcnt vmcnt(0)" ::: "memory");
        } else {
            XB_SPIN(xb_ld(&bar[XB_XGEN(bx)]) == gen, bar);
            __builtin_amdgcn_fence(__ATOMIC_ACQUIRE, "agent");
            asm volatile("s_waitcnt vmcnt(0)" ::: "memory");
        }
    }
    __syncthreads();
}


typedef __attribute__((address_space(3))) unsigned char lds_u8;
extern __shared__ __attribute__((aligned(16))) unsigned char smem[];
DEV unsigned char* smem_base() { return smem; }

DEV bf16_t* wsb(const Args& a, size_t off) { return (bf16_t*)(a.ws + off); }
DEV float* wsf(const Args& a, size_t off) { return (float*)(a.ws + off); }

DEV void ph_rowprep(const Args& a, bool from_x, const int tid0) {
    const int lane = tid0 & 63, wv = tid0 >> 6;
    const int gw = blockIdx.x * 8 + wv, nw = gridDim.x * 8;
    bf16_t* hb = wsb(a, HB_OFF); float* ssq = wsf(a, SSQ_OFF);
    for (int t = gw; t < T; t += nw) {
        const float* src = from_x ? (t < TP ? a.x_prompt + (size_t)t * D : a.x_sample + (size_t)(t - TP) * D) : a.h + (size_t)t * D;
        f32x4 v[4]; float ss = 0.f;
#pragma unroll
        for (int i = 0; i < 4; ++i) { v[i] = *(const f32x4*)(src + (i * 64 + lane) * 4); ss += v[i][0] * v[i][0] + v[i][1] * v[i][1] + v[i][2] * v[i][2] + v[i][3] * v[i][3]; }
        ss = wave_sum(ss);
#pragma unroll
        for (int i = 0; i < 4; ++i) {
            if (from_x) *(f32x4*)(a.h + (size_t)t * D + (i * 64 + lane) * 4) = v[i];
            u32x2 p; p.x = pack2(v[i][0], v[i][1]); p.y = pack2(v[i][2], v[i][3]);
            *(u32x2*)(hb + (size_t)t * D + (i * 64 + lane) * 4) = p;
        }
        if (lane < 16) ssq[(size_t)t * 16 + lane] = (lane == 0) ? ss : 0.f;
    }
}

DEV void ph_final(const Args& a, const int tid0) {
    const int lane = tid0 & 63, wv = tid0 >> 6;
    const int gw = blockIdx.x * 8 + wv, nw = gridDim.x * 8;
    for (int t = gw; t < T; t += nw) {
        float* row = a.h + (size_t)t * D;
        f32x4 v[4]; float ss = 0.f;
#pragma unroll
        for (int i = 0; i < 4; ++i) { v[i] = *(const f32x4*)(row + (i * 64 + lane) * 4); ss += v[i][0] * v[i][0] + v[i][1] * v[i][1] + v[i][2] * v[i][2] + v[i][3] * v[i][3]; }
        ss = wave_sum(ss);
        const float r = rsqrtf(ss * (1.0f / 1024.0f) + 1e-6f);
#pragma unroll
        for (int i = 0; i < 4; ++i) { const f32x4 g = *(const f32x4*)(a.final_norm_g + (i * 64 + lane) * 4); *(f32x4*)(row + (i * 64 + lane) * 4) = v[i] * r * g; }
    }
}

DEV void transpose_cvt(const float* __restrict__ src, bf16_t* __restrict__ dst, int K, int N, int Npad, const float* __restrict__ g, float* tile, const int tid0) {
    const int tx = tid0 & 63, ty = tid0 >> 6;
    const int tk = K / 64, tn = Npad / 64;
    for (int tl = blockIdx.x; tl < tk * tn; tl += gridDim.x) {
        const int k0 = (tl % tk) * 64, n0 = (tl / tk) * 64;
        __syncthreads();
        for (int i = ty; i < 64; i += 8) { const int k = k0 + i, n = n0 + tx; float v = (n < N) ? src[(size_t)k * N + n] : 0.f; if (g) v *= g[k]; tile[i * 65 + tx] = v; }
        __syncthreads();
        for (int i = ty; i < 64; i += 8) dst[(size_t)(n0 + i) * K + k0 + tx] = (bf16_t)f2bf(tile[tx * 65 + i]);
    }
}
DEV void fold_wqk(const Args& a, float* lds, const int tid0) {
    float* swq = lds;
    float* ssk = lds + 64 * 132;
    const int tid = tid0, key = tid & 127, kq = tid >> 7;
    for (int un = blockIdx.x; un < NL * 16 * 16; un += gridDim.x) {
        const int l = un >> 8, hp = (un >> 4) & 15, k0 = (un & 15) * 64;
        __syncthreads();
        for (int i = tid; i < 64 * 128; i += NTHR) { const int r = i >> 7, c = i & 127; swq[r * 132 + c] = a.peer_w_q[((size_t)l * 1024 + k0 + r) * 2048 + hp * 128 + c]; }
        for (int i = tid; i < 128 * 128; i += NTHR) { const int r = i >> 7, c = i & 127; ssk[r * 132 + c] = a.peer_sub_keys[(((size_t)l * 16 + hp) * 128 + r) * 128 + c]; }
        __syncthreads();
        float acc[16];
#pragma unroll
        for (int i = 0; i < 16; ++i) acc[i] = 0.f;
        for (int c = 0; c < 128; c += 4) {
            const f32x4 s = *(const f32x4*)(ssk + key * 132 + c);
#pragma unroll
            for (int i = 0; i < 16; ++i) { const f32x4 w = *(const f32x4*)(swq + (kq * 16 + i) * 132 + c); acc[i] += s[0] * w[0] + s[1] * w[1] + s[2] * w[2] + s[3] * w[3]; }
        }
        bf16_t* dst = wsb(a, WB_OFF + (size_t)l * WB_LAYER + WB_QK) + (size_t)(hp * 128 + key) * 1024 + k0 + kq * 16;
        const float* g = a.norm_ffn_g + l * 1024 + k0 + kq * 16;
#pragma unroll
        for (int i = 0; i < 16; i += 2) *(unsigned*)(dst + i) = pack2(acc[i] * g[i], acc[i + 1] * g[i + 1]);
    }
}
DEV void ph_prologue(const Args& a, float* lds, const int tid0) {
    { float* rc = wsf(a, ROPEC_OFF); float* rs = wsf(a, ROPES_OFF);
      for (int i = blockIdx.x * NTHR + tid0; i < 4096 * 8; i += gridDim.x * NTHR) {
          const int pos = i >> 3, f = i & 7;
          const float invf = (float)pow(500000.0, -(double)f / 8.0);
          const float ang = (float)pos * invf;
          rc[i] = (float)cos((double)ang); rs[i] = (float)sin((double)ang);
      } }
    for (int l = 0; l < NL; ++l) {
        bf16_t* wb = wsb(a, WB_OFF + (size_t)l * WB_LAYER);
        transpose_cvt(a.w_in + (size_t)l * 1024 * INC, wb + WB_IN / 2, 1024, INC, INP, a.norm_mix_g + l * 1024, lds, tid0);
        transpose_cvt(a.w_out + (size_t)l * 1024 * 1024, wb + WB_OUT / 2, 1024, 1024, 1024, nullptr, lds, tid0);
        transpose_cvt(a.ple_w_gate + (size_t)l * 1024 * 1024, wb + WB_GATE / 2, 1024, 1024, 1024, a.ple_norm_g + l * 1024, lds, tid0);
        transpose_cvt(a.ple_w_proj + (size_t)l * 256 * 1024, wb + WB_PROJ / 2, 256, 1024, 1024, nullptr, lds, tid0);
        for (int dr = 0; dr < 2; ++dr) {
            transpose_cvt(a.rwkv_w2 + (size_t)(l * 2 + dr) * 64 * 512, wb + WB_LORA / 2 + dr * 512 * 64, 64, 512, 512, nullptr, lds, tid0);
            transpose_cvt(a.rwkv_a2 + (size_t)(l * 2 + dr) * 64 * 512, wb + WB_LORA / 2 + (2 + dr) * 512 * 64, 64, 512, 512, nullptr, lds, tid0);
        }
        transpose_cvt(a.rwkv_g2 + (size_t)l * 128 * 512, wb + WB_LORA / 2 + 4 * 512 * 64, 128, 512, 512, nullptr, lds, tid0);
    }
    fold_wqk(a, lds, tid0);
}

DEV float sum16(float v) {
    v = sum8(v);
    v += __int_as_float(__builtin_amdgcn_mov_dpp(__float_as_int(v), 0x140, 0xF, 0xF, true));
    return v;
}
DEV float max16(float v) {
    v = fmaxf(v, __int_as_float(__builtin_amdgcn_mov_dpp(__float_as_int(v), 0xB1, 0xF, 0xF, true)));
    v = fmaxf(v, __int_as_float(__builtin_amdgcn_mov_dpp(__float_as_int(v), 0x4E, 0xF, 0xF, true)));
    v = fmaxf(v, __int_as_float(__builtin_amdgcn_mov_dpp(__float_as_int(v), 0x141, 0xF, 0xF, true)));
    v = fmaxf(v, __int_as_float(__builtin_amdgcn_mov_dpp(__float_as_int(v), 0x140, 0xF, 0xF, true)));
    return v;
}
DEV float rl(float v, int l) { return __int_as_float(__builtin_amdgcn_readlane(__float_as_int(v), l)); }
DEV float wave_sum_dpp(float v) { v = sum16(v); return (rl(v, 0) + rl(v, 16)) + (rl(v, 32) + rl(v, 48)); }
DEV unsigned fkey(float f) { const unsigned b = __float_as_uint(f); return b ^ ((unsigned)((int)b >> 31) | 0x80000000u); }
DEV int mbcnt64(unsigned long long m) { return (int)__builtin_amdgcn_mbcnt_hi((unsigned)(m >> 32), __builtin_amdgcn_mbcnt_lo((unsigned)m, 0u)); }

#ifndef TOPK_NU
#define TOPK_NU 4
#endif
DEV void ph_topk2(const Args& a, float* lds, const int tid0, const int gw, const int nw, const int NP, int* TOPI, float* TOPG, const int tbase) {
    const int lane = tid0 & 63, wv = __builtin_amdgcn_readfirstlane(tid0 >> 6);
    constexpr int NU = TOPK_NU, NQ = 2 * NU, GPT = 8 / NU;
    float* tvb = lds + wv * (NQ * 16); int* tib = (int*)(lds + 8 * NQ * 16) + wv * (NQ * 16);
    const float* SC = wsf(a, SC_OFF); const float* ssq = wsf(a, SSQ_OFF);
    float vn[NU][4];
    if (gw < NP) {
#pragma unroll
        for (int u = 0; u < NU; ++u)
#pragma unroll
            for (int i = 0; i < 4; ++i) vn[u][i] = SC[(size_t)gw * (NU * 256) + u * 256 + i * 64 + lane];
    }
    for (int up = gw; up < NP; up += nw) {
        const int t = up / GPT, hd0 = (up % GPT) * NU;
        float v[NU][4]; unsigned k[NU][4];
#pragma unroll
        for (int u = 0; u < NU; ++u)
#pragma unroll
            for (int i = 0; i < 4; ++i) { v[u][i] = vn[u][i]; k[u][i] = fkey(v[u][i]); }
        if (up + nw < NP) {
#pragma unroll
            for (int u = 0; u < NU; ++u)
#pragma unroll
                for (int i = 0; i < 4; ++i) vn[u][i] = SC[(size_t)(up + nw) * (NU * 256) + u * 256 + i * 64 + lane];
        }
        unsigned th[NQ]; unsigned dm = 0u;
#pragma unroll
        for (int q = 0; q < NQ; ++q) th[q] = 0u;
        for (int b = 31; b >= 0; --b) {
            const unsigned bit = 1u << b;
            unsigned long long ma[NQ], mb[NQ];
#pragma unroll
            for (int q = 0; q < NQ; ++q) { const unsigned c = th[q] | bit; ma[q] = __ballot(k[q >> 1][2 * (q & 1)] >= c); mb[q] = __ballot(k[q >> 1][2 * (q & 1) + 1] >= c); }
#pragma unroll
            for (int q = 0; q < NQ; ++q) {
                const int n = __builtin_popcountll(ma[q]) + __builtin_popcountll(mb[q]);
                th[q] = (n >= 16) ? (th[q] | bit) : th[q]; dm |= (n == 16) ? (1u << q) : 0u;
            }
            if (dm == (1u << NQ) - 1u) break;
        }
#pragma unroll
        for (int q = 0; q < NQ; ++q) {
            const int u = q >> 1, p = q & 1; const unsigned tp = th[q];
            const unsigned ka = k[u][2 * p], kb = k[u][2 * p + 1];
            const unsigned long long ga = __ballot(ka > tp), gb = __ballot(kb > tp), ea = __ballot(ka == tp), eb = __ballot(kb == tp);
            const int nga = __builtin_popcountll(ga), ng = nga + __builtin_popcountll(gb), need = 16 - ng, nea = __builtin_popcountll(ea);
            const int rga = mbcnt64(ga), rgb = nga + mbcnt64(gb), rea = mbcnt64(ea), reb = nea + mbcnt64(eb);
            const int pa = (ka > tp) ? rga : ((ka == tp && rea < need) ? ng + rea : -1);
            const int pb = (kb > tp) ? rgb : ((kb == tp && reb < need) ? ng + reb : -1);
            if (pa >= 0) { tvb[q * 16 + pa] = v[u][2 * p]; tib[q * 16 + pa] = lane; }
            if (pb >= 0) { tvb[q * 16 + pb] = v[u][2 * p + 1]; tib[q * 16 + pb] = 64 + lane; }
        }
        float cv[NU][4]; unsigned kc[NU][4]; float mx[NU];
#pragma unroll
        for (int u = 0; u < NU; ++u) {
#pragma unroll
            for (int s = 0; s < 4; ++s) { const int c = lane + 64 * s; cv[u][s] = tvb[u * 32 + (c >> 4)] + tvb[u * 32 + 16 + (c & 15)]; kc[u][s] = fkey(cv[u][s]); }
            const float m0 = max16(lane < 16 ? tvb[u * 32 + (lane & 15)] : -3.0e38f), m1 = max16(lane < 16 ? tvb[u * 32 + 16 + (lane & 15)] : -3.0e38f);
            mx[u] = rl(m0, 0) + rl(m1, 0);
        }
        unsigned t2[NU]; unsigned dm2 = 0u;
#pragma unroll
        for (int u = 0; u < NU; ++u) t2[u] = 0u;
        for (int b = 31; b >= 0; --b) {
            const unsigned bit = 1u << b;
            unsigned long long mc[NU][4];
#pragma unroll
            for (int u = 0; u < NU; ++u)
#pragma unroll
                for (int s4 = 0; s4 < 4; ++s4) mc[u][s4] = __ballot(kc[u][s4] >= (t2[u] | bit));
#pragma unroll
            for (int u = 0; u < NU; ++u) {
                const int n = (__builtin_popcountll(mc[u][0]) + __builtin_popcountll(mc[u][1])) + (__builtin_popcountll(mc[u][2]) + __builtin_popcountll(mc[u][3]));
                t2[u] = (n >= 16) ? (t2[u] | bit) : t2[u]; dm2 |= (n == 16) ? (1u << u) : 0u;
            }
            if (dm2 == (1u << NU) - 1u) break;
        }
        const float rs = rstd_parts(ssq, t);
#pragma unroll
        for (int u = 0; u < NU; ++u) {
            int pos[4]; int ng = 0;
#pragma unroll
            for (int s = 0; s < 4; ++s) { const unsigned long long g = __ballot(kc[u][s] > t2[u]); pos[s] = (kc[u][s] > t2[u]) ? ng + mbcnt64(g) : -1; ng += __builtin_popcountll(g); }
            int ne = 0; const int need = 16 - ng;
#pragma unroll
            for (int s = 0; s < 4; ++s) { const unsigned long long e = __ballot(kc[u][s] == t2[u]); const int r = ne + mbcnt64(e); pos[s] = (kc[u][s] == t2[u] && r < need) ? ng + r : pos[s]; ne += __builtin_popcountll(e); }
            float ex[4]; float es = 0.f;
#pragma unroll
            for (int s = 0; s < 4; ++s) { ex[s] = (pos[s] >= 0) ? __expf(rs * (cv[u][s] - mx[u])) : 0.f; es += ex[s]; }
            const float inv = __builtin_amdgcn_rcpf(wave_sum_dpp(es));
#pragma unroll
            for (int s = 0; s < 4; ++s) if (pos[s] >= 0) {
                const int c = lane + 64 * s;
                TOPI[(t - tbase) * 128 + (hd0 + u) * 16 + pos[s]] = tib[u * 32 + (c >> 4)] * 128 + tib[u * 32 + 16 + (c & 15)];
                TOPG[(t - tbase) * 128 + (hd0 + u) * 16 + pos[s]] = ex[s] * inv;
            }
        }
    }
}

DEV unsigned pack4_fp8(float a, float b, float c, float d) {
    int w = __builtin_amdgcn_cvt_pk_fp8_f32(a, b, 0, false);
    w = __builtin_amdgcn_cvt_pk_fp8_f32(c, d, w, true);
    return (unsigned)w;
}
DEV void ph_convert8(const Args& a, int layer, const int tid0) {
    const size_t gtid = (size_t)blockIdx.x * NTHR + tid0, gn = (size_t)gridDim.x * NTHR;
    const float* us = a.peer_u + (size_t)layer * 16384 * 1024; const float* vs = a.peer_v + (size_t)layer * 16384 * 1024;
    unsigned* ud = (unsigned*)(a.ws + PTU_OFF); unsigned* vd = (unsigned*)(a.ws + PTV_OFF);
    const float* g = a.norm_ffn_g + layer * 1024;
    for (size_t i = gtid; i < (size_t)16384 * 1024 / 16; i += gn) {
        u32x4 pu, pv;
#pragma unroll
        for (int j = 0; j < 4; ++j) {
            const f32x4 x = *(const f32x4*)(us + i * 16 + j * 4), y = *(const f32x4*)(vs + i * 16 + j * 4), gg = *(const f32x4*)(g + ((i * 16 + j * 4) & 1023));
            pu[j] = pack4_fp8(x[0] * gg[0] * 256.f, x[1] * gg[1] * 256.f, x[2] * gg[2] * 256.f, x[3] * gg[3] * 256.f);
            pv[j] = pack4_fp8(y[0] * 32.f, y[1] * 32.f, y[2] * 32.f, y[3] * 32.f);
        }
        *(u32x4*)(ud + i * 4) = pu; *(u32x4*)(vd + i * 4) = pv;
    }
    bf16_t* pb = wsb(a, PB_OFF);
    const float* pp = a.p_prompt + (size_t)layer * TP * 256; const float* ps = a.p_sample + (size_t)layer * (T - TP) * 256;
    for (size_t i = gtid; i < (size_t)T * 256 / 4; i += gn) {
        const size_t e = i * 4; const f32x4 x = (e < (size_t)TP * 256) ? *(const f32x4*)(pp + e) : *(const f32x4*)(ps + (e - (size_t)TP * 256));
        u32x2 p; p.x = pack2(x[0], x[1]); p.y = pack2(x[2], x[3]); *(u32x2*)(pb + e) = p;
    }
}


typedef short bf16x8 __attribute__((ext_vector_type(8)));
typedef float f32x16 __attribute__((ext_vector_type(16)));
#define MFMA32(a, b, c) __builtin_amdgcn_mfma_f32_32x32x16_bf16((a), (b), (c), 0, 0, 0)
DEV bf16x8 pack_frag(float x0, float x1, float x2, float x3, float x4, float x5, float x6, float x7) {
    u32x4 p;
    asm volatile("v_cvt_pk_bf16_f32 %0, %4, %5\n\tv_cvt_pk_bf16_f32 %1, %6, %7\n\tv_cvt_pk_bf16_f32 %2, %8, %9\n\tv_cvt_pk_bf16_f32 %3, %10, %11\n\ts_nop 1"
                 : "=&v"(p[0]), "=&v"(p[1]), "=&v"(p[2]), "=&v"(p[3]) : "v"(x0), "v"(x1), "v"(x2), "v"(x3), "v"(x4), "v"(x5), "v"(x6), "v"(x7));
    return __builtin_bit_cast(bf16x8, p);
}
DEV void ph_attn3(const Args& a, int layer, unsigned char* ldsb, const int tid0) {
    const int lane = tid0 & 63, wv = __builtin_amdgcn_readfirstlane(tid0 >> 6), r = lane & 31, h = lane >> 5;
    unsigned char* OL = ldsb;
    float* MLl = (float*)(ldsb + 73728);
    unsigned char* vt = ldsb + 77824 + wv * 4608;
    const bf16_t* qkv = wsb(a, QKV_OFF);
    bf16_t* mix = wsb(a, MIX_OFF);
    const int i16 = lane & 15, tq = i16 >> 2, tp = i16 & 3, tblk = (lane >> 4) & 1;
    const unsigned tr_addr = (unsigned)(size_t)vt + (4 * h + tq) * 144 + 2 * (16 * tblk + 4 * tp);
    const float sc = 0.125f * 1.44269504f, NEG = -1.0e30f;
    for (int un = blockIdx.x; un < NSEQ * 8 * 8; un += gridDim.x) {
      const int sh = un >> 3, sp = un & 7, seq = sh >> 3, hd = sh & 7; const size_t tb = (size_t)seq * 4096;
      __syncthreads();
#pragma unroll 1
      for (int di = 0; di < 3; ++di) {
#pragma unroll 1
       for (int k2 = 0; k2 < 2; ++k2) {
        const int idx16 = wv * 2 + k2;
        const int sft = 2 * di, nlen = 4096 >> sft;
        const int rr = (di == 0) ? 0 : (di == 1 ? (idx16 >> 2) : idx16), cb = (di == 0) ? (16 * sp + idx16) : (di == 1 ? (4 * sp + (idx16 & 3)) : sp), cq0 = cb * 32;
        const size_t tokq = tb + ((size_t)(cq0 + r) << sft) + rr;
        const bf16_t* qp = qkv + tokq * 1536 + hd * 64 + 8 * h;
        bf16x8 qf[4];
#pragma unroll
        for (int s = 0; s < 4; ++s) qf[s] = *(const bf16x8*)(qp + 16 * s);
        float m = NEG, l = 0.f;
        f32x16 O0, O1;
#pragma unroll
        for (int i = 0; i < 16; ++i) { O0[i] = 0.f; O1[i] = 0.f; }
        bf16x8 kfb[2][4], vfb[2][4];
#define ATT_LOAD(kt_) do { const int kb_ = cq0 - 64 + 32 * (kt_); const size_t tokk_ = tb + ((size_t)(kb_ + r) << sft) + rr; const bf16_t* kp_ = qkv + tokk_ * 1536 + 512 + hd * 64 + 8 * h; \
            _Pragma("unroll") for (int s_ = 0; s_ < 4; ++s_) { kfb[(kt_) & 1][s_] = *(const bf16x8*)(kp_ + 16 * s_); vfb[(kt_) & 1][s_] = *(const bf16x8*)(kp_ + 512 + 16 * s_); } } while (0)
        if (cq0 - 64 >= 0) ATT_LOAD(0);
#pragma unroll
        for (int kt = 0; kt < 5; ++kt) {
            const int kb = cq0 - 64 + 32 * kt;
            if (kt + 1 < 5) { const int kbn = kb + 32; if (kbn >= 0 && kbn < nlen) ATT_LOAD(kt + 1); }
            asm volatile("" ::: "memory");
            if (kb < 0 || kb >= nlen) continue;
            bf16x8 kf[4], vf[4];
#pragma unroll
            for (int s = 0; s < 4; ++s) { kf[s] = kfb[kt & 1][s]; vf[s] = vfb[kt & 1][s]; }
            f32x16 S;
#pragma unroll
            for (int i = 0; i < 16; ++i) S[i] = 0.f;
#pragma unroll
            for (int s = 0; s < 4; ++s) S = MFMA32(kf[s], qf[s], S);
            float lm = NEG;
#pragma unroll
            for (int i = 0; i < 16; ++i) {
                const int row = (i & 3) + 8 * (i >> 2) + 4 * h;
                float v = S[i] * sc;
                if (kt == 0) v = (row >= r) ? v : NEG;
                if (kt == 4) v = (row <= r) ? v : NEG;
                S[i] = v; lm = fmaxf(lm, v);
            }
            lm = fmaxf(lm, SHX(lm, 32));
            const float mn = fmaxf(m, lm), alpha = __builtin_amdgcn_exp2f(m - mn);
            m = mn; l *= alpha;
            float ps = 0.f;
#pragma unroll
            for (int i = 0; i < 16; ++i) { O0[i] *= alpha; O1[i] *= alpha; S[i] = __builtin_amdgcn_exp2f(S[i] - mn); ps += S[i]; }
            l += ps;
            const bf16x8 pb0 = pack_frag(S[0], S[1], S[2], S[3], S[4], S[5], S[6], S[7]);
            const bf16x8 pb1 = pack_frag(S[8], S[9], S[10], S[11], S[12], S[13], S[14], S[15]);
            asm volatile("" ::: "memory");
#pragma unroll
            for (int i = 0; i < 4; ++i) *(bf16x8*)(vt + r * 144 + 2 * (16 * i + 8 * h)) = vf[i];
            typedef short s16x4 __attribute__((ext_vector_type(4)));
            s16x4 t00l, t00h, t01l, t01h, t10l, t10h, t11l, t11h;
            asm volatile("s_waitcnt lgkmcnt(0)\n\t"
                         "ds_read_b64_tr_b16 %0, %8\n\tds_read_b64_tr_b16 %1, %8 offset:1152\n\t"
                         "ds_read_b64_tr_b16 %2, %8 offset:2304\n\tds_read_b64_tr_b16 %3, %8 offset:3456\n\t"
                         "ds_read_b64_tr_b16 %4, %8 offset:64\n\tds_read_b64_tr_b16 %5, %8 offset:1216\n\t"
                         "ds_read_b64_tr_b16 %6, %8 offset:2368\n\tds_read_b64_tr_b16 %7, %8 offset:3520\n\t"
                         "s_waitcnt lgkmcnt(0)"
                         : "=&v"(t00l), "=&v"(t00h), "=&v"(t01l), "=&v"(t01h), "=&v"(t10l), "=&v"(t10h), "=&v"(t11l), "=&v"(t11h) : "v"(tr_addr) : "memory");
            const bf16x8 a00 = __builtin_shufflevector(t00l, t00h, 0, 1, 2, 3, 4, 5, 6, 7), a01 = __builtin_shufflevector(t01l, t01h, 0, 1, 2, 3, 4, 5, 6, 7);
            const bf16x8 a10 = __builtin_shufflevector(t10l, t10h, 0, 1, 2, 3, 4, 5, 6, 7), a11 = __builtin_shufflevector(t11l, t11h, 0, 1, 2, 3, 4, 5, 6, 7);
            O0 = MFMA32(a00, pb0, O0); O1 = MFMA32(a10, pb0, O1);
            O0 = MFMA32(a01, pb1, O0); O1 = MFMA32(a11, pb1, O1);
            asm volatile("" ::: "memory");
        }
#undef ATT_LOAD
        l += SHX(l, 32);
        const int ql = (((cq0 + r) << sft) + rr) - 512 * sp;
        unsigned char* orow = OL + ql * 144 + 8 * h;
        float ao = 0.f, ap = 1.0f;
        if (di > 0) {
            const f32x2 mo = *(const f32x2*)(MLl + 2 * ql);
            const float mn = fmaxf(mo[0], m);
            ao = __builtin_amdgcn_exp2f(mo[0] - mn); ap = __builtin_amdgcn_exp2f(m - mn);
            l = ao * mo[1] + ap * l; m = mn;
        }
#pragma unroll
        for (int g = 0; g < 4; ++g) {
            f32x4 v0 = {O0[4 * g] * ap, O0[4 * g + 1] * ap, O0[4 * g + 2] * ap, O0[4 * g + 3] * ap}, v1 = {O1[4 * g] * ap, O1[4 * g + 1] * ap, O1[4 * g + 2] * ap, O1[4 * g + 3] * ap};
            if (di > 0) {
                const u32x2 o0 = *(const u32x2*)(orow + 16 * g), o1 = *(const u32x2*)(orow + 64 + 16 * g);
                v0[0] += ao * bflo(o0.x); v0[1] += ao * bfhi(o0.x); v0[2] += ao * bflo(o0.y); v0[3] += ao * bfhi(o0.y);
                v1[0] += ao * bflo(o1.x); v1[1] += ao * bfhi(o1.x); v1[2] += ao * bflo(o1.y); v1[3] += ao * bfhi(o1.y);
            }
            u32x2 p0, p1; p0.x = pack2(v0[0], v0[1]); p0.y = pack2(v0[2], v0[3]); p1.x = pack2(v1[0], v1[1]); p1.y = pack2(v1[2], v1[3]);
            *(u32x2*)(orow + 16 * g) = p0; *(u32x2*)(orow + 64 + 16 * g) = p1;
        }
        if (h == 0) { f32x2 ml; ml[0] = m; ml[1] = l; *(f32x2*)(MLl + 2 * ql) = ml; }
       }
       __syncthreads();
      }
      {
        const int ql = tid0;
        const float inv = __builtin_amdgcn_rcpf(MLl[2 * ql + 1]);
        float o[64]; float ss = 0.f;
#pragma unroll
        for (int c = 0; c < 8; ++c) {
            const u32x4 w4 = *(const u32x4*)(OL + ql * 144 + 16 * c);
#pragma unroll
            for (int i = 0; i < 4; ++i) { o[8 * c + 2 * i] = bflo(w4[i]) * inv; o[8 * c + 2 * i + 1] = bfhi(w4[i]) * inv; ss += o[8 * c + 2 * i] * o[8 * c + 2 * i] + o[8 * c + 2 * i + 1] * o[8 * c + 2 * i + 1]; }
        }
        const float rn = rsqrtf(ss * (1.0f / 64.0f) + 1e-6f);
        const float* gp = a.att_norm_g + layer * 512 + hd * 64;
        bf16_t* dst = mix + (tb + 512 * sp + ql) * 1024 + hd * 64;
#pragma unroll
        for (int c = 0; c < 8; ++c) {
            const f32x4 g0 = *(const f32x4*)(gp + 8 * c), g1 = *(const f32x4*)(gp + 8 * c + 4);
            u32x4 w4; w4.x = pack2(o[8 * c] * rn * g0[0], o[8 * c + 1] * rn * g0[1]); w4.y = pack2(o[8 * c + 2] * rn * g0[2], o[8 * c + 3] * rn * g0[3]);
            w4.z = pack2(o[8 * c + 4] * rn * g1[0], o[8 * c + 5] * rn * g1[1]); w4.w = pack2(o[8 * c + 6] * rn * g1[2], o[8 * c + 7] * rn * g1[3]);
            *(u32x4*)(dst + 8 * c) = w4;
        }
      }
    }
}

DEV float tanh_fast(float x) { return 1.0f - 2.0f * __builtin_amdgcn_rcpf(1.0f + __expf(2.0f * x)); }

DEV void ph_rwkv_prep1(const Args& a, int layer, unsigned char* ldsb, const int tid0) {
    const int lane = tid0 & 63, wv = __builtin_amdgcn_readfirstlane(tid0 >> 6), r = lane & 31, h = lane >> 5;
    const int gw = blockIdx.x * 8 + wv, nw = gridDim.x * 8;
    const int sub = wv & 1, ng = wv >> 1;
    const bf16_t* U = wsb(a, U_OFF);
    const float* sw = a.rwkv_shift + (size_t)layer * 3 * UC;
    const bf16_t* wl = wsb(a, WB_OFF + (size_t)layer * WB_LAYER + WB_LORA);
#pragma unroll 1
    for (int arr = 0; arr < 5; ++arr) {
        const int coff = (arr < 4) ? arr * 64 : 256, nk = (arr < 4) ? 4 : 8, kw = nk * 16, rsb = kw * 2 + 16;
        __syncthreads();
        {
            const bf16_t* wsrc = wl + (arr < 4 ? arr * 512 * 64 : 4 * 512 * 64);
            const int cpr = kw / 8;
            for (int i = tid0; i < 512 * cpr; i += NTHR) { const int row = i / cpr, c = i - row * cpr; *(u32x4*)(ldsb + row * rsb + c * 16) = *(const u32x4*)(wsrc + (size_t)row * kw + c * 8); }
        }
        __syncthreads();
        bf16_t* outb = wsb(a, arr == 0 ? WF_OFF : arr == 1 ? WB2_OFF : arr == 2 ? AF_OFF : arr == 3 ? AB_OFF : G_OFF);
        const float* bias = (arr < 2) ? a.rwkv_w0 + (layer * 2 + arr) * 512 : a.rwkv_a0 + (layer * 2 + (arr & 1)) * 512;
        f32x4 bvr[4][4];
#pragma unroll
        for (int q = 0; q < 4; ++q)
#pragma unroll
            for (int g = 0; g < 4; ++g) bvr[q][g] = *(const f32x4*)(bias + (ng * 4 + q) * 32 + 8 * g + 4 * h);
#pragma unroll 1
        for (int tile = blockIdx.x; tile < T / 64; tile += gridDim.x) {
            const int t = tile * 64 + sub * 32 + r, pos = t & 4095;
            const bool hp = pos > 0, hn = pos < 4095;
            const bf16_t* up = U + (size_t)t * UW + 1536 + 8 * h;
            bf16x8 xf[8];
#pragma unroll
            for (int s = 0; s < 8; ++s) {
                if (s < nk) {
                    const int col = coff + 16 * s;
                    const u32x4 c = *(const u32x4*)(up + col);
                    u32x4 p = {0u, 0u, 0u, 0u}, n = {0u, 0u, 0u, 0u};
                    if (hp) p = *(const u32x4*)(up - UW + col);
                    if (hn) n = *(const u32x4*)(up + UW + col);
                    const float* s0 = sw + 1536 + 8 * h + col;
                    const f32x4 wp0 = *(const f32x4*)(s0), wp1 = *(const f32x4*)(s0 + 4), wc0 = *(const f32x4*)(s0 + UC), wc1 = *(const f32x4*)(s0 + UC + 4), wn0 = *(const f32x4*)(s0 + 2 * UC), wn1 = *(const f32x4*)(s0 + 2 * UC + 4);
                    float v[8];
#pragma unroll
                    for (int i = 0; i < 4; ++i) {
                        const float a0 = (i < 2) ? wp0[2 * i] : wp1[2 * i - 4], a1 = (i < 2) ? wp0[2 * i + 1] : wp1[2 * i - 3];
                        const float b0 = (i < 2) ? wc0[2 * i] : wc1[2 * i - 4], b1 = (i < 2) ? wc0[2 * i + 1] : wc1[2 * i - 3];
                        const float c0 = (i < 2) ? wn0[2 * i] : wn1[2 * i - 4], c1 = (i < 2) ? wn0[2 * i + 1] : wn1[2 * i - 3];
                        v[2 * i] = a0 * bflo(p[i]) + b0 * bflo(c[i]) + c0 * bflo(n[i]);
                        v[2 * i + 1] = a1 * bfhi(p[i]) + b1 * bfhi(c[i]) + c1 * bfhi(n[i]);
                    }
                    if (arr < 2) {
#pragma unroll
                        for (int i = 0; i < 8; ++i) v[i] = tanh_fast(v[i]);
                    } else if (arr == 4) {
#pragma unroll
                        for (int i = 0; i < 8; ++i) v[i] = sigmoidf_(v[i]);
                    }
                    xf[s] = pack_frag(v[0], v[1], v[2], v[3], v[4], v[5], v[6], v[7]);
                }
            }
            bf16_t* out = outb + (size_t)t * 512 + 4 * h;
#pragma unroll
            for (int q = 0; q < 4; ++q) {
                const int nt = ng * 4 + q;
                f32x16 C;
#pragma unroll
                for (int i = 0; i < 16; ++i) C[i] = 0.f;
                const unsigned char* wr = ldsb + (nt * 32 + r) * rsb + 16 * h;
#pragma unroll
                for (int s = 0; s < 8; ++s) if (s < nk) { const bf16x8 A = *(const bf16x8*)(wr + 32 * s); C = MFMA32(A, xf[s], C); }
#pragma unroll
                for (int g = 0; g < 4; ++g) {
                    float o[4];
                    if (arr < 4) {
                        const f32x4 bv = bvr[q][g];
#pragma unroll
                        for (int j = 0; j < 4; ++j) { const float sg = sigmoidf_(C[4 * g + j] + bv[j]); o[j] = (arr < 2) ? __expf(-0.60653066f * sg) : sg; }
                    } else {
#pragma unroll
                        for (int j = 0; j < 4; ++j) o[j] = C[4 * g + j];
                    }
                    u32x2 pk; pk.x = pack2(o[0], o[1]); pk.y = pack2(o[2], o[3]);
                    *(u32x2*)(out + nt * 32 + 8 * g) = pk;
                }
            }
        }
    }
    {
        const int c16 = 16 * lane;
        bf16_t* dst = wsb(a, lane < 32 ? RS_OFF : KS_OFF) + (c16 & 511);
        float swp[16], swc[16], swn[16];
#pragma unroll
        for (int i = 0; i < 16; ++i) { swp[i] = sw[c16 + i]; swc[i] = sw[UC + c16 + i]; swn[i] = sw[2 * UC + c16 + i]; }
        for (int t0 = gw; t0 < T; t0 += 2 * nw) {
            u32x4 c[2][2], p[2][2], n[2][2];
#pragma unroll
            for (int k = 0; k < 2; ++k) {
                const int t = t0 + k * nw; const int pos = t & 4095; const bool hp = pos > 0, hn = pos < 4095;
                const bf16_t* up = U + (size_t)t * UW + c16;
#pragma unroll
                for (int q = 0; q < 2; ++q) {
                    c[k][q] = *(const u32x4*)(up + 8 * q); p[k][q] = (u32x4){0u, 0u, 0u, 0u}; n[k][q] = (u32x4){0u, 0u, 0u, 0u};
                    if (hp) p[k][q] = *(const u32x4*)(up - UW + 8 * q);
                    if (hn) n[k][q] = *(const u32x4*)(up + UW + 8 * q);
                }
            }
#pragma unroll
            for (int k = 0; k < 2; ++k) {
                const int t = t0 + k * nw;
                u32x4 o[2];
#pragma unroll
                for (int q = 0; q < 2; ++q)
#pragma unroll
                    for (int i = 0; i < 4; ++i) {
                        const int e = 8 * q + 2 * i;
                        const float lo = swp[e] * bflo(p[k][q][i]) + swc[e] * bflo(c[k][q][i]) + swn[e] * bflo(n[k][q][i]);
                        const float hi = swp[e + 1] * bfhi(p[k][q][i]) + swc[e + 1] * bfhi(c[k][q][i]) + swn[e + 1] * bfhi(n[k][q][i]);
                        o[q][i] = pack2(lo, hi);
                    }
                *(u32x4*)(dst + (size_t)t * 512) = o[0]; *(u32x4*)(dst + (size_t)t * 512 + 8) = o[1];
            }
        }
    }
}
DEV void ph_rwkv_prep2(const Args& a, int layer, const int tid0) {
    const int lane = tid0 & 63, wv = tid0 >> 6;
    const int gw = blockIdx.x * 8 + wv, nw = gridDim.x * 8;
    bf16_t* U = wsb(a, U_OFF); const bf16_t* KS = wsb(a, KS_OFF);
    const float* sw = a.rwkv_shift + (size_t)layer * 3 * UC;
    const int c8 = 8 * lane;
    float kkc[8], sv[3][8];
#pragma unroll
    for (int i = 0; i < 8; ++i) { kkc[i] = a.rwkv_k_k[layer * 512 + c8 + i]; sv[0][i] = sw[1024 + c8 + i]; sv[1][i] = sw[UC + 1024 + c8 + i]; sv[2][i] = sw[2 * UC + 1024 + c8 + i]; }
    for (int t = gw; t < T; t += nw) {
        const int pos = t & 4095; const bool hp = pos > 0, hn = pos < 4095;
        bf16_t* up = U + (size_t)t * UW;
        const u32x4 ks = *(const u32x4*)(KS + (size_t)t * 512 + c8);
        const u32x4 c = *(const u32x4*)(up + 1024 + c8);
        u32x4 p = {0u, 0u, 0u, 0u}, n = {0u, 0u, 0u, 0u};
        if (hp) p = *(const u32x4*)(up - UW + 1024 + c8);
        if (hn) n = *(const u32x4*)(up + UW + 1024 + c8);
        float kx[8]; float ss = 0.f;
#pragma unroll
        for (int i = 0; i < 4; ++i) { kx[2 * i] = bflo(ks[i]) * kkc[2 * i]; kx[2 * i + 1] = bfhi(ks[i]) * kkc[2 * i + 1]; ss += kx[2 * i] * kx[2 * i] + kx[2 * i + 1] * kx[2 * i + 1]; }
        const float inv = 1.0f / fmaxf(sqrtf(sum8(ss)), 1e-12f);
        u32x4 ko, vo;
#pragma unroll
        for (int i = 0; i < 4; ++i) {
            ko[i] = pack2(kx[2 * i] * inv, kx[2 * i + 1] * inv);
            vo[i] = pack2(sv[0][2 * i] * bflo(p[i]) + sv[1][2 * i] * bflo(c[i]) + sv[2][2 * i] * bflo(n[i]), sv[0][2 * i + 1] * bfhi(p[i]) + sv[1][2 * i + 1] * bfhi(c[i]) + sv[2][2 * i + 1] * bfhi(n[i]));
        }
        *(u32x4*)(up + c8) = ko; *(u32x4*)(up + 1536 + c8) = vo;
    }
}

DEV void ph_post2(const Args& a, int layer, const int tid0) {
    const int lane = tid0 & 63, wv = tid0 >> 6;
    const int gw = blockIdx.x * 8 + wv, nw = gridDim.x * 8;
    const bf16_t* U = wsb(a, U_OFF); const bf16_t* RS = wsb(a, RS_OFF); const bf16_t* KS = wsb(a, KS_OFF); const bf16_t* G = wsb(a, G_OFF);
    const bf16_t* AF = wsb(a, AF_OFF); const bf16_t* AB = wsb(a, AB_OFF); bf16_t* mix = wsb(a, MIX_OFF);
    const int c8 = 8 * lane;
    float kac[8], rkc[8], lnw[8], lnb[8];
#pragma unroll
    for (int i = 0; i < 8; ++i) { kac[i] = a.rwkv_k_a[layer * 512 + c8 + i]; rkc[i] = a.rwkv_r_k[layer * 512 + c8 + i]; lnw[i] = a.rwkv_ln_w[layer * 512 + c8 + i]; lnb[i] = a.rwkv_ln_b[layer * 512 + c8 + i]; }
    struct PostLd { u32x4 rp, kp, gp, afp, abp, yfp, ybp, vp; };
    for (int t0 = gw; t0 < T; t0 += 2 * nw) {
        PostLd L[2];
#pragma unroll
        for (int k = 0; k < 2; ++k) {
            const int t = t0 + k * nw; const bf16_t* up = U + (size_t)t * UW;
            L[k].rp = *(const u32x4*)(RS + (size_t)t * 512 + c8); L[k].kp = *(const u32x4*)(KS + (size_t)t * 512 + c8); L[k].gp = *(const u32x4*)(G + (size_t)t * 512 + c8);
            L[k].afp = *(const u32x4*)(AF + (size_t)t * 512 + c8); L[k].abp = *(const u32x4*)(AB + (size_t)t * 512 + c8);
            L[k].yfp = *(const u32x4*)(up + 512 + c8); L[k].ybp = *(const u32x4*)(up + 1024 + c8); L[k].vp = *(const u32x4*)(up + 1536 + c8);
        }
#pragma unroll
        for (int k = 0; k < 2; ++k) {
        const int t = t0 + k * nw;
        const u32x4 rp = L[k].rp, kp = L[k].kp, gp = L[k].gp, afp = L[k].afp, abp = L[k].abp, yfp = L[k].yfp, ybp = L[k].ybp, vp = L[k].vp;
        float y[8], rr[8], kk[8], vv[8], gg[8], sa[8];
#pragma unroll
        for (int i = 0; i < 4; ++i) {
            y[2 * i] = bflo(yfp[i]) + bflo(ybp[i]); y[2 * i + 1] = bfhi(yfp[i]) + bfhi(ybp[i]);
            rr[2 * i] = bflo(rp[i]); rr[2 * i + 1] = bfhi(rp[i]); kk[2 * i] = bflo(kp[i]); kk[2 * i + 1] = bfhi(kp[i]);
            vv[2 * i] = bflo(vp[i]); vv[2 * i + 1] = bfhi(vp[i]); gg[2 * i] = bflo(gp[i]); gg[2 * i + 1] = bfhi(gp[i]);
            sa[2 * i] = bflo(afp[i]) + bflo(abp[i]); sa[2 * i + 1] = bfhi(afp[i]) + bfhi(abp[i]);
        }
        float ysum = 0.f, bs = 0.f;
#pragma unroll
        for (int i = 0; i < 8; ++i) { ysum += y[i]; bs += rr[i] * kk[i] * (2.0f + (sa[i] - 2.0f) * kac[i]) * rkc[i]; }
        const float mu = sum8(ysum) * (1.0f / 64.0f);
        float vs = 0.f;
#pragma unroll
        for (int i = 0; i < 8; ++i) { y[i] -= mu; vs += y[i] * y[i]; }
        const float rstdv = rsqrtf(sum8(vs) * (1.0f / 64.0f) + 64e-5f);
        bs = sum8(bs);
        float o[8];
#pragma unroll
        for (int i = 0; i < 8; ++i) o[i] = (y[i] * rstdv * lnw[i] + lnb[i] + bs * vv[i]) * gg[i];
        u32x4 ov; ov.x = pack2(o[0], o[1]); ov.y = pack2(o[2], o[3]); ov.z = pack2(o[4], o[5]); ov.w = pack2(o[6], o[7]);
        *(u32x4*)(mix + (size_t)t * 1024 + 512 + c8) = ov;
        }
    }
}

#ifdef PROBE_EMASK
#define PEER_EM(e) (DRY ? ((e) & PROBE_EMASK) : (e))
#else
#define PEER_EM(e) (e)
#endif
template <bool DRY> DEV void ph_peer_pipe(const Args& a, const int tid0, const int gw, const int nw, const int ntok, const int* TOPI, const float* TOPG, const int tbase) {
    const int lane = tid0 & 63;
    bf16_t* hb = wsb(a, HB_OFF); float* rstd = wsf(a, RSTD_OFF); const float* ssq = wsf(a, SSQ_OFF);
    const unsigned char* PU = a.ws + PTU_OFF; const unsigned char* PV = a.ws + PTV_OFF;
    const int c16 = 16 * lane;
    const bool b5 = lane & 32, b4 = lane & 16, b3 = lane & 8;
    const bool dost = DRY ? (__builtin_amdgcn_readfirstlane(*(const int*)(a.ws + TOPI_OFF)) == -12345) : true;
    u32x4 ur[2][8], vr[8];
    int e0, e1, e0n = 0, e1n = 0; float g0, g1, g0n = 0.f, g1n = 0.f;
    u32x4 xa, xb, xan = {0u, 0u, 0u, 0u}, xbn = {0u, 0u, 0u, 0u}; float rsv, rsn = 0.f;
#define PEER_ISSUE_U(slot_, b_, es0_, es1_) do { _Pragma("unroll") for (int i_ = 0; i_ < 8; ++i_) { const int k_ = (b_) * 8 + i_; \
        const int e_ = PEER_EM(__builtin_amdgcn_readlane((k_ < 64) ? (es0_) : (es1_), k_ & 63)); ur[slot_][i_] = *(const u32x4*)(PU + (size_t)e_ * 1024 + c16); } } while (0)
#define PEER_ISSUE_V(slot_, b_, es0_, es1_) do { _Pragma("unroll") for (int i_ = 0; i_ < 8; ++i_) { const int k_ = (b_) * 8 + i_; \
        const int e_ = PEER_EM(__builtin_amdgcn_readlane((k_ < 64) ? (es0_) : (es1_), k_ & 63)); vr[i_] = *(const u32x4*)(PV + (size_t)e_ * 1024 + c16); } } while (0)
    if (ntok <= 0) return;
    {   const int t0 = gw;
        e0 = TOPI[(t0 - tbase) * 128 + lane]; e1 = TOPI[(t0 - tbase) * 128 + 64 + lane]; g0 = TOPG[(t0 - tbase) * 128 + lane]; g1 = TOPG[(t0 - tbase) * 128 + 64 + lane];
        xa = *(const u32x4*)(hb + (size_t)t0 * 1024 + c16); xb = *(const u32x4*)(hb + (size_t)t0 * 1024 + c16 + 8); rsv = rstd_parts(ssq, t0); }
    PEER_ISSUE_U(0, 0, e0, e1);
#pragma unroll 1
    for (int j = 0; j < ntok; ++j) {
        const int t = gw + nw * j; const bool more = (j + 1 < ntok);
        float* hr = a.h + (size_t)t * 1024 + c16;
        if (more) { const int tn = t + nw;
            e0n = TOPI[(tn - tbase) * 128 + lane]; e1n = TOPI[(tn - tbase) * 128 + 64 + lane]; }
        const float rs = rsv * (1.0f / 256.0f);
        float out[16];
#pragma unroll
        for (int i = 0; i < 16; ++i) out[i] = 0.f;
#pragma unroll 1
        for (int b2 = 0; b2 < 16; b2 += 2)
#pragma unroll
        for (int bb = 0; bb < 2; ++bb) {
            const int b = b2 + bb;
            PEER_ISSUE_V(0, b, e0, e1);
            if (bb == 0) PEER_ISSUE_U(1, b + 1, e0, e1);
            else if (b < 15) PEER_ISSUE_U(0, b + 1, e0, e1);
            else if (more) PEER_ISSUE_U(0, 0, e0n, e1n);
            asm volatile("" ::: "memory");
            float d[8];
#pragma unroll
            for (int i = 0; i < 8; ++i) {
                float sm = 0.f;
#pragma unroll
                for (int q = 0; q < 4; ++q) {
                    const unsigned uw = ur[bb][i][q];
                    const f32x2 lo = __builtin_amdgcn_cvt_pk_f32_fp8((int)uw, false), hi = __builtin_amdgcn_cvt_pk_f32_fp8((int)uw, true);
                    const unsigned ulo = pack2(lo[0], lo[1]), uhi = pack2(hi[0], hi[1]);
                    const unsigned xlo = (q < 2) ? xa[2 * q] : xb[2 * q - 4], xhi = (q < 2) ? xa[2 * q + 1] : xb[2 * q - 3];
                    sm = dot2bf(ulo, xlo, sm); sm = dot2bf(uhi, xhi, sm);
                }
                d[i] = sm;
            }
            float r4[4], r2[2];
#pragma unroll
            for (int i = 0; i < 4; ++i) { const float send = b5 ? d[i] : d[4 + i], keep = b5 ? d[4 + i] : d[i]; r4[i] = keep + SHX(send, 32); }
#pragma unroll
            for (int i = 0; i < 2; ++i) { const float send = b4 ? r4[i] : r4[2 + i], keep = b4 ? r4[2 + i] : r4[i]; r2[i] = keep + SHX(send, 16); }
            const float send1 = b3 ? r2[0] : r2[1], keep1 = b3 ? r2[1] : r2[0];
            const float dd = sum8(keep1 + SHX(send1, 8));
            const float hp = rs * dd;
            const float gt = SHF((b < 8) ? g0 : g1, (b * 8 + (lane >> 3)) & 63);
            const float w = gt * 0.5f * hp * (1.0f + erff(hp * 0.70710678f)) * (1.0f / 32.0f);
#pragma unroll
            for (int i = 0; i < 8; ++i) {
                const float wi = rl(w, 8 * i);
#pragma unroll
                for (int q = 0; q < 4; ++q) {
                    const unsigned vw = vr[i][q];
                    const f32x2 lo = __builtin_amdgcn_cvt_pk_f32_fp8((int)vw, false), hi = __builtin_amdgcn_cvt_pk_f32_fp8((int)vw, true);
                    out[4 * q] += wi * lo[0]; out[4 * q + 1] += wi * lo[1]; out[4 * q + 2] += wi * hi[0]; out[4 * q + 3] += wi * hi[1];
                }
            }
        }
        if (more) { const int tn = t + nw;
            g0n = TOPG[(tn - tbase) * 128 + lane]; g1n = TOPG[(tn - tbase) * 128 + 64 + lane];
            xan = *(const u32x4*)(hb + (size_t)tn * 1024 + c16); xbn = *(const u32x4*)(hb + (size_t)tn * 1024 + c16 + 8); rsn = rstd_parts(ssq, tn); }
        float ss = 0.f;
        f32x4 hv[4];
#pragma unroll
        for (int q = 0; q < 4; ++q) hv[q] = *(const f32x4*)(hr + 4 * q);
#pragma unroll
        for (int q = 0; q < 4; ++q) {
#pragma unroll
            for (int c = 0; c < 4; ++c) { hv[q][c] += out[4 * q + c]; ss += hv[q][c] * hv[q][c]; }
            if (dost) *(f32x4*)(hr + 4 * q) = hv[q];
        }
        ss = wave_sum(ss);
        if (dost) {
            u32x4 p0, p1;
            p0.x = pack2(hv[0][0], hv[0][1]); p0.y = pack2(hv[0][2], hv[0][3]); p0.z = pack2(hv[1][0], hv[1][1]); p0.w = pack2(hv[1][2], hv[1][3]);
            p1.x = pack2(hv[2][0], hv[2][1]); p1.y = pack2(hv[2][2], hv[2][3]); p1.z = pack2(hv[3][0], hv[3][1]); p1.w = pack2(hv[3][2], hv[3][3]);
            *(u32x4*)(hb + (size_t)t * 1024 + c16) = p0; *(u32x4*)(hb + (size_t)t * 1024 + c16 + 8) = p1;
            if (lane == 0) rstd[t] = rsqrtf(ss * (1.0f / 1024.0f) + 1e-6f);
        }
        e0 = e0n; e1 = e1n; g0 = g0n; g1 = g1n; xa = xan; xb = xbn; rsv = rsn;
    }
#undef PEER_ISSUE_U
#undef PEER_ISSUE_V
}

#ifndef PEER_NPW
#define PEER_NPW 3
#endif
DEV void ph_topk_peer(const Args& a, float* lds, const int tid0) {
    const int wv = __builtin_amdgcn_readfirstlane(tid0 >> 6);
    constexpr int TPW = T / NWG, MC = 20, NMC = TPW / MC, GPT = 8 / TOPK_NU;
    static_assert(TPW * NWG == T && NMC * MC == TPW, "token split");
    int* EL = (int*)(lds + 4096);
    float* GL = (float*)(EL + 2 * MC * 128);
    const int tok_wg = blockIdx.x * TPW;
    __syncthreads();
#pragma unroll 1
    for (int s = 0; s <= NMC; ++s) {
        const int tsel = tok_wg + s * MC, tgat = tok_wg + (s - 1) * MC;
        int* ELs = EL + (s & 1) * MC * 128; float* GLs = GL + (s & 1) * MC * 128;
        const int* ELg = EL + ((s - 1) & 1) * MC * 128; const float* GLg = GL + ((s - 1) & 1) * MC * 128;
        if (s == 0) {
            ph_topk2(a, lds, tid0, tsel * GPT + wv, 8, (tsel + MC) * GPT, ELs, GLs, tsel);
        } else if (s == NMC) {
            ph_peer_pipe<false>(a, tid0, tgat + wv, 8, (MC - wv + 7) / 8, ELg, GLg, tgat);
        } else if (wv < PEER_NPW) {
            ph_peer_pipe<false>(a, tid0, tgat + wv, PEER_NPW, (MC - wv + PEER_NPW - 1) / PEER_NPW, ELg, GLg, tgat);
        } else {
            ph_topk2(a, lds, tid0, tsel * GPT + (wv - PEER_NPW), 8 - PEER_NPW, (tsel + MC) * GPT, ELs, GLs, tsel);
        }
        __syncthreads();
    }
}

typedef float f32x4v __attribute__((ext_vector_type(4)));
#define MFMA16(a, b, c) __builtin_amdgcn_mfma_f32_16x16x32_bf16((a), (b), (c), 0, 0, 0)
namespace sc4 {
constexpr int E_AH = 0, E_RH = 2304, E_BH = 4608, E_KH = 6912, E_BHT = 9216, E_KHT = 12288, E_VT = 15360, E_GC = 18432, E_BYTES = 18688;
constexpr int G_NKAT = 0, G_NBRT = 768, G_NKRT = 1536, G_BYTES = 2304;
constexpr int OFF_E = 0, OFF_G = 6 * E_BYTES, OFF_NBAT = OFF_G + 4 * G_BYTES, OFF_TT = OFF_NBAT + 4 * 1024, OFF_Y = OFF_TT + 4 * 768, TOTAL = OFF_Y + 16384;
}
DEV bf16x8 frag2(u32x2 lo, u32x2 hi) { u32x4 v; v.x = lo.x; v.y = lo.y; v.z = hi.x; v.w = hi.y; return __builtin_bit_cast(bf16x8, v); }
DEV bf16x8 pack_acc(f32x4v p, f32x4v q) { u32x4 v; v.x = pack2(p[0], p[1]); v.y = pack2(p[2], p[3]); v.z = pack2(q[0], q[1]); v.w = pack2(q[2], q[3]); return __builtin_bit_cast(bf16x8, v); }
DEV void ph_scan4(const Args& a, int layer, unsigned char* lb, const int tid0) {
    using namespace sc4;
    static_assert(TOTAL <= LDS_BYTES - 16, "scan LDS map");
    const int lane = tid0 & 63, wv = __builtin_amdgcn_readfirstlane(tid0 >> 6);
    const int r = lane & 15, g = lane >> 4;
    const bf16_t* U = wsb(a, U_OFF); const bf16_t* RS = wsb(a, RS_OFF); const bf16_t* KS = wsb(a, KS_OFF); bf16_t* Uw = wsb(a, U_OFF);
    const bool is_state = wv < 4;
    const int dir = is_state ? (wv >> 1) : ((wv - 4) >> 1), role = wv & 1;
    const bf16_t* Wd = wsb(a, dir ? WB2_OFF : WF_OFF); const bf16_t* Ad = wsb(a, dir ? AB_OFF : AF_OFF);
    const u32x2 z2 = {0u, 0u}; const u32x4 z4 = {0u, 0u, 0u, 0u};
    for (int un = blockIdx.x; un < NSEQ * 8; un += gridDim.x) {
        const int seq = un >> 3, hd = un & 7; const size_t tb = (size_t)seq * 4096; const int cb = hd * 64, pch = cb + lane;
        const float kac = a.rwkv_k_a[layer * 512 + pch];
        __syncthreads();
        if (is_state) {
            f32x4v X[4][2];
#pragma unroll
            for (int m = 0; m < 4; ++m)
#pragma unroll
                for (int vt = 0; vt < 2; ++vt) X[m][vt] = (f32x4v){0.f, 0.f, 0.f, 0.f};
#pragma unroll 1
            for (int p = 0; p < 260; ++p) {
                if (p >= 2 && p < 258) {
                    const int n = p - 2;
                    const unsigned char* E = lb + OFF_E + (dir * 3 + (n % 3)) * E_BYTES;
                    const unsigned char* G = lb + OFF_G + (dir * 2 + (n & 1)) * G_BYTES;
                    float* yb = (float*)(lb + OFF_Y) + (((n & 1) * 2 + dir) * 16) * 64 + 32 * role;
                    bf16x8 fa[2], fr[2];
#pragma unroll
                    for (int s = 0; s < 2; ++s) {
                        fa[s] = frag2(*(const u32x2*)(E + E_AH + r * 144 + 2 * (32 * s + 4 * g)), *(const u32x2*)(E + E_AH + r * 144 + 2 * (32 * s + 16 + 4 * g)));
                        fr[s] = frag2(*(const u32x2*)(E + E_RH + r * 144 + 2 * (32 * s + 4 * g)), *(const u32x2*)(E + E_RH + r * 144 + 2 * (32 * s + 16 + 4 * g)));
                    }
                    const int g1 = g & 1;
                    u32x4 nka = *(const u32x4*)(G + G_NKAT + r * 48 + 16 * g1), nkr = *(const u32x4*)(G + G_NKRT + r * 48 + 16 * g1);
                    if (g >= 2) { nka = z4; nkr = z4; }
                    const bf16x8 fnka = __builtin_bit_cast(bf16x8, nka), fnkr = __builtin_bit_cast(bf16x8, nkr);
                    bf16x8 ftt;
                    {
                        const float* nbat = (const float*)(lb + OFF_NBAT + (dir * 2 + (n & 1)) * 1024);
                        unsigned char* tts = lb + OFF_TT + wv * 768;
                        float Tr[16];
#pragma unroll
                        for (int tg = 0; tg < 4; ++tg) {
                            f32x4v nbq[4][4];
#pragma unroll
                            for (int tt = 0; tt < 4; ++tt)
#pragma unroll
                                for (int i4 = 0; i4 < 4; ++i4) if (4 * i4 < 4 * tg + tt) nbq[tt][i4] = *(const f32x4v*)(nbat + (4 * tg + tt) * 16 + 4 * i4);
#pragma unroll
                            for (int tt = 0; tt < 4; ++tt) {
                                const int t = 4 * tg + tt;
                                float acc = (lane == t) ? 1.0f : 0.f, acc2 = 0.f;
#pragma unroll
                                for (int i = 0; i < t; ++i) { const float pr_ = Tr[i] * nbq[tt][i >> 2][i & 3]; if (i & 1) acc2 += pr_; else acc += pr_; }
                                acc += acc2; Tr[t] = acc;
                                if (lane < 16) *(unsigned short*)(tts + t * 48 + 2 * lane) = (unsigned short)f2bf(acc);
                            }
                        }
                        asm volatile("s_waitcnt lgkmcnt(0)" ::: "memory");
                        ftt = frag2(*(const u32x2*)(tts + r * 48 + 8 * g), z2);
                    }
                    const bf16x8 fnbr = frag2(*(const u32x2*)(G + G_NBRT + r * 48 + 8 * g), z2);
                    bf16x8 fbt[4], fkt[4]; f32x4v gc[4];
#pragma unroll
                    for (int m = 0; m < 4; ++m) {
                        fbt[m] = frag2(*(const u32x2*)(E + E_BHT + (16 * m + r) * 48 + 8 * g), z2);
                        u32x4 kt = *(const u32x4*)(E + E_KHT + (16 * m + r) * 48 + 16 * g1); if (g >= 2) kt = z4; fkt[m] = __builtin_bit_cast(bf16x8, kt);
                        gc[m] = *(const f32x4v*)(E + E_GC + 4 * (16 * m + 4 * g));
                    }
#pragma unroll
                    for (int vt = 0; vt < 2; ++vt) {
                        const int v0 = 32 * role + 16 * vt;
                        u32x4 vv = *(const u32x4*)(E + E_VT + (v0 + r) * 48 + 16 * g1); if (g >= 2) vv = z4;
                        const bf16x8 vb = __builtin_bit_cast(bf16x8, vv);
                        const bf16x8 xb0 = pack_acc(X[0][vt], X[1][vt]), xb1 = pack_acc(X[2][vt], X[3][vt]);
                        f32x4v W = {0.f, 0.f, 0.f, 0.f};
                        W = MFMA16(fa[0], xb0, W); W = MFMA16(fa[1], xb1, W); W = MFMA16(fnka, vb, W);
                        const f32x4v zero4 = {0.f, 0.f, 0.f, 0.f};
                        f32x4v Uc = MFMA16(ftt, pack_acc(W, zero4), zero4);
                        const bf16x8 ub = pack_acc(Uc, zero4);
                        f32x4v Y = {0.f, 0.f, 0.f, 0.f};
                        Y = MFMA16(fr[0], xb0, Y); Y = MFMA16(fr[1], xb1, Y); Y = MFMA16(fnbr, ub, Y); Y = MFMA16(fnkr, vb, Y);
#pragma unroll
                        for (int i = 0; i < 4; ++i) yb[(4 * g + i) * 64 + 16 * vt + r] = Y[i];
#pragma unroll
                        for (int m = 0; m < 4; ++m) { f32x4v xm = MFMA16(fbt[m], ub, X[m][vt]); xm = MFMA16(fkt[m], vb, xm); X[m][vt] = xm * gc[m]; }
                    }
                }
                __syncthreads();
            }
        } else {
            unsigned short prA[8][6], pwA[8], prB[8][6], pwB[8];
#define SC5_ISSUE(pr, pw, n_) do { _Pragma("unroll") for (int s_ = 0; s_ < 8; ++s_) { const int step_ = (n_) * 16 + 8 * role + s_, pos_ = dir ? 4095 - step_ : step_; const size_t t_ = tb + pos_; \
            pr[s_][0] = Wd[t_ * 512 + pch]; pr[s_][1] = U[t_ * UW + pch]; pr[s_][2] = Ad[t_ * 512 + pch]; pr[s_][3] = KS[t_ * 512 + pch]; pr[s_][4] = RS[t_ * 512 + pch]; pr[s_][5] = U[t_ * UW + 1536 + pch]; \
            if (role) { const int st0_ = (n_) * 16 + s_, p0_ = dir ? 4095 - st0_ : st0_; pw[s_] = Wd[(tb + p0_) * 512 + pch]; } } } while (0)
            SC5_ISSUE(prA, pwA, 0); SC5_ISSUE(prB, pwB, 1);
#define SC5_PERIOD(pr, pw, p_) do { const int p = (p_); \
                if (p < 256) { \
                    unsigned char* E = lb + OFF_E + (dir * 3 + (p % 3)) * E_BYTES; \
                    float gcur = 1.0f; \
                    if (role) { \
_Pragma("unroll") \
                        for (int s = 0; s < 8; ++s) gcur *= bf2f(pw[s]); \
                    } \
                    unsigned bt[4], kt[4], vtw[4]; \
_Pragma("unroll") \
                    for (int s = 0; s < 8; ++s) { \
                        const int st = 8 * role + s; \
                        const float w_ = bf2f(pr[s][0]), kk_ = bf2f(pr[s][1]), ic_ = bf2f(pr[s][2]), ks_ = bf2f(pr[s][3]), r_ = bf2f(pr[s][4]); \
                        const float gprev = gcur; gcur *= w_; \
                        const float ig = __builtin_amdgcn_rcpf(gcur); \
                        const unsigned ah = f2bf(-gprev * kk_), bh = f2bf(kk_ * ic_ * ig), kh = f2bf(ks_ * (1.0f + (ic_ - 1.0f) * kac) * ig), rh = f2bf(gcur * r_), vh = pr[s][5]; \
                        *(unsigned short*)(E + E_AH + st * 144 + 2 * lane) = (unsigned short)ah; *(unsigned short*)(E + E_RH + st * 144 + 2 * lane) = (unsigned short)rh; \
                        *(unsigned short*)(E + E_BH + st * 144 + 2 * lane) = (unsigned short)bh; *(unsigned short*)(E + E_KH + st * 144 + 2 * lane) = (unsigned short)kh; \
                        if (s & 1) { bt[s >> 1] |= bh << 16; kt[s >> 1] |= kh << 16; vtw[s >> 1] |= vh << 16; } else { bt[s >> 1] = bh; kt[s >> 1] = kh; vtw[s >> 1] = vh; } \
                    } \
                    *(u32x4*)(E + E_BHT + lane * 48 + 16 * role) = (u32x4){bt[0], bt[1], bt[2], bt[3]}; \
                    *(u32x4*)(E + E_KHT + lane * 48 + 16 * role) = (u32x4){kt[0], kt[1], kt[2], kt[3]}; \
                    *(u32x4*)(E + E_VT + lane * 48 + 16 * role) = (u32x4){vtw[0], vtw[1], vtw[2], vtw[3]}; \
                    if (role) *(float*)(E + E_GC + 4 * lane) = gcur; \
                } \
                if (role == 0) { \
                    if (p >= 1 && p < 257) { \
                        const int n = p - 1; \
                        const unsigned char* E = lb + OFF_E + (dir * 3 + (n % 3)) * E_BYTES; \
                        unsigned char* G = lb + OFF_G + (dir * 2 + (n & 1)) * G_BYTES; \
                        float* nbat = (float*)(lb + OFF_NBAT + (dir * 2 + (n & 1)) * 1024); \
                        bf16x8 ab[2], rb[2], bA[2], kA[2]; \
_Pragma("unroll") \
                        for (int s = 0; s < 2; ++s) { \
                            ab[s] = *(const bf16x8*)(E + E_AH + r * 144 + 2 * (32 * s + 8 * g)); rb[s] = *(const bf16x8*)(E + E_RH + r * 144 + 2 * (32 * s + 8 * g)); \
                            bA[s] = *(const bf16x8*)(E + E_BH + r * 144 + 2 * (32 * s + 8 * g)); kA[s] = *(const bf16x8*)(E + E_KH + r * 144 + 2 * (32 * s + 8 * g)); \
                        } \
                        const f32x4v zero4 = {0.f, 0.f, 0.f, 0.f}; \
                        f32x4v nba = MFMA16(bA[1], ab[1], MFMA16(bA[0], ab[0], zero4)), nka = MFMA16(kA[1], ab[1], MFMA16(kA[0], ab[0], zero4)); \
                        f32x4v nbr = MFMA16(bA[1], rb[1], MFMA16(bA[0], rb[0], zero4)), nkr = MFMA16(kA[1], rb[1], MFMA16(kA[0], rb[0], zero4)); \
_Pragma("unroll") \
                        for (int i = 0; i < 4; ++i) { const int j = 4 * g + i; if (j >= r) { nba[i] = 0.f; nka[i] = 0.f; } if (j > r) { nbr[i] = 0.f; nkr[i] = 0.f; } } \
                        *(f32x4v*)(nbat + r * 16 + 4 * g) = nba; \
                        u32x2 pk; pk.x = pack2(nka[0], nka[1]); pk.y = pack2(nka[2], nka[3]); *(u32x2*)(G + G_NKAT + r * 48 + 8 * g) = pk; \
                        pk.x = pack2(nbr[0], nbr[1]); pk.y = pack2(nbr[2], nbr[3]); *(u32x2*)(G + G_NBRT + r * 48 + 8 * g) = pk; \
                        pk.x = pack2(nkr[0], nkr[1]); pk.y = pack2(nkr[2], nkr[3]); *(u32x2*)(G + G_NKRT + r * 48 + 8 * g) = pk; \
                    } \
                } else { \
                    if (p >= 3 && p < 259) { \
                        const int n = p - 3; \
                        const float* yb = (const float*)(lb + OFF_Y) + (((n & 1) * 2 + dir) * 16) * 64; \
                        const int s2 = lane >> 2, c16 = (lane & 3) * 16; \
                        const f32x4v y0 = *(const f32x4v*)(yb + s2 * 64 + c16), y1 = *(const f32x4v*)(yb + s2 * 64 + c16 + 4), y2 = *(const f32x4v*)(yb + s2 * 64 + c16 + 8), y3 = *(const f32x4v*)(yb + s2 * 64 + c16 + 12); \
                        const int step = n * 16 + s2, pos = dir ? 4095 - step : step; \
                        u32x4 o0, o1; o0.x = pack2(y0[0], y0[1]); o0.y = pack2(y0[2], y0[3]); o0.z = pack2(y1[0], y1[1]); o0.w = pack2(y1[2], y1[3]); \
                        o1.x = pack2(y2[0], y2[1]); o1.y = pack2(y2[2], y2[3]); o1.z = pack2(y3[0], y3[1]); o1.w = pack2(y3[2], y3[3]); \
                        bf16_t* dst = Uw + (tb + pos) * UW + 512 + 512 * dir + cb + c16; \
                        *(u32x4*)(dst) = o0; *(u32x4*)(dst + 8) = o1; \
                    } \
                } \
                if (p + 2 < 256) SC5_ISSUE(pr, pw, p + 2); \
                __syncthreads(); \
            } while (0)
#pragma unroll 1
            for (int p2 = 0; p2 < 260; p2 += 2) { SC5_PERIOD(prA, pwA, p2); SC5_PERIOD(prB, pwB, p2 + 1); }
#undef SC5_PERIOD
#undef SC5_ISSUE
        }
    }
}

extern __shared__ __attribute__((aligned(16))) unsigned char smem[];

enum { PH_PROLOGUE = 0, PH_ROWPREP_X, PH_GEMM1, PH_ATTN, PH_LORA, PH_PREP2, PH_SCAN, PH_POST, PH_GEMM2, PH_CONVERT, PH_GEMM3, PH_TOPK, PH_PEER, PH_PEERDRY, PH_TOPKPEER, PH_GEMM4A, PH_GEMM4B, PH_FINAL };

template <int PH> DEV void run_phase(const Args& a, int layer, const int tid0) {
    float* ldsf = (float*)smem;
    PG8_LAS unsigned char* ldsg = (PG8_LAS unsigned char*)smem;
    const bf16_t* wb = wsb(a, WB_OFF + (size_t)layer * WB_LAYER);
    if constexpr (PH == PH_PROLOGUE) ph_prologue(a, ldsf, tid0);
    else if constexpr (PH == PH_ROWPREP_X) ph_rowprep(a, true, tid0);
    else if constexpr (PH == PH_GEMM1) {
        pg8::Gemm g{wsb(a, HB_OFF), wb + WB_IN / 2, T, INP, 1024};
        pg8::StaticOrder S; S.init(T, INP, gridDim.x, blockIdx.x);
        pg8::EpiProj E{wsb(a, QKV_OFF), wsb(a, U_OFF), wsf(a, SSQ_OFF), wsf(a, ROPEC_OFF), wsf(a, ROPES_OFF)};
        pg8::gemm_phase<pg8::EpiProj, pg8::StaticOrder, false>(ldsg, g, S, E, nullptr, tid0);
    }
    else if constexpr (PH == PH_ATTN) ph_attn3(a, layer, smem, tid0);
    else if constexpr (PH == PH_LORA) ph_rwkv_prep1(a, layer, smem, tid0);
    else if constexpr (PH == PH_PREP2) ph_rwkv_prep2(a, layer, tid0);
    else if constexpr (PH == PH_SCAN) ph_scan4(a, layer, smem, tid0);
    else if constexpr (PH == PH_POST) ph_post2(a, layer, tid0);
    else if constexpr (PH == PH_GEMM2) {
        pg8::Gemm g{wsb(a, MIX_OFF), wb + WB_OUT / 2, T, 1024, 1024};
        pg8::StaticOrder S; S.init(T, 1024, gridDim.x, blockIdx.x);
        pg8::EpiF32x<1> E{a.h, 1024, nullptr, wsb(a, HB_OFF), wsf(a, SSQ_OFF)};
        pg8::gemm_phase<pg8::EpiF32x<1>, pg8::StaticOrder, false>(ldsg, g, S, E, nullptr, tid0);
    }
    else if constexpr (PH == PH_CONVERT) ph_convert8(a, layer, tid0);
    else if constexpr (PH == PH_GEMM3) {
        pg8::Gemm g{wsb(a, HB_OFF), wb + WB_QK / 2, T, 2048, 1024};
        pg8::StaticOrder S; S.init(T, 2048, gridDim.x, blockIdx.x);
        pg8::EpiF32x<0> E{wsf(a, SC_OFF), 2048, nullptr, nullptr, nullptr};
        pg8::gemm_phase<pg8::EpiF32x<0>, pg8::StaticOrder, false>(ldsg, g, S, E, nullptr, tid0);
    }
    else if constexpr (PH == PH_TOPK) ph_topk2(a, ldsf, tid0, blockIdx.x * 8 + (tid0 >> 6), gridDim.x * 8, T * (8 / TOPK_NU), (int*)(a.ws + TOPI_OFF), wsf(a, TOPG_OFF), 0);
    else if constexpr (PH == PH_TOPKPEER) ph_topk_peer(a, ldsf, tid0);
    else if constexpr (PH == PH_PEER) ph_peer_pipe<false>(a, tid0, blockIdx.x * 8 + (tid0 >> 6), gridDim.x * 8, T / (gridDim.x * 8), (const int*)(a.ws + TOPI_OFF), wsf(a, TOPG_OFF), 0);
    else if constexpr (PH == PH_PEERDRY) ph_peer_pipe<true>(a, tid0, blockIdx.x * 8 + (tid0 >> 6), gridDim.x * 8, T / (gridDim.x * 8), (const int*)(a.ws + TOPI_OFF), wsf(a, TOPG_OFF), 0);
    else if constexpr (PH == PH_GEMM4A) {
        pg8::Gemm g{wsb(a, HB_OFF), wb + WB_GATE / 2, T, 1024, 1024};
        pg8::StaticOrder S; S.init(T, 1024, gridDim.x, blockIdx.x);
        pg8::EpiGate E{wsb(a, GATE_OFF), wsf(a, RSTD_OFF), a.ple_b_gate + layer * 1024};
        pg8::gemm_phase<pg8::EpiGate, pg8::StaticOrder, false>(ldsg, g, S, E, nullptr, tid0);
    }
    else if constexpr (PH == PH_GEMM4B) {
        pg8::Gemm g{wsb(a, PB_OFF), wb + WB_PROJ / 2, T, 1024, 256};
        pg8::StaticOrder S; S.init(T, 1024, gridDim.x, blockIdx.x);
        pg8::EpiF32x<2> E{a.h, 1024, wsb(a, GATE_OFF), wsb(a, HB_OFF), wsf(a, SSQ_OFF)};
        pg8::gemm_phase<pg8::EpiF32x<2>, pg8::StaticOrder, false>(ldsg, g, S, E, nullptr, tid0);
    }
    else if constexpr (PH == PH_FINAL) ph_final(a, tid0);
}

#if !ONE_LAUNCH
template <int PH> __global__ void __launch_bounds__(NTHR, 2) k_phase(Args a, int layer) { run_phase<PH>(a, layer, (int)threadIdx.x); }
#endif

#if ONE_LAUNCH
#ifndef REP_PEER
#define REP_PEER 1
#endif
#ifndef REP_SCAN
#define REP_SCAN 1
#endif
#ifndef REP_TOPK
#define REP_TOPK 1
#endif
#ifndef REP_GEMM1
#define REP_GEMM1 1
#endif
#ifndef REP_LORA
#define REP_LORA 1
#endif
#ifndef REP_POST
#define REP_POST 1
#endif
#ifndef REP_ATTN
#define REP_ATTN 1
#endif
#ifndef REP_GEMM3
#define REP_GEMM3 1
#endif
typedef const __attribute__((address_space(4))) unsigned long long* kargs_t;
static_assert(sizeof(Args) == 31 * 8, "Args is 31 pointers, no padding");
#define AS1 __attribute__((address_space(1)))
DEV Args load_args(kargs_t kp) {
    Args r; const float** d = (const float**)&r;
#pragma unroll
    for (int i = 0; i < 29; ++i) d[i] = (const float*)(AS1 const float*)kp[i];
    r.h = (float*)(AS1 float*)kp[29]; r.ws = (unsigned char*)(AS1 unsigned char*)kp[30];
    return r; }
#define RUN(PH, layer) do { kargs_t kp_ = (kargs_t)__builtin_amdgcn_kernarg_segment_ptr(); asm volatile("" : "+s"(kp_)); const Args la_ = load_args(kp_); int t_; asm volatile("v_mbcnt_lo_u32_b32 %0, -1, 0\n\tv_mbcnt_hi_u32_b32 %0, -1, %0\n\tv_lshl_add_u32 %0, %1, 6, %0" : "=&v"(t_) : "s"(wv0_)); run_phase<PH>(la_, layer, t_); } while (0)
#define BAR() do { kargs_t kp_ = (kargs_t)__builtin_amdgcn_kernarg_segment_ptr(); asm volatile("" : "+s"(kp_)); XcdBarrier b_; b_.bar = (unsigned*)((unsigned char*)kp_[30] + BAR_OFF); b_.x = xb_xcc_id(); b_.st = (volatile LAS unsigned*)(smem + LDS_BYTES - 16); int t_; asm volatile("v_mbcnt_lo_u32_b32 %0, -1, 0\n\tv_mbcnt_hi_u32_b32 %0, -1, %0\n\tv_lshl_add_u32 %0, %1, 6, %0" : "=&v"(t_) : "s"(wv0_)); xcd_barrier(b_, t_); } while (0)
#define LAYER_BODY(layer) do { \
        for (int rep_ = 0; rep_ < REP_GEMM1; ++rep_) { RUN(PH_GEMM1, layer); BAR(); } \
        for (int rep_ = 0; rep_ < REP_ATTN; ++rep_) { RUN(PH_ATTN, layer); BAR(); } \
        for (int rep_ = 0; rep_ < REP_LORA; ++rep_) { RUN(PH_LORA, layer); BAR(); } \
        for (int rep_ = 0; rep_ < REP_PREP2; ++rep_) { RUN(PH_PREP2, layer); BAR(); } \
        for (int rep_ = 0; rep_ < REP_SCAN; ++rep_) { RUN(PH_SCAN, layer); BAR(); } \
        for (int rep_ = 0; rep_ < REP_POST; ++rep_) { RUN(PH_POST, layer); BAR(); } \
        RUN(PH_GEMM2, layer); BAR(); \
        for (int rep_ = 0; rep_ < REP_CONVERT; ++rep_) { RUN(PH_CONVERT, layer); BAR(); } \
        for (int rep_ = 0; rep_ < REP_GEMM3; ++rep_) { RUN(PH_GEMM3, layer); BAR(); } \
        RUN(PH_TOPKPEER, layer); BAR(); \
        for (int rep_ = 0; rep_ < REP_GEMM4A; ++rep_) { RUN(PH_GEMM4A, layer); BAR(); } \
        RUN(PH_GEMM4B, layer); BAR(); \
    } while (0)
__global__ void __launch_bounds__(NTHR, 2) k_mega(Args a) {
    if (threadIdx.x == 0) *(uint4*)(smem + LDS_BYTES - 16) = make_uint4(0u, 0u, 0u, 0u);
    __syncthreads();
    (void)xcd_barrier_post((unsigned*)(a.ws + BAR_OFF), (volatile LAS unsigned*)(smem + LDS_BYTES - 16));
    const int wv0_ = __builtin_amdgcn_readfirstlane((int)threadIdx.x >> 6);
    RUN(PH_PROLOGUE, 0);
    RUN(PH_ROWPREP_X, 0); BAR();
    LAYER_BODY(0); LAYER_BODY(1); LAYER_BODY(2); LAYER_BODY(3);
    RUN(PH_FINAL, 0);
}
#endif

#if !ONE_LAUNCH
template <int PH> static void launch_phase(const Args& a, int layer, hipStream_t st) {
    static bool attr = false;
    if (!attr) { (void)hipFuncSetAttribute((const void*)k_phase<PH>, hipFuncAttributeMaxDynamicSharedMemorySize, LDS_BYTES); attr = true; }
    hipLaunchKernelGGL(k_phase<PH>, dim3(NWG), dim3(NTHR), LDS_BYTES, st, a, layer);
}
#endif

extern "C" void kernel_launch(void* const* d_in, const int* in_sizes, int n_in, void* d_out, int out_size, void* d_ws, size_t ws_size, hipStream_t stream) {
    if (n_in != 29 || out_size != T * D || ws_size < WS_END) {
        fprintf(stderr, "kernel_launch: unexpected shapes (n_in %d, out %d, ws %zu, need %zu); nothing launched\n", n_in, out_size, ws_size, (size_t)WS_END);
        return;
    }
    Args a{};
    const float** ap = (const float**)&a;
    for (int i = 0; i < 29; ++i) ap[i] = (const float*)d_in[i];
    a.h = (float*)d_out; a.ws = (unsigned char*)d_ws;
#if ONE_LAUNCH
    static bool attr = false;
    if (!attr) { (void)hipFuncSetAttribute((const void*)k_mega, hipFuncAttributeMaxDynamicSharedMemorySize, LDS_BYTES); attr = true; }
    (void)hipMemsetAsync((char*)d_ws + BAR_OFF, 0, XCD_BAR_WORDS * sizeof(unsigned), stream);
    hipLaunchKernelGGL(k_mega, dim3(NWG), dim3(NTHR), LDS_BYTES, stream, a);
#else
    launch_phase<PH_PROLOGUE>(a, 0, stream);
    launch_phase<PH_ROWPREP_X>(a, 0, stream);
    for (int layer = 0; layer < NL; ++layer) {
        launch_phase<PH_GEMM1>(a, layer, stream);
        launch_phase<PH_ATTN>(a, layer, stream);
        launch_phase<PH_LORA>(a, layer, stream);
        launch_phase<PH_PREP2>(a, layer, stream);
        launch_phase<PH_SCAN>(a, layer, stream);
        launch_phase<PH_POST>(a, layer, stream);
        launch_phase<PH_GEMM2>(a, layer, stream);
        launch_phase<PH_CONVERT>(a, layer, stream);
        launch_phase<PH_GEMM3>(a, layer, stream);
        launch_phase<PH_TOPK>(a, layer, stream);
        launch_phase<PH_PEER>(a, layer, stream);
        launch_phase<PH_GEMM4A>(a, layer, stream);
        launch_phase<PH_GEMM4B>(a, layer, stream);
    }
    launch_phase<PH_FINAL>(a, 0, stream);
#endif
}
```

```cpp
#define PEER_NPW 2
#include <hip/hip_runtime.h>
#include <stdint.h>
#include <stdio.h>

#ifndef ONE_LAUNCH
#define ONE_LAUNCH 1
#endif

#ifndef REP_PREP2
#define REP_PREP2 1
#endif
#ifndef REP_CONVERT
#define REP_CONVERT 1
#endif
#ifndef REP_GEMM4A
#define REP_GEMM4A 1
#endif
#ifndef REP_ATTNX
#define REP_ATTNX 0
#endif
#ifndef REP_MERGE
#define REP_MERGE 0
#endif
#ifndef FP4_EMU
#define FP4_EMU 0
#endif
#ifndef PEER_FP4
#define PEER_FP4 1
#endif
#define PEER_USC 64.0f
#define PEER_VSC 10.0f
#ifndef PEER_MX
#define PEER_MX 2
#endif
#ifndef PEER_MXU
#define PEER_MXU 1
#endif
#ifndef PEER_MXV
#define PEER_MXV 1
#endif
#ifndef PEER_XF4
#define PEER_XF4 0
#endif
#ifndef REP_TOPK
#define REP_TOPK 1
#endif
#ifndef PEER_PRIO
#define PEER_PRIO 2
#endif
#ifndef MX_HWS
#define MX_HWS 1
#endif
#ifndef ATTN_VAR
#define ATTN_VAR 0
#endif

typedef unsigned short bf16_t;
typedef float f32x4 __attribute__((ext_vector_type(4)));
typedef float f32x2 __attribute__((ext_vector_type(2)));
typedef unsigned u32x4 __attribute__((ext_vector_type(4)));
typedef unsigned u32x2 __attribute__((ext_vector_type(2)));
typedef __bf16 bf16x2_t __attribute__((ext_vector_type(2)));

#define DEV __device__ __forceinline__

namespace cfg {
constexpr int NSEQ = 20, SEQ = 4096, T = NSEQ * SEQ, TP = 4 * SEQ, D = 1024, NL = 4;
constexpr int INC = 3456, INP = 3584;
constexpr int QKVW = 1536, UW = 2048, UC = 1920;
constexpr int NWG = 256, NTHR = 512;
constexpr int LDS_BYTES = 163840;
constexpr size_t MiB = 1ull << 20;
constexpr size_t WB_OFF = 0;
constexpr size_t WB_LAYER = 16 * MiB;
constexpr size_t WB_IN = 0, WB_OUT = 7 * MiB, WB_QK = 9 * MiB, WB_GATE = 13 * MiB, WB_PROJ = 15 * MiB, WB_LORA = 15 * MiB + 512 * 1024;
constexpr size_t HB_OFF = 64 * MiB;
constexpr size_t MIX_OFF = 224 * MiB;
constexpr size_t SMALL_OFF = 384 * MiB;
constexpr size_t RSTD_OFF = SMALL_OFF;
constexpr size_t ROPEC_OFF = SMALL_OFF + 512 * 1024, ROPES_OFF = SMALL_OFF + 640 * 1024;
constexpr size_t BAR_OFF = SMALL_OFF + 1 * MiB;
constexpr size_t BIG_OFF = 386 * MiB;
constexpr size_t QKV_OFF = BIG_OFF;
constexpr size_t RS_OFF = BIG_OFF, KS_OFF = BIG_OFF + 80 * MiB, G_OFF = BIG_OFF + 160 * MiB;
constexpr size_t U_OFF = BIG_OFF + 240 * MiB;
constexpr size_t WF_OFF = BIG_OFF + 560 * MiB, WB2_OFF = BIG_OFF + 640 * MiB, AF_OFF = BIG_OFF + 720 * MiB, AB_OFF = BIG_OFF + 800 * MiB;
constexpr size_t OP_OFF = BIG_OFF + 560 * MiB;
constexpr size_t ML_OFF = BIG_OFF + 800 * MiB;
constexpr size_t SC_OFF = BIG_OFF;
constexpr size_t TOPI_OFF = BIG_OFF + 640 * MiB, TOPG_OFF = BIG_OFF + 680 * MiB;
constexpr size_t PTU_OFF = BIG_OFF + 720 * MiB, PTV_OFF = BIG_OFF + 752 * MiB;
constexpr size_t PB_OFF = BIG_OFF + 784 * MiB;
constexpr size_t GATE_OFF = BIG_OFF;
constexpr size_t SSQ_OFF = BIG_OFF + 880 * MiB;
constexpr size_t WS_END = BIG_OFF + 886 * MiB;
}
using namespace cfg;

struct Args {
    const float* x_prompt; const float* x_sample; const float* p_prompt; const float* p_sample;
    const float* norm_mix_g; const float* w_in; const float* att_norm_g; const float* rwkv_shift;
    const float* rwkv_w0; const float* rwkv_w2; const float* rwkv_a0; const float* rwkv_a2; const float* rwkv_g2;
    const float* rwkv_k_k; const float* rwkv_k_a; const float* rwkv_r_k; const float* rwkv_ln_w; const float* rwkv_ln_b;
    const float* w_out; const float* norm_ffn_g; const float* peer_w_q; const float* peer_sub_keys; const float* peer_u; const float* peer_v;
    const float* ple_norm_g; const float* ple_w_gate; const float* ple_b_gate; const float* ple_w_proj; const float* final_norm_g;
    float* h;
    unsigned char* ws;
};

DEV int tid_() { int t = threadIdx.x; asm volatile("" : "+v"(t)); return t; }
DEV float bf2f(unsigned h) { return __uint_as_float(h << 16); }
DEV float bflo(unsigned d) { return __uint_as_float(d << 16); }
DEV float bfhi(unsigned d) { return __uint_as_float(d & 0xffff0000u); }
DEV unsigned pack2(float lo, float hi) { const f32x2 v = {lo, hi}; return __builtin_bit_cast(unsigned, __builtin_convertvector(v, bf16x2_t)); }
DEV unsigned f2bf(float f) { return pack2(f, 0.f) & 0xffffu; }
DEV float dot2bf(unsigned a, unsigned b, float c) { return __builtin_amdgcn_fdot2_f32_bf16(__builtin_bit_cast(bf16x2_t, a), __builtin_bit_cast(bf16x2_t, b), c, false); }
DEV float shx_(float v, int lane, int o) { return __int_as_float(__builtin_amdgcn_ds_bpermute((lane ^ o) << 2, __float_as_int(v))); }
DEV float shf_(float v, int src) { return __int_as_float(__builtin_amdgcn_ds_bpermute(src << 2, __float_as_int(v))); }
DEV int shf_(int v, int src) { return __builtin_amdgcn_ds_bpermute(src << 2, v); }
#define SHX(v, o) shx_((v), lane, (o))
#define SHF(v, src) shf_((v), (src))
DEV float wave_sum_(float v, int lane) {
#pragma unroll
    for (int o = 32; o > 0; o >>= 1) v += shx_(v, lane, o);
    return v;
}
DEV float wave_max_(float v, int lane) {
#pragma unroll
    for (int o = 32; o > 0; o >>= 1) v = fmaxf(v, shx_(v, lane, o));
    return v;
}
#define wave_sum(x) wave_sum_((x), lane)
#define wave_max(x) wave_max_((x), lane)
DEV float sum8(float v) {
    v += __int_as_float(__builtin_amdgcn_mov_dpp(__float_as_int(v), 0xB1, 0xF, 0xF, true));
    v += __int_as_float(__builtin_amdgcn_mov_dpp(__float_as_int(v), 0x4E, 0xF, 0xF, true));
    v += __int_as_float(__builtin_amdgcn_mov_dpp(__float_as_int(v), 0x141, 0xF, 0xF, true));
    return v;
}
DEV float rstd_parts(const float* ssq, int t) { const f32x4* p = (const f32x4*)(ssq + (size_t)t * 16); const f32x4 a = p[0], b = p[1], c = p[2], d = p[3];
    const float s = ((a[0] + a[1]) + (a[2] + a[3])) + ((b[0] + b[1]) + (b[2] + b[3])) + ((c[0] + c[1]) + (c[2] + c[3])) + ((d[0] + d[1]) + (d[2] + d[3]));
    return rsqrtf(s * (1.0f / 1024.0f) + 1e-6f); }
DEV float sigmoidf_(float x) { return __builtin_amdgcn_rcpf(1.0f + __expf(-x)); }
namespace pg8 {
#define PG8_LAS __attribute__((address_space(3)))
typedef unsigned short bf16_t;
typedef short bf16x8 __attribute__((ext_vector_type(8)));
typedef float f32x4 __attribute__((ext_vector_type(4)));
typedef unsigned u32x4 __attribute__((ext_vector_type(4)));
constexpr int BM = 256, BK = 64, HALF = 128, HTB = HALF * BK * 2  , STAGE_BYTES = 8 * HTB, NXCD = 8, WGM = 8;

__host__ __device__ __forceinline__ int lds_byte(int r, int c) { const int st = (r >> 4) * 2 + (c >> 5), rr = r & 15, cc = c & 31, ob = rr * 64 + cc * 2; return st * 1024 + (ob ^ (((ob >> 9) & 1) << 5)); }
__host__ __device__ __forceinline__ void stage_rc(int b, int& R, int& C) { const int st = b / 1024, sb = b % 1024, swz = sb ^ (((sb >> 9) & 1) << 5); R = (st >> 1) * 16 + swz / 64; C = (st & 1) * 32 + (swz % 64) / 2; }
__host__ __device__ __forceinline__ int perm32(int rho) { const int n = rho >> 4, i = rho & 15; return 8 * (i >> 2) + 4 * n + (i & 3); }

struct Unit { int pm, pn; };
struct Gemm { const bf16_t* A; const bf16_t* Bt; int M, N, K; };

struct StaticOrder {
    int nM, nN, nwg, G, c;
    __host__ __device__ void init(int M, int N, int G_, int c_) { nM = M / BM; nN = N / BM; nwg = nM * nN; G = G_; c = c_; }
    __host__ __device__ bool next(int i, Unit& u) const {
        const long L = (long)i * G + c; if (L >= nwg) return false;
        int wgid = (int)L; { const int q = nwg / NXCD, r = nwg % NXCD, xcd = wgid % NXCD, off = wgid / NXCD; wgid = (xcd < r ? xcd * (q + 1) : r * (q + 1) + (xcd - r) * q) + off; }
        const int nig = WGM * nN, gid = wgid / nig, fm = gid * WGM, gsz = (nM - fm) < WGM ? (nM - fm) : WGM;
        u.pm = fm + ((wgid % nig) % gsz); u.pn = (wgid % nig) / gsz; return true;
    }
    __device__ __forceinline__ void a_ready(const Unit&) const {}
    __device__ __forceinline__ void done(const Unit&) const {}
};
__device__ __forceinline__ unsigned cvt_pk_bf16(float lo, float hi) { unsigned r; asm volatile("v_cvt_pk_bf16_f32 %0, %1, %2" : "=v"(r) : "v"(lo), "v"(hi)); return r; }

struct EpiProj {
    static constexpr bool PERM = true, AFTER_DRAIN = false;
    bf16_t* qkv; bf16_t* u; const float* ssq; const float* rc; const float* rs;
    __device__ __forceinline__ void operator()(const f32x4 (&acc)[2][2][4][2], const Unit& un, int wr, int wc, int fr, int fq) const {
        const int row0 = un.pm * BM + wr * 64 + fr, lane = fr + 16 * fq;
        const bool isq = un.pn < 6;
        bf16_t* base = isq ? qkv : u; const int ld = isq ? 1536 : 2048; const int colt = isq ? un.pn * BM : (un.pn - 6) * BM;
        const int col0 = colt + wc * 32 + 8 * fq;
        const bool rope = (un.pn < 4) && ((wc & 1) == 0);
        f32x4 pq[2][4];
#pragma unroll
        for (int ai = 0; ai < 2; ++ai)
#pragma unroll
            for (int m = 0; m < 4; ++m) pq[ai][m] = *(const f32x4*)(ssq + (size_t)(row0 + ai * HALF + m * 16) * 16 + 4 * fq);
        float rsd[2][4];
#pragma unroll
        for (int ai = 0; ai < 2; ++ai)
#pragma unroll
            for (int m = 0; m < 4; ++m) { float t = (pq[ai][m][0] + pq[ai][m][1]) + (pq[ai][m][2] + pq[ai][m][3]); t += SHX(t, 16); t += SHX(t, 32); rsd[ai][m] = rsqrtf(t * (1.0f / 1024.0f) + 1e-6f); }
#pragma unroll
        for (int ai = 0; ai < 2; ++ai)
#pragma unroll
            for (int m = 0; m < 4; ++m) {
                const int row = row0 + ai * HALF + m * 16; const float s = rsd[ai][m]; const int pos = row & 4095;
                f32x4 c0 = {1.f, 1.f, 1.f, 1.f}, c1 = c0, s0 = {0.f, 0.f, 0.f, 0.f}, s1 = s0;
                if (rope) { c0 = *(const f32x4*)(rc + pos * 8); c1 = *(const f32x4*)(rc + pos * 8 + 4); s0 = *(const f32x4*)(rs + pos * 8); s1 = *(const f32x4*)(rs + pos * 8 + 4); }
                bf16_t* rowp = base + (size_t)row * ld + col0;
#pragma unroll
                for (int bj = 0; bj < 2; ++bj) {
                    f32x4 v0 = acc[ai][bj][m][0] * s, v1 = acc[ai][bj][m][1] * s;
                    if (rope) {
                        f32x4 o0, o1;
#pragma unroll
                        for (int c = 0; c < 4; ++c) { o0[c] = SHX(v0[c], 16); o1[c] = SHX(v1[c], 16); }
                        if (fq == 0) { v0 = v0 * c0 - o0 * s0; v1 = v1 * c1 - o1 * s1; }
                        else if (fq == 1) { v0 = v0 * c0 + o0 * s0; v1 = v1 * c1 + o1 * s1; }
                    }
                    u32x4 w; w.x = cvt_pk_bf16(v0[0], v0[1]); w.y = cvt_pk_bf16(v0[2], v0[3]); w.z = cvt_pk_bf16(v1[0], v1[1]); w.w = cvt_pk_bf16(v1[2], v1[3]);
                    *(u32x4*)(rowp + bj * HALF) = w;
                }
            }
    }
};
template <int MODE> struct EpiF32x {
    static constexpr bool PERM = true, AFTER_DRAIN = false;
    float* C; int ldc; const bf16_t* gate; bf16_t* hb; float* ssq;
    __device__ __forceinline__ void operator()(const f32x4 (&acc)[2][2][4][2], const Unit& un, int wr, int wc, int fr, int fq) const {
        const int row0 = un.pm * BM + wr * 64 + fr, col0 = un.pn * BM + wc * 32 + 8 * fq, lane = fr + 16 * fq;
#pragma unroll
        for (int ai = 0; ai < 2; ++ai)
#pragma unroll
            for (int m = 0; m < 4; ++m) {
                const int row = row0 + ai * HALF + m * 16;
                const size_t ro = (size_t)row * ldc + col0;
                if (MODE != 0) asm volatile("" ::: "memory");
                float ss = 0.f;
#pragma unroll
                for (int bj = 0; bj < 2; ++bj) {
                    if (MODE == 2 && bj) asm volatile("" ::: "memory");
                    f32x4* p = (f32x4*)(C + ro + bj * HALF);
                    if (MODE == 0) { p[0] = acc[ai][bj][m][0]; p[1] = acc[ai][bj][m][1]; }
                    else {
                        f32x4 v0, v1;
                        if (MODE == 1) { v0 = p[0] + acc[ai][bj][m][0]; v1 = p[1] + acc[ai][bj][m][1]; }
                        else { const u32x4 g = *(const u32x4*)(gate + ro + bj * HALF);
                               f32x4 g0, g1; g0[0] = __uint_as_float(g.x << 16); g0[1] = __uint_as_float(g.x & 0xffff0000u); g0[2] = __uint_as_float(g.y << 16); g0[3] = __uint_as_float(g.y & 0xffff0000u);
                               g1[0] = __uint_as_float(g.z << 16); g1[1] = __uint_as_float(g.z & 0xffff0000u); g1[2] = __uint_as_float(g.w << 16); g1[3] = __uint_as_float(g.w & 0xffff0000u);
                               v0 = p[0] + g0 * acc[ai][bj][m][0]; v1 = p[1] + g1 * acc[ai][bj][m][1]; }
                        p[0] = v0; p[1] = v1;
                        ss += ((v0[0] * v0[0] + v0[1] * v0[1]) + (v0[2] * v0[2] + v0[3] * v0[3])) + ((v1[0] * v1[0] + v1[1] * v1[1]) + (v1[2] * v1[2] + v1[3] * v1[3]));
                        u32x4 pk; pk.x = cvt_pk_bf16(v0[0], v0[1]); pk.y = cvt_pk_bf16(v0[2], v0[3]); pk.z = cvt_pk_bf16(v1[0], v1[1]); pk.w = cvt_pk_bf16(v1[2], v1[3]);
                        *(u32x4*)(hb + ro + bj * HALF) = pk;
                    }
                }
                if (MODE != 0) {
                    ss += SHX(ss, 16); ss += SHX(ss, 32);
                    if (fq == 0) ssq[(size_t)row * 16 + un.pn * 4 + wc] = ss;
                }
            }
    }
};
struct EpiGate {
    static constexpr bool PERM = true, AFTER_DRAIN = false;
    bf16_t* O; const float* rstd; const float* bias;
    __device__ __forceinline__ void operator()(const f32x4 (&acc)[2][2][4][2], const Unit& un, int wr, int wc, int fr, int fq) const {
        const int row0 = un.pm * BM + wr * 64 + fr, col0 = un.pn * BM + wc * 32 + 8 * fq;
        f32x4 bv[2][2];
#pragma unroll
        for (int bj = 0; bj < 2; ++bj)
#pragma unroll
            for (int n = 0; n < 2; ++n) bv[bj][n] = *(const f32x4*)(bias + col0 + bj * HALF + 4 * n);
#pragma unroll
        for (int ai = 0; ai < 2; ++ai)
#pragma unroll
            for (int m = 0; m < 4; ++m) {
                const int row = row0 + ai * HALF + m * 16; const float s = rstd[row];
                bf16_t* rowp = O + (size_t)row * 1024 + col0;
#pragma unroll
                for (int bj = 0; bj < 2; ++bj) {
                    f32x4 v0 = acc[ai][bj][m][0] * s + bv[bj][0], v1 = acc[ai][bj][m][1] * s + bv[bj][1];
#pragma unroll
                    for (int c = 0; c < 4; ++c) { v0[c] = __builtin_amdgcn_rcpf(1.0f + __expf(-v0[c])); v1[c] = __builtin_amdgcn_rcpf(1.0f + __expf(-v1[c])); }
                    u32x4 w; w.x = cvt_pk_bf16(v0[0], v0[1]); w.y = cvt_pk_bf16(v0[2], v0[3]); w.z = cvt_pk_bf16(v1[0], v1[1]); w.w = cvt_pk_bf16(v1[2], v1[3]);
                    *(u32x4*)(rowp + bj * HALF) = w;
                }
            }
    }
};
template <class Epi, class Sched, bool STAMP = false>
__device__ __forceinline__ void gemm_phase(PG8_LAS unsigned char* lds, const Gemm g, const Sched& S, const Epi& E, unsigned long long* stamps, const int tid_in) {
    const int tid = tid_in, wid = __builtin_amdgcn_readfirstlane(tid >> 6), lane = tid & 63, wr = wid >> 2, wc = wid & 3, fr = lane & 15, fq = lane >> 4;
    const int K = g.K, nt = K / BK;
    int ts_lo = 0, ts_hi = 0, nts = 0; const unsigned long long rt_entry = STAMP ? (unsigned long long)wall_clock64() : 0ull;
#define PG8_STAMP() do { if (STAMP && wid == 0 && nts < 64) { const unsigned long long _c = (unsigned long long)clock64(); \
        ts_lo = (lane == nts) ? (int)(unsigned)_c : ts_lo; ts_hi = (lane == nts) ? (int)(unsigned)(_c >> 32) : ts_hi; ++nts; } } while (0)
    PG8_STAMP();
    unsigned voffA[2], voffB[2];
#pragma unroll
    for (int i = 0; i < 2; ++i) { int R, C; stage_rc(tid * 16 + i * 8192, R, C); const int Rb = Epi::PERM ? ((R & ~31) + perm32(R & 31)) : R;
        voffA[i] = (unsigned)(R * K + C) * 2u; voffB[i] = (unsigned)(Rb * K + C) * 2u; }
    const size_t kstep = (size_t)(BK * 2);
    const size_t hstep = (size_t)HALF * K * 2;
    const size_t tstep = 2 * hstep;
    const unsigned ldsw = (unsigned)wid * 1024u;
    const int aoff = lds_byte(wr * 64 + fr, fq * 8), boff = lds_byte(wc * 32 + fr, fq * 8);
#define PG8_SA(b, h) (((b) * 2 + (h)) * HTB)
#define PG8_SB(b, h) ((4 + (b) * 2 + (h)) * HTB)
#define PG8_STAGE(bufoff, gbase, voff) do { _Pragma("unroll") for (int _i = 0; _i < 2; ++_i) \
        __builtin_amdgcn_global_load_lds((const unsigned*)((const char*)(gbase) + (voff)[_i]), (PG8_LAS unsigned*)(lds + (bufoff) + ldsw + _i * 8192), 16, 0, 0); } while (0)
#define PG8_LDA(dst, b, h) do { _Pragma("unroll") for (int m = 0; m < 4; ++m) _Pragma("unroll") for (int k = 0; k < 2; ++k) dst[m][k] = *(const PG8_LAS bf16x8*)(lds + PG8_SA(b, h) + aoff + m * 2048 + k * 1024); } while (0)
#define PG8_LDB(dst, b, h) do { _Pragma("unroll") for (int n = 0; n < 2; ++n) _Pragma("unroll") for (int k = 0; k < 2; ++k) dst[n][k] = *(const PG8_LAS bf16x8*)(lds + PG8_SB(b, h) + boff + n * 2048 + k * 1024); } while (0)
#define PG8_MMA(ai, bj, At, Bt) do { __builtin_amdgcn_s_setprio(1); _Pragma("unroll") for (int m = 0; m < 4; ++m) _Pragma("unroll") for (int n = 0; n < 2; ++n) _Pragma("unroll") for (int k = 0; k < 2; ++k) \
        acc[ai][bj][m][n] = __builtin_amdgcn_mfma_f32_16x16x32_bf16(Bt[n][k], At[m][k], acc[ai][bj][m][n], 0, 0, 0); __builtin_amdgcn_s_setprio(0); } while (0)
#define PG8_WAIT_V(n) asm volatile("s_waitcnt vmcnt(" #n ")" ::: "memory")
#define PG8_WAIT_L(n) asm volatile("s_waitcnt lgkmcnt(" #n ")" ::: "memory")
#define PG8_BAR __builtin_amdgcn_s_barrier()
#define PG8_SCHED __builtin_amdgcn_sched_barrier(0)
    Unit cur, nxt; int ui = 0;
    if (!S.next(0, cur)) return;
    f32x4 acc[2][2][4][2];
#pragma unroll
    for (int a = 0; a < 2; ++a)
#pragma unroll
        for (int b = 0; b < 2; ++b)
#pragma unroll
            for (int m = 0; m < 4; ++m)
#pragma unroll
                for (int n = 0; n < 2; ++n) acc[a][b][m][n] = (f32x4){0.f, 0.f, 0.f, 0.f};
    bf16x8 At[4][2], B0[2][2], B1[2][2];
    const char* cA = (const char*)g.A + (size_t)cur.pm * tstep; const char* cB = (const char*)g.Bt + (size_t)cur.pn * tstep;
    S.a_ready(cur);
    PG8_STAGE(PG8_SB(0, 0), cB, voffB); PG8_STAGE(PG8_SA(0, 0), cA, voffA); PG8_STAGE(PG8_SB(0, 1), cB + hstep, voffB); PG8_STAGE(PG8_SA(0, 1), cA + hstep, voffA);
    if (wr == 1) PG8_BAR;
    PG8_WAIT_V(4); PG8_BAR;
    PG8_STAGE(PG8_SB(1, 0), cB + kstep, voffB); PG8_STAGE(PG8_SA(1, 0), cA + kstep, voffA); PG8_STAGE(PG8_SB(1, 1), cB + hstep + kstep, voffB);
    PG8_WAIT_V(6); PG8_BAR;
    PG8_STAMP();
    for (;;) {
        const bool has_next = S.next(ui + 1, nxt);
        const char* nA = has_next ? (const char*)g.A + (size_t)nxt.pm * tstep : cA; const char* nB = has_next ? (const char*)g.Bt + (size_t)nxt.pn * tstep : cB;
        for (int t = 0; t < nt; t += 2) {
            const bool last = (t == nt - 2);
            const char* a1 = cA + (size_t)(t + 1) * kstep;
            const char* a2 = last ? nA : cA + (size_t)(t + 2) * kstep; const char* b2 = last ? nB : cB + (size_t)(t + 2) * kstep;
            const char* a3 = a2 + kstep; const char* b3 = b2 + kstep;
            if (last && has_next) S.a_ready(nxt);
            PG8_LDB(B0, 0, 0); PG8_SCHED; PG8_LDA(At, 0, 0); PG8_STAGE(PG8_SA(1, 1), a1 + hstep, voffA);
            PG8_WAIT_L(8); PG8_BAR; PG8_WAIT_L(0); PG8_MMA(0, 0, At, B0); PG8_BAR; PG8_SCHED;
            PG8_LDB(B1, 0, 1); PG8_STAGE(PG8_SB(0, 0), b2, voffB);
            PG8_BAR; PG8_WAIT_L(0); PG8_MMA(0, 1, At, B1); PG8_BAR;
            PG8_LDA(At, 0, 1); PG8_STAGE(PG8_SA(0, 0), a2, voffA);
            PG8_BAR; PG8_WAIT_L(0); PG8_MMA(1, 0, At, B0); PG8_BAR; PG8_SCHED;
            PG8_STAGE(PG8_SB(0, 1), b2 + hstep, voffB);
            PG8_WAIT_V(6); PG8_BAR; PG8_MMA(1, 1, At, B1); PG8_BAR;
            PG8_LDB(B0, 1, 0); PG8_SCHED; PG8_LDA(At, 1, 0); PG8_STAGE(PG8_SA(0, 1), a2 + hstep, voffA);
            PG8_WAIT_L(8); PG8_BAR; PG8_WAIT_L(0); PG8_MMA(0, 0, At, B0); PG8_BAR; PG8_SCHED;
            PG8_LDB(B1, 1, 1); PG8_STAGE(PG8_SB(1, 0), b3, voffB);
            PG8_BAR; PG8_WAIT_L(0); PG8_MMA(0, 1, At, B1); PG8_BAR;
            PG8_LDA(At, 1, 1); PG8_STAGE(PG8_SA(1, 0), a3, voffA);
            PG8_BAR; PG8_WAIT_L(0); PG8_MMA(1, 0, At, B0); PG8_BAR; PG8_SCHED;
            PG8_STAGE(PG8_SB(1, 1), b3 + hstep, voffB);
            PG8_WAIT_V(6); PG8_BAR; PG8_MMA(1, 1, At, B1); PG8_BAR;
        }
        PG8_STAMP();
        if constexpr (!Epi::AFTER_DRAIN) { E(acc, cur, wr, wc, fr, fq); S.done(cur); }
        PG8_STAMP();
        if (!has_next) break;
#pragma unroll
        for (int a = 0; a < 2; ++a)
#pragma unroll
            for (int b = 0; b < 2; ++b)
#pragma unroll
                for (int m = 0; m < 4; ++m)
#pragma unroll
                    for (int n = 0; n < 2; ++n) acc[a][b][m][n] = (f32x4){0.f, 0.f, 0.f, 0.f};
        cur = nxt; cA = nA; cB = nB; ++ui;
    }
    PG8_WAIT_V(0);
    if (wr == 0) PG8_BAR;
    PG8_BAR;
    if constexpr (Epi::AFTER_DRAIN) { E.fused(acc, cur, wr, wc, fr, fq, lds, wid, lane); S.done(cur); }
    PG8_STAMP();
    if (STAMP && wid == 0) { stamps[lane] = lane < nts ? (((unsigned long long)(unsigned)ts_hi << 32) | (unsigned)ts_lo) : 0ull;
        if (lane == 62) stamps[62] = rt_entry; if (lane == 63) stamps[63] = (unsigned long long)wall_clock64(); }
#undef PG8_STAMP
#undef PG8_SA
#undef PG8_SB
#undef PG8_STAGE
#undef PG8_LDA
#undef PG8_LDB
#undef PG8_MMA
#undef PG8_WAIT_V
#undef PG8_WAIT_L
#undef PG8_BAR
#undef PG8_SCHED
}
}
#define XB_TMO      128
#define XB_XCNT(j)  (256  + 64 * (j))
#define XB_XSUB(j)  (1280 + 64 * (j))
#define XB_XGEN(j)  (2304 + 64 * (j))
#define XB_TOP      3328
#define XB_TOPGEN   3392
#define XCD_BAR_WORDS 3456
#define XB_SPIN_CAP (1u << 23)
#define LAS __attribute__((address_space(3)))

__device__ __forceinline__ unsigned xb_ld(unsigned* p)              { return __hip_atomic_load(p, __ATOMIC_RELAXED, __HIP_MEMORY_SCOPE_AGENT); }
__device__ __forceinline__ unsigned xb_add(unsigned* p, unsigned v) { return __hip_atomic_fetch_add(p, v, __ATOMIC_RELAXED, __HIP_MEMORY_SCOPE_AGENT); }
__device__ __forceinline__ unsigned xb_xcc_id() { return (unsigned)__builtin_amdgcn_s_getreg((3 << 11) | 20) & 0xFu; }
#define XB_SPIN(cond, bar) do { unsigned _sp = 0; while (cond) { __builtin_amdgcn_s_sleep(1); \
    if ((++_sp & 255u) == 0u) { if (xb_ld(&(bar)[XB_TMO])) break; if (_sp > XB_SPIN_CAP) { atomicAdd(&(bar)[XB_TMO], 1u); break; } } } } while (0)

struct XcdBarrier {
    unsigned* bar; unsigned x;
    volatile LAS unsigned* st;
};

__device__ __forceinline__ XcdBarrier xcd_barrier_post(unsigned* bar, volatile LAS unsigned* st) {
    XcdBarrier b; b.bar = bar; b.x = xb_xcc_id(); b.st = st;
    if (threadIdx.x == 0) (void)xb_add(&bar[XB_XCNT(b.x)], 1u);
    return b;
}
__device__ __forceinline__ void xcd_barrier_complete(unsigned* bar, unsigned x, unsigned& nloc, unsigned& nx) {
    const unsigned G = gridDim.x * gridDim.y * gridDim.z;
    unsigned sum, cnt, mine, sp = 0u;
    for (;;) {
        sum = 0u; cnt = 0u; mine = 0u;
#pragma unroll
        for (unsigned j = 0; j < 16; ++j) { const unsigned c = xb_ld(&bar[XB_XCNT(j)]); sum += c; cnt += (c > 0u) ? 1u : 0u; mine = (j == x) ? c : mine; }
        if (sum == G) break;
        __builtin_amdgcn_s_sleep(1);
        if ((++sp & 255u) == 0u) { if (xb_ld(&bar[XB_TMO])) break; if (sp > XB_SPIN_CAP) { atomicAdd(&bar[XB_TMO], 1u); break; } }
    }
    nloc = mine > 0u ? mine : 1u; nx = cnt > 0u ? cnt : 1u;
}

__device__ __forceinline__ void xcd_barrier(const XcdBarrier& b, const int tid) {
    asm volatile("s_waitcnt vmcnt(0)" ::: "memory");
    __syncthreads();
    if (tid == 0) {
        unsigned* bar = b.bar; unsigned bx = b.x;
        asm volatile("" : "+s"(bar), "+s"(bx));
        __builtin_amdgcn_s_waitcnt(0);
        unsigned nloc = b.st[0], nx = b.st[1];
        if (nloc == 0u) { xcd_barrier_complete(bar, bx, nloc, nx); b.st[0] = nloc; b.st[1] = nx; }
        const unsigned old = xb_add(&bar[XB_XSUB(bx)], 1u);
        const unsigned gen = old / nloc;
        if (old + 1u == (gen + 1u) * nloc) {
            __builtin_amdgcn_fence(__ATOMIC_RELEASE, "agent");
            asm volatile("s_waitcnt vmcnt(0)" ::: "memory");
            const unsigned og = xb_add(&bar[XB_TOP], 1u);
            const unsigned tg = og / nx;
            if (og + 1u == (tg + 1u) * nx) xb_add(&bar[XB_TOPGEN], 1u);
            else XB_SPIN(xb_ld(&bar[XB_TOPGEN]) == tg, bar);
            __builtin_amdgcn_fence(__ATOMIC_ACQUIRE, "agent");
            xb_add(&bar[XB_XGEN(bx)], 1u);
            asm volatile("s_waitcnt vmcnt(0)" ::: "memory");
        } else {
            XB_SPIN(xb_ld(&bar[XB_XGEN(bx)]) == gen, bar);
            __builtin_amdgcn_fence(__ATOMIC_ACQUIRE, "agent");
            asm volatile("s_waitcnt vmcnt(0)" ::: "memory");
        }
    }
    __syncthreads();
}


typedef __attribute__((address_space(3))) unsigned char lds_u8;
extern __shared__ __attribute__((aligned(16))) unsigned char smem[];
DEV unsigned char* smem_base() { return smem; }

DEV bf16_t* wsb(const Args& a, size_t off) { return (bf16_t*)(a.ws + off); }
DEV float* wsf(const Args& a, size_t off) { return (float*)(a.ws + off); }

DEV void ph_rowprep(const Args& a, bool from_x, const int tid0) {
    const int lane = tid0 & 63, wv = tid0 >> 6;
    const int gw = blockIdx.x * 8 + wv, nw = gridDim.x * 8;
    bf16_t* hb = wsb(a, HB_OFF); float* ssq = wsf(a, SSQ_OFF);
    for (int t = gw; t < T; t += nw) {
        const float* src = from_x ? (t < TP ? a.x_prompt + (size_t)t * D : a.x_sample + (size_t)(t - TP) * D) : a.h + (size_t)t * D;
        f32x4 v[4]; float ss = 0.f;
#pragma unroll
        for (int i = 0; i < 4; ++i) { v[i] = *(const f32x4*)(src + (i * 64 + lane) * 4); ss += v[i][0] * v[i][0] + v[i][1] * v[i][1] + v[i][2] * v[i][2] + v[i][3] * v[i][3]; }
        ss = wave_sum(ss);
#pragma unroll
        for (int i = 0; i < 4; ++i) {
            if (from_x) *(f32x4*)(a.h + (size_t)t * D + (i * 64 + lane) * 4) = v[i];
            u32x2 p; p.x = pack2(v[i][0], v[i][1]); p.y = pack2(v[i][2], v[i][3]);
            *(u32x2*)(hb + (size_t)t * D + (i * 64 + lane) * 4) = p;
        }
        if (lane < 16) ssq[(size_t)t * 16 + lane] = (lane == 0) ? ss : 0.f;
    }
}

DEV void ph_final(const Args& a, const int tid0) {
    const int lane = tid0 & 63, wv = tid0 >> 6;
    const int gw = blockIdx.x * 8 + wv, nw = gridDim.x * 8;
    for (int t = gw; t < T; t += nw) {
        float* row = a.h + (size_t)t * D;
        f32x4 v[4]; float ss = 0.f;
#pragma unroll
        for (int i = 0; i < 4; ++i) { v[i] = *(const f32x4*)(row + (i * 64 + lane) * 4); ss += v[i][0] * v[i][0] + v[i][1] * v[i][1] + v[i][2] * v[i][2] + v[i][3] * v[i][3]; }
        ss = wave_sum(ss);
        const float r = rsqrtf(ss * (1.0f / 1024.0f) + 1e-6f);
#pragma unroll
        for (int i = 0; i < 4; ++i) { const f32x4 g = *(const f32x4*)(a.final_norm_g + (i * 64 + lane) * 4); *(f32x4*)(row + (i * 64 + lane) * 4) = v[i] * r * g; }
    }
}

DEV void transpose_cvt(const float* __restrict__ src, bf16_t* __restrict__ dst, int K, int N, int Npad, const float* __restrict__ g, float* tile, const int tid0) {
    const int tx = tid0 & 63, ty = tid0 >> 6;
    const int tk = K / 64, tn = Npad / 64;
    for (int tl = blockIdx.x; tl < tk * tn; tl += gridDim.x) {
        const int k0 = (tl % tk) * 64, n0 = (tl / tk) * 64;
        __syncthreads();
        for (int i = ty; i < 64; i += 8) { const int k = k0 + i, n = n0 + tx; float v = (n < N) ? src[(size_t)k * N + n] : 0.f; if (g) v *= g[k]; tile[i * 65 + tx] = v; }
        __syncthreads();
        for (int i = ty; i < 64; i += 8) dst[(size_t)(n0 + i) * K + k0 + tx] = (bf16_t)f2bf(tile[tx * 65 + i]);
    }
}
DEV void fold_wqk(const Args& a, float* lds, const int tid0) {
    float* swq = lds;
    float* ssk = lds + 64 * 132;
    const int tid = tid0, key = tid & 127, kq = tid >> 7;
    for (int un = blockIdx.x; un < NL * 16 * 16; un += gridDim.x) {
        const int l = un >> 8, hp = (un >> 4) & 15, k0 = (un & 15) * 64;
        __syncthreads();
        for (int i = tid; i < 64 * 128; i += NTHR) { const int r = i >> 7, c = i & 127; swq[r * 132 + c] = a.peer_w_q[((size_t)l * 1024 + k0 + r) * 2048 + hp * 128 + c]; }
        for (int i = tid; i < 128 * 128; i += NTHR) { const int r = i >> 7, c = i & 127; ssk[r * 132 + c] = a.peer_sub_keys[(((size_t)l * 16 + hp) * 128 + r) * 128 + c]; }
        __syncthreads();
        float acc[16];
#pragma unroll
        for (int i = 0; i < 16; ++i) acc[i] = 0.f;
        for (int c = 0; c < 128; c += 4) {
            const f32x4 s = *(const f32x4*)(ssk + key * 132 + c);
#pragma unroll
            for (int i = 0; i < 16; ++i) { const f32x4 w = *(const f32x4*)(swq + (kq * 16 + i) * 132 + c); acc[i] += s[0] * w[0] + s[1] * w[1] + s[2] * w[2] + s[3] * w[3]; }
        }
        bf16_t* dst = wsb(a, WB_OFF + (size_t)l * WB_LAYER + WB_QK) + (size_t)(hp * 128 + key) * 1024 + k0 + kq * 16;
        const float* g = a.norm_ffn_g + l * 1024 + k0 + kq * 16;
#pragma unroll
        for (int i = 0; i < 16; i += 2) *(unsigned*)(dst + i) = pack2(acc[i] * g[i], acc[i + 1] * g[i + 1]);
    }
}
DEV void ph_prologue(const Args& a, float* lds, const int tid0) {
    { float* rc = wsf(a, ROPEC_OFF); float* rs = wsf(a, ROPES_OFF);
      for (int i = blockIdx.x * NTHR + tid0; i < 4096 * 8; i += gridDim.x * NTHR) {
          const int pos = i >> 3, f = i & 7;
          const float invf = (float)pow(500000.0, -(double)f / 8.0);
          const float ang = (float)pos * invf;
          rc[i] = (float)cos((double)ang); rs[i] = (float)sin((double)ang);
      } }
    for (int l = 0; l < NL; ++l) {
        bf16_t* wb = wsb(a, WB_OFF + (size_t)l * WB_LAYER);
        transpose_cvt(a.w_in + (size_t)l * 1024 * INC, wb + WB_IN / 2, 1024, INC, INP, a.norm_mix_g + l * 1024, lds, tid0);
        transpose_cvt(a.w_out + (size_t)l * 1024 * 1024, wb + WB_OUT / 2, 1024, 1024, 1024, nullptr, lds, tid0);
        transpose_cvt(a.ple_w_gate + (size_t)l * 1024 * 1024, wb + WB_GATE / 2, 1024, 1024, 1024, a.ple_norm_g + l * 1024, lds, tid0);
        transpose_cvt(a.ple_w_proj + (size_t)l * 256 * 1024, wb + WB_PROJ / 2, 256, 1024, 1024, nullptr, lds, tid0);
        for (int dr = 0; dr < 2; ++dr) {
            transpose_cvt(a.rwkv_w2 + (size_t)(l * 2 + dr) * 64 * 512, wb + WB_LORA / 2 + dr * 512 * 64, 64, 512, 512, nullptr, lds, tid0);
            transpose_cvt(a.rwkv_a2 + (size_t)(l * 2 + dr) * 64 * 512, wb + WB_LORA / 2 + (2 + dr) * 512 * 64, 64, 512, 512, nullptr, lds, tid0);
        }
        transpose_cvt(a.rwkv_g2 + (size_t)l * 128 * 512, wb + WB_LORA / 2 + 4 * 512 * 64, 128, 512, 512, nullptr, lds, tid0);
    }
    fold_wqk(a, lds, tid0);
}

DEV float sum16(float v) {
    v = sum8(v);
    v += __int_as_float(__builtin_amdgcn_mov_dpp(__float_as_int(v), 0x140, 0xF, 0xF, true));
    return v;
}
DEV float max16(float v) {
    v = fmaxf(v, __int_as_float(__builtin_amdgcn_mov_dpp(__float_as_int(v), 0xB1, 0xF, 0xF, true)));
    v = fmaxf(v, __int_as_float(__builtin_amdgcn_mov_dpp(__float_as_int(v), 0x4E, 0xF, 0xF, true)));
    v = fmaxf(v, __int_as_float(__builtin_amdgcn_mov_dpp(__float_as_int(v), 0x141, 0xF, 0xF, true)));
    v = fmaxf(v, __int_as_float(__builtin_amdgcn_mov_dpp(__float_as_int(v), 0x140, 0xF, 0xF, true)));
    return v;
}
DEV float rl(float v, int l) { return __int_as_float(__builtin_amdgcn_readlane(__float_as_int(v), l)); }
DEV float wave_sum_dpp(float v) { v = sum16(v); return (rl(v, 0) + rl(v, 16)) + (rl(v, 32) + rl(v, 48)); }
DEV unsigned fkey(float f) { const unsigned b = __float_as_uint(f); return b ^ ((unsigned)((int)b >> 31) | 0x80000000u); }
DEV int mbcnt64(unsigned long long m) { return (int)__builtin_amdgcn_mbcnt_hi((unsigned)(m >> 32), __builtin_amdgcn_mbcnt_lo((unsigned)m, 0u)); }

#ifndef TOPK_NU
#define TOPK_NU 4
#endif
DEV void ph_topk2(const Args& a, float* lds, const int tid0, const int gw, const int nw, const int NP, int* TOPI, float* TOPG, const int tbase, float* RL = nullptr) {
    const int lane = tid0 & 63, wv = __builtin_amdgcn_readfirstlane(tid0 >> 6);
    constexpr int NU = TOPK_NU, NQ = 2 * NU, GPT = 8 / NU;
    float* tvb = lds + wv * (NQ * 16); int* tib = (int*)(lds + 8 * NQ * 16) + wv * (NQ * 16);
    const float* SC = wsf(a, SC_OFF); const float* ssq = wsf(a, SSQ_OFF);
    float vn[NU][4];
    if (gw < NP) {
#pragma unroll
        for (int u = 0; u < NU; ++u)
#pragma unroll
            for (int i = 0; i < 4; ++i) vn[u][i] = SC[(size_t)gw * (NU * 256) + u * 256 + i * 64 + lane];
    }
    for (int up = gw; up < NP; up += nw) {
        const int t = up / GPT, hd0 = (up % GPT) * NU;
        float v[NU][4]; unsigned k[NU][4];
#pragma unroll
        for (int u = 0; u < NU; ++u)
#pragma unroll
            for (int i = 0; i < 4; ++i) { v[u][i] = vn[u][i]; k[u][i] = fkey(v[u][i]); }
        if (up + nw < NP) {
#pragma unroll
            for (int u = 0; u < NU; ++u)
#pragma unroll
                for (int i = 0; i < 4; ++i) vn[u][i] = SC[(size_t)(up + nw) * (NU * 256) + u * 256 + i * 64 + lane];
        }
        unsigned th[NQ]; unsigned dm = 0u;
#pragma unroll
        for (int q = 0; q < NQ; ++q) th[q] = 0u;
        for (int b = 31; b >= 0; --b) {
            const unsigned bit = 1u << b;
            unsigned long long ma[NQ], mb[NQ];
#pragma unroll
            for (int q = 0; q < NQ; ++q) { const unsigned c = th[q] | bit; ma[q] = __ballot(k[q >> 1][2 * (q & 1)] >= c); mb[q] = __ballot(k[q >> 1][2 * (q & 1) + 1] >= c); }
#pragma unroll
            for (int q = 0; q < NQ; ++q) {
                const int n = __builtin_popcountll(ma[q]) + __builtin_popcountll(mb[q]);
                th[q] = (n >= 16) ? (th[q] | bit) : th[q]; dm |= (n == 16) ? (1u << q) : 0u;
            }
            if (dm == (1u << NQ) - 1u) break;
        }
#pragma unroll
        for (int q = 0; q < NQ; ++q) {
            const int u = q >> 1, p = q & 1; const unsigned tp = th[q];
            const unsigned ka = k[u][2 * p], kb = k[u][2 * p + 1];
            const unsigned long long ga = __ballot(ka > tp), gb = __ballot(kb > tp), ea = __ballot(ka == tp), eb = __ballot(kb == tp);
            const int nga = __builtin_popcountll(ga), ng = nga + __builtin_popcountll(gb), need = 16 - ng, nea = __builtin_popcountll(ea);
            const int rga = mbcnt64(ga), rgb = nga + mbcnt64(gb), rea = mbcnt64(ea), reb = nea + mbcnt64(eb);
            const int pa = (ka > tp) ? rga : ((ka == tp && rea < need) ? ng + rea : -1);
            const int pb = (kb > tp) ? rgb : ((kb == tp && reb < need) ? ng + reb : -1);
            if (pa >= 0) { tvb[q * 16 + pa] = v[u][2 * p]; tib[q * 16 + pa] = lane; }
            if (pb >= 0) { tvb[q * 16 + pb] = v[u][2 * p + 1]; tib[q * 16 + pb] = 64 + lane; }
        }
        float cv[NU][4]; unsigned kc[NU][4]; float mx[NU];
#pragma unroll
        for (int u = 0; u < NU; ++u) {
#pragma unroll
            for (int s = 0; s < 4; ++s) { const int c = lane + 64 * s; cv[u][s] = tvb[u * 32 + (c >> 4)] + tvb[u * 32 + 16 + (c & 15)]; kc[u][s] = fkey(cv[u][s]); }
            const float m0 = max16(lane < 16 ? tvb[u * 32 + (lane & 15)] : -3.0e38f), m1 = max16(lane < 16 ? tvb[u * 32 + 16 + (lane & 15)] : -3.0e38f);
            mx[u] = rl(m0, 0) + rl(m1, 0);
        }
        unsigned t2[NU]; unsigned dm2 = 0u;
#pragma unroll
        for (int u = 0; u < NU; ++u) t2[u] = 0u;
        for (int b = 31; b >= 0; --b) {
            const unsigned bit = 1u << b;
            unsigned long long mc[NU][4];
#pragma unroll
            for (int u = 0; u < NU; ++u)
#pragma unroll
                for (int s4 = 0; s4 < 4; ++s4) mc[u][s4] = __ballot(kc[u][s4] >= (t2[u] | bit));
#pragma unroll
            for (int u = 0; u < NU; ++u) {
                const int n = (__builtin_popcountll(mc[u][0]) + __builtin_popcountll(mc[u][1])) + (__builtin_popcountll(mc[u][2]) + __builtin_popcountll(mc[u][3]));
                t2[u] = (n >= 16) ? (t2[u] | bit) : t2[u]; dm2 |= (n == 16) ? (1u << u) : 0u;
            }
            if (dm2 == (1u << NU) - 1u) break;
        }
        const float rs = rstd_parts(ssq, t);
#pragma unroll
        for (int u = 0; u < NU; ++u) {
            int pos[4]; int ng = 0;
#pragma unroll
            for (int s = 0; s < 4; ++s) { const unsigned long long g = __ballot(kc[u][s] > t2[u]); pos[s] = (kc[u][s] > t2[u]) ? ng + mbcnt64(g) : -1; ng += __builtin_popcountll(g); }
            int ne = 0; const int need = 16 - ng;
#pragma unroll
            for (int s = 0; s < 4; ++s) { const unsigned long long e = __ballot(kc[u][s] == t2[u]); const int r = ne + mbcnt64(e); pos[s] = (kc[u][s] == t2[u] && r < need) ? ng + r : pos[s]; ne += __builtin_popcountll(e); }
            float ex[4]; float es = 0.f;
#pragma unroll
            for (int s = 0; s < 4; ++s) { ex[s] = (pos[s] >= 0) ? __expf(rs * (cv[u][s] - mx[u])) : 0.f; es += ex[s]; }
            const float inv = __builtin_amdgcn_rcpf(wave_sum_dpp(es));
#pragma unroll
            for (int s = 0; s < 4; ++s) if (pos[s] >= 0) {
                const int c = lane + 64 * s;
                const int eid = tib[u * 32 + (c >> 4)] * 128 + tib[u * 32 + 16 + (c & 15)];
                if (TOPG) { TOPI[(t - tbase) * 128 + (hd0 + u) * 16 + pos[s]] = eid; TOPG[(t - tbase) * 128 + (hd0 + u) * 16 + pos[s]] = ex[s] * inv; }
                else TOPI[(t - tbase) * 128 + (hd0 + u) * 16 + pos[s]] = eid | ((int)(ex[s] * inv * 262143.0f + 0.5f) << 14);
            }
        }
        if (RL && hd0 == 0 && lane == 0) RL[t - tbase] = rs;
    }
}

DEV unsigned pack4_fp8(float a, float b, float c, float d) {
    int w = __builtin_amdgcn_cvt_pk_fp8_f32(a, b, 0, false);
    w = __builtin_amdgcn_cvt_pk_fp8_f32(c, d, w, true);
    return (unsigned)w;
}
DEV void ph_convert8(const Args& a, int layer, const int tid0) {
    const size_t gtid = (size_t)blockIdx.x * NTHR + tid0, gn = (size_t)gridDim.x * NTHR;
    const float* us = a.peer_u + (size_t)layer * 16384 * 1024; const float* vs = a.peer_v + (size_t)layer * 16384 * 1024;
    unsigned* ud = (unsigned*)(a.ws + PTU_OFF); unsigned* vd = (unsigned*)(a.ws + PTV_OFF);
    const float* g = a.norm_ffn_g + layer * 1024;
#if PEER_FP4
    for (size_t i = gtid; i < (size_t)16384 * 1024 / 16; i += gn) {
        u32x2 pu = {0u, 0u}, pv = {0u, 0u};
#pragma unroll
        for (int j = 0; j < 4; ++j) {
            const f32x4 x = *(const f32x4*)(us + i * 16 + j * 4), y = *(const f32x4*)(vs + i * 16 + j * 4), gg = *(const f32x4*)(g + ((i * 16 + j * 4) & 1023));
            unsigned wu = pu[j >> 1], wv = pv[j >> 1];
            if (j & 1) { wu = __builtin_amdgcn_cvt_scalef32_pk_fp4_f32(wu, x[0] * gg[0] * PEER_USC, x[1] * gg[1] * PEER_USC, 1.0f, 2); wu = __builtin_amdgcn_cvt_scalef32_pk_fp4_f32(wu, x[2] * gg[2] * PEER_USC, x[3] * gg[3] * PEER_USC, 1.0f, 3);
                         wv = __builtin_amdgcn_cvt_scalef32_pk_fp4_f32(wv, y[0] * PEER_VSC, y[1] * PEER_VSC, 1.0f, 2); wv = __builtin_amdgcn_cvt_scalef32_pk_fp4_f32(wv, y[2] * PEER_VSC, y[3] * PEER_VSC, 1.0f, 3); }
            else       { wu = __builtin_amdgcn_cvt_scalef32_pk_fp4_f32(wu, x[0] * gg[0] * PEER_USC, x[1] * gg[1] * PEER_USC, 1.0f, 0); wu = __builtin_amdgcn_cvt_scalef32_pk_fp4_f32(wu, x[2] * gg[2] * PEER_USC, x[3] * gg[3] * PEER_USC, 1.0f, 1);
                         wv = __builtin_amdgcn_cvt_scalef32_pk_fp4_f32(wv, y[0] * PEER_VSC, y[1] * PEER_VSC, 1.0f, 0); wv = __builtin_amdgcn_cvt_scalef32_pk_fp4_f32(wv, y[2] * PEER_VSC, y[3] * PEER_VSC, 1.0f, 1); }
            pu[j >> 1] = wu; pv[j >> 1] = wv;
        }
        *(u32x2*)(ud + i * 2) = pu; *(u32x2*)(vd + i * 2) = pv;
    }
#else
    for (size_t i = gtid; i < (size_t)16384 * 1024 / 16; i += gn) {
        u32x4 pu, pv;
#pragma unroll
        for (int j = 0; j < 4; ++j) {
            const f32x4 x = *(const f32x4*)(us + i * 16 + j * 4), y = *(const f32x4*)(vs + i * 16 + j * 4), gg = *(const f32x4*)(g + ((i * 16 + j * 4) & 1023));
#if FP4_EMU
            { const unsigned q0 = __builtin_amdgcn_cvt_scalef32_pk_fp4_f32(0u, x[0] * gg[0] * 64.f, x[1] * gg[1] * 64.f, 1.0f, 0), q1 = __builtin_amdgcn_cvt_scalef32_pk_fp4_f32(0u, x[2] * gg[2] * 64.f, x[3] * gg[3] * 64.f, 1.0f, 0);
              const f32x2 r0 = __builtin_amdgcn_cvt_scalef32_pk_f32_fp4(q0, 1.0f, 0), r1 = __builtin_amdgcn_cvt_scalef32_pk_f32_fp4(q1, 1.0f, 0);
              pu[j] = pack4_fp8(r0[0] * 4.f, r0[1] * 4.f, r1[0] * 4.f, r1[1] * 4.f);
              const unsigned q2 = __builtin_amdgcn_cvt_scalef32_pk_fp4_f32(0u, y[0] * 8.f, y[1] * 8.f, 1.0f, 0), q3 = __builtin_amdgcn_cvt_scalef32_pk_fp4_f32(0u, y[2] * 8.f, y[3] * 8.f, 1.0f, 0);
              const f32x2 r2 = __builtin_amdgcn_cvt_scalef32_pk_f32_fp4(q2, 1.0f, 0), r3 = __builtin_amdgcn_cvt_scalef32_pk_f32_fp4(q3, 1.0f, 0);
              pv[j] = pack4_fp8(r2[0] * 4.f, r2[1] * 4.f, r3[0] * 4.f, r3[1] * 4.f); }
#else
            pu[j] = pack4_fp8(x[0] * gg[0] * 256.f, x[1] * gg[1] * 256.f, x[2] * gg[2] * 256.f, x[3] * gg[3] * 256.f);
            pv[j] = pack4_fp8(y[0] * 32.f, y[1] * 32.f, y[2] * 32.f, y[3] * 32.f);
#endif
        }
        *(u32x4*)(ud + i * 4) = pu; *(u32x4*)(vd + i * 4) = pv;
    }
#endif
    bf16_t* pb = wsb(a, PB_OFF);
    const float* pp = a.p_prompt + (size_t)layer * TP * 256; const float* ps = a.p_sample + (size_t)layer * (T - TP) * 256;
    for (size_t i = gtid; i < (size_t)T * 256 / 4; i += gn) {
        const size_t e = i * 4; const f32x4 x = (e < (size_t)TP * 256) ? *(const f32x4*)(pp + e) : *(const f32x4*)(ps + (e - (size_t)TP * 256));
        u32x2 p; p.x = pack2(x[0], x[1]); p.y = pack2(x[2], x[3]); *(u32x2*)(pb + e) = p;
    }
}


typedef short bf16x8 __attribute__((ext_vector_type(8)));
typedef float f32x16 __attribute__((ext_vector_type(16)));
#define MFMA32(a, b, c) __builtin_amdgcn_mfma_f32_32x32x16_bf16((a), (b), (c), 0, 0, 0)
DEV bf16x8 pack_frag(float x0, float x1, float x2, float x3, float x4, float x5, float x6, float x7) {
    u32x4 p;
    asm volatile("v_cvt_pk_bf16_f32 %0, %4, %5\n\tv_cvt_pk_bf16_f32 %1, %6, %7\n\tv_cvt_pk_bf16_f32 %2, %8, %9\n\tv_cvt_pk_bf16_f32 %3, %10, %11\n\ts_nop 1"
                 : "=&v"(p[0]), "=&v"(p[1]), "=&v"(p[2]), "=&v"(p[3]) : "v"(x0), "v"(x1), "v"(x2), "v"(x3), "v"(x4), "v"(x5), "v"(x6), "v"(x7));
    return __builtin_bit_cast(bf16x8, p);
}
DEV void ph_attn3(const Args& a, int layer, unsigned char* ldsb, const int tid0) {
    const int lane = tid0 & 63, wv = __builtin_amdgcn_readfirstlane(tid0 >> 6), r = lane & 31, h = lane >> 5;
    unsigned char* OL = ldsb;
    float* MLl = (float*)(ldsb + 73728);
    unsigned char* vt = ldsb + 77824 + wv * 4608;
    const bf16_t* qkv = wsb(a, QKV_OFF);
    bf16_t* mix = wsb(a, MIX_OFF);
    const int i16 = lane & 15, tq = i16 >> 2, tp = i16 & 3, tblk = (lane >> 4) & 1;
    const unsigned tr_addr = (unsigned)(size_t)vt + (4 * h + tq) * 144 + 2 * (16 * tblk + 4 * tp);
    const float sc = 0.125f * 1.44269504f, NEG = -1.0e30f;
    for (int un = blockIdx.x; un < NSEQ * 8 * 8; un += gridDim.x) {
      const int sh = un >> 3, sp = un & 7, seq = sh >> 3, hd = sh & 7; const size_t tb = (size_t)seq * 4096;
      __syncthreads();
#pragma unroll 1
      for (int di = 0; di < 3; ++di) {
       bf16x8 qfN[4], kN[4], vN[4];
#pragma unroll
       for (int k2 = 0; k2 < 2; ++k2) {
        const int idx16 = wv * 2 + k2;
        const int sft = 2 * di, nlen = 4096 >> sft;
        const int rr = (di == 0) ? 0 : (di == 1 ? (idx16 >> 2) : idx16), cb = (di == 0) ? (16 * sp + idx16) : (di == 1 ? (4 * sp + (idx16 & 3)) : sp), cq0 = cb * 32;
        const size_t tokq = tb + ((size_t)(cq0 + r) << sft) + rr;
        const bf16_t* qp = qkv + tokq * 1536 + hd * 64 + 8 * h;
        bf16x8 qf[4];
#pragma unroll
        for (int s = 0; s < 4; ++s) qf[s] = (k2 == 1) ? qfN[s] : *(const bf16x8*)(qp + 16 * s);
        float m = NEG, l = 0.f;
        f32x16 O0, O1;
#pragma unroll
        for (int i = 0; i < 16; ++i) { O0[i] = 0.f; O1[i] = 0.f; }
        bf16x8 kfb[2][4], vfb[2][4];
#define ATT_LOAD(kt_) do { const int kb_ = cq0 - 64 + 32 * (kt_); const size_t tokk_ = tb + ((size_t)(kb_ + r) << sft) + rr; const bf16_t* kp_ = qkv + tokk_ * 1536 + 512 + hd * 64 + 8 * h; \
            _Pragma("unroll") for (int s_ = 0; s_ < 4; ++s_) { kfb[(kt_) & 1][s_] = *(const bf16x8*)(kp_ + 16 * s_); vfb[(kt_) & 1][s_] = *(const bf16x8*)(kp_ + 512 + 16 * s_); } } while (0)
        if (cq0 - 64 >= 0) {
            if (k2 == 1) {
#pragma unroll
                for (int s_ = 0; s_ < 4; ++s_) { kfb[0][s_] = kN[s_]; vfb[0][s_] = vN[s_]; }
            } else ATT_LOAD(0);
        }
#pragma unroll
        for (int kt = 0; kt < 5; ++kt) {
            const int kb = cq0 - 64 + 32 * kt;
            if (kt + 1 < 5) { const int kbn = kb + 32; if (kbn >= 0 && kbn < nlen) ATT_LOAD(kt + 1); }
            if (k2 == 0 && kt == 4) {
                const int ix1 = idx16 + 1;
                const int rr1 = (di == 0) ? 0 : (di == 1 ? (ix1 >> 2) : ix1), cb1 = (di == 0) ? (16 * sp + ix1) : (di == 1 ? (4 * sp + (ix1 & 3)) : sp), cq1 = cb1 * 32;
                const bf16_t* qp1 = qkv + (tb + ((size_t)(cq1 + r) << sft) + rr1) * 1536 + hd * 64 + 8 * h;
#pragma unroll
                for (int s_ = 0; s_ < 4; ++s_) qfN[s_] = *(const bf16x8*)(qp1 + 16 * s_);
                if (cq1 - 64 >= 0) {
                    const bf16_t* kp1 = qkv + (tb + ((size_t)(cq1 - 64 + r) << sft) + rr1) * 1536 + 512 + hd * 64 + 8 * h;
#pragma unroll
                    for (int s_ = 0; s_ < 4; ++s_) { kN[s_] = *(const bf16x8*)(kp1 + 16 * s_); vN[s_] = *(const bf16x8*)(kp1 + 512 + 16 * s_); }
                }
            }
            asm volatile("" ::: "memory");
            if (kb < 0 || kb >= nlen) continue;
            bf16x8 kf[4], vf[4];
#pragma unroll
            for (int s = 0; s < 4; ++s) { kf[s] = kfb[kt & 1][s]; vf[s] = vfb[kt & 1][s]; }
            f32x16 S;
#pragma unroll
            for (int i = 0; i < 16; ++i) S[i] = 0.f;
#pragma unroll
            for (int s = 0; s < 4; ++s) S = MFMA32(kf[s], qf[s], S);
            float lm = NEG;
#pragma unroll
            for (int i = 0; i < 16; ++i) {
                const int row = (i & 3) + 8 * (i >> 2) + 4 * h;
                float v = S[i] * sc;
                if (kt == 0) v = (row >= r) ? v : NEG;
                if (kt == 4) v = (row <= r) ? v : NEG;
                S[i] = v; lm = fmaxf(lm, v);
            }
            lm = fmaxf(lm, SHX(lm, 32));
            const float mn = fmaxf(m, lm), alpha = __builtin_amdgcn_exp2f(m - mn);
            m = mn; l *= alpha;
            float ps = 0.f;
#pragma unroll
            for (int i = 0; i < 16; ++i) { O0[i] *= alpha; O1[i] *= alpha; S[i] = __builtin_amdgcn_exp2f(S[i] - mn); ps += S[i]; }
            l += ps;
            const bf16x8 pb0 = pack_frag(S[0], S[1], S[2], S[3], S[4], S[5], S[6], S[7]);
            const bf16x8 pb1 = pack_frag(S[8], S[9], S[10], S[11], S[12], S[13], S[14], S[15]);
            asm volatile("" ::: "memory");
#pragma unroll
            for (int i = 0; i < 4; ++i) *(bf16x8*)(vt + r * 144 + 2 * (16 * i + 8 * h)) = vf[i];
            typedef short s16x4 __attribute__((ext_vector_type(4)));
            s16x4 t00l, t00h, t01l, t01h, t10l, t10h, t11l, t11h;
            asm volatile("s_waitcnt lgkmcnt(0)\n\t"
                         "ds_read_b64_tr_b16 %0, %8\n\tds_read_b64_tr_b16 %1, %8 offset:1152\n\t"
                         "ds_read_b64_tr_b16 %2, %8 offset:2304\n\tds_read_b64_tr_b16 %3, %8 offset:3456\n\t"
                         "ds_read_b64_tr_b16 %4, %8 offset:64\n\tds_read_b64_tr_b16 %5, %8 offset:1216\n\t"
                         "ds_read_b64_tr_b16 %6, %8 offset:2368\n\tds_read_b64_tr_b16 %7, %8 offset:3520\n\t"
                         "s_waitcnt lgkmcnt(0)"
                         : "=&v"(t00l), "=&v"(t00h), "=&v"(t01l), "=&v"(t01h), "=&v"(t10l), "=&v"(t10h), "=&v"(t11l), "=&v"(t11h) : "v"(tr_addr) : "memory");
            const bf16x8 a00 = __builtin_shufflevector(t00l, t00h, 0, 1, 2, 3, 4, 5, 6, 7), a01 = __builtin_shufflevector(t01l, t01h, 0, 1, 2, 3, 4, 5, 6, 7);
            const bf16x8 a10 = __builtin_shufflevector(t10l, t10h, 0, 1, 2, 3, 4, 5, 6, 7), a11 = __builtin_shufflevector(t11l, t11h, 0, 1, 2, 3, 4, 5, 6, 7);
            O0 = MFMA32(a00, pb0, O0); O1 = MFMA32(a10, pb0, O1);
            O0 = MFMA32(a01, pb1, O0); O1 = MFMA32(a11, pb1, O1);
            asm volatile("" ::: "memory");
        }
#undef ATT_LOAD
        l += SHX(l, 32);
        const int ql = (((cq0 + r) << sft) + rr) - 512 * sp;
        unsigned char* orow = OL + ql * 144 + 8 * h;
        float ao = 0.f, ap = 1.0f;
        if (di > 0) {
            const f32x2 mo = *(const f32x2*)(MLl + 2 * ql);
            const float mn = fmaxf(mo[0], m);
            ao = __builtin_amdgcn_exp2f(mo[0] - mn); ap = __builtin_amdgcn_exp2f(m - mn);
            l = ao * mo[1] + ap * l; m = mn;
        }
#pragma unroll
        for (int g = 0; g < 4; ++g) {
            f32x4 v0 = {O0[4 * g] * ap, O0[4 * g + 1] * ap, O0[4 * g + 2] * ap, O0[4 * g + 3] * ap}, v1 = {O1[4 * g] * ap, O1[4 * g + 1] * ap, O1[4 * g + 2] * ap, O1[4 * g + 3] * ap};
            if (di > 0) {
                const u32x2 o0 = *(const u32x2*)(orow + 16 * g), o1 = *(const u32x2*)(orow + 64 + 16 * g);
                v0[0] += ao * bflo(o0.x); v0[1] += ao * bfhi(o0.x); v0[2] += ao * bflo(o0.y); v0[3] += ao * bfhi(o0.y);
                v1[0] += ao * bflo(o1.x); v1[1] += ao * bfhi(o1.x); v1[2] += ao * bflo(o1.y); v1[3] += ao * bfhi(o1.y);
            }
            u32x2 p0, p1; p0.x = pack2(v0[0], v0[1]); p0.y = pack2(v0[2], v0[3]); p1.x = pack2(v1[0], v1[1]); p1.y = pack2(v1[2], v1[3]);
            *(u32x2*)(orow + 16 * g) = p0; *(u32x2*)(orow + 64 + 16 * g) = p1;
        }
        if (h == 0) { f32x2 ml; ml[0] = m; ml[1] = l; *(f32x2*)(MLl + 2 * ql) = ml; }
       }
       __syncthreads();
      }
      {
        const int ql = tid0;
        const float inv = __builtin_amdgcn_rcpf(MLl[2 * ql + 1]);
        float o[64]; float ss = 0.f;
#pragma unroll
        for (int c = 0; c < 8; ++c) {
            const u32x4 w4 = *(const u32x4*)(OL + ql * 144 + 16 * c);
#pragma unroll
            for (int i = 0; i < 4; ++i) { o[8 * c + 2 * i] = bflo(w4[i]) * inv; o[8 * c + 2 * i + 1] = bfhi(w4[i]) * inv; ss += o[8 * c + 2 * i] * o[8 * c + 2 * i] + o[8 * c + 2 * i + 1] * o[8 * c + 2 * i + 1]; }
        }
        const float rn = rsqrtf(ss * (1.0f / 64.0f) + 1e-6f);
        const float* gp = a.att_norm_g + layer * 512 + hd * 64;
        bf16_t* dst = mix + (tb + 512 * sp + ql) * 1024 + hd * 64;
#pragma unroll
        for (int c = 0; c < 8; ++c) {
            const f32x4 g0 = *(const f32x4*)(gp + 8 * c), g1 = *(const f32x4*)(gp + 8 * c + 4);
            u32x4 w4; w4.x = pack2(o[8 * c] * rn * g0[0], o[8 * c + 1] * rn * g0[1]); w4.y = pack2(o[8 * c + 2] * rn * g0[2], o[8 * c + 3] * rn * g0[3]);
            w4.z = pack2(o[8 * c + 4] * rn * g1[0], o[8 * c + 5] * rn * g1[1]); w4.w = pack2(o[8 * c + 6] * rn * g1[2], o[8 * c + 7] * rn * g1[3]);
            *(u32x4*)(dst + 8 * c) = w4;
        }
      }
    }
}

DEV float tanh_fast(float x) { return 1.0f - 2.0f * __builtin_amdgcn_rcpf(1.0f + __expf(2.0f * x)); }

DEV void ph_rwkv_prep1(const Args& a, int layer, unsigned char* ldsb, const int tid0) {
    const int lane = tid0 & 63, wv = __builtin_amdgcn_readfirstlane(tid0 >> 6), r = lane & 31, h = lane >> 5;
    const int gw = blockIdx.x * 8 + wv, nw = gridDim.x * 8;
    const int sub = wv & 1, ng = wv >> 1;
    const bf16_t* U = wsb(a, U_OFF);
    const float* sw = a.rwkv_shift + (size_t)layer * 3 * UC;
    const bf16_t* wl = wsb(a, WB_OFF + (size_t)layer * WB_LAYER + WB_LORA);
#pragma unroll 1
    for (int arr = 0; arr < 5; ++arr) {
        const int coff = (arr < 4) ? arr * 64 : 256, nk = (arr < 4) ? 4 : 8, kw = nk * 16, rsb = kw * 2 + 16;
        __syncthreads();
        {
            const bf16_t* wsrc = wl + (arr < 4 ? arr * 512 * 64 : 4 * 512 * 64);
            const int cpr = kw / 8;
            for (int i = tid0; i < 512 * cpr; i += NTHR) { const int row = i / cpr, c = i - row * cpr; *(u32x4*)(ldsb + row * rsb + c * 16) = *(const u32x4*)(wsrc + (size_t)row * kw + c * 8); }
        }
        __syncthreads();
        bf16_t* outb = wsb(a, arr == 0 ? WF_OFF : arr == 1 ? WB2_OFF : arr == 2 ? AF_OFF : arr == 3 ? AB_OFF : G_OFF);
        const float* bias = (arr < 2) ? a.rwkv_w0 + (layer * 2 + arr) * 512 : a.rwkv_a0 + (layer * 2 + (arr & 1)) * 512;
        f32x4 bvr[4][4];
#pragma unroll
        for (int q = 0; q < 4; ++q)
#pragma unroll
            for (int g = 0; g < 4; ++g) bvr[q][g] = *(const f32x4*)(bias + (ng * 4 + q) * 32 + 8 * g + 4 * h);
#pragma unroll 1
        for (int tile = blockIdx.x; tile < T / 64; tile += gridDim.x) {
            const int t = tile * 64 + sub * 32 + r, pos = t & 4095;
            const bool hp = pos > 0, hn = pos < 4095;
            const bf16_t* up = U + (size_t)t * UW + 1536 + 8 * h;
            bf16x8 xf[8];
#pragma unroll
            for (int s = 0; s < 8; ++s) {
                if (s < nk) {
                    const int col = coff + 16 * s;
                    const u32x4 c = *(const u32x4*)(up + col);
                    u32x4 p = {0u, 0u, 0u, 0u}, n = {0u, 0u, 0u, 0u};
                    if (hp) p = *(const u32x4*)(up - UW + col);
                    if (hn) n = *(const u32x4*)(up + UW + col);
                    const float* s0 = sw + 1536 + 8 * h + col;
                    const f32x4 wp0 = *(const f32x4*)(s0), wp1 = *(const f32x4*)(s0 + 4), wc0 = *(const f32x4*)(s0 + UC), wc1 = *(const f32x4*)(s0 + UC + 4), wn0 = *(const f32x4*)(s0 + 2 * UC), wn1 = *(const f32x4*)(s0 + 2 * UC + 4);
                    float v[8];
#pragma unroll
                    for (int i = 0; i < 4; ++i) {
                        const float a0 = (i < 2) ? wp0[2 * i] : wp1[2 * i - 4], a1 = (i < 2) ? wp0[2 * i + 1] : wp1[2 * i - 3];
                        const float b0 = (i < 2) ? wc0[2 * i] : wc1[2 * i - 4], b1 = (i < 2) ? wc0[2 * i + 1] : wc1[2 * i - 3];
                        const float c0 = (i < 2) ? wn0[2 * i] : wn1[2 * i - 4], c1 = (i < 2) ? wn0[2 * i + 1] : wn1[2 * i - 3];
                        v[2 * i] = a0 * bflo(p[i]) + b0 * bflo(c[i]) + c0 * bflo(n[i]);
                        v[2 * i + 1] = a1 * bfhi(p[i]) + b1 * bfhi(c[i]) + c1 * bfhi(n[i]);
                    }
                    if (arr < 2) {
#pragma unroll
                        for (int i = 0; i < 8; ++i) v[i] = tanh_fast(v[i]);
                    } else if (arr == 4) {
#pragma unroll
                        for (int i = 0; i < 8; ++i) v[i] = sigmoidf_(v[i]);
                    }
                    xf[s] = pack_frag(v[0], v[1], v[2], v[3], v[4], v[5], v[6], v[7]);
                }
            }
            bf16_t* out = outb + (size_t)t * 512 + 4 * h;
#pragma unroll
            for (int q = 0; q < 4; ++q) {
                const int nt = ng * 4 + q;
                f32x16 C;
#pragma unroll
                for (int i = 0; i < 16; ++i) C[i] = 0.f;
                const unsigned char* wr = ldsb + (nt * 32 + r) * rsb + 16 * h;
#pragma unroll
                for (int s = 0; s < 8; ++s) if (s < nk) { const bf16x8 A = *(const bf16x8*)(wr + 32 * s); C = MFMA32(A, xf[s], C); }
#pragma unroll
                for (int g = 0; g < 4; ++g) {
                    float o[4];
                    if (arr < 4) {
                        const f32x4 bv = bvr[q][g];
#pragma unroll
                        for (int j = 0; j < 4; ++j) { const float sg = sigmoidf_(C[4 * g + j] + bv[j]); o[j] = (arr < 2) ? __expf(-0.60653066f * sg) : sg; }
                    } else {
#pragma unroll
                        for (int j = 0; j < 4; ++j) o[j] = C[4 * g + j];
                    }
                    u32x2 pk; pk.x = pack2(o[0], o[1]); pk.y = pack2(o[2], o[3]);
                    *(u32x2*)(out + nt * 32 + 8 * g) = pk;
                }
            }
        }
    }
    {
        const int c16 = 16 * lane;
        bf16_t* dst = wsb(a, lane < 32 ? RS_OFF : KS_OFF) + (c16 & 511);
        float swp[16], swc[16], swn[16];
#pragma unroll
        for (int i = 0; i < 16; ++i) { swp[i] = sw[c16 + i]; swc[i] = sw[UC + c16 + i]; swn[i] = sw[2 * UC + c16 + i]; }
        for (int t0 = gw; t0 < T; t0 += 2 * nw) {
            u32x4 c[2][2], p[2][2], n[2][2];
#pragma unroll
            for (int k = 0; k < 2; ++k) {
                const int t = t0 + k * nw; const int pos = t & 4095; const bool hp = pos > 0, hn = pos < 4095;
                const bf16_t* up = U + (size_t)t * UW + c16;
#pragma unroll
                for (int q = 0; q < 2; ++q) {
                    c[k][q] = *(const u32x4*)(up + 8 * q); p[k][q] = (u32x4){0u, 0u, 0u, 0u}; n[k][q] = (u32x4){0u, 0u, 0u, 0u};
                    if (hp) p[k][q] = *(const u32x4*)(up - UW + 8 * q);
                    if (hn) n[k][q] = *(const u32x4*)(up + UW + 8 * q);
                }
            }
#pragma unroll
            for (int k = 0; k < 2; ++k) {
                const int t = t0 + k * nw;
                u32x4 o[2];
#pragma unroll
                for (int q = 0; q < 2; ++q)
#pragma unroll
                    for (int i = 0; i < 4; ++i) {
                        const int e = 8 * q + 2 * i;
                        const float lo = swp[e] * bflo(p[k][q][i]) + swc[e] * bflo(c[k][q][i]) + swn[e] * bflo(n[k][q][i]);
                        const float hi = swp[e + 1] * bfhi(p[k][q][i]) + swc[e + 1] * bfhi(c[k][q][i]) + swn[e + 1] * bfhi(n[k][q][i]);
                        o[q][i] = pack2(lo, hi);
                    }
                *(u32x4*)(dst + (size_t)t * 512) = o[0]; *(u32x4*)(dst + (size_t)t * 512 + 8) = o[1];
            }
        }
    }
}
DEV void ph_rwkv_prep2(const Args& a, int layer, const int tid0) {
    const int lane = tid0 & 63, wv = tid0 >> 6;
    const int gw = blockIdx.x * 8 + wv, nw = gridDim.x * 8;
    bf16_t* U = wsb(a, U_OFF); const bf16_t* KS = wsb(a, KS_OFF);
    const float* sw = a.rwkv_shift + (size_t)layer * 3 * UC;
    const int c8 = 8 * lane;
    float kkc[8], sv[3][8];
#pragma unroll
    for (int i = 0; i < 8; ++i) { kkc[i] = a.rwkv_k_k[layer * 512 + c8 + i]; sv[0][i] = sw[1024 + c8 + i]; sv[1][i] = sw[UC + 1024 + c8 + i]; sv[2][i] = sw[2 * UC + 1024 + c8 + i]; }
    for (int t = gw; t < T; t += nw) {
        const int pos = t & 4095; const bool hp = pos > 0, hn = pos < 4095;
        bf16_t* up = U + (size_t)t * UW;
        const u32x4 ks = *(const u32x4*)(KS + (size_t)t * 512 + c8);
        const u32x4 c = *(const u32x4*)(up + 1024 + c8);
        u32x4 p = {0u, 0u, 0u, 0u}, n = {0u, 0u, 0u, 0u};
        if (hp) p = *(const u32x4*)(up - UW + 1024 + c8);
        if (hn) n = *(const u32x4*)(up + UW + 1024 + c8);
        float kx[8]; float ss = 0.f;
#pragma unroll
        for (int i = 0; i < 4; ++i) { kx[2 * i] = bflo(ks[i]) * kkc[2 * i]; kx[2 * i + 1] = bfhi(ks[i]) * kkc[2 * i + 1]; ss += kx[2 * i] * kx[2 * i] + kx[2 * i + 1] * kx[2 * i + 1]; }
        const float inv = 1.0f / fmaxf(sqrtf(sum8(ss)), 1e-12f);
        u32x4 ko, vo;
#pragma unroll
        for (int i = 0; i < 4; ++i) {
            ko[i] = pack2(kx[2 * i] * inv, kx[2 * i + 1] * inv);
            vo[i] = pack2(sv[0][2 * i] * bflo(p[i]) + sv[1][2 * i] * bflo(c[i]) + sv[2][2 * i] * bflo(n[i]), sv[0][2 * i + 1] * bfhi(p[i]) + sv[1][2 * i + 1] * bfhi(c[i]) + sv[2][2 * i + 1] * bfhi(n[i]));
        }
        *(u32x4*)(up + c8) = ko; *(u32x4*)(up + 1536 + c8) = vo;
    }
}

DEV void ph_post2(const Args& a, int layer, const int tid0) {
    const int lane = tid0 & 63, wv = tid0 >> 6;
    const int gw = blockIdx.x * 8 + wv, nw = gridDim.x * 8;
    const bf16_t* U = wsb(a, U_OFF); const bf16_t* RS = wsb(a, RS_OFF); const bf16_t* KS = wsb(a, KS_OFF); const bf16_t* G = wsb(a, G_OFF);
    const bf16_t* AF = wsb(a, AF_OFF); const bf16_t* AB = wsb(a, AB_OFF); bf16_t* mix = wsb(a, MIX_OFF);
    const int c8 = 8 * lane;
    float kac[8], rkc[8], lnw[8], lnb[8];
#pragma unroll
    for (int i = 0; i < 8; ++i) { kac[i] = a.rwkv_k_a[layer * 512 + c8 + i]; rkc[i] = a.rwkv_r_k[layer * 512 + c8 + i]; lnw[i] = a.rwkv_ln_w[layer * 512 + c8 + i]; lnb[i] = a.rwkv_ln_b[layer * 512 + c8 + i]; }
    struct PostLd { u32x4 rp, kp, gp, afp, abp, yfp, ybp, vp; };
    for (int t0 = gw; t0 < T; t0 += 2 * nw) {
        PostLd L[2];
#pragma unroll
        for (int k = 0; k < 2; ++k) {
            const int t = t0 + k * nw; const bf16_t* up = U + (size_t)t * UW;
            L[k].rp = *(const u32x4*)(RS + (size_t)t * 512 + c8); L[k].kp = *(const u32x4*)(KS + (size_t)t * 512 + c8); L[k].gp = *(const u32x4*)(G + (size_t)t * 512 + c8);
            L[k].afp = *(const u32x4*)(AF + (size_t)t * 512 + c8); L[k].abp = *(const u32x4*)(AB + (size_t)t * 512 + c8);
            L[k].yfp = *(const u32x4*)(up + 512 + c8); L[k].ybp = *(const u32x4*)(up + 1024 + c8); L[k].vp = *(const u32x4*)(up + 1536 + c8);
        }
#pragma unroll
        for (int k = 0; k < 2; ++k) {
        const int t = t0 + k * nw;
        const u32x4 rp = L[k].rp, kp = L[k].kp, gp = L[k].gp, afp = L[k].afp, abp = L[k].abp, yfp = L[k].yfp, ybp = L[k].ybp, vp = L[k].vp;
        float y[8], rr[8], kk[8], vv[8], gg[8], sa[8];
#pragma unroll
        for (int i = 0; i < 4; ++i) {
            y[2 * i] = bflo(yfp[i]) + bflo(ybp[i]); y[2 * i + 1] = bfhi(yfp[i]) + bfhi(ybp[i]);
            rr[2 * i] = bflo(rp[i]); rr[2 * i + 1] = bfhi(rp[i]); kk[2 * i] = bflo(kp[i]); kk[2 * i + 1] = bfhi(kp[i]);
            vv[2 * i] = bflo(vp[i]); vv[2 * i + 1] = bfhi(vp[i]); gg[2 * i] = bflo(gp[i]); gg[2 * i + 1] = bfhi(gp[i]);
            sa[2 * i] = bflo(afp[i]) + bflo(abp[i]); sa[2 * i + 1] = bfhi(afp[i]) + bfhi(abp[i]);
        }
        float ysum = 0.f, bs = 0.f;
#pragma unroll
        for (int i = 0; i < 8; ++i) { ysum += y[i]; bs += rr[i] * kk[i] * (2.0f + (sa[i] - 2.0f) * kac[i]) * rkc[i]; }
        const float mu = sum8(ysum) * (1.0f / 64.0f);
        float vs = 0.f;
#pragma unroll
        for (int i = 0; i < 8; ++i) { y[i] -= mu; vs += y[i] * y[i]; }
        const float rstdv = rsqrtf(sum8(vs) * (1.0f / 64.0f) + 64e-5f);
        bs = sum8(bs);
        float o[8];
#pragma unroll
        for (int i = 0; i < 8; ++i) o[i] = (y[i] * rstdv * lnw[i] + lnb[i] + bs * vv[i]) * gg[i];
        u32x4 ov; ov.x = pack2(o[0], o[1]); ov.y = pack2(o[2], o[3]); ov.z = pack2(o[4], o[5]); ov.w = pack2(o[6], o[7]);
        *(u32x4*)(mix + (size_t)t * 1024 + 512 + c8) = ov;
        }
    }
}

#ifdef PROBE_EMASK
#define PEER_EM(e) (DRY ? ((e) & PROBE_EMASK) : (e))
#else
#define PEER_EM(e) (e)
#endif
template <bool DRY> DEV void ph_peer_pipe(const Args& a, const int tid0, const int gw, const int nw, const int ntok, const int* TOPI, const float* TOPG, const int tbase) {
    const int lane = tid0 & 63;
    bf16_t* hb = wsb(a, HB_OFF); float* rstd = wsf(a, RSTD_OFF); const float* ssq = wsf(a, SSQ_OFF);
    const unsigned char* PU = a.ws + PTU_OFF; const unsigned char* PV = a.ws + PTV_OFF;
    const int c16 = 16 * lane;
    const bool b5 = lane & 32, b4 = lane & 16, b3 = lane & 8;
    const bool dost = DRY ? (__builtin_amdgcn_readfirstlane(*(const int*)(a.ws + TOPI_OFF)) == -12345) : true;
    u32x4 ur[2][8], vr[8];
    int e0, e1, e0n = 0, e1n = 0; float g0, g1, g0n = 0.f, g1n = 0.f;
    u32x4 xa, xb, xan = {0u, 0u, 0u, 0u}, xbn = {0u, 0u, 0u, 0u}; float rsv, rsn = 0.f;
#define PEER_ISSUE_U(slot_, b_, es0_, es1_) do { _Pragma("unroll") for (int i_ = 0; i_ < 8; ++i_) { const int k_ = (b_) * 8 + i_; \
        const int e_ = PEER_EM(__builtin_amdgcn_readlane((k_ < 64) ? (es0_) : (es1_), k_ & 63)); ur[slot_][i_] = *(const u32x4*)(PU + (size_t)e_ * 1024 + c16); } } while (0)
#define PEER_ISSUE_V(slot_, b_, es0_, es1_) do { _Pragma("unroll") for (int i_ = 0; i_ < 8; ++i_) { const int k_ = (b_) * 8 + i_; \
        const int e_ = PEER_EM(__builtin_amdgcn_readlane((k_ < 64) ? (es0_) : (es1_), k_ & 63)); vr[i_] = *(const u32x4*)(PV + (size_t)e_ * 1024 + c16); } } while (0)
    if (ntok <= 0) return;
    {   const int t0 = gw;
        e0 = TOPI[(t0 - tbase) * 128 + lane]; e1 = TOPI[(t0 - tbase) * 128 + 64 + lane]; g0 = TOPG[(t0 - tbase) * 128 + lane]; g1 = TOPG[(t0 - tbase) * 128 + 64 + lane];
        xa = *(const u32x4*)(hb + (size_t)t0 * 1024 + c16); xb = *(const u32x4*)(hb + (size_t)t0 * 1024 + c16 + 8); rsv = rstd_parts(ssq, t0); }
    PEER_ISSUE_U(0, 0, e0, e1);
#pragma unroll 1
    for (int j = 0; j < ntok; ++j) {
        const int t = gw + nw * j; const bool more = (j + 1 < ntok);
        float* hr = a.h + (size_t)t * 1024 + c16;
        if (more) { const int tn = t + nw;
            e0n = TOPI[(tn - tbase) * 128 + lane]; e1n = TOPI[(tn - tbase) * 128 + 64 + lane]; }
        const float rs = rsv * (1.0f / 256.0f);
        float out[16];
#pragma unroll
        for (int i = 0; i < 16; ++i) out[i] = 0.f;
#pragma unroll 1
        for (int b2 = 0; b2 < 16; b2 += 2)
#pragma unroll
        for (int bb = 0; bb < 2; ++bb) {
            const int b = b2 + bb;
            PEER_ISSUE_V(0, b, e0, e1);
            if (bb == 0) PEER_ISSUE_U(1, b + 1, e0, e1);
            else if (b < 15) PEER_ISSUE_U(0, b + 1, e0, e1);
            else if (more) PEER_ISSUE_U(0, 0, e0n, e1n);
            asm volatile("" ::: "memory");
            float d[8];
#pragma unroll
            for (int i = 0; i < 8; ++i) {
                float sm = 0.f;
#pragma unroll
                for (int q = 0; q < 4; ++q) {
                    const unsigned uw = ur[bb][i][q];
                    const f32x2 lo = __builtin_amdgcn_cvt_pk_f32_fp8((int)uw, false), hi = __builtin_amdgcn_cvt_pk_f32_fp8((int)uw, true);
                    const unsigned ulo = pack2(lo[0], lo[1]), uhi = pack2(hi[0], hi[1]);
                    const unsigned xlo = (q < 2) ? xa[2 * q] : xb[2 * q - 4], xhi = (q < 2) ? xa[2 * q + 1] : xb[2 * q - 3];
                    sm = dot2bf(ulo, xlo, sm); sm = dot2bf(uhi, xhi, sm);
                }
                d[i] = sm;
            }
            float r4[4], r2[2];
#pragma unroll
            for (int i = 0; i < 4; ++i) { const float send = b5 ? d[i] : d[4 + i], keep = b5 ? d[4 + i] : d[i]; r4[i] = keep + SHX(send, 32); }
#pragma unroll
            for (int i = 0; i < 2; ++i) { const float send = b4 ? r4[i] : r4[2 + i], keep = b4 ? r4[2 + i] : r4[i]; r2[i] = keep + SHX(send, 16); }
            const float send1 = b3 ? r2[0] : r2[1], keep1 = b3 ? r2[1] : r2[0];
            const float dd = sum8(keep1 + SHX(send1, 8));
            const float hp = rs * dd;
            const float gt = SHF((b < 8) ? g0 : g1, (b * 8 + (lane >> 3)) & 63);
            const float w = gt * 0.5f * hp * (1.0f + erff(hp * 0.70710678f)) * (1.0f / 32.0f);
#pragma unroll
            for (int i = 0; i < 8; ++i) {
                const float wi = rl(w, 8 * i);
#pragma unroll
                for (int q = 0; q < 4; ++q) {
                    const unsigned vw = vr[i][q];
                    const f32x2 lo = __builtin_amdgcn_cvt_pk_f32_fp8((int)vw, false), hi = __builtin_amdgcn_cvt_pk_f32_fp8((int)vw, true);
                    out[4 * q] += wi * lo[0]; out[4 * q + 1] += wi * lo[1]; out[4 * q + 2] += wi * hi[0]; out[4 * q + 3] += wi * hi[1];
                }
            }
        }
        if (more) { const int tn = t + nw;
            g0n = TOPG[(tn - tbase) * 128 + lane]; g1n = TOPG[(tn - tbase) * 128 + 64 + lane];
            xan = *(const u32x4*)(hb + (size_t)tn * 1024 + c16); xbn = *(const u32x4*)(hb + (size_t)tn * 1024 + c16 + 8); rsn = rstd_parts(ssq, tn); }
        float ss = 0.f;
        f32x4 hv[4];
#pragma unroll
        for (int q = 0; q < 4; ++q) hv[q] = *(const f32x4*)(hr + 4 * q);
#pragma unroll
        for (int q = 0; q < 4; ++q) {
#pragma unroll
            for (int c = 0; c < 4; ++c) { hv[q][c] += out[4 * q + c]; ss += hv[q][c] * hv[q][c]; }
            if (dost) *(f32x4*)(hr + 4 * q) = hv[q];
        }
        ss = wave_sum(ss);
        if (dost) {
            u32x4 p0, p1;
            p0.x = pack2(hv[0][0], hv[0][1]); p0.y = pack2(hv[0][2], hv[0][3]); p0.z = pack2(hv[1][0], hv[1][1]); p0.w = pack2(hv[1][2], hv[1][3]);
            p1.x = pack2(hv[2][0], hv[2][1]); p1.y = pack2(hv[2][2], hv[2][3]); p1.z = pack2(hv[3][0], hv[3][1]); p1.w = pack2(hv[3][2], hv[3][3]);
            *(u32x4*)(hb + (size_t)t * 1024 + c16) = p0; *(u32x4*)(hb + (size_t)t * 1024 + c16 + 8) = p1;
            if (lane == 0) rstd[t] = rsqrtf(ss * (1.0f / 1024.0f) + 1e-6f);
        }
        e0 = e0n; e1 = e1n; g0 = g0n; g1 = g1n; xa = xan; xb = xbn; rsv = rsn;
    }
#undef PEER_ISSUE_U
#undef PEER_ISSUE_V
}


#if PEER_FP4
DEV void ph_peer_pipe4(const Args& a, const int tid0, const int gw, const int nw, const int ntok, const int* TOPI, const float* TOPG, const int tbase) {
    const int lane = tid0 & 63;
    bf16_t* hb = wsb(a, HB_OFF); float* rstd = wsf(a, RSTD_OFF); const float* ssq = wsf(a, SSQ_OFF);
    const unsigned char* PU = a.ws + PTU_OFF; const unsigned char* PV = a.ws + PTV_OFF;
    const int c16 = 16 * lane, c8 = 8 * lane;
    const bool b5 = lane & 32, b4 = lane & 16, b3 = lane & 8;
    u32x2 ur[2][16], vr[16];
    int e0, e1, e0n = 0, e1n = 0; float g0, g1, g0n = 0.f, g1n = 0.f;
    u32x4 xa, xb, xan = {0u, 0u, 0u, 0u}, xbn = {0u, 0u, 0u, 0u}; float rsv, rsn = 0.f;
#define PEER_ISSUE_U(slot_, b_, es0_, es1_) do { _Pragma("unroll") for (int i_ = 0; i_ < 16; ++i_) { const int k_ = (b_) * 16 + i_; \
        const int e_ = __builtin_amdgcn_readlane((k_ < 64) ? (es0_) : (es1_), k_ & 63); ur[slot_][i_] = *(const u32x2*)(PU + (size_t)e_ * 512 + c8); } } while (0)
#define PEER_ISSUE_V(b_, es0_, es1_) do { _Pragma("unroll") for (int i_ = 0; i_ < 16; ++i_) { const int k_ = (b_) * 16 + i_; \
        const int e_ = __builtin_amdgcn_readlane((k_ < 64) ? (es0_) : (es1_), k_ & 63); vr[i_] = *(const u32x2*)(PV + (size_t)e_ * 512 + c8); } } while (0)
    if (ntok <= 0) return;
    {   const int t0 = gw;
        e0 = TOPI[(t0 - tbase) * 128 + lane]; e1 = TOPI[(t0 - tbase) * 128 + 64 + lane]; g0 = TOPG[(t0 - tbase) * 128 + lane]; g1 = TOPG[(t0 - tbase) * 128 + 64 + lane];
        xa = *(const u32x4*)(hb + (size_t)t0 * 1024 + c16); xb = *(const u32x4*)(hb + (size_t)t0 * 1024 + c16 + 8); rsv = rstd_parts(ssq, t0); }
    PEER_ISSUE_U(0, 0, e0, e1);
#pragma unroll 1
    for (int j = 0; j < ntok; ++j) {
        const int t = gw + nw * j; const bool more = (j + 1 < ntok);
        float* hr = a.h + (size_t)t * 1024 + c16;
        if (more) { const int tn = t + nw;
            e0n = TOPI[(tn - tbase) * 128 + lane]; e1n = TOPI[(tn - tbase) * 128 + 64 + lane]; }
        const float rs = rsv * (1.0f / PEER_USC);
        f32x2 out[8];
#pragma unroll
        for (int i = 0; i < 8; ++i) out[i] = (f32x2){0.f, 0.f};
#pragma unroll 1
        for (int b2 = 0; b2 < 8; b2 += 2)
#pragma unroll
        for (int bb = 0; bb < 2; ++bb) {
            const int b = b2 + bb;
            PEER_ISSUE_V(b, e0, e1);
            if (bb == 0) PEER_ISSUE_U(1, b + 1, e0, e1);
            else if (b < 7) PEER_ISSUE_U(0, b + 1, e0, e1);
            else if (more) PEER_ISSUE_U(0, 0, e0n, e1n);
            asm volatile("" ::: "memory");
            float w2[2];
#pragma unroll
            for (int hf = 0; hf < 2; ++hf) {
                float d[8];
#pragma unroll
                for (int i = 0; i < 8; ++i) {
                    float sm = 0.f;
#pragma unroll
                    for (int q = 0; q < 2; ++q) {
                        const unsigned uw = ur[bb][hf * 8 + i][q]; const u32x4 xq = (q == 0) ? xa : xb;
#define PEER_UD(sb_) sm = dot2bf(__builtin_bit_cast(unsigned, __builtin_amdgcn_cvt_scalef32_pk_bf16_fp4(uw, 1.0f, sb_)), xq[sb_], sm)
                        PEER_UD(0); PEER_UD(1); PEER_UD(2); PEER_UD(3);
#undef PEER_UD
                    }
                    d[i] = sm;
                }
                float r4[4], r2[2];
#pragma unroll
                for (int i = 0; i < 4; ++i) { const float send = b5 ? d[i] : d[4 + i], keep = b5 ? d[4 + i] : d[i]; r4[i] = keep + SHX(send, 32); }
#pragma unroll
                for (int i = 0; i < 2; ++i) { const float send = b4 ? r4[i] : r4[2 + i], keep = b4 ? r4[2 + i] : r4[i]; r2[i] = keep + SHX(send, 16); }
                const float send1 = b3 ? r2[0] : r2[1], keep1 = b3 ? r2[1] : r2[0];
                const float dd = sum8(keep1 + SHX(send1, 8));
                const float hp = rs * dd;
                const float gt = SHF((b < 4) ? g0 : g1, (b * 16 + hf * 8 + (lane >> 3)) & 63);
                w2[hf] = gt * 0.5f * hp * (1.0f + erff(hp * 0.70710678f)) * (1.0f / PEER_VSC);
            }
#pragma unroll
            for (int i = 0; i < 16; ++i) {
                const float wi = rl(w2[i >> 3], 8 * (i & 7));
                const f32x2 wv2 = {wi, wi};
#pragma unroll
                for (int q = 0; q < 2; ++q) {
                    const unsigned vw = vr[i][q];
#define PEER_VA(sb_) out[q * 4 + sb_] = __builtin_elementwise_fma(__builtin_amdgcn_cvt_scalef32_pk_f32_fp4(vw, 1.0f, sb_), wv2, out[q * 4 + sb_])
                    PEER_VA(0); PEER_VA(1); PEER_VA(2); PEER_VA(3);
#undef PEER_VA
                }
            }
        }
        if (more) { const int tn = t + nw;
            g0n = TOPG[(tn - tbase) * 128 + lane]; g1n = TOPG[(tn - tbase) * 128 + 64 + lane];
            xan = *(const u32x4*)(hb + (size_t)tn * 1024 + c16); xbn = *(const u32x4*)(hb + (size_t)tn * 1024 + c16 + 8); rsn = rstd_parts(ssq, tn); }
        float ss = 0.f;
        f32x4 hv[4];
#pragma unroll
        for (int q = 0; q < 4; ++q) hv[q] = *(const f32x4*)(hr + 4 * q);
#pragma unroll
        for (int q = 0; q < 4; ++q) {
#pragma unroll
            for (int c = 0; c < 4; ++c) { hv[q][c] += out[2 * q + (c >> 1)][c & 1]; ss += hv[q][c] * hv[q][c]; }
            *(f32x4*)(hr + 4 * q) = hv[q];
        }
        ss = wave_sum(ss);
        {
            u32x4 p0, p1;
            p0.x = pack2(hv[0][0], hv[0][1]); p0.y = pack2(hv[0][2], hv[0][3]); p0.z = pack2(hv[1][0], hv[1][1]); p0.w = pack2(hv[1][2], hv[1][3]);
            p1.x = pack2(hv[2][0], hv[2][1]); p1.y = pack2(hv[2][2], hv[2][3]); p1.z = pack2(hv[3][0], hv[3][1]); p1.w = pack2(hv[3][2], hv[3][3]);
            *(u32x4*)(hb + (size_t)t * 1024 + c16) = p0; *(u32x4*)(hb + (size_t)t * 1024 + c16 + 8) = p1;
            if (lane == 0) rstd[t] = rsqrtf(ss * (1.0f / 1024.0f) + 1e-6f);
        }
        e0 = e0n; e1 = e1n; g0 = g0n; g1 = g1n; xa = xan; xb = xbn; rsv = rsn;
    }
#undef PEER_ISSUE_U
#undef PEER_ISSUE_V
}
#define PEER_PIPE(...) ph_peer_pipe4(__VA_ARGS__)
#else
#define PEER_PIPE(...) ph_peer_pipe<false>(__VA_ARGS__)
#endif


#if PEER_MX
typedef int i32x8 __attribute__((ext_vector_type(8)));
#define MXF(A_, B_, C_) __builtin_amdgcn_mfma_scale_f32_16x16x128_f8f6f4((A_), (B_), (C_), 4, 4, 0, 0x7F7F7F7F, 0, 0x7F7F7F7F)
#define MXFS(A_, B_, C_, SB_) __builtin_amdgcn_mfma_scale_f32_16x16x128_f8f6f4((A_), (B_), (C_), 4, 4, 0, 0x7F7F7F7F, 0, (SB_))
#define MX8(v_) ((i32x8){(int)(v_).x, (int)(v_).y, (int)(v_).z, (int)(v_).w, 0, 0, 0, 0})
namespace mx { constexpr int U0 = 0, VB = 16384, XQ = 49152, WF = 50176, WL = 51200, BASE = 57344; constexpr float XSC = 1.5f; }
DEV int mx_sw(int r) { return ((r & 3) << 2) | (r >> 2); }
#define MX_Q2(d1_, d2_, va_, vb_, sel_) do { d1_ = __builtin_amdgcn_cvt_scalef32_pk_fp4_f32(d1_, (va_), (vb_), 1.0f, sel_); const f32x2 q_ = __builtin_amdgcn_cvt_scalef32_pk_f32_fp4(d1_, 1.0f, sel_); \
        d2_ = __builtin_amdgcn_cvt_scalef32_pk_fp4_f32(d2_, ((va_) - q_[0]) * 8.0f, ((vb_) - q_[1]) * 8.0f, 1.0f, sel_); } while (0)
#define MX_Q3(d1_, d2_, d3_, va_, vb_, sel_) do { d1_ = __builtin_amdgcn_cvt_scalef32_pk_fp4_f32(d1_, (va_), (vb_), 1.0f, sel_); const f32x2 q_ = __builtin_amdgcn_cvt_scalef32_pk_f32_fp4(d1_, 1.0f, sel_); \
        const float ra_ = ((va_) - q_[0]) * 8.0f, rb_ = ((vb_) - q_[1]) * 8.0f; d2_ = __builtin_amdgcn_cvt_scalef32_pk_fp4_f32(d2_, ra_, rb_, 1.0f, sel_); const f32x2 p_ = __builtin_amdgcn_cvt_scalef32_pk_f32_fp4(d2_, 1.0f, sel_); \
        d3_ = __builtin_amdgcn_cvt_scalef32_pk_fp4_f32(d3_, (ra_ - p_[0]) * 8.0f, (rb_ - p_[1]) * 8.0f, 1.0f, sel_); } while (0)
DEV void ph_peer_mx(const Args& a, const int tid0, const int t0, const int tstride, const int ntok, const int* EL, const float* GL, const int tbase, PG8_LAS unsigned char* wl, unsigned char* wg) {
    const int lane = tid0 & 63, r = lane & 15, kq = lane >> 4;
    bf16_t* hb = wsb(a, HB_OFF); float* rstd = wsf(a, RSTD_OFF); const float* ssq = wsf(a, SSQ_OFF);
    const unsigned char* PU = a.ws + PTU_OFF; const unsigned char* PV = a.ws + PTV_OFF;
    const int c16 = 16 * lane;
#pragma unroll 1
    for (int j = 0; j < ntok; ++j) {
        const int t = t0 + tstride * j;
        const int* el = EL + (t - tbase) * 128; const float* gl = GL + (t - tbase) * 128;
        {   const u32x4 xa = *(const u32x4*)(hb + (size_t)t * 1024 + c16), xb = *(const u32x4*)(hb + (size_t)t * 1024 + c16 + 8);
            const float sc = rstd_parts(ssq, t) * mx::XSC;
            u32x2 q1 = {0u, 0u}, q2 = {0u, 0u};
            MX_Q2(q1.x, q2.x, bflo(xa.x) * sc, bfhi(xa.x) * sc, 0); MX_Q2(q1.x, q2.x, bflo(xa.y) * sc, bfhi(xa.y) * sc, 1); MX_Q2(q1.x, q2.x, bflo(xa.z) * sc, bfhi(xa.z) * sc, 2); MX_Q2(q1.x, q2.x, bflo(xa.w) * sc, bfhi(xa.w) * sc, 3);
            MX_Q2(q1.y, q2.y, bflo(xb.x) * sc, bfhi(xb.x) * sc, 0); MX_Q2(q1.y, q2.y, bflo(xb.y) * sc, bfhi(xb.y) * sc, 1); MX_Q2(q1.y, q2.y, bflo(xb.z) * sc, bfhi(xb.z) * sc, 2); MX_Q2(q1.y, q2.y, bflo(xb.w) * sc, bfhi(xb.w) * sc, 3);
            *(u32x2*)(wg + mx::XQ + 8 * lane) = q1; *(u32x2*)(wg + mx::XQ + 512 + 8 * lane) = q2; }
        u32x4 xB1[8], xB2[8];
#pragma unroll
        for (int s = 0; s < 8; ++s) { xB1[s] = *(const u32x4*)(wg + mx::XQ + 64 * s + 16 * kq); xB2[s] = *(const u32x4*)(wg + mx::XQ + 512 + 64 * s + 16 * kq); }
#pragma unroll 1
        for (int g = 0; g < 8; ++g) {
#pragma unroll
            for (int m = 0; m < 8; ++m) {
                const int row = 2 * m + (lane >> 5); const int e = el[16 * g + row];
                const unsigned char* gp = PU + (size_t)e * 512 + (((lane & 31) ^ mx_sw(row)) * 16);
                __builtin_amdgcn_global_load_lds((const unsigned*)gp, (PG8_LAS unsigned*)(wl + mx::U0 + m * 1024), 16, 0, 0);
            }
            asm volatile("s_waitcnt vmcnt(0)" ::: "memory");
            f32x4 acc1 = {0.f, 0.f, 0.f, 0.f}, acc2 = {0.f, 0.f, 0.f, 0.f};
#pragma unroll
            for (int s = 0; s < 8; ++s) {
                const u32x4 a4 = *(const u32x4*)(wg + mx::U0 + r * 512 + (((4 * s + kq) ^ mx_sw(r)) * 16));
                acc1 = MXF(MX8(a4), MX8(xB1[s]), acc1); acc2 = MXF(MX8(a4), MX8(xB2[s]), acc2);
            }
            const f32x4 gt = *(const f32x4*)(gl + 16 * g + 4 * kq);
            f32x4 w;
#pragma unroll
            for (int i2 = 0; i2 < 4; ++i2) { const float hp = (acc1[i2] + 0.125f * acc2[i2]) * (1.0f / (PEER_USC * mx::XSC)); w[i2] = gt[i2] * 0.5f * hp * (1.0f + erff(hp * 0.70710678f)); }
            if (r == 0) *(f32x4*)(wg + mx::WF + (16 * g + 4 * kq) * 4) = w;
            asm volatile("" ::: "memory");
        }
        float wmx = fmaxf(fabsf(*(const float*)(wg + mx::WF + 4 * lane)), fabsf(*(const float*)(wg + mx::WF + 256 + 4 * lane)));
        wmx = wave_max(wmx);
        const float wS = (wmx > 0.f) ? 4.0f * __builtin_amdgcn_rcpf(wmx) : 0.f, wIS = wmx * 0.25f * (1.0f / PEER_VSC);
        u32x4 wB1 = {0u, 0u, 0u, 0u}, wB2 = wB1, wB3 = wB1;
#pragma unroll
        for (int q = 0; q < 4; ++q) {
            const f32x4 w0 = *(const f32x4*)(wg + mx::WF + 128 * kq + 32 * q), w1 = *(const f32x4*)(wg + mx::WF + 128 * kq + 32 * q + 16);
            MX_Q3(wB1[q], wB2[q], wB3[q], w0[0] * wS, w0[1] * wS, 0); MX_Q3(wB1[q], wB2[q], wB3[q], w0[2] * wS, w0[3] * wS, 1);
            MX_Q3(wB1[q], wB2[q], wB3[q], w1[0] * wS, w1[1] * wS, 2); MX_Q3(wB1[q], wB2[q], wB3[q], w1[2] * wS, w1[3] * wS, 3);
        }
        float ss = 0.f;
#if !PEER_MXV
        {   f32x2 out[8];
#pragma unroll
            for (int i2 = 0; i2 < 8; ++i2) out[i2] = (f32x2){0.f, 0.f};
#pragma unroll 1
            for (int k = 0; k < 128; ++k) {
                const int e = el[k]; const u32x2 vw2 = *(const u32x2*)(PV + (size_t)e * 512 + 8 * lane);
                const float wi = *(const float*)(wg + mx::WF + 4 * k) * (1.0f / PEER_VSC); const f32x2 wv2 = {wi, wi};
#define PEER_VA(q_, sb_) out[q_ * 4 + sb_] = __builtin_elementwise_fma(__builtin_amdgcn_cvt_scalef32_pk_f32_fp4(vw2[q_], 1.0f, sb_), wv2, out[q_ * 4 + sb_])
                PEER_VA(0, 0); PEER_VA(0, 1); PEER_VA(0, 2); PEER_VA(0, 3); PEER_VA(1, 0); PEER_VA(1, 1); PEER_VA(1, 2); PEER_VA(1, 3);
#undef PEER_VA
            }
            float* hr = a.h + (size_t)t * 1024 + c16;
            f32x4 hv[4];
#pragma unroll
            for (int q = 0; q < 4; ++q) hv[q] = *(const f32x4*)(hr + 4 * q);
#pragma unroll
            for (int q = 0; q < 4; ++q) {
#pragma unroll
                for (int c = 0; c < 4; ++c) { hv[q][c] += out[2 * q + (c >> 1)][c & 1]; ss += hv[q][c] * hv[q][c]; }
                *(f32x4*)(hr + 4 * q) = hv[q];
            }
            u32x4 p0, p1;
            p0.x = pack2(hv[0][0], hv[0][1]); p0.y = pack2(hv[0][2], hv[0][3]); p0.z = pack2(hv[1][0], hv[1][1]); p0.w = pack2(hv[1][2], hv[1][3]);
            p1.x = pack2(hv[2][0], hv[2][1]); p1.y = pack2(hv[2][2], hv[2][3]); p1.z = pack2(hv[3][0], hv[3][1]); p1.w = pack2(hv[3][2], hv[3][3]);
            *(u32x4*)(hb + (size_t)t * 1024 + c16) = p0; *(u32x4*)(hb + (size_t)t * 1024 + c16 + 8) = p1;
        }
#else
#pragma unroll 1
        for (int hf = 0; hf < 2; ++hf) {
#pragma unroll 1
            for (int m4 = 0; m4 < 32; m4 += 4)
#pragma unroll
            for (int mm = 0; mm < 4; ++mm) {
                const int m = m4 + mm;
                const int ei = 4 * m + (lane >> 4); const int e = el[ei];
                const unsigned char* gp = PV + (size_t)e * 512 + ((hf * 16 + ((lane & 15) ^ (ei & 15))) * 16);
                __builtin_amdgcn_global_load_lds((const unsigned*)gp, (PG8_LAS unsigned*)(wl + mx::VB + m * 1024), 16, 0, 0);
            }
            asm volatile("s_waitcnt vmcnt(0)" ::: "memory");
#pragma unroll 1
            for (int cg = 0; cg < 2; ++cg) {
                f32x4 keep = {0.f, 0.f, 0.f, 0.f};
#pragma unroll
                for (int cb16 = 0; cb16 < 16; ++cb16) {
                    const int cb = cg * 16 + cb16;
                    const unsigned ad = (unsigned)(size_t)(wg + mx::VB) + (32 * kq + r) * 256 + (((cb >> 1) ^ r) * 16) + (cb & 1) * 8;
                    u32x2 lo, hi;
                    asm volatile("ds_read_b64_tr_b4 %0, %2\n\tds_read_b64_tr_b4 %1, %2 offset:4096\n\ts_waitcnt lgkmcnt(0)" : "=&v"(lo), "=&v"(hi) : "v"(ad) : "memory");
                    const i32x8 A8 = {(int)lo.x, (int)lo.y, (int)hi.x, (int)hi.y, 0, 0, 0, 0};
                    const f32x4 z = {0.f, 0.f, 0.f, 0.f};
                    const f32x4 d1 = MXF(A8, MX8(wB1), z), d2 = MXF(A8, MX8(wB2), z), d3 = MXF(A8, MX8(wB3), z);
                    const bool mine = (r == cb16);
#pragma unroll
                    for (int i2 = 0; i2 < 4; ++i2) keep[i2] = mine ? (d1[i2] + 0.125f * (d2[i2] + 0.125f * d3[i2])) : keep[i2];
                }
                const int c0 = hf * 512 + cg * 256 + 16 * r + 4 * kq;
                float* hr = a.h + (size_t)t * 1024 + c0;
                f32x4 hv = *(const f32x4*)hr;
#pragma unroll
                for (int i2 = 0; i2 < 4; ++i2) { hv[i2] += keep[i2] * wIS; ss += hv[i2] * hv[i2]; }
                *(f32x4*)hr = hv;
                u32x2 pk; pk.x = pack2(hv[0], hv[1]); pk.y = pack2(hv[2], hv[3]);
                *(u32x2*)(hb + (size_t)t * 1024 + c0) = pk;
            }
            asm volatile("" ::: "memory");
        }
#endif
        ss = wave_sum(ss);
        if (lane == 0) rstd[t] = rsqrtf(ss * (1.0f / 1024.0f) + 1e-6f);
        asm volatile("s_waitcnt vmcnt(0) lgkmcnt(0)" ::: "memory");
    }
}
#endif

#if PEER_MX == 2
#ifndef MXN
#define MXN 7
#endif
namespace mx2 { constexpr int XQ = MXN * 8192, WF = XQ + 1024, XR = XQ + 2048, HR = XQ + 4096, WL = XQ + 8192, BASE = 29696; }
static_assert(mx2::BASE + 2 * mx2::WL <= LDS_BYTES - 16, "LDS budget of the expert phase");
#define MX_WAIT(n_) asm volatile("s_waitcnt vmcnt(" #n_ ")" ::: "memory")
DEV void mx_ids(const int c, const int* el, const int lane, int (&e)[8]) {
    const int* p = (c < 8) ? el + 16 * c + (lane >> 5) : el + 32 * ((c - 8) & 3) + (lane >> 4);
    const int st = (c < 8) ? 2 : 4;
#pragma unroll
    for (int m = 0; m < 8; ++m) e[m] = p[st * m] & 16383;
}
DEV void mx_dma(const int c, const int (&e)[8], const int lane, const unsigned char* PU, const unsigned char* PV, PG8_LAS unsigned char* wl, int& slot) {
    PG8_LAS unsigned char* dst = wl + slot * 8192;
    if (c < 8) {
#pragma unroll
        for (int m = 0; m < 8; ++m) {
            const int row = 2 * m + (lane >> 5);
            const unsigned char* gp = PU + (size_t)e[m] * 512 + (((lane & 31) ^ mx_sw(row)) * 16);
            __builtin_amdgcn_global_load_lds((const unsigned*)gp, (PG8_LAS unsigned*)(dst + m * 1024), 16, 0, 0);
        }
    } else {
        const int hf = (c - 8) >> 2;
#pragma unroll
        for (int m = 0; m < 8; ++m) {
            const int li = 4 * m + (lane >> 4);
            const unsigned char* gp = PV + (size_t)e[m] * 512 + ((hf * 16 + ((lane & 15) ^ (li & 15))) * 16);
            __builtin_amdgcn_global_load_lds((const unsigned*)gp, (PG8_LAS unsigned*)(dst + m * 1024), 16, 0, 0);
        }
    }
    slot = (slot + 1 == MXN) ? 0 : slot + 1;
}
DEV void mx_dma_x(const bf16_t* hb, const int t, const int lane, PG8_LAS unsigned char* wl) {
#pragma unroll
    for (int i = 0; i < 2; ++i) __builtin_amdgcn_global_load_lds((const unsigned*)((const unsigned char*)hb + (size_t)t * 2048 + i * 1024 + lane * 16), (PG8_LAS unsigned*)(wl + mx2::XR + i * 1024), 16, 0, 0);
}
DEV void mx_dma_h(const float* h, const int t, const int lane, PG8_LAS unsigned char* wl) {
#pragma unroll
    for (int i = 0; i < 4; ++i) __builtin_amdgcn_global_load_lds((const unsigned*)((const unsigned char*)h + (size_t)t * 4096 + i * 1024 + lane * 16), (PG8_LAS unsigned*)(wl + mx2::HR + i * 1024), 16, 0, 0);
}
DEV float mx_erf(float x) { const float ax = fabsf(x), t = __builtin_amdgcn_rcpf(1.0f + 0.3275911f * ax);
    const float pl = ((((1.061405429f * t - 1.453152027f) * t + 1.421413741f) * t - 0.284496736f) * t + 0.254829592f) * t;
    return copysignf(1.0f - pl * __expf(-ax * ax), x); }
DEV void ph_peer_mx2(const Args& a, const int tid0, const int t0, const int tstride, const int ntok, const int* EL, const float* RL, const int tbase, PG8_LAS unsigned char* wl, unsigned char* wg) {
    const int lane = tid0 & 63, r = lane & 15, kq = lane >> 4, ri = r & 3;
    bf16_t* hb = wsb(a, HB_OFF); float* rstd = wsf(a, RSTD_OFF);
    const unsigned char* PU = a.ws + PTU_OFF; const unsigned char* PV = a.ws + PTV_OFF;
    if (ntok <= 0) return;
    __builtin_amdgcn_s_setprio(PEER_PRIO);
    int islot = 0, cslot = 0;
    {   const int* el0 = EL + (t0 - tbase) * 128;
        mx_dma_x(hb, t0, lane, wl);
#pragma unroll 1
        for (int c = 0; c < MXN; ++c) { int e[8]; mx_ids(c, el0, lane, e); mx_dma(c, e, lane, PU, PV, wl, islot); }
        mx_dma_h(a.h, t0, lane, wl); }
#pragma unroll 1
    for (int j = 0; j < ntok; ++j) {
        const int t = t0 + tstride * j; const bool more = (j + 1 < ntok);
        const int* el = EL + (t - tbase) * 128; const int* eln = el + tstride * 128;
        if (j == 0) MX_WAIT(56); else MX_WAIT(32);
        {   const u32x4 xa = *(const u32x4*)(wg + mx2::XR + 32 * lane), xb = *(const u32x4*)(wg + mx2::XR + 32 * lane + 16);
            const float sc = RL[t - tbase] * mx::XSC;
            u32x2 q1 = {0u, 0u}, q2 = {0u, 0u};
            MX_Q2(q1.x, q2.x, bflo(xa.x) * sc, bfhi(xa.x) * sc, 0); MX_Q2(q1.x, q2.x, bflo(xa.y) * sc, bfhi(xa.y) * sc, 1); MX_Q2(q1.x, q2.x, bflo(xa.z) * sc, bfhi(xa.z) * sc, 2); MX_Q2(q1.x, q2.x, bflo(xa.w) * sc, bfhi(xa.w) * sc, 3);
            MX_Q2(q1.y, q2.y, bflo(xb.x) * sc, bfhi(xb.x) * sc, 0); MX_Q2(q1.y, q2.y, bflo(xb.y) * sc, bfhi(xb.y) * sc, 1); MX_Q2(q1.y, q2.y, bflo(xb.z) * sc, bfhi(xb.z) * sc, 2); MX_Q2(q1.y, q2.y, bflo(xb.w) * sc, bfhi(xb.w) * sc, 3);
            *(u32x2*)(wg + mx2::XQ + 8 * lane) = q1; *(u32x2*)(wg + mx2::XQ + 512 + 8 * lane) = q2; }
        u32x4 xB1[8], xB2[8];
#pragma unroll
        for (int s = 0; s < 8; ++s) { xB1[s] = *(const u32x4*)(wg + mx2::XQ + 64 * s + 16 * kq); xB2[s] = *(const u32x4*)(wg + mx2::XQ + 512 + 64 * s + 16 * kq); }
#pragma unroll 1
        for (int g = 0; g < 8; ++g) {
            int en[8]; mx_ids(g + MXN, el, lane, en);
            const float gt = (float)((unsigned)el[16 * g + 4 * kq + ri] >> 14) * (1.0f / 262143.0f);
            asm volatile("s_waitcnt vmcnt(%0)" :: "n"(8 * (MXN - 1)) : "memory");
            const unsigned char* ub = wg + cslot * 8192;
            f32x4 acc1 = {0.f, 0.f, 0.f, 0.f}, acc2 = {0.f, 0.f, 0.f, 0.f};
#pragma unroll
            for (int s = 0; s < 8; ++s) {
                const u32x4 a4 = *(const u32x4*)(ub + r * 512 + (((4 * s + kq) ^ mx_sw(r)) * 16));
#if MX_HWS
                acc1 = MXF(MX8(a4), MX8(xB1[s]), acc1); acc1 = MXFS(MX8(a4), MX8(xB2[s]), acc1, 0x7C7C7C7C);
#else
                acc1 = MXF(MX8(a4), MX8(xB1[s]), acc1); acc2 = MXF(MX8(a4), MX8(xB2[s]), acc2);
#endif
            }
            asm volatile("" ::: "memory");
            cslot = (cslot + 1 == MXN) ? 0 : cslot + 1;
            mx_dma(g + MXN, en, lane, PU, PV, wl, islot);
            const float d0 = acc1[0] + 0.125f * acc2[0], d1 = acc1[1] + 0.125f * acc2[1], d2 = acc1[2] + 0.125f * acc2[2], d3 = acc1[3] + 0.125f * acc2[3];
            const float hp = ((ri & 2) ? ((ri & 1) ? d3 : d2) : ((ri & 1) ? d1 : d0)) * (1.0f / (PEER_USC * mx::XSC));
            const float w = gt * 0.5f * hp * (1.0f + mx_erf(hp * 0.70710678f));
            if (r < 4) *(float*)(wg + mx2::WF + (16 * g + 4 * kq + r) * 4) = w;
            asm volatile("" ::: "memory");
        }
        float wmx = fmaxf(fabsf(*(const float*)(wg + mx2::WF + 4 * lane)), fabsf(*(const float*)(wg + mx2::WF + 256 + 4 * lane)));
        wmx = wave_max(wmx);
        const float wS = (wmx > 0.f) ? 4.0f * __builtin_amdgcn_rcpf(wmx) : 0.f, wIS = wmx * 0.25f * (1.0f / PEER_VSC);
        u32x4 wB1 = {0u, 0u, 0u, 0u}, wB2 = wB1, wB3 = wB1;
#pragma unroll
        for (int q = 0; q < 4; ++q) {
            const f32x4 w0 = *(const f32x4*)(wg + mx2::WF + 128 * kq + 32 * q), w1 = *(const f32x4*)(wg + mx2::WF + 128 * kq + 32 * q + 16);
            MX_Q3(wB1[q], wB2[q], wB3[q], w0[0] * wS, w0[1] * wS, 0); MX_Q3(wB1[q], wB2[q], wB3[q], w0[2] * wS, w0[3] * wS, 1);
            MX_Q3(wB1[q], wB2[q], wB3[q], w1[0] * wS, w1[1] * wS, 2); MX_Q3(wB1[q], wB2[q], wB3[q], w1[2] * wS, w1[3] * wS, 3);
        }
        float ss = 0.f;
#pragma unroll 1
        for (int hf = 0; hf < 2; ++hf) {
            int e4[4][8];
#pragma unroll
            for (int i4 = 0; i4 < 4; ++i4) { const int ca = 8 + MXN + 4 * hf + i4; if (ca < 16) mx_ids(ca, el, lane, e4[i4]); else mx_ids(ca - 16, eln, lane, e4[i4]); }
            if (hf == 0 || more) asm volatile("s_waitcnt vmcnt(%0)" :: "n"(8 * (MXN - 4)) : "memory"); else MX_WAIT(0);
            int vs = cslot + kq; vs = (vs >= MXN) ? vs - MXN : vs;
            const unsigned vbase = (unsigned)(size_t)wg + vs * 8192 + r * 256;
#pragma unroll 1
            for (int cg = 0; cg < 2; ++cg) {
                f32x4 keep = {0.f, 0.f, 0.f, 0.f};
                u32x2 L0, H0, L1, H1;
#define MX_AD(cb_) (vbase + ((((cb_) >> 1) ^ r) * 16) + ((cb_) & 1) * 8)
                asm volatile("ds_read_b64_tr_b4 %0, %2\n\tds_read_b64_tr_b4 %1, %2 offset:4096" : "=&v"(L0), "=&v"(H0) : "v"(MX_AD(cg * 16)) : "memory");
#pragma unroll
                for (int cb16 = 0; cb16 < 16; ++cb16) {
                    const int cb = cg * 16 + cb16;
                    u32x2 lo, hi;
                    if (cb16 & 1) {
                        if (cb16 < 15) asm volatile("ds_read_b64_tr_b4 %0, %4\n\tds_read_b64_tr_b4 %1, %4 offset:4096\n\ts_waitcnt lgkmcnt(2)" : "=&v"(L0), "=&v"(H0), "+v"(L1), "+v"(H1) : "v"(MX_AD(cb + 1)) : "memory");
                        else asm volatile("s_waitcnt lgkmcnt(0)" : "+v"(L1), "+v"(H1) :: "memory");
                        lo = L1; hi = H1;
                    } else {
                        asm volatile("ds_read_b64_tr_b4 %0, %4\n\tds_read_b64_tr_b4 %1, %4 offset:4096\n\ts_waitcnt lgkmcnt(2)" : "=&v"(L1), "=&v"(H1), "+v"(L0), "+v"(H0) : "v"(MX_AD(cb + 1)) : "memory");
                        lo = L0; hi = H0;
                    }
                    const i32x8 A8 = {(int)lo.x, (int)lo.y, (int)hi.x, (int)hi.y, 0, 0, 0, 0};
                    const f32x4 z = {0.f, 0.f, 0.f, 0.f};
                    const bool mine = (r == cb16);
#if MX_HWS
                    f32x4 d1 = MXF(A8, MX8(wB1), z); d1 = MXFS(A8, MX8(wB2), d1, 0x7C7C7C7C); d1 = MXFS(A8, MX8(wB3), d1, 0x79797979);
#pragma unroll
                    for (int i2 = 0; i2 < 4; ++i2) keep[i2] = mine ? d1[i2] : keep[i2];
#else
                    const f32x4 d1 = MXF(A8, MX8(wB1), z), d2 = MXF(A8, MX8(wB2), z), d3 = MXF(A8, MX8(wB3), z);
#pragma unroll
                    for (int i2 = 0; i2 < 4; ++i2) keep[i2] = mine ? (d1[i2] + 0.125f * (d2[i2] + 0.125f * d3[i2])) : keep[i2];
#endif
                }
#undef MX_AD
                const int c0 = hf * 512 + cg * 256 + 16 * r + 4 * kq;
                f32x4 hv = *(const f32x4*)(wg + mx2::HR + 4 * c0);
#pragma unroll
                for (int i2 = 0; i2 < 4; ++i2) { hv[i2] += keep[i2] * wIS; ss += hv[i2] * hv[i2]; }
                *(f32x4*)(a.h + (size_t)t * 1024 + c0) = hv;
                u32x2 pk; pk.x = pack2(hv[0], hv[1]); pk.y = pack2(hv[2], hv[3]);
                *(u32x2*)(hb + (size_t)t * 1024 + c0) = pk;
            }
            asm volatile("" ::: "memory");
            cslot += 4; cslot = (cslot >= MXN) ? cslot - MXN : cslot;
#pragma unroll
            for (int i4 = 0; i4 < 4; ++i4) { const int ca = 8 + MXN + 4 * hf + i4; if (ca < 16) mx_dma(ca, e4[i4], lane, PU, PV, wl, islot); else if (more) mx_dma(ca - 16, e4[i4], lane, PU, PV, wl, islot); }
            if (more) { if (hf == 0) mx_dma_x(hb, t + tstride, lane, wl); else mx_dma_h(a.h, t + tstride, lane, wl); }
            asm volatile("" ::: "memory");
        }
        ss = wave_sum(ss);
        if (lane == 0) rstd[t] = rsqrtf(ss * (1.0f / 1024.0f) + 1e-6f);
    }
    asm volatile("s_waitcnt vmcnt(0) lgkmcnt(0)" ::: "memory");
    __builtin_amdgcn_s_setprio(0);
}
#endif

#ifndef PEER_NPW
#define PEER_NPW 3
#endif
DEV void ph_topk_peer(const Args& a, float* lds, const int tid0) {
    const int wv = __builtin_amdgcn_readfirstlane(tid0 >> 6);
    constexpr int TPW = T / NWG, MC = 20, NMC = TPW / MC, GPT = 8 / TOPK_NU;
    static_assert(TPW * NWG == T && NMC * MC == TPW, "token split");
#if PEER_MX == 2
    int* EL = (int*)(lds + 2048);
    float* RLb = (float*)(EL + 2 * MC * 128);
    static_assert(8192 + 2 * MC * 128 * 4 + 2 * MC * 4 <= mx2::BASE, "list area");
#else
    int* EL = (int*)(lds + 4096);
    float* GL = (float*)(EL + 2 * MC * 128);
#endif
    const int tok_wg = blockIdx.x * TPW;
    __syncthreads();
#pragma unroll 1
    for (int s = 0; s <= NMC; ++s) {
        const int tsel = tok_wg + s * MC, tgat = tok_wg + (s - 1) * MC;
        int* ELs = EL + (s & 1) * MC * 128; const int* ELg = EL + ((s - 1) & 1) * MC * 128;
#if PEER_MX == 2
        float* RLs = RLb + (s & 1) * MC; const float* RLg = RLb + ((s - 1) & 1) * MC;
        if (s == 0) {
            ph_topk2(a, lds, tid0, tsel * GPT + wv, 8, (tsel + MC) * GPT, ELs, nullptr, tsel, RLs);
        } else if (wv < PEER_NPW) {
            ph_peer_mx2(a, tid0, tgat + wv, PEER_NPW, (MC - wv + PEER_NPW - 1) / PEER_NPW, ELg, RLg, tgat,
                        (PG8_LAS unsigned char*)smem + mx2::BASE + wv * mx2::WL, (unsigned char*)lds + mx2::BASE + wv * mx2::WL);
        } else if (s < NMC) {
            for (int rep_ = 0; rep_ < REP_TOPK; ++rep_)
            ph_topk2(a, lds, tid0, tsel * GPT + (wv - PEER_NPW), 8 - PEER_NPW, (tsel + MC) * GPT, ELs, nullptr, tsel, RLs);
        }
#else
        float* GLs = GL + (s & 1) * MC * 128; const float* GLg = GL + ((s - 1) & 1) * MC * 128;
        if (s == 0) {
            ph_topk2(a, lds, tid0, tsel * GPT + wv, 8, (tsel + MC) * GPT, ELs, GLs, tsel);
#if PEER_MX
        } else if (wv < PEER_NPW) {
            ph_peer_mx(a, tid0, tgat + wv, PEER_NPW, (MC - wv + PEER_NPW - 1) / PEER_NPW, ELg, GLg, tgat,
                       (PG8_LAS unsigned char*)smem + mx::BASE + wv * mx::WL, (unsigned char*)lds + mx::BASE + wv * mx::WL);
        } else if (s == NMC) {
#else
        } else if (s == NMC) {
            PEER_PIPE(a, tid0, tgat + wv, 8, (MC - wv + 7) / 8, ELg, GLg, tgat);
        } else if (wv < PEER_NPW) {
            PEER_PIPE(a, tid0, tgat + wv, PEER_NPW, (MC - wv + PEER_NPW - 1) / PEER_NPW, ELg, GLg, tgat);
#endif
        } else {
            ph_topk2(a, lds, tid0, tsel * GPT + (wv - PEER_NPW), 8 - PEER_NPW, (tsel + MC) * GPT, ELs, GLs, tsel);
        }
#endif
        __syncthreads();
    }
}

typedef float f32x4v __attribute__((ext_vector_type(4)));
#define MFMA16(a, b, c) __builtin_amdgcn_mfma_f32_16x16x32_bf16((a), (b), (c), 0, 0, 0)
namespace sc4 {
constexpr int E_AH = 0, E_RH = 2304, E_BH = 4608, E_KH = 6912, E_BHT = 9216, E_KHT = 12288, E_VT = 15360, E_GC = 18432, E_BYTES = 18688;
constexpr int G_NKAT = 0, G_NBRT = 768, G_NKRT = 1536, G_BYTES = 2304;
constexpr int OFF_E = 0, OFF_G = 6 * E_BYTES, OFF_NBAT = OFF_G + 4 * G_BYTES, OFF_TT = OFF_NBAT + 4 * 1024, OFF_Y = OFF_TT + 4 * 768, TOTAL = OFF_Y + 16384;
}
DEV bf16x8 frag2(u32x2 lo, u32x2 hi) { u32x4 v; v.x = lo.x; v.y = lo.y; v.z = hi.x; v.w = hi.y; return __builtin_bit_cast(bf16x8, v); }
DEV bf16x8 pack_acc(f32x4v p, f32x4v q) { u32x4 v; v.x = pack2(p[0], p[1]); v.y = pack2(p[2], p[3]); v.z = pack2(q[0], q[1]); v.w = pack2(q[2], q[3]); return __builtin_bit_cast(bf16x8, v); }
DEV void ph_scan4(const Args& a, int layer, unsigned char* lb, const int tid0) {
    using namespace sc4;
    static_assert(TOTAL <= LDS_BYTES - 16, "scan LDS map");
    const int lane = tid0 & 63, wv = __builtin_amdgcn_readfirstlane(tid0 >> 6);
    const int r = lane & 15, g = lane >> 4;
    const bf16_t* U = wsb(a, U_OFF); const bf16_t* RS = wsb(a, RS_OFF); const bf16_t* KS = wsb(a, KS_OFF); bf16_t* Uw = wsb(a, U_OFF);
    const bool is_state = wv < 4;
    const int dir = is_state ? (wv >> 1) : ((wv - 4) >> 1), role = wv & 1;
    const bf16_t* Wd = wsb(a, dir ? WB2_OFF : WF_OFF); const bf16_t* Ad = wsb(a, dir ? AB_OFF : AF_OFF);
    const u32x2 z2 = {0u, 0u}; const u32x4 z4 = {0u, 0u, 0u, 0u};
    for (int un = blockIdx.x; un < NSEQ * 8; un += gridDim.x) {
        const int seq = un >> 3, hd = un & 7; const size_t tb = (size_t)seq * 4096; const int cb = hd * 64, pch = cb + lane;
        const float kac = a.rwkv_k_a[layer * 512 + pch];
        __syncthreads();
        if (is_state) {
            f32x4v X[4][2];
#pragma unroll
            for (int m = 0; m < 4; ++m)
#pragma unroll
                for (int vt = 0; vt < 2; ++vt) X[m][vt] = (f32x4v){0.f, 0.f, 0.f, 0.f};
#pragma unroll 1
            for (int p = 0; p < 260; ++p) {
                if (p >= 2 && p < 258) {
                    const int n = p - 2;
                    const unsigned char* E = lb + OFF_E + (dir * 3 + (n % 3)) * E_BYTES;
                    const unsigned char* G = lb + OFF_G + (dir * 2 + (n & 1)) * G_BYTES;
                    float* yb = (float*)(lb + OFF_Y) + (((n & 1) * 2 + dir) * 16) * 64 + 32 * role;
                    bf16x8 fa[2], fr[2];
#pragma unroll
                    for (int s = 0; s < 2; ++s) {
                        fa[s] = frag2(*(const u32x2*)(E + E_AH + r * 144 + 2 * (32 * s + 4 * g)), *(const u32x2*)(E + E_AH + r * 144 + 2 * (32 * s + 16 + 4 * g)));
                        fr[s] = frag2(*(const u32x2*)(E + E_RH + r * 144 + 2 * (32 * s + 4 * g)), *(const u32x2*)(E + E_RH + r * 144 + 2 * (32 * s + 16 + 4 * g)));
                    }
                    const int g1 = g & 1;
                    u32x4 nka = *(const u32x4*)(G + G_NKAT + r * 48 + 16 * g1), nkr = *(const u32x4*)(G + G_NKRT + r * 48 + 16 * g1);
                    if (g >= 2) { nka = z4; nkr = z4; }
                    const bf16x8 fnka = __builtin_bit_cast(bf16x8, nka), fnkr = __builtin_bit_cast(bf16x8, nkr);
                    bf16x8 ftt;
                    {
                        const float* nbat = (const float*)(lb + OFF_NBAT + (dir * 2 + (n & 1)) * 1024);
                        unsigned char* tts = lb + OFF_TT + wv * 768;
                        float Tr[16];
#pragma unroll
                        for (int tg = 0; tg < 4; ++tg) {
                            f32x4v nbq[4][4];
#pragma unroll
                            for (int tt = 0; tt < 4; ++tt)
#pragma unroll
                                for (int i4 = 0; i4 < 4; ++i4) if (4 * i4 < 4 * tg + tt) nbq[tt][i4] = *(const f32x4v*)(nbat + (4 * tg + tt) * 16 + 4 * i4);
#pragma unroll
                            for (int tt = 0; tt < 4; ++tt) {
                                const int t = 4 * tg + tt;
                                float acc = (lane == t) ? 1.0f : 0.f, acc2 = 0.f;
#pragma unroll
                                for (int i = 0; i < t; ++i) { const float pr_ = Tr[i] * nbq[tt][i >> 2][i & 3]; if (i & 1) acc2 += pr_; else acc += pr_; }
                                acc += acc2; Tr[t] = acc;
                                if (lane < 16) *(unsigned short*)(tts + t * 48 + 2 * lane) = (unsigned short)f2bf(acc);
                            }
                        }
                        asm volatile("s_waitcnt lgkmcnt(0)" ::: "memory");
                        ftt = frag2(*(const u32x2*)(tts + r * 48 + 8 * g), z2);
                    }
                    const bf16x8 fnbr = frag2(*(const u32x2*)(G + G_NBRT + r * 48 + 8 * g), z2);
                    bf16x8 fbt[4], fkt[4]; f32x4v gc[4];
#pragma unroll
                    for (int m = 0; m < 4; ++m) {
                        fbt[m] = frag2(*(const u32x2*)(E + E_BHT + (16 * m + r) * 48 + 8 * g), z2);
                        u32x4 kt = *(const u32x4*)(E + E_KHT + (16 * m + r) * 48 + 16 * g1); if (g >= 2) kt = z4; fkt[m] = __builtin_bit_cast(bf16x8, kt);
                        gc[m] = *(const f32x4v*)(E + E_GC + 4 * (16 * m + 4 * g));
                    }
#pragma unroll
                    for (int vt = 0; vt < 2; ++vt) {
                        const int v0 = 32 * role + 16 * vt;
                        u32x4 vv = *(const u32x4*)(E + E_VT + (v0 + r) * 48 + 16 * g1); if (g >= 2) vv = z4;
                        const bf16x8 vb = __builtin_bit_cast(bf16x8, vv);
                        const bf16x8 xb0 = pack_acc(X[0][vt], X[1][vt]), xb1 = pack_acc(X[2][vt], X[3][vt]);
                        f32x4v W = {0.f, 0.f, 0.f, 0.f};
                        W = MFMA16(fa[0], xb0, W); W = MFMA16(fa[1], xb1, W); W = MFMA16(fnka, vb, W);
                        const f32x4v zero4 = {0.f, 0.f, 0.f, 0.f};
                        f32x4v Uc = MFMA16(ftt, pack_acc(W, zero4), zero4);
                        const bf16x8 ub = pack_acc(Uc, zero4);
                        f32x4v Y = {0.f, 0.f, 0.f, 0.f};
                        Y = MFMA16(fr[0], xb0, Y); Y = MFMA16(fr[1], xb1, Y); Y = MFMA16(fnbr, ub, Y); Y = MFMA16(fnkr, vb, Y);
#pragma unroll
                        for (int i = 0; i < 4; ++i) yb[(4 * g + i) * 64 + 16 * vt + r] = Y[i];
#pragma unroll
                        for (int m = 0; m < 4; ++m) { f32x4v xm = MFMA16(fbt[m], ub, X[m][vt]); xm = MFMA16(fkt[m], vb, xm); X[m][vt] = xm * gc[m]; }
                    }
                }
                __syncthreads();
            }
        } else {
            unsigned short prA[8][6], pwA[8], prB[8][6], pwB[8];
#define SC5_ISSUE(pr, pw, n_) do { _Pragma("unroll") for (int s_ = 0; s_ < 8; ++s_) { const int step_ = (n_) * 16 + 8 * role + s_, pos_ = dir ? 4095 - step_ : step_; const size_t t_ = tb + pos_; \
            pr[s_][0] = Wd[t_ * 512 + pch]; pr[s_][1] = U[t_ * UW + pch]; pr[s_][2] = Ad[t_ * 512 + pch]; pr[s_][3] = KS[t_ * 512 + pch]; pr[s_][4] = RS[t_ * 512 + pch]; pr[s_][5] = U[t_ * UW + 1536 + pch]; \
            if (role) { const int st0_ = (n_) * 16 + s_, p0_ = dir ? 4095 - st0_ : st0_; pw[s_] = Wd[(tb + p0_) * 512 + pch]; } } } while (0)
            SC5_ISSUE(prA, pwA, 0); SC5_ISSUE(prB, pwB, 1);
#define SC5_PERIOD(pr, pw, p_) do { const int p = (p_); \
                if (p < 256) { \
                    unsigned char* E = lb + OFF_E + (dir * 3 + (p % 3)) * E_BYTES; \
                    float gcur = 1.0f; \
                    if (role) { \
_Pragma("unroll") \
                        for (int s = 0; s < 8; ++s) gcur *= bf2f(pw[s]); \
                    } \
                    unsigned bt[4], kt[4], vtw[4]; \
_Pragma("unroll") \
                    for (int s = 0; s < 8; ++s) { \
                        const int st = 8 * role + s; \
                        const float w_ = bf2f(pr[s][0]), kk_ = bf2f(pr[s][1]), ic_ = bf2f(pr[s][2]), ks_ = bf2f(pr[s][3]), r_ = bf2f(pr[s][4]); \
                        const float gprev = gcur; gcur *= w_; \
                        const float ig = __builtin_amdgcn_rcpf(gcur); \
                        const unsigned ah = f2bf(-gprev * kk_), bh = f2bf(kk_ * ic_ * ig), kh = f2bf(ks_ * (1.0f + (ic_ - 1.0f) * kac) * ig), rh = f2bf(gcur * r_), vh = pr[s][5]; \
                        *(unsigned short*)(E + E_AH + st * 144 + 2 * lane) = (unsigned short)ah; *(unsigned short*)(E + E_RH + st * 144 + 2 * lane) = (unsigned short)rh; \
                        *(unsigned short*)(E + E_BH + st * 144 + 2 * lane) = (unsigned short)bh; *(unsigned short*)(E + E_KH + st * 144 + 2 * lane) = (unsigned short)kh; \
                        if (s & 1) { bt[s >> 1] |= bh << 16; kt[s >> 1] |= kh << 16; vtw[s >> 1] |= vh << 16; } else { bt[s >> 1] = bh; kt[s >> 1] = kh; vtw[s >> 1] = vh; } \
                    } \
                    *(u32x4*)(E + E_BHT + lane * 48 + 16 * role) = (u32x4){bt[0], bt[1], bt[2], bt[3]}; \
                    *(u32x4*)(E + E_KHT + lane * 48 + 16 * role) = (u32x4){kt[0], kt[1], kt[2], kt[3]}; \
                    *(u32x4*)(E + E_VT + lane * 48 + 16 * role) = (u32x4){vtw[0], vtw[1], vtw[2], vtw[3]}; \
                    if (role) *(float*)(E + E_GC + 4 * lane) = gcur; \
                } \
                if (role == 0) { \
                    if (p >= 1 && p < 257) { \
                        const int n = p - 1; \
                        const unsigned char* E = lb + OFF_E + (dir * 3 + (n % 3)) * E_BYTES; \
                        unsigned char* G = lb + OFF_G + (dir * 2 + (n & 1)) * G_BYTES; \
                        float* nbat = (float*)(lb + OFF_NBAT + (dir * 2 + (n & 1)) * 1024); \
                        bf16x8 ab[2], rb[2], bA[2], kA[2]; \
_Pragma("unroll") \
                        for (int s = 0; s < 2; ++s) { \
                            ab[s] = *(const bf16x8*)(E + E_AH + r * 144 + 2 * (32 * s + 8 * g)); rb[s] = *(const bf16x8*)(E + E_RH + r * 144 + 2 * (32 * s + 8 * g)); \
                            bA[s] = *(const bf16x8*)(E + E_BH + r * 144 + 2 * (32 * s + 8 * g)); kA[s] = *(const bf16x8*)(E + E_KH + r * 144 + 2 * (32 * s + 8 * g)); \
                        } \
                        const f32x4v zero4 = {0.f, 0.f, 0.f, 0.f}; \
                        f32x4v nba = MFMA16(bA[1], ab[1], MFMA16(bA[0], ab[0], zero4)), nka = MFMA16(kA[1], ab[1], MFMA16(kA[0], ab[0], zero4)); \
                        f32x4v nbr = MFMA16(bA[1], rb[1], MFMA16(bA[0], rb[0], zero4)), nkr = MFMA16(kA[1], rb[1], MFMA16(kA[0], rb[0], zero4)); \
_Pragma("unroll") \
                        for (int i = 0; i < 4; ++i) { const int j = 4 * g + i; if (j >= r) { nba[i] = 0.f; nka[i] = 0.f; } if (j > r) { nbr[i] = 0.f; nkr[i] = 0.f; } } \
                        *(f32x4v*)(nbat + r * 16 + 4 * g) = nba; \
                        u32x2 pk; pk.x = pack2(nka[0], nka[1]); pk.y = pack2(nka[2], nka[3]); *(u32x2*)(G + G_NKAT + r * 48 + 8 * g) = pk; \
                        pk.x = pack2(nbr[0], nbr[1]); pk.y = pack2(nbr[2], nbr[3]); *(u32x2*)(G + G_NBRT + r * 48 + 8 * g) = pk; \
                        pk.x = pack2(nkr[0], nkr[1]); pk.y = pack2(nkr[2], nkr[3]); *(u32x2*)(G + G_NKRT + r * 48 + 8 * g) = pk; \
                    } \
                } else { \
                    if (p >= 3 && p < 259) { \
                        const int n = p - 3; \
                        const float* yb = (const float*)(lb + OFF_Y) + (((n & 1) * 2 + dir) * 16) * 64; \
                        const int s2 = lane >> 2, c16 = (lane & 3) * 16; \
                        const f32x4v y0 = *(const f32x4v*)(yb + s2 * 64 + c16), y1 = *(const f32x4v*)(yb + s2 * 64 + c16 + 4), y2 = *(const f32x4v*)(yb + s2 * 64 + c16 + 8), y3 = *(const f32x4v*)(yb + s2 * 64 + c16 + 12); \
                        const int step = n * 16 + s2, pos = dir ? 4095 - step : step; \
                        u32x4 o0, o1; o0.x = pack2(y0[0], y0[1]); o0.y = pack2(y0[2], y0[3]); o0.z = pack2(y1[0], y1[1]); o0.w = pack2(y1[2], y1[3]); \
                        o1.x = pack2(y2[0], y2[1]); o1.y = pack2(y2[2], y2[3]); o1.z = pack2(y3[0], y3[1]); o1.w = pack2(y3[2], y3[3]); \
                        bf16_t* dst = Uw + (tb + pos) * UW + 512 + 512 * dir + cb + c16; \
                        *(u32x4*)(dst) = o0; *(u32x4*)(dst + 8) = o1; \
                    } \
                } \
                if (p + 2 < 256) SC5_ISSUE(pr, pw, p + 2); \
                __syncthreads(); \
            } while (0)
#pragma unroll 1
            for (int p2 = 0; p2 < 260; p2 += 2) { SC5_PERIOD(prA, pwA, p2); SC5_PERIOD(prB, pwB, p2 + 1); }
#undef SC5_PERIOD
#undef SC5_ISSUE
        }
    }
}

extern __shared__ __attribute__((aligned(16))) unsigned char smem[];

enum { PH_PROLOGUE = 0, PH_ROWPREP_X, PH_GEMM1, PH_ATTN, PH_LORA, PH_PREP2, PH_SCAN, PH_POST, PH_GEMM2, PH_CONVERT, PH_GEMM3, PH_TOPK, PH_PEER, PH_PEERDRY, PH_TOPKPEER, PH_GEMM4A, PH_GEMM4B, PH_FINAL };

template <int PH> DEV void run_phase(const Args& a, int layer, const int tid0) {
    float* ldsf = (float*)smem;
    PG8_LAS unsigned char* ldsg = (PG8_LAS unsigned char*)smem;
    const bf16_t* wb = wsb(a, WB_OFF + (size_t)layer * WB_LAYER);
    if constexpr (PH == PH_PROLOGUE) ph_prologue(a, ldsf, tid0);
    else if constexpr (PH == PH_ROWPREP_X) ph_rowprep(a, true, tid0);
    else if constexpr (PH == PH_GEMM1) {
        pg8::Gemm g{wsb(a, HB_OFF), wb + WB_IN / 2, T, INP, 1024};
        pg8::StaticOrder S; S.init(T, INP, gridDim.x, blockIdx.x);
        pg8::EpiProj E{wsb(a, QKV_OFF), wsb(a, U_OFF), wsf(a, SSQ_OFF), wsf(a, ROPEC_OFF), wsf(a, ROPES_OFF)};
        pg8::gemm_phase<pg8::EpiProj, pg8::StaticOrder, false>(ldsg, g, S, E, nullptr, tid0);
    }
    else if constexpr (PH == PH_ATTN) ph_attn3(a, layer, smem, tid0);
    else if constexpr (PH == PH_LORA) ph_rwkv_prep1(a, layer, smem, tid0);
    else if constexpr (PH == PH_PREP2) ph_rwkv_prep2(a, layer, tid0);
    else if constexpr (PH == PH_SCAN) ph_scan4(a, layer, smem, tid0);
    else if constexpr (PH == PH_POST) ph_post2(a, layer, tid0);
    else if constexpr (PH == PH_GEMM2) {
        pg8::Gemm g{wsb(a, MIX_OFF), wb + WB_OUT / 2, T, 1024, 1024};
        pg8::StaticOrder S; S.init(T, 1024, gridDim.x, blockIdx.x);
        pg8::EpiF32x<1> E{a.h, 1024, nullptr, wsb(a, HB_OFF), wsf(a, SSQ_OFF)};
        pg8::gemm_phase<pg8::EpiF32x<1>, pg8::StaticOrder, false>(ldsg, g, S, E, nullptr, tid0);
    }
    else if constexpr (PH == PH_CONVERT) ph_convert8(a, layer, tid0);
    else if constexpr (PH == PH_GEMM3) {
        pg8::Gemm g{wsb(a, HB_OFF), wb + WB_QK / 2, T, 2048, 1024};
        pg8::StaticOrder S; S.init(T, 2048, gridDim.x, blockIdx.x);
        pg8::EpiF32x<0> E{wsf(a, SC_OFF), 2048, nullptr, nullptr, nullptr};
        pg8::gemm_phase<pg8::EpiF32x<0>, pg8::StaticOrder, false>(ldsg, g, S, E, nullptr, tid0);
    }
    else if constexpr (PH == PH_TOPK) ph_topk2(a, ldsf, tid0, blockIdx.x * 8 + (tid0 >> 6), gridDim.x * 8, T * (8 / TOPK_NU), (int*)(a.ws + TOPI_OFF), wsf(a, TOPG_OFF), 0);
    else if constexpr (PH == PH_TOPKPEER) ph_topk_peer(a, ldsf, tid0);
    else if constexpr (PH == PH_PEER) ph_peer_pipe<false>(a, tid0, blockIdx.x * 8 + (tid0 >> 6), gridDim.x * 8, T / (gridDim.x * 8), (const int*)(a.ws + TOPI_OFF), wsf(a, TOPG_OFF), 0);
    else if constexpr (PH == PH_PEERDRY) ph_peer_pipe<true>(a, tid0, blockIdx.x * 8 + (tid0 >> 6), gridDim.x * 8, T / (gridDim.x * 8), (const int*)(a.ws + TOPI_OFF), wsf(a, TOPG_OFF), 0);
    else if constexpr (PH == PH_GEMM4A) {
        pg8::Gemm g{wsb(a, HB_OFF), wb + WB_GATE / 2, T, 1024, 1024};
        pg8::StaticOrder S; S.init(T, 1024, gridDim.x, blockIdx.x);
        pg8::EpiGate E{wsb(a, GATE_OFF), wsf(a, RSTD_OFF), a.ple_b_gate + layer * 1024};
        pg8::gemm_phase<pg8::EpiGate, pg8::StaticOrder, false>(ldsg, g, S, E, nullptr, tid0);
    }
    else if constexpr (PH == PH_GEMM4B) {
        pg8::Gemm g{wsb(a, PB_OFF), wb + WB_PROJ / 2, T, 1024, 256};
        pg8::StaticOrder S; S.init(T, 1024, gridDim.x, blockIdx.x);
        pg8::EpiF32x<2> E{a.h, 1024, wsb(a, GATE_OFF), wsb(a, HB_OFF), wsf(a, SSQ_OFF)};
        pg8::gemm_phase<pg8::EpiF32x<2>, pg8::StaticOrder, false>(ldsg, g, S, E, nullptr, tid0);
    }
    else if constexpr (PH == PH_FINAL) ph_final(a, tid0);
}

#if !ONE_LAUNCH
template <int PH> __global__ void __launch_bounds__(NTHR, 2) k_phase(Args a, int layer) { run_phase<PH>(a, layer, (int)threadIdx.x); }
#endif

#if ONE_LAUNCH
#ifndef REP_PEER
#define REP_PEER 1
#endif
#ifndef REP_SCAN
#define REP_SCAN 1
#endif
#ifndef REP_TOPK
#define REP_TOPK 1
#endif
#ifndef REP_GEMM1
#define REP_GEMM1 1
#endif
#ifndef REP_LORA
#define REP_LORA 1
#endif
#ifndef REP_POST
#define REP_POST 1
#endif
#ifndef REP_ATTN
#define REP_ATTN 1
#endif
#ifndef REP_GEMM3
#define REP_GEMM3 1
#endif
typedef const __attribute__((address_space(4))) unsigned long long* kargs_t;
static_assert(sizeof(Args) == 31 * 8, "Args is 31 pointers, no padding");
#define AS1 __attribute__((address_space(1)))
DEV Args load_args(kargs_t kp) {
    Args r; const float** d = (const float**)&r;
#pragma unroll
    for (int i = 0; i < 29; ++i) d[i] = (const float*)(AS1 const float*)kp[i];
    r.h = (float*)(AS1 float*)kp[29]; r.ws = (unsigned char*)(AS1 unsigned char*)kp[30];
    return r; }
#define RUN(PH, layer) do { kargs_t kp_ = (kargs_t)__builtin_amdgcn_kernarg_segment_ptr(); asm volatile("" : "+s"(kp_)); const Args la_ = load_args(kp_); int t_; asm volatile("v_mbcnt_lo_u32_b32 %0, -1, 0\n\tv_mbcnt_hi_u32_b32 %0, -1, %0\n\tv_lshl_add_u32 %0, %1, 6, %0" : "=&v"(t_) : "s"(wv0_)); run_phase<PH>(la_, layer, t_); } while (0)
#define BAR() do { kargs_t kp_ = (kargs_t)__builtin_amdgcn_kernarg_segment_ptr(); asm volatile("" : "+s"(kp_)); XcdBarrier b_; b_.bar = (unsigned*)((unsigned char*)kp_[30] + BAR_OFF); b_.x = xb_xcc_id(); b_.st = (volatile LAS unsigned*)(smem + LDS_BYTES - 16); int t_; asm volatile("v_mbcnt_lo_u32_b32 %0, -1, 0\n\tv_mbcnt_hi_u32_b32 %0, -1, %0\n\tv_lshl_add_u32 %0, %1, 6, %0" : "=&v"(t_) : "s"(wv0_)); xcd_barrier(b_, t_); } while (0)
#define LAYER_BODY(layer) do { \
        for (int rep_ = 0; rep_ < REP_GEMM1; ++rep_) { RUN(PH_GEMM1, layer); BAR(); } \
        for (int rep_ = 0; rep_ < REP_ATTN; ++rep_) { RUN(PH_ATTN, layer); BAR(); } \
        for (int rep_ = 0; rep_ < REP_LORA; ++rep_) { RUN(PH_LORA, layer); BAR(); } \
        for (int rep_ = 0; rep_ < REP_PREP2; ++rep_) { RUN(PH_PREP2, layer); BAR(); } \
        for (int rep_ = 0; rep_ < REP_SCAN; ++rep_) { RUN(PH_SCAN, layer); BAR(); } \
        for (int rep_ = 0; rep_ < REP_POST; ++rep_) { RUN(PH_POST, layer); BAR(); } \
        RUN(PH_GEMM2, layer); RUN(PH_CONVERT, layer); BAR(); \
        for (int rep_ = 0; rep_ < REP_GEMM3; ++rep_) { RUN(PH_GEMM3, layer); BAR(); } \
        RUN(PH_TOPKPEER, layer); BAR(); \
        for (int rep_ = 0; rep_ < REP_GEMM4A; ++rep_) { RUN(PH_GEMM4A, layer); BAR(); } \
        RUN(PH_GEMM4B, layer); BAR(); \
    } while (0)
__global__ void __launch_bounds__(NTHR, 2) k_mega(Args a) {
    if (threadIdx.x == 0) *(uint4*)(smem + LDS_BYTES - 16) = make_uint4(0u, 0u, 0u, 0u);
    __syncthreads();
    (void)xcd_barrier_post((unsigned*)(a.ws + BAR_OFF), (volatile LAS unsigned*)(smem + LDS_BYTES - 16));
    const int wv0_ = __builtin_amdgcn_readfirstlane((int)threadIdx.x >> 6);
    RUN(PH_PROLOGUE, 0);
    RUN(PH_ROWPREP_X, 0); BAR();
    LAYER_BODY(0); LAYER_BODY(1); LAYER_BODY(2); LAYER_BODY(3);
    RUN(PH_FINAL, 0);
}
#endif

#if !ONE_LAUNCH
template <int PH> static void launch_phase(const Args& a, int layer, hipStream_t st) {
    static bool attr = false;
    if (!attr) { (void)hipFuncSetAttribute((const void*)k_phase<PH>, hipFuncAttributeMaxDynamicSharedMemorySize, LDS_BYTES); attr = true; }
    hipLaunchKernelGGL(k_phase<PH>, dim3(NWG), dim3(NTHR), LDS_BYTES, st, a, layer);
}
#endif

extern "C" void kernel_launch(void* const* d_in, const int* in_sizes, int n_in, void* d_out, int out_size, void* d_ws, size_t ws_size, hipStream_t stream) {
    if (n_in != 29 || out_size != T * D || ws_size < WS_END) {
        fprintf(stderr, "kernel_launch: unexpected shapes (n_in %d, out %d, ws %zu, need %zu); nothing launched\n", n_in, out_size, ws_size, (size_t)WS_END);
        return;
    }
    Args a{};
    const float** ap = (const float**)&a;
    for (int i = 0; i < 29; ++i) ap[i] = (const float*)d_in[i];
    a.h = (float*)d_out; a.ws = (unsigned char*)d_ws;
#if ONE_LAUNCH
    static bool attr = false;
    if (!attr) { (void)hipFuncSetAttribute((const void*)k_mega, hipFuncAttributeMaxDynamicSharedMemorySize, LDS_BYTES); attr = true; }
    (void)hipMemsetAsync((char*)d_ws + BAR_OFF, 0, XCD_BAR_WORDS * sizeof(unsigned), stream);
    hipLaunchKernelGGL(k_mega, dim3(NWG), dim3(NTHR), LDS_BYTES, stream, a);
#else
    launch_phase<PH_PROLOGUE>(a, 0, stream);
    launch_phase<PH_ROWPREP_X>(a, 0, stream);
    for (int layer = 0; layer < NL; ++layer) {
        launch_phase<PH_GEMM1>(a, layer, stream);
        launch_phase<PH_ATTN>(a, layer, stream);
        launch_phase<PH_LORA>(a, layer, stream);
        launch_phase<PH_PREP2>(a, layer, stream);
        launch_phase<PH_SCAN>(a, layer, stream);
        launch_phase<PH_POST>(a, layer, stream);
        launch_phase<PH_GEMM2>(a, layer, stream);
        launch_phase<PH_CONVERT>(a, layer, stream);
        launch_phase<PH_GEMM3>(a, layer, stream);
        launch_phase<PH_TOPK>(a, layer, stream);
        launch_phase<PH_PEER>(a, layer, stream);
        launch_phase<PH_GEMM4A>(a, layer, stream);
        launch_phase<PH_GEMM4B>(a, layer, stream);
    }
    launch_phase<PH_FINAL>(a, 0, stream);
#endif
}
```

```cpp
#include <hip/hip_runtime.h>
#include <stdint.h>
#include <stdio.h>

#ifndef ONE_LAUNCH
#define ONE_LAUNCH 1
#endif

#ifndef REP_PREP2
#define REP_PREP2 1
#endif
#ifndef REP_CONVERT
#define REP_CONVERT 1
#endif
#ifndef REP_GEMM4A
#define REP_GEMM4A 1
#endif
#ifndef REP_ATTNX
#define REP_ATTNX 0
#endif
#ifndef REP_MERGE
#define REP_MERGE 0
#endif
#ifndef FP4_EMU
#define FP4_EMU 0
#endif
#ifndef PEER_FP4
#define PEER_FP4 1
#endif
#define PEER_USC 64.0f
#define PEER_VSC 10.0f
#ifndef PEER_MX
#define PEER_MX 2
#endif
#ifndef PEER_MXU
#define PEER_MXU 1
#endif
#ifndef PEER_MXV
#define PEER_MXV 1
#endif
#ifndef PEER_XF4
#define PEER_XF4 0
#endif
#ifndef REP_TOPK
#define REP_TOPK 1
#endif
#ifndef PEER_PRIO
#define PEER_PRIO 2
#endif
#ifndef MX_HWS
#define MX_HWS 1
#endif
#ifndef PEER_MC
#define PEER_MC 10
#endif
#ifndef TOPK_DYN
#define TOPK_DYN 1
#endif
#ifndef TOPK_MIX
#define TOPK_MIX 0
#endif
#ifndef ATTN_VAR
#define ATTN_VAR 0
#endif

typedef unsigned short bf16_t;
typedef float f32x4 __attribute__((ext_vector_type(4)));
typedef float f32x2 __attribute__((ext_vector_type(2)));
typedef unsigned u32x4 __attribute__((ext_vector_type(4)));
typedef unsigned u32x2 __attribute__((ext_vector_type(2)));
typedef __bf16 bf16x2_t __attribute__((ext_vector_type(2)));

#define DEV __device__ __forceinline__

namespace cfg {
constexpr int NSEQ = 20, SEQ = 4096, T = NSEQ * SEQ, TP = 4 * SEQ, D = 1024, NL = 4;
constexpr int INC = 3456, INP = 3584;
constexpr int QKVW = 1536, UW = 2048, UC = 1920;
constexpr int NWG = 256, NTHR = 512;
constexpr int LDS_BYTES = 163840;
constexpr size_t MiB = 1ull << 20;
constexpr size_t WB_OFF = 0;
constexpr size_t WB_LAYER = 16 * MiB;
constexpr size_t WB_IN = 0, WB_OUT = 7 * MiB, WB_QK = 9 * MiB, WB_GATE = 13 * MiB, WB_PROJ = 15 * MiB, WB_LORA = 15 * MiB + 512 * 1024;
constexpr size_t HB_OFF = 64 * MiB;
constexpr size_t MIX_OFF = 224 * MiB;
constexpr size_t SMALL_OFF = 384 * MiB;
constexpr size_t RSTD_OFF = SMALL_OFF;
constexpr size_t ROPEC_OFF = SMALL_OFF + 512 * 1024, ROPES_OFF = SMALL_OFF + 640 * 1024;
constexpr size_t BAR_OFF = SMALL_OFF + 1 * MiB;
constexpr size_t BIG_OFF = 386 * MiB;
constexpr size_t QKV_OFF = BIG_OFF;
constexpr size_t RS_OFF = BIG_OFF, KS_OFF = BIG_OFF + 80 * MiB, G_OFF = BIG_OFF + 160 * MiB;
constexpr size_t U_OFF = BIG_OFF + 240 * MiB;
constexpr size_t WF_OFF = BIG_OFF + 560 * MiB, WB2_OFF = BIG_OFF + 640 * MiB, AF_OFF = BIG_OFF + 720 * MiB, AB_OFF = BIG_OFF + 800 * MiB;
constexpr size_t OP_OFF = BIG_OFF + 560 * MiB;
constexpr size_t ML_OFF = BIG_OFF + 800 * MiB;
constexpr size_t SC_OFF = BIG_OFF;
constexpr size_t TOPI_OFF = BIG_OFF + 640 * MiB, TOPG_OFF = BIG_OFF + 680 * MiB;
constexpr size_t PTU_OFF = BIG_OFF + 720 * MiB, PTV_OFF = BIG_OFF + 752 * MiB;
constexpr size_t PB_OFF = BIG_OFF + 784 * MiB;
constexpr size_t GATE_OFF = BIG_OFF;
constexpr size_t SSQ_OFF = BIG_OFF + 880 * MiB;
constexpr size_t WS_END = BIG_OFF + 886 * MiB;
}
using namespace cfg;

struct Args {
    const float* x_prompt; const float* x_sample; const float* p_prompt; const float* p_sample;
    const float* norm_mix_g; const float* w_in; const float* att_norm_g; const float* rwkv_shift;
    const float* rwkv_w0; const float* rwkv_w2; const float* rwkv_a0; const float* rwkv_a2; const float* rwkv_g2;
    const float* rwkv_k_k; const float* rwkv_k_a; const float* rwkv_r_k; const float* rwkv_ln_w; const float* rwkv_ln_b;
    const float* w_out; const float* norm_ffn_g; const float* peer_w_q; const float* peer_sub_keys; const float* peer_u; const float* peer_v;
    const float* ple_norm_g; const float* ple_w_gate; const float* ple_b_gate; const float* ple_w_proj; const float* final_norm_g;
    float* h;
    unsigned char* ws;
};

DEV int tid_() { int t = threadIdx.x; asm volatile("" : "+v"(t)); return t; }
DEV float bf2f(unsigned h) { return __uint_as_float(h << 16); }
DEV float bflo(unsigned d) { return __uint_as_float(d << 16); }
DEV float bfhi(unsigned d) { return __uint_as_float(d & 0xffff0000u); }
DEV unsigned pack2(float lo, float hi) { const f32x2 v = {lo, hi}; return __builtin_bit_cast(unsigned, __builtin_convertvector(v, bf16x2_t)); }
DEV unsigned f2bf(float f) { return pack2(f, 0.f) & 0xffffu; }
DEV float dot2bf(unsigned a, unsigned b, float c) { return __builtin_amdgcn_fdot2_f32_bf16(__builtin_bit_cast(bf16x2_t, a), __builtin_bit_cast(bf16x2_t, b), c, false); }
DEV float shx_(float v, int lane, int o) { return __int_as_float(__builtin_amdgcn_ds_bpermute((lane ^ o) << 2, __float_as_int(v))); }
DEV float shf_(float v, int src) { return __int_as_float(__builtin_amdgcn_ds_bpermute(src << 2, __float_as_int(v))); }
DEV int shf_(int v, int src) { return __builtin_amdgcn_ds_bpermute(src << 2, v); }
#define SHX(v, o) shx_((v), lane, (o))
#define SHF(v, src) shf_((v), (src))
DEV float wave_sum_(float v, int lane) {
#pragma unroll
    for (int o = 32; o > 0; o >>= 1) v += shx_(v, lane, o);
    return v;
}
DEV float wave_max_(float v, int lane) {
#pragma unroll
    for (int o = 32; o > 0; o >>= 1) v = fmaxf(v, shx_(v, lane, o));
    return v;
}
#define wave_sum(x) wave_sum_((x), lane)
#define wave_max(x) wave_max_((x), lane)
DEV float sum8(float v) {
    v += __int_as_float(__builtin_amdgcn_mov_dpp(__float_as_int(v), 0xB1, 0xF, 0xF, true));
    v += __int_as_float(__builtin_amdgcn_mov_dpp(__float_as_int(v), 0x4E, 0xF, 0xF, true));
    v += __int_as_float(__builtin_amdgcn_mov_dpp(__float_as_int(v), 0x141, 0xF, 0xF, true));
    return v;
}
DEV float rstd_parts(const float* ssq, int t) { const f32x4* p = (const f32x4*)(ssq + (size_t)t * 16); const f32x4 a = p[0], b = p[1], c = p[2], d = p[3];
    const float s = ((a[0] + a[1]) + (a[2] + a[3])) + ((b[0] + b[1]) + (b[2] + b[3])) + ((c[0] + c[1]) + (c[2] + c[3])) + ((d[0] + d[1]) + (d[2] + d[3]));
    return rsqrtf(s * (1.0f / 1024.0f) + 1e-6f); }
DEV float sigmoidf_(float x) { return __builtin_amdgcn_rcpf(1.0f + __expf(-x)); }
namespace pg8 {
#define PG8_LAS __attribute__((address_space(3)))
typedef unsigned short bf16_t;
typedef short bf16x8 __attribute__((ext_vector_type(8)));
typedef float f32x4 __attribute__((ext_vector_type(4)));
typedef unsigned u32x4 __attribute__((ext_vector_type(4)));
constexpr int BM = 256, BK = 64, HALF = 128, HTB = HALF * BK * 2  , STAGE_BYTES = 8 * HTB, NXCD = 8, WGM = 8;

__host__ __device__ __forceinline__ int lds_byte(int r, int c) { const int st = (r >> 4) * 2 + (c >> 5), rr = r & 15, cc = c & 31, ob = rr * 64 + cc * 2; return st * 1024 + (ob ^ (((ob >> 9) & 1) << 5)); }
__host__ __device__ __forceinline__ void stage_rc(int b, int& R, int& C) { const int st = b / 1024, sb = b % 1024, swz = sb ^ (((sb >> 9) & 1) << 5); R = (st >> 1) * 16 + swz / 64; C = (st & 1) * 32 + (swz % 64) / 2; }
__host__ __device__ __forceinline__ int perm32(int rho) { const int n = rho >> 4, i = rho & 15; return 8 * (i >> 2) + 4 * n + (i & 3); }

struct Unit { int pm, pn; };
struct Gemm { const bf16_t* A; const bf16_t* Bt; int M, N, K; };

struct StaticOrder {
    int nM, nN, nwg, G, c;
    __host__ __device__ void init(int M, int N, int G_, int c_) { nM = M / BM; nN = N / BM; nwg = nM * nN; G = G_; c = c_; }
    __host__ __device__ bool next(int i, Unit& u) const {
        const long L = (long)i * G + c; if (L >= nwg) return false;
        int wgid = (int)L; { const int q = nwg / NXCD, r = nwg % NXCD, xcd = wgid % NXCD, off = wgid / NXCD; wgid = (xcd < r ? xcd * (q + 1) : r * (q + 1) + (xcd - r) * q) + off; }
        const int nig = WGM * nN, gid = wgid / nig, fm = gid * WGM, gsz = (nM - fm) < WGM ? (nM - fm) : WGM;
        u.pm = fm + ((wgid % nig) % gsz); u.pn = (wgid % nig) / gsz; return true;
    }
    __device__ __forceinline__ void a_ready(const Unit&) const {}
    __device__ __forceinline__ void done(const Unit&) const {}
};
__device__ __forceinline__ unsigned cvt_pk_bf16(float lo, float hi) { unsigned r; asm volatile("v_cvt_pk_bf16_f32 %0, %1, %2" : "=v"(r) : "v"(lo), "v"(hi)); return r; }

struct EpiProj {
    static constexpr bool PERM = true, AFTER_DRAIN = false;
    bf16_t* qkv; bf16_t* u; const float* ssq; const float* rc; const float* rs;
    __device__ __forceinline__ void operator()(const f32x4 (&acc)[2][2][4][2], const Unit& un, int wr, int wc, int fr, int fq) const {
        const int row0 = un.pm * BM + wr * 64 + fr, lane = fr + 16 * fq;
        const bool isq = un.pn < 6;
        bf16_t* base = isq ? qkv : u; const int ld = isq ? 1536 : 2048; const int colt = isq ? un.pn * BM : (un.pn - 6) * BM;
        const int col0 = colt + wc * 32 + 8 * fq;
        const bool rope = (un.pn < 4) && ((wc & 1) == 0);
        f32x4 pq[2][4];
#pragma unroll
        for (int ai = 0; ai < 2; ++ai)
#pragma unroll
            for (int m = 0; m < 4; ++m) pq[ai][m] = *(const f32x4*)(ssq + (size_t)(row0 + ai * HALF + m * 16) * 16 + 4 * fq);
        float rsd[2][4];
#pragma unroll
        for (int ai = 0; ai < 2; ++ai)
#pragma unroll
            for (int m = 0; m < 4; ++m) { float t = (pq[ai][m][0] + pq[ai][m][1]) + (pq[ai][m][2] + pq[ai][m][3]); t += SHX(t, 16); t += SHX(t, 32); rsd[ai][m] = rsqrtf(t * (1.0f / 1024.0f) + 1e-6f); }
#pragma unroll
        for (int ai = 0; ai < 2; ++ai)
#pragma unroll
            for (int m = 0; m < 4; ++m) {
                const int row = row0 + ai * HALF + m * 16; const float s = rsd[ai][m]; const int pos = row & 4095;
                f32x4 c0 = {1.f, 1.f, 1.f, 1.f}, c1 = c0, s0 = {0.f, 0.f, 0.f, 0.f}, s1 = s0;
                if (rope) { c0 = *(const f32x4*)(rc + pos * 8); c1 = *(const f32x4*)(rc + pos * 8 + 4); s0 = *(const f32x4*)(rs + pos * 8); s1 = *(const f32x4*)(rs + pos * 8 + 4); }
                bf16_t* rowp = base + (size_t)row * ld + col0;
#pragma unroll
                for (int bj = 0; bj < 2; ++bj) {
                    f32x4 v0 = acc[ai][bj][m][0] * s, v1 = acc[ai][bj][m][1] * s;
                    if (rope) {
                        f32x4 o0, o1;
#pragma unroll
                        for (int c = 0; c < 4; ++c) { o0[c] = SHX(v0[c], 16); o1[c] = SHX(v1[c], 16); }
                        if (fq == 0) { v0 = v0 * c0 - o0 * s0; v1 = v1 * c1 - o1 * s1; }
                        else if (fq == 1) { v0 = v0 * c0 + o0 * s0; v1 = v1 * c1 + o1 * s1; }
                    }
                    u32x4 w; w.x = cvt_pk_bf16(v0[0], v0[1]); w.y = cvt_pk_bf16(v0[2], v0[3]); w.z = cvt_pk_bf16(v1[0], v1[1]); w.w = cvt_pk_bf16(v1[2], v1[3]);
                    *(u32x4*)(rowp + bj * HALF) = w;
                }
            }
    }
};
template <int MODE> struct EpiF32x {
    static constexpr bool PERM = true, AFTER_DRAIN = false;
    float* C; int ldc; const bf16_t* gate; bf16_t* hb; float* ssq;
    __device__ __forceinline__ void operator()(const f32x4 (&acc)[2][2][4][2], const Unit& un, int wr, int wc, int fr, int fq) const {
        const int row0 = un.pm * BM + wr * 64 + fr, col0 = un.pn * BM + wc * 32 + 8 * fq, lane = fr + 16 * fq;
#pragma unroll
        for (int ai = 0; ai < 2; ++ai)
#pragma unroll
            for (int m = 0; m < 4; ++m) {
                const int row = row0 + ai * HALF + m * 16;
                const size_t ro = (size_t)row * ldc + col0;
                if (MODE != 0) asm volatile("" ::: "memory");
                float ss = 0.f;
#pragma unroll
                for (int bj = 0; bj < 2; ++bj) {
                    if (MODE == 2 && bj) asm volatile("" ::: "memory");
                    f32x4* p = (f32x4*)(C + ro + bj * HALF);
                    if (MODE == 0) { p[0] = acc[ai][bj][m][0]; p[1] = acc[ai][bj][m][1]; }
                    else {
                        f32x4 v0, v1;
                        if (MODE == 1) { v0 = p[0] + acc[ai][bj][m][0]; v1 = p[1] + acc[ai][bj][m][1]; }
                        else { const u32x4 g = *(const u32x4*)(gate + ro + bj * HALF);
                               f32x4 g0, g1; g0[0] = __uint_as_float(g.x << 16); g0[1] = __uint_as_float(g.x & 0xffff0000u); g0[2] = __uint_as_float(g.y << 16); g0[3] = __uint_as_float(g.y & 0xffff0000u);
                               g1[0] = __uint_as_float(g.z << 16); g1[1] = __uint_as_float(g.z & 0xffff0000u); g1[2] = __uint_as_float(g.w << 16); g1[3] = __uint_as_float(g.w & 0xffff0000u);
                               v0 = p[0] + g0 * acc[ai][bj][m][0]; v1 = p[1] + g1 * acc[ai][bj][m][1]; }
                        p[0] = v0; p[1] = v1;
                        ss += ((v0[0] * v0[0] + v0[1] * v0[1]) + (v0[2] * v0[2] + v0[3] * v0[3])) + ((v1[0] * v1[0] + v1[1] * v1[1]) + (v1[2] * v1[2] + v1[3] * v1[3]));
                        u32x4 pk; pk.x = cvt_pk_bf16(v0[0], v0[1]); pk.y = cvt_pk_bf16(v0[2], v0[3]); pk.z = cvt_pk_bf16(v1[0], v1[1]); pk.w = cvt_pk_bf16(v1[2], v1[3]);
                        *(u32x4*)(hb + ro + bj * HALF) = pk;
                    }
                }
                if (MODE != 0) {
                    ss += SHX(ss, 16); ss += SHX(ss, 32);
                    if (fq == 0) ssq[(size_t)row * 16 + un.pn * 4 + wc] = ss;
                }
            }
    }
};
struct EpiGate {
    static constexpr bool PERM = true, AFTER_DRAIN = false;
    bf16_t* O; const float* rstd; const float* bias;
    __device__ __forceinline__ void operator()(const f32x4 (&acc)[2][2][4][2], const Unit& un, int wr, int wc, int fr, int fq) const {
        const int row0 = un.pm * BM + wr * 64 + fr, col0 = un.pn * BM + wc * 32 + 8 * fq;
        f32x4 bv[2][2];
#pragma unroll
        for (int bj = 0; bj < 2; ++bj)
#pragma unroll
            for (int n = 0; n < 2; ++n) bv[bj][n] = *(const f32x4*)(bias + col0 + bj * HALF + 4 * n);
#pragma unroll
        for (int ai = 0; ai < 2; ++ai)
#pragma unroll
            for (int m = 0; m < 4; ++m) {
                const int row = row0 + ai * HALF + m * 16; const float s = rstd[row];
                bf16_t* rowp = O + (size_t)row * 1024 + col0;
#pragma unroll
                for (int bj = 0; bj < 2; ++bj) {
                    f32x4 v0 = acc[ai][bj][m][0] * s + bv[bj][0], v1 = acc[ai][bj][m][1] * s + bv[bj][1];
#pragma unroll
                    for (int c = 0; c < 4; ++c) { v0[c] = __builtin_amdgcn_rcpf(1.0f + __expf(-v0[c])); v1[c] = __builtin_amdgcn_rcpf(1.0f + __expf(-v1[c])); }
                    u32x4 w; w.x = cvt_pk_bf16(v0[0], v0[1]); w.y = cvt_pk_bf16(v0[2], v0[3]); w.z = cvt_pk_bf16(v1[0], v1[1]); w.w = cvt_pk_bf16(v1[2], v1[3]);
                    *(u32x4*)(rowp + bj * HALF) = w;
                }
            }
    }
};
template <class Epi, class Sched, bool STAMP = false>
__device__ __forceinline__ void gemm_phase(PG8_LAS unsigned char* lds, const Gemm g, const Sched& S, const Epi& E, unsigned long long* stamps, const int tid_in) {
    const int tid = tid_in, wid = __builtin_amdgcn_readfirstlane(tid >> 6), lane = tid & 63, wr = wid >> 2, wc = wid & 3, fr = lane & 15, fq = lane >> 4;
    const int K = g.K, nt = K / BK;
    int ts_lo = 0, ts_hi = 0, nts = 0; const unsigned long long rt_entry = STAMP ? (unsigned long long)wall_clock64() : 0ull;
#define PG8_STAMP() do { if (STAMP && wid == 0 && nts < 64) { const unsigned long long _c = (unsigned long long)clock64(); \
        ts_lo = (lane == nts) ? (int)(unsigned)_c : ts_lo; ts_hi = (lane == nts) ? (int)(unsigned)(_c >> 32) : ts_hi; ++nts; } } while (0)
    PG8_STAMP();
    unsigned voffA[2], voffB[2];
#pragma unroll
    for (int i = 0; i < 2; ++i) { int R, C; stage_rc(tid * 16 + i * 8192, R, C); const int Rb = Epi::PERM ? ((R & ~31) + perm32(R & 31)) : R;
        voffA[i] = (unsigned)(R * K + C) * 2u; voffB[i] = (unsigned)(Rb * K + C) * 2u; }
    const size_t kstep = (size_t)(BK * 2);
    const size_t hstep = (size_t)HALF * K * 2;
    const size_t tstep = 2 * hstep;
    const unsigned ldsw = (unsigned)wid * 1024u;
    const int aoff = lds_byte(wr * 64 + fr, fq * 8), boff = lds_byte(wc * 32 + fr, fq * 8);
#define PG8_SA(b, h) (((b) * 2 + (h)) * HTB)
#define PG8_SB(b, h) ((4 + (b) * 2 + (h)) * HTB)
#define PG8_STAGE(bufoff, gbase, voff) do { _Pragma("unroll") for (int _i = 0; _i < 2; ++_i) \
        __builtin_amdgcn_global_load_lds((const unsigned*)((const char*)(gbase) + (voff)[_i]), (PG8_LAS unsigned*)(lds + (bufoff) + ldsw + _i * 8192), 16, 0, 0); } while (0)
#define PG8_LDA(dst, b, h) do { _Pragma("unroll") for (int m = 0; m < 4; ++m) _Pragma("unroll") for (int k = 0; k < 2; ++k) dst[m][k] = *(const PG8_LAS bf16x8*)(lds + PG8_SA(b, h) + aoff + m * 2048 + k * 1024); } while (0)
#define PG8_LDB(dst, b, h) do { _Pragma("unroll") for (int n = 0; n < 2; ++n) _Pragma("unroll") for (int k = 0; k < 2; ++k) dst[n][k] = *(const PG8_LAS bf16x8*)(lds + PG8_SB(b, h) + boff + n * 2048 + k * 1024); } while (0)
#define PG8_MMA(ai, bj, At, Bt) do { __builtin_amdgcn_s_setprio(1); _Pragma("unroll") for (int m = 0; m < 4; ++m) _Pragma("unroll") for (int n = 0; n < 2; ++n) _Pragma("unroll") for (int k = 0; k < 2; ++k) \
        acc[ai][bj][m][n] = __builtin_amdgcn_mfma_f32_16x16x32_bf16(Bt[n][k], At[m][k], acc[ai][bj][m][n], 0, 0, 0); __builtin_amdgcn_s_setprio(0); } while (0)
#define PG8_WAIT_V(n) asm volatile("s_waitcnt vmcnt(" #n ")" ::: "memory")
#define PG8_WAIT_L(n) asm volatile("s_waitcnt lgkmcnt(" #n ")" ::: "memory")
#define PG8_BAR __builtin_amdgcn_s_barrier()
#define PG8_SCHED __builtin_amdgcn_sched_barrier(0)
    Unit cur, nxt; int ui = 0;
    if (!S.next(0, cur)) return;
    f32x4 acc[2][2][4][2];
#pragma unroll
    for (int a = 0; a < 2; ++a)
#pragma unroll
        for (int b = 0; b < 2; ++b)
#pragma unroll
            for (int m = 0; m < 4; ++m)
#pragma unroll
                for (int n = 0; n < 2; ++n) acc[a][b][m][n] = (f32x4){0.f, 0.f, 0.f, 0.f};
    bf16x8 At[4][2], B0[2][2], B1[2][2];
    const char* cA = (const char*)g.A + (size_t)cur.pm * tstep; const char* cB = (const char*)g.Bt + (size_t)cur.pn * tstep;
    S.a_ready(cur);
    PG8_STAGE(PG8_SB(0, 0), cB, voffB); PG8_STAGE(PG8_SA(0, 0), cA, voffA); PG8_STAGE(PG8_SB(0, 1), cB + hstep, voffB); PG8_STAGE(PG8_SA(0, 1), cA + hstep, voffA);
    if (wr == 1) PG8_BAR;
    PG8_WAIT_V(4); PG8_BAR;
    PG8_STAGE(PG8_SB(1, 0), cB + kstep, voffB); PG8_STAGE(PG8_SA(1, 0), cA + kstep, voffA); PG8_STAGE(PG8_SB(1, 1), cB + hstep + kstep, voffB);
    PG8_WAIT_V(6); PG8_BAR;
    PG8_STAMP();
    for (;;) {
        const bool has_next = S.next(ui + 1, nxt);
        const char* nA = has_next ? (const char*)g.A + (size_t)nxt.pm * tstep : cA; const char* nB = has_next ? (const char*)g.Bt + (size_t)nxt.pn * tstep : cB;
        for (int t = 0; t < nt; t += 2) {
            const bool last = (t == nt - 2);
            const char* a1 = cA + (size_t)(t + 1) * kstep;
            const char* a2 = last ? nA : cA + (size_t)(t + 2) * kstep; const char* b2 = last ? nB : cB + (size_t)(t + 2) * kstep;
            const char* a3 = a2 + kstep; const char* b3 = b2 + kstep;
            if (last && has_next) S.a_ready(nxt);
            PG8_LDB(B0, 0, 0); PG8_SCHED; PG8_LDA(At, 0, 0); PG8_STAGE(PG8_SA(1, 1), a1 + hstep, voffA);
            PG8_WAIT_L(8); PG8_BAR; PG8_WAIT_L(0); PG8_MMA(0, 0, At, B0); PG8_BAR; PG8_SCHED;
            PG8_LDB(B1, 0, 1); PG8_STAGE(PG8_SB(0, 0), b2, voffB);
            PG8_BAR; PG8_WAIT_L(0); PG8_MMA(0, 1, At, B1); PG8_BAR;
            PG8_LDA(At, 0, 1); PG8_STAGE(PG8_SA(0, 0), a2, voffA);
            PG8_BAR; PG8_WAIT_L(0); PG8_MMA(1, 0, At, B0); PG8_BAR; PG8_SCHED;
            PG8_STAGE(PG8_SB(0, 1), b2 + hstep, voffB);
            PG8_WAIT_V(6); PG8_BAR; PG8_MMA(1, 1, At, B1); PG8_BAR;
            PG8_LDB(B0, 1, 0); PG8_SCHED; PG8_LDA(At, 1, 0); PG8_STAGE(PG8_SA(0, 1), a2 + hstep, voffA);
            PG8_WAIT_L(8); PG8_BAR; PG8_WAIT_L(0); PG8_MMA(0, 0, At, B0); PG8_BAR; PG8_SCHED;
            PG8_LDB(B1, 1, 1); PG8_STAGE(PG8_SB(1, 0), b3, voffB);
            PG8_BAR; PG8_WAIT_L(0); PG8_MMA(0, 1, At, B1); PG8_BAR;
            PG8_LDA(At, 1, 1); PG8_STAGE(PG8_SA(1, 0), a3, voffA);
            PG8_BAR; PG8_WAIT_L(0); PG8_MMA(1, 0, At, B0); PG8_BAR; PG8_SCHED;
            PG8_STAGE(PG8_SB(1, 1), b3 + hstep, voffB);
            PG8_WAIT_V(6); PG8_BAR; PG8_MMA(1, 1, At, B1); PG8_BAR;
        }
        PG8_STAMP();
        if constexpr (!Epi::AFTER_DRAIN) { E(acc, cur, wr, wc, fr, fq); S.done(cur); }
        PG8_STAMP();
        if (!has_next) break;
#pragma unroll
        for (int a = 0; a < 2; ++a)
#pragma unroll
            for (int b = 0; b < 2; ++b)
#pragma unroll
                for (int m = 0; m < 4; ++m)
#pragma unroll
                    for (int n = 0; n < 2; ++n) acc[a][b][m][n] = (f32x4){0.f, 0.f, 0.f, 0.f};
        cur = nxt; cA = nA; cB = nB; ++ui;
    }
    PG8_WAIT_V(0);
    if (wr == 0) PG8_BAR;
    PG8_BAR;
    if constexpr (Epi::AFTER_DRAIN) { E.fused(acc, cur, wr, wc, fr, fq, lds, wid, lane); S.done(cur); }
    PG8_STAMP();
    if (STAMP && wid == 0) { stamps[lane] = lane < nts ? (((unsigned long long)(unsigned)ts_hi << 32) | (unsigned)ts_lo) : 0ull;
        if (lane == 62) stamps[62] = rt_entry; if (lane == 63) stamps[63] = (unsigned long long)wall_clock64(); }
#undef PG8_STAMP
#undef PG8_SA
#undef PG8_SB
#undef PG8_STAGE
#undef PG8_LDA
#undef PG8_LDB
#undef PG8_MMA
#undef PG8_WAIT_V
#undef PG8_WAIT_L
#undef PG8_BAR
#undef PG8_SCHED
}
}
#define XB_TMO      128
#define XB_XCNT(j)  (256  + 64 * (j))
#define XB_XSUB(j)  (1280 + 64 * (j))
#define XB_XGEN(j)  (2304 + 64 * (j))
#define XB_TOP      3328
#define XB_TOPGEN   3392
#define XCD_BAR_WORDS 3456
#define XB_SPIN_CAP (1u << 23)
#define LAS __attribute__((address_space(3)))

__device__ __forceinline__ unsigned xb_ld(unsigned* p)              { return __hip_atomic_load(p, __ATOMIC_RELAXED, __HIP_MEMORY_SCOPE_AGENT); }
__device__ __forceinline__ unsigned xb_add(unsigned* p, unsigned v) { return __hip_atomic_fetch_add(p, v, __ATOMIC_RELAXED, __HIP_MEMORY_SCOPE_AGENT); }
__device__ __forceinline__ unsigned xb_xcc_id() { return (unsigned)__builtin_amdgcn_s_getreg((3 << 11) | 20) & 0xFu; }
#define XB_SPIN(cond, bar) do { unsigned _sp = 0; while (cond) { __builtin_amdgcn_s_sleep(1); \
    if ((++_sp & 255u) == 0u) { if (xb_ld(&(bar)[XB_TMO])) break; if (_sp > XB_SPIN_CAP) { atomicAdd(&(bar)[XB_TMO], 1u); break; } } } } while (0)

struct XcdBarrier {
    unsigned* bar; unsigned x;
    volatile LAS unsigned* st;
};

__device__ __forceinline__ XcdBarrier xcd_barrier_post(unsigned* bar, volatile LAS unsigned* st) {
    XcdBarrier b; b.bar = bar; b.x = xb_xcc_id(); b.st = st;
    if (threadIdx.x == 0) (void)xb_add(&bar[XB_XCNT(b.x)], 1u);
    return b;
}
__device__ __forceinline__ void xcd_barrier_complete(unsigned* bar, unsigned x, unsigned& nloc, unsigned& nx) {
    const unsigned G = gridDim.x * gridDim.y * gridDim.z;
    unsigned sum, cnt, mine, sp = 0u;
    for (;;) {
        sum = 0u; cnt = 0u; mine = 0u;
#pragma unroll
        for (unsigned j = 0; j < 16; ++j) { const unsigned c = xb_ld(&bar[XB_XCNT(j)]); sum += c; cnt += (c > 0u) ? 1u : 0u; mine = (j == x) ? c : mine; }
        if (sum == G) break;
        __builtin_amdgcn_s_sleep(1);
        if ((++sp & 255u) == 0u) { if (xb_ld(&bar[XB_TMO])) break; if (sp > XB_SPIN_CAP) { atomicAdd(&bar[XB_TMO], 1u); break; } }
    }
    nloc = mine > 0u ? mine : 1u; nx = cnt > 0u ? cnt : 1u;
}

__device__ __forceinline__ void xcd_barrier(const XcdBarrier& b, const int tid) {
    asm volatile("s_waitcnt vmcnt(0)" ::: "memory");
    __syncthreads();
    if (tid == 0) {
        unsigned* bar = b.bar; unsigned bx = b.x;
        asm volatile("" : "+s"(bar), "+s"(bx));
        __builtin_amdgcn_s_waitcnt(0);
        unsigned nloc = b.st[0], nx = b.st[1];
        if (nloc == 0u) { xcd_barrier_complete(bar, bx, nloc, nx); b.st[0] = nloc; b.st[1] = nx; }
        const unsigned old = xb_add(&bar[XB_XSUB(bx)], 1u);
        const unsigned gen = old / nloc;
        if (old + 1u == (gen + 1u) * nloc) {
            __builtin_amdgcn_fence(__ATOMIC_RELEASE, "agent");
            asm volatile("s_waitcnt vmcnt(0)" ::: "memory");
            const unsigned og = xb_add(&bar[XB_TOP], 1u);
            const unsigned tg = og / nx;
            if (og + 1u == (tg + 1u) * nx) xb_add(&bar[XB_TOPGEN], 1u);
            else XB_SPIN(xb_ld(&bar[XB_TOPGEN]) == tg, bar);
            __builtin_amdgcn_fence(__ATOMIC_ACQUIRE, "agent");
            xb_add(&bar[XB_XGEN(bx)], 1u);
            asm volatile("s_waitcnt vmcnt(0)" ::: "memory");
        } else {
            XB_SPIN(xb_ld(&bar[XB_XGEN(bx)]) == gen, bar);
            __builtin_amdgcn_fence(__ATOMIC_ACQUIRE, "agent");
            asm volatile("s_waitcnt vmcnt(0)" ::: "memory");
        }
    }
    __syncthreads();
}


typedef __attribute__((address_space(3))) unsigned char lds_u8;
extern __shared__ __attribute__((aligned(16))) unsigned char smem[];
DEV unsigned char* smem_base() { return smem; }

DEV bf16_t* wsb(const Args& a, size_t off) { return (bf16_t*)(a.ws + off); }
DEV float* wsf(const Args& a, size_t off) { return (float*)(a.ws + off); }

DEV void ph_rowprep(const Args& a, bool from_x, const int tid0) {
    const int lane = tid0 & 63, wv = tid0 >> 6;
    const int gw = blockIdx.x * 8 + wv, nw = gridDim.x * 8;
    bf16_t* hb = wsb(a, HB_OFF); float* ssq = wsf(a, SSQ_OFF);
    for (int t = gw; t < T; t += nw) {
        const float* src = from_x ? (t < TP ? a.x_prompt + (size_t)t * D : a.x_sample + (size_t)(t - TP) * D) : a.h + (size_t)t * D;
        f32x4 v[4]; float ss = 0.f;
#pragma unroll
        for (int i = 0; i < 4; ++i) { v[i] = *(const f32x4*)(src + (i * 64 + lane) * 4); ss += v[i][0] * v[i][0] + v[i][1] * v[i][1] + v[i][2] * v[i][2] + v[i][3] * v[i][3]; }
        ss = wave_sum(ss);
#pragma unroll
        for (int i = 0; i < 4; ++i) {
            if (from_x) *(f32x4*)(a.h + (size_t)t * D + (i * 64 + lane) * 4) = v[i];
            u32x2 p; p.x = pack2(v[i][0], v[i][1]); p.y = pack2(v[i][2], v[i][3]);
            *(u32x2*)(hb + (size_t)t * D + (i * 64 + lane) * 4) = p;
        }
        if (lane < 16) ssq[(size_t)t * 16 + lane] = (lane == 0) ? ss : 0.f;
    }
}

DEV void ph_final(const Args& a, const int tid0) {
    const int lane = tid0 & 63, wv = tid0 >> 6;
    const int gw = blockIdx.x * 8 + wv, nw = gridDim.x * 8;
    for (int t = gw; t < T; t += nw) {
        float* row = a.h + (size_t)t * D;
        f32x4 v[4]; float ss = 0.f;
#pragma unroll
        for (int i = 0; i < 4; ++i) { v[i] = *(const f32x4*)(row + (i * 64 + lane) * 4); ss += v[i][0] * v[i][0] + v[i][1] * v[i][1] + v[i][2] * v[i][2] + v[i][3] * v[i][3]; }
        ss = wave_sum(ss);
        const float r = rsqrtf(ss * (1.0f / 1024.0f) + 1e-6f);
#pragma unroll
        for (int i = 0; i < 4; ++i) { const f32x4 g = *(const f32x4*)(a.final_norm_g + (i * 64 + lane) * 4); *(f32x4*)(row + (i * 64 + lane) * 4) = v[i] * r * g; }
    }
}

DEV void transpose_cvt(const float* __restrict__ src, bf16_t* __restrict__ dst, int K, int N, int Npad, const float* __restrict__ g, float* tile, const int tid0) {
    const int tx = tid0 & 63, ty = tid0 >> 6;
    const int tk = K / 64, tn = Npad / 64;
    for (int tl = blockIdx.x; tl < tk * tn; tl += gridDim.x) {
        const int k0 = (tl % tk) * 64, n0 = (tl / tk) * 64;
        __syncthreads();
        for (int i = ty; i < 64; i += 8) { const int k = k0 + i, n = n0 + tx; float v = (n < N) ? src[(size_t)k * N + n] : 0.f; if (g) v *= g[k]; tile[i * 65 + tx] = v; }
        __syncthreads();
        for (int i = ty; i < 64; i += 8) dst[(size_t)(n0 + i) * K + k0 + tx] = (bf16_t)f2bf(tile[tx * 65 + i]);
    }
}
DEV void fold_wqk(const Args& a, float* lds, const int tid0) {
    float* swq = lds;
    float* ssk = lds + 64 * 132;
    const int tid = tid0, key = tid & 127, kq = tid >> 7;
    for (int un = blockIdx.x; un < NL * 16 * 16; un += gridDim.x) {
        const int l = un >> 8, hp = (un >> 4) & 15, k0 = (un & 15) * 64;
        __syncthreads();
        for (int i = tid; i < 64 * 128; i += NTHR) { const int r = i >> 7, c = i & 127; swq[r * 132 + c] = a.peer_w_q[((size_t)l * 1024 + k0 + r) * 2048 + hp * 128 + c]; }
        for (int i = tid; i < 128 * 128; i += NTHR) { const int r = i >> 7, c = i & 127; ssk[r * 132 + c] = a.peer_sub_keys[(((size_t)l * 16 + hp) * 128 + r) * 128 + c]; }
        __syncthreads();
        float acc[16];
#pragma unroll
        for (int i = 0; i < 16; ++i) acc[i] = 0.f;
        for (int c = 0; c < 128; c += 4) {
            const f32x4 s = *(const f32x4*)(ssk + key * 132 + c);
#pragma unroll
            for (int i = 0; i < 16; ++i) { const f32x4 w = *(const f32x4*)(swq + (kq * 16 + i) * 132 + c); acc[i] += s[0] * w[0] + s[1] * w[1] + s[2] * w[2] + s[3] * w[3]; }
        }
        bf16_t* dst = wsb(a, WB_OFF + (size_t)l * WB_LAYER + WB_QK) + (size_t)(hp * 128 + key) * 1024 + k0 + kq * 16;
        const float* g = a.norm_ffn_g + l * 1024 + k0 + kq * 16;
#pragma unroll
        for (int i = 0; i < 16; i += 2) *(unsigned*)(dst + i) = pack2(acc[i] * g[i], acc[i + 1] * g[i + 1]);
    }
}
DEV void ph_prologue(const Args& a, float* lds, const int tid0) {
    { float* rc = wsf(a, ROPEC_OFF); float* rs = wsf(a, ROPES_OFF);
      for (int i = blockIdx.x * NTHR + tid0; i < 4096 * 8; i += gridDim.x * NTHR) {
          const int pos = i >> 3, f = i & 7;
          const float invf = (float)pow(500000.0, -(double)f / 8.0);
          const float ang = (float)pos * invf;
          rc[i] = (float)cos((double)ang); rs[i] = (float)sin((double)ang);
      } }
    for (int l = 0; l < NL; ++l) {
        bf16_t* wb = wsb(a, WB_OFF + (size_t)l * WB_LAYER);
        transpose_cvt(a.w_in + (size_t)l * 1024 * INC, wb + WB_IN / 2, 1024, INC, INP, a.norm_mix_g + l * 1024, lds, tid0);
        transpose_cvt(a.w_out + (size_t)l * 1024 * 1024, wb + WB_OUT / 2, 1024, 1024, 1024, nullptr, lds, tid0);
        transpose_cvt(a.ple_w_gate + (size_t)l * 1024 * 1024, wb + WB_GATE / 2, 1024, 1024, 1024, a.ple_norm_g + l * 1024, lds, tid0);
        transpose_cvt(a.ple_w_proj + (size_t)l * 256 * 1024, wb + WB_PROJ / 2, 256, 1024, 1024, nullptr, lds, tid0);
        for (int dr = 0; dr < 2; ++dr) {
            transpose_cvt(a.rwkv_w2 + (size_t)(l * 2 + dr) * 64 * 512, wb + WB_LORA / 2 + dr * 512 * 64, 64, 512, 512, nullptr, lds, tid0);
            transpose_cvt(a.rwkv_a2 + (size_t)(l * 2 + dr) * 64 * 512, wb + WB_LORA / 2 + (2 + dr) * 512 * 64, 64, 512, 512, nullptr, lds, tid0);
        }
        transpose_cvt(a.rwkv_g2 + (size_t)l * 128 * 512, wb + WB_LORA / 2 + 4 * 512 * 64, 128, 512, 512, nullptr, lds, tid0);
    }
    fold_wqk(a, lds, tid0);
}

DEV float sum16(float v) {
    v = sum8(v);
    v += __int_as_float(__builtin_amdgcn_mov_dpp(__float_as_int(v), 0x140, 0xF, 0xF, true));
    return v;
}
DEV float max16(float v) {
    v = fmaxf(v, __int_as_float(__builtin_amdgcn_mov_dpp(__float_as_int(v), 0xB1, 0xF, 0xF, true)));
    v = fmaxf(v, __int_as_float(__builtin_amdgcn_mov_dpp(__float_as_int(v), 0x4E, 0xF, 0xF, true)));
    v = fmaxf(v, __int_as_float(__builtin_amdgcn_mov_dpp(__float_as_int(v), 0x141, 0xF, 0xF, true)));
    v = fmaxf(v, __int_as_float(__builtin_amdgcn_mov_dpp(__float_as_int(v), 0x140, 0xF, 0xF, true)));
    return v;
}
DEV float rl(float v, int l) { return __int_as_float(__builtin_amdgcn_readlane(__float_as_int(v), l)); }
DEV float wave_sum_dpp(float v) { v = sum16(v); return (rl(v, 0) + rl(v, 16)) + (rl(v, 32) + rl(v, 48)); }
DEV unsigned fkey(float f) { const unsigned b = __float_as_uint(f); return b ^ ((unsigned)((int)b >> 31) | 0x80000000u); }
DEV int mbcnt64(unsigned long long m) { return (int)__builtin_amdgcn_mbcnt_hi((unsigned)(m >> 32), __builtin_amdgcn_mbcnt_lo((unsigned)m, 0u)); }

#ifndef TOPK_NU
#define TOPK_NU 4
#endif
DEV int vpopc2(unsigned long long m1, unsigned long long m2) { int n;
    asm("v_bcnt_u32_b32 %0, %1, 0\n\tv_bcnt_u32_b32 %0, %2, %0\n\tv_bcnt_u32_b32 %0, %3, %0\n\tv_bcnt_u32_b32 %0, %4, %0" : "=&v"(n) : "s"((unsigned)m1), "s"((unsigned)(m1 >> 32)), "s"((unsigned)m2), "s"((unsigned)(m2 >> 32)));
    return n; }
template <bool MIXED = false> DEV void ph_topk2(const Args& a, float* lds, const int tid0, const int gw, const int nw, const int NP, int* TOPI, float* TOPG, const int tbase, float* RL = nullptr, int* ctr = nullptr) {
    const int lane = tid0 & 63, wv = __builtin_amdgcn_readfirstlane(tid0 >> 6);
    constexpr int NU = TOPK_NU, NQ = 2 * NU, GPT = 8 / NU;
    float* tvb = lds + wv * (NQ * 16); int* tib = (int*)(lds + 8 * NQ * 16) + wv * (NQ * 16);
    const float* SC = wsf(a, SC_OFF); const float* ssq = wsf(a, SSQ_OFF);
    float vn[NU][4];
#define TOPK_DRAW() ({ int v_ = 0; if (lane == 0) v_ = __hip_atomic_fetch_add(ctr, 1, __ATOMIC_RELAXED, __HIP_MEMORY_SCOPE_WORKGROUP); __builtin_amdgcn_readfirstlane(v_); })
    const int up0 = ctr ? gw + TOPK_DRAW() : gw;
    if (up0 < NP) {
#pragma unroll
        for (int u = 0; u < NU; ++u)
#pragma unroll
            for (int i = 0; i < 4; ++i) vn[u][i] = SC[(size_t)up0 * (NU * 256) + u * 256 + i * 64 + lane];
    }
    int upn = up0;
    for (int up = up0; up < NP; up = upn) {
        upn = ctr ? gw + TOPK_DRAW() : up + nw;
        const int t = up / GPT, hd0 = (up % GPT) * NU;
        float v[NU][4]; unsigned k[NU][4];
#pragma unroll
        for (int u = 0; u < NU; ++u)
#pragma unroll
            for (int i = 0; i < 4; ++i) { v[u][i] = vn[u][i]; k[u][i] = fkey(v[u][i]); }
        if (upn < NP) {
#pragma unroll
            for (int u = 0; u < NU; ++u)
#pragma unroll
                for (int i = 0; i < 4; ++i) vn[u][i] = SC[(size_t)upn * (NU * 256) + u * 256 + i * 64 + lane];
        }
        unsigned th[NQ]; unsigned dm = 0u;
        unsigned long long dq[NU];
#pragma unroll
        for (int q2 = 0; q2 < NU; ++q2) dq[q2] = 0ull;
#pragma unroll
        for (int q = 0; q < NQ; ++q) th[q] = 0u;
        for (int b = 31; b >= 0; --b) {
            const unsigned bit = 1u << b;
            unsigned long long ma[NQ], mb[NQ];
#pragma unroll
            for (int q = 0; q < NQ; ++q) { const unsigned c = th[q] | bit; ma[q] = __ballot(k[q >> 1][2 * (q & 1)] >= c); mb[q] = __ballot(k[q >> 1][2 * (q & 1) + 1] >= c); }
#pragma unroll
            for (int q = 0; q < NQ; ++q) {
                if (MIXED && (q & 1)) {
                    const int n = vpopc2(ma[q], mb[q]);
                    th[q] = (n >= 16) ? (th[q] | bit) : th[q]; dq[q >> 1] |= __ballot(n == 16);
                } else {
                    const int n = __builtin_popcountll(ma[q]) + __builtin_popcountll(mb[q]);
                    th[q] = (n >= 16) ? (th[q] | bit) : th[q]; dm |= (n == 16) ? (1u << q) : 0u;
                }
            }
            if (MIXED) { unsigned long long da = ~0ull;
#pragma unroll
                for (int q2 = 0; q2 < NU; ++q2) da &= dq[q2];
                if (dm == 0x55555555u % (1u << NQ) && da != 0ull) break; }
            else if (dm == (1u << NQ) - 1u) break;
        }
#pragma unroll
        for (int q = 0; q < NQ; ++q) {
            const int u = q >> 1, p = q & 1; const unsigned tp = th[q];
            const unsigned ka = k[u][2 * p], kb = k[u][2 * p + 1];
            const unsigned long long ga = __ballot(ka > tp), gb = __ballot(kb > tp), ea = __ballot(ka == tp), eb = __ballot(kb == tp);
            const int nga = __builtin_popcountll(ga), ng = nga + __builtin_popcountll(gb), need = 16 - ng, nea = __builtin_popcountll(ea);
            const int rga = mbcnt64(ga), rgb = nga + mbcnt64(gb), rea = mbcnt64(ea), reb = nea + mbcnt64(eb);
            const int pa = (ka > tp) ? rga : ((ka == tp && rea < need) ? ng + rea : -1);
            const int pb = (kb > tp) ? rgb : ((kb == tp && reb < need) ? ng + reb : -1);
            if (pa >= 0) { tvb[q * 16 + pa] = v[u][2 * p]; tib[q * 16 + pa] = lane; }
            if (pb >= 0) { tvb[q * 16 + pb] = v[u][2 * p + 1]; tib[q * 16 + pb] = 64 + lane; }
        }
        float cv[NU][4]; unsigned kc[NU][4]; float mx[NU];
#pragma unroll
        for (int u = 0; u < NU; ++u) {
#pragma unroll
            for (int s = 0; s < 4; ++s) { const int c = lane + 64 * s; cv[u][s] = tvb[u * 32 + (c >> 4)] + tvb[u * 32 + 16 + (c & 15)]; kc[u][s] = fkey(cv[u][s]); }
            const float m0 = max16(lane < 16 ? tvb[u * 32 + (lane & 15)] : -3.0e38f), m1 = max16(lane < 16 ? tvb[u * 32 + 16 + (lane & 15)] : -3.0e38f);
            mx[u] = rl(m0, 0) + rl(m1, 0);
        }
        unsigned t2[NU]; unsigned dm2 = 0u;
#pragma unroll
        for (int u = 0; u < NU; ++u) t2[u] = 0u;
        for (int b = 31; b >= 0; --b) {
            const unsigned bit = 1u << b;
            unsigned long long mc[NU][4];
#pragma unroll
            for (int u = 0; u < NU; ++u)
#pragma unroll
                for (int s4 = 0; s4 < 4; ++s4) mc[u][s4] = __ballot(kc[u][s4] >= (t2[u] | bit));
#pragma unroll
            for (int u = 0; u < NU; ++u) {
                const int n = (__builtin_popcountll(mc[u][0]) + __builtin_popcountll(mc[u][1])) + (__builtin_popcountll(mc[u][2]) + __builtin_popcountll(mc[u][3]));
                t2[u] = (n >= 16) ? (t2[u] | bit) : t2[u]; dm2 |= (n == 16) ? (1u << u) : 0u;
            }
            if (dm2 == (1u << NU) - 1u) break;
        }
        const float rs = rstd_parts(ssq, t);
#pragma unroll
        for (int u = 0; u < NU; ++u) {
            int pos[4]; int ng = 0;
#pragma unroll
            for (int s = 0; s < 4; ++s) { const unsigned long long g = __ballot(kc[u][s] > t2[u]); pos[s] = (kc[u][s] > t2[u]) ? ng + mbcnt64(g) : -1; ng += __builtin_popcountll(g); }
            int ne = 0; const int need = 16 - ng;
#pragma unroll
            for (int s = 0; s < 4; ++s) { const unsigned long long e = __ballot(kc[u][s] == t2[u]); const int r = ne + mbcnt64(e); pos[s] = (kc[u][s] == t2[u] && r < need) ? ng + r : pos[s]; ne += __builtin_popcountll(e); }
            float ex[4]; float es = 0.f;
#pragma unroll
            for (int s = 0; s < 4; ++s) { ex[s] = (pos[s] >= 0) ? __expf(rs * (cv[u][s] - mx[u])) : 0.f; es += ex[s]; }
            const float inv = __builtin_amdgcn_rcpf(wave_sum_dpp(es));
#pragma unroll
            for (int s = 0; s < 4; ++s) if (pos[s] >= 0) {
                const int c = lane + 64 * s;
                const int eid = tib[u * 32 + (c >> 4)] * 128 + tib[u * 32 + 16 + (c & 15)];
                if (TOPG) { TOPI[(t - tbase) * 128 + (hd0 + u) * 16 + pos[s]] = eid; TOPG[(t - tbase) * 128 + (hd0 + u) * 16 + pos[s]] = ex[s] * inv; }
                else TOPI[(t - tbase) * 128 + (hd0 + u) * 16 + pos[s]] = eid | ((int)(ex[s] * inv * 262143.0f + 0.5f) << 14);
            }
        }
        if (RL && hd0 == 0 && lane == 0) RL[t - tbase] = rs;
    }
}

DEV unsigned pack4_fp8(float a, float b, float c, float d) {
    int w = __builtin_amdgcn_cvt_pk_fp8_f32(a, b, 0, false);
    w = __builtin_amdgcn_cvt_pk_fp8_f32(c, d, w, true);
    return (unsigned)w;
}
DEV void ph_convert8(const Args& a, int layer, const int tid0) {
    const size_t gtid = (size_t)blockIdx.x * NTHR + tid0, gn = (size_t)gridDim.x * NTHR;
    const float* us = a.peer_u + (size_t)layer * 16384 * 1024; const float* vs = a.peer_v + (size_t)layer * 16384 * 1024;
    unsigned* ud = (unsigned*)(a.ws + PTU_OFF); unsigned* vd = (unsigned*)(a.ws + PTV_OFF);
    const float* g = a.norm_ffn_g + layer * 1024;
#if PEER_FP4
    for (size_t i = gtid; i < (size_t)16384 * 1024 / 16; i += gn) {
        u32x2 pu = {0u, 0u}, pv = {0u, 0u};
#pragma unroll
        for (int j = 0; j < 4; ++j) {
            const f32x4 x = *(const f32x4*)(us + i * 16 + j * 4), y = *(const f32x4*)(vs + i * 16 + j * 4), gg = *(const f32x4*)(g + ((i * 16 + j * 4) & 1023));
            unsigned wu = pu[j >> 1], wv = pv[j >> 1];
            if (j & 1) { wu = __builtin_amdgcn_cvt_scalef32_pk_fp4_f32(wu, x[0] * gg[0] * PEER_USC, x[1] * gg[1] * PEER_USC, 1.0f, 2); wu = __builtin_amdgcn_cvt_scalef32_pk_fp4_f32(wu, x[2] * gg[2] * PEER_USC, x[3] * gg[3] * PEER_USC, 1.0f, 3);
                         wv = __builtin_amdgcn_cvt_scalef32_pk_fp4_f32(wv, y[0] * PEER_VSC, y[1] * PEER_VSC, 1.0f, 2); wv = __builtin_amdgcn_cvt_scalef32_pk_fp4_f32(wv, y[2] * PEER_VSC, y[3] * PEER_VSC, 1.0f, 3); }
            else       { wu = __builtin_amdgcn_cvt_scalef32_pk_fp4_f32(wu, x[0] * gg[0] * PEER_USC, x[1] * gg[1] * PEER_USC, 1.0f, 0); wu = __builtin_amdgcn_cvt_scalef32_pk_fp4_f32(wu, x[2] * gg[2] * PEER_USC, x[3] * gg[3] * PEER_USC, 1.0f, 1);
                         wv = __builtin_amdgcn_cvt_scalef32_pk_fp4_f32(wv, y[0] * PEER_VSC, y[1] * PEER_VSC, 1.0f, 0); wv = __builtin_amdgcn_cvt_scalef32_pk_fp4_f32(wv, y[2] * PEER_VSC, y[3] * PEER_VSC, 1.0f, 1); }
            pu[j >> 1] = wu; pv[j >> 1] = wv;
        }
        *(u32x2*)(ud + i * 2) = pu; *(u32x2*)(vd + i * 2) = pv;
    }
#else
    for (size_t i = gtid; i < (size_t)16384 * 1024 / 16; i += gn) {
        u32x4 pu, pv;
#pragma unroll
        for (int j = 0; j < 4; ++j) {
            const f32x4 x = *(const f32x4*)(us + i * 16 + j * 4), y = *(const f32x4*)(vs + i * 16 + j * 4), gg = *(const f32x4*)(g + ((i * 16 + j * 4) & 1023));
#if FP4_EMU
            { const unsigned q0 = __builtin_amdgcn_cvt_scalef32_pk_fp4_f32(0u, x[0] * gg[0] * 64.f, x[1] * gg[1] * 64.f, 1.0f, 0), q1 = __builtin_amdgcn_cvt_scalef32_pk_fp4_f32(0u, x[2] * gg[2] * 64.f, x[3] * gg[3] * 64.f, 1.0f, 0);
              const f32x2 r0 = __builtin_amdgcn_cvt_scalef32_pk_f32_fp4(q0, 1.0f, 0), r1 = __builtin_amdgcn_cvt_scalef32_pk_f32_fp4(q1, 1.0f, 0);
              pu[j] = pack4_fp8(r0[0] * 4.f, r0[1] * 4.f, r1[0] * 4.f, r1[1] * 4.f);
              const unsigned q2 = __builtin_amdgcn_cvt_scalef32_pk_fp4_f32(0u, y[0] * 8.f, y[1] * 8.f, 1.0f, 0), q3 = __builtin_amdgcn_cvt_scalef32_pk_fp4_f32(0u, y[2] * 8.f, y[3] * 8.f, 1.0f, 0);
              const f32x2 r2 = __builtin_amdgcn_cvt_scalef32_pk_f32_fp4(q2, 1.0f, 0), r3 = __builtin_amdgcn_cvt_scalef32_pk_f32_fp4(q3, 1.0f, 0);
              pv[j] = pack4_fp8(r2[0] * 4.f, r2[1] * 4.f, r3[0] * 4.f, r3[1] * 4.f); }
#else
            pu[j] = pack4_fp8(x[0] * gg[0] * 256.f, x[1] * gg[1] * 256.f, x[2] * gg[2] * 256.f, x[3] * gg[3] * 256.f);
            pv[j] = pack4_fp8(y[0] * 32.f, y[1] * 32.f, y[2] * 32.f, y[3] * 32.f);
#endif
        }
        *(u32x4*)(ud + i * 4) = pu; *(u32x4*)(vd + i * 4) = pv;
    }
#endif
    bf16_t* pb = wsb(a, PB_OFF);
    const float* pp = a.p_prompt + (size_t)layer * TP * 256; const float* ps = a.p_sample + (size_t)layer * (T - TP) * 256;
    for (size_t i = gtid; i < (size_t)T * 256 / 4; i += gn) {
        const size_t e = i * 4; const f32x4 x = (e < (size_t)TP * 256) ? *(const f32x4*)(pp + e) : *(const f32x4*)(ps + (e - (size_t)TP * 256));
        u32x2 p; p.x = pack2(x[0], x[1]); p.y = pack2(x[2], x[3]); *(u32x2*)(pb + e) = p;
    }
}


typedef short bf16x8 __attribute__((ext_vector_type(8)));
typedef float f32x16 __attribute__((ext_vector_type(16)));
#define MFMA32(a, b, c) __builtin_amdgcn_mfma_f32_32x32x16_bf16((a), (b), (c), 0, 0, 0)
DEV bf16x8 pack_frag(float x0, float x1, float x2, float x3, float x4, float x5, float x6, float x7) {
    u32x4 p;
    asm volatile("v_cvt_pk_bf16_f32 %0, %4, %5\n\tv_cvt_pk_bf16_f32 %1, %6, %7\n\tv_cvt_pk_bf16_f32 %2, %8, %9\n\tv_cvt_pk_bf16_f32 %3, %10, %11\n\ts_nop 1"
                 : "=&v"(p[0]), "=&v"(p[1]), "=&v"(p[2]), "=&v"(p[3]) : "v"(x0), "v"(x1), "v"(x2), "v"(x3), "v"(x4), "v"(x5), "v"(x6), "v"(x7));
    return __builtin_bit_cast(bf16x8, p);
}
DEV void ph_attn3(const Args& a, int layer, unsigned char* ldsb, const int tid0) {
    const int lane = tid0 & 63, wv = __builtin_amdgcn_readfirstlane(tid0 >> 6), r = lane & 31, h = lane >> 5;
    unsigned char* OL = ldsb;
    float* MLl = (float*)(ldsb + 73728);
    unsigned char* vt = ldsb + 77824 + wv * 4608;
    const bf16_t* qkv = wsb(a, QKV_OFF);
    bf16_t* mix = wsb(a, MIX_OFF);
    const int i16 = lane & 15, tq = i16 >> 2, tp = i16 & 3, tblk = (lane >> 4) & 1;
    const unsigned tr_addr = (unsigned)(size_t)vt + (4 * h + tq) * 144 + 2 * (16 * tblk + 4 * tp);
    const float sc = 0.125f * 1.44269504f, NEG = -1.0e30f;
    for (int un = blockIdx.x; un < NSEQ * 8 * 8; un += gridDim.x) {
      const int sh = un >> 3, sp = un & 7, seq = sh >> 3, hd = sh & 7; const size_t tb = (size_t)seq * 4096;
      __syncthreads();
#pragma unroll 1
      for (int di = 0; di < 3; ++di) {
       bf16x8 qfN[4], kN[4], vN[4];
#pragma unroll
       for (int k2 = 0; k2 < 2; ++k2) {
        const int idx16 = wv * 2 + k2;
        const int sft = 2 * di, nlen = 4096 >> sft;
        const int rr = (di == 0) ? 0 : (di == 1 ? (idx16 >> 2) : idx16), cb = (di == 0) ? (16 * sp + idx16) : (di == 1 ? (4 * sp + (idx16 & 3)) : sp), cq0 = cb * 32;
        const size_t tokq = tb + ((size_t)(cq0 + r) << sft) + rr;
        const bf16_t* qp = qkv + tokq * 1536 + hd * 64 + 8 * h;
        bf16x8 qf[4];
#pragma unroll
        for (int s = 0; s < 4; ++s) qf[s] = (k2 == 1) ? qfN[s] : *(const bf16x8*)(qp + 16 * s);
        float m = NEG, l = 0.f;
        f32x16 O0, O1;
#pragma unroll
        for (int i = 0; i < 16; ++i) { O0[i] = 0.f; O1[i] = 0.f; }
        bf16x8 kfb[2][4], vfb[2][4];
#define ATT_LOAD(kt_) do { const int kb_ = cq0 - 64 + 32 * (kt_); const size_t tokk_ = tb + ((size_t)(kb_ + r) << sft) + rr; const bf16_t* kp_ = qkv + tokk_ * 1536 + 512 + hd * 64 + 8 * h; \
            _Pragma("unroll") for (int s_ = 0; s_ < 4; ++s_) { kfb[(kt_) & 1][s_] = *(const bf16x8*)(kp_ + 16 * s_); vfb[(kt_) & 1][s_] = *(const bf16x8*)(kp_ + 512 + 16 * s_); } } while (0)
        if (cq0 - 64 >= 0) {
            if (k2 == 1) {
#pragma unroll
                for (int s_ = 0; s_ < 4; ++s_) { kfb[0][s_] = kN[s_]; vfb[0][s_] = vN[s_]; }
            } else ATT_LOAD(0);
        }
#pragma unroll
        for (int kt = 0; kt < 5; ++kt) {
            const int kb = cq0 - 64 + 32 * kt;
            if (kt + 1 < 5) { const int kbn = kb + 32; if (kbn >= 0 && kbn < nlen) ATT_LOAD(kt + 1); }
            if (k2 == 0 && kt == 4) {
                const int ix1 = idx16 + 1;
                const int rr1 = (di == 0) ? 0 : (di == 1 ? (ix1 >> 2) : ix1), cb1 = (di == 0) ? (16 * sp + ix1) : (di == 1 ? (4 * sp + (ix1 & 3)) : sp), cq1 = cb1 * 32;
                const bf16_t* qp1 = qkv + (tb + ((size_t)(cq1 + r) << sft) + rr1) * 1536 + hd * 64 + 8 * h;
#pragma unroll
                for (int s_ = 0; s_ < 4; ++s_) qfN[s_] = *(const bf16x8*)(qp1 + 16 * s_);
                if (cq1 - 64 >= 0) {
                    const bf16_t* kp1 = qkv + (tb + ((size_t)(cq1 - 64 + r) << sft) + rr1) * 1536 + 512 + hd * 64 + 8 * h;
#pragma unroll
                    for (int s_ = 0; s_ < 4; ++s_) { kN[s_] = *(const bf16x8*)(kp1 + 16 * s_); vN[s_] = *(const bf16x8*)(kp1 + 512 + 16 * s_); }
                }
            }
            asm volatile("" ::: "memory");
            if (kb < 0 || kb >= nlen) continue;
            bf16x8 kf[4], vf[4];
#pragma unroll
            for (int s = 0; s < 4; ++s) { kf[s] = kfb[kt & 1][s]; vf[s] = vfb[kt & 1][s]; }
            f32x16 S;
#pragma unroll
            for (int i = 0; i < 16; ++i) S[i] = 0.f;
#pragma unroll
            for (int s = 0; s < 4; ++s) S = MFMA32(kf[s], qf[s], S);
            float lm = NEG;
#pragma unroll
            for (int i = 0; i < 16; ++i) {
                const int row = (i & 3) + 8 * (i >> 2) + 4 * h;
                float v = S[i] * sc;
                if (kt == 0) v = (row >= r) ? v : NEG;
                if (kt == 4) v = (row <= r) ? v : NEG;
                S[i] = v; lm = fmaxf(lm, v);
            }
            lm = fmaxf(lm, SHX(lm, 32));
            const float mn = fmaxf(m, lm), alpha = __builtin_amdgcn_exp2f(m - mn);
            m = mn; l *= alpha;
            float ps = 0.f;
#pragma unroll
            for (int i = 0; i < 16; ++i) { O0[i] *= alpha; O1[i] *= alpha; S[i] = __builtin_amdgcn_exp2f(S[i] - mn); ps += S[i]; }
            l += ps;
            const bf16x8 pb0 = pack_frag(S[0], S[1], S[2], S[3], S[4], S[5], S[6], S[7]);
            const bf16x8 pb1 = pack_frag(S[8], S[9], S[10], S[11], S[12], S[13], S[14], S[15]);
            asm volatile("" ::: "memory");
#pragma unroll
            for (int i = 0; i < 4; ++i) *(bf16x8*)(vt + r * 144 + 2 * (16 * i + 8 * h)) = vf[i];
            typedef short s16x4 __attribute__((ext_vector_type(4)));
            s16x4 t00l, t00h, t01l, t01h, t10l, t10h, t11l, t11h;
            asm volatile("s_waitcnt lgkmcnt(0)\n\t"
                         "ds_read_b64_tr_b16 %0, %8\n\tds_read_b64_tr_b16 %1, %8 offset:1152\n\t"
                         "ds_read_b64_tr_b16 %2, %8 offset:2304\n\tds_read_b64_tr_b16 %3, %8 offset:3456\n\t"
                         "ds_read_b64_tr_b16 %4, %8 offset:64\n\tds_read_b64_tr_b16 %5, %8 offset:1216\n\t"
                         "ds_read_b64_tr_b16 %6, %8 offset:2368\n\tds_read_b64_tr_b16 %7, %8 offset:3520\n\t"
                         "s_waitcnt lgkmcnt(0)"
                         : "=&v"(t00l), "=&v"(t00h), "=&v"(t01l), "=&v"(t01h), "=&v"(t10l), "=&v"(t10h), "=&v"(t11l), "=&v"(t11h) : "v"(tr_addr) : "memory");
            const bf16x8 a00 = __builtin_shufflevector(t00l, t00h, 0, 1, 2, 3, 4, 5, 6, 7), a01 = __builtin_shufflevector(t01l, t01h, 0, 1, 2, 3, 4, 5, 6, 7);
            const bf16x8 a10 = __builtin_shufflevector(t10l, t10h, 0, 1, 2, 3, 4, 5, 6, 7), a11 = __builtin_shufflevector(t11l, t11h, 0, 1, 2, 3, 4, 5, 6, 7);
            O0 = MFMA32(a00, pb0, O0); O1 = MFMA32(a10, pb0, O1);
            O0 = MFMA32(a01, pb1, O0); O1 = MFMA32(a11, pb1, O1);
            asm volatile("" ::: "memory");
        }
#undef ATT_LOAD
        l += SHX(l, 32);
        const int ql = (((cq0 + r) << sft) + rr) - 512 * sp;
        unsigned char* orow = OL + ql * 144 + 8 * h;
        float ao = 0.f, ap = 1.0f;
        if (di > 0) {
            const f32x2 mo = *(const f32x2*)(MLl + 2 * ql);
            const float mn = fmaxf(mo[0], m);
            ao = __builtin_amdgcn_exp2f(mo[0] - mn); ap = __builtin_amdgcn_exp2f(m - mn);
            l = ao * mo[1] + ap * l; m = mn;
        }
#pragma unroll
        for (int g = 0; g < 4; ++g) {
            f32x4 v0 = {O0[4 * g] * ap, O0[4 * g + 1] * ap, O0[4 * g + 2] * ap, O0[4 * g + 3] * ap}, v1 = {O1[4 * g] * ap, O1[4 * g + 1] * ap, O1[4 * g + 2] * ap, O1[4 * g + 3] * ap};
            if (di > 0) {
                const u32x2 o0 = *(const u32x2*)(orow + 16 * g), o1 = *(const u32x2*)(orow + 64 + 16 * g);
                v0[0] += ao * bflo(o0.x); v0[1] += ao * bfhi(o0.x); v0[2] += ao * bflo(o0.y); v0[3] += ao * bfhi(o0.y);
                v1[0] += ao * bflo(o1.x); v1[1] += ao * bfhi(o1.x); v1[2] += ao * bflo(o1.y); v1[3] += ao * bfhi(o1.y);
            }
            u32x2 p0, p1; p0.x = pack2(v0[0], v0[1]); p0.y = pack2(v0[2], v0[3]); p1.x = pack2(v1[0], v1[1]); p1.y = pack2(v1[2], v1[3]);
            *(u32x2*)(orow + 16 * g) = p0; *(u32x2*)(orow + 64 + 16 * g) = p1;
        }
        if (h == 0) { f32x2 ml; ml[0] = m; ml[1] = l; *(f32x2*)(MLl + 2 * ql) = ml; }
       }
       __syncthreads();
      }
      {
        const int ql = tid0;
        const float inv = __builtin_amdgcn_rcpf(MLl[2 * ql + 1]);
        float o[64]; float ss = 0.f;
#pragma unroll
        for (int c = 0; c < 8; ++c) {
            const u32x4 w4 = *(const u32x4*)(OL + ql * 144 + 16 * c);
#pragma unroll
            for (int i = 0; i < 4; ++i) { o[8 * c + 2 * i] = bflo(w4[i]) * inv; o[8 * c + 2 * i + 1] = bfhi(w4[i]) * inv; ss += o[8 * c + 2 * i] * o[8 * c + 2 * i] + o[8 * c + 2 * i + 1] * o[8 * c + 2 * i + 1]; }
        }
        const float rn = rsqrtf(ss * (1.0f / 64.0f) + 1e-6f);
        const float* gp = a.att_norm_g + layer * 512 + hd * 64;
        bf16_t* dst = mix + (tb + 512 * sp + ql) * 1024 + hd * 64;
#pragma unroll
        for (int c = 0; c < 8; ++c) {
            const f32x4 g0 = *(const f32x4*)(gp + 8 * c), g1 = *(const f32x4*)(gp + 8 * c + 4);
            u32x4 w4; w4.x = pack2(o[8 * c] * rn * g0[0], o[8 * c + 1] * rn * g0[1]); w4.y = pack2(o[8 * c + 2] * rn * g0[2], o[8 * c + 3] * rn * g0[3]);
            w4.z = pack2(o[8 * c + 4] * rn * g1[0], o[8 * c + 5] * rn * g1[1]); w4.w = pack2(o[8 * c + 6] * rn * g1[2], o[8 * c + 7] * rn * g1[3]);
            *(u32x4*)(dst + 8 * c) = w4;
        }
      }
    }
}

DEV float tanh_fast(float x) { return 1.0f - 2.0f * __builtin_amdgcn_rcpf(1.0f + __expf(2.0f * x)); }

DEV void ph_rwkv_prep1(const Args& a, int layer, unsigned char* ldsb, const int tid0) {
    const int lane = tid0 & 63, wv = __builtin_amdgcn_readfirstlane(tid0 >> 6), r = lane & 31, h = lane >> 5;
    const int gw = blockIdx.x * 8 + wv, nw = gridDim.x * 8;
    const int sub = wv & 1, ng = wv >> 1;
    const bf16_t* U = wsb(a, U_OFF);
    const float* sw = a.rwkv_shift + (size_t)layer * 3 * UC;
    const bf16_t* wl = wsb(a, WB_OFF + (size_t)layer * WB_LAYER + WB_LORA);
#pragma unroll 1
    for (int arr = 0; arr < 5; ++arr) {
        const int coff = (arr < 4) ? arr * 64 : 256, nk = (arr < 4) ? 4 : 8, kw = nk * 16, rsb = kw * 2 + 16;
        __syncthreads();
        {
            const bf16_t* wsrc = wl + (arr < 4 ? arr * 512 * 64 : 4 * 512 * 64);
            const int cpr = kw / 8;
            for (int i = tid0; i < 512 * cpr; i += NTHR) { const int row = i / cpr, c = i - row * cpr; *(u32x4*)(ldsb + row * rsb + c * 16) = *(const u32x4*)(wsrc + (size_t)row * kw + c * 8); }
        }
        __syncthreads();
        bf16_t* outb = wsb(a, arr == 0 ? WF_OFF : arr == 1 ? WB2_OFF : arr == 2 ? AF_OFF : arr == 3 ? AB_OFF : G_OFF);
        const float* bias = (arr < 2) ? a.rwkv_w0 + (layer * 2 + arr) * 512 : a.rwkv_a0 + (layer * 2 + (arr & 1)) * 512;
        f32x4 bvr[4][4];
#pragma unroll
        for (int q = 0; q < 4; ++q)
#pragma unroll
            for (int g = 0; g < 4; ++g) bvr[q][g] = *(const f32x4*)(bias + (ng * 4 + q) * 32 + 8 * g + 4 * h);
#pragma unroll 1
        for (int tile = blockIdx.x; tile < T / 64; tile += gridDim.x) {
            const int t = tile * 64 + sub * 32 + r, pos = t & 4095;
            const bool hp = pos > 0, hn = pos < 4095;
            const bf16_t* up = U + (size_t)t * UW + 1536 + 8 * h;
            bf16x8 xf[8];
#pragma unroll
            for (int s = 0; s < 8; ++s) {
                if (s < nk) {
                    const int col = coff + 16 * s;
                    const u32x4 c = *(const u32x4*)(up + col);
                    u32x4 p = {0u, 0u, 0u, 0u}, n = {0u, 0u, 0u, 0u};
                    if (hp) p = *(const u32x4*)(up - UW + col);
                    if (hn) n = *(const u32x4*)(up + UW + col);
                    const float* s0 = sw + 1536 + 8 * h + col;
                    const f32x4 wp0 = *(const f32x4*)(s0), wp1 = *(const f32x4*)(s0 + 4), wc0 = *(const f32x4*)(s0 + UC), wc1 = *(const f32x4*)(s0 + UC + 4), wn0 = *(const f32x4*)(s0 + 2 * UC), wn1 = *(const f32x4*)(s0 + 2 * UC + 4);
                    float v[8];
#pragma unroll
                    for (int i = 0; i < 4; ++i) {
                        const float a0 = (i < 2) ? wp0[2 * i] : wp1[2 * i - 4], a1 = (i < 2) ? wp0[2 * i + 1] : wp1[2 * i - 3];
                        const float b0 = (i < 2) ? wc0[2 * i] : wc1[2 * i - 4], b1 = (i < 2) ? wc0[2 * i + 1] : wc1[2 * i - 3];
                        const float c0 = (i < 2) ? wn0[2 * i] : wn1[2 * i - 4], c1 = (i < 2) ? wn0[2 * i + 1] : wn1[2 * i - 3];
                        v[2 * i] = a0 * bflo(p[i]) + b0 * bflo(c[i]) + c0 * bflo(n[i]);
                        v[2 * i + 1] = a1 * bfhi(p[i]) + b1 * bfhi(c[i]) + c1 * bfhi(n[i]);
                    }
                    if (arr < 2) {
#pragma unroll
                        for (int i = 0; i < 8; ++i) v[i] = tanh_fast(v[i]);
                    } else if (arr == 4) {
#pragma unroll
                        for (int i = 0; i < 8; ++i) v[i] = sigmoidf_(v[i]);
                    }
                    xf[s] = pack_frag(v[0], v[1], v[2], v[3], v[4], v[5], v[6], v[7]);
                }
            }
            bf16_t* out = outb + (size_t)t * 512 + 4 * h;
#pragma unroll
            for (int q = 0; q < 4; ++q) {
                const int nt = ng * 4 + q;
                f32x16 C;
#pragma unroll
                for (int i = 0; i < 16; ++i) C[i] = 0.f;
                const unsigned char* wr = ldsb + (nt * 32 + r) * rsb + 16 * h;
#pragma unroll
                for (int s = 0; s < 8; ++s) if (s < nk) { const bf16x8 A = *(const bf16x8*)(wr + 32 * s); C = MFMA32(A, xf[s], C); }
#pragma unroll
                for (int g = 0; g < 4; ++g) {
                    float o[4];
                    if (arr < 4) {
                        const f32x4 bv = bvr[q][g];
#pragma unroll
                        for (int j = 0; j < 4; ++j) { const float sg = sigmoidf_(C[4 * g + j] + bv[j]); o[j] = (arr < 2) ? __expf(-0.60653066f * sg) : sg; }
                    } else {
#pragma unroll
                        for (int j = 0; j < 4; ++j) o[j] = C[4 * g + j];
                    }
                    u32x2 pk; pk.x = pack2(o[0], o[1]); pk.y = pack2(o[2], o[3]);
                    *(u32x2*)(out + nt * 32 + 8 * g) = pk;
                }
            }
        }
    }
    {
        const int c16 = 16 * lane;
        bf16_t* dst = wsb(a, lane < 32 ? RS_OFF : KS_OFF) + (c16 & 511);
        float swp[16], swc[16], swn[16];
#pragma unroll
        for (int i = 0; i < 16; ++i) { swp[i] = sw[c16 + i]; swc[i] = sw[UC + c16 + i]; swn[i] = sw[2 * UC + c16 + i]; }
        for (int t0 = gw; t0 < T; t0 += 2 * nw) {
            u32x4 c[2][2], p[2][2], n[2][2];
#pragma unroll
            for (int k = 0; k < 2; ++k) {
                const int t = t0 + k * nw; const int pos = t & 4095; const bool hp = pos > 0, hn = pos < 4095;
                const bf16_t* up = U + (size_t)t * UW + c16;
#pragma unroll
                for (int q = 0; q < 2; ++q) {
                    c[k][q] = *(const u32x4*)(up + 8 * q); p[k][q] = (u32x4){0u, 0u, 0u, 0u}; n[k][q] = (u32x4){0u, 0u, 0u, 0u};
                    if (hp) p[k][q] = *(const u32x4*)(up - UW + 8 * q);
                    if (hn) n[k][q] = *(const u32x4*)(up + UW + 8 * q);
                }
            }
#pragma unroll
            for (int k = 0; k < 2; ++k) {
                const int t = t0 + k * nw;
                u32x4 o[2];
#pragma unroll
                for (int q = 0; q < 2; ++q)
#pragma unroll
                    for (int i = 0; i < 4; ++i) {
                        const int e = 8 * q + 2 * i;
                        const float lo = swp[e] * bflo(p[k][q][i]) + swc[e] * bflo(c[k][q][i]) + swn[e] * bflo(n[k][q][i]);
                        const float hi = swp[e + 1] * bfhi(p[k][q][i]) + swc[e + 1] * bfhi(c[k][q][i]) + swn[e + 1] * bfhi(n[k][q][i]);
                        o[q][i] = pack2(lo, hi);
                    }
                *(u32x4*)(dst + (size_t)t * 512) = o[0]; *(u32x4*)(dst + (size_t)t * 512 + 8) = o[1];
            }
        }
    }
}
DEV void ph_rwkv_prep2(const Args& a, int layer, const int tid0) {
    const int lane = tid0 & 63, wv = tid0 >> 6;
    const int gw = blockIdx.x * 8 + wv, nw = gridDim.x * 8;
    bf16_t* U = wsb(a, U_OFF); const bf16_t* KS = wsb(a, KS_OFF);
    const float* sw = a.rwkv_shift + (size_t)layer * 3 * UC;
    const int c8 = 8 * lane;
    float kkc[8], sv[3][8];
#pragma unroll
    for (int i = 0; i < 8; ++i) { kkc[i] = a.rwkv_k_k[layer * 512 + c8 + i]; sv[0][i] = sw[1024 + c8 + i]; sv[1][i] = sw[UC + 1024 + c8 + i]; sv[2][i] = sw[2 * UC + 1024 + c8 + i]; }
    for (int t = gw; t < T; t += nw) {
        const int pos = t & 4095; const bool hp = pos > 0, hn = pos < 4095;
        bf16_t* up = U + (size_t)t * UW;
        const u32x4 ks = *(const u32x4*)(KS + (size_t)t * 512 + c8);
        const u32x4 c = *(const u32x4*)(up + 1024 + c8);
        u32x4 p = {0u, 0u, 0u, 0u}, n = {0u, 0u, 0u, 0u};
        if (hp) p = *(const u32x4*)(up - UW + 1024 + c8);
        if (hn) n = *(const u32x4*)(up + UW + 1024 + c8);
        float kx[8]; float ss = 0.f;
#pragma unroll
        for (int i = 0; i < 4; ++i) { kx[2 * i] = bflo(ks[i]) * kkc[2 * i]; kx[2 * i + 1] = bfhi(ks[i]) * kkc[2 * i + 1]; ss += kx[2 * i] * kx[2 * i] + kx[2 * i + 1] * kx[2 * i + 1]; }
        const float inv = 1.0f / fmaxf(sqrtf(sum8(ss)), 1e-12f);
        u32x4 ko, vo;
#pragma unroll
        for (int i = 0; i < 4; ++i) {
            ko[i] = pack2(kx[2 * i] * inv, kx[2 * i + 1] * inv);
            vo[i] = pack2(sv[0][2 * i] * bflo(p[i]) + sv[1][2 * i] * bflo(c[i]) + sv[2][2 * i] * bflo(n[i]), sv[0][2 * i + 1] * bfhi(p[i]) + sv[1][2 * i + 1] * bfhi(c[i]) + sv[2][2 * i + 1] * bfhi(n[i]));
        }
        *(u32x4*)(up + c8) = ko; *(u32x4*)(up + 1536 + c8) = vo;
    }
}

DEV void ph_post2(const Args& a, int layer, const int tid0) {
    const int lane = tid0 & 63, wv = tid0 >> 6;
    const int gw = blockIdx.x * 8 + wv, nw = gridDim.x * 8;
    const bf16_t* U = wsb(a, U_OFF); const bf16_t* RS = wsb(a, RS_OFF); const bf16_t* KS = wsb(a, KS_OFF); const bf16_t* G = wsb(a, G_OFF);
    const bf16_t* AF = wsb(a, AF_OFF); const bf16_t* AB = wsb(a, AB_OFF); bf16_t* mix = wsb(a, MIX_OFF);
    const int c8 = 8 * lane;
    float kac[8], rkc[8], lnw[8], lnb[8];
#pragma unroll
    for (int i = 0; i < 8; ++i) { kac[i] = a.rwkv_k_a[layer * 512 + c8 + i]; rkc[i] = a.rwkv_r_k[layer * 512 + c8 + i]; lnw[i] = a.rwkv_ln_w[layer * 512 + c8 + i]; lnb[i] = a.rwkv_ln_b[layer * 512 + c8 + i]; }
    struct PostLd { u32x4 rp, kp, gp, afp, abp, yfp, ybp, vp; };
    for (int t0 = gw; t0 < T; t0 += 2 * nw) {
        PostLd L[2];
#pragma unroll
        for (int k = 0; k < 2; ++k) {
            const int t = t0 + k * nw; const bf16_t* up = U + (size_t)t * UW;
            L[k].rp = *(const u32x4*)(RS + (size_t)t * 512 + c8); L[k].kp = *(const u32x4*)(KS + (size_t)t * 512 + c8); L[k].gp = *(const u32x4*)(G + (size_t)t * 512 + c8);
            L[k].afp = *(const u32x4*)(AF + (size_t)t * 512 + c8); L[k].abp = *(const u32x4*)(AB + (size_t)t * 512 + c8);
            L[k].yfp = *(const u32x4*)(up + 512 + c8); L[k].ybp = *(const u32x4*)(up + 1024 + c8); L[k].vp = *(const u32x4*)(up + 1536 + c8);
        }
#pragma unroll
        for (int k = 0; k < 2; ++k) {
        const int t = t0 + k * nw;
        const u32x4 rp = L[k].rp, kp = L[k].kp, gp = L[k].gp, afp = L[k].afp, abp = L[k].abp, yfp = L[k].yfp, ybp = L[k].ybp, vp = L[k].vp;
        float y[8], rr[8], kk[8], vv[8], gg[8], sa[8];
#pragma unroll
        for (int i = 0; i < 4; ++i) {
            y[2 * i] = bflo(yfp[i]) + bflo(ybp[i]); y[2 * i + 1] = bfhi(yfp[i]) + bfhi(ybp[i]);
            rr[2 * i] = bflo(rp[i]); rr[2 * i + 1] = bfhi(rp[i]); kk[2 * i] = bflo(kp[i]); kk[2 * i + 1] = bfhi(kp[i]);
            vv[2 * i] = bflo(vp[i]); vv[2 * i + 1] = bfhi(vp[i]); gg[2 * i] = bflo(gp[i]); gg[2 * i + 1] = bfhi(gp[i]);
            sa[2 * i] = bflo(afp[i]) + bflo(abp[i]); sa[2 * i + 1] = bfhi(afp[i]) + bfhi(abp[i]);
        }
        float ysum = 0.f, bs = 0.f;
#pragma unroll
        for (int i = 0; i < 8; ++i) { ysum += y[i]; bs += rr[i] * kk[i] * (2.0f + (sa[i] - 2.0f) * kac[i]) * rkc[i]; }
        const float mu = sum8(ysum) * (1.0f / 64.0f);
        float vs = 0.f;
#pragma unroll
        for (int i = 0; i < 8; ++i) { y[i] -= mu; vs += y[i] * y[i]; }
        const float rstdv = rsqrtf(sum8(vs) * (1.0f / 64.0f) + 64e-5f);
        bs = sum8(bs);
        float o[8];
#pragma unroll
        for (int i = 0; i < 8; ++i) o[i] = (y[i] * rstdv * lnw[i] + lnb[i] + bs * vv[i]) * gg[i];
        u32x4 ov; ov.x = pack2(o[0], o[1]); ov.y = pack2(o[2], o[3]); ov.z = pack2(o[4], o[5]); ov.w = pack2(o[6], o[7]);
        *(u32x4*)(mix + (size_t)t * 1024 + 512 + c8) = ov;
        }
    }
}

#ifdef PROBE_EMASK
#define PEER_EM(e) (DRY ? ((e) & PROBE_EMASK) : (e))
#else
#define PEER_EM(e) (e)
#endif
template <bool DRY> DEV void ph_peer_pipe(const Args& a, const int tid0, const int gw, const int nw, const int ntok, const int* TOPI, const float* TOPG, const int tbase) {
    const int lane = tid0 & 63;
    bf16_t* hb = wsb(a, HB_OFF); float* rstd = wsf(a, RSTD_OFF); const float* ssq = wsf(a, SSQ_OFF);
    const unsigned char* PU = a.ws + PTU_OFF; const unsigned char* PV = a.ws + PTV_OFF;
    const int c16 = 16 * lane;
    const bool b5 = lane & 32, b4 = lane & 16, b3 = lane & 8;
    const bool dost = DRY ? (__builtin_amdgcn_readfirstlane(*(const int*)(a.ws + TOPI_OFF)) == -12345) : true;
    u32x4 ur[2][8], vr[8];
    int e0, e1, e0n = 0, e1n = 0; float g0, g1, g0n = 0.f, g1n = 0.f;
    u32x4 xa, xb, xan = {0u, 0u, 0u, 0u}, xbn = {0u, 0u, 0u, 0u}; float rsv, rsn = 0.f;
#define PEER_ISSUE_U(slot_, b_, es0_, es1_) do { _Pragma("unroll") for (int i_ = 0; i_ < 8; ++i_) { const int k_ = (b_) * 8 + i_; \
        const int e_ = PEER_EM(__builtin_amdgcn_readlane((k_ < 64) ? (es0_) : (es1_), k_ & 63)); ur[slot_][i_] = *(const u32x4*)(PU + (size_t)e_ * 1024 + c16); } } while (0)
#define PEER_ISSUE_V(slot_, b_, es0_, es1_) do { _Pragma("unroll") for (int i_ = 0; i_ < 8; ++i_) { const int k_ = (b_) * 8 + i_; \
        const int e_ = PEER_EM(__builtin_amdgcn_readlane((k_ < 64) ? (es0_) : (es1_), k_ & 63)); vr[i_] = *(const u32x4*)(PV + (size_t)e_ * 1024 + c16); } } while (0)
    if (ntok <= 0) return;
    {   const int t0 = gw;
        e0 = TOPI[(t0 - tbase) * 128 + lane]; e1 = TOPI[(t0 - tbase) * 128 + 64 + lane]; g0 = TOPG[(t0 - tbase) * 128 + lane]; g1 = TOPG[(t0 - tbase) * 128 + 64 + lane];
        xa = *(const u32x4*)(hb + (size_t)t0 * 1024 + c16); xb = *(const u32x4*)(hb + (size_t)t0 * 1024 + c16 + 8); rsv = rstd_parts(ssq, t0); }
    PEER_ISSUE_U(0, 0, e0, e1);
#pragma unroll 1
    for (int j = 0; j < ntok; ++j) {
        const int t = gw + nw * j; const bool more = (j + 1 < ntok);
        float* hr = a.h + (size_t)t * 1024 + c16;
        if (more) { const int tn = t + nw;
            e0n = TOPI[(tn - tbase) * 128 + lane]; e1n = TOPI[(tn - tbase) * 128 + 64 + lane]; }
        const float rs = rsv * (1.0f / 256.0f);
        float out[16];
#pragma unroll
        for (int i = 0; i < 16; ++i) out[i] = 0.f;
#pragma unroll 1
        for (int b2 = 0; b2 < 16; b2 += 2)
#pragma unroll
        for (int bb = 0; bb < 2; ++bb) {
            const int b = b2 + bb;
            PEER_ISSUE_V(0, b, e0, e1);
            if (bb == 0) PEER_ISSUE_U(1, b + 1, e0, e1);
            else if (b < 15) PEER_ISSUE_U(0, b + 1, e0, e1);
            else if (more) PEER_ISSUE_U(0, 0, e0n, e1n);
            asm volatile("" ::: "memory");
            float d[8];
#pragma unroll
            for (int i = 0; i < 8; ++i) {
                float sm = 0.f;
#pragma unroll
                for (int q = 0; q < 4; ++q) {
                    const unsigned uw = ur[bb][i][q];
                    const f32x2 lo = __builtin_amdgcn_cvt_pk_f32_fp8((int)uw, false), hi = __builtin_amdgcn_cvt_pk_f32_fp8((int)uw, true);
                    const unsigned ulo = pack2(lo[0], lo[1]), uhi = pack2(hi[0], hi[1]);
                    const unsigned xlo = (q < 2) ? xa[2 * q] : xb[2 * q - 4], xhi = (q < 2) ? xa[2 * q + 1] : xb[2 * q - 3];
                    sm = dot2bf(ulo, xlo, sm); sm = dot2bf(uhi, xhi, sm);
                }
                d[i] = sm;
            }
            float r4[4], r2[2];
#pragma unroll
            for (int i = 0; i < 4; ++i) { const float send = b5 ? d[i] : d[4 + i], keep = b5 ? d[4 + i] : d[i]; r4[i] = keep + SHX(send, 32); }
#pragma unroll
            for (int i = 0; i < 2; ++i) { const float send = b4 ? r4[i] : r4[2 + i], keep = b4 ? r4[2 + i] : r4[i]; r2[i] = keep + SHX(send, 16); }
            const float send1 = b3 ? r2[0] : r2[1], keep1 = b3 ? r2[1] : r2[0];
            const float dd = sum8(keep1 + SHX(send1, 8));
            const float hp = rs * dd;
            const float gt = SHF((b < 8) ? g0 : g1, (b * 8 + (lane >> 3)) & 63);
            const float w = gt * 0.5f * hp * (1.0f + erff(hp * 0.70710678f)) * (1.0f / 32.0f);
#pragma unroll
            for (int i = 0; i < 8; ++i) {
                const float wi = rl(w, 8 * i);
#pragma unroll
                for (int q = 0; q < 4; ++q) {
                    const unsigned vw = vr[i][q];
                    const f32x2 lo = __builtin_amdgcn_cvt_pk_f32_fp8((int)vw, false), hi = __builtin_amdgcn_cvt_pk_f32_fp8((int)vw, true);
                    out[4 * q] += wi * lo[0]; out[4 * q + 1] += wi * lo[1]; out[4 * q + 2] += wi * hi[0]; out[4 * q + 3] += wi * hi[1];
                }
            }
        }
        if (more) { const int tn = t + nw;
            g0n = TOPG[(tn - tbase) * 128 + lane]; g1n = TOPG[(tn - tbase) * 128 + 64 + lane];
            xan = *(const u32x4*)(hb + (size_t)tn * 1024 + c16); xbn = *(const u32x4*)(hb + (size_t)tn * 1024 + c16 + 8); rsn = rstd_parts(ssq, tn); }
        float ss = 0.f;
        f32x4 hv[4];
#pragma unroll
        for (int q = 0; q < 4; ++q) hv[q] = *(const f32x4*)(hr + 4 * q);
#pragma unroll
        for (int q = 0; q < 4; ++q) {
#pragma unroll
            for (int c = 0; c < 4; ++c) { hv[q][c] += out[4 * q + c]; ss += hv[q][c] * hv[q][c]; }
            if (dost) *(f32x4*)(hr + 4 * q) = hv[q];
        }
        ss = wave_sum(ss);
        if (dost) {
            u32x4 p0, p1;
            p0.x = pack2(hv[0][0], hv[0][1]); p0.y = pack2(hv[0][2], hv[0][3]); p0.z = pack2(hv[1][0], hv[1][1]); p0.w = pack2(hv[1][2], hv[1][3]);
            p1.x = pack2(hv[2][0], hv[2][1]); p1.y = pack2(hv[2][2], hv[2][3]); p1.z = pack2(hv[3][0], hv[3][1]); p1.w = pack2(hv[3][2], hv[3][3]);
            *(u32x4*)(hb + (size_t)t * 1024 + c16) = p0; *(u32x4*)(hb + (size_t)t * 1024 + c16 + 8) = p1;
            if (lane == 0) rstd[t] = rsqrtf(ss * (1.0f / 1024.0f) + 1e-6f);
        }
        e0 = e0n; e1 = e1n; g0 = g0n; g1 = g1n; xa = xan; xb = xbn; rsv = rsn;
    }
#undef PEER_ISSUE_U
#undef PEER_ISSUE_V
}


#if PEER_FP4
DEV void ph_peer_pipe4(const Args& a, const int tid0, const int gw, const int nw, const int ntok, const int* TOPI, const float* TOPG, const int tbase) {
    const int lane = tid0 & 63;
    bf16_t* hb = wsb(a, HB_OFF); float* rstd = wsf(a, RSTD_OFF); const float* ssq = wsf(a, SSQ_OFF);
    const unsigned char* PU = a.ws + PTU_OFF; const unsigned char* PV = a.ws + PTV_OFF;
    const int c16 = 16 * lane, c8 = 8 * lane;
    const bool b5 = lane & 32, b4 = lane & 16, b3 = lane & 8;
    u32x2 ur[2][16], vr[16];
    int e0, e1, e0n = 0, e1n = 0; float g0, g1, g0n = 0.f, g1n = 0.f;
    u32x4 xa, xb, xan = {0u, 0u, 0u, 0u}, xbn = {0u, 0u, 0u, 0u}; float rsv, rsn = 0.f;
#define PEER_ISSUE_U(slot_, b_, es0_, es1_) do { _Pragma("unroll") for (int i_ = 0; i_ < 16; ++i_) { const int k_ = (b_) * 16 + i_; \
        const int e_ = __builtin_amdgcn_readlane((k_ < 64) ? (es0_) : (es1_), k_ & 63); ur[slot_][i_] = *(const u32x2*)(PU + (size_t)e_ * 512 + c8); } } while (0)
#define PEER_ISSUE_V(b_, es0_, es1_) do { _Pragma("unroll") for (int i_ = 0; i_ < 16; ++i_) { const int k_ = (b_) * 16 + i_; \
        const int e_ = __builtin_amdgcn_readlane((k_ < 64) ? (es0_) : (es1_), k_ & 63); vr[i_] = *(const u32x2*)(PV + (size_t)e_ * 512 + c8); } } while (0)
    if (ntok <= 0) return;
    {   const int t0 = gw;
        e0 = TOPI[(t0 - tbase) * 128 + lane]; e1 = TOPI[(t0 - tbase) * 128 + 64 + lane]; g0 = TOPG[(t0 - tbase) * 128 + lane]; g1 = TOPG[(t0 - tbase) * 128 + 64 + lane];
        xa = *(const u32x4*)(hb + (size_t)t0 * 1024 + c16); xb = *(const u32x4*)(hb + (size_t)t0 * 1024 + c16 + 8); rsv = rstd_parts(ssq, t0); }
    PEER_ISSUE_U(0, 0, e0, e1);
#pragma unroll 1
    for (int j = 0; j < ntok; ++j) {
        const int t = gw + nw * j; const bool more = (j + 1 < ntok);
        float* hr = a.h + (size_t)t * 1024 + c16;
        if (more) { const int tn = t + nw;
            e0n = TOPI[(tn - tbase) * 128 + lane]; e1n = TOPI[(tn - tbase) * 128 + 64 + lane]; }
        const float rs = rsv * (1.0f / PEER_USC);
        f32x2 out[8];
#pragma unroll
        for (int i = 0; i < 8; ++i) out[i] = (f32x2){0.f, 0.f};
#pragma unroll 1
        for (int b2 = 0; b2 < 8; b2 += 2)
#pragma unroll
        for (int bb = 0; bb < 2; ++bb) {
            const int b = b2 + bb;
            PEER_ISSUE_V(b, e0, e1);
            if (bb == 0) PEER_ISSUE_U(1, b + 1, e0, e1);
            else if (b < 7) PEER_ISSUE_U(0, b + 1, e0, e1);
            else if (more) PEER_ISSUE_U(0, 0, e0n, e1n);
            asm volatile("" ::: "memory");
            float w2[2];
#pragma unroll
            for (int hf = 0; hf < 2; ++hf) {
                float d[8];
#pragma unroll
                for (int i = 0; i < 8; ++i) {
                    float sm = 0.f;
#pragma unroll
                    for (int q = 0; q < 2; ++q) {
                        const unsigned uw = ur[bb][hf * 8 + i][q]; const u32x4 xq = (q == 0) ? xa : xb;
#define PEER_UD(sb_) sm = dot2bf(__builtin_bit_cast(unsigned, __builtin_amdgcn_cvt_scalef32_pk_bf16_fp4(uw, 1.0f, sb_)), xq[sb_], sm)
                        PEER_UD(0); PEER_UD(1); PEER_UD(2); PEER_UD(3);
#undef PEER_UD
                    }
                    d[i] = sm;
                }
                float r4[4], r2[2];
#pragma unroll
                for (int i = 0; i < 4; ++i) { const float send = b5 ? d[i] : d[4 + i], keep = b5 ? d[4 + i] : d[i]; r4[i] = keep + SHX(send, 32); }
#pragma unroll
                for (int i = 0; i < 2; ++i) { const float send = b4 ? r4[i] : r4[2 + i], keep = b4 ? r4[2 + i] : r4[i]; r2[i] = keep + SHX(send, 16); }
                const float send1 = b3 ? r2[0] : r2[1], keep1 = b3 ? r2[1] : r2[0];
                const float dd = sum8(keep1 + SHX(send1, 8));
                const float hp = rs * dd;
                const float gt = SHF((b < 4) ? g0 : g1, (b * 16 + hf * 8 + (lane >> 3)) & 63);
                w2[hf] = gt * 0.5f * hp * (1.0f + erff(hp * 0.70710678f)) * (1.0f / PEER_VSC);
            }
#pragma unroll
            for (int i = 0; i < 16; ++i) {
                const float wi = rl(w2[i >> 3], 8 * (i & 7));
                const f32x2 wv2 = {wi, wi};
#pragma unroll
                for (int q = 0; q < 2; ++q) {
                    const unsigned vw = vr[i][q];
#define PEER_VA(sb_) out[q * 4 + sb_] = __builtin_elementwise_fma(__builtin_amdgcn_cvt_scalef32_pk_f32_fp4(vw, 1.0f, sb_), wv2, out[q * 4 + sb_])
                    PEER_VA(0); PEER_VA(1); PEER_VA(2); PEER_VA(3);
#undef PEER_VA
                }
            }
        }
        if (more) { const int tn = t + nw;
            g0n = TOPG[(tn - tbase) * 128 + lane]; g1n = TOPG[(tn - tbase) * 128 + 64 + lane];
            xan = *(const u32x4*)(hb + (size_t)tn * 1024 + c16); xbn = *(const u32x4*)(hb + (size_t)tn * 1024 + c16 + 8); rsn = rstd_parts(ssq, tn); }
        float ss = 0.f;
        f32x4 hv[4];
#pragma unroll
        for (int q = 0; q < 4; ++q) hv[q] = *(const f32x4*)(hr + 4 * q);
#pragma unroll
        for (int q = 0; q < 4; ++q) {
#pragma unroll
            for (int c = 0; c < 4; ++c) { hv[q][c] += out[2 * q + (c >> 1)][c & 1]; ss += hv[q][c] * hv[q][c]; }
            *(f32x4*)(hr + 4 * q) = hv[q];
        }
        ss = wave_sum(ss);
        {
            u32x4 p0, p1;
            p0.x = pack2(hv[0][0], hv[0][1]); p0.y = pack2(hv[0][2], hv[0][3]); p0.z = pack2(hv[1][0], hv[1][1]); p0.w = pack2(hv[1][2], hv[1][3]);
            p1.x = pack2(hv[2][0], hv[2][1]); p1.y = pack2(hv[2][2], hv[2][3]); p1.z = pack2(hv[3][0], hv[3][1]); p1.w = pack2(hv[3][2], hv[3][3]);
            *(u32x4*)(hb + (size_t)t * 1024 + c16) = p0; *(u32x4*)(hb + (size_t)t * 1024 + c16 + 8) = p1;
            if (lane == 0) rstd[t] = rsqrtf(ss * (1.0f / 1024.0f) + 1e-6f);
        }
        e0 = e0n; e1 = e1n; g0 = g0n; g1 = g1n; xa = xan; xb = xbn; rsv = rsn;
    }
#undef PEER_ISSUE_U
#undef PEER_ISSUE_V
}
#define PEER_PIPE(...) ph_peer_pipe4(__VA_ARGS__)
#else
#define PEER_PIPE(...) ph_peer_pipe<false>(__VA_ARGS__)
#endif


#if PEER_MX
typedef int i32x8 __attribute__((ext_vector_type(8)));
#define MXF(A_, B_, C_) __builtin_amdgcn_mfma_scale_f32_16x16x128_f8f6f4((A_), (B_), (C_), 4, 4, 0, 0x7F7F7F7F, 0, 0x7F7F7F7F)
#define MXFS(A_, B_, C_, SB_) __builtin_amdgcn_mfma_scale_f32_16x16x128_f8f6f4((A_), (B_), (C_), 4, 4, 0, 0x7F7F7F7F, 0, (SB_))
#define MX8(v_) ((i32x8){(int)(v_).x, (int)(v_).y, (int)(v_).z, (int)(v_).w, 0, 0, 0, 0})
namespace mx { constexpr int U0 = 0, VB = 16384, XQ = 49152, WF = 50176, WL = 51200, BASE = 57344; constexpr float XSC = 1.5f; }
DEV int mx_sw(int r) { return ((r & 3) << 2) | (r >> 2); }
#define MX_Q2(d1_, d2_, va_, vb_, sel_) do { d1_ = __builtin_amdgcn_cvt_scalef32_pk_fp4_f32(d1_, (va_), (vb_), 1.0f, sel_); const f32x2 q_ = __builtin_amdgcn_cvt_scalef32_pk_f32_fp4(d1_, 1.0f, sel_); \
        d2_ = __builtin_amdgcn_cvt_scalef32_pk_fp4_f32(d2_, ((va_) - q_[0]) * 8.0f, ((vb_) - q_[1]) * 8.0f, 1.0f, sel_); } while (0)
#define MX_Q3(d1_, d2_, d3_, va_, vb_, sel_) do { d1_ = __builtin_amdgcn_cvt_scalef32_pk_fp4_f32(d1_, (va_), (vb_), 1.0f, sel_); const f32x2 q_ = __builtin_amdgcn_cvt_scalef32_pk_f32_fp4(d1_, 1.0f, sel_); \
        const float ra_ = ((va_) - q_[0]) * 8.0f, rb_ = ((vb_) - q_[1]) * 8.0f; d2_ = __builtin_amdgcn_cvt_scalef32_pk_fp4_f32(d2_, ra_, rb_, 1.0f, sel_); const f32x2 p_ = __builtin_amdgcn_cvt_scalef32_pk_f32_fp4(d2_, 1.0f, sel_); \
        d3_ = __builtin_amdgcn_cvt_scalef32_pk_fp4_f32(d3_, (ra_ - p_[0]) * 8.0f, (rb_ - p_[1]) * 8.0f, 1.0f, sel_); } while (0)
DEV void ph_peer_mx(const Args& a, const int tid0, const int t0, const int tstride, const int ntok, const int* EL, const float* GL, const int tbase, PG8_LAS unsigned char* wl, unsigned char* wg) {
    const int lane = tid0 & 63, r = lane & 15, kq = lane >> 4;
    bf16_t* hb = wsb(a, HB_OFF); float* rstd = wsf(a, RSTD_OFF); const float* ssq = wsf(a, SSQ_OFF);
    const unsigned char* PU = a.ws + PTU_OFF; const unsigned char* PV = a.ws + PTV_OFF;
    const int c16 = 16 * lane;
#pragma unroll 1
    for (int j = 0; j < ntok; ++j) {
        const int t = t0 + tstride * j;
        const int* el = EL + (t - tbase) * 128; const float* gl = GL + (t - tbase) * 128;
        {   const u32x4 xa = *(const u32x4*)(hb + (size_t)t * 1024 + c16), xb = *(const u32x4*)(hb + (size_t)t * 1024 + c16 + 8);
            const float sc = rstd_parts(ssq, t) * mx::XSC;
            u32x2 q1 = {0u, 0u}, q2 = {0u, 0u};
            MX_Q2(q1.x, q2.x, bflo(xa.x) * sc, bfhi(xa.x) * sc, 0); MX_Q2(q1.x, q2.x, bflo(xa.y) * sc, bfhi(xa.y) * sc, 1); MX_Q2(q1.x, q2.x, bflo(xa.z) * sc, bfhi(xa.z) * sc, 2); MX_Q2(q1.x, q2.x, bflo(xa.w) * sc, bfhi(xa.w) * sc, 3);
            MX_Q2(q1.y, q2.y, bflo(xb.x) * sc, bfhi(xb.x) * sc, 0); MX_Q2(q1.y, q2.y, bflo(xb.y) * sc, bfhi(xb.y) * sc, 1); MX_Q2(q1.y, q2.y, bflo(xb.z) * sc, bfhi(xb.z) * sc, 2); MX_Q2(q1.y, q2.y, bflo(xb.w) * sc, bfhi(xb.w) * sc, 3);
            *(u32x2*)(wg + mx::XQ + 8 * lane) = q1; *(u32x2*)(wg + mx::XQ + 512 + 8 * lane) = q2; }
        u32x4 xB1[8], xB2[8];
#pragma unroll
        for (int s = 0; s < 8; ++s) { xB1[s] = *(const u32x4*)(wg + mx::XQ + 64 * s + 16 * kq); xB2[s] = *(const u32x4*)(wg + mx::XQ + 512 + 64 * s + 16 * kq); }
#pragma unroll 1
        for (int g = 0; g < 8; ++g) {
#pragma unroll
            for (int m = 0; m < 8; ++m) {
                const int row = 2 * m + (lane >> 5); const int e = el[16 * g + row];
                const unsigned char* gp = PU + (size_t)e * 512 + (((lane & 31) ^ mx_sw(row)) * 16);
                __builtin_amdgcn_global_load_lds((const unsigned*)gp, (PG8_LAS unsigned*)(wl + mx::U0 + m * 1024), 16, 0, 0);
            }
            asm volatile("s_waitcnt vmcnt(0)" ::: "memory");
            f32x4 acc1 = {0.f, 0.f, 0.f, 0.f}, acc2 = {0.f, 0.f, 0.f, 0.f};
#pragma unroll
            for (int s = 0; s < 8; ++s) {
                const u32x4 a4 = *(const u32x4*)(wg + mx::U0 + r * 512 + (((4 * s + kq) ^ mx_sw(r)) * 16));
                acc1 = MXF(MX8(a4), MX8(xB1[s]), acc1); acc2 = MXF(MX8(a4), MX8(xB2[s]), acc2);
            }
            const f32x4 gt = *(const f32x4*)(gl + 16 * g + 4 * kq);
            f32x4 w;
#pragma unroll
            for (int i2 = 0; i2 < 4; ++i2) { const float hp = (acc1[i2] + 0.125f * acc2[i2]) * (1.0f / (PEER_USC * mx::XSC)); w[i2] = gt[i2] * 0.5f * hp * (1.0f + erff(hp * 0.70710678f)); }
            if (r == 0) *(f32x4*)(wg + mx::WF + (16 * g + 4 * kq) * 4) = w;
            asm volatile("" ::: "memory");
        }
        float wmx = fmaxf(fabsf(*(const float*)(wg + mx::WF + 4 * lane)), fabsf(*(const float*)(wg + mx::WF + 256 + 4 * lane)));
        wmx = wave_max(wmx);
        const float wS = (wmx > 0.f) ? 4.0f * __builtin_amdgcn_rcpf(wmx) : 0.f, wIS = wmx * 0.25f * (1.0f / PEER_VSC);
        u32x4 wB1 = {0u, 0u, 0u, 0u}, wB2 = wB1, wB3 = wB1;
#pragma unroll
        for (int q = 0; q < 4; ++q) {
            const f32x4 w0 = *(const f32x4*)(wg + mx::WF + 128 * kq + 32 * q), w1 = *(const f32x4*)(wg + mx::WF + 128 * kq + 32 * q + 16);
            MX_Q3(wB1[q], wB2[q], wB3[q], w0[0] * wS, w0[1] * wS, 0); MX_Q3(wB1[q], wB2[q], wB3[q], w0[2] * wS, w0[3] * wS, 1);
            MX_Q3(wB1[q], wB2[q], wB3[q], w1[0] * wS, w1[1] * wS, 2); MX_Q3(wB1[q], wB2[q], wB3[q], w1[2] * wS, w1[3] * wS, 3);
        }
        float ss = 0.f;
#if !PEER_MXV
        {   f32x2 out[8];
#pragma unroll
            for (int i2 = 0; i2 < 8; ++i2) out[i2] = (f32x2){0.f, 0.f};
#pragma unroll 1
            for (int k = 0; k < 128; ++k) {
                const int e = el[k]; const u32x2 vw2 = *(const u32x2*)(PV + (size_t)e * 512 + 8 * lane);
                const float wi = *(const float*)(wg + mx::WF + 4 * k) * (1.0f / PEER_VSC); const f32x2 wv2 = {wi, wi};
#define PEER_VA(q_, sb_) out[q_ * 4 + sb_] = __builtin_elementwise_fma(__builtin_amdgcn_cvt_scalef32_pk_f32_fp4(vw2[q_], 1.0f, sb_), wv2, out[q_ * 4 + sb_])
                PEER_VA(0, 0); PEER_VA(0, 1); PEER_VA(0, 2); PEER_VA(0, 3); PEER_VA(1, 0); PEER_VA(1, 1); PEER_VA(1, 2); PEER_VA(1, 3);
#undef PEER_VA
            }
            float* hr = a.h + (size_t)t * 1024 + c16;
            f32x4 hv[4];
#pragma unroll
            for (int q = 0; q < 4; ++q) hv[q] = *(const f32x4*)(hr + 4 * q);
#pragma unroll
            for (int q = 0; q < 4; ++q) {
#pragma unroll
                for (int c = 0; c < 4; ++c) { hv[q][c] += out[2 * q + (c >> 1)][c & 1]; ss += hv[q][c] * hv[q][c]; }
                *(f32x4*)(hr + 4 * q) = hv[q];
            }
            u32x4 p0, p1;
            p0.x = pack2(hv[0][0], hv[0][1]); p0.y = pack2(hv[0][2], hv[0][3]); p0.z = pack2(hv[1][0], hv[1][1]); p0.w = pack2(hv[1][2], hv[1][3]);
            p1.x = pack2(hv[2][0], hv[2][1]); p1.y = pack2(hv[2][2], hv[2][3]); p1.z = pack2(hv[3][0], hv[3][1]); p1.w = pack2(hv[3][2], hv[3][3]);
            *(u32x4*)(hb + (size_t)t * 1024 + c16) = p0; *(u32x4*)(hb + (size_t)t * 1024 + c16 + 8) = p1;
        }
#else
#pragma unroll 1
        for (int hf = 0; hf < 2; ++hf) {
#pragma unroll 1
            for (int m4 = 0; m4 < 32; m4 += 4)
#pragma unroll
            for (int mm = 0; mm < 4; ++mm) {
                const int m = m4 + mm;
                const int ei = 4 * m + (lane >> 4); const int e = el[ei];
                const unsigned char* gp = PV + (size_t)e * 512 + ((hf * 16 + ((lane & 15) ^ (ei & 15))) * 16);
                __builtin_amdgcn_global_load_lds((const unsigned*)gp, (PG8_LAS unsigned*)(wl + mx::VB + m * 1024), 16, 0, 0);
            }
            asm volatile("s_waitcnt vmcnt(0)" ::: "memory");
#pragma unroll 1
            for (int cg = 0; cg < 2; ++cg) {
                f32x4 keep = {0.f, 0.f, 0.f, 0.f};
#pragma unroll
                for (int cb16 = 0; cb16 < 16; ++cb16) {
                    const int cb = cg * 16 + cb16;
                    const unsigned ad = (unsigned)(size_t)(wg + mx::VB) + (32 * kq + r) * 256 + (((cb >> 1) ^ r) * 16) + (cb & 1) * 8;
                    u32x2 lo, hi;
                    asm volatile("ds_read_b64_tr_b4 %0, %2\n\tds_read_b64_tr_b4 %1, %2 offset:4096\n\ts_waitcnt lgkmcnt(0)" : "=&v"(lo), "=&v"(hi) : "v"(ad) : "memory");
                    const i32x8 A8 = {(int)lo.x, (int)lo.y, (int)hi.x, (int)hi.y, 0, 0, 0, 0};
                    const f32x4 z = {0.f, 0.f, 0.f, 0.f};
                    const f32x4 d1 = MXF(A8, MX8(wB1), z), d2 = MXF(A8, MX8(wB2), z), d3 = MXF(A8, MX8(wB3), z);
                    const bool mine = (r == cb16);
#pragma unroll
                    for (int i2 = 0; i2 < 4; ++i2) keep[i2] = mine ? (d1[i2] + 0.125f * (d2[i2] + 0.125f * d3[i2])) : keep[i2];
                }
                const int c0 = hf * 512 + cg * 256 + 16 * r + 4 * kq;
                float* hr = a.h + (size_t)t * 1024 + c0;
                f32x4 hv = *(const f32x4*)hr;
#pragma unroll
                for (int i2 = 0; i2 < 4; ++i2) { hv[i2] += keep[i2] * wIS; ss += hv[i2] * hv[i2]; }
                *(f32x4*)hr = hv;
                u32x2 pk; pk.x = pack2(hv[0], hv[1]); pk.y = pack2(hv[2], hv[3]);
                *(u32x2*)(hb + (size_t)t * 1024 + c0) = pk;
            }
            asm volatile("" ::: "memory");
        }
#endif
        ss = wave_sum(ss);
        if (lane == 0) rstd[t] = rsqrtf(ss * (1.0f / 1024.0f) + 1e-6f);
        asm volatile("s_waitcnt vmcnt(0) lgkmcnt(0)" ::: "memory");
    }
}
#endif

#if PEER_MX == 2
#ifndef MXN
#define MXN 7
#endif
namespace mx2 { constexpr int XQ = MXN * 8192, WF = XQ + 1024, XR = XQ + 2048, HR = XQ + 4096, WL = XQ + 8192, BASE = 29696; }
static_assert(mx2::BASE + 2 * mx2::WL <= LDS_BYTES - 16, "LDS budget of the expert phase");
#define MX_WAIT(n_) asm volatile("s_waitcnt vmcnt(" #n_ ")" ::: "memory")
DEV void mx_ids(const int c, const int* el, const int lane, int (&e)[8]) {
    const int* p = (c < 8) ? el + 16 * c + (lane >> 5) : el + 32 * ((c - 8) & 3) + (lane >> 4);
    const int st = (c < 8) ? 2 : 4;
#pragma unroll
    for (int m = 0; m < 8; ++m) e[m] = p[st * m] & 16383;
}
DEV void mx_dma(const int c, const int (&e)[8], const int lane, const unsigned char* PU, const unsigned char* PV, PG8_LAS unsigned char* wl, int& slot) {
    PG8_LAS unsigned char* dst = wl + slot * 8192;
    if (c < 8) {
#pragma unroll
        for (int m = 0; m < 8; ++m) {
            const int row = 2 * m + (lane >> 5);
            const unsigned char* gp = PU + (size_t)e[m] * 512 + (((lane & 31) ^ mx_sw(row)) * 16);
            __builtin_amdgcn_global_load_lds((const unsigned*)gp, (PG8_LAS unsigned*)(dst + m * 1024), 16, 0, 0);
        }
    } else {
        const int hf = (c - 8) >> 2;
#pragma unroll
        for (int m = 0; m < 8; ++m) {
            const int li = 4 * m + (lane >> 4);
            const unsigned char* gp = PV + (size_t)e[m] * 512 + ((hf * 16 + ((lane & 15) ^ (li & 15))) * 16);
            __builtin_amdgcn_global_load_lds((const unsigned*)gp, (PG8_LAS unsigned*)(dst + m * 1024), 16, 0, 0);
        }
    }
    slot = (slot + 1 == MXN) ? 0 : slot + 1;
}
DEV void mx_dma_x(const bf16_t* hb, const int t, const int lane, PG8_LAS unsigned char* wl) {
#pragma unroll
    for (int i = 0; i < 2; ++i) __builtin_amdgcn_global_load_lds((const unsigned*)((const unsigned char*)hb + (size_t)t * 2048 + i * 1024 + lane * 16), (PG8_LAS unsigned*)(wl + mx2::XR + i * 1024), 16, 0, 0);
}
DEV void mx_dma_h(const float* h, const int t, const int lane, PG8_LAS unsigned char* wl) {
#pragma unroll
    for (int i = 0; i < 4; ++i) __builtin_amdgcn_global_load_lds((const unsigned*)((const unsigned char*)h + (size_t)t * 4096 + i * 1024 + lane * 16), (PG8_LAS unsigned*)(wl + mx2::HR + i * 1024), 16, 0, 0);
}
DEV float mx_erf(float x) { const float ax = fabsf(x), t = __builtin_amdgcn_rcpf(1.0f + 0.3275911f * ax);
    const float pl = ((((1.061405429f * t - 1.453152027f) * t + 1.421413741f) * t - 0.284496736f) * t + 0.254829592f) * t;
    return copysignf(1.0f - pl * __expf(-ax * ax), x); }
DEV void ph_peer_mx2(const Args& a, const int tid0, const int t0, const int tstride, const int ntok, const int* EL, const float* RL, const int tbase, PG8_LAS unsigned char* wl, unsigned char* wg) {
    const int lane = tid0 & 63, r = lane & 15, kq = lane >> 4, ri = r & 3;
    bf16_t* hb = wsb(a, HB_OFF); float* rstd = wsf(a, RSTD_OFF);
    const unsigned char* PU = a.ws + PTU_OFF; const unsigned char* PV = a.ws + PTV_OFF;
    if (ntok <= 0) return;
    int sm1[4], sm2[4];
#pragma unroll
    for (int q = 0; q < 4; ++q) { const bool on = ((r >> 2) == q); const int sh = 8 * (r & 3); sm1[q] = on ? (0x7F << sh) : 0; sm2[q] = on ? (0x7C << sh) : 0; }
    __builtin_amdgcn_s_setprio(PEER_PRIO);
    int islot = 0, cslot = 0;
    {   const int* el0 = EL + (t0 - tbase) * 128;
        mx_dma_x(hb, t0, lane, wl);
#pragma unroll 1
        for (int c = 0; c < MXN; ++c) { int e[8]; mx_ids(c, el0, lane, e); mx_dma(c, e, lane, PU, PV, wl, islot); }
        mx_dma_h(a.h, t0, lane, wl); }
#pragma unroll 1
    for (int j = 0; j < ntok; ++j) {
        const int t = t0 + tstride * j; const bool more = (j + 1 < ntok);
        const int* el = EL + (t - tbase) * 128; const int* eln = el + tstride * 128;
        if (j == 0) MX_WAIT(56); else MX_WAIT(32);
        {   const u32x4 xa = *(const u32x4*)(wg + mx2::XR + 32 * lane), xb = *(const u32x4*)(wg + mx2::XR + 32 * lane + 16);
            const float sc = RL[t - tbase] * mx::XSC;
            u32x2 q1 = {0u, 0u}, q2 = {0u, 0u};
            MX_Q2(q1.x, q2.x, bflo(xa.x) * sc, bfhi(xa.x) * sc, 0); MX_Q2(q1.x, q2.x, bflo(xa.y) * sc, bfhi(xa.y) * sc, 1); MX_Q2(q1.x, q2.x, bflo(xa.z) * sc, bfhi(xa.z) * sc, 2); MX_Q2(q1.x, q2.x, bflo(xa.w) * sc, bfhi(xa.w) * sc, 3);
            MX_Q2(q1.y, q2.y, bflo(xb.x) * sc, bfhi(xb.x) * sc, 0); MX_Q2(q1.y, q2.y, bflo(xb.y) * sc, bfhi(xb.y) * sc, 1); MX_Q2(q1.y, q2.y, bflo(xb.z) * sc, bfhi(xb.z) * sc, 2); MX_Q2(q1.y, q2.y, bflo(xb.w) * sc, bfhi(xb.w) * sc, 3);
            *(u32x2*)(wg + mx2::XQ + 8 * lane) = q1; *(u32x2*)(wg + mx2::XQ + 512 + 8 * lane) = q2; }
        u32x4 xB1[8], xB2[8];
#pragma unroll
        for (int s = 0; s < 8; ++s) { xB1[s] = *(const u32x4*)(wg + mx2::XQ + 64 * s + 16 * kq); xB2[s] = *(const u32x4*)(wg + mx2::XQ + 512 + 64 * s + 16 * kq); }
#pragma unroll 1
        for (int g = 0; g < 8; ++g) {
            int en[8]; mx_ids(g + MXN, el, lane, en);
            const float gt = (float)((unsigned)el[16 * g + 4 * kq + ri] >> 14) * (1.0f / 262143.0f);
            asm volatile("s_waitcnt vmcnt(%0)" :: "n"(8 * (MXN - 1)) : "memory");
            const unsigned char* ub = wg + cslot * 8192;
            f32x4 acc1 = {0.f, 0.f, 0.f, 0.f}, acc2 = {0.f, 0.f, 0.f, 0.f};
#pragma unroll
            for (int s = 0; s < 8; ++s) {
                const u32x4 a4 = *(const u32x4*)(ub + r * 512 + (((4 * s + kq) ^ mx_sw(r)) * 16));
#if MX_HWS
                acc1 = MXF(MX8(a4), MX8(xB1[s]), acc1); acc1 = MXFS(MX8(a4), MX8(xB2[s]), acc1, 0x7C7C7C7C);
#else
                acc1 = MXF(MX8(a4), MX8(xB1[s]), acc1); acc2 = MXF(MX8(a4), MX8(xB2[s]), acc2);
#endif
            }
            asm volatile("" ::: "memory");
            cslot = (cslot + 1 == MXN) ? 0 : cslot + 1;
            mx_dma(g + MXN, en, lane, PU, PV, wl, islot);
            const float d0 = acc1[0] + 0.125f * acc2[0], d1 = acc1[1] + 0.125f * acc2[1], d2 = acc1[2] + 0.125f * acc2[2], d3 = acc1[3] + 0.125f * acc2[3];
            const float hp = ((ri & 2) ? ((ri & 1) ? d3 : d2) : ((ri & 1) ? d1 : d0)) * (1.0f / (PEER_USC * mx::XSC));
            const float w = gt * 0.5f * hp * (1.0f + mx_erf(hp * 0.70710678f));
            if (r < 4) *(float*)(wg + mx2::WF + (16 * g + 4 * kq + r) * 4) = w;
            asm volatile("" ::: "memory");
        }
        float wmx = fmaxf(fabsf(*(const float*)(wg + mx2::WF + 4 * lane)), fabsf(*(const float*)(wg + mx2::WF + 256 + 4 * lane)));
        wmx = wave_max(wmx);
        const float wS = (wmx > 0.f) ? 4.0f * __builtin_amdgcn_rcpf(wmx) : 0.f, wIS = wmx * 0.25f * (1.0f / PEER_VSC);
        u32x4 wB1, wB2;
        {   const f32x2 wp = *(const f32x2*)(wg + mx2::WF + 4 * (32 * kq + 2 * r));
            unsigned b1 = 0u, b2 = 0u;
            MX_Q2(b1, b2, wp[0] * wS, wp[1] * wS, 0);
            unsigned char* wq = wg + mx2::WF + 512 + 16 * kq + r;
            wq[0] = (unsigned char)b1; wq[64] = (unsigned char)b2;
            wB1 = *(const u32x4*)(wg + mx2::WF + 512 + 16 * kq); wB2 = *(const u32x4*)(wg + mx2::WF + 576 + 16 * kq); }
        float ss = 0.f;
#pragma unroll 1
        for (int hf = 0; hf < 2; ++hf) {
            int e4[4][8];
#pragma unroll
            for (int i4 = 0; i4 < 4; ++i4) { const int ca = 8 + MXN + 4 * hf + i4; if (ca < 16) mx_ids(ca, el, lane, e4[i4]); else mx_ids(ca - 16, eln, lane, e4[i4]); }
            if (hf == 0 || more) asm volatile("s_waitcnt vmcnt(%0)" :: "n"(8 * (MXN - 4)) : "memory"); else MX_WAIT(0);
            int vs = cslot + kq; vs = (vs >= MXN) ? vs - MXN : vs;
            const unsigned vbase = (unsigned)(size_t)wg + vs * 8192 + r * 256;
#pragma unroll 1
            for (int cg = 0; cg < 2; ++cg) {
                f32x4 acc = {0.f, 0.f, 0.f, 0.f};
                u32x2 L0, H0, L1, H1, L2, H2;
#define MX_AD(cb_) (vbase + ((((cb_) >> 1) ^ r) * 16) + ((cb_) & 1) * 8)
#define MX_RD(Ln_, Hn_, cb_) asm volatile("ds_read_b64_tr_b4 %0, %2\n\tds_read_b64_tr_b4 %1, %2 offset:4096" : "=&v"(Ln_), "=&v"(Hn_) : "v"(MX_AD(cb_)) : "memory")
#define MX_RDW(Ln_, Hn_, Lc_, Hc_, cb_) asm volatile("ds_read_b64_tr_b4 %0, %4\n\tds_read_b64_tr_b4 %1, %4 offset:4096\n\ts_waitcnt lgkmcnt(4)" : "=&v"(Ln_), "=&v"(Hn_), "+v"(Lc_), "+v"(Hc_) : "v"(MX_AD(cb_)) : "memory")
#define MX_W(n_, Lc_, Hc_) asm volatile("s_waitcnt lgkmcnt(" #n_ ")" : "+v"(Lc_), "+v"(Hc_) :: "memory")
#define MX_MM(cb16_, Lc_, Hc_) do { const i32x8 A8 = {(int)Lc_.x, (int)Lc_.y, (int)Hc_.x, (int)Hc_.y, 0, 0, 0, 0}; \
                      \
                    acc = __builtin_amdgcn_mfma_scale_f32_16x16x128_f8f6f4(A8, MX8(wB1), acc, 4, 4, 0, 0x7F7F7F7F, (cb16_) & 3, sm1[(cb16_) >> 2]); \
                    acc = __builtin_amdgcn_mfma_scale_f32_16x16x128_f8f6f4(A8, MX8(wB2), acc, 4, 4, 0, 0x7F7F7F7F, (cb16_) & 3, sm2[(cb16_) >> 2]); } while (0)
                MX_RD(L0, H0, cg * 16); MX_RD(L1, H1, cg * 16 + 1);
                MX_RDW(L2, H2, L0, H0, cg * 16 + 2); MX_MM(0, L0, H0);   MX_RDW(L0, H0, L1, H1, cg * 16 + 3); MX_MM(1, L1, H1);   MX_RDW(L1, H1, L2, H2, cg * 16 + 4); MX_MM(2, L2, H2);
                MX_RDW(L2, H2, L0, H0, cg * 16 + 5); MX_MM(3, L0, H0);   MX_RDW(L0, H0, L1, H1, cg * 16 + 6); MX_MM(4, L1, H1);   MX_RDW(L1, H1, L2, H2, cg * 16 + 7); MX_MM(5, L2, H2);
                MX_RDW(L2, H2, L0, H0, cg * 16 + 8); MX_MM(6, L0, H0);   MX_RDW(L0, H0, L1, H1, cg * 16 + 9); MX_MM(7, L1, H1);   MX_RDW(L1, H1, L2, H2, cg * 16 + 10); MX_MM(8, L2, H2);
                MX_RDW(L2, H2, L0, H0, cg * 16 + 11); MX_MM(9, L0, H0);  MX_RDW(L0, H0, L1, H1, cg * 16 + 12); MX_MM(10, L1, H1); MX_RDW(L1, H1, L2, H2, cg * 16 + 13); MX_MM(11, L2, H2);
                MX_RDW(L2, H2, L0, H0, cg * 16 + 14); MX_MM(12, L0, H0); MX_RDW(L0, H0, L1, H1, cg * 16 + 15); MX_MM(13, L1, H1);
                MX_W(2, L2, H2); MX_MM(14, L2, H2); MX_W(0, L0, H0); MX_MM(15, L0, H0);
#undef MX_RD
#undef MX_RDW
#undef MX_W
#undef MX_MM
#undef MX_AD
                const int c0 = hf * 512 + cg * 256 + 16 * r + 4 * kq;
                f32x4 hv = *(const f32x4*)(wg + mx2::HR + 4 * c0);
#pragma unroll
                for (int i2 = 0; i2 < 4; ++i2) { hv[i2] += acc[i2] * wIS; ss += hv[i2] * hv[i2]; }
                *(f32x4*)(a.h + (size_t)t * 1024 + c0) = hv;
                u32x2 pk; pk.x = pack2(hv[0], hv[1]); pk.y = pack2(hv[2], hv[3]);
                *(u32x2*)(hb + (size_t)t * 1024 + c0) = pk;
            }
            asm volatile("" ::: "memory");
            cslot += 4; cslot = (cslot >= MXN) ? cslot - MXN : cslot;
#pragma unroll
            for (int i4 = 0; i4 < 4; ++i4) { const int ca = 8 + MXN + 4 * hf + i4; if (ca < 16) mx_dma(ca, e4[i4], lane, PU, PV, wl, islot); else if (more) mx_dma(ca - 16, e4[i4], lane, PU, PV, wl, islot); }
            if (more) { if (hf == 0) mx_dma_x(hb, t + tstride, lane, wl); else mx_dma_h(a.h, t + tstride, lane, wl); }
            asm volatile("" ::: "memory");
        }
        ss = wave_sum(ss);
        if (lane == 0) rstd[t] = rsqrtf(ss * (1.0f / 1024.0f) + 1e-6f);
    }
    asm volatile("s_waitcnt vmcnt(0) lgkmcnt(0)" ::: "memory");
    __builtin_amdgcn_s_setprio(0);
}
#endif

#ifndef PEER_NPW
#define PEER_NPW 2
#endif
DEV void ph_topk_peer(const Args& a, float* lds, const int tid0) {
    const int wv = __builtin_amdgcn_readfirstlane(tid0 >> 6);
    constexpr int TPW = T / NWG, MC = PEER_MC, NMC = TPW / MC, GPT = 8 / TOPK_NU;
    static_assert(TPW * NWG == T && NMC * MC == TPW, "token split");
#if PEER_MX == 2
    int* EL = (int*)(lds + 2048);
    float* RLb = (float*)(EL + 2 * MC * 128);
    int* CT = (int*)(RLb + 2 * MC);
    static_assert(8192 + 2 * MC * 128 * 4 + 2 * MC * 4 + 8 <= mx2::BASE, "list area");
    if (tid0 == 0) { CT[0] = 0; CT[1] = 0; }
#else
    int* EL = (int*)(lds + 4096);
    float* GL = (float*)(EL + 2 * MC * 128);
#endif
    const int tok_wg = blockIdx.x * TPW;
    __syncthreads();
#pragma unroll 1
    for (int s = 0; s <= NMC; ++s) {
        const int tsel = tok_wg + s * MC, tgat = tok_wg + (s - 1) * MC;
        int* ELs = EL + (s & 1) * MC * 128; const int* ELg = EL + ((s - 1) & 1) * MC * 128;
#if PEER_MX == 2
        float* RLs = RLb + (s & 1) * MC; const float* RLg = RLb + ((s - 1) & 1) * MC;
        if (tid0 == NTHR - 1) CT[(s + 1) & 1] = 0;
        if (s == 0) {
            ph_topk2(a, lds, tid0, tsel * GPT, 8, (tsel + MC) * GPT, ELs, nullptr, tsel, RLs, CT + (s & 1));
        } else if (wv < PEER_NPW) {
            ph_peer_mx2(a, tid0, tgat + wv, PEER_NPW, (MC - wv + PEER_NPW - 1) / PEER_NPW, ELg, RLg, tgat,
                        (PG8_LAS unsigned char*)smem + mx2::BASE + wv * mx2::WL, (unsigned char*)lds + mx2::BASE + wv * mx2::WL);
#if TOPK_DYN
            if (s < NMC) ph_topk2(a, lds, tid0, tsel * GPT, 8, (tsel + MC) * GPT, ELs, nullptr, tsel, RLs, CT + (s & 1));
#endif
        } else if (s < NMC) {
#if TOPK_DYN
#if TOPK_MIX
            if ((wv & 3) >= 2) ph_topk2<true>(a, lds, tid0, tsel * GPT, 8 - PEER_NPW, (tsel + MC) * GPT, ELs, nullptr, tsel, RLs, CT + (s & 1));
            else
#endif
            ph_topk2(a, lds, tid0, tsel * GPT, 8 - PEER_NPW, (tsel + MC) * GPT, ELs, nullptr, tsel, RLs, CT + (s & 1));
#else
            for (int rep_ = 0; rep_ < REP_TOPK; ++rep_)
            ph_topk2(a, lds, tid0, tsel * GPT + (wv - PEER_NPW), 8 - PEER_NPW, (tsel + MC) * GPT, ELs, nullptr, tsel, RLs);
#endif
        }
#else
        float* GLs = GL + (s & 1) * MC * 128; const float* GLg = GL + ((s - 1) & 1) * MC * 128;
        if (s == 0) {
            ph_topk2(a, lds, tid0, tsel * GPT + wv, 8, (tsel + MC) * GPT, ELs, GLs, tsel);
#if PEER_MX
        } else if (wv < PEER_NPW) {
            ph_peer_mx(a, tid0, tgat + wv, PEER_NPW, (MC - wv + PEER_NPW - 1) / PEER_NPW, ELg, GLg, tgat,
                       (PG8_LAS unsigned char*)smem + mx::BASE + wv * mx::WL, (unsigned char*)lds + mx::BASE + wv * mx::WL);
        } else if (s == NMC) {
#else
        } else if (s == NMC) {
            PEER_PIPE(a, tid0, tgat + wv, 8, (MC - wv + 7) / 8, ELg, GLg, tgat);
        } else if (wv < PEER_NPW) {
            PEER_PIPE(a, tid0, tgat + wv, PEER_NPW, (MC - wv + PEER_NPW - 1) / PEER_NPW, ELg, GLg, tgat);
#endif
        } else {
            ph_topk2(a, lds, tid0, tsel * GPT + (wv - PEER_NPW), 8 - PEER_NPW, (tsel + MC) * GPT, ELs, GLs, tsel);
        }
#endif
        __syncthreads();
    }
}

typedef float f32x4v __attribute__((ext_vector_type(4)));
#define MFMA16(a, b, c) __builtin_amdgcn_mfma_f32_16x16x32_bf16((a), (b), (c), 0, 0, 0)
namespace sc4 {
constexpr int E_AH = 0, E_RH = 2304, E_BH = 4608, E_KH = 6912, E_BHT = 9216, E_KHT = 12288, E_VT = 15360, E_GC = 18432, E_BYTES = 18688;
constexpr int G_NKAT = 0, G_NBRT = 768, G_NKRT = 1536, G_BYTES = 2304;
constexpr int OFF_E = 0, OFF_G = 6 * E_BYTES, OFF_NBAT = OFF_G + 4 * G_BYTES, OFF_TT = OFF_NBAT + 4 * 1024, OFF_Y = OFF_TT + 4 * 768, TOTAL = OFF_Y + 16384;
}
DEV bf16x8 frag2(u32x2 lo, u32x2 hi) { u32x4 v; v.x = lo.x; v.y = lo.y; v.z = hi.x; v.w = hi.y; return __builtin_bit_cast(bf16x8, v); }
DEV bf16x8 pack_acc(f32x4v p, f32x4v q) { u32x4 v; v.x = pack2(p[0], p[1]); v.y = pack2(p[2], p[3]); v.z = pack2(q[0], q[1]); v.w = pack2(q[2], q[3]); return __builtin_bit_cast(bf16x8, v); }
DEV void ph_scan4(const Args& a, int layer, unsigned char* lb, const int tid0) {
    using namespace sc4;
    static_assert(TOTAL <= LDS_BYTES - 16, "scan LDS map");
    const int lane = tid0 & 63, wv = __builtin_amdgcn_readfirstlane(tid0 >> 6);
    const int r = lane & 15, g = lane >> 4;
    const bf16_t* U = wsb(a, U_OFF); const bf16_t* RS = wsb(a, RS_OFF); const bf16_t* KS = wsb(a, KS_OFF); bf16_t* Uw = wsb(a, U_OFF);
    const bool is_state = wv < 4;
    const int dir = is_state ? (wv >> 1) : ((wv - 4) >> 1), role = wv & 1;
    const bf16_t* Wd = wsb(a, dir ? WB2_OFF : WF_OFF); const bf16_t* Ad = wsb(a, dir ? AB_OFF : AF_OFF);
    const u32x2 z2 = {0u, 0u}; const u32x4 z4 = {0u, 0u, 0u, 0u};
    for (int un = blockIdx.x; un < NSEQ * 8; un += gridDim.x) {
        const int seq = un >> 3, hd = un & 7; const size_t tb = (size_t)seq * 4096; const int cb = hd * 64, pch = cb + lane;
        const float kac = a.rwkv_k_a[layer * 512 + pch];
        __syncthreads();
        if (is_state) {
            f32x4v X[4][2];
#pragma unroll
            for (int m = 0; m < 4; ++m)
#pragma unroll
                for (int vt = 0; vt < 2; ++vt) X[m][vt] = (f32x4v){0.f, 0.f, 0.f, 0.f};
#pragma unroll 1
            for (int p = 0; p < 260; ++p) {
                if (p >= 2 && p < 258) {
                    const int n = p - 2;
                    const unsigned char* E = lb + OFF_E + (dir * 3 + (n % 3)) * E_BYTES;
                    const unsigned char* G = lb + OFF_G + (dir * 2 + (n & 1)) * G_BYTES;
                    float* yb = (float*)(lb + OFF_Y) + (((n & 1) * 2 + dir) * 16) * 64 + 32 * role;
                    bf16x8 fa[2], fr[2];
#pragma unroll
                    for (int s = 0; s < 2; ++s) {
                        fa[s] = frag2(*(const u32x2*)(E + E_AH + r * 144 + 2 * (32 * s + 4 * g)), *(const u32x2*)(E + E_AH + r * 144 + 2 * (32 * s + 16 + 4 * g)));
                        fr[s] = frag2(*(const u32x2*)(E + E_RH + r * 144 + 2 * (32 * s + 4 * g)), *(const u32x2*)(E + E_RH + r * 144 + 2 * (32 * s + 16 + 4 * g)));
                    }
                    const int g1 = g & 1;
                    u32x4 nka = *(const u32x4*)(G + G_NKAT + r * 48 + 16 * g1), nkr = *(const u32x4*)(G + G_NKRT + r * 48 + 16 * g1);
                    if (g >= 2) { nka = z4; nkr = z4; }
                    const bf16x8 fnka = __builtin_bit_cast(bf16x8, nka), fnkr = __builtin_bit_cast(bf16x8, nkr);
                    bf16x8 ftt;
                    {
                        const float* nbat = (const float*)(lb + OFF_NBAT + (dir * 2 + (n & 1)) * 1024);
                        unsigned char* tts = lb + OFF_TT + wv * 768;
                        float Tr[16];
#pragma unroll
                        for (int tg = 0; tg < 4; ++tg) {
                            f32x4v nbq[4][4];
#pragma unroll
                            for (int tt = 0; tt < 4; ++tt)
#pragma unroll
                                for (int i4 = 0; i4 < 4; ++i4) if (4 * i4 < 4 * tg + tt) nbq[tt][i4] = *(const f32x4v*)(nbat + (4 * tg + tt) * 16 + 4 * i4);
#pragma unroll
                            for (int tt = 0; tt < 4; ++tt) {
                                const int t = 4 * tg + tt;
                                float acc = (lane == t) ? 1.0f : 0.f, acc2 = 0.f;
#pragma unroll
                                for (int i = 0; i < t; ++i) { const float pr_ = Tr[i] * nbq[tt][i >> 2][i & 3]; if (i & 1) acc2 += pr_; else acc += pr_; }
                                acc += acc2; Tr[t] = acc;
                                if (lane < 16) *(unsigned short*)(tts + t * 48 + 2 * lane) = (unsigned short)f2bf(acc);
                            }
                        }
                        asm volatile("s_waitcnt lgkmcnt(0)" ::: "memory");
                        ftt = frag2(*(const u32x2*)(tts + r * 48 + 8 * g), z2);
                    }
                    const bf16x8 fnbr = frag2(*(const u32x2*)(G + G_NBRT + r * 48 + 8 * g), z2);
                    bf16x8 fbt[4], fkt[4]; f32x4v gc[4];
#pragma unroll
                    for (int m = 0; m < 4; ++m) {
                        fbt[m] = frag2(*(const u32x2*)(E + E_BHT + (16 * m + r) * 48 + 8 * g), z2);
                        u32x4 kt = *(const u32x4*)(E + E_KHT + (16 * m + r) * 48 + 16 * g1); if (g >= 2) kt = z4; fkt[m] = __builtin_bit_cast(bf16x8, kt);
                        gc[m] = *(const f32x4v*)(E + E_GC + 4 * (16 * m + 4 * g));
                    }
#pragma unroll
                    for (int vt = 0; vt < 2; ++vt) {
                        const int v0 = 32 * role + 16 * vt;
                        u32x4 vv = *(const u32x4*)(E + E_VT + (v0 + r) * 48 + 16 * g1); if (g >= 2) vv = z4;
                        const bf16x8 vb = __builtin_bit_cast(bf16x8, vv);
                        const bf16x8 xb0 = pack_acc(X[0][vt], X[1][vt]), xb1 = pack_acc(X[2][vt], X[3][vt]);
                        f32x4v W = {0.f, 0.f, 0.f, 0.f};
                        W = MFMA16(fa[0], xb0, W); W = MFMA16(fa[1], xb1, W); W = MFMA16(fnka, vb, W);
                        const f32x4v zero4 = {0.f, 0.f, 0.f, 0.f};
                        f32x4v Uc = MFMA16(ftt, pack_acc(W, zero4), zero4);
                        const bf16x8 ub = pack_acc(Uc, zero4);
                        f32x4v Y = {0.f, 0.f, 0.f, 0.f};
                        Y = MFMA16(fr[0], xb0, Y); Y = MFMA16(fr[1], xb1, Y); Y = MFMA16(fnbr, ub, Y); Y = MFMA16(fnkr, vb, Y);
#pragma unroll
                        for (int i = 0; i < 4; ++i) yb[(4 * g + i) * 64 + 16 * vt + r] = Y[i];
#pragma unroll
                        for (int m = 0; m < 4; ++m) { f32x4v xm = MFMA16(fbt[m], ub, X[m][vt]); xm = MFMA16(fkt[m], vb, xm); X[m][vt] = xm * gc[m]; }
                    }
                }
                __syncthreads();
            }
        } else {
            unsigned short prA[8][6], pwA[8], prB[8][6], pwB[8];
#define SC5_ISSUE(pr, pw, n_) do { _Pragma("unroll") for (int s_ = 0; s_ < 8; ++s_) { const int step_ = (n_) * 16 + 8 * role + s_, pos_ = dir ? 4095 - step_ : step_; const size_t t_ = tb + pos_; \
            pr[s_][0] = Wd[t_ * 512 + pch]; pr[s_][1] = U[t_ * UW + pch]; pr[s_][2] = Ad[t_ * 512 + pch]; pr[s_][3] = KS[t_ * 512 + pch]; pr[s_][4] = RS[t_ * 512 + pch]; pr[s_][5] = U[t_ * UW + 1536 + pch]; \
            if (role) { const int st0_ = (n_) * 16 + s_, p0_ = dir ? 4095 - st0_ : st0_; pw[s_] = Wd[(tb + p0_) * 512 + pch]; } } } while (0)
            SC5_ISSUE(prA, pwA, 0); SC5_ISSUE(prB, pwB, 1);
#define SC5_PERIOD(pr, pw, p_) do { const int p = (p_); \
                if (p < 256) { \
                    unsigned char* E = lb + OFF_E + (dir * 3 + (p % 3)) * E_BYTES; \
                    float gcur = 1.0f; \
                    if (role) { \
_Pragma("unroll") \
                        for (int s = 0; s < 8; ++s) gcur *= bf2f(pw[s]); \
                    } \
                    unsigned bt[4], kt[4], vtw[4]; \
_Pragma("unroll") \
                    for (int s = 0; s < 8; ++s) { \
                        const int st = 8 * role + s; \
                        const float w_ = bf2f(pr[s][0]), kk_ = bf2f(pr[s][1]), ic_ = bf2f(pr[s][2]), ks_ = bf2f(pr[s][3]), r_ = bf2f(pr[s][4]); \
                        const float gprev = gcur; gcur *= w_; \
                        const float ig = __builtin_amdgcn_rcpf(gcur); \
                        const unsigned ah = f2bf(-gprev * kk_), bh = f2bf(kk_ * ic_ * ig), kh = f2bf(ks_ * (1.0f + (ic_ - 1.0f) * kac) * ig), rh = f2bf(gcur * r_), vh = pr[s][5]; \
                        *(unsigned short*)(E + E_AH + st * 144 + 2 * lane) = (unsigned short)ah; *(unsigned short*)(E + E_RH + st * 144 + 2 * lane) = (unsigned short)rh; \
                        *(unsigned short*)(E + E_BH + st * 144 + 2 * lane) = (unsigned short)bh; *(unsigned short*)(E + E_KH + st * 144 + 2 * lane) = (unsigned short)kh; \
                        if (s & 1) { bt[s >> 1] |= bh << 16; kt[s >> 1] |= kh << 16; vtw[s >> 1] |= vh << 16; } else { bt[s >> 1] = bh; kt[s >> 1] = kh; vtw[s >> 1] = vh; } \
                    } \
                    *(u32x4*)(E + E_BHT + lane * 48 + 16 * role) = (u32x4){bt[0], bt[1], bt[2], bt[3]}; \
                    *(u32x4*)(E + E_KHT + lane * 48 + 16 * role) = (u32x4){kt[0], kt[1], kt[2], kt[3]}; \
                    *(u32x4*)(E + E_VT + lane * 48 + 16 * role) = (u32x4){vtw[0], vtw[1], vtw[2], vtw[3]}; \
                    if (role) *(float*)(E + E_GC + 4 * lane) = gcur; \
                } \
                if (role == 0) { \
                    if (p >= 1 && p < 257) { \
                        const int n = p - 1; \
                        const unsigned char* E = lb + OFF_E + (dir * 3 + (n % 3)) * E_BYTES; \
                        unsigned char* G = lb + OFF_G + (dir * 2 + (n & 1)) * G_BYTES; \
                        float* nbat = (float*)(lb + OFF_NBAT + (dir * 2 + (n & 1)) * 1024); \
                        bf16x8 ab[2], rb[2], bA[2], kA[2]; \
_Pragma("unroll") \
                        for (int s = 0; s < 2; ++s) { \
                            ab[s] = *(const bf16x8*)(E + E_AH + r * 144 + 2 * (32 * s + 8 * g)); rb[s] = *(const bf16x8*)(E + E_RH + r * 144 + 2 * (32 * s + 8 * g)); \
                            bA[s] = *(const bf16x8*)(E + E_BH + r * 144 + 2 * (32 * s + 8 * g)); kA[s] = *(const bf16x8*)(E + E_KH + r * 144 + 2 * (32 * s + 8 * g)); \
                        } \
                        const f32x4v zero4 = {0.f, 0.f, 0.f, 0.f}; \
                        f32x4v nba = MFMA16(bA[1], ab[1], MFMA16(bA[0], ab[0], zero4)), nka = MFMA16(kA[1], ab[1], MFMA16(kA[0], ab[0], zero4)); \
                        f32x4v nbr = MFMA16(bA[1], rb[1], MFMA16(bA[0], rb[0], zero4)), nkr = MFMA16(kA[1], rb[1], MFMA16(kA[0], rb[0], zero4)); \
_Pragma("unroll") \
                        for (int i = 0; i < 4; ++i) { const int j = 4 * g + i; if (j >= r) { nba[i] = 0.f; nka[i] = 0.f; } if (j > r) { nbr[i] = 0.f; nkr[i] = 0.f; } } \
                        *(f32x4v*)(nbat + r * 16 + 4 * g) = nba; \
                        u32x2 pk; pk.x = pack2(nka[0], nka[1]); pk.y = pack2(nka[2], nka[3]); *(u32x2*)(G + G_NKAT + r * 48 + 8 * g) = pk; \
                        pk.x = pack2(nbr[0], nbr[1]); pk.y = pack2(nbr[2], nbr[3]); *(u32x2*)(G + G_NBRT + r * 48 + 8 * g) = pk; \
                        pk.x = pack2(nkr[0], nkr[1]); pk.y = pack2(nkr[2], nkr[3]); *(u32x2*)(G + G_NKRT + r * 48 + 8 * g) = pk; \
                    } \
                } else { \
                    if (p >= 3 && p < 259) { \
                        const int n = p - 3; \
                        const float* yb = (const float*)(lb + OFF_Y) + (((n & 1) * 2 + dir) * 16) * 64; \
                        const int s2 = lane >> 2, c16 = (lane & 3) * 16; \
                        const f32x4v y0 = *(const f32x4v*)(yb + s2 * 64 + c16), y1 = *(const f32x4v*)(yb + s2 * 64 + c16 + 4), y2 = *(const f32x4v*)(yb + s2 * 64 + c16 + 8), y3 = *(const f32x4v*)(yb + s2 * 64 + c16 + 12); \
                        const int step = n * 16 + s2, pos = dir ? 4095 - step : step; \
                        u32x4 o0, o1; o0.x = pack2(y0[0], y0[1]); o0.y = pack2(y0[2], y0[3]); o0.z = pack2(y1[0], y1[1]); o0.w = pack2(y1[2], y1[3]); \
                        o1.x = pack2(y2[0], y2[1]); o1.y = pack2(y2[2], y2[3]); o1.z = pack2(y3[0], y3[1]); o1.w = pack2(y3[2], y3[3]); \
                        bf16_t* dst = Uw + (tb + pos) * UW + 512 + 512 * dir + cb + c16; \
                        *(u32x4*)(dst) = o0; *(u32x4*)(dst + 8) = o1; \
                    } \
                } \
                if (p + 2 < 256) SC5_ISSUE(pr, pw, p + 2); \
                __syncthreads(); \
            } while (0)
#pragma unroll 1
            for (int p2 = 0; p2 < 260; p2 += 2) { SC5_PERIOD(prA, pwA, p2); SC5_PERIOD(prB, pwB, p2 + 1); }
#undef SC5_PERIOD
#undef SC5_ISSUE
        }
    }
}

extern __shared__ __attribute__((aligned(16))) unsigned char smem[];

enum { PH_PROLOGUE = 0, PH_ROWPREP_X, PH_GEMM1, PH_ATTN, PH_LORA, PH_PREP2, PH_SCAN, PH_POST, PH_GEMM2, PH_CONVERT, PH_GEMM3, PH_TOPK, PH_PEER, PH_PEERDRY, PH_TOPKPEER, PH_GEMM4A, PH_GEMM4B, PH_FINAL };

template <int PH> DEV void run_phase(const Args& a, int layer, const int tid0) {
    float* ldsf = (float*)smem;
    PG8_LAS unsigned char* ldsg = (PG8_LAS unsigned char*)smem;
    const bf16_t* wb = wsb(a, WB_OFF + (size_t)layer * WB_LAYER);
    if constexpr (PH == PH_PROLOGUE) ph_prologue(a, ldsf, tid0);
    else if constexpr (PH == PH_ROWPREP_X) ph_rowprep(a, true, tid0);
    else if constexpr (PH == PH_GEMM1) {
        pg8::Gemm g{wsb(a, HB_OFF), wb + WB_IN / 2, T, INP, 1024};
        pg8::StaticOrder S; S.init(T, INP, gridDim.x, blockIdx.x);
        pg8::EpiProj E{wsb(a, QKV_OFF), wsb(a, U_OFF), wsf(a, SSQ_OFF), wsf(a, ROPEC_OFF), wsf(a, ROPES_OFF)};
        pg8::gemm_phase<pg8::EpiProj, pg8::StaticOrder, false>(ldsg, g, S, E, nullptr, tid0);
    }
    else if constexpr (PH == PH_ATTN) ph_attn3(a, layer, smem, tid0);
    else if constexpr (PH == PH_LORA) ph_rwkv_prep1(a, layer, smem, tid0);
    else if constexpr (PH == PH_PREP2) ph_rwkv_prep2(a, layer, tid0);
    else if constexpr (PH == PH_SCAN) ph_scan4(a, layer, smem, tid0);
    else if constexpr (PH == PH_POST) ph_post2(a, layer, tid0);
    else if constexpr (PH == PH_GEMM2) {
        pg8::Gemm g{wsb(a, MIX_OFF), wb + WB_OUT / 2, T, 1024, 1024};
        pg8::StaticOrder S; S.init(T, 1024, gridDim.x, blockIdx.x);
        pg8::EpiF32x<1> E{a.h, 1024, nullptr, wsb(a, HB_OFF), wsf(a, SSQ_OFF)};
        pg8::gemm_phase<pg8::EpiF32x<1>, pg8::StaticOrder, false>(ldsg, g, S, E, nullptr, tid0);
    }
    else if constexpr (PH == PH_CONVERT) ph_convert8(a, layer, tid0);
    else if constexpr (PH == PH_GEMM3) {
        pg8::Gemm g{wsb(a, HB_OFF), wb + WB_QK / 2, T, 2048, 1024};
        pg8::StaticOrder S; S.init(T, 2048, gridDim.x, blockIdx.x);
        pg8::EpiF32x<0> E{wsf(a, SC_OFF), 2048, nullptr, nullptr, nullptr};
        pg8::gemm_phase<pg8::EpiF32x<0>, pg8::StaticOrder, false>(ldsg, g, S, E, nullptr, tid0);
    }
    else if constexpr (PH == PH_TOPK) ph_topk2(a, ldsf, tid0, blockIdx.x * 8 + (tid0 >> 6), gridDim.x * 8, T * (8 / TOPK_NU), (int*)(a.ws + TOPI_OFF), wsf(a, TOPG_OFF), 0);
    else if constexpr (PH == PH_TOPKPEER) ph_topk_peer(a, ldsf, tid0);
    else if constexpr (PH == PH_PEER) ph_peer_pipe<false>(a, tid0, blockIdx.x * 8 + (tid0 >> 6), gridDim.x * 8, T / (gridDim.x * 8), (const int*)(a.ws + TOPI_OFF), wsf(a, TOPG_OFF), 0);
    else if constexpr (PH == PH_PEERDRY) ph_peer_pipe<true>(a, tid0, blockIdx.x * 8 + (tid0 >> 6), gridDim.x * 8, T / (gridDim.x * 8), (const int*)(a.ws + TOPI_OFF), wsf(a, TOPG_OFF), 0);
    else if constexpr (PH == PH_GEMM4A) {
        pg8::Gemm g{wsb(a, HB_OFF), wb + WB_GATE / 2, T, 1024, 1024};
        pg8::StaticOrder S; S.init(T, 1024, gridDim.x, blockIdx.x);
        pg8::EpiGate E{wsb(a, GATE_OFF), wsf(a, RSTD_OFF), a.ple_b_gate + layer * 1024};
        pg8::gemm_phase<pg8::EpiGate, pg8::StaticOrder, false>(ldsg, g, S, E, nullptr, tid0);
    }
    else if constexpr (PH == PH_GEMM4B) {
        pg8::Gemm g{wsb(a, PB_OFF), wb + WB_PROJ / 2, T, 1024, 256};
        pg8::StaticOrder S; S.init(T, 1024, gridDim.x, blockIdx.x);
        pg8::EpiF32x<2> E{a.h, 1024, wsb(a, GATE_OFF), wsb(a, HB_OFF), wsf(a, SSQ_OFF)};
        pg8::gemm_phase<pg8::EpiF32x<2>, pg8::StaticOrder, false>(ldsg, g, S, E, nullptr, tid0);
    }
    else if constexpr (PH == PH_FINAL) ph_final(a, tid0);
}

#if !ONE_LAUNCH
template <int PH> __global__ void __launch_bounds__(NTHR, 2) k_phase(Args a, int layer) { run_phase<PH>(a, layer, (int)threadIdx.x); }
#endif

#if ONE_LAUNCH
#ifndef REP_PEER
#define REP_PEER 1
#endif
#ifndef REP_SCAN
#define REP_SCAN 1
#endif
#ifndef REP_TOPK
#define REP_TOPK 1
#endif
#ifndef REP_GEMM1
#define REP_GEMM1 1
#endif
#ifndef REP_LORA
#define REP_LORA 1
#endif
#ifndef REP_POST
#define REP_POST 1
#endif
#ifndef REP_ATTN
#define REP_ATTN 1
#endif
#ifndef REP_GEMM3
#define REP_GEMM3 1
#endif
typedef const __attribute__((address_space(4))) unsigned long long* kargs_t;
static_assert(sizeof(Args) == 31 * 8, "Args is 31 pointers, no padding");
#define AS1 __attribute__((address_space(1)))
DEV Args load_args(kargs_t kp) {
    Args r; const float** d = (const float**)&r;
#pragma unroll
    for (int i = 0; i < 29; ++i) d[i] = (const float*)(AS1 const float*)kp[i];
    r.h = (float*)(AS1 float*)kp[29]; r.ws = (unsigned char*)(AS1 unsigned char*)kp[30];
    return r; }
#define RUN(PH, layer) do { kargs_t kp_ = (kargs_t)__builtin_amdgcn_kernarg_segment_ptr(); asm volatile("" : "+s"(kp_)); const Args la_ = load_args(kp_); int t_; asm volatile("v_mbcnt_lo_u32_b32 %0, -1, 0\n\tv_mbcnt_hi_u32_b32 %0, -1, %0\n\tv_lshl_add_u32 %0, %1, 6, %0" : "=&v"(t_) : "s"(wv0_)); run_phase<PH>(la_, layer, t_); } while (0)
#define BAR() do { kargs_t kp_ = (kargs_t)__builtin_amdgcn_kernarg_segment_ptr(); asm volatile("" : "+s"(kp_)); XcdBarrier b_; b_.bar = (unsigned*)((unsigned char*)kp_[30] + BAR_OFF); b_.x = xb_xcc_id(); b_.st = (volatile LAS unsigned*)(smem + LDS_BYTES - 16); int t_; asm volatile("v_mbcnt_lo_u32_b32 %0, -1, 0\n\tv_mbcnt_hi_u32_b32 %0, -1, %0\n\tv_lshl_add_u32 %0, %1, 6, %0" : "=&v"(t_) : "s"(wv0_)); xcd_barrier(b_, t_); } while (0)
#define LAYER_BODY(layer) do { \
        for (int rep_ = 0; rep_ < REP_GEMM1; ++rep_) { RUN(PH_GEMM1, layer); BAR(); } \
        for (int rep_ = 0; rep_ < REP_ATTN; ++rep_) { RUN(PH_ATTN, layer); BAR(); } \
        for (int rep_ = 0; rep_ < REP_LORA; ++rep_) { RUN(PH_LORA, layer); BAR(); } \
        for (int rep_ = 0; rep_ < REP_PREP2; ++rep_) { RUN(PH_PREP2, layer); BAR(); } \
        for (int rep_ = 0; rep_ < REP_SCAN; ++rep_) { RUN(PH_SCAN, layer); BAR(); } \
        for (int rep_ = 0; rep_ < REP_POST; ++rep_) { RUN(PH_POST, layer); BAR(); } \
        RUN(PH_GEMM2, layer); RUN(PH_CONVERT, layer); BAR(); \
        for (int rep_ = 0; rep_ < REP_GEMM3; ++rep_) { RUN(PH_GEMM3, layer); BAR(); } \
        RUN(PH_TOPKPEER, layer); BAR(); \
        for (int rep_ = 0; rep_ < REP_GEMM4A; ++rep_) { RUN(PH_GEMM4A, layer); BAR(); } \
        RUN(PH_GEMM4B, layer); BAR(); \
    } while (0)
__global__ void __launch_bounds__(NTHR, 2) k_mega(Args a) {
    if (threadIdx.x == 0) *(uint4*)(smem + LDS_BYTES - 16) = make_uint4(0u, 0u, 0u, 0u);
    __syncthreads();
    (void)xcd_barrier_post((unsigned*)(a.ws + BAR_OFF), (volatile LAS unsigned*)(smem + LDS_BYTES - 16));
    const int wv0_ = __builtin_amdgcn_readfirstlane((int)threadIdx.x >> 6);
    RUN(PH_PROLOGUE, 0);
    RUN(PH_ROWPREP_X, 0); BAR();
    LAYER_BODY(0); LAYER_BODY(1); LAYER_BODY(2); LAYER_BODY(3);
    RUN(PH_FINAL, 0);
}
#endif

#if !ONE_LAUNCH
template <int PH> static void launch_phase(const Args& a, int layer, hipStream_t st) {
    static bool attr = false;
    if (!attr) { (void)hipFuncSetAttribute((const void*)k_phase<PH>, hipFuncAttributeMaxDynamicSharedMemorySize, LDS_BYTES); attr = true; }
    hipLaunchKernelGGL(k_phase<PH>, dim3(NWG), dim3(NTHR), LDS_BYTES, st, a, layer);
}
#endif

extern "C" void kernel_launch(void* const* d_in, const int* in_sizes, int n_in, void* d_out, int out_size, void* d_ws, size_t ws_size, hipStream_t stream) {
    if (n_in != 29 || out_size != T * D || ws_size < WS_END) {
        fprintf(stderr, "kernel_launch: unexpected shapes (n_in %d, out %d, ws %zu, need %zu); nothing launched\n", n_in, out_size, ws_size, (size_t)WS_END);
        return;
    }
    Args a{};
    const float** ap = (const float**)&a;
    for (int i = 0; i < 29; ++i) ap[i] = (const float*)d_in[i];
    a.h = (float*)d_out; a.ws = (unsigned char*)d_ws;
#if ONE_LAUNCH
    static bool attr = false;
    if (!attr) { (void)hipFuncSetAttribute((const void*)k_mega, hipFuncAttributeMaxDynamicSharedMemorySize, LDS_BYTES); attr = true; }
    (void)hipMemsetAsync((char*)d_ws + BAR_OFF, 0, XCD_BAR_WORDS * sizeof(unsigned), stream);
    hipLaunchKernelGGL(k_mega, dim3(NWG), dim3(NTHR), LDS_BYTES, stream, a);
#else
    launch_phase<PH_PROLOGUE>(a, 0, stream);
    launch_phase<PH_ROWPREP_X>(a, 0, stream);
    for (int layer = 0; layer < NL; ++layer) {
        launch_phase<PH_GEMM1>(a, layer, stream);
        launch_phase<PH_ATTN>(a, layer, stream);
        launch_phase<PH_LORA>(a, layer, stream);
        launch_phase<PH_PREP2>(a, layer, stream);
        launch_phase<PH_SCAN>(a, layer, stream);
        launch_phase<PH_POST>(a, layer, stream);
        launch_phase<PH_GEMM2>(a, layer, stream);
        launch_phase<PH_CONVERT>(a, layer, stream);
        launch_phase<PH_GEMM3>(a, layer, stream);
        launch_phase<PH_TOPK>(a, layer, stream);
        launch_phase<PH_PEER>(a, layer, stream);
        launch_phase<PH_GEMM4A>(a, layer, stream);
        launch_phase<PH_GEMM4B>(a, layer, stream);
    }
    launch_phase<PH_FINAL>(a, 0, stream);
#endif
}
```

```cpp
#include <hip/hip_runtime.h>
#include <stdint.h>
#include <stdio.h>

#ifndef ONE_LAUNCH
#define ONE_LAUNCH 1
#endif

#ifndef REP_PREP2
#define REP_PREP2 1
#endif
#ifndef REP_CONVERT
#define REP_CONVERT 1
#endif
#ifndef REP_GEMM4A
#define REP_GEMM4A 1
#endif
#ifndef REP_ATTNX
#define REP_ATTNX 0
#endif
#ifndef REP_MERGE
#define REP_MERGE 0
#endif
#ifndef FP4_EMU
#define FP4_EMU 0
#endif
#ifndef PEER_FP4
#define PEER_FP4 1
#endif
#define PEER_USC 64.0f
#define PEER_VSC 10.0f
#ifndef PEER_MX
#define PEER_MX 2
#endif
#ifndef PEER_MXU
#define PEER_MXU 1
#endif
#ifndef PEER_MXV
#define PEER_MXV 1
#endif
#ifndef PEER_XF4
#define PEER_XF4 0
#endif
#ifndef REP_TOPK
#define REP_TOPK 1
#endif
#ifndef PEER_PRIO
#define PEER_PRIO 0
#endif
#ifndef MX_HWS
#define MX_HWS 1
#endif
#ifndef PEER_MC
#define PEER_MC 10
#endif
#ifndef TOPK_DYN
#define TOPK_DYN 1
#endif
#ifndef TOPK_MIX
#define TOPK_MIX 0
#endif
#ifndef TOPK_PRIO
#define TOPK_PRIO 0
#endif
#ifndef PEER_SAMESIMD
#define PEER_SAMESIMD 0
#endif
#if PEER_SAMESIMD
#define PEER_ISPW(wv_) (((wv_) & 3) == 0)
#define PEER_PWI(wv_) ((wv_) >> 2)
#else
#define PEER_ISPW(wv_) ((wv_) < PEER_NPW)
#define PEER_PWI(wv_) (wv_)
#endif
#ifndef ATTN_VAR
#define ATTN_VAR 0
#endif

typedef unsigned short bf16_t;
typedef float f32x4 __attribute__((ext_vector_type(4)));
typedef float f32x2 __attribute__((ext_vector_type(2)));
typedef unsigned u32x4 __attribute__((ext_vector_type(4)));
typedef unsigned u32x2 __attribute__((ext_vector_type(2)));
typedef __bf16 bf16x2_t __attribute__((ext_vector_type(2)));

#define DEV __device__ __forceinline__

namespace cfg {
constexpr int NSEQ = 20, SEQ = 4096, T = NSEQ * SEQ, TP = 4 * SEQ, D = 1024, NL = 4;
constexpr int INC = 3456, INP = 3584;
constexpr int QKVW = 1536, UW = 2048, UC = 1920;
constexpr int NWG = 256, NTHR = 512;
constexpr int LDS_BYTES = 163840;
constexpr size_t MiB = 1ull << 20;
constexpr size_t WB_OFF = 0;
constexpr size_t WB_LAYER = 16 * MiB;
constexpr size_t WB_IN = 0, WB_OUT = 7 * MiB, WB_QK = 9 * MiB, WB_GATE = 13 * MiB, WB_PROJ = 15 * MiB, WB_LORA = 15 * MiB + 512 * 1024;
constexpr size_t HB_OFF = 64 * MiB;
constexpr size_t MIX_OFF = 224 * MiB;
constexpr size_t SMALL_OFF = 384 * MiB;
constexpr size_t RSTD_OFF = SMALL_OFF;
constexpr size_t ROPEC_OFF = SMALL_OFF + 512 * 1024, ROPES_OFF = SMALL_OFF + 640 * 1024;
constexpr size_t BAR_OFF = SMALL_OFF + 1 * MiB;
constexpr size_t BIG_OFF = 386 * MiB;
constexpr size_t QKV_OFF = BIG_OFF;
constexpr size_t RS_OFF = BIG_OFF, KS_OFF = BIG_OFF + 80 * MiB, G_OFF = BIG_OFF + 160 * MiB;
constexpr size_t U_OFF = BIG_OFF + 240 * MiB;
constexpr size_t WF_OFF = BIG_OFF + 560 * MiB, WB2_OFF = BIG_OFF + 640 * MiB, AF_OFF = BIG_OFF + 720 * MiB, AB_OFF = BIG_OFF + 800 * MiB;
constexpr size_t OP_OFF = BIG_OFF + 560 * MiB;
constexpr size_t ML_OFF = BIG_OFF + 800 * MiB;
constexpr size_t SC_OFF = BIG_OFF;
constexpr size_t TOPI_OFF = BIG_OFF + 640 * MiB, TOPG_OFF = BIG_OFF + 680 * MiB;
constexpr size_t PTU_OFF = BIG_OFF + 720 * MiB, PTV_OFF = BIG_OFF + 752 * MiB;
constexpr size_t PB_OFF = BIG_OFF + 784 * MiB;
constexpr size_t GATE_OFF = BIG_OFF;
constexpr size_t SSQ_OFF = BIG_OFF + 880 * MiB;
constexpr size_t WS_END = BIG_OFF + 886 * MiB;
}
using namespace cfg;

struct Args {
    const float* x_prompt; const float* x_sample; const float* p_prompt; const float* p_sample;
    const float* norm_mix_g; const float* w_in; const float* att_norm_g; const float* rwkv_shift;
    const float* rwkv_w0; const float* rwkv_w2; const float* rwkv_a0; const float* rwkv_a2; const float* rwkv_g2;
    const float* rwkv_k_k; const float* rwkv_k_a; const float* rwkv_r_k; const float* rwkv_ln_w; const float* rwkv_ln_b;
    const float* w_out; const float* norm_ffn_g; const float* peer_w_q; const float* peer_sub_keys; const float* peer_u; const float* peer_v;
    const float* ple_norm_g; const float* ple_w_gate; const float* ple_b_gate; const float* ple_w_proj; const float* final_norm_g;
    float* h;
    unsigned char* ws;
};

DEV int tid_() { int t = threadIdx.x; asm volatile("" : "+v"(t)); return t; }
DEV float bf2f(unsigned h) { return __uint_as_float(h << 16); }
DEV float bflo(unsigned d) { return __uint_as_float(d << 16); }
DEV float bfhi(unsigned d) { return __uint_as_float(d & 0xffff0000u); }
DEV unsigned pack2(float lo, float hi) { const f32x2 v = {lo, hi}; return __builtin_bit_cast(unsigned, __builtin_convertvector(v, bf16x2_t)); }
DEV unsigned f2bf(float f) { return pack2(f, 0.f) & 0xffffu; }
DEV float dot2bf(unsigned a, unsigned b, float c) { return __builtin_amdgcn_fdot2_f32_bf16(__builtin_bit_cast(bf16x2_t, a), __builtin_bit_cast(bf16x2_t, b), c, false); }
DEV float shx_(float v, int lane, int o) { return __int_as_float(__builtin_amdgcn_ds_bpermute((lane ^ o) << 2, __float_as_int(v))); }
DEV float shf_(float v, int src) { return __int_as_float(__builtin_amdgcn_ds_bpermute(src << 2, __float_as_int(v))); }
DEV int shf_(int v, int src) { return __builtin_amdgcn_ds_bpermute(src << 2, v); }
#define SHX(v, o) shx_((v), lane, (o))
#define SHF(v, src) shf_((v), (src))
DEV float wave_sum_(float v, int lane) {
#pragma unroll
    for (int o = 32; o > 0; o >>= 1) v += shx_(v, lane, o);
    return v;
}
DEV float wave_max_(float v, int lane) {
#pragma unroll
    for (int o = 32; o > 0; o >>= 1) v = fmaxf(v, shx_(v, lane, o));
    return v;
}
#define wave_sum(x) wave_sum_((x), lane)
#define wave_max(x) wave_max_((x), lane)
DEV float sum8(float v) {
    v += __int_as_float(__builtin_amdgcn_mov_dpp(__float_as_int(v), 0xB1, 0xF, 0xF, true));
    v += __int_as_float(__builtin_amdgcn_mov_dpp(__float_as_int(v), 0x4E, 0xF, 0xF, true));
    v += __int_as_float(__builtin_amdgcn_mov_dpp(__float_as_int(v), 0x141, 0xF, 0xF, true));
    return v;
}
DEV float rstd_parts(const float* ssq, int t) { const f32x4* p = (const f32x4*)(ssq + (size_t)t * 16); const f32x4 a = p[0], b = p[1], c = p[2], d = p[3];
    const float s = ((a[0] + a[1]) + (a[2] + a[3])) + ((b[0] + b[1]) + (b[2] + b[3])) + ((c[0] + c[1]) + (c[2] + c[3])) + ((d[0] + d[1]) + (d[2] + d[3]));
    return rsqrtf(s * (1.0f / 1024.0f) + 1e-6f); }
DEV float sigmoidf_(float x) { return __builtin_amdgcn_rcpf(1.0f + __expf(-x)); }
namespace pg8 {
#define PG8_LAS __attribute__((address_space(3)))
typedef unsigned short bf16_t;
typedef short bf16x8 __attribute__((ext_vector_type(8)));
typedef float f32x4 __attribute__((ext_vector_type(4)));
typedef unsigned u32x4 __attribute__((ext_vector_type(4)));
constexpr int BM = 256, BK = 64, HALF = 128, HTB = HALF * BK * 2  , STAGE_BYTES = 8 * HTB, NXCD = 8, WGM = 8;

__host__ __device__ __forceinline__ int lds_byte(int r, int c) { const int st = (r >> 4) * 2 + (c >> 5), rr = r & 15, cc = c & 31, ob = rr * 64 + cc * 2; return st * 1024 + (ob ^ (((ob >> 9) & 1) << 5)); }
__host__ __device__ __forceinline__ void stage_rc(int b, int& R, int& C) { const int st = b / 1024, sb = b % 1024, swz = sb ^ (((sb >> 9) & 1) << 5); R = (st >> 1) * 16 + swz / 64; C = (st & 1) * 32 + (swz % 64) / 2; }
__host__ __device__ __forceinline__ int perm32(int rho) { const int n = rho >> 4, i = rho & 15; return 8 * (i >> 2) + 4 * n + (i & 3); }

struct Unit { int pm, pn; };
struct Gemm { const bf16_t* A; const bf16_t* Bt; int M, N, K; };

struct StaticOrder {
    int nM, nN, nwg, G, c;
    __host__ __device__ void init(int M, int N, int G_, int c_) { nM = M / BM; nN = N / BM; nwg = nM * nN; G = G_; c = c_; }
    __host__ __device__ bool next(int i, Unit& u) const {
        const long L = (long)i * G + c; if (L >= nwg) return false;
        int wgid = (int)L; { const int q = nwg / NXCD, r = nwg % NXCD, xcd = wgid % NXCD, off = wgid / NXCD; wgid = (xcd < r ? xcd * (q + 1) : r * (q + 1) + (xcd - r) * q) + off; }
        const int nig = WGM * nN, gid = wgid / nig, fm = gid * WGM, gsz = (nM - fm) < WGM ? (nM - fm) : WGM;
        u.pm = fm + ((wgid % nig) % gsz); u.pn = (wgid % nig) / gsz; return true;
    }
    __device__ __forceinline__ void a_ready(const Unit&) const {}
    __device__ __forceinline__ void done(const Unit&) const {}
};
__device__ __forceinline__ unsigned cvt_pk_bf16(float lo, float hi) { unsigned r; asm volatile("v_cvt_pk_bf16_f32 %0, %1, %2" : "=v"(r) : "v"(lo), "v"(hi)); return r; }

struct EpiProj {
    static constexpr bool PERM = true, AFTER_DRAIN = false;
    bf16_t* qkv; bf16_t* u; const float* ssq; const float* rc; const float* rs;
    __device__ __forceinline__ void operator()(const f32x4 (&acc)[2][2][4][2], const Unit& un, int wr, int wc, int fr, int fq) const {
        const int row0 = un.pm * BM + wr * 64 + fr, lane = fr + 16 * fq;
        const bool isq = un.pn < 6;
        bf16_t* base = isq ? qkv : u; const int ld = isq ? 1536 : 2048; const int colt = isq ? un.pn * BM : (un.pn - 6) * BM;
        const int col0 = colt + wc * 32 + 8 * fq;
        const bool rope = (un.pn < 4) && ((wc & 1) == 0);
        f32x4 pq[2][4];
#pragma unroll
        for (int ai = 0; ai < 2; ++ai)
#pragma unroll
            for (int m = 0; m < 4; ++m) pq[ai][m] = *(const f32x4*)(ssq + (size_t)(row0 + ai * HALF + m * 16) * 16 + 4 * fq);
        float rsd[2][4];
#pragma unroll
        for (int ai = 0; ai < 2; ++ai)
#pragma unroll
            for (int m = 0; m < 4; ++m) { float t = (pq[ai][m][0] + pq[ai][m][1]) + (pq[ai][m][2] + pq[ai][m][3]); t += SHX(t, 16); t += SHX(t, 32); rsd[ai][m] = rsqrtf(t * (1.0f / 1024.0f) + 1e-6f); }
#pragma unroll
        for (int ai = 0; ai < 2; ++ai)
#pragma unroll
            for (int m = 0; m < 4; ++m) {
                const int row = row0 + ai * HALF + m * 16; const float s = rsd[ai][m]; const int pos = row & 4095;
                f32x4 c0 = {1.f, 1.f, 1.f, 1.f}, c1 = c0, s0 = {0.f, 0.f, 0.f, 0.f}, s1 = s0;
                if (rope) { c0 = *(const f32x4*)(rc + pos * 8); c1 = *(const f32x4*)(rc + pos * 8 + 4); s0 = *(const f32x4*)(rs + pos * 8); s1 = *(const f32x4*)(rs + pos * 8 + 4); }
                bf16_t* rowp = base + (size_t)row * ld + col0;
#pragma unroll
                for (int bj = 0; bj < 2; ++bj) {
                    f32x4 v0 = acc[ai][bj][m][0] * s, v1 = acc[ai][bj][m][1] * s;
                    if (rope) {
                        f32x4 o0, o1;
#pragma unroll
                        for (int c = 0; c < 4; ++c) { o0[c] = SHX(v0[c], 16); o1[c] = SHX(v1[c], 16); }
                        if (fq == 0) { v0 = v0 * c0 - o0 * s0; v1 = v1 * c1 - o1 * s1; }
                        else if (fq == 1) { v0 = v0 * c0 + o0 * s0; v1 = v1 * c1 + o1 * s1; }
                    }
                    u32x4 w; w.x = cvt_pk_bf16(v0[0], v0[1]); w.y = cvt_pk_bf16(v0[2], v0[3]); w.z = cvt_pk_bf16(v1[0], v1[1]); w.w = cvt_pk_bf16(v1[2], v1[3]);
                    *(u32x4*)(rowp + bj * HALF) = w;
                }
            }
    }
};
template <int MODE> struct EpiF32x {
    static constexpr bool PERM = true, AFTER_DRAIN = false;
    float* C; int ldc; const bf16_t* gate; bf16_t* hb; float* ssq;
    __device__ __forceinline__ void operator()(const f32x4 (&acc)[2][2][4][2], const Unit& un, int wr, int wc, int fr, int fq) const {
        const int row0 = un.pm * BM + wr * 64 + fr, col0 = un.pn * BM + wc * 32 + 8 * fq, lane = fr + 16 * fq;
#pragma unroll
        for (int ai = 0; ai < 2; ++ai)
#pragma unroll
            for (int m = 0; m < 4; ++m) {
                const int row = row0 + ai * HALF + m * 16;
                const size_t ro = (size_t)row * ldc + col0;
                if (MODE != 0) asm volatile("" ::: "memory");
                float ss = 0.f;
#pragma unroll
                for (int bj = 0; bj < 2; ++bj) {
                    if (MODE == 2 && bj) asm volatile("" ::: "memory");
                    f32x4* p = (f32x4*)(C + ro + bj * HALF);
                    if (MODE == 0) { p[0] = acc[ai][bj][m][0]; p[1] = acc[ai][bj][m][1]; }
                    else {
                        f32x4 v0, v1;
                        if (MODE == 1) { v0 = p[0] + acc[ai][bj][m][0]; v1 = p[1] + acc[ai][bj][m][1]; }
                        else { const u32x4 g = *(const u32x4*)(gate + ro + bj * HALF);
                               f32x4 g0, g1; g0[0] = __uint_as_float(g.x << 16); g0[1] = __uint_as_float(g.x & 0xffff0000u); g0[2] = __uint_as_float(g.y << 16); g0[3] = __uint_as_float(g.y & 0xffff0000u);
                               g1[0] = __uint_as_float(g.z << 16); g1[1] = __uint_as_float(g.z & 0xffff0000u); g1[2] = __uint_as_float(g.w << 16); g1[3] = __uint_as_float(g.w & 0xffff0000u);
                               v0 = p[0] + g0 * acc[ai][bj][m][0]; v1 = p[1] + g1 * acc[ai][bj][m][1]; }
                        p[0] = v0; p[1] = v1;
                        ss += ((v0[0] * v0[0] + v0[1] * v0[1]) + (v0[2] * v0[2] + v0[3] * v0[3])) + ((v1[0] * v1[0] + v1[1] * v1[1]) + (v1[2] * v1[2] + v1[3] * v1[3]));
                        u32x4 pk; pk.x = cvt_pk_bf16(v0[0], v0[1]); pk.y = cvt_pk_bf16(v0[2], v0[3]); pk.z = cvt_pk_bf16(v1[0], v1[1]); pk.w = cvt_pk_bf16(v1[2], v1[3]);
                        *(u32x4*)(hb + ro + bj * HALF) = pk;
                    }
                }
                if (MODE != 0) {
                    ss += SHX(ss, 16); ss += SHX(ss, 32);
                    if (fq == 0) ssq[(size_t)row * 16 + un.pn * 4 + wc] = ss;
                }
            }
    }
};
struct EpiGate {
    static constexpr bool PERM = true, AFTER_DRAIN = false;
    bf16_t* O; const float* rstd; const float* bias;
    __device__ __forceinline__ void operator()(const f32x4 (&acc)[2][2][4][2], const Unit& un, int wr, int wc, int fr, int fq) const {
        const int row0 = un.pm * BM + wr * 64 + fr, col0 = un.pn * BM + wc * 32 + 8 * fq;
        f32x4 bv[2][2];
#pragma unroll
        for (int bj = 0; bj < 2; ++bj)
#pragma unroll
            for (int n = 0; n < 2; ++n) bv[bj][n] = *(const f32x4*)(bias + col0 + bj * HALF + 4 * n);
#pragma unroll
        for (int ai = 0; ai < 2; ++ai)
#pragma unroll
            for (int m = 0; m < 4; ++m) {
                const int row = row0 + ai * HALF + m * 16; const float s = rstd[row];
                bf16_t* rowp = O + (size_t)row * 1024 + col0;
#pragma unroll
                for (int bj = 0; bj < 2; ++bj) {
                    f32x4 v0 = acc[ai][bj][m][0] * s + bv[bj][0], v1 = acc[ai][bj][m][1] * s + bv[bj][1];
#pragma unroll
                    for (int c = 0; c < 4; ++c) { v0[c] = __builtin_amdgcn_rcpf(1.0f + __expf(-v0[c])); v1[c] = __builtin_amdgcn_rcpf(1.0f + __expf(-v1[c])); }
                    u32x4 w; w.x = cvt_pk_bf16(v0[0], v0[1]); w.y = cvt_pk_bf16(v0[2], v0[3]); w.z = cvt_pk_bf16(v1[0], v1[1]); w.w = cvt_pk_bf16(v1[2], v1[3]);
                    *(u32x4*)(rowp + bj * HALF) = w;
                }
            }
    }
};
template <class Epi, class Sched, bool STAMP = false>
__device__ __forceinline__ void gemm_phase(PG8_LAS unsigned char* lds, const Gemm g, const Sched& S, const Epi& E, unsigned long long* stamps, const int tid_in) {
    const int tid = tid_in, wid = __builtin_amdgcn_readfirstlane(tid >> 6), lane = tid & 63, wr = wid >> 2, wc = wid & 3, fr = lane & 15, fq = lane >> 4;
    const int K = g.K, nt = K / BK;
    int ts_lo = 0, ts_hi = 0, nts = 0; const unsigned long long rt_entry = STAMP ? (unsigned long long)wall_clock64() : 0ull;
#define PG8_STAMP() do { if (STAMP && wid == 0 && nts < 64) { const unsigned long long _c = (unsigned long long)clock64(); \
        ts_lo = (lane == nts) ? (int)(unsigned)_c : ts_lo; ts_hi = (lane == nts) ? (int)(unsigned)(_c >> 32) : ts_hi; ++nts; } } while (0)
    PG8_STAMP();
    unsigned voffA[2], voffB[2];
#pragma unroll
    for (int i = 0; i < 2; ++i) { int R, C; stage_rc(tid * 16 + i * 8192, R, C); const int Rb = Epi::PERM ? ((R & ~31) + perm32(R & 31)) : R;
        voffA[i] = (unsigned)(R * K + C) * 2u; voffB[i] = (unsigned)(Rb * K + C) * 2u; }
    const size_t kstep = (size_t)(BK * 2);
    const size_t hstep = (size_t)HALF * K * 2;
    const size_t tstep = 2 * hstep;
    const unsigned ldsw = (unsigned)wid * 1024u;
    const int aoff = lds_byte(wr * 64 + fr, fq * 8), boff = lds_byte(wc * 32 + fr, fq * 8);
#define PG8_SA(b, h) (((b) * 2 + (h)) * HTB)
#define PG8_SB(b, h) ((4 + (b) * 2 + (h)) * HTB)
#define PG8_STAGE(bufoff, gbase, voff) do { _Pragma("unroll") for (int _i = 0; _i < 2; ++_i) \
        __builtin_amdgcn_global_load_lds((const unsigned*)((const char*)(gbase) + (voff)[_i]), (PG8_LAS unsigned*)(lds + (bufoff) + ldsw + _i * 8192), 16, 0, 0); } while (0)
#define PG8_LDA(dst, b, h) do { _Pragma("unroll") for (int m = 0; m < 4; ++m) _Pragma("unroll") for (int k = 0; k < 2; ++k) dst[m][k] = *(const PG8_LAS bf16x8*)(lds + PG8_SA(b, h) + aoff + m * 2048 + k * 1024); } while (0)
#define PG8_LDB(dst, b, h) do { _Pragma("unroll") for (int n = 0; n < 2; ++n) _Pragma("unroll") for (int k = 0; k < 2; ++k) dst[n][k] = *(const PG8_LAS bf16x8*)(lds + PG8_SB(b, h) + boff + n * 2048 + k * 1024); } while (0)
#define PG8_MMA(ai, bj, At, Bt) do { __builtin_amdgcn_s_setprio(1); _Pragma("unroll") for (int m = 0; m < 4; ++m) _Pragma("unroll") for (int n = 0; n < 2; ++n) _Pragma("unroll") for (int k = 0; k < 2; ++k) \
        acc[ai][bj][m][n] = __builtin_amdgcn_mfma_f32_16x16x32_bf16(Bt[n][k], At[m][k], acc[ai][bj][m][n], 0, 0, 0); __builtin_amdgcn_s_setprio(0); } while (0)
#define PG8_WAIT_V(n) asm volatile("s_waitcnt vmcnt(" #n ")" ::: "memory")
#define PG8_WAIT_L(n) asm volatile("s_waitcnt lgkmcnt(" #n ")" ::: "memory")
#define PG8_BAR __builtin_amdgcn_s_barrier()
#define PG8_SCHED __builtin_amdgcn_sched_barrier(0)
    Unit cur, nxt; int ui = 0;
    if (!S.next(0, cur)) return;
    f32x4 acc[2][2][4][2];
#pragma unroll
    for (int a = 0; a < 2; ++a)
#pragma unroll
        for (int b = 0; b < 2; ++b)
#pragma unroll
            for (int m = 0; m < 4; ++m)
#pragma unroll
                for (int n = 0; n < 2; ++n) acc[a][b][m][n] = (f32x4){0.f, 0.f, 0.f, 0.f};
    bf16x8 At[4][2], B0[2][2], B1[2][2];
    const char* cA = (const char*)g.A + (size_t)cur.pm * tstep; const char* cB = (const char*)g.Bt + (size_t)cur.pn * tstep;
    S.a_ready(cur);
    PG8_STAGE(PG8_SB(0, 0), cB, voffB); PG8_STAGE(PG8_SA(0, 0), cA, voffA); PG8_STAGE(PG8_SB(0, 1), cB + hstep, voffB); PG8_STAGE(PG8_SA(0, 1), cA + hstep, voffA);
    if (wr == 1) PG8_BAR;
    PG8_WAIT_V(4); PG8_BAR;
    PG8_STAGE(PG8_SB(1, 0), cB + kstep, voffB); PG8_STAGE(PG8_SA(1, 0), cA + kstep, voffA); PG8_STAGE(PG8_SB(1, 1), cB + hstep + kstep, voffB);
    PG8_WAIT_V(6); PG8_BAR;
    PG8_STAMP();
    for (;;) {
        const bool has_next = S.next(ui + 1, nxt);
        const char* nA = has_next ? (const char*)g.A + (size_t)nxt.pm * tstep : cA; const char* nB = has_next ? (const char*)g.Bt + (size_t)nxt.pn * tstep : cB;
        for (int t = 0; t < nt; t += 2) {
            const bool last = (t == nt - 2);
            const char* a1 = cA + (size_t)(t + 1) * kstep;
            const char* a2 = last ? nA : cA + (size_t)(t + 2) * kstep; const char* b2 = last ? nB : cB + (size_t)(t + 2) * kstep;
            const char* a3 = a2 + kstep; const char* b3 = b2 + kstep;
            if (last && has_next) S.a_ready(nxt);
            PG8_LDB(B0, 0, 0); PG8_SCHED; PG8_LDA(At, 0, 0); PG8_STAGE(PG8_SA(1, 1), a1 + hstep, voffA);
            PG8_WAIT_L(8); PG8_BAR; PG8_WAIT_L(0); PG8_MMA(0, 0, At, B0); PG8_BAR; PG8_SCHED;
            PG8_LDB(B1, 0, 1); PG8_STAGE(PG8_SB(0, 0), b2, voffB);
            PG8_BAR; PG8_WAIT_L(0); PG8_MMA(0, 1, At, B1); PG8_BAR;
            PG8_LDA(At, 0, 1); PG8_STAGE(PG8_SA(0, 0), a2, voffA);
            PG8_BAR; PG8_WAIT_L(0); PG8_MMA(1, 0, At, B0); PG8_BAR; PG8_SCHED;
            PG8_STAGE(PG8_SB(0, 1), b2 + hstep, voffB);
            PG8_WAIT_V(6); PG8_BAR; PG8_MMA(1, 1, At, B1); PG8_BAR;
            PG8_LDB(B0, 1, 0); PG8_SCHED; PG8_LDA(At, 1, 0); PG8_STAGE(PG8_SA(0, 1), a2 + hstep, voffA);
            PG8_WAIT_L(8); PG8_BAR; PG8_WAIT_L(0); PG8_MMA(0, 0, At, B0); PG8_BAR; PG8_SCHED;
            PG8_LDB(B1, 1, 1); PG8_STAGE(PG8_SB(1, 0), b3, voffB);
            PG8_BAR; PG8_WAIT_L(0); PG8_MMA(0, 1, At, B1); PG8_BAR;
            PG8_LDA(At, 1, 1); PG8_STAGE(PG8_SA(1, 0), a3, voffA);
            PG8_BAR; PG8_WAIT_L(0); PG8_MMA(1, 0, At, B0); PG8_BAR; PG8_SCHED;
            PG8_STAGE(PG8_SB(1, 1), b3 + hstep, voffB);
            PG8_WAIT_V(6); PG8_BAR; PG8_MMA(1, 1, At, B1); PG8_BAR;
        }
        PG8_STAMP();
        if constexpr (!Epi::AFTER_DRAIN) { E(acc, cur, wr, wc, fr, fq); S.done(cur); }
        PG8_STAMP();
        if (!has_next) break;
#pragma unroll
        for (int a = 0; a < 2; ++a)
#pragma unroll
            for (int b = 0; b < 2; ++b)
#pragma unroll
                for (int m = 0; m < 4; ++m)
#pragma unroll
                    for (int n = 0; n < 2; ++n) acc[a][b][m][n] = (f32x4){0.f, 0.f, 0.f, 0.f};
        cur = nxt; cA = nA; cB = nB; ++ui;
    }
    PG8_WAIT_V(0);
    if (wr == 0) PG8_BAR;
    PG8_BAR;
    if constexpr (Epi::AFTER_DRAIN) { E.fused(acc, cur, wr, wc, fr, fq, lds, wid, lane); S.done(cur); }
    PG8_STAMP();
    if (STAMP && wid == 0) { stamps[lane] = lane < nts ? (((unsigned long long)(unsigned)ts_hi << 32) | (unsigned)ts_lo) : 0ull;
        if (lane == 62) stamps[62] = rt_entry; if (lane == 63) stamps[63] = (unsigned long long)wall_clock64(); }
#undef PG8_STAMP
#undef PG8_SA
#undef PG8_SB
#undef PG8_STAGE
#undef PG8_LDA
#undef PG8_LDB
#undef PG8_MMA
#undef PG8_WAIT_V
#undef PG8_WAIT_L
#undef PG8_BAR
#undef PG8_SCHED
}
}
#define XB_TMO      128
#define XB_XCNT(j)  (256  + 64 * (j))
#define XB_XSUB(j)  (1280 + 64 * (j))
#define XB_XGEN(j)  (2304 + 64 * (j))
#define XB_TOP      3328
#define XB_TOPGEN   3392
#define XCD_BAR_WORDS 3456
#define XB_SPIN_CAP (1u << 23)
#define LAS __attribute__((address_space(3)))

__device__ __forceinline__ unsigned xb_ld(unsigned* p)              { return __hip_atomic_load(p, __ATOMIC_RELAXED, __HIP_MEMORY_SCOPE_AGENT); }
__device__ __forceinline__ unsigned xb_add(unsigned* p, unsigned v) { return __hip_atomic_fetch_add(p, v, __ATOMIC_RELAXED, __HIP_MEMORY_SCOPE_AGENT); }
__device__ __forceinline__ unsigned xb_xcc_id() { return (unsigned)__builtin_amdgcn_s_getreg((3 << 11) | 20) & 0xFu; }
#define XB_SPIN(cond, bar) do { unsigned _sp = 0; while (cond) { __builtin_amdgcn_s_sleep(1); \
    if ((++_sp & 255u) == 0u) { if (xb_ld(&(bar)[XB_TMO])) break; if (_sp > XB_SPIN_CAP) { atomicAdd(&(bar)[XB_TMO], 1u); break; } } } } while (0)

struct XcdBarrier {
    unsigned* bar; unsigned x;
    volatile LAS unsigned* st;
};

__device__ __forceinline__ XcdBarrier xcd_barrier_post(unsigned* bar, volatile LAS unsigned* st) {
    XcdBarrier b; b.bar = bar; b.x = xb_xcc_id(); b.st = st;
    if (threadIdx.x == 0) (void)xb_add(&bar[XB_XCNT(b.x)], 1u);
    return b;
}
__device__ __forceinline__ void xcd_barrier_complete(unsigned* bar, unsigned x, unsigned& nloc, unsigned& nx) {
    const unsigned G = gridDim.x * gridDim.y * gridDim.z;
    unsigned sum, cnt, mine, sp = 0u;
    for (;;) {
        sum = 0u; cnt = 0u; mine = 0u;
#pragma unroll
        for (unsigned j = 0; j < 16; ++j) { const unsigned c = xb_ld(&bar[XB_XCNT(j)]); sum += c; cnt += (c > 0u) ? 1u : 0u; mine = (j == x) ? c : mine; }
        if (sum == G) break;
        __builtin_amdgcn_s_sleep(1);
        if ((++sp & 255u) == 0u) { if (xb_ld(&bar[XB_TMO])) break; if (sp > XB_SPIN_CAP) { atomicAdd(&bar[XB_TMO], 1u); break; } }
    }
    nloc = mine > 0u ? mine : 1u; nx = cnt > 0u ? cnt : 1u;
}

__device__ __forceinline__ void xcd_barrier(const XcdBarrier& b, const int tid) {
    asm volatile("s_waitcnt vmcnt(0)" ::: "memory");
    __syncthreads();
    if (tid == 0) {
        unsigned* bar = b.bar; unsigned bx = b.x;
        asm volatile("" : "+s"(bar), "+s"(bx));
        __builtin_amdgcn_s_waitcnt(0);
        unsigned nloc = b.st[0], nx = b.st[1];
        if (nloc == 0u) { xcd_barrier_complete(bar, bx, nloc, nx); b.st[0] = nloc; b.st[1] = nx; }
        const unsigned old = xb_add(&bar[XB_XSUB(bx)], 1u);
        const unsigned gen = old / nloc;
        if (old + 1u == (gen + 1u) * nloc) {
            __builtin_amdgcn_fence(__ATOMIC_RELEASE, "agent");
            asm volatile("s_waitcnt vmcnt(0)" ::: "memory");
            const unsigned og = xb_add(&bar[XB_TOP], 1u);
            const unsigned tg = og / nx;
            if (og + 1u == (tg + 1u) * nx) xb_add(&bar[XB_TOPGEN], 1u);
            else XB_SPIN(xb_ld(&bar[XB_TOPGEN]) == tg, bar);
            __builtin_amdgcn_fence(__ATOMIC_ACQUIRE, "agent");
            xb_add(&bar[XB_XGEN(bx)], 1u);
            asm volatile("s_waitcnt vmcnt(0)" ::: "memory");
        } else {
            XB_SPIN(xb_ld(&bar[XB_XGEN(bx)]) == gen, bar);
            __builtin_amdgcn_fence(__ATOMIC_ACQUIRE, "agent");
            asm volatile("s_waitcnt vmcnt(0)" ::: "memory");
        }
    }
    __syncthreads();
}


typedef __attribute__((address_space(3))) unsigned char lds_u8;
extern __shared__ __attribute__((aligned(16))) unsigned char smem[];
DEV unsigned char* smem_base() { return smem; }

DEV bf16_t* wsb(const Args& a, size_t off) { return (bf16_t*)(a.ws + off); }
DEV float* wsf(const Args& a, size_t off) { return (float*)(a.ws + off); }

DEV void ph_rowprep(const Args& a, bool from_x, const int tid0) {
    const int lane = tid0 & 63, wv = tid0 >> 6;
    const int gw = blockIdx.x * 8 + wv, nw = gridDim.x * 8;
    bf16_t* hb = wsb(a, HB_OFF); float* ssq = wsf(a, SSQ_OFF);
    for (int t = gw; t < T; t += nw) {
        const float* src = from_x ? (t < TP ? a.x_prompt + (size_t)t * D : a.x_sample + (size_t)(t - TP) * D) : a.h + (size_t)t * D;
        f32x4 v[4]; float ss = 0.f;
#pragma unroll
        for (int i = 0; i < 4; ++i) { v[i] = *(const f32x4*)(src + (i * 64 + lane) * 4); ss += v[i][0] * v[i][0] + v[i][1] * v[i][1] + v[i][2] * v[i][2] + v[i][3] * v[i][3]; }
        ss = wave_sum(ss);
#pragma unroll
        for (int i = 0; i < 4; ++i) {
            if (from_x) *(f32x4*)(a.h + (size_t)t * D + (i * 64 + lane) * 4) = v[i];
            u32x2 p; p.x = pack2(v[i][0], v[i][1]); p.y = pack2(v[i][2], v[i][3]);
            *(u32x2*)(hb + (size_t)t * D + (i * 64 + lane) * 4) = p;
        }
        if (lane < 16) ssq[(size_t)t * 16 + lane] = (lane == 0) ? ss : 0.f;
    }
}

DEV void ph_final(const Args& a, const int tid0) {
    const int lane = tid0 & 63, wv = tid0 >> 6;
    const int gw = blockIdx.x * 8 + wv, nw = gridDim.x * 8;
    for (int t = gw; t < T; t += nw) {
        float* row = a.h + (size_t)t * D;
        f32x4 v[4]; float ss = 0.f;
#pragma unroll
        for (int i = 0; i < 4; ++i) { v[i] = *(const f32x4*)(row + (i * 64 + lane) * 4); ss += v[i][0] * v[i][0] + v[i][1] * v[i][1] + v[i][2] * v[i][2] + v[i][3] * v[i][3]; }
        ss = wave_sum(ss);
        const float r = rsqrtf(ss * (1.0f / 1024.0f) + 1e-6f);
#pragma unroll
        for (int i = 0; i < 4; ++i) { const f32x4 g = *(const f32x4*)(a.final_norm_g + (i * 64 + lane) * 4); *(f32x4*)(row + (i * 64 + lane) * 4) = v[i] * r * g; }
    }
}

DEV void transpose_cvt(const float* __restrict__ src, bf16_t* __restrict__ dst, int K, int N, int Npad, const float* __restrict__ g, float* tile, const int tid0) {
    const int tx = tid0 & 63, ty = tid0 >> 6;
    const int tk = K / 64, tn = Npad / 64;
    for (int tl = blockIdx.x; tl < tk * tn; tl += gridDim.x) {
        const int k0 = (tl % tk) * 64, n0 = (tl / tk) * 64;
        __syncthreads();
        for (int i = ty; i < 64; i += 8) { const int k = k0 + i, n = n0 + tx; float v = (n < N) ? src[(size_t)k * N + n] : 0.f; if (g) v *= g[k]; tile[i * 65 + tx] = v; }
        __syncthreads();
        for (int i = ty; i < 64; i += 8) dst[(size_t)(n0 + i) * K + k0 + tx] = (bf16_t)f2bf(tile[tx * 65 + i]);
    }
}
DEV void fold_wqk(const Args& a, float* lds, const int tid0) {
    float* swq = lds;
    float* ssk = lds + 64 * 132;
    const int tid = tid0, key = tid & 127, kq = tid >> 7;
    for (int un = blockIdx.x; un < NL * 16 * 16; un += gridDim.x) {
        const int l = un >> 8, hp = (un >> 4) & 15, k0 = (un & 15) * 64;
        __syncthreads();
        for (int i = tid; i < 64 * 128; i += NTHR) { const int r = i >> 7, c = i & 127; swq[r * 132 + c] = a.peer_w_q[((size_t)l * 1024 + k0 + r) * 2048 + hp * 128 + c]; }
        for (int i = tid; i < 128 * 128; i += NTHR) { const int r = i >> 7, c = i & 127; ssk[r * 132 + c] = a.peer_sub_keys[(((size_t)l * 16 + hp) * 128 + r) * 128 + c]; }
        __syncthreads();
        float acc[16];
#pragma unroll
        for (int i = 0; i < 16; ++i) acc[i] = 0.f;
        for (int c = 0; c < 128; c += 4) {
            const f32x4 s = *(const f32x4*)(ssk + key * 132 + c);
#pragma unroll
            for (int i = 0; i < 16; ++i) { const f32x4 w = *(const f32x4*)(swq + (kq * 16 + i) * 132 + c); acc[i] += s[0] * w[0] + s[1] * w[1] + s[2] * w[2] + s[3] * w[3]; }
        }
        bf16_t* dst = wsb(a, WB_OFF + (size_t)l * WB_LAYER + WB_QK) + (size_t)(hp * 128 + key) * 1024 + k0 + kq * 16;
        const float* g = a.norm_ffn_g + l * 1024 + k0 + kq * 16;
#pragma unroll
        for (int i = 0; i < 16; i += 2) *(unsigned*)(dst + i) = pack2(acc[i] * g[i], acc[i + 1] * g[i + 1]);
    }
}
DEV void ph_prologue(const Args& a, float* lds, const int tid0) {
    { float* rc = wsf(a, ROPEC_OFF); float* rs = wsf(a, ROPES_OFF);
      for (int i = blockIdx.x * NTHR + tid0; i < 4096 * 8; i += gridDim.x * NTHR) {
          const int pos = i >> 3, f = i & 7;
          const float invf = (float)pow(500000.0, -(double)f / 8.0);
          const float ang = (float)pos * invf;
          rc[i] = (float)cos((double)ang); rs[i] = (float)sin((double)ang);
      } }
    for (int l = 0; l < NL; ++l) {
        bf16_t* wb = wsb(a, WB_OFF + (size_t)l * WB_LAYER);
        transpose_cvt(a.w_in + (size_t)l * 1024 * INC, wb + WB_IN / 2, 1024, INC, INP, a.norm_mix_g + l * 1024, lds, tid0);
        transpose_cvt(a.w_out + (size_t)l * 1024 * 1024, wb + WB_OUT / 2, 1024, 1024, 1024, nullptr, lds, tid0);
        transpose_cvt(a.ple_w_gate + (size_t)l * 1024 * 1024, wb + WB_GATE / 2, 1024, 1024, 1024, a.ple_norm_g + l * 1024, lds, tid0);
        transpose_cvt(a.ple_w_proj + (size_t)l * 256 * 1024, wb + WB_PROJ / 2, 256, 1024, 1024, nullptr, lds, tid0);
        for (int dr = 0; dr < 2; ++dr) {
            transpose_cvt(a.rwkv_w2 + (size_t)(l * 2 + dr) * 64 * 512, wb + WB_LORA / 2 + dr * 512 * 64, 64, 512, 512, nullptr, lds, tid0);
            transpose_cvt(a.rwkv_a2 + (size_t)(l * 2 + dr) * 64 * 512, wb + WB_LORA / 2 + (2 + dr) * 512 * 64, 64, 512, 512, nullptr, lds, tid0);
        }
        transpose_cvt(a.rwkv_g2 + (size_t)l * 128 * 512, wb + WB_LORA / 2 + 4 * 512 * 64, 128, 512, 512, nullptr, lds, tid0);
    }
    fold_wqk(a, lds, tid0);
}

DEV float sum16(float v) {
    v = sum8(v);
    v += __int_as_float(__builtin_amdgcn_mov_dpp(__float_as_int(v), 0x140, 0xF, 0xF, true));
    return v;
}
DEV float max16(float v) {
    v = fmaxf(v, __int_as_float(__builtin_amdgcn_mov_dpp(__float_as_int(v), 0xB1, 0xF, 0xF, true)));
    v = fmaxf(v, __int_as_float(__builtin_amdgcn_mov_dpp(__float_as_int(v), 0x4E, 0xF, 0xF, true)));
    v = fmaxf(v, __int_as_float(__builtin_amdgcn_mov_dpp(__float_as_int(v), 0x141, 0xF, 0xF, true)));
    v = fmaxf(v, __int_as_float(__builtin_amdgcn_mov_dpp(__float_as_int(v), 0x140, 0xF, 0xF, true)));
    return v;
}
DEV float rl(float v, int l) { return __int_as_float(__builtin_amdgcn_readlane(__float_as_int(v), l)); }
DEV float wave_sum_dpp(float v) { v = sum16(v); return (rl(v, 0) + rl(v, 16)) + (rl(v, 32) + rl(v, 48)); }
DEV unsigned fkey(float f) { const unsigned b = __float_as_uint(f); return b ^ ((unsigned)((int)b >> 31) | 0x80000000u); }
DEV int mbcnt64(unsigned long long m) { return (int)__builtin_amdgcn_mbcnt_hi((unsigned)(m >> 32), __builtin_amdgcn_mbcnt_lo((unsigned)m, 0u)); }

#ifndef TOPK_NU
#define TOPK_NU 4
#endif
DEV int vpopc2(unsigned long long m1, unsigned long long m2) { int n;
    asm("v_bcnt_u32_b32 %0, %1, 0\n\tv_bcnt_u32_b32 %0, %2, %0\n\tv_bcnt_u32_b32 %0, %3, %0\n\tv_bcnt_u32_b32 %0, %4, %0" : "=&v"(n) : "s"((unsigned)m1), "s"((unsigned)(m1 >> 32)), "s"((unsigned)m2), "s"((unsigned)(m2 >> 32)));
    return n; }
template <bool MIXED = false> DEV void ph_topk2(const Args& a, float* lds, const int tid0, const int gw, const int nw, const int NP, int* TOPI, float* TOPG, const int tbase, float* RL = nullptr, int* ctr = nullptr) {
    const int lane = tid0 & 63, wv = __builtin_amdgcn_readfirstlane(tid0 >> 6);
    constexpr int NU = TOPK_NU, NQ = 2 * NU, GPT = 8 / NU;
    float* tvb = lds + wv * (NQ * 16); int* tib = (int*)(lds + 8 * NQ * 16) + wv * (NQ * 16);
    const float* SC = wsf(a, SC_OFF); const float* ssq = wsf(a, SSQ_OFF);
    float vn[NU][4];
#define TOPK_DRAW() ({ int v_ = 0; if (lane == 0) v_ = __hip_atomic_fetch_add(ctr, 1, __ATOMIC_RELAXED, __HIP_MEMORY_SCOPE_WORKGROUP); __builtin_amdgcn_readfirstlane(v_); })
    const int up0 = ctr ? gw + TOPK_DRAW() : gw;
    if (up0 < NP) {
#pragma unroll
        for (int u = 0; u < NU; ++u)
#pragma unroll
            for (int i = 0; i < 4; ++i) vn[u][i] = SC[(size_t)up0 * (NU * 256) + u * 256 + i * 64 + lane];
    }
    int upn = up0;
    for (int up = up0; up < NP; up = upn) {
        upn = ctr ? gw + TOPK_DRAW() : up + nw;
        const int t = up / GPT, hd0 = (up % GPT) * NU;
        float v[NU][4]; unsigned k[NU][4];
#pragma unroll
        for (int u = 0; u < NU; ++u)
#pragma unroll
            for (int i = 0; i < 4; ++i) { v[u][i] = vn[u][i]; k[u][i] = fkey(v[u][i]); }
        if (upn < NP) {
#pragma unroll
            for (int u = 0; u < NU; ++u)
#pragma unroll
                for (int i = 0; i < 4; ++i) vn[u][i] = SC[(size_t)upn * (NU * 256) + u * 256 + i * 64 + lane];
        }
        unsigned th[NQ]; unsigned dm = 0u;
        unsigned long long dq[NU];
#pragma unroll
        for (int q2 = 0; q2 < NU; ++q2) dq[q2] = 0ull;
#pragma unroll
        for (int q = 0; q < NQ; ++q) th[q] = 0u;
        for (int b = 31; b >= 0; --b) {
            const unsigned bit = 1u << b;
            unsigned long long ma[NQ], mb[NQ];
#pragma unroll
            for (int q = 0; q < NQ; ++q) { const unsigned c = th[q] | bit; ma[q] = __ballot(k[q >> 1][2 * (q & 1)] >= c); mb[q] = __ballot(k[q >> 1][2 * (q & 1) + 1] >= c); }
#pragma unroll
            for (int q = 0; q < NQ; ++q) {
                if (MIXED && (q & 1)) {
                    const int n = vpopc2(ma[q], mb[q]);
                    th[q] = (n >= 16) ? (th[q] | bit) : th[q]; dq[q >> 1] |= __ballot(n == 16);
                } else {
                    const int n = __builtin_popcountll(ma[q]) + __builtin_popcountll(mb[q]);
                    th[q] = (n >= 16) ? (th[q] | bit) : th[q]; dm |= (n == 16) ? (1u << q) : 0u;
                }
            }
            if (MIXED) { unsigned long long da = ~0ull;
#pragma unroll
                for (int q2 = 0; q2 < NU; ++q2) da &= dq[q2];
                if (dm == 0x55555555u % (1u << NQ) && da != 0ull) break; }
            else if (dm == (1u << NQ) - 1u) break;
        }
#pragma unroll
        for (int q = 0; q < NQ; ++q) {
            const int u = q >> 1, p = q & 1; const unsigned tp = th[q];
            const unsigned ka = k[u][2 * p], kb = k[u][2 * p + 1];
            const unsigned long long ga = __ballot(ka > tp), gb = __ballot(kb > tp), ea = __ballot(ka == tp), eb = __ballot(kb == tp);
            const int nga = __builtin_popcountll(ga), ng = nga + __builtin_popcountll(gb), need = 16 - ng, nea = __builtin_popcountll(ea);
            const int rga = mbcnt64(ga), rgb = nga + mbcnt64(gb), rea = mbcnt64(ea), reb = nea + mbcnt64(eb);
            const int pa = (ka > tp) ? rga : ((ka == tp && rea < need) ? ng + rea : -1);
            const int pb = (kb > tp) ? rgb : ((kb == tp && reb < need) ? ng + reb : -1);
            if (pa >= 0) { tvb[q * 16 + pa] = v[u][2 * p]; tib[q * 16 + pa] = lane; }
            if (pb >= 0) { tvb[q * 16 + pb] = v[u][2 * p + 1]; tib[q * 16 + pb] = 64 + lane; }
        }
        float cv[NU][4]; unsigned kc[NU][4]; float mx[NU];
#pragma unroll
        for (int u = 0; u < NU; ++u) {
#pragma unroll
            for (int s = 0; s < 4; ++s) { const int c = lane + 64 * s; cv[u][s] = tvb[u * 32 + (c >> 4)] + tvb[u * 32 + 16 + (c & 15)]; kc[u][s] = fkey(cv[u][s]); }
            const float m0 = max16(lane < 16 ? tvb[u * 32 + (lane & 15)] : -3.0e38f), m1 = max16(lane < 16 ? tvb[u * 32 + 16 + (lane & 15)] : -3.0e38f);
            mx[u] = rl(m0, 0) + rl(m1, 0);
        }
        unsigned t2[NU]; unsigned dm2 = 0u;
#pragma unroll
        for (int u = 0; u < NU; ++u) t2[u] = 0u;
        for (int b = 31; b >= 0; --b) {
            const unsigned bit = 1u << b;
            unsigned long long mc[NU][4];
#pragma unroll
            for (int u = 0; u < NU; ++u)
#pragma unroll
                for (int s4 = 0; s4 < 4; ++s4) mc[u][s4] = __ballot(kc[u][s4] >= (t2[u] | bit));
#pragma unroll
            for (int u = 0; u < NU; ++u) {
                const int n = (__builtin_popcountll(mc[u][0]) + __builtin_popcountll(mc[u][1])) + (__builtin_popcountll(mc[u][2]) + __builtin_popcountll(mc[u][3]));
                t2[u] = (n >= 16) ? (t2[u] | bit) : t2[u]; dm2 |= (n == 16) ? (1u << u) : 0u;
            }
            if (dm2 == (1u << NU) - 1u) break;
        }
        const float rs = rstd_parts(ssq, t);
#pragma unroll
        for (int u = 0; u < NU; ++u) {
            int pos[4]; int ng = 0;
#pragma unroll
            for (int s = 0; s < 4; ++s) { const unsigned long long g = __ballot(kc[u][s] > t2[u]); pos[s] = (kc[u][s] > t2[u]) ? ng + mbcnt64(g) : -1; ng += __builtin_popcountll(g); }
            int ne = 0; const int need = 16 - ng;
#pragma unroll
            for (int s = 0; s < 4; ++s) { const unsigned long long e = __ballot(kc[u][s] == t2[u]); const int r = ne + mbcnt64(e); pos[s] = (kc[u][s] == t2[u] && r < need) ? ng + r : pos[s]; ne += __builtin_popcountll(e); }
            float ex[4]; float es = 0.f;
#pragma unroll
            for (int s = 0; s < 4; ++s) { ex[s] = (pos[s] >= 0) ? __expf(rs * (cv[u][s] - mx[u])) : 0.f; es += ex[s]; }
            const float inv = __builtin_amdgcn_rcpf(wave_sum_dpp(es));
#pragma unroll
            for (int s = 0; s < 4; ++s) if (pos[s] >= 0) {
                const int c = lane + 64 * s;
                const int eid = tib[u * 32 + (c >> 4)] * 128 + tib[u * 32 + 16 + (c & 15)];
                if (TOPG) { TOPI[(t - tbase) * 128 + (hd0 + u) * 16 + pos[s]] = eid; TOPG[(t - tbase) * 128 + (hd0 + u) * 16 + pos[s]] = ex[s] * inv; }
                else TOPI[(t - tbase) * 128 + (hd0 + u) * 16 + pos[s]] = eid | ((int)(ex[s] * inv * 262143.0f + 0.5f) << 14);
            }
        }
        if (RL && hd0 == 0 && lane == 0) RL[t - tbase] = rs;
    }
}

DEV unsigned pack4_fp8(float a, float b, float c, float d) {
    int w = __builtin_amdgcn_cvt_pk_fp8_f32(a, b, 0, false);
    w = __builtin_amdgcn_cvt_pk_fp8_f32(c, d, w, true);
    return (unsigned)w;
}
DEV void ph_convert8(const Args& a, int layer, const int tid0) {
    const size_t gtid = (size_t)blockIdx.x * NTHR + tid0, gn = (size_t)gridDim.x * NTHR;
    const float* us = a.peer_u + (size_t)layer * 16384 * 1024; const float* vs = a.peer_v + (size_t)layer * 16384 * 1024;
    unsigned* ud = (unsigned*)(a.ws + PTU_OFF); unsigned* vd = (unsigned*)(a.ws + PTV_OFF);
    const float* g = a.norm_ffn_g + layer * 1024;
#if PEER_FP4
    for (size_t i = gtid; i < (size_t)16384 * 1024 / 16; i += gn) {
        u32x2 pu = {0u, 0u}, pv = {0u, 0u};
#pragma unroll
        for (int j = 0; j < 4; ++j) {
            const f32x4 x = *(const f32x4*)(us + i * 16 + j * 4), y = *(const f32x4*)(vs + i * 16 + j * 4), gg = *(const f32x4*)(g + ((i * 16 + j * 4) & 1023));
            unsigned wu = pu[j >> 1], wv = pv[j >> 1];
            if (j & 1) { wu = __builtin_amdgcn_cvt_scalef32_pk_fp4_f32(wu, x[0] * gg[0] * PEER_USC, x[1] * gg[1] * PEER_USC, 1.0f, 2); wu = __builtin_amdgcn_cvt_scalef32_pk_fp4_f32(wu, x[2] * gg[2] * PEER_USC, x[3] * gg[3] * PEER_USC, 1.0f, 3);
                         wv = __builtin_amdgcn_cvt_scalef32_pk_fp4_f32(wv, y[0] * PEER_VSC, y[1] * PEER_VSC, 1.0f, 2); wv = __builtin_amdgcn_cvt_scalef32_pk_fp4_f32(wv, y[2] * PEER_VSC, y[3] * PEER_VSC, 1.0f, 3); }
            else       { wu = __builtin_amdgcn_cvt_scalef32_pk_fp4_f32(wu, x[0] * gg[0] * PEER_USC, x[1] * gg[1] * PEER_USC, 1.0f, 0); wu = __builtin_amdgcn_cvt_scalef32_pk_fp4_f32(wu, x[2] * gg[2] * PEER_USC, x[3] * gg[3] * PEER_USC, 1.0f, 1);
                         wv = __builtin_amdgcn_cvt_scalef32_pk_fp4_f32(wv, y[0] * PEER_VSC, y[1] * PEER_VSC, 1.0f, 0); wv = __builtin_amdgcn_cvt_scalef32_pk_fp4_f32(wv, y[2] * PEER_VSC, y[3] * PEER_VSC, 1.0f, 1); }
            pu[j >> 1] = wu; pv[j >> 1] = wv;
        }
        *(u32x2*)(ud + i * 2) = pu; *(u32x2*)(vd + i * 2) = pv;
    }
#else
    for (size_t i = gtid; i < (size_t)16384 * 1024 / 16; i += gn) {
        u32x4 pu, pv;
#pragma unroll
        for (int j = 0; j < 4; ++j) {
            const f32x4 x = *(const f32x4*)(us + i * 16 + j * 4), y = *(const f32x4*)(vs + i * 16 + j * 4), gg = *(const f32x4*)(g + ((i * 16 + j * 4) & 1023));
#if FP4_EMU
            { const unsigned q0 = __builtin_amdgcn_cvt_scalef32_pk_fp4_f32(0u, x[0] * gg[0] * 64.f, x[1] * gg[1] * 64.f, 1.0f, 0), q1 = __builtin_amdgcn_cvt_scalef32_pk_fp4_f32(0u, x[2] * gg[2] * 64.f, x[3] * gg[3] * 64.f, 1.0f, 0);
              const f32x2 r0 = __builtin_amdgcn_cvt_scalef32_pk_f32_fp4(q0, 1.0f, 0), r1 = __builtin_amdgcn_cvt_scalef32_pk_f32_fp4(q1, 1.0f, 0);
              pu[j] = pack4_fp8(r0[0] * 4.f, r0[1] * 4.f, r1[0] * 4.f, r1[1] * 4.f);
              const unsigned q2 = __builtin_amdgcn_cvt_scalef32_pk_fp4_f32(0u, y[0] * 8.f, y[1] * 8.f, 1.0f, 0), q3 = __builtin_amdgcn_cvt_scalef32_pk_fp4_f32(0u, y[2] * 8.f, y[3] * 8.f, 1.0f, 0);
              const f32x2 r2 = __builtin_amdgcn_cvt_scalef32_pk_f32_fp4(q2, 1.0f, 0), r3 = __builtin_amdgcn_cvt_scalef32_pk_f32_fp4(q3, 1.0f, 0);
              pv[j] = pack4_fp8(r2[0] * 4.f, r2[1] * 4.f, r3[0] * 4.f, r3[1] * 4.f); }
#else
            pu[j] = pack4_fp8(x[0] * gg[0] * 256.f, x[1] * gg[1] * 256.f, x[2] * gg[2] * 256.f, x[3] * gg[3] * 256.f);
            pv[j] = pack4_fp8(y[0] * 32.f, y[1] * 32.f, y[2] * 32.f, y[3] * 32.f);
#endif
        }
        *(u32x4*)(ud + i * 4) = pu; *(u32x4*)(vd + i * 4) = pv;
    }
#endif
    bf16_t* pb = wsb(a, PB_OFF);
    const float* pp = a.p_prompt + (size_t)layer * TP * 256; const float* ps = a.p_sample + (size_t)layer * (T - TP) * 256;
    for (size_t i = gtid; i < (size_t)T * 256 / 4; i += gn) {
        const size_t e = i * 4; const f32x4 x = (e < (size_t)TP * 256) ? *(const f32x4*)(pp + e) : *(const f32x4*)(ps + (e - (size_t)TP * 256));
        u32x2 p; p.x = pack2(x[0], x[1]); p.y = pack2(x[2], x[3]); *(u32x2*)(pb + e) = p;
    }
}


typedef short bf16x8 __attribute__((ext_vector_type(8)));
typedef float f32x16 __attribute__((ext_vector_type(16)));
#define MFMA32(a, b, c) __builtin_amdgcn_mfma_f32_32x32x16_bf16((a), (b), (c), 0, 0, 0)
DEV bf16x8 pack_frag(float x0, float x1, float x2, float x3, float x4, float x5, float x6, float x7) {
    u32x4 p;
    asm volatile("v_cvt_pk_bf16_f32 %0, %4, %5\n\tv_cvt_pk_bf16_f32 %1, %6, %7\n\tv_cvt_pk_bf16_f32 %2, %8, %9\n\tv_cvt_pk_bf16_f32 %3, %10, %11\n\ts_nop 1"
                 : "=&v"(p[0]), "=&v"(p[1]), "=&v"(p[2]), "=&v"(p[3]) : "v"(x0), "v"(x1), "v"(x2), "v"(x3), "v"(x4), "v"(x5), "v"(x6), "v"(x7));
    return __builtin_bit_cast(bf16x8, p);
}
DEV void ph_attn3(const Args& a, int layer, unsigned char* ldsb, const int tid0) {
    const int lane = tid0 & 63, wv = __builtin_amdgcn_readfirstlane(tid0 >> 6), r = lane & 31, h = lane >> 5;
    unsigned char* OL = ldsb;
    float* MLl = (float*)(ldsb + 73728);
    unsigned char* vt = ldsb + 77824 + wv * 4608;
    const bf16_t* qkv = wsb(a, QKV_OFF);
    bf16_t* mix = wsb(a, MIX_OFF);
    const int i16 = lane & 15, tq = i16 >> 2, tp = i16 & 3, tblk = (lane >> 4) & 1;
    const unsigned tr_addr = (unsigned)(size_t)vt + (4 * h + tq) * 144 + 2 * (16 * tblk + 4 * tp);
    const float sc = 0.125f * 1.44269504f, NEG = -1.0e30f;
    for (int un = blockIdx.x; un < NSEQ * 8 * 8; un += gridDim.x) {
      const int sh = un >> 3, sp = un & 7, seq = sh >> 3, hd = sh & 7; const size_t tb = (size_t)seq * 4096;
      __syncthreads();
#pragma unroll 1
      for (int di = 0; di < 3; ++di) {
       bf16x8 qfN[4], kN[4], vN[4];
#pragma unroll
       for (int k2 = 0; k2 < 2; ++k2) {
        const int idx16 = wv * 2 + k2;
        const int sft = 2 * di, nlen = 4096 >> sft;
        const int rr = (di == 0) ? 0 : (di == 1 ? (idx16 >> 2) : idx16), cb = (di == 0) ? (16 * sp + idx16) : (di == 1 ? (4 * sp + (idx16 & 3)) : sp), cq0 = cb * 32;
        const size_t tokq = tb + ((size_t)(cq0 + r) << sft) + rr;
        const bf16_t* qp = qkv + tokq * 1536 + hd * 64 + 8 * h;
        bf16x8 qf[4];
#pragma unroll
        for (int s = 0; s < 4; ++s) qf[s] = (k2 == 1) ? qfN[s] : *(const bf16x8*)(qp + 16 * s);
        float m = NEG, l = 0.f;
        f32x16 O0, O1;
#pragma unroll
        for (int i = 0; i < 16; ++i) { O0[i] = 0.f; O1[i] = 0.f; }
        bf16x8 kfb[2][4], vfb[2][4];
#define ATT_LOAD(kt_) do { const int kb_ = cq0 - 64 + 32 * (kt_); const size_t tokk_ = tb + ((size_t)(kb_ + r) << sft) + rr; const bf16_t* kp_ = qkv + tokk_ * 1536 + 512 + hd * 64 + 8 * h; \
            _Pragma("unroll") for (int s_ = 0; s_ < 4; ++s_) { kfb[(kt_) & 1][s_] = *(const bf16x8*)(kp_ + 16 * s_); vfb[(kt_) & 1][s_] = *(const bf16x8*)(kp_ + 512 + 16 * s_); } } while (0)
        if (cq0 - 64 >= 0) {
            if (k2 == 1) {
#pragma unroll
                for (int s_ = 0; s_ < 4; ++s_) { kfb[0][s_] = kN[s_]; vfb[0][s_] = vN[s_]; }
            } else ATT_LOAD(0);
        }
#pragma unroll
        for (int kt = 0; kt < 5; ++kt) {
            const int kb = cq0 - 64 + 32 * kt;
            if (kt + 1 < 5) { const int kbn = kb + 32; if (kbn >= 0 && kbn < nlen) ATT_LOAD(kt + 1); }
            if (k2 == 0 && kt == 4) {
                const int ix1 = idx16 + 1;
                const int rr1 = (di == 0) ? 0 : (di == 1 ? (ix1 >> 2) : ix1), cb1 = (di == 0) ? (16 * sp + ix1) : (di == 1 ? (4 * sp + (ix1 & 3)) : sp), cq1 = cb1 * 32;
                const bf16_t* qp1 = qkv + (tb + ((size_t)(cq1 + r) << sft) + rr1) * 1536 + hd * 64 + 8 * h;
#pragma unroll
                for (int s_ = 0; s_ < 4; ++s_) qfN[s_] = *(const bf16x8*)(qp1 + 16 * s_);
                if (cq1 - 64 >= 0) {
                    const bf16_t* kp1 = qkv + (tb + ((size_t)(cq1 - 64 + r) << sft) + rr1) * 1536 + 512 + hd * 64 + 8 * h;
#pragma unroll
                    for (int s_ = 0; s_ < 4; ++s_) { kN[s_] = *(const bf16x8*)(kp1 + 16 * s_); vN[s_] = *(const bf16x8*)(kp1 + 512 + 16 * s_); }
                }
            }
            asm volatile("" ::: "memory");
            if (kb < 0 || kb >= nlen) continue;
            bf16x8 kf[4], vf[4];
#pragma unroll
            for (int s = 0; s < 4; ++s) { kf[s] = kfb[kt & 1][s]; vf[s] = vfb[kt & 1][s]; }
            f32x16 S;
#pragma unroll
            for (int i = 0; i < 16; ++i) S[i] = 0.f;
#pragma unroll
            for (int s = 0; s < 4; ++s) S = MFMA32(kf[s], qf[s], S);
            float lm = NEG;
#pragma unroll
            for (int i = 0; i < 16; ++i) {
                const int row = (i & 3) + 8 * (i >> 2) + 4 * h;
                float v = S[i] * sc;
                if (kt == 0) v = (row >= r) ? v : NEG;
                if (kt == 4) v = (row <= r) ? v : NEG;
                S[i] = v; lm = fmaxf(lm, v);
            }
            lm = fmaxf(lm, SHX(lm, 32));
            const float mn = fmaxf(m, lm), alpha = __builtin_amdgcn_exp2f(m - mn);
            m = mn; l *= alpha;
            float ps = 0.f;
#pragma unroll
            for (int i = 0; i < 16; ++i) { O0[i] *= alpha; O1[i] *= alpha; S[i] = __builtin_amdgcn_exp2f(S[i] - mn); ps += S[i]; }
            l += ps;
            const bf16x8 pb0 = pack_frag(S[0], S[1], S[2], S[3], S[4], S[5], S[6], S[7]);
            const bf16x8 pb1 = pack_frag(S[8], S[9], S[10], S[11], S[12], S[13], S[14], S[15]);
            asm volatile("" ::: "memory");
#pragma unroll
            for (int i = 0; i < 4; ++i) *(bf16x8*)(vt + r * 144 + 2 * (16 * i + 8 * h)) = vf[i];
            typedef short s16x4 __attribute__((ext_vector_type(4)));
            s16x4 t00l, t00h, t01l, t01h, t10l, t10h, t11l, t11h;
            asm volatile("s_waitcnt lgkmcnt(0)\n\t"
                         "ds_read_b64_tr_b16 %0, %8\n\tds_read_b64_tr_b16 %1, %8 offset:1152\n\t"
                         "ds_read_b64_tr_b16 %2, %8 offset:2304\n\tds_read_b64_tr_b16 %3, %8 offset:3456\n\t"
                         "ds_read_b64_tr_b16 %4, %8 offset:64\n\tds_read_b64_tr_b16 %5, %8 offset:1216\n\t"
                         "ds_read_b64_tr_b16 %6, %8 offset:2368\n\tds_read_b64_tr_b16 %7, %8 offset:3520\n\t"
                         "s_waitcnt lgkmcnt(0)"
                         : "=&v"(t00l), "=&v"(t00h), "=&v"(t01l), "=&v"(t01h), "=&v"(t10l), "=&v"(t10h), "=&v"(t11l), "=&v"(t11h) : "v"(tr_addr) : "memory");
            const bf16x8 a00 = __builtin_shufflevector(t00l, t00h, 0, 1, 2, 3, 4, 5, 6, 7), a01 = __builtin_shufflevector(t01l, t01h, 0, 1, 2, 3, 4, 5, 6, 7);
            const bf16x8 a10 = __builtin_shufflevector(t10l, t10h, 0, 1, 2, 3, 4, 5, 6, 7), a11 = __builtin_shufflevector(t11l, t11h, 0, 1, 2, 3, 4, 5, 6, 7);
            O0 = MFMA32(a00, pb0, O0); O1 = MFMA32(a10, pb0, O1);
            O0 = MFMA32(a01, pb1, O0); O1 = MFMA32(a11, pb1, O1);
            asm volatile("" ::: "memory");
        }
#undef ATT_LOAD
        l += SHX(l, 32);
        const int ql = (((cq0 + r) << sft) + rr) - 512 * sp;
        unsigned char* orow = OL + ql * 144 + 8 * h;
        float ao = 0.f, ap = 1.0f;
        if (di > 0) {
            const f32x2 mo = *(const f32x2*)(MLl + 2 * ql);
            const float mn = fmaxf(mo[0], m);
            ao = __builtin_amdgcn_exp2f(mo[0] - mn); ap = __builtin_amdgcn_exp2f(m - mn);
            l = ao * mo[1] + ap * l; m = mn;
        }
#pragma unroll
        for (int g = 0; g < 4; ++g) {
            f32x4 v0 = {O0[4 * g] * ap, O0[4 * g + 1] * ap, O0[4 * g + 2] * ap, O0[4 * g + 3] * ap}, v1 = {O1[4 * g] * ap, O1[4 * g + 1] * ap, O1[4 * g + 2] * ap, O1[4 * g + 3] * ap};
            if (di > 0) {
                const u32x2 o0 = *(const u32x2*)(orow + 16 * g), o1 = *(const u32x2*)(orow + 64 + 16 * g);
                v0[0] += ao * bflo(o0.x); v0[1] += ao * bfhi(o0.x); v0[2] += ao * bflo(o0.y); v0[3] += ao * bfhi(o0.y);
                v1[0] += ao * bflo(o1.x); v1[1] += ao * bfhi(o1.x); v1[2] += ao * bflo(o1.y); v1[3] += ao * bfhi(o1.y);
            }
            u32x2 p0, p1; p0.x = pack2(v0[0], v0[1]); p0.y = pack2(v0[2], v0[3]); p1.x = pack2(v1[0], v1[1]); p1.y = pack2(v1[2], v1[3]);
            *(u32x2*)(orow + 16 * g) = p0; *(u32x2*)(orow + 64 + 16 * g) = p1;
        }
        if (h == 0) { f32x2 ml; ml[0] = m; ml[1] = l; *(f32x2*)(MLl + 2 * ql) = ml; }
       }
       __syncthreads();
      }
      {
        const int ql = tid0;
        const float inv = __builtin_amdgcn_rcpf(MLl[2 * ql + 1]);
        float o[64]; float ss = 0.f;
#pragma unroll
        for (int c = 0; c < 8; ++c) {
            const u32x4 w4 = *(const u32x4*)(OL + ql * 144 + 16 * c);
#pragma unroll
            for (int i = 0; i < 4; ++i) { o[8 * c + 2 * i] = bflo(w4[i]) * inv; o[8 * c + 2 * i + 1] = bfhi(w4[i]) * inv; ss += o[8 * c + 2 * i] * o[8 * c + 2 * i] + o[8 * c + 2 * i + 1] * o[8 * c + 2 * i + 1]; }
        }
        const float rn = rsqrtf(ss * (1.0f / 64.0f) + 1e-6f);
        const float* gp = a.att_norm_g + layer * 512 + hd * 64;
        bf16_t* dst = mix + (tb + 512 * sp + ql) * 1024 + hd * 64;
#pragma unroll
        for (int c = 0; c < 8; ++c) {
            const f32x4 g0 = *(const f32x4*)(gp + 8 * c), g1 = *(const f32x4*)(gp + 8 * c + 4);
            u32x4 w4; w4.x = pack2(o[8 * c] * rn * g0[0], o[8 * c + 1] * rn * g0[1]); w4.y = pack2(o[8 * c + 2] * rn * g0[2], o[8 * c + 3] * rn * g0[3]);
            w4.z = pack2(o[8 * c + 4] * rn * g1[0], o[8 * c + 5] * rn * g1[1]); w4.w = pack2(o[8 * c + 6] * rn * g1[2], o[8 * c + 7] * rn * g1[3]);
            *(u32x4*)(dst + 8 * c) = w4;
        }
      }
    }
}

DEV float tanh_fast(float x) { return 1.0f - 2.0f * __builtin_amdgcn_rcpf(1.0f + __expf(2.0f * x)); }

DEV void ph_rwkv_prep1(const Args& a, int layer, unsigned char* ldsb, const int tid0) {
    const int lane = tid0 & 63, wv = __builtin_amdgcn_readfirstlane(tid0 >> 6), r = lane & 31, h = lane >> 5;
    const int gw = blockIdx.x * 8 + wv, nw = gridDim.x * 8;
    const int sub = wv & 1, ng = wv >> 1;
    const bf16_t* U = wsb(a, U_OFF);
    const float* sw = a.rwkv_shift + (size_t)layer * 3 * UC;
    const bf16_t* wl = wsb(a, WB_OFF + (size_t)layer * WB_LAYER + WB_LORA);
#pragma unroll 1
    for (int arr = 0; arr < 5; ++arr) {
        const int coff = (arr < 4) ? arr * 64 : 256, nk = (arr < 4) ? 4 : 8, kw = nk * 16, rsb = kw * 2 + 16;
        __syncthreads();
        {
            const bf16_t* wsrc = wl + (arr < 4 ? arr * 512 * 64 : 4 * 512 * 64);
            const int cpr = kw / 8;
            for (int i = tid0; i < 512 * cpr; i += NTHR) { const int row = i / cpr, c = i - row * cpr; *(u32x4*)(ldsb + row * rsb + c * 16) = *(const u32x4*)(wsrc + (size_t)row * kw + c * 8); }
        }
        __syncthreads();
        bf16_t* outb = wsb(a, arr == 0 ? WF_OFF : arr == 1 ? WB2_OFF : arr == 2 ? AF_OFF : arr == 3 ? AB_OFF : G_OFF);
        const float* bias = (arr < 2) ? a.rwkv_w0 + (layer * 2 + arr) * 512 : a.rwkv_a0 + (layer * 2 + (arr & 1)) * 512;
        f32x4 bvr[4][4];
#pragma unroll
        for (int q = 0; q < 4; ++q)
#pragma unroll
            for (int g = 0; g < 4; ++g) bvr[q][g] = *(const f32x4*)(bias + (ng * 4 + q) * 32 + 8 * g + 4 * h);
#pragma unroll 1
        for (int tile = blockIdx.x; tile < T / 64; tile += gridDim.x) {
            const int t = tile * 64 + sub * 32 + r, pos = t & 4095;
            const bool hp = pos > 0, hn = pos < 4095;
            const bf16_t* up = U + (size_t)t * UW + 1536 + 8 * h;
            bf16x8 xf[8];
#pragma unroll
            for (int s = 0; s < 8; ++s) {
                if (s < nk) {
                    const int col = coff + 16 * s;
                    const u32x4 c = *(const u32x4*)(up + col);
                    u32x4 p = {0u, 0u, 0u, 0u}, n = {0u, 0u, 0u, 0u};
                    if (hp) p = *(const u32x4*)(up - UW + col);
                    if (hn) n = *(const u32x4*)(up + UW + col);
                    const float* s0 = sw + 1536 + 8 * h + col;
                    const f32x4 wp0 = *(const f32x4*)(s0), wp1 = *(const f32x4*)(s0 + 4), wc0 = *(const f32x4*)(s0 + UC), wc1 = *(const f32x4*)(s0 + UC + 4), wn0 = *(const f32x4*)(s0 + 2 * UC), wn1 = *(const f32x4*)(s0 + 2 * UC + 4);
                    float v[8];
#pragma unroll
                    for (int i = 0; i < 4; ++i) {
                        const float a0 = (i < 2) ? wp0[2 * i] : wp1[2 * i - 4], a1 = (i < 2) ? wp0[2 * i + 1] : wp1[2 * i - 3];
                        const float b0 = (i < 2) ? wc0[2 * i] : wc1[2 * i - 4], b1 = (i < 2) ? wc0[2 * i + 1] : wc1[2 * i - 3];
                        const float c0 = (i < 2) ? wn0[2 * i] : wn1[2 * i - 4], c1 = (i < 2) ? wn0[2 * i + 1] : wn1[2 * i - 3];
                        v[2 * i] = a0 * bflo(p[i]) + b0 * bflo(c[i]) + c0 * bflo(n[i]);
                        v[2 * i + 1] = a1 * bfhi(p[i]) + b1 * bfhi(c[i]) + c1 * bfhi(n[i]);
                    }
                    if (arr < 2) {
#pragma unroll
                        for (int i = 0; i < 8; ++i) v[i] = tanh_fast(v[i]);
                    } else if (arr == 4) {
#pragma unroll
                        for (int i = 0; i < 8; ++i) v[i] = sigmoidf_(v[i]);
                    }
                    xf[s] = pack_frag(v[0], v[1], v[2], v[3], v[4], v[5], v[6], v[7]);
                }
            }
            bf16_t* out = outb + (size_t)t * 512 + 4 * h;
#pragma unroll
            for (int q = 0; q < 4; ++q) {
                const int nt = ng * 4 + q;
                f32x16 C;
#pragma unroll
                for (int i = 0; i < 16; ++i) C[i] = 0.f;
                const unsigned char* wr = ldsb + (nt * 32 + r) * rsb + 16 * h;
#pragma unroll
                for (int s = 0; s < 8; ++s) if (s < nk) { const bf16x8 A = *(const bf16x8*)(wr + 32 * s); C = MFMA32(A, xf[s], C); }
#pragma unroll
                for (int g = 0; g < 4; ++g) {
                    float o[4];
                    if (arr < 4) {
                        const f32x4 bv = bvr[q][g];
#pragma unroll
                        for (int j = 0; j < 4; ++j) { const float sg = sigmoidf_(C[4 * g + j] + bv[j]); o[j] = (arr < 2) ? __expf(-0.60653066f * sg) : sg; }
                    } else {
#pragma unroll
                        for (int j = 0; j < 4; ++j) o[j] = C[4 * g + j];
                    }
                    u32x2 pk; pk.x = pack2(o[0], o[1]); pk.y = pack2(o[2], o[3]);
                    *(u32x2*)(out + nt * 32 + 8 * g) = pk;
                }
            }
        }
    }
    {
        const int c16 = 16 * lane;
        bf16_t* dst = wsb(a, lane < 32 ? RS_OFF : KS_OFF) + (c16 & 511);
        float swp[16], swc[16], swn[16];
#pragma unroll
        for (int i = 0; i < 16; ++i) { swp[i] = sw[c16 + i]; swc[i] = sw[UC + c16 + i]; swn[i] = sw[2 * UC + c16 + i]; }
        for (int t0 = gw; t0 < T; t0 += 2 * nw) {
            u32x4 c[2][2], p[2][2], n[2][2];
#pragma unroll
            for (int k = 0; k < 2; ++k) {
                const int t = t0 + k * nw; const int pos = t & 4095; const bool hp = pos > 0, hn = pos < 4095;
                const bf16_t* up = U + (size_t)t * UW + c16;
#pragma unroll
                for (int q = 0; q < 2; ++q) {
                    c[k][q] = *(const u32x4*)(up + 8 * q); p[k][q] = (u32x4){0u, 0u, 0u, 0u}; n[k][q] = (u32x4){0u, 0u, 0u, 0u};
                    if (hp) p[k][q] = *(const u32x4*)(up - UW + 8 * q);
                    if (hn) n[k][q] = *(const u32x4*)(up + UW + 8 * q);
                }
            }
#pragma unroll
            for (int k = 0; k < 2; ++k) {
                const int t = t0 + k * nw;
                u32x4 o[2];
#pragma unroll
                for (int q = 0; q < 2; ++q)
#pragma unroll
                    for (int i = 0; i < 4; ++i) {
                        const int e = 8 * q + 2 * i;
                        const float lo = swp[e] * bflo(p[k][q][i]) + swc[e] * bflo(c[k][q][i]) + swn[e] * bflo(n[k][q][i]);
                        const float hi = swp[e + 1] * bfhi(p[k][q][i]) + swc[e + 1] * bfhi(c[k][q][i]) + swn[e + 1] * bfhi(n[k][q][i]);
                        o[q][i] = pack2(lo, hi);
                    }
                *(u32x4*)(dst + (size_t)t * 512) = o[0]; *(u32x4*)(dst + (size_t)t * 512 + 8) = o[1];
            }
        }
    }
}
DEV void ph_rwkv_prep2(const Args& a, int layer, const int tid0) {
    const int lane = tid0 & 63, wv = tid0 >> 6;
    const int gw = blockIdx.x * 8 + wv, nw = gridDim.x * 8;
    bf16_t* U = wsb(a, U_OFF); const bf16_t* KS = wsb(a, KS_OFF);
    const float* sw = a.rwkv_shift + (size_t)layer * 3 * UC;
    const int c8 = 8 * lane;
    float kkc[8], sv[3][8];
#pragma unroll
    for (int i = 0; i < 8; ++i) { kkc[i] = a.rwkv_k_k[layer * 512 + c8 + i]; sv[0][i] = sw[1024 + c8 + i]; sv[1][i] = sw[UC + 1024 + c8 + i]; sv[2][i] = sw[2 * UC + 1024 + c8 + i]; }
    for (int t = gw; t < T; t += nw) {
        const int pos = t & 4095; const bool hp = pos > 0, hn = pos < 4095;
        bf16_t* up = U + (size_t)t * UW;
        const u32x4 ks = *(const u32x4*)(KS + (size_t)t * 512 + c8);
        const u32x4 c = *(const u32x4*)(up + 1024 + c8);
        u32x4 p = {0u, 0u, 0u, 0u}, n = {0u, 0u, 0u, 0u};
        if (hp) p = *(const u32x4*)(up - UW + 1024 + c8);
        if (hn) n = *(const u32x4*)(up + UW + 1024 + c8);
        float kx[8]; float ss = 0.f;
#pragma unroll
        for (int i = 0; i < 4; ++i) { kx[2 * i] = bflo(ks[i]) * kkc[2 * i]; kx[2 * i + 1] = bfhi(ks[i]) * kkc[2 * i + 1]; ss += kx[2 * i] * kx[2 * i] + kx[2 * i + 1] * kx[2 * i + 1]; }
        const float inv = 1.0f / fmaxf(sqrtf(sum8(ss)), 1e-12f);
        u32x4 ko, vo;
#pragma unroll
        for (int i = 0; i < 4; ++i) {
            ko[i] = pack2(kx[2 * i] * inv, kx[2 * i + 1] * inv);
            vo[i] = pack2(sv[0][2 * i] * bflo(p[i]) + sv[1][2 * i] * bflo(c[i]) + sv[2][2 * i] * bflo(n[i]), sv[0][2 * i + 1] * bfhi(p[i]) + sv[1][2 * i + 1] * bfhi(c[i]) + sv[2][2 * i + 1] * bfhi(n[i]));
        }
        *(u32x4*)(up + c8) = ko; *(u32x4*)(up + 1536 + c8) = vo;
    }
}

DEV void ph_post2(const Args& a, int layer, const int tid0) {
    const int lane = tid0 & 63, wv = tid0 >> 6;
    const int gw = blockIdx.x * 8 + wv, nw = gridDim.x * 8;
    const bf16_t* U = wsb(a, U_OFF); const bf16_t* RS = wsb(a, RS_OFF); const bf16_t* KS = wsb(a, KS_OFF); const bf16_t* G = wsb(a, G_OFF);
    const bf16_t* AF = wsb(a, AF_OFF); const bf16_t* AB = wsb(a, AB_OFF); bf16_t* mix = wsb(a, MIX_OFF);
    const int c8 = 8 * lane;
    float kac[8], rkc[8], lnw[8], lnb[8];
#pragma unroll
    for (int i = 0; i < 8; ++i) { kac[i] = a.rwkv_k_a[layer * 512 + c8 + i]; rkc[i] = a.rwkv_r_k[layer * 512 + c8 + i]; lnw[i] = a.rwkv_ln_w[layer * 512 + c8 + i]; lnb[i] = a.rwkv_ln_b[layer * 512 + c8 + i]; }
    struct PostLd { u32x4 rp, kp, gp, afp, abp, yfp, ybp, vp; };
    for (int t0 = gw; t0 < T; t0 += 2 * nw) {
        PostLd L[2];
#pragma unroll
        for (int k = 0; k < 2; ++k) {
            const int t = t0 + k * nw; const bf16_t* up = U + (size_t)t * UW;
            L[k].rp = *(const u32x4*)(RS + (size_t)t * 512 + c8); L[k].kp = *(const u32x4*)(KS + (size_t)t * 512 + c8); L[k].gp = *(const u32x4*)(G + (size_t)t * 512 + c8);
            L[k].afp = *(const u32x4*)(AF + (size_t)t * 512 + c8); L[k].abp = *(const u32x4*)(AB + (size_t)t * 512 + c8);
            L[k].yfp = *(const u32x4*)(up + 512 + c8); L[k].ybp = *(const u32x4*)(up + 1024 + c8); L[k].vp = *(const u32x4*)(up + 1536 + c8);
        }
#pragma unroll
        for (int k = 0; k < 2; ++k) {
        const int t = t0 + k * nw;
        const u32x4 rp = L[k].rp, kp = L[k].kp, gp = L[k].gp, afp = L[k].afp, abp = L[k].abp, yfp = L[k].yfp, ybp = L[k].ybp, vp = L[k].vp;
        float y[8], rr[8], kk[8], vv[8], gg[8], sa[8];
#pragma unroll
        for (int i = 0; i < 4; ++i) {
            y[2 * i] = bflo(yfp[i]) + bflo(ybp[i]); y[2 * i + 1] = bfhi(yfp[i]) + bfhi(ybp[i]);
            rr[2 * i] = bflo(rp[i]); rr[2 * i + 1] = bfhi(rp[i]); kk[2 * i] = bflo(kp[i]); kk[2 * i + 1] = bfhi(kp[i]);
            vv[2 * i] = bflo(vp[i]); vv[2 * i + 1] = bfhi(vp[i]); gg[2 * i] = bflo(gp[i]); gg[2 * i + 1] = bfhi(gp[i]);
            sa[2 * i] = bflo(afp[i]) + bflo(abp[i]); sa[2 * i + 1] = bfhi(afp[i]) + bfhi(abp[i]);
        }
        float ysum = 0.f, bs = 0.f;
#pragma unroll
        for (int i = 0; i < 8; ++i) { ysum += y[i]; bs += rr[i] * kk[i] * (2.0f + (sa[i] - 2.0f) * kac[i]) * rkc[i]; }
        const float mu = sum8(ysum) * (1.0f / 64.0f);
        float vs = 0.f;
#pragma unroll
        for (int i = 0; i < 8; ++i) { y[i] -= mu; vs += y[i] * y[i]; }
        const float rstdv = rsqrtf(sum8(vs) * (1.0f / 64.0f) + 64e-5f);
        bs = sum8(bs);
        float o[8];
#pragma unroll
        for (int i = 0; i < 8; ++i) o[i] = (y[i] * rstdv * lnw[i] + lnb[i] + bs * vv[i]) * gg[i];
        u32x4 ov; ov.x = pack2(o[0], o[1]); ov.y = pack2(o[2], o[3]); ov.z = pack2(o[4], o[5]); ov.w = pack2(o[6], o[7]);
        *(u32x4*)(mix + (size_t)t * 1024 + 512 + c8) = ov;
        }
    }
}

#ifdef PROBE_EMASK
#define PEER_EM(e) (DRY ? ((e) & PROBE_EMASK) : (e))
#else
#define PEER_EM(e) (e)
#endif
template <bool DRY> DEV void ph_peer_pipe(const Args& a, const int tid0, const int gw, const int nw, const int ntok, const int* TOPI, const float* TOPG, const int tbase) {
    const int lane = tid0 & 63;
    bf16_t* hb = wsb(a, HB_OFF); float* rstd = wsf(a, RSTD_OFF); const float* ssq = wsf(a, SSQ_OFF);
    const unsigned char* PU = a.ws + PTU_OFF; const unsigned char* PV = a.ws + PTV_OFF;
    const int c16 = 16 * lane;
    const bool b5 = lane & 32, b4 = lane & 16, b3 = lane & 8;
    const bool dost = DRY ? (__builtin_amdgcn_readfirstlane(*(const int*)(a.ws + TOPI_OFF)) == -12345) : true;
    u32x4 ur[2][8], vr[8];
    int e0, e1, e0n = 0, e1n = 0; float g0, g1, g0n = 0.f, g1n = 0.f;
    u32x4 xa, xb, xan = {0u, 0u, 0u, 0u}, xbn = {0u, 0u, 0u, 0u}; float rsv, rsn = 0.f;
#define PEER_ISSUE_U(slot_, b_, es0_, es1_) do { _Pragma("unroll") for (int i_ = 0; i_ < 8; ++i_) { const int k_ = (b_) * 8 + i_; \
        const int e_ = PEER_EM(__builtin_amdgcn_readlane((k_ < 64) ? (es0_) : (es1_), k_ & 63)); ur[slot_][i_] = *(const u32x4*)(PU + (size_t)e_ * 1024 + c16); } } while (0)
#define PEER_ISSUE_V(slot_, b_, es0_, es1_) do { _Pragma("unroll") for (int i_ = 0; i_ < 8; ++i_) { const int k_ = (b_) * 8 + i_; \
        const int e_ = PEER_EM(__builtin_amdgcn_readlane((k_ < 64) ? (es0_) : (es1_), k_ & 63)); vr[i_] = *(const u32x4*)(PV + (size_t)e_ * 1024 + c16); } } while (0)
    if (ntok <= 0) return;
    {   const int t0 = gw;
        e0 = TOPI[(t0 - tbase) * 128 + lane]; e1 = TOPI[(t0 - tbase) * 128 + 64 + lane]; g0 = TOPG[(t0 - tbase) * 128 + lane]; g1 = TOPG[(t0 - tbase) * 128 + 64 + lane];
        xa = *(const u32x4*)(hb + (size_t)t0 * 1024 + c16); xb = *(const u32x4*)(hb + (size_t)t0 * 1024 + c16 + 8); rsv = rstd_parts(ssq, t0); }
    PEER_ISSUE_U(0, 0, e0, e1);
#pragma unroll 1
    for (int j = 0; j < ntok; ++j) {
        const int t = gw + nw * j; const bool more = (j + 1 < ntok);
        float* hr = a.h + (size_t)t * 1024 + c16;
        if (more) { const int tn = t + nw;
            e0n = TOPI[(tn - tbase) * 128 + lane]; e1n = TOPI[(tn - tbase) * 128 + 64 + lane]; }
        const float rs = rsv * (1.0f / 256.0f);
        float out[16];
#pragma unroll
        for (int i = 0; i < 16; ++i) out[i] = 0.f;
#pragma unroll 1
        for (int b2 = 0; b2 < 16; b2 += 2)
#pragma unroll
        for (int bb = 0; bb < 2; ++bb) {
            const int b = b2 + bb;
            PEER_ISSUE_V(0, b, e0, e1);
            if (bb == 0) PEER_ISSUE_U(1, b + 1, e0, e1);
            else if (b < 15) PEER_ISSUE_U(0, b + 1, e0, e1);
            else if (more) PEER_ISSUE_U(0, 0, e0n, e1n);
            asm volatile("" ::: "memory");
            float d[8];
#pragma unroll
            for (int i = 0; i < 8; ++i) {
                float sm = 0.f;
#pragma unroll
                for (int q = 0; q < 4; ++q) {
                    const unsigned uw = ur[bb][i][q];
                    const f32x2 lo = __builtin_amdgcn_cvt_pk_f32_fp8((int)uw, false), hi = __builtin_amdgcn_cvt_pk_f32_fp8((int)uw, true);
                    const unsigned ulo = pack2(lo[0], lo[1]), uhi = pack2(hi[0], hi[1]);
                    const unsigned xlo = (q < 2) ? xa[2 * q] : xb[2 * q - 4], xhi = (q < 2) ? xa[2 * q + 1] : xb[2 * q - 3];
                    sm = dot2bf(ulo, xlo, sm); sm = dot2bf(uhi, xhi, sm);
                }
                d[i] = sm;
            }
            float r4[4], r2[2];
#pragma unroll
            for (int i = 0; i < 4; ++i) { const float send = b5 ? d[i] : d[4 + i], keep = b5 ? d[4 + i] : d[i]; r4[i] = keep + SHX(send, 32); }
#pragma unroll
            for (int i = 0; i < 2; ++i) { const float send = b4 ? r4[i] : r4[2 + i], keep = b4 ? r4[2 + i] : r4[i]; r2[i] = keep + SHX(send, 16); }
            const float send1 = b3 ? r2[0] : r2[1], keep1 = b3 ? r2[1] : r2[0];
            const float dd = sum8(keep1 + SHX(send1, 8));
            const float hp = rs * dd;
            const float gt = SHF((b < 8) ? g0 : g1, (b * 8 + (lane >> 3)) & 63);
            const float w = gt * 0.5f * hp * (1.0f + erff(hp * 0.70710678f)) * (1.0f / 32.0f);
#pragma unroll
            for (int i = 0; i < 8; ++i) {
                const float wi = rl(w, 8 * i);
#pragma unroll
                for (int q = 0; q < 4; ++q) {
                    const unsigned vw = vr[i][q];
                    const f32x2 lo = __builtin_amdgcn_cvt_pk_f32_fp8((int)vw, false), hi = __builtin_amdgcn_cvt_pk_f32_fp8((int)vw, true);
                    out[4 * q] += wi * lo[0]; out[4 * q + 1] += wi * lo[1]; out[4 * q + 2] += wi * hi[0]; out[4 * q + 3] += wi * hi[1];
                }
            }
        }
        if (more) { const int tn = t + nw;
            g0n = TOPG[(tn - tbase) * 128 + lane]; g1n = TOPG[(tn - tbase) * 128 + 64 + lane];
            xan = *(const u32x4*)(hb + (size_t)tn * 1024 + c16); xbn = *(const u32x4*)(hb + (size_t)tn * 1024 + c16 + 8); rsn = rstd_parts(ssq, tn); }
        float ss = 0.f;
        f32x4 hv[4];
#pragma unroll
        for (int q = 0; q < 4; ++q) hv[q] = *(const f32x4*)(hr + 4 * q);
#pragma unroll
        for (int q = 0; q < 4; ++q) {
#pragma unroll
            for (int c = 0; c < 4; ++c) { hv[q][c] += out[4 * q + c]; ss += hv[q][c] * hv[q][c]; }
            if (dost) *(f32x4*)(hr + 4 * q) = hv[q];
        }
        ss = wave_sum(ss);
        if (dost) {
            u32x4 p0, p1;
            p0.x = pack2(hv[0][0], hv[0][1]); p0.y = pack2(hv[0][2], hv[0][3]); p0.z = pack2(hv[1][0], hv[1][1]); p0.w = pack2(hv[1][2], hv[1][3]);
            p1.x = pack2(hv[2][0], hv[2][1]); p1.y = pack2(hv[2][2], hv[2][3]); p1.z = pack2(hv[3][0], hv[3][1]); p1.w = pack2(hv[3][2], hv[3][3]);
            *(u32x4*)(hb + (size_t)t * 1024 + c16) = p0; *(u32x4*)(hb + (size_t)t * 1024 + c16 + 8) = p1;
            if (lane == 0) rstd[t] = rsqrtf(ss * (1.0f / 1024.0f) + 1e-6f);
        }
        e0 = e0n; e1 = e1n; g0 = g0n; g1 = g1n; xa = xan; xb = xbn; rsv = rsn;
    }
#undef PEER_ISSUE_U
#undef PEER_ISSUE_V
}


#if PEER_FP4
DEV void ph_peer_pipe4(const Args& a, const int tid0, const int gw, const int nw, const int ntok, const int* TOPI, const float* TOPG, const int tbase) {
    const int lane = tid0 & 63;
    bf16_t* hb = wsb(a, HB_OFF); float* rstd = wsf(a, RSTD_OFF); const float* ssq = wsf(a, SSQ_OFF);
    const unsigned char* PU = a.ws + PTU_OFF; const unsigned char* PV = a.ws + PTV_OFF;
    const int c16 = 16 * lane, c8 = 8 * lane;
    const bool b5 = lane & 32, b4 = lane & 16, b3 = lane & 8;
    u32x2 ur[2][16], vr[16];
    int e0, e1, e0n = 0, e1n = 0; float g0, g1, g0n = 0.f, g1n = 0.f;
    u32x4 xa, xb, xan = {0u, 0u, 0u, 0u}, xbn = {0u, 0u, 0u, 0u}; float rsv, rsn = 0.f;
#define PEER_ISSUE_U(slot_, b_, es0_, es1_) do { _Pragma("unroll") for (int i_ = 0; i_ < 16; ++i_) { const int k_ = (b_) * 16 + i_; \
        const int e_ = __builtin_amdgcn_readlane((k_ < 64) ? (es0_) : (es1_), k_ & 63); ur[slot_][i_] = *(const u32x2*)(PU + (size_t)e_ * 512 + c8); } } while (0)
#define PEER_ISSUE_V(b_, es0_, es1_) do { _Pragma("unroll") for (int i_ = 0; i_ < 16; ++i_) { const int k_ = (b_) * 16 + i_; \
        const int e_ = __builtin_amdgcn_readlane((k_ < 64) ? (es0_) : (es1_), k_ & 63); vr[i_] = *(const u32x2*)(PV + (size_t)e_ * 512 + c8); } } while (0)
    if (ntok <= 0) return;
    {   const int t0 = gw;
        e0 = TOPI[(t0 - tbase) * 128 + lane]; e1 = TOPI[(t0 - tbase) * 128 + 64 + lane]; g0 = TOPG[(t0 - tbase) * 128 + lane]; g1 = TOPG[(t0 - tbase) * 128 + 64 + lane];
        xa = *(const u32x4*)(hb + (size_t)t0 * 1024 + c16); xb = *(const u32x4*)(hb + (size_t)t0 * 1024 + c16 + 8); rsv = rstd_parts(ssq, t0); }
    PEER_ISSUE_U(0, 0, e0, e1);
#pragma unroll 1
    for (int j = 0; j < ntok; ++j) {
        const int t = gw + nw * j; const bool more = (j + 1 < ntok);
        float* hr = a.h + (size_t)t * 1024 + c16;
        if (more) { const int tn = t + nw;
            e0n = TOPI[(tn - tbase) * 128 + lane]; e1n = TOPI[(tn - tbase) * 128 + 64 + lane]; }
        const float rs = rsv * (1.0f / PEER_USC);
        f32x2 out[8];
#pragma unroll
        for (int i = 0; i < 8; ++i) out[i] = (f32x2){0.f, 0.f};
#pragma unroll 1
        for (int b2 = 0; b2 < 8; b2 += 2)
#pragma unroll
        for (int bb = 0; bb < 2; ++bb) {
            const int b = b2 + bb;
            PEER_ISSUE_V(b, e0, e1);
            if (bb == 0) PEER_ISSUE_U(1, b + 1, e0, e1);
            else if (b < 7) PEER_ISSUE_U(0, b + 1, e0, e1);
            else if (more) PEER_ISSUE_U(0, 0, e0n, e1n);
            asm volatile("" ::: "memory");
            float w2[2];
#pragma unroll
            for (int hf = 0; hf < 2; ++hf) {
                float d[8];
#pragma unroll
                for (int i = 0; i < 8; ++i) {
                    float sm = 0.f;
#pragma unroll
                    for (int q = 0; q < 2; ++q) {
                        const unsigned uw = ur[bb][hf * 8 + i][q]; const u32x4 xq = (q == 0) ? xa : xb;
#define PEER_UD(sb_) sm = dot2bf(__builtin_bit_cast(unsigned, __builtin_amdgcn_cvt_scalef32_pk_bf16_fp4(uw, 1.0f, sb_)), xq[sb_], sm)
                        PEER_UD(0); PEER_UD(1); PEER_UD(2); PEER_UD(3);
#undef PEER_UD
                    }
                    d[i] = sm;
                }
                float r4[4], r2[2];
#pragma unroll
                for (int i = 0; i < 4; ++i) { const float send = b5 ? d[i] : d[4 + i], keep = b5 ? d[4 + i] : d[i]; r4[i] = keep + SHX(send, 32); }
#pragma unroll
                for (int i = 0; i < 2; ++i) { const float send = b4 ? r4[i] : r4[2 + i], keep = b4 ? r4[2 + i] : r4[i]; r2[i] = keep + SHX(send, 16); }
                const float send1 = b3 ? r2[0] : r2[1], keep1 = b3 ? r2[1] : r2[0];
                const float dd = sum8(keep1 + SHX(send1, 8));
                const float hp = rs * dd;
                const float gt = SHF((b < 4) ? g0 : g1, (b * 16 + hf * 8 + (lane >> 3)) & 63);
                w2[hf] = gt * 0.5f * hp * (1.0f + erff(hp * 0.70710678f)) * (1.0f / PEER_VSC);
            }
#pragma unroll
            for (int i = 0; i < 16; ++i) {
                const float wi = rl(w2[i >> 3], 8 * (i & 7));
                const f32x2 wv2 = {wi, wi};
#pragma unroll
                for (int q = 0; q < 2; ++q) {
                    const unsigned vw = vr[i][q];
#define PEER_VA(sb_) out[q * 4 + sb_] = __builtin_elementwise_fma(__builtin_amdgcn_cvt_scalef32_pk_f32_fp4(vw, 1.0f, sb_), wv2, out[q * 4 + sb_])
                    PEER_VA(0); PEER_VA(1); PEER_VA(2); PEER_VA(3);
#undef PEER_VA
                }
            }
        }
        if (more) { const int tn = t + nw;
            g0n = TOPG[(tn - tbase) * 128 + lane]; g1n = TOPG[(tn - tbase) * 128 + 64 + lane];
            xan = *(const u32x4*)(hb + (size_t)tn * 1024 + c16); xbn = *(const u32x4*)(hb + (size_t)tn * 1024 + c16 + 8); rsn = rstd_parts(ssq, tn); }
        float ss = 0.f;
        f32x4 hv[4];
#pragma unroll
        for (int q = 0; q < 4; ++q) hv[q] = *(const f32x4*)(hr + 4 * q);
#pragma unroll
        for (int q = 0; q < 4; ++q) {
#pragma unroll
            for (int c = 0; c < 4; ++c) { hv[q][c] += out[2 * q + (c >> 1)][c & 1]; ss += hv[q][c] * hv[q][c]; }
            *(f32x4*)(hr + 4 * q) = hv[q];
        }
        ss = wave_sum(ss);
        {
            u32x4 p0, p1;
            p0.x = pack2(hv[0][0], hv[0][1]); p0.y = pack2(hv[0][2], hv[0][3]); p0.z = pack2(hv[1][0], hv[1][1]); p0.w = pack2(hv[1][2], hv[1][3]);
            p1.x = pack2(hv[2][0], hv[2][1]); p1.y = pack2(hv[2][2], hv[2][3]); p1.z = pack2(hv[3][0], hv[3][1]); p1.w = pack2(hv[3][2], hv[3][3]);
            *(u32x4*)(hb + (size_t)t * 1024 + c16) = p0; *(u32x4*)(hb + (size_t)t * 1024 + c16 + 8) = p1;
            if (lane == 0) rstd[t] = rsqrtf(ss * (1.0f / 1024.0f) + 1e-6f);
        }
        e0 = e0n; e1 = e1n; g0 = g0n; g1 = g1n; xa = xan; xb = xbn; rsv = rsn;
    }
#undef PEER_ISSUE_U
#undef PEER_ISSUE_V
}
#define PEER_PIPE(...) ph_peer_pipe4(__VA_ARGS__)
#else
#define PEER_PIPE(...) ph_peer_pipe<false>(__VA_ARGS__)
#endif


#if PEER_MX
typedef int i32x8 __attribute__((ext_vector_type(8)));
#define MXF(A_, B_, C_) __builtin_amdgcn_mfma_scale_f32_16x16x128_f8f6f4((A_), (B_), (C_), 4, 4, 0, 0x7F7F7F7F, 0, 0x7F7F7F7F)
#define MXFS(A_, B_, C_, SB_) __builtin_amdgcn_mfma_scale_f32_16x16x128_f8f6f4((A_), (B_), (C_), 4, 4, 0, 0x7F7F7F7F, 0, (SB_))
#define MX8(v_) ((i32x8){(int)(v_).x, (int)(v_).y, (int)(v_).z, (int)(v_).w, 0, 0, 0, 0})
namespace mx { constexpr int U0 = 0, VB = 16384, XQ = 49152, WF = 50176, WL = 51200, BASE = 57344; constexpr float XSC = 1.5f; }
DEV int mx_sw(int r) { return ((r & 3) << 2) | (r >> 2); }
#define MX_Q2(d1_, d2_, va_, vb_, sel_) do { d1_ = __builtin_amdgcn_cvt_scalef32_pk_fp4_f32(d1_, (va_), (vb_), 1.0f, sel_); const f32x2 q_ = __builtin_amdgcn_cvt_scalef32_pk_f32_fp4(d1_, 1.0f, sel_); \
        d2_ = __builtin_amdgcn_cvt_scalef32_pk_fp4_f32(d2_, ((va_) - q_[0]) * 8.0f, ((vb_) - q_[1]) * 8.0f, 1.0f, sel_); } while (0)
#define MX_Q3(d1_, d2_, d3_, va_, vb_, sel_) do { d1_ = __builtin_amdgcn_cvt_scalef32_pk_fp4_f32(d1_, (va_), (vb_), 1.0f, sel_); const f32x2 q_ = __builtin_amdgcn_cvt_scalef32_pk_f32_fp4(d1_, 1.0f, sel_); \
        const float ra_ = ((va_) - q_[0]) * 8.0f, rb_ = ((vb_) - q_[1]) * 8.0f; d2_ = __builtin_amdgcn_cvt_scalef32_pk_fp4_f32(d2_, ra_, rb_, 1.0f, sel_); const f32x2 p_ = __builtin_amdgcn_cvt_scalef32_pk_f32_fp4(d2_, 1.0f, sel_); \
        d3_ = __builtin_amdgcn_cvt_scalef32_pk_fp4_f32(d3_, (ra_ - p_[0]) * 8.0f, (rb_ - p_[1]) * 8.0f, 1.0f, sel_); } while (0)
DEV void ph_peer_mx(const Args& a, const int tid0, const int t0, const int tstride, const int ntok, const int* EL, const float* GL, const int tbase, PG8_LAS unsigned char* wl, unsigned char* wg) {
    const int lane = tid0 & 63, r = lane & 15, kq = lane >> 4;
    bf16_t* hb = wsb(a, HB_OFF); float* rstd = wsf(a, RSTD_OFF); const float* ssq = wsf(a, SSQ_OFF);
    const unsigned char* PU = a.ws + PTU_OFF; const unsigned char* PV = a.ws + PTV_OFF;
    const int c16 = 16 * lane;
#pragma unroll 1
    for (int j = 0; j < ntok; ++j) {
        const int t = t0 + tstride * j;
        const int* el = EL + (t - tbase) * 128; const float* gl = GL + (t - tbase) * 128;
        {   const u32x4 xa = *(const u32x4*)(hb + (size_t)t * 1024 + c16), xb = *(const u32x4*)(hb + (size_t)t * 1024 + c16 + 8);
            const float sc = rstd_parts(ssq, t) * mx::XSC;
            u32x2 q1 = {0u, 0u}, q2 = {0u, 0u};
            MX_Q2(q1.x, q2.x, bflo(xa.x) * sc, bfhi(xa.x) * sc, 0); MX_Q2(q1.x, q2.x, bflo(xa.y) * sc, bfhi(xa.y) * sc, 1); MX_Q2(q1.x, q2.x, bflo(xa.z) * sc, bfhi(xa.z) * sc, 2); MX_Q2(q1.x, q2.x, bflo(xa.w) * sc, bfhi(xa.w) * sc, 3);
            MX_Q2(q1.y, q2.y, bflo(xb.x) * sc, bfhi(xb.x) * sc, 0); MX_Q2(q1.y, q2.y, bflo(xb.y) * sc, bfhi(xb.y) * sc, 1); MX_Q2(q1.y, q2.y, bflo(xb.z) * sc, bfhi(xb.z) * sc, 2); MX_Q2(q1.y, q2.y, bflo(xb.w) * sc, bfhi(xb.w) * sc, 3);
            *(u32x2*)(wg + mx::XQ + 8 * lane) = q1; *(u32x2*)(wg + mx::XQ + 512 + 8 * lane) = q2; }
        u32x4 xB1[8], xB2[8];
#pragma unroll
        for (int s = 0; s < 8; ++s) { xB1[s] = *(const u32x4*)(wg + mx::XQ + 64 * s + 16 * kq); xB2[s] = *(const u32x4*)(wg + mx::XQ + 512 + 64 * s + 16 * kq); }
#pragma unroll 1
        for (int g = 0; g < 8; ++g) {
#pragma unroll
            for (int m = 0; m < 8; ++m) {
                const int row = 2 * m + (lane >> 5); const int e = el[16 * g + row];
                const unsigned char* gp = PU + (size_t)e * 512 + (((lane & 31) ^ mx_sw(row)) * 16);
                __builtin_amdgcn_global_load_lds((const unsigned*)gp, (PG8_LAS unsigned*)(wl + mx::U0 + m * 1024), 16, 0, 0);
            }
            asm volatile("s_waitcnt vmcnt(0)" ::: "memory");
            f32x4 acc1 = {0.f, 0.f, 0.f, 0.f}, acc2 = {0.f, 0.f, 0.f, 0.f};
#pragma unroll
            for (int s = 0; s < 8; ++s) {
                const u32x4 a4 = *(const u32x4*)(wg + mx::U0 + r * 512 + (((4 * s + kq) ^ mx_sw(r)) * 16));
                acc1 = MXF(MX8(a4), MX8(xB1[s]), acc1); acc2 = MXF(MX8(a4), MX8(xB2[s]), acc2);
            }
            const f32x4 gt = *(const f32x4*)(gl + 16 * g + 4 * kq);
            f32x4 w;
#pragma unroll
            for (int i2 = 0; i2 < 4; ++i2) { const float hp = (acc1[i2] + 0.125f * acc2[i2]) * (1.0f / (PEER_USC * mx::XSC)); w[i2] = gt[i2] * 0.5f * hp * (1.0f + erff(hp * 0.70710678f)); }
            if (r == 0) *(f32x4*)(wg + mx::WF + (16 * g + 4 * kq) * 4) = w;
            asm volatile("" ::: "memory");
        }
        float wmx = fmaxf(fabsf(*(const float*)(wg + mx::WF + 4 * lane)), fabsf(*(const float*)(wg + mx::WF + 256 + 4 * lane)));
        wmx = wave_max(wmx);
        const float wS = (wmx > 0.f) ? 4.0f * __builtin_amdgcn_rcpf(wmx) : 0.f, wIS = wmx * 0.25f * (1.0f / PEER_VSC);
        u32x4 wB1 = {0u, 0u, 0u, 0u}, wB2 = wB1, wB3 = wB1;
#pragma unroll
        for (int q = 0; q < 4; ++q) {
            const f32x4 w0 = *(const f32x4*)(wg + mx::WF + 128 * kq + 32 * q), w1 = *(const f32x4*)(wg + mx::WF + 128 * kq + 32 * q + 16);
            MX_Q3(wB1[q], wB2[q], wB3[q], w0[0] * wS, w0[1] * wS, 0); MX_Q3(wB1[q], wB2[q], wB3[q], w0[2] * wS, w0[3] * wS, 1);
            MX_Q3(wB1[q], wB2[q], wB3[q], w1[0] * wS, w1[1] * wS, 2); MX_Q3(wB1[q], wB2[q], wB3[q], w1[2] * wS, w1[3] * wS, 3);
        }
        float ss = 0.f;
#if !PEER_MXV
        {   f32x2 out[8];
#pragma unroll
            for (int i2 = 0; i2 < 8; ++i2) out[i2] = (f32x2){0.f, 0.f};
#pragma unroll 1
            for (int k = 0; k < 128; ++k) {
                const int e = el[k]; const u32x2 vw2 = *(const u32x2*)(PV + (size_t)e * 512 + 8 * lane);
                const float wi = *(const float*)(wg + mx::WF + 4 * k) * (1.0f / PEER_VSC); const f32x2 wv2 = {wi, wi};
#define PEER_VA(q_, sb_) out[q_ * 4 + sb_] = __builtin_elementwise_fma(__builtin_amdgcn_cvt_scalef32_pk_f32_fp4(vw2[q_], 1.0f, sb_), wv2, out[q_ * 4 + sb_])
                PEER_VA(0, 0); PEER_VA(0, 1); PEER_VA(0, 2); PEER_VA(0, 3); PEER_VA(1, 0); PEER_VA(1, 1); PEER_VA(1, 2); PEER_VA(1, 3);
#undef PEER_VA
            }
            float* hr = a.h + (size_t)t * 1024 + c16;
            f32x4 hv[4];
#pragma unroll
            for (int q = 0; q < 4; ++q) hv[q] = *(const f32x4*)(hr + 4 * q);
#pragma unroll
            for (int q = 0; q < 4; ++q) {
#pragma unroll
                for (int c = 0; c < 4; ++c) { hv[q][c] += out[2 * q + (c >> 1)][c & 1]; ss += hv[q][c] * hv[q][c]; }
                *(f32x4*)(hr + 4 * q) = hv[q];
            }
            u32x4 p0, p1;
            p0.x = pack2(hv[0][0], hv[0][1]); p0.y = pack2(hv[0][2], hv[0][3]); p0.z = pack2(hv[1][0], hv[1][1]); p0.w = pack2(hv[1][2], hv[1][3]);
            p1.x = pack2(hv[2][0], hv[2][1]); p1.y = pack2(hv[2][2], hv[2][3]); p1.z = pack2(hv[3][0], hv[3][1]); p1.w = pack2(hv[3][2], hv[3][3]);
            *(u32x4*)(hb + (size_t)t * 1024 + c16) = p0; *(u32x4*)(hb + (size_t)t * 1024 + c16 + 8) = p1;
        }
#else
#pragma unroll 1
        for (int hf = 0; hf < 2; ++hf) {
#pragma unroll 1
            for (int m4 = 0; m4 < 32; m4 += 4)
#pragma unroll
            for (int mm = 0; mm < 4; ++mm) {
                const int m = m4 + mm;
                const int ei = 4 * m + (lane >> 4); const int e = el[ei];
                const unsigned char* gp = PV + (size_t)e * 512 + ((hf * 16 + ((lane & 15) ^ (ei & 15))) * 16);
                __builtin_amdgcn_global_load_lds((const unsigned*)gp, (PG8_LAS unsigned*)(wl + mx::VB + m * 1024), 16, 0, 0);
            }
            asm volatile("s_waitcnt vmcnt(0)" ::: "memory");
#pragma unroll 1
            for (int cg = 0; cg < 2; ++cg) {
                f32x4 keep = {0.f, 0.f, 0.f, 0.f};
#pragma unroll
                for (int cb16 = 0; cb16 < 16; ++cb16) {
                    const int cb = cg * 16 + cb16;
                    const unsigned ad = (unsigned)(size_t)(wg + mx::VB) + (32 * kq + r) * 256 + (((cb >> 1) ^ r) * 16) + (cb & 1) * 8;
                    u32x2 lo, hi;
                    asm volatile("ds_read_b64_tr_b4 %0, %2\n\tds_read_b64_tr_b4 %1, %2 offset:4096\n\ts_waitcnt lgkmcnt(0)" : "=&v"(lo), "=&v"(hi) : "v"(ad) : "memory");
                    const i32x8 A8 = {(int)lo.x, (int)lo.y, (int)hi.x, (int)hi.y, 0, 0, 0, 0};
                    const f32x4 z = {0.f, 0.f, 0.f, 0.f};
                    const f32x4 d1 = MXF(A8, MX8(wB1), z), d2 = MXF(A8, MX8(wB2), z), d3 = MXF(A8, MX8(wB3), z);
                    const bool mine = (r == cb16);
#pragma unroll
                    for (int i2 = 0; i2 < 4; ++i2) keep[i2] = mine ? (d1[i2] + 0.125f * (d2[i2] + 0.125f * d3[i2])) : keep[i2];
                }
                const int c0 = hf * 512 + cg * 256 + 16 * r + 4 * kq;
                float* hr = a.h + (size_t)t * 1024 + c0;
                f32x4 hv = *(const f32x4*)hr;
#pragma unroll
                for (int i2 = 0; i2 < 4; ++i2) { hv[i2] += keep[i2] * wIS; ss += hv[i2] * hv[i2]; }
                *(f32x4*)hr = hv;
                u32x2 pk; pk.x = pack2(hv[0], hv[1]); pk.y = pack2(hv[2], hv[3]);
                *(u32x2*)(hb + (size_t)t * 1024 + c0) = pk;
            }
            asm volatile("" ::: "memory");
        }
#endif
        ss = wave_sum(ss);
        if (lane == 0) rstd[t] = rsqrtf(ss * (1.0f / 1024.0f) + 1e-6f);
        asm volatile("s_waitcnt vmcnt(0) lgkmcnt(0)" ::: "memory");
    }
}
#endif

#if PEER_MX == 2
#ifndef MXN
#define MXN 7
#endif
namespace mx2 { constexpr int XQ = MXN * 8192, WF = XQ + 1024, XR = XQ + 2048, HR = XQ + 4096, WL = XQ + 8192, BASE = 29696; }
static_assert(mx2::BASE + 2 * mx2::WL <= LDS_BYTES - 16, "LDS budget of the expert phase");
#define MX_WAIT(n_) asm volatile("s_waitcnt vmcnt(" #n_ ")" ::: "memory")
DEV void mx_ids(const int c, const int* el, const int lane, int (&e)[8]) {
    const int* p = (c < 8) ? el + 16 * c + (lane >> 5) : el + 32 * ((c - 8) & 3) + (lane >> 4);
    const int st = (c < 8) ? 2 : 4;
#pragma unroll
    for (int m = 0; m < 8; ++m) e[m] = p[st * m] & 16383;
}
DEV void mx_dma(const int c, const int (&e)[8], const int lane, const unsigned char* PU, const unsigned char* PV, PG8_LAS unsigned char* wl, int& slot) {
    PG8_LAS unsigned char* dst = wl + slot * 8192;
    if (c < 8) {
#pragma unroll
        for (int m = 0; m < 8; ++m) {
            const int row = 2 * m + (lane >> 5);
            const unsigned char* gp = PU + (size_t)e[m] * 512 + (((lane & 31) ^ mx_sw(row)) * 16);
            __builtin_amdgcn_global_load_lds((const unsigned*)gp, (PG8_LAS unsigned*)(dst + m * 1024), 16, 0, 0);
        }
    } else {
        const int hf = (c - 8) >> 2;
#pragma unroll
        for (int m = 0; m < 8; ++m) {
            const int li = 4 * m + (lane >> 4);
            const unsigned char* gp = PV + (size_t)e[m] * 512 + ((hf * 16 + ((lane & 15) ^ (li & 15))) * 16);
            __builtin_amdgcn_global_load_lds((const unsigned*)gp, (PG8_LAS unsigned*)(dst + m * 1024), 16, 0, 0);
        }
    }
    slot = (slot + 1 == MXN) ? 0 : slot + 1;
}
DEV void mx_dma_x(const bf16_t* hb, const int t, const int lane, PG8_LAS unsigned char* wl) {
#pragma unroll
    for (int i = 0; i < 2; ++i) __builtin_amdgcn_global_load_lds((const unsigned*)((const unsigned char*)hb + (size_t)t * 2048 + i * 1024 + lane * 16), (PG8_LAS unsigned*)(wl + mx2::XR + i * 1024), 16, 0, 0);
}
DEV void mx_dma_h(const float* h, const int t, const int lane, PG8_LAS unsigned char* wl) {
#pragma unroll
    for (int i = 0; i < 4; ++i) __builtin_amdgcn_global_load_lds((const unsigned*)((const unsigned char*)h + (size_t)t * 4096 + i * 1024 + lane * 16), (PG8_LAS unsigned*)(wl + mx2::HR + i * 1024), 16, 0, 0);
}
DEV float mx_erf(float x) { const float ax = fabsf(x), t = __builtin_amdgcn_rcpf(1.0f + 0.3275911f * ax);
    const float pl = ((((1.061405429f * t - 1.453152027f) * t + 1.421413741f) * t - 0.284496736f) * t + 0.254829592f) * t;
    return copysignf(1.0f - pl * __expf(-ax * ax), x); }
DEV void ph_peer_mx2(const Args& a, const int tid0, const int t0, const int tstride, const int ntok, const int* EL, const float* RL, const int tbase, PG8_LAS unsigned char* wl, unsigned char* wg) {
    const int lane = tid0 & 63, r = lane & 15, kq = lane >> 4, ri = r & 3;
    bf16_t* hb = wsb(a, HB_OFF); float* rstd = wsf(a, RSTD_OFF);
    const unsigned char* PU = a.ws + PTU_OFF; const unsigned char* PV = a.ws + PTV_OFF;
    if (ntok <= 0) return;
    int sm1[4], sm2[4];
#pragma unroll
    for (int q = 0; q < 4; ++q) { const bool on = ((r >> 2) == q); const int sh = 8 * (r & 3); sm1[q] = on ? (0x7F << sh) : 0; sm2[q] = on ? (0x7C << sh) : 0; }
    __builtin_amdgcn_s_setprio(PEER_PRIO);
    int islot = 0, cslot = 0;
    {   const int* el0 = EL + (t0 - tbase) * 128;
        mx_dma_x(hb, t0, lane, wl);
#pragma unroll 1
        for (int c = 0; c < MXN; ++c) { int e[8]; mx_ids(c, el0, lane, e); mx_dma(c, e, lane, PU, PV, wl, islot); }
        mx_dma_h(a.h, t0, lane, wl); }
#pragma unroll 1
    for (int j = 0; j < ntok; ++j) {
        const int t = t0 + tstride * j; const bool more = (j + 1 < ntok);
        const int* el = EL + (t - tbase) * 128; const int* eln = el + tstride * 128;
        if (j == 0) MX_WAIT(56); else MX_WAIT(32);
        {   const u32x4 xa = *(const u32x4*)(wg + mx2::XR + 32 * lane), xb = *(const u32x4*)(wg + mx2::XR + 32 * lane + 16);
            const float sc = RL[t - tbase] * mx::XSC;
            u32x2 q1 = {0u, 0u}, q2 = {0u, 0u};
            MX_Q2(q1.x, q2.x, bflo(xa.x) * sc, bfhi(xa.x) * sc, 0); MX_Q2(q1.x, q2.x, bflo(xa.y) * sc, bfhi(xa.y) * sc, 1); MX_Q2(q1.x, q2.x, bflo(xa.z) * sc, bfhi(xa.z) * sc, 2); MX_Q2(q1.x, q2.x, bflo(xa.w) * sc, bfhi(xa.w) * sc, 3);
            MX_Q2(q1.y, q2.y, bflo(xb.x) * sc, bfhi(xb.x) * sc, 0); MX_Q2(q1.y, q2.y, bflo(xb.y) * sc, bfhi(xb.y) * sc, 1); MX_Q2(q1.y, q2.y, bflo(xb.z) * sc, bfhi(xb.z) * sc, 2); MX_Q2(q1.y, q2.y, bflo(xb.w) * sc, bfhi(xb.w) * sc, 3);
            *(u32x2*)(wg + mx2::XQ + 8 * lane) = q1; *(u32x2*)(wg + mx2::XQ + 512 + 8 * lane) = q2; }
        u32x4 xB1[8], xB2[8];
#pragma unroll
        for (int s = 0; s < 8; ++s) { xB1[s] = *(const u32x4*)(wg + mx2::XQ + 64 * s + 16 * kq); xB2[s] = *(const u32x4*)(wg + mx2::XQ + 512 + 64 * s + 16 * kq); }
#pragma unroll 1
        for (int g = 0; g < 8; ++g) {
            int en[8]; mx_ids(g + MXN, el, lane, en);
            const float gt = (float)((unsigned)el[16 * g + 4 * kq + ri] >> 14) * (1.0f / 262143.0f);
            asm volatile("s_waitcnt vmcnt(%0)" :: "n"(8 * (MXN - 1)) : "memory");
            const unsigned char* ub = wg + cslot * 8192;
            f32x4 acc1 = {0.f, 0.f, 0.f, 0.f}, acc2 = {0.f, 0.f, 0.f, 0.f};
#pragma unroll
            for (int s = 0; s < 8; ++s) {
                const u32x4 a4 = *(const u32x4*)(ub + r * 512 + (((4 * s + kq) ^ mx_sw(r)) * 16));
#if MX_HWS
                acc1 = MXF(MX8(a4), MX8(xB1[s]), acc1); acc1 = MXFS(MX8(a4), MX8(xB2[s]), acc1, 0x7C7C7C7C);
#else
                acc1 = MXF(MX8(a4), MX8(xB1[s]), acc1); acc2 = MXF(MX8(a4), MX8(xB2[s]), acc2);
#endif
            }
            asm volatile("" ::: "memory");
            cslot = (cslot + 1 == MXN) ? 0 : cslot + 1;
            mx_dma(g + MXN, en, lane, PU, PV, wl, islot);
            const float d0 = acc1[0] + 0.125f * acc2[0], d1 = acc1[1] + 0.125f * acc2[1], d2 = acc1[2] + 0.125f * acc2[2], d3 = acc1[3] + 0.125f * acc2[3];
            const float hp = ((ri & 2) ? ((ri & 1) ? d3 : d2) : ((ri & 1) ? d1 : d0)) * (1.0f / (PEER_USC * mx::XSC));
            const float w = gt * 0.5f * hp * (1.0f + mx_erf(hp * 0.70710678f));
            if (r < 4) *(float*)(wg + mx2::WF + (16 * g + 4 * kq + r) * 4) = w;
            asm volatile("" ::: "memory");
        }
        float wmx = fmaxf(fabsf(*(const float*)(wg + mx2::WF + 4 * lane)), fabsf(*(const float*)(wg + mx2::WF + 256 + 4 * lane)));
        wmx = wave_max(wmx);
        const float wS = (wmx > 0.f) ? 4.0f * __builtin_amdgcn_rcpf(wmx) : 0.f, wIS = wmx * 0.25f * (1.0f / PEER_VSC);
        u32x4 wB1, wB2;
        {   const f32x2 wp = *(const f32x2*)(wg + mx2::WF + 4 * (32 * kq + 2 * r));
            unsigned b1 = 0u, b2 = 0u;
            MX_Q2(b1, b2, wp[0] * wS, wp[1] * wS, 0);
            unsigned char* wq = wg + mx2::WF + 512 + 16 * kq + r;
            wq[0] = (unsigned char)b1; wq[64] = (unsigned char)b2;
            wB1 = *(const u32x4*)(wg + mx2::WF + 512 + 16 * kq); wB2 = *(const u32x4*)(wg + mx2::WF + 576 + 16 * kq); }
        float ss = 0.f;
#pragma unroll 1
        for (int hf = 0; hf < 2; ++hf) {
            int e4[4][8];
#pragma unroll
            for (int i4 = 0; i4 < 4; ++i4) { const int ca = 8 + MXN + 4 * hf + i4; if (ca < 16) mx_ids(ca, el, lane, e4[i4]); else mx_ids(ca - 16, eln, lane, e4[i4]); }
            if (hf == 0 || more) asm volatile("s_waitcnt vmcnt(%0)" :: "n"(8 * (MXN - 4)) : "memory"); else MX_WAIT(0);
            int vs = cslot + kq; vs = (vs >= MXN) ? vs - MXN : vs;
            const unsigned vbase = (unsigned)(size_t)wg + vs * 8192 + r * 256;
#pragma unroll 1
            for (int cg = 0; cg < 2; ++cg) {
                f32x4 acc = {0.f, 0.f, 0.f, 0.f};
                u32x2 L0, H0, L1, H1, L2, H2;
#define MX_AD(cb_) (vbase + ((((cb_) >> 1) ^ r) * 16) + ((cb_) & 1) * 8)
#define MX_RD(Ln_, Hn_, cb_) asm volatile("ds_read_b64_tr_b4 %0, %2\n\tds_read_b64_tr_b4 %1, %2 offset:4096" : "=&v"(Ln_), "=&v"(Hn_) : "v"(MX_AD(cb_)) : "memory")
#define MX_RDW(Ln_, Hn_, Lc_, Hc_, cb_) asm volatile("ds_read_b64_tr_b4 %0, %4\n\tds_read_b64_tr_b4 %1, %4 offset:4096\n\ts_waitcnt lgkmcnt(4)" : "=&v"(Ln_), "=&v"(Hn_), "+v"(Lc_), "+v"(Hc_) : "v"(MX_AD(cb_)) : "memory")
#define MX_W(n_, Lc_, Hc_) asm volatile("s_waitcnt lgkmcnt(" #n_ ")" : "+v"(Lc_), "+v"(Hc_) :: "memory")
#define MX_MM(cb16_, Lc_, Hc_) do { const i32x8 A8 = {(int)Lc_.x, (int)Lc_.y, (int)Hc_.x, (int)Hc_.y, 0, 0, 0, 0}; \
                      \
                    acc = __builtin_amdgcn_mfma_scale_f32_16x16x128_f8f6f4(A8, MX8(wB1), acc, 4, 4, 0, 0x7F7F7F7F, (cb16_) & 3, sm1[(cb16_) >> 2]); \
                    acc = __builtin_amdgcn_mfma_scale_f32_16x16x128_f8f6f4(A8, MX8(wB2), acc, 4, 4, 0, 0x7F7F7F7F, (cb16_) & 3, sm2[(cb16_) >> 2]); } while (0)
                MX_RD(L0, H0, cg * 16); MX_RD(L1, H1, cg * 16 + 1);
                MX_RDW(L2, H2, L0, H0, cg * 16 + 2); MX_MM(0, L0, H0);   MX_RDW(L0, H0, L1, H1, cg * 16 + 3); MX_MM(1, L1, H1);   MX_RDW(L1, H1, L2, H2, cg * 16 + 4); MX_MM(2, L2, H2);
                MX_RDW(L2, H2, L0, H0, cg * 16 + 5); MX_MM(3, L0, H0);   MX_RDW(L0, H0, L1, H1, cg * 16 + 6); MX_MM(4, L1, H1);   MX_RDW(L1, H1, L2, H2, cg * 16 + 7); MX_MM(5, L2, H2);
                MX_RDW(L2, H2, L0, H0, cg * 16 + 8); MX_MM(6, L0, H0);   MX_RDW(L0, H0, L1, H1, cg * 16 + 9); MX_MM(7, L1, H1);   MX_RDW(L1, H1, L2, H2, cg * 16 + 10); MX_MM(8, L2, H2);
                MX_RDW(L2, H2, L0, H0, cg * 16 + 11); MX_MM(9, L0, H0);  MX_RDW(L0, H0, L1, H1, cg * 16 + 12); MX_MM(10, L1, H1); MX_RDW(L1, H1, L2, H2, cg * 16 + 13); MX_MM(11, L2, H2);
                MX_RDW(L2, H2, L0, H0, cg * 16 + 14); MX_MM(12, L0, H0); MX_RDW(L0, H0, L1, H1, cg * 16 + 15); MX_MM(13, L1, H1);
                MX_W(2, L2, H2); MX_MM(14, L2, H2); MX_W(0, L0, H0); MX_MM(15, L0, H0);
#undef MX_RD
#undef MX_RDW
#undef MX_W
#undef MX_MM
#undef MX_AD
                const int c0 = hf * 512 + cg * 256 + 16 * r + 4 * kq;
                f32x4 hv = *(const f32x4*)(wg + mx2::HR + 4 * c0);
#pragma unroll
                for (int i2 = 0; i2 < 4; ++i2) { hv[i2] += acc[i2] * wIS; ss += hv[i2] * hv[i2]; }
                *(f32x4*)(a.h + (size_t)t * 1024 + c0) = hv;
                u32x2 pk; pk.x = pack2(hv[0], hv[1]); pk.y = pack2(hv[2], hv[3]);
                *(u32x2*)(hb + (size_t)t * 1024 + c0) = pk;
            }
            asm volatile("" ::: "memory");
            cslot += 4; cslot = (cslot >= MXN) ? cslot - MXN : cslot;
#pragma unroll
            for (int i4 = 0; i4 < 4; ++i4) { const int ca = 8 + MXN + 4 * hf + i4; if (ca < 16) mx_dma(ca, e4[i4], lane, PU, PV, wl, islot); else if (more) mx_dma(ca - 16, e4[i4], lane, PU, PV, wl, islot); }
            if (more) { if (hf == 0) mx_dma_x(hb, t + tstride, lane, wl); else mx_dma_h(a.h, t + tstride, lane, wl); }
            asm volatile("" ::: "memory");
        }
        ss = wave_sum(ss);
        if (lane == 0) rstd[t] = rsqrtf(ss * (1.0f / 1024.0f) + 1e-6f);
    }
    asm volatile("s_waitcnt vmcnt(0) lgkmcnt(0)" ::: "memory");
    __builtin_amdgcn_s_setprio(0);
}
#endif

#ifndef PEER_NPW
#define PEER_NPW 2
#endif
DEV void ph_topk_peer(const Args& a, float* lds, const int tid0) {
    const int wv = __builtin_amdgcn_readfirstlane(tid0 >> 6);
    constexpr int TPW = T / NWG, MC = PEER_MC, NMC = TPW / MC, GPT = 8 / TOPK_NU;
    static_assert(TPW * NWG == T && NMC * MC == TPW, "token split");
#if PEER_MX == 2
    int* EL = (int*)(lds + 2048);
    float* RLb = (float*)(EL + 2 * MC * 128);
    int* CT = (int*)(RLb + 2 * MC);
    static_assert(8192 + 2 * MC * 128 * 4 + 2 * MC * 4 + 8 <= mx2::BASE && TOPK_NU == 4, "list area (the selection scratch is 8 KB with 4 heads per iteration)");
    if (tid0 == 0) { CT[0] = 0; CT[1] = 0; }
#else
    int* EL = (int*)(lds + 4096);
    float* GL = (float*)(EL + 2 * MC * 128);
#endif
    const int tok_wg = blockIdx.x * TPW;
    __syncthreads();
#pragma unroll 1
    for (int s = 0; s <= NMC; ++s) {
        const int tsel = tok_wg + s * MC, tgat = tok_wg + (s - 1) * MC;
        int* ELs = EL + (s & 1) * MC * 128; const int* ELg = EL + ((s - 1) & 1) * MC * 128;
#if PEER_MX == 2
        float* RLs = RLb + (s & 1) * MC; const float* RLg = RLb + ((s - 1) & 1) * MC;
        if (tid0 == NTHR - 1) CT[(s + 1) & 1] = 0;
        if (s == 0) {
            ph_topk2(a, lds, tid0, tsel * GPT, 8, (tsel + MC) * GPT, ELs, nullptr, tsel, RLs, CT + (s & 1));
        } else if (PEER_ISPW(wv)) {
            const int pw = PEER_PWI(wv);
            ph_peer_mx2(a, tid0, tgat + pw, PEER_NPW, (MC - pw + PEER_NPW - 1) / PEER_NPW, ELg, RLg, tgat,
                        (PG8_LAS unsigned char*)smem + mx2::BASE + pw * mx2::WL, (unsigned char*)lds + mx2::BASE + pw * mx2::WL);
#if TOPK_DYN
            if (s < NMC) ph_topk2(a, lds, tid0, tsel * GPT, 8, (tsel + MC) * GPT, ELs, nullptr, tsel, RLs, CT + (s & 1));
#endif
        } else if (s < NMC) {
            __builtin_amdgcn_s_setprio(TOPK_PRIO);
#if TOPK_DYN
#if TOPK_MIX
            if ((wv & 3) >= 2) ph_topk2<true>(a, lds, tid0, tsel * GPT, 8 - PEER_NPW, (tsel + MC) * GPT, ELs, nullptr, tsel, RLs, CT + (s & 1));
            else
#endif
            ph_topk2(a, lds, tid0, tsel * GPT, 8 - PEER_NPW, (tsel + MC) * GPT, ELs, nullptr, tsel, RLs, CT + (s & 1));
#else
            for (int rep_ = 0; rep_ < REP_TOPK; ++rep_)
            ph_topk2(a, lds, tid0, tsel * GPT + (wv - PEER_NPW), 8 - PEER_NPW, (tsel + MC) * GPT, ELs, nullptr, tsel, RLs);
#endif
        }
#else
        float* GLs = GL + (s & 1) * MC * 128; const float* GLg = GL + ((s - 1) & 1) * MC * 128;
        if (s == 0) {
            ph_topk2(a, lds, tid0, tsel * GPT + wv, 8, (tsel + MC) * GPT, ELs, GLs, tsel);
#if PEER_MX
        } else if (wv < PEER_NPW) {
            ph_peer_mx(a, tid0, tgat + wv, PEER_NPW, (MC - wv + PEER_NPW - 1) / PEER_NPW, ELg, GLg, tgat,
                       (PG8_LAS unsigned char*)smem + mx::BASE + wv * mx::WL, (unsigned char*)lds + mx::BASE + wv * mx::WL);
        } else if (s == NMC) {
#else
        } else if (s == NMC) {
            PEER_PIPE(a, tid0, tgat + wv, 8, (MC - wv + 7) / 8, ELg, GLg, tgat);
        } else if (wv < PEER_NPW) {
            PEER_PIPE(a, tid0, tgat + wv, PEER_NPW, (MC - wv + PEER_NPW - 1) / PEER_NPW, ELg, GLg, tgat);
#endif
        } else {
            ph_topk2(a, lds, tid0, tsel * GPT + (wv - PEER_NPW), 8 - PEER_NPW, (tsel + MC) * GPT, ELs, GLs, tsel);
        }
#endif
        __syncthreads();
    }
}

typedef float f32x4v __attribute__((ext_vector_type(4)));
#define MFMA16(a, b, c) __builtin_amdgcn_mfma_f32_16x16x32_bf16((a), (b), (c), 0, 0, 0)
namespace sc4 {
constexpr int E_AH = 0, E_RH = 2304, E_BH = 4608, E_KH = 6912, E_BHT = 9216, E_KHT = 12288, E_VT = 15360, E_GC = 18432, E_BYTES = 18688;
constexpr int G_NKAT = 0, G_NBRT = 768, G_NKRT = 1536, G_BYTES = 2304;
constexpr int OFF_E = 0, OFF_G = 6 * E_BYTES, OFF_NBAT = OFF_G + 4 * G_BYTES, OFF_TT = OFF_NBAT + 4 * 1024, OFF_Y = OFF_TT + 4 * 768, TOTAL = OFF_Y + 16384;
}
DEV bf16x8 frag2(u32x2 lo, u32x2 hi) { u32x4 v; v.x = lo.x; v.y = lo.y; v.z = hi.x; v.w = hi.y; return __builtin_bit_cast(bf16x8, v); }
DEV bf16x8 pack_acc(f32x4v p, f32x4v q) { u32x4 v; v.x = pack2(p[0], p[1]); v.y = pack2(p[2], p[3]); v.z = pack2(q[0], q[1]); v.w = pack2(q[2], q[3]); return __builtin_bit_cast(bf16x8, v); }
DEV void ph_scan4(const Args& a, int layer, unsigned char* lb, const int tid0) {
    using namespace sc4;
    static_assert(TOTAL <= LDS_BYTES - 16, "scan LDS map");
    const int lane = tid0 & 63, wv = __builtin_amdgcn_readfirstlane(tid0 >> 6);
    const int r = lane & 15, g = lane >> 4;
    const bf16_t* U = wsb(a, U_OFF); const bf16_t* RS = wsb(a, RS_OFF); const bf16_t* KS = wsb(a, KS_OFF); bf16_t* Uw = wsb(a, U_OFF);
    const bool is_state = wv < 4;
    const int dir = is_state ? (wv >> 1) : ((wv - 4) >> 1), role = wv & 1;
    const bf16_t* Wd = wsb(a, dir ? WB2_OFF : WF_OFF); const bf16_t* Ad = wsb(a, dir ? AB_OFF : AF_OFF);
    const u32x2 z2 = {0u, 0u}; const u32x4 z4 = {0u, 0u, 0u, 0u};
    for (int un = blockIdx.x; un < NSEQ * 8; un += gridDim.x) {
        const int seq = un >> 3, hd = un & 7; const size_t tb = (size_t)seq * 4096; const int cb = hd * 64, pch = cb + lane;
        const float kac = a.rwkv_k_a[layer * 512 + pch];
        __syncthreads();
        if (is_state) {
            f32x4v X[4][2];
#pragma unroll
            for (int m = 0; m < 4; ++m)
#pragma unroll
                for (int vt = 0; vt < 2; ++vt) X[m][vt] = (f32x4v){0.f, 0.f, 0.f, 0.f};
#pragma unroll 1
            for (int p = 0; p < 260; ++p) {
                if (p >= 2 && p < 258) {
                    const int n = p - 2;
                    const unsigned char* E = lb + OFF_E + (dir * 3 + (n % 3)) * E_BYTES;
                    const unsigned char* G = lb + OFF_G + (dir * 2 + (n & 1)) * G_BYTES;
                    float* yb = (float*)(lb + OFF_Y) + (((n & 1) * 2 + dir) * 16) * 64 + 32 * role;
                    bf16x8 fa[2], fr[2];
#pragma unroll
                    for (int s = 0; s < 2; ++s) {
                        fa[s] = frag2(*(const u32x2*)(E + E_AH + r * 144 + 2 * (32 * s + 4 * g)), *(const u32x2*)(E + E_AH + r * 144 + 2 * (32 * s + 16 + 4 * g)));
                        fr[s] = frag2(*(const u32x2*)(E + E_RH + r * 144 + 2 * (32 * s + 4 * g)), *(const u32x2*)(E + E_RH + r * 144 + 2 * (32 * s + 16 + 4 * g)));
                    }
                    const int g1 = g & 1;
                    u32x4 nka = *(const u32x4*)(G + G_NKAT + r * 48 + 16 * g1), nkr = *(const u32x4*)(G + G_NKRT + r * 48 + 16 * g1);
                    if (g >= 2) { nka = z4; nkr = z4; }
                    const bf16x8 fnka = __builtin_bit_cast(bf16x8, nka), fnkr = __builtin_bit_cast(bf16x8, nkr);
                    bf16x8 ftt;
                    {
                        const float* nbat = (const float*)(lb + OFF_NBAT + (dir * 2 + (n & 1)) * 1024);
                        unsigned char* tts = lb + OFF_TT + wv * 768;
                        float Tr[16];
#pragma unroll
                        for (int tg = 0; tg < 4; ++tg) {
                            f32x4v nbq[4][4];
#pragma unroll
                            for (int tt = 0; tt < 4; ++tt)
#pragma unroll
                                for (int i4 = 0; i4 < 4; ++i4) if (4 * i4 < 4 * tg + tt) nbq[tt][i4] = *(const f32x4v*)(nbat + (4 * tg + tt) * 16 + 4 * i4);
#pragma unroll
                            for (int tt = 0; tt < 4; ++tt) {
                                const int t = 4 * tg + tt;
                                float acc = (lane == t) ? 1.0f : 0.f, acc2 = 0.f;
#pragma unroll
                                for (int i = 0; i < t; ++i) { const float pr_ = Tr[i] * nbq[tt][i >> 2][i & 3]; if (i & 1) acc2 += pr_; else acc += pr_; }
                                acc += acc2; Tr[t] = acc;
                                if (lane < 16) *(unsigned short*)(tts + t * 48 + 2 * lane) = (unsigned short)f2bf(acc);
                            }
                        }
                        asm volatile("s_waitcnt lgkmcnt(0)" ::: "memory");
                        ftt = frag2(*(const u32x2*)(tts + r * 48 + 8 * g), z2);
                    }
                    const bf16x8 fnbr = frag2(*(const u32x2*)(G + G_NBRT + r * 48 + 8 * g), z2);
                    bf16x8 fbt[4], fkt[4]; f32x4v gc[4];
#pragma unroll
                    for (int m = 0; m < 4; ++m) {
                        fbt[m] = frag2(*(const u32x2*)(E + E_BHT + (16 * m + r) * 48 + 8 * g), z2);
                        u32x4 kt = *(const u32x4*)(E + E_KHT + (16 * m + r) * 48 + 16 * g1); if (g >= 2) kt = z4; fkt[m] = __builtin_bit_cast(bf16x8, kt);
                        gc[m] = *(const f32x4v*)(E + E_GC + 4 * (16 * m + 4 * g));
                    }
#pragma unroll
                    for (int vt = 0; vt < 2; ++vt) {
                        const int v0 = 32 * role + 16 * vt;
                        u32x4 vv = *(const u32x4*)(E + E_VT + (v0 + r) * 48 + 16 * g1); if (g >= 2) vv = z4;
                        const bf16x8 vb = __builtin_bit_cast(bf16x8, vv);
                        const bf16x8 xb0 = pack_acc(X[0][vt], X[1][vt]), xb1 = pack_acc(X[2][vt], X[3][vt]);
                        f32x4v W = {0.f, 0.f, 0.f, 0.f};
                        W = MFMA16(fa[0], xb0, W); W = MFMA16(fa[1], xb1, W); W = MFMA16(fnka, vb, W);
                        const f32x4v zero4 = {0.f, 0.f, 0.f, 0.f};
                        f32x4v Uc = MFMA16(ftt, pack_acc(W, zero4), zero4);
                        const bf16x8 ub = pack_acc(Uc, zero4);
                        f32x4v Y = {0.f, 0.f, 0.f, 0.f};
                        Y = MFMA16(fr[0], xb0, Y); Y = MFMA16(fr[1], xb1, Y); Y = MFMA16(fnbr, ub, Y); Y = MFMA16(fnkr, vb, Y);
#pragma unroll
                        for (int i = 0; i < 4; ++i) yb[(4 * g + i) * 64 + 16 * vt + r] = Y[i];
#pragma unroll
                        for (int m = 0; m < 4; ++m) { f32x4v xm = MFMA16(fbt[m], ub, X[m][vt]); xm = MFMA16(fkt[m], vb, xm); X[m][vt] = xm * gc[m]; }
                    }
                }
                __syncthreads();
            }
        } else {
            unsigned short prA[8][6], pwA[8], prB[8][6], pwB[8];
#define SC5_ISSUE(pr, pw, n_) do { _Pragma("unroll") for (int s_ = 0; s_ < 8; ++s_) { const int step_ = (n_) * 16 + 8 * role + s_, pos_ = dir ? 4095 - step_ : step_; const size_t t_ = tb + pos_; \
            pr[s_][0] = Wd[t_ * 512 + pch]; pr[s_][1] = U[t_ * UW + pch]; pr[s_][2] = Ad[t_ * 512 + pch]; pr[s_][3] = KS[t_ * 512 + pch]; pr[s_][4] = RS[t_ * 512 + pch]; pr[s_][5] = U[t_ * UW + 1536 + pch]; \
            if (role) { const int st0_ = (n_) * 16 + s_, p0_ = dir ? 4095 - st0_ : st0_; pw[s_] = Wd[(tb + p0_) * 512 + pch]; } } } while (0)
            SC5_ISSUE(prA, pwA, 0); SC5_ISSUE(prB, pwB, 1);
#define SC5_PERIOD(pr, pw, p_) do { const int p = (p_); \
                if (p < 256) { \
                    unsigned char* E = lb + OFF_E + (dir * 3 + (p % 3)) * E_BYTES; \
                    float gcur = 1.0f; \
                    if (role) { \
_Pragma("unroll") \
                        for (int s = 0; s < 8; ++s) gcur *= bf2f(pw[s]); \
                    } \
                    unsigned bt[4], kt[4], vtw[4]; \
_Pragma("unroll") \
                    for (int s = 0; s < 8; ++s) { \
                        const int st = 8 * role + s; \
                        const float w_ = bf2f(pr[s][0]), kk_ = bf2f(pr[s][1]), ic_ = bf2f(pr[s][2]), ks_ = bf2f(pr[s][3]), r_ = bf2f(pr[s][4]); \
                        const float gprev = gcur; gcur *= w_; \
                        const float ig = __builtin_amdgcn_rcpf(gcur); \
                        const unsigned ah = f2bf(-gprev * kk_), bh = f2bf(kk_ * ic_ * ig), kh = f2bf(ks_ * (1.0f + (ic_ - 1.0f) * kac) * ig), rh = f2bf(gcur * r_), vh = pr[s][5]; \
                        *(unsigned short*)(E + E_AH + st * 144 + 2 * lane) = (unsigned short)ah; *(unsigned short*)(E + E_RH + st * 144 + 2 * lane) = (unsigned short)rh; \
                        *(unsigned short*)(E + E_BH + st * 144 + 2 * lane) = (unsigned short)bh; *(unsigned short*)(E + E_KH + st * 144 + 2 * lane) = (unsigned short)kh; \
                        if (s & 1) { bt[s >> 1] |= bh << 16; kt[s >> 1] |= kh << 16; vtw[s >> 1] |= vh << 16; } else { bt[s >> 1] = bh; kt[s >> 1] = kh; vtw[s >> 1] = vh; } \
                    } \
                    *(u32x4*)(E + E_BHT + lane * 48 + 16 * role) = (u32x4){bt[0], bt[1], bt[2], bt[3]}; \
                    *(u32x4*)(E + E_KHT + lane * 48 + 16 * role) = (u32x4){kt[0], kt[1], kt[2], kt[3]}; \
                    *(u32x4*)(E + E_VT + lane * 48 + 16 * role) = (u32x4){vtw[0], vtw[1], vtw[2], vtw[3]}; \
                    if (role) *(float*)(E + E_GC + 4 * lane) = gcur; \
                } \
                if (role == 0) { \
                    if (p >= 1 && p < 257) { \
                        const int n = p - 1; \
                        const unsigned char* E = lb + OFF_E + (dir * 3 + (n % 3)) * E_BYTES; \
                        unsigned char* G = lb + OFF_G + (dir * 2 + (n & 1)) * G_BYTES; \
                        float* nbat = (float*)(lb + OFF_NBAT + (dir * 2 + (n & 1)) * 1024); \
                        bf16x8 ab[2], rb[2], bA[2], kA[2]; \
_Pragma("unroll") \
                        for (int s = 0; s < 2; ++s) { \
                            ab[s] = *(const bf16x8*)(E + E_AH + r * 144 + 2 * (32 * s + 8 * g)); rb[s] = *(const bf16x8*)(E + E_RH + r * 144 + 2 * (32 * s + 8 * g)); \
                            bA[s] = *(const bf16x8*)(E + E_BH + r * 144 + 2 * (32 * s + 8 * g)); kA[s] = *(const bf16x8*)(E + E_KH + r * 144 + 2 * (32 * s + 8 * g)); \
                        } \
                        const f32x4v zero4 = {0.f, 0.f, 0.f, 0.f}; \
                        f32x4v nba = MFMA16(bA[1], ab[1], MFMA16(bA[0], ab[0], zero4)), nka = MFMA16(kA[1], ab[1], MFMA16(kA[0], ab[0], zero4)); \
                        f32x4v nbr = MFMA16(bA[1], rb[1], MFMA16(bA[0], rb[0], zero4)), nkr = MFMA16(kA[1], rb[1], MFMA16(kA[0], rb[0], zero4)); \
_Pragma("unroll") \
                        for (int i = 0; i < 4; ++i) { const int j = 4 * g + i; if (j >= r) { nba[i] = 0.f; nka[i] = 0.f; } if (j > r) { nbr[i] = 0.f; nkr[i] = 0.f; } } \
                        *(f32x4v*)(nbat + r * 16 + 4 * g) = nba; \
                        u32x2 pk; pk.x = pack2(nka[0], nka[1]); pk.y = pack2(nka[2], nka[3]); *(u32x2*)(G + G_NKAT + r * 48 + 8 * g) = pk; \
                        pk.x = pack2(nbr[0], nbr[1]); pk.y = pack2(nbr[2], nbr[3]); *(u32x2*)(G + G_NBRT + r * 48 + 8 * g) = pk; \
                        pk.x = pack2(nkr[0], nkr[1]); pk.y = pack2(nkr[2], nkr[3]); *(u32x2*)(G + G_NKRT + r * 48 + 8 * g) = pk; \
                    } \
                } else { \
                    if (p >= 3 && p < 259) { \
                        const int n = p - 3; \
                        const float* yb = (const float*)(lb + OFF_Y) + (((n & 1) * 2 + dir) * 16) * 64; \
                        const int s2 = lane >> 2, c16 = (lane & 3) * 16; \
                        const f32x4v y0 = *(const f32x4v*)(yb + s2 * 64 + c16), y1 = *(const f32x4v*)(yb + s2 * 64 + c16 + 4), y2 = *(const f32x4v*)(yb + s2 * 64 + c16 + 8), y3 = *(const f32x4v*)(yb + s2 * 64 + c16 + 12); \
                        const int step = n * 16 + s2, pos = dir ? 4095 - step : step; \
                        u32x4 o0, o1; o0.x = pack2(y0[0], y0[1]); o0.y = pack2(y0[2], y0[3]); o0.z = pack2(y1[0], y1[1]); o0.w = pack2(y1[2], y1[3]); \
                        o1.x = pack2(y2[0], y2[1]); o1.y = pack2(y2[2], y2[3]); o1.z = pack2(y3[0], y3[1]); o1.w = pack2(y3[2], y3[3]); \
                        bf16_t* dst = Uw + (tb + pos) * UW + 512 + 512 * dir + cb + c16; \
                        *(u32x4*)(dst) = o0; *(u32x4*)(dst + 8) = o1; \
                    } \
                } \
                if (p + 2 < 256) SC5_ISSUE(pr, pw, p + 2); \
                __syncthreads(); \
            } while (0)
#pragma unroll 1
            for (int p2 = 0; p2 < 260; p2 += 2) { SC5_PERIOD(prA, pwA, p2); SC5_PERIOD(prB, pwB, p2 + 1); }
#undef SC5_PERIOD
#undef SC5_ISSUE
        }
    }
}

extern __shared__ __attribute__((aligned(16))) unsigned char smem[];

enum { PH_PROLOGUE = 0, PH_ROWPREP_X, PH_GEMM1, PH_ATTN, PH_LORA, PH_PREP2, PH_SCAN, PH_POST, PH_GEMM2, PH_CONVERT, PH_GEMM3, PH_TOPK, PH_PEER, PH_PEERDRY, PH_TOPKPEER, PH_GEMM4A, PH_GEMM4B, PH_FINAL };

template <int PH> DEV void run_phase(const Args& a, int layer, const int tid0) {
    float* ldsf = (float*)smem;
    PG8_LAS unsigned char* ldsg = (PG8_LAS unsigned char*)smem;
    const bf16_t* wb = wsb(a, WB_OFF + (size_t)layer * WB_LAYER);
    if constexpr (PH == PH_PROLOGUE) ph_prologue(a, ldsf, tid0);
    else if constexpr (PH == PH_ROWPREP_X) ph_rowprep(a, true, tid0);
    else if constexpr (PH == PH_GEMM1) {
        pg8::Gemm g{wsb(a, HB_OFF), wb + WB_IN / 2, T, INP, 1024};
        pg8::StaticOrder S; S.init(T, INP, gridDim.x, blockIdx.x);
        pg8::EpiProj E{wsb(a, QKV_OFF), wsb(a, U_OFF), wsf(a, SSQ_OFF), wsf(a, ROPEC_OFF), wsf(a, ROPES_OFF)};
        pg8::gemm_phase<pg8::EpiProj, pg8::StaticOrder, false>(ldsg, g, S, E, nullptr, tid0);
    }
    else if constexpr (PH == PH_ATTN) ph_attn3(a, layer, smem, tid0);
    else if constexpr (PH == PH_LORA) ph_rwkv_prep1(a, layer, smem, tid0);
    else if constexpr (PH == PH_PREP2) ph_rwkv_prep2(a, layer, tid0);
    else if constexpr (PH == PH_SCAN) ph_scan4(a, layer, smem, tid0);
    else if constexpr (PH == PH_POST) ph_post2(a, layer, tid0);
    else if constexpr (PH == PH_GEMM2) {
        pg8::Gemm g{wsb(a, MIX_OFF), wb + WB_OUT / 2, T, 1024, 1024};
        pg8::StaticOrder S; S.init(T, 1024, gridDim.x, blockIdx.x);
        pg8::EpiF32x<1> E{a.h, 1024, nullptr, wsb(a, HB_OFF), wsf(a, SSQ_OFF)};
        pg8::gemm_phase<pg8::EpiF32x<1>, pg8::StaticOrder, false>(ldsg, g, S, E, nullptr, tid0);
    }
    else if constexpr (PH == PH_CONVERT) ph_convert8(a, layer, tid0);
    else if constexpr (PH == PH_GEMM3) {
        pg8::Gemm g{wsb(a, HB_OFF), wb + WB_QK / 2, T, 2048, 1024};
        pg8::StaticOrder S; S.init(T, 2048, gridDim.x, blockIdx.x);
        pg8::EpiF32x<0> E{wsf(a, SC_OFF), 2048, nullptr, nullptr, nullptr};
        pg8::gemm_phase<pg8::EpiF32x<0>, pg8::StaticOrder, false>(ldsg, g, S, E, nullptr, tid0);
    }
    else if constexpr (PH == PH_TOPK) ph_topk2(a, ldsf, tid0, blockIdx.x * 8 + (tid0 >> 6), gridDim.x * 8, T * (8 / TOPK_NU), (int*)(a.ws + TOPI_OFF), wsf(a, TOPG_OFF), 0);
    else if constexpr (PH == PH_TOPKPEER) ph_topk_peer(a, ldsf, tid0);
    else if constexpr (PH == PH_PEER) ph_peer_pipe<false>(a, tid0, blockIdx.x * 8 + (tid0 >> 6), gridDim.x * 8, T / (gridDim.x * 8), (const int*)(a.ws + TOPI_OFF), wsf(a, TOPG_OFF), 0);
    else if constexpr (PH == PH_PEERDRY) ph_peer_pipe<true>(a, tid0, blockIdx.x * 8 + (tid0 >> 6), gridDim.x * 8, T / (gridDim.x * 8), (const int*)(a.ws + TOPI_OFF), wsf(a, TOPG_OFF), 0);
    else if constexpr (PH == PH_GEMM4A) {
        pg8::Gemm g{wsb(a, HB_OFF), wb + WB_GATE / 2, T, 1024, 1024};
        pg8::StaticOrder S; S.init(T, 1024, gridDim.x, blockIdx.x);
        pg8::EpiGate E{wsb(a, GATE_OFF), wsf(a, RSTD_OFF), a.ple_b_gate + layer * 1024};
        pg8::gemm_phase<pg8::EpiGate, pg8::StaticOrder, false>(ldsg, g, S, E, nullptr, tid0);
    }
    else if constexpr (PH == PH_GEMM4B) {
        pg8::Gemm g{wsb(a, PB_OFF), wb + WB_PROJ / 2, T, 1024, 256};
        pg8::StaticOrder S; S.init(T, 1024, gridDim.x, blockIdx.x);
        pg8::EpiF32x<2> E{a.h, 1024, wsb(a, GATE_OFF), wsb(a, HB_OFF), wsf(a, SSQ_OFF)};
        pg8::gemm_phase<pg8::EpiF32x<2>, pg8::StaticOrder, false>(ldsg, g, S, E, nullptr, tid0);
    }
    else if constexpr (PH == PH_FINAL) ph_final(a, tid0);
}

#if !ONE_LAUNCH
template <int PH> __global__ void __launch_bounds__(NTHR, 2) k_phase(Args a, int layer) { run_phase<PH>(a, layer, (int)threadIdx.x); }
#endif

#if ONE_LAUNCH
#ifndef REP_PEER
#define REP_PEER 1
#endif
#ifndef REP_SCAN
#define REP_SCAN 1
#endif
#ifndef REP_TOPK
#define REP_TOPK 1
#endif
#ifndef REP_GEMM1
#define REP_GEMM1 1
#endif
#ifndef REP_LORA
#define REP_LORA 1
#endif
#ifndef REP_POST
#define REP_POST 1
#endif
#ifndef REP_ATTN
#define REP_ATTN 1
#endif
#ifndef REP_GEMM3
#define REP_GEMM3 1
#endif
typedef const __attribute__((address_space(4))) unsigned long long* kargs_t;
static_assert(sizeof(Args) == 31 * 8, "Args is 31 pointers, no padding");
#define AS1 __attribute__((address_space(1)))
DEV Args load_args(kargs_t kp) {
    Args r; const float** d = (const float**)&r;
#pragma unroll
    for (int i = 0; i < 29; ++i) d[i] = (const float*)(AS1 const float*)kp[i];
    r.h = (float*)(AS1 float*)kp[29]; r.ws = (unsigned char*)(AS1 unsigned char*)kp[30];
    return r; }
#define RUN(PH, layer) do { kargs_t kp_ = (kargs_t)__builtin_amdgcn_kernarg_segment_ptr(); asm volatile("" : "+s"(kp_)); const Args la_ = load_args(kp_); int t_; asm volatile("v_mbcnt_lo_u32_b32 %0, -1, 0\n\tv_mbcnt_hi_u32_b32 %0, -1, %0\n\tv_lshl_add_u32 %0, %1, 6, %0" : "=&v"(t_) : "s"(wv0_)); run_phase<PH>(la_, layer, t_); } while (0)
#define BAR() do { kargs_t kp_ = (kargs_t)__builtin_amdgcn_kernarg_segment_ptr(); asm volatile("" : "+s"(kp_)); XcdBarrier b_; b_.bar = (unsigned*)((unsigned char*)kp_[30] + BAR_OFF); b_.x = xb_xcc_id(); b_.st = (volatile LAS unsigned*)(smem + LDS_BYTES - 16); int t_; asm volatile("v_mbcnt_lo_u32_b32 %0, -1, 0\n\tv_mbcnt_hi_u32_b32 %0, -1, %0\n\tv_lshl_add_u32 %0, %1, 6, %0" : "=&v"(t_) : "s"(wv0_)); xcd_barrier(b_, t_); } while (0)
#define LAYER_BODY(layer) do { \
        for (int rep_ = 0; rep_ < REP_GEMM1; ++rep_) { RUN(PH_GEMM1, layer); BAR(); } \
        for (int rep_ = 0; rep_ < REP_ATTN; ++rep_) { RUN(PH_ATTN, layer); BAR(); } \
        for (int rep_ = 0; rep_ < REP_LORA; ++rep_) { RUN(PH_LORA, layer); BAR(); } \
        for (int rep_ = 0; rep_ < REP_PREP2; ++rep_) { RUN(PH_PREP2, layer); BAR(); } \
        for (int rep_ = 0; rep_ < REP_SCAN; ++rep_) { RUN(PH_SCAN, layer); BAR(); } \
        for (int rep_ = 0; rep_ < REP_POST; ++rep_) { RUN(PH_POST, layer); BAR(); } \
        RUN(PH_GEMM2, layer); RUN(PH_CONVERT, layer); BAR(); \
        for (int rep_ = 0; rep_ < REP_GEMM3; ++rep_) { RUN(PH_GEMM3, layer); BAR(); } \
        RUN(PH_TOPKPEER, layer); BAR(); \
        for (int rep_ = 0; rep_ < REP_GEMM4A; ++rep_) { RUN(PH_GEMM4A, layer); BAR(); } \
        RUN(PH_GEMM4B, layer); BAR(); \
    } while (0)
__global__ void __launch_bounds__(NTHR, 2) k_mega(Args a) {
    if (threadIdx.x == 0) *(uint4*)(smem + LDS_BYTES - 16) = make_uint4(0u, 0u, 0u, 0u);
    __syncthreads();
    (void)xcd_barrier_post((unsigned*)(a.ws + BAR_OFF), (volatile LAS unsigned*)(smem + LDS_BYTES - 16));
    const int wv0_ = __builtin_amdgcn_readfirstlane((int)threadIdx.x >> 6);
    RUN(PH_PROLOGUE, 0);
    RUN(PH_ROWPREP_X, 0); BAR();
    LAYER_BODY(0); LAYER_BODY(1); LAYER_BODY(2); LAYER_BODY(3);
    RUN(PH_FINAL, 0);
}
#endif

#if !ONE_LAUNCH
template <int PH> static void launch_phase(const Args& a, int layer, hipStream_t st) {
    static bool attr = false;
    if (!attr) { (void)hipFuncSetAttribute((const void*)k_phase<PH>, hipFuncAttributeMaxDynamicSharedMemorySize, LDS_BYTES); attr = true; }
    hipLaunchKernelGGL(k_phase<PH>, dim3(NWG), dim3(NTHR), LDS_BYTES, st, a, layer);
}
#endif

extern "C" void kernel_launch(void* const* d_in, const int* in_sizes, int n_in, void* d_out, int out_size, void* d_ws, size_t ws_size, hipStream_t stream) {
    if (n_in != 29 || out_size != T * D || ws_size < WS_END) {
        fprintf(stderr, "kernel_launch: unexpected shapes (n_in %d, out %d, ws %zu, need %zu); nothing launched\n", n_in, out_size, ws_size, (size_t)WS_END);
        return;
    }
    Args a{};
    const float** ap = (const float**)&a;
    for (int i = 0; i < 29; ++i) ap[i] = (const float*)d_in[i];
    a.h = (float*)d_out; a.ws = (unsigned char*)d_ws;
#if ONE_LAUNCH
    static bool attr = false;
    if (!attr) { (void)hipFuncSetAttribute((const void*)k_mega, hipFuncAttributeMaxDynamicSharedMemorySize, LDS_BYTES); attr = true; }
    (void)hipMemsetAsync((char*)d_ws + BAR_OFF, 0, XCD_BAR_WORDS * sizeof(unsigned), stream);
    hipLaunchKernelGGL(k_mega, dim3(NWG), dim3(NTHR), LDS_BYTES, stream, a);
#else
    launch_phase<PH_PROLOGUE>(a, 0, stream);
    launch_phase<PH_ROWPREP_X>(a, 0, stream);
    for (int layer = 0; layer < NL; ++layer) {
        launch_phase<PH_GEMM1>(a, layer, stream);
        launch_phase<PH_ATTN>(a, layer, stream);
        launch_phase<PH_LORA>(a, layer, stream);
        launch_phase<PH_PREP2>(a, layer, stream);
        launch_phase<PH_SCAN>(a, layer, stream);
        launch_phase<PH_POST>(a, layer, stream);
        launch_phase<PH_GEMM2>(a, layer, stream);
        launch_phase<PH_CONVERT>(a, layer, stream);
        launch_phase<PH_GEMM3>(a, layer, stream);
        launch_phase<PH_TOPK>(a, layer, stream);
        launch_phase<PH_PEER>(a, layer, stream);
        launch_phase<PH_GEMM4A>(a, layer, stream);
        launch_phase<PH_GEMM4B>(a, layer, stream);
    }
    launch_phase<PH_FINAL>(a, 0, stream);
#endif
}
```

```cpp
#include <hip/hip_runtime.h>
#include <stdint.h>
#include <stdio.h>

#ifndef ONE_LAUNCH
#define ONE_LAUNCH 1
#endif

#ifndef REP_PREP2
#define REP_PREP2 1
#endif
#ifndef REP_CONVERT
#define REP_CONVERT 1
#endif
#ifndef REP_GEMM4A
#define REP_GEMM4A 1
#endif
#ifndef REP_ATTNX
#define REP_ATTNX 0
#endif
#ifndef REP_MERGE
#define REP_MERGE 0
#endif
#ifndef FP4_EMU
#define FP4_EMU 0
#endif
#ifndef PEER_FP4
#define PEER_FP4 1
#endif
#define PEER_USC 64.0f
#define PEER_VSC 10.0f
#ifndef PEER_MX
#define PEER_MX 2
#endif
#ifndef PEER_MXU
#define PEER_MXU 1
#endif
#ifndef PEER_MXV
#define PEER_MXV 1
#endif
#ifndef PEER_XF4
#define PEER_XF4 0
#endif
#ifndef REP_TOPK
#define REP_TOPK 1
#endif
#ifndef PEER_PRIO
#define PEER_PRIO 0
#endif
#ifndef MX_HWS
#define MX_HWS 1
#endif
#ifndef PEER_MC
#define PEER_MC 10
#endif
#ifndef TOPK_DYN
#define TOPK_DYN 1
#endif
#ifndef TOPK_MIX
#define TOPK_MIX 0
#endif
#ifndef TOPK_PRIO
#define TOPK_PRIO 0
#endif
#ifndef PEER_SAMESIMD
#define PEER_SAMESIMD 0
#endif
#if PEER_SAMESIMD
#define PEER_ISPW(wv_) (((wv_) & 3) == 0)
#define PEER_PWI(wv_) ((wv_) >> 2)
#else
#define PEER_ISPW(wv_) ((wv_) < PEER_NPW)
#define PEER_PWI(wv_) (wv_)
#endif
#ifndef PEER_MX3
#define PEER_MX3 0
#endif
#ifndef LOCAL_SEAM
#define LOCAL_SEAM 1
#endif
#ifndef NT_HINTS
#define NT_HINTS 1
#endif
#ifndef ATTN_VAR
#define ATTN_VAR 0
#endif

typedef unsigned short bf16_t;
typedef float f32x4 __attribute__((ext_vector_type(4)));
typedef float f32x2 __attribute__((ext_vector_type(2)));
typedef unsigned u32x4 __attribute__((ext_vector_type(4)));
typedef unsigned u32x2 __attribute__((ext_vector_type(2)));
typedef __bf16 bf16x2_t __attribute__((ext_vector_type(2)));

#define DEV __device__ __forceinline__

namespace cfg {
constexpr int NSEQ = 20, SEQ = 4096, T = NSEQ * SEQ, TP = 4 * SEQ, D = 1024, NL = 4;
constexpr int INC = 3456, INP = 3584;
constexpr int QKVW = 1536, UW = 2048, UC = 1920;
constexpr int NWG = 256, NTHR = 512;
constexpr int LDS_BYTES = 163840;
constexpr size_t MiB = 1ull << 20;
constexpr size_t WB_OFF = 0;
constexpr size_t WB_LAYER = 16 * MiB;
constexpr size_t WB_IN = 0, WB_OUT = 7 * MiB, WB_QK = 9 * MiB, WB_GATE = 13 * MiB, WB_PROJ = 15 * MiB, WB_LORA = 15 * MiB + 512 * 1024;
constexpr size_t HB_OFF = 64 * MiB;
constexpr size_t MIX_OFF = 224 * MiB;
constexpr size_t SMALL_OFF = 384 * MiB;
constexpr size_t RSTD_OFF = SMALL_OFF;
constexpr size_t ROPEC_OFF = SMALL_OFF + 512 * 1024, ROPES_OFF = SMALL_OFF + 640 * 1024;
constexpr size_t BAR_OFF = SMALL_OFF + 1 * MiB;
constexpr size_t BIG_OFF = 386 * MiB;
constexpr size_t QKV_OFF = BIG_OFF;
constexpr size_t RS_OFF = BIG_OFF, KS_OFF = BIG_OFF + 80 * MiB, G_OFF = BIG_OFF + 160 * MiB;
constexpr size_t U_OFF = BIG_OFF + 240 * MiB;
constexpr size_t WF_OFF = BIG_OFF + 560 * MiB, WB2_OFF = BIG_OFF + 640 * MiB, AF_OFF = BIG_OFF + 720 * MiB, AB_OFF = BIG_OFF + 800 * MiB;
constexpr size_t OP_OFF = BIG_OFF + 560 * MiB;
constexpr size_t ML_OFF = BIG_OFF + 800 * MiB;
constexpr size_t SC_OFF = BIG_OFF;
constexpr size_t TOPI_OFF = BIG_OFF + 640 * MiB, TOPG_OFF = BIG_OFF + 680 * MiB;
constexpr size_t PTU_OFF = BIG_OFF + 720 * MiB, PTV_OFF = BIG_OFF + 752 * MiB;
constexpr size_t PB_OFF = BIG_OFF + 784 * MiB;
constexpr size_t GATE_OFF = BIG_OFF;
constexpr size_t SSQ_OFF = BIG_OFF + 880 * MiB;
constexpr size_t WS_END = BIG_OFF + 886 * MiB;
}
using namespace cfg;

struct Args {
    const float* x_prompt; const float* x_sample; const float* p_prompt; const float* p_sample;
    const float* norm_mix_g; const float* w_in; const float* att_norm_g; const float* rwkv_shift;
    const float* rwkv_w0; const float* rwkv_w2; const float* rwkv_a0; const float* rwkv_a2; const float* rwkv_g2;
    const float* rwkv_k_k; const float* rwkv_k_a; const float* rwkv_r_k; const float* rwkv_ln_w; const float* rwkv_ln_b;
    const float* w_out; const float* norm_ffn_g; const float* peer_w_q; const float* peer_sub_keys; const float* peer_u; const float* peer_v;
    const float* ple_norm_g; const float* ple_w_gate; const float* ple_b_gate; const float* ple_w_proj; const float* final_norm_g;
    float* h;
    unsigned char* ws;
};

DEV int tid_() { int t = threadIdx.x; asm volatile("" : "+v"(t)); return t; }
DEV float bf2f(unsigned h) { return __uint_as_float(h << 16); }
DEV float bflo(unsigned d) { return __uint_as_float(d << 16); }
DEV float bfhi(unsigned d) { return __uint_as_float(d & 0xffff0000u); }
DEV unsigned pack2(float lo, float hi) { const f32x2 v = {lo, hi}; return __builtin_bit_cast(unsigned, __builtin_convertvector(v, bf16x2_t)); }
DEV unsigned f2bf(float f) { return pack2(f, 0.f) & 0xffffu; }
DEV float dot2bf(unsigned a, unsigned b, float c) { return __builtin_amdgcn_fdot2_f32_bf16(__builtin_bit_cast(bf16x2_t, a), __builtin_bit_cast(bf16x2_t, b), c, false); }
DEV float shx_(float v, int lane, int o) { return __int_as_float(__builtin_amdgcn_ds_bpermute((lane ^ o) << 2, __float_as_int(v))); }
DEV float shf_(float v, int src) { return __int_as_float(__builtin_amdgcn_ds_bpermute(src << 2, __float_as_int(v))); }
DEV int shf_(int v, int src) { return __builtin_amdgcn_ds_bpermute(src << 2, v); }
#define SHX(v, o) shx_((v), lane, (o))
#define SHF(v, src) shf_((v), (src))
DEV float wave_sum_(float v, int lane) {
#pragma unroll
    for (int o = 32; o > 0; o >>= 1) v += shx_(v, lane, o);
    return v;
}
DEV float wave_max_(float v, int lane) {
#pragma unroll
    for (int o = 32; o > 0; o >>= 1) v = fmaxf(v, shx_(v, lane, o));
    return v;
}
#define wave_sum(x) wave_sum_((x), lane)
#define wave_max(x) wave_max_((x), lane)
DEV float sum8(float v) {
    v += __int_as_float(__builtin_amdgcn_mov_dpp(__float_as_int(v), 0xB1, 0xF, 0xF, true));
    v += __int_as_float(__builtin_amdgcn_mov_dpp(__float_as_int(v), 0x4E, 0xF, 0xF, true));
    v += __int_as_float(__builtin_amdgcn_mov_dpp(__float_as_int(v), 0x141, 0xF, 0xF, true));
    return v;
}
DEV float rstd_parts(const float* ssq, int t) { const f32x4* p = (const f32x4*)(ssq + (size_t)t * 16); const f32x4 a = p[0], b = p[1], c = p[2], d = p[3];
    const float s = ((a[0] + a[1]) + (a[2] + a[3])) + ((b[0] + b[1]) + (b[2] + b[3])) + ((c[0] + c[1]) + (c[2] + c[3])) + ((d[0] + d[1]) + (d[2] + d[3]));
    return rsqrtf(s * (1.0f / 1024.0f) + 1e-6f); }
DEV float sigmoidf_(float x) { return __builtin_amdgcn_rcpf(1.0f + __expf(-x)); }
namespace pg8 {
#define PG8_LAS __attribute__((address_space(3)))
typedef unsigned short bf16_t;
typedef short bf16x8 __attribute__((ext_vector_type(8)));
typedef float f32x4 __attribute__((ext_vector_type(4)));
typedef unsigned u32x4 __attribute__((ext_vector_type(4)));
constexpr int BM = 256, BK = 64, HALF = 128, HTB = HALF * BK * 2  , STAGE_BYTES = 8 * HTB, NXCD = 8, WGM = 8;

__host__ __device__ __forceinline__ int lds_byte(int r, int c) { const int st = (r >> 4) * 2 + (c >> 5), rr = r & 15, cc = c & 31, ob = rr * 64 + cc * 2; return st * 1024 + (ob ^ (((ob >> 9) & 1) << 5)); }
__host__ __device__ __forceinline__ void stage_rc(int b, int& R, int& C) { const int st = b / 1024, sb = b % 1024, swz = sb ^ (((sb >> 9) & 1) << 5); R = (st >> 1) * 16 + swz / 64; C = (st & 1) * 32 + (swz % 64) / 2; }
__host__ __device__ __forceinline__ int perm32(int rho) { const int n = rho >> 4, i = rho & 15; return 8 * (i >> 2) + 4 * n + (i & 3); }

struct Unit { int pm, pn; };
struct Gemm { const bf16_t* A; const bf16_t* Bt; int M, N, K; };

struct StaticOrder {
    int nM, nN, nwg, G, c;
    __host__ __device__ void init(int M, int N, int G_, int c_) { nM = M / BM; nN = N / BM; nwg = nM * nN; G = G_; c = c_; }
    __host__ __device__ bool next(int i, Unit& u) const {
        const long L = (long)i * G + c; if (L >= nwg) return false;
        int wgid = (int)L; { const int q = nwg / NXCD, r = nwg % NXCD, xcd = wgid % NXCD, off = wgid / NXCD; wgid = (xcd < r ? xcd * (q + 1) : r * (q + 1) + (xcd - r) * q) + off; }
        const int nig = WGM * nN, gid = wgid / nig, fm = gid * WGM, gsz = (nM - fm) < WGM ? (nM - fm) : WGM;
        u.pm = fm + ((wgid % nig) % gsz); u.pn = (wgid % nig) / gsz; return true;
    }
    __device__ __forceinline__ void a_ready(const Unit&) const {}
    __device__ __forceinline__ void done(const Unit&) const {}
};
__device__ __forceinline__ unsigned cvt_pk_bf16(float lo, float hi) { unsigned r; asm volatile("v_cvt_pk_bf16_f32 %0, %1, %2" : "=v"(r) : "v"(lo), "v"(hi)); return r; }

struct EpiProj {
    static constexpr bool PERM = true, AFTER_DRAIN = false;
    bf16_t* qkv; bf16_t* u; const float* ssq; const float* rc; const float* rs;
    __device__ __forceinline__ void operator()(const f32x4 (&acc)[2][2][4][2], const Unit& un, int wr, int wc, int fr, int fq) const {
        const int row0 = un.pm * BM + wr * 64 + fr, lane = fr + 16 * fq;
        const bool isq = un.pn < 6;
        bf16_t* base = isq ? qkv : u; const int ld = isq ? 1536 : 2048; const int colt = isq ? un.pn * BM : (un.pn - 6) * BM;
        const int col0 = colt + wc * 32 + 8 * fq;
        const bool rope = (un.pn < 4) && ((wc & 1) == 0);
        f32x4 pq[2][4];
#pragma unroll
        for (int ai = 0; ai < 2; ++ai)
#pragma unroll
            for (int m = 0; m < 4; ++m) pq[ai][m] = *(const f32x4*)(ssq + (size_t)(row0 + ai * HALF + m * 16) * 16 + 4 * fq);
        float rsd[2][4];
#pragma unroll
        for (int ai = 0; ai < 2; ++ai)
#pragma unroll
            for (int m = 0; m < 4; ++m) { float t = (pq[ai][m][0] + pq[ai][m][1]) + (pq[ai][m][2] + pq[ai][m][3]); t += SHX(t, 16); t += SHX(t, 32); rsd[ai][m] = rsqrtf(t * (1.0f / 1024.0f) + 1e-6f); }
#pragma unroll
        for (int ai = 0; ai < 2; ++ai)
#pragma unroll
            for (int m = 0; m < 4; ++m) {
                const int row = row0 + ai * HALF + m * 16; const float s = rsd[ai][m]; const int pos = row & 4095;
                f32x4 c0 = {1.f, 1.f, 1.f, 1.f}, c1 = c0, s0 = {0.f, 0.f, 0.f, 0.f}, s1 = s0;
                if (rope) { c0 = *(const f32x4*)(rc + pos * 8); c1 = *(const f32x4*)(rc + pos * 8 + 4); s0 = *(const f32x4*)(rs + pos * 8); s1 = *(const f32x4*)(rs + pos * 8 + 4); }
                bf16_t* rowp = base + (size_t)row * ld + col0;
#pragma unroll
                for (int bj = 0; bj < 2; ++bj) {
                    f32x4 v0 = acc[ai][bj][m][0] * s, v1 = acc[ai][bj][m][1] * s;
                    if (rope) {
                        f32x4 o0, o1;
#pragma unroll
                        for (int c = 0; c < 4; ++c) { o0[c] = SHX(v0[c], 16); o1[c] = SHX(v1[c], 16); }
                        if (fq == 0) { v0 = v0 * c0 - o0 * s0; v1 = v1 * c1 - o1 * s1; }
                        else if (fq == 1) { v0 = v0 * c0 + o0 * s0; v1 = v1 * c1 + o1 * s1; }
                    }
                    u32x4 w; w.x = cvt_pk_bf16(v0[0], v0[1]); w.y = cvt_pk_bf16(v0[2], v0[3]); w.z = cvt_pk_bf16(v1[0], v1[1]); w.w = cvt_pk_bf16(v1[2], v1[3]);
                    *(u32x4*)(rowp + bj * HALF) = w;
                }
            }
    }
};
template <int MODE> struct EpiF32x {
    static constexpr bool PERM = true, AFTER_DRAIN = false;
    float* C; int ldc; const bf16_t* gate; bf16_t* hb; float* ssq;
    __device__ __forceinline__ void operator()(const f32x4 (&acc)[2][2][4][2], const Unit& un, int wr, int wc, int fr, int fq) const {
        const int row0 = un.pm * BM + wr * 64 + fr, col0 = un.pn * BM + wc * 32 + 8 * fq, lane = fr + 16 * fq;
#pragma unroll
        for (int ai = 0; ai < 2; ++ai)
#pragma unroll
            for (int m = 0; m < 4; ++m) {
                const int row = row0 + ai * HALF + m * 16;
                const size_t ro = (size_t)row * ldc + col0;
                if (MODE != 0) asm volatile("" ::: "memory");
                float ss = 0.f;
#pragma unroll
                for (int bj = 0; bj < 2; ++bj) {
                    if (MODE == 2 && bj) asm volatile("" ::: "memory");
                    f32x4* p = (f32x4*)(C + ro + bj * HALF);
                    if (MODE == 0) {
#if NT_HINTS
                        __builtin_nontemporal_store(acc[ai][bj][m][0], &p[0]); __builtin_nontemporal_store(acc[ai][bj][m][1], &p[1]);
#else
                        p[0] = acc[ai][bj][m][0]; p[1] = acc[ai][bj][m][1];
#endif
                    }
                    else {
                        f32x4 v0, v1;
                        if (MODE == 1) { v0 = p[0] + acc[ai][bj][m][0]; v1 = p[1] + acc[ai][bj][m][1]; }
                        else { const u32x4 g = *(const u32x4*)(gate + ro + bj * HALF);
                               f32x4 g0, g1; g0[0] = __uint_as_float(g.x << 16); g0[1] = __uint_as_float(g.x & 0xffff0000u); g0[2] = __uint_as_float(g.y << 16); g0[3] = __uint_as_float(g.y & 0xffff0000u);
                               g1[0] = __uint_as_float(g.z << 16); g1[1] = __uint_as_float(g.z & 0xffff0000u); g1[2] = __uint_as_float(g.w << 16); g1[3] = __uint_as_float(g.w & 0xffff0000u);
                               v0 = p[0] + g0 * acc[ai][bj][m][0]; v1 = p[1] + g1 * acc[ai][bj][m][1]; }
                        p[0] = v0; p[1] = v1;
                        ss += ((v0[0] * v0[0] + v0[1] * v0[1]) + (v0[2] * v0[2] + v0[3] * v0[3])) + ((v1[0] * v1[0] + v1[1] * v1[1]) + (v1[2] * v1[2] + v1[3] * v1[3]));
                        u32x4 pk; pk.x = cvt_pk_bf16(v0[0], v0[1]); pk.y = cvt_pk_bf16(v0[2], v0[3]); pk.z = cvt_pk_bf16(v1[0], v1[1]); pk.w = cvt_pk_bf16(v1[2], v1[3]);
                        *(u32x4*)(hb + ro + bj * HALF) = pk;
                    }
                }
                if (MODE != 0) {
                    ss += SHX(ss, 16); ss += SHX(ss, 32);
                    if (fq == 0) ssq[(size_t)row * 16 + un.pn * 4 + wc] = ss;
                }
            }
    }
};
struct EpiGate {
    static constexpr bool PERM = true, AFTER_DRAIN = false;
    bf16_t* O; const float* rstd; const float* bias;
    __device__ __forceinline__ void operator()(const f32x4 (&acc)[2][2][4][2], const Unit& un, int wr, int wc, int fr, int fq) const {
        const int row0 = un.pm * BM + wr * 64 + fr, col0 = un.pn * BM + wc * 32 + 8 * fq;
        f32x4 bv[2][2];
#pragma unroll
        for (int bj = 0; bj < 2; ++bj)
#pragma unroll
            for (int n = 0; n < 2; ++n) bv[bj][n] = *(const f32x4*)(bias + col0 + bj * HALF + 4 * n);
#pragma unroll
        for (int ai = 0; ai < 2; ++ai)
#pragma unroll
            for (int m = 0; m < 4; ++m) {
                const int row = row0 + ai * HALF + m * 16; const float s = rstd[row];
                bf16_t* rowp = O + (size_t)row * 1024 + col0;
#pragma unroll
                for (int bj = 0; bj < 2; ++bj) {
                    f32x4 v0 = acc[ai][bj][m][0] * s + bv[bj][0], v1 = acc[ai][bj][m][1] * s + bv[bj][1];
#pragma unroll
                    for (int c = 0; c < 4; ++c) { v0[c] = __builtin_amdgcn_rcpf(1.0f + __expf(-v0[c])); v1[c] = __builtin_amdgcn_rcpf(1.0f + __expf(-v1[c])); }
                    u32x4 w; w.x = cvt_pk_bf16(v0[0], v0[1]); w.y = cvt_pk_bf16(v0[2], v0[3]); w.z = cvt_pk_bf16(v1[0], v1[1]); w.w = cvt_pk_bf16(v1[2], v1[3]);
                    *(u32x4*)(rowp + bj * HALF) = w;
                }
            }
    }
};
template <class Epi, class Sched, bool STAMP = false>
__device__ __forceinline__ void gemm_phase(PG8_LAS unsigned char* lds, const Gemm g, const Sched& S, const Epi& E, unsigned long long* stamps, const int tid_in) {
    const int tid = tid_in, wid = __builtin_amdgcn_readfirstlane(tid >> 6), lane = tid & 63, wr = wid >> 2, wc = wid & 3, fr = lane & 15, fq = lane >> 4;
    const int K = g.K, nt = K / BK;
    int ts_lo = 0, ts_hi = 0, nts = 0; const unsigned long long rt_entry = STAMP ? (unsigned long long)wall_clock64() : 0ull;
#define PG8_STAMP() do { if (STAMP && wid == 0 && nts < 64) { const unsigned long long _c = (unsigned long long)clock64(); \
        ts_lo = (lane == nts) ? (int)(unsigned)_c : ts_lo; ts_hi = (lane == nts) ? (int)(unsigned)(_c >> 32) : ts_hi; ++nts; } } while (0)
    PG8_STAMP();
    unsigned voffA[2], voffB[2];
#pragma unroll
    for (int i = 0; i < 2; ++i) { int R, C; stage_rc(tid * 16 + i * 8192, R, C); const int Rb = Epi::PERM ? ((R & ~31) + perm32(R & 31)) : R;
        voffA[i] = (unsigned)(R * K + C) * 2u; voffB[i] = (unsigned)(Rb * K + C) * 2u; }
    const size_t kstep = (size_t)(BK * 2);
    const size_t hstep = (size_t)HALF * K * 2;
    const size_t tstep = 2 * hstep;
    const unsigned ldsw = (unsigned)wid * 1024u;
    const int aoff = lds_byte(wr * 64 + fr, fq * 8), boff = lds_byte(wc * 32 + fr, fq * 8);
#define PG8_SA(b, h) (((b) * 2 + (h)) * HTB)
#define PG8_SB(b, h) ((4 + (b) * 2 + (h)) * HTB)
#define PG8_STAGE(bufoff, gbase, voff) do { _Pragma("unroll") for (int _i = 0; _i < 2; ++_i) \
        __builtin_amdgcn_global_load_lds((const unsigned*)((const char*)(gbase) + (voff)[_i]), (PG8_LAS unsigned*)(lds + (bufoff) + ldsw + _i * 8192), 16, 0, 0); } while (0)
#define PG8_LDA(dst, b, h) do { _Pragma("unroll") for (int m = 0; m < 4; ++m) _Pragma("unroll") for (int k = 0; k < 2; ++k) dst[m][k] = *(const PG8_LAS bf16x8*)(lds + PG8_SA(b, h) + aoff + m * 2048 + k * 1024); } while (0)
#define PG8_LDB(dst, b, h) do { _Pragma("unroll") for (int n = 0; n < 2; ++n) _Pragma("unroll") for (int k = 0; k < 2; ++k) dst[n][k] = *(const PG8_LAS bf16x8*)(lds + PG8_SB(b, h) + boff + n * 2048 + k * 1024); } while (0)
#define PG8_MMA(ai, bj, At, Bt) do { __builtin_amdgcn_s_setprio(1); _Pragma("unroll") for (int m = 0; m < 4; ++m) _Pragma("unroll") for (int n = 0; n < 2; ++n) _Pragma("unroll") for (int k = 0; k < 2; ++k) \
        acc[ai][bj][m][n] = __builtin_amdgcn_mfma_f32_16x16x32_bf16(Bt[n][k], At[m][k], acc[ai][bj][m][n], 0, 0, 0); __builtin_amdgcn_s_setprio(0); } while (0)
#define PG8_WAIT_V(n) asm volatile("s_waitcnt vmcnt(" #n ")" ::: "memory")
#define PG8_WAIT_L(n) asm volatile("s_waitcnt lgkmcnt(" #n ")" ::: "memory")
#define PG8_BAR __builtin_amdgcn_s_barrier()
#define PG8_SCHED __builtin_amdgcn_sched_barrier(0)
    Unit cur, nxt; int ui = 0;
    if (!S.next(0, cur)) return;
    f32x4 acc[2][2][4][2];
#pragma unroll
    for (int a = 0; a < 2; ++a)
#pragma unroll
        for (int b = 0; b < 2; ++b)
#pragma unroll
            for (int m = 0; m < 4; ++m)
#pragma unroll
                for (int n = 0; n < 2; ++n) acc[a][b][m][n] = (f32x4){0.f, 0.f, 0.f, 0.f};
    bf16x8 At[4][2], B0[2][2], B1[2][2];
    const char* cA = (const char*)g.A + (size_t)cur.pm * tstep; const char* cB = (const char*)g.Bt + (size_t)cur.pn * tstep;
    S.a_ready(cur);
    PG8_STAGE(PG8_SB(0, 0), cB, voffB); PG8_STAGE(PG8_SA(0, 0), cA, voffA); PG8_STAGE(PG8_SB(0, 1), cB + hstep, voffB); PG8_STAGE(PG8_SA(0, 1), cA + hstep, voffA);
    if (wr == 1) PG8_BAR;
    PG8_WAIT_V(4); PG8_BAR;
    PG8_STAGE(PG8_SB(1, 0), cB + kstep, voffB); PG8_STAGE(PG8_SA(1, 0), cA + kstep, voffA); PG8_STAGE(PG8_SB(1, 1), cB + hstep + kstep, voffB);
    PG8_WAIT_V(6); PG8_BAR;
    PG8_STAMP();
    for (;;) {
        const bool has_next = S.next(ui + 1, nxt);
        const char* nA = has_next ? (const char*)g.A + (size_t)nxt.pm * tstep : cA; const char* nB = has_next ? (const char*)g.Bt + (size_t)nxt.pn * tstep : cB;
        for (int t = 0; t < nt; t += 2) {
            const bool last = (t == nt - 2);
            const char* a1 = cA + (size_t)(t + 1) * kstep;
            const char* a2 = last ? nA : cA + (size_t)(t + 2) * kstep; const char* b2 = last ? nB : cB + (size_t)(t + 2) * kstep;
            const char* a3 = a2 + kstep; const char* b3 = b2 + kstep;
            if (last && has_next) S.a_ready(nxt);
            PG8_LDB(B0, 0, 0); PG8_SCHED; PG8_LDA(At, 0, 0); PG8_STAGE(PG8_SA(1, 1), a1 + hstep, voffA);
            PG8_WAIT_L(8); PG8_BAR; PG8_WAIT_L(0); PG8_MMA(0, 0, At, B0); PG8_BAR; PG8_SCHED;
            PG8_LDB(B1, 0, 1); PG8_STAGE(PG8_SB(0, 0), b2, voffB);
            PG8_BAR; PG8_WAIT_L(0); PG8_MMA(0, 1, At, B1); PG8_BAR;
            PG8_LDA(At, 0, 1); PG8_STAGE(PG8_SA(0, 0), a2, voffA);
            PG8_BAR; PG8_WAIT_L(0); PG8_MMA(1, 0, At, B0); PG8_BAR; PG8_SCHED;
            PG8_STAGE(PG8_SB(0, 1), b2 + hstep, voffB);
            PG8_WAIT_V(6); PG8_BAR; PG8_MMA(1, 1, At, B1); PG8_BAR;
            PG8_LDB(B0, 1, 0); PG8_SCHED; PG8_LDA(At, 1, 0); PG8_STAGE(PG8_SA(0, 1), a2 + hstep, voffA);
            PG8_WAIT_L(8); PG8_BAR; PG8_WAIT_L(0); PG8_MMA(0, 0, At, B0); PG8_BAR; PG8_SCHED;
            PG8_LDB(B1, 1, 1); PG8_STAGE(PG8_SB(1, 0), b3, voffB);
            PG8_BAR; PG8_WAIT_L(0); PG8_MMA(0, 1, At, B1); PG8_BAR;
            PG8_LDA(At, 1, 1); PG8_STAGE(PG8_SA(1, 0), a3, voffA);
            PG8_BAR; PG8_WAIT_L(0); PG8_MMA(1, 0, At, B0); PG8_BAR; PG8_SCHED;
            PG8_STAGE(PG8_SB(1, 1), b3 + hstep, voffB);
            PG8_WAIT_V(6); PG8_BAR; PG8_MMA(1, 1, At, B1); PG8_BAR;
        }
        PG8_STAMP();
        if constexpr (!Epi::AFTER_DRAIN) { E(acc, cur, wr, wc, fr, fq); S.done(cur); }
        PG8_STAMP();
        if (!has_next) break;
#pragma unroll
        for (int a = 0; a < 2; ++a)
#pragma unroll
            for (int b = 0; b < 2; ++b)
#pragma unroll
                for (int m = 0; m < 4; ++m)
#pragma unroll
                    for (int n = 0; n < 2; ++n) acc[a][b][m][n] = (f32x4){0.f, 0.f, 0.f, 0.f};
        cur = nxt; cA = nA; cB = nB; ++ui;
    }
    PG8_WAIT_V(0);
    if (wr == 0) PG8_BAR;
    PG8_BAR;
    if constexpr (Epi::AFTER_DRAIN) { E.fused(acc, cur, wr, wc, fr, fq, lds, wid, lane); S.done(cur); }
    PG8_STAMP();
    if (STAMP && wid == 0) { stamps[lane] = lane < nts ? (((unsigned long long)(unsigned)ts_hi << 32) | (unsigned)ts_lo) : 0ull;
        if (lane == 62) stamps[62] = rt_entry; if (lane == 63) stamps[63] = (unsigned long long)wall_clock64(); }
#undef PG8_STAMP
#undef PG8_SA
#undef PG8_SB
#undef PG8_STAGE
#undef PG8_LDA
#undef PG8_LDB
#undef PG8_MMA
#undef PG8_WAIT_V
#undef PG8_WAIT_L
#undef PG8_BAR
#undef PG8_SCHED
}
}
#define XB_TMO      128
#define XB_XCNT(j)  (256  + 64 * (j))
#define XB_XSUB(j)  (1280 + 64 * (j))
#define XB_XGEN(j)  (2304 + 64 * (j))
#define XB_TOP      3328
#define XB_TOPGEN   3392
#define XCD_BAR_WORDS 3456
#define XB_SPIN_CAP (1u << 23)
#define LAS __attribute__((address_space(3)))

__device__ __forceinline__ unsigned xb_ld(unsigned* p)              { return __hip_atomic_load(p, __ATOMIC_RELAXED, __HIP_MEMORY_SCOPE_AGENT); }
__device__ __forceinline__ unsigned xb_add(unsigned* p, unsigned v) { return __hip_atomic_fetch_add(p, v, __ATOMIC_RELAXED, __HIP_MEMORY_SCOPE_AGENT); }
__device__ __forceinline__ unsigned xb_xcc_id() { return (unsigned)__builtin_amdgcn_s_getreg((3 << 11) | 20) & 0xFu; }
#define XB_SPIN(cond, bar) do { unsigned _sp = 0; while (cond) { __builtin_amdgcn_s_sleep(1); \
    if ((++_sp & 255u) == 0u) { if (xb_ld(&(bar)[XB_TMO])) break; if (_sp > XB_SPIN_CAP) { atomicAdd(&(bar)[XB_TMO], 1u); break; } } } } while (0)

struct XcdBarrier {
    unsigned* bar; unsigned x;
    volatile LAS unsigned* st;
};

__device__ __forceinline__ XcdBarrier xcd_barrier_post(unsigned* bar, volatile LAS unsigned* st) {
    XcdBarrier b; b.bar = bar; b.x = xb_xcc_id(); b.st = st;
    if (threadIdx.x == 0) (void)xb_add(&bar[XB_XCNT(b.x)], 1u);
    return b;
}
__device__ __forceinline__ void xcd_barrier_complete(unsigned* bar, unsigned x, unsigned& nloc, unsigned& nx) {
    const unsigned G = gridDim.x * gridDim.y * gridDim.z;
    unsigned sum, cnt, mine, sp = 0u;
    for (;;) {
        sum = 0u; cnt = 0u; mine = 0u;
#pragma unroll
        for (unsigned j = 0; j < 16; ++j) { const unsigned c = xb_ld(&bar[XB_XCNT(j)]); sum += c; cnt += (c > 0u) ? 1u : 0u; mine = (j == x) ? c : mine; }
        if (sum == G) break;
        __builtin_amdgcn_s_sleep(1);
        if ((++sp & 255u) == 0u) { if (xb_ld(&bar[XB_TMO])) break; if (sp > XB_SPIN_CAP) { atomicAdd(&bar[XB_TMO], 1u); break; } }
    }
    nloc = mine > 0u ? mine : 1u; nx = cnt > 0u ? cnt : 1u;
}

__device__ __forceinline__ void xcd_barrier(const XcdBarrier& b, const int tid) {
    asm volatile("s_waitcnt vmcnt(0)" ::: "memory");
    __syncthreads();
    if (tid == 0) {
        unsigned* bar = b.bar; unsigned bx = b.x;
        asm volatile("" : "+s"(bar), "+s"(bx));
        __builtin_amdgcn_s_waitcnt(0);
        unsigned nloc = b.st[0], nx = b.st[1];
        if (nloc == 0u) { xcd_barrier_complete(bar, bx, nloc, nx); b.st[0] = nloc; b.st[1] = nx; }
        const unsigned old = xb_add(&bar[XB_XSUB(bx)], 1u);
        const unsigned gen = old / nloc;
        if (old + 1u == (gen + 1u) * nloc) {
            __builtin_amdgcn_fence(__ATOMIC_RELEASE, "agent");
            asm volatile("s_waitcnt vmcnt(0)" ::: "memory");
            const unsigned og = xb_add(&bar[XB_TOP], 1u);
            const unsigned tg = og / nx;
            if (og + 1u == (tg + 1u) * nx) xb_add(&bar[XB_TOPGEN], 1u);
            else XB_SPIN(xb_ld(&bar[XB_TOPGEN]) == tg, bar);
            __builtin_amdgcn_fence(__ATOMIC_ACQUIRE, "agent");
            xb_add(&bar[XB_XGEN(bx)], 1u);
            asm volatile("s_waitcnt vmcnt(0)" ::: "memory");
        } else {
            XB_SPIN(xb_ld(&bar[XB_XGEN(bx)]) == gen, bar);
            __builtin_amdgcn_fence(__ATOMIC_ACQUIRE, "agent");
            asm volatile("s_waitcnt vmcnt(0)" ::: "memory");
        }
    }
    __syncthreads();
}


typedef __attribute__((address_space(3))) unsigned char lds_u8;
extern __shared__ __attribute__((aligned(16))) unsigned char smem[];
DEV unsigned char* smem_base() { return smem; }

DEV bf16_t* wsb(const Args& a, size_t off) { return (bf16_t*)(a.ws + off); }
DEV float* wsf(const Args& a, size_t off) { return (float*)(a.ws + off); }

DEV void ph_rowprep(const Args& a, bool from_x, const int tid0) {
    const int lane = tid0 & 63, wv = tid0 >> 6;
    const int gw = blockIdx.x * 8 + wv, nw = gridDim.x * 8;
    bf16_t* hb = wsb(a, HB_OFF); float* ssq = wsf(a, SSQ_OFF);
    for (int t = gw; t < T; t += nw) {
        const float* src = from_x ? (t < TP ? a.x_prompt + (size_t)t * D : a.x_sample + (size_t)(t - TP) * D) : a.h + (size_t)t * D;
        f32x4 v[4]; float ss = 0.f;
#pragma unroll
        for (int i = 0; i < 4; ++i) { v[i] = *(const f32x4*)(src + (i * 64 + lane) * 4); ss += v[i][0] * v[i][0] + v[i][1] * v[i][1] + v[i][2] * v[i][2] + v[i][3] * v[i][3]; }
        ss = wave_sum(ss);
#pragma unroll
        for (int i = 0; i < 4; ++i) {
            if (from_x) *(f32x4*)(a.h + (size_t)t * D + (i * 64 + lane) * 4) = v[i];
            u32x2 p; p.x = pack2(v[i][0], v[i][1]); p.y = pack2(v[i][2], v[i][3]);
            *(u32x2*)(hb + (size_t)t * D + (i * 64 + lane) * 4) = p;
        }
        if (lane < 16) ssq[(size_t)t * 16 + lane] = (lane == 0) ? ss : 0.f;
    }
}

DEV void ph_final(const Args& a, const int tid0) {
    const int lane = tid0 & 63, wv = tid0 >> 6;
    const int gw = blockIdx.x * 8 + wv, nw = gridDim.x * 8;
    for (int t = gw; t < T; t += nw) {
        float* row = a.h + (size_t)t * D;
        f32x4 v[4]; float ss = 0.f;
#pragma unroll
        for (int i = 0; i < 4; ++i) { v[i] = *(const f32x4*)(row + (i * 64 + lane) * 4); ss += v[i][0] * v[i][0] + v[i][1] * v[i][1] + v[i][2] * v[i][2] + v[i][3] * v[i][3]; }
        ss = wave_sum(ss);
        const float r = rsqrtf(ss * (1.0f / 1024.0f) + 1e-6f);
#pragma unroll
        for (int i = 0; i < 4; ++i) { const f32x4 g = *(const f32x4*)(a.final_norm_g + (i * 64 + lane) * 4); *(f32x4*)(row + (i * 64 + lane) * 4) = v[i] * r * g; }
    }
}

DEV void transpose_cvt(const float* __restrict__ src, bf16_t* __restrict__ dst, int K, int N, int Npad, const float* __restrict__ g, float* tile, const int tid0) {
    const int tx = tid0 & 63, ty = tid0 >> 6;
    const int tk = K / 64, tn = Npad / 64;
    for (int tl = blockIdx.x; tl < tk * tn; tl += gridDim.x) {
        const int k0 = (tl % tk) * 64, n0 = (tl / tk) * 64;
        __syncthreads();
        for (int i = ty; i < 64; i += 8) { const int k = k0 + i, n = n0 + tx; float v = (n < N) ? src[(size_t)k * N + n] : 0.f; if (g) v *= g[k]; tile[i * 65 + tx] = v; }
        __syncthreads();
        for (int i = ty; i < 64; i += 8) dst[(size_t)(n0 + i) * K + k0 + tx] = (bf16_t)f2bf(tile[tx * 65 + i]);
    }
}
DEV void fold_wqk(const Args& a, float* lds, const int tid0) {
    float* swq = lds;
    float* ssk = lds + 64 * 132;
    const int tid = tid0, key = tid & 127, kq = tid >> 7;
    for (int un = blockIdx.x; un < NL * 16 * 16; un += gridDim.x) {
        const int l = un >> 8, hp = (un >> 4) & 15, k0 = (un & 15) * 64;
        __syncthreads();
        for (int i = tid; i < 64 * 128; i += NTHR) { const int r = i >> 7, c = i & 127; swq[r * 132 + c] = a.peer_w_q[((size_t)l * 1024 + k0 + r) * 2048 + hp * 128 + c]; }
        for (int i = tid; i < 128 * 128; i += NTHR) { const int r = i >> 7, c = i & 127; ssk[r * 132 + c] = a.peer_sub_keys[(((size_t)l * 16 + hp) * 128 + r) * 128 + c]; }
        __syncthreads();
        float acc[16];
#pragma unroll
        for (int i = 0; i < 16; ++i) acc[i] = 0.f;
        for (int c = 0; c < 128; c += 4) {
            const f32x4 s = *(const f32x4*)(ssk + key * 132 + c);
#pragma unroll
            for (int i = 0; i < 16; ++i) { const f32x4 w = *(const f32x4*)(swq + (kq * 16 + i) * 132 + c); acc[i] += s[0] * w[0] + s[1] * w[1] + s[2] * w[2] + s[3] * w[3]; }
        }
        bf16_t* dst = wsb(a, WB_OFF + (size_t)l * WB_LAYER + WB_QK) + (size_t)(hp * 128 + key) * 1024 + k0 + kq * 16;
        const float* g = a.norm_ffn_g + l * 1024 + k0 + kq * 16;
#pragma unroll
        for (int i = 0; i < 16; i += 2) *(unsigned*)(dst + i) = pack2(acc[i] * g[i], acc[i + 1] * g[i + 1]);
    }
}
DEV void ph_prologue(const Args& a, float* lds, const int tid0) {
    { float* rc = wsf(a, ROPEC_OFF); float* rs = wsf(a, ROPES_OFF);
      for (int i = blockIdx.x * NTHR + tid0; i < 4096 * 8; i += gridDim.x * NTHR) {
          const int pos = i >> 3, f = i & 7;
          const float invf = (float)pow(500000.0, -(double)f / 8.0);
          const float ang = (float)pos * invf;
          rc[i] = (float)cos((double)ang); rs[i] = (float)sin((double)ang);
      } }
    for (int l = 0; l < NL; ++l) {
        bf16_t* wb = wsb(a, WB_OFF + (size_t)l * WB_LAYER);
        transpose_cvt(a.w_in + (size_t)l * 1024 * INC, wb + WB_IN / 2, 1024, INC, INP, a.norm_mix_g + l * 1024, lds, tid0);
        transpose_cvt(a.w_out + (size_t)l * 1024 * 1024, wb + WB_OUT / 2, 1024, 1024, 1024, nullptr, lds, tid0);
        transpose_cvt(a.ple_w_gate + (size_t)l * 1024 * 1024, wb + WB_GATE / 2, 1024, 1024, 1024, a.ple_norm_g + l * 1024, lds, tid0);
        transpose_cvt(a.ple_w_proj + (size_t)l * 256 * 1024, wb + WB_PROJ / 2, 256, 1024, 1024, nullptr, lds, tid0);
        for (int dr = 0; dr < 2; ++dr) {
            transpose_cvt(a.rwkv_w2 + (size_t)(l * 2 + dr) * 64 * 512, wb + WB_LORA / 2 + dr * 512 * 64, 64, 512, 512, nullptr, lds, tid0);
            transpose_cvt(a.rwkv_a2 + (size_t)(l * 2 + dr) * 64 * 512, wb + WB_LORA / 2 + (2 + dr) * 512 * 64, 64, 512, 512, nullptr, lds, tid0);
        }
        transpose_cvt(a.rwkv_g2 + (size_t)l * 128 * 512, wb + WB_LORA / 2 + 4 * 512 * 64, 128, 512, 512, nullptr, lds, tid0);
    }
    fold_wqk(a, lds, tid0);
}

DEV float sum16(float v) {
    v = sum8(v);
    v += __int_as_float(__builtin_amdgcn_mov_dpp(__float_as_int(v), 0x140, 0xF, 0xF, true));
    return v;
}
DEV float max16(float v) {
    v = fmaxf(v, __int_as_float(__builtin_amdgcn_mov_dpp(__float_as_int(v), 0xB1, 0xF, 0xF, true)));
    v = fmaxf(v, __int_as_float(__builtin_amdgcn_mov_dpp(__float_as_int(v), 0x4E, 0xF, 0xF, true)));
    v = fmaxf(v, __int_as_float(__builtin_amdgcn_mov_dpp(__float_as_int(v), 0x141, 0xF, 0xF, true)));
    v = fmaxf(v, __int_as_float(__builtin_amdgcn_mov_dpp(__float_as_int(v), 0x140, 0xF, 0xF, true)));
    return v;
}
DEV float rl(float v, int l) { return __int_as_float(__builtin_amdgcn_readlane(__float_as_int(v), l)); }
DEV float wave_sum_dpp(float v) { v = sum16(v); return (rl(v, 0) + rl(v, 16)) + (rl(v, 32) + rl(v, 48)); }
DEV unsigned fkey(float f) { const unsigned b = __float_as_uint(f); return b ^ ((unsigned)((int)b >> 31) | 0x80000000u); }
DEV int mbcnt64(unsigned long long m) { return (int)__builtin_amdgcn_mbcnt_hi((unsigned)(m >> 32), __builtin_amdgcn_mbcnt_lo((unsigned)m, 0u)); }

#ifndef TOPK_NU
#define TOPK_NU 4
#endif
#if NT_HINTS
#define TOPK_LD(p_) __builtin_nontemporal_load(p_)
#else
#define TOPK_LD(p_) (*(p_))
#endif
DEV int vpopc2(unsigned long long m1, unsigned long long m2) { int n;
    asm("v_bcnt_u32_b32 %0, %1, 0\n\tv_bcnt_u32_b32 %0, %2, %0\n\tv_bcnt_u32_b32 %0, %3, %0\n\tv_bcnt_u32_b32 %0, %4, %0" : "=&v"(n) : "s"((unsigned)m1), "s"((unsigned)(m1 >> 32)), "s"((unsigned)m2), "s"((unsigned)(m2 >> 32)));
    return n; }
template <bool MIXED = false> DEV void ph_topk2(const Args& a, float* lds, const int tid0, const int gw, const int nw, const int NP, int* TOPI, float* TOPG, const int tbase, float* RL = nullptr, int* ctr = nullptr) {
    const int lane = tid0 & 63, wv = __builtin_amdgcn_readfirstlane(tid0 >> 6);
    constexpr int NU = TOPK_NU, NQ = 2 * NU, GPT = 8 / NU;
    float* tvb = lds + wv * (NQ * 16); int* tib = (int*)(lds + 8 * NQ * 16) + wv * (NQ * 16);
    const float* SC = wsf(a, SC_OFF); const float* ssq = wsf(a, SSQ_OFF);
    float vn[NU][4];
#define TOPK_DRAW() ({ int v_ = 0; if (lane == 0) v_ = __hip_atomic_fetch_add(ctr, 1, __ATOMIC_RELAXED, __HIP_MEMORY_SCOPE_WORKGROUP); __builtin_amdgcn_readfirstlane(v_); })
    const int up0 = ctr ? gw + TOPK_DRAW() : gw;
    if (up0 < NP) {
#pragma unroll
        for (int u = 0; u < NU; ++u)
#pragma unroll
            for (int i = 0; i < 4; ++i) vn[u][i] = TOPK_LD(&SC[(size_t)up0 * (NU * 256) + u * 256 + i * 64 + lane]);
    }
    int upn = up0;
    for (int up = up0; up < NP; up = upn) {
        upn = ctr ? gw + TOPK_DRAW() : up + nw;
        const int t = up / GPT, hd0 = (up % GPT) * NU;
        const f32x4* sqp = (const f32x4*)(ssq + (size_t)t * 16); const f32x4 sq0 = sqp[0], sq1 = sqp[1], sq2 = sqp[2], sq3 = sqp[3];
        float v[NU][4]; unsigned k[NU][4];
#pragma unroll
        for (int u = 0; u < NU; ++u)
#pragma unroll
            for (int i = 0; i < 4; ++i) { v[u][i] = vn[u][i]; k[u][i] = fkey(v[u][i]); }
        if (upn < NP) {
#pragma unroll
            for (int u = 0; u < NU; ++u)
#pragma unroll
                for (int i = 0; i < 4; ++i) vn[u][i] = TOPK_LD(&SC[(size_t)upn * (NU * 256) + u * 256 + i * 64 + lane]);
        }
        unsigned th[NQ]; unsigned dm = 0u;
        unsigned long long dq[NU];
#pragma unroll
        for (int q2 = 0; q2 < NU; ++q2) dq[q2] = 0ull;
#pragma unroll
        for (int q = 0; q < NQ; ++q) th[q] = 0u;
        for (int b = 31; b >= 0; --b) {
            const unsigned bit = 1u << b;
            unsigned long long ma[NQ], mb[NQ];
#pragma unroll
            for (int q = 0; q < NQ; ++q) { const unsigned c = th[q] | bit; ma[q] = __ballot(k[q >> 1][2 * (q & 1)] >= c); mb[q] = __ballot(k[q >> 1][2 * (q & 1) + 1] >= c); }
#pragma unroll
            for (int q = 0; q < NQ; ++q) {
                if (MIXED && (q & 1)) {
                    const int n = vpopc2(ma[q], mb[q]);
                    th[q] = (n >= 16) ? (th[q] | bit) : th[q]; dq[q >> 1] |= __ballot(n == 16);
                } else {
                    const int n = __builtin_popcountll(ma[q]) + __builtin_popcountll(mb[q]);
                    th[q] = (n >= 16) ? (th[q] | bit) : th[q]; dm |= (n == 16) ? (1u << q) : 0u;
                }
            }
            if (MIXED) { unsigned long long da = ~0ull;
#pragma unroll
                for (int q2 = 0; q2 < NU; ++q2) da &= dq[q2];
                if (dm == 0x55555555u % (1u << NQ) && da != 0ull) break; }
            else if (dm == (1u << NQ) - 1u) break;
        }
#pragma unroll
        for (int q = 0; q < NQ; ++q) {
            const int u = q >> 1, p = q & 1; const unsigned tp = th[q];
            const unsigned ka = k[u][2 * p], kb = k[u][2 * p + 1];
            const unsigned long long ga = __ballot(ka > tp), gb = __ballot(kb > tp), ea = __ballot(ka == tp), eb = __ballot(kb == tp);
            const int nga = __builtin_popcountll(ga), ng = nga + __builtin_popcountll(gb), need = 16 - ng, nea = __builtin_popcountll(ea);
            const int rga = mbcnt64(ga), rgb = nga + mbcnt64(gb), rea = mbcnt64(ea), reb = nea + mbcnt64(eb);
            const int pa = (ka > tp) ? rga : ((ka == tp && rea < need) ? ng + rea : -1);
            const int pb = (kb > tp) ? rgb : ((kb == tp && reb < need) ? ng + reb : -1);
            if (pa >= 0) { tvb[q * 16 + pa] = v[u][2 * p]; tib[q * 16 + pa] = lane; }
            if (pb >= 0) { tvb[q * 16 + pb] = v[u][2 * p + 1]; tib[q * 16 + pb] = 64 + lane; }
        }
        float cv[NU][4]; unsigned kc[NU][4]; float mx[NU];
#pragma unroll
        for (int u = 0; u < NU; ++u) {
#pragma unroll
            for (int s = 0; s < 4; ++s) { const int c = lane + 64 * s; cv[u][s] = tvb[u * 32 + (c >> 4)] + tvb[u * 32 + 16 + (c & 15)]; kc[u][s] = fkey(cv[u][s]); }
            const float m0 = max16(lane < 16 ? tvb[u * 32 + (lane & 15)] : -3.0e38f), m1 = max16(lane < 16 ? tvb[u * 32 + 16 + (lane & 15)] : -3.0e38f);
            mx[u] = rl(m0, 0) + rl(m1, 0);
        }
        unsigned t2[NU]; unsigned dm2 = 0u;
#pragma unroll
        for (int u = 0; u < NU; ++u) t2[u] = 0u;
        for (int b = 31; b >= 0; --b) {
            const unsigned bit = 1u << b;
            unsigned long long mc[NU][4];
#pragma unroll
            for (int u = 0; u < NU; ++u)
#pragma unroll
                for (int s4 = 0; s4 < 4; ++s4) mc[u][s4] = __ballot(kc[u][s4] >= (t2[u] | bit));
#pragma unroll
            for (int u = 0; u < NU; ++u) {
                const int n = (__builtin_popcountll(mc[u][0]) + __builtin_popcountll(mc[u][1])) + (__builtin_popcountll(mc[u][2]) + __builtin_popcountll(mc[u][3]));
                t2[u] = (n >= 16) ? (t2[u] | bit) : t2[u]; dm2 |= (n == 16) ? (1u << u) : 0u;
            }
            if (dm2 == (1u << NU) - 1u) break;
        }
        const float rs = rsqrtf((((sq0[0] + sq0[1]) + (sq0[2] + sq0[3])) + ((sq1[0] + sq1[1]) + (sq1[2] + sq1[3])) + ((sq2[0] + sq2[1]) + (sq2[2] + sq2[3])) + ((sq3[0] + sq3[1]) + (sq3[2] + sq3[3]))) * (1.0f / 1024.0f) + 1e-6f);
#pragma unroll
        for (int u = 0; u < NU; ++u) {
            int pos[4]; int ng = 0;
#pragma unroll
            for (int s = 0; s < 4; ++s) { const unsigned long long g = __ballot(kc[u][s] > t2[u]); pos[s] = (kc[u][s] > t2[u]) ? ng + mbcnt64(g) : -1; ng += __builtin_popcountll(g); }
            int ne = 0; const int need = 16 - ng;
#pragma unroll
            for (int s = 0; s < 4; ++s) { const unsigned long long e = __ballot(kc[u][s] == t2[u]); const int r = ne + mbcnt64(e); pos[s] = (kc[u][s] == t2[u] && r < need) ? ng + r : pos[s]; ne += __builtin_popcountll(e); }
            float ex[4]; float es = 0.f;
#pragma unroll
            for (int s = 0; s < 4; ++s) { ex[s] = (pos[s] >= 0) ? __expf(rs * (cv[u][s] - mx[u])) : 0.f; es += ex[s]; }
            const float inv = __builtin_amdgcn_rcpf(wave_sum_dpp(es));
#pragma unroll
            for (int s = 0; s < 4; ++s) if (pos[s] >= 0) {
                const int c = lane + 64 * s;
                const int eid = tib[u * 32 + (c >> 4)] * 128 + tib[u * 32 + 16 + (c & 15)];
                if (TOPG) { TOPI[(t - tbase) * 128 + (hd0 + u) * 16 + pos[s]] = eid; TOPG[(t - tbase) * 128 + (hd0 + u) * 16 + pos[s]] = ex[s] * inv; }
                else TOPI[(t - tbase) * 128 + (hd0 + u) * 16 + pos[s]] = eid | ((int)(ex[s] * inv * 262143.0f + 0.5f) << 14);
            }
        }
        if (RL && hd0 == 0 && lane == 0) RL[t - tbase] = rs;
    }
}

DEV unsigned pack4_fp8(float a, float b, float c, float d) {
    int w = __builtin_amdgcn_cvt_pk_fp8_f32(a, b, 0, false);
    w = __builtin_amdgcn_cvt_pk_fp8_f32(c, d, w, true);
    return (unsigned)w;
}
DEV void ph_convert8(const Args& a, int layer, const int tid0) {
    const size_t gtid = (size_t)blockIdx.x * NTHR + tid0, gn = (size_t)gridDim.x * NTHR;
    const float* us = a.peer_u + (size_t)layer * 16384 * 1024; const float* vs = a.peer_v + (size_t)layer * 16384 * 1024;
    unsigned* ud = (unsigned*)(a.ws + PTU_OFF); unsigned* vd = (unsigned*)(a.ws + PTV_OFF);
    const float* g = a.norm_ffn_g + layer * 1024;
#if PEER_FP4
    for (size_t i = gtid; i < (size_t)16384 * 1024 / 16; i += gn) {
        u32x2 pu = {0u, 0u}, pv = {0u, 0u};
#pragma unroll
        for (int j = 0; j < 4; ++j) {
            const f32x4 x = *(const f32x4*)(us + i * 16 + j * 4), y = *(const f32x4*)(vs + i * 16 + j * 4), gg = *(const f32x4*)(g + ((i * 16 + j * 4) & 1023));
            unsigned wu = pu[j >> 1], wv = pv[j >> 1];
            if (j & 1) { wu = __builtin_amdgcn_cvt_scalef32_pk_fp4_f32(wu, x[0] * gg[0] * PEER_USC, x[1] * gg[1] * PEER_USC, 1.0f, 2); wu = __builtin_amdgcn_cvt_scalef32_pk_fp4_f32(wu, x[2] * gg[2] * PEER_USC, x[3] * gg[3] * PEER_USC, 1.0f, 3);
                         wv = __builtin_amdgcn_cvt_scalef32_pk_fp4_f32(wv, y[0] * PEER_VSC, y[1] * PEER_VSC, 1.0f, 2); wv = __builtin_amdgcn_cvt_scalef32_pk_fp4_f32(wv, y[2] * PEER_VSC, y[3] * PEER_VSC, 1.0f, 3); }
            else       { wu = __builtin_amdgcn_cvt_scalef32_pk_fp4_f32(wu, x[0] * gg[0] * PEER_USC, x[1] * gg[1] * PEER_USC, 1.0f, 0); wu = __builtin_amdgcn_cvt_scalef32_pk_fp4_f32(wu, x[2] * gg[2] * PEER_USC, x[3] * gg[3] * PEER_USC, 1.0f, 1);
                         wv = __builtin_amdgcn_cvt_scalef32_pk_fp4_f32(wv, y[0] * PEER_VSC, y[1] * PEER_VSC, 1.0f, 0); wv = __builtin_amdgcn_cvt_scalef32_pk_fp4_f32(wv, y[2] * PEER_VSC, y[3] * PEER_VSC, 1.0f, 1); }
            pu[j >> 1] = wu; pv[j >> 1] = wv;
        }
        *(u32x2*)(ud + i * 2) = pu; *(u32x2*)(vd + i * 2) = pv;
    }
#else
    for (size_t i = gtid; i < (size_t)16384 * 1024 / 16; i += gn) {
        u32x4 pu, pv;
#pragma unroll
        for (int j = 0; j < 4; ++j) {
            const f32x4 x = *(const f32x4*)(us + i * 16 + j * 4), y = *(const f32x4*)(vs + i * 16 + j * 4), gg = *(const f32x4*)(g + ((i * 16 + j * 4) & 1023));
#if FP4_EMU
            { const unsigned q0 = __builtin_amdgcn_cvt_scalef32_pk_fp4_f32(0u, x[0] * gg[0] * 64.f, x[1] * gg[1] * 64.f, 1.0f, 0), q1 = __builtin_amdgcn_cvt_scalef32_pk_fp4_f32(0u, x[2] * gg[2] * 64.f, x[3] * gg[3] * 64.f, 1.0f, 0);
              const f32x2 r0 = __builtin_amdgcn_cvt_scalef32_pk_f32_fp4(q0, 1.0f, 0), r1 = __builtin_amdgcn_cvt_scalef32_pk_f32_fp4(q1, 1.0f, 0);
              pu[j] = pack4_fp8(r0[0] * 4.f, r0[1] * 4.f, r1[0] * 4.f, r1[1] * 4.f);
              const unsigned q2 = __builtin_amdgcn_cvt_scalef32_pk_fp4_f32(0u, y[0] * 8.f, y[1] * 8.f, 1.0f, 0), q3 = __builtin_amdgcn_cvt_scalef32_pk_fp4_f32(0u, y[2] * 8.f, y[3] * 8.f, 1.0f, 0);
              const f32x2 r2 = __builtin_amdgcn_cvt_scalef32_pk_f32_fp4(q2, 1.0f, 0), r3 = __builtin_amdgcn_cvt_scalef32_pk_f32_fp4(q3, 1.0f, 0);
              pv[j] = pack4_fp8(r2[0] * 4.f, r2[1] * 4.f, r3[0] * 4.f, r3[1] * 4.f); }
#else
            pu[j] = pack4_fp8(x[0] * gg[0] * 256.f, x[1] * gg[1] * 256.f, x[2] * gg[2] * 256.f, x[3] * gg[3] * 256.f);
            pv[j] = pack4_fp8(y[0] * 32.f, y[1] * 32.f, y[2] * 32.f, y[3] * 32.f);
#endif
        }
        *(u32x4*)(ud + i * 4) = pu; *(u32x4*)(vd + i * 4) = pv;
    }
#endif
    bf16_t* pb = wsb(a, PB_OFF);
    const float* pp = a.p_prompt + (size_t)layer * TP * 256; const float* ps = a.p_sample + (size_t)layer * (T - TP) * 256;
    for (size_t i = gtid; i < (size_t)T * 256 / 4; i += gn) {
        const size_t e = i * 4; const f32x4 x = (e < (size_t)TP * 256) ? *(const f32x4*)(pp + e) : *(const f32x4*)(ps + (e - (size_t)TP * 256));
        u32x2 p; p.x = pack2(x[0], x[1]); p.y = pack2(x[2], x[3]); *(u32x2*)(pb + e) = p;
    }
}


typedef short bf16x8 __attribute__((ext_vector_type(8)));
typedef float f32x16 __attribute__((ext_vector_type(16)));
#define MFMA32(a, b, c) __builtin_amdgcn_mfma_f32_32x32x16_bf16((a), (b), (c), 0, 0, 0)
DEV bf16x8 pack_frag(float x0, float x1, float x2, float x3, float x4, float x5, float x6, float x7) {
    u32x4 p;
    asm volatile("v_cvt_pk_bf16_f32 %0, %4, %5\n\tv_cvt_pk_bf16_f32 %1, %6, %7\n\tv_cvt_pk_bf16_f32 %2, %8, %9\n\tv_cvt_pk_bf16_f32 %3, %10, %11\n\ts_nop 1"
                 : "=&v"(p[0]), "=&v"(p[1]), "=&v"(p[2]), "=&v"(p[3]) : "v"(x0), "v"(x1), "v"(x2), "v"(x3), "v"(x4), "v"(x5), "v"(x6), "v"(x7));
    return __builtin_bit_cast(bf16x8, p);
}
DEV void ph_attn3(const Args& a, int layer, unsigned char* ldsb, const int tid0) {
    const int lane = tid0 & 63, wv = __builtin_amdgcn_readfirstlane(tid0 >> 6), r = lane & 31, h = lane >> 5;
    unsigned char* OL = ldsb;
    float* MLl = (float*)(ldsb + 73728);
    unsigned char* vt = ldsb + 77824 + wv * 4608;
    const bf16_t* qkv = wsb(a, QKV_OFF);
    bf16_t* mix = wsb(a, MIX_OFF);
    const int i16 = lane & 15, tq = i16 >> 2, tp = i16 & 3, tblk = (lane >> 4) & 1;
    const unsigned tr_addr = (unsigned)(size_t)vt + (4 * h + tq) * 144 + 2 * (16 * tblk + 4 * tp);
    const float sc = 0.125f * 1.44269504f, NEG = -1.0e30f;
    for (int un = blockIdx.x; un < NSEQ * 8 * 8; un += gridDim.x) {
      const int sh = un >> 3, sp = un & 7, seq = sh >> 3, hd = sh & 7; const size_t tb = (size_t)seq * 4096;
      __syncthreads();
#pragma unroll 1
      for (int di = 0; di < 3; ++di) {
       bf16x8 qfN[4], kN[4], vN[4];
#pragma unroll
       for (int k2 = 0; k2 < 2; ++k2) {
        const int idx16 = wv * 2 + k2;
        const int sft = 2 * di, nlen = 4096 >> sft;
        const int rr = (di == 0) ? 0 : (di == 1 ? (idx16 >> 2) : idx16), cb = (di == 0) ? (16 * sp + idx16) : (di == 1 ? (4 * sp + (idx16 & 3)) : sp), cq0 = cb * 32;
        const size_t tokq = tb + ((size_t)(cq0 + r) << sft) + rr;
        const bf16_t* qp = qkv + tokq * 1536 + hd * 64 + 8 * h;
        bf16x8 qf[4];
#pragma unroll
        for (int s = 0; s < 4; ++s) qf[s] = (k2 == 1) ? qfN[s] : *(const bf16x8*)(qp + 16 * s);
        float m = NEG, l = 0.f;
        f32x16 O0, O1;
#pragma unroll
        for (int i = 0; i < 16; ++i) { O0[i] = 0.f; O1[i] = 0.f; }
        bf16x8 kfb[2][4], vfb[2][4];
#define ATT_LOAD(kt_) do { const int kb_ = cq0 - 64 + 32 * (kt_); const size_t tokk_ = tb + ((size_t)(kb_ + r) << sft) + rr; const bf16_t* kp_ = qkv + tokk_ * 1536 + 512 + hd * 64 + 8 * h; \
            _Pragma("unroll") for (int s_ = 0; s_ < 4; ++s_) { kfb[(kt_) & 1][s_] = *(const bf16x8*)(kp_ + 16 * s_); vfb[(kt_) & 1][s_] = *(const bf16x8*)(kp_ + 512 + 16 * s_); } } while (0)
        if (cq0 - 64 >= 0) {
            if (k2 == 1) {
#pragma unroll
                for (int s_ = 0; s_ < 4; ++s_) { kfb[0][s_] = kN[s_]; vfb[0][s_] = vN[s_]; }
            } else ATT_LOAD(0);
        }
#pragma unroll
        for (int kt = 0; kt < 5; ++kt) {
            const int kb = cq0 - 64 + 32 * kt;
            if (kt + 1 < 5) { const int kbn = kb + 32; if (kbn >= 0 && kbn < nlen) ATT_LOAD(kt + 1); }
            if (k2 == 0 && kt == 4) {
                const int ix1 = idx16 + 1;
                const int rr1 = (di == 0) ? 0 : (di == 1 ? (ix1 >> 2) : ix1), cb1 = (di == 0) ? (16 * sp + ix1) : (di == 1 ? (4 * sp + (ix1 & 3)) : sp), cq1 = cb1 * 32;
                const bf16_t* qp1 = qkv + (tb + ((size_t)(cq1 + r) << sft) + rr1) * 1536 + hd * 64 + 8 * h;
#pragma unroll
                for (int s_ = 0; s_ < 4; ++s_) qfN[s_] = *(const bf16x8*)(qp1 + 16 * s_);
                if (cq1 - 64 >= 0) {
                    const bf16_t* kp1 = qkv + (tb + ((size_t)(cq1 - 64 + r) << sft) + rr1) * 1536 + 512 + hd * 64 + 8 * h;
#pragma unroll
                    for (int s_ = 0; s_ < 4; ++s_) { kN[s_] = *(const bf16x8*)(kp1 + 16 * s_); vN[s_] = *(const bf16x8*)(kp1 + 512 + 16 * s_); }
                }
            }
            asm volatile("" ::: "memory");
            if (kb < 0 || kb >= nlen) continue;
            bf16x8 kf[4], vf[4];
#pragma unroll
            for (int s = 0; s < 4; ++s) { kf[s] = kfb[kt & 1][s]; vf[s] = vfb[kt & 1][s]; }
            f32x16 S;
#pragma unroll
            for (int i = 0; i < 16; ++i) S[i] = 0.f;
#pragma unroll
            for (int s = 0; s < 4; ++s) S = MFMA32(kf[s], qf[s], S);
            float lm = NEG;
#pragma unroll
            for (int i = 0; i < 16; ++i) {
                const int row = (i & 3) + 8 * (i >> 2) + 4 * h;
                float v = S[i] * sc;
                if (kt == 0) v = (row >= r) ? v : NEG;
                if (kt == 4) v = (row <= r) ? v : NEG;
                S[i] = v; lm = fmaxf(lm, v);
            }
            lm = fmaxf(lm, SHX(lm, 32));
            const float mn = fmaxf(m, lm), alpha = __builtin_amdgcn_exp2f(m - mn);
            m = mn; l *= alpha;
            float ps = 0.f;
#pragma unroll
            for (int i = 0; i < 16; ++i) { O0[i] *= alpha; O1[i] *= alpha; S[i] = __builtin_amdgcn_exp2f(S[i] - mn); ps += S[i]; }
            l += ps;
            const bf16x8 pb0 = pack_frag(S[0], S[1], S[2], S[3], S[4], S[5], S[6], S[7]);
            const bf16x8 pb1 = pack_frag(S[8], S[9], S[10], S[11], S[12], S[13], S[14], S[15]);
            asm volatile("" ::: "memory");
#pragma unroll
            for (int i = 0; i < 4; ++i) *(bf16x8*)(vt + r * 144 + 2 * (16 * i + 8 * h)) = vf[i];
            typedef short s16x4 __attribute__((ext_vector_type(4)));
            s16x4 t00l, t00h, t01l, t01h, t10l, t10h, t11l, t11h;
            asm volatile("s_waitcnt lgkmcnt(0)\n\t"
                         "ds_read_b64_tr_b16 %0, %8\n\tds_read_b64_tr_b16 %1, %8 offset:1152\n\t"
                         "ds_read_b64_tr_b16 %2, %8 offset:2304\n\tds_read_b64_tr_b16 %3, %8 offset:3456\n\t"
                         "ds_read_b64_tr_b16 %4, %8 offset:64\n\tds_read_b64_tr_b16 %5, %8 offset:1216\n\t"
                         "ds_read_b64_tr_b16 %6, %8 offset:2368\n\tds_read_b64_tr_b16 %7, %8 offset:3520\n\t"
                         "s_waitcnt lgkmcnt(0)"
                         : "=&v"(t00l), "=&v"(t00h), "=&v"(t01l), "=&v"(t01h), "=&v"(t10l), "=&v"(t10h), "=&v"(t11l), "=&v"(t11h) : "v"(tr_addr) : "memory");
            const bf16x8 a00 = __builtin_shufflevector(t00l, t00h, 0, 1, 2, 3, 4, 5, 6, 7), a01 = __builtin_shufflevector(t01l, t01h, 0, 1, 2, 3, 4, 5, 6, 7);
            const bf16x8 a10 = __builtin_shufflevector(t10l, t10h, 0, 1, 2, 3, 4, 5, 6, 7), a11 = __builtin_shufflevector(t11l, t11h, 0, 1, 2, 3, 4, 5, 6, 7);
            O0 = MFMA32(a00, pb0, O0); O1 = MFMA32(a10, pb0, O1);
            O0 = MFMA32(a01, pb1, O0); O1 = MFMA32(a11, pb1, O1);
            asm volatile("" ::: "memory");
        }
#undef ATT_LOAD
        l += SHX(l, 32);
        const int ql = (((cq0 + r) << sft) + rr) - 512 * sp;
        unsigned char* orow = OL + ql * 144 + 8 * h;
        float ao = 0.f, ap = 1.0f;
        if (di > 0) {
            const f32x2 mo = *(const f32x2*)(MLl + 2 * ql);
            const float mn = fmaxf(mo[0], m);
            ao = __builtin_amdgcn_exp2f(mo[0] - mn); ap = __builtin_amdgcn_exp2f(m - mn);
            l = ao * mo[1] + ap * l; m = mn;
        }
#pragma unroll
        for (int g = 0; g < 4; ++g) {
            f32x4 v0 = {O0[4 * g] * ap, O0[4 * g + 1] * ap, O0[4 * g + 2] * ap, O0[4 * g + 3] * ap}, v1 = {O1[4 * g] * ap, O1[4 * g + 1] * ap, O1[4 * g + 2] * ap, O1[4 * g + 3] * ap};
            if (di > 0) {
                const u32x2 o0 = *(const u32x2*)(orow + 16 * g), o1 = *(const u32x2*)(orow + 64 + 16 * g);
                v0[0] += ao * bflo(o0.x); v0[1] += ao * bfhi(o0.x); v0[2] += ao * bflo(o0.y); v0[3] += ao * bfhi(o0.y);
                v1[0] += ao * bflo(o1.x); v1[1] += ao * bfhi(o1.x); v1[2] += ao * bflo(o1.y); v1[3] += ao * bfhi(o1.y);
            }
            u32x2 p0, p1; p0.x = pack2(v0[0], v0[1]); p0.y = pack2(v0[2], v0[3]); p1.x = pack2(v1[0], v1[1]); p1.y = pack2(v1[2], v1[3]);
            *(u32x2*)(orow + 16 * g) = p0; *(u32x2*)(orow + 64 + 16 * g) = p1;
        }
        if (h == 0) { f32x2 ml; ml[0] = m; ml[1] = l; *(f32x2*)(MLl + 2 * ql) = ml; }
       }
       __syncthreads();
      }
      {
        const int ql = tid0;
        const float inv = __builtin_amdgcn_rcpf(MLl[2 * ql + 1]);
        float o[64]; float ss = 0.f;
#pragma unroll
        for (int c = 0; c < 8; ++c) {
            const u32x4 w4 = *(const u32x4*)(OL + ql * 144 + 16 * c);
#pragma unroll
            for (int i = 0; i < 4; ++i) { o[8 * c + 2 * i] = bflo(w4[i]) * inv; o[8 * c + 2 * i + 1] = bfhi(w4[i]) * inv; ss += o[8 * c + 2 * i] * o[8 * c + 2 * i] + o[8 * c + 2 * i + 1] * o[8 * c + 2 * i + 1]; }
        }
        const float rn = rsqrtf(ss * (1.0f / 64.0f) + 1e-6f);
        const float* gp = a.att_norm_g + layer * 512 + hd * 64;
        bf16_t* dst = mix + (tb + 512 * sp + ql) * 1024 + hd * 64;
#pragma unroll
        for (int c = 0; c < 8; ++c) {
            const f32x4 g0 = *(const f32x4*)(gp + 8 * c), g1 = *(const f32x4*)(gp + 8 * c + 4);
            u32x4 w4; w4.x = pack2(o[8 * c] * rn * g0[0], o[8 * c + 1] * rn * g0[1]); w4.y = pack2(o[8 * c + 2] * rn * g0[2], o[8 * c + 3] * rn * g0[3]);
            w4.z = pack2(o[8 * c + 4] * rn * g1[0], o[8 * c + 5] * rn * g1[1]); w4.w = pack2(o[8 * c + 6] * rn * g1[2], o[8 * c + 7] * rn * g1[3]);
            *(u32x4*)(dst + 8 * c) = w4;
        }
      }
    }
}

DEV float tanh_fast(float x) { return 1.0f - 2.0f * __builtin_amdgcn_rcpf(1.0f + __expf(2.0f * x)); }

DEV void ph_rwkv_prep1(const Args& a, int layer, unsigned char* ldsb, const int tid0) {
    const int lane = tid0 & 63, wv = __builtin_amdgcn_readfirstlane(tid0 >> 6), r = lane & 31, h = lane >> 5;
    const int gw = blockIdx.x * 8 + wv, nw = gridDim.x * 8;
    const int sub = wv & 1, ng = wv >> 1;
    const bf16_t* U = wsb(a, U_OFF);
    const float* sw = a.rwkv_shift + (size_t)layer * 3 * UC;
    const bf16_t* wl = wsb(a, WB_OFF + (size_t)layer * WB_LAYER + WB_LORA);
#pragma unroll 1
    for (int arr = 0; arr < 5; ++arr) {
        const int coff = (arr < 4) ? arr * 64 : 256, nk = (arr < 4) ? 4 : 8, kw = nk * 16, rsb = kw * 2 + 16;
        __syncthreads();
        {
            const bf16_t* wsrc = wl + (arr < 4 ? arr * 512 * 64 : 4 * 512 * 64);
            const int cpr = kw / 8;
            for (int i = tid0; i < 512 * cpr; i += NTHR) { const int row = i / cpr, c = i - row * cpr; *(u32x4*)(ldsb + row * rsb + c * 16) = *(const u32x4*)(wsrc + (size_t)row * kw + c * 8); }
        }
        __syncthreads();
        bf16_t* outb = wsb(a, arr == 0 ? WF_OFF : arr == 1 ? WB2_OFF : arr == 2 ? AF_OFF : arr == 3 ? AB_OFF : G_OFF);
        const float* bias = (arr < 2) ? a.rwkv_w0 + (layer * 2 + arr) * 512 : a.rwkv_a0 + (layer * 2 + (arr & 1)) * 512;
        f32x4 bvr[4][4];
#pragma unroll
        for (int q = 0; q < 4; ++q)
#pragma unroll
            for (int g = 0; g < 4; ++g) bvr[q][g] = *(const f32x4*)(bias + (ng * 4 + q) * 32 + 8 * g + 4 * h);
#pragma unroll 1
        for (int tile = blockIdx.x; tile < T / 64; tile += gridDim.x) {
            const int t = tile * 64 + sub * 32 + r, pos = t & 4095;
            const bool hp = pos > 0, hn = pos < 4095;
            const bf16_t* up = U + (size_t)t * UW + 1536 + 8 * h;
            bf16x8 xf[8];
#pragma unroll
            for (int s = 0; s < 8; ++s) {
                if (s < nk) {
                    const int col = coff + 16 * s;
                    const u32x4 c = *(const u32x4*)(up + col);
                    u32x4 p = {0u, 0u, 0u, 0u}, n = {0u, 0u, 0u, 0u};
                    if (hp) p = *(const u32x4*)(up - UW + col);
                    if (hn) n = *(const u32x4*)(up + UW + col);
                    const float* s0 = sw + 1536 + 8 * h + col;
                    const f32x4 wp0 = *(const f32x4*)(s0), wp1 = *(const f32x4*)(s0 + 4), wc0 = *(const f32x4*)(s0 + UC), wc1 = *(const f32x4*)(s0 + UC + 4), wn0 = *(const f32x4*)(s0 + 2 * UC), wn1 = *(const f32x4*)(s0 + 2 * UC + 4);
                    float v[8];
#pragma unroll
                    for (int i = 0; i < 4; ++i) {
                        const float a0 = (i < 2) ? wp0[2 * i] : wp1[2 * i - 4], a1 = (i < 2) ? wp0[2 * i + 1] : wp1[2 * i - 3];
                        const float b0 = (i < 2) ? wc0[2 * i] : wc1[2 * i - 4], b1 = (i < 2) ? wc0[2 * i + 1] : wc1[2 * i - 3];
                        const float c0 = (i < 2) ? wn0[2 * i] : wn1[2 * i - 4], c1 = (i < 2) ? wn0[2 * i + 1] : wn1[2 * i - 3];
                        v[2 * i] = a0 * bflo(p[i]) + b0 * bflo(c[i]) + c0 * bflo(n[i]);
                        v[2 * i + 1] = a1 * bfhi(p[i]) + b1 * bfhi(c[i]) + c1 * bfhi(n[i]);
                    }
                    if (arr < 2) {
#pragma unroll
                        for (int i = 0; i < 8; ++i) v[i] = tanh_fast(v[i]);
                    } else if (arr == 4) {
#pragma unroll
                        for (int i = 0; i < 8; ++i) v[i] = sigmoidf_(v[i]);
                    }
                    xf[s] = pack_frag(v[0], v[1], v[2], v[3], v[4], v[5], v[6], v[7]);
                }
            }
            bf16_t* out = outb + (size_t)t * 512 + 4 * h;
#pragma unroll
            for (int q = 0; q < 4; ++q) {
                const int nt = ng * 4 + q;
                f32x16 C;
#pragma unroll
                for (int i = 0; i < 16; ++i) C[i] = 0.f;
                const unsigned char* wr = ldsb + (nt * 32 + r) * rsb + 16 * h;
#pragma unroll
                for (int s = 0; s < 8; ++s) if (s < nk) { const bf16x8 A = *(const bf16x8*)(wr + 32 * s); C = MFMA32(A, xf[s], C); }
#pragma unroll
                for (int g = 0; g < 4; ++g) {
                    float o[4];
                    if (arr < 4) {
                        const f32x4 bv = bvr[q][g];
#pragma unroll
                        for (int j = 0; j < 4; ++j) { const float sg = sigmoidf_(C[4 * g + j] + bv[j]); o[j] = (arr < 2) ? __expf(-0.60653066f * sg) : sg; }
                    } else {
#pragma unroll
                        for (int j = 0; j < 4; ++j) o[j] = C[4 * g + j];
                    }
                    u32x2 pk; pk.x = pack2(o[0], o[1]); pk.y = pack2(o[2], o[3]);
                    *(u32x2*)(out + nt * 32 + 8 * g) = pk;
                }
            }
        }
    }
    {
        const int c16 = 16 * lane;
        bf16_t* dst = wsb(a, lane < 32 ? RS_OFF : KS_OFF) + (c16 & 511);
        float swp[16], swc[16], swn[16];
#pragma unroll
        for (int i = 0; i < 16; ++i) { swp[i] = sw[c16 + i]; swc[i] = sw[UC + c16 + i]; swn[i] = sw[2 * UC + c16 + i]; }
        for (int t0 = gw; t0 < T; t0 += 2 * nw) {
            u32x4 c[2][2], p[2][2], n[2][2];
#pragma unroll
            for (int k = 0; k < 2; ++k) {
                const int t = t0 + k * nw; const int pos = t & 4095; const bool hp = pos > 0, hn = pos < 4095;
                const bf16_t* up = U + (size_t)t * UW + c16;
#pragma unroll
                for (int q = 0; q < 2; ++q) {
                    c[k][q] = *(const u32x4*)(up + 8 * q); p[k][q] = (u32x4){0u, 0u, 0u, 0u}; n[k][q] = (u32x4){0u, 0u, 0u, 0u};
                    if (hp) p[k][q] = *(const u32x4*)(up - UW + 8 * q);
                    if (hn) n[k][q] = *(const u32x4*)(up + UW + 8 * q);
                }
            }
#pragma unroll
            for (int k = 0; k < 2; ++k) {
                const int t = t0 + k * nw;
                u32x4 o[2];
#pragma unroll
                for (int q = 0; q < 2; ++q)
#pragma unroll
                    for (int i = 0; i < 4; ++i) {
                        const int e = 8 * q + 2 * i;
                        const float lo = swp[e] * bflo(p[k][q][i]) + swc[e] * bflo(c[k][q][i]) + swn[e] * bflo(n[k][q][i]);
                        const float hi = swp[e + 1] * bfhi(p[k][q][i]) + swc[e + 1] * bfhi(c[k][q][i]) + swn[e + 1] * bfhi(n[k][q][i]);
                        o[q][i] = pack2(lo, hi);
                    }
                *(u32x4*)(dst + (size_t)t * 512) = o[0]; *(u32x4*)(dst + (size_t)t * 512 + 8) = o[1];
            }
        }
    }
}
DEV void ph_rwkv_prep2(const Args& a, int layer, const int tid0) {
    const int lane = tid0 & 63, wv = tid0 >> 6;
    const int gw = blockIdx.x * 8 + wv, nw = gridDim.x * 8;
    bf16_t* U = wsb(a, U_OFF); const bf16_t* KS = wsb(a, KS_OFF);
    const float* sw = a.rwkv_shift + (size_t)layer * 3 * UC;
    const int c8 = 8 * lane;
    float kkc[8], sv[3][8];
#pragma unroll
    for (int i = 0; i < 8; ++i) { kkc[i] = a.rwkv_k_k[layer * 512 + c8 + i]; sv[0][i] = sw[1024 + c8 + i]; sv[1][i] = sw[UC + 1024 + c8 + i]; sv[2][i] = sw[2 * UC + 1024 + c8 + i]; }
    for (int t = gw; t < T; t += nw) {
        const int pos = t & 4095; const bool hp = pos > 0, hn = pos < 4095;
        bf16_t* up = U + (size_t)t * UW;
        const u32x4 ks = *(const u32x4*)(KS + (size_t)t * 512 + c8);
        const u32x4 c = *(const u32x4*)(up + 1024 + c8);
        u32x4 p = {0u, 0u, 0u, 0u}, n = {0u, 0u, 0u, 0u};
        if (hp) p = *(const u32x4*)(up - UW + 1024 + c8);
        if (hn) n = *(const u32x4*)(up + UW + 1024 + c8);
        float kx[8]; float ss = 0.f;
#pragma unroll
        for (int i = 0; i < 4; ++i) { kx[2 * i] = bflo(ks[i]) * kkc[2 * i]; kx[2 * i + 1] = bfhi(ks[i]) * kkc[2 * i + 1]; ss += kx[2 * i] * kx[2 * i] + kx[2 * i + 1] * kx[2 * i + 1]; }
        const float inv = 1.0f / fmaxf(sqrtf(sum8(ss)), 1e-12f);
        u32x4 ko, vo;
#pragma unroll
        for (int i = 0; i < 4; ++i) {
            ko[i] = pack2(kx[2 * i] * inv, kx[2 * i + 1] * inv);
            vo[i] = pack2(sv[0][2 * i] * bflo(p[i]) + sv[1][2 * i] * bflo(c[i]) + sv[2][2 * i] * bflo(n[i]), sv[0][2 * i + 1] * bfhi(p[i]) + sv[1][2 * i + 1] * bfhi(c[i]) + sv[2][2 * i + 1] * bfhi(n[i]));
        }
        *(u32x4*)(up + c8) = ko; *(u32x4*)(up + 1536 + c8) = vo;
    }
}

DEV void ph_post2(const Args& a, int layer, const int tid0) {
    const int lane = tid0 & 63, wv = tid0 >> 6;
    const int gw = blockIdx.x * 8 + wv, nw = gridDim.x * 8;
    const bf16_t* U = wsb(a, U_OFF); const bf16_t* RS = wsb(a, RS_OFF); const bf16_t* KS = wsb(a, KS_OFF); const bf16_t* G = wsb(a, G_OFF);
    const bf16_t* AF = wsb(a, AF_OFF); const bf16_t* AB = wsb(a, AB_OFF); bf16_t* mix = wsb(a, MIX_OFF);
    const int c8 = 8 * lane;
    float kac[8], rkc[8], lnw[8], lnb[8];
#pragma unroll
    for (int i = 0; i < 8; ++i) { kac[i] = a.rwkv_k_a[layer * 512 + c8 + i]; rkc[i] = a.rwkv_r_k[layer * 512 + c8 + i]; lnw[i] = a.rwkv_ln_w[layer * 512 + c8 + i]; lnb[i] = a.rwkv_ln_b[layer * 512 + c8 + i]; }
    struct PostLd { u32x4 rp, kp, gp, afp, abp, yfp, ybp, vp; };
    for (int t0 = gw; t0 < T; t0 += 2 * nw) {
        PostLd L[2];
#pragma unroll
        for (int k = 0; k < 2; ++k) {
            const int t = t0 + k * nw; const bf16_t* up = U + (size_t)t * UW;
            L[k].rp = *(const u32x4*)(RS + (size_t)t * 512 + c8); L[k].kp = *(const u32x4*)(KS + (size_t)t * 512 + c8); L[k].gp = *(const u32x4*)(G + (size_t)t * 512 + c8);
            L[k].afp = *(const u32x4*)(AF + (size_t)t * 512 + c8); L[k].abp = *(const u32x4*)(AB + (size_t)t * 512 + c8);
            L[k].yfp = *(const u32x4*)(up + 512 + c8); L[k].ybp = *(const u32x4*)(up + 1024 + c8); L[k].vp = *(const u32x4*)(up + 1536 + c8);
        }
#pragma unroll
        for (int k = 0; k < 2; ++k) {
        const int t = t0 + k * nw;
        const u32x4 rp = L[k].rp, kp = L[k].kp, gp = L[k].gp, afp = L[k].afp, abp = L[k].abp, yfp = L[k].yfp, ybp = L[k].ybp, vp = L[k].vp;
        float y[8], rr[8], kk[8], vv[8], gg[8], sa[8];
#pragma unroll
        for (int i = 0; i < 4; ++i) {
            y[2 * i] = bflo(yfp[i]) + bflo(ybp[i]); y[2 * i + 1] = bfhi(yfp[i]) + bfhi(ybp[i]);
            rr[2 * i] = bflo(rp[i]); rr[2 * i + 1] = bfhi(rp[i]); kk[2 * i] = bflo(kp[i]); kk[2 * i + 1] = bfhi(kp[i]);
            vv[2 * i] = bflo(vp[i]); vv[2 * i + 1] = bfhi(vp[i]); gg[2 * i] = bflo(gp[i]); gg[2 * i + 1] = bfhi(gp[i]);
            sa[2 * i] = bflo(afp[i]) + bflo(abp[i]); sa[2 * i + 1] = bfhi(afp[i]) + bfhi(abp[i]);
        }
        float ysum = 0.f, bs = 0.f;
#pragma unroll
        for (int i = 0; i < 8; ++i) { ysum += y[i]; bs += rr[i] * kk[i] * (2.0f + (sa[i] - 2.0f) * kac[i]) * rkc[i]; }
        const float mu = sum8(ysum) * (1.0f / 64.0f);
        float vs = 0.f;
#pragma unroll
        for (int i = 0; i < 8; ++i) { y[i] -= mu; vs += y[i] * y[i]; }
        const float rstdv = rsqrtf(sum8(vs) * (1.0f / 64.0f) + 64e-5f);
        bs = sum8(bs);
        float o[8];
#pragma unroll
        for (int i = 0; i < 8; ++i) o[i] = (y[i] * rstdv * lnw[i] + lnb[i] + bs * vv[i]) * gg[i];
        u32x4 ov; ov.x = pack2(o[0], o[1]); ov.y = pack2(o[2], o[3]); ov.z = pack2(o[4], o[5]); ov.w = pack2(o[6], o[7]);
        *(u32x4*)(mix + (size_t)t * 1024 + 512 + c8) = ov;
        }
    }
}

#ifdef PROBE_EMASK
#define PEER_EM(e) (DRY ? ((e) & PROBE_EMASK) : (e))
#else
#define PEER_EM(e) (e)
#endif
template <bool DRY> DEV void ph_peer_pipe(const Args& a, const int tid0, const int gw, const int nw, const int ntok, const int* TOPI, const float* TOPG, const int tbase) {
    const int lane = tid0 & 63;
    bf16_t* hb = wsb(a, HB_OFF); float* rstd = wsf(a, RSTD_OFF); const float* ssq = wsf(a, SSQ_OFF);
    const unsigned char* PU = a.ws + PTU_OFF; const unsigned char* PV = a.ws + PTV_OFF;
    const int c16 = 16 * lane;
    const bool b5 = lane & 32, b4 = lane & 16, b3 = lane & 8;
    const bool dost = DRY ? (__builtin_amdgcn_readfirstlane(*(const int*)(a.ws + TOPI_OFF)) == -12345) : true;
    u32x4 ur[2][8], vr[8];
    int e0, e1, e0n = 0, e1n = 0; float g0, g1, g0n = 0.f, g1n = 0.f;
    u32x4 xa, xb, xan = {0u, 0u, 0u, 0u}, xbn = {0u, 0u, 0u, 0u}; float rsv, rsn = 0.f;
#define PEER_ISSUE_U(slot_, b_, es0_, es1_) do { _Pragma("unroll") for (int i_ = 0; i_ < 8; ++i_) { const int k_ = (b_) * 8 + i_; \
        const int e_ = PEER_EM(__builtin_amdgcn_readlane((k_ < 64) ? (es0_) : (es1_), k_ & 63)); ur[slot_][i_] = *(const u32x4*)(PU + (size_t)e_ * 1024 + c16); } } while (0)
#define PEER_ISSUE_V(slot_, b_, es0_, es1_) do { _Pragma("unroll") for (int i_ = 0; i_ < 8; ++i_) { const int k_ = (b_) * 8 + i_; \
        const int e_ = PEER_EM(__builtin_amdgcn_readlane((k_ < 64) ? (es0_) : (es1_), k_ & 63)); vr[i_] = *(const u32x4*)(PV + (size_t)e_ * 1024 + c16); } } while (0)
    if (ntok <= 0) return;
    {   const int t0 = gw;
        e0 = TOPI[(t0 - tbase) * 128 + lane]; e1 = TOPI[(t0 - tbase) * 128 + 64 + lane]; g0 = TOPG[(t0 - tbase) * 128 + lane]; g1 = TOPG[(t0 - tbase) * 128 + 64 + lane];
        xa = *(const u32x4*)(hb + (size_t)t0 * 1024 + c16); xb = *(const u32x4*)(hb + (size_t)t0 * 1024 + c16 + 8); rsv = rstd_parts(ssq, t0); }
    PEER_ISSUE_U(0, 0, e0, e1);
#pragma unroll 1
    for (int j = 0; j < ntok; ++j) {
        const int t = gw + nw * j; const bool more = (j + 1 < ntok);
        float* hr = a.h + (size_t)t * 1024 + c16;
        if (more) { const int tn = t + nw;
            e0n = TOPI[(tn - tbase) * 128 + lane]; e1n = TOPI[(tn - tbase) * 128 + 64 + lane]; }
        const float rs = rsv * (1.0f / 256.0f);
        float out[16];
#pragma unroll
        for (int i = 0; i < 16; ++i) out[i] = 0.f;
#pragma unroll 1
        for (int b2 = 0; b2 < 16; b2 += 2)
#pragma unroll
        for (int bb = 0; bb < 2; ++bb) {
            const int b = b2 + bb;
            PEER_ISSUE_V(0, b, e0, e1);
            if (bb == 0) PEER_ISSUE_U(1, b + 1, e0, e1);
            else if (b < 15) PEER_ISSUE_U(0, b + 1, e0, e1);
            else if (more) PEER_ISSUE_U(0, 0, e0n, e1n);
            asm volatile("" ::: "memory");
            float d[8];
#pragma unroll
            for (int i = 0; i < 8; ++i) {
                float sm = 0.f;
#pragma unroll
                for (int q = 0; q < 4; ++q) {
                    const unsigned uw = ur[bb][i][q];
                    const f32x2 lo = __builtin_amdgcn_cvt_pk_f32_fp8((int)uw, false), hi = __builtin_amdgcn_cvt_pk_f32_fp8((int)uw, true);
                    const unsigned ulo = pack2(lo[0], lo[1]), uhi = pack2(hi[0], hi[1]);
                    const unsigned xlo = (q < 2) ? xa[2 * q] : xb[2 * q - 4], xhi = (q < 2) ? xa[2 * q + 1] : xb[2 * q - 3];
                    sm = dot2bf(ulo, xlo, sm); sm = dot2bf(uhi, xhi, sm);
                }
                d[i] = sm;
            }
            float r4[4], r2[2];
#pragma unroll
            for (int i = 0; i < 4; ++i) { const float send = b5 ? d[i] : d[4 + i], keep = b5 ? d[4 + i] : d[i]; r4[i] = keep + SHX(send, 32); }
#pragma unroll
            for (int i = 0; i < 2; ++i) { const float send = b4 ? r4[i] : r4[2 + i], keep = b4 ? r4[2 + i] : r4[i]; r2[i] = keep + SHX(send, 16); }
            const float send1 = b3 ? r2[0] : r2[1], keep1 = b3 ? r2[1] : r2[0];
            const float dd = sum8(keep1 + SHX(send1, 8));
            const float hp = rs * dd;
            const float gt = SHF((b < 8) ? g0 : g1, (b * 8 + (lane >> 3)) & 63);
            const float w = gt * 0.5f * hp * (1.0f + erff(hp * 0.70710678f)) * (1.0f / 32.0f);
#pragma unroll
            for (int i = 0; i < 8; ++i) {
                const float wi = rl(w, 8 * i);
#pragma unroll
                for (int q = 0; q < 4; ++q) {
                    const unsigned vw = vr[i][q];
                    const f32x2 lo = __builtin_amdgcn_cvt_pk_f32_fp8((int)vw, false), hi = __builtin_amdgcn_cvt_pk_f32_fp8((int)vw, true);
                    out[4 * q] += wi * lo[0]; out[4 * q + 1] += wi * lo[1]; out[4 * q + 2] += wi * hi[0]; out[4 * q + 3] += wi * hi[1];
                }
            }
        }
        if (more) { const int tn = t + nw;
            g0n = TOPG[(tn - tbase) * 128 + lane]; g1n = TOPG[(tn - tbase) * 128 + 64 + lane];
            xan = *(const u32x4*)(hb + (size_t)tn * 1024 + c16); xbn = *(const u32x4*)(hb + (size_t)tn * 1024 + c16 + 8); rsn = rstd_parts(ssq, tn); }
        float ss = 0.f;
        f32x4 hv[4];
#pragma unroll
        for (int q = 0; q < 4; ++q) hv[q] = *(const f32x4*)(hr + 4 * q);
#pragma unroll
        for (int q = 0; q < 4; ++q) {
#pragma unroll
            for (int c = 0; c < 4; ++c) { hv[q][c] += out[4 * q + c]; ss += hv[q][c] * hv[q][c]; }
            if (dost) *(f32x4*)(hr + 4 * q) = hv[q];
        }
        ss = wave_sum(ss);
        if (dost) {
            u32x4 p0, p1;
            p0.x = pack2(hv[0][0], hv[0][1]); p0.y = pack2(hv[0][2], hv[0][3]); p0.z = pack2(hv[1][0], hv[1][1]); p0.w = pack2(hv[1][2], hv[1][3]);
            p1.x = pack2(hv[2][0], hv[2][1]); p1.y = pack2(hv[2][2], hv[2][3]); p1.z = pack2(hv[3][0], hv[3][1]); p1.w = pack2(hv[3][2], hv[3][3]);
            *(u32x4*)(hb + (size_t)t * 1024 + c16) = p0; *(u32x4*)(hb + (size_t)t * 1024 + c16 + 8) = p1;
            if (lane == 0) rstd[t] = rsqrtf(ss * (1.0f / 1024.0f) + 1e-6f);
        }
        e0 = e0n; e1 = e1n; g0 = g0n; g1 = g1n; xa = xan; xb = xbn; rsv = rsn;
    }
#undef PEER_ISSUE_U
#undef PEER_ISSUE_V
}


#if PEER_FP4
DEV void ph_peer_pipe4(const Args& a, const int tid0, const int gw, const int nw, const int ntok, const int* TOPI, const float* TOPG, const int tbase) {
    const int lane = tid0 & 63;
    bf16_t* hb = wsb(a, HB_OFF); float* rstd = wsf(a, RSTD_OFF); const float* ssq = wsf(a, SSQ_OFF);
    const unsigned char* PU = a.ws + PTU_OFF; const unsigned char* PV = a.ws + PTV_OFF;
    const int c16 = 16 * lane, c8 = 8 * lane;
    const bool b5 = lane & 32, b4 = lane & 16, b3 = lane & 8;
    u32x2 ur[2][16], vr[16];
    int e0, e1, e0n = 0, e1n = 0; float g0, g1, g0n = 0.f, g1n = 0.f;
    u32x4 xa, xb, xan = {0u, 0u, 0u, 0u}, xbn = {0u, 0u, 0u, 0u}; float rsv, rsn = 0.f;
#define PEER_ISSUE_U(slot_, b_, es0_, es1_) do { _Pragma("unroll") for (int i_ = 0; i_ < 16; ++i_) { const int k_ = (b_) * 16 + i_; \
        const int e_ = __builtin_amdgcn_readlane((k_ < 64) ? (es0_) : (es1_), k_ & 63); ur[slot_][i_] = *(const u32x2*)(PU + (size_t)e_ * 512 + c8); } } while (0)
#define PEER_ISSUE_V(b_, es0_, es1_) do { _Pragma("unroll") for (int i_ = 0; i_ < 16; ++i_) { const int k_ = (b_) * 16 + i_; \
        const int e_ = __builtin_amdgcn_readlane((k_ < 64) ? (es0_) : (es1_), k_ & 63); vr[i_] = *(const u32x2*)(PV + (size_t)e_ * 512 + c8); } } while (0)
    if (ntok <= 0) return;
    {   const int t0 = gw;
        e0 = TOPI[(t0 - tbase) * 128 + lane]; e1 = TOPI[(t0 - tbase) * 128 + 64 + lane]; g0 = TOPG[(t0 - tbase) * 128 + lane]; g1 = TOPG[(t0 - tbase) * 128 + 64 + lane];
        xa = *(const u32x4*)(hb + (size_t)t0 * 1024 + c16); xb = *(const u32x4*)(hb + (size_t)t0 * 1024 + c16 + 8); rsv = rstd_parts(ssq, t0); }
    PEER_ISSUE_U(0, 0, e0, e1);
#pragma unroll 1
    for (int j = 0; j < ntok; ++j) {
        const int t = gw + nw * j; const bool more = (j + 1 < ntok);
        float* hr = a.h + (size_t)t * 1024 + c16;
        if (more) { const int tn = t + nw;
            e0n = TOPI[(tn - tbase) * 128 + lane]; e1n = TOPI[(tn - tbase) * 128 + 64 + lane]; }
        const float rs = rsv * (1.0f / PEER_USC);
        f32x2 out[8];
#pragma unroll
        for (int i = 0; i < 8; ++i) out[i] = (f32x2){0.f, 0.f};
#pragma unroll 1
        for (int b2 = 0; b2 < 8; b2 += 2)
#pragma unroll
        for (int bb = 0; bb < 2; ++bb) {
            const int b = b2 + bb;
            PEER_ISSUE_V(b, e0, e1);
            if (bb == 0) PEER_ISSUE_U(1, b + 1, e0, e1);
            else if (b < 7) PEER_ISSUE_U(0, b + 1, e0, e1);
            else if (more) PEER_ISSUE_U(0, 0, e0n, e1n);
            asm volatile("" ::: "memory");
            float w2[2];
#pragma unroll
            for (int hf = 0; hf < 2; ++hf) {
                float d[8];
#pragma unroll
                for (int i = 0; i < 8; ++i) {
                    float sm = 0.f;
#pragma unroll
                    for (int q = 0; q < 2; ++q) {
                        const unsigned uw = ur[bb][hf * 8 + i][q]; const u32x4 xq = (q == 0) ? xa : xb;
#define PEER_UD(sb_) sm = dot2bf(__builtin_bit_cast(unsigned, __builtin_amdgcn_cvt_scalef32_pk_bf16_fp4(uw, 1.0f, sb_)), xq[sb_], sm)
                        PEER_UD(0); PEER_UD(1); PEER_UD(2); PEER_UD(3);
#undef PEER_UD
                    }
                    d[i] = sm;
                }
                float r4[4], r2[2];
#pragma unroll
                for (int i = 0; i < 4; ++i) { const float send = b5 ? d[i] : d[4 + i], keep = b5 ? d[4 + i] : d[i]; r4[i] = keep + SHX(send, 32); }
#pragma unroll
                for (int i = 0; i < 2; ++i) { const float send = b4 ? r4[i] : r4[2 + i], keep = b4 ? r4[2 + i] : r4[i]; r2[i] = keep + SHX(send, 16); }
                const float send1 = b3 ? r2[0] : r2[1], keep1 = b3 ? r2[1] : r2[0];
                const float dd = sum8(keep1 + SHX(send1, 8));
                const float hp = rs * dd;
                const float gt = SHF((b < 4) ? g0 : g1, (b * 16 + hf * 8 + (lane >> 3)) & 63);
                w2[hf] = gt * 0.5f * hp * (1.0f + erff(hp * 0.70710678f)) * (1.0f / PEER_VSC);
            }
#pragma unroll
            for (int i = 0; i < 16; ++i) {
                const float wi = rl(w2[i >> 3], 8 * (i & 7));
                const f32x2 wv2 = {wi, wi};
#pragma unroll
                for (int q = 0; q < 2; ++q) {
                    const unsigned vw = vr[i][q];
#define PEER_VA(sb_) out[q * 4 + sb_] = __builtin_elementwise_fma(__builtin_amdgcn_cvt_scalef32_pk_f32_fp4(vw, 1.0f, sb_), wv2, out[q * 4 + sb_])
                    PEER_VA(0); PEER_VA(1); PEER_VA(2); PEER_VA(3);
#undef PEER_VA
                }
            }
        }
        if (more) { const int tn = t + nw;
            g0n = TOPG[(tn - tbase) * 128 + lane]; g1n = TOPG[(tn - tbase) * 128 + 64 + lane];
            xan = *(const u32x4*)(hb + (size_t)tn * 1024 + c16); xbn = *(const u32x4*)(hb + (size_t)tn * 1024 + c16 + 8); rsn = rstd_parts(ssq, tn); }
        float ss = 0.f;
        f32x4 hv[4];
#pragma unroll
        for (int q = 0; q < 4; ++q) hv[q] = *(const f32x4*)(hr + 4 * q);
#pragma unroll
        for (int q = 0; q < 4; ++q) {
#pragma unroll
            for (int c = 0; c < 4; ++c) { hv[q][c] += out[2 * q + (c >> 1)][c & 1]; ss += hv[q][c] * hv[q][c]; }
            *(f32x4*)(hr + 4 * q) = hv[q];
        }
        ss = wave_sum(ss);
        {
            u32x4 p0, p1;
            p0.x = pack2(hv[0][0], hv[0][1]); p0.y = pack2(hv[0][2], hv[0][3]); p0.z = pack2(hv[1][0], hv[1][1]); p0.w = pack2(hv[1][2], hv[1][3]);
            p1.x = pack2(hv[2][0], hv[2][1]); p1.y = pack2(hv[2][2], hv[2][3]); p1.z = pack2(hv[3][0], hv[3][1]); p1.w = pack2(hv[3][2], hv[3][3]);
            *(u32x4*)(hb + (size_t)t * 1024 + c16) = p0; *(u32x4*)(hb + (size_t)t * 1024 + c16 + 8) = p1;
            if (lane == 0) rstd[t] = rsqrtf(ss * (1.0f / 1024.0f) + 1e-6f);
        }
        e0 = e0n; e1 = e1n; g0 = g0n; g1 = g1n; xa = xan; xb = xbn; rsv = rsn;
    }
#undef PEER_ISSUE_U
#undef PEER_ISSUE_V
}
#define PEER_PIPE(...) ph_peer_pipe4(__VA_ARGS__)
#else
#define PEER_PIPE(...) ph_peer_pipe<false>(__VA_ARGS__)
#endif


#if PEER_MX
typedef int i32x8 __attribute__((ext_vector_type(8)));
#define MXF(A_, B_, C_) __builtin_amdgcn_mfma_scale_f32_16x16x128_f8f6f4((A_), (B_), (C_), 4, 4, 0, 0x7F7F7F7F, 0, 0x7F7F7F7F)
#define MXFS(A_, B_, C_, SB_) __builtin_amdgcn_mfma_scale_f32_16x16x128_f8f6f4((A_), (B_), (C_), 4, 4, 0, 0x7F7F7F7F, 0, (SB_))
#define MX8(v_) ((i32x8){(int)(v_).x, (int)(v_).y, (int)(v_).z, (int)(v_).w, 0, 0, 0, 0})
namespace mx { constexpr int U0 = 0, VB = 16384, XQ = 49152, WF = 50176, WL = 51200, BASE = 57344; constexpr float XSC = 1.5f; }
DEV int mx_sw(int r) { return ((r & 3) << 2) | (r >> 2); }
#define MX_Q2(d1_, d2_, va_, vb_, sel_) do { d1_ = __builtin_amdgcn_cvt_scalef32_pk_fp4_f32(d1_, (va_), (vb_), 1.0f, sel_); const f32x2 q_ = __builtin_amdgcn_cvt_scalef32_pk_f32_fp4(d1_, 1.0f, sel_); \
        d2_ = __builtin_amdgcn_cvt_scalef32_pk_fp4_f32(d2_, ((va_) - q_[0]) * 8.0f, ((vb_) - q_[1]) * 8.0f, 1.0f, sel_); } while (0)
#define MX_Q3(d1_, d2_, d3_, va_, vb_, sel_) do { d1_ = __builtin_amdgcn_cvt_scalef32_pk_fp4_f32(d1_, (va_), (vb_), 1.0f, sel_); const f32x2 q_ = __builtin_amdgcn_cvt_scalef32_pk_f32_fp4(d1_, 1.0f, sel_); \
        const float ra_ = ((va_) - q_[0]) * 8.0f, rb_ = ((vb_) - q_[1]) * 8.0f; d2_ = __builtin_amdgcn_cvt_scalef32_pk_fp4_f32(d2_, ra_, rb_, 1.0f, sel_); const f32x2 p_ = __builtin_amdgcn_cvt_scalef32_pk_f32_fp4(d2_, 1.0f, sel_); \
        d3_ = __builtin_amdgcn_cvt_scalef32_pk_fp4_f32(d3_, (ra_ - p_[0]) * 8.0f, (rb_ - p_[1]) * 8.0f, 1.0f, sel_); } while (0)
DEV void ph_peer_mx(const Args& a, const int tid0, const int t0, const int tstride, const int ntok, const int* EL, const float* GL, const int tbase, PG8_LAS unsigned char* wl, unsigned char* wg) {
    const int lane = tid0 & 63, r = lane & 15, kq = lane >> 4;
    bf16_t* hb = wsb(a, HB_OFF); float* rstd = wsf(a, RSTD_OFF); const float* ssq = wsf(a, SSQ_OFF);
    const unsigned char* PU = a.ws + PTU_OFF; const unsigned char* PV = a.ws + PTV_OFF;
    const int c16 = 16 * lane;
#pragma unroll 1
    for (int j = 0; j < ntok; ++j) {
        const int t = t0 + tstride * j;
        const int* el = EL + (t - tbase) * 128; const float* gl = GL + (t - tbase) * 128;
        {   const u32x4 xa = *(const u32x4*)(hb + (size_t)t * 1024 + c16), xb = *(const u32x4*)(hb + (size_t)t * 1024 + c16 + 8);
            const float sc = rstd_parts(ssq, t) * mx::XSC;
            u32x2 q1 = {0u, 0u}, q2 = {0u, 0u};
            MX_Q2(q1.x, q2.x, bflo(xa.x) * sc, bfhi(xa.x) * sc, 0); MX_Q2(q1.x, q2.x, bflo(xa.y) * sc, bfhi(xa.y) * sc, 1); MX_Q2(q1.x, q2.x, bflo(xa.z) * sc, bfhi(xa.z) * sc, 2); MX_Q2(q1.x, q2.x, bflo(xa.w) * sc, bfhi(xa.w) * sc, 3);
            MX_Q2(q1.y, q2.y, bflo(xb.x) * sc, bfhi(xb.x) * sc, 0); MX_Q2(q1.y, q2.y, bflo(xb.y) * sc, bfhi(xb.y) * sc, 1); MX_Q2(q1.y, q2.y, bflo(xb.z) * sc, bfhi(xb.z) * sc, 2); MX_Q2(q1.y, q2.y, bflo(xb.w) * sc, bfhi(xb.w) * sc, 3);
            *(u32x2*)(wg + mx::XQ + 8 * lane) = q1; *(u32x2*)(wg + mx::XQ + 512 + 8 * lane) = q2; }
        u32x4 xB1[8], xB2[8];
#pragma unroll
        for (int s = 0; s < 8; ++s) { xB1[s] = *(const u32x4*)(wg + mx::XQ + 64 * s + 16 * kq); xB2[s] = *(const u32x4*)(wg + mx::XQ + 512 + 64 * s + 16 * kq); }
#pragma unroll 1
        for (int g = 0; g < 8; ++g) {
#pragma unroll
            for (int m = 0; m < 8; ++m) {
                const int row = 2 * m + (lane >> 5); const int e = el[16 * g + row];
                const unsigned char* gp = PU + (size_t)e * 512 + (((lane & 31) ^ mx_sw(row)) * 16);
                __builtin_amdgcn_global_load_lds((const unsigned*)gp, (PG8_LAS unsigned*)(wl + mx::U0 + m * 1024), 16, 0, 0);
            }
            asm volatile("s_waitcnt vmcnt(0)" ::: "memory");
            f32x4 acc1 = {0.f, 0.f, 0.f, 0.f}, acc2 = {0.f, 0.f, 0.f, 0.f};
#pragma unroll
            for (int s = 0; s < 8; ++s) {
                const u32x4 a4 = *(const u32x4*)(wg + mx::U0 + r * 512 + (((4 * s + kq) ^ mx_sw(r)) * 16));
                acc1 = MXF(MX8(a4), MX8(xB1[s]), acc1); acc2 = MXF(MX8(a4), MX8(xB2[s]), acc2);
            }
            const f32x4 gt = *(const f32x4*)(gl + 16 * g + 4 * kq);
            f32x4 w;
#pragma unroll
            for (int i2 = 0; i2 < 4; ++i2) { const float hp = (acc1[i2] + 0.125f * acc2[i2]) * (1.0f / (PEER_USC * mx::XSC)); w[i2] = gt[i2] * 0.5f * hp * (1.0f + erff(hp * 0.70710678f)); }
            if (r == 0) *(f32x4*)(wg + mx::WF + (16 * g + 4 * kq) * 4) = w;
            asm volatile("" ::: "memory");
        }
        float wmx = fmaxf(fabsf(*(const float*)(wg + mx::WF + 4 * lane)), fabsf(*(const float*)(wg + mx::WF + 256 + 4 * lane)));
        wmx = wave_max(wmx);
        const float wS = (wmx > 0.f) ? 4.0f * __builtin_amdgcn_rcpf(wmx) : 0.f, wIS = wmx * 0.25f * (1.0f / PEER_VSC);
        u32x4 wB1 = {0u, 0u, 0u, 0u}, wB2 = wB1, wB3 = wB1;
#pragma unroll
        for (int q = 0; q < 4; ++q) {
            const f32x4 w0 = *(const f32x4*)(wg + mx::WF + 128 * kq + 32 * q), w1 = *(const f32x4*)(wg + mx::WF + 128 * kq + 32 * q + 16);
            MX_Q3(wB1[q], wB2[q], wB3[q], w0[0] * wS, w0[1] * wS, 0); MX_Q3(wB1[q], wB2[q], wB3[q], w0[2] * wS, w0[3] * wS, 1);
            MX_Q3(wB1[q], wB2[q], wB3[q], w1[0] * wS, w1[1] * wS, 2); MX_Q3(wB1[q], wB2[q], wB3[q], w1[2] * wS, w1[3] * wS, 3);
        }
        float ss = 0.f;
#if !PEER_MXV
        {   f32x2 out[8];
#pragma unroll
            for (int i2 = 0; i2 < 8; ++i2) out[i2] = (f32x2){0.f, 0.f};
#pragma unroll 1
            for (int k = 0; k < 128; ++k) {
                const int e = el[k]; const u32x2 vw2 = *(const u32x2*)(PV + (size_t)e * 512 + 8 * lane);
                const float wi = *(const float*)(wg + mx::WF + 4 * k) * (1.0f / PEER_VSC); const f32x2 wv2 = {wi, wi};
#define PEER_VA(q_, sb_) out[q_ * 4 + sb_] = __builtin_elementwise_fma(__builtin_amdgcn_cvt_scalef32_pk_f32_fp4(vw2[q_], 1.0f, sb_), wv2, out[q_ * 4 + sb_])
                PEER_VA(0, 0); PEER_VA(0, 1); PEER_VA(0, 2); PEER_VA(0, 3); PEER_VA(1, 0); PEER_VA(1, 1); PEER_VA(1, 2); PEER_VA(1, 3);
#undef PEER_VA
            }
            float* hr = a.h + (size_t)t * 1024 + c16;
            f32x4 hv[4];
#pragma unroll
            for (int q = 0; q < 4; ++q) hv[q] = *(const f32x4*)(hr + 4 * q);
#pragma unroll
            for (int q = 0; q < 4; ++q) {
#pragma unroll
                for (int c = 0; c < 4; ++c) { hv[q][c] += out[2 * q + (c >> 1)][c & 1]; ss += hv[q][c] * hv[q][c]; }
                *(f32x4*)(hr + 4 * q) = hv[q];
            }
            u32x4 p0, p1;
            p0.x = pack2(hv[0][0], hv[0][1]); p0.y = pack2(hv[0][2], hv[0][3]); p0.z = pack2(hv[1][0], hv[1][1]); p0.w = pack2(hv[1][2], hv[1][3]);
            p1.x = pack2(hv[2][0], hv[2][1]); p1.y = pack2(hv[2][2], hv[2][3]); p1.z = pack2(hv[3][0], hv[3][1]); p1.w = pack2(hv[3][2], hv[3][3]);
            *(u32x4*)(hb + (size_t)t * 1024 + c16) = p0; *(u32x4*)(hb + (size_t)t * 1024 + c16 + 8) = p1;
        }
#else
#pragma unroll 1
        for (int hf = 0; hf < 2; ++hf) {
#pragma unroll 1
            for (int m4 = 0; m4 < 32; m4 += 4)
#pragma unroll
            for (int mm = 0; mm < 4; ++mm) {
                const int m = m4 + mm;
                const int ei = 4 * m + (lane >> 4); const int e = el[ei];
                const unsigned char* gp = PV + (size_t)e * 512 + ((hf * 16 + ((lane & 15) ^ (ei & 15))) * 16);
                __builtin_amdgcn_global_load_lds((const unsigned*)gp, (PG8_LAS unsigned*)(wl + mx::VB + m * 1024), 16, 0, 0);
            }
            asm volatile("s_waitcnt vmcnt(0)" ::: "memory");
#pragma unroll 1
            for (int cg = 0; cg < 2; ++cg) {
                f32x4 keep = {0.f, 0.f, 0.f, 0.f};
#pragma unroll
                for (int cb16 = 0; cb16 < 16; ++cb16) {
                    const int cb = cg * 16 + cb16;
                    const unsigned ad = (unsigned)(size_t)(wg + mx::VB) + (32 * kq + r) * 256 + (((cb >> 1) ^ r) * 16) + (cb & 1) * 8;
                    u32x2 lo, hi;
                    asm volatile("ds_read_b64_tr_b4 %0, %2\n\tds_read_b64_tr_b4 %1, %2 offset:4096\n\ts_waitcnt lgkmcnt(0)" : "=&v"(lo), "=&v"(hi) : "v"(ad) : "memory");
                    const i32x8 A8 = {(int)lo.x, (int)lo.y, (int)hi.x, (int)hi.y, 0, 0, 0, 0};
                    const f32x4 z = {0.f, 0.f, 0.f, 0.f};
                    const f32x4 d1 = MXF(A8, MX8(wB1), z), d2 = MXF(A8, MX8(wB2), z), d3 = MXF(A8, MX8(wB3), z);
                    const bool mine = (r == cb16);
#pragma unroll
                    for (int i2 = 0; i2 < 4; ++i2) keep[i2] = mine ? (d1[i2] + 0.125f * (d2[i2] + 0.125f * d3[i2])) : keep[i2];
                }
                const int c0 = hf * 512 + cg * 256 + 16 * r + 4 * kq;
                float* hr = a.h + (size_t)t * 1024 + c0;
                f32x4 hv = *(const f32x4*)hr;
#pragma unroll
                for (int i2 = 0; i2 < 4; ++i2) { hv[i2] += keep[i2] * wIS; ss += hv[i2] * hv[i2]; }
                *(f32x4*)hr = hv;
                u32x2 pk; pk.x = pack2(hv[0], hv[1]); pk.y = pack2(hv[2], hv[3]);
                *(u32x2*)(hb + (size_t)t * 1024 + c0) = pk;
            }
            asm volatile("" ::: "memory");
        }
#endif
        ss = wave_sum(ss);
        if (lane == 0) rstd[t] = rsqrtf(ss * (1.0f / 1024.0f) + 1e-6f);
        asm volatile("s_waitcnt vmcnt(0) lgkmcnt(0)" ::: "memory");
    }
}
#endif

#if PEER_MX == 2
#ifndef MXN
#if PEER_MX3
#define MXN 6
#else
#define MXN 7
#endif
#endif
namespace mx2 { constexpr int XQ = MXN * 8192, WF = XQ + 1024, XR = XQ + 2048, HR = XQ + 4096, WL = XQ + 8192, BASE = 29696; }
static_assert(mx2::BASE + 2 * mx2::WL <= LDS_BYTES - 16, "LDS budget of the expert phase");
#define MX_WAIT(n_) asm volatile("s_waitcnt vmcnt(" #n_ ")" ::: "memory")
DEV void mx_ids(const int c, const int* el, const int lane, int (&e)[8]) {
    const int* p = (c < 8) ? el + 16 * c + (lane >> 5) : el + 32 * ((c - 8) & 3) + (lane >> 4);
    const int st = (c < 8) ? 2 : 4;
#pragma unroll
    for (int m = 0; m < 8; ++m) e[m] = p[st * m] & 16383;
}
DEV void mx_dma(const int c, const int (&e)[8], const int lane, const unsigned char* PU, const unsigned char* PV, PG8_LAS unsigned char* wl, int& slot) {
    PG8_LAS unsigned char* dst = wl + slot * 8192;
    if (c < 8) {
#pragma unroll
        for (int m = 0; m < 8; ++m) {
            const int row = 2 * m + (lane >> 5);
            const unsigned char* gp = PU + (size_t)e[m] * 512 + (((lane & 31) ^ mx_sw(row)) * 16);
            __builtin_amdgcn_global_load_lds((const unsigned*)gp, (PG8_LAS unsigned*)(dst + m * 1024), 16, 0, 0);
        }
    } else {
        const int hf = (c - 8) >> 2;
#pragma unroll
        for (int m = 0; m < 8; ++m) {
            const int li = 4 * m + (lane >> 4);
            const unsigned char* gp = PV + (size_t)e[m] * 512 + ((hf * 16 + ((lane & 15) ^ (li & 15))) * 16);
            __builtin_amdgcn_global_load_lds((const unsigned*)gp, (PG8_LAS unsigned*)(dst + m * 1024), 16, 0, 0);
        }
    }
    slot = (slot + 1 == MXN) ? 0 : slot + 1;
}
DEV void mx_dma_x(const bf16_t* hb, const int t, const int lane, PG8_LAS unsigned char* wl) {
#pragma unroll
    for (int i = 0; i < 2; ++i) __builtin_amdgcn_global_load_lds((const unsigned*)((const unsigned char*)hb + (size_t)t * 2048 + i * 1024 + lane * 16), (PG8_LAS unsigned*)(wl + mx2::XR + i * 1024), 16, 0, NT_HINTS ? 2 : 0);
}
DEV void mx_dma_h(const float* h, const int t, const int lane, PG8_LAS unsigned char* wl) {
#pragma unroll
    for (int i = 0; i < 4; ++i) __builtin_amdgcn_global_load_lds((const unsigned*)((const unsigned char*)h + (size_t)t * 4096 + i * 1024 + lane * 16), (PG8_LAS unsigned*)(wl + mx2::HR + i * 1024), 16, 0, NT_HINTS ? 2 : 0);
}
DEV float mx_erf(float x) { const float ax = fabsf(x), t = __builtin_amdgcn_rcpf(1.0f + 0.3275911f * ax);
    const float pl = ((((1.061405429f * t - 1.453152027f) * t + 1.421413741f) * t - 0.284496736f) * t + 0.254829592f) * t;
    return copysignf(1.0f - pl * __expf(-ax * ax), x); }
DEV void ph_peer_mx2(const Args& a, const int tid0, const int t0, const int tstride, const int ntok, const int* EL, const float* RL, const int tbase, PG8_LAS unsigned char* wl, unsigned char* wg) {
    const int lane = tid0 & 63, r = lane & 15, kq = lane >> 4, ri = r & 3;
    bf16_t* hb = wsb(a, HB_OFF); float* rstd = wsf(a, RSTD_OFF);
    const unsigned char* PU = a.ws + PTU_OFF; const unsigned char* PV = a.ws + PTV_OFF;
    if (ntok <= 0) return;
    int sm1[4], sm2[4];
#pragma unroll
    for (int q = 0; q < 4; ++q) { const bool on = ((r >> 2) == q); const int sh = 8 * (r & 3); sm1[q] = on ? (0x7F << sh) : 0; sm2[q] = on ? (0x7C << sh) : 0; }
    __builtin_amdgcn_s_setprio(PEER_PRIO);
    int islot = 0, cslot = 0;
    {   const int* el0 = EL + (t0 - tbase) * 128;
        mx_dma_x(hb, t0, lane, wl);
#pragma unroll 1
        for (int c = 0; c < MXN; ++c) { int e[8]; mx_ids(c, el0, lane, e); mx_dma(c, e, lane, PU, PV, wl, islot); }
        mx_dma_h(a.h, t0, lane, wl); }
#pragma unroll 1
    for (int j = 0; j < ntok; ++j) {
        const int t = t0 + tstride * j; const bool more = (j + 1 < ntok);
        const int* el = EL + (t - tbase) * 128; const int* eln = el + tstride * 128;
        if (j == 0) MX_WAIT(56); else MX_WAIT(32);
        {   const u32x4 xa = *(const u32x4*)(wg + mx2::XR + 32 * lane), xb = *(const u32x4*)(wg + mx2::XR + 32 * lane + 16);
            const float sc = RL[t - tbase] * mx::XSC;
            u32x2 q1 = {0u, 0u}, q2 = {0u, 0u};
            MX_Q2(q1.x, q2.x, bflo(xa.x) * sc, bfhi(xa.x) * sc, 0); MX_Q2(q1.x, q2.x, bflo(xa.y) * sc, bfhi(xa.y) * sc, 1); MX_Q2(q1.x, q2.x, bflo(xa.z) * sc, bfhi(xa.z) * sc, 2); MX_Q2(q1.x, q2.x, bflo(xa.w) * sc, bfhi(xa.w) * sc, 3);
            MX_Q2(q1.y, q2.y, bflo(xb.x) * sc, bfhi(xb.x) * sc, 0); MX_Q2(q1.y, q2.y, bflo(xb.y) * sc, bfhi(xb.y) * sc, 1); MX_Q2(q1.y, q2.y, bflo(xb.z) * sc, bfhi(xb.z) * sc, 2); MX_Q2(q1.y, q2.y, bflo(xb.w) * sc, bfhi(xb.w) * sc, 3);
            *(u32x2*)(wg + mx2::XQ + 8 * lane) = q1; *(u32x2*)(wg + mx2::XQ + 512 + 8 * lane) = q2; }
        u32x4 xB1[8], xB2[8];
#pragma unroll
        for (int s = 0; s < 8; ++s) { xB1[s] = *(const u32x4*)(wg + mx2::XQ + 64 * s + 16 * kq); xB2[s] = *(const u32x4*)(wg + mx2::XQ + 512 + 64 * s + 16 * kq); }
#pragma unroll 1
        for (int g = 0; g < 8; ++g) {
            int en[8]; mx_ids(g + MXN, el, lane, en);
            const float gt = (float)((unsigned)el[16 * g + 4 * kq + ri] >> 14) * (1.0f / 262143.0f);
            asm volatile("s_waitcnt vmcnt(%0)" :: "n"(8 * (MXN - 1)) : "memory");
            const unsigned char* ub = wg + cslot * 8192;
            f32x4 acc1 = {0.f, 0.f, 0.f, 0.f}, acc2 = {0.f, 0.f, 0.f, 0.f};
#pragma unroll
            for (int s = 0; s < 8; ++s) {
                const u32x4 a4 = *(const u32x4*)(ub + r * 512 + (((4 * s + kq) ^ mx_sw(r)) * 16));
#if MX_HWS
                acc1 = MXF(MX8(a4), MX8(xB1[s]), acc1); acc1 = MXFS(MX8(a4), MX8(xB2[s]), acc1, 0x7C7C7C7C);
#else
                acc1 = MXF(MX8(a4), MX8(xB1[s]), acc1); acc2 = MXF(MX8(a4), MX8(xB2[s]), acc2);
#endif
            }
            asm volatile("" ::: "memory");
            cslot = (cslot + 1 == MXN) ? 0 : cslot + 1;
            mx_dma(g + MXN, en, lane, PU, PV, wl, islot);
            const float d0 = acc1[0] + 0.125f * acc2[0], d1 = acc1[1] + 0.125f * acc2[1], d2 = acc1[2] + 0.125f * acc2[2], d3 = acc1[3] + 0.125f * acc2[3];
            const float hp = ((ri & 2) ? ((ri & 1) ? d3 : d2) : ((ri & 1) ? d1 : d0)) * (1.0f / (PEER_USC * mx::XSC));
            const float w = gt * 0.5f * hp * (1.0f + mx_erf(hp * 0.70710678f));
            if (r < 4) *(float*)(wg + mx2::WF + (16 * g + 4 * kq + r) * 4) = w;
            asm volatile("" ::: "memory");
        }
        float wmx = fmaxf(fabsf(*(const float*)(wg + mx2::WF + 4 * lane)), fabsf(*(const float*)(wg + mx2::WF + 256 + 4 * lane)));
        wmx = wave_max(wmx);
        const float wS = (wmx > 0.f) ? 4.0f * __builtin_amdgcn_rcpf(wmx) : 0.f, wIS = wmx * 0.25f * (1.0f / PEER_VSC);
        u32x4 wB1, wB2;
        {   const f32x2 wp = *(const f32x2*)(wg + mx2::WF + 4 * (32 * kq + 2 * r));
            unsigned b1 = 0u, b2 = 0u;
            MX_Q2(b1, b2, wp[0] * wS, wp[1] * wS, 0);
            unsigned char* wq = wg + mx2::WF + 512 + 16 * kq + r;
            wq[0] = (unsigned char)b1; wq[64] = (unsigned char)b2;
            wB1 = *(const u32x4*)(wg + mx2::WF + 512 + 16 * kq); wB2 = *(const u32x4*)(wg + mx2::WF + 576 + 16 * kq); }
        float ss = 0.f;
#pragma unroll 1
        for (int hf = 0; hf < 2; ++hf) {
            int e4[4][8];
#pragma unroll
            for (int i4 = 0; i4 < 4; ++i4) { const int ca = 8 + MXN + 4 * hf + i4; if (ca < 16) mx_ids(ca, el, lane, e4[i4]); else mx_ids(ca - 16, eln, lane, e4[i4]); }
            if (hf == 0 || more) asm volatile("s_waitcnt vmcnt(%0)" :: "n"(8 * (MXN - 4)) : "memory"); else MX_WAIT(0);
            int vs = cslot + kq; vs = (vs >= MXN) ? vs - MXN : vs;
            const unsigned vbase = (unsigned)(size_t)wg + vs * 8192 + r * 256;
#pragma unroll 1
            for (int cg = 0; cg < 2; ++cg) {
                f32x4 acc = {0.f, 0.f, 0.f, 0.f};
                u32x2 L0, H0, L1, H1, L2, H2;
#define MX_AD(cb_) (vbase + ((((cb_) >> 1) ^ r) * 16) + ((cb_) & 1) * 8)
#define MX_RD(Ln_, Hn_, cb_) asm volatile("ds_read_b64_tr_b4 %0, %2\n\tds_read_b64_tr_b4 %1, %2 offset:4096" : "=&v"(Ln_), "=&v"(Hn_) : "v"(MX_AD(cb_)) : "memory")
#define MX_RDW(Ln_, Hn_, Lc_, Hc_, cb_) asm volatile("ds_read_b64_tr_b4 %0, %4\n\tds_read_b64_tr_b4 %1, %4 offset:4096\n\ts_waitcnt lgkmcnt(4)" : "=&v"(Ln_), "=&v"(Hn_), "+v"(Lc_), "+v"(Hc_) : "v"(MX_AD(cb_)) : "memory")
#define MX_W(n_, Lc_, Hc_) asm volatile("s_waitcnt lgkmcnt(" #n_ ")" : "+v"(Lc_), "+v"(Hc_) :: "memory")
#define MX_MM(cb16_, Lc_, Hc_) do { const i32x8 A8 = {(int)Lc_.x, (int)Lc_.y, (int)Hc_.x, (int)Hc_.y, 0, 0, 0, 0}; \
                      \
                    acc = __builtin_amdgcn_mfma_scale_f32_16x16x128_f8f6f4(A8, MX8(wB1), acc, 4, 4, 0, 0x7F7F7F7F, (cb16_) & 3, sm1[(cb16_) >> 2]); \
                    acc = __builtin_amdgcn_mfma_scale_f32_16x16x128_f8f6f4(A8, MX8(wB2), acc, 4, 4, 0, 0x7F7F7F7F, (cb16_) & 3, sm2[(cb16_) >> 2]); } while (0)
                MX_RD(L0, H0, cg * 16); MX_RD(L1, H1, cg * 16 + 1);
                MX_RDW(L2, H2, L0, H0, cg * 16 + 2); MX_MM(0, L0, H0);   MX_RDW(L0, H0, L1, H1, cg * 16 + 3); MX_MM(1, L1, H1);   MX_RDW(L1, H1, L2, H2, cg * 16 + 4); MX_MM(2, L2, H2);
                MX_RDW(L2, H2, L0, H0, cg * 16 + 5); MX_MM(3, L0, H0);   MX_RDW(L0, H0, L1, H1, cg * 16 + 6); MX_MM(4, L1, H1);   MX_RDW(L1, H1, L2, H2, cg * 16 + 7); MX_MM(5, L2, H2);
                MX_RDW(L2, H2, L0, H0, cg * 16 + 8); MX_MM(6, L0, H0);   MX_RDW(L0, H0, L1, H1, cg * 16 + 9); MX_MM(7, L1, H1);   MX_RDW(L1, H1, L2, H2, cg * 16 + 10); MX_MM(8, L2, H2);
                MX_RDW(L2, H2, L0, H0, cg * 16 + 11); MX_MM(9, L0, H0);  MX_RDW(L0, H0, L1, H1, cg * 16 + 12); MX_MM(10, L1, H1); MX_RDW(L1, H1, L2, H2, cg * 16 + 13); MX_MM(11, L2, H2);
                MX_RDW(L2, H2, L0, H0, cg * 16 + 14); MX_MM(12, L0, H0); MX_RDW(L0, H0, L1, H1, cg * 16 + 15); MX_MM(13, L1, H1);
                MX_W(2, L2, H2); MX_MM(14, L2, H2); MX_W(0, L0, H0); MX_MM(15, L0, H0);
#undef MX_RD
#undef MX_RDW
#undef MX_W
#undef MX_MM
#undef MX_AD
                const int c0 = hf * 512 + cg * 256 + 16 * r + 4 * kq;
                f32x4 hv = *(const f32x4*)(wg + mx2::HR + 4 * c0);
#pragma unroll
                for (int i2 = 0; i2 < 4; ++i2) { hv[i2] += acc[i2] * wIS; ss += hv[i2] * hv[i2]; }
                u32x2 pk; pk.x = pack2(hv[0], hv[1]); pk.y = pack2(hv[2], hv[3]);
#if NT_HINTS
                __builtin_nontemporal_store(hv, (f32x4*)(a.h + (size_t)t * 1024 + c0)); __builtin_nontemporal_store(pk, (u32x2*)(hb + (size_t)t * 1024 + c0));
#else
                *(f32x4*)(a.h + (size_t)t * 1024 + c0) = hv; *(u32x2*)(hb + (size_t)t * 1024 + c0) = pk;
#endif
            }
            asm volatile("" ::: "memory");
            cslot += 4; cslot = (cslot >= MXN) ? cslot - MXN : cslot;
#pragma unroll
            for (int i4 = 0; i4 < 4; ++i4) { const int ca = 8 + MXN + 4 * hf + i4; if (ca < 16) mx_dma(ca, e4[i4], lane, PU, PV, wl, islot); else if (more) mx_dma(ca - 16, e4[i4], lane, PU, PV, wl, islot); }
            if (more) { if (hf == 0) mx_dma_x(hb, t + tstride, lane, wl); else mx_dma_h(a.h, t + tstride, lane, wl); }
            asm volatile("" ::: "memory");
        }
        ss = wave_sum(ss);
        if (lane == 0) rstd[t] = rsqrtf(ss * (1.0f / 1024.0f) + 1e-6f);
    }
    asm volatile("s_waitcnt vmcnt(0) lgkmcnt(0)" ::: "memory");
    __builtin_amdgcn_s_setprio(0);
}
#endif

#if PEER_MX3
namespace mx3 { constexpr int XQ = MXN * 8192, WF = XQ + 1024, XR = XQ + 2048, HR = XQ + 4096, WQ = XQ + 12288, WIS = WQ + 1536, WL = XQ + 14336, BASE = 29696; }
static_assert(mx3::BASE + 2 * mx3::WL <= LDS_BYTES - 16, "LDS budget of the expert phase (two-pass)");
DEV void mx3_dma_rows(const unsigned char* src, const int n, const int lane, PG8_LAS unsigned char* dst) {
#pragma unroll
    for (int i = 0; i < 4; ++i) if (i < n) __builtin_amdgcn_global_load_lds((const unsigned*)(src + i * 1024 + lane * 16), (PG8_LAS unsigned*)(dst + i * 1024), 16, 0, 0);
}
DEV void ph_peer_mx3(const Args& a, const int tid0, const int t0, const int tstride, const int ntok, const int* EL, const float* RL, const int tbase, PG8_LAS unsigned char* wl, unsigned char* wg) {
    const int lane = tid0 & 63, r = lane & 15, kq = lane >> 4, ri = r & 3;
    bf16_t* hb = wsb(a, HB_OFF); float* rstd = wsf(a, RSTD_OFF);
    const unsigned char* PU = a.ws + PTU_OFF; const unsigned char* PV = a.ws + PTV_OFF;
    if (ntok <= 0) return;
    int sm1[4], sm2[4];
#pragma unroll
    for (int q = 0; q < 4; ++q) { const bool on = ((r >> 2) == q); const int sh = 8 * (r & 3); sm1[q] = on ? (0x7F << sh) : 0; sm2[q] = on ? (0x7C << sh) : 0; }
    const int NU8 = 8 * ntok, NS = 16 * ntok;
    const int* EL0 = EL + (t0 - tbase) * 128;
    int islot = 0, cslot = 0, ni = 0;
#define MX3_TOKC(n_, tok_, c_) const int tok_ = ((n_) < NU8) ? ((n_) >> 3) : (((n_) - NU8) >> 3); const int c_ = ((n_) < NU8) ? ((n_) & 7) : (8 + (((n_) - NU8) & 7))
#define MX3_IDS(n_, e_) do { MX3_TOKC(n_, tk_, cc_); mx_ids(cc_, EL0 + tstride * tk_ * 128, lane, e_); } while (0)
#define MX3_DMA(n_, e_) do { if ((n_) < NS) { MX3_TOKC(n_, tk_, cc_); mx_dma(cc_, e_, lane, PU, PV, wl, islot); } } while (0)
    mx3_dma_rows((const unsigned char*)hb + (size_t)t0 * 2048, 2, lane, wl + mx3::XR);
#pragma unroll 1
    for (int c = 0; c < MXN; ++c) { int e[8]; MX3_IDS(ni, e); MX3_DMA(ni, e); ++ni; }
#pragma unroll 1
    for (int j = 0; j < ntok; ++j) {
        const int t = t0 + tstride * j;
        const int* el = EL0 + tstride * j * 128;
        if (j == 0) asm volatile("s_waitcnt vmcnt(%0)" :: "n"(8 * MXN) : "memory"); else MX_WAIT(56);
        {   const u32x4 xa = *(const u32x4*)(wg + mx3::XR + 32 * lane), xb = *(const u32x4*)(wg + mx3::XR + 32 * lane + 16);
            const float sc = RL[t - tbase] * mx::XSC;
            u32x2 q1 = {0u, 0u}, q2 = {0u, 0u};
            MX_Q2(q1.x, q2.x, bflo(xa.x) * sc, bfhi(xa.x) * sc, 0); MX_Q2(q1.x, q2.x, bflo(xa.y) * sc, bfhi(xa.y) * sc, 1); MX_Q2(q1.x, q2.x, bflo(xa.z) * sc, bfhi(xa.z) * sc, 2); MX_Q2(q1.x, q2.x, bflo(xa.w) * sc, bfhi(xa.w) * sc, 3);
            MX_Q2(q1.y, q2.y, bflo(xb.x) * sc, bfhi(xb.x) * sc, 0); MX_Q2(q1.y, q2.y, bflo(xb.y) * sc, bfhi(xb.y) * sc, 1); MX_Q2(q1.y, q2.y, bflo(xb.z) * sc, bfhi(xb.z) * sc, 2); MX_Q2(q1.y, q2.y, bflo(xb.w) * sc, bfhi(xb.w) * sc, 3);
            *(u32x2*)(wg + mx3::XQ + 8 * lane) = q1; *(u32x2*)(wg + mx3::XQ + 512 + 8 * lane) = q2; }
        u32x4 xB1[8], xB2[8];
#pragma unroll
        for (int s = 0; s < 8; ++s) { xB1[s] = *(const u32x4*)(wg + mx3::XQ + 64 * s + 16 * kq); xB2[s] = *(const u32x4*)(wg + mx3::XQ + 512 + 64 * s + 16 * kq); }
        asm volatile("s_waitcnt lgkmcnt(0)" ::: "memory");
        if (j + 1 < ntok) mx3_dma_rows((const unsigned char*)hb + (size_t)(t + tstride) * 2048, 2, lane, wl + mx3::XR);
        if (j == ntok - 1) mx3_dma_rows((const unsigned char*)a.h + (size_t)t0 * 4096, 4, lane, wl + mx3::HR);
#pragma unroll 1
        for (int g = 0; g < 8; ++g) {
            int en[8]; MX3_IDS(ni, en);
            const float gt = (float)((unsigned)el[16 * g + 4 * kq + ri] >> 14) * (1.0f / 262143.0f);
            asm volatile("s_waitcnt vmcnt(%0)" :: "n"(8 * (MXN - 1)) : "memory");
            const unsigned char* ub = wg + cslot * 8192;
            f32x4 acc1 = {0.f, 0.f, 0.f, 0.f};
#pragma unroll
            for (int s = 0; s < 8; ++s) {
                const u32x4 a4 = *(const u32x4*)(ub + r * 512 + (((4 * s + kq) ^ mx_sw(r)) * 16));
                acc1 = MXF(MX8(a4), MX8(xB1[s]), acc1); acc1 = MXFS(MX8(a4), MX8(xB2[s]), acc1, 0x7C7C7C7C);
            }
            asm volatile("" ::: "memory");
            cslot = (cslot + 1 == MXN) ? 0 : cslot + 1;
            MX3_DMA(ni, en); ++ni;
            const float hp = ((ri & 2) ? ((ri & 1) ? acc1[3] : acc1[2]) : ((ri & 1) ? acc1[1] : acc1[0])) * (1.0f / (PEER_USC * mx::XSC));
            const float w = gt * 0.5f * hp * (1.0f + mx_erf(hp * 0.70710678f));
            if (r < 4) *(float*)(wg + mx3::WF + (16 * g + 4 * kq + r) * 4) = w;
            asm volatile("" ::: "memory");
        }
        float wmx = fmaxf(fabsf(*(const float*)(wg + mx3::WF + 4 * lane)), fabsf(*(const float*)(wg + mx3::WF + 256 + 4 * lane)));
        wmx = wave_max(wmx);
        const float wS = (wmx > 0.f) ? 4.0f * __builtin_amdgcn_rcpf(wmx) : 0.f;
        {   const f32x2 wp = *(const f32x2*)(wg + mx3::WF + 4 * (32 * kq + 2 * r));
            unsigned b1 = 0u, b2 = 0u;
            MX_Q2(b1, b2, wp[0] * wS, wp[1] * wS, 0);
            unsigned char* wq = wg + mx3::WQ + 128 * j + 16 * kq + r;
            wq[0] = (unsigned char)b1; wq[64] = (unsigned char)b2;
            if (lane == 0) *(float*)(wg + mx3::WIS + 4 * j) = wmx * 0.25f * (1.0f / PEER_VSC); }
        asm volatile("s_waitcnt lgkmcnt(0)" ::: "memory");
    }
#pragma unroll 1
    for (int j = 0; j < ntok; ++j) {
        const int t = t0 + tstride * j;
        if (j + 1 < ntok) mx3_dma_rows((const unsigned char*)a.h + (size_t)(t + tstride) * 4096, 4, lane, wl + mx3::HR + ((j + 1) & 1) * 4096);
        const u32x4 wB1 = *(const u32x4*)(wg + mx3::WQ + 128 * j + 16 * kq), wB2 = *(const u32x4*)(wg + mx3::WQ + 128 * j + 64 + 16 * kq);
        const float wIS = *(const float*)(wg + mx3::WIS + 4 * j);
        const unsigned char* hrow = wg + mx3::HR + (j & 1) * 4096;
        float ss = 0.f;
#pragma unroll 1
        for (int hf = 0; hf < 2; ++hf) {
            int e4[4][8];
#pragma unroll
            for (int i4 = 0; i4 < 4; ++i4) MX3_IDS(ni + i4, e4[i4]);
            const int nlast = NU8 + 8 * j + 4 * hf + 3, nis = (ni < NS) ? ni : NS;
            if (nis - 1 - nlast >= MXN - 4) asm volatile("s_waitcnt vmcnt(%0)" :: "n"(8 * (MXN - 4)) : "memory"); else MX_WAIT(0);
            int vs = cslot + kq; vs = (vs >= MXN) ? vs - MXN : vs;
            const unsigned vbase = (unsigned)(size_t)wg + vs * 8192 + r * 256;
#pragma unroll 1
            for (int cg = 0; cg < 2; ++cg) {
                f32x4 acc = {0.f, 0.f, 0.f, 0.f};
                u32x2 L0, H0, L1, H1, L2, H2;
#define MX_AD(cb_) (vbase + ((((cb_) >> 1) ^ r) * 16) + ((cb_) & 1) * 8)
#define MX_RD(Ln_, Hn_, cb_) asm volatile("ds_read_b64_tr_b4 %0, %2\n\tds_read_b64_tr_b4 %1, %2 offset:4096" : "=&v"(Ln_), "=&v"(Hn_) : "v"(MX_AD(cb_)) : "memory")
#define MX_RDW(Ln_, Hn_, Lc_, Hc_, cb_) asm volatile("ds_read_b64_tr_b4 %0, %4\n\tds_read_b64_tr_b4 %1, %4 offset:4096\n\ts_waitcnt lgkmcnt(4)" : "=&v"(Ln_), "=&v"(Hn_), "+v"(Lc_), "+v"(Hc_) : "v"(MX_AD(cb_)) : "memory")
#define MX_W(n_, Lc_, Hc_) asm volatile("s_waitcnt lgkmcnt(" #n_ ")" : "+v"(Lc_), "+v"(Hc_) :: "memory")
#define MX_MM(cb16_, Lc_, Hc_) do { const i32x8 A8 = {(int)Lc_.x, (int)Lc_.y, (int)Hc_.x, (int)Hc_.y, 0, 0, 0, 0}; \
                    acc = __builtin_amdgcn_mfma_scale_f32_16x16x128_f8f6f4(A8, MX8(wB1), acc, 4, 4, 0, 0x7F7F7F7F, (cb16_) & 3, sm1[(cb16_) >> 2]); \
                    acc = __builtin_amdgcn_mfma_scale_f32_16x16x128_f8f6f4(A8, MX8(wB2), acc, 4, 4, 0, 0x7F7F7F7F, (cb16_) & 3, sm2[(cb16_) >> 2]); } while (0)
                MX_RD(L0, H0, cg * 16); MX_RD(L1, H1, cg * 16 + 1);
                MX_RDW(L2, H2, L0, H0, cg * 16 + 2); MX_MM(0, L0, H0);   MX_RDW(L0, H0, L1, H1, cg * 16 + 3); MX_MM(1, L1, H1);   MX_RDW(L1, H1, L2, H2, cg * 16 + 4); MX_MM(2, L2, H2);
                MX_RDW(L2, H2, L0, H0, cg * 16 + 5); MX_MM(3, L0, H0);   MX_RDW(L0, H0, L1, H1, cg * 16 + 6); MX_MM(4, L1, H1);   MX_RDW(L1, H1, L2, H2, cg * 16 + 7); MX_MM(5, L2, H2);
                MX_RDW(L2, H2, L0, H0, cg * 16 + 8); MX_MM(6, L0, H0);   MX_RDW(L0, H0, L1, H1, cg * 16 + 9); MX_MM(7, L1, H1);   MX_RDW(L1, H1, L2, H2, cg * 16 + 10); MX_MM(8, L2, H2);
                MX_RDW(L2, H2, L0, H0, cg * 16 + 11); MX_MM(9, L0, H0);  MX_RDW(L0, H0, L1, H1, cg * 16 + 12); MX_MM(10, L1, H1); MX_RDW(L1, H1, L2, H2, cg * 16 + 13); MX_MM(11, L2, H2);
                MX_RDW(L2, H2, L0, H0, cg * 16 + 14); MX_MM(12, L0, H0); MX_RDW(L0, H0, L1, H1, cg * 16 + 15); MX_MM(13, L1, H1);
                MX_W(2, L2, H2); MX_MM(14, L2, H2); MX_W(0, L0, H0); MX_MM(15, L0, H0);
#undef MX_RD
#undef MX_RDW
#undef MX_W
#undef MX_MM
#undef MX_AD
                const int c0 = hf * 512 + cg * 256 + 16 * r + 4 * kq;
                f32x4 hv = *(const f32x4*)(hrow + 4 * c0);
#pragma unroll
                for (int i2 = 0; i2 < 4; ++i2) { hv[i2] += acc[i2] * wIS; ss += hv[i2] * hv[i2]; }
                *(f32x4*)(a.h + (size_t)t * 1024 + c0) = hv;
                u32x2 pk; pk.x = pack2(hv[0], hv[1]); pk.y = pack2(hv[2], hv[3]);
                *(u32x2*)(hb + (size_t)t * 1024 + c0) = pk;
            }
            asm volatile("" ::: "memory");
            cslot += 4; cslot = (cslot >= MXN) ? cslot - MXN : cslot;
#pragma unroll
            for (int i4 = 0; i4 < 4; ++i4) { MX3_DMA(ni, e4[i4]); ++ni; }
            asm volatile("" ::: "memory");
        }
        ss = wave_sum(ss);
        if (lane == 0) rstd[t] = rsqrtf(ss * (1.0f / 1024.0f) + 1e-6f);
    }
    asm volatile("s_waitcnt vmcnt(0) lgkmcnt(0)" ::: "memory");
#undef MX3_TOKC
#undef MX3_IDS
#undef MX3_DMA
}
#endif

#ifndef PEER_NPW
#define PEER_NPW 2
#endif
DEV void ph_topk_peer(const Args& a, float* lds, const int tid0) {
    const int wv = __builtin_amdgcn_readfirstlane(tid0 >> 6);
    constexpr int TPW = T / NWG, MC = PEER_MC, NMC = TPW / MC, GPT = 8 / TOPK_NU;
    static_assert(TPW * NWG == T && NMC * MC == TPW, "token split");
#if PEER_MX == 2
    int* EL = (int*)(lds + 2048);
    float* RLb = (float*)(EL + 2 * MC * 128);
    int* CT = (int*)(RLb + 2 * MC);
    static_assert(8192 + 2 * MC * 128 * 4 + 2 * MC * 4 + 8 <= mx2::BASE && TOPK_NU == 4, "list area (the selection scratch is 8 KB with 4 heads per iteration)");
    if (tid0 == 0) { CT[0] = 0; CT[1] = 0; }
#else
    int* EL = (int*)(lds + 4096);
    float* GL = (float*)(EL + 2 * MC * 128);
#endif
    const int tok_wg = blockIdx.x * TPW;
    __syncthreads();
#pragma unroll 1
    for (int s = 0; s <= NMC; ++s) {
        const int tsel = tok_wg + s * MC, tgat = tok_wg + (s - 1) * MC;
        int* ELs = EL + (s & 1) * MC * 128; const int* ELg = EL + ((s - 1) & 1) * MC * 128;
#if PEER_MX == 2
        float* RLs = RLb + (s & 1) * MC; const float* RLg = RLb + ((s - 1) & 1) * MC;
        if (tid0 == NTHR - 1) CT[(s + 1) & 1] = 0;
        if (s == 0) {
            ph_topk2(a, lds, tid0, tsel * GPT, 8, (tsel + MC) * GPT, ELs, nullptr, tsel, RLs, CT + (s & 1));
        } else if (PEER_ISPW(wv)) {
            const int pw = PEER_PWI(wv);
#if PEER_MX3
            ph_peer_mx3(a, tid0, tgat + pw, PEER_NPW, (MC - pw + PEER_NPW - 1) / PEER_NPW, ELg, RLg, tgat,
                        (PG8_LAS unsigned char*)smem + mx3::BASE + pw * mx3::WL, (unsigned char*)lds + mx3::BASE + pw * mx3::WL);
#else
            ph_peer_mx2(a, tid0, tgat + pw, PEER_NPW, (MC - pw + PEER_NPW - 1) / PEER_NPW, ELg, RLg, tgat,
                        (PG8_LAS unsigned char*)smem + mx2::BASE + pw * mx2::WL, (unsigned char*)lds + mx2::BASE + pw * mx2::WL);
#endif
#if TOPK_DYN
            if (s < NMC) ph_topk2(a, lds, tid0, tsel * GPT, 8, (tsel + MC) * GPT, ELs, nullptr, tsel, RLs, CT + (s & 1));
#endif
        } else if (s < NMC) {
            __builtin_amdgcn_s_setprio(TOPK_PRIO);
#if TOPK_DYN
#if TOPK_MIX
            if ((wv & 3) >= 2) ph_topk2<true>(a, lds, tid0, tsel * GPT, 8 - PEER_NPW, (tsel + MC) * GPT, ELs, nullptr, tsel, RLs, CT + (s & 1));
            else
#endif
            ph_topk2(a, lds, tid0, tsel * GPT, 8 - PEER_NPW, (tsel + MC) * GPT, ELs, nullptr, tsel, RLs, CT + (s & 1));
#else
            for (int rep_ = 0; rep_ < REP_TOPK; ++rep_)
            ph_topk2(a, lds, tid0, tsel * GPT + (wv - PEER_NPW), 8 - PEER_NPW, (tsel + MC) * GPT, ELs, nullptr, tsel, RLs);
#endif
        }
#else
        float* GLs = GL + (s & 1) * MC * 128; const float* GLg = GL + ((s - 1) & 1) * MC * 128;
        if (s == 0) {
            ph_topk2(a, lds, tid0, tsel * GPT + wv, 8, (tsel + MC) * GPT, ELs, GLs, tsel);
#if PEER_MX
        } else if (wv < PEER_NPW) {
            ph_peer_mx(a, tid0, tgat + wv, PEER_NPW, (MC - wv + PEER_NPW - 1) / PEER_NPW, ELg, GLg, tgat,
                       (PG8_LAS unsigned char*)smem + mx::BASE + wv * mx::WL, (unsigned char*)lds + mx::BASE + wv * mx::WL);
        } else if (s == NMC) {
#else
        } else if (s == NMC) {
            PEER_PIPE(a, tid0, tgat + wv, 8, (MC - wv + 7) / 8, ELg, GLg, tgat);
        } else if (wv < PEER_NPW) {
            PEER_PIPE(a, tid0, tgat + wv, PEER_NPW, (MC - wv + PEER_NPW - 1) / PEER_NPW, ELg, GLg, tgat);
#endif
        } else {
            ph_topk2(a, lds, tid0, tsel * GPT + (wv - PEER_NPW), 8 - PEER_NPW, (tsel + MC) * GPT, ELs, GLs, tsel);
        }
#endif
        __syncthreads();
    }
}

typedef float f32x4v __attribute__((ext_vector_type(4)));
#define MFMA16(a, b, c) __builtin_amdgcn_mfma_f32_16x16x32_bf16((a), (b), (c), 0, 0, 0)
namespace sc4 {
constexpr int E_AH = 0, E_RH = 2304, E_BH = 4608, E_KH = 6912, E_BHT = 9216, E_KHT = 12288, E_VT = 15360, E_GC = 18432, E_BYTES = 18688;
constexpr int G_NKAT = 0, G_NBRT = 768, G_NKRT = 1536, G_BYTES = 2304;
constexpr int OFF_E = 0, OFF_G = 6 * E_BYTES, OFF_NBAT = OFF_G + 4 * G_BYTES, OFF_TT = OFF_NBAT + 4 * 1024, OFF_Y = OFF_TT + 4 * 768, TOTAL = OFF_Y + 16384;
}
DEV bf16x8 frag2(u32x2 lo, u32x2 hi) { u32x4 v; v.x = lo.x; v.y = lo.y; v.z = hi.x; v.w = hi.y; return __builtin_bit_cast(bf16x8, v); }
DEV bf16x8 pack_acc(f32x4v p, f32x4v q) { u32x4 v; v.x = pack2(p[0], p[1]); v.y = pack2(p[2], p[3]); v.z = pack2(q[0], q[1]); v.w = pack2(q[2], q[3]); return __builtin_bit_cast(bf16x8, v); }
DEV void ph_scan4(const Args& a, int layer, unsigned char* lb, const int tid0) {
    using namespace sc4;
    static_assert(TOTAL <= LDS_BYTES - 16, "scan LDS map");
    const int lane = tid0 & 63, wv = __builtin_amdgcn_readfirstlane(tid0 >> 6);
    const int r = lane & 15, g = lane >> 4;
    const bf16_t* U = wsb(a, U_OFF); const bf16_t* RS = wsb(a, RS_OFF); const bf16_t* KS = wsb(a, KS_OFF); bf16_t* Uw = wsb(a, U_OFF);
    const bool is_state = wv < 4;
    const int dir = is_state ? (wv >> 1) : ((wv - 4) >> 1), role = wv & 1;
    const bf16_t* Wd = wsb(a, dir ? WB2_OFF : WF_OFF); const bf16_t* Ad = wsb(a, dir ? AB_OFF : AF_OFF);
    const u32x2 z2 = {0u, 0u}; const u32x4 z4 = {0u, 0u, 0u, 0u};
    for (int un = blockIdx.x; un < NSEQ * 8; un += gridDim.x) {
        const int seq = un >> 3, hd = un & 7; const size_t tb = (size_t)seq * 4096; const int cb = hd * 64, pch = cb + lane;
        const float kac = a.rwkv_k_a[layer * 512 + pch];
        __syncthreads();
        if (is_state) {
            f32x4v X[4][2];
#pragma unroll
            for (int m = 0; m < 4; ++m)
#pragma unroll
                for (int vt = 0; vt < 2; ++vt) X[m][vt] = (f32x4v){0.f, 0.f, 0.f, 0.f};
#pragma unroll 1
            for (int p = 0; p < 260; ++p) {
                if (p >= 2 && p < 258) {
                    const int n = p - 2;
                    const unsigned char* E = lb + OFF_E + (dir * 3 + (n % 3)) * E_BYTES;
                    const unsigned char* G = lb + OFF_G + (dir * 2 + (n & 1)) * G_BYTES;
                    float* yb = (float*)(lb + OFF_Y) + (((n & 1) * 2 + dir) * 16) * 64 + 32 * role;
                    bf16x8 fa[2], fr[2];
#pragma unroll
                    for (int s = 0; s < 2; ++s) {
                        fa[s] = frag2(*(const u32x2*)(E + E_AH + r * 144 + 2 * (32 * s + 4 * g)), *(const u32x2*)(E + E_AH + r * 144 + 2 * (32 * s + 16 + 4 * g)));
                        fr[s] = frag2(*(const u32x2*)(E + E_RH + r * 144 + 2 * (32 * s + 4 * g)), *(const u32x2*)(E + E_RH + r * 144 + 2 * (32 * s + 16 + 4 * g)));
                    }
                    const int g1 = g & 1;
                    u32x4 nka = *(const u32x4*)(G + G_NKAT + r * 48 + 16 * g1), nkr = *(const u32x4*)(G + G_NKRT + r * 48 + 16 * g1);
                    if (g >= 2) { nka = z4; nkr = z4; }
                    const bf16x8 fnka = __builtin_bit_cast(bf16x8, nka), fnkr = __builtin_bit_cast(bf16x8, nkr);
                    bf16x8 ftt;
                    {
                        const float* nbat = (const float*)(lb + OFF_NBAT + (dir * 2 + (n & 1)) * 1024);
                        unsigned char* tts = lb + OFF_TT + wv * 768;
                        float Tr[16];
#pragma unroll
                        for (int tg = 0; tg < 4; ++tg) {
                            f32x4v nbq[4][4];
#pragma unroll
                            for (int tt = 0; tt < 4; ++tt)
#pragma unroll
                                for (int i4 = 0; i4 < 4; ++i4) if (4 * i4 < 4 * tg + tt) nbq[tt][i4] = *(const f32x4v*)(nbat + (4 * tg + tt) * 16 + 4 * i4);
#pragma unroll
                            for (int tt = 0; tt < 4; ++tt) {
                                const int t = 4 * tg + tt;
                                float acc = (lane == t) ? 1.0f : 0.f, acc2 = 0.f;
#pragma unroll
                                for (int i = 0; i < t; ++i) { const float pr_ = Tr[i] * nbq[tt][i >> 2][i & 3]; if (i & 1) acc2 += pr_; else acc += pr_; }
                                acc += acc2; Tr[t] = acc;
                                if (lane < 16) *(unsigned short*)(tts + t * 48 + 2 * lane) = (unsigned short)f2bf(acc);
                            }
                        }
                        asm volatile("s_waitcnt lgkmcnt(0)" ::: "memory");
                        ftt = frag2(*(const u32x2*)(tts + r * 48 + 8 * g), z2);
                    }
                    const bf16x8 fnbr = frag2(*(const u32x2*)(G + G_NBRT + r * 48 + 8 * g), z2);
                    bf16x8 fbt[4], fkt[4]; f32x4v gc[4];
#pragma unroll
                    for (int m = 0; m < 4; ++m) {
                        fbt[m] = frag2(*(const u32x2*)(E + E_BHT + (16 * m + r) * 48 + 8 * g), z2);
                        u32x4 kt = *(const u32x4*)(E + E_KHT + (16 * m + r) * 48 + 16 * g1); if (g >= 2) kt = z4; fkt[m] = __builtin_bit_cast(bf16x8, kt);
                        gc[m] = *(const f32x4v*)(E + E_GC + 4 * (16 * m + 4 * g));
                    }
#pragma unroll
                    for (int vt = 0; vt < 2; ++vt) {
                        const int v0 = 32 * role + 16 * vt;
                        u32x4 vv = *(const u32x4*)(E + E_VT + (v0 + r) * 48 + 16 * g1); if (g >= 2) vv = z4;
                        const bf16x8 vb = __builtin_bit_cast(bf16x8, vv);
                        const bf16x8 xb0 = pack_acc(X[0][vt], X[1][vt]), xb1 = pack_acc(X[2][vt], X[3][vt]);
                        f32x4v W = {0.f, 0.f, 0.f, 0.f};
                        W = MFMA16(fa[0], xb0, W); W = MFMA16(fa[1], xb1, W); W = MFMA16(fnka, vb, W);
                        const f32x4v zero4 = {0.f, 0.f, 0.f, 0.f};
                        f32x4v Uc = MFMA16(ftt, pack_acc(W, zero4), zero4);
                        const bf16x8 ub = pack_acc(Uc, zero4);
                        f32x4v Y = {0.f, 0.f, 0.f, 0.f};
                        Y = MFMA16(fr[0], xb0, Y); Y = MFMA16(fr[1], xb1, Y); Y = MFMA16(fnbr, ub, Y); Y = MFMA16(fnkr, vb, Y);
#pragma unroll
                        for (int i = 0; i < 4; ++i) yb[(4 * g + i) * 64 + 16 * vt + r] = Y[i];
#pragma unroll
                        for (int m = 0; m < 4; ++m) { f32x4v xm = MFMA16(fbt[m], ub, X[m][vt]); xm = MFMA16(fkt[m], vb, xm); X[m][vt] = xm * gc[m]; }
                    }
                }
                __syncthreads();
            }
        } else {
            unsigned short prA[8][6], pwA[8], prB[8][6], pwB[8];
#define SC5_ISSUE(pr, pw, n_) do { _Pragma("unroll") for (int s_ = 0; s_ < 8; ++s_) { const int step_ = (n_) * 16 + 8 * role + s_, pos_ = dir ? 4095 - step_ : step_; const size_t t_ = tb + pos_; \
            pr[s_][0] = Wd[t_ * 512 + pch]; pr[s_][1] = U[t_ * UW + pch]; pr[s_][2] = Ad[t_ * 512 + pch]; pr[s_][3] = KS[t_ * 512 + pch]; pr[s_][4] = RS[t_ * 512 + pch]; pr[s_][5] = U[t_ * UW + 1536 + pch]; \
            if (role) { const int st0_ = (n_) * 16 + s_, p0_ = dir ? 4095 - st0_ : st0_; pw[s_] = Wd[(tb + p0_) * 512 + pch]; } } } while (0)
            SC5_ISSUE(prA, pwA, 0); SC5_ISSUE(prB, pwB, 1);
#define SC5_PERIOD(pr, pw, p_) do { const int p = (p_); \
                if (p < 256) { \
                    unsigned char* E = lb + OFF_E + (dir * 3 + (p % 3)) * E_BYTES; \
                    float gcur = 1.0f; \
                    if (role) { \
_Pragma("unroll") \
                        for (int s = 0; s < 8; ++s) gcur *= bf2f(pw[s]); \
                    } \
                    unsigned bt[4], kt[4], vtw[4]; \
_Pragma("unroll") \
                    for (int s = 0; s < 8; ++s) { \
                        const int st = 8 * role + s; \
                        const float w_ = bf2f(pr[s][0]), kk_ = bf2f(pr[s][1]), ic_ = bf2f(pr[s][2]), ks_ = bf2f(pr[s][3]), r_ = bf2f(pr[s][4]); \
                        const float gprev = gcur; gcur *= w_; \
                        const float ig = __builtin_amdgcn_rcpf(gcur); \
                        const unsigned ah = f2bf(-gprev * kk_), bh = f2bf(kk_ * ic_ * ig), kh = f2bf(ks_ * (1.0f + (ic_ - 1.0f) * kac) * ig), rh = f2bf(gcur * r_), vh = pr[s][5]; \
                        *(unsigned short*)(E + E_AH + st * 144 + 2 * lane) = (unsigned short)ah; *(unsigned short*)(E + E_RH + st * 144 + 2 * lane) = (unsigned short)rh; \
                        *(unsigned short*)(E + E_BH + st * 144 + 2 * lane) = (unsigned short)bh; *(unsigned short*)(E + E_KH + st * 144 + 2 * lane) = (unsigned short)kh; \
                        if (s & 1) { bt[s >> 1] |= bh << 16; kt[s >> 1] |= kh << 16; vtw[s >> 1] |= vh << 16; } else { bt[s >> 1] = bh; kt[s >> 1] = kh; vtw[s >> 1] = vh; } \
                    } \
                    *(u32x4*)(E + E_BHT + lane * 48 + 16 * role) = (u32x4){bt[0], bt[1], bt[2], bt[3]}; \
                    *(u32x4*)(E + E_KHT + lane * 48 + 16 * role) = (u32x4){kt[0], kt[1], kt[2], kt[3]}; \
                    *(u32x4*)(E + E_VT + lane * 48 + 16 * role) = (u32x4){vtw[0], vtw[1], vtw[2], vtw[3]}; \
                    if (role) *(float*)(E + E_GC + 4 * lane) = gcur; \
                } \
                if (role == 0) { \
                    if (p >= 1 && p < 257) { \
                        const int n = p - 1; \
                        const unsigned char* E = lb + OFF_E + (dir * 3 + (n % 3)) * E_BYTES; \
                        unsigned char* G = lb + OFF_G + (dir * 2 + (n & 1)) * G_BYTES; \
                        float* nbat = (float*)(lb + OFF_NBAT + (dir * 2 + (n & 1)) * 1024); \
                        bf16x8 ab[2], rb[2], bA[2], kA[2]; \
_Pragma("unroll") \
                        for (int s = 0; s < 2; ++s) { \
                            ab[s] = *(const bf16x8*)(E + E_AH + r * 144 + 2 * (32 * s + 8 * g)); rb[s] = *(const bf16x8*)(E + E_RH + r * 144 + 2 * (32 * s + 8 * g)); \
                            bA[s] = *(const bf16x8*)(E + E_BH + r * 144 + 2 * (32 * s + 8 * g)); kA[s] = *(const bf16x8*)(E + E_KH + r * 144 + 2 * (32 * s + 8 * g)); \
                        } \
                        const f32x4v zero4 = {0.f, 0.f, 0.f, 0.f}; \
                        f32x4v nba = MFMA16(bA[1], ab[1], MFMA16(bA[0], ab[0], zero4)), nka = MFMA16(kA[1], ab[1], MFMA16(kA[0], ab[0], zero4)); \
                        f32x4v nbr = MFMA16(bA[1], rb[1], MFMA16(bA[0], rb[0], zero4)), nkr = MFMA16(kA[1], rb[1], MFMA16(kA[0], rb[0], zero4)); \
_Pragma("unroll") \
                        for (int i = 0; i < 4; ++i) { const int j = 4 * g + i; if (j >= r) { nba[i] = 0.f; nka[i] = 0.f; } if (j > r) { nbr[i] = 0.f; nkr[i] = 0.f; } } \
                        *(f32x4v*)(nbat + r * 16 + 4 * g) = nba; \
                        u32x2 pk; pk.x = pack2(nka[0], nka[1]); pk.y = pack2(nka[2], nka[3]); *(u32x2*)(G + G_NKAT + r * 48 + 8 * g) = pk; \
                        pk.x = pack2(nbr[0], nbr[1]); pk.y = pack2(nbr[2], nbr[3]); *(u32x2*)(G + G_NBRT + r * 48 + 8 * g) = pk; \
                        pk.x = pack2(nkr[0], nkr[1]); pk.y = pack2(nkr[2], nkr[3]); *(u32x2*)(G + G_NKRT + r * 48 + 8 * g) = pk; \
                    } \
                } else { \
                    if (p >= 3 && p < 259) { \
                        const int n = p - 3; \
                        const float* yb = (const float*)(lb + OFF_Y) + (((n & 1) * 2 + dir) * 16) * 64; \
                        const int s2 = lane >> 2, c16 = (lane & 3) * 16; \
                        const f32x4v y0 = *(const f32x4v*)(yb + s2 * 64 + c16), y1 = *(const f32x4v*)(yb + s2 * 64 + c16 + 4), y2 = *(const f32x4v*)(yb + s2 * 64 + c16 + 8), y3 = *(const f32x4v*)(yb + s2 * 64 + c16 + 12); \
                        const int step = n * 16 + s2, pos = dir ? 4095 - step : step; \
                        u32x4 o0, o1; o0.x = pack2(y0[0], y0[1]); o0.y = pack2(y0[2], y0[3]); o0.z = pack2(y1[0], y1[1]); o0.w = pack2(y1[2], y1[3]); \
                        o1.x = pack2(y2[0], y2[1]); o1.y = pack2(y2[2], y2[3]); o1.z = pack2(y3[0], y3[1]); o1.w = pack2(y3[2], y3[3]); \
                        bf16_t* dst = Uw + (tb + pos) * UW + 512 + 512 * dir + cb + c16; \
                        *(u32x4*)(dst) = o0; *(u32x4*)(dst + 8) = o1; \
                    } \
                } \
                if (p + 2 < 256) SC5_ISSUE(pr, pw, p + 2); \
                __syncthreads(); \
            } while (0)
#pragma unroll 1
            for (int p2 = 0; p2 < 260; p2 += 2) { SC5_PERIOD(prA, pwA, p2); SC5_PERIOD(prB, pwB, p2 + 1); }
#undef SC5_PERIOD
#undef SC5_ISSUE
        }
    }
}

extern __shared__ __attribute__((aligned(16))) unsigned char smem[];

enum { PH_PROLOGUE = 0, PH_ROWPREP_X, PH_GEMM1, PH_ATTN, PH_LORA, PH_PREP2, PH_SCAN, PH_POST, PH_GEMM2, PH_CONVERT, PH_GEMM3, PH_TOPK, PH_PEER, PH_PEERDRY, PH_TOPKPEER, PH_GEMM4A, PH_GEMM4B, PH_FINAL };

template <int PH> DEV void run_phase(const Args& a, int layer, const int tid0) {
    float* ldsf = (float*)smem;
    PG8_LAS unsigned char* ldsg = (PG8_LAS unsigned char*)smem;
    const bf16_t* wb = wsb(a, WB_OFF + (size_t)layer * WB_LAYER);
    if constexpr (PH == PH_PROLOGUE) ph_prologue(a, ldsf, tid0);
    else if constexpr (PH == PH_ROWPREP_X) ph_rowprep(a, true, tid0);
    else if constexpr (PH == PH_GEMM1) {
        pg8::Gemm g{wsb(a, HB_OFF), wb + WB_IN / 2, T, INP, 1024};
        pg8::StaticOrder S; S.init(T, INP, gridDim.x, blockIdx.x);
        pg8::EpiProj E{wsb(a, QKV_OFF), wsb(a, U_OFF), wsf(a, SSQ_OFF), wsf(a, ROPEC_OFF), wsf(a, ROPES_OFF)};
        pg8::gemm_phase<pg8::EpiProj, pg8::StaticOrder, false>(ldsg, g, S, E, nullptr, tid0);
    }
    else if constexpr (PH == PH_ATTN) ph_attn3(a, layer, smem, tid0);
    else if constexpr (PH == PH_LORA) ph_rwkv_prep1(a, layer, smem, tid0);
    else if constexpr (PH == PH_PREP2) ph_rwkv_prep2(a, layer, tid0);
    else if constexpr (PH == PH_SCAN) ph_scan4(a, layer, smem, tid0);
    else if constexpr (PH == PH_POST) ph_post2(a, layer, tid0);
    else if constexpr (PH == PH_GEMM2) {
        pg8::Gemm g{wsb(a, MIX_OFF), wb + WB_OUT / 2, T, 1024, 1024};
        pg8::StaticOrder S; S.init(T, 1024, gridDim.x, blockIdx.x);
        pg8::EpiF32x<1> E{a.h, 1024, nullptr, wsb(a, HB_OFF), wsf(a, SSQ_OFF)};
        pg8::gemm_phase<pg8::EpiF32x<1>, pg8::StaticOrder, false>(ldsg, g, S, E, nullptr, tid0);
    }
    else if constexpr (PH == PH_CONVERT) ph_convert8(a, layer, tid0);
    else if constexpr (PH == PH_GEMM3) {
        pg8::Gemm g{wsb(a, HB_OFF), wb + WB_QK / 2, T, 2048, 1024};
        pg8::StaticOrder S; S.init(T, 2048, gridDim.x, blockIdx.x);
        pg8::EpiF32x<0> E{wsf(a, SC_OFF), 2048, nullptr, nullptr, nullptr};
        pg8::gemm_phase<pg8::EpiF32x<0>, pg8::StaticOrder, false>(ldsg, g, S, E, nullptr, tid0);
    }
    else if constexpr (PH == PH_TOPK) ph_topk2(a, ldsf, tid0, blockIdx.x * 8 + (tid0 >> 6), gridDim.x * 8, T * (8 / TOPK_NU), (int*)(a.ws + TOPI_OFF), wsf(a, TOPG_OFF), 0);
    else if constexpr (PH == PH_TOPKPEER) ph_topk_peer(a, ldsf, tid0);
    else if constexpr (PH == PH_PEER) ph_peer_pipe<false>(a, tid0, blockIdx.x * 8 + (tid0 >> 6), gridDim.x * 8, T / (gridDim.x * 8), (const int*)(a.ws + TOPI_OFF), wsf(a, TOPG_OFF), 0);
    else if constexpr (PH == PH_PEERDRY) ph_peer_pipe<true>(a, tid0, blockIdx.x * 8 + (tid0 >> 6), gridDim.x * 8, T / (gridDim.x * 8), (const int*)(a.ws + TOPI_OFF), wsf(a, TOPG_OFF), 0);
    else if constexpr (PH == PH_GEMM4A) {
        pg8::Gemm g{wsb(a, HB_OFF), wb + WB_GATE / 2, T, 1024, 1024};
        pg8::StaticOrder S; S.init(T, 1024, gridDim.x, blockIdx.x);
        pg8::EpiGate E{wsb(a, GATE_OFF), wsf(a, RSTD_OFF), a.ple_b_gate + layer * 1024};
        pg8::gemm_phase<pg8::EpiGate, pg8::StaticOrder, false>(ldsg, g, S, E, nullptr, tid0);
    }
    else if constexpr (PH == PH_GEMM4B) {
        pg8::Gemm g{wsb(a, PB_OFF), wb + WB_PROJ / 2, T, 1024, 256};
        pg8::StaticOrder S; S.init(T, 1024, gridDim.x, blockIdx.x);
        pg8::EpiF32x<2> E{a.h, 1024, wsb(a, GATE_OFF), wsb(a, HB_OFF), wsf(a, SSQ_OFF)};
        pg8::gemm_phase<pg8::EpiF32x<2>, pg8::StaticOrder, false>(ldsg, g, S, E, nullptr, tid0);
    }
    else if constexpr (PH == PH_FINAL) ph_final(a, tid0);
}

#if !ONE_LAUNCH
template <int PH> __global__ void __launch_bounds__(NTHR, 2) k_phase(Args a, int layer) { run_phase<PH>(a, layer, (int)threadIdx.x); }
#endif

#if ONE_LAUNCH
#ifndef REP_PEER
#define REP_PEER 1
#endif
#ifndef REP_SCAN
#define REP_SCAN 1
#endif
#ifndef REP_TOPK
#define REP_TOPK 1
#endif
#ifndef REP_GEMM1
#define REP_GEMM1 1
#endif
#ifndef REP_LORA
#define REP_LORA 1
#endif
#ifndef REP_POST
#define REP_POST 1
#endif
#ifndef REP_ATTN
#define REP_ATTN 1
#endif
#ifndef REP_GEMM3
#define REP_GEMM3 1
#endif
typedef const __attribute__((address_space(4))) unsigned long long* kargs_t;
static_assert(sizeof(Args) == 31 * 8, "Args is 31 pointers, no padding");
#define AS1 __attribute__((address_space(1)))
DEV Args load_args(kargs_t kp) {
    Args r; const float** d = (const float**)&r;
#pragma unroll
    for (int i = 0; i < 29; ++i) d[i] = (const float*)(AS1 const float*)kp[i];
    r.h = (float*)(AS1 float*)kp[29]; r.ws = (unsigned char*)(AS1 unsigned char*)kp[30];
    return r; }
#define RUN(PH, layer) do { kargs_t kp_ = (kargs_t)__builtin_amdgcn_kernarg_segment_ptr(); asm volatile("" : "+s"(kp_)); const Args la_ = load_args(kp_); int t_; asm volatile("v_mbcnt_lo_u32_b32 %0, -1, 0\n\tv_mbcnt_hi_u32_b32 %0, -1, %0\n\tv_lshl_add_u32 %0, %1, 6, %0" : "=&v"(t_) : "s"(wv0_)); run_phase<PH>(la_, layer, t_); } while (0)
#define BAR() do { kargs_t kp_ = (kargs_t)__builtin_amdgcn_kernarg_segment_ptr(); asm volatile("" : "+s"(kp_)); XcdBarrier b_; b_.bar = (unsigned*)((unsigned char*)kp_[30] + BAR_OFF); b_.x = xb_xcc_id(); b_.st = (volatile LAS unsigned*)(smem + LDS_BYTES - 16); int t_; asm volatile("v_mbcnt_lo_u32_b32 %0, -1, 0\n\tv_mbcnt_hi_u32_b32 %0, -1, %0\n\tv_lshl_add_u32 %0, %1, 6, %0" : "=&v"(t_) : "s"(wv0_)); xcd_barrier(b_, t_); } while (0)
#if LOCAL_SEAM
#define SEAM_4A4B() __syncthreads()
#else
#define SEAM_4A4B() BAR()
#endif
#define LAYER_BODY(layer) do { \
        for (int rep_ = 0; rep_ < REP_GEMM1; ++rep_) { RUN(PH_GEMM1, layer); BAR(); } \
        for (int rep_ = 0; rep_ < REP_ATTN; ++rep_) { RUN(PH_ATTN, layer); BAR(); } \
        for (int rep_ = 0; rep_ < REP_LORA; ++rep_) { RUN(PH_LORA, layer); BAR(); } \
        for (int rep_ = 0; rep_ < REP_PREP2; ++rep_) { RUN(PH_PREP2, layer); BAR(); } \
        for (int rep_ = 0; rep_ < REP_SCAN; ++rep_) { RUN(PH_SCAN, layer); BAR(); } \
        for (int rep_ = 0; rep_ < REP_POST; ++rep_) { RUN(PH_POST, layer); BAR(); } \
        RUN(PH_GEMM2, layer); RUN(PH_CONVERT, layer); BAR(); \
        for (int rep_ = 0; rep_ < REP_GEMM3; ++rep_) { RUN(PH_GEMM3, layer); BAR(); } \
        RUN(PH_TOPKPEER, layer); BAR(); \
        for (int rep_ = 0; rep_ < REP_GEMM4A; ++rep_) { RUN(PH_GEMM4A, layer); SEAM_4A4B(); } \
        RUN(PH_GEMM4B, layer); BAR(); \
    } while (0)
__global__ void __launch_bounds__(NTHR, 2) k_mega(Args a) {
    if (threadIdx.x == 0) *(uint4*)(smem + LDS_BYTES - 16) = make_uint4(0u, 0u, 0u, 0u);
    __syncthreads();
    (void)xcd_barrier_post((unsigned*)(a.ws + BAR_OFF), (volatile LAS unsigned*)(smem + LDS_BYTES - 16));
    const int wv0_ = __builtin_amdgcn_readfirstlane((int)threadIdx.x >> 6);
    RUN(PH_PROLOGUE, 0);
    RUN(PH_ROWPREP_X, 0); BAR();
    LAYER_BODY(0); LAYER_BODY(1); LAYER_BODY(2); LAYER_BODY(3);
    RUN(PH_FINAL, 0);
}
#endif

#if !ONE_LAUNCH
template <int PH> static void launch_phase(const Args& a, int layer, hipStream_t st) {
    static bool attr = false;
    if (!attr) { (void)hipFuncSetAttribute((const void*)k_phase<PH>, hipFuncAttributeMaxDynamicSharedMemorySize, LDS_BYTES); attr = true; }
    hipLaunchKernelGGL(k_phase<PH>, dim3(NWG), dim3(NTHR), LDS_BYTES, st, a, layer);
}
#endif

extern "C" void kernel_launch(void* const* d_in, const int* in_sizes, int n_in, void* d_out, int out_size, void* d_ws, size_t ws_size, hipStream_t stream) {
    if (n_in != 29 || out_size != T * D || ws_size < WS_END) {
        fprintf(stderr, "kernel_launch: unexpected shapes (n_in %d, out %d, ws %zu, need %zu); nothing launched\n", n_in, out_size, ws_size, (size_t)WS_END);
        return;
    }
    Args a{};
    const float** ap = (const float**)&a;
    for (int i = 0; i < 29; ++i) ap[i] = (const float*)d_in[i];
    a.h = (float*)d_out; a.ws = (unsigned char*)d_ws;
#if ONE_LAUNCH
    static bool attr = false;
    if (!attr) { (void)hipFuncSetAttribute((const void*)k_mega, hipFuncAttributeMaxDynamicSharedMemorySize, LDS_BYTES); attr = true; }
    (void)hipMemsetAsync((char*)d_ws + BAR_OFF, 0, XCD_BAR_WORDS * sizeof(unsigned), stream);
    hipLaunchKernelGGL(k_mega, dim3(NWG), dim3(NTHR), LDS_BYTES, stream, a);
#else
    launch_phase<PH_PROLOGUE>(a, 0, stream);
    launch_phase<PH_ROWPREP_X>(a, 0, stream);
    for (int layer = 0; layer < NL; ++layer) {
        launch_phase<PH_GEMM1>(a, layer, stream);
        launch_phase<PH_ATTN>(a, layer, stream);
        launch_phase<PH_LORA>(a, layer, stream);
        launch_phase<PH_PREP2>(a, layer, stream);
        launch_phase<PH_SCAN>(a, layer, stream);
        launch_phase<PH_POST>(a, layer, stream);
        launch_phase<PH_GEMM2>(a, layer, stream);
        launch_phase<PH_CONVERT>(a, layer, stream);
        launch_phase<PH_GEMM3>(a, layer, stream);
        launch_phase<PH_TOPK>(a, layer, stream);
        launch_phase<PH_PEER>(a, layer, stream);
        launch_phase<PH_GEMM4A>(a, layer, stream);
        launch_phase<PH_GEMM4B>(a, layer, stream);
    }
    launch_phase<PH_FINAL>(a, 0, stream);
#endif
}
```
